# Optimizing an MI355X kernel written in HIP

```python
import math
import jax, jax.numpy as jnp
from jax import lax
import numpy as np

D_MODEL = 1024
BATCH = 8
SEQ = 2048
DEPTH = 4

CHUNK = 64
N_MIXERS = 3
N_RWKV = (DEPTH + 2) // 3
N_MLSTM = (DEPTH + 1) // 3
N_RET = DEPTH // 3
DN_ALPHA = (2 * DEPTH) ** 0.25
DN_BETA = (8 * DEPTH) ** -0.25
LN_EPS = 1e-5

RW_HEAD = 64
RW_HEADS = D_MODEL // RW_HEAD
RW_LORA_W = 64
RW_LORA_A = 64
RW_LORA_V = 32
RW_LORA_G = 128
RW_GN_EPS = 64e-5

ML_HEADS = 8
ML_QK = D_MODEL // 2
ML_V = D_MODEL
ML_DK = ML_QK // ML_HEADS
ML_DV = ML_V // ML_HEADS
ML_CONV = 4
ML_IN = 2 * ML_QK + 2 * ML_V + 2 * ML_HEADS

RT_HEADS = 4
RT_QK = D_MODEL
RT_V = 2 * D_MODEL
RT_DK = RT_QK // RT_HEADS
RT_DV = RT_V // RT_HEADS
RT_IN = 2 * RT_QK + 2 * RT_V
RT_ROPE_BASE = 10000.0

MOE_GROUPS = 4
MOE_PER_GROUP = 8
MOE_EXPERTS = MOE_GROUPS * MOE_PER_GROUP
MOE_TOPK = 2
MOE_HIDDEN = 512
MOE_BLOCK = 128

kernel_name = 'hybrid_rwkv7_mlstm_retention_hmoe_deepnorm_adaln'


def layer_norm(x, g, b, eps=LN_EPS):
    xf = x.astype(jnp.float32)
    mu = xf.mean(-1, keepdims=True)
    var = jnp.square(xf - mu).mean(-1, keepdims=True)
    return ((xf - mu) * lax.rsqrt(var + eps) * g + b).astype(x.dtype)


def head_norm(h, g, b, eps):
    B, T, H, d = h.shape
    return layer_norm(h, g.reshape(H, d), b.reshape(H, d), eps).reshape(B, T, H * d)


def token_shift(x):
    return jnp.pad(x, ((0, 0), (1, 0), (0, 0)))[:, :-1]


def causal_conv(x, w, b):
    K, T = w.shape[0], x.shape[1]
    xp = jnp.pad(x, ((0, 0), (K - 1, 0), (0, 0)))
    y = b
    for j in range(K):
        y = y + w[j] * xp[:, j:j + T]
    return y


def to_chunks(t):
    B, T, H = t.shape[:3]
    t = t.reshape(B, T // CHUNK, CHUNK, H, *t.shape[3:])
    return jnp.moveaxis(t, (1, 3), (0, 2))


def from_chunks(t):
    t = jnp.moveaxis(t, (0, 2), (1, 3))
    B, NC, L, H = t.shape[:4]
    return t.reshape(B, NC * L, H, *t.shape[4:])


def ada_modulation(c, w, b):
    mod = jax.nn.silu(c) @ w + b
    shift, scale, gate = jnp.split(mod[:, None, :], 3, axis=-1)
    return shift, scale, gate


def rwkv7_scan(r, w, k, v, a, b):
    B, T, H, N = r.shape
    seq = tuple(jnp.moveaxis(t.astype(jnp.float32), 1, 0) for t in (r, w, k, v, a, b))

    def step(S, inp):
        rt, wt, kt, vt, at, bt = inp
        sa = jnp.einsum('bhij,bhj->bhi', S, at)
        S = S * wt[:, :, None, :] + sa[..., None] * bt[:, :, None, :] + vt[..., None] * kt[:, :, None, :]
        return S, jnp.einsum('bhij,bhj->bhi', S, rt)

    _, y = lax.scan(step, jnp.zeros((B, H, N, N), jnp.float32), seq)
    return jnp.moveaxis(y, 0, 1).astype(r.dtype)


def rwkv7_mixer(h, v_first, mu, w_rkv, w0, w1, w2, a0, a1, a2, g1, g2, k_k, k_a, r_k, gn_g, gn_b, w_out, vmix):
    B, T, D = h.shape
    xx = token_shift(h) - h
    xs = h[None] + xx[None] * mu[:, None, None, :]
    r, k, v = jnp.einsum('nbtd,nde->nbte', xs[:3], w_rkv)
    xv, xw, xa, xg = xs[2], xs[3], xs[4], xs[5]
    w_log = -jax.nn.softplus(-(w0 + jnp.tanh(xw @ w1) @ w2)) - 0.5
    decay = jnp.exp(-jnp.exp(w_log.astype(jnp.float32)))
    if vmix is None:
        v_first = v
    else:
        v0, v1, v2 = vmix
        v = v + (v_first - v) * jax.nn.sigmoid(v0 + (xv @ v1) @ v2)
    a = jax.nn.sigmoid(a0 + (xa @ a1) @ a2)
    g = jax.nn.sigmoid(xg @ g1) @ g2
    heads = lambda t: t.reshape(B, T, RW_HEADS, RW_HEAD)
    kk = heads(k * k_k)
    kk = kk / jnp.maximum(jnp.sqrt(jnp.sum(kk * kk, -1, keepdims=True)), 1e-12)
    k = k * (1 + (a - 1) * k_a)
    rh, kh, vh, ah = heads(r), heads(k), heads(v), heads(a)
    y = rwkv7_scan(rh, heads(decay), kh, vh, -kk, kk * ah)
    y = head_norm(y, gn_g, gn_b, RW_GN_EPS)
    bonus = jnp.sum(rh * kh * r_k, -1, keepdims=True) * vh
    y = y + bonus.reshape(B, T, D)
    return (y * g) @ w_out, v_first


def mlstm_chunkwise(q, k, v, log_i, log_f):
    B, T, H, DK = q.shape
    DV = v.shape[-1]
    qc, kc, vc = (to_chunks(t.astype(jnp.float32)) for t in (q, k, v))
    ic, fc = to_chunks(log_i), to_chunks(log_f)
    causal = jnp.tril(jnp.ones((CHUNK, CHUNK), bool))

    def step(carry, inp):
        C, n, m = carry
        qb, kb, vb, ib, fb = inp
        bcum = jnp.cumsum(fb, -1)
        dmat = jnp.where(causal, bcum[..., :, None] - bcum[..., None, :] + ib[..., None, :], -jnp.inf)
        inter = bcum + m[..., None]
        m_s = jnp.maximum(dmat.max(-1), inter)
        s = jnp.einsum('bhsd,bhjd->bhsj', qb, kb) * jnp.exp(dmat - m_s[..., None])
        w_inter = jnp.exp(inter - m_s)
        num = jnp.einsum('bhsj,bhjv->bhsv', s, vb) + w_inter[..., None] * jnp.einsum('bhvd,bhsd->bhsv', C, qb)
        den = s.sum(-1) + w_inter * jnp.einsum('bhd,bhsd->bhs', n, qb)
        hb = num / jnp.maximum(jnp.abs(den), jnp.exp(-m_s))[..., None]
        b_end = bcum[..., -1]
        to_end = b_end[..., None] - bcum + ib
        m_new = jnp.maximum(b_end + m, to_end.max(-1))
        w_end = jnp.exp(to_end - m_new[..., None])
        carry_decay = jnp.exp(b_end + m - m_new)
        C = carry_decay[..., None, None] * C + jnp.einsum('bhj,bhjv,bhjd->bhvd', w_end, vb, kb)
        n = carry_decay[..., None] * n + jnp.einsum('bhj,bhjd->bhd', w_end, kb)
        return (C, n, m_new), hb

    init = (jnp.zeros((B, H, DV, DK), jnp.float32), jnp.zeros((B, H, DK), jnp.float32), jnp.zeros((B, H), jnp.float32))
    _, y = lax.scan(step, init, (qc, kc, vc, ic, fc))
    return from_chunks(y).astype(v.dtype)


def mlstm_mixer(h, w_in, b_gate, conv_w, conv_b, gn_g, gn_b, w_out):
    B, T, D = h.shape
    H = ML_HEADS
    proj = h @ w_in
    qk, v, o, gates = jnp.split(proj, [2 * ML_QK, 2 * ML_QK + ML_V, 2 * ML_QK + 2 * ML_V], axis=-1)
    qk = jax.nn.silu(causal_conv(qk, conv_w, conv_b))
    q, k = jnp.split(qk, 2, axis=-1)
    gates = (gates + b_gate).astype(jnp.float32)
    log_i = gates[..., :H]
    log_f = jax.nn.log_sigmoid(gates[..., H:])
    y = mlstm_chunkwise(q.reshape(B, T, H, ML_DK) * ML_DK ** -0.5, k.reshape(B, T, H, ML_DK),
                        v.reshape(B, T, H, ML_DV), log_i, log_f)
    y = head_norm(y, gn_g, gn_b, 1e-6) * jax.nn.sigmoid(o)
    return y @ w_out


def rotary(x, base):
    T, dk = x.shape[1], x.shape[-1]
    half = dk // 2
    inv = base ** -(jnp.arange(half, dtype=jnp.float32) / (half - 1))
    ang = jnp.arange(T, dtype=jnp.float32)[:, None] * inv[None, :]
    cos, sin = jnp.cos(ang)[None, :, None, :], jnp.sin(ang)[None, :, None, :]
    x1, x2 = x[..., :half], x[..., half:]
    return jnp.concatenate([x1 * cos - x2 * sin, x1 * sin + x2 * cos], -1).astype(x.dtype)


def retention_chunkwise(q, k, v):
    B, T, H, DK = q.shape
    DV = v.shape[-1]
    log_g = jnp.log1p(-jnp.exp2(-5.0 - jnp.arange(H, dtype=jnp.float32)))
    pos = jnp.arange(CHUNK, dtype=jnp.float32)
    rel = pos[:, None] - pos[None, :]
    intra = jnp.where(rel >= 0, jnp.exp(log_g[:, None, None] * jnp.maximum(rel, 0.0)), 0.0)
    q_dec = jnp.exp(log_g[:, None] * (pos + 1.0))
    k_dec = jnp.exp(log_g[:, None] * (CHUNK - 1.0 - pos))
    chunk_dec = jnp.exp(log_g * CHUNK)
    qc, kc, vc = (to_chunks(t.astype(jnp.float32)) for t in (q, k, v))
    inner = jnp.einsum('cbhsj,cbhjv->cbhsv', jnp.einsum('cbhsd,cbhjd->cbhsj', qc, kc) * intra, vc)

    def step(R, inp):
        qb, kb, vb = inp
        cross = jnp.einsum('bhsd,bhdv->bhsv', qb, R) * q_dec[:, :, None]
        R = chunk_dec[:, None, None] * R + jnp.einsum('bhjd,hj,bhjv->bhdv', kb, k_dec, vb)
        return R, cross

    _, cross = lax.scan(step, jnp.zeros((B, H, DK, DV), jnp.float32), (qc, kc, vc))
    return from_chunks(inner + cross).astype(v.dtype)


def retention_mixer(h, w_in, gn_g, gn_b, w_out):
    B, T, D = h.shape
    H = RT_HEADS
    proj = h @ w_in
    q, k, v, g = jnp.split(proj, [RT_QK, 2 * RT_QK, 2 * RT_QK + RT_V], axis=-1)
    q = rotary(q.reshape(B, T, H, RT_DK), RT_ROPE_BASE)
    k = rotary(k.reshape(B, T, H, RT_DK), RT_ROPE_BASE) * RT_DK ** -0.5
    y = retention_chunkwise(q, k, v.reshape(B, T, H, RT_DV))
    y = head_norm(y, gn_g, gn_b, 1e-6)
    return (jax.nn.silu(g) * y) @ w_out


def hier_moe(h, w_grp, b_grp, w_exp, b_exp, w1, w3, w2):
    B, T, D = h.shape
    N = B * T
    hf = h.reshape(N, D)
    rows = jnp.arange(N)
    g_logit = (hf @ w_grp + b_grp).astype(jnp.float32)
    g_prob = jax.nn.softmax(g_logit, axis=-1)
    g_idx = jnp.argmax(g_logit, axis=-1).astype(jnp.int32)
    g_gate = g_prob[rows, g_idx]
    e_logit = (hf @ w_exp + b_exp).astype(jnp.float32).reshape(N, MOE_GROUPS, MOE_PER_GROUP)
    e_prob = jax.nn.softmax(e_logit[rows, g_idx], axis=-1)
    top_p, top_i = lax.top_k(e_prob, MOE_TOPK)
    weight = g_gate[:, None] * top_p / top_p.sum(-1, keepdims=True)
    expert = g_idx[:, None] * MOE_PER_GROUP + top_i.astype(jnp.int32)

    A = N * MOE_TOPK
    e_flat = expert.reshape(A)
    w_flat = weight.reshape(A)
    tok_flat = jnp.repeat(jnp.arange(N, dtype=jnp.int32), MOE_TOPK)
    order = jnp.argsort(e_flat)
    e_sorted, tok_sorted, w_sorted = e_flat[order], tok_flat[order], w_flat[order]
    counts = jnp.zeros((MOE_EXPERTS,), jnp.int32).at[e_flat].add(1)
    padded = (counts + MOE_BLOCK - 1) // MOE_BLOCK * MOE_BLOCK
    starts = jnp.cumsum(counts) - counts
    pends = jnp.cumsum(padded)
    pstarts = pends - padded
    dest = pstarts[e_sorted] + (jnp.arange(A, dtype=jnp.int32) - starts[e_sorted])
    P = A + MOE_EXPERTS * MOE_BLOCK
    n_blocks = P // MOE_BLOCK
    slot_tok = jnp.zeros((P,), jnp.int32).at[dest].set(tok_sorted)
    slot_w = jnp.zeros((P,), h.dtype).at[dest].set(w_sorted.astype(h.dtype))
    blk_start = jnp.arange(n_blocks, dtype=jnp.int32) * MOE_BLOCK
    blk_e = jnp.minimum(jnp.searchsorted(pends, blk_start, side='right'), MOE_EXPERTS - 1).astype(jnp.int32)
    xs = hf[slot_tok].reshape(n_blocks, MOE_BLOCK, D)

    def expert_block(args):
        xb, e = args
        return (jax.nn.silu(xb @ w1[e]) * (xb @ w3[e])) @ w2[e]

    ys = lax.map(expert_block, (xs, blk_e)).reshape(P, D)
    out = jnp.zeros((N, D), h.dtype).at[slot_tok].add(ys * slot_w[:, None])
    return out.reshape(B, T, D)


def setup_inputs(seed: int = 0) -> dict:
    key = jax.random.key(seed)
    ks = iter(jax.random.split(key, 64))
    f32 = jnp.float32
    D = D_MODEL

    def nrm(shape, scale):
        return jax.random.normal(next(ks), shape, f32) * scale

    NA, NB, NC = N_RWKV, N_MLSTM, N_RET
    inp = {}
    inp['x'] = nrm((BATCH, SEQ, D), 1.0)
    inp['c'] = nrm((BATCH, D), 1.0)
    inp['ada_w'] = nrm((DEPTH, 2, D, 3 * D), 0.5 * D ** -0.5)
    inp['ada_b'] = nrm((DEPTH, 2, 3 * D), 0.02)
    inp['ln_g'] = 1.0 + nrm((DEPTH, 2, D), 0.05)
    inp['ln_b'] = nrm((DEPTH, 2, D), 0.02)
    inp['rw_mu'] = jax.random.uniform(next(ks), (NA, 6, D), f32, 0.0, 1.0)
    inp['rw_w_rkv'] = nrm((NA, 3, D, D), D ** -0.5)
    inp['rw_w0'] = jnp.linspace(-5.0, -1.0, D, dtype=f32) + nrm((NA, D), 0.1)
    inp['rw_w1'] = nrm((NA, D, RW_LORA_W), D ** -0.5)
    inp['rw_w2'] = nrm((NA, RW_LORA_W, D), 0.1 * RW_LORA_W ** -0.5)
    inp['rw_a0'] = nrm((NA, D), 0.1)
    inp['rw_a1'] = nrm((NA, D, RW_LORA_A), D ** -0.5)
    inp['rw_a2'] = nrm((NA, RW_LORA_A, D), RW_LORA_A ** -0.5)
    inp['rw_v0'] = 1.0 + nrm((NA - 1, D), 0.1)
    inp['rw_v1'] = nrm((NA - 1, D, RW_LORA_V), D ** -0.5)
    inp['rw_v2'] = nrm((NA - 1, RW_LORA_V, D), RW_LORA_V ** -0.5)
    inp['rw_g1'] = nrm((NA, D, RW_LORA_G), D ** -0.5)
    inp['rw_g2'] = nrm((NA, RW_LORA_G, D), RW_LORA_G ** -0.5)
    inp['rw_kk'] = 0.85 + nrm((NA, D), 0.05)
    inp['rw_ka'] = 1.0 + nrm((NA, D), 0.05)
    inp['rw_rk'] = nrm((NA, RW_HEADS, RW_HEAD), 0.1)
    inp['rw_gn_g'] = 1.0 + nrm((NA, D), 0.05)
    inp['rw_gn_b'] = nrm((NA, D), 0.02)
    inp['rw_w_out'] = nrm((NA, D, D), DN_BETA * D ** -0.5)
    inp['ml_w_in'] = nrm((NB, D, ML_IN), D ** -0.5)
    inp['ml_b_gate'] = jnp.concatenate([nrm((NB, ML_HEADS), 0.1),
                                        jnp.linspace(3.0, 6.0, ML_HEADS, dtype=f32) + nrm((NB, ML_HEADS), 0.1)], -1)
    inp['ml_conv_w'] = nrm((NB, ML_CONV, 2 * ML_QK), ML_CONV ** -0.5)
    inp['ml_conv_b'] = nrm((NB, 2 * ML_QK), 0.02)
    inp['ml_gn_g'] = 1.0 + nrm((NB, ML_V), 0.05)
    inp['ml_gn_b'] = nrm((NB, ML_V), 0.02)
    inp['ml_w_out'] = nrm((NB, ML_V, D), DN_BETA * ML_V ** -0.5)
    inp['rt_w_in'] = nrm((NC, D, RT_IN), D ** -0.5)
    inp['rt_gn_g'] = 1.0 + nrm((NC, RT_V), 0.05)
    inp['rt_gn_b'] = nrm((NC, RT_V), 0.02)
    inp['rt_w_out'] = nrm((NC, RT_V, D), DN_BETA * RT_V ** -0.5)
    inp['moe_w_grp'] = nrm((DEPTH, D, MOE_GROUPS), D ** -0.5)
    inp['moe_b_grp'] = nrm((DEPTH, MOE_GROUPS), 0.01)
    inp['moe_w_exp'] = nrm((DEPTH, D, MOE_EXPERTS), D ** -0.5)
    inp['moe_b_exp'] = nrm((DEPTH, MOE_EXPERTS), 0.01)
    inp['moe_w1'] = nrm((DEPTH, MOE_EXPERTS, D, MOE_HIDDEN), D ** -0.5)
    inp['moe_w3'] = nrm((DEPTH, MOE_EXPERTS, D, MOE_HIDDEN), D ** -0.5)
    inp['moe_w2'] = nrm((DEPTH, MOE_EXPERTS, MOE_HIDDEN, D), DN_BETA * MOE_HIDDEN ** -0.5)
    return inp


def reference(x, c, ada_w, ada_b, ln_g, ln_b,
              rw_mu, rw_w_rkv, rw_w0, rw_w1, rw_w2, rw_a0, rw_a1, rw_a2, rw_v0, rw_v1, rw_v2,
              rw_g1, rw_g2, rw_kk, rw_ka, rw_rk, rw_gn_g, rw_gn_b, rw_w_out,
              ml_w_in, ml_b_gate, ml_conv_w, ml_conv_b, ml_gn_g, ml_gn_b, ml_w_out,
              rt_w_in, rt_gn_g, rt_gn_b, rt_w_out,
              moe_w_grp, moe_b_grp, moe_w_exp, moe_b_exp, moe_w1, moe_w3, moe_w2):
    v_first = None
    for i in range(DEPTH):
        kind, j = i % N_MIXERS, i // N_MIXERS
        shift, scale, gate = ada_modulation(c, ada_w[i, 0], ada_b[i, 0])
        h = x * (1 + scale) + shift
        if kind == 0:
            vmix = None if j == 0 else (rw_v0[j - 1], rw_v1[j - 1], rw_v2[j - 1])
            y, v_first = rwkv7_mixer(h, v_first, rw_mu[j], rw_w_rkv[j], rw_w0[j], rw_w1[j], rw_w2[j],
                                     rw_a0[j], rw_a1[j], rw_a2[j], rw_g1[j], rw_g2[j], rw_kk[j], rw_ka[j],
                                     rw_rk[j], rw_gn_g[j], rw_gn_b[j], rw_w_out[j], vmix)
        elif kind == 1:
            y = mlstm_mixer(h, ml_w_in[j], ml_b_gate[j], ml_conv_w[j], ml_conv_b[j],
                            ml_gn_g[j], ml_gn_b[j], ml_w_out[j])
        else:
            y = retention_mixer(h, rt_w_in[j], rt_gn_g[j], rt_gn_b[j], rt_w_out[j])
        x = layer_norm(DN_ALPHA * x + (1 + gate) * y, ln_g[i, 0], ln_b[i, 0])
        shift, scale, gate = ada_modulation(c, ada_w[i, 1], ada_b[i, 1])
        y = hier_moe(x * (1 + scale) + shift, moe_w_grp[i], moe_b_grp[i], moe_w_exp[i], moe_b_exp[i],
                     moe_w1[i], moe_w3[i], moe_w2[i])
        x = layer_norm(DN_ALPHA * x + (1 + gate) * y, ln_g[i, 1], ln_b[i, 1])
    return x
```

```cpp
#include <hip/hip_runtime.h>
#include <cstdio>
#include <cstdint>

#ifndef ONE_LAUNCH
#define ONE_LAUNCH 0
#endif

typedef unsigned short bf16_t;
typedef short bf16x8 __attribute__((ext_vector_type(8)));
typedef float f32x4 __attribute__((ext_vector_type(4)));
#define LAS __attribute__((address_space(3)))

constexpr int NTOK = 16384, DM = 1024, TSEQ = 2048, NBATCH = 8;
constexpr float DN_ALPHA = 1.681792830507429f;
constexpr float LN_EPS = 1e-5f;
constexpr size_t MB = 1u << 20;
constexpr size_t OFF_CTL = 0, OFF_CNT = 16384, CTL_BYTES = 65536;
constexpr size_t OFF_MOD = 65536;
constexpr size_t OFF_ROT = 1 * MB;
constexpr size_t OFF_BONUS = 3 * MB, OFF_GATES = 4 * MB, OFF_STAT = 5 * MB, OFF_LW = 13 * MB, OFF_LA = 15 * MB, OFF_LG = 17 * MB, OFF_LV = 21 * MB,
                 OFF_WGT = 22 * MB, OFF_LIST = 23 * MB, OFF_RTW = 25 * MB;
constexpr size_t OFF_W = 32 * MB;
constexpr size_t W_RKV = OFF_W, W_OUT = W_RKV + 12 * MB, W_W1T = W_OUT + 4 * MB, W_A1T = W_W1T + 256 * 1024, W_G1T = W_A1T + 256 * 1024, W_V1T = W_G1T + 512 * 1024,
                 W_W2T = W_V1T + 64 * 1024, W_A2T = W_W2T + 256 * 1024, W_G2T = W_A2T + 256 * 1024, W_V2T = W_G2T + 512 * 1024, W_MLIN = W_V2T + 64 * 1024 + 832 * 1024,
                 W_MLOUT = W_MLIN + 6400 * 1024, W_RTIN = W_MLOUT + 2 * MB, W_RTOUT = W_RTIN + 12 * MB, W_MOE13 = W_RTOUT + 4 * MB, W_MOE2 = W_MOE13 + 256 * MB,
                 W_END = W_MOE2 + 128 * MB;
constexpr size_t OFF_XRES = 464 * MB;
constexpr size_t OFF_SLOT = 528 * MB, SLOT = 32 * MB;
static_assert(W_END <= OFF_XRES, "weights overflow");
constexpr size_t OFF_XRES2 = OFF_SLOT + 12 * SLOT;
constexpr size_t WS_NEED = OFF_XRES2 + 2 * SLOT;
constexpr int LIST_CAP = 16384;

#define XB_TMO      128
#define XB_XCNT(j)  (256  + 64 * (j))
#define XB_XSUB(j)  (1280 + 64 * (j))
#define XB_XGEN(j)  (2304 + 64 * (j))
#define XB_TOP      3328
#define XB_TOPGEN   3392
#define XCD_BAR_WORDS 3456
#define XB_SPIN_CAP (1u << 22)
__device__ __forceinline__ unsigned xb_ld(unsigned* p)              { return __hip_atomic_load(p, __ATOMIC_RELAXED, __HIP_MEMORY_SCOPE_AGENT); }
__device__ __forceinline__ unsigned xb_add(unsigned* p, unsigned v) { return __hip_atomic_fetch_add(p, v, __ATOMIC_RELAXED, __HIP_MEMORY_SCOPE_AGENT); }
__device__ __forceinline__ unsigned xb_xcc_id() { return (unsigned)__builtin_amdgcn_s_getreg((3 << 11) | 20) & 0xFu; }
#define XB_SPIN(cond, bar) do { unsigned _sp = 0; while (cond) { __builtin_amdgcn_s_sleep(1); \
    if ((++_sp & 255u) == 0u) { if (xb_ld(&(bar)[XB_TMO])) break; if (_sp > XB_SPIN_CAP) { atomicAdd(&(bar)[XB_TMO], 1u); break; } } } } while (0)
struct XcdBarrier { unsigned* bar; unsigned x; volatile LAS unsigned* st; };
__device__ __forceinline__ XcdBarrier xcd_barrier_post(unsigned* bar, volatile LAS unsigned* st) {
    XcdBarrier b; b.bar = bar; b.x = xb_xcc_id(); b.st = st;
    if (threadIdx.x == 0) (void)xb_add(&bar[XB_XCNT(b.x)], 1u);
    return b;
}
__device__ __forceinline__ void xcd_barrier_complete(unsigned* bar, unsigned x, unsigned& nloc, unsigned& nx) {
    const unsigned G = gridDim.x;
    unsigned sum, cnt, mine, sp = 0u;
    for (;;) {
        sum = 0u; cnt = 0u; mine = 0u;
#pragma unroll
        for (unsigned j = 0; j < 16; ++j) { const unsigned c = xb_ld(&bar[XB_XCNT(j)]); sum += c; cnt += (c > 0u) ? 1u : 0u; mine = (j == x) ? c : mine; }
        if (sum == G) break;
        __builtin_amdgcn_s_sleep(1);
        if ((++sp & 255u) == 0u) { if (xb_ld(&bar[XB_TMO])) break; if (sp > XB_SPIN_CAP) { atomicAdd(&bar[XB_TMO], 1u); break; } }
    }
    nloc = mine > 0u ? mine : 1u; nx = cnt > 0u ? cnt : 1u;
}
__device__ __forceinline__ void xcd_barrier(const XcdBarrier& b) {
    asm volatile("s_waitcnt vmcnt(0)" ::: "memory");
    __syncthreads();
    if (threadIdx.x == 0) {
        unsigned* bar = b.bar;
        __builtin_amdgcn_s_waitcnt(0);
        unsigned nloc = b.st[0], nx = b.st[1];
        if (nloc == 0u) { xcd_barrier_complete(bar, b.x, nloc, nx); b.st[0] = nloc; b.st[1] = nx; }
        const unsigned old = xb_add(&bar[XB_XSUB(b.x)], 1u);
        const unsigned gen = old / nloc;
        if (old + 1u == (gen + 1u) * nloc) {
            __builtin_amdgcn_fence(__ATOMIC_RELEASE, "agent");
            asm volatile("s_waitcnt vmcnt(0)" ::: "memory");
            const unsigned og = xb_add(&bar[XB_TOP], 1u);
            const unsigned tg = og / nx;
            if (og + 1u == (tg + 1u) * nx) xb_add(&bar[XB_TOPGEN], 1u);
            else XB_SPIN(xb_ld(&bar[XB_TOPGEN]) == tg, bar);
            __builtin_amdgcn_fence(__ATOMIC_ACQUIRE, "agent");
            xb_add(&bar[XB_XGEN(b.x)], 1u);
            asm volatile("s_waitcnt vmcnt(0)" ::: "memory");
        } else {
            XB_SPIN(xb_ld(&bar[XB_XGEN(b.x)]) == gen, bar);
            __builtin_amdgcn_fence(__ATOMIC_ACQUIRE, "agent");
            asm volatile("s_waitcnt vmcnt(0)" ::: "memory");
        }
    }
    __syncthreads();
}

__device__ __forceinline__ int tidx() { int t = threadIdx.x; asm volatile("" : "+v"(t)); return t; }
typedef __bf16 bf16x2_t __attribute__((ext_vector_type(2)));
typedef float f32x2_t __attribute__((ext_vector_type(2)));
__device__ __forceinline__ unsigned cvt_pk(float lo, float hi) {
    f32x2_t v = {lo, hi}; bf16x2_t r = __builtin_convertvector(v, bf16x2_t);
    unsigned u; __builtin_memcpy(&u, &r, 4); return u;
}
__device__ __forceinline__ bf16_t f2bf(float f) { return (bf16_t)(cvt_pk(f, 0.f) & 0xffffu); }
__device__ __forceinline__ float bflo(unsigned u) { return __uint_as_float(u << 16); }
__device__ __forceinline__ float bfhi(unsigned u) { return __uint_as_float(u & 0xffff0000u); }
__device__ __forceinline__ float bf2f(bf16_t u) { return __uint_as_float(((unsigned)u) << 16); }
__device__ __forceinline__ void unpack8(const uint4& u, float (&f)[8]) {
    f[0] = bflo(u.x); f[1] = bfhi(u.x); f[2] = bflo(u.y); f[3] = bfhi(u.y); f[4] = bflo(u.z); f[5] = bfhi(u.z); f[6] = bflo(u.w); f[7] = bfhi(u.w);
}
__device__ __forceinline__ uint4 pack8(const float (&f)[8]) { uint4 u; u.x = cvt_pk(f[0], f[1]); u.y = cvt_pk(f[2], f[3]); u.z = cvt_pk(f[4], f[5]); u.w = cvt_pk(f[6], f[7]); return u; }
__device__ __forceinline__ float sigmoidf_(float x) { return 1.0f / (1.0f + __expf(-x)); }
__device__ __forceinline__ float siluf_(float x) { return x / (1.0f + __expf(-x)); }
__device__ __forceinline__ float softplusf_(float x) { return fmaxf(x, 0.f) + log1pf(__expf(-fabsf(x))); }
__device__ __forceinline__ float row16_sum(float v);
__device__ __forceinline__ float wave_sum(float v) {
    v = row16_sum(v); v += __shfl_xor(v, 16); v += __shfl_xor(v, 32);
    return v;
}
__device__ __forceinline__ float row16_sum(float v) {
    v += __builtin_amdgcn_update_dpp(0.f, v, 0x128, 0xf, 0xf, false);
    v += __builtin_amdgcn_update_dpp(0.f, v, 0x124, 0xf, 0xf, false);
    v += __builtin_amdgcn_update_dpp(0.f, v, 0x122, 0xf, 0xf, false);
    v += __builtin_amdgcn_update_dpp(0.f, v, 0x121, 0xf, 0xf, false);
    return v;
}
__device__ __forceinline__ float oct_sum(float v) {
    v += __builtin_amdgcn_update_dpp(0.f, v, 0xB1, 0xf, 0xf, false);
    v += __builtin_amdgcn_update_dpp(0.f, v, 0x4E, 0xf, 0xf, false);
    v += __builtin_amdgcn_update_dpp(0.f, v, 0x141, 0xf, 0xf, false);
    return v;
}

enum { MODE_BF16 = 0, MODE_TANH = 1, MODE_SIGM = 2, MODE_ML1 = 3, MODE_RT1 = 4 };
struct GJob { const bf16_t* A; const bf16_t* Bt; bf16_t* out; int K, N, ldo, mode, ntn, tile0; };
struct CJob { const float* src; bf16_t* dst; int K, N, nb, mode; long sbs, dbs; int tiles_pb, tile0; };
constexpr int NGJ = 16, NCJ = 24;
struct Params {
    const float* in[43]; float* out; char* ws;
    int ph_lo, ph_hi, ncj, cj_tiles;
    GJob gj[NGJ];
    CJob cj[NCJ];
};

__device__ __forceinline__ f32x4 mfma16(const uint4& a, const uint4& b, f32x4 c) {
    bf16x8 av, bv; __builtin_memcpy(&av, &a, 16); __builtin_memcpy(&bv, &b, 16);
    return __builtin_amdgcn_mfma_f32_16x16x32_bf16(av, bv, c, 0, 0, 0);
}
template <bool PFA = true, class AL, class BL>
__device__ __forceinline__ void gemm_mainloop(char* lds, int nk, const AL& al, const BL& bl, f32x4 (&acc)[4][4]) {
    const int t = tidx(), c = t & 7, r0 = t >> 3;
    const int lane = t & 63, wid = t >> 6, wr = wid >> 1, wc = wid & 1, fr = lane & 15, fq = lane >> 4;
    typename AL::Raw ra[4]; typename BL::Raw rb[4];
    const int woff = r0 * 128 + ((c ^ (r0 & 7)) << 4);
#pragma unroll
    for (int i = 0; i < 4; ++i) { if (PFA) ra[i] = al.fetch(i, r0 + 32 * i, c); rb[i] = bl.fetch(i, r0 + 32 * i, c); }
#pragma unroll
    for (int i = 0; i < 4; ++i) {
        if (!PFA) { ra[i] = al.fetch(i, r0 + 32 * i, c); }
        *(uint4*)(lds + woff + i * 4096) = al.finish(ra[i], i, r0 + 32 * i, c);
        *(uint4*)(lds + 16384 + woff + i * 4096) = bl.finish(rb[i], i, r0 + 32 * i, c);
        if (!PFA) asm volatile("" ::: "memory");
    }
#pragma unroll
    for (int m = 0; m < 4; ++m)
#pragma unroll
        for (int n = 0; n < 4; ++n) acc[m][n] = (f32x4){0.f, 0.f, 0.f, 0.f};
    __syncthreads();
    const int aoff = (wr * 64 + fr) * 128, boff = 16384 + (wc * 64 + fr) * 128, sw = fr & 7;
    for (int kt = 0; kt < nk; ++kt) {
        const bool more = (kt + 1 < nk);
        if (more) {
#pragma unroll
            for (int i = 0; i < 4; ++i) { if (PFA) ra[i] = al.fetch(i, r0 + 32 * i, (kt + 1) * 8 + c); rb[i] = bl.fetch(i, r0 + 32 * i, (kt + 1) * 8 + c); }
        }
        const char* buf = lds + (kt & 1) * 32768;
#pragma unroll
        for (int ks = 0; ks < 2; ++ks) {
            uint4 af[4], bfm[4];
            const int ch = ((ks * 4 + fq) ^ sw) << 4;
#pragma unroll
            for (int m = 0; m < 4; ++m) af[m] = *(const uint4*)(buf + aoff + m * 2048 + ch);
#pragma unroll
            for (int n = 0; n < 4; ++n) bfm[n] = *(const uint4*)(buf + boff + n * 2048 + ch);
#pragma unroll
            for (int m = 0; m < 4; ++m)
#pragma unroll
                for (int n = 0; n < 4; ++n) acc[m][n] = mfma16(bfm[n], af[m], acc[m][n]);
        }
        if (more) {
            char* nb = lds + ((kt + 1) & 1) * 32768;
#pragma unroll
            for (int i = 0; i < 4; ++i) {
                if (!PFA) ra[i] = al.fetch(i, r0 + 32 * i, (kt + 1) * 8 + c);
                *(uint4*)(nb + woff + i * 4096) = al.finish(ra[i], i, r0 + 32 * i, (kt + 1) * 8 + c);
                *(uint4*)(nb + 16384 + woff + i * 4096) = bl.finish(rb[i], i, r0 + 32 * i, (kt + 1) * 8 + c);
                if (!PFA) asm volatile("" ::: "memory");
            }
        }
        __syncthreads();
    }
}
__device__ __forceinline__ void glds16(const bf16_t* g, char* l) {
    __builtin_amdgcn_global_load_lds((const unsigned*)g, (LAS unsigned*)l, 16, 0, 0);
}
__device__ __forceinline__ int glds_chunk(int t) { return (t & 7) ^ ((t >> 3) & 7); }
__device__ __forceinline__ void mma_ktile(const char* buf, int aoff, int boff, int sw, int fq, f32x4 (&acc)[4][4]) {
#pragma unroll
    for (int ks = 0; ks < 2; ++ks) {
        uint4 af[4], bfm[4];
        const int ch = ((ks * 4 + fq) ^ sw) << 4;
#pragma unroll
        for (int m = 0; m < 4; ++m) af[m] = *(const uint4*)(buf + aoff + m * 2048 + ch);
#pragma unroll
        for (int n = 0; n < 4; ++n) bfm[n] = *(const uint4*)(buf + boff + n * 2048 + ch);
#pragma unroll
        for (int m = 0; m < 4; ++m)
#pragma unroll
            for (int n = 0; n < 4; ++n) acc[m][n] = mfma16(bfm[n], af[m], acc[m][n]);
    }
}
__device__ __forceinline__ void gemm_gg(char* lds, int nk, const bf16_t* const (&ar)[4], const bf16_t* const (&br)[4], f32x4 (&acc)[4][4]) {
    const int t = tidx();
    const int lane = t & 63, wid = t >> 6, wr = wid >> 1, wc = wid & 1, fr = lane & 15, fq = lane >> 4;
    char* wb = lds + wid * 1024;
#pragma unroll
    for (int i = 0; i < 4; ++i) { glds16(ar[i], wb + i * 4096); glds16(br[i], wb + 16384 + i * 4096); }
#pragma unroll
    for (int m = 0; m < 4; ++m)
#pragma unroll
        for (int n = 0; n < 4; ++n) acc[m][n] = (f32x4){0.f, 0.f, 0.f, 0.f};
    asm volatile("s_waitcnt vmcnt(0)" ::: "memory");
    __syncthreads();
    const int aoff = (wr * 64 + fr) * 128, boff = 16384 + (wc * 64 + fr) * 128, sw = fr & 7;
    for (int kt = 0; kt < nk; ++kt) {
        if (kt + 1 < nk) {
            char* nb = wb + ((kt + 1) & 1) * 32768;
#pragma unroll
            for (int i = 0; i < 4; ++i) { glds16(ar[i] + (kt + 1) * 64, nb + i * 4096); glds16(br[i] + (kt + 1) * 64, nb + 16384 + i * 4096); }
        }
        mma_ktile(lds + (kt & 1) * 32768, aoff, boff, sw, fq, acc);
        asm volatile("s_waitcnt vmcnt(0)" ::: "memory");
        __syncthreads();
    }
}
template <class AL>
__device__ __forceinline__ void gemm_rg(char* lds, int nk, const AL& al, const bf16_t* const (&br)[4], f32x4 (&acc)[4][4]) {
    const int t = tidx(), c = t & 7, r0 = t >> 3;
    const int lane = t & 63, wid = t >> 6, wr = wid >> 1, wc = wid & 1, fr = lane & 15, fq = lane >> 4;
    char* wb = lds + wid * 1024;
    const int woff = r0 * 128 + ((c ^ (r0 & 7)) << 4);
#pragma unroll
    for (int i = 0; i < 4; ++i) glds16(br[i], wb + 16384 + i * 4096);
#pragma unroll
    for (int i = 0; i < 4; ++i) {
        typename AL::Raw ra = al.fetch(i, r0 + 32 * i, c);
        *(uint4*)(lds + woff + i * 4096) = al.finish(ra, i, r0 + 32 * i, c);
        asm volatile("" ::: "memory");
    }
#pragma unroll
    for (int m = 0; m < 4; ++m)
#pragma unroll
        for (int n = 0; n < 4; ++n) acc[m][n] = (f32x4){0.f, 0.f, 0.f, 0.f};
    asm volatile("s_waitcnt vmcnt(0)" ::: "memory");
    __syncthreads();
    const int aoff = (wr * 64 + fr) * 128, boff = 16384 + (wc * 64 + fr) * 128, sw = fr & 7;
    for (int kt = 0; kt < nk; ++kt) {
        const bool more = (kt + 1 < nk);
        char* nbuf = lds + ((kt + 1) & 1) * 32768;
        if (more) {
#pragma unroll
            for (int i = 0; i < 4; ++i) glds16(br[i] + (kt + 1) * 64, nbuf + wid * 1024 + 16384 + i * 4096);
        }
        mma_ktile(lds + (kt & 1) * 32768, aoff, boff, sw, fq, acc);
        if (more) {
#pragma unroll
            for (int i = 0; i < 4; ++i) {
                typename AL::Raw ra = al.fetch(i, r0 + 32 * i, (kt + 1) * 8 + c);
                *(uint4*)(nbuf + woff + i * 4096) = al.finish(ra, i, r0 + 32 * i, (kt + 1) * 8 + c);
                asm volatile("" ::: "memory");
            }
        }
        asm volatile("s_waitcnt vmcnt(0)" ::: "memory");
        __syncthreads();
    }
}
struct LdPlain {
    typedef uint4 Raw;
    const bf16_t* p; int ld; int nvalid;
    __device__ __forceinline__ uint4 fetch(int, int r, int kc) const { return (r < nvalid) ? *(const uint4*)(p + (size_t)r * ld + kc * 8) : make_uint4(0u, 0u, 0u, 0u); }
    __device__ __forceinline__ uint4 finish(const uint4& v, int, int, int) const { return v; }
};
struct LdGather {
    typedef uint4 Raw;
    const bf16_t* rp[4];
    __device__ __forceinline__ uint4 fetch(int i, int, int kc) const { const bf16_t* q = rp[i]; return q ? *(const uint4*)(q + kc * 8) : make_uint4(0u, 0u, 0u, 0u); }
    __device__ __forceinline__ uint4 finish(const uint4& v, int, int, int) const { return v; }
};
__device__ __forceinline__ void tile_map(int id, int NT, int& mt, int& nt) { const int x = id & 7, q = id >> 3; mt = (q / NT) * 8 + x; nt = q % NT; }

__device__ __forceinline__ int conv_row(int mode, int n) {
    if (mode == 1) return (n >> 4) * 32 + (n & 15);
    if (mode == 2) return (n >> 4) * 32 + 16 + (n & 15);
    if (mode == 3 && n < 2048) { const int c = n & 255, c2 = c & 127; return (n & ~255) + (c2 >> 4) * 32 + ((c >> 7) << 4) + (c2 & 15); }
    return n;
}
__device__ __forceinline__ void phase_prologue(const Params& p, char* lds) {
    const int t = tidx();
    const int n_ada = 8 * 48, n_rot = 256 + 144;
    const int total = n_ada + n_rot + p.cj_tiles;
    float* mod = (float*)(p.ws + OFF_MOD);
    for (int it = blockIdx.x; it < total; it += gridDim.x) {
        if (it < n_ada) {
            const int pr = it / 48, cb = it % 48;
            float* sc = (float*)lds;
            float* red = (float*)(lds + 32768);
            for (int i = t; i < 8192; i += 256) { const int b = i >> 10, k = i & 1023; sc[k * 8 + b] = siluf_(p.in[1][b * 1024 + k]); }
            __syncthreads();
            const int kg = t >> 6, cl = t & 63, col = cb * 64 + cl;
            const float* W = p.in[2] + (size_t)pr * 1024 * 3072 + col;
            float a[8] = {0, 0, 0, 0, 0, 0, 0, 0};
#pragma unroll 8
            for (int k = kg * 256; k < kg * 256 + 256; ++k) {
                const float w = W[(size_t)k * 3072];
                const float4 s0 = *(const float4*)(sc + k * 8), s1 = *(const float4*)(sc + k * 8 + 4);
                a[0] += w * s0.x; a[1] += w * s0.y; a[2] += w * s0.z; a[3] += w * s0.w; a[4] += w * s1.x; a[5] += w * s1.y; a[6] += w * s1.z; a[7] += w * s1.w;
            }
#pragma unroll
            for (int b = 0; b < 8; ++b) red[(kg * 8 + b) * 64 + cl] = a[b];
            __syncthreads();
            for (int i = t; i < 512; i += 256) {
                const int b = i >> 6, c2 = i & 63;
                const float s = red[(0 * 8 + b) * 64 + c2] + red[(1 * 8 + b) * 64 + c2] + red[(2 * 8 + b) * 64 + c2] + red[(3 * 8 + b) * 64 + c2];
                mod[((size_t)pr * 8 + b) * 3072 + cb * 64 + c2] = s + p.in[3][pr * 3072 + cb * 64 + c2];
            }
            __syncthreads();
        } else if (it >= n_ada + 256 && it < n_ada + n_rot) {
            float* rtw = (float*)(p.ws + OFF_RTW);
            const int base = (it - n_ada - 256) * 1024;
            for (int e = base + t; e < base + 1024; e += 256) {
                const int L = e / (36 * 1024), o = (e >> 10) % 36, k = e & 1023;
                rtw[e] = (o < 4) ? p.in[36][((size_t)L * 1024 + k) * 4 + o] : p.in[38][((size_t)L * 1024 + k) * 32 + (o - 4)];
            }
        } else if (it < n_ada + 256) {
            float* rot = (float*)(p.ws + OFF_ROT);
            const int base = (it - n_ada) * 1024;
            for (int e = base + t; e < base + 1024; e += 256) {
                const int tt = e >> 7, i = e & 127;
                const float inv = __builtin_amdgcn_exp2f(-(float)i * (13.287712379549449f / 127.0f));
                const float ang = (float)tt * inv;
                float rev = ang * 0.15915494309189535f; rev -= floorf(rev);
                rot[e * 2] = __builtin_amdgcn_cosf(rev); rot[e * 2 + 1] = __builtin_amdgcn_sinf(rev);
            }
        } else {
            int ct = it - n_ada - n_rot, j = 0;
            while (j + 1 < p.ncj && ct >= p.cj[j + 1].tile0) ++j;
            CJob cjb; cjb.src = p.cj[j].src; cjb.dst = p.cj[j].dst; cjb.K = p.cj[j].K; cjb.N = p.cj[j].N; cjb.mode = p.cj[j].mode; cjb.sbs = p.cj[j].sbs; cjb.dbs = p.cj[j].dbs; cjb.tiles_pb = p.cj[j].tiles_pb; cjb.tile0 = p.cj[j].tile0;
            ct -= cjb.tile0;
            const int bidx = ct / cjb.tiles_pb, tl = ct % cjb.tiles_pb;
            const int nNt = (cjb.N + 63) >> 6, kt = tl / nNt, nt = tl % nNt;
            const float* src = cjb.src + (size_t)bidx * cjb.sbs;
            bf16_t* dst = cjb.dst + (size_t)bidx * cjb.dbs;
            float* sm = (float*)lds;
#pragma unroll
            for (int i = 0; i < 4; ++i) {
                const int kl = (t >> 4) + 16 * i, k = kt * 64 + kl, n = nt * 64 + (t & 15) * 4;
                float4 v = make_float4(0.f, 0.f, 0.f, 0.f);
                if (k < cjb.K && n < cjb.N) v = *(const float4*)(src + (size_t)k * cjb.N + n);
                float* q = sm + kl * 65 + (t & 15) * 4; q[0] = v.x; q[1] = v.y; q[2] = v.z; q[3] = v.w;
            }
            __syncthreads();
            {
                const int nl = t >> 2, kc = t & 3, n = nt * 64 + nl, k0 = kt * 64 + kc * 16;
                if (n < cjb.N && k0 < cjb.K) {
                    float f[8], g[8];
#pragma unroll
                    for (int q = 0; q < 8; ++q) { f[q] = sm[(kc * 16 + q) * 65 + nl]; g[q] = sm[(kc * 16 + 8 + q) * 65 + nl]; }
                    bf16_t* d = dst + (size_t)conv_row(cjb.mode, n) * cjb.K + k0;
                    *(uint4*)d = pack8(f); *(uint4*)(d + 8) = pack8(g);
                }
            }
            __syncthreads();
        }
    }
}

__device__ __forceinline__ void row_load_f32(const float* p, float (&v)[16], int lane) {
#pragma unroll
    for (int c = 0; c < 4; ++c) { const float4 x = *(const float4*)(p + c * 256 + lane * 4); v[c * 4] = x.x; v[c * 4 + 1] = x.y; v[c * 4 + 2] = x.z; v[c * 4 + 3] = x.w; }
}
__device__ __forceinline__ void row_load_bf16(const bf16_t* p, float (&v)[16], int lane) {
#pragma unroll
    for (int c = 0; c < 4; ++c) { const uint2 x = *(const uint2*)(p + c * 256 + lane * 4); v[c * 4] = bflo(x.x); v[c * 4 + 1] = bfhi(x.x); v[c * 4 + 2] = bflo(x.y); v[c * 4 + 3] = bfhi(x.y); }
}
__device__ __forceinline__ void row_store_bf16(bf16_t* p, const float (&v)[16], int lane) {
#pragma unroll
    for (int c = 0; c < 4; ++c) { uint2 x; x.x = cvt_pk(v[c * 4], v[c * 4 + 1]); x.y = cvt_pk(v[c * 4 + 2], v[c * 4 + 3]); *(uint2*)(p + c * 256 + lane * 4) = x; }
}
__device__ __forceinline__ void row_store_f32(float* p, const float (&v)[16], int lane) {
#pragma unroll
    for (int c = 0; c < 4; ++c) *(float4*)(p + c * 256 + lane * 4) = make_float4(v[c * 4], v[c * 4 + 1], v[c * 4 + 2], v[c * 4 + 3]);
}
__device__ __forceinline__ void row_layernorm(float (&v)[16], const float* g, const float* b, int lane) {
    float s = 0.f;
#pragma unroll
    for (int i = 0; i < 16; ++i) s += v[i];
    const float mean = wave_sum(s) * (1.0f / 1024.0f);
    float q = 0.f;
#pragma unroll
    for (int i = 0; i < 16; ++i) { const float d = v[i] - mean; q += d * d; }
    const float rstd = rsqrtf(wave_sum(q) * (1.0f / 1024.0f) + LN_EPS);
    float gg[16], bb[16]; row_load_f32(g, gg, lane); row_load_f32(b, bb, lane);
#pragma unroll
    for (int i = 0; i < 16; ++i) v[i] = (v[i] - mean) * rstd * gg[i] + bb[i];
}
__device__ __forceinline__ void row_modulate(const float (&x)[16], float (&h)[16], const float* mod3, int lane) {
    float sh[16], sc[16]; row_load_f32(mod3, sh, lane); row_load_f32(mod3 + 1024, sc, lane);
#pragma unroll
    for (int i = 0; i < 16; ++i) h[i] = x[i] * (1.0f + sc[i]) + sh[i];
}
__device__ __forceinline__ void emit_next(const Params& p, int kind, int jr, int row, const float (&h)[16], const float (&hp)[16], int lane) {
    bf16_t* s0 = (bf16_t*)(p.ws + OFF_SLOT);
    if (kind == 0) {
        const float* mu = p.in[6] + (size_t)jr * 6 * 1024;
#pragma unroll
        for (int n = 0; n < 6; ++n) {
            float m[16], o[16]; row_load_f32(mu + n * 1024, m, lane);
#pragma unroll
            for (int i = 0; i < 16; ++i) o[i] = h[i] + (hp[i] - h[i]) * m[i];
            row_store_bf16(s0 + (size_t)n * (SLOT / 2) + (size_t)row * 1024, o, lane);
        }
    } else row_store_bf16(s0 + (size_t)row * 1024, h, lane);
}
__device__ __forceinline__ void phase_h0(const Params& p) {
    const int t_ = tidx(); const int lane = t_ & 63, gw = blockIdx.x * 4 + (t_ >> 6), nw = gridDim.x * 4;
    const int rpw = NTOK / nw;
    const int r_lo = gw * rpw;
    const float* mod = (const float*)(p.ws + OFF_MOD);
    float hp[16];
#pragma unroll
    for (int i = 0; i < 16; ++i) hp[i] = 0.f;
    for (int r = r_lo - 1; r < r_lo + rpw; ++r) {
        if (r < 0) continue;
        if (r < r_lo && (r_lo & 2047) == 0) continue;
        float x[16], h[16]; row_load_f32(p.in[0] + (size_t)r * 1024, x, lane);
        row_modulate(x, h, mod + ((size_t)(0 * 2 + 0) * 8 + (r >> 11)) * 3072, lane);
        if (r >= r_lo) emit_next(p, 0, 0, r, h, hp, lane);
#pragma unroll
        for (int i = 0; i < 16; ++i) hp[i] = h[i];
        if (((r + 1) & 2047) == 0) {
#pragma unroll
            for (int i = 0; i < 16; ++i) hp[i] = 0.f;
        }
    }
}
__device__ __forceinline__ int layer_kind(int L) { return L % 3; }
__device__ __forceinline__ void phase_ln2(const Params& p, int L) {
    const int t_ = tidx(); const int lane = t_ & 63, gw = blockIdx.x * 4 + (t_ >> 6), nw = gridDim.x * 4;
    const int rpw = NTOK / nw, r_lo = gw * rpw;
    const float* mod = (const float*)(p.ws + OFF_MOD);
    float* xres = (float*)(p.ws + OFF_XRES);
    const bf16_t* Y = (const bf16_t*)(p.ws + OFF_SLOT + 9 * SLOT);
    const float* wgt = (const float*)(p.ws + OFF_WGT);
    const bool last = (L == 3);
    const int nk = layer_kind(L + 1), njr = (L + 1) / 3;
    float hp[16];
#pragma unroll
    for (int i = 0; i < 16; ++i) hp[i] = 0.f;
    const bool need_prev = (!last && nk == 0);
    for (int r = r_lo - (need_prev ? 1 : 0); r < r_lo + rpw; ++r) {
        if (r < 0) continue;
        if (r < r_lo && (r_lo & 2047) == 0) continue;
        float x[16], y0[16], y1[16];
        row_load_f32(xres + (size_t)r * 1024, x, lane);
        row_load_bf16(Y + (size_t)(2 * r) * 1024, y0, lane); row_load_bf16(Y + (size_t)(2 * r + 1) * 1024, y1, lane);
        const float w0 = wgt[2 * r], w1 = wgt[2 * r + 1];
        const float* m3 = mod + ((size_t)(L * 2 + 1) * 8 + (r >> 11)) * 3072;
        float gt[16]; row_load_f32(m3 + 2048, gt, lane);
#pragma unroll
        for (int i = 0; i < 16; ++i) x[i] = DN_ALPHA * x[i] + (1.0f + gt[i]) * (w0 * y0[i] + w1 * y1[i]);
        row_layernorm(x, p.in[4] + (L * 2 + 1) * 1024, p.in[5] + (L * 2 + 1) * 1024, lane);
        if (last) { row_store_f32(p.out + (size_t)r * 1024, x, lane); continue; }
        float h[16];
        row_modulate(x, h, mod + ((size_t)((L + 1) * 2 + 0) * 8 + (r >> 11)) * 3072, lane);
        if (r >= r_lo) { row_store_f32((float*)(p.ws + OFF_XRES2) + (size_t)r * 1024, x, lane); emit_next(p, nk, njr, r, h, hp, lane); }
#pragma unroll
        for (int i = 0; i < 16; ++i) hp[i] = h[i];
        if (((r + 1) & 2047) == 0) {
#pragma unroll
            for (int i = 0; i < 16; ++i) hp[i] = 0.f;
        }
    }
}
__device__ __forceinline__ void phase_ln1(const Params& p, int L, char* lds, const bf16_t* ymix, bf16_t* hm) {
    const int t = tidx(), lane = t & 63, wid = t >> 6;
    const float* mod = (const float*)(p.ws + OFF_MOD);
    const float* xin = (L == 0) ? p.in[0] : (const float*)(p.ws + OFF_XRES2);
    float* xres = (float*)(p.ws + OFF_XRES);
    int* cnt = (int*)(p.ws + OFF_CNT) + L * 32;
    int* list = (int*)(p.ws + OFF_LIST);
    float* wgt = (float*)(p.ws + OFF_WGT);
    float* hrow = (float*)lds;
    float* lg = (float*)(lds + 16384);
    const float* rtw = (const float*)(p.ws + OFF_RTW) + (size_t)L * 36 * 1024;
    const int rpb = NTOK / gridDim.x, r_lo = blockIdx.x * rpb;
    for (int rb = r_lo; rb < r_lo + rpb; rb += 4) {
        const int r = rb + wid;
        {
            float x[16], y[16], gt[16];
            row_load_f32(xin + (size_t)r * 1024, x, lane); row_load_bf16(ymix + (size_t)r * 1024, y, lane);
            row_load_f32(mod + ((size_t)(L * 2 + 0) * 8 + (r >> 11)) * 3072 + 2048, gt, lane);
#pragma unroll
            for (int i = 0; i < 16; ++i) x[i] = DN_ALPHA * x[i] + (1.0f + gt[i]) * y[i];
            row_layernorm(x, p.in[4] + (L * 2 + 0) * 1024, p.in[5] + (L * 2 + 0) * 1024, lane);
            row_store_f32(xres + (size_t)r * 1024, x, lane);
            float h[16]; row_modulate(x, h, mod + ((size_t)(L * 2 + 1) * 8 + (r >> 11)) * 3072, lane);
            row_store_bf16(hm + (size_t)r * 1024, h, lane);
            row_store_f32(hrow + wid * 1024, h, lane);
        }
        __syncthreads();
        {
            float h[4][16];
#pragma unroll
            for (int rr = 0; rr < 4; ++rr) row_load_f32(hrow + rr * 1024, h[rr], lane);
#pragma unroll 1
            for (int q = 0; q < 9; ++q) {
                float w[16]; row_load_f32(rtw + (size_t)(wid * 9 + q) * 1024, w, lane);
                float a4[4];
#pragma unroll
                for (int rr = 0; rr < 4; ++rr) { float s = 0.f;
#pragma unroll
                    for (int i = 0; i < 16; ++i) s += h[rr][i] * w[i];
                    a4[rr] = wave_sum(s); }
                if (lane == 0) {
#pragma unroll
                    for (int rr = 0; rr < 4; ++rr) lg[rr * 36 + wid * 9 + q] = a4[rr];
                }
            }
        }
        __syncthreads();
        if (t < 4) {
            const int row = rb + t; const float* l = lg + t * 36;
            float g[4]; for (int i = 0; i < 4; ++i) g[i] = l[i] + p.in[37][L * 4 + i];
            int gi = 0; for (int i = 1; i < 4; ++i) if (g[i] > g[gi]) gi = i;
            float gs = 0.f; for (int i = 0; i < 4; ++i) gs += __expf(g[i] - g[gi]);
            const float ggate = 1.0f / gs;
            float e[8]; for (int i = 0; i < 8; ++i) e[i] = l[4 + gi * 8 + i] + p.in[39][L * 32 + gi * 8 + i];
            int i0 = 0; for (int i = 1; i < 8; ++i) if (e[i] > e[i0]) i0 = i;
            int i1 = (i0 == 0) ? 1 : 0; for (int i = 0; i < 8; ++i) if (i != i0 && e[i] > e[i1]) i1 = i;
            const float p1 = __expf(e[i1] - e[i0]);
            const float w0 = ggate / (1.0f + p1), w1 = ggate * p1 / (1.0f + p1);
            const int e0 = gi * 8 + i0, e1 = gi * 8 + i1;
            const int pos0 = atomicAdd(&cnt[e0], 1), pos1 = atomicAdd(&cnt[e1], 1);
            list[e0 * LIST_CAP + pos0] = 2 * row; list[e1 * LIST_CAP + pos1] = 2 * row + 1;
            wgt[2 * row] = w0; wgt[2 * row + 1] = w1;
        }
        __syncthreads();
    }
}

__device__ __forceinline__ void gemm_epilogue(const Params& p, const GJob& jb, int mt, int nt, const f32x4 (&acc)[4][4]) {
    const int t_ = tidx(); const int lane = t_ & 63, wid = t_ >> 6, wr = wid >> 1, wc = wid & 1, fr = lane & 15, fq = lane >> 4;
    const int row0 = mt * 128 + wr * 64 + fr;
    if (jb.mode <= MODE_SIGM) {
#pragma unroll
        for (int n = 0; n < 4; ++n) {
            const int col = nt * 128 + wc * 64 + n * 16 + fq * 4;
            if (col < jb.N) {
#pragma unroll
                for (int m = 0; m < 4; ++m) {
                    f32x4 v = acc[m][n];
                    if (jb.mode == MODE_TANH) { v[0] = tanhf(v[0]); v[1] = tanhf(v[1]); v[2] = tanhf(v[2]); v[3] = tanhf(v[3]); }
                    else if (jb.mode == MODE_SIGM) { v[0] = sigmoidf_(v[0]); v[1] = sigmoidf_(v[1]); v[2] = sigmoidf_(v[2]); v[3] = sigmoidf_(v[3]); }
                    uint2 o; o.x = cvt_pk(v[0], v[1]); o.y = cvt_pk(v[2], v[3]);
                    *(uint2*)(jb.out + (size_t)(row0 + m * 16) * jb.ldo + col) = o;
                }
            }
        }
    } else if (jb.mode == MODE_ML1) {
        if (nt < 24) {
            bf16_t* ob = (bf16_t*)(p.ws + OFF_SLOT + (size_t)(1 + (nt >> 3)) * SLOT);
            const bool sg = (nt >= 16);
#pragma unroll
            for (int n = 0; n < 4; ++n) {
                const int col = (nt & 7) * 128 + wc * 64 + n * 16 + fq * 4;
#pragma unroll
                for (int m = 0; m < 4; ++m) {
                    f32x4 v = acc[m][n];
                    if (sg) { v[0] = sigmoidf_(v[0]); v[1] = sigmoidf_(v[1]); v[2] = sigmoidf_(v[2]); v[3] = sigmoidf_(v[3]); }
                    uint2 o; o.x = cvt_pk(v[0], v[1]); o.y = cvt_pk(v[2], v[3]);
                    *(uint2*)(ob + (size_t)(row0 + m * 16) * 1024 + col) = o;
                }
            }
        } else if (wc == 0) {
            float* gates = (float*)(p.ws + OFF_GATES);
            const float* bg = p.in[26];
            const int c0 = fq * 4;
#pragma unroll
            for (int m = 0; m < 4; ++m) {
                f32x4 v = acc[m][0], o;
#pragma unroll
                for (int j = 0; j < 4; ++j) { const float g = v[j] + bg[c0 + j]; o[j] = (c0 + j < 8) ? g : -softplusf_(-g); }
                *(f32x4*)(gates + (size_t)(row0 + m * 16) * 16 + c0) = o;
            }
        }
    } else {
        if (nt < 16) {
            const float* rot = (const float*)(p.ws + OFF_ROT);
            bf16_t* ob = (bf16_t*)(p.ws + OFF_SLOT + (size_t)(1 + (nt >> 3)) * SLOT);
            const float scl = (nt >= 8) ? 0.0625f : 1.0f;
#pragma unroll
            for (int pp = 0; pp < 2; ++pp) {
                const int blk32 = (nt & 7) * 4 + wc * 2 + pp, head = blk32 >> 3, i0 = (blk32 & 7) * 16 + fq * 4;
#pragma unroll
                for (int m = 0; m < 4; ++m) {
                    const int row = row0 + m * 16, tt = row & 2047;
                    const float4 c0 = *(const float4*)(rot + ((size_t)tt * 128 + i0) * 2), c1 = *(const float4*)(rot + ((size_t)tt * 128 + i0) * 2 + 4);
                    const float cs[4] = {c0.x, c0.z, c1.x, c1.z}, sn[4] = {c0.y, c0.w, c1.y, c1.w};
                    const f32x4 x1 = acc[m][2 * pp], x2 = acc[m][2 * pp + 1];
                    float o1[4], o2[4];
#pragma unroll
                    for (int j = 0; j < 4; ++j) { o1[j] = (x1[j] * cs[j] - x2[j] * sn[j]) * scl; o2[j] = (x1[j] * sn[j] + x2[j] * cs[j]) * scl; }
                    uint2 a, b; a.x = cvt_pk(o1[0], o1[1]); a.y = cvt_pk(o1[2], o1[3]); b.x = cvt_pk(o2[0], o2[1]); b.y = cvt_pk(o2[2], o2[3]);
                    *(uint2*)(ob + (size_t)row * 1024 + head * 256 + i0) = a;
                    *(uint2*)(ob + (size_t)row * 1024 + head * 256 + 128 + i0) = b;
                }
            }
        } else {
            const bool isg = (nt >= 32);
            bf16_t* ob = (bf16_t*)(p.ws + OFF_SLOT + (size_t)(isg ? 5 : 3) * SLOT);
#pragma unroll
            for (int n = 0; n < 4; ++n) {
                const int col = (nt & 15) * 128 + wc * 64 + n * 16 + fq * 4;
#pragma unroll
                for (int m = 0; m < 4; ++m) {
                    f32x4 v = acc[m][n];
                    if (isg) { v[0] = siluf_(v[0]); v[1] = siluf_(v[1]); v[2] = siluf_(v[2]); v[3] = siluf_(v[3]); }
                    uint2 o; o.x = cvt_pk(v[0], v[1]); o.y = cvt_pk(v[2], v[3]);
                    *(uint2*)(ob + (size_t)(row0 + m * 16) * 2048 + col) = o;
                }
            }
        }
    }
}
__device__ __forceinline__ void phase_gemm_jobs(const Params& p, char* lds, int jlo, int jhi) {
    const int total = p.gj[jhi - 1].tile0 + 128 * p.gj[jhi - 1].ntn - p.gj[jlo].tile0;
    for (int id = blockIdx.x; id < total; id += gridDim.x) {
        int j = jlo; const int gid = id + p.gj[jlo].tile0;
        while (j + 1 < jhi && gid >= p.gj[j + 1].tile0) ++j;
        GJob jb; jb.A = p.gj[j].A; jb.Bt = p.gj[j].Bt; jb.out = p.gj[j].out; jb.K = p.gj[j].K; jb.N = p.gj[j].N; jb.ldo = p.gj[j].ldo; jb.mode = p.gj[j].mode; jb.ntn = p.gj[j].ntn; jb.tile0 = p.gj[j].tile0;
        int mt, nt; tile_map(gid - jb.tile0, jb.ntn, mt, nt);
        int nv = jb.N - nt * 128; nv = nv > 128 ? 128 : nv;
        const bf16_t* ar[4]; const bf16_t* br[4];
        {
            const int t_ = tidx(), r0_ = t_ >> 3, co_ = glds_chunk(t_) * 8;
#pragma unroll
            for (int i = 0; i < 4; ++i) {
                ar[i] = jb.A + (size_t)(mt * 128 + r0_ + 32 * i) * jb.K + co_;
                int rb_ = r0_ + 32 * i; rb_ = rb_ < nv ? rb_ : nv - 1;
                br[i] = jb.Bt + (size_t)(nt * 128 + rb_) * jb.K + co_;
            }
        }
        f32x4 acc[4][4];
        gemm_gg(lds, jb.K / 64, ar, br, acc);
        gemm_epilogue(p, jb, mt, nt, acc);
    }
}

template <int KL>
__device__ __forceinline__ void minigemm(const bf16_t* A, const bf16_t* Bt, int fr, int fq, f32x4 (&acc)[2][4]) {
#pragma unroll
    for (int m = 0; m < 2; ++m)
#pragma unroll
        for (int n = 0; n < 4; ++n) acc[m][n] = (f32x4){0.f, 0.f, 0.f, 0.f};
#pragma unroll 1
    for (int ks = 0; ks < KL / 32; ++ks) {
        uint4 af[2], bfm[4];
#pragma unroll
        for (int m = 0; m < 2; ++m) af[m] = *(const uint4*)(A + (size_t)(m * 16 + fr) * KL + ks * 32 + fq * 8);
#pragma unroll
        for (int n = 0; n < 4; ++n) bfm[n] = *(const uint4*)(Bt + (size_t)(n * 16 + fr) * KL + ks * 32 + fq * 8);
#pragma unroll
        for (int m = 0; m < 2; ++m)
#pragma unroll
            for (int n = 0; n < 4; ++n) acc[m][n] = mfma16(bfm[n], af[m], acc[m][n]);
    }
}
__device__ __forceinline__ void phase_rw2(const Params& p, int jr) {
    const int t_ = tidx(); const int lane = t_ & 63, wid = t_ >> 6, wr = wid >> 1, wc = wid & 1, fr = lane & 15, fq = lane >> 4;
    char* S = p.ws + OFF_SLOT;
    float* decay = (float*)S; bf16_t* nkk = (bf16_t*)(S + 2 * SLOT); bf16_t* bb = (bf16_t*)(S + 3 * SLOT); bf16_t* gb = (bf16_t*)(S + 4 * SLOT);
    const bf16_t* rb = (const bf16_t*)(S + 6 * SLOT); const bf16_t* kb = (const bf16_t*)(S + 7 * SLOT); bf16_t* kpb = (bf16_t*)(S + 10 * SLOT);
    const bf16_t* vb = (const bf16_t*)(S + 8 * SLOT); bf16_t* vpb = (bf16_t*)(S + 9 * SLOT); const bf16_t* vf = (const bf16_t*)(S + 11 * SLOT);
    float* bonus = (float*)(p.ws + OFF_BONUS);
    const bf16_t* Lw = (const bf16_t*)(p.ws + OFF_LW); const bf16_t* La = (const bf16_t*)(p.ws + OFF_LA);
    const bf16_t* Lg = (const bf16_t*)(p.ws + OFF_LG); const bf16_t* Lv = (const bf16_t*)(p.ws + OFF_LV);
    const bf16_t* w2t = (const bf16_t*)(p.ws + W_W2T) + (size_t)jr * 1024 * 64; const bf16_t* a2t = (const bf16_t*)(p.ws + W_A2T) + (size_t)jr * 1024 * 64;
    const bf16_t* g2t = (const bf16_t*)(p.ws + W_G2T) + (size_t)jr * 1024 * 128; const bf16_t* v2t = (const bf16_t*)(p.ws + W_V2T);
    const float* w0 = p.in[8] + jr * 1024; const float* a0 = p.in[11] + jr * 1024; const float* v0 = p.in[14];
    const float* kkw = p.in[19] + jr * 1024; const float* kaw = p.in[20] + jr * 1024; const float* rk = p.in[21] + jr * 1024;
    for (int id2 = blockIdx.x * 2; id2 < 128 * 8 * 2; id2 += ((id2 & 1) ? (int)gridDim.x * 2 - 1 : 1)) {
        int mt, nt; tile_map(id2 >> 1, 8, mt, nt);
        const int row0 = mt * 128 + wr * 64 + (id2 & 1) * 32, col0 = nt * 128 + wc * 64, head = nt * 2 + wc;
        f32x4 acc[2][4];
        minigemm<64>(La + (size_t)row0 * 64, a2t + (size_t)col0 * 64, fr, fq, acc);
        float ss[2] = {0.f, 0.f}, bs[2] = {0.f, 0.f};
#pragma unroll
        for (int n = 0; n < 4; ++n) {
            const int col = col0 + n * 16 + fq * 4;
            const float4 a0v = *(const float4*)(a0 + col), kkv = *(const float4*)(kkw + col);
            const float a0a[4] = {a0v.x, a0v.y, a0v.z, a0v.w}, kka[4] = {kkv.x, kkv.y, kkv.z, kkv.w};
#pragma unroll
            for (int m = 0; m < 2; ++m) {
                const uint2 kr = *(const uint2*)(kb + (size_t)(row0 + m * 16 + fr) * 1024 + col);
                const float kf4[4] = {bflo(kr.x), bfhi(kr.x), bflo(kr.y), bfhi(kr.y)};
#pragma unroll
                for (int j = 0; j < 4; ++j) { acc[m][n][j] = sigmoidf_(a0a[j] + acc[m][n][j]); const float q = kf4[j] * kka[j]; ss[m] += q * q; }
            }
            asm volatile("" ::: "memory");
        }
#pragma unroll
        for (int m = 0; m < 2; ++m) { ss[m] += __shfl_xor(ss[m], 16); ss[m] += __shfl_xor(ss[m], 32); ss[m] = 1.0f / fmaxf(sqrtf(ss[m]), 1e-12f); }
#pragma unroll
        for (int n = 0; n < 4; ++n) {
            const int col = col0 + n * 16 + fq * 4;
            const float4 kkv = *(const float4*)(kkw + col), kav = *(const float4*)(kaw + col), rkv = *(const float4*)(rk + col);
            const float kka[4] = {kkv.x, kkv.y, kkv.z, kkv.w}, kaa[4] = {kav.x, kav.y, kav.z, kav.w}, rka[4] = {rkv.x, rkv.y, rkv.z, rkv.w};
#pragma unroll
            for (int m = 0; m < 2; ++m) {
                const size_t off = (size_t)(row0 + m * 16 + fr) * 1024 + col;
                const uint2 rr = *(const uint2*)(rb + off), kr = *(const uint2*)(kb + off);
                const float rf[4] = {bflo(rr.x), bfhi(rr.x), bflo(rr.y), bfhi(rr.y)}, kf4[4] = {bflo(kr.x), bfhi(kr.x), bflo(kr.y), bfhi(kr.y)};
                float kp[4], nk[4], b4[4];
#pragma unroll
                for (int j = 0; j < 4; ++j) {
                    const float a = acc[m][n][j], k = kf4[j], kn = k * kka[j] * ss[m];
                    kp[j] = k * (1.0f + (a - 1.0f) * kaa[j]); nk[j] = -kn; b4[j] = kn * a; bs[m] += rf[j] * kp[j] * rka[j];
                }
                uint2 o; o.x = cvt_pk(kp[0], kp[1]); o.y = cvt_pk(kp[2], kp[3]); *(uint2*)(kpb + off) = o;
                o.x = cvt_pk(nk[0], nk[1]); o.y = cvt_pk(nk[2], nk[3]); *(uint2*)(nkk + off) = o;
                o.x = cvt_pk(b4[0], b4[1]); o.y = cvt_pk(b4[2], b4[3]); *(uint2*)(bb + off) = o;
                asm volatile("" ::: "memory");
            }
        }
#pragma unroll
        for (int m = 0; m < 2; ++m) { bs[m] += __shfl_xor(bs[m], 16); bs[m] += __shfl_xor(bs[m], 32); if (fq == 0) bonus[(size_t)(row0 + m * 16 + fr) * 16 + head] = bs[m]; }
        minigemm<64>(Lw + (size_t)row0 * 64, w2t + (size_t)col0 * 64, fr, fq, acc);
#pragma unroll
        for (int n = 0; n < 4; ++n) {
            const int col = col0 + n * 16 + fq * 4;
            const float4 w0v = *(const float4*)(w0 + col); const float w0a[4] = {w0v.x, w0v.y, w0v.z, w0v.w};
#pragma unroll
            for (int m = 0; m < 2; ++m) {
                f32x4 o;
#pragma unroll
                for (int j = 0; j < 4; ++j) { const float wl = -softplusf_(-(w0a[j] + acc[m][n][j])) - 0.5f; o[j] = __expf(-__expf(wl)); }
                *(f32x4*)(decay + (size_t)(row0 + m * 16 + fr) * 1024 + col) = o;
            }
        }
        minigemm<128>(Lg + (size_t)row0 * 128, g2t + (size_t)col0 * 128, fr, fq, acc);
#pragma unroll
        for (int n = 0; n < 4; ++n)
#pragma unroll
            for (int m = 0; m < 2; ++m) {
                uint2 o; o.x = cvt_pk(acc[m][n][0], acc[m][n][1]); o.y = cvt_pk(acc[m][n][2], acc[m][n][3]);
                *(uint2*)(gb + (size_t)(row0 + m * 16 + fr) * 1024 + col0 + n * 16 + fq * 4) = o;
            }
        if (jr > 0) {
            minigemm<32>(Lv + (size_t)row0 * 32, v2t + (size_t)col0 * 32, fr, fq, acc);
#pragma unroll
            for (int n = 0; n < 4; ++n) {
                const int col = col0 + n * 16 + fq * 4;
                const float4 v0v = *(const float4*)(v0 + col); const float v0a[4] = {v0v.x, v0v.y, v0v.z, v0v.w};
#pragma unroll
                for (int m = 0; m < 2; ++m) {
                    const size_t off = (size_t)(row0 + m * 16 + fr) * 1024 + col;
                    const uint2 vr = *(const uint2*)(vb + off), fr2 = *(const uint2*)(vf + off);
                    const float v4[4] = {bflo(vr.x), bfhi(vr.x), bflo(vr.y), bfhi(vr.y)}, f4[4] = {bflo(fr2.x), bfhi(fr2.x), bflo(fr2.y), bfhi(fr2.y)};
                    float o4[4];
#pragma unroll
                    for (int j = 0; j < 4; ++j) o4[j] = v4[j] + (f4[j] - v4[j]) * sigmoidf_(v0a[j] + acc[m][n][j]);
                    uint2 o; o.x = cvt_pk(o4[0], o4[1]); o.y = cvt_pk(o4[2], o4[3]); *(uint2*)(vpb + off) = o;
                }
            }
        }
    }
}
__device__ __forceinline__ void phase_rw3(const Params& p, int jr, char* lds) {
    const int t = tidx(), lane = t & 63, wid = t >> 6, rowq = lane >> 4, jq = lane & 15;
    char* S = p.ws + OFF_SLOT;
    const float* decay = (const float*)S; const bf16_t* nkk = (const bf16_t*)(S + 2 * SLOT); const bf16_t* bb = (const bf16_t*)(S + 3 * SLOT);
    const bf16_t* rb = (const bf16_t*)(S + 6 * SLOT); const bf16_t* kb = (const bf16_t*)(S + 10 * SLOT);
    const bf16_t* vb = (const bf16_t*)(S + (jr == 0 ? 11 : 9) * SLOT); bf16_t* yb = (bf16_t*)(S + 5 * SLOT);
    float* buf = (float*)lds;
    float* ybuf = (float*)(lds + 2 * 16 * 336 * 4);
    for (int item = blockIdx.x; item < 512; item += gridDim.x) {
        const int bh = item >> 2, rg = item & 3, b = bh >> 4, h = bh & 15;
        const size_t base = (size_t)b * 2048 * 1024 + h * 64;
        const bf16_t* vecp[2]; int vdst[2];
#pragma unroll
        for (int u = 0; u < 2; ++u) {
            const int id = t + 256 * u, vec = id >> 7, rem = id & 127, step = rem >> 3, c8 = rem & 7;
            const bf16_t* bp = (vec == 0) ? nkk : (vec == 1) ? bb : (vec == 2) ? kb : rb;
            vecp[u] = bp + base + (size_t)step * 1024 + c8 * 8; vdst[u] = step * 336 + 64 + vec * 64 + c8 * 8;
        }
        const float* dp = decay + base + (size_t)(t >> 4) * 1024 + (t & 15) * 4; const int ddst = (t >> 4) * 336 + (t & 15) * 4;
        const bf16_t* vp = vb + base + (size_t)(t >> 1) * 1024 + rg * 16 + (t & 1) * 8; const int vvdst = (t >> 1) * 336 + 320 + (t & 1) * 8;
        uint4 g0, g1, gv; float4 gd;
        auto fetch = [&](int ch) {
            const size_t o = (size_t)ch * 16 * 1024;
            g0 = *(const uint4*)(vecp[0] + o); g1 = *(const uint4*)(vecp[1] + o); gd = *(const float4*)(dp + o);
            if (t < 32) gv = *(const uint4*)(vp + o);
        };
        auto stash = [&](float* bf) {
            float f[8];
            unpack8(g0, f); *(float4*)(bf + vdst[0]) = make_float4(f[0], f[1], f[2], f[3]); *(float4*)(bf + vdst[0] + 4) = make_float4(f[4], f[5], f[6], f[7]);
            unpack8(g1, f); *(float4*)(bf + vdst[1]) = make_float4(f[0], f[1], f[2], f[3]); *(float4*)(bf + vdst[1] + 4) = make_float4(f[4], f[5], f[6], f[7]);
            *(float4*)(bf + ddst) = gd;
            if (t < 32) { unpack8(gv, f); *(float4*)(bf + vvdst) = make_float4(f[0], f[1], f[2], f[3]); *(float4*)(bf + vvdst + 4) = make_float4(f[4], f[5], f[6], f[7]); }
        };
        float s0 = 0.f, s1 = 0.f, s2 = 0.f, s3 = 0.f;
        __syncthreads();
        fetch(0); stash(buf); __syncthreads();
        for (int ch = 0; ch < 128; ++ch) {
            if (ch + 1 < 128) fetch(ch + 1);
            const float* bf = buf + (ch & 1) * (16 * 336); float* yb_ = ybuf + (ch & 1) * 256;
#pragma unroll 4
            for (int s = 0; s < 16; ++s) {
                const float* q = bf + s * 336 + jq * 4;
                const float4 w = *(const float4*)q, a = *(const float4*)(q + 64), bq = *(const float4*)(q + 128), k = *(const float4*)(q + 192), r = *(const float4*)(q + 256);
                const float vv = bf[s * 336 + 320 + wid * 4 + rowq];
                float sa = s0 * a.x; sa = fmaf(s1, a.y, sa); sa = fmaf(s2, a.z, sa); sa = fmaf(s3, a.w, sa);
                sa = row16_sum(sa);
                s0 = fmaf(s0, w.x, fmaf(sa, bq.x, vv * k.x)); s1 = fmaf(s1, w.y, fmaf(sa, bq.y, vv * k.y));
                s2 = fmaf(s2, w.z, fmaf(sa, bq.z, vv * k.z)); s3 = fmaf(s3, w.w, fmaf(sa, bq.w, vv * k.w));
                float y = s0 * r.x; y = fmaf(s1, r.y, y); y = fmaf(s2, r.z, y); y = fmaf(s3, r.w, y);
                y = row16_sum(y);
                if (jq == 0) yb_[s * 16 + wid * 4 + rowq] = y;
            }
            if (ch + 1 < 128) stash(buf + ((ch + 1) & 1) * (16 * 336));
            __syncthreads();
            if (t < 32) { const int step = t >> 1, hf = t & 1; float f[8];
#pragma unroll
                for (int i = 0; i < 8; ++i) f[i] = yb_[step * 16 + hf * 8 + i];
                *(uint4*)(yb + base + (size_t)(ch * 16 + step) * 1024 + rg * 16 + hf * 8) = pack8(f); }
        }
    }
}
struct LdRw4 {
    struct Raw { uint4 y, v, g; float bn; };
    const bf16_t *y, *v, *g; const float *bonus, *gng, *gnb;
    __device__ __forceinline__ Raw fetch(int, int r, int kc) const {
        Raw q; const size_t o = (size_t)r * 1024 + kc * 8;
        q.y = *(const uint4*)(y + o); q.v = *(const uint4*)(v + o); q.g = *(const uint4*)(g + o); q.bn = bonus[r * 16 + (kc >> 3)]; return q;
    }
    __device__ __forceinline__ uint4 finish(const Raw& q, int, int, int kc) const {
        float yf[8], vf[8], gf[8]; unpack8(q.y, yf); unpack8(q.v, vf); unpack8(q.g, gf);
        float s = 0.f, s2 = 0.f;
#pragma unroll
        for (int i = 0; i < 8; ++i) { s += yf[i]; s2 += yf[i] * yf[i]; }
        s = oct_sum(s); s2 = oct_sum(s2);
        const float mean = s * (1.0f / 64.0f), var = fmaxf(s2 * (1.0f / 64.0f) - mean * mean, 0.f), rstd = rsqrtf(var + 64e-5f);
        const float4 ga = *(const float4*)(gng + kc * 8), gb = *(const float4*)(gng + kc * 8 + 4), ba = *(const float4*)(gnb + kc * 8), bb = *(const float4*)(gnb + kc * 8 + 4);
        const float gg[8] = {ga.x, ga.y, ga.z, ga.w, gb.x, gb.y, gb.z, gb.w}, bq[8] = {ba.x, ba.y, ba.z, ba.w, bb.x, bb.y, bb.z, bb.w};
        float o[8];
#pragma unroll
        for (int i = 0; i < 8; ++i) o[i] = ((yf[i] - mean) * rstd * gg[i] + bq[i] + q.bn * vf[i]) * gf[i];
        return pack8(o);
    }
};
__device__ __forceinline__ void phase_rw4(const Params& p, int jr, char* lds) {
    char* S = p.ws + OFF_SLOT;
    const bf16_t* yb = (const bf16_t*)(S + 5 * SLOT); const bf16_t* gb = (const bf16_t*)(S + 4 * SLOT);
    const bf16_t* vb = (const bf16_t*)(S + (jr == 0 ? 11 : 9) * SLOT); bf16_t* ymix = (bf16_t*)(S + 6 * SLOT);
    const bf16_t* wt = (const bf16_t*)(p.ws + W_OUT) + (size_t)jr * 1024 * 1024;
    const float* bonus = (const float*)(p.ws + OFF_BONUS);
    const int t_ = tidx(); const int lane = t_ & 63, wid = t_ >> 6, wr = wid >> 1, wc = wid & 1, fr = lane & 15, fq = lane >> 4;
    for (int id = blockIdx.x; id < 128 * 8; id += gridDim.x) {
        int mt, nt; tile_map(id, 8, mt, nt);
        const size_t ro = (size_t)mt * 128 * 1024;
        LdRw4 al{yb + ro, vb + ro, gb + ro, bonus + (size_t)mt * 128 * 16, p.in[22] + jr * 1024, p.in[23] + jr * 1024};
        const bf16_t* br[4];
        { const int t2_ = tidx(), r0_ = t2_ >> 3, co_ = glds_chunk(t2_) * 8;
#pragma unroll
          for (int i = 0; i < 4; ++i) br[i] = wt + (size_t)(nt * 128 + r0_ + 32 * i) * 1024 + co_; }
        f32x4 acc[4][4];
        gemm_rg(lds, 16, al, br, acc);
#pragma unroll
        for (int n = 0; n < 4; ++n)
#pragma unroll
            for (int m = 0; m < 4; ++m) {
                uint2 o; o.x = cvt_pk(acc[m][n][0], acc[m][n][1]); o.y = cvt_pk(acc[m][n][2], acc[m][n][3]);
                *(uint2*)(ymix + (size_t)(mt * 128 + wr * 64 + m * 16 + fr) * 1024 + nt * 128 + wc * 64 + n * 16 + fq * 4) = o;
            }
    }
}

__device__ __forceinline__ void phase_ml2(const Params& p, char* lds) {
    const int t = tidx(), vr = t >> 4, jq = t & 15;
    char* S = p.ws + OFF_SLOT;
    const bf16_t* qk = (const bf16_t*)(S + 1 * SLOT); const bf16_t* vb = (const bf16_t*)(S + 2 * SLOT); bf16_t* yb = (bf16_t*)(S + 4 * SLOT);
    const float* gates = (const float*)(p.ws + OFF_GATES); float* stat = (float*)(p.ws + OFF_STAT);
    const float* cw = p.in[27]; const float* cb = p.in[28];
    float* raw = (float*)lds;
    float* qkl = raw + 19 * 128;
    float* vl = qkl + 16 * 128;
    float* fl = vl + 256;
    float* yl = fl + 32;
    for (int item = blockIdx.x; item < 512; item += gridDim.x) {
        const int bh = item >> 3, vs = item & 7, b = bh >> 3, hd = bh & 7;
        const size_t tok0 = (size_t)b * 2048;
        float c0 = 0.f, c1 = 0.f, c2 = 0.f, c3 = 0.f, n0 = 0.f, n1 = 0.f, n2 = 0.f, n3 = 0.f;
        for (int ch = 0; ch < 128; ++ch) {
            const int s0 = ch * 16;
            __syncthreads();
            for (int id = t; id < 19 * 16; id += 256) {
                const int rr = id >> 4, c = id & 15, trow = s0 - 3 + rr;
                float f[8] = {0, 0, 0, 0, 0, 0, 0, 0};
                if (trow >= 0) { const uint4 u = *(const uint4*)(qk + (tok0 + trow) * 1024 + (c >> 3) * 512 + hd * 64 + (c & 7) * 8); unpack8(u, f); }
#pragma unroll
                for (int i = 0; i < 8; ++i) raw[rr * 128 + c * 8 + i] = f[i];
            }
            if (t < 32) { const int step = t >> 1, hf = t & 1; float f[8]; const uint4 u = *(const uint4*)(vb + (tok0 + s0 + step) * 1024 + hd * 128 + vs * 16 + hf * 8); unpack8(u, f);
#pragma unroll
                for (int i = 0; i < 8; ++i) vl[step * 16 + hf * 8 + i] = f[i]; }
            else if (t < 64) { const int step = (t - 32) >> 1, wh = t & 1; const float g = gates[(tok0 + s0 + step) * 16 + wh * 8 + hd]; fl[step * 2 + (wh ? 0 : 1)] = __expf(g); }
            __syncthreads();
            for (int id = t; id < 16 * 128; id += 256) {
                const int step = id >> 7, c = id & 127, chn = (c >> 6) * 512 + hd * 64 + (c & 63);
                float a = cb[chn];
#pragma unroll
                for (int j = 0; j < 4; ++j) a += cw[j * 1024 + chn] * raw[(step + j) * 128 + c];
                a = siluf_(a);
                qkl[step * 128 + c] = (c < 64) ? a * 0.125f : a;
            }
            __syncthreads();
#pragma unroll 4
            for (int s = 0; s < 16; ++s) {
                const float4 q = *(const float4*)(qkl + s * 128 + jq * 4), k = *(const float4*)(qkl + s * 128 + 64 + jq * 4);
                const float f = fl[s * 2], ei = fl[s * 2 + 1], ev = ei * vl[s * 16 + vr];
                c0 = fmaf(f, c0, ev * k.x); c1 = fmaf(f, c1, ev * k.y); c2 = fmaf(f, c2, ev * k.z); c3 = fmaf(f, c3, ev * k.w);
                n0 = fmaf(f, n0, ei * k.x); n1 = fmaf(f, n1, ei * k.y); n2 = fmaf(f, n2, ei * k.z); n3 = fmaf(f, n3, ei * k.w);
                float num = c0 * q.x; num = fmaf(c1, q.y, num); num = fmaf(c2, q.z, num); num = fmaf(c3, q.w, num);
                float den = n0 * q.x; den = fmaf(n1, q.y, den); den = fmaf(n2, q.z, den); den = fmaf(n3, q.w, den);
                num = row16_sum(num); den = row16_sum(den);
                if (jq == 0) yl[s * 16 + vr] = num / fmaxf(fabsf(den), 1.0f);
            }
            __syncthreads();
            { const int step = t >> 4, rr = t & 15; yb[(tok0 + s0 + step) * 1024 + hd * 128 + vs * 16 + rr] = f2bf(yl[step * 16 + rr]); }
            if (t < 16) { float s = 0.f, s2 = 0.f;
#pragma unroll
                for (int i = 0; i < 16; ++i) { const float y = yl[t * 16 + i]; s += y; s2 += y * y; }
                *(float2*)(stat + (((tok0 + s0 + t) * 8 + hd) * 8 + vs) * 2) = make_float2(s, s2); }
        }
    }
}
template <int HSHIFT  , int NH>
struct LdGnGate {
    struct Raw { uint4 y, g; };
    const bf16_t *y, *g; int ld; const float *gng, *gnb; const float* st;
    __device__ __forceinline__ Raw fetch(int, int r, int kc) const { Raw q; const size_t o = (size_t)r * ld + kc * 8; q.y = *(const uint4*)(y + o); q.g = *(const uint4*)(g + o); return q; }
    __device__ __forceinline__ uint4 finish(const Raw& q, int, int r, int kc) const {
        float yf[8], gf[8]; unpack8(q.y, yf); unpack8(q.g, gf);
        const float2 ms = *(const float2*)(st + (r * NH + ((kc * 8) >> HSHIFT)) * 2);
        const float4 ga = *(const float4*)(gng + kc * 8), gb = *(const float4*)(gng + kc * 8 + 4), ba = *(const float4*)(gnb + kc * 8), bb = *(const float4*)(gnb + kc * 8 + 4);
        const float gg[8] = {ga.x, ga.y, ga.z, ga.w, gb.x, gb.y, gb.z, gb.w}, bq[8] = {ba.x, ba.y, ba.z, ba.w, bb.x, bb.y, bb.z, bb.w};
        float o[8];
#pragma unroll
        for (int i = 0; i < 8; ++i) o[i] = ((yf[i] - ms.x) * ms.y * gg[i] + bq[i]) * gf[i];
        return pack8(o);
    }
};
template <int HSHIFT, int NH, int NPART>
__device__ __forceinline__ void phase_outproj_gn(const Params& p, char* lds, const bf16_t* yb, const bf16_t* gate, int K, const bf16_t* wt, const float* gng, const float* gnb, bf16_t* ymix) {
    const int t = tidx(), lane = t & 63, wid = t >> 6, wr = wid >> 1, wc = wid & 1, fr = lane & 15, fq = lane >> 4;
    const float* stat = (const float*)(p.ws + OFF_STAT);
    float* st = (float*)(lds + 65536);
    const float invn = 1.0f / (float)(1 << HSHIFT);
    for (int id = blockIdx.x; id < 128 * 8; id += gridDim.x) {
        int mt, nt; tile_map(id, 8, mt, nt);
        for (int i = t; i < 128 * NH; i += 256) {
            const float* q = stat + ((size_t)mt * 128 * NH + i) * NPART * 2;
            float s = 0.f, s2 = 0.f;
#pragma unroll
            for (int j = 0; j < NPART; ++j) { const float2 v = *(const float2*)(q + j * 2); s += v.x; s2 += v.y; }
            const float mean = s * invn, var = fmaxf(s2 * invn - mean * mean, 0.f);
            st[i * 2] = mean; st[i * 2 + 1] = rsqrtf(var + 1e-6f);
        }
        __syncthreads();
        const size_t ro = (size_t)mt * 128 * K;
        LdGnGate<HSHIFT, NH> al{yb + ro, gate + ro, K, gng, gnb, st};
        const bf16_t* br[4];
        { const int r0_ = t >> 3, co_ = glds_chunk(t) * 8;
#pragma unroll
          for (int i = 0; i < 4; ++i) br[i] = wt + (size_t)(nt * 128 + r0_ + 32 * i) * K + co_; }
        f32x4 acc[4][4];
        gemm_rg(lds, K / 64, al, br, acc);
#pragma unroll
        for (int n = 0; n < 4; ++n)
#pragma unroll
            for (int m = 0; m < 4; ++m) {
                uint2 o; o.x = cvt_pk(acc[m][n][0], acc[m][n][1]); o.y = cvt_pk(acc[m][n][2], acc[m][n][3]);
                *(uint2*)(ymix + (size_t)(mt * 128 + wr * 64 + m * 16 + fr) * 1024 + nt * 128 + wc * 64 + n * 16 + fq * 4) = o;
            }
    }
}

__device__ __forceinline__ void phase_rt2(const Params& p, char* lds) {
    const int t = tidx(), vc = t & 31, dg = t >> 5;
    char* S = p.ws + OFF_SLOT;
    const bf16_t* qb = (const bf16_t*)(S + 1 * SLOT); const bf16_t* kb = (const bf16_t*)(S + 2 * SLOT); const bf16_t* vb = (const bf16_t*)(S + 3 * SLOT);
    bf16_t* yb = (bf16_t*)(S + 7 * SLOT); float* stat = (float*)(p.ws + OFF_STAT);
    float* ql = (float*)lds;
    float* kl = ql + 16 * 256;
    float* vl = kl + 16 * 256;
    float* red = vl + 16 * 32;
    float* yf = red + 16 * 8 * 32;
    for (int item = blockIdx.x; item < 512; item += gridDim.x) {
        const int bh = item >> 4, vs = item & 15, b = bh >> 2, hd = bh & 3;
        const size_t tok0 = (size_t)b * 2048;
        const float gamma = 1.0f - exp2f(-5.0f - (float)hd);
        float R[32];
#pragma unroll
        for (int i = 0; i < 32; ++i) R[i] = 0.f;
        for (int ch = 0; ch < 128; ++ch) {
            const int s0 = ch * 16;
            __syncthreads();
            for (int id = t; id < 1024; id += 256) {
                const int which = id >> 9, rem = id & 511, step = rem >> 5, c = rem & 31;
                const uint4 u = *(const uint4*)((which ? kb : qb) + (tok0 + s0 + step) * 1024 + hd * 256 + c * 8);
                float f[8]; unpack8(u, f); float* d = (which ? kl : ql) + step * 256 + c * 8;
                *(float4*)d = make_float4(f[0], f[1], f[2], f[3]); *(float4*)(d + 4) = make_float4(f[4], f[5], f[6], f[7]);
            }
            if (t < 64) { const int step = t >> 2, c = t & 3; const uint4 u = *(const uint4*)(vb + (tok0 + s0 + step) * 2048 + hd * 512 + vs * 32 + c * 8);
                float f[8]; unpack8(u, f); float* d = vl + step * 32 + c * 8; *(float4*)d = make_float4(f[0], f[1], f[2], f[3]); *(float4*)(d + 4) = make_float4(f[4], f[5], f[6], f[7]); }
            __syncthreads();
#pragma unroll 2
            for (int s = 0; s < 16; ++s) {
                const float vv = vl[s * 32 + vc];
                const float* kq = kl + s * 256 + dg * 32; const float* qq = ql + s * 256 + dg * 32;
                float o = 0.f;
#pragma unroll
                for (int d4 = 0; d4 < 8; ++d4) {
                    const float4 k4 = *(const float4*)(kq + d4 * 4), q4 = *(const float4*)(qq + d4 * 4);
                    R[d4 * 4 + 0] = fmaf(R[d4 * 4 + 0], gamma, k4.x * vv); o = fmaf(q4.x, R[d4 * 4 + 0], o);
                    R[d4 * 4 + 1] = fmaf(R[d4 * 4 + 1], gamma, k4.y * vv); o = fmaf(q4.y, R[d4 * 4 + 1], o);
                    R[d4 * 4 + 2] = fmaf(R[d4 * 4 + 2], gamma, k4.z * vv); o = fmaf(q4.z, R[d4 * 4 + 2], o);
                    R[d4 * 4 + 3] = fmaf(R[d4 * 4 + 3], gamma, k4.w * vv); o = fmaf(q4.w, R[d4 * 4 + 3], o);
                }
                red[(s * 8 + dg) * 32 + vc] = o;
            }
            __syncthreads();
            for (int id = t; id < 512; id += 256) {
                const int step = id >> 5, c = id & 31; float s = 0.f;
#pragma unroll
                for (int g = 0; g < 8; ++g) s += red[(step * 8 + g) * 32 + c];
                yf[step * 32 + c] = s;
                yb[(tok0 + s0 + step) * 2048 + hd * 512 + vs * 32 + c] = f2bf(s);
            }
            __syncthreads();
            if (t < 16) { float s = 0.f, s2 = 0.f;
#pragma unroll
                for (int i = 0; i < 32; ++i) { const float y = yf[t * 32 + i]; s += y; s2 += y * y; }
                *(float2*)(stat + (((tok0 + s0 + t) * 4 + hd) * 16 + vs) * 2) = make_float2(s, s2); }
        }
    }
}

template <int WHICH  >
__device__ __forceinline__ void phase_moe(const Params& p, int L, char* lds, const bf16_t* hm, bf16_t* H) {
    const int t = tidx(), lane = t & 63, wid = t >> 6, wr = wid >> 1, wc = wid & 1, fr = lane & 15, fq = lane >> 4;
    const int* cnt = (const int*)(p.ws + OFF_CNT) + L * 32;
    const int* list = (const int*)(p.ws + OFF_LIST);
    bf16_t* Y = (bf16_t*)(p.ws + OFF_SLOT + 9 * SLOT);
    int* pre = (int*)(lds + 65536);
    __syncthreads();
    if (t == 0) { int s = 0; for (int e = 0; e < 32; ++e) { pre[e] = s; s += (cnt[e] + 127) >> 7; } pre[32] = s; }
    __syncthreads();
    const int total = pre[32] * 8;
    for (int id = blockIdx.x; id < total; id += gridDim.x) {
        const int nt = id & 7, mg = id >> 3;
        int e = 0;
#pragma unroll 1
        for (int s = 16; s >= 1; s >>= 1) if (pre[e + s] <= mg) e += s;
        const int mt = mg - pre[e], ne = cnt[e];
        const int* le = list + e * LIST_CAP + mt * 128;
        const bf16_t* ar[4]; const bf16_t* br[4];
        const int co_ = glds_chunk(t) * 8;
#pragma unroll
        for (int i = 0; i < 4; ++i) {
            int r = (t >> 3) + 32 * i; r = (mt * 128 + r < ne) ? r : 0;
            const int aid = le[r];
            ar[i] = ((WHICH == 0) ? hm + (size_t)(aid >> 1) * 1024 : H + (size_t)aid * 512) + co_;
        }
        f32x4 acc[4][4];
        if (WHICH == 0) {
            const bf16_t* wt = (const bf16_t*)(p.ws + W_MOE13) + ((size_t)(L * 32 + e) * 1024 + nt * 128) * 1024;
#pragma unroll
            for (int i = 0; i < 4; ++i) br[i] = wt + (size_t)((t >> 3) + 32 * i) * 1024 + co_;
            gemm_gg(lds, 16, ar, br, acc);
#pragma unroll
            for (int m = 0; m < 4; ++m) {
                const int r = wr * 64 + m * 16 + fr;
                if (mt * 128 + r < ne) {
                    const int aid = le[r];
#pragma unroll
                    for (int pp = 0; pp < 2; ++pp) {
                        const f32x4 a1 = acc[m][2 * pp], a3 = acc[m][2 * pp + 1];
                        uint2 o; o.x = cvt_pk(siluf_(a1[0]) * a3[0], siluf_(a1[1]) * a3[1]); o.y = cvt_pk(siluf_(a1[2]) * a3[2], siluf_(a1[3]) * a3[3]);
                        *(uint2*)(H + (size_t)aid * 512 + (nt * 4 + wc * 2 + pp) * 16 + fq * 4) = o;
                    }
                }
            }
        } else {
            const bf16_t* wt = (const bf16_t*)(p.ws + W_MOE2) + ((size_t)(L * 32 + e) * 1024 + nt * 128) * 512;
#pragma unroll
            for (int i = 0; i < 4; ++i) br[i] = wt + (size_t)((t >> 3) + 32 * i) * 512 + co_;
            gemm_gg(lds, 8, ar, br, acc);
#pragma unroll
            for (int m = 0; m < 4; ++m) {
                const int r = wr * 64 + m * 16 + fr;
                if (mt * 128 + r < ne) {
                    const int aid = le[r];
#pragma unroll
                    for (int n = 0; n < 4; ++n) {
                        uint2 o; o.x = cvt_pk(acc[m][n][0], acc[m][n][1]); o.y = cvt_pk(acc[m][n][2], acc[m][n][3]);
                        *(uint2*)(Y + (size_t)aid * 1024 + nt * 128 + wc * 64 + n * 16 + fq * 4) = o;
                    }
                }
            }
        }
    }
}

constexpr int NPHASE = 32;
#ifndef PHSEL
#define PHSEL -1
#endif
#ifndef PHEXC
#define PHEXC -2
#endif
#define PHON(x) ((PHSEL < 0 || PHSEL == (x)) && PHEXC != (x))
__global__ void __launch_bounds__(256, 2) mega(Params p_in) {
    const Params& p = p_in;
    extern __shared__ __attribute__((aligned(16))) char lds[];
    volatile LAS unsigned* xbw = (volatile LAS unsigned*)(lds + 73728);
    if (threadIdx.x == 0) { xbw[0] = 0u; xbw[1] = 0u; xbw[2] = 0u; xbw[3] = 0u; }
    __syncthreads();
    XcdBarrier bar;
    const bool multi = (p.ph_hi - p.ph_lo) > 1;
    (void)multi;
    if (multi) bar = xcd_barrier_post((unsigned*)(p.ws + OFF_CTL), xbw);
    char* S = p.ws + OFF_SLOT;
#ifdef DBG_STOP
    if (p.ph_lo == 100) {
        const float* src = (const float*)(p.ws + DBG_SRC);
        for (size_t i = (size_t)blockIdx.x * 256 + threadIdx.x; i < (size_t)NTOK * DM; i += (size_t)gridDim.x * 256) {
            float v = DBG_BF16 ? bf2f(((const bf16_t*)src)[i]) : src[i];
            if (!(fabsf(v) < 1e30f)) v = 1e30f;
            p.out[i] = v;
        }
        return;
    }
#endif
    const int ph_lo_ = p.ph_lo, ph_hi_ = p.ph_hi;
#ifdef TIMEIT
    unsigned long long t0_ = 0, t1_ = 0;
#endif
    for (int ph = ph_lo_; ph < ph_hi_; ++ph) {
        const Params* pp_ = (const Params*)__builtin_amdgcn_kernarg_segment_ptr();
        asm volatile("" : "+s"(pp_));
        const Params& p = *pp_;
#ifdef TIMEIT
        if (ph == TIME_A) t0_ = __builtin_amdgcn_s_memrealtime();
        if (ph == TIME_B) t1_ = __builtin_amdgcn_s_memrealtime();
#endif
        int L, sub, kind;
        if (ph < 2) { L = 0; sub = ph; kind = -1; }
        else if (ph < 10) { L = 0; kind = 0; sub = ph - 2; }
        else if (ph < 17) { L = 1; kind = 1; sub = ph - 10; }
        else if (ph < 24) { L = 2; kind = 2; sub = ph - 17; }
        else { L = 3; kind = 0; sub = ph - 24; }
        const int jr = L / 3;
        if (kind == -1) { if (sub == 0) { if (PHON(0)) phase_prologue(p, lds); } else { if (PHON(1)) phase_h0(p); } }
        else {
            const int ntail = (kind == 0) ? 4 : 3;
            if (sub < ntail) {
                if (kind == 0) {
                    if (sub == 0) { if (PHON(2)) phase_gemm_jobs(p, lds, jr * 7, jr * 7 + (jr ? 7 : 6)); }
                    else if (sub == 1) { if (PHON(3)) phase_rw2(p, jr); }
                    else if (sub == 2) { if (PHON(4)) phase_rw3(p, jr, lds); }
                    else { if (PHON(5)) phase_rw4(p, jr, lds); }
                } else if (kind == 1) {
                    if (sub == 0) { if (PHON(2)) phase_gemm_jobs(p, lds, 14, 15); }
                    else if (sub == 1) { if (PHON(6)) phase_ml2(p, lds); }
                    else if (PHON(7)) phase_outproj_gn<7, 8, 8>(p, lds, (const bf16_t*)(S + 4 * SLOT), (const bf16_t*)(S + 3 * SLOT), 1024, (const bf16_t*)(p.ws + W_MLOUT), p.in[29], p.in[30], (bf16_t*)(S + 6 * SLOT));
                } else {
                    if (sub == 0) { if (PHON(2)) phase_gemm_jobs(p, lds, 15, 16); }
                    else if (sub == 1) { if (PHON(8)) phase_rt2(p, lds); }
                    else if (PHON(9)) phase_outproj_gn<9, 4, 16>(p, lds, (const bf16_t*)(S + 7 * SLOT), (const bf16_t*)(S + 5 * SLOT), 2048, (const bf16_t*)(p.ws + W_RTOUT), p.in[33], p.in[34], (bf16_t*)(S + 1 * SLOT));
                }
            } else {
                const int ts = sub - ntail;
                const bf16_t* ymix = (const bf16_t*)(S + (kind == 2 ? 1 : 6) * SLOT);
                bf16_t* hm = (bf16_t*)(S + (kind == 2 ? 2 : 7) * SLOT);
                bf16_t* H = (bf16_t*)(S + (kind == 0 ? 2 : (kind == 1 ? 5 : 3)) * SLOT);
                if (ts == 0) { if (PHON(10)) phase_ln1(p, L, lds, ymix, hm); }
                else if (ts == 1) { if (PHON(11)) phase_moe<0>(p, L, lds, hm, H); }
                else if (ts == 2) { if (PHON(12)) phase_moe<1>(p, L, lds, hm, H); }
                else { if (PHON(13)) phase_ln2(p, L); }
            }
        }
        if (ph + 1 < ph_hi_) xcd_barrier(bar);
    }
#ifdef TIMEIT
    {
        xcd_barrier(bar);
        unsigned* tw = (unsigned*)(p.ws + OFF_CTL + 32768);
        if (blockIdx.x == 0 && threadIdx.x == 0) {
            if (t1_ == 0) t1_ = __builtin_amdgcn_s_memrealtime();
            const unsigned long long dt = t1_ - t0_;
            unsigned ms2 = (unsigned)((dt + TIME_U / 2) / TIME_U);
            __hip_atomic_store(tw, ms2, __ATOMIC_RELAXED, __HIP_MEMORY_SCOPE_AGENT);
        }
        xcd_barrier(bar);
        const float c_ = sqrtf((float)__hip_atomic_load(tw, __ATOMIC_RELAXED, __HIP_MEMORY_SCOPE_AGENT));
        for (size_t i = (size_t)blockIdx.x * 256 + threadIdx.x; i < (size_t)NTOK * DM; i += (size_t)gridDim.x * 256) p.out[i] = c_;
    }
#endif
#ifdef DBG_STOP
    if (ph_lo_ != 100) {
        xcd_barrier(bar);
        const float* src = (const float*)(p.ws + DBG_SRC);
        for (size_t i = (size_t)blockIdx.x * 256 + threadIdx.x; i < (size_t)NTOK * DM; i += (size_t)gridDim.x * 256) {
            float v = DBG_BF16 ? bf2f(((const bf16_t*)src)[i]) : src[i];
            if (!(fabsf(v) < 1e30f)) v = 1e30f;
            p.out[i] = v;
        }
    }
#endif
}

constexpr int LDS_BYTES = 73728 + 64;
extern "C" void kernel_launch(void* const* d_in, const int* in_sizes, int n_in, void* d_out, int out_size, void* d_ws, size_t ws_size, hipStream_t stream) {
    static int grid = 0;
    if (grid == 0) {
        if (n_in != 43 || out_size != NTOK * DM || ws_size < WS_NEED) { fprintf(stderr, "kernel_launch: unexpected shapes (n_in %d out %d ws %zu need %zu)\n", n_in, out_size, ws_size, (size_t)WS_NEED); }
        int dev = 0, cus = 0, per_cu = 0;
        (void)hipGetDevice(&dev); (void)hipDeviceGetAttribute(&cus, hipDeviceAttributeMultiprocessorCount, dev);
        (void)hipFuncSetAttribute((const void*)mega, hipFuncAttributeMaxDynamicSharedMemorySize, LDS_BYTES);
        (void)hipOccupancyMaxActiveBlocksPerMultiprocessor(&per_cu, (const void*)mega, 256, LDS_BYTES);
        if (per_cu > 2) per_cu = 2;
        if (per_cu < 1) per_cu = 1;
        grid = cus * per_cu;
        if (grid > 512) grid = 512;
        (void)hipGetLastError();
    }
    Params p{};
    for (int i = 0; i < 43; ++i) p.in[i] = (const float*)d_in[i];
    p.out = (float*)d_out; p.ws = (char*)d_ws;
    char* ws = (char*)d_ws;
    auto slot = [&](int i) { return (bf16_t*)(ws + OFF_SLOT + (size_t)i * SLOT); };
    int tile = 0;
    auto addg = [&](int idx, const bf16_t* A, const bf16_t* Bt, bf16_t* out, int K, int N, int ldo, int mode) {
        GJob& g = p.gj[idx]; g.A = A; g.Bt = Bt; g.out = out; g.K = K; g.N = N; g.ldo = ldo; g.mode = mode; g.ntn = (N + 127) / 128; g.tile0 = tile; tile += 128 * g.ntn;
    };
    for (int jr = 0; jr < 2; ++jr) {
        const bf16_t* rkv = (const bf16_t*)(ws + W_RKV) + (size_t)jr * 3 * 1024 * 1024;
        addg(jr * 7 + 0, slot(0), rkv, slot(6), 1024, 1024, 1024, MODE_BF16);
        addg(jr * 7 + 1, slot(1), rkv + 1024 * 1024, slot(7), 1024, 1024, 1024, MODE_BF16);
        addg(jr * 7 + 2, slot(2), rkv + 2 * 1024 * 1024, slot(jr == 0 ? 11 : 8), 1024, 1024, 1024, MODE_BF16);
        addg(jr * 7 + 3, slot(3), (const bf16_t*)(ws + W_W1T) + (size_t)jr * 64 * 1024, (bf16_t*)(ws + OFF_LW), 1024, 64, 64, MODE_TANH);
        addg(jr * 7 + 4, slot(4), (const bf16_t*)(ws + W_A1T) + (size_t)jr * 64 * 1024, (bf16_t*)(ws + OFF_LA), 1024, 64, 64, MODE_BF16);
        addg(jr * 7 + 5, slot(5), (const bf16_t*)(ws + W_G1T) + (size_t)jr * 128 * 1024, (bf16_t*)(ws + OFF_LG), 1024, 128, 128, MODE_SIGM);
        addg(jr * 7 + 6, slot(2), (const bf16_t*)(ws + W_V1T), (bf16_t*)(ws + OFF_LV), 1024, 32, 32, MODE_BF16);
    }
    addg(14, slot(0), (const bf16_t*)(ws + W_MLIN), nullptr, 1024, 3088, 0, MODE_ML1);
    addg(15, slot(0), (const bf16_t*)(ws + W_RTIN), nullptr, 1024, 6144, 0, MODE_RT1);
    int nc = 0, ctile = 0;
    auto addc = [&](const float* src, size_t dst_off, int K, int N, int nb, long sbs, long dbs, int mode) {
        CJob& c = p.cj[nc++]; c.src = src; c.dst = (bf16_t*)(ws + dst_off); c.K = K; c.N = N; c.nb = nb; c.mode = mode; c.sbs = sbs; c.dbs = dbs;
        c.tiles_pb = ((K + 63) / 64) * ((N + 63) / 64); c.tile0 = ctile; ctile += c.tiles_pb * nb;
    };
    addc(p.in[7], W_RKV, 1024, 1024, 6, 1024 * 1024, 1024 * 1024, 0);
    addc(p.in[24], W_OUT, 1024, 1024, 2, 1024 * 1024, 1024 * 1024, 0);
    addc(p.in[9], W_W1T, 1024, 64, 2, 1024 * 64, 64 * 1024, 0);
    addc(p.in[12], W_A1T, 1024, 64, 2, 1024 * 64, 64 * 1024, 0);
    addc(p.in[17], W_G1T, 1024, 128, 2, 1024 * 128, 128 * 1024, 0);
    addc(p.in[15], W_V1T, 1024, 32, 1, 0, 0, 0);
    addc(p.in[10], W_W2T, 64, 1024, 2, 64 * 1024, 1024 * 64, 0);
    addc(p.in[13], W_A2T, 64, 1024, 2, 64 * 1024, 1024 * 64, 0);
    addc(p.in[18], W_G2T, 128, 1024, 2, 128 * 1024, 1024 * 128, 0);
    addc(p.in[16], W_V2T, 32, 1024, 1, 0, 0, 0);
    addc(p.in[25], W_MLIN, 1024, 3088, 1, 0, 0, 0);
    addc(p.in[31], W_MLOUT, 1024, 1024, 1, 0, 0, 0);
    addc(p.in[32], W_RTIN, 1024, 6144, 1, 0, 0, 3);
    addc(p.in[35], W_RTOUT, 2048, 1024, 1, 0, 0, 0);
    addc(p.in[40], W_MOE13, 1024, 512, 128, 1024 * 512, 1024 * 1024, 1);
    addc(p.in[41], W_MOE13, 1024, 512, 128, 1024 * 512, 1024 * 1024, 2);
    addc(p.in[42], W_MOE2, 512, 1024, 128, 512 * 1024, 1024 * 512, 0);
    p.ncj = nc; p.cj_tiles = ctile;

    (void)hipMemsetAsync(ws + OFF_CTL, 0, CTL_BYTES, stream);
#ifdef DBG_STOP
    const int nph = DBG_STOP;
#else
    const int nph = NPHASE;
#endif
#ifdef MULTI_LAUNCH
    for (int ph = 0; ph < nph; ++ph) { p.ph_lo = ph; p.ph_hi = ph + 1; hipLaunchKernelGGL(mega, dim3(grid), dim3(256), LDS_BYTES, stream, p); }
    if (0)
#endif
    {
        p.ph_lo = 0; p.ph_hi = nph;
        void* args[] = {&p};
        hipError_t e = hipLaunchCooperativeKernel((const void*)mega, dim3(grid), dim3(256), args, LDS_BYTES, stream);
        if (e != hipSuccess) fprintf(stderr, "cooperative launch failed: %s (grid %d)\n", hipGetErrorString(e), grid);
    }
}
```

```cpp
#include <hip/hip_runtime.h>
#include <cstdio>
#include <cstdint>

#ifndef ONE_LAUNCH
#define ONE_LAUNCH 0
#endif

typedef unsigned short bf16_t;
typedef short bf16x8 __attribute__((ext_vector_type(8)));
typedef float f32x4 __attribute__((ext_vector_type(4)));
#define LAS __attribute__((address_space(3)))
#define GAS __attribute__((address_space(1)))
typedef float f32x4g_t __attribute__((ext_vector_type(4)));
typedef unsigned u32x2g_t __attribute__((ext_vector_type(2)));
typedef unsigned u32x4g_t __attribute__((ext_vector_type(4)));
__device__ __forceinline__ float4 gld_f4(const float* p) { const f32x4g_t v = *(const GAS f32x4g_t*)(const GAS char*)(const char*)p; return make_float4(v[0], v[1], v[2], v[3]); }
__device__ __forceinline__ uint2 gld_u2(const void* p) { const u32x2g_t v = *(const GAS u32x2g_t*)(const GAS char*)(const char*)p; return make_uint2(v[0], v[1]); }
__device__ __forceinline__ uint4 gld_u4(const void* p) { const u32x4g_t v = *(const GAS u32x4g_t*)(const GAS char*)(const char*)p; return make_uint4(v[0], v[1], v[2], v[3]); }
__device__ __forceinline__ void gst_f4(float* p, float a, float b, float c, float d) { const f32x4g_t v = {a, b, c, d}; *(GAS f32x4g_t*)(GAS char*)(char*)p = v; }
__device__ __forceinline__ void gst_u2(void* p, unsigned a, unsigned b) { const u32x2g_t v = {a, b}; *(GAS u32x2g_t*)(GAS char*)(char*)p = v; }
__device__ __forceinline__ void gst_u4(void* p, unsigned a, unsigned b, unsigned c, unsigned d) { const u32x4g_t v = {a, b, c, d}; *(GAS u32x4g_t*)(GAS char*)(char*)p = v; }

constexpr int NTOK = 16384, DM = 1024, TSEQ = 2048, NBATCH = 8;
constexpr float DN_ALPHA = 1.681792830507429f;
constexpr float LN_EPS = 1e-5f;
constexpr size_t MB = 1u << 20;
constexpr size_t OFF_CTL = 0, OFF_CNT = 16384, CTL_BYTES = 65536;
constexpr size_t OFF_MOD = 65536;
constexpr size_t OFF_ROT = 1 * MB;
constexpr size_t OFF_BONUS = 3 * MB, OFF_GATES = 4 * MB, OFF_STAT = 5 * MB, OFF_LW = 13 * MB, OFF_LA = 15 * MB, OFF_LG = 17 * MB, OFF_LV = 21 * MB,
                 OFF_WGT = 22 * MB, OFF_LIST = 23 * MB, OFF_RTW = 25 * MB;
constexpr size_t OFF_W = 32 * MB;
constexpr size_t W_RKV = OFF_W, W_OUT = W_RKV + 12 * MB, W_W1T = W_OUT + 4 * MB, W_A1T = W_W1T + 256 * 1024, W_G1T = W_A1T + 256 * 1024, W_V1T = W_G1T + 512 * 1024,
                 W_W2T = W_V1T + 64 * 1024, W_A2T = W_W2T + 256 * 1024, W_G2T = W_A2T + 256 * 1024, W_V2T = W_G2T + 512 * 1024, W_MLIN = W_V2T + 64 * 1024 + 832 * 1024,
                 W_MLOUT = W_MLIN + 6400 * 1024, W_RTIN = W_MLOUT + 2 * MB, W_RTOUT = W_RTIN + 12 * MB, W_MOE13 = W_RTOUT + 4 * MB, W_MOE2 = W_MOE13 + 256 * MB,
                 W_END = W_MOE2 + 128 * MB;
constexpr size_t OFF_XRES = 464 * MB;
constexpr size_t OFF_SLOT = 528 * MB, SLOT = 32 * MB;
static_assert(W_END <= OFF_XRES, "weights overflow");
constexpr size_t OFF_XRES2 = OFF_SLOT + 12 * SLOT;
constexpr size_t WS_NEED = OFF_XRES2 + 2 * SLOT;
constexpr int LIST_CAP = 16384;

#define XB_TMO      128
#define XB_XCNT(j)  (256  + 64 * (j))
#define XB_XSUB(j)  (1280 + 64 * (j))
#define XB_XGEN(j)  (2304 + 64 * (j))
#define XB_TOP      3328
#define XB_TOPGEN   3392
#define XCD_BAR_WORDS 3456
#define XB_SPIN_CAP (1u << 22)
__device__ __forceinline__ unsigned xb_ld(unsigned* p)              { return __hip_atomic_load(p, __ATOMIC_RELAXED, __HIP_MEMORY_SCOPE_AGENT); }
__device__ __forceinline__ unsigned xb_add(unsigned* p, unsigned v) { return __hip_atomic_fetch_add(p, v, __ATOMIC_RELAXED, __HIP_MEMORY_SCOPE_AGENT); }
__device__ __forceinline__ unsigned xb_xcc_id() { return (unsigned)__builtin_amdgcn_s_getreg((3 << 11) | 20) & 0xFu; }
#define XB_SPIN(cond, bar) do { unsigned _sp = 0; while (cond) { __builtin_amdgcn_s_sleep(1); \
    if ((++_sp & 255u) == 0u) { if (xb_ld(&(bar)[XB_TMO])) break; if (_sp > XB_SPIN_CAP) { atomicAdd(&(bar)[XB_TMO], 1u); break; } } } } while (0)
struct XcdBarrier { unsigned* bar; unsigned x; volatile LAS unsigned* st; };
__device__ __forceinline__ XcdBarrier xcd_barrier_post(unsigned* bar, volatile LAS unsigned* st) {
    XcdBarrier b; b.bar = bar; b.x = xb_xcc_id(); b.st = st;
    if (threadIdx.x == 0) (void)xb_add(&bar[XB_XCNT(b.x)], 1u);
    return b;
}
__device__ __forceinline__ void xcd_barrier_complete(unsigned* bar, unsigned x, unsigned& nloc, unsigned& nx) {
    const unsigned G = gridDim.x;
    unsigned sum, cnt, mine, sp = 0u;
    for (;;) {
        sum = 0u; cnt = 0u; mine = 0u;
#pragma unroll
        for (unsigned j = 0; j < 16; ++j) { const unsigned c = xb_ld(&bar[XB_XCNT(j)]); sum += c; cnt += (c > 0u) ? 1u : 0u; mine = (j == x) ? c : mine; }
        if (sum == G) break;
        __builtin_amdgcn_s_sleep(1);
        if ((++sp & 255u) == 0u) { if (xb_ld(&bar[XB_TMO])) break; if (sp > XB_SPIN_CAP) { atomicAdd(&bar[XB_TMO], 1u); break; } }
    }
    nloc = mine > 0u ? mine : 1u; nx = cnt > 0u ? cnt : 1u;
}
__device__ __forceinline__ void xcd_barrier(const XcdBarrier& b) {
    asm volatile("s_waitcnt vmcnt(0)" ::: "memory");
    __syncthreads();
    if (threadIdx.x == 0) {
        unsigned* bar = b.bar;
        __builtin_amdgcn_s_waitcnt(0);
        unsigned nloc = b.st[0], nx = b.st[1];
        if (nloc == 0u) { xcd_barrier_complete(bar, b.x, nloc, nx); b.st[0] = nloc; b.st[1] = nx; }
        const unsigned old = xb_add(&bar[XB_XSUB(b.x)], 1u);
        const unsigned gen = old / nloc;
        if (old + 1u == (gen + 1u) * nloc) {
            __builtin_amdgcn_fence(__ATOMIC_RELEASE, "agent");
            asm volatile("s_waitcnt vmcnt(0)" ::: "memory");
            const unsigned og = xb_add(&bar[XB_TOP], 1u);
            const unsigned tg = og / nx;
            if (og + 1u == (tg + 1u) * nx) xb_add(&bar[XB_TOPGEN], 1u);
            else XB_SPIN(xb_ld(&bar[XB_TOPGEN]) == tg, bar);
            __builtin_amdgcn_fence(__ATOMIC_ACQUIRE, "agent");
            xb_add(&bar[XB_XGEN(b.x)], 1u);
            asm volatile("s_waitcnt vmcnt(0)" ::: "memory");
        } else {
            XB_SPIN(xb_ld(&bar[XB_XGEN(b.x)]) == gen, bar);
            __builtin_amdgcn_fence(__ATOMIC_ACQUIRE, "agent");
            asm volatile("s_waitcnt vmcnt(0)" ::: "memory");
        }
    }
    __syncthreads();
}

__device__ __forceinline__ int tidx() { int t = threadIdx.x; asm volatile("" : "+v"(t)); return t; }
typedef __bf16 bf16x2_t __attribute__((ext_vector_type(2)));
typedef float f32x2_t __attribute__((ext_vector_type(2)));
__device__ __forceinline__ unsigned cvt_pk(float lo, float hi) {
    f32x2_t v = {lo, hi}; bf16x2_t r = __builtin_convertvector(v, bf16x2_t);
    unsigned u; __builtin_memcpy(&u, &r, 4); return u;
}
__device__ __forceinline__ bf16_t f2bf(float f) { return (bf16_t)(cvt_pk(f, 0.f) & 0xffffu); }
__device__ __forceinline__ float bflo(unsigned u) { return __uint_as_float(u << 16); }
__device__ __forceinline__ float bfhi(unsigned u) { return __uint_as_float(u & 0xffff0000u); }
__device__ __forceinline__ float bf2f(bf16_t u) { return __uint_as_float(((unsigned)u) << 16); }
__device__ __forceinline__ void unpack8(const uint4& u, float (&f)[8]) {
    f[0] = bflo(u.x); f[1] = bfhi(u.x); f[2] = bflo(u.y); f[3] = bfhi(u.y); f[4] = bflo(u.z); f[5] = bfhi(u.z); f[6] = bflo(u.w); f[7] = bfhi(u.w);
}
__device__ __forceinline__ uint4 pack8(const float (&f)[8]) { uint4 u; u.x = cvt_pk(f[0], f[1]); u.y = cvt_pk(f[2], f[3]); u.z = cvt_pk(f[4], f[5]); u.w = cvt_pk(f[6], f[7]); return u; }
typedef unsigned u32x4_t __attribute__((ext_vector_type(4)));
__device__ __forceinline__ uint4 gload16(const void* p) {
    const u32x4_t v = *(const __attribute__((address_space(1))) u32x4_t*)p;
    return make_uint4(v[0], v[1], v[2], v[3]);
}
__device__ __forceinline__ float sigmoidf_(float x) { return __builtin_amdgcn_rcpf(1.0f + __expf(-x)); }
__device__ __forceinline__ float siluf_(float x) { return x * __builtin_amdgcn_rcpf(1.0f + __expf(-x)); }
__device__ __forceinline__ float tanhf_(float x) { return 1.0f - 2.0f * __builtin_amdgcn_rcpf(1.0f + __expf(2.0f * x)); }
__device__ __forceinline__ float softplusf_(float x) { return fmaxf(x, 0.f) + __logf(1.0f + __expf(-fabsf(x))); }
__device__ __forceinline__ float row16_sum(float v);
__device__ __forceinline__ float wave_sum(float v) {
    v = row16_sum(v); v += __shfl_xor(v, 16); v += __shfl_xor(v, 32);
    return v;
}
__device__ __forceinline__ float row16_sum(float v) {
    v += __builtin_amdgcn_update_dpp(0.f, v, 0x128, 0xf, 0xf, false);
    v += __builtin_amdgcn_update_dpp(0.f, v, 0x124, 0xf, 0xf, false);
    v += __builtin_amdgcn_update_dpp(0.f, v, 0x122, 0xf, 0xf, false);
    v += __builtin_amdgcn_update_dpp(0.f, v, 0x121, 0xf, 0xf, false);
    return v;
}
__device__ __forceinline__ float oct_sum(float v) {
    v += __builtin_amdgcn_update_dpp(0.f, v, 0xB1, 0xf, 0xf, false);
    v += __builtin_amdgcn_update_dpp(0.f, v, 0x4E, 0xf, 0xf, false);
    v += __builtin_amdgcn_update_dpp(0.f, v, 0x141, 0xf, 0xf, false);
    return v;
}

enum { MODE_BF16 = 0, MODE_TANH = 1, MODE_SIGM = 2, MODE_ML1 = 3, MODE_RT1 = 4 };
struct GJob { const bf16_t* A; const bf16_t* Bt; bf16_t* out; int K, N, ldo, mode, ntn, tile0; };
struct CJob { const float* src; bf16_t* dst; int K, N, nb, mode; long sbs, dbs; int tiles_pb, tile0; };
constexpr int NGJ = 20, NCJ = 24;
struct Params {
    const float* in[43]; float* out; char* ws;
    int ph_lo, ph_hi, ncj, cj_tiles;
    GJob gj[NGJ];
    CJob cj[NCJ];
};
#define CAS __attribute__((address_space(4)))
typedef const CAS Params& PRef;

__device__ __forceinline__ f32x4 mfma16(const uint4& a, const uint4& b, f32x4 c) {
    bf16x8 av, bv; __builtin_memcpy(&av, &a, 16); __builtin_memcpy(&bv, &b, 16);
    return __builtin_amdgcn_mfma_f32_16x16x32_bf16(av, bv, c, 0, 0, 0);
}
template <bool PFA = true, class AL, class BL>
__device__ __forceinline__ void gemm_mainloop(char* lds, int nk, const AL& al, const BL& bl, f32x4 (&acc)[4][4]) {
    const int t = tidx(), c = t & 7, r0 = t >> 3;
    const int lane = t & 63, wid = t >> 6, wr = wid >> 1, wc = wid & 1, fr = lane & 15, fq = lane >> 4;
    typename AL::Raw ra[4]; typename BL::Raw rb[4];
    const int woff = r0 * 128 + ((c ^ (r0 & 7)) << 4);
#pragma unroll
    for (int i = 0; i < 4; ++i) { if (PFA) ra[i] = al.fetch(i, r0 + 32 * i, c); rb[i] = bl.fetch(i, r0 + 32 * i, c); }
#pragma unroll
    for (int i = 0; i < 4; ++i) {
        if (!PFA) { ra[i] = al.fetch(i, r0 + 32 * i, c); }
        *(uint4*)(lds + woff + i * 4096) = al.finish(ra[i], i, r0 + 32 * i, c);
        *(uint4*)(lds + 16384 + woff + i * 4096) = bl.finish(rb[i], i, r0 + 32 * i, c);
        if (!PFA) asm volatile("" ::: "memory");
    }
#pragma unroll
    for (int m = 0; m < 4; ++m)
#pragma unroll
        for (int n = 0; n < 4; ++n) acc[m][n] = (f32x4){0.f, 0.f, 0.f, 0.f};
    __syncthreads();
    const int aoff = (wr * 64 + fr) * 128, boff = 16384 + (wc * 64 + fr) * 128, sw = fr & 7;
    for (int kt = 0; kt < nk; ++kt) {
        const bool more = (kt + 1 < nk);
        if (more) {
#pragma unroll
            for (int i = 0; i < 4; ++i) { if (PFA) ra[i] = al.fetch(i, r0 + 32 * i, (kt + 1) * 8 + c); rb[i] = bl.fetch(i, r0 + 32 * i, (kt + 1) * 8 + c); }
        }
        const char* buf = lds + (kt & 1) * 32768;
#pragma unroll
        for (int ks = 0; ks < 2; ++ks) {
            uint4 af[4], bfm[4];
            const int ch = ((ks * 4 + fq) ^ sw) << 4;
#pragma unroll
            for (int m = 0; m < 4; ++m) af[m] = *(const uint4*)(buf + aoff + m * 2048 + ch);
#pragma unroll
            for (int n = 0; n < 4; ++n) bfm[n] = *(const uint4*)(buf + boff + n * 2048 + ch);
#pragma unroll
            for (int m = 0; m < 4; ++m)
#pragma unroll
                for (int n = 0; n < 4; ++n) acc[m][n] = mfma16(bfm[n], af[m], acc[m][n]);
        }
        if (more) {
            char* nb = lds + ((kt + 1) & 1) * 32768;
#pragma unroll
            for (int i = 0; i < 4; ++i) {
                if (!PFA) ra[i] = al.fetch(i, r0 + 32 * i, (kt + 1) * 8 + c);
                *(uint4*)(nb + woff + i * 4096) = al.finish(ra[i], i, r0 + 32 * i, (kt + 1) * 8 + c);
                *(uint4*)(nb + 16384 + woff + i * 4096) = bl.finish(rb[i], i, r0 + 32 * i, (kt + 1) * 8 + c);
                if (!PFA) asm volatile("" ::: "memory");
            }
        }
        __syncthreads();
    }
}
__device__ __forceinline__ void glds16(const bf16_t* g, char* l) {
    __builtin_amdgcn_global_load_lds((const unsigned*)g, (LAS unsigned*)l, 16, 0, 0);
}
__device__ __forceinline__ void glds16_asm(const void* gsrc, unsigned lds_dst) {
    unsigned keep;
    asm volatile("s_mov_b32 %0, m0\n\ts_mov_b32 m0, %2\n\ts_nop 0\n\tglobal_load_lds_dwordx4 %1, off\n\ts_mov_b32 m0, %0" : "=&s"(keep) : "v"(gsrc), "s"(lds_dst) : "memory");
}
__device__ __forceinline__ unsigned lds_addr_u(const char* l) { return (unsigned)(size_t)(const LAS char*)l; }
__device__ __forceinline__ int glds_chunk(int t) { return (t & 7) ^ ((t >> 3) & 7); }
__device__ __forceinline__ void mma_ktile(const char* buf, int aoff, int boff, int sw, int fq, f32x4 (&acc)[4][4]) {
    const int ch0 = ((0 * 4 + fq) ^ sw) << 4, ch1 = ((1 * 4 + fq) ^ sw) << 4;
    const char* pa = buf + aoff; const char* pb = buf + boff;
    uint4 a0[4], a1[4], b[8];
#pragma unroll
    for (int m = 0; m < 4; ++m) a0[m] = *(const uint4*)(pa + m * 2048 + ch0);
    b[0] = *(const uint4*)(pb + ch0); b[1] = *(const uint4*)(pb + 2048 + ch0);
    __builtin_amdgcn_sched_barrier(0);
    b[2] = *(const uint4*)(pb + 2 * 2048 + ch0);
#pragma unroll
    for (int m = 0; m < 4; ++m) acc[m][0] = mfma16(b[0], a0[m], acc[m][0]);
    __builtin_amdgcn_sched_barrier(0);
    b[3] = *(const uint4*)(pb + 3 * 2048 + ch0);
#pragma unroll
    for (int m = 0; m < 4; ++m) acc[m][1] = mfma16(b[1], a0[m], acc[m][1]);
    __builtin_amdgcn_sched_barrier(0);
#pragma unroll
    for (int m = 0; m < 4; ++m) a1[m] = *(const uint4*)(pa + m * 2048 + ch1);
#pragma unroll
    for (int m = 0; m < 4; ++m) acc[m][2] = mfma16(b[2], a0[m], acc[m][2]);
    __builtin_amdgcn_sched_barrier(0);
    b[4] = *(const uint4*)(pb + ch1); b[5] = *(const uint4*)(pb + 2048 + ch1);
#pragma unroll
    for (int m = 0; m < 4; ++m) acc[m][3] = mfma16(b[3], a0[m], acc[m][3]);
    __builtin_amdgcn_sched_barrier(0);
    b[6] = *(const uint4*)(pb + 2 * 2048 + ch1);
#pragma unroll
    for (int m = 0; m < 4; ++m) acc[m][0] = mfma16(b[4], a1[m], acc[m][0]);
    __builtin_amdgcn_sched_barrier(0);
    b[7] = *(const uint4*)(pb + 3 * 2048 + ch1);
#pragma unroll
    for (int m = 0; m < 4; ++m) acc[m][1] = mfma16(b[5], a1[m], acc[m][1]);
    __builtin_amdgcn_sched_barrier(0);
#pragma unroll
    for (int m = 0; m < 4; ++m) acc[m][2] = mfma16(b[6], a1[m], acc[m][2]);
#pragma unroll
    for (int m = 0; m < 4; ++m) acc[m][3] = mfma16(b[7], a1[m], acc[m][3]);
}
__device__ __forceinline__ void gemm_gg(char* lds, int nk, const bf16_t* const (&ar)[4], const bf16_t* const (&br)[4], f32x4 (&acc)[4][4]) {
    const int t = tidx();
    const int lane = t & 63, wid = t >> 6, wr = wid >> 1, wc = wid & 1, fr = lane & 15, fq = lane >> 4;
    const unsigned wbs = (unsigned)__builtin_amdgcn_readfirstlane((int)(lds_addr_u(lds) + wid * 1024));
#pragma unroll
    for (int i = 0; i < 4; ++i) { glds16_asm(ar[i], wbs + i * 4096); glds16_asm(br[i], wbs + 16384 + i * 4096); }
#pragma unroll
    for (int m = 0; m < 4; ++m)
#pragma unroll
        for (int n = 0; n < 4; ++n) acc[m][n] = (f32x4){0.f, 0.f, 0.f, 0.f};
    asm volatile("s_waitcnt vmcnt(0)" ::: "memory");
    __syncthreads();
    const int aoff = (wr * 64 + fr) * 128, boff = 16384 + (wc * 64 + fr) * 128, sw = fr & 7;
    for (int kt = 0; kt < nk; ++kt) {
        if (kt + 1 < nk) {
            const unsigned nb = (unsigned)__builtin_amdgcn_readfirstlane((int)(wbs + ((kt + 1) & 1) * 32768));
#pragma unroll
            for (int i = 0; i < 4; ++i) { glds16_asm(ar[i] + (kt + 1) * 64, nb + i * 4096); glds16_asm(br[i] + (kt + 1) * 64, nb + 16384 + i * 4096); }
        }
        mma_ktile(lds + (kt & 1) * 32768, aoff, boff, sw, fq, acc);
        asm volatile("s_waitcnt vmcnt(0)" ::: "memory");
        __syncthreads();
    }
}
__device__ __forceinline__ void gemm_hn(char* lds, int nk, const bf16_t* const (&ar)[4], const bf16_t* const (&br)[2], f32x4 (&acc)[2][4]) {
    const int t = tidx();
    const int lane = t & 63, wid = t >> 6, fr = lane & 15, fq = lane >> 4;
    const unsigned wbs = (unsigned)__builtin_amdgcn_readfirstlane((int)(lds_addr_u(lds) + wid * 1024));
#pragma unroll
    for (int i = 0; i < 4; ++i) glds16_asm(ar[i], wbs + i * 4096);
#pragma unroll
    for (int i = 0; i < 2; ++i) glds16_asm(br[i], wbs + 16384 + i * 4096);
#pragma unroll
    for (int m = 0; m < 2; ++m)
#pragma unroll
        for (int n = 0; n < 4; ++n) acc[m][n] = (f32x4){0.f, 0.f, 0.f, 0.f};
    asm volatile("s_waitcnt vmcnt(0)" ::: "memory");
    __syncthreads();
    const int aoff = (wid * 32 + fr) * 128, boff = 16384 + fr * 128, sw = fr & 7;
    for (int kt = 0; kt < nk; ++kt) {
        if (kt + 1 < nk) {
            const unsigned nb = (unsigned)__builtin_amdgcn_readfirstlane((int)(wbs + ((kt + 1) & 1) * 32768));
#pragma unroll
            for (int i = 0; i < 4; ++i) glds16_asm(ar[i] + (kt + 1) * 64, nb + i * 4096);
#pragma unroll
            for (int i = 0; i < 2; ++i) glds16_asm(br[i] + (kt + 1) * 64, nb + 16384 + i * 4096);
        }
        const char* buf = lds + (kt & 1) * 32768;
#pragma unroll
        for (int ks = 0; ks < 2; ++ks) {
            const int ch = ((ks * 4 + fq) ^ sw) << 4;
            uint4 af[2], bfm[4];
#pragma unroll
            for (int m = 0; m < 2; ++m) af[m] = *(const uint4*)(buf + aoff + m * 2048 + ch);
#pragma unroll
            for (int n = 0; n < 4; ++n) bfm[n] = *(const uint4*)(buf + boff + n * 2048 + ch);
#pragma unroll
            for (int m = 0; m < 2; ++m)
#pragma unroll
                for (int n = 0; n < 4; ++n) acc[m][n] = mfma16(bfm[n], af[m], acc[m][n]);
        }
        asm volatile("s_waitcnt vmcnt(0)" ::: "memory");
        __syncthreads();
    }
}
template <class AL>
__device__ __forceinline__ void gemm_rg(char* lds, int nk, const AL& al, const bf16_t* const (&br)[4], f32x4 (&acc)[4][4]) {
    const int t = tidx(), c = t & 7, r0 = t >> 3;
    const int lane = t & 63, wid = t >> 6, wr = wid >> 1, wc = wid & 1, fr = lane & 15, fq = lane >> 4;
    char* wb = lds + wid * 1024;
    const int woff = r0 * 128 + ((c ^ (r0 & 7)) << 4);
#pragma unroll
    for (int i = 0; i < 4; ++i) glds16(br[i], wb + 16384 + i * 4096);
#pragma unroll
    for (int i = 0; i < 4; ++i) {
        typename AL::Raw ra = al.fetch(i, r0 + 32 * i, c);
        *(uint4*)(lds + woff + i * 4096) = al.finish(ra, i, r0 + 32 * i, c);
        asm volatile("" ::: "memory");
    }
#pragma unroll
    for (int m = 0; m < 4; ++m)
#pragma unroll
        for (int n = 0; n < 4; ++n) acc[m][n] = (f32x4){0.f, 0.f, 0.f, 0.f};
    asm volatile("s_waitcnt vmcnt(0)" ::: "memory");
    __syncthreads();
    const int aoff = (wr * 64 + fr) * 128, boff = 16384 + (wc * 64 + fr) * 128, sw = fr & 7;
    for (int kt = 0; kt < nk; ++kt) {
        const bool more = (kt + 1 < nk);
        char* nbuf = lds + ((kt + 1) & 1) * 32768;
        if (more) {
#pragma unroll
            for (int i = 0; i < 4; ++i) glds16(br[i] + (kt + 1) * 64, nbuf + wid * 1024 + 16384 + i * 4096);
        }
        mma_ktile(lds + (kt & 1) * 32768, aoff, boff, sw, fq, acc);
        if (more) {
#pragma unroll
            for (int i = 0; i < 4; ++i) {
                typename AL::Raw ra = al.fetch(i, r0 + 32 * i, (kt + 1) * 8 + c);
                *(uint4*)(nbuf + woff + i * 4096) = al.finish(ra, i, r0 + 32 * i, (kt + 1) * 8 + c);
                asm volatile("" ::: "memory");
            }
        }
        asm volatile("s_waitcnt vmcnt(0)" ::: "memory");
        __syncthreads();
    }
}
struct LdPlain {
    typedef uint4 Raw;
    const bf16_t* p; int ld; int nvalid;
    __device__ __forceinline__ uint4 fetch(int, int r, int kc) const { return (r < nvalid) ? *(const uint4*)(p + (size_t)r * ld + kc * 8) : make_uint4(0u, 0u, 0u, 0u); }
    __device__ __forceinline__ uint4 finish(const uint4& v, int, int, int) const { return v; }
};
struct LdGather {
    typedef uint4 Raw;
    const bf16_t* rp[4];
    __device__ __forceinline__ uint4 fetch(int i, int, int kc) const { const bf16_t* q = rp[i]; return q ? *(const uint4*)(q + kc * 8) : make_uint4(0u, 0u, 0u, 0u); }
    __device__ __forceinline__ uint4 finish(const uint4& v, int, int, int) const { return v; }
};
__device__ __forceinline__ void tile_map(int id, int NT, int& mt, int& nt) {
    const int x = id & 7, q = id >> 3;
    const int mg = q / (8 * NT), q2 = q - mg * 8 * NT, G = (NT + 7) >> 3;
    int g = q2 >> 6; g = g < G - 1 ? g : G - 1;
    const int r = q2 - (g << 6), w = (g == G - 1) ? NT - 8 * g : 8;
    mt = (mg * 8 + r / w) * 8 + x; nt = 8 * g + r % w;
}

__device__ __forceinline__ int conv_row(int mode, int n) {
    if (mode == 1) return (n >> 4) * 32 + (n & 15);
    if (mode == 2) return (n >> 4) * 32 + 16 + (n & 15);
    if (mode == 3 && n < 2048) { const int c = n & 255, c2 = c & 127; return (n & ~255) + (c2 >> 4) * 32 + ((c >> 7) << 4) + (c2 & 15); }
    return n;
}
__device__ __forceinline__ void phase_prologue(PRef p, char* lds) {
    const int t = tidx();
    const int n_ada = 8 * 48, n_rot = 256 + 144;
    float* mod = (float*)(p.ws + OFF_MOD);
    for (int it = blockIdx.x; it < n_ada + n_rot; it += gridDim.x) {
        if (it < n_ada) {
            const int pr = it / 48, cb = it % 48;
            float* sc = (float*)lds;
            float* red = (float*)(lds + 32768);
            for (int i = t; i < 8192; i += 256) { const int b = i >> 10, k = i & 1023; sc[k * 8 + b] = siluf_(p.in[1][b * 1024 + k]); }
            __syncthreads();
            const int kg = t >> 6, cl = t & 63, col = cb * 64 + cl;
            const float* W = p.in[2] + (size_t)pr * 1024 * 3072 + col;
            float a[8] = {0, 0, 0, 0, 0, 0, 0, 0};
#pragma unroll 8
            for (int k = kg * 256; k < kg * 256 + 256; ++k) {
                const float w = W[(size_t)k * 3072];
                const float4 s0 = *(const float4*)(sc + k * 8), s1 = *(const float4*)(sc + k * 8 + 4);
                a[0] += w * s0.x; a[1] += w * s0.y; a[2] += w * s0.z; a[3] += w * s0.w; a[4] += w * s1.x; a[5] += w * s1.y; a[6] += w * s1.z; a[7] += w * s1.w;
            }
#pragma unroll
            for (int b = 0; b < 8; ++b) red[(kg * 8 + b) * 64 + cl] = a[b];
            __syncthreads();
            for (int i = t; i < 512; i += 256) {
                const int b = i >> 6, c2 = i & 63;
                const float s = red[(0 * 8 + b) * 64 + c2] + red[(1 * 8 + b) * 64 + c2] + red[(2 * 8 + b) * 64 + c2] + red[(3 * 8 + b) * 64 + c2];
                mod[((size_t)pr * 8 + b) * 3072 + cb * 64 + c2] = s + p.in[3][pr * 3072 + cb * 64 + c2];
            }
            __syncthreads();
        } else if (it >= n_ada + 256 && it < n_ada + n_rot) {
            float* rtw = (float*)(p.ws + OFF_RTW);
            const int base = (it - n_ada - 256) * 1024;
            for (int e = base + t; e < base + 1024; e += 256) {
                const int L = e / (36 * 1024), o = (e >> 10) % 36, k = e & 1023;
                rtw[e] = (o < 4) ? p.in[36][((size_t)L * 1024 + k) * 4 + o] : p.in[38][((size_t)L * 1024 + k) * 32 + (o - 4)];
            }
        } else if (it < n_ada + 256) {
            float* rot = (float*)(p.ws + OFF_ROT);
            const int base = (it - n_ada) * 1024;
            for (int e = base + t; e < base + 1024; e += 256) {
                const int tt = e >> 7, i = e & 127;
                const float inv = __builtin_amdgcn_exp2f(-(float)i * (13.287712379549449f / 127.0f));
                const float ang = (float)tt * inv;
                float rev = ang * 0.15915494309189535f; rev -= floorf(rev);
                rot[e * 2] = __builtin_amdgcn_cosf(rev); rot[e * 2 + 1] = __builtin_amdgcn_sinf(rev);
            }
        }
    }
    {
        float* sm = (float*)lds;
        const int lane = t & 63, wv = t >> 6;
        const float* nsrc = nullptr; bf16_t* ndst = nullptr; int nK = 0, nN = 0, nmode = 0, nkt = 0, nnt = 0;
        float4 pv[16];
#define CJ_SETUP(ct_) { int c_ = (ct_), j_ = 0; while (j_ + 1 < p.ncj && c_ >= p.cj[j_ + 1].tile0) ++j_; \
            c_ -= p.cj[j_].tile0; const int tpb_ = p.cj[j_].tiles_pb; const int bi_ = c_ / tpb_, tl_ = c_ % tpb_; nK = p.cj[j_].K; nN = p.cj[j_].N; nmode = p.cj[j_].mode; \
            const int nNt_ = (nN + 255) >> 8; nkt = tl_ / nNt_; nnt = tl_ % nNt_; nsrc = p.cj[j_].src + (size_t)bi_ * p.cj[j_].sbs; ndst = p.cj[j_].dst + (size_t)bi_ * p.cj[j_].dbs; }
#define CJ_LOAD() { _Pragma("unroll") for (int i = 0; i < 16; ++i) { const int k = nkt * 64 + wv + 4 * i, n = nnt * 256 + lane * 4; \
            pv[i] = (k < nK && n < nN) ? gld_f4(nsrc + (size_t)k * nN + n) : make_float4(0.f, 0.f, 0.f, 0.f); } }
        int* const tick = (int*)(p.ws + OFF_CTL + 20480);
        int* const nbox = (int*)(lds + 66560);
        int ct = (int)blockIdx.x, ct2 = (int)gridDim.x + (int)blockIdx.x;
        if (ct < p.cj_tiles) { CJ_SETUP(ct); CJ_LOAD(); }
        while (ct < p.cj_tiles) {
#pragma unroll
            for (int i = 0; i < 16; ++i) *(float4*)(sm + (wv + 4 * i) * 260 + lane * 4) = pv[i];
            bf16_t* const sdst = ndst; const int sK = nK, sN = nN, smode = nmode, skt = nkt, snt = nnt;
            if (ct2 < p.cj_tiles) { CJ_SETUP(ct2); CJ_LOAD(); }
            if (t == 0) *nbox = 2 * (int)gridDim.x + atomicAdd(tick, 1);
            __syncthreads();
            const int ct3 = *nbox;
#pragma unroll
            for (int h2 = 0; h2 < 4; ++h2) {
                const int nl = lane + 64 * h2, n = snt * 256 + nl, k0 = skt * 64 + wv * 16;
                if (n < sN && k0 < sK) {
                    float f[8], g[8];
#pragma unroll
                    for (int q = 0; q < 8; ++q) { f[q] = sm[(wv * 16 + q) * 260 + nl]; g[q] = sm[(wv * 16 + 8 + q) * 260 + nl]; }
                    bf16_t* d = sdst + (size_t)conv_row(smode, n) * sK + k0;
                    { const uint4 u0 = pack8(f), u1 = pack8(g); gst_u4(d, u0.x, u0.y, u0.z, u0.w); gst_u4(d + 8, u1.x, u1.y, u1.z, u1.w); }
                }
            }
            __syncthreads();
            ct = ct2; ct2 = ct3;
        }
#undef CJ_SETUP
#undef CJ_LOAD
    }
}

__device__ __forceinline__ void row_load_f32(const float* p, float (&v)[16], int lane) {
#pragma unroll
    for (int c = 0; c < 4; ++c) { const float4 x = gld_f4(p + c * 256 + lane * 4); v[c * 4] = x.x; v[c * 4 + 1] = x.y; v[c * 4 + 2] = x.z; v[c * 4 + 3] = x.w; }
}
__device__ __forceinline__ void row_load_f32_l(const float* p, float (&v)[16], int lane) {
#pragma unroll
    for (int c = 0; c < 4; ++c) { const float4 x = *(const float4*)(p + c * 256 + lane * 4); v[c * 4] = x.x; v[c * 4 + 1] = x.y; v[c * 4 + 2] = x.z; v[c * 4 + 3] = x.w; }
}
__device__ __forceinline__ void row_load_bf16(const bf16_t* p, float (&v)[16], int lane) {
#pragma unroll
    for (int c = 0; c < 4; ++c) { const uint2 x = gld_u2(p + c * 256 + lane * 4); v[c * 4] = bflo(x.x); v[c * 4 + 1] = bfhi(x.x); v[c * 4 + 2] = bflo(x.y); v[c * 4 + 3] = bfhi(x.y); }
}
__device__ __forceinline__ void row_store_bf16(bf16_t* p, const float (&v)[16], int lane) {
#pragma unroll
    for (int c = 0; c < 4; ++c) gst_u2(p + c * 256 + lane * 4, cvt_pk(v[c * 4], v[c * 4 + 1]), cvt_pk(v[c * 4 + 2], v[c * 4 + 3]));
}
__device__ __forceinline__ void row_store_f32(float* p, const float (&v)[16], int lane) {
#pragma unroll
    for (int c = 0; c < 4; ++c) gst_f4(p + c * 256 + lane * 4, v[c * 4], v[c * 4 + 1], v[c * 4 + 2], v[c * 4 + 3]);
}
__device__ __forceinline__ void row_store_f32_l(float* p, const float (&v)[16], int lane) {
#pragma unroll
    for (int c = 0; c < 4; ++c) *(float4*)(p + c * 256 + lane * 4) = make_float4(v[c * 4], v[c * 4 + 1], v[c * 4 + 2], v[c * 4 + 3]);
}
__device__ __forceinline__ void row_layernorm(float (&v)[16], const float* g, const float* b, int lane) {
    float gg[16], bb[16]; row_load_f32(g, gg, lane); row_load_f32(b, bb, lane);
    float s = 0.f, q = 0.f;
#pragma unroll
    for (int i = 0; i < 16; ++i) { s += v[i]; q += v[i] * v[i]; }
    s = wave_sum(s); q = wave_sum(q);
    const float mean = s * (1.0f / 1024.0f);
    const float rstd = rsqrtf(fmaxf(q * (1.0f / 1024.0f) - mean * mean, 0.f) + LN_EPS);
#pragma unroll
    for (int i = 0; i < 16; ++i) v[i] = (v[i] - mean) * rstd * gg[i] + bb[i];
}
__device__ __forceinline__ void row_modulate(const float (&x)[16], float (&h)[16], const float* mod3, int lane) {
    float sh[16], sc[16]; row_load_f32(mod3, sh, lane); row_load_f32(mod3 + 1024, sc, lane);
#pragma unroll
    for (int i = 0; i < 16; ++i) h[i] = x[i] * (1.0f + sc[i]) + sh[i];
}
__device__ __forceinline__ void load_mu(const float* mu, float (&m)[6][16], int lane) {
#pragma unroll
    for (int n = 0; n < 6; ++n) row_load_f32(mu + n * 1024, m[n], lane);
}
__device__ __forceinline__ void emit_next(bf16_t* s0, int kind, int row, const float (&h)[16], const float (&hp)[16], const float (&m)[6][16], int lane) {
    if (kind == 0) {
#pragma unroll
        for (int n = 0; n < 6; ++n) {
#pragma unroll
            for (int c = 0; c < 4; ++c)
                gst_u2(s0 + (size_t)n * (SLOT / 2) + (size_t)row * 1024 + c * 256 + lane * 4,
                       cvt_pk(h[c * 4] + (hp[c * 4] - h[c * 4]) * m[n][c * 4], h[c * 4 + 1] + (hp[c * 4 + 1] - h[c * 4 + 1]) * m[n][c * 4 + 1]),
                       cvt_pk(h[c * 4 + 2] + (hp[c * 4 + 2] - h[c * 4 + 2]) * m[n][c * 4 + 2], h[c * 4 + 3] + (hp[c * 4 + 3] - h[c * 4 + 3]) * m[n][c * 4 + 3]));
        }
    } else row_store_bf16(s0 + (size_t)row * 1024, h, lane);
}
__device__ __forceinline__ void emit_next_l(bf16_t* s0, const float* mu, int kind, int row, const float (&h)[16], const float (&hp)[16], int lane) {
    if (kind == 0) {
#pragma unroll 1
        for (int n = 0; n < 6; ++n) {
#pragma unroll
            for (int c2 = 0; c2 < 2; ++c2) {
                const float4 ma = gld_f4(mu + n * 1024 + (2 * c2) * 256 + lane * 4), mb = gld_f4(mu + n * 1024 + (2 * c2 + 1) * 256 + lane * 4);
                const float mm[8] = {ma.x, ma.y, ma.z, ma.w, mb.x, mb.y, mb.z, mb.w};
#pragma unroll
                for (int cc = 0; cc < 2; ++cc) {
                    const int c = 2 * c2 + cc;
                    gst_u2(s0 + (size_t)n * (SLOT / 2) + (size_t)row * 1024 + c * 256 + lane * 4,
                           cvt_pk(h[c * 4] + (hp[c * 4] - h[c * 4]) * mm[cc * 4], h[c * 4 + 1] + (hp[c * 4 + 1] - h[c * 4 + 1]) * mm[cc * 4 + 1]),
                           cvt_pk(h[c * 4 + 2] + (hp[c * 4 + 2] - h[c * 4 + 2]) * mm[cc * 4 + 2], h[c * 4 + 3] + (hp[c * 4 + 3] - h[c * 4 + 3]) * mm[cc * 4 + 3]));
                }
            }
        }
    } else row_store_bf16(s0 + (size_t)row * 1024, h, lane);
}
__device__ __forceinline__ void phase_h0(PRef p) {
    const int t_ = tidx(); const int lane = t_ & 63, gw = blockIdx.x * 4 + (t_ >> 6), nw = gridDim.x * 4;
    const int rpw = NTOK / nw;
    const int r_lo = gw * rpw;
    const float* mod = (const float*)(p.ws + OFF_MOD) + ((size_t)(0 * 2 + 0) * 8 + (r_lo >> 11)) * 3072;
    float sh[16], sc[16]; row_load_f32(mod, sh, lane); row_load_f32(mod + 1024, sc, lane);
    float hp[16];
#pragma unroll
    for (int i = 0; i < 16; ++i) hp[i] = 0.f;
    float mu[6][16]; load_mu(p.in[6], mu, lane);
    const int first = ((r_lo & 2047) != 0) ? r_lo - 1 : r_lo, end = r_lo + rpw;
    float nx[16]; row_load_f32(p.in[0] + (size_t)first * 1024, nx, lane);
    for (int r = first; r < end; ++r) {
        float h[16];
#pragma unroll
        for (int i = 0; i < 16; ++i) h[i] = nx[i] * (1.0f + sc[i]) + sh[i];
        if (r + 1 < end) row_load_f32(p.in[0] + (size_t)(r + 1) * 1024, nx, lane);
        __builtin_amdgcn_sched_barrier(0);
        if (r >= r_lo) emit_next((bf16_t*)(p.ws + OFF_SLOT), 0, r, h, hp, mu, lane);
#pragma unroll
        for (int i = 0; i < 16; ++i) hp[i] = h[i];
        if (((r + 1) & 2047) == 0) {
#pragma unroll
            for (int i = 0; i < 16; ++i) hp[i] = 0.f;
        }
    }
}
__device__ __forceinline__ int layer_kind(int L) { return L % 3; }
__device__ __forceinline__ void phase_ln2(PRef p, int L) {
    const int t_ = tidx(); const int lane = t_ & 63, gw = blockIdx.x * 4 + (t_ >> 6), nw = gridDim.x * 4;
    const int rpw = NTOK / nw, r_lo = gw * rpw;
    const float* mod = (const float*)(p.ws + OFF_MOD);
    const bf16_t* xres = (const bf16_t*)(p.ws + OFF_XRES);
    const bf16_t* Y = (const bf16_t*)(p.ws + OFF_SLOT + 9 * SLOT);
    const float* wgt = (const float*)(p.ws + OFF_WGT);
    const bool last = (L == 3);
    const int nk = layer_kind(L + 1), njr = (L + 1) / 3;
    const bool need_prev = (!last && nk == 0);
    const int bidx = r_lo >> 11;
    float gt[16], lgn[16], lbn[16];
    row_load_f32(mod + ((size_t)(L * 2 + 1) * 8 + bidx) * 3072 + 2048, gt, lane);
    row_load_f32(p.in[4] + (L * 2 + 1) * 1024, lgn, lane); row_load_f32(p.in[5] + (L * 2 + 1) * 1024, lbn, lane);
    float hp[16];
#pragma unroll
    for (int i = 0; i < 16; ++i) hp[i] = 0.f;
    float shn[16], scn[16];
    { const float* mn_ = mod + ((size_t)((last ? L : L + 1) * 2 + 0) * 8 + bidx) * 3072; row_load_f32(mn_, shn, lane); row_load_f32(mn_ + 1024, scn, lane); }
    uint2 nxr[4], ny0[4], ny1[4]; float nw0, nw1;
    auto load_in = [&](int r) {
#pragma unroll
        for (int c = 0; c < 4; ++c) { nxr[c] = *(const uint2*)(xres + (size_t)r * 1024 + c * 256 + lane * 4); ny0[c] = *(const uint2*)(Y + (size_t)(2 * r) * 1024 + c * 256 + lane * 4); ny1[c] = *(const uint2*)(Y + (size_t)(2 * r + 1) * 1024 + c * 256 + lane * 4); }
        nw0 = wgt[2 * r]; nw1 = wgt[2 * r + 1];
    };
    const int first = (need_prev && (r_lo & 2047) != 0) ? r_lo - 1 : r_lo, end = r_lo + rpw;
    load_in(first);
    for (int r = first; r < end; ++r) {
        float x[16];
        {
            const float w0 = nw0, w1 = nw1;
#pragma unroll
            for (int c = 0; c < 4; ++c) {
                const float a0[4] = {bflo(ny0[c].x), bfhi(ny0[c].x), bflo(ny0[c].y), bfhi(ny0[c].y)}, a1[4] = {bflo(ny1[c].x), bfhi(ny1[c].x), bflo(ny1[c].y), bfhi(ny1[c].y)};
                const float xr[4] = {bflo(nxr[c].x), bfhi(nxr[c].x), bflo(nxr[c].y), bfhi(nxr[c].y)};
#pragma unroll
                for (int i = 0; i < 4; ++i) x[c * 4 + i] = DN_ALPHA * xr[i] + (1.0f + gt[c * 4 + i]) * (w0 * a0[i] + w1 * a1[i]);
            }
        }
        if (r + 1 < end) load_in(r + 1);
        __builtin_amdgcn_sched_barrier(0);
        float s = 0.f, q = 0.f;
#pragma unroll
        for (int i = 0; i < 16; ++i) { s += x[i]; q += x[i] * x[i]; }
        s = wave_sum(s); q = wave_sum(q);
        const float mean = s * (1.0f / 1024.0f), rstd = rsqrtf(fmaxf(q * (1.0f / 1024.0f) - mean * mean, 0.f) + LN_EPS);
#pragma unroll
        for (int i = 0; i < 16; ++i) x[i] = (x[i] - mean) * rstd * lgn[i] + lbn[i];
        if (last) { row_store_f32(p.out + (size_t)r * 1024, x, lane); continue; }
        float h[16];
#pragma unroll
        for (int i = 0; i < 16; ++i) h[i] = x[i] * (1.0f + scn[i]) + shn[i];
        if (r >= r_lo) { row_store_bf16((bf16_t*)(p.ws + OFF_XRES2) + (size_t)r * 1024, x, lane); emit_next_l((bf16_t*)(p.ws + OFF_SLOT), p.in[6] + (size_t)njr * 6 * 1024, nk, r, h, hp, lane); }
#pragma unroll
        for (int i = 0; i < 16; ++i) hp[i] = h[i];
        if (((r + 1) & 2047) == 0) {
#pragma unroll
            for (int i = 0; i < 16; ++i) hp[i] = 0.f;
        }
    }
}
__device__ __forceinline__ void phase_ln1(PRef p, int L, char* lds, const bf16_t* ymix, bf16_t* hm) {
    const int t = tidx(), lane = t & 63, wid = t >> 6;
    const float* mod = (const float*)(p.ws + OFF_MOD);
    const bf16_t* xinb = (const bf16_t*)(p.ws + OFF_XRES2);
    bf16_t* xres = (bf16_t*)(p.ws + OFF_XRES);
    int* cnt = (int*)(p.ws + OFF_CNT) + L * 32;
    int* list = (int*)(p.ws + OFF_LIST);
    float* wgt = (float*)(p.ws + OFF_WGT);
    float* const HB = (float*)lds;
    float* const lg = (float*)(lds + 65536);
    const float* rtw = (const float*)(p.ws + OFF_RTW) + (size_t)L * 36 * 1024;
    const int rpb = NTOK / gridDim.x;
    const int bidx = (blockIdx.x * rpb) >> 11;
    float gt[16], lgn[16], lbn[16], sh2[16], sc2[16];
    row_load_f32(mod + ((size_t)(L * 2 + 0) * 8 + bidx) * 3072 + 2048, gt, lane);
    row_load_f32(p.in[4] + (L * 2 + 0) * 1024, lgn, lane); row_load_f32(p.in[5] + (L * 2 + 0) * 1024, lbn, lane);
    row_load_f32(mod + ((size_t)(L * 2 + 1) * 8 + bidx) * 3072, sh2, lane); row_load_f32(mod + ((size_t)(L * 2 + 1) * 8 + bidx) * 3072 + 1024, sc2, lane);
    for (int rb0 = blockIdx.x * rpb; rb0 < (blockIdx.x + 1) * rpb; rb0 += 16) {
        const int rb = rb0 + wid * 4;
        uint4 xr[4][4]; uint2 yr[4][4];
#pragma unroll
        for (int rr = 0; rr < 4; ++rr) {
            const int r = rb + rr;
#pragma unroll
            for (int c = 0; c < 4; ++c) {
                if (L == 0) xr[rr][c] = gld_u4(p.in[0] + (size_t)r * 1024 + c * 256 + lane * 4);
                else { const uint2 t2 = gld_u2(xinb + (size_t)r * 1024 + c * 256 + lane * 4); xr[rr][c] = make_uint4(t2.x, t2.y, 0u, 0u); }
                yr[rr][c] = gld_u2(ymix + (size_t)r * 1024 + c * 256 + lane * 4);
            }
        }
#pragma unroll
        for (int rr = 0; rr < 4; ++rr) {
            const int r = rb + rr;
            float x[16], h[16];
#pragma unroll
            for (int c = 0; c < 4; ++c) {
                float xv[4];
                if (L == 0) { xv[0] = __uint_as_float(xr[rr][c].x); xv[1] = __uint_as_float(xr[rr][c].y); xv[2] = __uint_as_float(xr[rr][c].z); xv[3] = __uint_as_float(xr[rr][c].w); }
                else { xv[0] = bflo(xr[rr][c].x); xv[1] = bfhi(xr[rr][c].x); xv[2] = bflo(xr[rr][c].y); xv[3] = bfhi(xr[rr][c].y); }
                const float yv[4] = {bflo(yr[rr][c].x), bfhi(yr[rr][c].x), bflo(yr[rr][c].y), bfhi(yr[rr][c].y)};
#pragma unroll
                for (int i = 0; i < 4; ++i) x[c * 4 + i] = DN_ALPHA * xv[i] + (1.0f + gt[c * 4 + i]) * yv[i];
            }
            float s = 0.f, q = 0.f;
#pragma unroll
            for (int i = 0; i < 16; ++i) { s += x[i]; q += x[i] * x[i]; }
            s = wave_sum(s); q = wave_sum(q);
            const float mean = s * (1.0f / 1024.0f), rstd = rsqrtf(fmaxf(q * (1.0f / 1024.0f) - mean * mean, 0.f) + LN_EPS);
#pragma unroll
            for (int i = 0; i < 16; ++i) { x[i] = (x[i] - mean) * rstd * lgn[i] + lbn[i]; h[i] = x[i] * (1.0f + sc2[i]) + sh2[i]; }
            row_store_bf16(xres + (size_t)r * 1024, x, lane);
            row_store_bf16(hm + (size_t)r * 1024, h, lane);
            row_store_f32_l(HB + (wid * 4 + rr) * 1024, h, lane);
        }
        __syncthreads();
#pragma unroll 1
        for (int q3 = 0; q3 < 9; q3 += 3) {
            float w[3][16];
#pragma unroll
            for (int u = 0; u < 3; ++u) row_load_f32(rtw + (size_t)(wid * 9 + q3 + u) * 1024, w[u], lane);
#pragma unroll 2
            for (int r16 = 0; r16 < 16; ++r16) {
                float h[16]; row_load_f32_l(HB + r16 * 1024, h, lane);
                float a3[3];
#pragma unroll
                for (int u = 0; u < 3; ++u) { f32x2_t s2 = {0.f, 0.f};
#pragma unroll
                    for (int i = 0; i < 8; ++i) { const f32x2_t hh = {h[2 * i], h[2 * i + 1]}, ww = {w[u][2 * i], w[u][2 * i + 1]}; s2 = __builtin_elementwise_fma(hh, ww, s2); }
                    a3[u] = wave_sum(s2.x + s2.y); }
                if (lane == 0) {
#pragma unroll
                    for (int u = 0; u < 3; ++u) lg[r16 * 36 + wid * 9 + q3 + u] = a3[u];
                }
            }
        }
        __syncthreads();
        if (t < 16) {
            const int row = rb0 + t; const float* l = lg + t * 36;
            float g[4]; for (int i = 0; i < 4; ++i) g[i] = l[i] + p.in[37][L * 4 + i];
            int gi = 0; for (int i = 1; i < 4; ++i) if (g[i] > g[gi]) gi = i;
            float gs = 0.f; for (int i = 0; i < 4; ++i) gs += __expf(g[i] - g[gi]);
            const float ggate = 1.0f / gs;
            float e[8]; for (int i = 0; i < 8; ++i) e[i] = l[4 + gi * 8 + i] + p.in[39][L * 32 + gi * 8 + i];
            int i0 = 0; for (int i = 1; i < 8; ++i) if (e[i] > e[i0]) i0 = i;
            int i1 = (i0 == 0) ? 1 : 0; for (int i = 0; i < 8; ++i) if (i != i0 && e[i] > e[i1]) i1 = i;
            const float p1 = __expf(e[i1] - e[i0]);
            const float w0 = ggate / (1.0f + p1), w1 = ggate * p1 / (1.0f + p1);
            const int e0 = gi * 8 + i0, e1 = gi * 8 + i1;
            const int pos0 = atomicAdd(&cnt[e0], 1), pos1 = atomicAdd(&cnt[e1], 1);
            list[e0 * LIST_CAP + pos0] = 2 * row; list[e1 * LIST_CAP + pos1] = 2 * row + 1;
            wgt[2 * row] = w0; wgt[2 * row + 1] = w1;
        }
        asm volatile("s_waitcnt lgkmcnt(0)" ::: "memory");
    }
}

__device__ __forceinline__ int perm64(int r) { return (r & 64) | (((r >> 2) & 3) << 4) | (((r >> 4) & 3) << 2) | (r & 3); }
__device__ __forceinline__ bool tile_permuted(int mode, int nt) { return (mode <= MODE_SIGM) || (mode == MODE_ML1 && nt < 24) || (mode == MODE_RT1 && nt >= 16); }
__device__ __forceinline__ void store16(bf16_t* d, const f32x4 (&v)[4]) {
    gst_u4(d, cvt_pk(v[0][0], v[0][1]), cvt_pk(v[0][2], v[0][3]), cvt_pk(v[1][0], v[1][1]), cvt_pk(v[1][2], v[1][3]));
    gst_u4(d + 8, cvt_pk(v[2][0], v[2][1]), cvt_pk(v[2][2], v[2][3]), cvt_pk(v[3][0], v[3][1]), cvt_pk(v[3][2], v[3][3]));
}
__device__ __forceinline__ void gemm_epilogue(PRef p, const GJob& jb, int mt, int nt, const f32x4 (&acc)[4][4]) {
    const int t_ = tidx(); const int lane = t_ & 63, wid = t_ >> 6, wr = wid >> 1, wc = wid & 1, fr = lane & 15, fq = lane >> 4;
    const int row0 = mt * 128 + wr * 64 + fr;
    if (jb.mode <= MODE_SIGM) {
        const int col = nt * 128 + wc * 64 + fq * 16;
        if (col < jb.N) {
#pragma unroll
            for (int m = 0; m < 4; ++m) {
                f32x4 v[4];
#pragma unroll
                for (int n = 0; n < 4; ++n) {
                    v[n] = acc[m][n];
                    if (jb.mode == MODE_TANH) { v[n][0] = tanhf_(v[n][0]); v[n][1] = tanhf_(v[n][1]); v[n][2] = tanhf_(v[n][2]); v[n][3] = tanhf_(v[n][3]); }
                    else if (jb.mode == MODE_SIGM) { v[n][0] = sigmoidf_(v[n][0]); v[n][1] = sigmoidf_(v[n][1]); v[n][2] = sigmoidf_(v[n][2]); v[n][3] = sigmoidf_(v[n][3]); }
                }
                store16(jb.out + (size_t)(row0 + m * 16) * jb.ldo + col, v);
            }
        }
    } else if (jb.mode == MODE_ML1) {
        if (nt < 24) {
            bf16_t* ob = (bf16_t*)(p.ws + OFF_SLOT + (size_t)(1 + (nt >> 3)) * SLOT);
            const bool sg = (nt >= 16);
            const int col = (nt & 7) * 128 + wc * 64 + fq * 16;
#pragma unroll
            for (int m = 0; m < 4; ++m) {
                f32x4 v[4];
#pragma unroll
                for (int n = 0; n < 4; ++n) {
                    v[n] = acc[m][n];
                    if (sg) { v[n][0] = sigmoidf_(v[n][0]); v[n][1] = sigmoidf_(v[n][1]); v[n][2] = sigmoidf_(v[n][2]); v[n][3] = sigmoidf_(v[n][3]); }
                }
                store16(ob + (size_t)(row0 + m * 16) * 1024 + col, v);
            }
        } else if (wc == 0) {
            float* gates = (float*)(p.ws + OFF_GATES);
            const float* bg = p.in[26];
            const int c0 = fq * 4;
#pragma unroll
            for (int m = 0; m < 4; ++m) {
                f32x4 v = acc[m][0], o;
#pragma unroll
                for (int j = 0; j < 4; ++j) { const float g = v[j] + bg[c0 + j]; o[j] = (c0 + j < 8) ? g : -softplusf_(-g); }
                gst_f4(gates + (size_t)(row0 + m * 16) * 16 + c0, o[0], o[1], o[2], o[3]);
            }
        }
    } else {
        if (nt < 16) {
            const float* rot = (const float*)(p.ws + OFF_ROT);
            bf16_t* ob = (bf16_t*)(p.ws + OFF_SLOT + (size_t)(1 + (nt >> 3)) * SLOT);
            const float scl = (nt >= 8) ? 0.0625f : 1.0f;
#pragma unroll
            for (int pp = 0; pp < 2; ++pp) {
                const int blk32 = (nt & 7) * 4 + wc * 2 + pp, head = blk32 >> 3, i0 = (blk32 & 7) * 16 + fq * 4;
                float4 rc0[4], rc1[4];
#pragma unroll
                for (int m = 0; m < 4; ++m) { const int tt = (row0 + m * 16) & 2047; rc0[m] = gld_f4(rot + ((size_t)tt * 128 + i0) * 2); rc1[m] = gld_f4(rot + ((size_t)tt * 128 + i0) * 2 + 4); }
#pragma unroll
                for (int m = 0; m < 4; ++m) {
                    const int row = row0 + m * 16;
                    const float4 c0 = rc0[m], c1 = rc1[m];
                    const float cs[4] = {c0.x, c0.z, c1.x, c1.z}, sn[4] = {c0.y, c0.w, c1.y, c1.w};
                    const f32x4 x1 = acc[m][2 * pp], x2 = acc[m][2 * pp + 1];
                    float o1[4], o2[4];
#pragma unroll
                    for (int j = 0; j < 4; ++j) { o1[j] = (x1[j] * cs[j] - x2[j] * sn[j]) * scl; o2[j] = (x1[j] * sn[j] + x2[j] * cs[j]) * scl; }
                    gst_u2(ob + (size_t)row * 1024 + head * 256 + i0, cvt_pk(o1[0], o1[1]), cvt_pk(o1[2], o1[3]));
                    gst_u2(ob + (size_t)row * 1024 + head * 256 + 128 + i0, cvt_pk(o2[0], o2[1]), cvt_pk(o2[2], o2[3]));
                }
            }
        } else {
            const bool isg = (nt >= 32);
            bf16_t* ob = (bf16_t*)(p.ws + OFF_SLOT + (size_t)(isg ? 5 : 3) * SLOT);
            const int col = (nt & 15) * 128 + wc * 64 + fq * 16;
#pragma unroll
            for (int m = 0; m < 4; ++m) {
                f32x4 v[4];
#pragma unroll
                for (int n = 0; n < 4; ++n) {
                    v[n] = acc[m][n];
                    if (isg) { v[n][0] = siluf_(v[n][0]); v[n][1] = siluf_(v[n][1]); v[n][2] = siluf_(v[n][2]); v[n][3] = siluf_(v[n][3]); }
                }
                store16(ob + (size_t)(row0 + m * 16) * 2048 + col, v);
            }
        }
    }
}
__device__ __forceinline__ void phase_gemm_jobs(PRef p, char* lds, int jlo, int jhi) {
    const int total = p.gj[jhi - 1].tile0 + 128 * p.gj[jhi - 1].ntn - p.gj[jlo].tile0;
    for (int id = blockIdx.x; id < total; id += gridDim.x) {
        int j = jlo; const int gid = id + p.gj[jlo].tile0;
        while (j + 1 < jhi && gid >= p.gj[j + 1].tile0) ++j;
        GJob jb; jb.A = p.gj[j].A; jb.Bt = p.gj[j].Bt; jb.out = p.gj[j].out; jb.K = p.gj[j].K; jb.N = p.gj[j].N; jb.ldo = p.gj[j].ldo; jb.mode = p.gj[j].mode; jb.ntn = p.gj[j].ntn; jb.tile0 = p.gj[j].tile0;
        int mt, nt; tile_map(gid - jb.tile0, jb.ntn, mt, nt);
        int nv = jb.N - nt * 128; nv = nv > 128 ? 128 : nv;
        const bf16_t* ar[4]; const bf16_t* br[4];
        {
            const int t_ = tidx(), r0_ = t_ >> 3, co_ = glds_chunk(t_) * 8;
            const bool pm_ = tile_permuted(jb.mode, nt);
#pragma unroll
            for (int i = 0; i < 4; ++i) {
                ar[i] = jb.A + (size_t)(mt * 128 + r0_ + 32 * i) * jb.K + co_;
                int rb_ = r0_ + 32 * i; rb_ = pm_ ? perm64(rb_) : rb_; rb_ = rb_ < nv ? rb_ : nv - 1;
                br[i] = jb.Bt + (size_t)(nt * 128 + rb_) * jb.K + co_;
            }
        }
        f32x4 acc[4][4];
        gemm_gg(lds, jb.K / 64, ar, br, acc);
        gemm_epilogue(p, jb, mt, nt, acc);
    }
}

template <int KL>
__device__ __forceinline__ void minigemm(const bf16_t* A, const bf16_t* Bt, int fr, int fq, f32x4 (&acc)[2][4]) {
#pragma unroll
    for (int m = 0; m < 2; ++m)
#pragma unroll
        for (int n = 0; n < 4; ++n) acc[m][n] = (f32x4){0.f, 0.f, 0.f, 0.f};
#pragma unroll
    for (int ks = 0; ks < KL / 32; ++ks) {
        uint4 af[2], bfm[4];
#pragma unroll
        for (int m = 0; m < 2; ++m) af[m] = gld_u4(A + (size_t)(m * 16 + fr) * KL + ks * 32 + fq * 8);
#pragma unroll
        for (int n = 0; n < 4; ++n) bfm[n] = gld_u4(Bt + (size_t)((fr >> 2) * 16 + n * 4 + (fr & 3)) * KL + ks * 32 + fq * 8);
#pragma unroll
        for (int m = 0; m < 2; ++m)
#pragma unroll
            for (int n = 0; n < 4; ++n) acc[m][n] = mfma16(bfm[n], af[m], acc[m][n]);
    }
}
__device__ __forceinline__ void phase_rw2(PRef p, int jr) {
    const int t_ = tidx(); const int lane = t_ & 63, wid = t_ >> 6, wr = wid >> 1, wc = wid & 1, fr = lane & 15, fq = lane >> 4;
    char* S = p.ws + OFF_SLOT;
    float* decay = (float*)S; bf16_t* nkk = (bf16_t*)(S + 2 * SLOT); bf16_t* bb = (bf16_t*)(S + 3 * SLOT); bf16_t* gb = (bf16_t*)(S + 4 * SLOT);
    const bf16_t* rb = (const bf16_t*)(S + 6 * SLOT); const bf16_t* kb = (const bf16_t*)(S + 7 * SLOT); bf16_t* kpb = (bf16_t*)(S + 10 * SLOT);
    const bf16_t* vb = (const bf16_t*)(S + 8 * SLOT); bf16_t* vpb = (bf16_t*)(S + 9 * SLOT); const bf16_t* vf = (const bf16_t*)(S + 11 * SLOT);
    float* bonus = (float*)(p.ws + OFF_BONUS);
    const bf16_t* Lw = (const bf16_t*)(p.ws + OFF_LW); const bf16_t* La = (const bf16_t*)(p.ws + OFF_LA);
    const bf16_t* Lg = (const bf16_t*)(p.ws + OFF_LG); const bf16_t* Lv = (const bf16_t*)(p.ws + OFF_LV);
    const bf16_t* w2t = (const bf16_t*)(p.ws + W_W2T) + (size_t)jr * 1024 * 64; const bf16_t* a2t = (const bf16_t*)(p.ws + W_A2T) + (size_t)jr * 1024 * 64;
    const bf16_t* g2t = (const bf16_t*)(p.ws + W_G2T) + (size_t)jr * 1024 * 128; const bf16_t* v2t = (const bf16_t*)(p.ws + W_V2T);
    const float* w0 = p.in[8] + jr * 1024; const float* a0 = p.in[11] + jr * 1024; const float* v0 = p.in[14];
    const float* kkw = p.in[19] + jr * 1024; const float* kaw = p.in[20] + jr * 1024; const float* rk = p.in[21] + jr * 1024;
    for (int id2 = blockIdx.x * 2; id2 < 128 * 8 * 2; id2 += ((id2 & 1) ? (int)gridDim.x * 2 - 1 : 1)) {
        int mt, nt; tile_map(id2 >> 1, 8, mt, nt);
        const int row0 = mt * 128 + wr * 64 + (id2 & 1) * 32, col0 = nt * 128 + wc * 64, head = nt * 2 + wc;
        f32x4 acc[2][4];
        const int c0 = col0 + fq * 16;
        minigemm<64>(La + (size_t)row0 * 64, a2t + (size_t)col0 * 64, fr, fq, acc);
        float ss[2] = {0.f, 0.f}, bs[2] = {0.f, 0.f};
#pragma unroll
        for (int m = 0; m < 2; ++m) {
            const size_t off = (size_t)(row0 + m * 16 + fr) * 1024 + c0;
            const uint4 kq0 = *(const uint4*)(kb + off), kq1 = *(const uint4*)(kb + off + 8);
            const unsigned kw[8] = {kq0.x, kq0.y, kq0.z, kq0.w, kq1.x, kq1.y, kq1.z, kq1.w};
#pragma unroll
            for (int n = 0; n < 4; ++n) {
                const float4 a0v = *(const float4*)(a0 + c0 + n * 4), kkv = *(const float4*)(kkw + c0 + n * 4);
                const float a0a[4] = {a0v.x, a0v.y, a0v.z, a0v.w}, kka[4] = {kkv.x, kkv.y, kkv.z, kkv.w};
                const float kf4[4] = {bflo(kw[n * 2]), bfhi(kw[n * 2]), bflo(kw[n * 2 + 1]), bfhi(kw[n * 2 + 1])};
#pragma unroll
                for (int j = 0; j < 4; ++j) { acc[m][n][j] = sigmoidf_(a0a[j] + acc[m][n][j]); const float q = kf4[j] * kka[j]; ss[m] += q * q; }
            }
            asm volatile("" ::: "memory");
        }
#pragma unroll
        for (int m = 0; m < 2; ++m) { ss[m] += __shfl_xor(ss[m], 16); ss[m] += __shfl_xor(ss[m], 32); ss[m] = fminf(__builtin_amdgcn_rsqf(ss[m]), 1e12f); }
        float4 kkq[4], kaq[4], rkq[4];
#pragma unroll
        for (int n = 0; n < 4; ++n) { kkq[n] = gld_f4(kkw + c0 + n * 4); kaq[n] = gld_f4(kaw + c0 + n * 4); rkq[n] = gld_f4(rk + c0 + n * 4); }
#pragma unroll
        for (int m = 0; m < 2; ++m) {
            const size_t off = (size_t)(row0 + m * 16 + fr) * 1024 + c0;
            const uint4 rq0 = *(const uint4*)(rb + off), rq1 = *(const uint4*)(rb + off + 8), kq0 = *(const uint4*)(kb + off), kq1 = *(const uint4*)(kb + off + 8);
            const unsigned kw[8] = {kq0.x, kq0.y, kq0.z, kq0.w, kq1.x, kq1.y, kq1.z, kq1.w};
            const unsigned rw[8] = {rq0.x, rq0.y, rq0.z, rq0.w, rq1.x, rq1.y, rq1.z, rq1.w};
            unsigned okp[8], onk[8], obb[8];
#pragma unroll
            for (int n = 0; n < 4; ++n) {
                const float kka[4] = {kkq[n].x, kkq[n].y, kkq[n].z, kkq[n].w}, kaa[4] = {kaq[n].x, kaq[n].y, kaq[n].z, kaq[n].w}, rka[4] = {rkq[n].x, rkq[n].y, rkq[n].z, rkq[n].w};
                const float rf[4] = {bflo(rw[n * 2]), bfhi(rw[n * 2]), bflo(rw[n * 2 + 1]), bfhi(rw[n * 2 + 1])}, kf4[4] = {bflo(kw[n * 2]), bfhi(kw[n * 2]), bflo(kw[n * 2 + 1]), bfhi(kw[n * 2 + 1])};
                float kp[4], nk[4], b4[4];
#pragma unroll
                for (int j = 0; j < 4; ++j) {
                    const float a = acc[m][n][j], k = kf4[j], kn = k * kka[j] * ss[m];
                    kp[j] = k * (1.0f + (a - 1.0f) * kaa[j]); nk[j] = -kn; b4[j] = kn * a; bs[m] += rf[j] * kp[j] * rka[j];
                }
                okp[n * 2] = cvt_pk(kp[0], kp[1]); okp[n * 2 + 1] = cvt_pk(kp[2], kp[3]);
                onk[n * 2] = cvt_pk(nk[0], nk[1]); onk[n * 2 + 1] = cvt_pk(nk[2], nk[3]);
                obb[n * 2] = cvt_pk(b4[0], b4[1]); obb[n * 2 + 1] = cvt_pk(b4[2], b4[3]);
            }
            *(uint4*)(kpb + off) = make_uint4(okp[0], okp[1], okp[2], okp[3]); *(uint4*)(kpb + off + 8) = make_uint4(okp[4], okp[5], okp[6], okp[7]);
            *(uint4*)(nkk + off) = make_uint4(onk[0], onk[1], onk[2], onk[3]); *(uint4*)(nkk + off + 8) = make_uint4(onk[4], onk[5], onk[6], onk[7]);
            *(uint4*)(bb + off) = make_uint4(obb[0], obb[1], obb[2], obb[3]); *(uint4*)(bb + off + 8) = make_uint4(obb[4], obb[5], obb[6], obb[7]);
            asm volatile("" ::: "memory");
        }
#pragma unroll
        for (int m = 0; m < 2; ++m) { bs[m] += __shfl_xor(bs[m], 16); bs[m] += __shfl_xor(bs[m], 32); if (fq == 0) bonus[(size_t)(row0 + m * 16 + fr) * 16 + head] = bs[m]; }
        minigemm<64>(Lw + (size_t)row0 * 64, w2t + (size_t)col0 * 64, fr, fq, acc);
        float4 w0q[4];
#pragma unroll
        for (int n = 0; n < 4; ++n) w0q[n] = gld_f4(w0 + c0 + n * 4);
#pragma unroll
        for (int n = 0; n < 4; ++n) {
            const float w0a[4] = {w0q[n].x, w0q[n].y, w0q[n].z, w0q[n].w};
#pragma unroll
            for (int m = 0; m < 2; ++m) {
                f32x4 o;
#pragma unroll
                for (int j = 0; j < 4; ++j) { const float wl = -softplusf_(-(w0a[j] + acc[m][n][j])) - 0.5f; o[j] = __expf(-__expf(wl)); }
                *(f32x4*)(decay + (size_t)(row0 + m * 16 + fr) * 1024 + c0 + n * 4) = o;
            }
        }
        minigemm<128>(Lg + (size_t)row0 * 128, g2t + (size_t)col0 * 128, fr, fq, acc);
#pragma unroll
        for (int m = 0; m < 2; ++m) {
            unsigned o[8];
#pragma unroll
            for (int n = 0; n < 4; ++n) { o[n * 2] = cvt_pk(acc[m][n][0], acc[m][n][1]); o[n * 2 + 1] = cvt_pk(acc[m][n][2], acc[m][n][3]); }
            bf16_t* d = gb + (size_t)(row0 + m * 16 + fr) * 1024 + c0;
            *(uint4*)d = make_uint4(o[0], o[1], o[2], o[3]); *(uint4*)(d + 8) = make_uint4(o[4], o[5], o[6], o[7]);
        }
        if (jr > 0) {
            minigemm<32>(Lv + (size_t)row0 * 32, v2t + (size_t)col0 * 32, fr, fq, acc);
#pragma unroll
            for (int m = 0; m < 2; ++m) {
                const size_t off = (size_t)(row0 + m * 16 + fr) * 1024 + c0;
                const uint4 vq0 = *(const uint4*)(vb + off), vq1 = *(const uint4*)(vb + off + 8), fq0 = *(const uint4*)(vf + off), fq1 = *(const uint4*)(vf + off + 8);
                const unsigned vw[8] = {vq0.x, vq0.y, vq0.z, vq0.w, vq1.x, vq1.y, vq1.z, vq1.w}, fw[8] = {fq0.x, fq0.y, fq0.z, fq0.w, fq1.x, fq1.y, fq1.z, fq1.w};
                unsigned o[8];
#pragma unroll
                for (int n = 0; n < 4; ++n) {
                    const float4 v0v = *(const float4*)(v0 + c0 + n * 4); const float v0a[4] = {v0v.x, v0v.y, v0v.z, v0v.w};
                    const float v4[4] = {bflo(vw[n * 2]), bfhi(vw[n * 2]), bflo(vw[n * 2 + 1]), bfhi(vw[n * 2 + 1])}, f4[4] = {bflo(fw[n * 2]), bfhi(fw[n * 2]), bflo(fw[n * 2 + 1]), bfhi(fw[n * 2 + 1])};
                    float o4[4];
#pragma unroll
                    for (int j = 0; j < 4; ++j) o4[j] = v4[j] + (f4[j] - v4[j]) * sigmoidf_(v0a[j] + acc[m][n][j]);
                    o[n * 2] = cvt_pk(o4[0], o4[1]); o[n * 2 + 1] = cvt_pk(o4[2], o4[3]);
                }
                *(uint4*)(vpb + off) = make_uint4(o[0], o[1], o[2], o[3]); *(uint4*)(vpb + off + 8) = make_uint4(o[4], o[5], o[6], o[7]);
            }
        }
    }
}
__device__ __forceinline__ void phase_rw3(PRef p, int jr, char* lds) {
    const int t = tidx(), lane = t & 63, wid = t >> 6, rowq = lane >> 4, jq = lane & 15;
    char* S = p.ws + OFF_SLOT;
    const float* decay = (const float*)S; const bf16_t* nkk = (const bf16_t*)(S + 2 * SLOT); const bf16_t* bb = (const bf16_t*)(S + 3 * SLOT);
    const bf16_t* rb = (const bf16_t*)(S + 6 * SLOT); const bf16_t* kb = (const bf16_t*)(S + 10 * SLOT);
    const bf16_t* vb = (const bf16_t*)(S + (jr == 0 ? 11 : 9) * SLOT); bf16_t* yb = (bf16_t*)(S + 5 * SLOT);
    float* buf = (float*)lds;
    float* ybuf = (float*)(lds + 2 * 16 * 336 * 4);
    for (int item = blockIdx.x; item < 512; item += gridDim.x) {
        const int bh = item >> 2, rg = item & 3, b = bh >> 4, h = bh & 15;
        const size_t base = (size_t)b * 2048 * 1024 + h * 64;
        const bf16_t* vecp[2]; int vdst[2];
#pragma unroll
        for (int u = 0; u < 2; ++u) {
            const int id = t + 256 * u, vec = id >> 7, rem = id & 127, step = rem >> 3, c8 = rem & 7;
            const bf16_t* bp = (vec == 0) ? nkk : (vec == 1) ? bb : (vec == 2) ? kb : rb;
            vecp[u] = bp + base + (size_t)step * 1024 + c8 * 8; vdst[u] = step * 336 + 64 + vec * 64 + c8 * 8;
        }
        const float* dp = decay + base + (size_t)(t >> 4) * 1024 + (t & 15) * 4; const int ddst = (t >> 4) * 336 + (t & 15) * 4;
        const bf16_t* vp = vb + base + (size_t)(t >> 1) * 1024 + rg * 16 + (t & 1) * 8; const int vvdst = (t >> 1) * 336 + 320 + (t & 1) * 8;
        uint4 g0, g1, gv; float4 gd;
        auto fetch = [&](int ch) {
            const size_t o = (size_t)ch * 16 * 1024;
            g0 = gload16(vecp[0] + o); g1 = gload16(vecp[1] + o);
            { const uint4 d_ = gload16(dp + o); gd = make_float4(__uint_as_float(d_.x), __uint_as_float(d_.y), __uint_as_float(d_.z), __uint_as_float(d_.w)); }
            if (t < 32) gv = gload16(vp + o);
        };
        auto stash = [&](float* bf) {
            float f[8];
            unpack8(g0, f); *(float4*)(bf + vdst[0]) = make_float4(f[0], f[1], f[2], f[3]); *(float4*)(bf + vdst[0] + 4) = make_float4(f[4], f[5], f[6], f[7]);
            unpack8(g1, f); *(float4*)(bf + vdst[1]) = make_float4(f[0], f[1], f[2], f[3]); *(float4*)(bf + vdst[1] + 4) = make_float4(f[4], f[5], f[6], f[7]);
            *(float4*)(bf + ddst) = gd;
            if (t < 32) { unpack8(gv, f); *(float4*)(bf + vvdst) = make_float4(f[0], f[1], f[2], f[3]); *(float4*)(bf + vvdst + 4) = make_float4(f[4], f[5], f[6], f[7]); }
        };
        float s0 = 0.f, s1 = 0.f, s2 = 0.f, s3 = 0.f;
        __syncthreads();
        fetch(0); stash(buf); __syncthreads();
        for (int ch = 0; ch < 128; ++ch) {
            if (ch + 1 < 128) fetch(ch + 1);
            const float* bf = buf + (ch & 1) * (16 * 336); float* yb_ = ybuf + (ch & 1) * 256;
            float ykeep = 0.f;
            const float* q0 = bf + jq * 4; const float* v0p = bf + 320 + wid * 4 + rowq;
            float4 nw = *(const float4*)q0, na = *(const float4*)(q0 + 64), nb2 = *(const float4*)(q0 + 128), nk = *(const float4*)(q0 + 192), nr = *(const float4*)(q0 + 256);
            float nv = v0p[0];
#pragma unroll 4
            for (int s = 0; s < 16; ++s) {
                const float4 w = nw, a = na, bq = nb2, k = nk, r = nr; const float vv = nv;
                const float* q = q0 + (s + 1) * 336;
                nw = *(const float4*)q; na = *(const float4*)(q + 64); nb2 = *(const float4*)(q + 128); nk = *(const float4*)(q + 192); nr = *(const float4*)(q + 256);
                nv = v0p[(s + 1) * 336];
                __builtin_amdgcn_sched_barrier(0);
                float sa = s0 * a.x; sa = fmaf(s1, a.y, sa); sa = fmaf(s2, a.z, sa); sa = fmaf(s3, a.w, sa);
                sa = row16_sum(sa);
                s0 = fmaf(s0, w.x, fmaf(sa, bq.x, vv * k.x)); s1 = fmaf(s1, w.y, fmaf(sa, bq.y, vv * k.y));
                s2 = fmaf(s2, w.z, fmaf(sa, bq.z, vv * k.z)); s3 = fmaf(s3, w.w, fmaf(sa, bq.w, vv * k.w));
                float y = s0 * r.x; y = fmaf(s1, r.y, y); y = fmaf(s2, r.z, y); y = fmaf(s3, r.w, y);
                y = row16_sum(y);
                ykeep = (jq == s) ? y : ykeep;
            }
            yb_[jq * 16 + wid * 4 + rowq] = ykeep;
            if (ch + 1 < 128) stash(buf + ((ch + 1) & 1) * (16 * 336));
            __syncthreads();
            if (t < 32) { const int step = t >> 1, hf = t & 1; float f[8];
#pragma unroll
                for (int i = 0; i < 8; ++i) f[i] = yb_[step * 16 + hf * 8 + i];
                *(uint4*)(yb + base + (size_t)(ch * 16 + step) * 1024 + rg * 16 + hf * 8) = pack8(f); }
        }
    }
}
__device__ __forceinline__ uint2 lds_tr16(const char* p) {
    typedef short v4s_t __attribute__((ext_vector_type(4)));
    const v4s_t r = __builtin_amdgcn_ds_read_tr16_b64_v4i16((LAS v4s_t*)p);
    uint2 u; __builtin_memcpy(&u, &r, 8); return u;
}
__device__ __forceinline__ int sw64(int row, int col) { return row * 128 + ((((col >> 3) ^ (row & 7))) << 4) + (col & 7) * 2; }
__device__ __forceinline__ void phase_rw3c(PRef p, int jr, char* lds) {
    const int t = tidx(), lane = t & 63, w = t >> 6, fr = lane & 15, fq = lane >> 4;
    char* S = p.ws + OFF_SLOT;
    const float* decay = (const float*)S; const bf16_t* nkk = (const bf16_t*)(S + 2 * SLOT); const bf16_t* bb = (const bf16_t*)(S + 3 * SLOT);
    const bf16_t* rb = (const bf16_t*)(S + 6 * SLOT); const bf16_t* kb = (const bf16_t*)(S + 10 * SLOT);
    const bf16_t* vb = (const bf16_t*)(S + (jr == 0 ? 11 : 9) * SLOT); bf16_t* yb = (bf16_t*)(S + 5 * SLOT);
    char* const AT = lds;              char* const RT = lds + 4096;  char* const BT = lds + 8192;  char* const KT = lds + 12288;
    float* const PL = (float*)(lds + 16384);
    float* const GAB = (float*)(lds + 43264);
    char* const GAK = lds + 28672;     char* const GRB = lds + 30720; char* const GRK = lds + 32768;
    char* const VT = lds + 34816;      char* const UT = lds + 35840;
    char* const SB = lds + 36864;
    float* const XL = (float*)(lds + 38912);
    float* const PC = (float*)(lds + 40960);
    float* const GS = (float*)(lds + 41216);
    bf16_t* const YB = (bf16_t*)(lds + 42240);
    const int pj = t & 63, ptg = t >> 6;
    const int tk = t >> 3, ck = t & 7;
    const int vtau = t >> 3, vi2 = (t & 7) * 2;
    const int qq = fr >> 2, pp = fr & 3;
    for (int item = blockIdx.x; item < 512; item += gridDim.x) {
        const int bh = item >> 2, rg = item & 3, b = bh >> 4, h = bh & 15;
        const size_t base = (size_t)b * 2048 * 1024 + h * 64;
        __syncthreads();
        for (int i = t; i < 128; i += 256) *(uint4*)(SB + i * 16) = make_uint4(0u, 0u, 0u, 0u);
        f32x4 Sacc = (f32x4){0.f, 0.f, 0.f, 0.f};
        float gw[8]; uint4 ra, rb4, rk, rr, rw0, rw1; unsigned gvv = 0;
        auto fetch = [&](int c) {
#pragma unroll
            for (int s2 = 0; s2 < 8; ++s2) gw[s2] = *(const __attribute__((address_space(1))) float*)(decay + base + (size_t)(c * 32 + ptg * 8 + s2) * 1024 + pj);
            const size_t o = base + (size_t)(c * 32 + tk) * 1024 + ck * 8;
            ra = gload16(nkk + o); rb4 = gload16(bb + o); rk = gload16(kb + o); rr = gload16(rb + o); rw0 = gload16(decay + o); rw1 = gload16(decay + o + 4);
            gvv = *(const __attribute__((address_space(1))) unsigned*)(vb + base + (size_t)(c * 32 + vtau) * 1024 + rg * 16 + vi2);
        };
        fetch(0);
        for (int c = 0; c < 64; ++c) {
            {
                float cum[8]; float run = 0.f;
#pragma unroll
                for (int s2 = 0; s2 < 8; ++s2) { run += __builtin_amdgcn_logf(gw[s2]); cum[s2] = run; }
                GS[ptg * 64 + pj] = run;
                __syncthreads();
                const float g0 = GS[pj], g1 = GS[64 + pj], g2 = GS[128 + pj], g3 = GS[192 + pj];
                const float off = (ptg > 0 ? g0 : 0.f) + (ptg > 1 ? g1 : 0.f) + (ptg > 2 ? g2 : 0.f);
                if (ptg == 0) PC[pj] = __builtin_amdgcn_exp2f((g0 + g1) + (g2 + g3));
#pragma unroll
                for (int s2 = 0; s2 < 8; ++s2) PL[(ptg * 8 + s2) * 64 + pj] = __builtin_amdgcn_exp2f(off + cum[s2]);
            }
            __syncthreads();
            {
                const float4 p0 = *(const float4*)(PL + tk * 64 + ck * 8), p1 = *(const float4*)(PL + tk * 64 + ck * 8 + 4);
                const unsigned ua[4] = {ra.x, ra.y, ra.z, ra.w}, ub[4] = {rb4.x, rb4.y, rb4.z, rb4.w}, uk[4] = {rk.x, rk.y, rk.z, rk.w}, ur[4] = {rr.x, rr.y, rr.z, rr.w};
                const f32x2_t Pp[4] = {{p0.x, p0.y}, {p0.z, p0.w}, {p1.x, p1.y}, {p1.z, p1.w}};
                const f32x2_t Wp[4] = {{__uint_as_float(rw0.x), __uint_as_float(rw0.y)}, {__uint_as_float(rw0.z), __uint_as_float(rw0.w)}, {__uint_as_float(rw1.x), __uint_as_float(rw1.y)}, {__uint_as_float(rw1.z), __uint_as_float(rw1.w)}};
                unsigned oa[4], orr[4], ob[4], ok[4];
#pragma unroll
                for (int i = 0; i < 4; ++i) {
                    const f32x2_t ei = {__builtin_amdgcn_rcpf(Pp[i].x), __builtin_amdgcn_rcpf(Pp[i].y)};
                    const f32x2_t rw = {__builtin_amdgcn_rcpf(Wp[i].x), __builtin_amdgcn_rcpf(Wp[i].y)};
                    const f32x2_t ex = Pp[i] * rw;
                    const f32x2_t va = {__uint_as_float(ua[i] << 16), __uint_as_float(ua[i] & 0xffff0000u)}, vr = {__uint_as_float(ur[i] << 16), __uint_as_float(ur[i] & 0xffff0000u)};
                    const f32x2_t vb2 = {__uint_as_float(ub[i] << 16), __uint_as_float(ub[i] & 0xffff0000u)}, vk = {__uint_as_float(uk[i] << 16), __uint_as_float(uk[i] & 0xffff0000u)};
                    const f32x2_t xa = va * ex, xr = vr * Pp[i], xb = vb2 * ei, xk = vk * ei;
                    oa[i] = cvt_pk(xa.x, xa.y); orr[i] = cvt_pk(xr.x, xr.y); ob[i] = cvt_pk(xb.x, xb.y); ok[i] = cvt_pk(xk.x, xk.y);
                }
                const int o = tk * 128 + ((ck ^ (tk & 7)) << 4);
                *(uint4*)(AT + o) = make_uint4(oa[0], oa[1], oa[2], oa[3]); *(uint4*)(RT + o) = make_uint4(orr[0], orr[1], orr[2], orr[3]);
                *(uint4*)(BT + o) = make_uint4(ob[0], ob[1], ob[2], ob[3]); *(uint4*)(KT + o) = make_uint4(ok[0], ok[1], ok[2], ok[3]);
                *(bf16_t*)(VT + vi2 * 64 + vtau * 2) = (bf16_t)(gvv & 0xffffu);
                *(bf16_t*)(VT + (vi2 + 1) * 64 + vtau * 2) = (bf16_t)(gvv >> 16);
            }
            if (c + 1 < 64) fetch(c + 1);
            __syncthreads();
            {
                const char* Mt = (w < 2) ? AT : RT; const char* Nt = (w & 1) ? BT : KT;
                f32x4 g[2][2];
#pragma unroll
                for (int m = 0; m < 2; ++m) { g[m][0] = (f32x4){0.f, 0.f, 0.f, 0.f}; g[m][1] = (f32x4){0.f, 0.f, 0.f, 0.f}; }
#pragma unroll
                for (int ks = 0; ks < 2; ++ks) {
                    const int chs = ((ks * 4 + fq) ^ (fr & 7)) << 4;
                    uint4 mf[2], nf[2];
#pragma unroll
                    for (int m = 0; m < 2; ++m) { mf[m] = *(const uint4*)(Mt + (m * 16 + fr) * 128 + chs); nf[m] = *(const uint4*)(Nt + (m * 16 + fr) * 128 + chs); }
#pragma unroll
                    for (int m = 0; m < 2; ++m)
#pragma unroll
                        for (int n = 0; n < 2; ++n) g[m][n] = mfma16(nf[n], mf[m], g[m][n]);
                }
#pragma unroll
                for (int m = 0; m < 2; ++m)
#pragma unroll
                    for (int n = 0; n < 2; ++n) {
                        const int tt = m * 16 + fr, tau0 = n * 16 + fq * 4;
                        f32x4 v4;
#pragma unroll
                        for (int j = 0; j < 4; ++j) { const int tau = tau0 + j; const bool keep = (w < 2) ? (tau < tt) : (tau <= tt); v4[j] = keep ? g[m][n][j] : 0.f; }
                        if (w == 1) *(f32x4*)(GAB + tt * 36 + tau0) = v4;
                        else {
                            char* G = (w == 0) ? GAK : (w == 2) ? GRK : GRB;
                            uint2 o; o.x = cvt_pk(v4[0], v4[1]); o.y = cvt_pk(v4[2], v4[3]);
                            *(uint2*)(G + tt * 64 + tau0 * 2) = o;
                        }
                    }
            }
            __syncthreads();
            if (w < 2) {
                f32x4 x = (f32x4){0.f, 0.f, 0.f, 0.f};
#pragma unroll
                for (int ks = 0; ks < 2; ++ks) {
                    const int chs = ((ks * 4 + fq) ^ (fr & 7)) << 4;
                    x = mfma16(*(const uint4*)(AT + (w * 16 + fr) * 128 + chs), *(const uint4*)(SB + fr * 128 + chs), x);
                }
                x = mfma16(*(const uint4*)(GAK + (w * 16 + fr) * 64 + fq * 16), *(const uint4*)(VT + fr * 64 + fq * 16), x);
                *(f32x4*)(XL + fr * 32 + w * 16 + fq * 4) = x;
            }
            __syncthreads();
            {
                const int tl = lane & 31;
                float Gr[32];
#pragma unroll
                for (int q4 = 0; q4 < 8; ++q4) { const float4 g4 = *(const float4*)(GAB + tl * 36 + q4 * 4); Gr[q4 * 4] = g4.x; Gr[q4 * 4 + 1] = g4.y; Gr[q4 * 4 + 2] = g4.z; Gr[q4 * 4 + 3] = g4.w; }
                float acc[4];
#pragma unroll
                for (int r = 0; r < 4; ++r) acc[r] = XL[(4 * w + r) * 32 + tl];
#pragma unroll
                for (int tau = 0; tau < 31; ++tau)
#pragma unroll
                    for (int r = 0; r < 4; ++r) acc[r] = fmaf(__int_as_float(__builtin_amdgcn_readlane(__float_as_int(acc[r]), tau)), Gr[tau], acc[r]);
                if (lane < 32) {
#pragma unroll
                    for (int r = 0; r < 4; ++r) *(bf16_t*)(UT + (4 * w + r) * 64 + tl * 2) = f2bf(acc[r]);
                }
            }
            __syncthreads();
            if (w < 2) {
                f32x4 y = (f32x4){0.f, 0.f, 0.f, 0.f};
#pragma unroll
                for (int ks = 0; ks < 2; ++ks) {
                    const int chs = ((ks * 4 + fq) ^ (fr & 7)) << 4;
                    y = mfma16(*(const uint4*)(RT + (w * 16 + fr) * 128 + chs), *(const uint4*)(SB + fr * 128 + chs), y);
                }
                y = mfma16(*(const uint4*)(GRB + (w * 16 + fr) * 64 + fq * 16), *(const uint4*)(UT + fr * 64 + fq * 16), y);
                y = mfma16(*(const uint4*)(GRK + (w * 16 + fr) * 64 + fq * 16), *(const uint4*)(VT + fr * 64 + fq * 16), y);
#pragma unroll
                for (int j = 0; j < 4; ++j) YB[(w * 16 + fq * 4 + j) * 16 + fr] = f2bf(y[j]);
            }
            {
                const int r0 = fq * 8 + qq, kc = 2 * w + (pp >> 1);
                const int o0 = r0 * 128 + ((kc ^ (r0 & 7)) << 4) + (pp & 1) * 8, o1 = (r0 + 4) * 128 + ((kc ^ ((r0 + 4) & 7)) << 4) + (pp & 1) * 8;
                const uint2 blo = lds_tr16(BT + o0), bhi = lds_tr16(BT + o1), klo = lds_tr16(KT + o0), khi = lds_tr16(KT + o1);
                Sacc = mfma16(make_uint4(blo.x, blo.y, bhi.x, bhi.y), *(const uint4*)(UT + fr * 64 + fq * 16), Sacc);
                Sacc = mfma16(make_uint4(klo.x, klo.y, khi.x, khi.y), *(const uint4*)(VT + fr * 64 + fq * 16), Sacc);
                const float4 pc = *(const float4*)(PC + 16 * w + fq * 4);
                Sacc[0] *= pc.x; Sacc[1] *= pc.y; Sacc[2] *= pc.z; Sacc[3] *= pc.w;
            }
            __syncthreads();
            {
                uint2 o; o.x = cvt_pk(Sacc[0], Sacc[1]); o.y = cvt_pk(Sacc[2], Sacc[3]);
                *(uint2*)(SB + fr * 128 + ((((2 * w + (fq >> 1))) ^ (fr & 7)) << 4) + (fq & 1) * 8) = o;
                if (t < 64) {
                    const int tt = t >> 1, hf = t & 1;
                    const uint4 yv_ = *(const uint4*)((const char*)YB + tt * 32 + hf * 16); const u32x4_t yx_ = {yv_.x, yv_.y, yv_.z, yv_.w};
                    *(__attribute__((address_space(1))) u32x4_t*)(yb + base + (size_t)(c * 32 + tt) * 1024 + rg * 16 + hf * 8) = yx_;
                }
            }
        }
    }
}
struct LdRw4 {
    struct Raw { uint4 y, v, g; float bn; };
    const bf16_t *y, *v, *g; const float *bonus, *gng, *gnb;
    __device__ __forceinline__ Raw fetch(int, int r, int kc) const {
        Raw q; const size_t o = (size_t)r * 1024 + kc * 8;
        q.y = *(const uint4*)(y + o); q.v = *(const uint4*)(v + o); q.g = *(const uint4*)(g + o); q.bn = bonus[r * 16 + (kc >> 3)]; return q;
    }
    __device__ __forceinline__ uint4 finish(const Raw& q, int, int, int kc) const {
        float yf[8], vf[8], gf[8]; unpack8(q.y, yf); unpack8(q.v, vf); unpack8(q.g, gf);
        float s = 0.f, s2 = 0.f;
#pragma unroll
        for (int i = 0; i < 8; ++i) { s += yf[i]; s2 += yf[i] * yf[i]; }
        s = oct_sum(s); s2 = oct_sum(s2);
        const float mean = s * (1.0f / 64.0f), var = fmaxf(s2 * (1.0f / 64.0f) - mean * mean, 0.f), rstd = rsqrtf(var + 64e-5f);
        const float4 ga = *(const float4*)(gng + kc * 8), gb = *(const float4*)(gng + kc * 8 + 4), ba = *(const float4*)(gnb + kc * 8), bb = *(const float4*)(gnb + kc * 8 + 4);
        const float gg[8] = {ga.x, ga.y, ga.z, ga.w, gb.x, gb.y, gb.z, gb.w}, bq[8] = {ba.x, ba.y, ba.z, ba.w, bb.x, bb.y, bb.z, bb.w};
        float o[8];
#pragma unroll
        for (int i = 0; i < 8; ++i) o[i] = ((yf[i] - mean) * rstd * gg[i] + bq[i] + q.bn * vf[i]) * gf[i];
        return pack8(o);
    }
};
__device__ __forceinline__ void phase_rw4(PRef p, int jr, char* lds) {
    char* S = p.ws + OFF_SLOT;
    const bf16_t* yb = (const bf16_t*)(S + 5 * SLOT); const bf16_t* gb = (const bf16_t*)(S + 4 * SLOT);
    const bf16_t* vb = (const bf16_t*)(S + (jr == 0 ? 11 : 9) * SLOT); bf16_t* ymix = (bf16_t*)(S + 6 * SLOT);
    const bf16_t* wt = (const bf16_t*)(p.ws + W_OUT) + (size_t)jr * 1024 * 1024;
    const float* bonus = (const float*)(p.ws + OFF_BONUS);
    const int t_ = tidx(); const int lane = t_ & 63, wid = t_ >> 6, wr = wid >> 1, wc = wid & 1, fr = lane & 15, fq = lane >> 4;
    for (int id = blockIdx.x; id < 128 * 8; id += gridDim.x) {
        int mt, nt; tile_map(id, 8, mt, nt);
        const size_t ro = (size_t)mt * 128 * 1024;
        LdRw4 al{yb + ro, vb + ro, gb + ro, bonus + (size_t)mt * 128 * 16, p.in[22] + jr * 1024, p.in[23] + jr * 1024};
        const bf16_t* br[4];
        { const int t2_ = tidx(), r0_ = t2_ >> 3, co_ = glds_chunk(t2_) * 8;
#pragma unroll
          for (int i = 0; i < 4; ++i) br[i] = wt + (size_t)(nt * 128 + r0_ + 32 * i) * 1024 + co_; }
        f32x4 acc[4][4];
        gemm_rg(lds, 16, al, br, acc);
#pragma unroll
        for (int n = 0; n < 4; ++n)
#pragma unroll
            for (int m = 0; m < 4; ++m) {
                uint2 o; o.x = cvt_pk(acc[m][n][0], acc[m][n][1]); o.y = cvt_pk(acc[m][n][2], acc[m][n][3]);
                *(uint2*)(ymix + (size_t)(mt * 128 + wr * 64 + m * 16 + fr) * 1024 + nt * 128 + wc * 64 + n * 16 + fq * 4) = o;
            }
    }
}

__device__ __forceinline__ void phase_cml(PRef p) {
    const int t = tidx();
    char* S = p.ws + OFF_SLOT;
    const bf16_t* src = (const bf16_t*)(S + 1 * SLOT); bf16_t* dst = (bf16_t*)(S + 8 * SLOT);
    const int col = (t & 127) * 8, half = t >> 7;
    float cw[4][8], cb[8];
#pragma unroll
    for (int j = 0; j < 4; ++j) {
        const float4 a = *(const float4*)(p.in[27] + j * 1024 + col), b = *(const float4*)(p.in[27] + j * 1024 + col + 4);
        cw[j][0] = a.x; cw[j][1] = a.y; cw[j][2] = a.z; cw[j][3] = a.w; cw[j][4] = b.x; cw[j][5] = b.y; cw[j][6] = b.z; cw[j][7] = b.w;
    }
    { const float4 a = *(const float4*)(p.in[28] + col), b = *(const float4*)(p.in[28] + col + 4);
      cb[0] = a.x; cb[1] = a.y; cb[2] = a.z; cb[3] = a.w; cb[4] = b.x; cb[5] = b.y; cb[6] = b.z; cb[7] = b.w; }
    const float qs = (col < 512) ? 0.125f : 1.0f;
    for (int item = blockIdx.x; item < 1024; item += gridDim.x) {
        const int b = item >> 7, s0 = (item & 127) * 16 + half * 8;
        const bf16_t* base = src + (size_t)b * 2048 * 1024 + col;
        uint4 r[11];
#pragma unroll
        for (int i = 0; i < 11; ++i) { const int sr = s0 - 3 + i; r[i] = gload16(base + (size_t)max(sr, 0) * 1024); if (sr < 0) r[i] = make_uint4(0u, 0u, 0u, 0u); }
        float x0[8], x1[8], x2[8];
        unpack8(r[0], x0); unpack8(r[1], x1); unpack8(r[2], x2);
#pragma unroll
        for (int i = 0; i < 8; ++i) {
            float x3[8], a[8]; unpack8(r[i + 3], x3);
#pragma unroll
            for (int e = 0; e < 8; ++e) { a[e] = cb[e] + cw[0][e] * x0[e] + cw[1][e] * x1[e] + cw[2][e] * x2[e] + cw[3][e] * x3[e]; a[e] = siluf_(a[e]) * qs; }
            *(uint4*)(dst + ((size_t)b * 2048 + s0 + i) * 1024 + col) = pack8(a);
#pragma unroll
            for (int e = 0; e < 8; ++e) { x0[e] = x1[e]; x1[e] = x2[e]; x2[e] = x3[e]; }
        }
    }
}
__device__ __forceinline__ void phase_ml2(PRef p, char* lds) {
    const int t = tidx(), lane = t & 63, w = t >> 6, fr = lane & 15, fq = lane >> 4;
    char* S = p.ws + OFF_SLOT;
    const bf16_t* qk = (const bf16_t*)(S + 8 * SLOT); const bf16_t* vb = (const bf16_t*)(S + 2 * SLOT); bf16_t* yb = (bf16_t*)(S + 4 * SLOT);
    const float* gates = (const float*)(p.ws + OFF_GATES); float* stat = (float*)(p.ws + OFF_STAT);
    char* const RAW = lds;
    char* const QT = lds + 17408; char* const KT = lds + 25600;
    char* const VT = lds + 33792;
    char* const VX = lds + 35840;
    char* const PB = lds + 39936;
    char* const CT = lds + 48128;
    float* const FS = (float*)(lds + 52224); float* const GJ = FS + 64; float* const WJ = FS + 128;
    float* const CW = (float*)(lds + 53248);
    const int qq = fr >> 2, pp = fr & 3;
    for (int item = blockIdx.x; item < 512; item += gridDim.x) {
        const int bh = item >> 3, vs = item & 7, b = bh >> 3, hd = bh & 7;
        const size_t tok0 = (size_t)b * 2048;
        __syncthreads();
        for (int i = t; i < 256; i += 256) *(uint4*)(CT + i * 16) = make_uint4(0u, 0u, 0u, 0u);
        f32x4 Cacc[2] = {(f32x4){0.f, 0.f, 0.f, 0.f}, (f32x4){0.f, 0.f, 0.f, 0.f}};
        uint4 gr0, gr1, gr2, gr3; uint4 gv = make_uint4(0u, 0u, 0u, 0u); float gg = 0.f;
        const int frr = t >> 4, fc = t & 15;
        const bf16_t* const qkt = qk + (tok0 + frr) * 1024 + (fc >> 3) * 512 + hd * 64 + (fc & 7) * 8;
        char* const qkd = ((fc < 8) ? QT : KT) + frr * 128 + (((fc & 7) ^ (frr & 7)) << 4);
        auto fetch = [&](int ch) {
            const int s0 = ch * 64;
            const bf16_t* q0 = qkt + (size_t)s0 * 1024;
            gr0 = gload16(q0); gr1 = gload16(q0 + 16 * 1024); gr2 = gload16(q0 + 32 * 1024); gr3 = gload16(q0 + 48 * 1024);
            if (t < 128) { gv = gload16(vb + (tok0 + s0 + (t >> 1)) * 1024 + hd * 128 + vs * 16 + (t & 1) * 8);
                           gg = *(const __attribute__((address_space(1))) float*)(gates + (tok0 + s0 + (t & 63)) * 16 + (t >> 6) * 8 + hd); }
        };
        fetch(0);
        for (int ch = 0; ch < 32; ++ch) {
            const int s0 = ch * 64;
            *(uint4*)qkd = gr0; *(uint4*)(qkd + 16 * 128) = gr1; *(uint4*)(qkd + 32 * 128) = gr2; *(uint4*)(qkd + 48 * 128) = gr3;
            if (t < 128) *(uint4*)(VT + t * 16) = gv;
            float vf8[8]; unpack8(gv, vf8);
            if (t >= 64 && t < 128) GJ[t - 64] = gg;
            const float ggc = gg;
            if (ch + 1 < 32) fetch(ch + 1);
            __syncthreads();
            if (t < 64) {
                float f = GJ[t];
#pragma unroll
                for (int o = 1; o < 64; o <<= 1) { const float u2 = __shfl_up(f, o); if (t >= o) f += u2; }
                const float fend = __shfl(f, 63);
                FS[t] = f; WJ[t] = __expf(fend - f + ggc);
                GJ[t] = ggc - f;
            }
            __syncthreads();
            const float efend = __expf(FS[63]);
            {
                if (t < 128) {
                    const int j = t >> 1; const float wj = WJ[j];
                    float f[8];
#pragma unroll
                    for (int i = 0; i < 8; ++i) f[i] = vf8[i] * wj;
                    *(uint4*)(VX + j * 64 + (t & 1) * 16) = pack8(f);
                    float g8[8] = {0.f, 0.f, 0.f, 0.f, 0.f, 0.f, 0.f, 0.f}; if ((t & 1) == 0) g8[0] = wj;
                    *(uint4*)(VX + j * 64 + 32 + (t & 1) * 16) = pack8(g8);
                }
            }
            __syncthreads();
            const int srow = 16 * w + fr;
            f32x4 Sacc[4], Xacc[2];
#pragma unroll
            for (int n = 0; n < 4; ++n) Sacc[n] = (f32x4){0.f, 0.f, 0.f, 0.f};
            Xacc[0] = (f32x4){0.f, 0.f, 0.f, 0.f}; Xacc[1] = (f32x4){0.f, 0.f, 0.f, 0.f};
            Cacc[0] *= efend; Cacc[1] *= efend;
#pragma unroll
            for (int ks = 0; ks < 2; ++ks) {
                const int chs = ((ks * 4 + fq) ^ (fr & 7)) << 4;
                const uint4 qf = *(const uint4*)(QT + srow * 128 + chs);
#pragma unroll
                for (int n = 0; n < 4; ++n) { const uint4 kf = *(const uint4*)(KT + (n * 16 + fr) * 128 + chs); Sacc[n] = mfma16(kf, qf, Sacc[n]); }
#pragma unroll
                for (int nn = 0; nn < 2; ++nn) { const uint4 rf = *(const uint4*)(CT + (nn * 16 + fr) * 128 + chs); Xacc[nn] = mfma16(rf, qf, Xacc[nn]); }
                const int r0 = ks * 32 + fq * 8 + qq, kc = 2 * w + (pp >> 1);
                const uint2 klo = lds_tr16(KT + r0 * 128 + ((kc ^ (r0 & 7)) << 4) + (pp & 1) * 8);
                const uint2 khi = lds_tr16(KT + (r0 + 4) * 128 + ((kc ^ ((r0 + 4) & 7)) << 4) + (pp & 1) * 8);
                const uint4 kt = make_uint4(klo.x, klo.y, khi.x, khi.y);
#pragma unroll
                for (int m = 0; m < 2; ++m) {
                    const uint2 vlo = lds_tr16(VX + r0 * 64 + (16 * m + 4 * pp) * 2), vhi = lds_tr16(VX + (r0 + 4) * 64 + (16 * m + 4 * pp) * 2);
                    Cacc[m] = mfma16(kt, make_uint4(vlo.x, vlo.y, vhi.x, vhi.y), Cacc[m]);
                }
            }
            const float fs = FS[srow];
            float dsum = 0.f;
#pragma unroll
            for (int n = 0; n < 4; ++n) {
                const float4 g4 = *(const float4*)(GJ + n * 16 + fq * 4); const float ga[4] = {g4.x, g4.y, g4.z, g4.w};
                float pv[4];
#pragma unroll
                for (int j = 0; j < 4; ++j) { const int jc = n * 16 + fq * 4 + j; pv[j] = (srow >= jc) ? Sacc[n][j] * __expf(fs + ga[j]) : 0.f; dsum += pv[j]; }
                uint2 o; o.x = cvt_pk(pv[0], pv[1]); o.y = cvt_pk(pv[2], pv[3]);
                *(uint2*)(PB + srow * 128 + (((n * 2 + (fq >> 1)) ^ (fr & 7)) << 4) + (fq & 1) * 8) = o;
            }
            dsum += __shfl_xor(dsum, 16); dsum += __shfl_xor(dsum, 32);
            f32x4 Iacc = (f32x4){0.f, 0.f, 0.f, 0.f};
#pragma unroll
            for (int ks = 0; ks < 2; ++ks) {
                const uint4 pf = *(const uint4*)(PB + srow * 128 + (((ks * 4 + fq) ^ (fr & 7)) << 4));
                const int r0 = ks * 32 + fq * 8 + qq;
                const uint2 vlo = lds_tr16(VT + r0 * 32 + (4 * pp) * 2), vhi = lds_tr16(VT + (r0 + 4) * 32 + (4 * pp) * 2);
                Iacc = mfma16(make_uint4(vlo.x, vlo.y, vhi.x, vhi.y), pf, Iacc);
            }
            const float efs = __expf(fs);
            const float ndq = __shfl(Xacc[1][0], fr);
            const float den = dsum + efs * ndq;
            const float rden = 1.0f / fmaxf(fabsf(den), 1.0f);
            const size_t tok = tok0 + s0 + srow;
            float o4[4], ssum = 0.f, ssq = 0.f;
#pragma unroll
            for (int j = 0; j < 4; ++j) { o4[j] = (Iacc[j] + efs * Xacc[0][j]) * rden; ssum += o4[j]; ssq += o4[j] * o4[j]; }
            gst_u2(yb + tok * 1024 + hd * 128 + vs * 16 + fq * 4, cvt_pk(o4[0], o4[1]), cvt_pk(o4[2], o4[3]));
            ssum += __shfl_xor(ssum, 16); ssum += __shfl_xor(ssum, 32); ssq += __shfl_xor(ssq, 16); ssq += __shfl_xor(ssq, 32);
            if (fq == 0) gst_u2(stat + ((tok * 8 + hd) * 8 + vs) * 2, __float_as_uint(ssum), __float_as_uint(ssq));
            __syncthreads();
#pragma unroll
            for (int m = 0; m < 2; ++m) {
                const int v = m * 16 + fr;
                uint2 o; o.x = cvt_pk(Cacc[m][0], Cacc[m][1]); o.y = cvt_pk(Cacc[m][2], Cacc[m][3]);
                *(uint2*)(CT + v * 128 + (((2 * w + (fq >> 1)) ^ (v & 7)) << 4) + (fq & 1) * 8) = o;
            }
        }
    }
}
template <int HSHIFT  , int NH>
struct LdGnGate {
    struct Raw { uint4 y, g; };
    const bf16_t *y, *g; int ld; const float *gng, *gnb; const float* st;
    __device__ __forceinline__ Raw fetch(int, int r, int kc) const { Raw q; const size_t o = (size_t)r * ld + kc * 8; q.y = *(const uint4*)(y + o); q.g = *(const uint4*)(g + o); return q; }
    __device__ __forceinline__ uint4 finish(const Raw& q, int, int r, int kc) const {
        float yf[8], gf[8]; unpack8(q.y, yf); unpack8(q.g, gf);
        const float2 ms = *(const float2*)(st + (r * NH + ((kc * 8) >> HSHIFT)) * 2);
        const float4 ga = *(const float4*)(gng + kc * 8), gb = *(const float4*)(gng + kc * 8 + 4), ba = *(const float4*)(gnb + kc * 8), bb = *(const float4*)(gnb + kc * 8 + 4);
        const float gg[8] = {ga.x, ga.y, ga.z, ga.w, gb.x, gb.y, gb.z, gb.w}, bq[8] = {ba.x, ba.y, ba.z, ba.w, bb.x, bb.y, bb.z, bb.w};
        float o[8];
#pragma unroll
        for (int i = 0; i < 8; ++i) o[i] = ((yf[i] - ms.x) * ms.y * gg[i] + bq[i]) * gf[i];
        return pack8(o);
    }
};
template <int HSHIFT, int NH, int NPART>
__device__ __forceinline__ void phase_outproj_gn(PRef p, char* lds, const bf16_t* yb, const bf16_t* gate, int K, const bf16_t* wt, const float* gng, const float* gnb, bf16_t* ymix) {
    const int t = tidx(), lane = t & 63, wid = t >> 6, wr = wid >> 1, wc = wid & 1, fr = lane & 15, fq = lane >> 4;
    const float* stat = (const float*)(p.ws + OFF_STAT);
    float* st = (float*)(lds + 65536);
    const float invn = 1.0f / (float)(1 << HSHIFT);
    for (int id = blockIdx.x; id < 128 * 8; id += gridDim.x) {
        int mt, nt; tile_map(id, 8, mt, nt);
        for (int i = t; i < 128 * NH; i += 256) {
            const float* q = stat + ((size_t)mt * 128 * NH + i) * NPART * 2;
            float s = 0.f, s2 = 0.f;
#pragma unroll
            for (int j = 0; j < NPART; ++j) { const float2 v = *(const float2*)(q + j * 2); s += v.x; s2 += v.y; }
            const float mean = s * invn, var = fmaxf(s2 * invn - mean * mean, 0.f);
            st[i * 2] = mean; st[i * 2 + 1] = rsqrtf(var + 1e-6f);
        }
        __syncthreads();
        const size_t ro = (size_t)mt * 128 * K;
        LdGnGate<HSHIFT, NH> al{yb + ro, gate + ro, K, gng, gnb, st};
        const bf16_t* br[4];
        { const int r0_ = t >> 3, co_ = glds_chunk(t) * 8;
#pragma unroll
          for (int i = 0; i < 4; ++i) br[i] = wt + (size_t)(nt * 128 + r0_ + 32 * i) * K + co_; }
        f32x4 acc[4][4];
        gemm_rg(lds, K / 64, al, br, acc);
#pragma unroll
        for (int n = 0; n < 4; ++n)
#pragma unroll
            for (int m = 0; m < 4; ++m) {
                uint2 o; o.x = cvt_pk(acc[m][n][0], acc[m][n][1]); o.y = cvt_pk(acc[m][n][2], acc[m][n][3]);
                *(uint2*)(ymix + (size_t)(mt * 128 + wr * 64 + m * 16 + fr) * 1024 + nt * 128 + wc * 64 + n * 16 + fq * 4) = o;
            }
    }
}

__device__ __forceinline__ void phase_rt2(PRef p, char* lds) {
    const int t = tidx(), lane = t & 63, w = t >> 6, fr = lane & 15, fq = lane >> 4;
    char* S = p.ws + OFF_SLOT;
    const bf16_t* qb = (const bf16_t*)(S + 1 * SLOT); const bf16_t* kb = (const bf16_t*)(S + 2 * SLOT); const bf16_t* vb = (const bf16_t*)(S + 3 * SLOT);
    bf16_t* yb = (bf16_t*)(S + 7 * SLOT); float* stat = (float*)(p.ws + OFF_STAT);
    char* const VB = lds + 32768; char* const PB = lds + 49152; char* const RT = lds + 57344;
    const int gco = glds_chunk(t) * 8, gr0 = t >> 3;
    const int qq = fr >> 2, pp = fr & 3;
    for (int item = blockIdx.x; item < 512; item += gridDim.x) {
        const int bh = item >> 4, vs = item & 15, b = bh >> 2, hd = bh & 3;
        const size_t tok0 = (size_t)b * 2048;
        const float lg2 = log2f(1.0f - __builtin_amdgcn_exp2f(-5.0f - (float)hd));
        const float dec64 = __builtin_amdgcn_exp2f(64.0f * lg2);
        const bf16_t* qsrc = qb + (tok0 + gr0) * 1024 + hd * 256 + gco;
        const bf16_t* ksrc = kb + (tok0 + gr0) * 1024 + hd * 256 + gco;
        const bf16_t* vsrc = vb + (tok0 + (t >> 2)) * 2048 + hd * 512 + vs * 32 + (t & 3) * 8;
        f32x4 Racc[4][2];
#pragma unroll
        for (int a = 0; a < 4; ++a) { Racc[a][0] = (f32x4){0.f, 0.f, 0.f, 0.f}; Racc[a][1] = (f32x4){0.f, 0.f, 0.f, 0.f}; }
        __syncthreads();
        for (int i = t; i < 1024; i += 256) *(uint4*)(RT + i * 16) = make_uint4(0u, 0u, 0u, 0u);
        auto issue = [&](int pc) {
            const unsigned d = (unsigned)__builtin_amdgcn_readfirstlane((int)(lds_addr_u(lds) + (pc & 1) * 16384 + w * 1024));
            const size_t go = (size_t)(pc >> 2) * 64 * 1024 + (pc & 3) * 64;
#pragma unroll
            for (int i = 0; i < 2; ++i) { glds16_asm(qsrc + go + (size_t)i * 32 * 1024, d + i * 4096); glds16_asm(ksrc + go + (size_t)i * 32 * 1024, d + 8192 + i * 4096); }
        };
        auto put_v = [&](const uint4& raw, int ch) {
            char* vbuf = VB + (ch & 1) * 8192; const int j = t >> 2;
            *(uint4*)(vbuf + j * 64 + (t & 3) * 16) = raw;
            float f[8]; unpack8(raw, f); const float sc = __builtin_amdgcn_exp2f(lg2 * (float)(63 - j));
#pragma unroll
            for (int i = 0; i < 8; ++i) f[i] *= sc;
            *(uint4*)(vbuf + 4096 + j * 64 + (t & 3) * 16) = pack8(f);
        };
        issue(0);
        { const uint4 v0 = gld_u4(vsrc); put_v(v0, 0); }
        asm volatile("s_waitcnt vmcnt(0)" ::: "memory");
        __syncthreads();
        f32x4 Sacc[4], Xacc[2];
        uint4 vnext = make_uint4(0u, 0u, 0u, 0u);
        for (int ch = 0; ch < 32; ++ch) {
            const char* vbuf = VB + (ch & 1) * 8192;
#pragma unroll
            for (int qd = 0; qd < 4; ++qd) {
                const int pc = ch * 4 + qd;
                if (pc + 1 < 128) issue(pc + 1);
                if (qd == 0) {
                    if (ch + 1 < 32) vnext = gld_u4(vsrc + (size_t)(ch + 1) * 64 * 2048);
#pragma unroll
                    for (int n = 0; n < 4; ++n) Sacc[n] = (f32x4){0.f, 0.f, 0.f, 0.f};
                    Xacc[0] = (f32x4){0.f, 0.f, 0.f, 0.f}; Xacc[1] = (f32x4){0.f, 0.f, 0.f, 0.f};
                }
                const char* qk = lds + (pc & 1) * 16384;
                Racc[qd][0] *= dec64; Racc[qd][1] *= dec64;
#pragma unroll
                for (int ks = 0; ks < 2; ++ks) {
                    const int chs = ((ks * 4 + fq) ^ (fr & 7)) << 4;
                    const uint4 qf = *(const uint4*)(qk + (16 * w + fr) * 128 + chs);
#pragma unroll
                    for (int n = 0; n < 4; ++n) { const uint4 kf = *(const uint4*)(qk + 8192 + (n * 16 + fr) * 128 + chs); Sacc[n] = mfma16(kf, qf, Sacc[n]); }
#pragma unroll
                    for (int nn = 0; nn < 2; ++nn) {
                        const int v = nn * 16 + fr;
                        const uint4 rf = *(const uint4*)(RT + v * 512 + (((qd * 8 + ks * 4 + fq) ^ (v & 7)) << 4));
                        Xacc[nn] = mfma16(rf, qf, Xacc[nn]);
                    }
                    const int r0 = ks * 32 + fq * 8 + qq;
                    const int kc = 2 * w + (pp >> 1);
                    const uint2 klo = lds_tr16(qk + 8192 + r0 * 128 + ((kc ^ (r0 & 7)) << 4) + (pp & 1) * 8);
                    const uint2 khi = lds_tr16(qk + 8192 + (r0 + 4) * 128 + ((kc ^ ((r0 + 4) & 7)) << 4) + (pp & 1) * 8);
                    const uint4 kt = make_uint4(klo.x, klo.y, khi.x, khi.y);
#pragma unroll
                    for (int m = 0; m < 2; ++m) {
                        const uint2 vlo = lds_tr16(vbuf + 4096 + r0 * 64 + (16 * m + 4 * pp) * 2), vhi = lds_tr16(vbuf + 4096 + (r0 + 4) * 64 + (16 * m + 4 * pp) * 2);
                        Racc[qd][m] = mfma16(kt, make_uint4(vlo.x, vlo.y, vhi.x, vhi.y), Racc[qd][m]);
                    }
                }
                if (qd == 2 && ch + 1 < 32) put_v(vnext, ch + 1);
                asm volatile("s_waitcnt vmcnt(0)" ::: "memory");
                __syncthreads();
#pragma unroll
                for (int m = 0; m < 2; ++m) {
                    const int v = m * 16 + fr, cch = qd * 8 + 2 * w + (fq >> 1);
                    uint2 o; o.x = cvt_pk(Racc[qd][m][0], Racc[qd][m][1]); o.y = cvt_pk(Racc[qd][m][2], Racc[qd][m][3]);
                    *(uint2*)(RT + v * 512 + ((cch ^ (v & 7)) << 4) + (fq & 1) * 8) = o;
                }
            }
            const int srow = 16 * w + fr;
#pragma unroll
            for (int n = 0; n < 4; ++n) {
                float pv[4];
#pragma unroll
                for (int j = 0; j < 4; ++j) { const int jc = n * 16 + fq * 4 + j; pv[j] = (srow >= jc) ? Sacc[n][j] * __builtin_amdgcn_exp2f(lg2 * (float)(srow - jc)) : 0.f; }
                uint2 o; o.x = cvt_pk(pv[0], pv[1]); o.y = cvt_pk(pv[2], pv[3]);
                *(uint2*)(PB + srow * 128 + (((n * 2 + (fq >> 1)) ^ (fr & 7)) << 4) + (fq & 1) * 8) = o;
            }
            f32x4 Iacc[2] = {(f32x4){0.f, 0.f, 0.f, 0.f}, (f32x4){0.f, 0.f, 0.f, 0.f}};
#pragma unroll
            for (int ks = 0; ks < 2; ++ks) {
                const uint4 pf = *(const uint4*)(PB + srow * 128 + (((ks * 4 + fq) ^ (fr & 7)) << 4));
                const int r0 = ks * 32 + fq * 8 + qq;
#pragma unroll
                for (int nn = 0; nn < 2; ++nn) {
                    const uint2 vlo = lds_tr16(vbuf + r0 * 64 + (16 * nn + 4 * pp) * 2), vhi = lds_tr16(vbuf + (r0 + 4) * 64 + (16 * nn + 4 * pp) * 2);
                    Iacc[nn] = mfma16(make_uint4(vlo.x, vlo.y, vhi.x, vhi.y), pf, Iacc[nn]);
                }
            }
            const float qdec = __builtin_amdgcn_exp2f(lg2 * (float)(srow + 1));
            const size_t tok = tok0 + (size_t)ch * 64 + srow;
            float ssum = 0.f, ssq = 0.f;
#pragma unroll
            for (int nn = 0; nn < 2; ++nn) {
                float o4[4];
#pragma unroll
                for (int j = 0; j < 4; ++j) { o4[j] = Iacc[nn][j] + Xacc[nn][j] * qdec; ssum += o4[j]; ssq += o4[j] * o4[j]; }
                gst_u2(yb + tok * 2048 + hd * 512 + vs * 32 + nn * 16 + fq * 4, cvt_pk(o4[0], o4[1]), cvt_pk(o4[2], o4[3]));
            }
            ssum += __shfl_xor(ssum, 16); ssum += __shfl_xor(ssum, 32); ssq += __shfl_xor(ssq, 16); ssq += __shfl_xor(ssq, 32);
            if (fq == 0) gst_u2(stat + ((tok * 4 + hd) * 16 + vs) * 2, __float_as_uint(ssum), __float_as_uint(ssq));
        }
        __syncthreads();
    }
}

__device__ __forceinline__ void phase_zrw(PRef p, int jr) {
    const int t_ = tidx(); const int lane = t_ & 63, gw = blockIdx.x * 4 + (t_ >> 6), nw = gridDim.x * 4;
    char* S = p.ws + OFF_SLOT;
    const bf16_t* yb = (const bf16_t*)(S + 5 * SLOT); const bf16_t* gb = (const bf16_t*)(S + 4 * SLOT);
    const bf16_t* vb = (const bf16_t*)(S + (jr == 0 ? 11 : 9) * SLOT); bf16_t* zb = (bf16_t*)(S + 7 * SLOT);
    const float* bonus = (const float*)(p.ws + OFF_BONUS);
    float gg[16], bq[16]; row_load_f32(p.in[22] + jr * 1024, gg, lane); row_load_f32(p.in[23] + jr * 1024, bq, lane);
    const int rpw = NTOK / nw, first = gw * rpw, end = first + rpw;
    uint2 ny[4], nv[4], ng[4]; float nbn[4];
    auto load_in = [&](int r) {
#pragma unroll
        for (int c = 0; c < 4; ++c) { const size_t o = (size_t)r * 1024 + c * 256 + lane * 4; ny[c] = *(const uint2*)(yb + o); nv[c] = *(const uint2*)(vb + o); ng[c] = *(const uint2*)(gb + o);
                                      nbn[c] = bonus[(size_t)r * 16 + c * 4 + (lane >> 4)]; }
    };
    load_in(first);
    for (int r = first; r < end; ++r) {
        float y[16], v[16], g[16], bn[4];
#pragma unroll
        for (int c = 0; c < 4; ++c) {
            y[c * 4] = bflo(ny[c].x); y[c * 4 + 1] = bfhi(ny[c].x); y[c * 4 + 2] = bflo(ny[c].y); y[c * 4 + 3] = bfhi(ny[c].y);
            v[c * 4] = bflo(nv[c].x); v[c * 4 + 1] = bfhi(nv[c].x); v[c * 4 + 2] = bflo(nv[c].y); v[c * 4 + 3] = bfhi(nv[c].y);
            g[c * 4] = bflo(ng[c].x); g[c * 4 + 1] = bfhi(ng[c].x); g[c * 4 + 2] = bflo(ng[c].y); g[c * 4 + 3] = bfhi(ng[c].y);
            bn[c] = nbn[c];
        }
        if (r + 1 < end) load_in(r + 1);
        __builtin_amdgcn_sched_barrier(0);
        float z[16];
#pragma unroll
        for (int c = 0; c < 4; ++c) {
            float s = (y[c * 4] + y[c * 4 + 1]) + (y[c * 4 + 2] + y[c * 4 + 3]);
            float q = (y[c * 4] * y[c * 4] + y[c * 4 + 1] * y[c * 4 + 1]) + (y[c * 4 + 2] * y[c * 4 + 2] + y[c * 4 + 3] * y[c * 4 + 3]);
            s = row16_sum(s); q = row16_sum(q);
            const float mean = s * (1.0f / 64.0f), rstd = rsqrtf(fmaxf(q * (1.0f / 64.0f) - mean * mean, 0.f) + 64e-5f);
#pragma unroll
            for (int i = 0; i < 4; ++i) { const int e = c * 4 + i; z[e] = ((y[e] - mean) * rstd * gg[e] + bq[e] + bn[c] * v[e]) * g[e]; }
        }
        row_store_bf16(zb + (size_t)r * 1024, z, lane);
    }
}
__device__ __forceinline__ void phase_zml(PRef p) {
    const int t_ = tidx(); const int lane = t_ & 63, gw = blockIdx.x * 4 + (t_ >> 6), nw = gridDim.x * 4;
    char* S = p.ws + OFF_SLOT;
    const bf16_t* yb = (const bf16_t*)(S + 4 * SLOT); const bf16_t* ob = (const bf16_t*)(S + 3 * SLOT); bf16_t* zb = (bf16_t*)(S + 1 * SLOT);
    float gg[16], bq[16]; row_load_f32(p.in[29], gg, lane); row_load_f32(p.in[30], bq, lane);
    const int rpw = NTOK / nw, first = gw * rpw, end = first + rpw;
    uint2 ny[4], no[4];
    auto load_in = [&](int r) {
#pragma unroll
        for (int c = 0; c < 4; ++c) { const size_t o = (size_t)r * 1024 + c * 256 + lane * 4; ny[c] = *(const uint2*)(yb + o); no[c] = *(const uint2*)(ob + o); }
    };
    load_in(first);
    for (int r = first; r < end; ++r) {
        float y[16], o[16], z[16];
#pragma unroll
        for (int c = 0; c < 4; ++c) {
            y[c * 4] = bflo(ny[c].x); y[c * 4 + 1] = bfhi(ny[c].x); y[c * 4 + 2] = bflo(ny[c].y); y[c * 4 + 3] = bfhi(ny[c].y);
            o[c * 4] = bflo(no[c].x); o[c * 4 + 1] = bfhi(no[c].x); o[c * 4 + 2] = bflo(no[c].y); o[c * 4 + 3] = bfhi(no[c].y);
        }
        if (r + 1 < end) load_in(r + 1);
        __builtin_amdgcn_sched_barrier(0);
#pragma unroll
        for (int c = 0; c < 4; ++c) {
            float s = (y[c * 4] + y[c * 4 + 1]) + (y[c * 4 + 2] + y[c * 4 + 3]);
            float q = (y[c * 4] * y[c * 4] + y[c * 4 + 1] * y[c * 4 + 1]) + (y[c * 4 + 2] * y[c * 4 + 2] + y[c * 4 + 3] * y[c * 4 + 3]);
            s = row16_sum(s); q = row16_sum(q); s += __shfl_xor(s, 16); q += __shfl_xor(q, 16);
            const float mean = s * (1.0f / 128.0f), rstd = rsqrtf(fmaxf(q * (1.0f / 128.0f) - mean * mean, 0.f) + 1e-6f);
#pragma unroll
            for (int i = 0; i < 4; ++i) { const int e = c * 4 + i; z[e] = ((y[e] - mean) * rstd * gg[e] + bq[e]) * o[e]; }
        }
        row_store_bf16(zb + (size_t)r * 1024, z, lane);
    }
}
__device__ __forceinline__ void phase_zrt(PRef p) {
    const int t_ = tidx(); const int lane = t_ & 63, gw = blockIdx.x * 4 + (t_ >> 6), nw = gridDim.x * 4;
    char* S = p.ws + OFF_SLOT;
    const bf16_t* yb = (const bf16_t*)(S + 7 * SLOT); const bf16_t* sb = (const bf16_t*)(S + 5 * SLOT); bf16_t* zb = (bf16_t*)(S + 3 * SLOT);
    float gw8[4][8], bw8[4][8];
#pragma unroll
    for (int c = 0; c < 4; ++c) {
        const float4 ga = gld_f4(p.in[33] + lane * 32 + c * 8), gb2 = gld_f4(p.in[33] + lane * 32 + c * 8 + 4), ba = gld_f4(p.in[34] + lane * 32 + c * 8), bb2 = gld_f4(p.in[34] + lane * 32 + c * 8 + 4);
        gw8[c][0] = ga.x; gw8[c][1] = ga.y; gw8[c][2] = ga.z; gw8[c][3] = ga.w; gw8[c][4] = gb2.x; gw8[c][5] = gb2.y; gw8[c][6] = gb2.z; gw8[c][7] = gb2.w;
        bw8[c][0] = ba.x; bw8[c][1] = ba.y; bw8[c][2] = ba.z; bw8[c][3] = ba.w; bw8[c][4] = bb2.x; bw8[c][5] = bb2.y; bw8[c][6] = bb2.z; bw8[c][7] = bb2.w;
    }
    const int rpw = NTOK / nw, first = gw * rpw, end = first + rpw;
    uint4 nyr[4], nsr[4];
    auto load_in = [&](int r) {
        const size_t o = (size_t)r * 2048 + lane * 32;
#pragma unroll
        for (int c = 0; c < 4; ++c) { nyr[c] = *(const uint4*)(yb + o + c * 8); nsr[c] = *(const uint4*)(sb + o + c * 8); }
    };
    load_in(first);
    for (int r = first; r < end; ++r) {
        const size_t o = (size_t)r * 2048 + lane * 32;
        uint4 yr[4], sr[4];
#pragma unroll
        for (int c = 0; c < 4; ++c) { yr[c] = nyr[c]; sr[c] = nsr[c]; }
        if (r + 1 < end) load_in(r + 1);
        __builtin_amdgcn_sched_barrier(0);
        float s = 0.f, q = 0.f;
#pragma unroll
        for (int c = 0; c < 4; ++c) { float f[8]; unpack8(yr[c], f);
#pragma unroll
            for (int i = 0; i < 8; ++i) { s += f[i]; q += f[i] * f[i]; } }
        s = row16_sum(s); q = row16_sum(q);
        const float mean = s * (1.0f / 512.0f), rstd = rsqrtf(fmaxf(q * (1.0f / 512.0f) - mean * mean, 0.f) + 1e-6f);
#pragma unroll
        for (int c = 0; c < 4; ++c) {
            float f[8], g[8], z[8]; unpack8(yr[c], f); unpack8(sr[c], g);
#pragma unroll
            for (int i = 0; i < 8; ++i) z[i] = ((f[i] - mean) * rstd * gw8[c][i] + bw8[c][i]) * g[i];
            *(uint4*)(zb + o + c * 8) = pack8(z);
        }
    }
}

template <int WHICH  >
__device__ __forceinline__ void phase_moe(PRef p, int L, char* lds, const bf16_t* hm, bf16_t* H) {
    const int t = tidx(), lane = t & 63, wid = t >> 6, wr = wid >> 1, wc = wid & 1, fr = lane & 15, fq = lane >> 4;
    const int* cnt = (const int*)(p.ws + OFF_CNT) + L * 32;
    const int* list = (const int*)(p.ws + OFF_LIST);
    bf16_t* Y = (bf16_t*)(p.ws + OFF_SLOT + 9 * SLOT);
    int* pre = (int*)(lds + 65536);
    __syncthreads();
    if (t == 0) { int s = 0; for (int e = 0; e < 32; ++e) { pre[e] = s; s += (cnt[e] + 127) >> 7; } pre[32] = s; }
    __syncthreads();
    const int total_all = pre[32] * 8;
    const int full = (total_all / (int)gridDim.x) * (int)gridDim.x, rem = total_all - full;
    const bool split_tail = (rem > 0) && (2 * rem <= (int)gridDim.x);
    const int total = split_tail ? full : total_all;
    for (int id0 = 0; id0 < total; id0 += gridDim.x) {
        const int id = id0 + (blockIdx.x & 7) * (gridDim.x >> 3) + (blockIdx.x >> 3);
        if (id >= total) continue;
        const int nt = id & 7, mg = id >> 3;
        int e = 0;
#pragma unroll 1
        for (int s = 16; s >= 1; s >>= 1) if (pre[e + s] <= mg) e += s;
        const int mt = mg - pre[e], ne = cnt[e];
        const int* le = list + e * LIST_CAP + mt * 128;
        const bf16_t* ar[4]; const bf16_t* br[4];
        const int co_ = glds_chunk(t) * 8;
#pragma unroll
        for (int i = 0; i < 4; ++i) {
            int r = (t >> 3) + 32 * i; r = (mt * 128 + r < ne) ? r : 0;
            const int aid = le[r];
            ar[i] = ((WHICH == 0) ? hm + (size_t)(aid >> 1) * 1024 : H + (size_t)aid * 512) + co_;
        }
        f32x4 acc[4][4];
        if (WHICH == 0) {
            const bf16_t* wt = (const bf16_t*)(p.ws + W_MOE13) + ((size_t)(L * 32 + e) * 1024 + nt * 128) * 1024;
#pragma unroll
            for (int i = 0; i < 4; ++i) {
                const int ro = (t >> 3) + 32 * i, n_ = (ro >> 4) & 3, hc = ((ro >> 2) & 3) * 8 + (n_ >> 1) * 4 + (ro & 3);
                br[i] = wt + (size_t)((ro & 64) + (hc >> 4) * 32 + (n_ & 1) * 16 + (hc & 15)) * 1024 + co_;
            }
            gemm_gg(lds, 16, ar, br, acc);
            int aidq[4];
#pragma unroll
            for (int m = 0; m < 4; ++m) { const int r = wr * 64 + m * 16 + fr; aidq[m] = (mt * 128 + r < ne) ? le[r] : 0; }
#pragma unroll
            for (int m = 0; m < 4; ++m) {
                const int r = wr * 64 + m * 16 + fr;
                if (mt * 128 + r < ne) {
                    const int aid = aidq[m];
                    const f32x4 a1 = acc[m][0], a3 = acc[m][1], b1 = acc[m][2], b3 = acc[m][3];
                    gst_u4(H + (size_t)aid * 512 + nt * 64 + wc * 32 + fq * 8, cvt_pk(siluf_(a1[0]) * a3[0], siluf_(a1[1]) * a3[1]), cvt_pk(siluf_(a1[2]) * a3[2], siluf_(a1[3]) * a3[3]),
                           cvt_pk(siluf_(b1[0]) * b3[0], siluf_(b1[1]) * b3[1]), cvt_pk(siluf_(b1[2]) * b3[2], siluf_(b1[3]) * b3[3]));
                }
            }
        } else {
            const bf16_t* wt = (const bf16_t*)(p.ws + W_MOE2) + ((size_t)(L * 32 + e) * 1024 + nt * 128) * 512;
#pragma unroll
            for (int i = 0; i < 4; ++i) br[i] = wt + (size_t)perm64((t >> 3) + 32 * i) * 512 + co_;
            gemm_gg(lds, 8, ar, br, acc);
            int aidq[4];
#pragma unroll
            for (int m = 0; m < 4; ++m) { const int r = wr * 64 + m * 16 + fr; aidq[m] = (mt * 128 + r < ne) ? le[r] : 0; }
#pragma unroll
            for (int m = 0; m < 4; ++m) {
                const int r = wr * 64 + m * 16 + fr;
                if (mt * 128 + r < ne) {
                    const int aid = aidq[m];
                    store16(Y + (size_t)aid * 1024 + nt * 128 + wc * 64 + fq * 16, acc[m]);
                }
            }
        }
    }
    if (split_tail) {
        const int hid = (blockIdx.x & 7) * (gridDim.x >> 3) + (blockIdx.x >> 3);
        if (hid < 2 * rem) {
            const int id = full + (hid >> 1), hf = hid & 1;
            const int nt = id & 7, mg = id >> 3;
            int e = 0;
#pragma unroll 1
            for (int s2 = 16; s2 >= 1; s2 >>= 1) if (pre[e + s2] <= mg) e += s2;
            const int mt = mg - pre[e], ne = cnt[e];
            const int* le = list + e * LIST_CAP + mt * 128;
            const bf16_t* ar[4]; const bf16_t* br[2];
            const int co_ = glds_chunk(t) * 8;
#pragma unroll
            for (int i = 0; i < 4; ++i) {
                int r = (t >> 3) + 32 * i; r = (mt * 128 + r < ne) ? r : 0;
                const int aid = le[r];
                ar[i] = ((WHICH == 0) ? hm + (size_t)(aid >> 1) * 1024 : H + (size_t)aid * 512) + co_;
            }
            f32x4 acc[2][4];
            int aidq[2];
            if (WHICH == 0) {
                const bf16_t* wt = (const bf16_t*)(p.ws + W_MOE13) + ((size_t)(L * 32 + e) * 1024 + nt * 128 + hf * 64) * 1024;
#pragma unroll
                for (int i = 0; i < 2; ++i) {
                    const int ro = (t >> 3) + 32 * i, n_ = (ro >> 4) & 3, hc = ((ro >> 2) & 3) * 8 + (n_ >> 1) * 4 + (ro & 3);
                    br[i] = wt + (size_t)((hc >> 4) * 32 + (n_ & 1) * 16 + (hc & 15)) * 1024 + co_;
                }
                gemm_hn(lds, 16, ar, br, acc);
#pragma unroll
                for (int m = 0; m < 2; ++m) { const int r = wid * 32 + m * 16 + fr; aidq[m] = (mt * 128 + r < ne) ? le[r] : 0; }
#pragma unroll
                for (int m = 0; m < 2; ++m) {
                    const int r = wid * 32 + m * 16 + fr;
                    if (mt * 128 + r < ne) {
                        const f32x4 a1 = acc[m][0], a3 = acc[m][1], b1 = acc[m][2], b3 = acc[m][3];
                        gst_u4(H + (size_t)aidq[m] * 512 + nt * 64 + hf * 32 + fq * 8, cvt_pk(siluf_(a1[0]) * a3[0], siluf_(a1[1]) * a3[1]), cvt_pk(siluf_(a1[2]) * a3[2], siluf_(a1[3]) * a3[3]),
                               cvt_pk(siluf_(b1[0]) * b3[0], siluf_(b1[1]) * b3[1]), cvt_pk(siluf_(b1[2]) * b3[2], siluf_(b1[3]) * b3[3]));
                    }
                }
            } else {
                const bf16_t* wt = (const bf16_t*)(p.ws + W_MOE2) + ((size_t)(L * 32 + e) * 1024 + nt * 128 + hf * 64) * 512;
#pragma unroll
                for (int i = 0; i < 2; ++i) br[i] = wt + (size_t)perm64((t >> 3) + 32 * i) * 512 + co_;
                gemm_hn(lds, 8, ar, br, acc);
#pragma unroll
                for (int m = 0; m < 2; ++m) { const int r = wid * 32 + m * 16 + fr; aidq[m] = (mt * 128 + r < ne) ? le[r] : 0; }
#pragma unroll
                for (int m = 0; m < 2; ++m) {
                    const int r = wid * 32 + m * 16 + fr;
                    if (mt * 128 + r < ne) store16(Y + (size_t)aidq[m] * 1024 + nt * 128 + hf * 64 + fq * 16, acc[m]);
                }
            }
        }
    }
}

constexpr int NPHASE = 37;
#ifndef PHSEL
#define PHSEL -1
#endif
#ifndef PHEXC
#define PHEXC -2
#endif
#define PHON(x) ((PHSEL < 0 || PHSEL == (x)) && PHEXC != (x))
__global__ void __launch_bounds__(256, 2) mega(Params p_in) {
    PRef p = *(const CAS Params*)__builtin_amdgcn_kernarg_segment_ptr();
    extern __shared__ __attribute__((aligned(16))) char lds[];
    volatile LAS unsigned* xbw = (volatile LAS unsigned*)(lds + 73728);
    if (threadIdx.x == 0) { xbw[0] = 0u; xbw[1] = 0u; xbw[2] = 0u; xbw[3] = 0u; }
    __syncthreads();
    XcdBarrier bar;
    const bool multi = (p.ph_hi - p.ph_lo) > 1;
    (void)multi;
    if (multi) bar = xcd_barrier_post((unsigned*)(p.ws + OFF_CTL), xbw);
    char* S = p.ws + OFF_SLOT;
#ifdef DBG_STOP
    if (p.ph_lo == 100) {
        const float* src = (const float*)(p.ws + DBG_SRC);
        for (size_t i = (size_t)blockIdx.x * 256 + threadIdx.x; i < (size_t)NTOK * DM; i += (size_t)gridDim.x * 256) {
            float v = DBG_BF16 ? bf2f(((const bf16_t*)src)[i]) : src[i];
            if (!(fabsf(v) < 1e30f)) v = 1e30f;
            p.out[i] = v;
        }
        return;
    }
#endif
    const int ph_lo_ = p.ph_lo, ph_hi_ = p.ph_hi;
#ifdef TIMEIT
    unsigned long long t0_ = 0, t1_ = 0;
#endif
#ifdef DUP_PHASE
    bool dup_done_ = false;
#endif
    for (int ph = ph_lo_; ph < ph_hi_; ++ph) {
        const CAS Params* pp_ = (const CAS Params*)__builtin_amdgcn_kernarg_segment_ptr();
        asm volatile("" : "+s"(pp_));
        PRef p = *pp_;
#ifdef TIMEIT
        if (ph == TIME_A) t0_ = __builtin_amdgcn_s_memrealtime();
        if (ph == TIME_B) t1_ = __builtin_amdgcn_s_memrealtime();
#endif
        int L, sub, kind;
        if (ph < 2) { L = 0; sub = ph; kind = -1; }
        else if (ph < 11) { L = 0; kind = 0; sub = ph - 2; }
        else if (ph < 20) { L = 1; kind = 1; sub = ph - 11; }
        else if (ph < 28) { L = 2; kind = 2; sub = ph - 20; }
        else { L = 3; kind = 0; sub = ph - 28; }
        const int jr = L / 3;
        if (kind == -1) { if (sub == 0) { if (PHON(0)) phase_prologue(p, lds); } else { if (PHON(1)) phase_h0(p); } }
        else {
            const int ntail = (kind == 2) ? 4 : 5;
            if (sub < ntail) {
                if (kind == 0) {
                    if (sub == 0) { if (PHON(2)) phase_gemm_jobs(p, lds, jr * 7, jr * 7 + (jr ? 7 : 6)); }
                    else if (sub == 1) { if (PHON(3)) phase_rw2(p, jr); }
                    else if (sub == 2) { if (PHON(4)) {
#ifdef RW3_SCALAR
                        phase_rw3(p, jr, lds);
#else
                        phase_rw3c(p, jr, lds);
#endif
                    } }
                    else if (sub == 3) { if (PHON(5)) phase_zrw(p, jr); }
                    else { if (PHON(2)) phase_gemm_jobs(p, lds, 16 + jr, 17 + jr); }
                } else if (kind == 1) {
                    if (sub == 0) { if (PHON(2)) phase_gemm_jobs(p, lds, 14, 15); }
                    else if (sub == 1) { if (PHON(6)) phase_cml(p); }
                    else if (sub == 2) { if (PHON(6)) phase_ml2(p, lds); }
                    else if (sub == 3) { if (PHON(7)) phase_zml(p); }
                    else { if (PHON(2)) phase_gemm_jobs(p, lds, 18, 19); }
                } else {
                    if (sub == 0) { if (PHON(2)) phase_gemm_jobs(p, lds, 15, 16); }
                    else if (sub == 1) { if (PHON(8)) phase_rt2(p, lds); }
                    else if (sub == 2) { if (PHON(9)) phase_zrt(p); }
                    else { if (PHON(2)) phase_gemm_jobs(p, lds, 19, 20); }
                }
            } else {
                const int ts = sub - ntail;
                const bf16_t* ymix = (const bf16_t*)(S + (kind == 2 ? 1 : 6) * SLOT);
                bf16_t* hm = (bf16_t*)(S + (kind == 2 ? 2 : 7) * SLOT);
                bf16_t* H = (bf16_t*)(S + (kind == 0 ? 2 : (kind == 1 ? 5 : 3)) * SLOT);
                if (ts == 0) { if (PHON(10)) phase_ln1(p, L, lds, ymix, hm); }
                else if (ts == 1) { if (PHON(11)) phase_moe<0>(p, L, lds, hm, H); }
                else if (ts == 2) { if (PHON(12)) phase_moe<1>(p, L, lds, hm, H); }
                else { if (PHON(13)) phase_ln2(p, L); }
            }
        }
#ifdef DUP_PHASE
        if (((DUP_PHASE >> ph) & 1u) && !dup_done_) { dup_done_ = true; xcd_barrier(bar); --ph; continue; }
        dup_done_ = false;
#endif
        if (ph + 1 < ph_hi_) xcd_barrier(bar);
    }
#ifdef TIMEIT
    {
        xcd_barrier(bar);
        unsigned* tw = (unsigned*)(p.ws + OFF_CTL + 32768);
        if (blockIdx.x == 0 && threadIdx.x == 0) {
            if (t1_ == 0) t1_ = __builtin_amdgcn_s_memrealtime();
            const unsigned long long dt = t1_ - t0_;
            unsigned ms2 = (unsigned)((dt + TIME_U / 2) / TIME_U);
            __hip_atomic_store(tw, ms2, __ATOMIC_RELAXED, __HIP_MEMORY_SCOPE_AGENT);
        }
        xcd_barrier(bar);
        const float c_ = sqrtf((float)__hip_atomic_load(tw, __ATOMIC_RELAXED, __HIP_MEMORY_SCOPE_AGENT));
        for (size_t i = (size_t)blockIdx.x * 256 + threadIdx.x; i < (size_t)NTOK * DM; i += (size_t)gridDim.x * 256) p.out[i] = c_;
    }
#endif
#ifdef DBG_STOP
    if (ph_lo_ != 100) {
        xcd_barrier(bar);
        const float* src = (const float*)(p.ws + DBG_SRC);
        for (size_t i = (size_t)blockIdx.x * 256 + threadIdx.x; i < (size_t)NTOK * DM; i += (size_t)gridDim.x * 256) {
            float v = DBG_BF16 ? bf2f(((const bf16_t*)src)[i]) : src[i];
            if (!(fabsf(v) < 1e30f)) v = 1e30f;
            p.out[i] = v;
        }
    }
#endif
}

constexpr int LDS_BYTES = 73728 + 64;
extern "C" void kernel_launch(void* const* d_in, const int* in_sizes, int n_in, void* d_out, int out_size, void* d_ws, size_t ws_size, hipStream_t stream) {
    static int grid = 0;
    if (grid == 0) {
        if (n_in != 43 || out_size != NTOK * DM || ws_size < WS_NEED) { fprintf(stderr, "kernel_launch: unexpected shapes (n_in %d out %d ws %zu need %zu)\n", n_in, out_size, ws_size, (size_t)WS_NEED); }
        int dev = 0, cus = 0, per_cu = 0;
        (void)hipGetDevice(&dev); (void)hipDeviceGetAttribute(&cus, hipDeviceAttributeMultiprocessorCount, dev);
        (void)hipFuncSetAttribute((const void*)mega, hipFuncAttributeMaxDynamicSharedMemorySize, LDS_BYTES);
        (void)hipOccupancyMaxActiveBlocksPerMultiprocessor(&per_cu, (const void*)mega, 256, LDS_BYTES);
        if (per_cu > 2) per_cu = 2;
        if (per_cu < 1) per_cu = 1;
        grid = cus * per_cu;
        if (grid > 512) grid = 512;
        (void)hipGetLastError();
    }
    Params p{};
    for (int i = 0; i < 43; ++i) p.in[i] = (const float*)d_in[i];
    p.out = (float*)d_out; p.ws = (char*)d_ws;
    char* ws = (char*)d_ws;
    auto slot = [&](int i) { return (bf16_t*)(ws + OFF_SLOT + (size_t)i * SLOT); };
    int tile = 0;
    auto addg = [&](int idx, const bf16_t* A, const bf16_t* Bt, bf16_t* out, int K, int N, int ldo, int mode) {
        GJob& g = p.gj[idx]; g.A = A; g.Bt = Bt; g.out = out; g.K = K; g.N = N; g.ldo = ldo; g.mode = mode; g.ntn = (N + 127) / 128; g.tile0 = tile; tile += 128 * g.ntn;
    };
    for (int jr = 0; jr < 2; ++jr) {
        const bf16_t* rkv = (const bf16_t*)(ws + W_RKV) + (size_t)jr * 3 * 1024 * 1024;
        addg(jr * 7 + 0, slot(0), rkv, slot(6), 1024, 1024, 1024, MODE_BF16);
        addg(jr * 7 + 1, slot(1), rkv + 1024 * 1024, slot(7), 1024, 1024, 1024, MODE_BF16);
        addg(jr * 7 + 2, slot(2), rkv + 2 * 1024 * 1024, slot(jr == 0 ? 11 : 8), 1024, 1024, 1024, MODE_BF16);
        addg(jr * 7 + 3, slot(3), (const bf16_t*)(ws + W_W1T) + (size_t)jr * 64 * 1024, (bf16_t*)(ws + OFF_LW), 1024, 64, 64, MODE_TANH);
        addg(jr * 7 + 4, slot(4), (const bf16_t*)(ws + W_A1T) + (size_t)jr * 64 * 1024, (bf16_t*)(ws + OFF_LA), 1024, 64, 64, MODE_BF16);
        addg(jr * 7 + 5, slot(5), (const bf16_t*)(ws + W_G1T) + (size_t)jr * 128 * 1024, (bf16_t*)(ws + OFF_LG), 1024, 128, 128, MODE_SIGM);
        addg(jr * 7 + 6, slot(2), (const bf16_t*)(ws + W_V1T), (bf16_t*)(ws + OFF_LV), 1024, 32, 32, MODE_BF16);
    }
    addg(14, slot(0), (const bf16_t*)(ws + W_MLIN), nullptr, 1024, 3088, 0, MODE_ML1);
    addg(15, slot(0), (const bf16_t*)(ws + W_RTIN), nullptr, 1024, 6144, 0, MODE_RT1);
    addg(16, slot(7), (const bf16_t*)(ws + W_OUT), slot(6), 1024, 1024, 1024, MODE_BF16);
    addg(17, slot(7), (const bf16_t*)(ws + W_OUT) + 1024 * 1024, slot(6), 1024, 1024, 1024, MODE_BF16);
    addg(18, slot(1), (const bf16_t*)(ws + W_MLOUT), slot(6), 1024, 1024, 1024, MODE_BF16);
    addg(19, slot(3), (const bf16_t*)(ws + W_RTOUT), slot(1), 2048, 1024, 1024, MODE_BF16);
    int nc = 0, ctile = 0;
    auto addc = [&](const float* src, size_t dst_off, int K, int N, int nb, long sbs, long dbs, int mode) {
        CJob& c = p.cj[nc++]; c.src = src; c.dst = (bf16_t*)(ws + dst_off); c.K = K; c.N = N; c.nb = nb; c.mode = mode; c.sbs = sbs; c.dbs = dbs;
        c.tiles_pb = ((K + 63) / 64) * ((N + 255) / 256); c.tile0 = ctile; ctile += c.tiles_pb * nb;
    };
    addc(p.in[7], W_RKV, 1024, 1024, 6, 1024 * 1024, 1024 * 1024, 0);
    addc(p.in[24], W_OUT, 1024, 1024, 2, 1024 * 1024, 1024 * 1024, 0);
    addc(p.in[9], W_W1T, 1024, 64, 2, 1024 * 64, 64 * 1024, 0);
    addc(p.in[12], W_A1T, 1024, 64, 2, 1024 * 64, 64 * 1024, 0);
    addc(p.in[17], W_G1T, 1024, 128, 2, 1024 * 128, 128 * 1024, 0);
    addc(p.in[15], W_V1T, 1024, 32, 1, 0, 0, 0);
    addc(p.in[10], W_W2T, 64, 1024, 2, 64 * 1024, 1024 * 64, 0);
    addc(p.in[13], W_A2T, 64, 1024, 2, 64 * 1024, 1024 * 64, 0);
    addc(p.in[18], W_G2T, 128, 1024, 2, 128 * 1024, 1024 * 128, 0);
    addc(p.in[16], W_V2T, 32, 1024, 1, 0, 0, 0);
    addc(p.in[25], W_MLIN, 1024, 3088, 1, 0, 0, 0);
    addc(p.in[31], W_MLOUT, 1024, 1024, 1, 0, 0, 0);
    addc(p.in[32], W_RTIN, 1024, 6144, 1, 0, 0, 3);
    addc(p.in[35], W_RTOUT, 2048, 1024, 1, 0, 0, 0);
    addc(p.in[40], W_MOE13, 1024, 512, 128, 1024 * 512, 1024 * 1024, 1);
    addc(p.in[41], W_MOE13, 1024, 512, 128, 1024 * 512, 1024 * 1024, 2);
    addc(p.in[42], W_MOE2, 512, 1024, 128, 512 * 1024, 1024 * 512, 0);
    p.ncj = nc; p.cj_tiles = ctile;

    (void)hipMemsetAsync(ws + OFF_CTL, 0, CTL_BYTES, stream);
#ifdef DBG_STOP
    const int nph = DBG_STOP;
#else
    const int nph = NPHASE;
#endif
#ifdef MULTI_LAUNCH
    for (int ph = 0; ph < nph; ++ph) { p.ph_lo = ph; p.ph_hi = ph + 1; hipLaunchKernelGGL(mega, dim3(grid), dim3(256), LDS_BYTES, stream, p); }
    if (0)
#endif
    {
        p.ph_lo = 0; p.ph_hi = nph;
        void* args[] = {&p};
        hipError_t e = hipLaunchCooperativeKernel((const void*)mega, dim3(grid), dim3(256), args, LDS_BYTES, stream);
        if (e != hipSuccess) fprintf(stderr, "cooperative launch failed: %s (grid %d)\n", hipGetErrorString(e), grid);
    }
}
```

```cpp
#include <hip/hip_runtime.h>
#include <cstdio>
#include <cstdint>

#ifndef ONE_LAUNCH
#define ONE_LAUNCH 0
#endif

typedef unsigned short bf16_t;
typedef short bf16x8 __attribute__((ext_vector_type(8)));
typedef float f32x4 __attribute__((ext_vector_type(4)));
#define LAS __attribute__((address_space(3)))
#define GAS __attribute__((address_space(1)))
typedef float f32x4g_t __attribute__((ext_vector_type(4)));
typedef unsigned u32x2g_t __attribute__((ext_vector_type(2)));
typedef unsigned u32x4g_t __attribute__((ext_vector_type(4)));
__device__ __forceinline__ float4 gld_f4(const float* p) { const f32x4g_t v = *(const GAS f32x4g_t*)(const GAS char*)(const char*)p; return make_float4(v[0], v[1], v[2], v[3]); }
__device__ __forceinline__ uint2 gld_u2(const void* p) { const u32x2g_t v = *(const GAS u32x2g_t*)(const GAS char*)(const char*)p; return make_uint2(v[0], v[1]); }
__device__ __forceinline__ uint4 gld_u4(const void* p) { const u32x4g_t v = *(const GAS u32x4g_t*)(const GAS char*)(const char*)p; return make_uint4(v[0], v[1], v[2], v[3]); }
__device__ __forceinline__ void gst_f4(float* p, float a, float b, float c, float d) { const f32x4g_t v = {a, b, c, d}; *(GAS f32x4g_t*)(GAS char*)(char*)p = v; }
__device__ __forceinline__ void gst_u2(void* p, unsigned a, unsigned b) { const u32x2g_t v = {a, b}; *(GAS u32x2g_t*)(GAS char*)(char*)p = v; }
__device__ __forceinline__ void gst_u4(void* p, unsigned a, unsigned b, unsigned c, unsigned d) { const u32x4g_t v = {a, b, c, d}; *(GAS u32x4g_t*)(GAS char*)(char*)p = v; }

constexpr int NTOK = 16384, DM = 1024, TSEQ = 2048, NBATCH = 8;
constexpr float DN_ALPHA = 1.681792830507429f;
constexpr float LN_EPS = 1e-5f;
constexpr size_t MB = 1u << 20;
constexpr size_t OFF_CTL = 0, OFF_CNT = 16384, CTL_BYTES = 65536;
constexpr size_t OFF_MOD = 65536;
constexpr size_t OFF_ROT = 1 * MB;
constexpr size_t OFF_BONUS = 3 * MB, OFF_GATES = 4 * MB, OFF_STAT = 5 * MB, OFF_LW = 13 * MB, OFF_LA = 15 * MB, OFF_LG = 17 * MB, OFF_LV = 21 * MB,
                 OFF_WGT = 22 * MB, OFF_LIST = 23 * MB, OFF_RTW = 25 * MB;
constexpr size_t OFF_W = 32 * MB;
constexpr size_t W_RKV = OFF_W, W_OUT = W_RKV + 12 * MB, W_W1T = W_OUT + 4 * MB, W_A1T = W_W1T + 256 * 1024, W_G1T = W_A1T + 256 * 1024, W_V1T = W_G1T + 512 * 1024,
                 W_W2T = W_V1T + 64 * 1024, W_A2T = W_W2T + 256 * 1024, W_G2T = W_A2T + 256 * 1024, W_V2T = W_G2T + 512 * 1024, W_MLIN = W_V2T + 64 * 1024 + 832 * 1024,
                 W_MLOUT = W_MLIN + 6400 * 1024, W_RTIN = W_MLOUT + 2 * MB, W_RTOUT = W_RTIN + 12 * MB, W_MOE13 = W_RTOUT + 4 * MB, W_MOE2 = W_MOE13 + 256 * MB,
                 W_END = W_MOE2 + 128 * MB;
constexpr size_t OFF_XRES = 464 * MB;
constexpr size_t OFF_SLOT = 528 * MB, SLOT = 32 * MB;
static_assert(W_END <= OFF_XRES, "weights overflow");
constexpr size_t OFF_XRES2 = OFF_SLOT + 12 * SLOT;
constexpr size_t WS_NEED = OFF_XRES2 + 2 * SLOT;
constexpr int LIST_CAP = 16384;

#define XB_TMO      128
#define XB_XCNT(j)  (256  + 64 * (j))
#define XB_XSUB(j)  (1280 + 64 * (j))
#define XB_XGEN(j)  (2304 + 64 * (j))
#define XB_TOP      3328
#define XB_TOPGEN   3392
#define XCD_BAR_WORDS 3456
#define XB_SPIN_CAP (1u << 22)
__device__ __forceinline__ unsigned xb_ld(unsigned* p)              { return __hip_atomic_load(p, __ATOMIC_RELAXED, __HIP_MEMORY_SCOPE_AGENT); }
__device__ __forceinline__ unsigned xb_add(unsigned* p, unsigned v) { return __hip_atomic_fetch_add(p, v, __ATOMIC_RELAXED, __HIP_MEMORY_SCOPE_AGENT); }
__device__ __forceinline__ unsigned xb_xcc_id() { return (unsigned)__builtin_amdgcn_s_getreg((3 << 11) | 20) & 0xFu; }
#define XB_SPIN(cond, bar) do { unsigned _sp = 0; while (cond) { __builtin_amdgcn_s_sleep(1); \
    if ((++_sp & 255u) == 0u) { if (xb_ld(&(bar)[XB_TMO])) break; if (_sp > XB_SPIN_CAP) { atomicAdd(&(bar)[XB_TMO], 1u); break; } } } } while (0)
struct XcdBarrier { unsigned* bar; unsigned x; volatile LAS unsigned* st; };
__device__ __forceinline__ XcdBarrier xcd_barrier_post(unsigned* bar, volatile LAS unsigned* st) {
    XcdBarrier b; b.bar = bar; b.x = xb_xcc_id(); b.st = st;
    if (threadIdx.x == 0) (void)xb_add(&bar[XB_XCNT(b.x)], 1u);
    return b;
}
__device__ __forceinline__ void xcd_barrier_complete(unsigned* bar, unsigned x, unsigned& nloc, unsigned& nx) {
    const unsigned G = gridDim.x;
    unsigned sum, cnt, mine, sp = 0u;
    for (;;) {
        sum = 0u; cnt = 0u; mine = 0u;
#pragma unroll
        for (unsigned j = 0; j < 16; ++j) { const unsigned c = xb_ld(&bar[XB_XCNT(j)]); sum += c; cnt += (c > 0u) ? 1u : 0u; mine = (j == x) ? c : mine; }
        if (sum == G) break;
        __builtin_amdgcn_s_sleep(1);
        if ((++sp & 255u) == 0u) { if (xb_ld(&bar[XB_TMO])) break; if (sp > XB_SPIN_CAP) { atomicAdd(&bar[XB_TMO], 1u); break; } }
    }
    nloc = mine > 0u ? mine : 1u; nx = cnt > 0u ? cnt : 1u;
}
__device__ __forceinline__ void xcd_barrier(const XcdBarrier& b) {
    asm volatile("s_waitcnt vmcnt(0)" ::: "memory");
    __syncthreads();
    if (threadIdx.x == 0) {
        unsigned* bar = b.bar;
        __builtin_amdgcn_s_waitcnt(0);
        unsigned nloc = b.st[0], nx = b.st[1];
        if (nloc == 0u) { xcd_barrier_complete(bar, b.x, nloc, nx); b.st[0] = nloc; b.st[1] = nx; }
        const unsigned old = xb_add(&bar[XB_XSUB(b.x)], 1u);
        const unsigned gen = old / nloc;
        if (old + 1u == (gen + 1u) * nloc) {
            __builtin_amdgcn_fence(__ATOMIC_RELEASE, "agent");
            asm volatile("s_waitcnt vmcnt(0)" ::: "memory");
            const unsigned og = xb_add(&bar[XB_TOP], 1u);
            const unsigned tg = og / nx;
            if (og + 1u == (tg + 1u) * nx) xb_add(&bar[XB_TOPGEN], 1u);
            else XB_SPIN(xb_ld(&bar[XB_TOPGEN]) == tg, bar);
            __builtin_amdgcn_fence(__ATOMIC_ACQUIRE, "agent");
            xb_add(&bar[XB_XGEN(b.x)], 1u);
            asm volatile("s_waitcnt vmcnt(0)" ::: "memory");
        } else {
            XB_SPIN(xb_ld(&bar[XB_XGEN(b.x)]) == gen, bar);
            __builtin_amdgcn_fence(__ATOMIC_ACQUIRE, "agent");
            asm volatile("s_waitcnt vmcnt(0)" ::: "memory");
        }
    }
    __syncthreads();
}

__device__ __forceinline__ int tidx() { int t = threadIdx.x; asm volatile("" : "+v"(t)); return t; }
typedef __bf16 bf16x2_t __attribute__((ext_vector_type(2)));
typedef float f32x2_t __attribute__((ext_vector_type(2)));
__device__ __forceinline__ unsigned cvt_pk(float lo, float hi) {
    f32x2_t v = {lo, hi}; bf16x2_t r = __builtin_convertvector(v, bf16x2_t);
    unsigned u; __builtin_memcpy(&u, &r, 4); return u;
}
__device__ __forceinline__ bf16_t f2bf(float f) { return (bf16_t)(cvt_pk(f, 0.f) & 0xffffu); }
__device__ __forceinline__ float bflo(unsigned u) { return __uint_as_float(u << 16); }
__device__ __forceinline__ float bfhi(unsigned u) { return __uint_as_float(u & 0xffff0000u); }
__device__ __forceinline__ float bf2f(bf16_t u) { return __uint_as_float(((unsigned)u) << 16); }
__device__ __forceinline__ void unpack8(const uint4& u, float (&f)[8]) {
    f[0] = bflo(u.x); f[1] = bfhi(u.x); f[2] = bflo(u.y); f[3] = bfhi(u.y); f[4] = bflo(u.z); f[5] = bfhi(u.z); f[6] = bflo(u.w); f[7] = bfhi(u.w);
}
__device__ __forceinline__ uint4 pack8(const float (&f)[8]) { uint4 u; u.x = cvt_pk(f[0], f[1]); u.y = cvt_pk(f[2], f[3]); u.z = cvt_pk(f[4], f[5]); u.w = cvt_pk(f[6], f[7]); return u; }
typedef unsigned u32x4_t __attribute__((ext_vector_type(4)));
__device__ __forceinline__ uint4 gload16(const void* p) {
    const u32x4_t v = *(const __attribute__((address_space(1))) u32x4_t*)p;
    return make_uint4(v[0], v[1], v[2], v[3]);
}
__device__ __forceinline__ float sigmoidf_(float x) { return __builtin_amdgcn_rcpf(1.0f + __expf(-x)); }
__device__ __forceinline__ float siluf_(float x) { return x * __builtin_amdgcn_rcpf(1.0f + __expf(-x)); }
__device__ __forceinline__ float tanhf_(float x) { return 1.0f - 2.0f * __builtin_amdgcn_rcpf(1.0f + __expf(2.0f * x)); }
__device__ __forceinline__ float softplusf_(float x) { return fmaxf(x, 0.f) + __logf(1.0f + __expf(-fabsf(x))); }
__device__ __forceinline__ float row16_sum(float v);
__device__ __forceinline__ float wave_sum(float v) {
    v = row16_sum(v); v += __shfl_xor(v, 16); v += __shfl_xor(v, 32);
    return v;
}
__device__ __forceinline__ float row16_sum(float v) {
    v += __builtin_amdgcn_update_dpp(0.f, v, 0x128, 0xf, 0xf, false);
    v += __builtin_amdgcn_update_dpp(0.f, v, 0x124, 0xf, 0xf, false);
    v += __builtin_amdgcn_update_dpp(0.f, v, 0x122, 0xf, 0xf, false);
    v += __builtin_amdgcn_update_dpp(0.f, v, 0x121, 0xf, 0xf, false);
    return v;
}
__device__ __forceinline__ float oct_sum(float v) {
    v += __builtin_amdgcn_update_dpp(0.f, v, 0xB1, 0xf, 0xf, false);
    v += __builtin_amdgcn_update_dpp(0.f, v, 0x4E, 0xf, 0xf, false);
    v += __builtin_amdgcn_update_dpp(0.f, v, 0x141, 0xf, 0xf, false);
    return v;
}

enum { MODE_BF16 = 0, MODE_TANH = 1, MODE_SIGM = 2, MODE_ML1 = 3, MODE_RT1 = 4 };
struct GJob { const bf16_t* A; const bf16_t* Bt; bf16_t* out; int K, N, ldo, mode, ntn, tile0; };
struct CJob { const float* src; bf16_t* dst; int K, N, nb, mode; long sbs, dbs; int tiles_pb, tile0; };
constexpr int NGJ = 20, NCJ = 24;
struct Params {
    const float* in[43]; float* out; char* ws;
    int ph_lo, ph_hi, ncj, cj_tiles;
    GJob gj[NGJ];
    CJob cj[NCJ];
};
#define CAS __attribute__((address_space(4)))
typedef const CAS Params& PRef;

__device__ __forceinline__ f32x4 mfma16(const uint4& a, const uint4& b, f32x4 c) {
    bf16x8 av, bv; __builtin_memcpy(&av, &a, 16); __builtin_memcpy(&bv, &b, 16);
    return __builtin_amdgcn_mfma_f32_16x16x32_bf16(av, bv, c, 0, 0, 0);
}
template <bool PFA = true, class AL, class BL>
__device__ __forceinline__ void gemm_mainloop(char* lds, int nk, const AL& al, const BL& bl, f32x4 (&acc)[4][4]) {
    const int t = tidx(), c = t & 7, r0 = t >> 3;
    const int lane = t & 63, wid = t >> 6, wr = wid >> 1, wc = wid & 1, fr = lane & 15, fq = lane >> 4;
    typename AL::Raw ra[4]; typename BL::Raw rb[4];
    const int woff = r0 * 128 + ((c ^ (r0 & 7)) << 4);
#pragma unroll
    for (int i = 0; i < 4; ++i) { if (PFA) ra[i] = al.fetch(i, r0 + 32 * i, c); rb[i] = bl.fetch(i, r0 + 32 * i, c); }
#pragma unroll
    for (int i = 0; i < 4; ++i) {
        if (!PFA) { ra[i] = al.fetch(i, r0 + 32 * i, c); }
        *(uint4*)(lds + woff + i * 4096) = al.finish(ra[i], i, r0 + 32 * i, c);
        *(uint4*)(lds + 16384 + woff + i * 4096) = bl.finish(rb[i], i, r0 + 32 * i, c);
        if (!PFA) asm volatile("" ::: "memory");
    }
#pragma unroll
    for (int m = 0; m < 4; ++m)
#pragma unroll
        for (int n = 0; n < 4; ++n) acc[m][n] = (f32x4){0.f, 0.f, 0.f, 0.f};
    __syncthreads();
    const int aoff = (wr * 64 + fr) * 128, boff = 16384 + (wc * 64 + fr) * 128, sw = fr & 7;
    for (int kt = 0; kt < nk; ++kt) {
        const bool more = (kt + 1 < nk);
        if (more) {
#pragma unroll
            for (int i = 0; i < 4; ++i) { if (PFA) ra[i] = al.fetch(i, r0 + 32 * i, (kt + 1) * 8 + c); rb[i] = bl.fetch(i, r0 + 32 * i, (kt + 1) * 8 + c); }
        }
        const char* buf = lds + (kt & 1) * 32768;
#pragma unroll
        for (int ks = 0; ks < 2; ++ks) {
            uint4 af[4], bfm[4];
            const int ch = ((ks * 4 + fq) ^ sw) << 4;
#pragma unroll
            for (int m = 0; m < 4; ++m) af[m] = *(const uint4*)(buf + aoff + m * 2048 + ch);
#pragma unroll
            for (int n = 0; n < 4; ++n) bfm[n] = *(const uint4*)(buf + boff + n * 2048 + ch);
#pragma unroll
            for (int m = 0; m < 4; ++m)
#pragma unroll
                for (int n = 0; n < 4; ++n) acc[m][n] = mfma16(bfm[n], af[m], acc[m][n]);
        }
        if (more) {
            char* nb = lds + ((kt + 1) & 1) * 32768;
#pragma unroll
            for (int i = 0; i < 4; ++i) {
                if (!PFA) ra[i] = al.fetch(i, r0 + 32 * i, (kt + 1) * 8 + c);
                *(uint4*)(nb + woff + i * 4096) = al.finish(ra[i], i, r0 + 32 * i, (kt + 1) * 8 + c);
                *(uint4*)(nb + 16384 + woff + i * 4096) = bl.finish(rb[i], i, r0 + 32 * i, (kt + 1) * 8 + c);
                if (!PFA) asm volatile("" ::: "memory");
            }
        }
        __syncthreads();
    }
}
__device__ __forceinline__ void glds16(const bf16_t* g, char* l) {
    __builtin_amdgcn_global_load_lds((const unsigned*)g, (LAS unsigned*)l, 16, 0, 0);
}
__device__ __forceinline__ void glds16_asm(const void* gsrc, unsigned lds_dst) {
    unsigned keep;
    asm volatile("s_mov_b32 %0, m0\n\ts_mov_b32 m0, %2\n\ts_nop 0\n\tglobal_load_lds_dwordx4 %1, off\n\ts_mov_b32 m0, %0" : "=&s"(keep) : "v"(gsrc), "s"(lds_dst) : "memory");
}
__device__ __forceinline__ unsigned lds_addr_u(const char* l) { return (unsigned)(size_t)(const LAS char*)l; }
__device__ __forceinline__ int glds_chunk(int t) { return (t & 7) ^ ((t >> 3) & 7); }
__device__ __forceinline__ void mma_ktile(const char* buf, int aoff, int boff, int sw, int fq, f32x4 (&acc)[4][4]) {
    const int ch0 = ((0 * 4 + fq) ^ sw) << 4, ch1 = ((1 * 4 + fq) ^ sw) << 4;
    const char* pa = buf + aoff; const char* pb = buf + boff;
    uint4 a0[4], a1[4], b[8];
#pragma unroll
    for (int m = 0; m < 4; ++m) a0[m] = *(const uint4*)(pa + m * 2048 + ch0);
    b[0] = *(const uint4*)(pb + ch0); b[1] = *(const uint4*)(pb + 2048 + ch0);
    __builtin_amdgcn_sched_barrier(0);
    b[2] = *(const uint4*)(pb + 2 * 2048 + ch0);
#pragma unroll
    for (int m = 0; m < 4; ++m) acc[m][0] = mfma16(b[0], a0[m], acc[m][0]);
    __builtin_amdgcn_sched_barrier(0);
    b[3] = *(const uint4*)(pb + 3 * 2048 + ch0);
#pragma unroll
    for (int m = 0; m < 4; ++m) acc[m][1] = mfma16(b[1], a0[m], acc[m][1]);
    __builtin_amdgcn_sched_barrier(0);
#pragma unroll
    for (int m = 0; m < 4; ++m) a1[m] = *(const uint4*)(pa + m * 2048 + ch1);
#pragma unroll
    for (int m = 0; m < 4; ++m) acc[m][2] = mfma16(b[2], a0[m], acc[m][2]);
    __builtin_amdgcn_sched_barrier(0);
    b[4] = *(const uint4*)(pb + ch1); b[5] = *(const uint4*)(pb + 2048 + ch1);
#pragma unroll
    for (int m = 0; m < 4; ++m) acc[m][3] = mfma16(b[3], a0[m], acc[m][3]);
    __builtin_amdgcn_sched_barrier(0);
    b[6] = *(const uint4*)(pb + 2 * 2048 + ch1);
#pragma unroll
    for (int m = 0; m < 4; ++m) acc[m][0] = mfma16(b[4], a1[m], acc[m][0]);
    __builtin_amdgcn_sched_barrier(0);
    b[7] = *(const uint4*)(pb + 3 * 2048 + ch1);
#pragma unroll
    for (int m = 0; m < 4; ++m) acc[m][1] = mfma16(b[5], a1[m], acc[m][1]);
    __builtin_amdgcn_sched_barrier(0);
#pragma unroll
    for (int m = 0; m < 4; ++m) acc[m][2] = mfma16(b[6], a1[m], acc[m][2]);
#pragma unroll
    for (int m = 0; m < 4; ++m) acc[m][3] = mfma16(b[7], a1[m], acc[m][3]);
}
__device__ __forceinline__ void gemm_gg(char* lds, int nk, const bf16_t* const (&ar)[4], const bf16_t* const (&br)[4], f32x4 (&acc)[4][4]) {
    const int t = tidx();
    const int lane = t & 63, wid = t >> 6, wr = wid >> 1, wc = wid & 1, fr = lane & 15, fq = lane >> 4;
    const unsigned wbs = (unsigned)__builtin_amdgcn_readfirstlane((int)(lds_addr_u(lds) + wid * 1024));
#pragma unroll
    for (int i = 0; i < 4; ++i) { glds16_asm(ar[i], wbs + i * 4096); glds16_asm(br[i], wbs + 16384 + i * 4096); }
#pragma unroll
    for (int m = 0; m < 4; ++m)
#pragma unroll
        for (int n = 0; n < 4; ++n) acc[m][n] = (f32x4){0.f, 0.f, 0.f, 0.f};
    asm volatile("s_waitcnt vmcnt(0)" ::: "memory");
    __syncthreads();
    const int aoff = (wr * 64 + fr) * 128, boff = 16384 + (wc * 64 + fr) * 128, sw = fr & 7;
    for (int kt = 0; kt < nk; ++kt) {
        if (kt + 1 < nk) {
            const unsigned nb = (unsigned)__builtin_amdgcn_readfirstlane((int)(wbs + ((kt + 1) & 1) * 32768));
#pragma unroll
            for (int i = 0; i < 4; ++i) { glds16_asm(ar[i] + (kt + 1) * 64, nb + i * 4096); glds16_asm(br[i] + (kt + 1) * 64, nb + 16384 + i * 4096); }
        }
        mma_ktile(lds + (kt & 1) * 32768, aoff, boff, sw, fq, acc);
        asm volatile("s_waitcnt vmcnt(0)" ::: "memory");
        __syncthreads();
    }
}
__device__ __forceinline__ void gemm_hn(char* lds, int nk, const bf16_t* const (&ar)[4], const bf16_t* const (&br)[2], f32x4 (&acc)[2][4]) {
    const int t = tidx();
    const int lane = t & 63, wid = t >> 6, fr = lane & 15, fq = lane >> 4;
    const unsigned wbs = (unsigned)__builtin_amdgcn_readfirstlane((int)(lds_addr_u(lds) + wid * 1024));
#pragma unroll
    for (int i = 0; i < 4; ++i) glds16_asm(ar[i], wbs + i * 4096);
#pragma unroll
    for (int i = 0; i < 2; ++i) glds16_asm(br[i], wbs + 16384 + i * 4096);
#pragma unroll
    for (int m = 0; m < 2; ++m)
#pragma unroll
        for (int n = 0; n < 4; ++n) acc[m][n] = (f32x4){0.f, 0.f, 0.f, 0.f};
    asm volatile("s_waitcnt vmcnt(0)" ::: "memory");
    __syncthreads();
    const int aoff = (wid * 32 + fr) * 128, boff = 16384 + fr * 128, sw = fr & 7;
    for (int kt = 0; kt < nk; ++kt) {
        if (kt + 1 < nk) {
            const unsigned nb = (unsigned)__builtin_amdgcn_readfirstlane((int)(wbs + ((kt + 1) & 1) * 32768));
#pragma unroll
            for (int i = 0; i < 4; ++i) glds16_asm(ar[i] + (kt + 1) * 64, nb + i * 4096);
#pragma unroll
            for (int i = 0; i < 2; ++i) glds16_asm(br[i] + (kt + 1) * 64, nb + 16384 + i * 4096);
        }
        const char* buf = lds + (kt & 1) * 32768;
#pragma unroll
        for (int ks = 0; ks < 2; ++ks) {
            const int ch = ((ks * 4 + fq) ^ sw) << 4;
            uint4 af[2], bfm[4];
#pragma unroll
            for (int m = 0; m < 2; ++m) af[m] = *(const uint4*)(buf + aoff + m * 2048 + ch);
#pragma unroll
            for (int n = 0; n < 4; ++n) bfm[n] = *(const uint4*)(buf + boff + n * 2048 + ch);
#pragma unroll
            for (int m = 0; m < 2; ++m)
#pragma unroll
                for (int n = 0; n < 4; ++n) acc[m][n] = mfma16(bfm[n], af[m], acc[m][n]);
        }
        asm volatile("s_waitcnt vmcnt(0)" ::: "memory");
        __syncthreads();
    }
}
template <class AL>
__device__ __forceinline__ void gemm_rg(char* lds, int nk, const AL& al, const bf16_t* const (&br)[4], f32x4 (&acc)[4][4]) {
    const int t = tidx(), c = t & 7, r0 = t >> 3;
    const int lane = t & 63, wid = t >> 6, wr = wid >> 1, wc = wid & 1, fr = lane & 15, fq = lane >> 4;
    char* wb = lds + wid * 1024;
    const int woff = r0 * 128 + ((c ^ (r0 & 7)) << 4);
#pragma unroll
    for (int i = 0; i < 4; ++i) glds16(br[i], wb + 16384 + i * 4096);
#pragma unroll
    for (int i = 0; i < 4; ++i) {
        typename AL::Raw ra = al.fetch(i, r0 + 32 * i, c);
        *(uint4*)(lds + woff + i * 4096) = al.finish(ra, i, r0 + 32 * i, c);
        asm volatile("" ::: "memory");
    }
#pragma unroll
    for (int m = 0; m < 4; ++m)
#pragma unroll
        for (int n = 0; n < 4; ++n) acc[m][n] = (f32x4){0.f, 0.f, 0.f, 0.f};
    asm volatile("s_waitcnt vmcnt(0)" ::: "memory");
    __syncthreads();
    const int aoff = (wr * 64 + fr) * 128, boff = 16384 + (wc * 64 + fr) * 128, sw = fr & 7;
    for (int kt = 0; kt < nk; ++kt) {
        const bool more = (kt + 1 < nk);
        char* nbuf = lds + ((kt + 1) & 1) * 32768;
        if (more) {
#pragma unroll
            for (int i = 0; i < 4; ++i) glds16(br[i] + (kt + 1) * 64, nbuf + wid * 1024 + 16384 + i * 4096);
        }
        mma_ktile(lds + (kt & 1) * 32768, aoff, boff, sw, fq, acc);
        if (more) {
#pragma unroll
            for (int i = 0; i < 4; ++i) {
                typename AL::Raw ra = al.fetch(i, r0 + 32 * i, (kt + 1) * 8 + c);
                *(uint4*)(nbuf + woff + i * 4096) = al.finish(ra, i, r0 + 32 * i, (kt + 1) * 8 + c);
                asm volatile("" ::: "memory");
            }
        }
        asm volatile("s_waitcnt vmcnt(0)" ::: "memory");
        __syncthreads();
    }
}
struct LdPlain {
    typedef uint4 Raw;
    const bf16_t* p; int ld; int nvalid;
    __device__ __forceinline__ uint4 fetch(int, int r, int kc) const { return (r < nvalid) ? *(const uint4*)(p + (size_t)r * ld + kc * 8) : make_uint4(0u, 0u, 0u, 0u); }
    __device__ __forceinline__ uint4 finish(const uint4& v, int, int, int) const { return v; }
};
struct LdGather {
    typedef uint4 Raw;
    const bf16_t* rp[4];
    __device__ __forceinline__ uint4 fetch(int i, int, int kc) const { const bf16_t* q = rp[i]; return q ? *(const uint4*)(q + kc * 8) : make_uint4(0u, 0u, 0u, 0u); }
    __device__ __forceinline__ uint4 finish(const uint4& v, int, int, int) const { return v; }
};
__device__ __forceinline__ void tile_map(int id, int NT, int& mt, int& nt) {
    const int x = id & 7, q = id >> 3;
    const int mg = q / (8 * NT), q2 = q - mg * 8 * NT, G = (NT + 7) >> 3;
    int g = q2 >> 6; g = g < G - 1 ? g : G - 1;
    const int r = q2 - (g << 6), w = (g == G - 1) ? NT - 8 * g : 8;
    mt = (mg * 8 + r / w) * 8 + x; nt = 8 * g + r % w;
}

__device__ __forceinline__ int conv_row(int mode, int n) {
    if (mode == 1) return (n >> 4) * 32 + (n & 15);
    if (mode == 2) return (n >> 4) * 32 + 16 + (n & 15);
    if (mode == 3 && n < 2048) { const int c = n & 255, c2 = c & 127; return (n & ~255) + (c2 >> 4) * 32 + ((c >> 7) << 4) + (c2 & 15); }
    return n;
}
__device__ __forceinline__ void phase_prologue(PRef p, char* lds) {
    const int t = tidx();
    const int n_ada = 8 * 48, n_rot = 256 + 144;
    float* mod = (float*)(p.ws + OFF_MOD);
    for (int it = blockIdx.x; it < n_ada + n_rot; it += gridDim.x) {
        if (it < n_ada) {
            const int pr = it / 48, cb = it % 48;
            float* sc = (float*)lds;
            float* red = (float*)(lds + 32768);
            for (int i = t; i < 8192; i += 256) { const int b = i >> 10, k = i & 1023; sc[k * 8 + b] = siluf_(p.in[1][b * 1024 + k]); }
            __syncthreads();
            const int kg = t >> 6, cl = t & 63, col = cb * 64 + cl;
            const float* W = p.in[2] + (size_t)pr * 1024 * 3072 + col;
            float a[8] = {0, 0, 0, 0, 0, 0, 0, 0};
#pragma unroll 8
            for (int k = kg * 256; k < kg * 256 + 256; ++k) {
                const float w = W[(size_t)k * 3072];
                const float4 s0 = *(const float4*)(sc + k * 8), s1 = *(const float4*)(sc + k * 8 + 4);
                a[0] += w * s0.x; a[1] += w * s0.y; a[2] += w * s0.z; a[3] += w * s0.w; a[4] += w * s1.x; a[5] += w * s1.y; a[6] += w * s1.z; a[7] += w * s1.w;
            }
#pragma unroll
            for (int b = 0; b < 8; ++b) red[(kg * 8 + b) * 64 + cl] = a[b];
            __syncthreads();
            for (int i = t; i < 512; i += 256) {
                const int b = i >> 6, c2 = i & 63;
                const float s = red[(0 * 8 + b) * 64 + c2] + red[(1 * 8 + b) * 64 + c2] + red[(2 * 8 + b) * 64 + c2] + red[(3 * 8 + b) * 64 + c2];
                mod[((size_t)pr * 8 + b) * 3072 + cb * 64 + c2] = s + p.in[3][pr * 3072 + cb * 64 + c2];
            }
            __syncthreads();
        } else if (it >= n_ada + 256 && it < n_ada + n_rot) {
            float* rtw = (float*)(p.ws + OFF_RTW);
            const int base = (it - n_ada - 256) * 1024;
            for (int e = base + t; e < base + 1024; e += 256) {
                const int L = e / (36 * 1024), o = (e >> 10) % 36, k = e & 1023;
                rtw[e] = (o < 4) ? p.in[36][((size_t)L * 1024 + k) * 4 + o] : p.in[38][((size_t)L * 1024 + k) * 32 + (o - 4)];
            }
        } else if (it < n_ada + 256) {
            float* rot = (float*)(p.ws + OFF_ROT);
            const int base = (it - n_ada) * 1024;
            for (int e = base + t; e < base + 1024; e += 256) {
                const int tt = e >> 7, i = e & 127;
                const float inv = __builtin_amdgcn_exp2f(-(float)i * (13.287712379549449f / 127.0f));
                const float ang = (float)tt * inv;
                float rev = ang * 0.15915494309189535f; rev -= floorf(rev);
                rot[e * 2] = __builtin_amdgcn_cosf(rev); rot[e * 2 + 1] = __builtin_amdgcn_sinf(rev);
            }
        }
    }
    {
        float* sm = (float*)lds;
        const int lane = t & 63, wv = t >> 6;
        const float* nsrc = nullptr; bf16_t* ndst = nullptr; int nK = 0, nN = 0, nmode = 0, nkt = 0, nnt = 0;
        float4 pv[16];
#define CJ_SETUP(ct_) { int c_ = (ct_), j_ = 0; while (j_ + 1 < p.ncj && c_ >= p.cj[j_ + 1].tile0) ++j_; \
            c_ -= p.cj[j_].tile0; const int tpb_ = p.cj[j_].tiles_pb; const int bi_ = c_ / tpb_, tl_ = c_ % tpb_; nK = p.cj[j_].K; nN = p.cj[j_].N; nmode = p.cj[j_].mode; \
            const int nNt_ = (nN + 255) >> 8; nkt = tl_ / nNt_; nnt = tl_ % nNt_; nsrc = p.cj[j_].src + (size_t)bi_ * p.cj[j_].sbs; ndst = p.cj[j_].dst + (size_t)bi_ * p.cj[j_].dbs; }
#define CJ_LOAD() { _Pragma("unroll") for (int i = 0; i < 16; ++i) { const int k = nkt * 64 + wv + 4 * i, n = nnt * 256 + lane * 4; \
            pv[i] = (k < nK && n < nN) ? gld_f4(nsrc + (size_t)k * nN + n) : make_float4(0.f, 0.f, 0.f, 0.f); } }
        int* const tick = (int*)(p.ws + OFF_CTL + 20480);
        int* const nbox = (int*)(lds + 66560);
        int ct = (int)blockIdx.x, ct2 = (int)gridDim.x + (int)blockIdx.x;
        if (ct < p.cj_tiles) { CJ_SETUP(ct); CJ_LOAD(); }
        while (ct < p.cj_tiles) {
#pragma unroll
            for (int i = 0; i < 16; ++i) *(float4*)(sm + (wv + 4 * i) * 260 + lane * 4) = pv[i];
            bf16_t* const sdst = ndst; const int sK = nK, sN = nN, smode = nmode, skt = nkt, snt = nnt;
            if (ct2 < p.cj_tiles) { CJ_SETUP(ct2); CJ_LOAD(); }
            if (t == 0) *nbox = 2 * (int)gridDim.x + atomicAdd(tick, 1);
            __syncthreads();
            const int ct3 = *nbox;
#pragma unroll
            for (int h2 = 0; h2 < 4; ++h2) {
                const int nl = lane + 64 * h2, n = snt * 256 + nl, k0 = skt * 64 + wv * 16;
                if (n < sN && k0 < sK) {
                    float f[8], g[8];
#pragma unroll
                    for (int q = 0; q < 8; ++q) { f[q] = sm[(wv * 16 + q) * 260 + nl]; g[q] = sm[(wv * 16 + 8 + q) * 260 + nl]; }
                    bf16_t* d = sdst + (size_t)conv_row(smode, n) * sK + k0;
                    { const uint4 u0 = pack8(f), u1 = pack8(g); gst_u4(d, u0.x, u0.y, u0.z, u0.w); gst_u4(d + 8, u1.x, u1.y, u1.z, u1.w); }
                }
            }
            __syncthreads();
            ct = ct2; ct2 = ct3;
        }
#undef CJ_SETUP
#undef CJ_LOAD
    }
}

__device__ __forceinline__ void row_load_f32(const float* p, float (&v)[16], int lane) {
#pragma unroll
    for (int c = 0; c < 4; ++c) { const float4 x = gld_f4(p + c * 256 + lane * 4); v[c * 4] = x.x; v[c * 4 + 1] = x.y; v[c * 4 + 2] = x.z; v[c * 4 + 3] = x.w; }
}
__device__ __forceinline__ void row_load_f32_l(const float* p, float (&v)[16], int lane) {
#pragma unroll
    for (int c = 0; c < 4; ++c) { const float4 x = *(const float4*)(p + c * 256 + lane * 4); v[c * 4] = x.x; v[c * 4 + 1] = x.y; v[c * 4 + 2] = x.z; v[c * 4 + 3] = x.w; }
}
__device__ __forceinline__ void row_load_bf16(const bf16_t* p, float (&v)[16], int lane) {
#pragma unroll
    for (int c = 0; c < 4; ++c) { const uint2 x = gld_u2(p + c * 256 + lane * 4); v[c * 4] = bflo(x.x); v[c * 4 + 1] = bfhi(x.x); v[c * 4 + 2] = bflo(x.y); v[c * 4 + 3] = bfhi(x.y); }
}
__device__ __forceinline__ void row_store_bf16(bf16_t* p, const float (&v)[16], int lane) {
#pragma unroll
    for (int c = 0; c < 4; ++c) gst_u2(p + c * 256 + lane * 4, cvt_pk(v[c * 4], v[c * 4 + 1]), cvt_pk(v[c * 4 + 2], v[c * 4 + 3]));
}
__device__ __forceinline__ void row_store_f32(float* p, const float (&v)[16], int lane) {
#pragma unroll
    for (int c = 0; c < 4; ++c) gst_f4(p + c * 256 + lane * 4, v[c * 4], v[c * 4 + 1], v[c * 4 + 2], v[c * 4 + 3]);
}
__device__ __forceinline__ void row_store_f32_l(float* p, const float (&v)[16], int lane) {
#pragma unroll
    for (int c = 0; c < 4; ++c) *(float4*)(p + c * 256 + lane * 4) = make_float4(v[c * 4], v[c * 4 + 1], v[c * 4 + 2], v[c * 4 + 3]);
}
__device__ __forceinline__ void row_layernorm(float (&v)[16], const float* g, const float* b, int lane) {
    float gg[16], bb[16]; row_load_f32(g, gg, lane); row_load_f32(b, bb, lane);
    float s = 0.f, q = 0.f;
#pragma unroll
    for (int i = 0; i < 16; ++i) { s += v[i]; q += v[i] * v[i]; }
    s = wave_sum(s); q = wave_sum(q);
    const float mean = s * (1.0f / 1024.0f);
    const float rstd = rsqrtf(fmaxf(q * (1.0f / 1024.0f) - mean * mean, 0.f) + LN_EPS);
#pragma unroll
    for (int i = 0; i < 16; ++i) v[i] = (v[i] - mean) * rstd * gg[i] + bb[i];
}
__device__ __forceinline__ void row_modulate(const float (&x)[16], float (&h)[16], const float* mod3, int lane) {
    float sh[16], sc[16]; row_load_f32(mod3, sh, lane); row_load_f32(mod3 + 1024, sc, lane);
#pragma unroll
    for (int i = 0; i < 16; ++i) h[i] = x[i] * (1.0f + sc[i]) + sh[i];
}
__device__ __forceinline__ void load_mu(const float* mu, float (&m)[6][16], int lane) {
#pragma unroll
    for (int n = 0; n < 6; ++n) row_load_f32(mu + n * 1024, m[n], lane);
}
__device__ __forceinline__ void emit_next(bf16_t* s0, int kind, int row, const float (&h)[16], const float (&hp)[16], const float (&m)[6][16], int lane) {
    if (kind == 0) {
#pragma unroll
        for (int n = 0; n < 6; ++n) {
#pragma unroll
            for (int c = 0; c < 4; ++c)
                gst_u2(s0 + (size_t)n * (SLOT / 2) + (size_t)row * 1024 + c * 256 + lane * 4,
                       cvt_pk(h[c * 4] + (hp[c * 4] - h[c * 4]) * m[n][c * 4], h[c * 4 + 1] + (hp[c * 4 + 1] - h[c * 4 + 1]) * m[n][c * 4 + 1]),
                       cvt_pk(h[c * 4 + 2] + (hp[c * 4 + 2] - h[c * 4 + 2]) * m[n][c * 4 + 2], h[c * 4 + 3] + (hp[c * 4 + 3] - h[c * 4 + 3]) * m[n][c * 4 + 3]));
        }
    } else row_store_bf16(s0 + (size_t)row * 1024, h, lane);
}
__device__ __forceinline__ void emit_next_l(bf16_t* s0, const float* mu, int kind, int row, const float (&h)[16], const float (&hp)[16], int lane) {
    if (kind == 0) {
#pragma unroll 1
        for (int n = 0; n < 6; ++n) {
#pragma unroll
            for (int c2 = 0; c2 < 2; ++c2) {
                const float4 ma = gld_f4(mu + n * 1024 + (2 * c2) * 256 + lane * 4), mb = gld_f4(mu + n * 1024 + (2 * c2 + 1) * 256 + lane * 4);
                const float mm[8] = {ma.x, ma.y, ma.z, ma.w, mb.x, mb.y, mb.z, mb.w};
#pragma unroll
                for (int cc = 0; cc < 2; ++cc) {
                    const int c = 2 * c2 + cc;
                    gst_u2(s0 + (size_t)n * (SLOT / 2) + (size_t)row * 1024 + c * 256 + lane * 4,
                           cvt_pk(h[c * 4] + (hp[c * 4] - h[c * 4]) * mm[cc * 4], h[c * 4 + 1] + (hp[c * 4 + 1] - h[c * 4 + 1]) * mm[cc * 4 + 1]),
                           cvt_pk(h[c * 4 + 2] + (hp[c * 4 + 2] - h[c * 4 + 2]) * mm[cc * 4 + 2], h[c * 4 + 3] + (hp[c * 4 + 3] - h[c * 4 + 3]) * mm[cc * 4 + 3]));
                }
            }
        }
    } else row_store_bf16(s0 + (size_t)row * 1024, h, lane);
}
__device__ __forceinline__ void phase_h0(PRef p) {
    const int t_ = tidx(); const int lane = t_ & 63, gw = blockIdx.x * 4 + (t_ >> 6), nw = gridDim.x * 4;
    const int rpw = NTOK / nw;
    const int r_lo = gw * rpw;
    const float* mod = (const float*)(p.ws + OFF_MOD) + ((size_t)(0 * 2 + 0) * 8 + (r_lo >> 11)) * 3072;
    float sh[16], sc[16]; row_load_f32(mod, sh, lane); row_load_f32(mod + 1024, sc, lane);
    float hp[16];
#pragma unroll
    for (int i = 0; i < 16; ++i) hp[i] = 0.f;
    float mu[6][16]; load_mu(p.in[6], mu, lane);
    const int first = ((r_lo & 2047) != 0) ? r_lo - 1 : r_lo, end = r_lo + rpw;
    float nx[16]; row_load_f32(p.in[0] + (size_t)first * 1024, nx, lane);
    for (int r = first; r < end; ++r) {
        float h[16];
#pragma unroll
        for (int i = 0; i < 16; ++i) h[i] = nx[i] * (1.0f + sc[i]) + sh[i];
        if (r + 1 < end) row_load_f32(p.in[0] + (size_t)(r + 1) * 1024, nx, lane);
        __builtin_amdgcn_sched_barrier(0);
        if (r >= r_lo) emit_next((bf16_t*)(p.ws + OFF_SLOT), 0, r, h, hp, mu, lane);
#pragma unroll
        for (int i = 0; i < 16; ++i) hp[i] = h[i];
        if (((r + 1) & 2047) == 0) {
#pragma unroll
            for (int i = 0; i < 16; ++i) hp[i] = 0.f;
        }
    }
}
__device__ __forceinline__ int layer_kind(int L) { return L % 3; }
__device__ __forceinline__ void phase_ln2(PRef p, int L) {
    const int t_ = tidx(); const int lane = t_ & 63, gw = blockIdx.x * 4 + (t_ >> 6), nw = gridDim.x * 4;
    const int rpw = NTOK / nw, r_lo = gw * rpw;
    const float* mod = (const float*)(p.ws + OFF_MOD);
    const bf16_t* xres = (const bf16_t*)(p.ws + OFF_XRES);
    const bf16_t* Y = (const bf16_t*)(p.ws + OFF_SLOT + 9 * SLOT);
    const float* wgt = (const float*)(p.ws + OFF_WGT);
    const bool last = (L == 3);
    const int nk = layer_kind(L + 1), njr = (L + 1) / 3;
    const bool need_prev = (!last && nk == 0);
    const int bidx = r_lo >> 11;
    float gt[16], lgn[16], lbn[16];
    row_load_f32(mod + ((size_t)(L * 2 + 1) * 8 + bidx) * 3072 + 2048, gt, lane);
    row_load_f32(p.in[4] + (L * 2 + 1) * 1024, lgn, lane); row_load_f32(p.in[5] + (L * 2 + 1) * 1024, lbn, lane);
    float hp[16];
#pragma unroll
    for (int i = 0; i < 16; ++i) hp[i] = 0.f;
    float shn[16], scn[16];
    { const float* mn_ = mod + ((size_t)((last ? L : L + 1) * 2 + 0) * 8 + bidx) * 3072; row_load_f32(mn_, shn, lane); row_load_f32(mn_ + 1024, scn, lane); }
    uint2 nxr[4], ny0[4], ny1[4]; float nw0, nw1;
    auto load_in = [&](int r) {
#pragma unroll
        for (int c = 0; c < 4; ++c) { nxr[c] = *(const uint2*)(xres + (size_t)r * 1024 + c * 256 + lane * 4); ny0[c] = *(const uint2*)(Y + (size_t)(2 * r) * 1024 + c * 256 + lane * 4); ny1[c] = *(const uint2*)(Y + (size_t)(2 * r + 1) * 1024 + c * 256 + lane * 4); }
        nw0 = wgt[2 * r]; nw1 = wgt[2 * r + 1];
    };
    const int first = (need_prev && (r_lo & 2047) != 0) ? r_lo - 1 : r_lo, end = r_lo + rpw;
    load_in(first);
    for (int r = first; r < end; ++r) {
        float x[16];
        {
            const float w0 = nw0, w1 = nw1;
#pragma unroll
            for (int c = 0; c < 4; ++c) {
                const float a0[4] = {bflo(ny0[c].x), bfhi(ny0[c].x), bflo(ny0[c].y), bfhi(ny0[c].y)}, a1[4] = {bflo(ny1[c].x), bfhi(ny1[c].x), bflo(ny1[c].y), bfhi(ny1[c].y)};
                const float xr[4] = {bflo(nxr[c].x), bfhi(nxr[c].x), bflo(nxr[c].y), bfhi(nxr[c].y)};
#pragma unroll
                for (int i = 0; i < 4; ++i) x[c * 4 + i] = DN_ALPHA * xr[i] + (1.0f + gt[c * 4 + i]) * (w0 * a0[i] + w1 * a1[i]);
            }
        }
        if (r + 1 < end) load_in(r + 1);
        __builtin_amdgcn_sched_barrier(0);
        float s = 0.f, q = 0.f;
#pragma unroll
        for (int i = 0; i < 16; ++i) { s += x[i]; q += x[i] * x[i]; }
        s = wave_sum(s); q = wave_sum(q);
        const float mean = s * (1.0f / 1024.0f), rstd = rsqrtf(fmaxf(q * (1.0f / 1024.0f) - mean * mean, 0.f) + LN_EPS);
#pragma unroll
        for (int i = 0; i < 16; ++i) x[i] = (x[i] - mean) * rstd * lgn[i] + lbn[i];
        if (last) { row_store_f32(p.out + (size_t)r * 1024, x, lane); continue; }
        float h[16];
#pragma unroll
        for (int i = 0; i < 16; ++i) h[i] = x[i] * (1.0f + scn[i]) + shn[i];
        if (r >= r_lo) { row_store_bf16((bf16_t*)(p.ws + OFF_XRES2) + (size_t)r * 1024, x, lane); emit_next_l((bf16_t*)(p.ws + OFF_SLOT), p.in[6] + (size_t)njr * 6 * 1024, nk, r, h, hp, lane); }
#pragma unroll
        for (int i = 0; i < 16; ++i) hp[i] = h[i];
        if (((r + 1) & 2047) == 0) {
#pragma unroll
            for (int i = 0; i < 16; ++i) hp[i] = 0.f;
        }
    }
}
__device__ __forceinline__ void phase_ln1(PRef p, int L, char* lds, const bf16_t* ymix, bf16_t* hm) {
    const int t = tidx(), lane = t & 63, wid = t >> 6;
    const float* mod = (const float*)(p.ws + OFF_MOD);
    const bf16_t* xinb = (const bf16_t*)(p.ws + OFF_XRES2);
    bf16_t* xres = (bf16_t*)(p.ws + OFF_XRES);
    int* cnt = (int*)(p.ws + OFF_CNT) + L * 32;
    int* list = (int*)(p.ws + OFF_LIST);
    float* wgt = (float*)(p.ws + OFF_WGT);
    float* const HB = (float*)lds;
    float* const lg = (float*)(lds + 65536);
    const float* rtw = (const float*)(p.ws + OFF_RTW) + (size_t)L * 36 * 1024;
    const int rpb = NTOK / gridDim.x;
    const int bidx = (blockIdx.x * rpb) >> 11;
    float gt[16], lgn[16], lbn[16], sh2[16], sc2[16];
    row_load_f32(mod + ((size_t)(L * 2 + 0) * 8 + bidx) * 3072 + 2048, gt, lane);
    row_load_f32(p.in[4] + (L * 2 + 0) * 1024, lgn, lane); row_load_f32(p.in[5] + (L * 2 + 0) * 1024, lbn, lane);
    row_load_f32(mod + ((size_t)(L * 2 + 1) * 8 + bidx) * 3072, sh2, lane); row_load_f32(mod + ((size_t)(L * 2 + 1) * 8 + bidx) * 3072 + 1024, sc2, lane);
    for (int rb0 = blockIdx.x * rpb; rb0 < (blockIdx.x + 1) * rpb; rb0 += 16) {
        const int rb = rb0 + wid * 4;
        uint4 xr[4][4]; uint2 yr[4][4];
#pragma unroll
        for (int rr = 0; rr < 4; ++rr) {
            const int r = rb + rr;
#pragma unroll
            for (int c = 0; c < 4; ++c) {
                if (L == 0) xr[rr][c] = gld_u4(p.in[0] + (size_t)r * 1024 + c * 256 + lane * 4);
                else { const uint2 t2 = gld_u2(xinb + (size_t)r * 1024 + c * 256 + lane * 4); xr[rr][c] = make_uint4(t2.x, t2.y, 0u, 0u); }
                yr[rr][c] = gld_u2(ymix + (size_t)r * 1024 + c * 256 + lane * 4);
            }
        }
#pragma unroll
        for (int rr = 0; rr < 4; ++rr) {
            const int r = rb + rr;
            float x[16], h[16];
#pragma unroll
            for (int c = 0; c < 4; ++c) {
                float xv[4];
                if (L == 0) { xv[0] = __uint_as_float(xr[rr][c].x); xv[1] = __uint_as_float(xr[rr][c].y); xv[2] = __uint_as_float(xr[rr][c].z); xv[3] = __uint_as_float(xr[rr][c].w); }
                else { xv[0] = bflo(xr[rr][c].x); xv[1] = bfhi(xr[rr][c].x); xv[2] = bflo(xr[rr][c].y); xv[3] = bfhi(xr[rr][c].y); }
                const float yv[4] = {bflo(yr[rr][c].x), bfhi(yr[rr][c].x), bflo(yr[rr][c].y), bfhi(yr[rr][c].y)};
#pragma unroll
                for (int i = 0; i < 4; ++i) x[c * 4 + i] = DN_ALPHA * xv[i] + (1.0f + gt[c * 4 + i]) * yv[i];
            }
            float s = 0.f, q = 0.f;
#pragma unroll
            for (int i = 0; i < 16; ++i) { s += x[i]; q += x[i] * x[i]; }
            s = wave_sum(s); q = wave_sum(q);
            const float mean = s * (1.0f / 1024.0f), rstd = rsqrtf(fmaxf(q * (1.0f / 1024.0f) - mean * mean, 0.f) + LN_EPS);
#pragma unroll
            for (int i = 0; i < 16; ++i) { x[i] = (x[i] - mean) * rstd * lgn[i] + lbn[i]; h[i] = x[i] * (1.0f + sc2[i]) + sh2[i]; }
            row_store_bf16(xres + (size_t)r * 1024, x, lane);
            row_store_bf16(hm + (size_t)r * 1024, h, lane);
            row_store_f32_l(HB + (wid * 4 + rr) * 1024, h, lane);
        }
        __syncthreads();
#pragma unroll 1
        for (int q3 = 0; q3 < 9; q3 += 3) {
            float w[3][16];
#pragma unroll
            for (int u = 0; u < 3; ++u) row_load_f32(rtw + (size_t)(wid * 9 + q3 + u) * 1024, w[u], lane);
#pragma unroll 2
            for (int r16 = 0; r16 < 16; ++r16) {
                float h[16]; row_load_f32_l(HB + r16 * 1024, h, lane);
                float a3[3];
#pragma unroll
                for (int u = 0; u < 3; ++u) { float s2 = 0.f;
#pragma unroll
                    for (int i = 0; i < 16; ++i) s2 += h[i] * w[u][i];
                    a3[u] = wave_sum(s2); }
                if (lane == 0) {
#pragma unroll
                    for (int u = 0; u < 3; ++u) lg[r16 * 36 + wid * 9 + q3 + u] = a3[u];
                }
            }
        }
        __syncthreads();
        if (t < 16) {
            const int row = rb0 + t; const float* l = lg + t * 36;
            float g[4]; for (int i = 0; i < 4; ++i) g[i] = l[i] + p.in[37][L * 4 + i];
            int gi = 0; for (int i = 1; i < 4; ++i) if (g[i] > g[gi]) gi = i;
            float gs = 0.f; for (int i = 0; i < 4; ++i) gs += __expf(g[i] - g[gi]);
            const float ggate = 1.0f / gs;
            float e[8]; for (int i = 0; i < 8; ++i) e[i] = l[4 + gi * 8 + i] + p.in[39][L * 32 + gi * 8 + i];
            int i0 = 0; for (int i = 1; i < 8; ++i) if (e[i] > e[i0]) i0 = i;
            int i1 = (i0 == 0) ? 1 : 0; for (int i = 0; i < 8; ++i) if (i != i0 && e[i] > e[i1]) i1 = i;
            const float p1 = __expf(e[i1] - e[i0]);
            const float w0 = ggate / (1.0f + p1), w1 = ggate * p1 / (1.0f + p1);
            const int e0 = gi * 8 + i0, e1 = gi * 8 + i1;
            const int pos0 = atomicAdd(&cnt[e0], 1), pos1 = atomicAdd(&cnt[e1], 1);
            list[e0 * LIST_CAP + pos0] = 2 * row; list[e1 * LIST_CAP + pos1] = 2 * row + 1;
            wgt[2 * row] = w0; wgt[2 * row + 1] = w1;
        }
        asm volatile("s_waitcnt lgkmcnt(0)" ::: "memory");
    }
}

__device__ __forceinline__ int perm64(int r) { return (r & 64) | (((r >> 2) & 3) << 4) | (((r >> 4) & 3) << 2) | (r & 3); }
__device__ __forceinline__ bool tile_permuted(int mode, int nt) { return (mode <= MODE_SIGM) || (mode == MODE_ML1 && nt < 24) || (mode == MODE_RT1 && nt >= 16); }
__device__ __forceinline__ void store16(bf16_t* d, const f32x4 (&v)[4]) {
    gst_u4(d, cvt_pk(v[0][0], v[0][1]), cvt_pk(v[0][2], v[0][3]), cvt_pk(v[1][0], v[1][1]), cvt_pk(v[1][2], v[1][3]));
    gst_u4(d + 8, cvt_pk(v[2][0], v[2][1]), cvt_pk(v[2][2], v[2][3]), cvt_pk(v[3][0], v[3][1]), cvt_pk(v[3][2], v[3][3]));
}
__device__ __forceinline__ void gemm_epilogue(PRef p, const GJob& jb, int mt, int nt, const f32x4 (&acc)[4][4]) {
    const int t_ = tidx(); const int lane = t_ & 63, wid = t_ >> 6, wr = wid >> 1, wc = wid & 1, fr = lane & 15, fq = lane >> 4;
    const int row0 = mt * 128 + wr * 64 + fr;
    if (jb.mode <= MODE_SIGM) {
        const int col = nt * 128 + wc * 64 + fq * 16;
        if (col < jb.N) {
#pragma unroll
            for (int m = 0; m < 4; ++m) {
                f32x4 v[4];
#pragma unroll
                for (int n = 0; n < 4; ++n) {
                    v[n] = acc[m][n];
                    if (jb.mode == MODE_TANH) { v[n][0] = tanhf_(v[n][0]); v[n][1] = tanhf_(v[n][1]); v[n][2] = tanhf_(v[n][2]); v[n][3] = tanhf_(v[n][3]); }
                    else if (jb.mode == MODE_SIGM) { v[n][0] = sigmoidf_(v[n][0]); v[n][1] = sigmoidf_(v[n][1]); v[n][2] = sigmoidf_(v[n][2]); v[n][3] = sigmoidf_(v[n][3]); }
                }
                store16(jb.out + (size_t)(row0 + m * 16) * jb.ldo + col, v);
            }
        }
    } else if (jb.mode == MODE_ML1) {
        if (nt < 24) {
            bf16_t* ob = (bf16_t*)(p.ws + OFF_SLOT + (size_t)(1 + (nt >> 3)) * SLOT);
            const bool sg = (nt >= 16);
            const int col = (nt & 7) * 128 + wc * 64 + fq * 16;
#pragma unroll
            for (int m = 0; m < 4; ++m) {
                f32x4 v[4];
#pragma unroll
                for (int n = 0; n < 4; ++n) {
                    v[n] = acc[m][n];
                    if (sg) { v[n][0] = sigmoidf_(v[n][0]); v[n][1] = sigmoidf_(v[n][1]); v[n][2] = sigmoidf_(v[n][2]); v[n][3] = sigmoidf_(v[n][3]); }
                }
                store16(ob + (size_t)(row0 + m * 16) * 1024 + col, v);
            }
        } else if (wc == 0) {
            float* gates = (float*)(p.ws + OFF_GATES);
            const float* bg = p.in[26];
            const int c0 = fq * 4;
#pragma unroll
            for (int m = 0; m < 4; ++m) {
                f32x4 v = acc[m][0], o;
#pragma unroll
                for (int j = 0; j < 4; ++j) { const float g = v[j] + bg[c0 + j]; o[j] = (c0 + j < 8) ? g : -softplusf_(-g); }
                gst_f4(gates + (size_t)(row0 + m * 16) * 16 + c0, o[0], o[1], o[2], o[3]);
            }
        }
    } else {
        if (nt < 16) {
            const float* rot = (const float*)(p.ws + OFF_ROT);
            bf16_t* ob = (bf16_t*)(p.ws + OFF_SLOT + (size_t)(1 + (nt >> 3)) * SLOT);
            const float scl = (nt >= 8) ? 0.0625f : 1.0f;
#pragma unroll
            for (int pp = 0; pp < 2; ++pp) {
                const int blk32 = (nt & 7) * 4 + wc * 2 + pp, head = blk32 >> 3, i0 = (blk32 & 7) * 16 + fq * 4;
                float4 rc0[4], rc1[4];
#pragma unroll
                for (int m = 0; m < 4; ++m) { const int tt = (row0 + m * 16) & 2047; rc0[m] = gld_f4(rot + ((size_t)tt * 128 + i0) * 2); rc1[m] = gld_f4(rot + ((size_t)tt * 128 + i0) * 2 + 4); }
#pragma unroll
                for (int m = 0; m < 4; ++m) {
                    const int row = row0 + m * 16;
                    const float4 c0 = rc0[m], c1 = rc1[m];
                    const float cs[4] = {c0.x, c0.z, c1.x, c1.z}, sn[4] = {c0.y, c0.w, c1.y, c1.w};
                    const f32x4 x1 = acc[m][2 * pp], x2 = acc[m][2 * pp + 1];
                    float o1[4], o2[4];
#pragma unroll
                    for (int j = 0; j < 4; ++j) { o1[j] = (x1[j] * cs[j] - x2[j] * sn[j]) * scl; o2[j] = (x1[j] * sn[j] + x2[j] * cs[j]) * scl; }
                    gst_u2(ob + (size_t)row * 1024 + head * 256 + i0, cvt_pk(o1[0], o1[1]), cvt_pk(o1[2], o1[3]));
                    gst_u2(ob + (size_t)row * 1024 + head * 256 + 128 + i0, cvt_pk(o2[0], o2[1]), cvt_pk(o2[2], o2[3]));
                }
            }
        } else {
            const bool isg = (nt >= 32);
            bf16_t* ob = (bf16_t*)(p.ws + OFF_SLOT + (size_t)(isg ? 5 : 3) * SLOT);
            const int col = (nt & 15) * 128 + wc * 64 + fq * 16;
#pragma unroll
            for (int m = 0; m < 4; ++m) {
                f32x4 v[4];
#pragma unroll
                for (int n = 0; n < 4; ++n) {
                    v[n] = acc[m][n];
                    if (isg) { v[n][0] = siluf_(v[n][0]); v[n][1] = siluf_(v[n][1]); v[n][2] = siluf_(v[n][2]); v[n][3] = siluf_(v[n][3]); }
                }
                store16(ob + (size_t)(row0 + m * 16) * 2048 + col, v);
            }
        }
    }
}
__device__ __forceinline__ void phase_gemm_jobs(PRef p, char* lds, int jlo, int jhi) {
    const int total = p.gj[jhi - 1].tile0 + 128 * p.gj[jhi - 1].ntn - p.gj[jlo].tile0;
    for (int id = blockIdx.x; id < total; id += gridDim.x) {
        int j = jlo; const int gid = id + p.gj[jlo].tile0;
        while (j + 1 < jhi && gid >= p.gj[j + 1].tile0) ++j;
        GJob jb; jb.A = p.gj[j].A; jb.Bt = p.gj[j].Bt; jb.out = p.gj[j].out; jb.K = p.gj[j].K; jb.N = p.gj[j].N; jb.ldo = p.gj[j].ldo; jb.mode = p.gj[j].mode; jb.ntn = p.gj[j].ntn; jb.tile0 = p.gj[j].tile0;
        int mt, nt; tile_map(gid - jb.tile0, jb.ntn, mt, nt);
        int nv = jb.N - nt * 128; nv = nv > 128 ? 128 : nv;
        const bf16_t* ar[4]; const bf16_t* br[4];
        {
            const int t_ = tidx(), r0_ = t_ >> 3, co_ = glds_chunk(t_) * 8;
            const bool pm_ = tile_permuted(jb.mode, nt);
#pragma unroll
            for (int i = 0; i < 4; ++i) {
                ar[i] = jb.A + (size_t)(mt * 128 + r0_ + 32 * i) * jb.K + co_;
                int rb_ = r0_ + 32 * i; rb_ = pm_ ? perm64(rb_) : rb_; rb_ = rb_ < nv ? rb_ : nv - 1;
                br[i] = jb.Bt + (size_t)(nt * 128 + rb_) * jb.K + co_;
            }
        }
        f32x4 acc[4][4];
        gemm_gg(lds, jb.K / 64, ar, br, acc);
        gemm_epilogue(p, jb, mt, nt, acc);
    }
}

constexpr int RM = 4;
template <int KL>
__device__ __forceinline__ void minigemm(const bf16_t* A, const bf16_t* Bt, int fr, int fq, f32x4 (&acc)[RM][4]) {
#pragma unroll
    for (int m = 0; m < RM; ++m)
#pragma unroll
        for (int n = 0; n < 4; ++n) acc[m][n] = (f32x4){0.f, 0.f, 0.f, 0.f};
#pragma unroll 2
    for (int ks = 0; ks < KL / 32; ++ks) {
        uint4 af[RM], bfm[4];
#pragma unroll
        for (int m = 0; m < RM; ++m) af[m] = gld_u4(A + (size_t)(m * 16 + fr) * KL + ks * 32 + fq * 8);
#pragma unroll
        for (int n = 0; n < 4; ++n) bfm[n] = gld_u4(Bt + (size_t)((fr >> 2) * 16 + n * 4 + (fr & 3)) * KL + ks * 32 + fq * 8);
#pragma unroll
        for (int m = 0; m < RM; ++m)
#pragma unroll
            for (int n = 0; n < 4; ++n) acc[m][n] = mfma16(bfm[n], af[m], acc[m][n]);
    }
}
__device__ __forceinline__ void phase_rw2(PRef p, int jr) {
    const int t_ = tidx(); const int lane = t_ & 63, wid = t_ >> 6, wr = wid >> 1, wc = wid & 1, fr = lane & 15, fq = lane >> 4;
    char* S = p.ws + OFF_SLOT;
    float* decay = (float*)S; bf16_t* nkk = (bf16_t*)(S + 2 * SLOT); bf16_t* bb = (bf16_t*)(S + 3 * SLOT); bf16_t* gb = (bf16_t*)(S + 4 * SLOT);
    const bf16_t* rb = (const bf16_t*)(S + 6 * SLOT); const bf16_t* kb = (const bf16_t*)(S + 7 * SLOT); bf16_t* kpb = (bf16_t*)(S + 10 * SLOT);
    const bf16_t* vb = (const bf16_t*)(S + 8 * SLOT); bf16_t* vpb = (bf16_t*)(S + 9 * SLOT); const bf16_t* vf = (const bf16_t*)(S + 11 * SLOT);
    float* bonus = (float*)(p.ws + OFF_BONUS);
    const bf16_t* Lw = (const bf16_t*)(p.ws + OFF_LW); const bf16_t* La = (const bf16_t*)(p.ws + OFF_LA);
    const bf16_t* Lg = (const bf16_t*)(p.ws + OFF_LG); const bf16_t* Lv = (const bf16_t*)(p.ws + OFF_LV);
    const bf16_t* w2t = (const bf16_t*)(p.ws + W_W2T) + (size_t)jr * 1024 * 64; const bf16_t* a2t = (const bf16_t*)(p.ws + W_A2T) + (size_t)jr * 1024 * 64;
    const bf16_t* g2t = (const bf16_t*)(p.ws + W_G2T) + (size_t)jr * 1024 * 128; const bf16_t* v2t = (const bf16_t*)(p.ws + W_V2T);
    const float* w0 = p.in[8] + jr * 1024; const float* a0 = p.in[11] + jr * 1024; const float* v0 = p.in[14];
    const float* kkw = p.in[19] + jr * 1024; const float* kaw = p.in[20] + jr * 1024; const float* rk = p.in[21] + jr * 1024;
    for (int id2 = blockIdx.x; id2 < 128 * 8; id2 += gridDim.x) {
        int mt, nt; tile_map(id2, 8, mt, nt);
        const int row0 = mt * 128 + wr * 64, col0 = nt * 128 + wc * 64, head = nt * 2 + wc;
        f32x4 acc[RM][4];
        const int c0 = col0 + fq * 16;
        minigemm<64>(La + (size_t)row0 * 64, a2t + (size_t)col0 * 64, fr, fq, acc);
        float ss[RM], bs[RM];
#pragma unroll
        for (int m = 0; m < RM; ++m) { ss[m] = 0.f; bs[m] = 0.f; }
#pragma unroll
        for (int m = 0; m < RM; ++m) {
            const size_t off = (size_t)(row0 + m * 16 + fr) * 1024 + c0;
            const uint4 kq0 = *(const uint4*)(kb + off), kq1 = *(const uint4*)(kb + off + 8);
            const unsigned kw[8] = {kq0.x, kq0.y, kq0.z, kq0.w, kq1.x, kq1.y, kq1.z, kq1.w};
#pragma unroll
            for (int n = 0; n < 4; ++n) {
                const float4 a0v = *(const float4*)(a0 + c0 + n * 4), kkv = *(const float4*)(kkw + c0 + n * 4);
                const float a0a[4] = {a0v.x, a0v.y, a0v.z, a0v.w}, kka[4] = {kkv.x, kkv.y, kkv.z, kkv.w};
                const float kf4[4] = {bflo(kw[n * 2]), bfhi(kw[n * 2]), bflo(kw[n * 2 + 1]), bfhi(kw[n * 2 + 1])};
#pragma unroll
                for (int j = 0; j < 4; ++j) { acc[m][n][j] = sigmoidf_(a0a[j] + acc[m][n][j]); const float q = kf4[j] * kka[j]; ss[m] += q * q; }
            }
            asm volatile("" ::: "memory");
        }
#pragma unroll
        for (int m = 0; m < RM; ++m) { ss[m] += __shfl_xor(ss[m], 16); ss[m] += __shfl_xor(ss[m], 32); ss[m] = fminf(__builtin_amdgcn_rsqf(ss[m]), 1e12f); }
        float4 kkq[4], kaq[4], rkq[4];
#pragma unroll
        for (int n = 0; n < 4; ++n) { kkq[n] = gld_f4(kkw + c0 + n * 4); kaq[n] = gld_f4(kaw + c0 + n * 4); rkq[n] = gld_f4(rk + c0 + n * 4); }
#pragma unroll
        for (int m = 0; m < RM; ++m) {
            const size_t off = (size_t)(row0 + m * 16 + fr) * 1024 + c0;
            const uint4 rq0 = *(const uint4*)(rb + off), rq1 = *(const uint4*)(rb + off + 8), kq0 = *(const uint4*)(kb + off), kq1 = *(const uint4*)(kb + off + 8);
            const unsigned kw[8] = {kq0.x, kq0.y, kq0.z, kq0.w, kq1.x, kq1.y, kq1.z, kq1.w};
            const unsigned rw[8] = {rq0.x, rq0.y, rq0.z, rq0.w, rq1.x, rq1.y, rq1.z, rq1.w};
            unsigned okp[8], onk[8], obb[8];
#pragma unroll
            for (int n = 0; n < 4; ++n) {
                const float kka[4] = {kkq[n].x, kkq[n].y, kkq[n].z, kkq[n].w}, kaa[4] = {kaq[n].x, kaq[n].y, kaq[n].z, kaq[n].w}, rka[4] = {rkq[n].x, rkq[n].y, rkq[n].z, rkq[n].w};
                const float rf[4] = {bflo(rw[n * 2]), bfhi(rw[n * 2]), bflo(rw[n * 2 + 1]), bfhi(rw[n * 2 + 1])}, kf4[4] = {bflo(kw[n * 2]), bfhi(kw[n * 2]), bflo(kw[n * 2 + 1]), bfhi(kw[n * 2 + 1])};
                float kp[4], nk[4], b4[4];
#pragma unroll
                for (int j = 0; j < 4; ++j) {
                    const float a = acc[m][n][j], k = kf4[j], kn = k * kka[j] * ss[m];
                    kp[j] = k * (1.0f + (a - 1.0f) * kaa[j]); nk[j] = -kn; b4[j] = kn * a; bs[m] += rf[j] * kp[j] * rka[j];
                }
                okp[n * 2] = cvt_pk(kp[0], kp[1]); okp[n * 2 + 1] = cvt_pk(kp[2], kp[3]);
                onk[n * 2] = cvt_pk(nk[0], nk[1]); onk[n * 2 + 1] = cvt_pk(nk[2], nk[3]);
                obb[n * 2] = cvt_pk(b4[0], b4[1]); obb[n * 2 + 1] = cvt_pk(b4[2], b4[3]);
            }
            *(uint4*)(kpb + off) = make_uint4(okp[0], okp[1], okp[2], okp[3]); *(uint4*)(kpb + off + 8) = make_uint4(okp[4], okp[5], okp[6], okp[7]);
            *(uint4*)(nkk + off) = make_uint4(onk[0], onk[1], onk[2], onk[3]); *(uint4*)(nkk + off + 8) = make_uint4(onk[4], onk[5], onk[6], onk[7]);
            *(uint4*)(bb + off) = make_uint4(obb[0], obb[1], obb[2], obb[3]); *(uint4*)(bb + off + 8) = make_uint4(obb[4], obb[5], obb[6], obb[7]);
            asm volatile("" ::: "memory");
        }
#pragma unroll
        for (int m = 0; m < RM; ++m) { bs[m] += __shfl_xor(bs[m], 16); bs[m] += __shfl_xor(bs[m], 32); if (fq == 0) bonus[(size_t)(row0 + m * 16 + fr) * 16 + head] = bs[m]; }
        minigemm<64>(Lw + (size_t)row0 * 64, w2t + (size_t)col0 * 64, fr, fq, acc);
        float4 w0q[4];
#pragma unroll
        for (int n = 0; n < 4; ++n) w0q[n] = gld_f4(w0 + c0 + n * 4);
#pragma unroll
        for (int n = 0; n < 4; ++n) {
            const float w0a[4] = {w0q[n].x, w0q[n].y, w0q[n].z, w0q[n].w};
#pragma unroll
            for (int m = 0; m < RM; ++m) {
                f32x4 o;
#pragma unroll
                for (int j = 0; j < 4; ++j) { const float wl = -softplusf_(-(w0a[j] + acc[m][n][j])) - 0.5f; o[j] = __expf(-__expf(wl)); }
                *(f32x4*)(decay + (size_t)(row0 + m * 16 + fr) * 1024 + c0 + n * 4) = o;
            }
        }
        minigemm<128>(Lg + (size_t)row0 * 128, g2t + (size_t)col0 * 128, fr, fq, acc);
#pragma unroll
        for (int m = 0; m < RM; ++m) {
            unsigned o[8];
#pragma unroll
            for (int n = 0; n < 4; ++n) { o[n * 2] = cvt_pk(acc[m][n][0], acc[m][n][1]); o[n * 2 + 1] = cvt_pk(acc[m][n][2], acc[m][n][3]); }
            bf16_t* d = gb + (size_t)(row0 + m * 16 + fr) * 1024 + c0;
            *(uint4*)d = make_uint4(o[0], o[1], o[2], o[3]); *(uint4*)(d + 8) = make_uint4(o[4], o[5], o[6], o[7]);
        }
        if (jr > 0) {
            minigemm<32>(Lv + (size_t)row0 * 32, v2t + (size_t)col0 * 32, fr, fq, acc);
#pragma unroll
            for (int m = 0; m < RM; ++m) {
                const size_t off = (size_t)(row0 + m * 16 + fr) * 1024 + c0;
                const uint4 vq0 = *(const uint4*)(vb + off), vq1 = *(const uint4*)(vb + off + 8), fq0 = *(const uint4*)(vf + off), fq1 = *(const uint4*)(vf + off + 8);
                const unsigned vw[8] = {vq0.x, vq0.y, vq0.z, vq0.w, vq1.x, vq1.y, vq1.z, vq1.w}, fw[8] = {fq0.x, fq0.y, fq0.z, fq0.w, fq1.x, fq1.y, fq1.z, fq1.w};
                unsigned o[8];
#pragma unroll
                for (int n = 0; n < 4; ++n) {
                    const float4 v0v = *(const float4*)(v0 + c0 + n * 4); const float v0a[4] = {v0v.x, v0v.y, v0v.z, v0v.w};
                    const float v4[4] = {bflo(vw[n * 2]), bfhi(vw[n * 2]), bflo(vw[n * 2 + 1]), bfhi(vw[n * 2 + 1])}, f4[4] = {bflo(fw[n * 2]), bfhi(fw[n * 2]), bflo(fw[n * 2 + 1]), bfhi(fw[n * 2 + 1])};
                    float o4[4];
#pragma unroll
                    for (int j = 0; j < 4; ++j) o4[j] = v4[j] + (f4[j] - v4[j]) * sigmoidf_(v0a[j] + acc[m][n][j]);
                    o[n * 2] = cvt_pk(o4[0], o4[1]); o[n * 2 + 1] = cvt_pk(o4[2], o4[3]);
                }
                *(uint4*)(vpb + off) = make_uint4(o[0], o[1], o[2], o[3]); *(uint4*)(vpb + off + 8) = make_uint4(o[4], o[5], o[6], o[7]);
            }
        }
    }
}
__device__ __forceinline__ void phase_rw3(PRef p, int jr, char* lds) {
    const int t = tidx(), lane = t & 63, wid = t >> 6, rowq = lane >> 4, jq = lane & 15;
    char* S = p.ws + OFF_SLOT;
    const float* decay = (const float*)S; const bf16_t* nkk = (const bf16_t*)(S + 2 * SLOT); const bf16_t* bb = (const bf16_t*)(S + 3 * SLOT);
    const bf16_t* rb = (const bf16_t*)(S + 6 * SLOT); const bf16_t* kb = (const bf16_t*)(S + 10 * SLOT);
    const bf16_t* vb = (const bf16_t*)(S + (jr == 0 ? 11 : 9) * SLOT); bf16_t* yb = (bf16_t*)(S + 5 * SLOT);
    float* buf = (float*)lds;
    float* ybuf = (float*)(lds + 2 * 16 * 336 * 4);
    for (int item = blockIdx.x; item < 512; item += gridDim.x) {
        const int bh = item >> 2, rg = item & 3, b = bh >> 4, h = bh & 15;
        const size_t base = (size_t)b * 2048 * 1024 + h * 64;
        const bf16_t* vecp[2]; int vdst[2];
#pragma unroll
        for (int u = 0; u < 2; ++u) {
            const int id = t + 256 * u, vec = id >> 7, rem = id & 127, step = rem >> 3, c8 = rem & 7;
            const bf16_t* bp = (vec == 0) ? nkk : (vec == 1) ? bb : (vec == 2) ? kb : rb;
            vecp[u] = bp + base + (size_t)step * 1024 + c8 * 8; vdst[u] = step * 336 + 64 + vec * 64 + c8 * 8;
        }
        const float* dp = decay + base + (size_t)(t >> 4) * 1024 + (t & 15) * 4; const int ddst = (t >> 4) * 336 + (t & 15) * 4;
        const bf16_t* vp = vb + base + (size_t)(t >> 1) * 1024 + rg * 16 + (t & 1) * 8; const int vvdst = (t >> 1) * 336 + 320 + (t & 1) * 8;
        uint4 g0, g1, gv; float4 gd;
        auto fetch = [&](int ch) {
            const size_t o = (size_t)ch * 16 * 1024;
            g0 = gload16(vecp[0] + o); g1 = gload16(vecp[1] + o);
            { const uint4 d_ = gload16(dp + o); gd = make_float4(__uint_as_float(d_.x), __uint_as_float(d_.y), __uint_as_float(d_.z), __uint_as_float(d_.w)); }
            if (t < 32) gv = gload16(vp + o);
        };
        auto stash = [&](float* bf) {
            float f[8];
            unpack8(g0, f); *(float4*)(bf + vdst[0]) = make_float4(f[0], f[1], f[2], f[3]); *(float4*)(bf + vdst[0] + 4) = make_float4(f[4], f[5], f[6], f[7]);
            unpack8(g1, f); *(float4*)(bf + vdst[1]) = make_float4(f[0], f[1], f[2], f[3]); *(float4*)(bf + vdst[1] + 4) = make_float4(f[4], f[5], f[6], f[7]);
            *(float4*)(bf + ddst) = gd;
            if (t < 32) { unpack8(gv, f); *(float4*)(bf + vvdst) = make_float4(f[0], f[1], f[2], f[3]); *(float4*)(bf + vvdst + 4) = make_float4(f[4], f[5], f[6], f[7]); }
        };
        float s0 = 0.f, s1 = 0.f, s2 = 0.f, s3 = 0.f;
        __syncthreads();
        fetch(0); stash(buf); __syncthreads();
        for (int ch = 0; ch < 128; ++ch) {
            if (ch + 1 < 128) fetch(ch + 1);
            const float* bf = buf + (ch & 1) * (16 * 336); float* yb_ = ybuf + (ch & 1) * 256;
            float ykeep = 0.f;
            const float* q0 = bf + jq * 4; const float* v0p = bf + 320 + wid * 4 + rowq;
            float4 nw = *(const float4*)q0, na = *(const float4*)(q0 + 64), nb2 = *(const float4*)(q0 + 128), nk = *(const float4*)(q0 + 192), nr = *(const float4*)(q0 + 256);
            float nv = v0p[0];
#pragma unroll 4
            for (int s = 0; s < 16; ++s) {
                const float4 w = nw, a = na, bq = nb2, k = nk, r = nr; const float vv = nv;
                const float* q = q0 + (s + 1) * 336;
                nw = *(const float4*)q; na = *(const float4*)(q + 64); nb2 = *(const float4*)(q + 128); nk = *(const float4*)(q + 192); nr = *(const float4*)(q + 256);
                nv = v0p[(s + 1) * 336];
                __builtin_amdgcn_sched_barrier(0);
                float sa = s0 * a.x; sa = fmaf(s1, a.y, sa); sa = fmaf(s2, a.z, sa); sa = fmaf(s3, a.w, sa);
                sa = row16_sum(sa);
                s0 = fmaf(s0, w.x, fmaf(sa, bq.x, vv * k.x)); s1 = fmaf(s1, w.y, fmaf(sa, bq.y, vv * k.y));
                s2 = fmaf(s2, w.z, fmaf(sa, bq.z, vv * k.z)); s3 = fmaf(s3, w.w, fmaf(sa, bq.w, vv * k.w));
                float y = s0 * r.x; y = fmaf(s1, r.y, y); y = fmaf(s2, r.z, y); y = fmaf(s3, r.w, y);
                y = row16_sum(y);
                ykeep = (jq == s) ? y : ykeep;
            }
            yb_[jq * 16 + wid * 4 + rowq] = ykeep;
            if (ch + 1 < 128) stash(buf + ((ch + 1) & 1) * (16 * 336));
            __syncthreads();
            if (t < 32) { const int step = t >> 1, hf = t & 1; float f[8];
#pragma unroll
                for (int i = 0; i < 8; ++i) f[i] = yb_[step * 16 + hf * 8 + i];
                *(uint4*)(yb + base + (size_t)(ch * 16 + step) * 1024 + rg * 16 + hf * 8) = pack8(f); }
        }
    }
}
__device__ __forceinline__ uint2 lds_tr16(const char* p) {
    typedef short v4s_t __attribute__((ext_vector_type(4)));
    const v4s_t r = __builtin_amdgcn_ds_read_tr16_b64_v4i16((LAS v4s_t*)p);
    uint2 u; __builtin_memcpy(&u, &r, 8); return u;
}
__device__ __forceinline__ int sw64(int row, int col) { return row * 128 + ((((col >> 3) ^ (row & 7))) << 4) + (col & 7) * 2; }
__device__ __forceinline__ void phase_rw3c(PRef p, int jr, char* lds) {
    const int t = tidx(), lane = t & 63, w = t >> 6, fr = lane & 15, fq = lane >> 4;
    char* S = p.ws + OFF_SLOT;
    const float* decay = (const float*)S; const bf16_t* nkk = (const bf16_t*)(S + 2 * SLOT); const bf16_t* bb = (const bf16_t*)(S + 3 * SLOT);
    const bf16_t* rb = (const bf16_t*)(S + 6 * SLOT); const bf16_t* kb = (const bf16_t*)(S + 10 * SLOT);
    const bf16_t* vb = (const bf16_t*)(S + (jr == 0 ? 11 : 9) * SLOT); bf16_t* yb = (bf16_t*)(S + 5 * SLOT);
    char* const AT = lds;              char* const RT = lds + 4096;  char* const BT = lds + 8192;  char* const KT = lds + 12288;
    float* const PL = (float*)(lds + 16384);
    float* const GAB = (float*)(lds + 43264);
    char* const GAK = lds + 28672;     char* const GRB = lds + 30720; char* const GRK = lds + 32768;
    char* const VT = lds + 34816;      char* const UT = lds + 35840;
    char* const SB = lds + 36864;
    float* const XL = (float*)(lds + 38912);
    float* const PC = (float*)(lds + 40960);
    float* const GS = (float*)(lds + 41216);
    bf16_t* const YB = (bf16_t*)(lds + 42240);
    const int pj = t & 63, ptg = t >> 6;
    const int tk = t >> 3, ck = t & 7;
    const int vtau = t >> 3, vi2 = (t & 7) * 2;
    const int qq = fr >> 2, pp = fr & 3;
    for (int item = blockIdx.x; item < 512; item += gridDim.x) {
        const int bh = item >> 2, rg = item & 3, b = bh >> 4, h = bh & 15;
        const size_t base = (size_t)b * 2048 * 1024 + h * 64;
        __syncthreads();
        for (int i = t; i < 128; i += 256) *(uint4*)(SB + i * 16) = make_uint4(0u, 0u, 0u, 0u);
        f32x4 Sacc = (f32x4){0.f, 0.f, 0.f, 0.f};
        float gw[8]; uint4 ra, rb4, rk, rr, rw0, rw1; unsigned gvv = 0;
        auto fetch = [&](int c) {
#pragma unroll
            for (int s2 = 0; s2 < 8; ++s2) gw[s2] = *(const __attribute__((address_space(1))) float*)(decay + base + (size_t)(c * 32 + ptg * 8 + s2) * 1024 + pj);
            const size_t o = base + (size_t)(c * 32 + tk) * 1024 + ck * 8;
            ra = gload16(nkk + o); rb4 = gload16(bb + o); rk = gload16(kb + o); rr = gload16(rb + o); rw0 = gload16(decay + o); rw1 = gload16(decay + o + 4);
            gvv = *(const __attribute__((address_space(1))) unsigned*)(vb + base + (size_t)(c * 32 + vtau) * 1024 + rg * 16 + vi2);
        };
        fetch(0);
        for (int c = 0; c < 64; ++c) {
            {
                float cum[8]; float run = 0.f;
#pragma unroll
                for (int s2 = 0; s2 < 8; ++s2) { run += __builtin_amdgcn_logf(gw[s2]); cum[s2] = run; }
                GS[ptg * 64 + pj] = run;
                __syncthreads();
                const float g0 = GS[pj], g1 = GS[64 + pj], g2 = GS[128 + pj], g3 = GS[192 + pj];
                const float off = (ptg > 0 ? g0 : 0.f) + (ptg > 1 ? g1 : 0.f) + (ptg > 2 ? g2 : 0.f);
                if (ptg == 0) PC[pj] = __builtin_amdgcn_exp2f((g0 + g1) + (g2 + g3));
#pragma unroll
                for (int s2 = 0; s2 < 8; ++s2) PL[(ptg * 8 + s2) * 64 + pj] = __builtin_amdgcn_exp2f(off + cum[s2]);
            }
            __syncthreads();
            {
                const float4 p0 = *(const float4*)(PL + tk * 64 + ck * 8), p1 = *(const float4*)(PL + tk * 64 + ck * 8 + 4);
                const unsigned ua[4] = {ra.x, ra.y, ra.z, ra.w}, ub[4] = {rb4.x, rb4.y, rb4.z, rb4.w}, uk[4] = {rk.x, rk.y, rk.z, rk.w}, ur[4] = {rr.x, rr.y, rr.z, rr.w};
                const f32x2_t Pp[4] = {{p0.x, p0.y}, {p0.z, p0.w}, {p1.x, p1.y}, {p1.z, p1.w}};
                const f32x2_t Wp[4] = {{__uint_as_float(rw0.x), __uint_as_float(rw0.y)}, {__uint_as_float(rw0.z), __uint_as_float(rw0.w)}, {__uint_as_float(rw1.x), __uint_as_float(rw1.y)}, {__uint_as_float(rw1.z), __uint_as_float(rw1.w)}};
                unsigned oa[4], orr[4], ob[4], ok[4];
#pragma unroll
                for (int i = 0; i < 4; ++i) {
                    const f32x2_t ei = {__builtin_amdgcn_rcpf(Pp[i].x), __builtin_amdgcn_rcpf(Pp[i].y)};
                    const f32x2_t rw = {__builtin_amdgcn_rcpf(Wp[i].x), __builtin_amdgcn_rcpf(Wp[i].y)};
                    const f32x2_t ex = Pp[i] * rw;
                    const f32x2_t va = {__uint_as_float(ua[i] << 16), __uint_as_float(ua[i] & 0xffff0000u)}, vr = {__uint_as_float(ur[i] << 16), __uint_as_float(ur[i] & 0xffff0000u)};
                    const f32x2_t vb2 = {__uint_as_float(ub[i] << 16), __uint_as_float(ub[i] & 0xffff0000u)}, vk = {__uint_as_float(uk[i] << 16), __uint_as_float(uk[i] & 0xffff0000u)};
                    const f32x2_t xa = va * ex, xr = vr * Pp[i], xb = vb2 * ei, xk = vk * ei;
                    oa[i] = cvt_pk(xa.x, xa.y); orr[i] = cvt_pk(xr.x, xr.y); ob[i] = cvt_pk(xb.x, xb.y); ok[i] = cvt_pk(xk.x, xk.y);
                }
                const int o = tk * 128 + ((ck ^ (tk & 7)) << 4);
                *(uint4*)(AT + o) = make_uint4(oa[0], oa[1], oa[2], oa[3]); *(uint4*)(RT + o) = make_uint4(orr[0], orr[1], orr[2], orr[3]);
                *(uint4*)(BT + o) = make_uint4(ob[0], ob[1], ob[2], ob[3]); *(uint4*)(KT + o) = make_uint4(ok[0], ok[1], ok[2], ok[3]);
                *(bf16_t*)(VT + vi2 * 64 + vtau * 2) = (bf16_t)(gvv & 0xffffu);
                *(bf16_t*)(VT + (vi2 + 1) * 64 + vtau * 2) = (bf16_t)(gvv >> 16);
            }
            if (c + 1 < 64) fetch(c + 1);
            __syncthreads();
            {
                const char* Mt = (w < 2) ? AT : RT; const char* Nt = (w & 1) ? BT : KT;
                f32x4 g[2][2];
#pragma unroll
                for (int m = 0; m < 2; ++m) { g[m][0] = (f32x4){0.f, 0.f, 0.f, 0.f}; g[m][1] = (f32x4){0.f, 0.f, 0.f, 0.f}; }
#pragma unroll
                for (int ks = 0; ks < 2; ++ks) {
                    const int chs = ((ks * 4 + fq) ^ (fr & 7)) << 4;
                    uint4 mf[2], nf[2];
#pragma unroll
                    for (int m = 0; m < 2; ++m) { mf[m] = *(const uint4*)(Mt + (m * 16 + fr) * 128 + chs); nf[m] = *(const uint4*)(Nt + (m * 16 + fr) * 128 + chs); }
#pragma unroll
                    for (int m = 0; m < 2; ++m)
#pragma unroll
                        for (int n = 0; n < 2; ++n) g[m][n] = mfma16(nf[n], mf[m], g[m][n]);
                }
#pragma unroll
                for (int m = 0; m < 2; ++m)
#pragma unroll
                    for (int n = 0; n < 2; ++n) {
                        const int tt = m * 16 + fr, tau0 = n * 16 + fq * 4;
                        f32x4 v4;
#pragma unroll
                        for (int j = 0; j < 4; ++j) { const int tau = tau0 + j; const bool keep = (w < 2) ? (tau < tt) : (tau <= tt); v4[j] = keep ? g[m][n][j] : 0.f; }
                        if (w == 1) *(f32x4*)(GAB + tt * 36 + tau0) = v4;
                        else {
                            char* G = (w == 0) ? GAK : (w == 2) ? GRK : GRB;
                            uint2 o; o.x = cvt_pk(v4[0], v4[1]); o.y = cvt_pk(v4[2], v4[3]);
                            *(uint2*)(G + tt * 64 + tau0 * 2) = o;
                        }
                    }
            }
            __syncthreads();
            if (w < 2) {
                f32x4 x = (f32x4){0.f, 0.f, 0.f, 0.f};
#pragma unroll
                for (int ks = 0; ks < 2; ++ks) {
                    const int chs = ((ks * 4 + fq) ^ (fr & 7)) << 4;
                    x = mfma16(*(const uint4*)(AT + (w * 16 + fr) * 128 + chs), *(const uint4*)(SB + fr * 128 + chs), x);
                }
                x = mfma16(*(const uint4*)(GAK + (w * 16 + fr) * 64 + fq * 16), *(const uint4*)(VT + fr * 64 + fq * 16), x);
                *(f32x4*)(XL + fr * 32 + w * 16 + fq * 4) = x;
            }
            __syncthreads();
            {
                const int tl = lane & 31;
                float Gr[32];
#pragma unroll
                for (int q4 = 0; q4 < 8; ++q4) { const float4 g4 = *(const float4*)(GAB + tl * 36 + q4 * 4); Gr[q4 * 4] = g4.x; Gr[q4 * 4 + 1] = g4.y; Gr[q4 * 4 + 2] = g4.z; Gr[q4 * 4 + 3] = g4.w; }
                float acc[4];
#pragma unroll
                for (int r = 0; r < 4; ++r) acc[r] = XL[(4 * w + r) * 32 + tl];
#pragma unroll
                for (int tau = 0; tau < 31; ++tau)
#pragma unroll
                    for (int r = 0; r < 4; ++r) acc[r] = fmaf(__int_as_float(__builtin_amdgcn_readlane(__float_as_int(acc[r]), tau)), Gr[tau], acc[r]);
                if (lane < 32) {
#pragma unroll
                    for (int r = 0; r < 4; ++r) *(bf16_t*)(UT + (4 * w + r) * 64 + tl * 2) = f2bf(acc[r]);
                }
            }
            __syncthreads();
            if (w < 2) {
                f32x4 y = (f32x4){0.f, 0.f, 0.f, 0.f};
#pragma unroll
                for (int ks = 0; ks < 2; ++ks) {
                    const int chs = ((ks * 4 + fq) ^ (fr & 7)) << 4;
                    y = mfma16(*(const uint4*)(RT + (w * 16 + fr) * 128 + chs), *(const uint4*)(SB + fr * 128 + chs), y);
                }
                y = mfma16(*(const uint4*)(GRB + (w * 16 + fr) * 64 + fq * 16), *(const uint4*)(UT + fr * 64 + fq * 16), y);
                y = mfma16(*(const uint4*)(GRK + (w * 16 + fr) * 64 + fq * 16), *(const uint4*)(VT + fr * 64 + fq * 16), y);
#pragma unroll
                for (int j = 0; j < 4; ++j) YB[(w * 16 + fq * 4 + j) * 16 + fr] = f2bf(y[j]);
            }
            {
                const int r0 = fq * 8 + qq, kc = 2 * w + (pp >> 1);
                const int o0 = r0 * 128 + ((kc ^ (r0 & 7)) << 4) + (pp & 1) * 8, o1 = (r0 + 4) * 128 + ((kc ^ ((r0 + 4) & 7)) << 4) + (pp & 1) * 8;
                const uint2 blo = lds_tr16(BT + o0), bhi = lds_tr16(BT + o1), klo = lds_tr16(KT + o0), khi = lds_tr16(KT + o1);
                Sacc = mfma16(make_uint4(blo.x, blo.y, bhi.x, bhi.y), *(const uint4*)(UT + fr * 64 + fq * 16), Sacc);
                Sacc = mfma16(make_uint4(klo.x, klo.y, khi.x, khi.y), *(const uint4*)(VT + fr * 64 + fq * 16), Sacc);
                const float4 pc = *(const float4*)(PC + 16 * w + fq * 4);
                Sacc[0] *= pc.x; Sacc[1] *= pc.y; Sacc[2] *= pc.z; Sacc[3] *= pc.w;
            }
            __syncthreads();
            {
                uint2 o; o.x = cvt_pk(Sacc[0], Sacc[1]); o.y = cvt_pk(Sacc[2], Sacc[3]);
                *(uint2*)(SB + fr * 128 + ((((2 * w + (fq >> 1))) ^ (fr & 7)) << 4) + (fq & 1) * 8) = o;
                if (t < 64) {
                    const int tt = t >> 1, hf = t & 1;
                    const uint4 yv_ = *(const uint4*)((const char*)YB + tt * 32 + hf * 16); const u32x4_t yx_ = {yv_.x, yv_.y, yv_.z, yv_.w};
                    *(__attribute__((address_space(1))) u32x4_t*)(yb + base + (size_t)(c * 32 + tt) * 1024 + rg * 16 + hf * 8) = yx_;
                }
            }
        }
    }
}
struct LdRw4 {
    struct Raw { uint4 y, v, g; float bn; };
    const bf16_t *y, *v, *g; const float *bonus, *gng, *gnb;
    __device__ __forceinline__ Raw fetch(int, int r, int kc) const {
        Raw q; const size_t o = (size_t)r * 1024 + kc * 8;
        q.y = *(const uint4*)(y + o); q.v = *(const uint4*)(v + o); q.g = *(const uint4*)(g + o); q.bn = bonus[r * 16 + (kc >> 3)]; return q;
    }
    __device__ __forceinline__ uint4 finish(const Raw& q, int, int, int kc) const {
        float yf[8], vf[8], gf[8]; unpack8(q.y, yf); unpack8(q.v, vf); unpack8(q.g, gf);
        float s = 0.f, s2 = 0.f;
#pragma unroll
        for (int i = 0; i < 8; ++i) { s += yf[i]; s2 += yf[i] * yf[i]; }
        s = oct_sum(s); s2 = oct_sum(s2);
        const float mean = s * (1.0f / 64.0f), var = fmaxf(s2 * (1.0f / 64.0f) - mean * mean, 0.f), rstd = rsqrtf(var + 64e-5f);
        const float4 ga = *(const float4*)(gng + kc * 8), gb = *(const float4*)(gng + kc * 8 + 4), ba = *(const float4*)(gnb + kc * 8), bb = *(const float4*)(gnb + kc * 8 + 4);
        const float gg[8] = {ga.x, ga.y, ga.z, ga.w, gb.x, gb.y, gb.z, gb.w}, bq[8] = {ba.x, ba.y, ba.z, ba.w, bb.x, bb.y, bb.z, bb.w};
        float o[8];
#pragma unroll
        for (int i = 0; i < 8; ++i) o[i] = ((yf[i] - mean) * rstd * gg[i] + bq[i] + q.bn * vf[i]) * gf[i];
        return pack8(o);
    }
};
__device__ __forceinline__ void phase_rw4(PRef p, int jr, char* lds) {
    char* S = p.ws + OFF_SLOT;
    const bf16_t* yb = (const bf16_t*)(S + 5 * SLOT); const bf16_t* gb = (const bf16_t*)(S + 4 * SLOT);
    const bf16_t* vb = (const bf16_t*)(S + (jr == 0 ? 11 : 9) * SLOT); bf16_t* ymix = (bf16_t*)(S + 6 * SLOT);
    const bf16_t* wt = (const bf16_t*)(p.ws + W_OUT) + (size_t)jr * 1024 * 1024;
    const float* bonus = (const float*)(p.ws + OFF_BONUS);
    const int t_ = tidx(); const int lane = t_ & 63, wid = t_ >> 6, wr = wid >> 1, wc = wid & 1, fr = lane & 15, fq = lane >> 4;
    for (int id = blockIdx.x; id < 128 * 8; id += gridDim.x) {
        int mt, nt; tile_map(id, 8, mt, nt);
        const size_t ro = (size_t)mt * 128 * 1024;
        LdRw4 al{yb + ro, vb + ro, gb + ro, bonus + (size_t)mt * 128 * 16, p.in[22] + jr * 1024, p.in[23] + jr * 1024};
        const bf16_t* br[4];
        { const int t2_ = tidx(), r0_ = t2_ >> 3, co_ = glds_chunk(t2_) * 8;
#pragma unroll
          for (int i = 0; i < 4; ++i) br[i] = wt + (size_t)(nt * 128 + r0_ + 32 * i) * 1024 + co_; }
        f32x4 acc[4][4];
        gemm_rg(lds, 16, al, br, acc);
#pragma unroll
        for (int n = 0; n < 4; ++n)
#pragma unroll
            for (int m = 0; m < 4; ++m) {
                uint2 o; o.x = cvt_pk(acc[m][n][0], acc[m][n][1]); o.y = cvt_pk(acc[m][n][2], acc[m][n][3]);
                *(uint2*)(ymix + (size_t)(mt * 128 + wr * 64 + m * 16 + fr) * 1024 + nt * 128 + wc * 64 + n * 16 + fq * 4) = o;
            }
    }
}

__device__ __forceinline__ void phase_cml(PRef p) {
    const int t = tidx();
    char* S = p.ws + OFF_SLOT;
    const bf16_t* src = (const bf16_t*)(S + 1 * SLOT); bf16_t* dst = (bf16_t*)(S + 8 * SLOT);
    const int col = (t & 127) * 8, half = t >> 7;
    float cw[4][8], cb[8];
#pragma unroll
    for (int j = 0; j < 4; ++j) {
        const float4 a = *(const float4*)(p.in[27] + j * 1024 + col), b = *(const float4*)(p.in[27] + j * 1024 + col + 4);
        cw[j][0] = a.x; cw[j][1] = a.y; cw[j][2] = a.z; cw[j][3] = a.w; cw[j][4] = b.x; cw[j][5] = b.y; cw[j][6] = b.z; cw[j][7] = b.w;
    }
    { const float4 a = *(const float4*)(p.in[28] + col), b = *(const float4*)(p.in[28] + col + 4);
      cb[0] = a.x; cb[1] = a.y; cb[2] = a.z; cb[3] = a.w; cb[4] = b.x; cb[5] = b.y; cb[6] = b.z; cb[7] = b.w; }
    const float qs = (col < 512) ? 0.125f : 1.0f;
    for (int item = blockIdx.x; item < 1024; item += gridDim.x) {
        const int b = item >> 7, s0 = (item & 127) * 16 + half * 8;
        const bf16_t* base = src + (size_t)b * 2048 * 1024 + col;
        uint4 r[11];
#pragma unroll
        for (int i = 0; i < 11; ++i) { const int sr = s0 - 3 + i; r[i] = gload16(base + (size_t)max(sr, 0) * 1024); if (sr < 0) r[i] = make_uint4(0u, 0u, 0u, 0u); }
        float x0[8], x1[8], x2[8];
        unpack8(r[0], x0); unpack8(r[1], x1); unpack8(r[2], x2);
#pragma unroll
        for (int i = 0; i < 8; ++i) {
            float x3[8], a[8]; unpack8(r[i + 3], x3);
#pragma unroll
            for (int e = 0; e < 8; ++e) { a[e] = cb[e] + cw[0][e] * x0[e] + cw[1][e] * x1[e] + cw[2][e] * x2[e] + cw[3][e] * x3[e]; a[e] = siluf_(a[e]) * qs; }
            *(uint4*)(dst + ((size_t)b * 2048 + s0 + i) * 1024 + col) = pack8(a);
#pragma unroll
            for (int e = 0; e < 8; ++e) { x0[e] = x1[e]; x1[e] = x2[e]; x2[e] = x3[e]; }
        }
    }
}
__device__ __forceinline__ void phase_ml2(PRef p, char* lds) {
    const int t = tidx(), lane = t & 63, w = t >> 6, fr = lane & 15, fq = lane >> 4;
    char* S = p.ws + OFF_SLOT;
    const bf16_t* qk = (const bf16_t*)(S + 8 * SLOT); const bf16_t* vb = (const bf16_t*)(S + 2 * SLOT); bf16_t* yb = (bf16_t*)(S + 4 * SLOT);
    const float* gates = (const float*)(p.ws + OFF_GATES); float* stat = (float*)(p.ws + OFF_STAT);
    char* const RAW = lds;
    char* const QT = lds + 17408; char* const KT = lds + 25600;
    char* const VT = lds + 33792;
    char* const VX = lds + 35840;
    char* const PB = lds + 39936;
    char* const CT = lds + 48128;
    float* const FS = (float*)(lds + 52224); float* const GJ = FS + 64; float* const WJ = FS + 128;
    float* const CW = (float*)(lds + 53248);
    const int qq = fr >> 2, pp = fr & 3;
    for (int item = blockIdx.x; item < 512; item += gridDim.x) {
        const int bh = item >> 3, vs = item & 7, b = bh >> 3, hd = bh & 7;
        const size_t tok0 = (size_t)b * 2048;
        __syncthreads();
        for (int i = t; i < 256; i += 256) *(uint4*)(CT + i * 16) = make_uint4(0u, 0u, 0u, 0u);
        f32x4 Cacc[2] = {(f32x4){0.f, 0.f, 0.f, 0.f}, (f32x4){0.f, 0.f, 0.f, 0.f}};
        uint4 gr0, gr1, gr2, gr3; uint4 gv = make_uint4(0u, 0u, 0u, 0u); float gg = 0.f;
        const int frr = t >> 4, fc = t & 15;
        const bf16_t* const qkt = qk + (tok0 + frr) * 1024 + (fc >> 3) * 512 + hd * 64 + (fc & 7) * 8;
        char* const qkd = ((fc < 8) ? QT : KT) + frr * 128 + (((fc & 7) ^ (frr & 7)) << 4);
        auto fetch = [&](int ch) {
            const int s0 = ch * 64;
            const bf16_t* q0 = qkt + (size_t)s0 * 1024;
            gr0 = gload16(q0); gr1 = gload16(q0 + 16 * 1024); gr2 = gload16(q0 + 32 * 1024); gr3 = gload16(q0 + 48 * 1024);
            if (t < 128) { gv = gload16(vb + (tok0 + s0 + (t >> 1)) * 1024 + hd * 128 + vs * 16 + (t & 1) * 8);
                           gg = *(const __attribute__((address_space(1))) float*)(gates + (tok0 + s0 + (t & 63)) * 16 + (t >> 6) * 8 + hd); }
        };
        fetch(0);
        for (int ch = 0; ch < 32; ++ch) {
            const int s0 = ch * 64;
            *(uint4*)qkd = gr0; *(uint4*)(qkd + 16 * 128) = gr1; *(uint4*)(qkd + 32 * 128) = gr2; *(uint4*)(qkd + 48 * 128) = gr3;
            if (t < 128) *(uint4*)(VT + t * 16) = gv;
            float vf8[8]; unpack8(gv, vf8);
            if (t >= 64 && t < 128) GJ[t - 64] = gg;
            const float ggc = gg;
            if (ch + 1 < 32) fetch(ch + 1);
            __syncthreads();
            if (t < 64) {
                float f = GJ[t];
#pragma unroll
                for (int o = 1; o < 64; o <<= 1) { const float u2 = __shfl_up(f, o); if (t >= o) f += u2; }
                const float fend = __shfl(f, 63);
                FS[t] = f; WJ[t] = __expf(fend - f + ggc);
                GJ[t] = ggc - f;
            }
            __syncthreads();
            const float efend = __expf(FS[63]);
            {
                if (t < 128) {
                    const int j = t >> 1; const float wj = WJ[j];
                    float f[8];
#pragma unroll
                    for (int i = 0; i < 8; ++i) f[i] = vf8[i] * wj;
                    *(uint4*)(VX + j * 64 + (t & 1) * 16) = pack8(f);
                    float g8[8] = {0.f, 0.f, 0.f, 0.f, 0.f, 0.f, 0.f, 0.f}; if ((t & 1) == 0) g8[0] = wj;
                    *(uint4*)(VX + j * 64 + 32 + (t & 1) * 16) = pack8(g8);
                }
            }
            __syncthreads();
            const int srow = 16 * w + fr;
            f32x4 Sacc[4], Xacc[2];
#pragma unroll
            for (int n = 0; n < 4; ++n) Sacc[n] = (f32x4){0.f, 0.f, 0.f, 0.f};
            Xacc[0] = (f32x4){0.f, 0.f, 0.f, 0.f}; Xacc[1] = (f32x4){0.f, 0.f, 0.f, 0.f};
            Cacc[0] *= efend; Cacc[1] *= efend;
#pragma unroll
            for (int ks = 0; ks < 2; ++ks) {
                const int chs = ((ks * 4 + fq) ^ (fr & 7)) << 4;
                const uint4 qf = *(const uint4*)(QT + srow * 128 + chs);
#pragma unroll
                for (int n = 0; n < 4; ++n) { const uint4 kf = *(const uint4*)(KT + (n * 16 + fr) * 128 + chs); Sacc[n] = mfma16(kf, qf, Sacc[n]); }
#pragma unroll
                for (int nn = 0; nn < 2; ++nn) { const uint4 rf = *(const uint4*)(CT + (nn * 16 + fr) * 128 + chs); Xacc[nn] = mfma16(rf, qf, Xacc[nn]); }
                const int r0 = ks * 32 + fq * 8 + qq, kc = 2 * w + (pp >> 1);
                const uint2 klo = lds_tr16(KT + r0 * 128 + ((kc ^ (r0 & 7)) << 4) + (pp & 1) * 8);
                const uint2 khi = lds_tr16(KT + (r0 + 4) * 128 + ((kc ^ ((r0 + 4) & 7)) << 4) + (pp & 1) * 8);
                const uint4 kt = make_uint4(klo.x, klo.y, khi.x, khi.y);
#pragma unroll
                for (int m = 0; m < 2; ++m) {
                    const uint2 vlo = lds_tr16(VX + r0 * 64 + (16 * m + 4 * pp) * 2), vhi = lds_tr16(VX + (r0 + 4) * 64 + (16 * m + 4 * pp) * 2);
                    Cacc[m] = mfma16(kt, make_uint4(vlo.x, vlo.y, vhi.x, vhi.y), Cacc[m]);
                }
            }
            const float fs = FS[srow];
            float dsum = 0.f;
#pragma unroll
            for (int n = 0; n < 4; ++n) {
                const float4 g4 = *(const float4*)(GJ + n * 16 + fq * 4); const float ga[4] = {g4.x, g4.y, g4.z, g4.w};
                float pv[4];
#pragma unroll
                for (int j = 0; j < 4; ++j) { const int jc = n * 16 + fq * 4 + j; pv[j] = (srow >= jc) ? Sacc[n][j] * __expf(fs + ga[j]) : 0.f; dsum += pv[j]; }
                uint2 o; o.x = cvt_pk(pv[0], pv[1]); o.y = cvt_pk(pv[2], pv[3]);
                *(uint2*)(PB + srow * 128 + (((n * 2 + (fq >> 1)) ^ (fr & 7)) << 4) + (fq & 1) * 8) = o;
            }
            dsum += __shfl_xor(dsum, 16); dsum += __shfl_xor(dsum, 32);
            f32x4 Iacc = (f32x4){0.f, 0.f, 0.f, 0.f};
#pragma unroll
            for (int ks = 0; ks < 2; ++ks) {
                const uint4 pf = *(const uint4*)(PB + srow * 128 + (((ks * 4 + fq) ^ (fr & 7)) << 4));
                const int r0 = ks * 32 + fq * 8 + qq;
                const uint2 vlo = lds_tr16(VT + r0 * 32 + (4 * pp) * 2), vhi = lds_tr16(VT + (r0 + 4) * 32 + (4 * pp) * 2);
                Iacc = mfma16(make_uint4(vlo.x, vlo.y, vhi.x, vhi.y), pf, Iacc);
            }
            const float efs = __expf(fs);
            const float ndq = __shfl(Xacc[1][0], fr);
            const float den = dsum + efs * ndq;
            const float rden = 1.0f / fmaxf(fabsf(den), 1.0f);
            const size_t tok = tok0 + s0 + srow;
            float o4[4], ssum = 0.f, ssq = 0.f;
#pragma unroll
            for (int j = 0; j < 4; ++j) { o4[j] = (Iacc[j] + efs * Xacc[0][j]) * rden; ssum += o4[j]; ssq += o4[j] * o4[j]; }
            gst_u2(yb + tok * 1024 + hd * 128 + vs * 16 + fq * 4, cvt_pk(o4[0], o4[1]), cvt_pk(o4[2], o4[3]));
            ssum += __shfl_xor(ssum, 16); ssum += __shfl_xor(ssum, 32); ssq += __shfl_xor(ssq, 16); ssq += __shfl_xor(ssq, 32);
            if (fq == 0) gst_u2(stat + ((tok * 8 + hd) * 8 + vs) * 2, __float_as_uint(ssum), __float_as_uint(ssq));
            __syncthreads();
#pragma unroll
            for (int m = 0; m < 2; ++m) {
                const int v = m * 16 + fr;
                uint2 o; o.x = cvt_pk(Cacc[m][0], Cacc[m][1]); o.y = cvt_pk(Cacc[m][2], Cacc[m][3]);
                *(uint2*)(CT + v * 128 + (((2 * w + (fq >> 1)) ^ (v & 7)) << 4) + (fq & 1) * 8) = o;
            }
        }
    }
}
template <int HSHIFT  , int NH>
struct LdGnGate {
    struct Raw { uint4 y, g; };
    const bf16_t *y, *g; int ld; const float *gng, *gnb; const float* st;
    __device__ __forceinline__ Raw fetch(int, int r, int kc) const { Raw q; const size_t o = (size_t)r * ld + kc * 8; q.y = *(const uint4*)(y + o); q.g = *(const uint4*)(g + o); return q; }
    __device__ __forceinline__ uint4 finish(const Raw& q, int, int r, int kc) const {
        float yf[8], gf[8]; unpack8(q.y, yf); unpack8(q.g, gf);
        const float2 ms = *(const float2*)(st + (r * NH + ((kc * 8) >> HSHIFT)) * 2);
        const float4 ga = *(const float4*)(gng + kc * 8), gb = *(const float4*)(gng + kc * 8 + 4), ba = *(const float4*)(gnb + kc * 8), bb = *(const float4*)(gnb + kc * 8 + 4);
        const float gg[8] = {ga.x, ga.y, ga.z, ga.w, gb.x, gb.y, gb.z, gb.w}, bq[8] = {ba.x, ba.y, ba.z, ba.w, bb.x, bb.y, bb.z, bb.w};
        float o[8];
#pragma unroll
        for (int i = 0; i < 8; ++i) o[i] = ((yf[i] - ms.x) * ms.y * gg[i] + bq[i]) * gf[i];
        return pack8(o);
    }
};
template <int HSHIFT, int NH, int NPART>
__device__ __forceinline__ void phase_outproj_gn(PRef p, char* lds, const bf16_t* yb, const bf16_t* gate, int K, const bf16_t* wt, const float* gng, const float* gnb, bf16_t* ymix) {
    const int t = tidx(), lane = t & 63, wid = t >> 6, wr = wid >> 1, wc = wid & 1, fr = lane & 15, fq = lane >> 4;
    const float* stat = (const float*)(p.ws + OFF_STAT);
    float* st = (float*)(lds + 65536);
    const float invn = 1.0f / (float)(1 << HSHIFT);
    for (int id = blockIdx.x; id < 128 * 8; id += gridDim.x) {
        int mt, nt; tile_map(id, 8, mt, nt);
        for (int i = t; i < 128 * NH; i += 256) {
            const float* q = stat + ((size_t)mt * 128 * NH + i) * NPART * 2;
            float s = 0.f, s2 = 0.f;
#pragma unroll
            for (int j = 0; j < NPART; ++j) { const float2 v = *(const float2*)(q + j * 2); s += v.x; s2 += v.y; }
            const float mean = s * invn, var = fmaxf(s2 * invn - mean * mean, 0.f);
            st[i * 2] = mean; st[i * 2 + 1] = rsqrtf(var + 1e-6f);
        }
        __syncthreads();
        const size_t ro = (size_t)mt * 128 * K;
        LdGnGate<HSHIFT, NH> al{yb + ro, gate + ro, K, gng, gnb, st};
        const bf16_t* br[4];
        { const int r0_ = t >> 3, co_ = glds_chunk(t) * 8;
#pragma unroll
          for (int i = 0; i < 4; ++i) br[i] = wt + (size_t)(nt * 128 + r0_ + 32 * i) * K + co_; }
        f32x4 acc[4][4];
        gemm_rg(lds, K / 64, al, br, acc);
#pragma unroll
        for (int n = 0; n < 4; ++n)
#pragma unroll
            for (int m = 0; m < 4; ++m) {
                uint2 o; o.x = cvt_pk(acc[m][n][0], acc[m][n][1]); o.y = cvt_pk(acc[m][n][2], acc[m][n][3]);
                *(uint2*)(ymix + (size_t)(mt * 128 + wr * 64 + m * 16 + fr) * 1024 + nt * 128 + wc * 64 + n * 16 + fq * 4) = o;
            }
    }
}

__device__ __forceinline__ void phase_rt2(PRef p, char* lds) {
    const int t = tidx(), lane = t & 63, w = t >> 6, fr = lane & 15, fq = lane >> 4;
    char* S = p.ws + OFF_SLOT;
    const bf16_t* qb = (const bf16_t*)(S + 1 * SLOT); const bf16_t* kb = (const bf16_t*)(S + 2 * SLOT); const bf16_t* vb = (const bf16_t*)(S + 3 * SLOT);
    bf16_t* yb = (bf16_t*)(S + 7 * SLOT); float* stat = (float*)(p.ws + OFF_STAT);
    char* const VB = lds + 32768; char* const PB = lds + 49152; char* const RT = lds + 57344;
    const int gco = glds_chunk(t) * 8, gr0 = t >> 3;
    const int qq = fr >> 2, pp = fr & 3;
    for (int item = blockIdx.x; item < 512; item += gridDim.x) {
        const int bh = item >> 4, vs = item & 15, b = bh >> 2, hd = bh & 3;
        const size_t tok0 = (size_t)b * 2048;
        const float lg2 = log2f(1.0f - __builtin_amdgcn_exp2f(-5.0f - (float)hd));
        const float dec64 = __builtin_amdgcn_exp2f(64.0f * lg2);
        const bf16_t* qsrc = qb + (tok0 + gr0) * 1024 + hd * 256 + gco;
        const bf16_t* ksrc = kb + (tok0 + gr0) * 1024 + hd * 256 + gco;
        const bf16_t* vsrc = vb + (tok0 + (t >> 2)) * 2048 + hd * 512 + vs * 32 + (t & 3) * 8;
        f32x4 Racc[4][2];
#pragma unroll
        for (int a = 0; a < 4; ++a) { Racc[a][0] = (f32x4){0.f, 0.f, 0.f, 0.f}; Racc[a][1] = (f32x4){0.f, 0.f, 0.f, 0.f}; }
        __syncthreads();
        for (int i = t; i < 1024; i += 256) *(uint4*)(RT + i * 16) = make_uint4(0u, 0u, 0u, 0u);
        auto issue = [&](int pc) {
            const unsigned d = (unsigned)__builtin_amdgcn_readfirstlane((int)(lds_addr_u(lds) + (pc & 1) * 16384 + w * 1024));
            const size_t go = (size_t)(pc >> 2) * 64 * 1024 + (pc & 3) * 64;
#pragma unroll
            for (int i = 0; i < 2; ++i) { glds16_asm(qsrc + go + (size_t)i * 32 * 1024, d + i * 4096); glds16_asm(ksrc + go + (size_t)i * 32 * 1024, d + 8192 + i * 4096); }
        };
        auto put_v = [&](const uint4& raw, int ch) {
            char* vbuf = VB + (ch & 1) * 8192; const int j = t >> 2;
            *(uint4*)(vbuf + j * 64 + (t & 3) * 16) = raw;
            float f[8]; unpack8(raw, f); const float sc = __builtin_amdgcn_exp2f(lg2 * (float)(63 - j));
#pragma unroll
            for (int i = 0; i < 8; ++i) f[i] *= sc;
            *(uint4*)(vbuf + 4096 + j * 64 + (t & 3) * 16) = pack8(f);
        };
        issue(0);
        { const uint4 v0 = gld_u4(vsrc); put_v(v0, 0); }
        asm volatile("s_waitcnt vmcnt(0)" ::: "memory");
        __syncthreads();
        f32x4 Sacc[4], Xacc[2];
        uint4 vnext = make_uint4(0u, 0u, 0u, 0u);
        for (int ch = 0; ch < 32; ++ch) {
            const char* vbuf = VB + (ch & 1) * 8192;
#pragma unroll
            for (int qd = 0; qd < 4; ++qd) {
                const int pc = ch * 4 + qd;
                if (pc + 1 < 128) issue(pc + 1);
                if (qd == 0) {
                    if (ch + 1 < 32) vnext = gld_u4(vsrc + (size_t)(ch + 1) * 64 * 2048);
#pragma unroll
                    for (int n = 0; n < 4; ++n) Sacc[n] = (f32x4){0.f, 0.f, 0.f, 0.f};
                    Xacc[0] = (f32x4){0.f, 0.f, 0.f, 0.f}; Xacc[1] = (f32x4){0.f, 0.f, 0.f, 0.f};
                }
                const char* qk = lds + (pc & 1) * 16384;
                Racc[qd][0] *= dec64; Racc[qd][1] *= dec64;
#pragma unroll
                for (int ks = 0; ks < 2; ++ks) {
                    const int chs = ((ks * 4 + fq) ^ (fr & 7)) << 4;
                    const uint4 qf = *(const uint4*)(qk + (16 * w + fr) * 128 + chs);
#pragma unroll
                    for (int n = 0; n < 4; ++n) { const uint4 kf = *(const uint4*)(qk + 8192 + (n * 16 + fr) * 128 + chs); Sacc[n] = mfma16(kf, qf, Sacc[n]); }
#pragma unroll
                    for (int nn = 0; nn < 2; ++nn) {
                        const int v = nn * 16 + fr;
                        const uint4 rf = *(const uint4*)(RT + v * 512 + (((qd * 8 + ks * 4 + fq) ^ (v & 7)) << 4));
                        Xacc[nn] = mfma16(rf, qf, Xacc[nn]);
                    }
                    const int r0 = ks * 32 + fq * 8 + qq;
                    const int kc = 2 * w + (pp >> 1);
                    const uint2 klo = lds_tr16(qk + 8192 + r0 * 128 + ((kc ^ (r0 & 7)) << 4) + (pp & 1) * 8);
                    const uint2 khi = lds_tr16(qk + 8192 + (r0 + 4) * 128 + ((kc ^ ((r0 + 4) & 7)) << 4) + (pp & 1) * 8);
                    const uint4 kt = make_uint4(klo.x, klo.y, khi.x, khi.y);
#pragma unroll
                    for (int m = 0; m < 2; ++m) {
                        const uint2 vlo = lds_tr16(vbuf + 4096 + r0 * 64 + (16 * m + 4 * pp) * 2), vhi = lds_tr16(vbuf + 4096 + (r0 + 4) * 64 + (16 * m + 4 * pp) * 2);
                        Racc[qd][m] = mfma16(kt, make_uint4(vlo.x, vlo.y, vhi.x, vhi.y), Racc[qd][m]);
                    }
                }
                if (qd == 2 && ch + 1 < 32) put_v(vnext, ch + 1);
                asm volatile("s_waitcnt vmcnt(0)" ::: "memory");
                __syncthreads();
#pragma unroll
                for (int m = 0; m < 2; ++m) {
                    const int v = m * 16 + fr, cch = qd * 8 + 2 * w + (fq >> 1);
                    uint2 o; o.x = cvt_pk(Racc[qd][m][0], Racc[qd][m][1]); o.y = cvt_pk(Racc[qd][m][2], Racc[qd][m][3]);
                    *(uint2*)(RT + v * 512 + ((cch ^ (v & 7)) << 4) + (fq & 1) * 8) = o;
                }
            }
            const int srow = 16 * w + fr;
#pragma unroll
            for (int n = 0; n < 4; ++n) {
                float pv[4];
#pragma unroll
                for (int j = 0; j < 4; ++j) { const int jc = n * 16 + fq * 4 + j; pv[j] = (srow >= jc) ? Sacc[n][j] * __builtin_amdgcn_exp2f(lg2 * (float)(srow - jc)) : 0.f; }
                uint2 o; o.x = cvt_pk(pv[0], pv[1]); o.y = cvt_pk(pv[2], pv[3]);
                *(uint2*)(PB + srow * 128 + (((n * 2 + (fq >> 1)) ^ (fr & 7)) << 4) + (fq & 1) * 8) = o;
            }
            f32x4 Iacc[2] = {(f32x4){0.f, 0.f, 0.f, 0.f}, (f32x4){0.f, 0.f, 0.f, 0.f}};
#pragma unroll
            for (int ks = 0; ks < 2; ++ks) {
                const uint4 pf = *(const uint4*)(PB + srow * 128 + (((ks * 4 + fq) ^ (fr & 7)) << 4));
                const int r0 = ks * 32 + fq * 8 + qq;
#pragma unroll
                for (int nn = 0; nn < 2; ++nn) {
                    const uint2 vlo = lds_tr16(vbuf + r0 * 64 + (16 * nn + 4 * pp) * 2), vhi = lds_tr16(vbuf + (r0 + 4) * 64 + (16 * nn + 4 * pp) * 2);
                    Iacc[nn] = mfma16(make_uint4(vlo.x, vlo.y, vhi.x, vhi.y), pf, Iacc[nn]);
                }
            }
            const float qdec = __builtin_amdgcn_exp2f(lg2 * (float)(srow + 1));
            const size_t tok = tok0 + (size_t)ch * 64 + srow;
            float ssum = 0.f, ssq = 0.f;
#pragma unroll
            for (int nn = 0; nn < 2; ++nn) {
                float o4[4];
#pragma unroll
                for (int j = 0; j < 4; ++j) { o4[j] = Iacc[nn][j] + Xacc[nn][j] * qdec; ssum += o4[j]; ssq += o4[j] * o4[j]; }
                gst_u2(yb + tok * 2048 + hd * 512 + vs * 32 + nn * 16 + fq * 4, cvt_pk(o4[0], o4[1]), cvt_pk(o4[2], o4[3]));
            }
            ssum += __shfl_xor(ssum, 16); ssum += __shfl_xor(ssum, 32); ssq += __shfl_xor(ssq, 16); ssq += __shfl_xor(ssq, 32);
            if (fq == 0) gst_u2(stat + ((tok * 4 + hd) * 16 + vs) * 2, __float_as_uint(ssum), __float_as_uint(ssq));
        }
        __syncthreads();
    }
}

__device__ __forceinline__ void phase_zrw(PRef p, int jr) {
    const int t_ = tidx(); const int lane = t_ & 63, gw = blockIdx.x * 4 + (t_ >> 6), nw = gridDim.x * 4;
    char* S = p.ws + OFF_SLOT;
    const bf16_t* yb = (const bf16_t*)(S + 5 * SLOT); const bf16_t* gb = (const bf16_t*)(S + 4 * SLOT);
    const bf16_t* vb = (const bf16_t*)(S + (jr == 0 ? 11 : 9) * SLOT); bf16_t* zb = (bf16_t*)(S + 7 * SLOT);
    const float* bonus = (const float*)(p.ws + OFF_BONUS);
    float gg[16], bq[16]; row_load_f32(p.in[22] + jr * 1024, gg, lane); row_load_f32(p.in[23] + jr * 1024, bq, lane);
    const int rpw = NTOK / nw, first = gw * rpw, end = first + rpw;
    uint2 ny[4], nv[4], ng[4]; float nbn[4];
    auto load_in = [&](int r) {
#pragma unroll
        for (int c = 0; c < 4; ++c) { const size_t o = (size_t)r * 1024 + c * 256 + lane * 4; ny[c] = *(const uint2*)(yb + o); nv[c] = *(const uint2*)(vb + o); ng[c] = *(const uint2*)(gb + o);
                                      nbn[c] = bonus[(size_t)r * 16 + c * 4 + (lane >> 4)]; }
    };
    load_in(first);
    for (int r = first; r < end; ++r) {
        float y[16], v[16], g[16], bn[4];
#pragma unroll
        for (int c = 0; c < 4; ++c) {
            y[c * 4] = bflo(ny[c].x); y[c * 4 + 1] = bfhi(ny[c].x); y[c * 4 + 2] = bflo(ny[c].y); y[c * 4 + 3] = bfhi(ny[c].y);
            v[c * 4] = bflo(nv[c].x); v[c * 4 + 1] = bfhi(nv[c].x); v[c * 4 + 2] = bflo(nv[c].y); v[c * 4 + 3] = bfhi(nv[c].y);
            g[c * 4] = bflo(ng[c].x); g[c * 4 + 1] = bfhi(ng[c].x); g[c * 4 + 2] = bflo(ng[c].y); g[c * 4 + 3] = bfhi(ng[c].y);
            bn[c] = nbn[c];
        }
        if (r + 1 < end) load_in(r + 1);
        __builtin_amdgcn_sched_barrier(0);
        float z[16];
#pragma unroll
        for (int c = 0; c < 4; ++c) {
            float s = (y[c * 4] + y[c * 4 + 1]) + (y[c * 4 + 2] + y[c * 4 + 3]);
            float q = (y[c * 4] * y[c * 4] + y[c * 4 + 1] * y[c * 4 + 1]) + (y[c * 4 + 2] * y[c * 4 + 2] + y[c * 4 + 3] * y[c * 4 + 3]);
            s = row16_sum(s); q = row16_sum(q);
            const float mean = s * (1.0f / 64.0f), rstd = rsqrtf(fmaxf(q * (1.0f / 64.0f) - mean * mean, 0.f) + 64e-5f);
#pragma unroll
            for (int i = 0; i < 4; ++i) { const int e = c * 4 + i; z[e] = ((y[e] - mean) * rstd * gg[e] + bq[e] + bn[c] * v[e]) * g[e]; }
        }
        row_store_bf16(zb + (size_t)r * 1024, z, lane);
    }
}
__device__ __forceinline__ void phase_zml(PRef p) {
    const int t_ = tidx(); const int lane = t_ & 63, gw = blockIdx.x * 4 + (t_ >> 6), nw = gridDim.x * 4;
    char* S = p.ws + OFF_SLOT;
    const bf16_t* yb = (const bf16_t*)(S + 4 * SLOT); const bf16_t* ob = (const bf16_t*)(S + 3 * SLOT); bf16_t* zb = (bf16_t*)(S + 1 * SLOT);
    float gg[16], bq[16]; row_load_f32(p.in[29], gg, lane); row_load_f32(p.in[30], bq, lane);
    const int rpw = NTOK / nw, first = gw * rpw, end = first + rpw;
    uint2 ny[4], no[4];
    auto load_in = [&](int r) {
#pragma unroll
        for (int c = 0; c < 4; ++c) { const size_t o = (size_t)r * 1024 + c * 256 + lane * 4; ny[c] = *(const uint2*)(yb + o); no[c] = *(const uint2*)(ob + o); }
    };
    load_in(first);
    for (int r = first; r < end; ++r) {
        float y[16], o[16], z[16];
#pragma unroll
        for (int c = 0; c < 4; ++c) {
            y[c * 4] = bflo(ny[c].x); y[c * 4 + 1] = bfhi(ny[c].x); y[c * 4 + 2] = bflo(ny[c].y); y[c * 4 + 3] = bfhi(ny[c].y);
            o[c * 4] = bflo(no[c].x); o[c * 4 + 1] = bfhi(no[c].x); o[c * 4 + 2] = bflo(no[c].y); o[c * 4 + 3] = bfhi(no[c].y);
        }
        if (r + 1 < end) load_in(r + 1);
        __builtin_amdgcn_sched_barrier(0);
#pragma unroll
        for (int c = 0; c < 4; ++c) {
            float s = (y[c * 4] + y[c * 4 + 1]) + (y[c * 4 + 2] + y[c * 4 + 3]);
            float q = (y[c * 4] * y[c * 4] + y[c * 4 + 1] * y[c * 4 + 1]) + (y[c * 4 + 2] * y[c * 4 + 2] + y[c * 4 + 3] * y[c * 4 + 3]);
            s = row16_sum(s); q = row16_sum(q); s += __shfl_xor(s, 16); q += __shfl_xor(q, 16);
            const float mean = s * (1.0f / 128.0f), rstd = rsqrtf(fmaxf(q * (1.0f / 128.0f) - mean * mean, 0.f) + 1e-6f);
#pragma unroll
            for (int i = 0; i < 4; ++i) { const int e = c * 4 + i; z[e] = ((y[e] - mean) * rstd * gg[e] + bq[e]) * o[e]; }
        }
        row_store_bf16(zb + (size_t)r * 1024, z, lane);
    }
}
__device__ __forceinline__ void phase_zrt(PRef p) {
    const int t_ = tidx(); const int lane = t_ & 63, gw = blockIdx.x * 4 + (t_ >> 6), nw = gridDim.x * 4;
    char* S = p.ws + OFF_SLOT;
    const bf16_t* yb = (const bf16_t*)(S + 7 * SLOT); const bf16_t* sb = (const bf16_t*)(S + 5 * SLOT); bf16_t* zb = (bf16_t*)(S + 3 * SLOT);
    float gw8[4][8], bw8[4][8];
#pragma unroll
    for (int c = 0; c < 4; ++c) {
        const float4 ga = gld_f4(p.in[33] + lane * 32 + c * 8), gb2 = gld_f4(p.in[33] + lane * 32 + c * 8 + 4), ba = gld_f4(p.in[34] + lane * 32 + c * 8), bb2 = gld_f4(p.in[34] + lane * 32 + c * 8 + 4);
        gw8[c][0] = ga.x; gw8[c][1] = ga.y; gw8[c][2] = ga.z; gw8[c][3] = ga.w; gw8[c][4] = gb2.x; gw8[c][5] = gb2.y; gw8[c][6] = gb2.z; gw8[c][7] = gb2.w;
        bw8[c][0] = ba.x; bw8[c][1] = ba.y; bw8[c][2] = ba.z; bw8[c][3] = ba.w; bw8[c][4] = bb2.x; bw8[c][5] = bb2.y; bw8[c][6] = bb2.z; bw8[c][7] = bb2.w;
    }
    const int rpw = NTOK / nw, first = gw * rpw, end = first + rpw;
    uint4 nyr[4], nsr[4];
    auto load_in = [&](int r) {
        const size_t o = (size_t)r * 2048 + lane * 32;
#pragma unroll
        for (int c = 0; c < 4; ++c) { nyr[c] = *(const uint4*)(yb + o + c * 8); nsr[c] = *(const uint4*)(sb + o + c * 8); }
    };
    load_in(first);
    for (int r = first; r < end; ++r) {
        const size_t o = (size_t)r * 2048 + lane * 32;
        uint4 yr[4], sr[4];
#pragma unroll
        for (int c = 0; c < 4; ++c) { yr[c] = nyr[c]; sr[c] = nsr[c]; }
        if (r + 1 < end) load_in(r + 1);
        __builtin_amdgcn_sched_barrier(0);
        float s = 0.f, q = 0.f;
#pragma unroll
        for (int c = 0; c < 4; ++c) { float f[8]; unpack8(yr[c], f);
#pragma unroll
            for (int i = 0; i < 8; ++i) { s += f[i]; q += f[i] * f[i]; } }
        s = row16_sum(s); q = row16_sum(q);
        const float mean = s * (1.0f / 512.0f), rstd = rsqrtf(fmaxf(q * (1.0f / 512.0f) - mean * mean, 0.f) + 1e-6f);
#pragma unroll
        for (int c = 0; c < 4; ++c) {
            float f[8], g[8], z[8]; unpack8(yr[c], f); unpack8(sr[c], g);
#pragma unroll
            for (int i = 0; i < 8; ++i) z[i] = ((f[i] - mean) * rstd * gw8[c][i] + bw8[c][i]) * g[i];
            *(uint4*)(zb + o + c * 8) = pack8(z);
        }
    }
}

template <int WHICH  >
__device__ __forceinline__ void phase_moe(PRef p, int L, char* lds, const bf16_t* hm, bf16_t* H) {
    const int t = tidx(), lane = t & 63, wid = t >> 6, wr = wid >> 1, wc = wid & 1, fr = lane & 15, fq = lane >> 4;
    const int* cnt = (const int*)(p.ws + OFF_CNT) + L * 32;
    const int* list = (const int*)(p.ws + OFF_LIST);
    bf16_t* Y = (bf16_t*)(p.ws + OFF_SLOT + 9 * SLOT);
    int* pre = (int*)(lds + 65536);
    __syncthreads();
    if (t == 0) { int s = 0; for (int e = 0; e < 32; ++e) { pre[e] = s; s += (cnt[e] + 127) >> 7; } pre[32] = s; }
    __syncthreads();
    const int total_all = pre[32] * 8;
    const int full = (total_all / (int)gridDim.x) * (int)gridDim.x, rem = total_all - full;
    const bool split_tail = (rem > 0) && (2 * rem <= (int)gridDim.x);
    const int total = split_tail ? full : total_all;
    for (int id0 = 0; id0 < total; id0 += gridDim.x) {
        const int id = id0 + (blockIdx.x & 7) * (gridDim.x >> 3) + (blockIdx.x >> 3);
        if (id >= total) continue;
        const int nt = id & 7, mg = id >> 3;
        int e = 0;
#pragma unroll 1
        for (int s = 16; s >= 1; s >>= 1) if (pre[e + s] <= mg) e += s;
        const int mt = mg - pre[e], ne = cnt[e];
        const int* le = list + e * LIST_CAP + mt * 128;
        const bf16_t* ar[4]; const bf16_t* br[4];
        const int co_ = glds_chunk(t) * 8;
#pragma unroll
        for (int i = 0; i < 4; ++i) {
            int r = (t >> 3) + 32 * i; r = (mt * 128 + r < ne) ? r : 0;
            const int aid = le[r];
            ar[i] = ((WHICH == 0) ? hm + (size_t)(aid >> 1) * 1024 : H + (size_t)aid * 512) + co_;
        }
        f32x4 acc[4][4];
        if (WHICH == 0) {
            const bf16_t* wt = (const bf16_t*)(p.ws + W_MOE13) + ((size_t)(L * 32 + e) * 1024 + nt * 128) * 1024;
#pragma unroll
            for (int i = 0; i < 4; ++i) {
                const int ro = (t >> 3) + 32 * i, n_ = (ro >> 4) & 3, hc = ((ro >> 2) & 3) * 8 + (n_ >> 1) * 4 + (ro & 3);
                br[i] = wt + (size_t)((ro & 64) + (hc >> 4) * 32 + (n_ & 1) * 16 + (hc & 15)) * 1024 + co_;
            }
            gemm_gg(lds, 16, ar, br, acc);
            int aidq[4];
#pragma unroll
            for (int m = 0; m < 4; ++m) { const int r = wr * 64 + m * 16 + fr; aidq[m] = (mt * 128 + r < ne) ? le[r] : 0; }
#pragma unroll
            for (int m = 0; m < 4; ++m) {
                const int r = wr * 64 + m * 16 + fr;
                if (mt * 128 + r < ne) {
                    const int aid = aidq[m];
                    const f32x4 a1 = acc[m][0], a3 = acc[m][1], b1 = acc[m][2], b3 = acc[m][3];
                    gst_u4(H + (size_t)aid * 512 + nt * 64 + wc * 32 + fq * 8, cvt_pk(siluf_(a1[0]) * a3[0], siluf_(a1[1]) * a3[1]), cvt_pk(siluf_(a1[2]) * a3[2], siluf_(a1[3]) * a3[3]),
                           cvt_pk(siluf_(b1[0]) * b3[0], siluf_(b1[1]) * b3[1]), cvt_pk(siluf_(b1[2]) * b3[2], siluf_(b1[3]) * b3[3]));
                }
            }
        } else {
            const bf16_t* wt = (const bf16_t*)(p.ws + W_MOE2) + ((size_t)(L * 32 + e) * 1024 + nt * 128) * 512;
#pragma unroll
            for (int i = 0; i < 4; ++i) br[i] = wt + (size_t)perm64((t >> 3) + 32 * i) * 512 + co_;
            gemm_gg(lds, 8, ar, br, acc);
            int aidq[4];
#pragma unroll
            for (int m = 0; m < 4; ++m) { const int r = wr * 64 + m * 16 + fr; aidq[m] = (mt * 128 + r < ne) ? le[r] : 0; }
#pragma unroll
            for (int m = 0; m < 4; ++m) {
                const int r = wr * 64 + m * 16 + fr;
                if (mt * 128 + r < ne) {
                    const int aid = aidq[m];
                    store16(Y + (size_t)aid * 1024 + nt * 128 + wc * 64 + fq * 16, acc[m]);
                }
            }
        }
    }
    if (split_tail) {
        const int hid = (blockIdx.x & 7) * (gridDim.x >> 3) + (blockIdx.x >> 3);
        if (hid < 2 * rem) {
            const int id = full + (hid >> 1), hf = hid & 1;
            const int nt = id & 7, mg = id >> 3;
            int e = 0;
#pragma unroll 1
            for (int s2 = 16; s2 >= 1; s2 >>= 1) if (pre[e + s2] <= mg) e += s2;
            const int mt = mg - pre[e], ne = cnt[e];
            const int* le = list + e * LIST_CAP + mt * 128;
            const bf16_t* ar[4]; const bf16_t* br[2];
            const int co_ = glds_chunk(t) * 8;
#pragma unroll
            for (int i = 0; i < 4; ++i) {
                int r = (t >> 3) + 32 * i; r = (mt * 128 + r < ne) ? r : 0;
                const int aid = le[r];
                ar[i] = ((WHICH == 0) ? hm + (size_t)(aid >> 1) * 1024 : H + (size_t)aid * 512) + co_;
            }
            f32x4 acc[2][4];
            int aidq[2];
            if (WHICH == 0) {
                const bf16_t* wt = (const bf16_t*)(p.ws + W_MOE13) + ((size_t)(L * 32 + e) * 1024 + nt * 128 + hf * 64) * 1024;
#pragma unroll
                for (int i = 0; i < 2; ++i) {
                    const int ro = (t >> 3) + 32 * i, n_ = (ro >> 4) & 3, hc = ((ro >> 2) & 3) * 8 + (n_ >> 1) * 4 + (ro & 3);
                    br[i] = wt + (size_t)((hc >> 4) * 32 + (n_ & 1) * 16 + (hc & 15)) * 1024 + co_;
                }
                gemm_hn(lds, 16, ar, br, acc);
#pragma unroll
                for (int m = 0; m < 2; ++m) { const int r = wid * 32 + m * 16 + fr; aidq[m] = (mt * 128 + r < ne) ? le[r] : 0; }
#pragma unroll
                for (int m = 0; m < 2; ++m) {
                    const int r = wid * 32 + m * 16 + fr;
                    if (mt * 128 + r < ne) {
                        const f32x4 a1 = acc[m][0], a3 = acc[m][1], b1 = acc[m][2], b3 = acc[m][3];
                        gst_u4(H + (size_t)aidq[m] * 512 + nt * 64 + hf * 32 + fq * 8, cvt_pk(siluf_(a1[0]) * a3[0], siluf_(a1[1]) * a3[1]), cvt_pk(siluf_(a1[2]) * a3[2], siluf_(a1[3]) * a3[3]),
                               cvt_pk(siluf_(b1[0]) * b3[0], siluf_(b1[1]) * b3[1]), cvt_pk(siluf_(b1[2]) * b3[2], siluf_(b1[3]) * b3[3]));
                    }
                }
            } else {
                const bf16_t* wt = (const bf16_t*)(p.ws + W_MOE2) + ((size_t)(L * 32 + e) * 1024 + nt * 128 + hf * 64) * 512;
#pragma unroll
                for (int i = 0; i < 2; ++i) br[i] = wt + (size_t)perm64((t >> 3) + 32 * i) * 512 + co_;
                gemm_hn(lds, 8, ar, br, acc);
#pragma unroll
                for (int m = 0; m < 2; ++m) { const int r = wid * 32 + m * 16 + fr; aidq[m] = (mt * 128 + r < ne) ? le[r] : 0; }
#pragma unroll
                for (int m = 0; m < 2; ++m) {
                    const int r = wid * 32 + m * 16 + fr;
                    if (mt * 128 + r < ne) store16(Y + (size_t)aidq[m] * 1024 + nt * 128 + hf * 64 + fq * 16, acc[m]);
                }
            }
        }
    }
}

constexpr int NPHASE = 37;
#ifndef PHSEL
#define PHSEL -1
#endif
#ifndef PHEXC
#define PHEXC -2
#endif
#define PHON(x) ((PHSEL < 0 || PHSEL == (x)) && PHEXC != (x))
__global__ void __launch_bounds__(256, 2) mega(Params p_in) {
    PRef p = *(const CAS Params*)__builtin_amdgcn_kernarg_segment_ptr();
    extern __shared__ __attribute__((aligned(16))) char lds[];
    volatile LAS unsigned* xbw = (volatile LAS unsigned*)(lds + 73728);
    if (threadIdx.x == 0) { xbw[0] = 0u; xbw[1] = 0u; xbw[2] = 0u; xbw[3] = 0u; }
    __syncthreads();
    XcdBarrier bar;
    const bool multi = (p.ph_hi - p.ph_lo) > 1;
    (void)multi;
    if (multi) bar = xcd_barrier_post((unsigned*)(p.ws + OFF_CTL), xbw);
    char* S = p.ws + OFF_SLOT;
#ifdef DBG_STOP
    if (p.ph_lo == 100) {
        const float* src = (const float*)(p.ws + DBG_SRC);
        for (size_t i = (size_t)blockIdx.x * 256 + threadIdx.x; i < (size_t)NTOK * DM; i += (size_t)gridDim.x * 256) {
            float v = DBG_BF16 ? bf2f(((const bf16_t*)src)[i]) : src[i];
            if (!(fabsf(v) < 1e30f)) v = 1e30f;
            p.out[i] = v;
        }
        return;
    }
#endif
    const int ph_lo_ = p.ph_lo, ph_hi_ = p.ph_hi;
#ifdef TIMEIT
    unsigned long long t0_ = 0, t1_ = 0;
#endif
#ifdef DUP_PHASE
    bool dup_done_ = false;
#endif
    for (int ph = ph_lo_; ph < ph_hi_; ++ph) {
        const CAS Params* pp_ = (const CAS Params*)__builtin_amdgcn_kernarg_segment_ptr();
        asm volatile("" : "+s"(pp_));
        PRef p = *pp_;
#ifdef TIMEIT
        if (ph == TIME_A) t0_ = __builtin_amdgcn_s_memrealtime();
        if (ph == TIME_B) t1_ = __builtin_amdgcn_s_memrealtime();
#endif
        int L, sub, kind;
        if (ph < 2) { L = 0; sub = ph; kind = -1; }
        else if (ph < 11) { L = 0; kind = 0; sub = ph - 2; }
        else if (ph < 20) { L = 1; kind = 1; sub = ph - 11; }
        else if (ph < 28) { L = 2; kind = 2; sub = ph - 20; }
        else { L = 3; kind = 0; sub = ph - 28; }
        const int jr = L / 3;
        if (kind == -1) { if (sub == 0) { if (PHON(0)) phase_prologue(p, lds); } else { if (PHON(1)) phase_h0(p); } }
        else {
            const int ntail = (kind == 2) ? 4 : 5;
            if (sub < ntail) {
                if (kind == 0) {
                    if (sub == 0) { if (PHON(2)) phase_gemm_jobs(p, lds, jr * 7, jr * 7 + (jr ? 7 : 6)); }
                    else if (sub == 1) { if (PHON(3)) phase_rw2(p, jr); }
                    else if (sub == 2) { if (PHON(4)) {
#ifdef RW3_SCALAR
                        phase_rw3(p, jr, lds);
#else
                        phase_rw3c(p, jr, lds);
#endif
                    } }
                    else if (sub == 3) { if (PHON(5)) phase_zrw(p, jr); }
                    else { if (PHON(2)) phase_gemm_jobs(p, lds, 16 + jr, 17 + jr); }
                } else if (kind == 1) {
                    if (sub == 0) { if (PHON(2)) phase_gemm_jobs(p, lds, 14, 15); }
                    else if (sub == 1) { if (PHON(6)) phase_cml(p); }
                    else if (sub == 2) { if (PHON(6)) phase_ml2(p, lds); }
                    else if (sub == 3) { if (PHON(7)) phase_zml(p); }
                    else { if (PHON(2)) phase_gemm_jobs(p, lds, 18, 19); }
                } else {
                    if (sub == 0) { if (PHON(2)) phase_gemm_jobs(p, lds, 15, 16); }
                    else if (sub == 1) { if (PHON(8)) phase_rt2(p, lds); }
                    else if (sub == 2) { if (PHON(9)) phase_zrt(p); }
                    else { if (PHON(2)) phase_gemm_jobs(p, lds, 19, 20); }
                }
            } else {
                const int ts = sub - ntail;
                const bf16_t* ymix = (const bf16_t*)(S + (kind == 2 ? 1 : 6) * SLOT);
                bf16_t* hm = (bf16_t*)(S + (kind == 2 ? 2 : 7) * SLOT);
                bf16_t* H = (bf16_t*)(S + (kind == 0 ? 2 : (kind == 1 ? 5 : 3)) * SLOT);
                if (ts == 0) { if (PHON(10)) phase_ln1(p, L, lds, ymix, hm); }
                else if (ts == 1) { if (PHON(11)) phase_moe<0>(p, L, lds, hm, H); }
                else if (ts == 2) { if (PHON(12)) phase_moe<1>(p, L, lds, hm, H); }
                else { if (PHON(13)) phase_ln2(p, L); }
            }
        }
#ifdef DUP_PHASE
        if (((DUP_PHASE >> ph) & 1u) && !dup_done_) { dup_done_ = true; xcd_barrier(bar); --ph; continue; }
        dup_done_ = false;
#endif
        if (ph + 1 < ph_hi_) xcd_barrier(bar);
    }
#ifdef TIMEIT
    {
        xcd_barrier(bar);
        unsigned* tw = (unsigned*)(p.ws + OFF_CTL + 32768);
        if (blockIdx.x == 0 && threadIdx.x == 0) {
            if (t1_ == 0) t1_ = __builtin_amdgcn_s_memrealtime();
            const unsigned long long dt = t1_ - t0_;
            unsigned ms2 = (unsigned)((dt + TIME_U / 2) / TIME_U);
            __hip_atomic_store(tw, ms2, __ATOMIC_RELAXED, __HIP_MEMORY_SCOPE_AGENT);
        }
        xcd_barrier(bar);
        const float c_ = sqrtf((float)__hip_atomic_load(tw, __ATOMIC_RELAXED, __HIP_MEMORY_SCOPE_AGENT));
        for (size_t i = (size_t)blockIdx.x * 256 + threadIdx.x; i < (size_t)NTOK * DM; i += (size_t)gridDim.x * 256) p.out[i] = c_;
    }
#endif
#ifdef DBG_STOP
    if (ph_lo_ != 100) {
        xcd_barrier(bar);
        const float* src = (const float*)(p.ws + DBG_SRC);
        for (size_t i = (size_t)blockIdx.x * 256 + threadIdx.x; i < (size_t)NTOK * DM; i += (size_t)gridDim.x * 256) {
            float v = DBG_BF16 ? bf2f(((const bf16_t*)src)[i]) : src[i];
            if (!(fabsf(v) < 1e30f)) v = 1e30f;
            p.out[i] = v;
        }
    }
#endif
}

constexpr int LDS_BYTES = 73728 + 64;
extern "C" void kernel_launch(void* const* d_in, const int* in_sizes, int n_in, void* d_out, int out_size, void* d_ws, size_t ws_size, hipStream_t stream) {
    static int grid = 0;
    if (grid == 0) {
        if (n_in != 43 || out_size != NTOK * DM || ws_size < WS_NEED) { fprintf(stderr, "kernel_launch: unexpected shapes (n_in %d out %d ws %zu need %zu)\n", n_in, out_size, ws_size, (size_t)WS_NEED); }
        int dev = 0, cus = 0, per_cu = 0;
        (void)hipGetDevice(&dev); (void)hipDeviceGetAttribute(&cus, hipDeviceAttributeMultiprocessorCount, dev);
        (void)hipFuncSetAttribute((const void*)mega, hipFuncAttributeMaxDynamicSharedMemorySize, LDS_BYTES);
        (void)hipOccupancyMaxActiveBlocksPerMultiprocessor(&per_cu, (const void*)mega, 256, LDS_BYTES);
        if (per_cu > 2) per_cu = 2;
        if (per_cu < 1) per_cu = 1;
        grid = cus * per_cu;
        if (grid > 512) grid = 512;
        (void)hipGetLastError();
    }
    Params p{};
    for (int i = 0; i < 43; ++i) p.in[i] = (const float*)d_in[i];
    p.out = (float*)d_out; p.ws = (char*)d_ws;
    char* ws = (char*)d_ws;
    auto slot = [&](int i) { return (bf16_t*)(ws + OFF_SLOT + (size_t)i * SLOT); };
    int tile = 0;
    auto addg = [&](int idx, const bf16_t* A, const bf16_t* Bt, bf16_t* out, int K, int N, int ldo, int mode) {
        GJob& g = p.gj[idx]; g.A = A; g.Bt = Bt; g.out = out; g.K = K; g.N = N; g.ldo = ldo; g.mode = mode; g.ntn = (N + 127) / 128; g.tile0 = tile; tile += 128 * g.ntn;
    };
    for (int jr = 0; jr < 2; ++jr) {
        const bf16_t* rkv = (const bf16_t*)(ws + W_RKV) + (size_t)jr * 3 * 1024 * 1024;
        addg(jr * 7 + 0, slot(0), rkv, slot(6), 1024, 1024, 1024, MODE_BF16);
        addg(jr * 7 + 1, slot(1), rkv + 1024 * 1024, slot(7), 1024, 1024, 1024, MODE_BF16);
        addg(jr * 7 + 2, slot(2), rkv + 2 * 1024 * 1024, slot(jr == 0 ? 11 : 8), 1024, 1024, 1024, MODE_BF16);
        addg(jr * 7 + 3, slot(3), (const bf16_t*)(ws + W_W1T) + (size_t)jr * 64 * 1024, (bf16_t*)(ws + OFF_LW), 1024, 64, 64, MODE_TANH);
        addg(jr * 7 + 4, slot(4), (const bf16_t*)(ws + W_A1T) + (size_t)jr * 64 * 1024, (bf16_t*)(ws + OFF_LA), 1024, 64, 64, MODE_BF16);
        addg(jr * 7 + 5, slot(5), (const bf16_t*)(ws + W_G1T) + (size_t)jr * 128 * 1024, (bf16_t*)(ws + OFF_LG), 1024, 128, 128, MODE_SIGM);
        addg(jr * 7 + 6, slot(2), (const bf16_t*)(ws + W_V1T), (bf16_t*)(ws + OFF_LV), 1024, 32, 32, MODE_BF16);
    }
    addg(14, slot(0), (const bf16_t*)(ws + W_MLIN), nullptr, 1024, 3088, 0, MODE_ML1);
    addg(15, slot(0), (const bf16_t*)(ws + W_RTIN), nullptr, 1024, 6144, 0, MODE_RT1);
    addg(16, slot(7), (const bf16_t*)(ws + W_OUT), slot(6), 1024, 1024, 1024, MODE_BF16);
    addg(17, slot(7), (const bf16_t*)(ws + W_OUT) + 1024 * 1024, slot(6), 1024, 1024, 1024, MODE_BF16);
    addg(18, slot(1), (const bf16_t*)(ws + W_MLOUT), slot(6), 1024, 1024, 1024, MODE_BF16);
    addg(19, slot(3), (const bf16_t*)(ws + W_RTOUT), slot(1), 2048, 1024, 1024, MODE_BF16);
    int nc = 0, ctile = 0;
    auto addc = [&](const float* src, size_t dst_off, int K, int N, int nb, long sbs, long dbs, int mode) {
        CJob& c = p.cj[nc++]; c.src = src; c.dst = (bf16_t*)(ws + dst_off); c.K = K; c.N = N; c.nb = nb; c.mode = mode; c.sbs = sbs; c.dbs = dbs;
        c.tiles_pb = ((K + 63) / 64) * ((N + 255) / 256); c.tile0 = ctile; ctile += c.tiles_pb * nb;
    };
    addc(p.in[7], W_RKV, 1024, 1024, 6, 1024 * 1024, 1024 * 1024, 0);
    addc(p.in[24], W_OUT, 1024, 1024, 2, 1024 * 1024, 1024 * 1024, 0);
    addc(p.in[9], W_W1T, 1024, 64, 2, 1024 * 64, 64 * 1024, 0);
    addc(p.in[12], W_A1T, 1024, 64, 2, 1024 * 64, 64 * 1024, 0);
    addc(p.in[17], W_G1T, 1024, 128, 2, 1024 * 128, 128 * 1024, 0);
    addc(p.in[15], W_V1T, 1024, 32, 1, 0, 0, 0);
    addc(p.in[10], W_W2T, 64, 1024, 2, 64 * 1024, 1024 * 64, 0);
    addc(p.in[13], W_A2T, 64, 1024, 2, 64 * 1024, 1024 * 64, 0);
    addc(p.in[18], W_G2T, 128, 1024, 2, 128 * 1024, 1024 * 128, 0);
    addc(p.in[16], W_V2T, 32, 1024, 1, 0, 0, 0);
    addc(p.in[25], W_MLIN, 1024, 3088, 1, 0, 0, 0);
    addc(p.in[31], W_MLOUT, 1024, 1024, 1, 0, 0, 0);
    addc(p.in[32], W_RTIN, 1024, 6144, 1, 0, 0, 3);
    addc(p.in[35], W_RTOUT, 2048, 1024, 1, 0, 0, 0);
    addc(p.in[40], W_MOE13, 1024, 512, 128, 1024 * 512, 1024 * 1024, 1);
    addc(p.in[41], W_MOE13, 1024, 512, 128, 1024 * 512, 1024 * 1024, 2);
    addc(p.in[42], W_MOE2, 512, 1024, 128, 512 * 1024, 1024 * 512, 0);
    p.ncj = nc; p.cj_tiles = ctile;

    (void)hipMemsetAsync(ws + OFF_CTL, 0, CTL_BYTES, stream);
#ifdef DBG_STOP
    const int nph = DBG_STOP;
#else
    const int nph = NPHASE;
#endif
#ifdef MULTI_LAUNCH
    for (int ph = 0; ph < nph; ++ph) { p.ph_lo = ph; p.ph_hi = ph + 1; hipLaunchKernelGGL(mega, dim3(grid), dim3(256), LDS_BYTES, stream, p); }
    if (0)
#endif
    {
        p.ph_lo = 0; p.ph_hi = nph;
        void* args[] = {&p};
        hipError_t e = hipLaunchCooperativeKernel((const void*)mega, dim3(grid), dim3(256), args, LDS_BYTES, stream);
        if (e != hipSuccess) fprintf(stderr, "cooperative launch failed: %s (grid %d)\n", hipGetErrorString(e), grid);
    }
}
```

```cpp
#include <hip/hip_runtime.h>
#include <cstdio>
#include <cstdint>

#ifndef ONE_LAUNCH
#define ONE_LAUNCH 0
#endif

typedef unsigned short bf16_t;
typedef short bf16x8 __attribute__((ext_vector_type(8)));
typedef float f32x4 __attribute__((ext_vector_type(4)));
#define LAS __attribute__((address_space(3)))
#define GAS __attribute__((address_space(1)))
typedef float f32x4g_t __attribute__((ext_vector_type(4)));
typedef unsigned u32x2g_t __attribute__((ext_vector_type(2)));
typedef unsigned u32x4g_t __attribute__((ext_vector_type(4)));
__device__ __forceinline__ float4 gld_f4(const float* p) { const f32x4g_t v = *(const GAS f32x4g_t*)(const GAS char*)(const char*)p; return make_float4(v[0], v[1], v[2], v[3]); }
__device__ __forceinline__ uint2 gld_u2(const void* p) { const u32x2g_t v = *(const GAS u32x2g_t*)(const GAS char*)(const char*)p; return make_uint2(v[0], v[1]); }
__device__ __forceinline__ uint4 gld_u4(const void* p) { const u32x4g_t v = *(const GAS u32x4g_t*)(const GAS char*)(const char*)p; return make_uint4(v[0], v[1], v[2], v[3]); }
__device__ __forceinline__ void gst_f4(float* p, float a, float b, float c, float d) { const f32x4g_t v = {a, b, c, d}; *(GAS f32x4g_t*)(GAS char*)(char*)p = v; }
__device__ __forceinline__ void gst_u2(void* p, unsigned a, unsigned b) { const u32x2g_t v = {a, b}; *(GAS u32x2g_t*)(GAS char*)(char*)p = v; }
__device__ __forceinline__ void gst_u4(void* p, unsigned a, unsigned b, unsigned c, unsigned d) { const u32x4g_t v = {a, b, c, d}; *(GAS u32x4g_t*)(GAS char*)(char*)p = v; }

constexpr int NTOK = 16384, DM = 1024, TSEQ = 2048, NBATCH = 8;
constexpr float DN_ALPHA = 1.681792830507429f;
constexpr float LN_EPS = 1e-5f;
constexpr size_t MB = 1u << 20;
constexpr size_t OFF_CTL = 0, OFF_CNT = 16384, CTL_BYTES = 65536;
constexpr size_t OFF_MOD = 65536;
constexpr size_t OFF_ROT = 1 * MB;
constexpr size_t OFF_BONUS = 3 * MB, OFF_GATES = 4 * MB, OFF_STAT = 5 * MB, OFF_LW = 13 * MB, OFF_LA = 15 * MB, OFF_LG = 17 * MB, OFF_LV = 21 * MB,
                 OFF_WGT = 22 * MB, OFF_LIST = 23 * MB, OFF_RTW = 25 * MB;
constexpr size_t OFF_W = 32 * MB;
constexpr size_t W_RKV = OFF_W, W_OUT = W_RKV + 12 * MB, W_W1T = W_OUT + 4 * MB, W_A1T = W_W1T + 256 * 1024, W_G1T = W_A1T + 256 * 1024, W_V1T = W_G1T + 512 * 1024,
                 W_W2T = W_V1T + 64 * 1024, W_A2T = W_W2T + 256 * 1024, W_G2T = W_A2T + 256 * 1024, W_V2T = W_G2T + 512 * 1024, W_MLIN = W_V2T + 64 * 1024 + 832 * 1024,
                 W_MLOUT = W_MLIN + 6400 * 1024, W_RTIN = W_MLOUT + 2 * MB, W_RTOUT = W_RTIN + 12 * MB, W_MOE13 = W_RTOUT + 4 * MB, W_MOE2 = W_MOE13 + 256 * MB,
                 W_END = W_MOE2 + 128 * MB;
constexpr size_t OFF_XRES = 464 * MB;
constexpr size_t OFF_SLOT = 528 * MB, SLOT = 32 * MB;
static_assert(W_END <= OFF_XRES, "weights overflow");
constexpr size_t OFF_XRES2 = OFF_SLOT + 12 * SLOT;
constexpr size_t WS_NEED = OFF_XRES2 + 2 * SLOT;
constexpr int LIST_CAP = 16384;

#define XB_TMO      128
#define XB_XCNT(j)  (256  + 64 * (j))
#define XB_XSUB(j)  (1280 + 64 * (j))
#define XB_XGEN(j)  (2304 + 64 * (j))
#define XB_TOP      3328
#define XB_TOPGEN   3392
#define XCD_BAR_WORDS 3456
#define XB_SPIN_CAP (1u << 22)
__device__ __forceinline__ unsigned xb_ld(unsigned* p)              { return __hip_atomic_load(p, __ATOMIC_RELAXED, __HIP_MEMORY_SCOPE_AGENT); }
__device__ __forceinline__ unsigned xb_add(unsigned* p, unsigned v) { return __hip_atomic_fetch_add(p, v, __ATOMIC_RELAXED, __HIP_MEMORY_SCOPE_AGENT); }
__device__ __forceinline__ unsigned xb_xcc_id() { return (unsigned)__builtin_amdgcn_s_getreg((3 << 11) | 20) & 0xFu; }
#define XB_SPIN(cond, bar) do { unsigned _sp = 0; while (cond) { __builtin_amdgcn_s_sleep(1); \
    if ((++_sp & 255u) == 0u) { if (xb_ld(&(bar)[XB_TMO])) break; if (_sp > XB_SPIN_CAP) { atomicAdd(&(bar)[XB_TMO], 1u); break; } } } } while (0)
struct XcdBarrier { unsigned* bar; unsigned x; volatile LAS unsigned* st; };
__device__ __forceinline__ XcdBarrier xcd_barrier_post(unsigned* bar, volatile LAS unsigned* st) {
    XcdBarrier b; b.bar = bar; b.x = xb_xcc_id(); b.st = st;
    if (threadIdx.x == 0) (void)xb_add(&bar[XB_XCNT(b.x)], 1u);
    return b;
}
__device__ __forceinline__ void xcd_barrier_complete(unsigned* bar, unsigned x, unsigned& nloc, unsigned& nx) {
    const unsigned G = gridDim.x;
    unsigned sum, cnt, mine, sp = 0u;
    for (;;) {
        sum = 0u; cnt = 0u; mine = 0u;
#pragma unroll
        for (unsigned j = 0; j < 16; ++j) { const unsigned c = xb_ld(&bar[XB_XCNT(j)]); sum += c; cnt += (c > 0u) ? 1u : 0u; mine = (j == x) ? c : mine; }
        if (sum == G) break;
        __builtin_amdgcn_s_sleep(1);
        if ((++sp & 255u) == 0u) { if (xb_ld(&bar[XB_TMO])) break; if (sp > XB_SPIN_CAP) { atomicAdd(&bar[XB_TMO], 1u); break; } }
    }
    nloc = mine > 0u ? mine : 1u; nx = cnt > 0u ? cnt : 1u;
}
__device__ __forceinline__ void xcd_barrier(const XcdBarrier& b) {
    asm volatile("s_waitcnt vmcnt(0)" ::: "memory");
    __syncthreads();
    if (threadIdx.x == 0) {
        unsigned* bar = b.bar;
        __builtin_amdgcn_s_waitcnt(0);
        unsigned nloc = b.st[0], nx = b.st[1];
        if (nloc == 0u) { xcd_barrier_complete(bar, b.x, nloc, nx); b.st[0] = nloc; b.st[1] = nx; }
        const unsigned old = xb_add(&bar[XB_XSUB(b.x)], 1u);
        const unsigned gen = old / nloc;
        if (old + 1u == (gen + 1u) * nloc) {
            __builtin_amdgcn_fence(__ATOMIC_RELEASE, "agent");
            asm volatile("s_waitcnt vmcnt(0)" ::: "memory");
            const unsigned og = xb_add(&bar[XB_TOP], 1u);
            const unsigned tg = og / nx;
            if (og + 1u == (tg + 1u) * nx) xb_add(&bar[XB_TOPGEN], 1u);
            else XB_SPIN(xb_ld(&bar[XB_TOPGEN]) == tg, bar);
            __builtin_amdgcn_fence(__ATOMIC_ACQUIRE, "agent");
            xb_add(&bar[XB_XGEN(b.x)], 1u);
            asm volatile("s_waitcnt vmcnt(0)" ::: "memory");
        } else {
            XB_SPIN(xb_ld(&bar[XB_XGEN(b.x)]) == gen, bar);
            __builtin_amdgcn_fence(__ATOMIC_ACQUIRE, "agent");
            asm volatile("s_waitcnt vmcnt(0)" ::: "memory");
        }
    }
    __syncthreads();
}

__device__ __forceinline__ int tidx() { int t = threadIdx.x; asm volatile("" : "+v"(t)); return t; }
typedef __bf16 bf16x2_t __attribute__((ext_vector_type(2)));
typedef float f32x2_t __attribute__((ext_vector_type(2)));
__device__ __forceinline__ unsigned cvt_pk(float lo, float hi) {
    f32x2_t v = {lo, hi}; bf16x2_t r = __builtin_convertvector(v, bf16x2_t);
    unsigned u; __builtin_memcpy(&u, &r, 4); return u;
}
__device__ __forceinline__ bf16_t f2bf(float f) { return (bf16_t)(cvt_pk(f, 0.f) & 0xffffu); }
__device__ __forceinline__ float bflo(unsigned u) { return __uint_as_float(u << 16); }
__device__ __forceinline__ float bfhi(unsigned u) { return __uint_as_float(u & 0xffff0000u); }
__device__ __forceinline__ float bf2f(bf16_t u) { return __uint_as_float(((unsigned)u) << 16); }
__device__ __forceinline__ void unpack8(const uint4& u, float (&f)[8]) {
    f[0] = bflo(u.x); f[1] = bfhi(u.x); f[2] = bflo(u.y); f[3] = bfhi(u.y); f[4] = bflo(u.z); f[5] = bfhi(u.z); f[6] = bflo(u.w); f[7] = bfhi(u.w);
}
__device__ __forceinline__ uint4 pack8(const float (&f)[8]) { uint4 u; u.x = cvt_pk(f[0], f[1]); u.y = cvt_pk(f[2], f[3]); u.z = cvt_pk(f[4], f[5]); u.w = cvt_pk(f[6], f[7]); return u; }
typedef unsigned u32x4_t __attribute__((ext_vector_type(4)));
__device__ __forceinline__ uint4 gload16(const void* p) {
    const u32x4_t v = *(const __attribute__((address_space(1))) u32x4_t*)p;
    return make_uint4(v[0], v[1], v[2], v[3]);
}
__device__ __forceinline__ float sigmoidf_(float x) { return __builtin_amdgcn_rcpf(1.0f + __expf(-x)); }
__device__ __forceinline__ float siluf_(float x) { return x * __builtin_amdgcn_rcpf(1.0f + __expf(-x)); }
__device__ __forceinline__ float tanhf_(float x) { return 1.0f - 2.0f * __builtin_amdgcn_rcpf(1.0f + __expf(2.0f * x)); }
__device__ __forceinline__ float softplusf_(float x) { return fmaxf(x, 0.f) + __logf(1.0f + __expf(-fabsf(x))); }
__device__ __forceinline__ float row16_sum(float v);
__device__ __forceinline__ float wave_sum(float v) {
    v = row16_sum(v); v += __shfl_xor(v, 16); v += __shfl_xor(v, 32);
    return v;
}
__device__ __forceinline__ float row16_sum(float v) {
    v += __builtin_amdgcn_update_dpp(0.f, v, 0x128, 0xf, 0xf, false);
    v += __builtin_amdgcn_update_dpp(0.f, v, 0x124, 0xf, 0xf, false);
    v += __builtin_amdgcn_update_dpp(0.f, v, 0x122, 0xf, 0xf, false);
    v += __builtin_amdgcn_update_dpp(0.f, v, 0x121, 0xf, 0xf, false);
    return v;
}
__device__ __forceinline__ float oct_sum(float v) {
    v += __builtin_amdgcn_update_dpp(0.f, v, 0xB1, 0xf, 0xf, false);
    v += __builtin_amdgcn_update_dpp(0.f, v, 0x4E, 0xf, 0xf, false);
    v += __builtin_amdgcn_update_dpp(0.f, v, 0x141, 0xf, 0xf, false);
    return v;
}

enum { MODE_BF16 = 0, MODE_TANH = 1, MODE_SIGM = 2, MODE_ML1 = 3, MODE_RT1 = 4 };
struct GJob { const bf16_t* A; const bf16_t* Bt; bf16_t* out; int K, N, ldo, mode, ntn, tile0; };
struct CJob { const float* src; bf16_t* dst; int K, N, nb, mode; long sbs, dbs; int tiles_pb, tile0; };
constexpr int NGJ = 20, NCJ = 24;
struct Params {
    const float* in[43]; float* out; char* ws;
    int ph_lo, ph_hi, ncj, cj_tiles;
    GJob gj[NGJ];
    CJob cj[NCJ];
};
#define CAS __attribute__((address_space(4)))
typedef const CAS Params& PRef;

__device__ __forceinline__ f32x4 mfma16(const uint4& a, const uint4& b, f32x4 c) {
    bf16x8 av, bv; __builtin_memcpy(&av, &a, 16); __builtin_memcpy(&bv, &b, 16);
    return __builtin_amdgcn_mfma_f32_16x16x32_bf16(av, bv, c, 0, 0, 0);
}
template <bool PFA = true, class AL, class BL>
__device__ __forceinline__ void gemm_mainloop(char* lds, int nk, const AL& al, const BL& bl, f32x4 (&acc)[4][4]) {
    const int t = tidx(), c = t & 7, r0 = t >> 3;
    const int lane = t & 63, wid = t >> 6, wr = wid >> 1, wc = wid & 1, fr = lane & 15, fq = lane >> 4;
    typename AL::Raw ra[4]; typename BL::Raw rb[4];
    const int woff = r0 * 128 + ((c ^ (r0 & 7)) << 4);
#pragma unroll
    for (int i = 0; i < 4; ++i) { if (PFA) ra[i] = al.fetch(i, r0 + 32 * i, c); rb[i] = bl.fetch(i, r0 + 32 * i, c); }
#pragma unroll
    for (int i = 0; i < 4; ++i) {
        if (!PFA) { ra[i] = al.fetch(i, r0 + 32 * i, c); }
        *(uint4*)(lds + woff + i * 4096) = al.finish(ra[i], i, r0 + 32 * i, c);
        *(uint4*)(lds + 16384 + woff + i * 4096) = bl.finish(rb[i], i, r0 + 32 * i, c);
        if (!PFA) asm volatile("" ::: "memory");
    }
#pragma unroll
    for (int m = 0; m < 4; ++m)
#pragma unroll
        for (int n = 0; n < 4; ++n) acc[m][n] = (f32x4){0.f, 0.f, 0.f, 0.f};
    __syncthreads();
    const int aoff = (wr * 64 + fr) * 128, boff = 16384 + (wc * 64 + fr) * 128, sw = fr & 7;
    for (int kt = 0; kt < nk; ++kt) {
        const bool more = (kt + 1 < nk);
        if (more) {
#pragma unroll
            for (int i = 0; i < 4; ++i) { if (PFA) ra[i] = al.fetch(i, r0 + 32 * i, (kt + 1) * 8 + c); rb[i] = bl.fetch(i, r0 + 32 * i, (kt + 1) * 8 + c); }
        }
        const char* buf = lds + (kt & 1) * 32768;
#pragma unroll
        for (int ks = 0; ks < 2; ++ks) {
            uint4 af[4], bfm[4];
            const int ch = ((ks * 4 + fq) ^ sw) << 4;
#pragma unroll
            for (int m = 0; m < 4; ++m) af[m] = *(const uint4*)(buf + aoff + m * 2048 + ch);
#pragma unroll
            for (int n = 0; n < 4; ++n) bfm[n] = *(const uint4*)(buf + boff + n * 2048 + ch);
#pragma unroll
            for (int m = 0; m < 4; ++m)
#pragma unroll
                for (int n = 0; n < 4; ++n) acc[m][n] = mfma16(bfm[n], af[m], acc[m][n]);
        }
        if (more) {
            char* nb = lds + ((kt + 1) & 1) * 32768;
#pragma unroll
            for (int i = 0; i < 4; ++i) {
                if (!PFA) ra[i] = al.fetch(i, r0 + 32 * i, (kt + 1) * 8 + c);
                *(uint4*)(nb + woff + i * 4096) = al.finish(ra[i], i, r0 + 32 * i, (kt + 1) * 8 + c);
                *(uint4*)(nb + 16384 + woff + i * 4096) = bl.finish(rb[i], i, r0 + 32 * i, (kt + 1) * 8 + c);
                if (!PFA) asm volatile("" ::: "memory");
            }
        }
        __syncthreads();
    }
}
__device__ __forceinline__ void glds16(const bf16_t* g, char* l) {
    __builtin_amdgcn_global_load_lds((const unsigned*)g, (LAS unsigned*)l, 16, 0, 0);
}
__device__ __forceinline__ void glds16_asm(const void* gsrc, unsigned lds_dst) {
    unsigned keep;
    asm volatile("s_mov_b32 %0, m0\n\ts_mov_b32 m0, %2\n\ts_nop 0\n\tglobal_load_lds_dwordx4 %1, off\n\ts_mov_b32 m0, %0" : "=&s"(keep) : "v"(gsrc), "s"(lds_dst) : "memory");
}
__device__ __forceinline__ unsigned lds_addr_u(const char* l) { return (unsigned)(size_t)(const LAS char*)l; }
__device__ __forceinline__ int glds_chunk(int t) { return (t & 7) ^ ((t >> 3) & 7); }
__device__ __forceinline__ void mma_ktile(const char* buf, int aoff, int boff, int sw, int fq, f32x4 (&acc)[4][4]) {
    const int ch0 = ((0 * 4 + fq) ^ sw) << 4, ch1 = ((1 * 4 + fq) ^ sw) << 4;
    const char* pa = buf + aoff; const char* pb = buf + boff;
    uint4 a0[4], a1[4], b[8];
#pragma unroll
    for (int m = 0; m < 4; ++m) a0[m] = *(const uint4*)(pa + m * 2048 + ch0);
    b[0] = *(const uint4*)(pb + ch0); b[1] = *(const uint4*)(pb + 2048 + ch0);
    __builtin_amdgcn_sched_barrier(0);
    b[2] = *(const uint4*)(pb + 2 * 2048 + ch0);
#pragma unroll
    for (int m = 0; m < 4; ++m) acc[m][0] = mfma16(b[0], a0[m], acc[m][0]);
    __builtin_amdgcn_sched_barrier(0);
    b[3] = *(const uint4*)(pb + 3 * 2048 + ch0);
#pragma unroll
    for (int m = 0; m < 4; ++m) acc[m][1] = mfma16(b[1], a0[m], acc[m][1]);
    __builtin_amdgcn_sched_barrier(0);
#pragma unroll
    for (int m = 0; m < 4; ++m) a1[m] = *(const uint4*)(pa + m * 2048 + ch1);
#pragma unroll
    for (int m = 0; m < 4; ++m) acc[m][2] = mfma16(b[2], a0[m], acc[m][2]);
    __builtin_amdgcn_sched_barrier(0);
    b[4] = *(const uint4*)(pb + ch1); b[5] = *(const uint4*)(pb + 2048 + ch1);
#pragma unroll
    for (int m = 0; m < 4; ++m) acc[m][3] = mfma16(b[3], a0[m], acc[m][3]);
    __builtin_amdgcn_sched_barrier(0);
    b[6] = *(const uint4*)(pb + 2 * 2048 + ch1);
#pragma unroll
    for (int m = 0; m < 4; ++m) acc[m][0] = mfma16(b[4], a1[m], acc[m][0]);
    __builtin_amdgcn_sched_barrier(0);
    b[7] = *(const uint4*)(pb + 3 * 2048 + ch1);
#pragma unroll
    for (int m = 0; m < 4; ++m) acc[m][1] = mfma16(b[5], a1[m], acc[m][1]);
    __builtin_amdgcn_sched_barrier(0);
#pragma unroll
    for (int m = 0; m < 4; ++m) acc[m][2] = mfma16(b[6], a1[m], acc[m][2]);
#pragma unroll
    for (int m = 0; m < 4; ++m) acc[m][3] = mfma16(b[7], a1[m], acc[m][3]);
}
__device__ __forceinline__ void gemm_gg(char* lds, int nk, const bf16_t* const (&ar)[4], const bf16_t* const (&br)[4], f32x4 (&acc)[4][4]) {
    const int t = tidx();
    const int lane = t & 63, wid = t >> 6, wr = wid >> 1, wc = wid & 1, fr = lane & 15, fq = lane >> 4;
    const unsigned wbs = (unsigned)__builtin_amdgcn_readfirstlane((int)(lds_addr_u(lds) + wid * 1024));
#pragma unroll
    for (int i = 0; i < 4; ++i) { glds16_asm(ar[i], wbs + i * 4096); glds16_asm(br[i], wbs + 16384 + i * 4096); }
#pragma unroll
    for (int m = 0; m < 4; ++m)
#pragma unroll
        for (int n = 0; n < 4; ++n) acc[m][n] = (f32x4){0.f, 0.f, 0.f, 0.f};
    asm volatile("s_waitcnt vmcnt(0)" ::: "memory");
    __syncthreads();
    const int aoff = (wr * 64 + fr) * 128, boff = 16384 + (wc * 64 + fr) * 128, sw = fr & 7;
    for (int kt = 0; kt < nk; ++kt) {
        if (kt + 1 < nk) {
            const unsigned nb = (unsigned)__builtin_amdgcn_readfirstlane((int)(wbs + ((kt + 1) & 1) * 32768));
#pragma unroll
            for (int i = 0; i < 4; ++i) { glds16_asm(ar[i] + (kt + 1) * 64, nb + i * 4096); glds16_asm(br[i] + (kt + 1) * 64, nb + 16384 + i * 4096); }
        }
        mma_ktile(lds + (kt & 1) * 32768, aoff, boff, sw, fq, acc);
        asm volatile("s_waitcnt vmcnt(0)" ::: "memory");
        __syncthreads();
    }
}
__device__ __forceinline__ void gemm_hn(char* lds, int nk, const bf16_t* const (&ar)[4], const bf16_t* const (&br)[2], f32x4 (&acc)[2][4]) {
    const int t = tidx();
    const int lane = t & 63, wid = t >> 6, fr = lane & 15, fq = lane >> 4;
    const unsigned wbs = (unsigned)__builtin_amdgcn_readfirstlane((int)(lds_addr_u(lds) + wid * 1024));
#pragma unroll
    for (int i = 0; i < 4; ++i) glds16_asm(ar[i], wbs + i * 4096);
#pragma unroll
    for (int i = 0; i < 2; ++i) glds16_asm(br[i], wbs + 16384 + i * 4096);
#pragma unroll
    for (int m = 0; m < 2; ++m)
#pragma unroll
        for (int n = 0; n < 4; ++n) acc[m][n] = (f32x4){0.f, 0.f, 0.f, 0.f};
    asm volatile("s_waitcnt vmcnt(0)" ::: "memory");
    __syncthreads();
    const int aoff = (wid * 32 + fr) * 128, boff = 16384 + fr * 128, sw = fr & 7;
    for (int kt = 0; kt < nk; ++kt) {
        if (kt + 1 < nk) {
            const unsigned nb = (unsigned)__builtin_amdgcn_readfirstlane((int)(wbs + ((kt + 1) & 1) * 32768));
#pragma unroll
            for (int i = 0; i < 4; ++i) glds16_asm(ar[i] + (kt + 1) * 64, nb + i * 4096);
#pragma unroll
            for (int i = 0; i < 2; ++i) glds16_asm(br[i] + (kt + 1) * 64, nb + 16384 + i * 4096);
        }
        const char* buf = lds + (kt & 1) * 32768;
#pragma unroll
        for (int ks = 0; ks < 2; ++ks) {
            const int ch = ((ks * 4 + fq) ^ sw) << 4;
            uint4 af[2], bfm[4];
#pragma unroll
            for (int m = 0; m < 2; ++m) af[m] = *(const uint4*)(buf + aoff + m * 2048 + ch);
#pragma unroll
            for (int n = 0; n < 4; ++n) bfm[n] = *(const uint4*)(buf + boff + n * 2048 + ch);
#pragma unroll
            for (int m = 0; m < 2; ++m)
#pragma unroll
                for (int n = 0; n < 4; ++n) acc[m][n] = mfma16(bfm[n], af[m], acc[m][n]);
        }
        asm volatile("s_waitcnt vmcnt(0)" ::: "memory");
        __syncthreads();
    }
}
template <class AL>
__device__ __forceinline__ void gemm_rg(char* lds, int nk, const AL& al, const bf16_t* const (&br)[4], f32x4 (&acc)[4][4]) {
    const int t = tidx(), c = t & 7, r0 = t >> 3;
    const int lane = t & 63, wid = t >> 6, wr = wid >> 1, wc = wid & 1, fr = lane & 15, fq = lane >> 4;
    char* wb = lds + wid * 1024;
    const int woff = r0 * 128 + ((c ^ (r0 & 7)) << 4);
#pragma unroll
    for (int i = 0; i < 4; ++i) glds16(br[i], wb + 16384 + i * 4096);
#pragma unroll
    for (int i = 0; i < 4; ++i) {
        typename AL::Raw ra = al.fetch(i, r0 + 32 * i, c);
        *(uint4*)(lds + woff + i * 4096) = al.finish(ra, i, r0 + 32 * i, c);
        asm volatile("" ::: "memory");
    }
#pragma unroll
    for (int m = 0; m < 4; ++m)
#pragma unroll
        for (int n = 0; n < 4; ++n) acc[m][n] = (f32x4){0.f, 0.f, 0.f, 0.f};
    asm volatile("s_waitcnt vmcnt(0)" ::: "memory");
    __syncthreads();
    const int aoff = (wr * 64 + fr) * 128, boff = 16384 + (wc * 64 + fr) * 128, sw = fr & 7;
    for (int kt = 0; kt < nk; ++kt) {
        const bool more = (kt + 1 < nk);
        char* nbuf = lds + ((kt + 1) & 1) * 32768;
        if (more) {
#pragma unroll
            for (int i = 0; i < 4; ++i) glds16(br[i] + (kt + 1) * 64, nbuf + wid * 1024 + 16384 + i * 4096);
        }
        mma_ktile(lds + (kt & 1) * 32768, aoff, boff, sw, fq, acc);
        if (more) {
#pragma unroll
            for (int i = 0; i < 4; ++i) {
                typename AL::Raw ra = al.fetch(i, r0 + 32 * i, (kt + 1) * 8 + c);
                *(uint4*)(nbuf + woff + i * 4096) = al.finish(ra, i, r0 + 32 * i, (kt + 1) * 8 + c);
                asm volatile("" ::: "memory");
            }
        }
        asm volatile("s_waitcnt vmcnt(0)" ::: "memory");
        __syncthreads();
    }
}
struct LdPlain {
    typedef uint4 Raw;
    const bf16_t* p; int ld; int nvalid;
    __device__ __forceinline__ uint4 fetch(int, int r, int kc) const { return (r < nvalid) ? *(const uint4*)(p + (size_t)r * ld + kc * 8) : make_uint4(0u, 0u, 0u, 0u); }
    __device__ __forceinline__ uint4 finish(const uint4& v, int, int, int) const { return v; }
};
struct LdGather {
    typedef uint4 Raw;
    const bf16_t* rp[4];
    __device__ __forceinline__ uint4 fetch(int i, int, int kc) const { const bf16_t* q = rp[i]; return q ? *(const uint4*)(q + kc * 8) : make_uint4(0u, 0u, 0u, 0u); }
    __device__ __forceinline__ uint4 finish(const uint4& v, int, int, int) const { return v; }
};
__device__ __forceinline__ void tile_map(int id, int NT, int& mt, int& nt) {
    const int x = id & 7, q = id >> 3;
    const int mg = q / (8 * NT), q2 = q - mg * 8 * NT, G = (NT + 7) >> 3;
    int g = q2 >> 6; g = g < G - 1 ? g : G - 1;
    const int r = q2 - (g << 6), w = (g == G - 1) ? NT - 8 * g : 8;
    mt = (mg * 8 + r / w) * 8 + x; nt = 8 * g + r % w;
}

__device__ __forceinline__ int conv_row(int mode, int n) {
    if (mode == 1) return (n >> 4) * 32 + (n & 15);
    if (mode == 2) return (n >> 4) * 32 + 16 + (n & 15);
    if (mode == 3 && n < 2048) { const int c = n & 255, c2 = c & 127; return (n & ~255) + (c2 >> 4) * 32 + ((c >> 7) << 4) + (c2 & 15); }
    return n;
}
__device__ __forceinline__ void phase_prologue(PRef p, char* lds) {
    const int t = tidx();
    const int n_ada = 8 * 48, n_rot = 256 + 144;
    float* mod = (float*)(p.ws + OFF_MOD);
    for (int it = blockIdx.x; it < n_ada + n_rot; it += gridDim.x) {
        if (it < n_ada) {
            const int pr = it / 48, cb = it % 48;
            float* sc = (float*)lds;
            float* red = (float*)(lds + 32768);
            for (int i = t; i < 8192; i += 256) { const int b = i >> 10, k = i & 1023; sc[k * 8 + b] = siluf_(p.in[1][b * 1024 + k]); }
            __syncthreads();
            const int kg = t >> 6, cl = t & 63, col = cb * 64 + cl;
            const float* W = p.in[2] + (size_t)pr * 1024 * 3072 + col;
            float a[8] = {0, 0, 0, 0, 0, 0, 0, 0};
#pragma unroll 8
            for (int k = kg * 256; k < kg * 256 + 256; ++k) {
                const float w = W[(size_t)k * 3072];
                const float4 s0 = *(const float4*)(sc + k * 8), s1 = *(const float4*)(sc + k * 8 + 4);
                a[0] += w * s0.x; a[1] += w * s0.y; a[2] += w * s0.z; a[3] += w * s0.w; a[4] += w * s1.x; a[5] += w * s1.y; a[6] += w * s1.z; a[7] += w * s1.w;
            }
#pragma unroll
            for (int b = 0; b < 8; ++b) red[(kg * 8 + b) * 64 + cl] = a[b];
            __syncthreads();
            for (int i = t; i < 512; i += 256) {
                const int b = i >> 6, c2 = i & 63;
                const float s = red[(0 * 8 + b) * 64 + c2] + red[(1 * 8 + b) * 64 + c2] + red[(2 * 8 + b) * 64 + c2] + red[(3 * 8 + b) * 64 + c2];
                mod[((size_t)pr * 8 + b) * 3072 + cb * 64 + c2] = s + p.in[3][pr * 3072 + cb * 64 + c2];
            }
            __syncthreads();
        } else if (it >= n_ada + 256 && it < n_ada + n_rot) {
            float* rtw = (float*)(p.ws + OFF_RTW);
            const int base = (it - n_ada - 256) * 1024;
            for (int e = base + t; e < base + 1024; e += 256) {
                const int L = e / (36 * 1024), o = (e >> 10) % 36, k = e & 1023;
                rtw[e] = (o < 4) ? p.in[36][((size_t)L * 1024 + k) * 4 + o] : p.in[38][((size_t)L * 1024 + k) * 32 + (o - 4)];
            }
        } else if (it < n_ada + 256) {
            float* rot = (float*)(p.ws + OFF_ROT);
            const int base = (it - n_ada) * 1024;
            for (int e = base + t; e < base + 1024; e += 256) {
                const int tt = e >> 7, i = e & 127;
                const float inv = __builtin_amdgcn_exp2f(-(float)i * (13.287712379549449f / 127.0f));
                const float ang = (float)tt * inv;
                float rev = ang * 0.15915494309189535f; rev -= floorf(rev);
                rot[e * 2] = __builtin_amdgcn_cosf(rev); rot[e * 2 + 1] = __builtin_amdgcn_sinf(rev);
            }
        }
    }
    {
        float* sm = (float*)lds;
        const int lane = t & 63, wv = t >> 6;
        const float* nsrc = nullptr; bf16_t* ndst = nullptr; int nK = 0, nN = 0, nmode = 0, nkt = 0, nnt = 0;
        float4 pv[16];
#define CJ_SETUP(ct_) { int c_ = (ct_), j_ = 0; while (j_ + 1 < p.ncj && c_ >= p.cj[j_ + 1].tile0) ++j_; \
            c_ -= p.cj[j_].tile0; const int tpb_ = p.cj[j_].tiles_pb; const int bi_ = c_ / tpb_, tl_ = c_ % tpb_; nK = p.cj[j_].K; nN = p.cj[j_].N; nmode = p.cj[j_].mode; \
            const int nNt_ = (nN + 255) >> 8; nkt = tl_ / nNt_; nnt = tl_ % nNt_; nsrc = p.cj[j_].src + (size_t)bi_ * p.cj[j_].sbs; ndst = p.cj[j_].dst + (size_t)bi_ * p.cj[j_].dbs; }
#define CJ_LOAD() { _Pragma("unroll") for (int i = 0; i < 16; ++i) { const int k = nkt * 64 + wv + 4 * i, n = nnt * 256 + lane * 4; \
            pv[i] = (k < nK && n < nN) ? gld_f4(nsrc + (size_t)k * nN + n) : make_float4(0.f, 0.f, 0.f, 0.f); } }
        int* const tick = (int*)(p.ws + OFF_CTL + 20480);
        int* const nbox = (int*)(lds + 66560);
        int ct = (int)blockIdx.x, ct2 = (int)gridDim.x + (int)blockIdx.x;
        if (ct < p.cj_tiles) { CJ_SETUP(ct); CJ_LOAD(); }
        while (ct < p.cj_tiles) {
#pragma unroll
            for (int i = 0; i < 16; ++i) *(float4*)(sm + (wv + 4 * i) * 260 + lane * 4) = pv[i];
            bf16_t* const sdst = ndst; const int sK = nK, sN = nN, smode = nmode, skt = nkt, snt = nnt;
            if (ct2 < p.cj_tiles) { CJ_SETUP(ct2); CJ_LOAD(); }
            if (t == 0) *nbox = 2 * (int)gridDim.x + atomicAdd(tick, 1);
            __syncthreads();
            const int ct3 = *nbox;
#pragma unroll
            for (int h2 = 0; h2 < 4; ++h2) {
                const int nl = lane + 64 * h2, n = snt * 256 + nl, k0 = skt * 64 + wv * 16;
                if (n < sN && k0 < sK) {
                    float f[8], g[8];
#pragma unroll
                    for (int q = 0; q < 8; ++q) { f[q] = sm[(wv * 16 + q) * 260 + nl]; g[q] = sm[(wv * 16 + 8 + q) * 260 + nl]; }
                    bf16_t* d = sdst + (size_t)conv_row(smode, n) * sK + k0;
                    { const uint4 u0 = pack8(f), u1 = pack8(g); gst_u4(d, u0.x, u0.y, u0.z, u0.w); gst_u4(d + 8, u1.x, u1.y, u1.z, u1.w); }
                }
            }
            __syncthreads();
            ct = ct2; ct2 = ct3;
        }
#undef CJ_SETUP
#undef CJ_LOAD
    }
}

__device__ __forceinline__ void row_load_f32(const float* p, float (&v)[16], int lane) {
#pragma unroll
    for (int c = 0; c < 4; ++c) { const float4 x = gld_f4(p + c * 256 + lane * 4); v[c * 4] = x.x; v[c * 4 + 1] = x.y; v[c * 4 + 2] = x.z; v[c * 4 + 3] = x.w; }
}
__device__ __forceinline__ void row_load_f32_l(const float* p, float (&v)[16], int lane) {
#pragma unroll
    for (int c = 0; c < 4; ++c) { const float4 x = *(const float4*)(p + c * 256 + lane * 4); v[c * 4] = x.x; v[c * 4 + 1] = x.y; v[c * 4 + 2] = x.z; v[c * 4 + 3] = x.w; }
}
__device__ __forceinline__ void row_load_bf16(const bf16_t* p, float (&v)[16], int lane) {
#pragma unroll
    for (int c = 0; c < 4; ++c) { const uint2 x = gld_u2(p + c * 256 + lane * 4); v[c * 4] = bflo(x.x); v[c * 4 + 1] = bfhi(x.x); v[c * 4 + 2] = bflo(x.y); v[c * 4 + 3] = bfhi(x.y); }
}
__device__ __forceinline__ void row_store_bf16(bf16_t* p, const float (&v)[16], int lane) {
#pragma unroll
    for (int c = 0; c < 4; ++c) gst_u2(p + c * 256 + lane * 4, cvt_pk(v[c * 4], v[c * 4 + 1]), cvt_pk(v[c * 4 + 2], v[c * 4 + 3]));
}
__device__ __forceinline__ void row_store_f32(float* p, const float (&v)[16], int lane) {
#pragma unroll
    for (int c = 0; c < 4; ++c) gst_f4(p + c * 256 + lane * 4, v[c * 4], v[c * 4 + 1], v[c * 4 + 2], v[c * 4 + 3]);
}
__device__ __forceinline__ void row_store_f32_l(float* p, const float (&v)[16], int lane) {
#pragma unroll
    for (int c = 0; c < 4; ++c) *(float4*)(p + c * 256 + lane * 4) = make_float4(v[c * 4], v[c * 4 + 1], v[c * 4 + 2], v[c * 4 + 3]);
}
__device__ __forceinline__ void row_layernorm(float (&v)[16], const float* g, const float* b, int lane) {
    float gg[16], bb[16]; row_load_f32(g, gg, lane); row_load_f32(b, bb, lane);
    float s = 0.f, q = 0.f;
#pragma unroll
    for (int i = 0; i < 16; ++i) { s += v[i]; q += v[i] * v[i]; }
    s = wave_sum(s); q = wave_sum(q);
    const float mean = s * (1.0f / 1024.0f);
    const float rstd = rsqrtf(fmaxf(q * (1.0f / 1024.0f) - mean * mean, 0.f) + LN_EPS);
#pragma unroll
    for (int i = 0; i < 16; ++i) v[i] = (v[i] - mean) * rstd * gg[i] + bb[i];
}
__device__ __forceinline__ void row_modulate(const float (&x)[16], float (&h)[16], const float* mod3, int lane) {
    float sh[16], sc[16]; row_load_f32(mod3, sh, lane); row_load_f32(mod3 + 1024, sc, lane);
#pragma unroll
    for (int i = 0; i < 16; ++i) h[i] = x[i] * (1.0f + sc[i]) + sh[i];
}
__device__ __forceinline__ void load_mu(const float* mu, float (&m)[6][16], int lane) {
#pragma unroll
    for (int n = 0; n < 6; ++n) row_load_f32(mu + n * 1024, m[n], lane);
}
__device__ __forceinline__ void emit_next(bf16_t* s0, int kind, int row, const float (&h)[16], const float (&hp)[16], const float (&m)[6][16], int lane) {
    if (kind == 0) {
#pragma unroll
        for (int n = 0; n < 6; ++n) {
#pragma unroll
            for (int c = 0; c < 4; ++c)
                gst_u2(s0 + (size_t)n * (SLOT / 2) + (size_t)row * 1024 + c * 256 + lane * 4,
                       cvt_pk(h[c * 4] + (hp[c * 4] - h[c * 4]) * m[n][c * 4], h[c * 4 + 1] + (hp[c * 4 + 1] - h[c * 4 + 1]) * m[n][c * 4 + 1]),
                       cvt_pk(h[c * 4 + 2] + (hp[c * 4 + 2] - h[c * 4 + 2]) * m[n][c * 4 + 2], h[c * 4 + 3] + (hp[c * 4 + 3] - h[c * 4 + 3]) * m[n][c * 4 + 3]));
        }
    } else row_store_bf16(s0 + (size_t)row * 1024, h, lane);
}
__device__ __forceinline__ void emit_next_l(bf16_t* s0, const float* mu, int kind, int row, const float (&h)[16], const float (&hp)[16], int lane) {
    if (kind == 0) {
#pragma unroll 1
        for (int n = 0; n < 6; ++n) {
#pragma unroll
            for (int c2 = 0; c2 < 2; ++c2) {
                const float4 ma = gld_f4(mu + n * 1024 + (2 * c2) * 256 + lane * 4), mb = gld_f4(mu + n * 1024 + (2 * c2 + 1) * 256 + lane * 4);
                const float mm[8] = {ma.x, ma.y, ma.z, ma.w, mb.x, mb.y, mb.z, mb.w};
#pragma unroll
                for (int cc = 0; cc < 2; ++cc) {
                    const int c = 2 * c2 + cc;
                    gst_u2(s0 + (size_t)n * (SLOT / 2) + (size_t)row * 1024 + c * 256 + lane * 4,
                           cvt_pk(h[c * 4] + (hp[c * 4] - h[c * 4]) * mm[cc * 4], h[c * 4 + 1] + (hp[c * 4 + 1] - h[c * 4 + 1]) * mm[cc * 4 + 1]),
                           cvt_pk(h[c * 4 + 2] + (hp[c * 4 + 2] - h[c * 4 + 2]) * mm[cc * 4 + 2], h[c * 4 + 3] + (hp[c * 4 + 3] - h[c * 4 + 3]) * mm[cc * 4 + 3]));
                }
            }
        }
    } else row_store_bf16(s0 + (size_t)row * 1024, h, lane);
}
__device__ __forceinline__ void phase_h0(PRef p) {
    const int t_ = tidx(); const int lane = t_ & 63, gw = blockIdx.x * 4 + (t_ >> 6), nw = gridDim.x * 4;
    const int rpw = NTOK / nw;
    const int r_lo = gw * rpw;
    const float* mod = (const float*)(p.ws + OFF_MOD) + ((size_t)(0 * 2 + 0) * 8 + (r_lo >> 11)) * 3072;
    float sh[16], sc[16]; row_load_f32(mod, sh, lane); row_load_f32(mod + 1024, sc, lane);
    float hp[16];
#pragma unroll
    for (int i = 0; i < 16; ++i) hp[i] = 0.f;
    float mu[6][16]; load_mu(p.in[6], mu, lane);
    const int first = ((r_lo & 2047) != 0) ? r_lo - 1 : r_lo, end = r_lo + rpw;
    float nx[16]; row_load_f32(p.in[0] + (size_t)first * 1024, nx, lane);
    for (int r = first; r < end; ++r) {
        float h[16];
#pragma unroll
        for (int i = 0; i < 16; ++i) h[i] = nx[i] * (1.0f + sc[i]) + sh[i];
        if (r + 1 < end) row_load_f32(p.in[0] + (size_t)(r + 1) * 1024, nx, lane);
        __builtin_amdgcn_sched_barrier(0);
        if (r >= r_lo) emit_next((bf16_t*)(p.ws + OFF_SLOT), 0, r, h, hp, mu, lane);
#pragma unroll
        for (int i = 0; i < 16; ++i) hp[i] = h[i];
        if (((r + 1) & 2047) == 0) {
#pragma unroll
            for (int i = 0; i < 16; ++i) hp[i] = 0.f;
        }
    }
}
__device__ __forceinline__ int layer_kind(int L) { return L % 3; }
__device__ __forceinline__ void phase_ln2(PRef p, int L) {
    const int t_ = tidx(); const int lane = t_ & 63, gw = blockIdx.x * 4 + (t_ >> 6), nw = gridDim.x * 4;
    const int rpw = NTOK / nw, r_lo = gw * rpw;
    const float* mod = (const float*)(p.ws + OFF_MOD);
    const bf16_t* xres = (const bf16_t*)(p.ws + OFF_XRES);
    const bf16_t* Y = (const bf16_t*)(p.ws + OFF_SLOT + 9 * SLOT);
    const float* wgt = (const float*)(p.ws + OFF_WGT);
    const bool last = (L == 3);
    const int nk = layer_kind(L + 1), njr = (L + 1) / 3;
    const bool need_prev = (!last && nk == 0);
    const int bidx = r_lo >> 11;
    float gt[16], lgn[16], lbn[16];
    row_load_f32(mod + ((size_t)(L * 2 + 1) * 8 + bidx) * 3072 + 2048, gt, lane);
    row_load_f32(p.in[4] + (L * 2 + 1) * 1024, lgn, lane); row_load_f32(p.in[5] + (L * 2 + 1) * 1024, lbn, lane);
    float hp[16];
#pragma unroll
    for (int i = 0; i < 16; ++i) hp[i] = 0.f;
    float shn[16], scn[16];
    { const float* mn_ = mod + ((size_t)((last ? L : L + 1) * 2 + 0) * 8 + bidx) * 3072; row_load_f32(mn_, shn, lane); row_load_f32(mn_ + 1024, scn, lane); }
    uint2 nxr[4], ny0[4], ny1[4]; float nw0, nw1;
    auto load_in = [&](int r) {
#pragma unroll
        for (int c = 0; c < 4; ++c) { nxr[c] = *(const uint2*)(xres + (size_t)r * 1024 + c * 256 + lane * 4); ny0[c] = *(const uint2*)(Y + (size_t)(2 * r) * 1024 + c * 256 + lane * 4); ny1[c] = *(const uint2*)(Y + (size_t)(2 * r + 1) * 1024 + c * 256 + lane * 4); }
        nw0 = wgt[2 * r]; nw1 = wgt[2 * r + 1];
    };
    const int first = (need_prev && (r_lo & 2047) != 0) ? r_lo - 1 : r_lo, end = r_lo + rpw;
    load_in(first);
    for (int r = first; r < end; ++r) {
        float x[16];
        {
            const float w0 = nw0, w1 = nw1;
#pragma unroll
            for (int c = 0; c < 4; ++c) {
                const float a0[4] = {bflo(ny0[c].x), bfhi(ny0[c].x), bflo(ny0[c].y), bfhi(ny0[c].y)}, a1[4] = {bflo(ny1[c].x), bfhi(ny1[c].x), bflo(ny1[c].y), bfhi(ny1[c].y)};
                const float xr[4] = {bflo(nxr[c].x), bfhi(nxr[c].x), bflo(nxr[c].y), bfhi(nxr[c].y)};
#pragma unroll
                for (int i = 0; i < 4; ++i) x[c * 4 + i] = DN_ALPHA * xr[i] + (1.0f + gt[c * 4 + i]) * (w0 * a0[i] + w1 * a1[i]);
            }
        }
        if (r + 1 < end) load_in(r + 1);
        __builtin_amdgcn_sched_barrier(0);
        float s = 0.f, q = 0.f;
#pragma unroll
        for (int i = 0; i < 16; ++i) { s += x[i]; q += x[i] * x[i]; }
        s = wave_sum(s); q = wave_sum(q);
        const float mean = s * (1.0f / 1024.0f), rstd = rsqrtf(fmaxf(q * (1.0f / 1024.0f) - mean * mean, 0.f) + LN_EPS);
#pragma unroll
        for (int i = 0; i < 16; ++i) x[i] = (x[i] - mean) * rstd * lgn[i] + lbn[i];
        if (last) { row_store_f32(p.out + (size_t)r * 1024, x, lane); continue; }
        float h[16];
#pragma unroll
        for (int i = 0; i < 16; ++i) h[i] = x[i] * (1.0f + scn[i]) + shn[i];
        if (r >= r_lo) { row_store_bf16((bf16_t*)(p.ws + OFF_XRES2) + (size_t)r * 1024, x, lane); emit_next_l((bf16_t*)(p.ws + OFF_SLOT), p.in[6] + (size_t)njr * 6 * 1024, nk, r, h, hp, lane); }
#pragma unroll
        for (int i = 0; i < 16; ++i) hp[i] = h[i];
        if (((r + 1) & 2047) == 0) {
#pragma unroll
            for (int i = 0; i < 16; ++i) hp[i] = 0.f;
        }
    }
}
__device__ __forceinline__ void phase_ln1(PRef p, int L, char* lds, const bf16_t* ymix, bf16_t* hm) {
    const int t = tidx(), lane = t & 63, wid = t >> 6;
    const float* mod = (const float*)(p.ws + OFF_MOD);
    const bf16_t* xinb = (const bf16_t*)(p.ws + OFF_XRES2);
    bf16_t* xres = (bf16_t*)(p.ws + OFF_XRES);
    int* cnt = (int*)(p.ws + OFF_CNT) + L * 32;
    int* list = (int*)(p.ws + OFF_LIST);
    float* wgt = (float*)(p.ws + OFF_WGT);
    float* const HB = (float*)lds;
    float* const lg = (float*)(lds + 65536);
    const float* rtw = (const float*)(p.ws + OFF_RTW) + (size_t)L * 36 * 1024;
    const int rpb = NTOK / gridDim.x;
    const int bidx = (blockIdx.x * rpb) >> 11;
    float gt[16], lgn[16], lbn[16], sh2[16], sc2[16];
    row_load_f32(mod + ((size_t)(L * 2 + 0) * 8 + bidx) * 3072 + 2048, gt, lane);
    row_load_f32(p.in[4] + (L * 2 + 0) * 1024, lgn, lane); row_load_f32(p.in[5] + (L * 2 + 0) * 1024, lbn, lane);
    row_load_f32(mod + ((size_t)(L * 2 + 1) * 8 + bidx) * 3072, sh2, lane); row_load_f32(mod + ((size_t)(L * 2 + 1) * 8 + bidx) * 3072 + 1024, sc2, lane);
    for (int rb0 = blockIdx.x * rpb; rb0 < (blockIdx.x + 1) * rpb; rb0 += 16) {
        const int rb = rb0 + wid * 4;
        uint4 xr[4][4]; uint2 yr[4][4];
#pragma unroll
        for (int rr = 0; rr < 4; ++rr) {
            const int r = rb + rr;
#pragma unroll
            for (int c = 0; c < 4; ++c) {
                if (L == 0) xr[rr][c] = gld_u4(p.in[0] + (size_t)r * 1024 + c * 256 + lane * 4);
                else { const uint2 t2 = gld_u2(xinb + (size_t)r * 1024 + c * 256 + lane * 4); xr[rr][c] = make_uint4(t2.x, t2.y, 0u, 0u); }
                yr[rr][c] = gld_u2(ymix + (size_t)r * 1024 + c * 256 + lane * 4);
            }
        }
#pragma unroll
        for (int rr = 0; rr < 4; ++rr) {
            const int r = rb + rr;
            float x[16], h[16];
#pragma unroll
            for (int c = 0; c < 4; ++c) {
                float xv[4];
                if (L == 0) { xv[0] = __uint_as_float(xr[rr][c].x); xv[1] = __uint_as_float(xr[rr][c].y); xv[2] = __uint_as_float(xr[rr][c].z); xv[3] = __uint_as_float(xr[rr][c].w); }
                else { xv[0] = bflo(xr[rr][c].x); xv[1] = bfhi(xr[rr][c].x); xv[2] = bflo(xr[rr][c].y); xv[3] = bfhi(xr[rr][c].y); }
                const float yv[4] = {bflo(yr[rr][c].x), bfhi(yr[rr][c].x), bflo(yr[rr][c].y), bfhi(yr[rr][c].y)};
#pragma unroll
                for (int i = 0; i < 4; ++i) x[c * 4 + i] = DN_ALPHA * xv[i] + (1.0f + gt[c * 4 + i]) * yv[i];
            }
            float s = 0.f, q = 0.f;
#pragma unroll
            for (int i = 0; i < 16; ++i) { s += x[i]; q += x[i] * x[i]; }
            s = wave_sum(s); q = wave_sum(q);
            const float mean = s * (1.0f / 1024.0f), rstd = rsqrtf(fmaxf(q * (1.0f / 1024.0f) - mean * mean, 0.f) + LN_EPS);
#pragma unroll
            for (int i = 0; i < 16; ++i) { x[i] = (x[i] - mean) * rstd * lgn[i] + lbn[i]; h[i] = x[i] * (1.0f + sc2[i]) + sh2[i]; }
            row_store_bf16(xres + (size_t)r * 1024, x, lane);
            row_store_bf16(hm + (size_t)r * 1024, h, lane);
            row_store_f32_l(HB + (wid * 4 + rr) * 1024, h, lane);
        }
        __syncthreads();
#pragma unroll 1
        for (int q3 = 0; q3 < 9; q3 += 3) {
            float w[3][16];
#pragma unroll
            for (int u = 0; u < 3; ++u) row_load_f32(rtw + (size_t)(wid * 9 + q3 + u) * 1024, w[u], lane);
#pragma unroll 2
            for (int r16 = 0; r16 < 16; ++r16) {
                float h[16]; row_load_f32_l(HB + r16 * 1024, h, lane);
                float a3[3];
#pragma unroll
                for (int u = 0; u < 3; ++u) { float s2 = 0.f;
#pragma unroll
                    for (int i = 0; i < 16; ++i) s2 += h[i] * w[u][i];
                    a3[u] = wave_sum(s2); }
                if (lane == 0) {
#pragma unroll
                    for (int u = 0; u < 3; ++u) lg[r16 * 36 + wid * 9 + q3 + u] = a3[u];
                }
            }
        }
        __syncthreads();
        if (t < 16) {
            const int row = rb0 + t; const float* l = lg + t * 36;
            float g[4]; for (int i = 0; i < 4; ++i) g[i] = l[i] + p.in[37][L * 4 + i];
            int gi = 0; for (int i = 1; i < 4; ++i) if (g[i] > g[gi]) gi = i;
            float gs = 0.f; for (int i = 0; i < 4; ++i) gs += __expf(g[i] - g[gi]);
            const float ggate = 1.0f / gs;
            float e[8]; for (int i = 0; i < 8; ++i) e[i] = l[4 + gi * 8 + i] + p.in[39][L * 32 + gi * 8 + i];
            int i0 = 0; for (int i = 1; i < 8; ++i) if (e[i] > e[i0]) i0 = i;
            int i1 = (i0 == 0) ? 1 : 0; for (int i = 0; i < 8; ++i) if (i != i0 && e[i] > e[i1]) i1 = i;
            const float p1 = __expf(e[i1] - e[i0]);
            const float w0 = ggate / (1.0f + p1), w1 = ggate * p1 / (1.0f + p1);
            const int e0 = gi * 8 + i0, e1 = gi * 8 + i1;
            const int pos0 = atomicAdd(&cnt[e0], 1), pos1 = atomicAdd(&cnt[e1], 1);
            list[e0 * LIST_CAP + pos0] = 2 * row; list[e1 * LIST_CAP + pos1] = 2 * row + 1;
            wgt[2 * row] = w0; wgt[2 * row + 1] = w1;
        }
        asm volatile("s_waitcnt lgkmcnt(0)" ::: "memory");
    }
}

__device__ __forceinline__ int perm64(int r) { return (r & 64) | (((r >> 2) & 3) << 4) | (((r >> 4) & 3) << 2) | (r & 3); }
__device__ __forceinline__ bool tile_permuted(int mode, int nt) { return (mode <= MODE_SIGM) || (mode == MODE_ML1 && nt < 24) || (mode == MODE_RT1 && nt >= 16); }
__device__ __forceinline__ void store16(bf16_t* d, const f32x4 (&v)[4]) {
    gst_u4(d, cvt_pk(v[0][0], v[0][1]), cvt_pk(v[0][2], v[0][3]), cvt_pk(v[1][0], v[1][1]), cvt_pk(v[1][2], v[1][3]));
    gst_u4(d + 8, cvt_pk(v[2][0], v[2][1]), cvt_pk(v[2][2], v[2][3]), cvt_pk(v[3][0], v[3][1]), cvt_pk(v[3][2], v[3][3]));
}
__device__ __forceinline__ void gemm_epilogue(PRef p, const GJob& jb, int mt, int nt, const f32x4 (&acc)[4][4]) {
    const int t_ = tidx(); const int lane = t_ & 63, wid = t_ >> 6, wr = wid >> 1, wc = wid & 1, fr = lane & 15, fq = lane >> 4;
    const int row0 = mt * 128 + wr * 64 + fr;
    if (jb.mode <= MODE_SIGM) {
        const int col = nt * 128 + wc * 64 + fq * 16;
        if (col < jb.N) {
#pragma unroll
            for (int m = 0; m < 4; ++m) {
                f32x4 v[4];
#pragma unroll
                for (int n = 0; n < 4; ++n) {
                    v[n] = acc[m][n];
                    if (jb.mode == MODE_TANH) { v[n][0] = tanhf_(v[n][0]); v[n][1] = tanhf_(v[n][1]); v[n][2] = tanhf_(v[n][2]); v[n][3] = tanhf_(v[n][3]); }
                    else if (jb.mode == MODE_SIGM) { v[n][0] = sigmoidf_(v[n][0]); v[n][1] = sigmoidf_(v[n][1]); v[n][2] = sigmoidf_(v[n][2]); v[n][3] = sigmoidf_(v[n][3]); }
                }
                store16(jb.out + (size_t)(row0 + m * 16) * jb.ldo + col, v);
            }
        }
    } else if (jb.mode == MODE_ML1) {
        if (nt < 24) {
            bf16_t* ob = (bf16_t*)(p.ws + OFF_SLOT + (size_t)(1 + (nt >> 3)) * SLOT);
            const bool sg = (nt >= 16);
            const int col = (nt & 7) * 128 + wc * 64 + fq * 16;
#pragma unroll
            for (int m = 0; m < 4; ++m) {
                f32x4 v[4];
#pragma unroll
                for (int n = 0; n < 4; ++n) {
                    v[n] = acc[m][n];
                    if (sg) { v[n][0] = sigmoidf_(v[n][0]); v[n][1] = sigmoidf_(v[n][1]); v[n][2] = sigmoidf_(v[n][2]); v[n][3] = sigmoidf_(v[n][3]); }
                }
                store16(ob + (size_t)(row0 + m * 16) * 1024 + col, v);
            }
        } else if (wc == 0) {
            float* gates = (float*)(p.ws + OFF_GATES);
            const float* bg = p.in[26];
            const int c0 = fq * 4;
#pragma unroll
            for (int m = 0; m < 4; ++m) {
                f32x4 v = acc[m][0], o;
#pragma unroll
                for (int j = 0; j < 4; ++j) { const float g = v[j] + bg[c0 + j]; o[j] = (c0 + j < 8) ? g : -softplusf_(-g); }
                gst_f4(gates + (size_t)(row0 + m * 16) * 16 + c0, o[0], o[1], o[2], o[3]);
            }
        }
    } else {
        if (nt < 16) {
            const float* rot = (const float*)(p.ws + OFF_ROT);
            bf16_t* ob = (bf16_t*)(p.ws + OFF_SLOT + (size_t)(1 + (nt >> 3)) * SLOT);
            const float scl = (nt >= 8) ? 0.0625f : 1.0f;
#pragma unroll
            for (int pp = 0; pp < 2; ++pp) {
                const int blk32 = (nt & 7) * 4 + wc * 2 + pp, head = blk32 >> 3, i0 = (blk32 & 7) * 16 + fq * 4;
                float4 rc0[4], rc1[4];
#pragma unroll
                for (int m = 0; m < 4; ++m) { const int tt = (row0 + m * 16) & 2047; rc0[m] = gld_f4(rot + ((size_t)tt * 128 + i0) * 2); rc1[m] = gld_f4(rot + ((size_t)tt * 128 + i0) * 2 + 4); }
#pragma unroll
                for (int m = 0; m < 4; ++m) {
                    const int row = row0 + m * 16;
                    const float4 c0 = rc0[m], c1 = rc1[m];
                    const float cs[4] = {c0.x, c0.z, c1.x, c1.z}, sn[4] = {c0.y, c0.w, c1.y, c1.w};
                    const f32x4 x1 = acc[m][2 * pp], x2 = acc[m][2 * pp + 1];
                    float o1[4], o2[4];
#pragma unroll
                    for (int j = 0; j < 4; ++j) { o1[j] = (x1[j] * cs[j] - x2[j] * sn[j]) * scl; o2[j] = (x1[j] * sn[j] + x2[j] * cs[j]) * scl; }
                    gst_u2(ob + (size_t)row * 1024 + head * 256 + i0, cvt_pk(o1[0], o1[1]), cvt_pk(o1[2], o1[3]));
                    gst_u2(ob + (size_t)row * 1024 + head * 256 + 128 + i0, cvt_pk(o2[0], o2[1]), cvt_pk(o2[2], o2[3]));
                }
            }
        } else {
            const bool isg = (nt >= 32);
            bf16_t* ob = (bf16_t*)(p.ws + OFF_SLOT + (size_t)(isg ? 5 : 3) * SLOT);
            const int col = (nt & 15) * 128 + wc * 64 + fq * 16;
#pragma unroll
            for (int m = 0; m < 4; ++m) {
                f32x4 v[4];
#pragma unroll
                for (int n = 0; n < 4; ++n) {
                    v[n] = acc[m][n];
                    if (isg) { v[n][0] = siluf_(v[n][0]); v[n][1] = siluf_(v[n][1]); v[n][2] = siluf_(v[n][2]); v[n][3] = siluf_(v[n][3]); }
                }
                store16(ob + (size_t)(row0 + m * 16) * 2048 + col, v);
            }
        }
    }
}
__device__ __forceinline__ void phase_gemm_jobs(PRef p, char* lds, int jlo, int jhi) {
    const int total = p.gj[jhi - 1].tile0 + 128 * p.gj[jhi - 1].ntn - p.gj[jlo].tile0;
    for (int id = blockIdx.x; id < total; id += gridDim.x) {
        int j = jlo; const int gid = id + p.gj[jlo].tile0;
        while (j + 1 < jhi && gid >= p.gj[j + 1].tile0) ++j;
        GJob jb; jb.A = p.gj[j].A; jb.Bt = p.gj[j].Bt; jb.out = p.gj[j].out; jb.K = p.gj[j].K; jb.N = p.gj[j].N; jb.ldo = p.gj[j].ldo; jb.mode = p.gj[j].mode; jb.ntn = p.gj[j].ntn; jb.tile0 = p.gj[j].tile0;
        int mt, nt; tile_map(gid - jb.tile0, jb.ntn, mt, nt);
        int nv = jb.N - nt * 128; nv = nv > 128 ? 128 : nv;
        const bf16_t* ar[4]; const bf16_t* br[4];
        {
            const int t_ = tidx(), r0_ = t_ >> 3, co_ = glds_chunk(t_) * 8;
            const bool pm_ = tile_permuted(jb.mode, nt);
#pragma unroll
            for (int i = 0; i < 4; ++i) {
                ar[i] = jb.A + (size_t)(mt * 128 + r0_ + 32 * i) * jb.K + co_;
                int rb_ = r0_ + 32 * i; rb_ = pm_ ? perm64(rb_) : rb_; rb_ = rb_ < nv ? rb_ : nv - 1;
                br[i] = jb.Bt + (size_t)(nt * 128 + rb_) * jb.K + co_;
            }
        }
        f32x4 acc[4][4];
        gemm_gg(lds, jb.K / 64, ar, br, acc);
        gemm_epilogue(p, jb, mt, nt, acc);
    }
}

constexpr int RM = 4;
template <int KL>
__device__ __forceinline__ void minigemm(const bf16_t* A, const bf16_t* Bt, int fr, int fq, f32x4 (&acc)[RM][4]) {
#pragma unroll
    for (int m = 0; m < RM; ++m)
#pragma unroll
        for (int n = 0; n < 4; ++n) acc[m][n] = (f32x4){0.f, 0.f, 0.f, 0.f};
#pragma unroll 2
    for (int ks = 0; ks < KL / 32; ++ks) {
        uint4 af[RM], bfm[4];
#pragma unroll
        for (int m = 0; m < RM; ++m) af[m] = gld_u4(A + (size_t)(m * 16 + fr) * KL + ks * 32 + fq * 8);
#pragma unroll
        for (int n = 0; n < 4; ++n) bfm[n] = gld_u4(Bt + (size_t)((fr >> 2) * 16 + n * 4 + (fr & 3)) * KL + ks * 32 + fq * 8);
#pragma unroll
        for (int m = 0; m < RM; ++m)
#pragma unroll
            for (int n = 0; n < 4; ++n) acc[m][n] = mfma16(bfm[n], af[m], acc[m][n]);
    }
}
__device__ __forceinline__ void phase_rw2(PRef p, int jr) {
    const int t_ = tidx(); const int lane = t_ & 63, wid = t_ >> 6, wr = wid >> 1, wc = wid & 1, fr = lane & 15, fq = lane >> 4;
    char* S = p.ws + OFF_SLOT;
    float* decay = (float*)S; bf16_t* nkk = (bf16_t*)(S + 2 * SLOT); bf16_t* bb = (bf16_t*)(S + 3 * SLOT); bf16_t* gb = (bf16_t*)(S + 4 * SLOT);
    const bf16_t* rb = (const bf16_t*)(S + 6 * SLOT); const bf16_t* kb = (const bf16_t*)(S + 7 * SLOT); bf16_t* kpb = (bf16_t*)(S + 10 * SLOT);
    const bf16_t* vb = (const bf16_t*)(S + 8 * SLOT); bf16_t* vpb = (bf16_t*)(S + 9 * SLOT); const bf16_t* vf = (const bf16_t*)(S + 11 * SLOT);
    float* bonus = (float*)(p.ws + OFF_BONUS);
    const bf16_t* Lw = (const bf16_t*)(p.ws + OFF_LW); const bf16_t* La = (const bf16_t*)(p.ws + OFF_LA);
    const bf16_t* Lg = (const bf16_t*)(p.ws + OFF_LG); const bf16_t* Lv = (const bf16_t*)(p.ws + OFF_LV);
    const bf16_t* w2t = (const bf16_t*)(p.ws + W_W2T) + (size_t)jr * 1024 * 64; const bf16_t* a2t = (const bf16_t*)(p.ws + W_A2T) + (size_t)jr * 1024 * 64;
    const bf16_t* g2t = (const bf16_t*)(p.ws + W_G2T) + (size_t)jr * 1024 * 128; const bf16_t* v2t = (const bf16_t*)(p.ws + W_V2T);
    const float* w0 = p.in[8] + jr * 1024; const float* a0 = p.in[11] + jr * 1024; const float* v0 = p.in[14];
    const float* kkw = p.in[19] + jr * 1024; const float* kaw = p.in[20] + jr * 1024; const float* rk = p.in[21] + jr * 1024;
    for (int id2 = blockIdx.x; id2 < 128 * 8; id2 += gridDim.x) {
        int mt, nt; tile_map(id2, 8, mt, nt);
        const int row0 = mt * 128 + wr * 64, col0 = nt * 128 + wc * 64, head = nt * 2 + wc;
        f32x4 acc[RM][4];
        const int c0 = col0 + fq * 16;
        minigemm<64>(La + (size_t)row0 * 64, a2t + (size_t)col0 * 64, fr, fq, acc);
        float ss[RM], bs[RM];
#pragma unroll
        for (int m = 0; m < RM; ++m) { ss[m] = 0.f; bs[m] = 0.f; }
#pragma unroll
        for (int m = 0; m < RM; ++m) {
            const size_t off = (size_t)(row0 + m * 16 + fr) * 1024 + c0;
            const uint4 kq0 = *(const uint4*)(kb + off), kq1 = *(const uint4*)(kb + off + 8);
            const unsigned kw[8] = {kq0.x, kq0.y, kq0.z, kq0.w, kq1.x, kq1.y, kq1.z, kq1.w};
#pragma unroll
            for (int n = 0; n < 4; ++n) {
                const float4 a0v = *(const float4*)(a0 + c0 + n * 4), kkv = *(const float4*)(kkw + c0 + n * 4);
                const float a0a[4] = {a0v.x, a0v.y, a0v.z, a0v.w}, kka[4] = {kkv.x, kkv.y, kkv.z, kkv.w};
                const float kf4[4] = {bflo(kw[n * 2]), bfhi(kw[n * 2]), bflo(kw[n * 2 + 1]), bfhi(kw[n * 2 + 1])};
#pragma unroll
                for (int j = 0; j < 4; ++j) { acc[m][n][j] = sigmoidf_(a0a[j] + acc[m][n][j]); const float q = kf4[j] * kka[j]; ss[m] += q * q; }
            }
            asm volatile("" ::: "memory");
        }
#pragma unroll
        for (int m = 0; m < RM; ++m) { ss[m] += __shfl_xor(ss[m], 16); ss[m] += __shfl_xor(ss[m], 32); ss[m] = fminf(__builtin_amdgcn_rsqf(ss[m]), 1e12f); }
        float4 kkq[4], kaq[4], rkq[4];
#pragma unroll
        for (int n = 0; n < 4; ++n) { kkq[n] = gld_f4(kkw + c0 + n * 4); kaq[n] = gld_f4(kaw + c0 + n * 4); rkq[n] = gld_f4(rk + c0 + n * 4); }
#pragma unroll
        for (int m = 0; m < RM; ++m) {
            const size_t off = (size_t)(row0 + m * 16 + fr) * 1024 + c0;
            const uint4 rq0 = *(const uint4*)(rb + off), rq1 = *(const uint4*)(rb + off + 8), kq0 = *(const uint4*)(kb + off), kq1 = *(const uint4*)(kb + off + 8);
            const unsigned kw[8] = {kq0.x, kq0.y, kq0.z, kq0.w, kq1.x, kq1.y, kq1.z, kq1.w};
            const unsigned rw[8] = {rq0.x, rq0.y, rq0.z, rq0.w, rq1.x, rq1.y, rq1.z, rq1.w};
            unsigned okp[8], onk[8], obb[8];
#pragma unroll
            for (int n = 0; n < 4; ++n) {
                const float kka[4] = {kkq[n].x, kkq[n].y, kkq[n].z, kkq[n].w}, kaa[4] = {kaq[n].x, kaq[n].y, kaq[n].z, kaq[n].w}, rka[4] = {rkq[n].x, rkq[n].y, rkq[n].z, rkq[n].w};
                const float rf[4] = {bflo(rw[n * 2]), bfhi(rw[n * 2]), bflo(rw[n * 2 + 1]), bfhi(rw[n * 2 + 1])}, kf4[4] = {bflo(kw[n * 2]), bfhi(kw[n * 2]), bflo(kw[n * 2 + 1]), bfhi(kw[n * 2 + 1])};
                float kp[4], nk[4], b4[4];
#pragma unroll
                for (int j = 0; j < 4; ++j) {
                    const float a = acc[m][n][j], k = kf4[j], kn = k * kka[j] * ss[m];
                    kp[j] = k * (1.0f + (a - 1.0f) * kaa[j]); nk[j] = -kn; b4[j] = kn * a; bs[m] += rf[j] * kp[j] * rka[j];
                }
                okp[n * 2] = cvt_pk(kp[0], kp[1]); okp[n * 2 + 1] = cvt_pk(kp[2], kp[3]);
                onk[n * 2] = cvt_pk(nk[0], nk[1]); onk[n * 2 + 1] = cvt_pk(nk[2], nk[3]);
                obb[n * 2] = cvt_pk(b4[0], b4[1]); obb[n * 2 + 1] = cvt_pk(b4[2], b4[3]);
            }
            *(uint4*)(kpb + off) = make_uint4(okp[0], okp[1], okp[2], okp[3]); *(uint4*)(kpb + off + 8) = make_uint4(okp[4], okp[5], okp[6], okp[7]);
            *(uint4*)(nkk + off) = make_uint4(onk[0], onk[1], onk[2], onk[3]); *(uint4*)(nkk + off + 8) = make_uint4(onk[4], onk[5], onk[6], onk[7]);
            *(uint4*)(bb + off) = make_uint4(obb[0], obb[1], obb[2], obb[3]); *(uint4*)(bb + off + 8) = make_uint4(obb[4], obb[5], obb[6], obb[7]);
            asm volatile("" ::: "memory");
        }
#pragma unroll
        for (int m = 0; m < RM; ++m) { bs[m] += __shfl_xor(bs[m], 16); bs[m] += __shfl_xor(bs[m], 32); if (fq == 0) bonus[(size_t)(row0 + m * 16 + fr) * 16 + head] = bs[m]; }
        minigemm<64>(Lw + (size_t)row0 * 64, w2t + (size_t)col0 * 64, fr, fq, acc);
        float4 w0q[4];
#pragma unroll
        for (int n = 0; n < 4; ++n) w0q[n] = gld_f4(w0 + c0 + n * 4);
#pragma unroll
        for (int n = 0; n < 4; ++n) {
            const float w0a[4] = {w0q[n].x, w0q[n].y, w0q[n].z, w0q[n].w};
#pragma unroll
            for (int m = 0; m < RM; ++m) {
                f32x4 o;
#pragma unroll
                for (int j = 0; j < 4; ++j) { const float wl = -softplusf_(-(w0a[j] + acc[m][n][j])) - 0.5f; o[j] = __expf(-__expf(wl)); }
                *(f32x4*)(decay + (size_t)(row0 + m * 16 + fr) * 1024 + c0 + n * 4) = o;
            }
        }
        minigemm<128>(Lg + (size_t)row0 * 128, g2t + (size_t)col0 * 128, fr, fq, acc);
#pragma unroll
        for (int m = 0; m < RM; ++m) {
            unsigned o[8];
#pragma unroll
            for (int n = 0; n < 4; ++n) { o[n * 2] = cvt_pk(acc[m][n][0], acc[m][n][1]); o[n * 2 + 1] = cvt_pk(acc[m][n][2], acc[m][n][3]); }
            bf16_t* d = gb + (size_t)(row0 + m * 16 + fr) * 1024 + c0;
            *(uint4*)d = make_uint4(o[0], o[1], o[2], o[3]); *(uint4*)(d + 8) = make_uint4(o[4], o[5], o[6], o[7]);
        }
        if (jr > 0) {
            minigemm<32>(Lv + (size_t)row0 * 32, v2t + (size_t)col0 * 32, fr, fq, acc);
#pragma unroll
            for (int m = 0; m < RM; ++m) {
                const size_t off = (size_t)(row0 + m * 16 + fr) * 1024 + c0;
                const uint4 vq0 = *(const uint4*)(vb + off), vq1 = *(const uint4*)(vb + off + 8), fq0 = *(const uint4*)(vf + off), fq1 = *(const uint4*)(vf + off + 8);
                const unsigned vw[8] = {vq0.x, vq0.y, vq0.z, vq0.w, vq1.x, vq1.y, vq1.z, vq1.w}, fw[8] = {fq0.x, fq0.y, fq0.z, fq0.w, fq1.x, fq1.y, fq1.z, fq1.w};
                unsigned o[8];
#pragma unroll
                for (int n = 0; n < 4; ++n) {
                    const float4 v0v = *(const float4*)(v0 + c0 + n * 4); const float v0a[4] = {v0v.x, v0v.y, v0v.z, v0v.w};
                    const float v4[4] = {bflo(vw[n * 2]), bfhi(vw[n * 2]), bflo(vw[n * 2 + 1]), bfhi(vw[n * 2 + 1])}, f4[4] = {bflo(fw[n * 2]), bfhi(fw[n * 2]), bflo(fw[n * 2 + 1]), bfhi(fw[n * 2 + 1])};
                    float o4[4];
#pragma unroll
                    for (int j = 0; j < 4; ++j) o4[j] = v4[j] + (f4[j] - v4[j]) * sigmoidf_(v0a[j] + acc[m][n][j]);
                    o[n * 2] = cvt_pk(o4[0], o4[1]); o[n * 2 + 1] = cvt_pk(o4[2], o4[3]);
                }
                *(uint4*)(vpb + off) = make_uint4(o[0], o[1], o[2], o[3]); *(uint4*)(vpb + off + 8) = make_uint4(o[4], o[5], o[6], o[7]);
            }
        }
    }
}
__device__ __forceinline__ void phase_rw3(PRef p, int jr, char* lds) {
    const int t = tidx(), lane = t & 63, wid = t >> 6, rowq = lane >> 4, jq = lane & 15;
    char* S = p.ws + OFF_SLOT;
    const float* decay = (const float*)S; const bf16_t* nkk = (const bf16_t*)(S + 2 * SLOT); const bf16_t* bb = (const bf16_t*)(S + 3 * SLOT);
    const bf16_t* rb = (const bf16_t*)(S + 6 * SLOT); const bf16_t* kb = (const bf16_t*)(S + 10 * SLOT);
    const bf16_t* vb = (const bf16_t*)(S + (jr == 0 ? 11 : 9) * SLOT); bf16_t* yb = (bf16_t*)(S + 5 * SLOT);
    float* buf = (float*)lds;
    float* ybuf = (float*)(lds + 2 * 16 * 336 * 4);
    for (int item = blockIdx.x; item < 512; item += gridDim.x) {
        const int bh = item >> 2, rg = item & 3, b = bh >> 4, h = bh & 15;
        const size_t base = (size_t)b * 2048 * 1024 + h * 64;
        const bf16_t* vecp[2]; int vdst[2];
#pragma unroll
        for (int u = 0; u < 2; ++u) {
            const int id = t + 256 * u, vec = id >> 7, rem = id & 127, step = rem >> 3, c8 = rem & 7;
            const bf16_t* bp = (vec == 0) ? nkk : (vec == 1) ? bb : (vec == 2) ? kb : rb;
            vecp[u] = bp + base + (size_t)step * 1024 + c8 * 8; vdst[u] = step * 336 + 64 + vec * 64 + c8 * 8;
        }
        const float* dp = decay + base + (size_t)(t >> 4) * 1024 + (t & 15) * 4; const int ddst = (t >> 4) * 336 + (t & 15) * 4;
        const bf16_t* vp = vb + base + (size_t)(t >> 1) * 1024 + rg * 16 + (t & 1) * 8; const int vvdst = (t >> 1) * 336 + 320 + (t & 1) * 8;
        uint4 g0, g1, gv; float4 gd;
        auto fetch = [&](int ch) {
            const size_t o = (size_t)ch * 16 * 1024;
            g0 = gload16(vecp[0] + o); g1 = gload16(vecp[1] + o);
            { const uint4 d_ = gload16(dp + o); gd = make_float4(__uint_as_float(d_.x), __uint_as_float(d_.y), __uint_as_float(d_.z), __uint_as_float(d_.w)); }
            if (t < 32) gv = gload16(vp + o);
        };
        auto stash = [&](float* bf) {
            float f[8];
            unpack8(g0, f); *(float4*)(bf + vdst[0]) = make_float4(f[0], f[1], f[2], f[3]); *(float4*)(bf + vdst[0] + 4) = make_float4(f[4], f[5], f[6], f[7]);
            unpack8(g1, f); *(float4*)(bf + vdst[1]) = make_float4(f[0], f[1], f[2], f[3]); *(float4*)(bf + vdst[1] + 4) = make_float4(f[4], f[5], f[6], f[7]);
            *(float4*)(bf + ddst) = gd;
            if (t < 32) { unpack8(gv, f); *(float4*)(bf + vvdst) = make_float4(f[0], f[1], f[2], f[3]); *(float4*)(bf + vvdst + 4) = make_float4(f[4], f[5], f[6], f[7]); }
        };
        float s0 = 0.f, s1 = 0.f, s2 = 0.f, s3 = 0.f;
        __syncthreads();
        fetch(0); stash(buf); __syncthreads();
        for (int ch = 0; ch < 128; ++ch) {
            if (ch + 1 < 128) fetch(ch + 1);
            const float* bf = buf + (ch & 1) * (16 * 336); float* yb_ = ybuf + (ch & 1) * 256;
            float ykeep = 0.f;
            const float* q0 = bf + jq * 4; const float* v0p = bf + 320 + wid * 4 + rowq;
            float4 nw = *(const float4*)q0, na = *(const float4*)(q0 + 64), nb2 = *(const float4*)(q0 + 128), nk = *(const float4*)(q0 + 192), nr = *(const float4*)(q0 + 256);
            float nv = v0p[0];
#pragma unroll 4
            for (int s = 0; s < 16; ++s) {
                const float4 w = nw, a = na, bq = nb2, k = nk, r = nr; const float vv = nv;
                const float* q = q0 + (s + 1) * 336;
                nw = *(const float4*)q; na = *(const float4*)(q + 64); nb2 = *(const float4*)(q + 128); nk = *(const float4*)(q + 192); nr = *(const float4*)(q + 256);
                nv = v0p[(s + 1) * 336];
                __builtin_amdgcn_sched_barrier(0);
                float sa = s0 * a.x; sa = fmaf(s1, a.y, sa); sa = fmaf(s2, a.z, sa); sa = fmaf(s3, a.w, sa);
                sa = row16_sum(sa);
                s0 = fmaf(s0, w.x, fmaf(sa, bq.x, vv * k.x)); s1 = fmaf(s1, w.y, fmaf(sa, bq.y, vv * k.y));
                s2 = fmaf(s2, w.z, fmaf(sa, bq.z, vv * k.z)); s3 = fmaf(s3, w.w, fmaf(sa, bq.w, vv * k.w));
                float y = s0 * r.x; y = fmaf(s1, r.y, y); y = fmaf(s2, r.z, y); y = fmaf(s3, r.w, y);
                y = row16_sum(y);
                ykeep = (jq == s) ? y : ykeep;
            }
            yb_[jq * 16 + wid * 4 + rowq] = ykeep;
            if (ch + 1 < 128) stash(buf + ((ch + 1) & 1) * (16 * 336));
            __syncthreads();
            if (t < 32) { const int step = t >> 1, hf = t & 1; float f[8];
#pragma unroll
                for (int i = 0; i < 8; ++i) f[i] = yb_[step * 16 + hf * 8 + i];
                *(uint4*)(yb + base + (size_t)(ch * 16 + step) * 1024 + rg * 16 + hf * 8) = pack8(f); }
        }
    }
}
__device__ __forceinline__ uint2 lds_tr16(const char* p) {
    typedef short v4s_t __attribute__((ext_vector_type(4)));
    const v4s_t r = __builtin_amdgcn_ds_read_tr16_b64_v4i16((LAS v4s_t*)p);
    uint2 u; __builtin_memcpy(&u, &r, 8); return u;
}
__device__ __forceinline__ int sw64(int row, int col) { return row * 128 + ((((col >> 3) ^ (row & 7))) << 4) + (col & 7) * 2; }
__device__ __forceinline__ void phase_rw3c(PRef p, int jr, char* lds) {
    const int t = tidx(), lane = t & 63, w = t >> 6, fr = lane & 15, fq = lane >> 4;
    char* S = p.ws + OFF_SLOT;
    const float* decay = (const float*)S; const bf16_t* nkk = (const bf16_t*)(S + 2 * SLOT); const bf16_t* bb = (const bf16_t*)(S + 3 * SLOT);
    const bf16_t* rb = (const bf16_t*)(S + 6 * SLOT); const bf16_t* kb = (const bf16_t*)(S + 10 * SLOT);
    const bf16_t* vb = (const bf16_t*)(S + (jr == 0 ? 11 : 9) * SLOT); bf16_t* yb = (bf16_t*)(S + 5 * SLOT);
    char* const AT = lds;              char* const RT = lds + 4096;  char* const BT = lds + 8192;  char* const KT = lds + 12288;
    float* const PL = (float*)(lds + 16384);
    float* const GAB = (float*)(lds + 43264);
    char* const GAK = lds + 28672;     char* const GRB = lds + 30720; char* const GRK = lds + 32768;
    char* const VT = lds + 34816;      char* const UT = lds + 35840;
    char* const SB = lds + 36864;
    float* const XL = (float*)(lds + 38912);
    float* const PC = (float*)(lds + 40960);
    float* const GS = (float*)(lds + 41216);
    bf16_t* const YB = (bf16_t*)(lds + 42240);
    const int pj = t & 63, ptg = t >> 6;
    const int tk = t >> 3, ck = t & 7;
    const int vtau = t >> 3, vi2 = (t & 7) * 2;
    const int qq = fr >> 2, pp = fr & 3;
    for (int item = blockIdx.x; item < 512; item += gridDim.x) {
        const int bh = ((item >> 3) >> 2) * 8 + (item & 7), rg = (item >> 3) & 3, b = bh >> 4, h = bh & 15;
        const size_t base = (size_t)b * 2048 * 1024 + h * 64;
        __syncthreads();
        for (int i = t; i < 128; i += 256) *(uint4*)(SB + i * 16) = make_uint4(0u, 0u, 0u, 0u);
        f32x4 Sacc = (f32x4){0.f, 0.f, 0.f, 0.f};
        float gw[8]; uint4 ra, rb4, rk, rr, rw0, rw1; unsigned gvv = 0;
        auto fetch = [&](int c) {
#pragma unroll
            for (int s2 = 0; s2 < 8; ++s2) gw[s2] = *(const __attribute__((address_space(1))) float*)(decay + base + (size_t)(c * 32 + ptg * 8 + s2) * 1024 + pj);
            const size_t o = base + (size_t)(c * 32 + tk) * 1024 + ck * 8;
            ra = gload16(nkk + o); rb4 = gload16(bb + o); rk = gload16(kb + o); rr = gload16(rb + o); rw0 = gload16(decay + o); rw1 = gload16(decay + o + 4);
            gvv = *(const __attribute__((address_space(1))) unsigned*)(vb + base + (size_t)(c * 32 + vtau) * 1024 + rg * 16 + vi2);
        };
        fetch(0);
        for (int c = 0; c < 64; ++c) {
            {
                float cum[8]; float run = 0.f;
#pragma unroll
                for (int s2 = 0; s2 < 8; ++s2) { run += __builtin_amdgcn_logf(gw[s2]); cum[s2] = run; }
                GS[ptg * 64 + pj] = run;
                __syncthreads();
                const float g0 = GS[pj], g1 = GS[64 + pj], g2 = GS[128 + pj], g3 = GS[192 + pj];
                const float off = (ptg > 0 ? g0 : 0.f) + (ptg > 1 ? g1 : 0.f) + (ptg > 2 ? g2 : 0.f);
                if (ptg == 0) PC[pj] = __builtin_amdgcn_exp2f((g0 + g1) + (g2 + g3));
#pragma unroll
                for (int s2 = 0; s2 < 8; ++s2) PL[(ptg * 8 + s2) * 64 + pj] = __builtin_amdgcn_exp2f(off + cum[s2]);
            }
            __syncthreads();
            {
                const float4 p0 = *(const float4*)(PL + tk * 64 + ck * 8), p1 = *(const float4*)(PL + tk * 64 + ck * 8 + 4);
                const unsigned ua[4] = {ra.x, ra.y, ra.z, ra.w}, ub[4] = {rb4.x, rb4.y, rb4.z, rb4.w}, uk[4] = {rk.x, rk.y, rk.z, rk.w}, ur[4] = {rr.x, rr.y, rr.z, rr.w};
                const f32x2_t Pp[4] = {{p0.x, p0.y}, {p0.z, p0.w}, {p1.x, p1.y}, {p1.z, p1.w}};
                const f32x2_t Wp[4] = {{__uint_as_float(rw0.x), __uint_as_float(rw0.y)}, {__uint_as_float(rw0.z), __uint_as_float(rw0.w)}, {__uint_as_float(rw1.x), __uint_as_float(rw1.y)}, {__uint_as_float(rw1.z), __uint_as_float(rw1.w)}};
                unsigned oa[4], orr[4], ob[4], ok[4];
#pragma unroll
                for (int i = 0; i < 4; ++i) {
                    const f32x2_t ei = {__builtin_amdgcn_rcpf(Pp[i].x), __builtin_amdgcn_rcpf(Pp[i].y)};
                    const f32x2_t rw = {__builtin_amdgcn_rcpf(Wp[i].x), __builtin_amdgcn_rcpf(Wp[i].y)};
                    const f32x2_t ex = Pp[i] * rw;
                    const f32x2_t va = {__uint_as_float(ua[i] << 16), __uint_as_float(ua[i] & 0xffff0000u)}, vr = {__uint_as_float(ur[i] << 16), __uint_as_float(ur[i] & 0xffff0000u)};
                    const f32x2_t vb2 = {__uint_as_float(ub[i] << 16), __uint_as_float(ub[i] & 0xffff0000u)}, vk = {__uint_as_float(uk[i] << 16), __uint_as_float(uk[i] & 0xffff0000u)};
                    const f32x2_t xa = va * ex, xr = vr * Pp[i], xb = vb2 * ei, xk = vk * ei;
                    oa[i] = cvt_pk(xa.x, xa.y); orr[i] = cvt_pk(xr.x, xr.y); ob[i] = cvt_pk(xb.x, xb.y); ok[i] = cvt_pk(xk.x, xk.y);
                }
                const int o = tk * 128 + ((ck ^ (tk & 7)) << 4);
                *(uint4*)(AT + o) = make_uint4(oa[0], oa[1], oa[2], oa[3]); *(uint4*)(RT + o) = make_uint4(orr[0], orr[1], orr[2], orr[3]);
                *(uint4*)(BT + o) = make_uint4(ob[0], ob[1], ob[2], ob[3]); *(uint4*)(KT + o) = make_uint4(ok[0], ok[1], ok[2], ok[3]);
                *(bf16_t*)(VT + vi2 * 64 + vtau * 2) = (bf16_t)(gvv & 0xffffu);
                *(bf16_t*)(VT + (vi2 + 1) * 64 + vtau * 2) = (bf16_t)(gvv >> 16);
            }
            if (c + 1 < 64) fetch(c + 1);
            __syncthreads();
            {
                const char* Mt = (w < 2) ? AT : RT; const char* Nt = (w & 1) ? BT : KT;
                f32x4 g[2][2];
#pragma unroll
                for (int m = 0; m < 2; ++m) { g[m][0] = (f32x4){0.f, 0.f, 0.f, 0.f}; g[m][1] = (f32x4){0.f, 0.f, 0.f, 0.f}; }
#pragma unroll
                for (int ks = 0; ks < 2; ++ks) {
                    const int chs = ((ks * 4 + fq) ^ (fr & 7)) << 4;
                    uint4 mf[2], nf[2];
#pragma unroll
                    for (int m = 0; m < 2; ++m) { mf[m] = *(const uint4*)(Mt + (m * 16 + fr) * 128 + chs); nf[m] = *(const uint4*)(Nt + (m * 16 + fr) * 128 + chs); }
#pragma unroll
                    for (int m = 0; m < 2; ++m)
#pragma unroll
                        for (int n = 0; n < 2; ++n) g[m][n] = mfma16(nf[n], mf[m], g[m][n]);
                }
#pragma unroll
                for (int m = 0; m < 2; ++m)
#pragma unroll
                    for (int n = 0; n < 2; ++n) {
                        const int tt = m * 16 + fr, tau0 = n * 16 + fq * 4;
                        f32x4 v4;
#pragma unroll
                        for (int j = 0; j < 4; ++j) { const int tau = tau0 + j; const bool keep = (w < 2) ? (tau < tt) : (tau <= tt); v4[j] = keep ? g[m][n][j] : 0.f; }
                        if (w == 1) *(f32x4*)(GAB + tt * 36 + tau0) = v4;
                        else {
                            char* G = (w == 0) ? GAK : (w == 2) ? GRK : GRB;
                            uint2 o; o.x = cvt_pk(v4[0], v4[1]); o.y = cvt_pk(v4[2], v4[3]);
                            *(uint2*)(G + tt * 64 + tau0 * 2) = o;
                        }
                    }
            }
            __syncthreads();
            if (w < 2) {
                f32x4 x = (f32x4){0.f, 0.f, 0.f, 0.f};
#pragma unroll
                for (int ks = 0; ks < 2; ++ks) {
                    const int chs = ((ks * 4 + fq) ^ (fr & 7)) << 4;
                    x = mfma16(*(const uint4*)(AT + (w * 16 + fr) * 128 + chs), *(const uint4*)(SB + fr * 128 + chs), x);
                }
                x = mfma16(*(const uint4*)(GAK + (w * 16 + fr) * 64 + fq * 16), *(const uint4*)(VT + fr * 64 + fq * 16), x);
                *(f32x4*)(XL + fr * 32 + w * 16 + fq * 4) = x;
            }
            __syncthreads();
            {
                const int tl = lane & 31;
                float Gr[32];
#pragma unroll
                for (int q4 = 0; q4 < 8; ++q4) { const float4 g4 = *(const float4*)(GAB + tl * 36 + q4 * 4); Gr[q4 * 4] = g4.x; Gr[q4 * 4 + 1] = g4.y; Gr[q4 * 4 + 2] = g4.z; Gr[q4 * 4 + 3] = g4.w; }
                float acc[4];
#pragma unroll
                for (int r = 0; r < 4; ++r) acc[r] = XL[(4 * w + r) * 32 + tl];
#pragma unroll
                for (int tau = 0; tau < 31; ++tau)
#pragma unroll
                    for (int r = 0; r < 4; ++r) acc[r] = fmaf(__int_as_float(__builtin_amdgcn_readlane(__float_as_int(acc[r]), tau)), Gr[tau], acc[r]);
                if (lane < 32) {
#pragma unroll
                    for (int r = 0; r < 4; ++r) *(bf16_t*)(UT + (4 * w + r) * 64 + tl * 2) = f2bf(acc[r]);
                }
            }
            __syncthreads();
            if (w < 2) {
                f32x4 y = (f32x4){0.f, 0.f, 0.f, 0.f};
#pragma unroll
                for (int ks = 0; ks < 2; ++ks) {
                    const int chs = ((ks * 4 + fq) ^ (fr & 7)) << 4;
                    y = mfma16(*(const uint4*)(RT + (w * 16 + fr) * 128 + chs), *(const uint4*)(SB + fr * 128 + chs), y);
                }
                y = mfma16(*(const uint4*)(GRB + (w * 16 + fr) * 64 + fq * 16), *(const uint4*)(UT + fr * 64 + fq * 16), y);
                y = mfma16(*(const uint4*)(GRK + (w * 16 + fr) * 64 + fq * 16), *(const uint4*)(VT + fr * 64 + fq * 16), y);
#pragma unroll
                for (int j = 0; j < 4; ++j) YB[(w * 16 + fq * 4 + j) * 16 + fr] = f2bf(y[j]);
            }
            {
                const int r0 = fq * 8 + qq, kc = 2 * w + (pp >> 1);
                const int o0 = r0 * 128 + ((kc ^ (r0 & 7)) << 4) + (pp & 1) * 8, o1 = (r0 + 4) * 128 + ((kc ^ ((r0 + 4) & 7)) << 4) + (pp & 1) * 8;
                const uint2 blo = lds_tr16(BT + o0), bhi = lds_tr16(BT + o1), klo = lds_tr16(KT + o0), khi = lds_tr16(KT + o1);
                Sacc = mfma16(make_uint4(blo.x, blo.y, bhi.x, bhi.y), *(const uint4*)(UT + fr * 64 + fq * 16), Sacc);
                Sacc = mfma16(make_uint4(klo.x, klo.y, khi.x, khi.y), *(const uint4*)(VT + fr * 64 + fq * 16), Sacc);
                const float4 pc = *(const float4*)(PC + 16 * w + fq * 4);
                Sacc[0] *= pc.x; Sacc[1] *= pc.y; Sacc[2] *= pc.z; Sacc[3] *= pc.w;
            }
            __syncthreads();
            {
                uint2 o; o.x = cvt_pk(Sacc[0], Sacc[1]); o.y = cvt_pk(Sacc[2], Sacc[3]);
                *(uint2*)(SB + fr * 128 + ((((2 * w + (fq >> 1))) ^ (fr & 7)) << 4) + (fq & 1) * 8) = o;
                if (t < 64) {
                    const int tt = t >> 1, hf = t & 1;
                    const uint4 yv_ = *(const uint4*)((const char*)YB + tt * 32 + hf * 16); const u32x4_t yx_ = {yv_.x, yv_.y, yv_.z, yv_.w};
                    *(__attribute__((address_space(1))) u32x4_t*)(yb + base + (size_t)(c * 32 + tt) * 1024 + rg * 16 + hf * 8) = yx_;
                }
            }
        }
    }
}
struct LdRw4 {
    struct Raw { uint4 y, v, g; float bn; };
    const bf16_t *y, *v, *g; const float *bonus, *gng, *gnb;
    __device__ __forceinline__ Raw fetch(int, int r, int kc) const {
        Raw q; const size_t o = (size_t)r * 1024 + kc * 8;
        q.y = *(const uint4*)(y + o); q.v = *(const uint4*)(v + o); q.g = *(const uint4*)(g + o); q.bn = bonus[r * 16 + (kc >> 3)]; return q;
    }
    __device__ __forceinline__ uint4 finish(const Raw& q, int, int, int kc) const {
        float yf[8], vf[8], gf[8]; unpack8(q.y, yf); unpack8(q.v, vf); unpack8(q.g, gf);
        float s = 0.f, s2 = 0.f;
#pragma unroll
        for (int i = 0; i < 8; ++i) { s += yf[i]; s2 += yf[i] * yf[i]; }
        s = oct_sum(s); s2 = oct_sum(s2);
        const float mean = s * (1.0f / 64.0f), var = fmaxf(s2 * (1.0f / 64.0f) - mean * mean, 0.f), rstd = rsqrtf(var + 64e-5f);
        const float4 ga = *(const float4*)(gng + kc * 8), gb = *(const float4*)(gng + kc * 8 + 4), ba = *(const float4*)(gnb + kc * 8), bb = *(const float4*)(gnb + kc * 8 + 4);
        const float gg[8] = {ga.x, ga.y, ga.z, ga.w, gb.x, gb.y, gb.z, gb.w}, bq[8] = {ba.x, ba.y, ba.z, ba.w, bb.x, bb.y, bb.z, bb.w};
        float o[8];
#pragma unroll
        for (int i = 0; i < 8; ++i) o[i] = ((yf[i] - mean) * rstd * gg[i] + bq[i] + q.bn * vf[i]) * gf[i];
        return pack8(o);
    }
};
__device__ __forceinline__ void phase_rw4(PRef p, int jr, char* lds) {
    char* S = p.ws + OFF_SLOT;
    const bf16_t* yb = (const bf16_t*)(S + 5 * SLOT); const bf16_t* gb = (const bf16_t*)(S + 4 * SLOT);
    const bf16_t* vb = (const bf16_t*)(S + (jr == 0 ? 11 : 9) * SLOT); bf16_t* ymix = (bf16_t*)(S + 6 * SLOT);
    const bf16_t* wt = (const bf16_t*)(p.ws + W_OUT) + (size_t)jr * 1024 * 1024;
    const float* bonus = (const float*)(p.ws + OFF_BONUS);
    const int t_ = tidx(); const int lane = t_ & 63, wid = t_ >> 6, wr = wid >> 1, wc = wid & 1, fr = lane & 15, fq = lane >> 4;
    for (int id = blockIdx.x; id < 128 * 8; id += gridDim.x) {
        int mt, nt; tile_map(id, 8, mt, nt);
        const size_t ro = (size_t)mt * 128 * 1024;
        LdRw4 al{yb + ro, vb + ro, gb + ro, bonus + (size_t)mt * 128 * 16, p.in[22] + jr * 1024, p.in[23] + jr * 1024};
        const bf16_t* br[4];
        { const int t2_ = tidx(), r0_ = t2_ >> 3, co_ = glds_chunk(t2_) * 8;
#pragma unroll
          for (int i = 0; i < 4; ++i) br[i] = wt + (size_t)(nt * 128 + r0_ + 32 * i) * 1024 + co_; }
        f32x4 acc[4][4];
        gemm_rg(lds, 16, al, br, acc);
#pragma unroll
        for (int n = 0; n < 4; ++n)
#pragma unroll
            for (int m = 0; m < 4; ++m) {
                uint2 o; o.x = cvt_pk(acc[m][n][0], acc[m][n][1]); o.y = cvt_pk(acc[m][n][2], acc[m][n][3]);
                *(uint2*)(ymix + (size_t)(mt * 128 + wr * 64 + m * 16 + fr) * 1024 + nt * 128 + wc * 64 + n * 16 + fq * 4) = o;
            }
    }
}

__device__ __forceinline__ void phase_cml(PRef p) {
    const int t = tidx();
    char* S = p.ws + OFF_SLOT;
    const bf16_t* src = (const bf16_t*)(S + 1 * SLOT); bf16_t* dst = (bf16_t*)(S + 8 * SLOT);
    const int col = (t & 127) * 8, half = t >> 7;
    float cw[4][8], cb[8];
#pragma unroll
    for (int j = 0; j < 4; ++j) {
        const float4 a = *(const float4*)(p.in[27] + j * 1024 + col), b = *(const float4*)(p.in[27] + j * 1024 + col + 4);
        cw[j][0] = a.x; cw[j][1] = a.y; cw[j][2] = a.z; cw[j][3] = a.w; cw[j][4] = b.x; cw[j][5] = b.y; cw[j][6] = b.z; cw[j][7] = b.w;
    }
    { const float4 a = *(const float4*)(p.in[28] + col), b = *(const float4*)(p.in[28] + col + 4);
      cb[0] = a.x; cb[1] = a.y; cb[2] = a.z; cb[3] = a.w; cb[4] = b.x; cb[5] = b.y; cb[6] = b.z; cb[7] = b.w; }
    const float qs = (col < 512) ? 0.125f : 1.0f;
    for (int item = blockIdx.x; item < 1024; item += gridDim.x) {
        const int b = item >> 7, s0 = (item & 127) * 16 + half * 8;
        const bf16_t* base = src + (size_t)b * 2048 * 1024 + col;
        uint4 r[11];
#pragma unroll
        for (int i = 0; i < 11; ++i) { const int sr = s0 - 3 + i; r[i] = gload16(base + (size_t)max(sr, 0) * 1024); if (sr < 0) r[i] = make_uint4(0u, 0u, 0u, 0u); }
        float x0[8], x1[8], x2[8];
        unpack8(r[0], x0); unpack8(r[1], x1); unpack8(r[2], x2);
#pragma unroll
        for (int i = 0; i < 8; ++i) {
            float x3[8], a[8]; unpack8(r[i + 3], x3);
#pragma unroll
            for (int e = 0; e < 8; ++e) { a[e] = cb[e] + cw[0][e] * x0[e] + cw[1][e] * x1[e] + cw[2][e] * x2[e] + cw[3][e] * x3[e]; a[e] = siluf_(a[e]) * qs; }
            *(uint4*)(dst + ((size_t)b * 2048 + s0 + i) * 1024 + col) = pack8(a);
#pragma unroll
            for (int e = 0; e < 8; ++e) { x0[e] = x1[e]; x1[e] = x2[e]; x2[e] = x3[e]; }
        }
    }
}
__device__ __forceinline__ void phase_ml2(PRef p, char* lds) {
    const int t = tidx(), lane = t & 63, w = t >> 6, fr = lane & 15, fq = lane >> 4;
    char* S = p.ws + OFF_SLOT;
    const bf16_t* qk = (const bf16_t*)(S + 8 * SLOT); const bf16_t* vb = (const bf16_t*)(S + 2 * SLOT); bf16_t* yb = (bf16_t*)(S + 4 * SLOT);
    const float* gates = (const float*)(p.ws + OFF_GATES); float* stat = (float*)(p.ws + OFF_STAT);
    char* const RAW = lds;
    char* const QT = lds + 17408; char* const KT = lds + 25600;
    char* const VT = lds + 33792;
    char* const VX = lds + 35840;
    char* const PB = lds + 39936;
    char* const CT = lds + 48128;
    float* const FS = (float*)(lds + 52224); float* const GJ = FS + 64; float* const WJ = FS + 128;
    float* const CW = (float*)(lds + 53248);
    const int qq = fr >> 2, pp = fr & 3;
    for (int item = blockIdx.x; item < 512; item += gridDim.x) {
        const int bh = ((item >> 3) >> 3) * 8 + (item & 7), vs = (item >> 3) & 7, b = bh >> 3, hd = bh & 7;
        const size_t tok0 = (size_t)b * 2048;
        __syncthreads();
        for (int i = t; i < 256; i += 256) *(uint4*)(CT + i * 16) = make_uint4(0u, 0u, 0u, 0u);
        f32x4 Cacc[2] = {(f32x4){0.f, 0.f, 0.f, 0.f}, (f32x4){0.f, 0.f, 0.f, 0.f}};
        uint4 gr0, gr1, gr2, gr3; uint4 gv = make_uint4(0u, 0u, 0u, 0u); float gg = 0.f;
        const int frr = t >> 4, fc = t & 15;
        const bf16_t* const qkt = qk + (tok0 + frr) * 1024 + (fc >> 3) * 512 + hd * 64 + (fc & 7) * 8;
        char* const qkd = ((fc < 8) ? QT : KT) + frr * 128 + (((fc & 7) ^ (frr & 7)) << 4);
        auto fetch = [&](int ch) {
            const int s0 = ch * 64;
            const bf16_t* q0 = qkt + (size_t)s0 * 1024;
            gr0 = gload16(q0); gr1 = gload16(q0 + 16 * 1024); gr2 = gload16(q0 + 32 * 1024); gr3 = gload16(q0 + 48 * 1024);
            if (t < 128) { gv = gload16(vb + (tok0 + s0 + (t >> 1)) * 1024 + hd * 128 + vs * 16 + (t & 1) * 8);
                           gg = *(const __attribute__((address_space(1))) float*)(gates + (tok0 + s0 + (t & 63)) * 16 + (t >> 6) * 8 + hd); }
        };
        fetch(0);
        for (int ch = 0; ch < 32; ++ch) {
            const int s0 = ch * 64;
            *(uint4*)qkd = gr0; *(uint4*)(qkd + 16 * 128) = gr1; *(uint4*)(qkd + 32 * 128) = gr2; *(uint4*)(qkd + 48 * 128) = gr3;
            if (t < 128) *(uint4*)(VT + t * 16) = gv;
            float vf8[8]; unpack8(gv, vf8);
            if (t >= 64 && t < 128) GJ[t - 64] = gg;
            const float ggc = gg;
            if (ch + 1 < 32) fetch(ch + 1);
            __syncthreads();
            if (t < 64) {
                float f = GJ[t];
#pragma unroll
                for (int o = 1; o < 64; o <<= 1) { const float u2 = __shfl_up(f, o); if (t >= o) f += u2; }
                const float fend = __shfl(f, 63);
                FS[t] = f; WJ[t] = __expf(fend - f + ggc);
                GJ[t] = ggc - f;
            }
            __syncthreads();
            const float efend = __expf(FS[63]);
            {
                if (t < 128) {
                    const int j = t >> 1; const float wj = WJ[j];
                    float f[8];
#pragma unroll
                    for (int i = 0; i < 8; ++i) f[i] = vf8[i] * wj;
                    *(uint4*)(VX + j * 64 + (t & 1) * 16) = pack8(f);
                    float g8[8] = {0.f, 0.f, 0.f, 0.f, 0.f, 0.f, 0.f, 0.f}; if ((t & 1) == 0) g8[0] = wj;
                    *(uint4*)(VX + j * 64 + 32 + (t & 1) * 16) = pack8(g8);
                }
            }
            __syncthreads();
            const int srow = 16 * w + fr;
            f32x4 Sacc[4], Xacc[2];
#pragma unroll
            for (int n = 0; n < 4; ++n) Sacc[n] = (f32x4){0.f, 0.f, 0.f, 0.f};
            Xacc[0] = (f32x4){0.f, 0.f, 0.f, 0.f}; Xacc[1] = (f32x4){0.f, 0.f, 0.f, 0.f};
            Cacc[0] *= efend; Cacc[1] *= efend;
#pragma unroll
            for (int ks = 0; ks < 2; ++ks) {
                const int chs = ((ks * 4 + fq) ^ (fr & 7)) << 4;
                const uint4 qf = *(const uint4*)(QT + srow * 128 + chs);
#pragma unroll
                for (int n = 0; n < 4; ++n) { const uint4 kf = *(const uint4*)(KT + (n * 16 + fr) * 128 + chs); Sacc[n] = mfma16(kf, qf, Sacc[n]); }
#pragma unroll
                for (int nn = 0; nn < 2; ++nn) { const uint4 rf = *(const uint4*)(CT + (nn * 16 + fr) * 128 + chs); Xacc[nn] = mfma16(rf, qf, Xacc[nn]); }
                const int r0 = ks * 32 + fq * 8 + qq, kc = 2 * w + (pp >> 1);
                const uint2 klo = lds_tr16(KT + r0 * 128 + ((kc ^ (r0 & 7)) << 4) + (pp & 1) * 8);
                const uint2 khi = lds_tr16(KT + (r0 + 4) * 128 + ((kc ^ ((r0 + 4) & 7)) << 4) + (pp & 1) * 8);
                const uint4 kt = make_uint4(klo.x, klo.y, khi.x, khi.y);
#pragma unroll
                for (int m = 0; m < 2; ++m) {
                    const uint2 vlo = lds_tr16(VX + r0 * 64 + (16 * m + 4 * pp) * 2), vhi = lds_tr16(VX + (r0 + 4) * 64 + (16 * m + 4 * pp) * 2);
                    Cacc[m] = mfma16(kt, make_uint4(vlo.x, vlo.y, vhi.x, vhi.y), Cacc[m]);
                }
            }
            const float fs = FS[srow];
            float dsum = 0.f;
#pragma unroll
            for (int n = 0; n < 4; ++n) {
                const float4 g4 = *(const float4*)(GJ + n * 16 + fq * 4); const float ga[4] = {g4.x, g4.y, g4.z, g4.w};
                float pv[4];
#pragma unroll
                for (int j = 0; j < 4; ++j) { const int jc = n * 16 + fq * 4 + j; pv[j] = (srow >= jc) ? Sacc[n][j] * __expf(fs + ga[j]) : 0.f; dsum += pv[j]; }
                uint2 o; o.x = cvt_pk(pv[0], pv[1]); o.y = cvt_pk(pv[2], pv[3]);
                *(uint2*)(PB + srow * 128 + (((n * 2 + (fq >> 1)) ^ (fr & 7)) << 4) + (fq & 1) * 8) = o;
            }
            dsum += __shfl_xor(dsum, 16); dsum += __shfl_xor(dsum, 32);
            f32x4 Iacc = (f32x4){0.f, 0.f, 0.f, 0.f};
#pragma unroll
            for (int ks = 0; ks < 2; ++ks) {
                const uint4 pf = *(const uint4*)(PB + srow * 128 + (((ks * 4 + fq) ^ (fr & 7)) << 4));
                const int r0 = ks * 32 + fq * 8 + qq;
                const uint2 vlo = lds_tr16(VT + r0 * 32 + (4 * pp) * 2), vhi = lds_tr16(VT + (r0 + 4) * 32 + (4 * pp) * 2);
                Iacc = mfma16(make_uint4(vlo.x, vlo.y, vhi.x, vhi.y), pf, Iacc);
            }
            const float efs = __expf(fs);
            const float ndq = __shfl(Xacc[1][0], fr);
            const float den = dsum + efs * ndq;
            const float rden = 1.0f / fmaxf(fabsf(den), 1.0f);
            const size_t tok = tok0 + s0 + srow;
            float o4[4], ssum = 0.f, ssq = 0.f;
#pragma unroll
            for (int j = 0; j < 4; ++j) { o4[j] = (Iacc[j] + efs * Xacc[0][j]) * rden; ssum += o4[j]; ssq += o4[j] * o4[j]; }
            gst_u2(yb + tok * 1024 + hd * 128 + vs * 16 + fq * 4, cvt_pk(o4[0], o4[1]), cvt_pk(o4[2], o4[3]));
            ssum += __shfl_xor(ssum, 16); ssum += __shfl_xor(ssum, 32); ssq += __shfl_xor(ssq, 16); ssq += __shfl_xor(ssq, 32);
            if (fq == 0) gst_u2(stat + ((tok * 8 + hd) * 8 + vs) * 2, __float_as_uint(ssum), __float_as_uint(ssq));
            __syncthreads();
#pragma unroll
            for (int m = 0; m < 2; ++m) {
                const int v = m * 16 + fr;
                uint2 o; o.x = cvt_pk(Cacc[m][0], Cacc[m][1]); o.y = cvt_pk(Cacc[m][2], Cacc[m][3]);
                *(uint2*)(CT + v * 128 + (((2 * w + (fq >> 1)) ^ (v & 7)) << 4) + (fq & 1) * 8) = o;
            }
        }
    }
}
template <int HSHIFT  , int NH>
struct LdGnGate {
    struct Raw { uint4 y, g; };
    const bf16_t *y, *g; int ld; const float *gng, *gnb; const float* st;
    __device__ __forceinline__ Raw fetch(int, int r, int kc) const { Raw q; const size_t o = (size_t)r * ld + kc * 8; q.y = *(const uint4*)(y + o); q.g = *(const uint4*)(g + o); return q; }
    __device__ __forceinline__ uint4 finish(const Raw& q, int, int r, int kc) const {
        float yf[8], gf[8]; unpack8(q.y, yf); unpack8(q.g, gf);
        const float2 ms = *(const float2*)(st + (r * NH + ((kc * 8) >> HSHIFT)) * 2);
        const float4 ga = *(const float4*)(gng + kc * 8), gb = *(const float4*)(gng + kc * 8 + 4), ba = *(const float4*)(gnb + kc * 8), bb = *(const float4*)(gnb + kc * 8 + 4);
        const float gg[8] = {ga.x, ga.y, ga.z, ga.w, gb.x, gb.y, gb.z, gb.w}, bq[8] = {ba.x, ba.y, ba.z, ba.w, bb.x, bb.y, bb.z, bb.w};
        float o[8];
#pragma unroll
        for (int i = 0; i < 8; ++i) o[i] = ((yf[i] - ms.x) * ms.y * gg[i] + bq[i]) * gf[i];
        return pack8(o);
    }
};
template <int HSHIFT, int NH, int NPART>
__device__ __forceinline__ void phase_outproj_gn(PRef p, char* lds, const bf16_t* yb, const bf16_t* gate, int K, const bf16_t* wt, const float* gng, const float* gnb, bf16_t* ymix) {
    const int t = tidx(), lane = t & 63, wid = t >> 6, wr = wid >> 1, wc = wid & 1, fr = lane & 15, fq = lane >> 4;
    const float* stat = (const float*)(p.ws + OFF_STAT);
    float* st = (float*)(lds + 65536);
    const float invn = 1.0f / (float)(1 << HSHIFT);
    for (int id = blockIdx.x; id < 128 * 8; id += gridDim.x) {
        int mt, nt; tile_map(id, 8, mt, nt);
        for (int i = t; i < 128 * NH; i += 256) {
            const float* q = stat + ((size_t)mt * 128 * NH + i) * NPART * 2;
            float s = 0.f, s2 = 0.f;
#pragma unroll
            for (int j = 0; j < NPART; ++j) { const float2 v = *(const float2*)(q + j * 2); s += v.x; s2 += v.y; }
            const float mean = s * invn, var = fmaxf(s2 * invn - mean * mean, 0.f);
            st[i * 2] = mean; st[i * 2 + 1] = rsqrtf(var + 1e-6f);
        }
        __syncthreads();
        const size_t ro = (size_t)mt * 128 * K;
        LdGnGate<HSHIFT, NH> al{yb + ro, gate + ro, K, gng, gnb, st};
        const bf16_t* br[4];
        { const int r0_ = t >> 3, co_ = glds_chunk(t) * 8;
#pragma unroll
          for (int i = 0; i < 4; ++i) br[i] = wt + (size_t)(nt * 128 + r0_ + 32 * i) * K + co_; }
        f32x4 acc[4][4];
        gemm_rg(lds, K / 64, al, br, acc);
#pragma unroll
        for (int n = 0; n < 4; ++n)
#pragma unroll
            for (int m = 0; m < 4; ++m) {
                uint2 o; o.x = cvt_pk(acc[m][n][0], acc[m][n][1]); o.y = cvt_pk(acc[m][n][2], acc[m][n][3]);
                *(uint2*)(ymix + (size_t)(mt * 128 + wr * 64 + m * 16 + fr) * 1024 + nt * 128 + wc * 64 + n * 16 + fq * 4) = o;
            }
    }
}

__device__ __forceinline__ void phase_rt2(PRef p, char* lds) {
    const int t = tidx(), lane = t & 63, w = t >> 6, fr = lane & 15, fq = lane >> 4;
    char* S = p.ws + OFF_SLOT;
    const bf16_t* qb = (const bf16_t*)(S + 1 * SLOT); const bf16_t* kb = (const bf16_t*)(S + 2 * SLOT); const bf16_t* vb = (const bf16_t*)(S + 3 * SLOT);
    bf16_t* yb = (bf16_t*)(S + 7 * SLOT); float* stat = (float*)(p.ws + OFF_STAT);
    char* const VB = lds + 32768; char* const PB = lds + 49152; char* const RT = lds + 57344;
    const int gco = glds_chunk(t) * 8, gr0 = t >> 3;
    const int qq = fr >> 2, pp = fr & 3;
    for (int item = blockIdx.x; item < 512; item += gridDim.x) {
        const int bh = ((item >> 3) >> 4) * 8 + (item & 7), vs = (item >> 3) & 15, b = bh >> 2, hd = bh & 3;
        const size_t tok0 = (size_t)b * 2048;
        const float lg2 = log2f(1.0f - __builtin_amdgcn_exp2f(-5.0f - (float)hd));
        const float dec64 = __builtin_amdgcn_exp2f(64.0f * lg2);
        const bf16_t* qsrc = qb + (tok0 + gr0) * 1024 + hd * 256 + gco;
        const bf16_t* ksrc = kb + (tok0 + gr0) * 1024 + hd * 256 + gco;
        const bf16_t* vsrc = vb + (tok0 + (t >> 2)) * 2048 + hd * 512 + vs * 32 + (t & 3) * 8;
        f32x4 Racc[4][2];
#pragma unroll
        for (int a = 0; a < 4; ++a) { Racc[a][0] = (f32x4){0.f, 0.f, 0.f, 0.f}; Racc[a][1] = (f32x4){0.f, 0.f, 0.f, 0.f}; }
        __syncthreads();
        for (int i = t; i < 1024; i += 256) *(uint4*)(RT + i * 16) = make_uint4(0u, 0u, 0u, 0u);
        auto issue = [&](int pc) {
            const unsigned d = (unsigned)__builtin_amdgcn_readfirstlane((int)(lds_addr_u(lds) + (pc & 1) * 16384 + w * 1024));
            const size_t go = (size_t)(pc >> 2) * 64 * 1024 + (pc & 3) * 64;
#pragma unroll
            for (int i = 0; i < 2; ++i) { glds16_asm(qsrc + go + (size_t)i * 32 * 1024, d + i * 4096); glds16_asm(ksrc + go + (size_t)i * 32 * 1024, d + 8192 + i * 4096); }
        };
        auto put_v = [&](const uint4& raw, int ch) {
            char* vbuf = VB + (ch & 1) * 8192; const int j = t >> 2;
            *(uint4*)(vbuf + j * 64 + (t & 3) * 16) = raw;
            float f[8]; unpack8(raw, f); const float sc = __builtin_amdgcn_exp2f(lg2 * (float)(63 - j));
#pragma unroll
            for (int i = 0; i < 8; ++i) f[i] *= sc;
            *(uint4*)(vbuf + 4096 + j * 64 + (t & 3) * 16) = pack8(f);
        };
        issue(0);
        { const uint4 v0 = gld_u4(vsrc); put_v(v0, 0); }
        asm volatile("s_waitcnt vmcnt(0)" ::: "memory");
        __syncthreads();
        f32x4 Sacc[4], Xacc[2];
        uint4 vnext = make_uint4(0u, 0u, 0u, 0u);
        for (int ch = 0; ch < 32; ++ch) {
            const char* vbuf = VB + (ch & 1) * 8192;
#pragma unroll
            for (int qd = 0; qd < 4; ++qd) {
                const int pc = ch * 4 + qd;
                if (pc + 1 < 128) issue(pc + 1);
                if (qd == 0) {
                    if (ch + 1 < 32) vnext = gld_u4(vsrc + (size_t)(ch + 1) * 64 * 2048);
#pragma unroll
                    for (int n = 0; n < 4; ++n) Sacc[n] = (f32x4){0.f, 0.f, 0.f, 0.f};
                    Xacc[0] = (f32x4){0.f, 0.f, 0.f, 0.f}; Xacc[1] = (f32x4){0.f, 0.f, 0.f, 0.f};
                }
                const char* qk = lds + (pc & 1) * 16384;
                Racc[qd][0] *= dec64; Racc[qd][1] *= dec64;
#pragma unroll
                for (int ks = 0; ks < 2; ++ks) {
                    const int chs = ((ks * 4 + fq) ^ (fr & 7)) << 4;
                    const uint4 qf = *(const uint4*)(qk + (16 * w + fr) * 128 + chs);
#pragma unroll
                    for (int n = 0; n < 4; ++n) { const uint4 kf = *(const uint4*)(qk + 8192 + (n * 16 + fr) * 128 + chs); Sacc[n] = mfma16(kf, qf, Sacc[n]); }
#pragma unroll
                    for (int nn = 0; nn < 2; ++nn) {
                        const int v = nn * 16 + fr;
                        const uint4 rf = *(const uint4*)(RT + v * 512 + (((qd * 8 + ks * 4 + fq) ^ (v & 7)) << 4));
                        Xacc[nn] = mfma16(rf, qf, Xacc[nn]);
                    }
                    const int r0 = ks * 32 + fq * 8 + qq;
                    const int kc = 2 * w + (pp >> 1);
                    const uint2 klo = lds_tr16(qk + 8192 + r0 * 128 + ((kc ^ (r0 & 7)) << 4) + (pp & 1) * 8);
                    const uint2 khi = lds_tr16(qk + 8192 + (r0 + 4) * 128 + ((kc ^ ((r0 + 4) & 7)) << 4) + (pp & 1) * 8);
                    const uint4 kt = make_uint4(klo.x, klo.y, khi.x, khi.y);
#pragma unroll
                    for (int m = 0; m < 2; ++m) {
                        const uint2 vlo = lds_tr16(vbuf + 4096 + r0 * 64 + (16 * m + 4 * pp) * 2), vhi = lds_tr16(vbuf + 4096 + (r0 + 4) * 64 + (16 * m + 4 * pp) * 2);
                        Racc[qd][m] = mfma16(kt, make_uint4(vlo.x, vlo.y, vhi.x, vhi.y), Racc[qd][m]);
                    }
                }
                if (qd == 2 && ch + 1 < 32) put_v(vnext, ch + 1);
                asm volatile("s_waitcnt vmcnt(0)" ::: "memory");
                __syncthreads();
#pragma unroll
                for (int m = 0; m < 2; ++m) {
                    const int v = m * 16 + fr, cch = qd * 8 + 2 * w + (fq >> 1);
                    uint2 o; o.x = cvt_pk(Racc[qd][m][0], Racc[qd][m][1]); o.y = cvt_pk(Racc[qd][m][2], Racc[qd][m][3]);
                    *(uint2*)(RT + v * 512 + ((cch ^ (v & 7)) << 4) + (fq & 1) * 8) = o;
                }
            }
            const int srow = 16 * w + fr;
#pragma unroll
            for (int n = 0; n < 4; ++n) {
                float pv[4];
#pragma unroll
                for (int j = 0; j < 4; ++j) { const int jc = n * 16 + fq * 4 + j; pv[j] = (srow >= jc) ? Sacc[n][j] * __builtin_amdgcn_exp2f(lg2 * (float)(srow - jc)) : 0.f; }
                uint2 o; o.x = cvt_pk(pv[0], pv[1]); o.y = cvt_pk(pv[2], pv[3]);
                *(uint2*)(PB + srow * 128 + (((n * 2 + (fq >> 1)) ^ (fr & 7)) << 4) + (fq & 1) * 8) = o;
            }
            f32x4 Iacc[2] = {(f32x4){0.f, 0.f, 0.f, 0.f}, (f32x4){0.f, 0.f, 0.f, 0.f}};
#pragma unroll
            for (int ks = 0; ks < 2; ++ks) {
                const uint4 pf = *(const uint4*)(PB + srow * 128 + (((ks * 4 + fq) ^ (fr & 7)) << 4));
                const int r0 = ks * 32 + fq * 8 + qq;
#pragma unroll
                for (int nn = 0; nn < 2; ++nn) {
                    const uint2 vlo = lds_tr16(vbuf + r0 * 64 + (16 * nn + 4 * pp) * 2), vhi = lds_tr16(vbuf + (r0 + 4) * 64 + (16 * nn + 4 * pp) * 2);
                    Iacc[nn] = mfma16(make_uint4(vlo.x, vlo.y, vhi.x, vhi.y), pf, Iacc[nn]);
                }
            }
            const float qdec = __builtin_amdgcn_exp2f(lg2 * (float)(srow + 1));
            const size_t tok = tok0 + (size_t)ch * 64 + srow;
            float ssum = 0.f, ssq = 0.f;
#pragma unroll
            for (int nn = 0; nn < 2; ++nn) {
                float o4[4];
#pragma unroll
                for (int j = 0; j < 4; ++j) { o4[j] = Iacc[nn][j] + Xacc[nn][j] * qdec; ssum += o4[j]; ssq += o4[j] * o4[j]; }
                gst_u2(yb + tok * 2048 + hd * 512 + vs * 32 + nn * 16 + fq * 4, cvt_pk(o4[0], o4[1]), cvt_pk(o4[2], o4[3]));
            }
            ssum += __shfl_xor(ssum, 16); ssum += __shfl_xor(ssum, 32); ssq += __shfl_xor(ssq, 16); ssq += __shfl_xor(ssq, 32);
            if (fq == 0) gst_u2(stat + ((tok * 4 + hd) * 16 + vs) * 2, __float_as_uint(ssum), __float_as_uint(ssq));
        }
        __syncthreads();
    }
}

__device__ __forceinline__ void phase_zrw(PRef p, int jr) {
    const int t_ = tidx(); const int lane = t_ & 63, gw = blockIdx.x * 4 + (t_ >> 6), nw = gridDim.x * 4;
    char* S = p.ws + OFF_SLOT;
    const bf16_t* yb = (const bf16_t*)(S + 5 * SLOT); const bf16_t* gb = (const bf16_t*)(S + 4 * SLOT);
    const bf16_t* vb = (const bf16_t*)(S + (jr == 0 ? 11 : 9) * SLOT); bf16_t* zb = (bf16_t*)(S + 7 * SLOT);
    const float* bonus = (const float*)(p.ws + OFF_BONUS);
    float gg[16], bq[16]; row_load_f32(p.in[22] + jr * 1024, gg, lane); row_load_f32(p.in[23] + jr * 1024, bq, lane);
    const int rpw = NTOK / nw, first = gw * rpw, end = first + rpw;
    uint2 ny[4], nv[4], ng[4]; float nbn[4];
    auto load_in = [&](int r) {
#pragma unroll
        for (int c = 0; c < 4; ++c) { const size_t o = (size_t)r * 1024 + c * 256 + lane * 4; ny[c] = *(const uint2*)(yb + o); nv[c] = *(const uint2*)(vb + o); ng[c] = *(const uint2*)(gb + o);
                                      nbn[c] = bonus[(size_t)r * 16 + c * 4 + (lane >> 4)]; }
    };
    load_in(first);
    for (int r = first; r < end; ++r) {
        float y[16], v[16], g[16], bn[4];
#pragma unroll
        for (int c = 0; c < 4; ++c) {
            y[c * 4] = bflo(ny[c].x); y[c * 4 + 1] = bfhi(ny[c].x); y[c * 4 + 2] = bflo(ny[c].y); y[c * 4 + 3] = bfhi(ny[c].y);
            v[c * 4] = bflo(nv[c].x); v[c * 4 + 1] = bfhi(nv[c].x); v[c * 4 + 2] = bflo(nv[c].y); v[c * 4 + 3] = bfhi(nv[c].y);
            g[c * 4] = bflo(ng[c].x); g[c * 4 + 1] = bfhi(ng[c].x); g[c * 4 + 2] = bflo(ng[c].y); g[c * 4 + 3] = bfhi(ng[c].y);
            bn[c] = nbn[c];
        }
        if (r + 1 < end) load_in(r + 1);
        __builtin_amdgcn_sched_barrier(0);
        float z[16];
#pragma unroll
        for (int c = 0; c < 4; ++c) {
            float s = (y[c * 4] + y[c * 4 + 1]) + (y[c * 4 + 2] + y[c * 4 + 3]);
            float q = (y[c * 4] * y[c * 4] + y[c * 4 + 1] * y[c * 4 + 1]) + (y[c * 4 + 2] * y[c * 4 + 2] + y[c * 4 + 3] * y[c * 4 + 3]);
            s = row16_sum(s); q = row16_sum(q);
            const float mean = s * (1.0f / 64.0f), rstd = rsqrtf(fmaxf(q * (1.0f / 64.0f) - mean * mean, 0.f) + 64e-5f);
#pragma unroll
            for (int i = 0; i < 4; ++i) { const int e = c * 4 + i; z[e] = ((y[e] - mean) * rstd * gg[e] + bq[e] + bn[c] * v[e]) * g[e]; }
        }
        row_store_bf16(zb + (size_t)r * 1024, z, lane);
    }
}
__device__ __forceinline__ void phase_zml(PRef p) {
    const int t_ = tidx(); const int lane = t_ & 63, gw = blockIdx.x * 4 + (t_ >> 6), nw = gridDim.x * 4;
    char* S = p.ws + OFF_SLOT;
    const bf16_t* yb = (const bf16_t*)(S + 4 * SLOT); const bf16_t* ob = (const bf16_t*)(S + 3 * SLOT); bf16_t* zb = (bf16_t*)(S + 1 * SLOT);
    float gg[16], bq[16]; row_load_f32(p.in[29], gg, lane); row_load_f32(p.in[30], bq, lane);
    const int rpw = NTOK / nw, first = gw * rpw, end = first + rpw;
    uint2 ny[4], no[4];
    auto load_in = [&](int r) {
#pragma unroll
        for (int c = 0; c < 4; ++c) { const size_t o = (size_t)r * 1024 + c * 256 + lane * 4; ny[c] = *(const uint2*)(yb + o); no[c] = *(const uint2*)(ob + o); }
    };
    load_in(first);
    for (int r = first; r < end; ++r) {
        float y[16], o[16], z[16];
#pragma unroll
        for (int c = 0; c < 4; ++c) {
            y[c * 4] = bflo(ny[c].x); y[c * 4 + 1] = bfhi(ny[c].x); y[c * 4 + 2] = bflo(ny[c].y); y[c * 4 + 3] = bfhi(ny[c].y);
            o[c * 4] = bflo(no[c].x); o[c * 4 + 1] = bfhi(no[c].x); o[c * 4 + 2] = bflo(no[c].y); o[c * 4 + 3] = bfhi(no[c].y);
        }
        if (r + 1 < end) load_in(r + 1);
        __builtin_amdgcn_sched_barrier(0);
#pragma unroll
        for (int c = 0; c < 4; ++c) {
            float s = (y[c * 4] + y[c * 4 + 1]) + (y[c * 4 + 2] + y[c * 4 + 3]);
            float q = (y[c * 4] * y[c * 4] + y[c * 4 + 1] * y[c * 4 + 1]) + (y[c * 4 + 2] * y[c * 4 + 2] + y[c * 4 + 3] * y[c * 4 + 3]);
            s = row16_sum(s); q = row16_sum(q); s += __shfl_xor(s, 16); q += __shfl_xor(q, 16);
            const float mean = s * (1.0f / 128.0f), rstd = rsqrtf(fmaxf(q * (1.0f / 128.0f) - mean * mean, 0.f) + 1e-6f);
#pragma unroll
            for (int i = 0; i < 4; ++i) { const int e = c * 4 + i; z[e] = ((y[e] - mean) * rstd * gg[e] + bq[e]) * o[e]; }
        }
        row_store_bf16(zb + (size_t)r * 1024, z, lane);
    }
}
__device__ __forceinline__ void phase_zrt(PRef p) {
    const int t_ = tidx(); const int lane = t_ & 63, gw = blockIdx.x * 4 + (t_ >> 6), nw = gridDim.x * 4;
    char* S = p.ws + OFF_SLOT;
    const bf16_t* yb = (const bf16_t*)(S + 7 * SLOT); const bf16_t* sb = (const bf16_t*)(S + 5 * SLOT); bf16_t* zb = (bf16_t*)(S + 3 * SLOT);
    float gw8[4][8], bw8[4][8];
#pragma unroll
    for (int c = 0; c < 4; ++c) {
        const float4 ga = gld_f4(p.in[33] + lane * 32 + c * 8), gb2 = gld_f4(p.in[33] + lane * 32 + c * 8 + 4), ba = gld_f4(p.in[34] + lane * 32 + c * 8), bb2 = gld_f4(p.in[34] + lane * 32 + c * 8 + 4);
        gw8[c][0] = ga.x; gw8[c][1] = ga.y; gw8[c][2] = ga.z; gw8[c][3] = ga.w; gw8[c][4] = gb2.x; gw8[c][5] = gb2.y; gw8[c][6] = gb2.z; gw8[c][7] = gb2.w;
        bw8[c][0] = ba.x; bw8[c][1] = ba.y; bw8[c][2] = ba.z; bw8[c][3] = ba.w; bw8[c][4] = bb2.x; bw8[c][5] = bb2.y; bw8[c][6] = bb2.z; bw8[c][7] = bb2.w;
    }
    const int rpw = NTOK / nw, first = gw * rpw, end = first + rpw;
    uint4 nyr[4], nsr[4];
    auto load_in = [&](int r) {
        const size_t o = (size_t)r * 2048 + lane * 32;
#pragma unroll
        for (int c = 0; c < 4; ++c) { nyr[c] = *(const uint4*)(yb + o + c * 8); nsr[c] = *(const uint4*)(sb + o + c * 8); }
    };
    load_in(first);
    for (int r = first; r < end; ++r) {
        const size_t o = (size_t)r * 2048 + lane * 32;
        uint4 yr[4], sr[4];
#pragma unroll
        for (int c = 0; c < 4; ++c) { yr[c] = nyr[c]; sr[c] = nsr[c]; }
        if (r + 1 < end) load_in(r + 1);
        __builtin_amdgcn_sched_barrier(0);
        float s = 0.f, q = 0.f;
#pragma unroll
        for (int c = 0; c < 4; ++c) { float f[8]; unpack8(yr[c], f);
#pragma unroll
            for (int i = 0; i < 8; ++i) { s += f[i]; q += f[i] * f[i]; } }
        s = row16_sum(s); q = row16_sum(q);
        const float mean = s * (1.0f / 512.0f), rstd = rsqrtf(fmaxf(q * (1.0f / 512.0f) - mean * mean, 0.f) + 1e-6f);
#pragma unroll
        for (int c = 0; c < 4; ++c) {
            float f[8], g[8], z[8]; unpack8(yr[c], f); unpack8(sr[c], g);
#pragma unroll
            for (int i = 0; i < 8; ++i) z[i] = ((f[i] - mean) * rstd * gw8[c][i] + bw8[c][i]) * g[i];
            *(uint4*)(zb + o + c * 8) = pack8(z);
        }
    }
}

template <int WHICH  >
__device__ __forceinline__ void phase_moe(PRef p, int L, char* lds, const bf16_t* hm, bf16_t* H) {
    const int t = tidx(), lane = t & 63, wid = t >> 6, wr = wid >> 1, wc = wid & 1, fr = lane & 15, fq = lane >> 4;
    const int* cnt = (const int*)(p.ws + OFF_CNT) + L * 32;
    const int* list = (const int*)(p.ws + OFF_LIST);
    bf16_t* Y = (bf16_t*)(p.ws + OFF_SLOT + 9 * SLOT);
    int* pre = (int*)(lds + 65536);
    __syncthreads();
    if (t == 0) { int s = 0; for (int e = 0; e < 32; ++e) { pre[e] = s; s += (cnt[e] + 127) >> 7; } pre[32] = s; }
    __syncthreads();
    const int total_all = pre[32] * 8;
    const int full = (total_all / (int)gridDim.x) * (int)gridDim.x, rem = total_all - full;
    const bool split_tail = (rem > 0) && (2 * rem <= (int)gridDim.x);
    const int total = split_tail ? full : total_all;
    for (int id0 = 0; id0 < total; id0 += gridDim.x) {
        const int id = id0 + (blockIdx.x & 7) * (gridDim.x >> 3) + (blockIdx.x >> 3);
        if (id >= total) continue;
        const int nt = id & 7, mg = id >> 3;
        int e = 0;
#pragma unroll 1
        for (int s = 16; s >= 1; s >>= 1) if (pre[e + s] <= mg) e += s;
        const int mt = mg - pre[e], ne = cnt[e];
        const int* le = list + e * LIST_CAP + mt * 128;
        const bf16_t* ar[4]; const bf16_t* br[4];
        const int co_ = glds_chunk(t) * 8;
#pragma unroll
        for (int i = 0; i < 4; ++i) {
            int r = (t >> 3) + 32 * i; r = (mt * 128 + r < ne) ? r : 0;
            const int aid = le[r];
            ar[i] = ((WHICH == 0) ? hm + (size_t)(aid >> 1) * 1024 : H + (size_t)aid * 512) + co_;
        }
        f32x4 acc[4][4];
        if (WHICH == 0) {
            const bf16_t* wt = (const bf16_t*)(p.ws + W_MOE13) + ((size_t)(L * 32 + e) * 1024 + nt * 128) * 1024;
#pragma unroll
            for (int i = 0; i < 4; ++i) {
                const int ro = (t >> 3) + 32 * i, n_ = (ro >> 4) & 3, hc = ((ro >> 2) & 3) * 8 + (n_ >> 1) * 4 + (ro & 3);
                br[i] = wt + (size_t)((ro & 64) + (hc >> 4) * 32 + (n_ & 1) * 16 + (hc & 15)) * 1024 + co_;
            }
            gemm_gg(lds, 16, ar, br, acc);
            int aidq[4];
#pragma unroll
            for (int m = 0; m < 4; ++m) { const int r = wr * 64 + m * 16 + fr; aidq[m] = (mt * 128 + r < ne) ? le[r] : 0; }
#pragma unroll
            for (int m = 0; m < 4; ++m) {
                const int r = wr * 64 + m * 16 + fr;
                if (mt * 128 + r < ne) {
                    const int aid = aidq[m];
                    const f32x4 a1 = acc[m][0], a3 = acc[m][1], b1 = acc[m][2], b3 = acc[m][3];
                    gst_u4(H + (size_t)aid * 512 + nt * 64 + wc * 32 + fq * 8, cvt_pk(siluf_(a1[0]) * a3[0], siluf_(a1[1]) * a3[1]), cvt_pk(siluf_(a1[2]) * a3[2], siluf_(a1[3]) * a3[3]),
                           cvt_pk(siluf_(b1[0]) * b3[0], siluf_(b1[1]) * b3[1]), cvt_pk(siluf_(b1[2]) * b3[2], siluf_(b1[3]) * b3[3]));
                }
            }
        } else {
            const bf16_t* wt = (const bf16_t*)(p.ws + W_MOE2) + ((size_t)(L * 32 + e) * 1024 + nt * 128) * 512;
#pragma unroll
            for (int i = 0; i < 4; ++i) br[i] = wt + (size_t)perm64((t >> 3) + 32 * i) * 512 + co_;
            gemm_gg(lds, 8, ar, br, acc);
            int aidq[4];
#pragma unroll
            for (int m = 0; m < 4; ++m) { const int r = wr * 64 + m * 16 + fr; aidq[m] = (mt * 128 + r < ne) ? le[r] : 0; }
#pragma unroll
            for (int m = 0; m < 4; ++m) {
                const int r = wr * 64 + m * 16 + fr;
                if (mt * 128 + r < ne) {
                    const int aid = aidq[m];
                    store16(Y + (size_t)aid * 1024 + nt * 128 + wc * 64 + fq * 16, acc[m]);
                }
            }
        }
    }
    if (split_tail) {
        const int hid = (blockIdx.x & 7) * (gridDim.x >> 3) + (blockIdx.x >> 3);
        if (hid < 2 * rem) {
            const int id = full + (hid >> 1), hf = hid & 1;
            const int nt = id & 7, mg = id >> 3;
            int e = 0;
#pragma unroll 1
            for (int s2 = 16; s2 >= 1; s2 >>= 1) if (pre[e + s2] <= mg) e += s2;
            const int mt = mg - pre[e], ne = cnt[e];
            const int* le = list + e * LIST_CAP + mt * 128;
            const bf16_t* ar[4]; const bf16_t* br[2];
            const int co_ = glds_chunk(t) * 8;
#pragma unroll
            for (int i = 0; i < 4; ++i) {
                int r = (t >> 3) + 32 * i; r = (mt * 128 + r < ne) ? r : 0;
                const int aid = le[r];
                ar[i] = ((WHICH == 0) ? hm + (size_t)(aid >> 1) * 1024 : H + (size_t)aid * 512) + co_;
            }
            f32x4 acc[2][4];
            int aidq[2];
            if (WHICH == 0) {
                const bf16_t* wt = (const bf16_t*)(p.ws + W_MOE13) + ((size_t)(L * 32 + e) * 1024 + nt * 128 + hf * 64) * 1024;
#pragma unroll
                for (int i = 0; i < 2; ++i) {
                    const int ro = (t >> 3) + 32 * i, n_ = (ro >> 4) & 3, hc = ((ro >> 2) & 3) * 8 + (n_ >> 1) * 4 + (ro & 3);
                    br[i] = wt + (size_t)((hc >> 4) * 32 + (n_ & 1) * 16 + (hc & 15)) * 1024 + co_;
                }
                gemm_hn(lds, 16, ar, br, acc);
#pragma unroll
                for (int m = 0; m < 2; ++m) { const int r = wid * 32 + m * 16 + fr; aidq[m] = (mt * 128 + r < ne) ? le[r] : 0; }
#pragma unroll
                for (int m = 0; m < 2; ++m) {
                    const int r = wid * 32 + m * 16 + fr;
                    if (mt * 128 + r < ne) {
                        const f32x4 a1 = acc[m][0], a3 = acc[m][1], b1 = acc[m][2], b3 = acc[m][3];
                        gst_u4(H + (size_t)aidq[m] * 512 + nt * 64 + hf * 32 + fq * 8, cvt_pk(siluf_(a1[0]) * a3[0], siluf_(a1[1]) * a3[1]), cvt_pk(siluf_(a1[2]) * a3[2], siluf_(a1[3]) * a3[3]),
                               cvt_pk(siluf_(b1[0]) * b3[0], siluf_(b1[1]) * b3[1]), cvt_pk(siluf_(b1[2]) * b3[2], siluf_(b1[3]) * b3[3]));
                    }
                }
            } else {
                const bf16_t* wt = (const bf16_t*)(p.ws + W_MOE2) + ((size_t)(L * 32 + e) * 1024 + nt * 128 + hf * 64) * 512;
#pragma unroll
                for (int i = 0; i < 2; ++i) br[i] = wt + (size_t)perm64((t >> 3) + 32 * i) * 512 + co_;
                gemm_hn(lds, 8, ar, br, acc);
#pragma unroll
                for (int m = 0; m < 2; ++m) { const int r = wid * 32 + m * 16 + fr; aidq[m] = (mt * 128 + r < ne) ? le[r] : 0; }
#pragma unroll
                for (int m = 0; m < 2; ++m) {
                    const int r = wid * 32 + m * 16 + fr;
                    if (mt * 128 + r < ne) store16(Y + (size_t)aidq[m] * 1024 + nt * 128 + hf * 64 + fq * 16, acc[m]);
                }
            }
        }
    }
}

constexpr int NPHASE = 37;
#ifndef PHSEL
#define PHSEL -1
#endif
#ifndef PHEXC
#define PHEXC -2
#endif
#define PHON(x) ((PHSEL < 0 || PHSEL == (x)) && PHEXC != (x))
__global__ void __launch_bounds__(256, 2) mega(Params p_in) {
    PRef p = *(const CAS Params*)__builtin_amdgcn_kernarg_segment_ptr();
    extern __shared__ __attribute__((aligned(16))) char lds[];
    volatile LAS unsigned* xbw = (volatile LAS unsigned*)(lds + 73728);
    if (threadIdx.x == 0) { xbw[0] = 0u; xbw[1] = 0u; xbw[2] = 0u; xbw[3] = 0u; }
    __syncthreads();
    XcdBarrier bar;
    const bool multi = (p.ph_hi - p.ph_lo) > 1;
    (void)multi;
    if (multi) bar = xcd_barrier_post((unsigned*)(p.ws + OFF_CTL), xbw);
    char* S = p.ws + OFF_SLOT;
#ifdef DBG_STOP
    if (p.ph_lo == 100) {
        const float* src = (const float*)(p.ws + DBG_SRC);
        for (size_t i = (size_t)blockIdx.x * 256 + threadIdx.x; i < (size_t)NTOK * DM; i += (size_t)gridDim.x * 256) {
            float v = DBG_BF16 ? bf2f(((const bf16_t*)src)[i]) : src[i];
            if (!(fabsf(v) < 1e30f)) v = 1e30f;
            p.out[i] = v;
        }
        return;
    }
#endif
    const int ph_lo_ = p.ph_lo, ph_hi_ = p.ph_hi;
#ifdef TIMEIT
    unsigned long long t0_ = 0, t1_ = 0;
#endif
#ifdef DUP_PHASE
    bool dup_done_ = false;
#endif
    for (int ph = ph_lo_; ph < ph_hi_; ++ph) {
        const CAS Params* pp_ = (const CAS Params*)__builtin_amdgcn_kernarg_segment_ptr();
        asm volatile("" : "+s"(pp_));
        PRef p = *pp_;
#ifdef TIMEIT
        if (ph == TIME_A) t0_ = __builtin_amdgcn_s_memrealtime();
        if (ph == TIME_B) t1_ = __builtin_amdgcn_s_memrealtime();
#endif
        int L, sub, kind;
        if (ph < 2) { L = 0; sub = ph; kind = -1; }
        else if (ph < 11) { L = 0; kind = 0; sub = ph - 2; }
        else if (ph < 20) { L = 1; kind = 1; sub = ph - 11; }
        else if (ph < 28) { L = 2; kind = 2; sub = ph - 20; }
        else { L = 3; kind = 0; sub = ph - 28; }
        const int jr = L / 3;
        if (kind == -1) { if (sub == 0) { if (PHON(0)) phase_prologue(p, lds); } else { if (PHON(1)) phase_h0(p); } }
        else {
            const int ntail = (kind == 2) ? 4 : 5;
            if (sub < ntail) {
                if (kind == 0) {
                    if (sub == 0) { if (PHON(2)) phase_gemm_jobs(p, lds, jr * 7, jr * 7 + (jr ? 7 : 6)); }
                    else if (sub == 1) { if (PHON(3)) phase_rw2(p, jr); }
                    else if (sub == 2) { if (PHON(4)) {
#ifdef RW3_SCALAR
                        phase_rw3(p, jr, lds);
#else
                        phase_rw3c(p, jr, lds);
#endif
                    } }
                    else if (sub == 3) { if (PHON(5)) phase_zrw(p, jr); }
                    else { if (PHON(2)) phase_gemm_jobs(p, lds, 16 + jr, 17 + jr); }
                } else if (kind == 1) {
                    if (sub == 0) { if (PHON(2)) phase_gemm_jobs(p, lds, 14, 15); }
                    else if (sub == 1) { if (PHON(6)) phase_cml(p); }
                    else if (sub == 2) { if (PHON(6)) phase_ml2(p, lds); }
                    else if (sub == 3) { if (PHON(7)) phase_zml(p); }
                    else { if (PHON(2)) phase_gemm_jobs(p, lds, 18, 19); }
                } else {
                    if (sub == 0) { if (PHON(2)) phase_gemm_jobs(p, lds, 15, 16); }
                    else if (sub == 1) { if (PHON(8)) phase_rt2(p, lds); }
                    else if (sub == 2) { if (PHON(9)) phase_zrt(p); }
                    else { if (PHON(2)) phase_gemm_jobs(p, lds, 19, 20); }
                }
            } else {
                const int ts = sub - ntail;
                const bf16_t* ymix = (const bf16_t*)(S + (kind == 2 ? 1 : 6) * SLOT);
                bf16_t* hm = (bf16_t*)(S + (kind == 2 ? 2 : 7) * SLOT);
                bf16_t* H = (bf16_t*)(S + (kind == 0 ? 2 : (kind == 1 ? 5 : 3)) * SLOT);
                if (ts == 0) { if (PHON(10)) phase_ln1(p, L, lds, ymix, hm); }
                else if (ts == 1) { if (PHON(11)) phase_moe<0>(p, L, lds, hm, H); }
                else if (ts == 2) { if (PHON(12)) phase_moe<1>(p, L, lds, hm, H); }
                else { if (PHON(13)) phase_ln2(p, L); }
            }
        }
#ifdef DUP_PHASE
        if (((DUP_PHASE >> ph) & 1u) && !dup_done_) { dup_done_ = true; xcd_barrier(bar); --ph; continue; }
        dup_done_ = false;
#endif
        if (ph + 1 < ph_hi_) xcd_barrier(bar);
    }
#ifdef TIMEIT
    {
        xcd_barrier(bar);
        unsigned* tw = (unsigned*)(p.ws + OFF_CTL + 32768);
        if (blockIdx.x == 0 && threadIdx.x == 0) {
            if (t1_ == 0) t1_ = __builtin_amdgcn_s_memrealtime();
            const unsigned long long dt = t1_ - t0_;
            unsigned ms2 = (unsigned)((dt + TIME_U / 2) / TIME_U);
            __hip_atomic_store(tw, ms2, __ATOMIC_RELAXED, __HIP_MEMORY_SCOPE_AGENT);
        }
        xcd_barrier(bar);
        const float c_ = sqrtf((float)__hip_atomic_load(tw, __ATOMIC_RELAXED, __HIP_MEMORY_SCOPE_AGENT));
        for (size_t i = (size_t)blockIdx.x * 256 + threadIdx.x; i < (size_t)NTOK * DM; i += (size_t)gridDim.x * 256) p.out[i] = c_;
    }
#endif
#ifdef DBG_STOP
    if (ph_lo_ != 100) {
        xcd_barrier(bar);
        const float* src = (const float*)(p.ws + DBG_SRC);
        for (size_t i = (size_t)blockIdx.x * 256 + threadIdx.x; i < (size_t)NTOK * DM; i += (size_t)gridDim.x * 256) {
            float v = DBG_BF16 ? bf2f(((const bf16_t*)src)[i]) : src[i];
            if (!(fabsf(v) < 1e30f)) v = 1e30f;
            p.out[i] = v;
        }
    }
#endif
}

constexpr int LDS_BYTES = 73728 + 64;
extern "C" void kernel_launch(void* const* d_in, const int* in_sizes, int n_in, void* d_out, int out_size, void* d_ws, size_t ws_size, hipStream_t stream) {
    static int grid = 0;
    if (grid == 0) {
        if (n_in != 43 || out_size != NTOK * DM || ws_size < WS_NEED) { fprintf(stderr, "kernel_launch: unexpected shapes (n_in %d out %d ws %zu need %zu)\n", n_in, out_size, ws_size, (size_t)WS_NEED); }
        int dev = 0, cus = 0, per_cu = 0;
        (void)hipGetDevice(&dev); (void)hipDeviceGetAttribute(&cus, hipDeviceAttributeMultiprocessorCount, dev);
        (void)hipFuncSetAttribute((const void*)mega, hipFuncAttributeMaxDynamicSharedMemorySize, LDS_BYTES);
        (void)hipOccupancyMaxActiveBlocksPerMultiprocessor(&per_cu, (const void*)mega, 256, LDS_BYTES);
        if (per_cu > 2) per_cu = 2;
        if (per_cu < 1) per_cu = 1;
        grid = cus * per_cu;
        if (grid > 512) grid = 512;
        (void)hipGetLastError();
    }
    Params p{};
    for (int i = 0; i < 43; ++i) p.in[i] = (const float*)d_in[i];
    p.out = (float*)d_out; p.ws = (char*)d_ws;
    char* ws = (char*)d_ws;
    auto slot = [&](int i) { return (bf16_t*)(ws + OFF_SLOT + (size_t)i * SLOT); };
    int tile = 0;
    auto addg = [&](int idx, const bf16_t* A, const bf16_t* Bt, bf16_t* out, int K, int N, int ldo, int mode) {
        GJob& g = p.gj[idx]; g.A = A; g.Bt = Bt; g.out = out; g.K = K; g.N = N; g.ldo = ldo; g.mode = mode; g.ntn = (N + 127) / 128; g.tile0 = tile; tile += 128 * g.ntn;
    };
    for (int jr = 0; jr < 2; ++jr) {
        const bf16_t* rkv = (const bf16_t*)(ws + W_RKV) + (size_t)jr * 3 * 1024 * 1024;
        addg(jr * 7 + 0, slot(0), rkv, slot(6), 1024, 1024, 1024, MODE_BF16);
        addg(jr * 7 + 1, slot(1), rkv + 1024 * 1024, slot(7), 1024, 1024, 1024, MODE_BF16);
        addg(jr * 7 + 2, slot(2), rkv + 2 * 1024 * 1024, slot(jr == 0 ? 11 : 8), 1024, 1024, 1024, MODE_BF16);
        addg(jr * 7 + 3, slot(3), (const bf16_t*)(ws + W_W1T) + (size_t)jr * 64 * 1024, (bf16_t*)(ws + OFF_LW), 1024, 64, 64, MODE_TANH);
        addg(jr * 7 + 4, slot(4), (const bf16_t*)(ws + W_A1T) + (size_t)jr * 64 * 1024, (bf16_t*)(ws + OFF_LA), 1024, 64, 64, MODE_BF16);
        addg(jr * 7 + 5, slot(5), (const bf16_t*)(ws + W_G1T) + (size_t)jr * 128 * 1024, (bf16_t*)(ws + OFF_LG), 1024, 128, 128, MODE_SIGM);
        addg(jr * 7 + 6, slot(2), (const bf16_t*)(ws + W_V1T), (bf16_t*)(ws + OFF_LV), 1024, 32, 32, MODE_BF16);
    }
    addg(14, slot(0), (const bf16_t*)(ws + W_MLIN), nullptr, 1024, 3088, 0, MODE_ML1);
    addg(15, slot(0), (const bf16_t*)(ws + W_RTIN), nullptr, 1024, 6144, 0, MODE_RT1);
    addg(16, slot(7), (const bf16_t*)(ws + W_OUT), slot(6), 1024, 1024, 1024, MODE_BF16);
    addg(17, slot(7), (const bf16_t*)(ws + W_OUT) + 1024 * 1024, slot(6), 1024, 1024, 1024, MODE_BF16);
    addg(18, slot(1), (const bf16_t*)(ws + W_MLOUT), slot(6), 1024, 1024, 1024, MODE_BF16);
    addg(19, slot(3), (const bf16_t*)(ws + W_RTOUT), slot(1), 2048, 1024, 1024, MODE_BF16);
    int nc = 0, ctile = 0;
    auto addc = [&](const float* src, size_t dst_off, int K, int N, int nb, long sbs, long dbs, int mode) {
        CJob& c = p.cj[nc++]; c.src = src; c.dst = (bf16_t*)(ws + dst_off); c.K = K; c.N = N; c.nb = nb; c.mode = mode; c.sbs = sbs; c.dbs = dbs;
        c.tiles_pb = ((K + 63) / 64) * ((N + 255) / 256); c.tile0 = ctile; ctile += c.tiles_pb * nb;
    };
    addc(p.in[7], W_RKV, 1024, 1024, 6, 1024 * 1024, 1024 * 1024, 0);
    addc(p.in[24], W_OUT, 1024, 1024, 2, 1024 * 1024, 1024 * 1024, 0);
    addc(p.in[9], W_W1T, 1024, 64, 2, 1024 * 64, 64 * 1024, 0);
    addc(p.in[12], W_A1T, 1024, 64, 2, 1024 * 64, 64 * 1024, 0);
    addc(p.in[17], W_G1T, 1024, 128, 2, 1024 * 128, 128 * 1024, 0);
    addc(p.in[15], W_V1T, 1024, 32, 1, 0, 0, 0);
    addc(p.in[10], W_W2T, 64, 1024, 2, 64 * 1024, 1024 * 64, 0);
    addc(p.in[13], W_A2T, 64, 1024, 2, 64 * 1024, 1024 * 64, 0);
    addc(p.in[18], W_G2T, 128, 1024, 2, 128 * 1024, 1024 * 128, 0);
    addc(p.in[16], W_V2T, 32, 1024, 1, 0, 0, 0);
    addc(p.in[25], W_MLIN, 1024, 3088, 1, 0, 0, 0);
    addc(p.in[31], W_MLOUT, 1024, 1024, 1, 0, 0, 0);
    addc(p.in[32], W_RTIN, 1024, 6144, 1, 0, 0, 3);
    addc(p.in[35], W_RTOUT, 2048, 1024, 1, 0, 0, 0);
    addc(p.in[40], W_MOE13, 1024, 512, 128, 1024 * 512, 1024 * 1024, 1);
    addc(p.in[41], W_MOE13, 1024, 512, 128, 1024 * 512, 1024 * 1024, 2);
    addc(p.in[42], W_MOE2, 512, 1024, 128, 512 * 1024, 1024 * 512, 0);
    p.ncj = nc; p.cj_tiles = ctile;

    (void)hipMemsetAsync(ws + OFF_CTL, 0, CTL_BYTES, stream);
#ifdef DBG_STOP
    const int nph = DBG_STOP;
#else
    const int nph = NPHASE;
#endif
#ifdef MULTI_LAUNCH
    for (int ph = 0; ph < nph; ++ph) { p.ph_lo = ph; p.ph_hi = ph + 1; hipLaunchKernelGGL(mega, dim3(grid), dim3(256), LDS_BYTES, stream, p); }
    if (0)
#endif
    {
        p.ph_lo = 0; p.ph_hi = nph;
        void* args[] = {&p};
        hipError_t e = hipLaunchCooperativeKernel((const void*)mega, dim3(grid), dim3(256), args, LDS_BYTES, stream);
        if (e != hipSuccess) fprintf(stderr, "cooperative launch failed: %s (grid %d)\n", hipGetErrorString(e), grid);
    }
}
```

```cpp
#include <hip/hip_runtime.h>
#include <cstdio>
#include <cstdint>

#ifndef ONE_LAUNCH
#define ONE_LAUNCH 0
#endif

typedef unsigned short bf16_t;
typedef short bf16x8 __attribute__((ext_vector_type(8)));
typedef float f32x4 __attribute__((ext_vector_type(4)));
#define LAS __attribute__((address_space(3)))
#define GAS __attribute__((address_space(1)))
typedef float f32x4g_t __attribute__((ext_vector_type(4)));
typedef unsigned u32x2g_t __attribute__((ext_vector_type(2)));
typedef unsigned u32x4g_t __attribute__((ext_vector_type(4)));
__device__ __forceinline__ float4 gld_f4(const float* p) { const f32x4g_t v = *(const GAS f32x4g_t*)(const GAS char*)(const char*)p; return make_float4(v[0], v[1], v[2], v[3]); }
__device__ __forceinline__ uint2 gld_u2(const void* p) { const u32x2g_t v = *(const GAS u32x2g_t*)(const GAS char*)(const char*)p; return make_uint2(v[0], v[1]); }
__device__ __forceinline__ uint4 gld_u4(const void* p) { const u32x4g_t v = *(const GAS u32x4g_t*)(const GAS char*)(const char*)p; return make_uint4(v[0], v[1], v[2], v[3]); }
__device__ __forceinline__ void gst_f4(float* p, float a, float b, float c, float d) { const f32x4g_t v = {a, b, c, d}; *(GAS f32x4g_t*)(GAS char*)(char*)p = v; }
__device__ __forceinline__ void gst_u2(void* p, unsigned a, unsigned b) { const u32x2g_t v = {a, b}; *(GAS u32x2g_t*)(GAS char*)(char*)p = v; }
__device__ __forceinline__ void gst_u4(void* p, unsigned a, unsigned b, unsigned c, unsigned d) { const u32x4g_t v = {a, b, c, d}; *(GAS u32x4g_t*)(GAS char*)(char*)p = v; }

constexpr int NTOK = 16384, DM = 1024, TSEQ = 2048, NBATCH = 8;
constexpr float DN_ALPHA = 1.681792830507429f;
constexpr float LN_EPS = 1e-5f;
constexpr size_t MB = 1u << 20;
constexpr size_t OFF_CTL = 0, OFF_CNT = 16384, CTL_BYTES = 65536;
constexpr size_t OFF_MOD = 65536;
constexpr size_t OFF_ROT = 1 * MB;
constexpr size_t OFF_BONUS = 3 * MB, OFF_GATES = 4 * MB, OFF_STAT = 5 * MB, OFF_LW = 13 * MB, OFF_LA = 15 * MB, OFF_LG = 17 * MB, OFF_LV = 21 * MB,
                 OFF_WGT = 22 * MB, OFF_LIST = 23 * MB, OFF_RTW = 25 * MB;
constexpr size_t OFF_W = 32 * MB;
constexpr size_t W_RKV = OFF_W, W_OUT = W_RKV + 12 * MB, W_W1T = W_OUT + 4 * MB, W_A1T = W_W1T + 256 * 1024, W_G1T = W_A1T + 256 * 1024, W_V1T = W_G1T + 512 * 1024,
                 W_W2T = W_V1T + 64 * 1024, W_A2T = W_W2T + 256 * 1024, W_G2T = W_A2T + 256 * 1024, W_V2T = W_G2T + 512 * 1024, W_MLIN = W_V2T + 64 * 1024 + 832 * 1024,
                 W_MLOUT = W_MLIN + 6400 * 1024, W_RTIN = W_MLOUT + 2 * MB, W_RTOUT = W_RTIN + 12 * MB, W_MOE13 = W_RTOUT + 4 * MB, W_MOE2 = W_MOE13 + 256 * MB,
                 W_END = W_MOE2 + 128 * MB;
constexpr size_t OFF_XRES = 464 * MB;
constexpr size_t OFF_SLOT = 528 * MB, SLOT = 32 * MB;
static_assert(W_END <= OFF_XRES, "weights overflow");
constexpr size_t OFF_XRES2 = OFF_SLOT + 12 * SLOT;
constexpr size_t WS_NEED = OFF_XRES2 + 2 * SLOT;
constexpr int LIST_CAP = 16384;

#define XB_TMO      128
#define XB_XCNT(j)  (256  + 64 * (j))
#define XB_XSUB(j)  (1280 + 64 * (j))
#define XB_XGEN(j)  (2304 + 64 * (j))
#define XB_TOP      3328
#define XB_TOPGEN   3392
#define XCD_BAR_WORDS 3456
#define XB_SPIN_CAP (1u << 22)
__device__ __forceinline__ unsigned xb_ld(unsigned* p)              { return __hip_atomic_load(p, __ATOMIC_RELAXED, __HIP_MEMORY_SCOPE_AGENT); }
__device__ __forceinline__ unsigned xb_add(unsigned* p, unsigned v) { return __hip_atomic_fetch_add(p, v, __ATOMIC_RELAXED, __HIP_MEMORY_SCOPE_AGENT); }
__device__ __forceinline__ unsigned xb_xcc_id() { return (unsigned)__builtin_amdgcn_s_getreg((3 << 11) | 20) & 0xFu; }
#define XB_SPIN(cond, bar) do { unsigned _sp = 0; while (cond) { __builtin_amdgcn_s_sleep(1); \
    if ((++_sp & 255u) == 0u) { if (xb_ld(&(bar)[XB_TMO])) break; if (_sp > XB_SPIN_CAP) { atomicAdd(&(bar)[XB_TMO], 1u); break; } } } } while (0)
struct XcdBarrier { unsigned* bar; unsigned x; volatile LAS unsigned* st; };
__device__ __forceinline__ XcdBarrier xcd_barrier_post(unsigned* bar, volatile LAS unsigned* st) {
    XcdBarrier b; b.bar = bar; b.x = xb_xcc_id(); b.st = st;
    if (threadIdx.x == 0) (void)xb_add(&bar[XB_XCNT(b.x)], 1u);
    return b;
}
__device__ __forceinline__ void xcd_barrier_complete(unsigned* bar, unsigned x, unsigned& nloc, unsigned& nx) {
    const unsigned G = gridDim.x;
    unsigned sum, cnt, mine, sp = 0u;
    for (;;) {
        sum = 0u; cnt = 0u; mine = 0u;
#pragma unroll
        for (unsigned j = 0; j < 16; ++j) { const unsigned c = xb_ld(&bar[XB_XCNT(j)]); sum += c; cnt += (c > 0u) ? 1u : 0u; mine = (j == x) ? c : mine; }
        if (sum == G) break;
        __builtin_amdgcn_s_sleep(1);
        if ((++sp & 255u) == 0u) { if (xb_ld(&bar[XB_TMO])) break; if (sp > XB_SPIN_CAP) { atomicAdd(&bar[XB_TMO], 1u); break; } }
    }
    nloc = mine > 0u ? mine : 1u; nx = cnt > 0u ? cnt : 1u;
}
__device__ __forceinline__ void xcd_barrier(const XcdBarrier& b) {
    asm volatile("s_waitcnt vmcnt(0)" ::: "memory");
    __syncthreads();
    if (threadIdx.x == 0) {
        unsigned* bar = b.bar;
        __builtin_amdgcn_s_waitcnt(0);
        unsigned nloc = b.st[0], nx = b.st[1];
        if (nloc == 0u) { xcd_barrier_complete(bar, b.x, nloc, nx); b.st[0] = nloc; b.st[1] = nx; }
        const unsigned old = xb_add(&bar[XB_XSUB(b.x)], 1u);
        const unsigned gen = old / nloc;
        if (old + 1u == (gen + 1u) * nloc) {
            __builtin_amdgcn_fence(__ATOMIC_RELEASE, "agent");
            asm volatile("s_waitcnt vmcnt(0)" ::: "memory");
            const unsigned og = xb_add(&bar[XB_TOP], 1u);
            const unsigned tg = og / nx;
            if (og + 1u == (tg + 1u) * nx) xb_add(&bar[XB_TOPGEN], 1u);
            else XB_SPIN(xb_ld(&bar[XB_TOPGEN]) == tg, bar);
            __builtin_amdgcn_fence(__ATOMIC_ACQUIRE, "agent");
            xb_add(&bar[XB_XGEN(b.x)], 1u);
            asm volatile("s_waitcnt vmcnt(0)" ::: "memory");
        } else {
            XB_SPIN(xb_ld(&bar[XB_XGEN(b.x)]) == gen, bar);
            __builtin_amdgcn_fence(__ATOMIC_ACQUIRE, "agent");
            asm volatile("s_waitcnt vmcnt(0)" ::: "memory");
        }
    }
    __syncthreads();
}

__device__ __forceinline__ int tidx() { int t = threadIdx.x; asm volatile("" : "+v"(t)); return t; }
typedef __bf16 bf16x2_t __attribute__((ext_vector_type(2)));
typedef float f32x2_t __attribute__((ext_vector_type(2)));
__device__ __forceinline__ unsigned cvt_pk(float lo, float hi) {
    f32x2_t v = {lo, hi}; bf16x2_t r = __builtin_convertvector(v, bf16x2_t);
    unsigned u; __builtin_memcpy(&u, &r, 4); return u;
}
__device__ __forceinline__ bf16_t f2bf(float f) { return (bf16_t)(cvt_pk(f, 0.f) & 0xffffu); }
__device__ __forceinline__ float bflo(unsigned u) { return __uint_as_float(u << 16); }
__device__ __forceinline__ float bfhi(unsigned u) { return __uint_as_float(u & 0xffff0000u); }
__device__ __forceinline__ float bf2f(bf16_t u) { return __uint_as_float(((unsigned)u) << 16); }
__device__ __forceinline__ void unpack8(const uint4& u, float (&f)[8]) {
    f[0] = bflo(u.x); f[1] = bfhi(u.x); f[2] = bflo(u.y); f[3] = bfhi(u.y); f[4] = bflo(u.z); f[5] = bfhi(u.z); f[6] = bflo(u.w); f[7] = bfhi(u.w);
}
__device__ __forceinline__ uint4 pack8(const float (&f)[8]) { uint4 u; u.x = cvt_pk(f[0], f[1]); u.y = cvt_pk(f[2], f[3]); u.z = cvt_pk(f[4], f[5]); u.w = cvt_pk(f[6], f[7]); return u; }
typedef unsigned u32x4_t __attribute__((ext_vector_type(4)));
__device__ __forceinline__ uint4 gload16(const void* p) {
    const u32x4_t v = *(const __attribute__((address_space(1))) u32x4_t*)p;
    return make_uint4(v[0], v[1], v[2], v[3]);
}
__device__ __forceinline__ float sigmoidf_(float x) { return __builtin_amdgcn_rcpf(1.0f + __expf(-x)); }
__device__ __forceinline__ float siluf_(float x) { return x * __builtin_amdgcn_rcpf(1.0f + __expf(-x)); }
__device__ __forceinline__ float tanhf_(float x) { return 1.0f - 2.0f * __builtin_amdgcn_rcpf(1.0f + __expf(2.0f * x)); }
__device__ __forceinline__ float softplusf_(float x) { return fmaxf(x, 0.f) + __logf(1.0f + __expf(-fabsf(x))); }
__device__ __forceinline__ float row16_sum(float v);
__device__ __forceinline__ float wave_sum(float v) {
    v = row16_sum(v); v += __shfl_xor(v, 16); v += __shfl_xor(v, 32);
    return v;
}
__device__ __forceinline__ float row16_sum(float v) {
    v += __builtin_amdgcn_update_dpp(0.f, v, 0x128, 0xf, 0xf, false);
    v += __builtin_amdgcn_update_dpp(0.f, v, 0x124, 0xf, 0xf, false);
    v += __builtin_amdgcn_update_dpp(0.f, v, 0x122, 0xf, 0xf, false);
    v += __builtin_amdgcn_update_dpp(0.f, v, 0x121, 0xf, 0xf, false);
    return v;
}
__device__ __forceinline__ float oct_sum(float v) {
    v += __builtin_amdgcn_update_dpp(0.f, v, 0xB1, 0xf, 0xf, false);
    v += __builtin_amdgcn_update_dpp(0.f, v, 0x4E, 0xf, 0xf, false);
    v += __builtin_amdgcn_update_dpp(0.f, v, 0x141, 0xf, 0xf, false);
    return v;
}

enum { MODE_BF16 = 0, MODE_TANH = 1, MODE_SIGM = 2, MODE_ML1 = 3, MODE_RT1 = 4 };
struct GJob { const bf16_t* A; const bf16_t* Bt; bf16_t* out; int K, N, ldo, mode, ntn, tile0, half; };
struct CJob { const float* src; bf16_t* dst; int K, N, nb, mode; long sbs, dbs; int tiles_pb, tile0; };
constexpr int NGJ = 20, NCJ = 24;
struct Params {
    const float* in[43]; float* out; char* ws;
    int ph_lo, ph_hi, ncj, cj_tiles;
    GJob gj[NGJ];
    CJob cj[NCJ];
};
#define CAS __attribute__((address_space(4)))
typedef const CAS Params& PRef;

__device__ __forceinline__ f32x4 mfma16(const uint4& a, const uint4& b, f32x4 c) {
    bf16x8 av, bv; __builtin_memcpy(&av, &a, 16); __builtin_memcpy(&bv, &b, 16);
    return __builtin_amdgcn_mfma_f32_16x16x32_bf16(av, bv, c, 0, 0, 0);
}
template <bool PFA = true, class AL, class BL>
__device__ __forceinline__ void gemm_mainloop(char* lds, int nk, const AL& al, const BL& bl, f32x4 (&acc)[4][4]) {
    const int t = tidx(), c = t & 7, r0 = t >> 3;
    const int lane = t & 63, wid = t >> 6, wr = wid >> 1, wc = wid & 1, fr = lane & 15, fq = lane >> 4;
    typename AL::Raw ra[4]; typename BL::Raw rb[4];
    const int woff = r0 * 128 + ((c ^ (r0 & 7)) << 4);
#pragma unroll
    for (int i = 0; i < 4; ++i) { if (PFA) ra[i] = al.fetch(i, r0 + 32 * i, c); rb[i] = bl.fetch(i, r0 + 32 * i, c); }
#pragma unroll
    for (int i = 0; i < 4; ++i) {
        if (!PFA) { ra[i] = al.fetch(i, r0 + 32 * i, c); }
        *(uint4*)(lds + woff + i * 4096) = al.finish(ra[i], i, r0 + 32 * i, c);
        *(uint4*)(lds + 16384 + woff + i * 4096) = bl.finish(rb[i], i, r0 + 32 * i, c);
        if (!PFA) asm volatile("" ::: "memory");
    }
#pragma unroll
    for (int m = 0; m < 4; ++m)
#pragma unroll
        for (int n = 0; n < 4; ++n) acc[m][n] = (f32x4){0.f, 0.f, 0.f, 0.f};
    __syncthreads();
    const int aoff = (wr * 64 + fr) * 128, boff = 16384 + (wc * 64 + fr) * 128, sw = fr & 7;
    for (int kt = 0; kt < nk; ++kt) {
        const bool more = (kt + 1 < nk);
        if (more) {
#pragma unroll
            for (int i = 0; i < 4; ++i) { if (PFA) ra[i] = al.fetch(i, r0 + 32 * i, (kt + 1) * 8 + c); rb[i] = bl.fetch(i, r0 + 32 * i, (kt + 1) * 8 + c); }
        }
        const char* buf = lds + (kt & 1) * 32768;
#pragma unroll
        for (int ks = 0; ks < 2; ++ks) {
            uint4 af[4], bfm[4];
            const int ch = ((ks * 4 + fq) ^ sw) << 4;
#pragma unroll
            for (int m = 0; m < 4; ++m) af[m] = *(const uint4*)(buf + aoff + m * 2048 + ch);
#pragma unroll
            for (int n = 0; n < 4; ++n) bfm[n] = *(const uint4*)(buf + boff + n * 2048 + ch);
#pragma unroll
            for (int m = 0; m < 4; ++m)
#pragma unroll
                for (int n = 0; n < 4; ++n) acc[m][n] = mfma16(bfm[n], af[m], acc[m][n]);
        }
        if (more) {
            char* nb = lds + ((kt + 1) & 1) * 32768;
#pragma unroll
            for (int i = 0; i < 4; ++i) {
                if (!PFA) ra[i] = al.fetch(i, r0 + 32 * i, (kt + 1) * 8 + c);
                *(uint4*)(nb + woff + i * 4096) = al.finish(ra[i], i, r0 + 32 * i, (kt + 1) * 8 + c);
                *(uint4*)(nb + 16384 + woff + i * 4096) = bl.finish(rb[i], i, r0 + 32 * i, (kt + 1) * 8 + c);
                if (!PFA) asm volatile("" ::: "memory");
            }
        }
        __syncthreads();
    }
}
__device__ __forceinline__ void glds16(const bf16_t* g, char* l) {
    __builtin_amdgcn_global_load_lds((const unsigned*)g, (LAS unsigned*)l, 16, 0, 0);
}
__device__ __forceinline__ void glds16_asm(const void* gsrc, unsigned lds_dst) {
    unsigned keep;
    asm volatile("s_mov_b32 %0, m0\n\ts_mov_b32 m0, %2\n\ts_nop 0\n\tglobal_load_lds_dwordx4 %1, off\n\ts_mov_b32 m0, %0" : "=&s"(keep) : "v"(gsrc), "s"(lds_dst) : "memory");
}
__device__ __forceinline__ unsigned lds_addr_u(const char* l) { return (unsigned)(size_t)(const LAS char*)l; }
__device__ __forceinline__ int glds_chunk(int t) { return (t & 7) ^ ((t >> 3) & 7); }
__device__ __forceinline__ void mma_ktile(const char* buf, int aoff, int boff, int sw, int fq, f32x4 (&acc)[4][4]) {
    const int ch0 = ((0 * 4 + fq) ^ sw) << 4, ch1 = ((1 * 4 + fq) ^ sw) << 4;
    const char* pa = buf + aoff; const char* pb = buf + boff;
    uint4 a0[4], a1[4], b[8];
#pragma unroll
    for (int m = 0; m < 4; ++m) a0[m] = *(const uint4*)(pa + m * 2048 + ch0);
    b[0] = *(const uint4*)(pb + ch0); b[1] = *(const uint4*)(pb + 2048 + ch0);
    __builtin_amdgcn_sched_barrier(0);
    b[2] = *(const uint4*)(pb + 2 * 2048 + ch0);
#pragma unroll
    for (int m = 0; m < 4; ++m) acc[m][0] = mfma16(b[0], a0[m], acc[m][0]);
    __builtin_amdgcn_sched_barrier(0);
    b[3] = *(const uint4*)(pb + 3 * 2048 + ch0);
#pragma unroll
    for (int m = 0; m < 4; ++m) acc[m][1] = mfma16(b[1], a0[m], acc[m][1]);
    __builtin_amdgcn_sched_barrier(0);
#pragma unroll
    for (int m = 0; m < 4; ++m) a1[m] = *(const uint4*)(pa + m * 2048 + ch1);
#pragma unroll
    for (int m = 0; m < 4; ++m) acc[m][2] = mfma16(b[2], a0[m], acc[m][2]);
    __builtin_amdgcn_sched_barrier(0);
    b[4] = *(const uint4*)(pb + ch1); b[5] = *(const uint4*)(pb + 2048 + ch1);
#pragma unroll
    for (int m = 0; m < 4; ++m) acc[m][3] = mfma16(b[3], a0[m], acc[m][3]);
    __builtin_amdgcn_sched_barrier(0);
    b[6] = *(const uint4*)(pb + 2 * 2048 + ch1);
#pragma unroll
    for (int m = 0; m < 4; ++m) acc[m][0] = mfma16(b[4], a1[m], acc[m][0]);
    __builtin_amdgcn_sched_barrier(0);
    b[7] = *(const uint4*)(pb + 3 * 2048 + ch1);
#pragma unroll
    for (int m = 0; m < 4; ++m) acc[m][1] = mfma16(b[5], a1[m], acc[m][1]);
    __builtin_amdgcn_sched_barrier(0);
#pragma unroll
    for (int m = 0; m < 4; ++m) acc[m][2] = mfma16(b[6], a1[m], acc[m][2]);
#pragma unroll
    for (int m = 0; m < 4; ++m) acc[m][3] = mfma16(b[7], a1[m], acc[m][3]);
}
__device__ __forceinline__ void gemm_gg(char* lds, int nk, const bf16_t* const (&ar)[4], const bf16_t* const (&br)[4], f32x4 (&acc)[4][4]) {
    const int t = tidx();
    const int lane = t & 63, wid = t >> 6, wr = wid >> 1, wc = wid & 1, fr = lane & 15, fq = lane >> 4;
    const unsigned wbs = (unsigned)__builtin_amdgcn_readfirstlane((int)(lds_addr_u(lds) + wid * 1024));
#pragma unroll
    for (int i = 0; i < 4; ++i) { glds16_asm(ar[i], wbs + i * 4096); glds16_asm(br[i], wbs + 16384 + i * 4096); }
#pragma unroll
    for (int m = 0; m < 4; ++m)
#pragma unroll
        for (int n = 0; n < 4; ++n) acc[m][n] = (f32x4){0.f, 0.f, 0.f, 0.f};
    asm volatile("s_waitcnt vmcnt(0)" ::: "memory");
    __syncthreads();
    const int aoff = (wr * 64 + fr) * 128, boff = 16384 + (wc * 64 + fr) * 128, sw = fr & 7;
    for (int kt = 0; kt < nk; ++kt) {
        if (kt + 1 < nk) {
            const unsigned nb = (unsigned)__builtin_amdgcn_readfirstlane((int)(wbs + ((kt + 1) & 1) * 32768));
#pragma unroll
            for (int i = 0; i < 4; ++i) { glds16_asm(ar[i] + (kt + 1) * 64, nb + i * 4096); glds16_asm(br[i] + (kt + 1) * 64, nb + 16384 + i * 4096); }
        }
        mma_ktile(lds + (kt & 1) * 32768, aoff, boff, sw, fq, acc);
        asm volatile("s_waitcnt vmcnt(0)" ::: "memory");
        __syncthreads();
    }
}
__device__ __forceinline__ void gemm_hn(char* lds, int nk, const bf16_t* const (&ar)[4], const bf16_t* const (&br)[2], f32x4 (&acc)[2][4]) {
    const int t = tidx();
    const int lane = t & 63, wid = t >> 6, fr = lane & 15, fq = lane >> 4;
    const unsigned wbs = (unsigned)__builtin_amdgcn_readfirstlane((int)(lds_addr_u(lds) + wid * 1024));
#pragma unroll
    for (int i = 0; i < 4; ++i) glds16_asm(ar[i], wbs + i * 4096);
#pragma unroll
    for (int i = 0; i < 2; ++i) glds16_asm(br[i], wbs + 16384 + i * 4096);
#pragma unroll
    for (int m = 0; m < 2; ++m)
#pragma unroll
        for (int n = 0; n < 4; ++n) acc[m][n] = (f32x4){0.f, 0.f, 0.f, 0.f};
    asm volatile("s_waitcnt vmcnt(0)" ::: "memory");
    __syncthreads();
    const int aoff = (wid * 32 + fr) * 128, boff = 16384 + fr * 128, sw = fr & 7;
    for (int kt = 0; kt < nk; ++kt) {
        if (kt + 1 < nk) {
            const unsigned nb = (unsigned)__builtin_amdgcn_readfirstlane((int)(wbs + ((kt + 1) & 1) * 32768));
#pragma unroll
            for (int i = 0; i < 4; ++i) glds16_asm(ar[i] + (kt + 1) * 64, nb + i * 4096);
#pragma unroll
            for (int i = 0; i < 2; ++i) glds16_asm(br[i] + (kt + 1) * 64, nb + 16384 + i * 4096);
        }
        const char* buf = lds + (kt & 1) * 32768;
#pragma unroll
        for (int ks = 0; ks < 2; ++ks) {
            const int ch = ((ks * 4 + fq) ^ sw) << 4;
            uint4 af[2], bfm[4];
#pragma unroll
            for (int m = 0; m < 2; ++m) af[m] = *(const uint4*)(buf + aoff + m * 2048 + ch);
#pragma unroll
            for (int n = 0; n < 4; ++n) bfm[n] = *(const uint4*)(buf + boff + n * 2048 + ch);
#pragma unroll
            for (int m = 0; m < 2; ++m)
#pragma unroll
                for (int n = 0; n < 4; ++n) acc[m][n] = mfma16(bfm[n], af[m], acc[m][n]);
        }
        asm volatile("s_waitcnt vmcnt(0)" ::: "memory");
        __syncthreads();
    }
}
template <class AL>
__device__ __forceinline__ void gemm_rg(char* lds, int nk, const AL& al, const bf16_t* const (&br)[4], f32x4 (&acc)[4][4]) {
    const int t = tidx(), c = t & 7, r0 = t >> 3;
    const int lane = t & 63, wid = t >> 6, wr = wid >> 1, wc = wid & 1, fr = lane & 15, fq = lane >> 4;
    char* wb = lds + wid * 1024;
    const int woff = r0 * 128 + ((c ^ (r0 & 7)) << 4);
#pragma unroll
    for (int i = 0; i < 4; ++i) glds16(br[i], wb + 16384 + i * 4096);
#pragma unroll
    for (int i = 0; i < 4; ++i) {
        typename AL::Raw ra = al.fetch(i, r0 + 32 * i, c);
        *(uint4*)(lds + woff + i * 4096) = al.finish(ra, i, r0 + 32 * i, c);
        asm volatile("" ::: "memory");
    }
#pragma unroll
    for (int m = 0; m < 4; ++m)
#pragma unroll
        for (int n = 0; n < 4; ++n) acc[m][n] = (f32x4){0.f, 0.f, 0.f, 0.f};
    asm volatile("s_waitcnt vmcnt(0)" ::: "memory");
    __syncthreads();
    const int aoff = (wr * 64 + fr) * 128, boff = 16384 + (wc * 64 + fr) * 128, sw = fr & 7;
    for (int kt = 0; kt < nk; ++kt) {
        const bool more = (kt + 1 < nk);
        char* nbuf = lds + ((kt + 1) & 1) * 32768;
        if (more) {
#pragma unroll
            for (int i = 0; i < 4; ++i) glds16(br[i] + (kt + 1) * 64, nbuf + wid * 1024 + 16384 + i * 4096);
        }
        mma_ktile(lds + (kt & 1) * 32768, aoff, boff, sw, fq, acc);
        if (more) {
#pragma unroll
            for (int i = 0; i < 4; ++i) {
                typename AL::Raw ra = al.fetch(i, r0 + 32 * i, (kt + 1) * 8 + c);
                *(uint4*)(nbuf + woff + i * 4096) = al.finish(ra, i, r0 + 32 * i, (kt + 1) * 8 + c);
                asm volatile("" ::: "memory");
            }
        }
        asm volatile("s_waitcnt vmcnt(0)" ::: "memory");
        __syncthreads();
    }
}
struct LdPlain {
    typedef uint4 Raw;
    const bf16_t* p; int ld; int nvalid;
    __device__ __forceinline__ uint4 fetch(int, int r, int kc) const { return (r < nvalid) ? *(const uint4*)(p + (size_t)r * ld + kc * 8) : make_uint4(0u, 0u, 0u, 0u); }
    __device__ __forceinline__ uint4 finish(const uint4& v, int, int, int) const { return v; }
};
struct LdGather {
    typedef uint4 Raw;
    const bf16_t* rp[4];
    __device__ __forceinline__ uint4 fetch(int i, int, int kc) const { const bf16_t* q = rp[i]; return q ? *(const uint4*)(q + kc * 8) : make_uint4(0u, 0u, 0u, 0u); }
    __device__ __forceinline__ uint4 finish(const uint4& v, int, int, int) const { return v; }
};
__device__ __forceinline__ void tile_map(int id, int NT, int& mt, int& nt) {
    const int x = id & 7, q = id >> 3;
    const int mg = q / (8 * NT), q2 = q - mg * 8 * NT, G = (NT + 7) >> 3;
    int g = q2 >> 6; g = g < G - 1 ? g : G - 1;
    const int r = q2 - (g << 6), w = (g == G - 1) ? NT - 8 * g : 8;
    mt = (mg * 8 + r / w) * 8 + x; nt = 8 * g + r % w;
}

__device__ __forceinline__ int conv_row(int mode, int n) {
    if (mode == 1) return (n >> 4) * 32 + (n & 15);
    if (mode == 2) return (n >> 4) * 32 + 16 + (n & 15);
    if (mode == 3 && n < 2048) { const int c = n & 255, c2 = c & 127; return (n & ~255) + (c2 >> 4) * 32 + ((c >> 7) << 4) + (c2 & 15); }
    return n;
}
__device__ __forceinline__ void phase_prologue(PRef p, char* lds) {
    const int t = tidx();
    const int n_ada = 8 * 48, n_rot = 256 + 144;
    float* mod = (float*)(p.ws + OFF_MOD);
    for (int it = blockIdx.x; it < n_ada + n_rot; it += gridDim.x) {
        if (it < n_ada) {
            const int pr = it / 48, cb = it % 48;
            float* sc = (float*)lds;
            float* red = (float*)(lds + 32768);
            for (int i = t; i < 8192; i += 256) { const int b = i >> 10, k = i & 1023; sc[k * 8 + b] = siluf_(p.in[1][b * 1024 + k]); }
            __syncthreads();
            const int kg = t >> 6, cl = t & 63, col = cb * 64 + cl;
            const float* W = p.in[2] + (size_t)pr * 1024 * 3072 + col;
            float a[8] = {0, 0, 0, 0, 0, 0, 0, 0};
#pragma unroll 8
            for (int k = kg * 256; k < kg * 256 + 256; ++k) {
                const float w = W[(size_t)k * 3072];
                const float4 s0 = *(const float4*)(sc + k * 8), s1 = *(const float4*)(sc + k * 8 + 4);
                a[0] += w * s0.x; a[1] += w * s0.y; a[2] += w * s0.z; a[3] += w * s0.w; a[4] += w * s1.x; a[5] += w * s1.y; a[6] += w * s1.z; a[7] += w * s1.w;
            }
#pragma unroll
            for (int b = 0; b < 8; ++b) red[(kg * 8 + b) * 64 + cl] = a[b];
            __syncthreads();
            for (int i = t; i < 512; i += 256) {
                const int b = i >> 6, c2 = i & 63;
                const float s = red[(0 * 8 + b) * 64 + c2] + red[(1 * 8 + b) * 64 + c2] + red[(2 * 8 + b) * 64 + c2] + red[(3 * 8 + b) * 64 + c2];
                mod[((size_t)pr * 8 + b) * 3072 + cb * 64 + c2] = s + p.in[3][pr * 3072 + cb * 64 + c2];
            }
            __syncthreads();
        } else if (it >= n_ada + 256 && it < n_ada + n_rot) {
            float* rtw = (float*)(p.ws + OFF_RTW);
            const int base = (it - n_ada - 256) * 1024;
            for (int e = base + t; e < base + 1024; e += 256) {
                const int L = e / (36 * 1024), o = (e >> 10) % 36, k = e & 1023;
                rtw[e] = (o < 4) ? p.in[36][((size_t)L * 1024 + k) * 4 + o] : p.in[38][((size_t)L * 1024 + k) * 32 + (o - 4)];
            }
        } else if (it < n_ada + 256) {
            float* rot = (float*)(p.ws + OFF_ROT);
            const int base = (it - n_ada) * 1024;
            for (int e = base + t; e < base + 1024; e += 256) {
                const int tt = e >> 7, i = e & 127;
                const float inv = __builtin_amdgcn_exp2f(-(float)i * (13.287712379549449f / 127.0f));
                const float ang = (float)tt * inv;
                float rev = ang * 0.15915494309189535f; rev -= floorf(rev);
                rot[e * 2] = __builtin_amdgcn_cosf(rev); rot[e * 2 + 1] = __builtin_amdgcn_sinf(rev);
            }
        }
    }
    {
        float* sm = (float*)lds;
        const int lane = t & 63, wv = t >> 6;
        const float* nsrc = nullptr; bf16_t* ndst = nullptr; int nK = 0, nN = 0, nmode = 0, nkt = 0, nnt = 0;
        float4 pv[16];
#define CJ_SETUP(ct_) { int c_ = (ct_), j_ = 0; while (j_ + 1 < p.ncj && c_ >= p.cj[j_ + 1].tile0) ++j_; \
            c_ -= p.cj[j_].tile0; const int tpb_ = p.cj[j_].tiles_pb; const int bi_ = c_ / tpb_, tl_ = c_ % tpb_; nK = p.cj[j_].K; nN = p.cj[j_].N; nmode = p.cj[j_].mode; \
            const int nNt_ = (nN + 255) >> 8; nkt = tl_ / nNt_; nnt = tl_ % nNt_; nsrc = p.cj[j_].src + (size_t)bi_ * p.cj[j_].sbs; ndst = p.cj[j_].dst + (size_t)bi_ * p.cj[j_].dbs; }
#define CJ_LOAD() { _Pragma("unroll") for (int i = 0; i < 16; ++i) { const int k = nkt * 64 + wv + 4 * i, n = nnt * 256 + lane * 4; \
            pv[i] = (k < nK && n < nN) ? gld_f4(nsrc + (size_t)k * nN + n) : make_float4(0.f, 0.f, 0.f, 0.f); } }
        int* const tick = (int*)(p.ws + OFF_CTL + 20480);
        int* const nbox = (int*)(lds + 66560);
        int ct = (int)blockIdx.x, ct2 = (int)gridDim.x + (int)blockIdx.x;
        if (ct < p.cj_tiles) { CJ_SETUP(ct); CJ_LOAD(); }
        while (ct < p.cj_tiles) {
#pragma unroll
            for (int i = 0; i < 16; ++i) *(float4*)(sm + (wv + 4 * i) * 260 + lane * 4) = pv[i];
            bf16_t* const sdst = ndst; const int sK = nK, sN = nN, smode = nmode, skt = nkt, snt = nnt;
            if (ct2 < p.cj_tiles) { CJ_SETUP(ct2); CJ_LOAD(); }
            if (t == 0) *nbox = 2 * (int)gridDim.x + atomicAdd(tick, 1);
            __syncthreads();
            const int ct3 = *nbox;
#pragma unroll
            for (int h2 = 0; h2 < 4; ++h2) {
                const int nl = lane + 64 * h2, n = snt * 256 + nl, k0 = skt * 64 + wv * 16;
                if (n < sN && k0 < sK) {
                    float f[8], g[8];
#pragma unroll
                    for (int q = 0; q < 8; ++q) { f[q] = sm[(wv * 16 + q) * 260 + nl]; g[q] = sm[(wv * 16 + 8 + q) * 260 + nl]; }
                    bf16_t* d = sdst + (size_t)conv_row(smode, n) * sK + k0;
                    { const uint4 u0 = pack8(f), u1 = pack8(g); gst_u4(d, u0.x, u0.y, u0.z, u0.w); gst_u4(d + 8, u1.x, u1.y, u1.z, u1.w); }
                }
            }
            __syncthreads();
            ct = ct2; ct2 = ct3;
        }
#undef CJ_SETUP
#undef CJ_LOAD
    }
}

__device__ __forceinline__ void row_load_f32(const float* p, float (&v)[16], int lane) {
#pragma unroll
    for (int c = 0; c < 4; ++c) { const float4 x = gld_f4(p + c * 256 + lane * 4); v[c * 4] = x.x; v[c * 4 + 1] = x.y; v[c * 4 + 2] = x.z; v[c * 4 + 3] = x.w; }
}
__device__ __forceinline__ void row_load_f32_l(const float* p, float (&v)[16], int lane) {
#pragma unroll
    for (int c = 0; c < 4; ++c) { const float4 x = *(const float4*)(p + c * 256 + lane * 4); v[c * 4] = x.x; v[c * 4 + 1] = x.y; v[c * 4 + 2] = x.z; v[c * 4 + 3] = x.w; }
}
__device__ __forceinline__ void row_load_bf16(const bf16_t* p, float (&v)[16], int lane) {
#pragma unroll
    for (int c = 0; c < 4; ++c) { const uint2 x = gld_u2(p + c * 256 + lane * 4); v[c * 4] = bflo(x.x); v[c * 4 + 1] = bfhi(x.x); v[c * 4 + 2] = bflo(x.y); v[c * 4 + 3] = bfhi(x.y); }
}
__device__ __forceinline__ void row_store_bf16(bf16_t* p, const float (&v)[16], int lane) {
#pragma unroll
    for (int c = 0; c < 4; ++c) gst_u2(p + c * 256 + lane * 4, cvt_pk(v[c * 4], v[c * 4 + 1]), cvt_pk(v[c * 4 + 2], v[c * 4 + 3]));
}
__device__ __forceinline__ void row_store_f32(float* p, const float (&v)[16], int lane) {
#pragma unroll
    for (int c = 0; c < 4; ++c) gst_f4(p + c * 256 + lane * 4, v[c * 4], v[c * 4 + 1], v[c * 4 + 2], v[c * 4 + 3]);
}
__device__ __forceinline__ void row_store_f32_l(float* p, const float (&v)[16], int lane) {
#pragma unroll
    for (int c = 0; c < 4; ++c) *(float4*)(p + c * 256 + lane * 4) = make_float4(v[c * 4], v[c * 4 + 1], v[c * 4 + 2], v[c * 4 + 3]);
}
__device__ __forceinline__ void row_layernorm(float (&v)[16], const float* g, const float* b, int lane) {
    float gg[16], bb[16]; row_load_f32(g, gg, lane); row_load_f32(b, bb, lane);
    float s = 0.f, q = 0.f;
#pragma unroll
    for (int i = 0; i < 16; ++i) { s += v[i]; q += v[i] * v[i]; }
    s = wave_sum(s); q = wave_sum(q);
    const float mean = s * (1.0f / 1024.0f);
    const float rstd = rsqrtf(fmaxf(q * (1.0f / 1024.0f) - mean * mean, 0.f) + LN_EPS);
#pragma unroll
    for (int i = 0; i < 16; ++i) v[i] = (v[i] - mean) * rstd * gg[i] + bb[i];
}
__device__ __forceinline__ void row_modulate(const float (&x)[16], float (&h)[16], const float* mod3, int lane) {
    float sh[16], sc[16]; row_load_f32(mod3, sh, lane); row_load_f32(mod3 + 1024, sc, lane);
#pragma unroll
    for (int i = 0; i < 16; ++i) h[i] = x[i] * (1.0f + sc[i]) + sh[i];
}
__device__ __forceinline__ void load_mu(const float* mu, float (&m)[6][16], int lane) {
#pragma unroll
    for (int n = 0; n < 6; ++n) row_load_f32(mu + n * 1024, m[n], lane);
}
__device__ __forceinline__ void emit_next(bf16_t* s0, int kind, int row, const float (&h)[16], const float (&hp)[16], const float (&m)[6][16], int lane) {
    if (kind == 0) {
#pragma unroll
        for (int n = 0; n < 6; ++n) {
#pragma unroll
            for (int c = 0; c < 4; ++c)
                gst_u2(s0 + (size_t)n * (SLOT / 2) + (size_t)row * 1024 + c * 256 + lane * 4,
                       cvt_pk(h[c * 4] + (hp[c * 4] - h[c * 4]) * m[n][c * 4], h[c * 4 + 1] + (hp[c * 4 + 1] - h[c * 4 + 1]) * m[n][c * 4 + 1]),
                       cvt_pk(h[c * 4 + 2] + (hp[c * 4 + 2] - h[c * 4 + 2]) * m[n][c * 4 + 2], h[c * 4 + 3] + (hp[c * 4 + 3] - h[c * 4 + 3]) * m[n][c * 4 + 3]));
        }
    } else row_store_bf16(s0 + (size_t)row * 1024, h, lane);
}
__device__ __forceinline__ void emit_next_l(bf16_t* s0, const float* mu, int kind, int row, const float (&h)[16], const float (&hp)[16], int lane) {
    if (kind == 0) {
#pragma unroll 1
        for (int n = 0; n < 6; ++n) {
#pragma unroll
            for (int c2 = 0; c2 < 2; ++c2) {
                const float4 ma = gld_f4(mu + n * 1024 + (2 * c2) * 256 + lane * 4), mb = gld_f4(mu + n * 1024 + (2 * c2 + 1) * 256 + lane * 4);
                const float mm[8] = {ma.x, ma.y, ma.z, ma.w, mb.x, mb.y, mb.z, mb.w};
#pragma unroll
                for (int cc = 0; cc < 2; ++cc) {
                    const int c = 2 * c2 + cc;
                    gst_u2(s0 + (size_t)n * (SLOT / 2) + (size_t)row * 1024 + c * 256 + lane * 4,
                           cvt_pk(h[c * 4] + (hp[c * 4] - h[c * 4]) * mm[cc * 4], h[c * 4 + 1] + (hp[c * 4 + 1] - h[c * 4 + 1]) * mm[cc * 4 + 1]),
                           cvt_pk(h[c * 4 + 2] + (hp[c * 4 + 2] - h[c * 4 + 2]) * mm[cc * 4 + 2], h[c * 4 + 3] + (hp[c * 4 + 3] - h[c * 4 + 3]) * mm[cc * 4 + 3]));
                }
            }
        }
    } else row_store_bf16(s0 + (size_t)row * 1024, h, lane);
}
__device__ __forceinline__ void phase_h0(PRef p) {
    const int t_ = tidx(); const int lane = t_ & 63, gw = blockIdx.x * 4 + (t_ >> 6), nw = gridDim.x * 4;
    const int rpw = NTOK / nw;
    const int r_lo = gw * rpw;
    const float* mod = (const float*)(p.ws + OFF_MOD) + ((size_t)(0 * 2 + 0) * 8 + (r_lo >> 11)) * 3072;
    float sh[16], sc[16]; row_load_f32(mod, sh, lane); row_load_f32(mod + 1024, sc, lane);
    float hp[16];
#pragma unroll
    for (int i = 0; i < 16; ++i) hp[i] = 0.f;
    float mu[6][16]; load_mu(p.in[6], mu, lane);
    const int first = ((r_lo & 2047) != 0) ? r_lo - 1 : r_lo, end = r_lo + rpw;
    float nx[16]; row_load_f32(p.in[0] + (size_t)first * 1024, nx, lane);
    for (int r = first; r < end; ++r) {
        float h[16];
#pragma unroll
        for (int i = 0; i < 16; ++i) h[i] = nx[i] * (1.0f + sc[i]) + sh[i];
        if (r + 1 < end) row_load_f32(p.in[0] + (size_t)(r + 1) * 1024, nx, lane);
        __builtin_amdgcn_sched_barrier(0);
        if (r >= r_lo) emit_next((bf16_t*)(p.ws + OFF_SLOT), 0, r, h, hp, mu, lane);
#pragma unroll
        for (int i = 0; i < 16; ++i) hp[i] = h[i];
        if (((r + 1) & 2047) == 0) {
#pragma unroll
            for (int i = 0; i < 16; ++i) hp[i] = 0.f;
        }
    }
}
__device__ __forceinline__ int layer_kind(int L) { return L % 3; }
__device__ __forceinline__ void phase_ln2(PRef p, int L) {
    const int t_ = tidx(); const int lane = t_ & 63, gw = blockIdx.x * 4 + (t_ >> 6), nw = gridDim.x * 4;
    const int rpw = NTOK / nw, r_lo = gw * rpw;
    const float* mod = (const float*)(p.ws + OFF_MOD);
    const bf16_t* xres = (const bf16_t*)(p.ws + OFF_XRES);
    const bf16_t* Y = (const bf16_t*)(p.ws + OFF_SLOT + 9 * SLOT);
    const float* wgt = (const float*)(p.ws + OFF_WGT);
    const bool last = (L == 3);
    const int nk = layer_kind(L + 1), njr = (L + 1) / 3;
    const bool need_prev = (!last && nk == 0);
    const int bidx = r_lo >> 11;
    float gt[16], lgn[16], lbn[16];
    row_load_f32(mod + ((size_t)(L * 2 + 1) * 8 + bidx) * 3072 + 2048, gt, lane);
    row_load_f32(p.in[4] + (L * 2 + 1) * 1024, lgn, lane); row_load_f32(p.in[5] + (L * 2 + 1) * 1024, lbn, lane);
    float hp[16];
#pragma unroll
    for (int i = 0; i < 16; ++i) hp[i] = 0.f;
    float shn[16], scn[16];
    { const float* mn_ = mod + ((size_t)((last ? L : L + 1) * 2 + 0) * 8 + bidx) * 3072; row_load_f32(mn_, shn, lane); row_load_f32(mn_ + 1024, scn, lane); }
    uint2 nxr[4], ny0[4], ny1[4]; float nw0, nw1;
    auto load_in = [&](int r) {
#pragma unroll
        for (int c = 0; c < 4; ++c) { nxr[c] = *(const uint2*)(xres + (size_t)r * 1024 + c * 256 + lane * 4); ny0[c] = *(const uint2*)(Y + (size_t)(2 * r) * 1024 + c * 256 + lane * 4); ny1[c] = *(const uint2*)(Y + (size_t)(2 * r + 1) * 1024 + c * 256 + lane * 4); }
        nw0 = wgt[2 * r]; nw1 = wgt[2 * r + 1];
    };
    const int first = (need_prev && (r_lo & 2047) != 0) ? r_lo - 1 : r_lo, end = r_lo + rpw;
    load_in(first);
    for (int r = first; r < end; ++r) {
        float x[16];
        {
            const float w0 = nw0, w1 = nw1;
#pragma unroll
            for (int c = 0; c < 4; ++c) {
                const float a0[4] = {bflo(ny0[c].x), bfhi(ny0[c].x), bflo(ny0[c].y), bfhi(ny0[c].y)}, a1[4] = {bflo(ny1[c].x), bfhi(ny1[c].x), bflo(ny1[c].y), bfhi(ny1[c].y)};
                const float xr[4] = {bflo(nxr[c].x), bfhi(nxr[c].x), bflo(nxr[c].y), bfhi(nxr[c].y)};
#pragma unroll
                for (int i = 0; i < 4; ++i) x[c * 4 + i] = DN_ALPHA * xr[i] + (1.0f + gt[c * 4 + i]) * (w0 * a0[i] + w1 * a1[i]);
            }
        }
        if (r + 1 < end) load_in(r + 1);
        __builtin_amdgcn_sched_barrier(0);
        float s = 0.f, q = 0.f;
#pragma unroll
        for (int i = 0; i < 16; ++i) { s += x[i]; q += x[i] * x[i]; }
        s = wave_sum(s); q = wave_sum(q);
        const float mean = s * (1.0f / 1024.0f), rstd = rsqrtf(fmaxf(q * (1.0f / 1024.0f) - mean * mean, 0.f) + LN_EPS);
#pragma unroll
        for (int i = 0; i < 16; ++i) x[i] = (x[i] - mean) * rstd * lgn[i] + lbn[i];
        if (last) { row_store_f32(p.out + (size_t)r * 1024, x, lane); continue; }
        float h[16];
#pragma unroll
        for (int i = 0; i < 16; ++i) h[i] = x[i] * (1.0f + scn[i]) + shn[i];
        if (r >= r_lo) { row_store_bf16((bf16_t*)(p.ws + OFF_XRES2) + (size_t)r * 1024, x, lane); emit_next_l((bf16_t*)(p.ws + OFF_SLOT), p.in[6] + (size_t)njr * 6 * 1024, nk, r, h, hp, lane); }
#pragma unroll
        for (int i = 0; i < 16; ++i) hp[i] = h[i];
        if (((r + 1) & 2047) == 0) {
#pragma unroll
            for (int i = 0; i < 16; ++i) hp[i] = 0.f;
        }
    }
}
__device__ __forceinline__ void phase_ln1(PRef p, int L, char* lds, const bf16_t* ymix, bf16_t* hm) {
    const int t = tidx(), lane = t & 63, wid = t >> 6;
    const float* mod = (const float*)(p.ws + OFF_MOD);
    const bf16_t* xinb = (const bf16_t*)(p.ws + OFF_XRES2);
    bf16_t* xres = (bf16_t*)(p.ws + OFF_XRES);
    int* cnt = (int*)(p.ws + OFF_CNT) + L * 32;
    int* list = (int*)(p.ws + OFF_LIST);
    float* wgt = (float*)(p.ws + OFF_WGT);
    float* const HB = (float*)lds;
    float* const lg = (float*)(lds + 65536);
    const float* rtw = (const float*)(p.ws + OFF_RTW) + (size_t)L * 36 * 1024;
    const int rpb = NTOK / gridDim.x;
    const int bidx = (blockIdx.x * rpb) >> 11;
    float gt[16], lgn[16], lbn[16], sh2[16], sc2[16];
    row_load_f32(mod + ((size_t)(L * 2 + 0) * 8 + bidx) * 3072 + 2048, gt, lane);
    row_load_f32(p.in[4] + (L * 2 + 0) * 1024, lgn, lane); row_load_f32(p.in[5] + (L * 2 + 0) * 1024, lbn, lane);
    row_load_f32(mod + ((size_t)(L * 2 + 1) * 8 + bidx) * 3072, sh2, lane); row_load_f32(mod + ((size_t)(L * 2 + 1) * 8 + bidx) * 3072 + 1024, sc2, lane);
    for (int rb0 = blockIdx.x * rpb; rb0 < (blockIdx.x + 1) * rpb; rb0 += 16) {
        const int rb = rb0 + wid * 4;
        uint4 xr[4][4]; uint2 yr[4][4];
#pragma unroll
        for (int rr = 0; rr < 4; ++rr) {
            const int r = rb + rr;
#pragma unroll
            for (int c = 0; c < 4; ++c) {
                if (L == 0) xr[rr][c] = gld_u4(p.in[0] + (size_t)r * 1024 + c * 256 + lane * 4);
                else { const uint2 t2 = gld_u2(xinb + (size_t)r * 1024 + c * 256 + lane * 4); xr[rr][c] = make_uint4(t2.x, t2.y, 0u, 0u); }
                yr[rr][c] = gld_u2(ymix + (size_t)r * 1024 + c * 256 + lane * 4);
            }
        }
#pragma unroll
        for (int rr = 0; rr < 4; ++rr) {
            const int r = rb + rr;
            float x[16], h[16];
#pragma unroll
            for (int c = 0; c < 4; ++c) {
                float xv[4];
                if (L == 0) { xv[0] = __uint_as_float(xr[rr][c].x); xv[1] = __uint_as_float(xr[rr][c].y); xv[2] = __uint_as_float(xr[rr][c].z); xv[3] = __uint_as_float(xr[rr][c].w); }
                else { xv[0] = bflo(xr[rr][c].x); xv[1] = bfhi(xr[rr][c].x); xv[2] = bflo(xr[rr][c].y); xv[3] = bfhi(xr[rr][c].y); }
                const float yv[4] = {bflo(yr[rr][c].x), bfhi(yr[rr][c].x), bflo(yr[rr][c].y), bfhi(yr[rr][c].y)};
#pragma unroll
                for (int i = 0; i < 4; ++i) x[c * 4 + i] = DN_ALPHA * xv[i] + (1.0f + gt[c * 4 + i]) * yv[i];
            }
            float s = 0.f, q = 0.f;
#pragma unroll
            for (int i = 0; i < 16; ++i) { s += x[i]; q += x[i] * x[i]; }
            s = wave_sum(s); q = wave_sum(q);
            const float mean = s * (1.0f / 1024.0f), rstd = rsqrtf(fmaxf(q * (1.0f / 1024.0f) - mean * mean, 0.f) + LN_EPS);
#pragma unroll
            for (int i = 0; i < 16; ++i) { x[i] = (x[i] - mean) * rstd * lgn[i] + lbn[i]; h[i] = x[i] * (1.0f + sc2[i]) + sh2[i]; }
            row_store_bf16(xres + (size_t)r * 1024, x, lane);
            row_store_bf16(hm + (size_t)r * 1024, h, lane);
            row_store_f32_l(HB + (wid * 4 + rr) * 1024, h, lane);
        }
        __syncthreads();
#pragma unroll 1
        for (int q3 = 0; q3 < 9; q3 += 3) {
            float w[3][16];
#pragma unroll
            for (int u = 0; u < 3; ++u) row_load_f32(rtw + (size_t)(wid * 9 + q3 + u) * 1024, w[u], lane);
#pragma unroll 2
            for (int r16 = 0; r16 < 16; ++r16) {
                float h[16]; row_load_f32_l(HB + r16 * 1024, h, lane);
                float a3[3];
#pragma unroll
                for (int u = 0; u < 3; ++u) { float s2 = 0.f;
#pragma unroll
                    for (int i = 0; i < 16; ++i) s2 += h[i] * w[u][i];
                    a3[u] = wave_sum(s2); }
                if (lane == 0) {
#pragma unroll
                    for (int u = 0; u < 3; ++u) lg[r16 * 36 + wid * 9 + q3 + u] = a3[u];
                }
            }
        }
        __syncthreads();
        if (t < 16) {
            const int row = rb0 + t; const float* l = lg + t * 36;
            float g[4]; for (int i = 0; i < 4; ++i) g[i] = l[i] + p.in[37][L * 4 + i];
            int gi = 0; for (int i = 1; i < 4; ++i) if (g[i] > g[gi]) gi = i;
            float gs = 0.f; for (int i = 0; i < 4; ++i) gs += __expf(g[i] - g[gi]);
            const float ggate = 1.0f / gs;
            float e[8]; for (int i = 0; i < 8; ++i) e[i] = l[4 + gi * 8 + i] + p.in[39][L * 32 + gi * 8 + i];
            int i0 = 0; for (int i = 1; i < 8; ++i) if (e[i] > e[i0]) i0 = i;
            int i1 = (i0 == 0) ? 1 : 0; for (int i = 0; i < 8; ++i) if (i != i0 && e[i] > e[i1]) i1 = i;
            const float p1 = __expf(e[i1] - e[i0]);
            const float w0 = ggate / (1.0f + p1), w1 = ggate * p1 / (1.0f + p1);
            const int e0 = gi * 8 + i0, e1 = gi * 8 + i1;
            const int pos0 = atomicAdd(&cnt[e0], 1), pos1 = atomicAdd(&cnt[e1], 1);
            list[e0 * LIST_CAP + pos0] = 2 * row; list[e1 * LIST_CAP + pos1] = 2 * row + 1;
            wgt[2 * row] = w0; wgt[2 * row + 1] = w1;
        }
        asm volatile("s_waitcnt lgkmcnt(0)" ::: "memory");
    }
}

__device__ __forceinline__ int perm64(int r) { return (r & 64) | (((r >> 2) & 3) << 4) | (((r >> 4) & 3) << 2) | (r & 3); }
__device__ __forceinline__ bool tile_permuted(int mode, int nt) { return (mode <= MODE_SIGM) || (mode == MODE_ML1 && nt < 24) || (mode == MODE_RT1 && nt >= 16); }
__device__ __forceinline__ void store16(bf16_t* d, const f32x4 (&v)[4]) {
    gst_u4(d, cvt_pk(v[0][0], v[0][1]), cvt_pk(v[0][2], v[0][3]), cvt_pk(v[1][0], v[1][1]), cvt_pk(v[1][2], v[1][3]));
    gst_u4(d + 8, cvt_pk(v[2][0], v[2][1]), cvt_pk(v[2][2], v[2][3]), cvt_pk(v[3][0], v[3][1]), cvt_pk(v[3][2], v[3][3]));
}
__device__ __forceinline__ void gemm_epilogue(PRef p, const GJob& jb, int mt, int nt, const f32x4 (&acc)[4][4]) {
    const int t_ = tidx(); const int lane = t_ & 63, wid = t_ >> 6, wr = wid >> 1, wc = wid & 1, fr = lane & 15, fq = lane >> 4;
    const int row0 = mt * 128 + wr * 64 + fr;
    if (jb.mode <= MODE_SIGM) {
        const int col = nt * 128 + wc * 64 + fq * 16;
        if (col < jb.N) {
#pragma unroll
            for (int m = 0; m < 4; ++m) {
                f32x4 v[4];
#pragma unroll
                for (int n = 0; n < 4; ++n) {
                    v[n] = acc[m][n];
                    if (jb.mode == MODE_TANH) { v[n][0] = tanhf_(v[n][0]); v[n][1] = tanhf_(v[n][1]); v[n][2] = tanhf_(v[n][2]); v[n][3] = tanhf_(v[n][3]); }
                    else if (jb.mode == MODE_SIGM) { v[n][0] = sigmoidf_(v[n][0]); v[n][1] = sigmoidf_(v[n][1]); v[n][2] = sigmoidf_(v[n][2]); v[n][3] = sigmoidf_(v[n][3]); }
                }
                store16(jb.out + (size_t)(row0 + m * 16) * jb.ldo + col, v);
            }
        }
    } else if (jb.mode == MODE_ML1) {
        if (nt < 24) {
            bf16_t* ob = (bf16_t*)(p.ws + OFF_SLOT + (size_t)(1 + (nt >> 3)) * SLOT);
            const bool sg = (nt >= 16);
            const int col = (nt & 7) * 128 + wc * 64 + fq * 16;
#pragma unroll
            for (int m = 0; m < 4; ++m) {
                f32x4 v[4];
#pragma unroll
                for (int n = 0; n < 4; ++n) {
                    v[n] = acc[m][n];
                    if (sg) { v[n][0] = sigmoidf_(v[n][0]); v[n][1] = sigmoidf_(v[n][1]); v[n][2] = sigmoidf_(v[n][2]); v[n][3] = sigmoidf_(v[n][3]); }
                }
                store16(ob + (size_t)(row0 + m * 16) * 1024 + col, v);
            }
        } else if (wc == 0) {
            float* gates = (float*)(p.ws + OFF_GATES);
            const float* bg = p.in[26];
            const int c0 = fq * 4;
#pragma unroll
            for (int m = 0; m < 4; ++m) {
                f32x4 v = acc[m][0], o;
#pragma unroll
                for (int j = 0; j < 4; ++j) { const float g = v[j] + bg[c0 + j]; o[j] = (c0 + j < 8) ? g : -softplusf_(-g); }
                gst_f4(gates + (size_t)(row0 + m * 16) * 16 + c0, o[0], o[1], o[2], o[3]);
            }
        }
    } else {
        if (nt < 16) {
            const float* rot = (const float*)(p.ws + OFF_ROT);
            bf16_t* ob = (bf16_t*)(p.ws + OFF_SLOT + (size_t)(1 + (nt >> 3)) * SLOT);
            const float scl = (nt >= 8) ? 0.0625f : 1.0f;
#pragma unroll
            for (int pp = 0; pp < 2; ++pp) {
                const int blk32 = (nt & 7) * 4 + wc * 2 + pp, head = blk32 >> 3, i0 = (blk32 & 7) * 16 + fq * 4;
                float4 rc0[4], rc1[4];
#pragma unroll
                for (int m = 0; m < 4; ++m) { const int tt = (row0 + m * 16) & 2047; rc0[m] = gld_f4(rot + ((size_t)tt * 128 + i0) * 2); rc1[m] = gld_f4(rot + ((size_t)tt * 128 + i0) * 2 + 4); }
#pragma unroll
                for (int m = 0; m < 4; ++m) {
                    const int row = row0 + m * 16;
                    const float4 c0 = rc0[m], c1 = rc1[m];
                    const float cs[4] = {c0.x, c0.z, c1.x, c1.z}, sn[4] = {c0.y, c0.w, c1.y, c1.w};
                    const f32x4 x1 = acc[m][2 * pp], x2 = acc[m][2 * pp + 1];
                    float o1[4], o2[4];
#pragma unroll
                    for (int j = 0; j < 4; ++j) { o1[j] = (x1[j] * cs[j] - x2[j] * sn[j]) * scl; o2[j] = (x1[j] * sn[j] + x2[j] * cs[j]) * scl; }
                    gst_u2(ob + (size_t)row * 1024 + head * 256 + i0, cvt_pk(o1[0], o1[1]), cvt_pk(o1[2], o1[3]));
                    gst_u2(ob + (size_t)row * 1024 + head * 256 + 128 + i0, cvt_pk(o2[0], o2[1]), cvt_pk(o2[2], o2[3]));
                }
            }
        } else {
            const bool isg = (nt >= 32);
            bf16_t* ob = (bf16_t*)(p.ws + OFF_SLOT + (size_t)(isg ? 5 : 3) * SLOT);
            const int col = (nt & 15) * 128 + wc * 64 + fq * 16;
#pragma unroll
            for (int m = 0; m < 4; ++m) {
                f32x4 v[4];
#pragma unroll
                for (int n = 0; n < 4; ++n) {
                    v[n] = acc[m][n];
                    if (isg) { v[n][0] = siluf_(v[n][0]); v[n][1] = siluf_(v[n][1]); v[n][2] = siluf_(v[n][2]); v[n][3] = siluf_(v[n][3]); }
                }
                store16(ob + (size_t)(row0 + m * 16) * 2048 + col, v);
            }
        }
    }
}
__device__ __forceinline__ void phase_gemm_jobs(PRef p, char* lds, int jlo, int jhi) {
    const int total = p.gj[jhi - 1].tile0 + 128 * p.gj[jhi - 1].ntn - p.gj[jlo].tile0;
    for (int id = blockIdx.x; id < total; id += gridDim.x) {
        int j = jlo; const int gid = id + p.gj[jlo].tile0;
        while (j + 1 < jhi && gid >= p.gj[j + 1].tile0) ++j;
        GJob jb; jb.A = p.gj[j].A; jb.Bt = p.gj[j].Bt; jb.out = p.gj[j].out; jb.K = p.gj[j].K; jb.N = p.gj[j].N; jb.ldo = p.gj[j].ldo; jb.mode = p.gj[j].mode; jb.ntn = p.gj[j].ntn; jb.tile0 = p.gj[j].tile0;
        jb.half = p.gj[j].half;
        int mt, nt; tile_map(gid - jb.tile0, jb.ntn, mt, nt);
        if (jb.half || (jb.mode == MODE_ML1 && nt == 24)) {
            const int t_ = tidx(), r0_ = t_ >> 3, co_ = glds_chunk(t_) * 8, ln_ = t_ & 63, wv_ = t_ >> 6, fr_ = ln_ & 15, fq_ = ln_ >> 4;
            const int cb = jb.half ? nt * 64 : nt * 128;
            int nvh = jb.N - cb; nvh = nvh > 64 ? 64 : nvh;
            const bf16_t* ar[4]; const bf16_t* brh[2];
#pragma unroll
            for (int i = 0; i < 4; ++i) ar[i] = jb.A + (size_t)(mt * 128 + r0_ + 32 * i) * jb.K + co_;
#pragma unroll
            for (int i = 0; i < 2; ++i) { int rb_ = r0_ + 32 * i; rb_ = jb.half ? perm64(rb_) : rb_; rb_ = rb_ < nvh ? rb_ : nvh - 1; brh[i] = jb.Bt + (size_t)(cb + rb_) * jb.K + co_; }
            f32x4 ah[2][4];
            gemm_hn(lds, jb.K / 64, ar, brh, ah);
            const int rowh = mt * 128 + wv_ * 32 + fr_;
            if (jb.half) {
                const int col = cb + fq_ * 16;
                if (col < jb.N) {
#pragma unroll
                    for (int m = 0; m < 2; ++m) {
                        f32x4 v[4];
#pragma unroll
                        for (int n = 0; n < 4; ++n) {
                            v[n] = ah[m][n];
#pragma unroll
                            for (int jj = 0; jj < 4; ++jj) v[n][jj] = (jb.mode == MODE_TANH) ? tanhf_(v[n][jj]) : (jb.mode == MODE_SIGM) ? sigmoidf_(v[n][jj]) : v[n][jj];
                        }
                        store16(jb.out + (size_t)(rowh + m * 16) * jb.ldo + col, v);
                    }
                }
            } else {
                float* gates = (float*)(p.ws + OFF_GATES);
                const float* bg = p.in[26];
                const int c0 = fq_ * 4;
                const float4 bq = gld_f4(bg + c0);
                const float bqa[4] = {bq.x, bq.y, bq.z, bq.w};
#pragma unroll
                for (int m = 0; m < 2; ++m) {
                    float o[4];
#pragma unroll
                    for (int jj = 0; jj < 4; ++jj) { const float g = ah[m][0][jj] + bqa[jj]; o[jj] = (c0 + jj < 8) ? g : -softplusf_(-g); }
                    gst_f4(gates + (size_t)(rowh + m * 16) * 16 + c0, o[0], o[1], o[2], o[3]);
                }
            }
            continue;
        }
        int nv = jb.N - nt * 128; nv = nv > 128 ? 128 : nv;
        const bf16_t* ar[4]; const bf16_t* br[4];
        {
            const int t_ = tidx(), r0_ = t_ >> 3, co_ = glds_chunk(t_) * 8;
            const bool pm_ = tile_permuted(jb.mode, nt);
#pragma unroll
            for (int i = 0; i < 4; ++i) {
                ar[i] = jb.A + (size_t)(mt * 128 + r0_ + 32 * i) * jb.K + co_;
                int rb_ = r0_ + 32 * i; rb_ = pm_ ? perm64(rb_) : rb_; rb_ = rb_ < nv ? rb_ : nv - 1;
                br[i] = jb.Bt + (size_t)(nt * 128 + rb_) * jb.K + co_;
            }
        }
        f32x4 acc[4][4];
        gemm_gg(lds, jb.K / 64, ar, br, acc);
        gemm_epilogue(p, jb, mt, nt, acc);
    }
}

constexpr int RM = 4;
template <int KL>
__device__ __forceinline__ void minigemm(const bf16_t* A, const bf16_t* Bt, int fr, int fq, f32x4 (&acc)[RM][4]) {
#pragma unroll
    for (int m = 0; m < RM; ++m)
#pragma unroll
        for (int n = 0; n < 4; ++n) acc[m][n] = (f32x4){0.f, 0.f, 0.f, 0.f};
#pragma unroll 2
    for (int ks = 0; ks < KL / 32; ++ks) {
        uint4 af[RM], bfm[4];
#pragma unroll
        for (int m = 0; m < RM; ++m) af[m] = gld_u4(A + (size_t)(m * 16 + fr) * KL + ks * 32 + fq * 8);
#pragma unroll
        for (int n = 0; n < 4; ++n) bfm[n] = gld_u4(Bt + (size_t)((fr >> 2) * 16 + n * 4 + (fr & 3)) * KL + ks * 32 + fq * 8);
#pragma unroll
        for (int m = 0; m < RM; ++m)
#pragma unroll
            for (int n = 0; n < 4; ++n) acc[m][n] = mfma16(bfm[n], af[m], acc[m][n]);
    }
}
__device__ __forceinline__ void phase_rw2(PRef p, int jr) {
    const int t_ = tidx(); const int lane = t_ & 63, wid = t_ >> 6, wr = wid >> 1, wc = wid & 1, fr = lane & 15, fq = lane >> 4;
    char* S = p.ws + OFF_SLOT;
    float* decay = (float*)S; bf16_t* nkk = (bf16_t*)(S + 2 * SLOT); bf16_t* bb = (bf16_t*)(S + 3 * SLOT); bf16_t* gb = (bf16_t*)(S + 4 * SLOT);
    const bf16_t* rb = (const bf16_t*)(S + 6 * SLOT); const bf16_t* kb = (const bf16_t*)(S + 7 * SLOT); bf16_t* kpb = (bf16_t*)(S + 10 * SLOT);
    const bf16_t* vb = (const bf16_t*)(S + 8 * SLOT); bf16_t* vpb = (bf16_t*)(S + 9 * SLOT); const bf16_t* vf = (const bf16_t*)(S + 11 * SLOT);
    float* bonus = (float*)(p.ws + OFF_BONUS);
    const bf16_t* Lw = (const bf16_t*)(p.ws + OFF_LW); const bf16_t* La = (const bf16_t*)(p.ws + OFF_LA);
    const bf16_t* Lg = (const bf16_t*)(p.ws + OFF_LG); const bf16_t* Lv = (const bf16_t*)(p.ws + OFF_LV);
    const bf16_t* w2t = (const bf16_t*)(p.ws + W_W2T) + (size_t)jr * 1024 * 64; const bf16_t* a2t = (const bf16_t*)(p.ws + W_A2T) + (size_t)jr * 1024 * 64;
    const bf16_t* g2t = (const bf16_t*)(p.ws + W_G2T) + (size_t)jr * 1024 * 128; const bf16_t* v2t = (const bf16_t*)(p.ws + W_V2T);
    const float* w0 = p.in[8] + jr * 1024; const float* a0 = p.in[11] + jr * 1024; const float* v0 = p.in[14];
    const float* kkw = p.in[19] + jr * 1024; const float* kaw = p.in[20] + jr * 1024; const float* rk = p.in[21] + jr * 1024;
    for (int id2 = blockIdx.x; id2 < 128 * 8; id2 += gridDim.x) {
        int mt, nt; tile_map(id2, 8, mt, nt);
        const int row0 = mt * 128 + wr * 64, col0 = nt * 128 + wc * 64, head = nt * 2 + wc;
        f32x4 acc[RM][4];
        const int c0 = col0 + fq * 16;
        minigemm<64>(La + (size_t)row0 * 64, a2t + (size_t)col0 * 64, fr, fq, acc);
        float ss[RM], bs[RM];
#pragma unroll
        for (int m = 0; m < RM; ++m) { ss[m] = 0.f; bs[m] = 0.f; }
#pragma unroll
        for (int m = 0; m < RM; ++m) {
            const size_t off = (size_t)(row0 + m * 16 + fr) * 1024 + c0;
            const uint4 kq0 = *(const uint4*)(kb + off), kq1 = *(const uint4*)(kb + off + 8);
            const unsigned kw[8] = {kq0.x, kq0.y, kq0.z, kq0.w, kq1.x, kq1.y, kq1.z, kq1.w};
#pragma unroll
            for (int n = 0; n < 4; ++n) {
                const float4 a0v = *(const float4*)(a0 + c0 + n * 4), kkv = *(const float4*)(kkw + c0 + n * 4);
                const float a0a[4] = {a0v.x, a0v.y, a0v.z, a0v.w}, kka[4] = {kkv.x, kkv.y, kkv.z, kkv.w};
                const float kf4[4] = {bflo(kw[n * 2]), bfhi(kw[n * 2]), bflo(kw[n * 2 + 1]), bfhi(kw[n * 2 + 1])};
#pragma unroll
                for (int j = 0; j < 4; ++j) { acc[m][n][j] = sigmoidf_(a0a[j] + acc[m][n][j]); const float q = kf4[j] * kka[j]; ss[m] += q * q; }
            }
            asm volatile("" ::: "memory");
        }
#pragma unroll
        for (int m = 0; m < RM; ++m) { ss[m] += __shfl_xor(ss[m], 16); ss[m] += __shfl_xor(ss[m], 32); ss[m] = fminf(__builtin_amdgcn_rsqf(ss[m]), 1e12f); }
        float4 kkq[4], kaq[4], rkq[4];
#pragma unroll
        for (int n = 0; n < 4; ++n) { kkq[n] = gld_f4(kkw + c0 + n * 4); kaq[n] = gld_f4(kaw + c0 + n * 4); rkq[n] = gld_f4(rk + c0 + n * 4); }
#pragma unroll
        for (int m = 0; m < RM; ++m) {
            const size_t off = (size_t)(row0 + m * 16 + fr) * 1024 + c0;
            const uint4 rq0 = *(const uint4*)(rb + off), rq1 = *(const uint4*)(rb + off + 8), kq0 = *(const uint4*)(kb + off), kq1 = *(const uint4*)(kb + off + 8);
            const unsigned kw[8] = {kq0.x, kq0.y, kq0.z, kq0.w, kq1.x, kq1.y, kq1.z, kq1.w};
            const unsigned rw[8] = {rq0.x, rq0.y, rq0.z, rq0.w, rq1.x, rq1.y, rq1.z, rq1.w};
            unsigned okp[8], onk[8], obb[8];
#pragma unroll
            for (int n = 0; n < 4; ++n) {
                const float kka[4] = {kkq[n].x, kkq[n].y, kkq[n].z, kkq[n].w}, kaa[4] = {kaq[n].x, kaq[n].y, kaq[n].z, kaq[n].w}, rka[4] = {rkq[n].x, rkq[n].y, rkq[n].z, rkq[n].w};
                const float rf[4] = {bflo(rw[n * 2]), bfhi(rw[n * 2]), bflo(rw[n * 2 + 1]), bfhi(rw[n * 2 + 1])}, kf4[4] = {bflo(kw[n * 2]), bfhi(kw[n * 2]), bflo(kw[n * 2 + 1]), bfhi(kw[n * 2 + 1])};
                float kp[4], nk[4], b4[4];
#pragma unroll
                for (int j = 0; j < 4; ++j) {
                    const float a = acc[m][n][j], k = kf4[j], kn = k * kka[j] * ss[m];
                    kp[j] = k * (1.0f + (a - 1.0f) * kaa[j]); nk[j] = -kn; b4[j] = kn * a; bs[m] += rf[j] * kp[j] * rka[j];
                }
                okp[n * 2] = cvt_pk(kp[0], kp[1]); okp[n * 2 + 1] = cvt_pk(kp[2], kp[3]);
                onk[n * 2] = cvt_pk(nk[0], nk[1]); onk[n * 2 + 1] = cvt_pk(nk[2], nk[3]);
                obb[n * 2] = cvt_pk(b4[0], b4[1]); obb[n * 2 + 1] = cvt_pk(b4[2], b4[3]);
            }
            *(uint4*)(kpb + off) = make_uint4(okp[0], okp[1], okp[2], okp[3]); *(uint4*)(kpb + off + 8) = make_uint4(okp[4], okp[5], okp[6], okp[7]);
            *(uint4*)(nkk + off) = make_uint4(onk[0], onk[1], onk[2], onk[3]); *(uint4*)(nkk + off + 8) = make_uint4(onk[4], onk[5], onk[6], onk[7]);
            *(uint4*)(bb + off) = make_uint4(obb[0], obb[1], obb[2], obb[3]); *(uint4*)(bb + off + 8) = make_uint4(obb[4], obb[5], obb[6], obb[7]);
            asm volatile("" ::: "memory");
        }
#pragma unroll
        for (int m = 0; m < RM; ++m) { bs[m] += __shfl_xor(bs[m], 16); bs[m] += __shfl_xor(bs[m], 32); if (fq == 0) bonus[(size_t)(row0 + m * 16 + fr) * 16 + head] = bs[m]; }
        minigemm<64>(Lw + (size_t)row0 * 64, w2t + (size_t)col0 * 64, fr, fq, acc);
        float4 w0q[4];
#pragma unroll
        for (int n = 0; n < 4; ++n) w0q[n] = gld_f4(w0 + c0 + n * 4);
#pragma unroll
        for (int n = 0; n < 4; ++n) {
            const float w0a[4] = {w0q[n].x, w0q[n].y, w0q[n].z, w0q[n].w};
#pragma unroll
            for (int m = 0; m < RM; ++m) {
                f32x4 o;
#pragma unroll
                for (int j = 0; j < 4; ++j) { const float wl = -softplusf_(-(w0a[j] + acc[m][n][j])) - 0.5f; o[j] = __expf(-__expf(wl)); }
                *(f32x4*)(decay + (size_t)(row0 + m * 16 + fr) * 1024 + c0 + n * 4) = o;
            }
        }
        minigemm<128>(Lg + (size_t)row0 * 128, g2t + (size_t)col0 * 128, fr, fq, acc);
#pragma unroll
        for (int m = 0; m < RM; ++m) {
            unsigned o[8];
#pragma unroll
            for (int n = 0; n < 4; ++n) { o[n * 2] = cvt_pk(acc[m][n][0], acc[m][n][1]); o[n * 2 + 1] = cvt_pk(acc[m][n][2], acc[m][n][3]); }
            bf16_t* d = gb + (size_t)(row0 + m * 16 + fr) * 1024 + c0;
            *(uint4*)d = make_uint4(o[0], o[1], o[2], o[3]); *(uint4*)(d + 8) = make_uint4(o[4], o[5], o[6], o[7]);
        }
        if (jr > 0) {
            minigemm<32>(Lv + (size_t)row0 * 32, v2t + (size_t)col0 * 32, fr, fq, acc);
#pragma unroll
            for (int m = 0; m < RM; ++m) {
                const size_t off = (size_t)(row0 + m * 16 + fr) * 1024 + c0;
                const uint4 vq0 = *(const uint4*)(vb + off), vq1 = *(const uint4*)(vb + off + 8), fq0 = *(const uint4*)(vf + off), fq1 = *(const uint4*)(vf + off + 8);
                const unsigned vw[8] = {vq0.x, vq0.y, vq0.z, vq0.w, vq1.x, vq1.y, vq1.z, vq1.w}, fw[8] = {fq0.x, fq0.y, fq0.z, fq0.w, fq1.x, fq1.y, fq1.z, fq1.w};
                unsigned o[8];
#pragma unroll
                for (int n = 0; n < 4; ++n) {
                    const float4 v0v = *(const float4*)(v0 + c0 + n * 4); const float v0a[4] = {v0v.x, v0v.y, v0v.z, v0v.w};
                    const float v4[4] = {bflo(vw[n * 2]), bfhi(vw[n * 2]), bflo(vw[n * 2 + 1]), bfhi(vw[n * 2 + 1])}, f4[4] = {bflo(fw[n * 2]), bfhi(fw[n * 2]), bflo(fw[n * 2 + 1]), bfhi(fw[n * 2 + 1])};
                    float o4[4];
#pragma unroll
                    for (int j = 0; j < 4; ++j) o4[j] = v4[j] + (f4[j] - v4[j]) * sigmoidf_(v0a[j] + acc[m][n][j]);
                    o[n * 2] = cvt_pk(o4[0], o4[1]); o[n * 2 + 1] = cvt_pk(o4[2], o4[3]);
                }
                *(uint4*)(vpb + off) = make_uint4(o[0], o[1], o[2], o[3]); *(uint4*)(vpb + off + 8) = make_uint4(o[4], o[5], o[6], o[7]);
            }
        }
    }
}
__device__ __forceinline__ void phase_rw3(PRef p, int jr, char* lds) {
    const int t = tidx(), lane = t & 63, wid = t >> 6, rowq = lane >> 4, jq = lane & 15;
    char* S = p.ws + OFF_SLOT;
    const float* decay = (const float*)S; const bf16_t* nkk = (const bf16_t*)(S + 2 * SLOT); const bf16_t* bb = (const bf16_t*)(S + 3 * SLOT);
    const bf16_t* rb = (const bf16_t*)(S + 6 * SLOT); const bf16_t* kb = (const bf16_t*)(S + 10 * SLOT);
    const bf16_t* vb = (const bf16_t*)(S + (jr == 0 ? 11 : 9) * SLOT); bf16_t* yb = (bf16_t*)(S + 5 * SLOT);
    float* buf = (float*)lds;
    float* ybuf = (float*)(lds + 2 * 16 * 336 * 4);
    for (int item = blockIdx.x; item < 512; item += gridDim.x) {
        const int bh = item >> 2, rg = item & 3, b = bh >> 4, h = bh & 15;
        const size_t base = (size_t)b * 2048 * 1024 + h * 64;
        const bf16_t* vecp[2]; int vdst[2];
#pragma unroll
        for (int u = 0; u < 2; ++u) {
            const int id = t + 256 * u, vec = id >> 7, rem = id & 127, step = rem >> 3, c8 = rem & 7;
            const bf16_t* bp = (vec == 0) ? nkk : (vec == 1) ? bb : (vec == 2) ? kb : rb;
            vecp[u] = bp + base + (size_t)step * 1024 + c8 * 8; vdst[u] = step * 336 + 64 + vec * 64 + c8 * 8;
        }
        const float* dp = decay + base + (size_t)(t >> 4) * 1024 + (t & 15) * 4; const int ddst = (t >> 4) * 336 + (t & 15) * 4;
        const bf16_t* vp = vb + base + (size_t)(t >> 1) * 1024 + rg * 16 + (t & 1) * 8; const int vvdst = (t >> 1) * 336 + 320 + (t & 1) * 8;
        uint4 g0, g1, gv; float4 gd;
        auto fetch = [&](int ch) {
            const size_t o = (size_t)ch * 16 * 1024;
            g0 = gload16(vecp[0] + o); g1 = gload16(vecp[1] + o);
            { const uint4 d_ = gload16(dp + o); gd = make_float4(__uint_as_float(d_.x), __uint_as_float(d_.y), __uint_as_float(d_.z), __uint_as_float(d_.w)); }
            if (t < 32) gv = gload16(vp + o);
        };
        auto stash = [&](float* bf) {
            float f[8];
            unpack8(g0, f); *(float4*)(bf + vdst[0]) = make_float4(f[0], f[1], f[2], f[3]); *(float4*)(bf + vdst[0] + 4) = make_float4(f[4], f[5], f[6], f[7]);
            unpack8(g1, f); *(float4*)(bf + vdst[1]) = make_float4(f[0], f[1], f[2], f[3]); *(float4*)(bf + vdst[1] + 4) = make_float4(f[4], f[5], f[6], f[7]);
            *(float4*)(bf + ddst) = gd;
            if (t < 32) { unpack8(gv, f); *(float4*)(bf + vvdst) = make_float4(f[0], f[1], f[2], f[3]); *(float4*)(bf + vvdst + 4) = make_float4(f[4], f[5], f[6], f[7]); }
        };
        float s0 = 0.f, s1 = 0.f, s2 = 0.f, s3 = 0.f;
        __syncthreads();
        fetch(0); stash(buf); __syncthreads();
        for (int ch = 0; ch < 128; ++ch) {
            if (ch + 1 < 128) fetch(ch + 1);
            const float* bf = buf + (ch & 1) * (16 * 336); float* yb_ = ybuf + (ch & 1) * 256;
            float ykeep = 0.f;
            const float* q0 = bf + jq * 4; const float* v0p = bf + 320 + wid * 4 + rowq;
            float4 nw = *(const float4*)q0, na = *(const float4*)(q0 + 64), nb2 = *(const float4*)(q0 + 128), nk = *(const float4*)(q0 + 192), nr = *(const float4*)(q0 + 256);
            float nv = v0p[0];
#pragma unroll 4
            for (int s = 0; s < 16; ++s) {
                const float4 w = nw, a = na, bq = nb2, k = nk, r = nr; const float vv = nv;
                const float* q = q0 + (s + 1) * 336;
                nw = *(const float4*)q; na = *(const float4*)(q + 64); nb2 = *(const float4*)(q + 128); nk = *(const float4*)(q + 192); nr = *(const float4*)(q + 256);
                nv = v0p[(s + 1) * 336];
                __builtin_amdgcn_sched_barrier(0);
                float sa = s0 * a.x; sa = fmaf(s1, a.y, sa); sa = fmaf(s2, a.z, sa); sa = fmaf(s3, a.w, sa);
                sa = row16_sum(sa);
                s0 = fmaf(s0, w.x, fmaf(sa, bq.x, vv * k.x)); s1 = fmaf(s1, w.y, fmaf(sa, bq.y, vv * k.y));
                s2 = fmaf(s2, w.z, fmaf(sa, bq.z, vv * k.z)); s3 = fmaf(s3, w.w, fmaf(sa, bq.w, vv * k.w));
                float y = s0 * r.x; y = fmaf(s1, r.y, y); y = fmaf(s2, r.z, y); y = fmaf(s3, r.w, y);
                y = row16_sum(y);
                ykeep = (jq == s) ? y : ykeep;
            }
            yb_[jq * 16 + wid * 4 + rowq] = ykeep;
            if (ch + 1 < 128) stash(buf + ((ch + 1) & 1) * (16 * 336));
            __syncthreads();
            if (t < 32) { const int step = t >> 1, hf = t & 1; float f[8];
#pragma unroll
                for (int i = 0; i < 8; ++i) f[i] = yb_[step * 16 + hf * 8 + i];
                *(uint4*)(yb + base + (size_t)(ch * 16 + step) * 1024 + rg * 16 + hf * 8) = pack8(f); }
        }
    }
}
__device__ __forceinline__ uint2 lds_tr16(const char* p) {
    typedef short v4s_t __attribute__((ext_vector_type(4)));
    const v4s_t r = __builtin_amdgcn_ds_read_tr16_b64_v4i16((LAS v4s_t*)p);
    uint2 u; __builtin_memcpy(&u, &r, 8); return u;
}
__device__ __forceinline__ int sw64(int row, int col) { return row * 128 + ((((col >> 3) ^ (row & 7))) << 4) + (col & 7) * 2; }
__device__ __forceinline__ void phase_rw3c(PRef p, int jr, char* lds) {
    const int t = tidx(), lane = t & 63, w = t >> 6, fr = lane & 15, fq = lane >> 4;
    char* S = p.ws + OFF_SLOT;
    const float* decay = (const float*)S; const bf16_t* nkk = (const bf16_t*)(S + 2 * SLOT); const bf16_t* bb = (const bf16_t*)(S + 3 * SLOT);
    const bf16_t* rb = (const bf16_t*)(S + 6 * SLOT); const bf16_t* kb = (const bf16_t*)(S + 10 * SLOT);
    const bf16_t* vb = (const bf16_t*)(S + (jr == 0 ? 11 : 9) * SLOT); bf16_t* yb = (bf16_t*)(S + 5 * SLOT);
    char* const AT = lds;              char* const RT = lds + 4096;  char* const BT = lds + 8192;  char* const KT = lds + 12288;
    float* const PL = (float*)(lds + 16384);
    float* const GAB = (float*)(lds + 43264);
    char* const GAK = lds + 28672;     char* const GRB = lds + 30720; char* const GRK = lds + 32768;
    char* const VT = lds + 34816;      char* const UT = lds + 35840;
    char* const SB = lds + 36864;
    float* const XL = (float*)(lds + 38912);
    float* const PC = (float*)(lds + 40960);
    float* const GS = (float*)(lds + 41216);
    bf16_t* const YB = (bf16_t*)(lds + 42240);
    const int pj = t & 63, ptg = t >> 6;
    const int tk = t >> 3, ck = t & 7;
    const int vtau = t >> 3, vi2 = (t & 7) * 2;
    const int qq = fr >> 2, pp = fr & 3;
    for (int item = blockIdx.x; item < 512; item += gridDim.x) {
        const int bh = ((item >> 3) >> 2) * 8 + (item & 7), rg = (item >> 3) & 3, b = bh >> 4, h = bh & 15;
        const size_t base = (size_t)b * 2048 * 1024 + h * 64;
        __syncthreads();
        for (int i = t; i < 128; i += 256) *(uint4*)(SB + i * 16) = make_uint4(0u, 0u, 0u, 0u);
        f32x4 Sacc = (f32x4){0.f, 0.f, 0.f, 0.f};
        float gw[8]; uint4 ra, rb4, rk, rr, rw0, rw1; unsigned gvv = 0;
        auto fetch = [&](int c) {
#pragma unroll
            for (int s2 = 0; s2 < 8; ++s2) gw[s2] = *(const __attribute__((address_space(1))) float*)(decay + base + (size_t)(c * 32 + ptg * 8 + s2) * 1024 + pj);
            const size_t o = base + (size_t)(c * 32 + tk) * 1024 + ck * 8;
            ra = gload16(nkk + o); rb4 = gload16(bb + o); rk = gload16(kb + o); rr = gload16(rb + o); rw0 = gload16(decay + o); rw1 = gload16(decay + o + 4);
            gvv = *(const __attribute__((address_space(1))) unsigned*)(vb + base + (size_t)(c * 32 + vtau) * 1024 + rg * 16 + vi2);
        };
        fetch(0);
        for (int c = 0; c < 64; ++c) {
            {
                float cum[8]; float run = 0.f;
#pragma unroll
                for (int s2 = 0; s2 < 8; ++s2) { run += __builtin_amdgcn_logf(gw[s2]); cum[s2] = run; }
                GS[ptg * 64 + pj] = run;
                __syncthreads();
                const float g0 = GS[pj], g1 = GS[64 + pj], g2 = GS[128 + pj], g3 = GS[192 + pj];
                const float off = (ptg > 0 ? g0 : 0.f) + (ptg > 1 ? g1 : 0.f) + (ptg > 2 ? g2 : 0.f);
                if (ptg == 0) PC[pj] = __builtin_amdgcn_exp2f((g0 + g1) + (g2 + g3));
#pragma unroll
                for (int s2 = 0; s2 < 8; ++s2) PL[(ptg * 8 + s2) * 64 + pj] = __builtin_amdgcn_exp2f(off + cum[s2]);
            }
            __syncthreads();
            {
                const float4 p0 = *(const float4*)(PL + tk * 64 + ck * 8), p1 = *(const float4*)(PL + tk * 64 + ck * 8 + 4);
                const unsigned ua[4] = {ra.x, ra.y, ra.z, ra.w}, ub[4] = {rb4.x, rb4.y, rb4.z, rb4.w}, uk[4] = {rk.x, rk.y, rk.z, rk.w}, ur[4] = {rr.x, rr.y, rr.z, rr.w};
                const f32x2_t Pp[4] = {{p0.x, p0.y}, {p0.z, p0.w}, {p1.x, p1.y}, {p1.z, p1.w}};
                const f32x2_t Wp[4] = {{__uint_as_float(rw0.x), __uint_as_float(rw0.y)}, {__uint_as_float(rw0.z), __uint_as_float(rw0.w)}, {__uint_as_float(rw1.x), __uint_as_float(rw1.y)}, {__uint_as_float(rw1.z), __uint_as_float(rw1.w)}};
                unsigned oa[4], orr[4], ob[4], ok[4];
#pragma unroll
                for (int i = 0; i < 4; ++i) {
                    const f32x2_t ei = {__builtin_amdgcn_rcpf(Pp[i].x), __builtin_amdgcn_rcpf(Pp[i].y)};
                    const f32x2_t rw = {__builtin_amdgcn_rcpf(Wp[i].x), __builtin_amdgcn_rcpf(Wp[i].y)};
                    const f32x2_t ex = Pp[i] * rw;
                    const f32x2_t va = {__uint_as_float(ua[i] << 16), __uint_as_float(ua[i] & 0xffff0000u)}, vr = {__uint_as_float(ur[i] << 16), __uint_as_float(ur[i] & 0xffff0000u)};
                    const f32x2_t vb2 = {__uint_as_float(ub[i] << 16), __uint_as_float(ub[i] & 0xffff0000u)}, vk = {__uint_as_float(uk[i] << 16), __uint_as_float(uk[i] & 0xffff0000u)};
                    const f32x2_t xa = va * ex, xr = vr * Pp[i], xb = vb2 * ei, xk = vk * ei;
                    oa[i] = cvt_pk(xa.x, xa.y); orr[i] = cvt_pk(xr.x, xr.y); ob[i] = cvt_pk(xb.x, xb.y); ok[i] = cvt_pk(xk.x, xk.y);
                }
                const int o = tk * 128 + ((ck ^ (tk & 7)) << 4);
                *(uint4*)(AT + o) = make_uint4(oa[0], oa[1], oa[2], oa[3]); *(uint4*)(RT + o) = make_uint4(orr[0], orr[1], orr[2], orr[3]);
                *(uint4*)(BT + o) = make_uint4(ob[0], ob[1], ob[2], ob[3]); *(uint4*)(KT + o) = make_uint4(ok[0], ok[1], ok[2], ok[3]);
                *(bf16_t*)(VT + vi2 * 64 + vtau * 2) = (bf16_t)(gvv & 0xffffu);
                *(bf16_t*)(VT + (vi2 + 1) * 64 + vtau * 2) = (bf16_t)(gvv >> 16);
            }
            if (c + 1 < 64) fetch(c + 1);
            __syncthreads();
            {
                const char* Mt = (w < 2) ? AT : RT; const char* Nt = (w & 1) ? BT : KT;
                f32x4 g[2][2];
#pragma unroll
                for (int m = 0; m < 2; ++m) { g[m][0] = (f32x4){0.f, 0.f, 0.f, 0.f}; g[m][1] = (f32x4){0.f, 0.f, 0.f, 0.f}; }
#pragma unroll
                for (int ks = 0; ks < 2; ++ks) {
                    const int chs = ((ks * 4 + fq) ^ (fr & 7)) << 4;
                    uint4 mf[2], nf[2];
#pragma unroll
                    for (int m = 0; m < 2; ++m) { mf[m] = *(const uint4*)(Mt + (m * 16 + fr) * 128 + chs); nf[m] = *(const uint4*)(Nt + (m * 16 + fr) * 128 + chs); }
#pragma unroll
                    for (int m = 0; m < 2; ++m)
#pragma unroll
                        for (int n = 0; n < 2; ++n) g[m][n] = mfma16(nf[n], mf[m], g[m][n]);
                }
#pragma unroll
                for (int m = 0; m < 2; ++m)
#pragma unroll
                    for (int n = 0; n < 2; ++n) {
                        const int tt = m * 16 + fr, tau0 = n * 16 + fq * 4;
                        f32x4 v4;
#pragma unroll
                        for (int j = 0; j < 4; ++j) { const int tau = tau0 + j; const bool keep = (w < 2) ? (tau < tt) : (tau <= tt); v4[j] = keep ? g[m][n][j] : 0.f; }
                        if (w == 1) *(f32x4*)(GAB + tt * 36 + tau0) = v4;
                        else {
                            char* G = (w == 0) ? GAK : (w == 2) ? GRK : GRB;
                            uint2 o; o.x = cvt_pk(v4[0], v4[1]); o.y = cvt_pk(v4[2], v4[3]);
                            *(uint2*)(G + tt * 64 + tau0 * 2) = o;
                        }
                    }
            }
            __syncthreads();
            if (w < 2) {
                f32x4 x = (f32x4){0.f, 0.f, 0.f, 0.f};
#pragma unroll
                for (int ks = 0; ks < 2; ++ks) {
                    const int chs = ((ks * 4 + fq) ^ (fr & 7)) << 4;
                    x = mfma16(*(const uint4*)(AT + (w * 16 + fr) * 128 + chs), *(const uint4*)(SB + fr * 128 + chs), x);
                }
                x = mfma16(*(const uint4*)(GAK + (w * 16 + fr) * 64 + fq * 16), *(const uint4*)(VT + fr * 64 + fq * 16), x);
                *(f32x4*)(XL + fr * 32 + w * 16 + fq * 4) = x;
            }
            __syncthreads();
            {
                const int tl = lane & 31;
                float Gr[32];
#pragma unroll
                for (int q4 = 0; q4 < 8; ++q4) { const float4 g4 = *(const float4*)(GAB + tl * 36 + q4 * 4); Gr[q4 * 4] = g4.x; Gr[q4 * 4 + 1] = g4.y; Gr[q4 * 4 + 2] = g4.z; Gr[q4 * 4 + 3] = g4.w; }
                float acc[4];
#pragma unroll
                for (int r = 0; r < 4; ++r) acc[r] = XL[(4 * w + r) * 32 + tl];
#pragma unroll
                for (int tau = 0; tau < 31; ++tau)
#pragma unroll
                    for (int r = 0; r < 4; ++r) acc[r] = fmaf(__int_as_float(__builtin_amdgcn_readlane(__float_as_int(acc[r]), tau)), Gr[tau], acc[r]);
                if (lane < 32) {
#pragma unroll
                    for (int r = 0; r < 4; ++r) *(bf16_t*)(UT + (4 * w + r) * 64 + tl * 2) = f2bf(acc[r]);
                }
            }
            __syncthreads();
            if (w < 2) {
                f32x4 y = (f32x4){0.f, 0.f, 0.f, 0.f};
#pragma unroll
                for (int ks = 0; ks < 2; ++ks) {
                    const int chs = ((ks * 4 + fq) ^ (fr & 7)) << 4;
                    y = mfma16(*(const uint4*)(RT + (w * 16 + fr) * 128 + chs), *(const uint4*)(SB + fr * 128 + chs), y);
                }
                y = mfma16(*(const uint4*)(GRB + (w * 16 + fr) * 64 + fq * 16), *(const uint4*)(UT + fr * 64 + fq * 16), y);
                y = mfma16(*(const uint4*)(GRK + (w * 16 + fr) * 64 + fq * 16), *(const uint4*)(VT + fr * 64 + fq * 16), y);
#pragma unroll
                for (int j = 0; j < 4; ++j) YB[(w * 16 + fq * 4 + j) * 16 + fr] = f2bf(y[j]);
            }
            {
                const int r0 = fq * 8 + qq, kc = 2 * w + (pp >> 1);
                const int o0 = r0 * 128 + ((kc ^ (r0 & 7)) << 4) + (pp & 1) * 8, o1 = (r0 + 4) * 128 + ((kc ^ ((r0 + 4) & 7)) << 4) + (pp & 1) * 8;
                const uint2 blo = lds_tr16(BT + o0), bhi = lds_tr16(BT + o1), klo = lds_tr16(KT + o0), khi = lds_tr16(KT + o1);
                Sacc = mfma16(make_uint4(blo.x, blo.y, bhi.x, bhi.y), *(const uint4*)(UT + fr * 64 + fq * 16), Sacc);
                Sacc = mfma16(make_uint4(klo.x, klo.y, khi.x, khi.y), *(const uint4*)(VT + fr * 64 + fq * 16), Sacc);
                const float4 pc = *(const float4*)(PC + 16 * w + fq * 4);
                Sacc[0] *= pc.x; Sacc[1] *= pc.y; Sacc[2] *= pc.z; Sacc[3] *= pc.w;
            }
            __syncthreads();
            {
                uint2 o; o.x = cvt_pk(Sacc[0], Sacc[1]); o.y = cvt_pk(Sacc[2], Sacc[3]);
                *(uint2*)(SB + fr * 128 + ((((2 * w + (fq >> 1))) ^ (fr & 7)) << 4) + (fq & 1) * 8) = o;
                if (t < 64) {
                    const int tt = t >> 1, hf = t & 1;
                    const uint4 yv_ = *(const uint4*)((const char*)YB + tt * 32 + hf * 16); const u32x4_t yx_ = {yv_.x, yv_.y, yv_.z, yv_.w};
                    *(__attribute__((address_space(1))) u32x4_t*)(yb + base + (size_t)(c * 32 + tt) * 1024 + rg * 16 + hf * 8) = yx_;
                }
            }
        }
    }
}
struct LdRw4 {
    struct Raw { uint4 y, v, g; float bn; };
    const bf16_t *y, *v, *g; const float *bonus, *gng, *gnb;
    __device__ __forceinline__ Raw fetch(int, int r, int kc) const {
        Raw q; const size_t o = (size_t)r * 1024 + kc * 8;
        q.y = *(const uint4*)(y + o); q.v = *(const uint4*)(v + o); q.g = *(const uint4*)(g + o); q.bn = bonus[r * 16 + (kc >> 3)]; return q;
    }
    __device__ __forceinline__ uint4 finish(const Raw& q, int, int, int kc) const {
        float yf[8], vf[8], gf[8]; unpack8(q.y, yf); unpack8(q.v, vf); unpack8(q.g, gf);
        float s = 0.f, s2 = 0.f;
#pragma unroll
        for (int i = 0; i < 8; ++i) { s += yf[i]; s2 += yf[i] * yf[i]; }
        s = oct_sum(s); s2 = oct_sum(s2);
        const float mean = s * (1.0f / 64.0f), var = fmaxf(s2 * (1.0f / 64.0f) - mean * mean, 0.f), rstd = rsqrtf(var + 64e-5f);
        const float4 ga = *(const float4*)(gng + kc * 8), gb = *(const float4*)(gng + kc * 8 + 4), ba = *(const float4*)(gnb + kc * 8), bb = *(const float4*)(gnb + kc * 8 + 4);
        const float gg[8] = {ga.x, ga.y, ga.z, ga.w, gb.x, gb.y, gb.z, gb.w}, bq[8] = {ba.x, ba.y, ba.z, ba.w, bb.x, bb.y, bb.z, bb.w};
        float o[8];
#pragma unroll
        for (int i = 0; i < 8; ++i) o[i] = ((yf[i] - mean) * rstd * gg[i] + bq[i] + q.bn * vf[i]) * gf[i];
        return pack8(o);
    }
};
__device__ __forceinline__ void phase_rw4(PRef p, int jr, char* lds) {
    char* S = p.ws + OFF_SLOT;
    const bf16_t* yb = (const bf16_t*)(S + 5 * SLOT); const bf16_t* gb = (const bf16_t*)(S + 4 * SLOT);
    const bf16_t* vb = (const bf16_t*)(S + (jr == 0 ? 11 : 9) * SLOT); bf16_t* ymix = (bf16_t*)(S + 6 * SLOT);
    const bf16_t* wt = (const bf16_t*)(p.ws + W_OUT) + (size_t)jr * 1024 * 1024;
    const float* bonus = (const float*)(p.ws + OFF_BONUS);
    const int t_ = tidx(); const int lane = t_ & 63, wid = t_ >> 6, wr = wid >> 1, wc = wid & 1, fr = lane & 15, fq = lane >> 4;
    for (int id = blockIdx.x; id < 128 * 8; id += gridDim.x) {
        int mt, nt; tile_map(id, 8, mt, nt);
        const size_t ro = (size_t)mt * 128 * 1024;
        LdRw4 al{yb + ro, vb + ro, gb + ro, bonus + (size_t)mt * 128 * 16, p.in[22] + jr * 1024, p.in[23] + jr * 1024};
        const bf16_t* br[4];
        { const int t2_ = tidx(), r0_ = t2_ >> 3, co_ = glds_chunk(t2_) * 8;
#pragma unroll
          for (int i = 0; i < 4; ++i) br[i] = wt + (size_t)(nt * 128 + r0_ + 32 * i) * 1024 + co_; }
        f32x4 acc[4][4];
        gemm_rg(lds, 16, al, br, acc);
#pragma unroll
        for (int n = 0; n < 4; ++n)
#pragma unroll
            for (int m = 0; m < 4; ++m) {
                uint2 o; o.x = cvt_pk(acc[m][n][0], acc[m][n][1]); o.y = cvt_pk(acc[m][n][2], acc[m][n][3]);
                *(uint2*)(ymix + (size_t)(mt * 128 + wr * 64 + m * 16 + fr) * 1024 + nt * 128 + wc * 64 + n * 16 + fq * 4) = o;
            }
    }
}

__device__ __forceinline__ void phase_cml(PRef p) {
    const int t = tidx();
    char* S = p.ws + OFF_SLOT;
    const bf16_t* src = (const bf16_t*)(S + 1 * SLOT); bf16_t* dst = (bf16_t*)(S + 8 * SLOT);
    const int col = (t & 127) * 8, half = t >> 7;
    float cw[4][8], cb[8];
#pragma unroll
    for (int j = 0; j < 4; ++j) {
        const float4 a = *(const float4*)(p.in[27] + j * 1024 + col), b = *(const float4*)(p.in[27] + j * 1024 + col + 4);
        cw[j][0] = a.x; cw[j][1] = a.y; cw[j][2] = a.z; cw[j][3] = a.w; cw[j][4] = b.x; cw[j][5] = b.y; cw[j][6] = b.z; cw[j][7] = b.w;
    }
    { const float4 a = *(const float4*)(p.in[28] + col), b = *(const float4*)(p.in[28] + col + 4);
      cb[0] = a.x; cb[1] = a.y; cb[2] = a.z; cb[3] = a.w; cb[4] = b.x; cb[5] = b.y; cb[6] = b.z; cb[7] = b.w; }
    const float qs = (col < 512) ? 0.125f : 1.0f;
    for (int item = blockIdx.x; item < 1024; item += gridDim.x) {
        const int b = item >> 7, s0 = (item & 127) * 16 + half * 8;
        const bf16_t* base = src + (size_t)b * 2048 * 1024 + col;
        uint4 r[11];
#pragma unroll
        for (int i = 0; i < 11; ++i) { const int sr = s0 - 3 + i; r[i] = gload16(base + (size_t)max(sr, 0) * 1024); if (sr < 0) r[i] = make_uint4(0u, 0u, 0u, 0u); }
        float x0[8], x1[8], x2[8];
        unpack8(r[0], x0); unpack8(r[1], x1); unpack8(r[2], x2);
#pragma unroll
        for (int i = 0; i < 8; ++i) {
            float x3[8], a[8]; unpack8(r[i + 3], x3);
#pragma unroll
            for (int e = 0; e < 8; ++e) { a[e] = cb[e] + cw[0][e] * x0[e] + cw[1][e] * x1[e] + cw[2][e] * x2[e] + cw[3][e] * x3[e]; a[e] = siluf_(a[e]) * qs; }
            *(uint4*)(dst + ((size_t)b * 2048 + s0 + i) * 1024 + col) = pack8(a);
#pragma unroll
            for (int e = 0; e < 8; ++e) { x0[e] = x1[e]; x1[e] = x2[e]; x2[e] = x3[e]; }
        }
    }
}
__device__ __forceinline__ void phase_ml2(PRef p, char* lds) {
    const int t = tidx(), lane = t & 63, w = t >> 6, fr = lane & 15, fq = lane >> 4;
    char* S = p.ws + OFF_SLOT;
    const bf16_t* qk = (const bf16_t*)(S + 8 * SLOT); const bf16_t* vb = (const bf16_t*)(S + 2 * SLOT); bf16_t* yb = (bf16_t*)(S + 4 * SLOT);
    const float* gates = (const float*)(p.ws + OFF_GATES); float* stat = (float*)(p.ws + OFF_STAT);
    char* const RAW = lds;
    char* const QT = lds + 17408; char* const KT = lds + 25600;
    char* const VT = lds + 33792;
    char* const VX = lds + 35840;
    char* const PB = lds + 39936;
    char* const CT = lds + 48128;
    float* const FS = (float*)(lds + 52224); float* const GJ = FS + 64; float* const WJ = FS + 128;
    float* const CW = (float*)(lds + 53248);
    const int qq = fr >> 2, pp = fr & 3;
    for (int item = blockIdx.x; item < 512; item += gridDim.x) {
        const int bh = ((item >> 3) >> 3) * 8 + (item & 7), vs = (item >> 3) & 7, b = bh >> 3, hd = bh & 7;
        const size_t tok0 = (size_t)b * 2048;
        __syncthreads();
        for (int i = t; i < 256; i += 256) *(uint4*)(CT + i * 16) = make_uint4(0u, 0u, 0u, 0u);
        f32x4 Cacc[2] = {(f32x4){0.f, 0.f, 0.f, 0.f}, (f32x4){0.f, 0.f, 0.f, 0.f}};
        uint4 gr0, gr1, gr2, gr3; uint4 gv = make_uint4(0u, 0u, 0u, 0u); float gg = 0.f;
        const int frr = t >> 4, fc = t & 15;
        const bf16_t* const qkt = qk + (tok0 + frr) * 1024 + (fc >> 3) * 512 + hd * 64 + (fc & 7) * 8;
        char* const qkd = ((fc < 8) ? QT : KT) + frr * 128 + (((fc & 7) ^ (frr & 7)) << 4);
        auto fetch = [&](int ch) {
            const int s0 = ch * 64;
            const bf16_t* q0 = qkt + (size_t)s0 * 1024;
            gr0 = gload16(q0); gr1 = gload16(q0 + 16 * 1024); gr2 = gload16(q0 + 32 * 1024); gr3 = gload16(q0 + 48 * 1024);
            if (t < 128) { gv = gload16(vb + (tok0 + s0 + (t >> 1)) * 1024 + hd * 128 + vs * 16 + (t & 1) * 8);
                           gg = *(const __attribute__((address_space(1))) float*)(gates + (tok0 + s0 + (t & 63)) * 16 + (t >> 6) * 8 + hd); }
        };
        fetch(0);
        for (int ch = 0; ch < 32; ++ch) {
            const int s0 = ch * 64;
            *(uint4*)qkd = gr0; *(uint4*)(qkd + 16 * 128) = gr1; *(uint4*)(qkd + 32 * 128) = gr2; *(uint4*)(qkd + 48 * 128) = gr3;
            if (t < 128) *(uint4*)(VT + t * 16) = gv;
            float vf8[8]; unpack8(gv, vf8);
            if (t >= 64 && t < 128) GJ[t - 64] = gg;
            const float ggc = gg;
            if (ch + 1 < 32) fetch(ch + 1);
            __syncthreads();
            if (t < 64) {
                float f = GJ[t];
#pragma unroll
                for (int o = 1; o < 64; o <<= 1) { const float u2 = __shfl_up(f, o); if (t >= o) f += u2; }
                const float fend = __shfl(f, 63);
                FS[t] = f; WJ[t] = __expf(fend - f + ggc);
                GJ[t] = ggc - f;
            }
            __syncthreads();
            const float efend = __expf(FS[63]);
            {
                if (t < 128) {
                    const int j = t >> 1; const float wj = WJ[j];
                    float f[8];
#pragma unroll
                    for (int i = 0; i < 8; ++i) f[i] = vf8[i] * wj;
                    *(uint4*)(VX + j * 64 + (t & 1) * 16) = pack8(f);
                    float g8[8] = {0.f, 0.f, 0.f, 0.f, 0.f, 0.f, 0.f, 0.f}; if ((t & 1) == 0) g8[0] = wj;
                    *(uint4*)(VX + j * 64 + 32 + (t & 1) * 16) = pack8(g8);
                }
            }
            __syncthreads();
            const int srow = 16 * w + fr;
            f32x4 Sacc[4], Xacc[2];
#pragma unroll
            for (int n = 0; n < 4; ++n) Sacc[n] = (f32x4){0.f, 0.f, 0.f, 0.f};
            Xacc[0] = (f32x4){0.f, 0.f, 0.f, 0.f}; Xacc[1] = (f32x4){0.f, 0.f, 0.f, 0.f};
            Cacc[0] *= efend; Cacc[1] *= efend;
#pragma unroll
            for (int ks = 0; ks < 2; ++ks) {
                const int chs = ((ks * 4 + fq) ^ (fr & 7)) << 4;
                const uint4 qf = *(const uint4*)(QT + srow * 128 + chs);
#pragma unroll
                for (int n = 0; n < 4; ++n) { const uint4 kf = *(const uint4*)(KT + (n * 16 + fr) * 128 + chs); Sacc[n] = mfma16(kf, qf, Sacc[n]); }
#pragma unroll
                for (int nn = 0; nn < 2; ++nn) { const uint4 rf = *(const uint4*)(CT + (nn * 16 + fr) * 128 + chs); Xacc[nn] = mfma16(rf, qf, Xacc[nn]); }
                const int r0 = ks * 32 + fq * 8 + qq, kc = 2 * w + (pp >> 1);
                const uint2 klo = lds_tr16(KT + r0 * 128 + ((kc ^ (r0 & 7)) << 4) + (pp & 1) * 8);
                const uint2 khi = lds_tr16(KT + (r0 + 4) * 128 + ((kc ^ ((r0 + 4) & 7)) << 4) + (pp & 1) * 8);
                const uint4 kt = make_uint4(klo.x, klo.y, khi.x, khi.y);
#pragma unroll
                for (int m = 0; m < 2; ++m) {
                    const uint2 vlo = lds_tr16(VX + r0 * 64 + (16 * m + 4 * pp) * 2), vhi = lds_tr16(VX + (r0 + 4) * 64 + (16 * m + 4 * pp) * 2);
                    Cacc[m] = mfma16(kt, make_uint4(vlo.x, vlo.y, vhi.x, vhi.y), Cacc[m]);
                }
            }
            const float fs = FS[srow];
            float dsum = 0.f;
#pragma unroll
            for (int n = 0; n < 4; ++n) {
                const float4 g4 = *(const float4*)(GJ + n * 16 + fq * 4); const float ga[4] = {g4.x, g4.y, g4.z, g4.w};
                float pv[4];
#pragma unroll
                for (int j = 0; j < 4; ++j) { const int jc = n * 16 + fq * 4 + j; pv[j] = (srow >= jc) ? Sacc[n][j] * __expf(fs + ga[j]) : 0.f; dsum += pv[j]; }
                uint2 o; o.x = cvt_pk(pv[0], pv[1]); o.y = cvt_pk(pv[2], pv[3]);
                *(uint2*)(PB + srow * 128 + (((n * 2 + (fq >> 1)) ^ (fr & 7)) << 4) + (fq & 1) * 8) = o;
            }
            dsum += __shfl_xor(dsum, 16); dsum += __shfl_xor(dsum, 32);
            f32x4 Iacc = (f32x4){0.f, 0.f, 0.f, 0.f};
#pragma unroll
            for (int ks = 0; ks < 2; ++ks) {
                const uint4 pf = *(const uint4*)(PB + srow * 128 + (((ks * 4 + fq) ^ (fr & 7)) << 4));
                const int r0 = ks * 32 + fq * 8 + qq;
                const uint2 vlo = lds_tr16(VT + r0 * 32 + (4 * pp) * 2), vhi = lds_tr16(VT + (r0 + 4) * 32 + (4 * pp) * 2);
                Iacc = mfma16(make_uint4(vlo.x, vlo.y, vhi.x, vhi.y), pf, Iacc);
            }
            const float efs = __expf(fs);
            const float ndq = __shfl(Xacc[1][0], fr);
            const float den = dsum + efs * ndq;
            const float rden = 1.0f / fmaxf(fabsf(den), 1.0f);
            const size_t tok = tok0 + s0 + srow;
            float o4[4], ssum = 0.f, ssq = 0.f;
#pragma unroll
            for (int j = 0; j < 4; ++j) { o4[j] = (Iacc[j] + efs * Xacc[0][j]) * rden; ssum += o4[j]; ssq += o4[j] * o4[j]; }
            gst_u2(yb + tok * 1024 + hd * 128 + vs * 16 + fq * 4, cvt_pk(o4[0], o4[1]), cvt_pk(o4[2], o4[3]));
            ssum += __shfl_xor(ssum, 16); ssum += __shfl_xor(ssum, 32); ssq += __shfl_xor(ssq, 16); ssq += __shfl_xor(ssq, 32);
            if (fq == 0) gst_u2(stat + ((tok * 8 + hd) * 8 + vs) * 2, __float_as_uint(ssum), __float_as_uint(ssq));
            __syncthreads();
#pragma unroll
            for (int m = 0; m < 2; ++m) {
                const int v = m * 16 + fr;
                uint2 o; o.x = cvt_pk(Cacc[m][0], Cacc[m][1]); o.y = cvt_pk(Cacc[m][2], Cacc[m][3]);
                *(uint2*)(CT + v * 128 + (((2 * w + (fq >> 1)) ^ (v & 7)) << 4) + (fq & 1) * 8) = o;
            }
        }
    }
}
template <int HSHIFT  , int NH>
struct LdGnGate {
    struct Raw { uint4 y, g; };
    const bf16_t *y, *g; int ld; const float *gng, *gnb; const float* st;
    __device__ __forceinline__ Raw fetch(int, int r, int kc) const { Raw q; const size_t o = (size_t)r * ld + kc * 8; q.y = *(const uint4*)(y + o); q.g = *(const uint4*)(g + o); return q; }
    __device__ __forceinline__ uint4 finish(const Raw& q, int, int r, int kc) const {
        float yf[8], gf[8]; unpack8(q.y, yf); unpack8(q.g, gf);
        const float2 ms = *(const float2*)(st + (r * NH + ((kc * 8) >> HSHIFT)) * 2);
        const float4 ga = *(const float4*)(gng + kc * 8), gb = *(const float4*)(gng + kc * 8 + 4), ba = *(const float4*)(gnb + kc * 8), bb = *(const float4*)(gnb + kc * 8 + 4);
        const float gg[8] = {ga.x, ga.y, ga.z, ga.w, gb.x, gb.y, gb.z, gb.w}, bq[8] = {ba.x, ba.y, ba.z, ba.w, bb.x, bb.y, bb.z, bb.w};
        float o[8];
#pragma unroll
        for (int i = 0; i < 8; ++i) o[i] = ((yf[i] - ms.x) * ms.y * gg[i] + bq[i]) * gf[i];
        return pack8(o);
    }
};
template <int HSHIFT, int NH, int NPART>
__device__ __forceinline__ void phase_outproj_gn(PRef p, char* lds, const bf16_t* yb, const bf16_t* gate, int K, const bf16_t* wt, const float* gng, const float* gnb, bf16_t* ymix) {
    const int t = tidx(), lane = t & 63, wid = t >> 6, wr = wid >> 1, wc = wid & 1, fr = lane & 15, fq = lane >> 4;
    const float* stat = (const float*)(p.ws + OFF_STAT);
    float* st = (float*)(lds + 65536);
    const float invn = 1.0f / (float)(1 << HSHIFT);
    for (int id = blockIdx.x; id < 128 * 8; id += gridDim.x) {
        int mt, nt; tile_map(id, 8, mt, nt);
        for (int i = t; i < 128 * NH; i += 256) {
            const float* q = stat + ((size_t)mt * 128 * NH + i) * NPART * 2;
            float s = 0.f, s2 = 0.f;
#pragma unroll
            for (int j = 0; j < NPART; ++j) { const float2 v = *(const float2*)(q + j * 2); s += v.x; s2 += v.y; }
            const float mean = s * invn, var = fmaxf(s2 * invn - mean * mean, 0.f);
            st[i * 2] = mean; st[i * 2 + 1] = rsqrtf(var + 1e-6f);
        }
        __syncthreads();
        const size_t ro = (size_t)mt * 128 * K;
        LdGnGate<HSHIFT, NH> al{yb + ro, gate + ro, K, gng, gnb, st};
        const bf16_t* br[4];
        { const int r0_ = t >> 3, co_ = glds_chunk(t) * 8;
#pragma unroll
          for (int i = 0; i < 4; ++i) br[i] = wt + (size_t)(nt * 128 + r0_ + 32 * i) * K + co_; }
        f32x4 acc[4][4];
        gemm_rg(lds, K / 64, al, br, acc);
#pragma unroll
        for (int n = 0; n < 4; ++n)
#pragma unroll
            for (int m = 0; m < 4; ++m) {
                uint2 o; o.x = cvt_pk(acc[m][n][0], acc[m][n][1]); o.y = cvt_pk(acc[m][n][2], acc[m][n][3]);
                *(uint2*)(ymix + (size_t)(mt * 128 + wr * 64 + m * 16 + fr) * 1024 + nt * 128 + wc * 64 + n * 16 + fq * 4) = o;
            }
    }
}

__device__ __forceinline__ void phase_rt2(PRef p, char* lds) {
    const int t = tidx(), lane = t & 63, w = t >> 6, fr = lane & 15, fq = lane >> 4;
    char* S = p.ws + OFF_SLOT;
    const bf16_t* qb = (const bf16_t*)(S + 1 * SLOT); const bf16_t* kb = (const bf16_t*)(S + 2 * SLOT); const bf16_t* vb = (const bf16_t*)(S + 3 * SLOT);
    bf16_t* yb = (bf16_t*)(S + 7 * SLOT); float* stat = (float*)(p.ws + OFF_STAT);
    char* const VB = lds + 32768; char* const PB = lds + 49152; char* const RT = lds + 57344;
    const int gco = glds_chunk(t) * 8, gr0 = t >> 3;
    const int qq = fr >> 2, pp = fr & 3;
    for (int item = blockIdx.x; item < 512; item += gridDim.x) {
        const int bh = ((item >> 3) >> 4) * 8 + (item & 7), vs = (item >> 3) & 15, b = bh >> 2, hd = bh & 3;
        const size_t tok0 = (size_t)b * 2048;
        const float lg2 = log2f(1.0f - __builtin_amdgcn_exp2f(-5.0f - (float)hd));
        const float dec64 = __builtin_amdgcn_exp2f(64.0f * lg2);
        const bf16_t* qsrc = qb + (tok0 + gr0) * 1024 + hd * 256 + gco;
        const bf16_t* ksrc = kb + (tok0 + gr0) * 1024 + hd * 256 + gco;
        const bf16_t* vsrc = vb + (tok0 + (t >> 2)) * 2048 + hd * 512 + vs * 32 + (t & 3) * 8;
        f32x4 Racc[4][2];
#pragma unroll
        for (int a = 0; a < 4; ++a) { Racc[a][0] = (f32x4){0.f, 0.f, 0.f, 0.f}; Racc[a][1] = (f32x4){0.f, 0.f, 0.f, 0.f}; }
        __syncthreads();
        for (int i = t; i < 1024; i += 256) *(uint4*)(RT + i * 16) = make_uint4(0u, 0u, 0u, 0u);
        auto issue = [&](int pc) {
            const unsigned d = (unsigned)__builtin_amdgcn_readfirstlane((int)(lds_addr_u(lds) + (pc & 1) * 16384 + w * 1024));
            const size_t go = (size_t)(pc >> 2) * 64 * 1024 + (pc & 3) * 64;
#pragma unroll
            for (int i = 0; i < 2; ++i) { glds16_asm(qsrc + go + (size_t)i * 32 * 1024, d + i * 4096); glds16_asm(ksrc + go + (size_t)i * 32 * 1024, d + 8192 + i * 4096); }
        };
        auto put_v = [&](const uint4& raw, int ch) {
            char* vbuf = VB + (ch & 1) * 8192; const int j = t >> 2;
            *(uint4*)(vbuf + j * 64 + (t & 3) * 16) = raw;
            float f[8]; unpack8(raw, f); const float sc = __builtin_amdgcn_exp2f(lg2 * (float)(63 - j));
#pragma unroll
            for (int i = 0; i < 8; ++i) f[i] *= sc;
            *(uint4*)(vbuf + 4096 + j * 64 + (t & 3) * 16) = pack8(f);
        };
        issue(0);
        { const uint4 v0 = gld_u4(vsrc); put_v(v0, 0); }
        asm volatile("s_waitcnt vmcnt(0)" ::: "memory");
        __syncthreads();
        f32x4 Sacc[4], Xacc[2];
        uint4 vnext = make_uint4(0u, 0u, 0u, 0u);
        for (int ch = 0; ch < 32; ++ch) {
            const char* vbuf = VB + (ch & 1) * 8192;
#pragma unroll
            for (int qd = 0; qd < 4; ++qd) {
                const int pc = ch * 4 + qd;
                if (pc + 1 < 128) issue(pc + 1);
                if (qd == 0) {
                    if (ch + 1 < 32) vnext = gld_u4(vsrc + (size_t)(ch + 1) * 64 * 2048);
#pragma unroll
                    for (int n = 0; n < 4; ++n) Sacc[n] = (f32x4){0.f, 0.f, 0.f, 0.f};
                    Xacc[0] = (f32x4){0.f, 0.f, 0.f, 0.f}; Xacc[1] = (f32x4){0.f, 0.f, 0.f, 0.f};
                }
                const char* qk = lds + (pc & 1) * 16384;
                Racc[qd][0] *= dec64; Racc[qd][1] *= dec64;
#pragma unroll
                for (int ks = 0; ks < 2; ++ks) {
                    const int chs = ((ks * 4 + fq) ^ (fr & 7)) << 4;
                    const uint4 qf = *(const uint4*)(qk + (16 * w + fr) * 128 + chs);
#pragma unroll
                    for (int n = 0; n < 4; ++n) { const uint4 kf = *(const uint4*)(qk + 8192 + (n * 16 + fr) * 128 + chs); Sacc[n] = mfma16(kf, qf, Sacc[n]); }
#pragma unroll
                    for (int nn = 0; nn < 2; ++nn) {
                        const int v = nn * 16 + fr;
                        const uint4 rf = *(const uint4*)(RT + v * 512 + (((qd * 8 + ks * 4 + fq) ^ (v & 7)) << 4));
                        Xacc[nn] = mfma16(rf, qf, Xacc[nn]);
                    }
                    const int r0 = ks * 32 + fq * 8 + qq;
                    const int kc = 2 * w + (pp >> 1);
                    const uint2 klo = lds_tr16(qk + 8192 + r0 * 128 + ((kc ^ (r0 & 7)) << 4) + (pp & 1) * 8);
                    const uint2 khi = lds_tr16(qk + 8192 + (r0 + 4) * 128 + ((kc ^ ((r0 + 4) & 7)) << 4) + (pp & 1) * 8);
                    const uint4 kt = make_uint4(klo.x, klo.y, khi.x, khi.y);
#pragma unroll
                    for (int m = 0; m < 2; ++m) {
                        const uint2 vlo = lds_tr16(vbuf + 4096 + r0 * 64 + (16 * m + 4 * pp) * 2), vhi = lds_tr16(vbuf + 4096 + (r0 + 4) * 64 + (16 * m + 4 * pp) * 2);
                        Racc[qd][m] = mfma16(kt, make_uint4(vlo.x, vlo.y, vhi.x, vhi.y), Racc[qd][m]);
                    }
                }
                if (qd == 2 && ch + 1 < 32) put_v(vnext, ch + 1);
                asm volatile("s_waitcnt vmcnt(0)" ::: "memory");
                __syncthreads();
#pragma unroll
                for (int m = 0; m < 2; ++m) {
                    const int v = m * 16 + fr, cch = qd * 8 + 2 * w + (fq >> 1);
                    uint2 o; o.x = cvt_pk(Racc[qd][m][0], Racc[qd][m][1]); o.y = cvt_pk(Racc[qd][m][2], Racc[qd][m][3]);
                    *(uint2*)(RT + v * 512 + ((cch ^ (v & 7)) << 4) + (fq & 1) * 8) = o;
                }
            }
            const int srow = 16 * w + fr;
#pragma unroll
            for (int n = 0; n < 4; ++n) {
                float pv[4];
#pragma unroll
                for (int j = 0; j < 4; ++j) { const int jc = n * 16 + fq * 4 + j; pv[j] = (srow >= jc) ? Sacc[n][j] * __builtin_amdgcn_exp2f(lg2 * (float)(srow - jc)) : 0.f; }
                uint2 o; o.x = cvt_pk(pv[0], pv[1]); o.y = cvt_pk(pv[2], pv[3]);
                *(uint2*)(PB + srow * 128 + (((n * 2 + (fq >> 1)) ^ (fr & 7)) << 4) + (fq & 1) * 8) = o;
            }
            f32x4 Iacc[2] = {(f32x4){0.f, 0.f, 0.f, 0.f}, (f32x4){0.f, 0.f, 0.f, 0.f}};
#pragma unroll
            for (int ks = 0; ks < 2; ++ks) {
                const uint4 pf = *(const uint4*)(PB + srow * 128 + (((ks * 4 + fq) ^ (fr & 7)) << 4));
                const int r0 = ks * 32 + fq * 8 + qq;
#pragma unroll
                for (int nn = 0; nn < 2; ++nn) {
                    const uint2 vlo = lds_tr16(vbuf + r0 * 64 + (16 * nn + 4 * pp) * 2), vhi = lds_tr16(vbuf + (r0 + 4) * 64 + (16 * nn + 4 * pp) * 2);
                    Iacc[nn] = mfma16(make_uint4(vlo.x, vlo.y, vhi.x, vhi.y), pf, Iacc[nn]);
                }
            }
            const float qdec = __builtin_amdgcn_exp2f(lg2 * (float)(srow + 1));
            const size_t tok = tok0 + (size_t)ch * 64 + srow;
            float ssum = 0.f, ssq = 0.f;
#pragma unroll
            for (int nn = 0; nn < 2; ++nn) {
                float o4[4];
#pragma unroll
                for (int j = 0; j < 4; ++j) { o4[j] = Iacc[nn][j] + Xacc[nn][j] * qdec; ssum += o4[j]; ssq += o4[j] * o4[j]; }
                gst_u2(yb + tok * 2048 + hd * 512 + vs * 32 + nn * 16 + fq * 4, cvt_pk(o4[0], o4[1]), cvt_pk(o4[2], o4[3]));
            }
            ssum += __shfl_xor(ssum, 16); ssum += __shfl_xor(ssum, 32); ssq += __shfl_xor(ssq, 16); ssq += __shfl_xor(ssq, 32);
            if (fq == 0) gst_u2(stat + ((tok * 4 + hd) * 16 + vs) * 2, __float_as_uint(ssum), __float_as_uint(ssq));
        }
        __syncthreads();
    }
}

__device__ __forceinline__ void phase_zrw(PRef p, int jr) {
    const int t_ = tidx(); const int lane = t_ & 63, gw = blockIdx.x * 4 + (t_ >> 6), nw = gridDim.x * 4;
    char* S = p.ws + OFF_SLOT;
    const bf16_t* yb = (const bf16_t*)(S + 5 * SLOT); const bf16_t* gb = (const bf16_t*)(S + 4 * SLOT);
    const bf16_t* vb = (const bf16_t*)(S + (jr == 0 ? 11 : 9) * SLOT); bf16_t* zb = (bf16_t*)(S + 7 * SLOT);
    const float* bonus = (const float*)(p.ws + OFF_BONUS);
    float gg[16], bq[16]; row_load_f32(p.in[22] + jr * 1024, gg, lane); row_load_f32(p.in[23] + jr * 1024, bq, lane);
    const int rpw = NTOK / nw, first = gw * rpw, end = first + rpw;
    uint2 ny[4], nv[4], ng[4]; float nbn[4];
    auto load_in = [&](int r) {
#pragma unroll
        for (int c = 0; c < 4; ++c) { const size_t o = (size_t)r * 1024 + c * 256 + lane * 4; ny[c] = *(const uint2*)(yb + o); nv[c] = *(const uint2*)(vb + o); ng[c] = *(const uint2*)(gb + o);
                                      nbn[c] = bonus[(size_t)r * 16 + c * 4 + (lane >> 4)]; }
    };
    load_in(first);
    for (int r = first; r < end; ++r) {
        float y[16], v[16], g[16], bn[4];
#pragma unroll
        for (int c = 0; c < 4; ++c) {
            y[c * 4] = bflo(ny[c].x); y[c * 4 + 1] = bfhi(ny[c].x); y[c * 4 + 2] = bflo(ny[c].y); y[c * 4 + 3] = bfhi(ny[c].y);
            v[c * 4] = bflo(nv[c].x); v[c * 4 + 1] = bfhi(nv[c].x); v[c * 4 + 2] = bflo(nv[c].y); v[c * 4 + 3] = bfhi(nv[c].y);
            g[c * 4] = bflo(ng[c].x); g[c * 4 + 1] = bfhi(ng[c].x); g[c * 4 + 2] = bflo(ng[c].y); g[c * 4 + 3] = bfhi(ng[c].y);
            bn[c] = nbn[c];
        }
        if (r + 1 < end) load_in(r + 1);
        __builtin_amdgcn_sched_barrier(0);
        float z[16];
#pragma unroll
        for (int c = 0; c < 4; ++c) {
            float s = (y[c * 4] + y[c * 4 + 1]) + (y[c * 4 + 2] + y[c * 4 + 3]);
            float q = (y[c * 4] * y[c * 4] + y[c * 4 + 1] * y[c * 4 + 1]) + (y[c * 4 + 2] * y[c * 4 + 2] + y[c * 4 + 3] * y[c * 4 + 3]);
            s = row16_sum(s); q = row16_sum(q);
            const float mean = s * (1.0f / 64.0f), rstd = rsqrtf(fmaxf(q * (1.0f / 64.0f) - mean * mean, 0.f) + 64e-5f);
#pragma unroll
            for (int i = 0; i < 4; ++i) { const int e = c * 4 + i; z[e] = ((y[e] - mean) * rstd * gg[e] + bq[e] + bn[c] * v[e]) * g[e]; }
        }
        row_store_bf16(zb + (size_t)r * 1024, z, lane);
    }
}
__device__ __forceinline__ void phase_zml(PRef p) {
    const int t_ = tidx(); const int lane = t_ & 63, gw = blockIdx.x * 4 + (t_ >> 6), nw = gridDim.x * 4;
    char* S = p.ws + OFF_SLOT;
    const bf16_t* yb = (const bf16_t*)(S + 4 * SLOT); const bf16_t* ob = (const bf16_t*)(S + 3 * SLOT); bf16_t* zb = (bf16_t*)(S + 1 * SLOT);
    float gg[16], bq[16]; row_load_f32(p.in[29], gg, lane); row_load_f32(p.in[30], bq, lane);
    const int rpw = NTOK / nw, first = gw * rpw, end = first + rpw;
    uint2 ny[4], no[4];
    auto load_in = [&](int r) {
#pragma unroll
        for (int c = 0; c < 4; ++c) { const size_t o = (size_t)r * 1024 + c * 256 + lane * 4; ny[c] = *(const uint2*)(yb + o); no[c] = *(const uint2*)(ob + o); }
    };
    load_in(first);
    for (int r = first; r < end; ++r) {
        float y[16], o[16], z[16];
#pragma unroll
        for (int c = 0; c < 4; ++c) {
            y[c * 4] = bflo(ny[c].x); y[c * 4 + 1] = bfhi(ny[c].x); y[c * 4 + 2] = bflo(ny[c].y); y[c * 4 + 3] = bfhi(ny[c].y);
            o[c * 4] = bflo(no[c].x); o[c * 4 + 1] = bfhi(no[c].x); o[c * 4 + 2] = bflo(no[c].y); o[c * 4 + 3] = bfhi(no[c].y);
        }
        if (r + 1 < end) load_in(r + 1);
        __builtin_amdgcn_sched_barrier(0);
#pragma unroll
        for (int c = 0; c < 4; ++c) {
            float s = (y[c * 4] + y[c * 4 + 1]) + (y[c * 4 + 2] + y[c * 4 + 3]);
            float q = (y[c * 4] * y[c * 4] + y[c * 4 + 1] * y[c * 4 + 1]) + (y[c * 4 + 2] * y[c * 4 + 2] + y[c * 4 + 3] * y[c * 4 + 3]);
            s = row16_sum(s); q = row16_sum(q); s += __shfl_xor(s, 16); q += __shfl_xor(q, 16);
            const float mean = s * (1.0f / 128.0f), rstd = rsqrtf(fmaxf(q * (1.0f / 128.0f) - mean * mean, 0.f) + 1e-6f);
#pragma unroll
            for (int i = 0; i < 4; ++i) { const int e = c * 4 + i; z[e] = ((y[e] - mean) * rstd * gg[e] + bq[e]) * o[e]; }
        }
        row_store_bf16(zb + (size_t)r * 1024, z, lane);
    }
}
__device__ __forceinline__ void phase_zrt(PRef p) {
    const int t_ = tidx(); const int lane = t_ & 63, gw = blockIdx.x * 4 + (t_ >> 6), nw = gridDim.x * 4;
    char* S = p.ws + OFF_SLOT;
    const bf16_t* yb = (const bf16_t*)(S + 7 * SLOT); const bf16_t* sb = (const bf16_t*)(S + 5 * SLOT); bf16_t* zb = (bf16_t*)(S + 3 * SLOT);
    float gw8[4][8], bw8[4][8];
#pragma unroll
    for (int c = 0; c < 4; ++c) {
        const float4 ga = gld_f4(p.in[33] + lane * 32 + c * 8), gb2 = gld_f4(p.in[33] + lane * 32 + c * 8 + 4), ba = gld_f4(p.in[34] + lane * 32 + c * 8), bb2 = gld_f4(p.in[34] + lane * 32 + c * 8 + 4);
        gw8[c][0] = ga.x; gw8[c][1] = ga.y; gw8[c][2] = ga.z; gw8[c][3] = ga.w; gw8[c][4] = gb2.x; gw8[c][5] = gb2.y; gw8[c][6] = gb2.z; gw8[c][7] = gb2.w;
        bw8[c][0] = ba.x; bw8[c][1] = ba.y; bw8[c][2] = ba.z; bw8[c][3] = ba.w; bw8[c][4] = bb2.x; bw8[c][5] = bb2.y; bw8[c][6] = bb2.z; bw8[c][7] = bb2.w;
    }
    const int rpw = NTOK / nw, first = gw * rpw, end = first + rpw;
    uint4 nyr[4], nsr[4];
    auto load_in = [&](int r) {
        const size_t o = (size_t)r * 2048 + lane * 32;
#pragma unroll
        for (int c = 0; c < 4; ++c) { nyr[c] = *(const uint4*)(yb + o + c * 8); nsr[c] = *(const uint4*)(sb + o + c * 8); }
    };
    load_in(first);
    for (int r = first; r < end; ++r) {
        const size_t o = (size_t)r * 2048 + lane * 32;
        uint4 yr[4], sr[4];
#pragma unroll
        for (int c = 0; c < 4; ++c) { yr[c] = nyr[c]; sr[c] = nsr[c]; }
        if (r + 1 < end) load_in(r + 1);
        __builtin_amdgcn_sched_barrier(0);
        float s = 0.f, q = 0.f;
#pragma unroll
        for (int c = 0; c < 4; ++c) { float f[8]; unpack8(yr[c], f);
#pragma unroll
            for (int i = 0; i < 8; ++i) { s += f[i]; q += f[i] * f[i]; } }
        s = row16_sum(s); q = row16_sum(q);
        const float mean = s * (1.0f / 512.0f), rstd = rsqrtf(fmaxf(q * (1.0f / 512.0f) - mean * mean, 0.f) + 1e-6f);
#pragma unroll
        for (int c = 0; c < 4; ++c) {
            float f[8], g[8], z[8]; unpack8(yr[c], f); unpack8(sr[c], g);
#pragma unroll
            for (int i = 0; i < 8; ++i) z[i] = ((f[i] - mean) * rstd * gw8[c][i] + bw8[c][i]) * g[i];
            *(uint4*)(zb + o + c * 8) = pack8(z);
        }
    }
}

template <int WHICH  >
__device__ __forceinline__ void phase_moe(PRef p, int L, char* lds, const bf16_t* hm, bf16_t* H) {
    const int t = tidx(), lane = t & 63, wid = t >> 6, wr = wid >> 1, wc = wid & 1, fr = lane & 15, fq = lane >> 4;
    const int* cnt = (const int*)(p.ws + OFF_CNT) + L * 32;
    const int* list = (const int*)(p.ws + OFF_LIST);
    bf16_t* Y = (bf16_t*)(p.ws + OFF_SLOT + 9 * SLOT);
    int* pre = (int*)(lds + 65536);
    __syncthreads();
    if (t == 0) { int s = 0; for (int e = 0; e < 32; ++e) { pre[e] = s; s += (cnt[e] + 127) >> 7; } pre[32] = s; }
    __syncthreads();
    const int total_all = pre[32] * 8;
    const int full = (total_all / (int)gridDim.x) * (int)gridDim.x, rem = total_all - full;
    const bool split_tail = (rem > 0) && (2 * rem <= (int)gridDim.x);
    const int total = split_tail ? full : total_all;
    for (int id0 = 0; id0 < total; id0 += gridDim.x) {
        const int id = id0 + (blockIdx.x & 7) * (gridDim.x >> 3) + (blockIdx.x >> 3);
        if (id >= total) continue;
        const int nt = id & 7, mg = id >> 3;
        int e = 0;
#pragma unroll 1
        for (int s = 16; s >= 1; s >>= 1) if (pre[e + s] <= mg) e += s;
        const int mt = mg - pre[e], ne = cnt[e];
        const int* le = list + e * LIST_CAP + mt * 128;
        const bf16_t* ar[4]; const bf16_t* br[4];
        const int co_ = glds_chunk(t) * 8;
#pragma unroll
        for (int i = 0; i < 4; ++i) {
            int r = (t >> 3) + 32 * i; r = (mt * 128 + r < ne) ? r : 0;
            const int aid = le[r];
            ar[i] = ((WHICH == 0) ? hm + (size_t)(aid >> 1) * 1024 : H + (size_t)aid * 512) + co_;
        }
        f32x4 acc[4][4];
        if (WHICH == 0) {
            const bf16_t* wt = (const bf16_t*)(p.ws + W_MOE13) + ((size_t)(L * 32 + e) * 1024 + nt * 128) * 1024;
#pragma unroll
            for (int i = 0; i < 4; ++i) {
                const int ro = (t >> 3) + 32 * i, n_ = (ro >> 4) & 3, hc = ((ro >> 2) & 3) * 8 + (n_ >> 1) * 4 + (ro & 3);
                br[i] = wt + (size_t)((ro & 64) + (hc >> 4) * 32 + (n_ & 1) * 16 + (hc & 15)) * 1024 + co_;
            }
            gemm_gg(lds, 16, ar, br, acc);
            int aidq[4];
#pragma unroll
            for (int m = 0; m < 4; ++m) { const int r = wr * 64 + m * 16 + fr; aidq[m] = (mt * 128 + r < ne) ? le[r] : 0; }
#pragma unroll
            for (int m = 0; m < 4; ++m) {
                const int r = wr * 64 + m * 16 + fr;
                if (mt * 128 + r < ne) {
                    const int aid = aidq[m];
                    const f32x4 a1 = acc[m][0], a3 = acc[m][1], b1 = acc[m][2], b3 = acc[m][3];
                    gst_u4(H + (size_t)aid * 512 + nt * 64 + wc * 32 + fq * 8, cvt_pk(siluf_(a1[0]) * a3[0], siluf_(a1[1]) * a3[1]), cvt_pk(siluf_(a1[2]) * a3[2], siluf_(a1[3]) * a3[3]),
                           cvt_pk(siluf_(b1[0]) * b3[0], siluf_(b1[1]) * b3[1]), cvt_pk(siluf_(b1[2]) * b3[2], siluf_(b1[3]) * b3[3]));
                }
            }
        } else {
            const bf16_t* wt = (const bf16_t*)(p.ws + W_MOE2) + ((size_t)(L * 32 + e) * 1024 + nt * 128) * 512;
#pragma unroll
            for (int i = 0; i < 4; ++i) br[i] = wt + (size_t)perm64((t >> 3) + 32 * i) * 512 + co_;
            gemm_gg(lds, 8, ar, br, acc);
            int aidq[4];
#pragma unroll
            for (int m = 0; m < 4; ++m) { const int r = wr * 64 + m * 16 + fr; aidq[m] = (mt * 128 + r < ne) ? le[r] : 0; }
#pragma unroll
            for (int m = 0; m < 4; ++m) {
                const int r = wr * 64 + m * 16 + fr;
                if (mt * 128 + r < ne) {
                    const int aid = aidq[m];
                    store16(Y + (size_t)aid * 1024 + nt * 128 + wc * 64 + fq * 16, acc[m]);
                }
            }
        }
    }
    if (split_tail) {
        const int hid = (blockIdx.x & 7) * (gridDim.x >> 3) + (blockIdx.x >> 3);
        if (hid < 2 * rem) {
            const int id = full + (hid >> 1), hf = hid & 1;
            const int nt = id & 7, mg = id >> 3;
            int e = 0;
#pragma unroll 1
            for (int s2 = 16; s2 >= 1; s2 >>= 1) if (pre[e + s2] <= mg) e += s2;
            const int mt = mg - pre[e], ne = cnt[e];
            const int* le = list + e * LIST_CAP + mt * 128;
            const bf16_t* ar[4]; const bf16_t* br[2];
            const int co_ = glds_chunk(t) * 8;
#pragma unroll
            for (int i = 0; i < 4; ++i) {
                int r = (t >> 3) + 32 * i; r = (mt * 128 + r < ne) ? r : 0;
                const int aid = le[r];
                ar[i] = ((WHICH == 0) ? hm + (size_t)(aid >> 1) * 1024 : H + (size_t)aid * 512) + co_;
            }
            f32x4 acc[2][4];
            int aidq[2];
            if (WHICH == 0) {
                const bf16_t* wt = (const bf16_t*)(p.ws + W_MOE13) + ((size_t)(L * 32 + e) * 1024 + nt * 128 + hf * 64) * 1024;
#pragma unroll
                for (int i = 0; i < 2; ++i) {
                    const int ro = (t >> 3) + 32 * i, n_ = (ro >> 4) & 3, hc = ((ro >> 2) & 3) * 8 + (n_ >> 1) * 4 + (ro & 3);
                    br[i] = wt + (size_t)((hc >> 4) * 32 + (n_ & 1) * 16 + (hc & 15)) * 1024 + co_;
                }
                gemm_hn(lds, 16, ar, br, acc);
#pragma unroll
                for (int m = 0; m < 2; ++m) { const int r = wid * 32 + m * 16 + fr; aidq[m] = (mt * 128 + r < ne) ? le[r] : 0; }
#pragma unroll
                for (int m = 0; m < 2; ++m) {
                    const int r = wid * 32 + m * 16 + fr;
                    if (mt * 128 + r < ne) {
                        const f32x4 a1 = acc[m][0], a3 = acc[m][1], b1 = acc[m][2], b3 = acc[m][3];
                        gst_u4(H + (size_t)aidq[m] * 512 + nt * 64 + hf * 32 + fq * 8, cvt_pk(siluf_(a1[0]) * a3[0], siluf_(a1[1]) * a3[1]), cvt_pk(siluf_(a1[2]) * a3[2], siluf_(a1[3]) * a3[3]),
                               cvt_pk(siluf_(b1[0]) * b3[0], siluf_(b1[1]) * b3[1]), cvt_pk(siluf_(b1[2]) * b3[2], siluf_(b1[3]) * b3[3]));
                    }
                }
            } else {
                const bf16_t* wt = (const bf16_t*)(p.ws + W_MOE2) + ((size_t)(L * 32 + e) * 1024 + nt * 128 + hf * 64) * 512;
#pragma unroll
                for (int i = 0; i < 2; ++i) br[i] = wt + (size_t)perm64((t >> 3) + 32 * i) * 512 + co_;
                gemm_hn(lds, 8, ar, br, acc);
#pragma unroll
                for (int m = 0; m < 2; ++m) { const int r = wid * 32 + m * 16 + fr; aidq[m] = (mt * 128 + r < ne) ? le[r] : 0; }
#pragma unroll
                for (int m = 0; m < 2; ++m) {
                    const int r = wid * 32 + m * 16 + fr;
                    if (mt * 128 + r < ne) store16(Y + (size_t)aidq[m] * 1024 + nt * 128 + hf * 64 + fq * 16, acc[m]);
                }
            }
        }
    }
}

constexpr int NPHASE = 37;
#ifndef PHSEL
#define PHSEL -1
#endif
#ifndef PHEXC
#define PHEXC -2
#endif
#define PHON(x) ((PHSEL < 0 || PHSEL == (x)) && PHEXC != (x))
__global__ void __launch_bounds__(256, 2) mega(Params p_in) {
    PRef p = *(const CAS Params*)__builtin_amdgcn_kernarg_segment_ptr();
    extern __shared__ __attribute__((aligned(16))) char lds[];
    volatile LAS unsigned* xbw = (volatile LAS unsigned*)(lds + 73728);
    if (threadIdx.x == 0) { xbw[0] = 0u; xbw[1] = 0u; xbw[2] = 0u; xbw[3] = 0u; }
    __syncthreads();
    XcdBarrier bar;
    const bool multi = (p.ph_hi - p.ph_lo) > 1;
    (void)multi;
    if (multi) bar = xcd_barrier_post((unsigned*)(p.ws + OFF_CTL), xbw);
    char* S = p.ws + OFF_SLOT;
#ifdef DBG_STOP
    if (p.ph_lo == 100) {
        const float* src = (const float*)(p.ws + DBG_SRC);
        for (size_t i = (size_t)blockIdx.x * 256 + threadIdx.x; i < (size_t)NTOK * DM; i += (size_t)gridDim.x * 256) {
            float v = DBG_BF16 ? bf2f(((const bf16_t*)src)[i]) : src[i];
            if (!(fabsf(v) < 1e30f)) v = 1e30f;
            p.out[i] = v;
        }
        return;
    }
#endif
    const int ph_lo_ = p.ph_lo, ph_hi_ = p.ph_hi;
#ifdef TIMEIT
    unsigned long long t0_ = 0, t1_ = 0;
#endif
#ifdef DUP_PHASE
    bool dup_done_ = false;
#endif
    for (int ph = ph_lo_; ph < ph_hi_; ++ph) {
        const CAS Params* pp_ = (const CAS Params*)__builtin_amdgcn_kernarg_segment_ptr();
        asm volatile("" : "+s"(pp_));
        PRef p = *pp_;
#ifdef TIMEIT
        if (ph == TIME_A) t0_ = __builtin_amdgcn_s_memrealtime();
        if (ph == TIME_B) t1_ = __builtin_amdgcn_s_memrealtime();
#endif
        int L, sub, kind;
        if (ph < 2) { L = 0; sub = ph; kind = -1; }
        else if (ph < 11) { L = 0; kind = 0; sub = ph - 2; }
        else if (ph < 20) { L = 1; kind = 1; sub = ph - 11; }
        else if (ph < 28) { L = 2; kind = 2; sub = ph - 20; }
        else { L = 3; kind = 0; sub = ph - 28; }
        const int jr = L / 3;
        if (kind == -1) { if (sub == 0) { if (PHON(0)) phase_prologue(p, lds); } else { if (PHON(1)) phase_h0(p); } }
        else {
            const int ntail = (kind == 2) ? 4 : 5;
            if (sub < ntail) {
                if (kind == 0) {
                    if (sub == 0) { if (PHON(2)) phase_gemm_jobs(p, lds, jr * 7, jr * 7 + (jr ? 7 : 6)); }
                    else if (sub == 1) { if (PHON(3)) phase_rw2(p, jr); }
                    else if (sub == 2) { if (PHON(4)) {
#ifdef RW3_SCALAR
                        phase_rw3(p, jr, lds);
#else
                        phase_rw3c(p, jr, lds);
#endif
                    } }
                    else if (sub == 3) { if (PHON(5)) phase_zrw(p, jr); }
                    else { if (PHON(2)) phase_gemm_jobs(p, lds, 16 + jr, 17 + jr); }
                } else if (kind == 1) {
                    if (sub == 0) { if (PHON(2)) phase_gemm_jobs(p, lds, 14, 15); }
                    else if (sub == 1) { if (PHON(6)) phase_cml(p); }
                    else if (sub == 2) { if (PHON(6)) phase_ml2(p, lds); }
                    else if (sub == 3) { if (PHON(7)) phase_zml(p); }
                    else { if (PHON(2)) phase_gemm_jobs(p, lds, 18, 19); }
                } else {
                    if (sub == 0) { if (PHON(2)) phase_gemm_jobs(p, lds, 15, 16); }
                    else if (sub == 1) { if (PHON(8)) phase_rt2(p, lds); }
                    else if (sub == 2) { if (PHON(9)) phase_zrt(p); }
                    else { if (PHON(2)) phase_gemm_jobs(p, lds, 19, 20); }
                }
            } else {
                const int ts = sub - ntail;
                const bf16_t* ymix = (const bf16_t*)(S + (kind == 2 ? 1 : 6) * SLOT);
                bf16_t* hm = (bf16_t*)(S + (kind == 2 ? 2 : 7) * SLOT);
                bf16_t* H = (bf16_t*)(S + (kind == 0 ? 2 : (kind == 1 ? 5 : 3)) * SLOT);
                if (ts == 0) { if (PHON(10)) phase_ln1(p, L, lds, ymix, hm); }
                else if (ts == 1) { if (PHON(11)) phase_moe<0>(p, L, lds, hm, H); }
                else if (ts == 2) { if (PHON(12)) phase_moe<1>(p, L, lds, hm, H); }
                else { if (PHON(13)) phase_ln2(p, L); }
            }
        }
#ifdef DUP_PHASE
        if (((DUP_PHASE >> ph) & 1u) && !dup_done_) { dup_done_ = true; xcd_barrier(bar); --ph; continue; }
        dup_done_ = false;
#endif
        if (ph + 1 < ph_hi_) xcd_barrier(bar);
    }
#ifdef TIMEIT
    {
        xcd_barrier(bar);
        unsigned* tw = (unsigned*)(p.ws + OFF_CTL + 32768);
        if (blockIdx.x == 0 && threadIdx.x == 0) {
            if (t1_ == 0) t1_ = __builtin_amdgcn_s_memrealtime();
            const unsigned long long dt = t1_ - t0_;
            unsigned ms2 = (unsigned)((dt + TIME_U / 2) / TIME_U);
            __hip_atomic_store(tw, ms2, __ATOMIC_RELAXED, __HIP_MEMORY_SCOPE_AGENT);
        }
        xcd_barrier(bar);
        const float c_ = sqrtf((float)__hip_atomic_load(tw, __ATOMIC_RELAXED, __HIP_MEMORY_SCOPE_AGENT));
        for (size_t i = (size_t)blockIdx.x * 256 + threadIdx.x; i < (size_t)NTOK * DM; i += (size_t)gridDim.x * 256) p.out[i] = c_;
    }
#endif
#ifdef DBG_STOP
    if (ph_lo_ != 100) {
        xcd_barrier(bar);
        const float* src = (const float*)(p.ws + DBG_SRC);
        for (size_t i = (size_t)blockIdx.x * 256 + threadIdx.x; i < (size_t)NTOK * DM; i += (size_t)gridDim.x * 256) {
            float v = DBG_BF16 ? bf2f(((const bf16_t*)src)[i]) : src[i];
            if (!(fabsf(v) < 1e30f)) v = 1e30f;
            p.out[i] = v;
        }
    }
#endif
}

constexpr int LDS_BYTES = 73728 + 64;
extern "C" void kernel_launch(void* const* d_in, const int* in_sizes, int n_in, void* d_out, int out_size, void* d_ws, size_t ws_size, hipStream_t stream) {
    static int grid = 0;
    if (grid == 0) {
        if (n_in != 43 || out_size != NTOK * DM || ws_size < WS_NEED) { fprintf(stderr, "kernel_launch: unexpected shapes (n_in %d out %d ws %zu need %zu)\n", n_in, out_size, ws_size, (size_t)WS_NEED); }
        int dev = 0, cus = 0, per_cu = 0;
        (void)hipGetDevice(&dev); (void)hipDeviceGetAttribute(&cus, hipDeviceAttributeMultiprocessorCount, dev);
        (void)hipFuncSetAttribute((const void*)mega, hipFuncAttributeMaxDynamicSharedMemorySize, LDS_BYTES);
        (void)hipOccupancyMaxActiveBlocksPerMultiprocessor(&per_cu, (const void*)mega, 256, LDS_BYTES);
        if (per_cu > 2) per_cu = 2;
        if (per_cu < 1) per_cu = 1;
        grid = cus * per_cu;
        if (grid > 512) grid = 512;
        (void)hipGetLastError();
    }
    Params p{};
    for (int i = 0; i < 43; ++i) p.in[i] = (const float*)d_in[i];
    p.out = (float*)d_out; p.ws = (char*)d_ws;
    char* ws = (char*)d_ws;
    auto slot = [&](int i) { return (bf16_t*)(ws + OFF_SLOT + (size_t)i * SLOT); };
    int tile = 0;
    auto addg = [&](int idx, const bf16_t* A, const bf16_t* Bt, bf16_t* out, int K, int N, int ldo, int mode) {
        GJob& g = p.gj[idx]; g.A = A; g.Bt = Bt; g.out = out; g.K = K; g.N = N; g.ldo = ldo; g.mode = mode; g.half = (mode <= MODE_SIGM && N <= 128) ? 1 : 0; g.ntn = g.half ? (N + 63) / 64 : (N + 127) / 128; g.tile0 = tile; tile += 128 * g.ntn;
    };
    for (int jr = 0; jr < 2; ++jr) {
        const bf16_t* rkv = (const bf16_t*)(ws + W_RKV) + (size_t)jr * 3 * 1024 * 1024;
        addg(jr * 7 + 0, slot(0), rkv, slot(6), 1024, 1024, 1024, MODE_BF16);
        addg(jr * 7 + 1, slot(1), rkv + 1024 * 1024, slot(7), 1024, 1024, 1024, MODE_BF16);
        addg(jr * 7 + 2, slot(2), rkv + 2 * 1024 * 1024, slot(jr == 0 ? 11 : 8), 1024, 1024, 1024, MODE_BF16);
        addg(jr * 7 + 3, slot(3), (const bf16_t*)(ws + W_W1T) + (size_t)jr * 64 * 1024, (bf16_t*)(ws + OFF_LW), 1024, 64, 64, MODE_TANH);
        addg(jr * 7 + 4, slot(4), (const bf16_t*)(ws + W_A1T) + (size_t)jr * 64 * 1024, (bf16_t*)(ws + OFF_LA), 1024, 64, 64, MODE_BF16);
        addg(jr * 7 + 5, slot(5), (const bf16_t*)(ws + W_G1T) + (size_t)jr * 128 * 1024, (bf16_t*)(ws + OFF_LG), 1024, 128, 128, MODE_SIGM);
        addg(jr * 7 + 6, slot(2), (const bf16_t*)(ws + W_V1T), (bf16_t*)(ws + OFF_LV), 1024, 32, 32, MODE_BF16);
    }
    addg(14, slot(0), (const bf16_t*)(ws + W_MLIN), nullptr, 1024, 3088, 0, MODE_ML1);
    addg(15, slot(0), (const bf16_t*)(ws + W_RTIN), nullptr, 1024, 6144, 0, MODE_RT1);
    addg(16, slot(7), (const bf16_t*)(ws + W_OUT), slot(6), 1024, 1024, 1024, MODE_BF16);
    addg(17, slot(7), (const bf16_t*)(ws + W_OUT) + 1024 * 1024, slot(6), 1024, 1024, 1024, MODE_BF16);
    addg(18, slot(1), (const bf16_t*)(ws + W_MLOUT), slot(6), 1024, 1024, 1024, MODE_BF16);
    addg(19, slot(3), (const bf16_t*)(ws + W_RTOUT), slot(1), 2048, 1024, 1024, MODE_BF16);
    int nc = 0, ctile = 0;
    auto addc = [&](const float* src, size_t dst_off, int K, int N, int nb, long sbs, long dbs, int mode) {
        CJob& c = p.cj[nc++]; c.src = src; c.dst = (bf16_t*)(ws + dst_off); c.K = K; c.N = N; c.nb = nb; c.mode = mode; c.sbs = sbs; c.dbs = dbs;
        c.tiles_pb = ((K + 63) / 64) * ((N + 255) / 256); c.tile0 = ctile; ctile += c.tiles_pb * nb;
    };
    addc(p.in[7], W_RKV, 1024, 1024, 6, 1024 * 1024, 1024 * 1024, 0);
    addc(p.in[24], W_OUT, 1024, 1024, 2, 1024 * 1024, 1024 * 1024, 0);
    addc(p.in[9], W_W1T, 1024, 64, 2, 1024 * 64, 64 * 1024, 0);
    addc(p.in[12], W_A1T, 1024, 64, 2, 1024 * 64, 64 * 1024, 0);
    addc(p.in[17], W_G1T, 1024, 128, 2, 1024 * 128, 128 * 1024, 0);
    addc(p.in[15], W_V1T, 1024, 32, 1, 0, 0, 0);
    addc(p.in[10], W_W2T, 64, 1024, 2, 64 * 1024, 1024 * 64, 0);
    addc(p.in[13], W_A2T, 64, 1024, 2, 64 * 1024, 1024 * 64, 0);
    addc(p.in[18], W_G2T, 128, 1024, 2, 128 * 1024, 1024 * 128, 0);
    addc(p.in[16], W_V2T, 32, 1024, 1, 0, 0, 0);
    addc(p.in[25], W_MLIN, 1024, 3088, 1, 0, 0, 0);
    addc(p.in[31], W_MLOUT, 1024, 1024, 1, 0, 0, 0);
    addc(p.in[32], W_RTIN, 1024, 6144, 1, 0, 0, 3);
    addc(p.in[35], W_RTOUT, 2048, 1024, 1, 0, 0, 0);
    addc(p.in[40], W_MOE13, 1024, 512, 128, 1024 * 512, 1024 * 1024, 1);
    addc(p.in[41], W_MOE13, 1024, 512, 128, 1024 * 512, 1024 * 1024, 2);
    addc(p.in[42], W_MOE2, 512, 1024, 128, 512 * 1024, 1024 * 512, 0);
    p.ncj = nc; p.cj_tiles = ctile;

    (void)hipMemsetAsync(ws + OFF_CTL, 0, CTL_BYTES, stream);
#ifdef DBG_STOP
    const int nph = DBG_STOP;
#else
    const int nph = NPHASE;
#endif
#ifdef MULTI_LAUNCH
    for (int ph = 0; ph < nph; ++ph) { p.ph_lo = ph; p.ph_hi = ph + 1; hipLaunchKernelGGL(mega, dim3(grid), dim3(256), LDS_BYTES, stream, p); }
    if (0)
#endif
    {
        p.ph_lo = 0; p.ph_hi = nph;
        void* args[] = {&p};
        hipError_t e = hipLaunchCooperativeKernel((const void*)mega, dim3(grid), dim3(256), args, LDS_BYTES, stream);
        if (e != hipSuccess) fprintf(stderr, "cooperative launch failed: %s (grid %d)\n", hipGetErrorString(e), grid);
    }
}
```

```cpp
#include <hip/hip_runtime.h>
#include <cstdio>
#include <cstdint>

#ifndef ONE_LAUNCH
#define ONE_LAUNCH 0
#endif

typedef unsigned short bf16_t;
typedef short bf16x8 __attribute__((ext_vector_type(8)));
typedef float f32x4 __attribute__((ext_vector_type(4)));
#define LAS __attribute__((address_space(3)))
#define GAS __attribute__((address_space(1)))
typedef float f32x4g_t __attribute__((ext_vector_type(4)));
typedef unsigned u32x2g_t __attribute__((ext_vector_type(2)));
typedef unsigned u32x4g_t __attribute__((ext_vector_type(4)));
__device__ __forceinline__ float4 gld_f4(const float* p) { const f32x4g_t v = *(const GAS f32x4g_t*)(const GAS char*)(const char*)p; return make_float4(v[0], v[1], v[2], v[3]); }
__device__ __forceinline__ uint2 gld_u2(const void* p) { const u32x2g_t v = *(const GAS u32x2g_t*)(const GAS char*)(const char*)p; return make_uint2(v[0], v[1]); }
__device__ __forceinline__ uint4 gld_u4(const void* p) { const u32x4g_t v = *(const GAS u32x4g_t*)(const GAS char*)(const char*)p; return make_uint4(v[0], v[1], v[2], v[3]); }
__device__ __forceinline__ void gst_f4(float* p, float a, float b, float c, float d) { const f32x4g_t v = {a, b, c, d}; *(GAS f32x4g_t*)(GAS char*)(char*)p = v; }
__device__ __forceinline__ void gst_u2(void* p, unsigned a, unsigned b) { const u32x2g_t v = {a, b}; *(GAS u32x2g_t*)(GAS char*)(char*)p = v; }
__device__ __forceinline__ void gst_u4(void* p, unsigned a, unsigned b, unsigned c, unsigned d) { const u32x4g_t v = {a, b, c, d}; *(GAS u32x4g_t*)(GAS char*)(char*)p = v; }

constexpr int NTOK = 16384, DM = 1024, TSEQ = 2048, NBATCH = 8;
constexpr float DN_ALPHA = 1.681792830507429f;
constexpr float LN_EPS = 1e-5f;
constexpr size_t MB = 1u << 20;
constexpr size_t OFF_CTL = 0, OFF_CNT = 16384, CTL_BYTES = 65536;
constexpr size_t OFF_MOD = 65536;
constexpr size_t OFF_ROT = 1 * MB;
constexpr size_t OFF_BONUS = 3 * MB, OFF_GATES = 4 * MB, OFF_STAT = 5 * MB, OFF_LW = 13 * MB, OFF_LA = 15 * MB, OFF_LG = 17 * MB, OFF_LV = 21 * MB,
                 OFF_WGT = 22 * MB, OFF_LIST = 23 * MB, OFF_RTW = 25 * MB;
constexpr size_t OFF_W = 32 * MB;
constexpr size_t W_RKV = OFF_W, W_OUT = W_RKV + 12 * MB, W_W1T = W_OUT + 4 * MB, W_A1T = W_W1T + 256 * 1024, W_G1T = W_A1T + 256 * 1024, W_V1T = W_G1T + 512 * 1024,
                 W_W2T = W_V1T + 64 * 1024, W_A2T = W_W2T + 256 * 1024, W_G2T = W_A2T + 256 * 1024, W_V2T = W_G2T + 512 * 1024, W_MLIN = W_V2T + 64 * 1024 + 832 * 1024,
                 W_MLOUT = W_MLIN + 6400 * 1024, W_RTIN = W_MLOUT + 2 * MB, W_RTOUT = W_RTIN + 12 * MB, W_MOE13 = W_RTOUT + 4 * MB, W_MOE2 = W_MOE13 + 256 * MB,
                 W_END = W_MOE2 + 128 * MB;
constexpr size_t OFF_XRES = 464 * MB;
constexpr size_t OFF_SLOT = 528 * MB, SLOT = 32 * MB;
static_assert(W_END <= OFF_XRES, "weights overflow");
constexpr size_t OFF_XRES2 = OFF_SLOT + 12 * SLOT;
constexpr size_t WS_NEED = OFF_XRES2 + 2 * SLOT;
constexpr int LIST_CAP = 16384;

#define XB_TMO      128
#define XB_XCNT(j)  (256  + 64 * (j))
#define XB_XSUB(j)  (1280 + 64 * (j))
#define XB_XGEN(j)  (2304 + 64 * (j))
#define XB_TOP      3328
#define XB_TOPGEN   3392
#define XCD_BAR_WORDS 3456
#define XB_SPIN_CAP (1u << 22)
__device__ __forceinline__ unsigned xb_ld(unsigned* p)              { return __hip_atomic_load(p, __ATOMIC_RELAXED, __HIP_MEMORY_SCOPE_AGENT); }
__device__ __forceinline__ unsigned xb_add(unsigned* p, unsigned v) { return __hip_atomic_fetch_add(p, v, __ATOMIC_RELAXED, __HIP_MEMORY_SCOPE_AGENT); }
__device__ __forceinline__ unsigned xb_xcc_id() { return (unsigned)__builtin_amdgcn_s_getreg((3 << 11) | 20) & 0xFu; }
#define XB_SPIN(cond, bar) do { unsigned _sp = 0; while (cond) { __builtin_amdgcn_s_sleep(1); \
    if ((++_sp & 255u) == 0u) { if (xb_ld(&(bar)[XB_TMO])) break; if (_sp > XB_SPIN_CAP) { atomicAdd(&(bar)[XB_TMO], 1u); break; } } } } while (0)
struct XcdBarrier { unsigned* bar; unsigned x; volatile LAS unsigned* st; };
__device__ __forceinline__ XcdBarrier xcd_barrier_post(unsigned* bar, volatile LAS unsigned* st) {
    XcdBarrier b; b.bar = bar; b.x = xb_xcc_id(); b.st = st;
    if (threadIdx.x == 0) (void)xb_add(&bar[XB_XCNT(b.x)], 1u);
    return b;
}
__device__ __forceinline__ void xcd_barrier_complete(unsigned* bar, unsigned x, unsigned& nloc, unsigned& nx) {
    const unsigned G = gridDim.x;
    unsigned sum, cnt, mine, sp = 0u;
    for (;;) {
        sum = 0u; cnt = 0u; mine = 0u;
#pragma unroll
        for (unsigned j = 0; j < 16; ++j) { const unsigned c = xb_ld(&bar[XB_XCNT(j)]); sum += c; cnt += (c > 0u) ? 1u : 0u; mine = (j == x) ? c : mine; }
        if (sum == G) break;
        __builtin_amdgcn_s_sleep(1);
        if ((++sp & 255u) == 0u) { if (xb_ld(&bar[XB_TMO])) break; if (sp > XB_SPIN_CAP) { atomicAdd(&bar[XB_TMO], 1u); break; } }
    }
    nloc = mine > 0u ? mine : 1u; nx = cnt > 0u ? cnt : 1u;
}
__device__ __forceinline__ void xcd_barrier(const XcdBarrier& b) {
    asm volatile("s_waitcnt vmcnt(0)" ::: "memory");
    __syncthreads();
    if (threadIdx.x == 0) {
        unsigned* bar = b.bar;
        __builtin_amdgcn_s_waitcnt(0);
        unsigned nloc = b.st[0], nx = b.st[1];
        if (nloc == 0u) { xcd_barrier_complete(bar, b.x, nloc, nx); b.st[0] = nloc; b.st[1] = nx; }
        const unsigned old = xb_add(&bar[XB_XSUB(b.x)], 1u);
        const unsigned gen = old / nloc;
        if (old + 1u == (gen + 1u) * nloc) {
            __builtin_amdgcn_fence(__ATOMIC_RELEASE, "agent");
            asm volatile("s_waitcnt vmcnt(0)" ::: "memory");
            const unsigned og = xb_add(&bar[XB_TOP], 1u);
            const unsigned tg = og / nx;
            if (og + 1u == (tg + 1u) * nx) xb_add(&bar[XB_TOPGEN], 1u);
            else XB_SPIN(xb_ld(&bar[XB_TOPGEN]) == tg, bar);
            __builtin_amdgcn_fence(__ATOMIC_ACQUIRE, "agent");
            xb_add(&bar[XB_XGEN(b.x)], 1u);
            asm volatile("s_waitcnt vmcnt(0)" ::: "memory");
        } else {
            XB_SPIN(xb_ld(&bar[XB_XGEN(b.x)]) == gen, bar);
            __builtin_amdgcn_fence(__ATOMIC_ACQUIRE, "agent");
            asm volatile("s_waitcnt vmcnt(0)" ::: "memory");
        }
    }
    __syncthreads();
}

__device__ __forceinline__ int tidx() { int t = threadIdx.x; asm volatile("" : "+v"(t)); return t; }
typedef __bf16 bf16x2_t __attribute__((ext_vector_type(2)));
typedef float f32x2_t __attribute__((ext_vector_type(2)));
__device__ __forceinline__ unsigned cvt_pk(float lo, float hi) {
    f32x2_t v = {lo, hi}; bf16x2_t r = __builtin_convertvector(v, bf16x2_t);
    unsigned u; __builtin_memcpy(&u, &r, 4); return u;
}
__device__ __forceinline__ bf16_t f2bf(float f) { return (bf16_t)(cvt_pk(f, 0.f) & 0xffffu); }
__device__ __forceinline__ float bflo(unsigned u) { return __uint_as_float(u << 16); }
__device__ __forceinline__ float bfhi(unsigned u) { return __uint_as_float(u & 0xffff0000u); }
__device__ __forceinline__ float bf2f(bf16_t u) { return __uint_as_float(((unsigned)u) << 16); }
__device__ __forceinline__ void unpack8(const uint4& u, float (&f)[8]) {
    f[0] = bflo(u.x); f[1] = bfhi(u.x); f[2] = bflo(u.y); f[3] = bfhi(u.y); f[4] = bflo(u.z); f[5] = bfhi(u.z); f[6] = bflo(u.w); f[7] = bfhi(u.w);
}
__device__ __forceinline__ uint4 pack8(const float (&f)[8]) { uint4 u; u.x = cvt_pk(f[0], f[1]); u.y = cvt_pk(f[2], f[3]); u.z = cvt_pk(f[4], f[5]); u.w = cvt_pk(f[6], f[7]); return u; }
typedef unsigned u32x4_t __attribute__((ext_vector_type(4)));
__device__ __forceinline__ uint4 gload16(const void* p) {
    const u32x4_t v = *(const __attribute__((address_space(1))) u32x4_t*)p;
    return make_uint4(v[0], v[1], v[2], v[3]);
}
__device__ __forceinline__ float sigmoidf_(float x) { return __builtin_amdgcn_rcpf(1.0f + __expf(-x)); }
__device__ __forceinline__ float siluf_(float x) { return x * __builtin_amdgcn_rcpf(1.0f + __expf(-x)); }
__device__ __forceinline__ float tanhf_(float x) { return 1.0f - 2.0f * __builtin_amdgcn_rcpf(1.0f + __expf(2.0f * x)); }
__device__ __forceinline__ float softplusf_(float x) { return fmaxf(x, 0.f) + __logf(1.0f + __expf(-fabsf(x))); }
__device__ __forceinline__ float row16_sum(float v);
__device__ __forceinline__ float wave_sum(float v) {
    v = row16_sum(v); v += __shfl_xor(v, 16); v += __shfl_xor(v, 32);
    return v;
}
__device__ __forceinline__ float row16_sum(float v) {
    v += __builtin_amdgcn_update_dpp(0.f, v, 0x128, 0xf, 0xf, false);
    v += __builtin_amdgcn_update_dpp(0.f, v, 0x124, 0xf, 0xf, false);
    v += __builtin_amdgcn_update_dpp(0.f, v, 0x122, 0xf, 0xf, false);
    v += __builtin_amdgcn_update_dpp(0.f, v, 0x121, 0xf, 0xf, false);
    return v;
}
__device__ __forceinline__ float oct_sum(float v) {
    v += __builtin_amdgcn_update_dpp(0.f, v, 0xB1, 0xf, 0xf, false);
    v += __builtin_amdgcn_update_dpp(0.f, v, 0x4E, 0xf, 0xf, false);
    v += __builtin_amdgcn_update_dpp(0.f, v, 0x141, 0xf, 0xf, false);
    return v;
}

enum { MODE_BF16 = 0, MODE_TANH = 1, MODE_SIGM = 2, MODE_ML1 = 3, MODE_RT1 = 4 };
struct GJob { const bf16_t* A; const bf16_t* Bt; bf16_t* out; int K, N, ldo, mode, ntn, tile0, half; };
struct CJob { const float* src; bf16_t* dst; int K, N, nb, mode; long sbs, dbs; int tiles_pb, tile0; };
constexpr int NGJ = 20, NCJ = 24;
struct Params {
    const float* in[43]; float* out; char* ws;
    int ph_lo, ph_hi, ncj, cj_tiles;
    GJob gj[NGJ];
    CJob cj[NCJ];
};
#define CAS __attribute__((address_space(4)))
typedef const CAS Params& PRef;

__device__ __forceinline__ f32x4 mfma16(const uint4& a, const uint4& b, f32x4 c) {
    bf16x8 av, bv; __builtin_memcpy(&av, &a, 16); __builtin_memcpy(&bv, &b, 16);
    return __builtin_amdgcn_mfma_f32_16x16x32_bf16(av, bv, c, 0, 0, 0);
}
template <bool PFA = true, class AL, class BL>
__device__ __forceinline__ void gemm_mainloop(char* lds, int nk, const AL& al, const BL& bl, f32x4 (&acc)[4][4]) {
    const int t = tidx(), c = t & 7, r0 = t >> 3;
    const int lane = t & 63, wid = t >> 6, wr = wid >> 1, wc = wid & 1, fr = lane & 15, fq = lane >> 4;
    typename AL::Raw ra[4]; typename BL::Raw rb[4];
    const int woff = r0 * 128 + ((c ^ (r0 & 7)) << 4);
#pragma unroll
    for (int i = 0; i < 4; ++i) { if (PFA) ra[i] = al.fetch(i, r0 + 32 * i, c); rb[i] = bl.fetch(i, r0 + 32 * i, c); }
#pragma unroll
    for (int i = 0; i < 4; ++i) {
        if (!PFA) { ra[i] = al.fetch(i, r0 + 32 * i, c); }
        *(uint4*)(lds + woff + i * 4096) = al.finish(ra[i], i, r0 + 32 * i, c);
        *(uint4*)(lds + 16384 + woff + i * 4096) = bl.finish(rb[i], i, r0 + 32 * i, c);
        if (!PFA) asm volatile("" ::: "memory");
    }
#pragma unroll
    for (int m = 0; m < 4; ++m)
#pragma unroll
        for (int n = 0; n < 4; ++n) acc[m][n] = (f32x4){0.f, 0.f, 0.f, 0.f};
    __syncthreads();
    const int aoff = (wr * 64 + fr) * 128, boff = 16384 + (wc * 64 + fr) * 128, sw = fr & 7;
    for (int kt = 0; kt < nk; ++kt) {
        const bool more = (kt + 1 < nk);
        if (more) {
#pragma unroll
            for (int i = 0; i < 4; ++i) { if (PFA) ra[i] = al.fetch(i, r0 + 32 * i, (kt + 1) * 8 + c); rb[i] = bl.fetch(i, r0 + 32 * i, (kt + 1) * 8 + c); }
        }
        const char* buf = lds + (kt & 1) * 32768;
#pragma unroll
        for (int ks = 0; ks < 2; ++ks) {
            uint4 af[4], bfm[4];
            const int ch = ((ks * 4 + fq) ^ sw) << 4;
#pragma unroll
            for (int m = 0; m < 4; ++m) af[m] = *(const uint4*)(buf + aoff + m * 2048 + ch);
#pragma unroll
            for (int n = 0; n < 4; ++n) bfm[n] = *(const uint4*)(buf + boff + n * 2048 + ch);
#pragma unroll
            for (int m = 0; m < 4; ++m)
#pragma unroll
                for (int n = 0; n < 4; ++n) acc[m][n] = mfma16(bfm[n], af[m], acc[m][n]);
        }
        if (more) {
            char* nb = lds + ((kt + 1) & 1) * 32768;
#pragma unroll
            for (int i = 0; i < 4; ++i) {
                if (!PFA) ra[i] = al.fetch(i, r0 + 32 * i, (kt + 1) * 8 + c);
                *(uint4*)(nb + woff + i * 4096) = al.finish(ra[i], i, r0 + 32 * i, (kt + 1) * 8 + c);
                *(uint4*)(nb + 16384 + woff + i * 4096) = bl.finish(rb[i], i, r0 + 32 * i, (kt + 1) * 8 + c);
                if (!PFA) asm volatile("" ::: "memory");
            }
        }
        __syncthreads();
    }
}
__device__ __forceinline__ void glds16(const bf16_t* g, char* l) {
    __builtin_amdgcn_global_load_lds((const unsigned*)g, (LAS unsigned*)l, 16, 0, 0);
}
__device__ __forceinline__ void glds16_asm(const void* gsrc, unsigned lds_dst) {
    unsigned keep;
    asm volatile("s_mov_b32 %0, m0\n\ts_mov_b32 m0, %2\n\ts_nop 0\n\tglobal_load_lds_dwordx4 %1, off\n\ts_mov_b32 m0, %0" : "=&s"(keep) : "v"(gsrc), "s"(lds_dst) : "memory");
}
__device__ __forceinline__ unsigned lds_addr_u(const char* l) { return (unsigned)(size_t)(const LAS char*)l; }
__device__ __forceinline__ int glds_chunk(int t) { return (t & 7) ^ ((t >> 3) & 7); }
__device__ __forceinline__ void mma_ktile(const char* buf, int aoff, int boff, int sw, int fq, f32x4 (&acc)[4][4]) {
    const int ch0 = ((0 * 4 + fq) ^ sw) << 4, ch1 = ((1 * 4 + fq) ^ sw) << 4;
    const char* pa = buf + aoff; const char* pb = buf + boff;
    uint4 a0[4], a1[4], b[8];
#pragma unroll
    for (int m = 0; m < 4; ++m) a0[m] = *(const uint4*)(pa + m * 2048 + ch0);
    b[0] = *(const uint4*)(pb + ch0); b[1] = *(const uint4*)(pb + 2048 + ch0);
    __builtin_amdgcn_sched_barrier(0);
    b[2] = *(const uint4*)(pb + 2 * 2048 + ch0);
#pragma unroll
    for (int m = 0; m < 4; ++m) acc[m][0] = mfma16(b[0], a0[m], acc[m][0]);
    __builtin_amdgcn_sched_barrier(0);
    b[3] = *(const uint4*)(pb + 3 * 2048 + ch0);
#pragma unroll
    for (int m = 0; m < 4; ++m) acc[m][1] = mfma16(b[1], a0[m], acc[m][1]);
    __builtin_amdgcn_sched_barrier(0);
#pragma unroll
    for (int m = 0; m < 4; ++m) a1[m] = *(const uint4*)(pa + m * 2048 + ch1);
#pragma unroll
    for (int m = 0; m < 4; ++m) acc[m][2] = mfma16(b[2], a0[m], acc[m][2]);
    __builtin_amdgcn_sched_barrier(0);
    b[4] = *(const uint4*)(pb + ch1); b[5] = *(const uint4*)(pb + 2048 + ch1);
#pragma unroll
    for (int m = 0; m < 4; ++m) acc[m][3] = mfma16(b[3], a0[m], acc[m][3]);
    __builtin_amdgcn_sched_barrier(0);
    b[6] = *(const uint4*)(pb + 2 * 2048 + ch1);
#pragma unroll
    for (int m = 0; m < 4; ++m) acc[m][0] = mfma16(b[4], a1[m], acc[m][0]);
    __builtin_amdgcn_sched_barrier(0);
    b[7] = *(const uint4*)(pb + 3 * 2048 + ch1);
#pragma unroll
    for (int m = 0; m < 4; ++m) acc[m][1] = mfma16(b[5], a1[m], acc[m][1]);
    __builtin_amdgcn_sched_barrier(0);
#pragma unroll
    for (int m = 0; m < 4; ++m) acc[m][2] = mfma16(b[6], a1[m], acc[m][2]);
#pragma unroll
    for (int m = 0; m < 4; ++m) acc[m][3] = mfma16(b[7], a1[m], acc[m][3]);
}
__device__ __forceinline__ void gemm_gg(char* lds, int nk, const bf16_t* const (&ar)[4], const bf16_t* const (&br)[4], f32x4 (&acc)[4][4]) {
    const int t = tidx();
    const int lane = t & 63, wid = t >> 6, wr = wid >> 1, wc = wid & 1, fr = lane & 15, fq = lane >> 4;
    const unsigned wbs = (unsigned)__builtin_amdgcn_readfirstlane((int)(lds_addr_u(lds) + wid * 1024));
#pragma unroll
    for (int i = 0; i < 4; ++i) { glds16_asm(ar[i], wbs + i * 4096); glds16_asm(br[i], wbs + 16384 + i * 4096); }
#pragma unroll
    for (int m = 0; m < 4; ++m)
#pragma unroll
        for (int n = 0; n < 4; ++n) acc[m][n] = (f32x4){0.f, 0.f, 0.f, 0.f};
    asm volatile("s_waitcnt vmcnt(0)" ::: "memory");
    __syncthreads();
    const int aoff = (wr * 64 + fr) * 128, boff = 16384 + (wc * 64 + fr) * 128, sw = fr & 7;
    for (int kt = 0; kt < nk; ++kt) {
        if (kt + 1 < nk) {
            const unsigned nb = (unsigned)__builtin_amdgcn_readfirstlane((int)(wbs + ((kt + 1) & 1) * 32768));
#pragma unroll
            for (int i = 0; i < 4; ++i) { glds16_asm(ar[i] + (kt + 1) * 64, nb + i * 4096); glds16_asm(br[i] + (kt + 1) * 64, nb + 16384 + i * 4096); }
        }
        mma_ktile(lds + (kt & 1) * 32768, aoff, boff, sw, fq, acc);
        asm volatile("s_waitcnt vmcnt(0)" ::: "memory");
        __syncthreads();
    }
}
__device__ __forceinline__ void gemm_hn(char* lds, int nk, const bf16_t* const (&ar)[4], const bf16_t* const (&br)[2], f32x4 (&acc)[2][4]) {
    const int t = tidx();
    const int lane = t & 63, wid = t >> 6, fr = lane & 15, fq = lane >> 4;
    const unsigned wbs = (unsigned)__builtin_amdgcn_readfirstlane((int)(lds_addr_u(lds) + wid * 1024));
#pragma unroll
    for (int i = 0; i < 4; ++i) glds16_asm(ar[i], wbs + i * 4096);
#pragma unroll
    for (int i = 0; i < 2; ++i) glds16_asm(br[i], wbs + 16384 + i * 4096);
#pragma unroll
    for (int m = 0; m < 2; ++m)
#pragma unroll
        for (int n = 0; n < 4; ++n) acc[m][n] = (f32x4){0.f, 0.f, 0.f, 0.f};
    asm volatile("s_waitcnt vmcnt(0)" ::: "memory");
    __syncthreads();
    const int aoff = (wid * 32 + fr) * 128, boff = 16384 + fr * 128, sw = fr & 7;
    for (int kt = 0; kt < nk; ++kt) {
        if (kt + 1 < nk) {
            const unsigned nb = (unsigned)__builtin_amdgcn_readfirstlane((int)(wbs + ((kt + 1) & 1) * 32768));
#pragma unroll
            for (int i = 0; i < 4; ++i) glds16_asm(ar[i] + (kt + 1) * 64, nb + i * 4096);
#pragma unroll
            for (int i = 0; i < 2; ++i) glds16_asm(br[i] + (kt + 1) * 64, nb + 16384 + i * 4096);
        }
        const char* buf = lds + (kt & 1) * 32768;
#pragma unroll
        for (int ks = 0; ks < 2; ++ks) {
            const int ch = ((ks * 4 + fq) ^ sw) << 4;
            uint4 af[2], bfm[4];
#pragma unroll
            for (int m = 0; m < 2; ++m) af[m] = *(const uint4*)(buf + aoff + m * 2048 + ch);
#pragma unroll
            for (int n = 0; n < 4; ++n) bfm[n] = *(const uint4*)(buf + boff + n * 2048 + ch);
#pragma unroll
            for (int m = 0; m < 2; ++m)
#pragma unroll
                for (int n = 0; n < 4; ++n) acc[m][n] = mfma16(bfm[n], af[m], acc[m][n]);
        }
        asm volatile("s_waitcnt vmcnt(0)" ::: "memory");
        __syncthreads();
    }
}
template <class AL>
__device__ __forceinline__ void gemm_rg(char* lds, int nk, const AL& al, const bf16_t* const (&br)[4], f32x4 (&acc)[4][4]) {
    const int t = tidx(), c = t & 7, r0 = t >> 3;
    const int lane = t & 63, wid = t >> 6, wr = wid >> 1, wc = wid & 1, fr = lane & 15, fq = lane >> 4;
    char* wb = lds + wid * 1024;
    const int woff = r0 * 128 + ((c ^ (r0 & 7)) << 4);
#pragma unroll
    for (int i = 0; i < 4; ++i) glds16(br[i], wb + 16384 + i * 4096);
#pragma unroll
    for (int i = 0; i < 4; ++i) {
        typename AL::Raw ra = al.fetch(i, r0 + 32 * i, c);
        *(uint4*)(lds + woff + i * 4096) = al.finish(ra, i, r0 + 32 * i, c);
        asm volatile("" ::: "memory");
    }
#pragma unroll
    for (int m = 0; m < 4; ++m)
#pragma unroll
        for (int n = 0; n < 4; ++n) acc[m][n] = (f32x4){0.f, 0.f, 0.f, 0.f};
    asm volatile("s_waitcnt vmcnt(0)" ::: "memory");
    __syncthreads();
    const int aoff = (wr * 64 + fr) * 128, boff = 16384 + (wc * 64 + fr) * 128, sw = fr & 7;
    for (int kt = 0; kt < nk; ++kt) {
        const bool more = (kt + 1 < nk);
        char* nbuf = lds + ((kt + 1) & 1) * 32768;
        if (more) {
#pragma unroll
            for (int i = 0; i < 4; ++i) glds16(br[i] + (kt + 1) * 64, nbuf + wid * 1024 + 16384 + i * 4096);
        }
        mma_ktile(lds + (kt & 1) * 32768, aoff, boff, sw, fq, acc);
        if (more) {
#pragma unroll
            for (int i = 0; i < 4; ++i) {
                typename AL::Raw ra = al.fetch(i, r0 + 32 * i, (kt + 1) * 8 + c);
                *(uint4*)(nbuf + woff + i * 4096) = al.finish(ra, i, r0 + 32 * i, (kt + 1) * 8 + c);
                asm volatile("" ::: "memory");
            }
        }
        asm volatile("s_waitcnt vmcnt(0)" ::: "memory");
        __syncthreads();
    }
}
struct LdPlain {
    typedef uint4 Raw;
    const bf16_t* p; int ld; int nvalid;
    __device__ __forceinline__ uint4 fetch(int, int r, int kc) const { return (r < nvalid) ? *(const uint4*)(p + (size_t)r * ld + kc * 8) : make_uint4(0u, 0u, 0u, 0u); }
    __device__ __forceinline__ uint4 finish(const uint4& v, int, int, int) const { return v; }
};
struct LdGather {
    typedef uint4 Raw;
    const bf16_t* rp[4];
    __device__ __forceinline__ uint4 fetch(int i, int, int kc) const { const bf16_t* q = rp[i]; return q ? *(const uint4*)(q + kc * 8) : make_uint4(0u, 0u, 0u, 0u); }
    __device__ __forceinline__ uint4 finish(const uint4& v, int, int, int) const { return v; }
};
__device__ __forceinline__ void tile_map(int id, int NT, int& mt, int& nt) {
    const int x = id & 7, q = id >> 3;
    const int mg = q / (8 * NT), q2 = q - mg * 8 * NT, G = (NT + 7) >> 3;
    int g = q2 >> 6; g = g < G - 1 ? g : G - 1;
    const int r = q2 - (g << 6), w = (g == G - 1) ? NT - 8 * g : 8;
    mt = (mg * 8 + r / w) * 8 + x; nt = 8 * g + r % w;
}

__device__ __forceinline__ int conv_row(int mode, int n) {
    if (mode == 1) return (n >> 4) * 32 + (n & 15);
    if (mode == 2) return (n >> 4) * 32 + 16 + (n & 15);
    if (mode == 3 && n < 2048) { const int c = n & 255, c2 = c & 127; return (n & ~255) + (c2 >> 4) * 32 + ((c >> 7) << 4) + (c2 & 15); }
    return n;
}
__device__ __forceinline__ void phase_prologue(PRef p, char* lds) {
    const int t = tidx();
    const int n_ada = 8 * 48, n_rot = 256 + 144;
    float* mod = (float*)(p.ws + OFF_MOD);
    for (int it = blockIdx.x; it < n_ada + n_rot; it += gridDim.x) {
        if (it < n_ada) {
            const int pr = it / 48, cb = it % 48;
            float* sc = (float*)lds;
            float* red = (float*)(lds + 32768);
            for (int i = t; i < 8192; i += 256) { const int b = i >> 10, k = i & 1023; sc[k * 8 + b] = siluf_(p.in[1][b * 1024 + k]); }
            __syncthreads();
            const int kg = t >> 6, cl = t & 63, col = cb * 64 + cl;
            const float* W = p.in[2] + (size_t)pr * 1024 * 3072 + col;
            float a[8] = {0, 0, 0, 0, 0, 0, 0, 0};
#pragma unroll 8
            for (int k = kg * 256; k < kg * 256 + 256; ++k) {
                const float w = W[(size_t)k * 3072];
                const float4 s0 = *(const float4*)(sc + k * 8), s1 = *(const float4*)(sc + k * 8 + 4);
                a[0] += w * s0.x; a[1] += w * s0.y; a[2] += w * s0.z; a[3] += w * s0.w; a[4] += w * s1.x; a[5] += w * s1.y; a[6] += w * s1.z; a[7] += w * s1.w;
            }
#pragma unroll
            for (int b = 0; b < 8; ++b) red[(kg * 8 + b) * 64 + cl] = a[b];
            __syncthreads();
            for (int i = t; i < 512; i += 256) {
                const int b = i >> 6, c2 = i & 63;
                const float s = red[(0 * 8 + b) * 64 + c2] + red[(1 * 8 + b) * 64 + c2] + red[(2 * 8 + b) * 64 + c2] + red[(3 * 8 + b) * 64 + c2];
                mod[((size_t)pr * 8 + b) * 3072 + cb * 64 + c2] = s + p.in[3][pr * 3072 + cb * 64 + c2];
            }
            __syncthreads();
        } else if (it >= n_ada + 256 && it < n_ada + n_rot) {
            float* rtw = (float*)(p.ws + OFF_RTW);
            const int base = (it - n_ada - 256) * 1024;
            for (int e = base + t; e < base + 1024; e += 256) {
                const int L = e / (36 * 1024), o = (e >> 10) % 36, k = e & 1023;
                rtw[e] = (o < 4) ? p.in[36][((size_t)L * 1024 + k) * 4 + o] : p.in[38][((size_t)L * 1024 + k) * 32 + (o - 4)];
            }
        } else if (it < n_ada + 256) {
            float* rot = (float*)(p.ws + OFF_ROT);
            const int base = (it - n_ada) * 1024;
            for (int e = base + t; e < base + 1024; e += 256) {
                const int tt = e >> 7, i = e & 127;
                const float inv = __builtin_amdgcn_exp2f(-(float)i * (13.287712379549449f / 127.0f));
                const float ang = (float)tt * inv;
                float rev = ang * 0.15915494309189535f; rev -= floorf(rev);
                rot[e * 2] = __builtin_amdgcn_cosf(rev); rot[e * 2 + 1] = __builtin_amdgcn_sinf(rev);
            }
        }
    }
    {
        float* sm = (float*)lds;
        const int lane = t & 63, wv = t >> 6;
        const float* nsrc = nullptr; bf16_t* ndst = nullptr; int nK = 0, nN = 0, nmode = 0, nkt = 0, nnt = 0;
        float4 pv[16];
#define CJ_SETUP(ct_) { int c_ = (ct_), j_ = 0; while (j_ + 1 < p.ncj && c_ >= p.cj[j_ + 1].tile0) ++j_; \
            c_ -= p.cj[j_].tile0; const int tpb_ = p.cj[j_].tiles_pb; const int bi_ = c_ / tpb_, tl_ = c_ % tpb_; nK = p.cj[j_].K; nN = p.cj[j_].N; nmode = p.cj[j_].mode; \
            const int nNt_ = (nN + 255) >> 8; nkt = tl_ / nNt_; nnt = tl_ % nNt_; nsrc = p.cj[j_].src + (size_t)bi_ * p.cj[j_].sbs; ndst = p.cj[j_].dst + (size_t)bi_ * p.cj[j_].dbs; }
#define CJ_LOAD() { _Pragma("unroll") for (int i = 0; i < 16; ++i) { const int k = nkt * 64 + wv + 4 * i, n = nnt * 256 + lane * 4; \
            pv[i] = (k < nK && n < nN) ? gld_f4(nsrc + (size_t)k * nN + n) : make_float4(0.f, 0.f, 0.f, 0.f); } }
        int* const tick = (int*)(p.ws + OFF_CTL + 20480);
        int* const nbox = (int*)(lds + 66560);
        int ct = (int)blockIdx.x, ct2 = (int)gridDim.x + (int)blockIdx.x;
        if (ct < p.cj_tiles) { CJ_SETUP(ct); CJ_LOAD(); }
        while (ct < p.cj_tiles) {
#pragma unroll
            for (int i = 0; i < 16; ++i) *(float4*)(sm + (wv + 4 * i) * 260 + lane * 4) = pv[i];
            bf16_t* const sdst = ndst; const int sK = nK, sN = nN, smode = nmode, skt = nkt, snt = nnt;
            if (ct2 < p.cj_tiles) { CJ_SETUP(ct2); CJ_LOAD(); }
            if (t == 0) *nbox = 2 * (int)gridDim.x + atomicAdd(tick, 1);
            __syncthreads();
            const int ct3 = *nbox;
#pragma unroll
            for (int h2 = 0; h2 < 4; ++h2) {
                const int nl = lane + 64 * h2, n = snt * 256 + nl, k0 = skt * 64 + wv * 16;
                if (n < sN && k0 < sK) {
                    float f[8], g[8];
#pragma unroll
                    for (int q = 0; q < 8; ++q) { f[q] = sm[(wv * 16 + q) * 260 + nl]; g[q] = sm[(wv * 16 + 8 + q) * 260 + nl]; }
                    bf16_t* d = sdst + (size_t)conv_row(smode, n) * sK + k0;
                    { const uint4 u0 = pack8(f), u1 = pack8(g); gst_u4(d, u0.x, u0.y, u0.z, u0.w); gst_u4(d + 8, u1.x, u1.y, u1.z, u1.w); }
                }
            }
            __syncthreads();
            ct = ct2; ct2 = ct3;
        }
#undef CJ_SETUP
#undef CJ_LOAD
    }
}

__device__ __forceinline__ void row_load_f32(const float* p, float (&v)[16], int lane) {
#pragma unroll
    for (int c = 0; c < 4; ++c) { const float4 x = gld_f4(p + c * 256 + lane * 4); v[c * 4] = x.x; v[c * 4 + 1] = x.y; v[c * 4 + 2] = x.z; v[c * 4 + 3] = x.w; }
}
__device__ __forceinline__ void row_load_f32_l(const float* p, float (&v)[16], int lane) {
#pragma unroll
    for (int c = 0; c < 4; ++c) { const float4 x = *(const float4*)(p + c * 256 + lane * 4); v[c * 4] = x.x; v[c * 4 + 1] = x.y; v[c * 4 + 2] = x.z; v[c * 4 + 3] = x.w; }
}
__device__ __forceinline__ void row_load_bf16(const bf16_t* p, float (&v)[16], int lane) {
#pragma unroll
    for (int c = 0; c < 4; ++c) { const uint2 x = gld_u2(p + c * 256 + lane * 4); v[c * 4] = bflo(x.x); v[c * 4 + 1] = bfhi(x.x); v[c * 4 + 2] = bflo(x.y); v[c * 4 + 3] = bfhi(x.y); }
}
__device__ __forceinline__ void row_store_bf16(bf16_t* p, const float (&v)[16], int lane) {
#pragma unroll
    for (int c = 0; c < 4; ++c) gst_u2(p + c * 256 + lane * 4, cvt_pk(v[c * 4], v[c * 4 + 1]), cvt_pk(v[c * 4 + 2], v[c * 4 + 3]));
}
__device__ __forceinline__ void row_store_f32(float* p, const float (&v)[16], int lane) {
#pragma unroll
    for (int c = 0; c < 4; ++c) gst_f4(p + c * 256 + lane * 4, v[c * 4], v[c * 4 + 1], v[c * 4 + 2], v[c * 4 + 3]);
}
__device__ __forceinline__ void row_store_f32_l(float* p, const float (&v)[16], int lane) {
#pragma unroll
    for (int c = 0; c < 4; ++c) *(float4*)(p + c * 256 + lane * 4) = make_float4(v[c * 4], v[c * 4 + 1], v[c * 4 + 2], v[c * 4 + 3]);
}
__device__ __forceinline__ void row_layernorm(float (&v)[16], const float* g, const float* b, int lane) {
    float gg[16], bb[16]; row_load_f32(g, gg, lane); row_load_f32(b, bb, lane);
    float s = 0.f, q = 0.f;
#pragma unroll
    for (int i = 0; i < 16; ++i) { s += v[i]; q += v[i] * v[i]; }
    s = wave_sum(s); q = wave_sum(q);
    const float mean = s * (1.0f / 1024.0f);
    const float rstd = rsqrtf(fmaxf(q * (1.0f / 1024.0f) - mean * mean, 0.f) + LN_EPS);
#pragma unroll
    for (int i = 0; i < 16; ++i) v[i] = (v[i] - mean) * rstd * gg[i] + bb[i];
}
__device__ __forceinline__ void row_modulate(const float (&x)[16], float (&h)[16], const float* mod3, int lane) {
    float sh[16], sc[16]; row_load_f32(mod3, sh, lane); row_load_f32(mod3 + 1024, sc, lane);
#pragma unroll
    for (int i = 0; i < 16; ++i) h[i] = x[i] * (1.0f + sc[i]) + sh[i];
}
__device__ __forceinline__ void load_mu(const float* mu, float (&m)[6][16], int lane) {
#pragma unroll
    for (int n = 0; n < 6; ++n) row_load_f32(mu + n * 1024, m[n], lane);
}
__device__ __forceinline__ void emit_next(bf16_t* s0, int kind, int row, const float (&h)[16], const float (&hp)[16], const float (&m)[6][16], int lane) {
    if (kind == 0) {
#pragma unroll
        for (int n = 0; n < 6; ++n) {
#pragma unroll
            for (int c = 0; c < 4; ++c)
                gst_u2(s0 + (size_t)n * (SLOT / 2) + (size_t)row * 1024 + c * 256 + lane * 4,
                       cvt_pk(h[c * 4] + (hp[c * 4] - h[c * 4]) * m[n][c * 4], h[c * 4 + 1] + (hp[c * 4 + 1] - h[c * 4 + 1]) * m[n][c * 4 + 1]),
                       cvt_pk(h[c * 4 + 2] + (hp[c * 4 + 2] - h[c * 4 + 2]) * m[n][c * 4 + 2], h[c * 4 + 3] + (hp[c * 4 + 3] - h[c * 4 + 3]) * m[n][c * 4 + 3]));
        }
    } else row_store_bf16(s0 + (size_t)row * 1024, h, lane);
}
__device__ __forceinline__ void emit_next_l(bf16_t* s0, const float* mu, int kind, int row, const float (&h)[16], const float (&hp)[16], int lane) {
    if (kind == 0) {
#pragma unroll 1
        for (int n = 0; n < 6; ++n) {
#pragma unroll
            for (int c2 = 0; c2 < 2; ++c2) {
                const float4 ma = gld_f4(mu + n * 1024 + (2 * c2) * 256 + lane * 4), mb = gld_f4(mu + n * 1024 + (2 * c2 + 1) * 256 + lane * 4);
                const float mm[8] = {ma.x, ma.y, ma.z, ma.w, mb.x, mb.y, mb.z, mb.w};
#pragma unroll
                for (int cc = 0; cc < 2; ++cc) {
                    const int c = 2 * c2 + cc;
                    gst_u2(s0 + (size_t)n * (SLOT / 2) + (size_t)row * 1024 + c * 256 + lane * 4,
                           cvt_pk(h[c * 4] + (hp[c * 4] - h[c * 4]) * mm[cc * 4], h[c * 4 + 1] + (hp[c * 4 + 1] - h[c * 4 + 1]) * mm[cc * 4 + 1]),
                           cvt_pk(h[c * 4 + 2] + (hp[c * 4 + 2] - h[c * 4 + 2]) * mm[cc * 4 + 2], h[c * 4 + 3] + (hp[c * 4 + 3] - h[c * 4 + 3]) * mm[cc * 4 + 3]));
                }
            }
        }
    } else row_store_bf16(s0 + (size_t)row * 1024, h, lane);
}
__device__ __forceinline__ void phase_h0(PRef p) {
    const int t_ = tidx(); const int lane = t_ & 63, gw = blockIdx.x * 4 + (t_ >> 6), nw = gridDim.x * 4;
    const int rpw = NTOK / nw;
    const int r_lo = gw * rpw;
    const float* mod = (const float*)(p.ws + OFF_MOD) + ((size_t)(0 * 2 + 0) * 8 + (r_lo >> 11)) * 3072;
    float sh[16], sc[16]; row_load_f32(mod, sh, lane); row_load_f32(mod + 1024, sc, lane);
    float hp[16];
#pragma unroll
    for (int i = 0; i < 16; ++i) hp[i] = 0.f;
    float mu[6][16]; load_mu(p.in[6], mu, lane);
    const int first = ((r_lo & 2047) != 0) ? r_lo - 1 : r_lo, end = r_lo + rpw;
    float nx[16]; row_load_f32(p.in[0] + (size_t)first * 1024, nx, lane);
    for (int r = first; r < end; ++r) {
        float h[16];
#pragma unroll
        for (int i = 0; i < 16; ++i) h[i] = nx[i] * (1.0f + sc[i]) + sh[i];
        if (r + 1 < end) row_load_f32(p.in[0] + (size_t)(r + 1) * 1024, nx, lane);
        __builtin_amdgcn_sched_barrier(0);
        if (r >= r_lo) emit_next((bf16_t*)(p.ws + OFF_SLOT), 0, r, h, hp, mu, lane);
#pragma unroll
        for (int i = 0; i < 16; ++i) hp[i] = h[i];
        if (((r + 1) & 2047) == 0) {
#pragma unroll
            for (int i = 0; i < 16; ++i) hp[i] = 0.f;
        }
    }
}
__device__ __forceinline__ int layer_kind(int L) { return L % 3; }
__device__ __forceinline__ void phase_ln2(PRef p, int L) {
    const int t_ = tidx(); const int lane = t_ & 63, gw = blockIdx.x * 4 + (t_ >> 6), nw = gridDim.x * 4;
    const int rpw = NTOK / nw, r_lo = gw * rpw;
    const float* mod = (const float*)(p.ws + OFF_MOD);
    const bf16_t* xres = (const bf16_t*)(p.ws + OFF_XRES);
    const bf16_t* Y = (const bf16_t*)(p.ws + OFF_SLOT + 9 * SLOT);
    const float* wgt = (const float*)(p.ws + OFF_WGT);
    const bool last = (L == 3);
    const int nk = layer_kind(L + 1), njr = (L + 1) / 3;
    const bool need_prev = (!last && nk == 0);
    const int bidx = r_lo >> 11;
    float gt[16], lgn[16], lbn[16];
    row_load_f32(mod + ((size_t)(L * 2 + 1) * 8 + bidx) * 3072 + 2048, gt, lane);
    row_load_f32(p.in[4] + (L * 2 + 1) * 1024, lgn, lane); row_load_f32(p.in[5] + (L * 2 + 1) * 1024, lbn, lane);
    float hp[16];
#pragma unroll
    for (int i = 0; i < 16; ++i) hp[i] = 0.f;
    float shn[16], scn[16];
    { const float* mn_ = mod + ((size_t)((last ? L : L + 1) * 2 + 0) * 8 + bidx) * 3072; row_load_f32(mn_, shn, lane); row_load_f32(mn_ + 1024, scn, lane); }
    uint2 nxr[4], ny0[4], ny1[4]; float nw0, nw1;
    auto load_in = [&](int r) {
#pragma unroll
        for (int c = 0; c < 4; ++c) { nxr[c] = *(const uint2*)(xres + (size_t)r * 1024 + c * 256 + lane * 4); ny0[c] = *(const uint2*)(Y + (size_t)(2 * r) * 1024 + c * 256 + lane * 4); ny1[c] = *(const uint2*)(Y + (size_t)(2 * r + 1) * 1024 + c * 256 + lane * 4); }
        nw0 = wgt[2 * r]; nw1 = wgt[2 * r + 1];
    };
    const int first = (need_prev && (r_lo & 2047) != 0) ? r_lo - 1 : r_lo, end = r_lo + rpw;
    load_in(first);
    for (int r = first; r < end; ++r) {
        float x[16];
        {
            const float w0 = nw0, w1 = nw1;
#pragma unroll
            for (int c = 0; c < 4; ++c) {
                const float a0[4] = {bflo(ny0[c].x), bfhi(ny0[c].x), bflo(ny0[c].y), bfhi(ny0[c].y)}, a1[4] = {bflo(ny1[c].x), bfhi(ny1[c].x), bflo(ny1[c].y), bfhi(ny1[c].y)};
                const float xr[4] = {bflo(nxr[c].x), bfhi(nxr[c].x), bflo(nxr[c].y), bfhi(nxr[c].y)};
#pragma unroll
                for (int i = 0; i < 4; ++i) x[c * 4 + i] = DN_ALPHA * xr[i] + (1.0f + gt[c * 4 + i]) * (w0 * a0[i] + w1 * a1[i]);
            }
        }
        if (r + 1 < end) load_in(r + 1);
        __builtin_amdgcn_sched_barrier(0);
        float s = 0.f, q = 0.f;
#pragma unroll
        for (int i = 0; i < 16; ++i) { s += x[i]; q += x[i] * x[i]; }
        s = wave_sum(s); q = wave_sum(q);
        const float mean = s * (1.0f / 1024.0f), rstd = rsqrtf(fmaxf(q * (1.0f / 1024.0f) - mean * mean, 0.f) + LN_EPS);
#pragma unroll
        for (int i = 0; i < 16; ++i) x[i] = (x[i] - mean) * rstd * lgn[i] + lbn[i];
        if (last) { row_store_f32(p.out + (size_t)r * 1024, x, lane); continue; }
        float h[16];
#pragma unroll
        for (int i = 0; i < 16; ++i) h[i] = x[i] * (1.0f + scn[i]) + shn[i];
        if (r >= r_lo) { row_store_bf16((bf16_t*)(p.ws + OFF_XRES2) + (size_t)r * 1024, x, lane); emit_next_l((bf16_t*)(p.ws + OFF_SLOT), p.in[6] + (size_t)njr * 6 * 1024, nk, r, h, hp, lane); }
#pragma unroll
        for (int i = 0; i < 16; ++i) hp[i] = h[i];
        if (((r + 1) & 2047) == 0) {
#pragma unroll
            for (int i = 0; i < 16; ++i) hp[i] = 0.f;
        }
    }
}
__device__ __forceinline__ void phase_ln1(PRef p, int L, char* lds, const bf16_t* ymix, bf16_t* hm) {
    const int t = tidx(), lane = t & 63, wid = t >> 6;
    const float* mod = (const float*)(p.ws + OFF_MOD);
    const bf16_t* xinb = (const bf16_t*)(p.ws + OFF_XRES2);
    bf16_t* xres = (bf16_t*)(p.ws + OFF_XRES);
    int* cnt = (int*)(p.ws + OFF_CNT) + L * 32;
    int* list = (int*)(p.ws + OFF_LIST);
    float* wgt = (float*)(p.ws + OFF_WGT);
    float* const HB = (float*)lds;
    float* const lg = (float*)(lds + 65536);
    const float* rtw = (const float*)(p.ws + OFF_RTW) + (size_t)L * 36 * 1024;
    const int rpb = NTOK / gridDim.x;
    const int bidx = (blockIdx.x * rpb) >> 11;
    float gt[16], lgn[16], lbn[16], sh2[16], sc2[16];
    row_load_f32(mod + ((size_t)(L * 2 + 0) * 8 + bidx) * 3072 + 2048, gt, lane);
    row_load_f32(p.in[4] + (L * 2 + 0) * 1024, lgn, lane); row_load_f32(p.in[5] + (L * 2 + 0) * 1024, lbn, lane);
    row_load_f32(mod + ((size_t)(L * 2 + 1) * 8 + bidx) * 3072, sh2, lane); row_load_f32(mod + ((size_t)(L * 2 + 1) * 8 + bidx) * 3072 + 1024, sc2, lane);
    for (int rb0 = blockIdx.x * rpb; rb0 < (blockIdx.x + 1) * rpb; rb0 += 16) {
        const int rb = rb0 + wid * 4;
        uint4 xr[4][4]; uint2 yr[4][4];
#pragma unroll
        for (int rr = 0; rr < 4; ++rr) {
            const int r = rb + rr;
#pragma unroll
            for (int c = 0; c < 4; ++c) {
                if (L == 0) xr[rr][c] = gld_u4(p.in[0] + (size_t)r * 1024 + c * 256 + lane * 4);
                else { const uint2 t2 = gld_u2(xinb + (size_t)r * 1024 + c * 256 + lane * 4); xr[rr][c] = make_uint4(t2.x, t2.y, 0u, 0u); }
                yr[rr][c] = gld_u2(ymix + (size_t)r * 1024 + c * 256 + lane * 4);
            }
        }
#pragma unroll
        for (int rr = 0; rr < 4; ++rr) {
            const int r = rb + rr;
            float x[16], h[16];
#pragma unroll
            for (int c = 0; c < 4; ++c) {
                float xv[4];
                if (L == 0) { xv[0] = __uint_as_float(xr[rr][c].x); xv[1] = __uint_as_float(xr[rr][c].y); xv[2] = __uint_as_float(xr[rr][c].z); xv[3] = __uint_as_float(xr[rr][c].w); }
                else { xv[0] = bflo(xr[rr][c].x); xv[1] = bfhi(xr[rr][c].x); xv[2] = bflo(xr[rr][c].y); xv[3] = bfhi(xr[rr][c].y); }
                const float yv[4] = {bflo(yr[rr][c].x), bfhi(yr[rr][c].x), bflo(yr[rr][c].y), bfhi(yr[rr][c].y)};
#pragma unroll
                for (int i = 0; i < 4; ++i) x[c * 4 + i] = DN_ALPHA * xv[i] + (1.0f + gt[c * 4 + i]) * yv[i];
            }
            float s = 0.f, q = 0.f;
#pragma unroll
            for (int i = 0; i < 16; ++i) { s += x[i]; q += x[i] * x[i]; }
            s = wave_sum(s); q = wave_sum(q);
            const float mean = s * (1.0f / 1024.0f), rstd = rsqrtf(fmaxf(q * (1.0f / 1024.0f) - mean * mean, 0.f) + LN_EPS);
#pragma unroll
            for (int i = 0; i < 16; ++i) { x[i] = (x[i] - mean) * rstd * lgn[i] + lbn[i]; h[i] = x[i] * (1.0f + sc2[i]) + sh2[i]; }
            row_store_bf16(xres + (size_t)r * 1024, x, lane);
            row_store_bf16(hm + (size_t)r * 1024, h, lane);
            row_store_f32_l(HB + (wid * 4 + rr) * 1024, h, lane);
        }
        __syncthreads();
#pragma unroll 1
        for (int q3 = 0; q3 < 9; q3 += 3) {
            float w[3][16];
#pragma unroll
            for (int u = 0; u < 3; ++u) row_load_f32(rtw + (size_t)(wid * 9 + q3 + u) * 1024, w[u], lane);
#pragma unroll 2
            for (int r16 = 0; r16 < 16; ++r16) {
                float h[16]; row_load_f32_l(HB + r16 * 1024, h, lane);
                float a3[3];
#pragma unroll
                for (int u = 0; u < 3; ++u) { float s2 = 0.f;
#pragma unroll
                    for (int i = 0; i < 16; ++i) s2 += h[i] * w[u][i];
                    a3[u] = wave_sum(s2); }
                if (lane == 0) {
#pragma unroll
                    for (int u = 0; u < 3; ++u) lg[r16 * 36 + wid * 9 + q3 + u] = a3[u];
                }
            }
        }
        __syncthreads();
        if (t < 16) {
            const int row = rb0 + t; const float* l = lg + t * 36;
            float g[4]; for (int i = 0; i < 4; ++i) g[i] = l[i] + p.in[37][L * 4 + i];
            int gi = 0; for (int i = 1; i < 4; ++i) if (g[i] > g[gi]) gi = i;
            float gs = 0.f; for (int i = 0; i < 4; ++i) gs += __expf(g[i] - g[gi]);
            const float ggate = 1.0f / gs;
            float e[8]; for (int i = 0; i < 8; ++i) e[i] = l[4 + gi * 8 + i] + p.in[39][L * 32 + gi * 8 + i];
            int i0 = 0; for (int i = 1; i < 8; ++i) if (e[i] > e[i0]) i0 = i;
            int i1 = (i0 == 0) ? 1 : 0; for (int i = 0; i < 8; ++i) if (i != i0 && e[i] > e[i1]) i1 = i;
            const float p1 = __expf(e[i1] - e[i0]);
            const float w0 = ggate / (1.0f + p1), w1 = ggate * p1 / (1.0f + p1);
            const int e0 = gi * 8 + i0, e1 = gi * 8 + i1;
            const int pos0 = atomicAdd(&cnt[e0], 1), pos1 = atomicAdd(&cnt[e1], 1);
            list[e0 * LIST_CAP + pos0] = 2 * row; list[e1 * LIST_CAP + pos1] = 2 * row + 1;
            wgt[2 * row] = w0; wgt[2 * row + 1] = w1;
        }
        asm volatile("s_waitcnt lgkmcnt(0)" ::: "memory");
    }
}

__device__ __forceinline__ int perm64(int r) { return (r & 64) | (((r >> 2) & 3) << 4) | (((r >> 4) & 3) << 2) | (r & 3); }
__device__ __forceinline__ bool tile_permuted(int mode, int nt) { return (mode <= MODE_SIGM) || (mode == MODE_ML1 && nt < 24) || (mode == MODE_RT1 && nt >= 16); }
__device__ __forceinline__ void store16(bf16_t* d, const f32x4 (&v)[4]) {
    gst_u4(d, cvt_pk(v[0][0], v[0][1]), cvt_pk(v[0][2], v[0][3]), cvt_pk(v[1][0], v[1][1]), cvt_pk(v[1][2], v[1][3]));
    gst_u4(d + 8, cvt_pk(v[2][0], v[2][1]), cvt_pk(v[2][2], v[2][3]), cvt_pk(v[3][0], v[3][1]), cvt_pk(v[3][2], v[3][3]));
}
__device__ __forceinline__ void gemm_epilogue(PRef p, const GJob& jb, int mt, int nt, const f32x4 (&acc)[4][4]) {
    const int t_ = tidx(); const int lane = t_ & 63, wid = t_ >> 6, wr = wid >> 1, wc = wid & 1, fr = lane & 15, fq = lane >> 4;
    const int row0 = mt * 128 + wr * 64 + fr;
    if (jb.mode <= MODE_SIGM) {
        const int col = nt * 128 + wc * 64 + fq * 16;
        if (col < jb.N) {
#pragma unroll
            for (int m = 0; m < 4; ++m) {
                f32x4 v[4];
#pragma unroll
                for (int n = 0; n < 4; ++n) {
                    v[n] = acc[m][n];
                    if (jb.mode == MODE_TANH) { v[n][0] = tanhf_(v[n][0]); v[n][1] = tanhf_(v[n][1]); v[n][2] = tanhf_(v[n][2]); v[n][3] = tanhf_(v[n][3]); }
                    else if (jb.mode == MODE_SIGM) { v[n][0] = sigmoidf_(v[n][0]); v[n][1] = sigmoidf_(v[n][1]); v[n][2] = sigmoidf_(v[n][2]); v[n][3] = sigmoidf_(v[n][3]); }
                }
                store16(jb.out + (size_t)(row0 + m * 16) * jb.ldo + col, v);
            }
        }
    } else if (jb.mode == MODE_ML1) {
        if (nt < 24) {
            bf16_t* ob = (bf16_t*)(p.ws + OFF_SLOT + (size_t)(1 + (nt >> 3)) * SLOT);
            const bool sg = (nt >= 16);
            const int col = (nt & 7) * 128 + wc * 64 + fq * 16;
#pragma unroll
            for (int m = 0; m < 4; ++m) {
                f32x4 v[4];
#pragma unroll
                for (int n = 0; n < 4; ++n) {
                    v[n] = acc[m][n];
                    if (sg) { v[n][0] = sigmoidf_(v[n][0]); v[n][1] = sigmoidf_(v[n][1]); v[n][2] = sigmoidf_(v[n][2]); v[n][3] = sigmoidf_(v[n][3]); }
                }
                store16(ob + (size_t)(row0 + m * 16) * 1024 + col, v);
            }
        } else if (wc == 0) {
            float* gates = (float*)(p.ws + OFF_GATES);
            const float* bg = p.in[26];
            const int c0 = fq * 4;
#pragma unroll
            for (int m = 0; m < 4; ++m) {
                f32x4 v = acc[m][0], o;
#pragma unroll
                for (int j = 0; j < 4; ++j) { const float g = v[j] + bg[c0 + j]; o[j] = (c0 + j < 8) ? g : -softplusf_(-g); }
                gst_f4(gates + (size_t)(row0 + m * 16) * 16 + c0, o[0], o[1], o[2], o[3]);
            }
        }
    } else {
        if (nt < 16) {
            const float* rot = (const float*)(p.ws + OFF_ROT);
            bf16_t* ob = (bf16_t*)(p.ws + OFF_SLOT + (size_t)(1 + (nt >> 3)) * SLOT);
            const float scl = (nt >= 8) ? 0.0625f : 1.0f;
#pragma unroll
            for (int pp = 0; pp < 2; ++pp) {
                const int blk32 = (nt & 7) * 4 + wc * 2 + pp, head = blk32 >> 3, i0 = (blk32 & 7) * 16 + fq * 4;
                float4 rc0[4], rc1[4];
#pragma unroll
                for (int m = 0; m < 4; ++m) { const int tt = (row0 + m * 16) & 2047; rc0[m] = gld_f4(rot + ((size_t)tt * 128 + i0) * 2); rc1[m] = gld_f4(rot + ((size_t)tt * 128 + i0) * 2 + 4); }
#pragma unroll
                for (int m = 0; m < 4; ++m) {
                    const int row = row0 + m * 16;
                    const float4 c0 = rc0[m], c1 = rc1[m];
                    const float cs[4] = {c0.x, c0.z, c1.x, c1.z}, sn[4] = {c0.y, c0.w, c1.y, c1.w};
                    const f32x4 x1 = acc[m][2 * pp], x2 = acc[m][2 * pp + 1];
                    float o1[4], o2[4];
#pragma unroll
                    for (int j = 0; j < 4; ++j) { o1[j] = (x1[j] * cs[j] - x2[j] * sn[j]) * scl; o2[j] = (x1[j] * sn[j] + x2[j] * cs[j]) * scl; }
                    gst_u2(ob + (size_t)row * 1024 + head * 256 + i0, cvt_pk(o1[0], o1[1]), cvt_pk(o1[2], o1[3]));
                    gst_u2(ob + (size_t)row * 1024 + head * 256 + 128 + i0, cvt_pk(o2[0], o2[1]), cvt_pk(o2[2], o2[3]));
                }
            }
        } else {
            const bool isg = (nt >= 32);
            bf16_t* ob = (bf16_t*)(p.ws + OFF_SLOT + (size_t)(isg ? 5 : 3) * SLOT);
            const int col = (nt & 15) * 128 + wc * 64 + fq * 16;
#pragma unroll
            for (int m = 0; m < 4; ++m) {
                f32x4 v[4];
#pragma unroll
                for (int n = 0; n < 4; ++n) {
                    v[n] = acc[m][n];
                    if (isg) { v[n][0] = siluf_(v[n][0]); v[n][1] = siluf_(v[n][1]); v[n][2] = siluf_(v[n][2]); v[n][3] = siluf_(v[n][3]); }
                }
                store16(ob + (size_t)(row0 + m * 16) * 2048 + col, v);
            }
        }
    }
}
__device__ __forceinline__ void phase_gemm_jobs(PRef p, char* lds, int jlo, int jhi) {
    const int total = p.gj[jhi - 1].tile0 + 128 * p.gj[jhi - 1].ntn - p.gj[jlo].tile0;
    for (int id = blockIdx.x; id < total; id += gridDim.x) {
        int j = jlo; const int gid = id + p.gj[jlo].tile0;
        while (j + 1 < jhi && gid >= p.gj[j + 1].tile0) ++j;
        GJob jb; jb.A = p.gj[j].A; jb.Bt = p.gj[j].Bt; jb.out = p.gj[j].out; jb.K = p.gj[j].K; jb.N = p.gj[j].N; jb.ldo = p.gj[j].ldo; jb.mode = p.gj[j].mode; jb.ntn = p.gj[j].ntn; jb.tile0 = p.gj[j].tile0;
        jb.half = p.gj[j].half;
        int mt, nt; tile_map(gid - jb.tile0, jb.ntn, mt, nt);
        if (jb.half || (jb.mode == MODE_ML1 && nt == 24)) {
            const int t_ = tidx(), r0_ = t_ >> 3, co_ = glds_chunk(t_) * 8, ln_ = t_ & 63, wv_ = t_ >> 6, fr_ = ln_ & 15, fq_ = ln_ >> 4;
            const int cb = jb.half ? nt * 64 : nt * 128;
            int nvh = jb.N - cb; nvh = nvh > 64 ? 64 : nvh;
            const bf16_t* ar[4]; const bf16_t* brh[2];
#pragma unroll
            for (int i = 0; i < 4; ++i) ar[i] = jb.A + (size_t)(mt * 128 + r0_ + 32 * i) * jb.K + co_;
#pragma unroll
            for (int i = 0; i < 2; ++i) { int rb_ = r0_ + 32 * i; rb_ = jb.half ? perm64(rb_) : rb_; rb_ = rb_ < nvh ? rb_ : nvh - 1; brh[i] = jb.Bt + (size_t)(cb + rb_) * jb.K + co_; }
            f32x4 ah[2][4];
            gemm_hn(lds, jb.K / 64, ar, brh, ah);
            const int rowh = mt * 128 + wv_ * 32 + fr_;
            if (jb.half) {
                const int col = cb + fq_ * 16;
                if (col < jb.N) {
#pragma unroll
                    for (int m = 0; m < 2; ++m) {
                        f32x4 v[4];
#pragma unroll
                        for (int n = 0; n < 4; ++n) {
                            v[n] = ah[m][n];
#pragma unroll
                            for (int jj = 0; jj < 4; ++jj) v[n][jj] = (jb.mode == MODE_TANH) ? tanhf_(v[n][jj]) : (jb.mode == MODE_SIGM) ? sigmoidf_(v[n][jj]) : v[n][jj];
                        }
                        store16(jb.out + (size_t)(rowh + m * 16) * jb.ldo + col, v);
                    }
                }
            } else {
                float* gates = (float*)(p.ws + OFF_GATES);
                const float* bg = p.in[26];
                const int c0 = fq_ * 4;
                const float4 bq = gld_f4(bg + c0);
                const float bqa[4] = {bq.x, bq.y, bq.z, bq.w};
#pragma unroll
                for (int m = 0; m < 2; ++m) {
                    float o[4];
#pragma unroll
                    for (int jj = 0; jj < 4; ++jj) { const float g = ah[m][0][jj] + bqa[jj]; o[jj] = (c0 + jj < 8) ? g : -softplusf_(-g); }
                    gst_f4(gates + (size_t)(rowh + m * 16) * 16 + c0, o[0], o[1], o[2], o[3]);
                }
            }
            continue;
        }
        int nv = jb.N - nt * 128; nv = nv > 128 ? 128 : nv;
        const bf16_t* ar[4]; const bf16_t* br[4];
        {
            const int t_ = tidx(), r0_ = t_ >> 3, co_ = glds_chunk(t_) * 8;
            const bool pm_ = tile_permuted(jb.mode, nt);
#pragma unroll
            for (int i = 0; i < 4; ++i) {
                ar[i] = jb.A + (size_t)(mt * 128 + r0_ + 32 * i) * jb.K + co_;
                int rb_ = r0_ + 32 * i; rb_ = pm_ ? perm64(rb_) : rb_; rb_ = rb_ < nv ? rb_ : nv - 1;
                br[i] = jb.Bt + (size_t)(nt * 128 + rb_) * jb.K + co_;
            }
        }
        f32x4 acc[4][4];
        gemm_gg(lds, jb.K / 64, ar, br, acc);
        gemm_epilogue(p, jb, mt, nt, acc);
    }
}

constexpr int RM = 4;
template <int KL>
__device__ __forceinline__ void minigemm(const bf16_t* A, const bf16_t* Bt, int fr, int fq, f32x4 (&acc)[RM][4]) {
#pragma unroll
    for (int m = 0; m < RM; ++m)
#pragma unroll
        for (int n = 0; n < 4; ++n) acc[m][n] = (f32x4){0.f, 0.f, 0.f, 0.f};
#pragma unroll 2
    for (int ks = 0; ks < KL / 32; ++ks) {
        uint4 af[RM], bfm[4];
#pragma unroll
        for (int m = 0; m < RM; ++m) af[m] = gld_u4(A + (size_t)(m * 16 + fr) * KL + ks * 32 + fq * 8);
#pragma unroll
        for (int n = 0; n < 4; ++n) bfm[n] = gld_u4(Bt + (size_t)((fr >> 2) * 16 + n * 4 + (fr & 3)) * KL + ks * 32 + fq * 8);
#pragma unroll
        for (int m = 0; m < RM; ++m)
#pragma unroll
            for (int n = 0; n < 4; ++n) acc[m][n] = mfma16(bfm[n], af[m], acc[m][n]);
    }
}
__device__ __forceinline__ void phase_rw2(PRef p, int jr) {
    const int t_ = tidx(); const int lane = t_ & 63, wid = t_ >> 6, wr = wid >> 1, wc = wid & 1, fr = lane & 15, fq = lane >> 4;
    char* S = p.ws + OFF_SLOT;
    float* decay = (float*)S; bf16_t* nkk = (bf16_t*)(S + 2 * SLOT); bf16_t* bb = (bf16_t*)(S + 3 * SLOT); bf16_t* gb = (bf16_t*)(S + 4 * SLOT);
    const bf16_t* rb = (const bf16_t*)(S + 6 * SLOT); const bf16_t* kb = (const bf16_t*)(S + 7 * SLOT); bf16_t* kpb = (bf16_t*)(S + 10 * SLOT);
    const bf16_t* vb = (const bf16_t*)(S + 8 * SLOT); bf16_t* vpb = (bf16_t*)(S + 9 * SLOT); const bf16_t* vf = (const bf16_t*)(S + 11 * SLOT);
    float* bonus = (float*)(p.ws + OFF_BONUS);
    const bf16_t* Lw = (const bf16_t*)(p.ws + OFF_LW); const bf16_t* La = (const bf16_t*)(p.ws + OFF_LA);
    const bf16_t* Lg = (const bf16_t*)(p.ws + OFF_LG); const bf16_t* Lv = (const bf16_t*)(p.ws + OFF_LV);
    const bf16_t* w2t = (const bf16_t*)(p.ws + W_W2T) + (size_t)jr * 1024 * 64; const bf16_t* a2t = (const bf16_t*)(p.ws + W_A2T) + (size_t)jr * 1024 * 64;
    const bf16_t* g2t = (const bf16_t*)(p.ws + W_G2T) + (size_t)jr * 1024 * 128; const bf16_t* v2t = (const bf16_t*)(p.ws + W_V2T);
    const float* w0 = p.in[8] + jr * 1024; const float* a0 = p.in[11] + jr * 1024; const float* v0 = p.in[14];
    const float* kkw = p.in[19] + jr * 1024; const float* kaw = p.in[20] + jr * 1024; const float* rk = p.in[21] + jr * 1024;
    for (int id2 = blockIdx.x; id2 < 128 * 8; id2 += gridDim.x) {
        int mt, nt; tile_map(id2, 8, mt, nt);
        const int row0 = mt * 128 + wr * 64, col0 = nt * 128 + wc * 64, head = nt * 2 + wc;
        f32x4 acc[RM][4];
        const int c0 = col0 + fq * 16;
        minigemm<64>(La + (size_t)row0 * 64, a2t + (size_t)col0 * 64, fr, fq, acc);
        float ss[RM], bs[RM];
#pragma unroll
        for (int m = 0; m < RM; ++m) { ss[m] = 0.f; bs[m] = 0.f; }
#pragma unroll
        for (int m = 0; m < RM; ++m) {
            const size_t off = (size_t)(row0 + m * 16 + fr) * 1024 + c0;
            const uint4 kq0 = *(const uint4*)(kb + off), kq1 = *(const uint4*)(kb + off + 8);
            const unsigned kw[8] = {kq0.x, kq0.y, kq0.z, kq0.w, kq1.x, kq1.y, kq1.z, kq1.w};
#pragma unroll
            for (int n = 0; n < 4; ++n) {
                const float4 a0v = *(const float4*)(a0 + c0 + n * 4), kkv = *(const float4*)(kkw + c0 + n * 4);
                const float a0a[4] = {a0v.x, a0v.y, a0v.z, a0v.w}, kka[4] = {kkv.x, kkv.y, kkv.z, kkv.w};
                const float kf4[4] = {bflo(kw[n * 2]), bfhi(kw[n * 2]), bflo(kw[n * 2 + 1]), bfhi(kw[n * 2 + 1])};
#pragma unroll
                for (int j = 0; j < 4; ++j) { acc[m][n][j] = sigmoidf_(a0a[j] + acc[m][n][j]); const float q = kf4[j] * kka[j]; ss[m] += q * q; }
            }
            asm volatile("" ::: "memory");
        }
#pragma unroll
        for (int m = 0; m < RM; ++m) { ss[m] += __shfl_xor(ss[m], 16); ss[m] += __shfl_xor(ss[m], 32); ss[m] = fminf(__builtin_amdgcn_rsqf(ss[m]), 1e12f); }
        float4 kkq[4], kaq[4], rkq[4];
#pragma unroll
        for (int n = 0; n < 4; ++n) { kkq[n] = gld_f4(kkw + c0 + n * 4); kaq[n] = gld_f4(kaw + c0 + n * 4); rkq[n] = gld_f4(rk + c0 + n * 4); }
#pragma unroll
        for (int m = 0; m < RM; ++m) {
            const size_t off = (size_t)(row0 + m * 16 + fr) * 1024 + c0;
            const uint4 rq0 = *(const uint4*)(rb + off), rq1 = *(const uint4*)(rb + off + 8), kq0 = *(const uint4*)(kb + off), kq1 = *(const uint4*)(kb + off + 8);
            const unsigned kw[8] = {kq0.x, kq0.y, kq0.z, kq0.w, kq1.x, kq1.y, kq1.z, kq1.w};
            const unsigned rw[8] = {rq0.x, rq0.y, rq0.z, rq0.w, rq1.x, rq1.y, rq1.z, rq1.w};
            unsigned okp[8], onk[8], obb[8];
#pragma unroll
            for (int n = 0; n < 4; ++n) {
                const float kka[4] = {kkq[n].x, kkq[n].y, kkq[n].z, kkq[n].w}, kaa[4] = {kaq[n].x, kaq[n].y, kaq[n].z, kaq[n].w}, rka[4] = {rkq[n].x, rkq[n].y, rkq[n].z, rkq[n].w};
                const float rf[4] = {bflo(rw[n * 2]), bfhi(rw[n * 2]), bflo(rw[n * 2 + 1]), bfhi(rw[n * 2 + 1])}, kf4[4] = {bflo(kw[n * 2]), bfhi(kw[n * 2]), bflo(kw[n * 2 + 1]), bfhi(kw[n * 2 + 1])};
                float kp[4], nk[4], b4[4];
#pragma unroll
                for (int j = 0; j < 4; ++j) {
                    const float a = acc[m][n][j], k = kf4[j], kn = k * kka[j] * ss[m];
                    kp[j] = k * (1.0f + (a - 1.0f) * kaa[j]); nk[j] = -kn; b4[j] = kn * a; bs[m] += rf[j] * kp[j] * rka[j];
                }
                okp[n * 2] = cvt_pk(kp[0], kp[1]); okp[n * 2 + 1] = cvt_pk(kp[2], kp[3]);
                onk[n * 2] = cvt_pk(nk[0], nk[1]); onk[n * 2 + 1] = cvt_pk(nk[2], nk[3]);
                obb[n * 2] = cvt_pk(b4[0], b4[1]); obb[n * 2 + 1] = cvt_pk(b4[2], b4[3]);
            }
            *(uint4*)(kpb + off) = make_uint4(okp[0], okp[1], okp[2], okp[3]); *(uint4*)(kpb + off + 8) = make_uint4(okp[4], okp[5], okp[6], okp[7]);
            *(uint4*)(nkk + off) = make_uint4(onk[0], onk[1], onk[2], onk[3]); *(uint4*)(nkk + off + 8) = make_uint4(onk[4], onk[5], onk[6], onk[7]);
            *(uint4*)(bb + off) = make_uint4(obb[0], obb[1], obb[2], obb[3]); *(uint4*)(bb + off + 8) = make_uint4(obb[4], obb[5], obb[6], obb[7]);
            asm volatile("" ::: "memory");
        }
#pragma unroll
        for (int m = 0; m < RM; ++m) { bs[m] += __shfl_xor(bs[m], 16); bs[m] += __shfl_xor(bs[m], 32); if (fq == 0) bonus[(size_t)(row0 + m * 16 + fr) * 16 + head] = bs[m]; }
        minigemm<64>(Lw + (size_t)row0 * 64, w2t + (size_t)col0 * 64, fr, fq, acc);
        float4 w0q[4];
#pragma unroll
        for (int n = 0; n < 4; ++n) w0q[n] = gld_f4(w0 + c0 + n * 4);
#pragma unroll
        for (int n = 0; n < 4; ++n) {
            const float w0a[4] = {w0q[n].x, w0q[n].y, w0q[n].z, w0q[n].w};
#pragma unroll
            for (int m = 0; m < RM; ++m) {
                f32x4 o;
#pragma unroll
                for (int j = 0; j < 4; ++j) { const float wl = -softplusf_(-(w0a[j] + acc[m][n][j])) - 0.5f; o[j] = __expf(-__expf(wl)); }
                *(f32x4*)(decay + (size_t)(row0 + m * 16 + fr) * 1024 + c0 + n * 4) = o;
            }
        }
        minigemm<128>(Lg + (size_t)row0 * 128, g2t + (size_t)col0 * 128, fr, fq, acc);
#pragma unroll
        for (int m = 0; m < RM; ++m) {
            unsigned o[8];
#pragma unroll
            for (int n = 0; n < 4; ++n) { o[n * 2] = cvt_pk(acc[m][n][0], acc[m][n][1]); o[n * 2 + 1] = cvt_pk(acc[m][n][2], acc[m][n][3]); }
            bf16_t* d = gb + (size_t)(row0 + m * 16 + fr) * 1024 + c0;
            *(uint4*)d = make_uint4(o[0], o[1], o[2], o[3]); *(uint4*)(d + 8) = make_uint4(o[4], o[5], o[6], o[7]);
        }
        if (jr > 0) {
            minigemm<32>(Lv + (size_t)row0 * 32, v2t + (size_t)col0 * 32, fr, fq, acc);
#pragma unroll
            for (int m = 0; m < RM; ++m) {
                const size_t off = (size_t)(row0 + m * 16 + fr) * 1024 + c0;
                const uint4 vq0 = *(const uint4*)(vb + off), vq1 = *(const uint4*)(vb + off + 8), fq0 = *(const uint4*)(vf + off), fq1 = *(const uint4*)(vf + off + 8);
                const unsigned vw[8] = {vq0.x, vq0.y, vq0.z, vq0.w, vq1.x, vq1.y, vq1.z, vq1.w}, fw[8] = {fq0.x, fq0.y, fq0.z, fq0.w, fq1.x, fq1.y, fq1.z, fq1.w};
                unsigned o[8];
#pragma unroll
                for (int n = 0; n < 4; ++n) {
                    const float4 v0v = *(const float4*)(v0 + c0 + n * 4); const float v0a[4] = {v0v.x, v0v.y, v0v.z, v0v.w};
                    const float v4[4] = {bflo(vw[n * 2]), bfhi(vw[n * 2]), bflo(vw[n * 2 + 1]), bfhi(vw[n * 2 + 1])}, f4[4] = {bflo(fw[n * 2]), bfhi(fw[n * 2]), bflo(fw[n * 2 + 1]), bfhi(fw[n * 2 + 1])};
                    float o4[4];
#pragma unroll
                    for (int j = 0; j < 4; ++j) o4[j] = v4[j] + (f4[j] - v4[j]) * sigmoidf_(v0a[j] + acc[m][n][j]);
                    o[n * 2] = cvt_pk(o4[0], o4[1]); o[n * 2 + 1] = cvt_pk(o4[2], o4[3]);
                }
                *(uint4*)(vpb + off) = make_uint4(o[0], o[1], o[2], o[3]); *(uint4*)(vpb + off + 8) = make_uint4(o[4], o[5], o[6], o[7]);
            }
        }
    }
}
__device__ __forceinline__ void phase_rw3(PRef p, int jr, char* lds) {
    const int t = tidx(), lane = t & 63, wid = t >> 6, rowq = lane >> 4, jq = lane & 15;
    char* S = p.ws + OFF_SLOT;
    const float* decay = (const float*)S; const bf16_t* nkk = (const bf16_t*)(S + 2 * SLOT); const bf16_t* bb = (const bf16_t*)(S + 3 * SLOT);
    const bf16_t* rb = (const bf16_t*)(S + 6 * SLOT); const bf16_t* kb = (const bf16_t*)(S + 10 * SLOT);
    const bf16_t* vb = (const bf16_t*)(S + (jr == 0 ? 11 : 9) * SLOT); bf16_t* yb = (bf16_t*)(S + 5 * SLOT);
    float* buf = (float*)lds;
    float* ybuf = (float*)(lds + 2 * 16 * 336 * 4);
    for (int item = blockIdx.x; item < 512; item += gridDim.x) {
        const int bh = item >> 2, rg = item & 3, b = bh >> 4, h = bh & 15;
        const size_t base = (size_t)b * 2048 * 1024 + h * 64;
        const bf16_t* vecp[2]; int vdst[2];
#pragma unroll
        for (int u = 0; u < 2; ++u) {
            const int id = t + 256 * u, vec = id >> 7, rem = id & 127, step = rem >> 3, c8 = rem & 7;
            const bf16_t* bp = (vec == 0) ? nkk : (vec == 1) ? bb : (vec == 2) ? kb : rb;
            vecp[u] = bp + base + (size_t)step * 1024 + c8 * 8; vdst[u] = step * 336 + 64 + vec * 64 + c8 * 8;
        }
        const float* dp = decay + base + (size_t)(t >> 4) * 1024 + (t & 15) * 4; const int ddst = (t >> 4) * 336 + (t & 15) * 4;
        const bf16_t* vp = vb + base + (size_t)(t >> 1) * 1024 + rg * 16 + (t & 1) * 8; const int vvdst = (t >> 1) * 336 + 320 + (t & 1) * 8;
        uint4 g0, g1, gv; float4 gd;
        auto fetch = [&](int ch) {
            const size_t o = (size_t)ch * 16 * 1024;
            g0 = gload16(vecp[0] + o); g1 = gload16(vecp[1] + o);
            { const uint4 d_ = gload16(dp + o); gd = make_float4(__uint_as_float(d_.x), __uint_as_float(d_.y), __uint_as_float(d_.z), __uint_as_float(d_.w)); }
            if (t < 32) gv = gload16(vp + o);
        };
        auto stash = [&](float* bf) {
            float f[8];
            unpack8(g0, f); *(float4*)(bf + vdst[0]) = make_float4(f[0], f[1], f[2], f[3]); *(float4*)(bf + vdst[0] + 4) = make_float4(f[4], f[5], f[6], f[7]);
            unpack8(g1, f); *(float4*)(bf + vdst[1]) = make_float4(f[0], f[1], f[2], f[3]); *(float4*)(bf + vdst[1] + 4) = make_float4(f[4], f[5], f[6], f[7]);
            *(float4*)(bf + ddst) = gd;
            if (t < 32) { unpack8(gv, f); *(float4*)(bf + vvdst) = make_float4(f[0], f[1], f[2], f[3]); *(float4*)(bf + vvdst + 4) = make_float4(f[4], f[5], f[6], f[7]); }
        };
        float s0 = 0.f, s1 = 0.f, s2 = 0.f, s3 = 0.f;
        __syncthreads();
        fetch(0); stash(buf); __syncthreads();
        for (int ch = 0; ch < 128; ++ch) {
            if (ch + 1 < 128) fetch(ch + 1);
            const float* bf = buf + (ch & 1) * (16 * 336); float* yb_ = ybuf + (ch & 1) * 256;
            float ykeep = 0.f;
            const float* q0 = bf + jq * 4; const float* v0p = bf + 320 + wid * 4 + rowq;
            float4 nw = *(const float4*)q0, na = *(const float4*)(q0 + 64), nb2 = *(const float4*)(q0 + 128), nk = *(const float4*)(q0 + 192), nr = *(const float4*)(q0 + 256);
            float nv = v0p[0];
#pragma unroll 4
            for (int s = 0; s < 16; ++s) {
                const float4 w = nw, a = na, bq = nb2, k = nk, r = nr; const float vv = nv;
                const float* q = q0 + (s + 1) * 336;
                nw = *(const float4*)q; na = *(const float4*)(q + 64); nb2 = *(const float4*)(q + 128); nk = *(const float4*)(q + 192); nr = *(const float4*)(q + 256);
                nv = v0p[(s + 1) * 336];
                __builtin_amdgcn_sched_barrier(0);
                float sa = s0 * a.x; sa = fmaf(s1, a.y, sa); sa = fmaf(s2, a.z, sa); sa = fmaf(s3, a.w, sa);
                sa = row16_sum(sa);
                s0 = fmaf(s0, w.x, fmaf(sa, bq.x, vv * k.x)); s1 = fmaf(s1, w.y, fmaf(sa, bq.y, vv * k.y));
                s2 = fmaf(s2, w.z, fmaf(sa, bq.z, vv * k.z)); s3 = fmaf(s3, w.w, fmaf(sa, bq.w, vv * k.w));
                float y = s0 * r.x; y = fmaf(s1, r.y, y); y = fmaf(s2, r.z, y); y = fmaf(s3, r.w, y);
                y = row16_sum(y);
                ykeep = (jq == s) ? y : ykeep;
            }
            yb_[jq * 16 + wid * 4 + rowq] = ykeep;
            if (ch + 1 < 128) stash(buf + ((ch + 1) & 1) * (16 * 336));
            __syncthreads();
            if (t < 32) { const int step = t >> 1, hf = t & 1; float f[8];
#pragma unroll
                for (int i = 0; i < 8; ++i) f[i] = yb_[step * 16 + hf * 8 + i];
                *(uint4*)(yb + base + (size_t)(ch * 16 + step) * 1024 + rg * 16 + hf * 8) = pack8(f); }
        }
    }
}
__device__ __forceinline__ uint2 lds_tr16(const char* p) {
    typedef short v4s_t __attribute__((ext_vector_type(4)));
    const v4s_t r = __builtin_amdgcn_ds_read_tr16_b64_v4i16((LAS v4s_t*)p);
    uint2 u; __builtin_memcpy(&u, &r, 8); return u;
}
__device__ __forceinline__ int sw64(int row, int col) { return row * 128 + ((((col >> 3) ^ (row & 7))) << 4) + (col & 7) * 2; }
__device__ __forceinline__ void phase_rw3c(PRef p, int jr, char* lds) {
    const int t = tidx(), lane = t & 63, w = t >> 6, fr = lane & 15, fq = lane >> 4;
    char* S = p.ws + OFF_SLOT;
    const float* decay = (const float*)S; const bf16_t* nkk = (const bf16_t*)(S + 2 * SLOT); const bf16_t* bb = (const bf16_t*)(S + 3 * SLOT);
    const bf16_t* rb = (const bf16_t*)(S + 6 * SLOT); const bf16_t* kb = (const bf16_t*)(S + 10 * SLOT);
    const bf16_t* vb = (const bf16_t*)(S + (jr == 0 ? 11 : 9) * SLOT); bf16_t* yb = (bf16_t*)(S + 5 * SLOT);
    char* const AT = lds;              char* const RT = lds + 4096;  char* const BT = lds + 8192;  char* const KT = lds + 12288;
    float* const PL = (float*)(lds + 16384);
    float* const GAB = (float*)(lds + 43264);
    char* const GAK = lds + 28672;     char* const GRB = lds + 30720; char* const GRK = lds + 32768;
    char* const VT = lds + 34816;      char* const UT = lds + 35840;
    char* const SB = lds + 36864;
    float* const XL = (float*)(lds + 38912);
    float* const PC = (float*)(lds + 40960);
    float* const GS = (float*)(lds + 41216);
    bf16_t* const YB = (bf16_t*)(lds + 42240);
    const int pj = t & 63, ptg = t >> 6;
    const int tk = t >> 3, ck = t & 7;
    const int vtau = t >> 3, vi2 = (t & 7) * 2;
    const int qq = fr >> 2, pp = fr & 3;
    for (int item = blockIdx.x; item < 512; item += gridDim.x) {
        const int bh = ((item >> 3) >> 2) * 8 + (item & 7), rg = (item >> 3) & 3, b = bh >> 4, h = bh & 15;
        const size_t base = (size_t)b * 2048 * 1024 + h * 64;
        __syncthreads();
        for (int i = t; i < 128; i += 256) *(uint4*)(SB + i * 16) = make_uint4(0u, 0u, 0u, 0u);
        f32x4 Sacc = (f32x4){0.f, 0.f, 0.f, 0.f};
        float gw[8]; uint4 ra, rb4, rk, rr, rw0, rw1; unsigned gvv = 0;
        auto fetch = [&](int c) {
#pragma unroll
            for (int s2 = 0; s2 < 8; ++s2) gw[s2] = *(const __attribute__((address_space(1))) float*)(decay + base + (size_t)(c * 32 + ptg * 8 + s2) * 1024 + pj);
            const size_t o = base + (size_t)(c * 32 + tk) * 1024 + ck * 8;
            ra = gload16(nkk + o); rb4 = gload16(bb + o); rk = gload16(kb + o); rr = gload16(rb + o); rw0 = gload16(decay + o); rw1 = gload16(decay + o + 4);
            gvv = *(const __attribute__((address_space(1))) unsigned*)(vb + base + (size_t)(c * 32 + vtau) * 1024 + rg * 16 + vi2);
        };
        fetch(0);
        for (int c = 0; c < 64; ++c) {
            {
                float cum[8]; float run = 1.f;
#pragma unroll
                for (int s2 = 0; s2 < 8; ++s2) { run *= gw[s2]; cum[s2] = run; }
                GS[ptg * 64 + pj] = run;
                __syncthreads();
                const float g0 = GS[pj], g1 = GS[64 + pj], g2 = GS[128 + pj], g3 = GS[192 + pj];
                const float off = (ptg > 0 ? g0 : 1.f) * (ptg > 1 ? g1 : 1.f) * (ptg > 2 ? g2 : 1.f);
                if (ptg == 0) PC[pj] = (g0 * g1) * (g2 * g3);
#pragma unroll
                for (int s2 = 0; s2 < 8; ++s2) PL[(ptg * 8 + s2) * 64 + pj] = off * cum[s2];
            }
            __syncthreads();
            {
                const float4 p0 = *(const float4*)(PL + tk * 64 + ck * 8), p1 = *(const float4*)(PL + tk * 64 + ck * 8 + 4);
                const unsigned ua[4] = {ra.x, ra.y, ra.z, ra.w}, ub[4] = {rb4.x, rb4.y, rb4.z, rb4.w}, uk[4] = {rk.x, rk.y, rk.z, rk.w}, ur[4] = {rr.x, rr.y, rr.z, rr.w};
                const f32x2_t Pp[4] = {{p0.x, p0.y}, {p0.z, p0.w}, {p1.x, p1.y}, {p1.z, p1.w}};
                const f32x2_t Wp[4] = {{__uint_as_float(rw0.x), __uint_as_float(rw0.y)}, {__uint_as_float(rw0.z), __uint_as_float(rw0.w)}, {__uint_as_float(rw1.x), __uint_as_float(rw1.y)}, {__uint_as_float(rw1.z), __uint_as_float(rw1.w)}};
                unsigned oa[4], orr[4], ob[4], ok[4];
#pragma unroll
                for (int i = 0; i < 4; ++i) {
                    const f32x2_t ei = {__builtin_amdgcn_rcpf(Pp[i].x), __builtin_amdgcn_rcpf(Pp[i].y)};
                    const f32x2_t rw = {__builtin_amdgcn_rcpf(Wp[i].x), __builtin_amdgcn_rcpf(Wp[i].y)};
                    const f32x2_t ex = Pp[i] * rw;
                    const f32x2_t va = {__uint_as_float(ua[i] << 16), __uint_as_float(ua[i] & 0xffff0000u)}, vr = {__uint_as_float(ur[i] << 16), __uint_as_float(ur[i] & 0xffff0000u)};
                    const f32x2_t vb2 = {__uint_as_float(ub[i] << 16), __uint_as_float(ub[i] & 0xffff0000u)}, vk = {__uint_as_float(uk[i] << 16), __uint_as_float(uk[i] & 0xffff0000u)};
                    const f32x2_t xa = va * ex, xr = vr * Pp[i], xb = vb2 * ei, xk = vk * ei;
                    oa[i] = cvt_pk(xa.x, xa.y); orr[i] = cvt_pk(xr.x, xr.y); ob[i] = cvt_pk(xb.x, xb.y); ok[i] = cvt_pk(xk.x, xk.y);
                }
                const int o = tk * 128 + ((ck ^ (tk & 7)) << 4);
                *(uint4*)(AT + o) = make_uint4(oa[0], oa[1], oa[2], oa[3]); *(uint4*)(RT + o) = make_uint4(orr[0], orr[1], orr[2], orr[3]);
                *(uint4*)(BT + o) = make_uint4(ob[0], ob[1], ob[2], ob[3]); *(uint4*)(KT + o) = make_uint4(ok[0], ok[1], ok[2], ok[3]);
                *(bf16_t*)(VT + vi2 * 64 + vtau * 2) = (bf16_t)(gvv & 0xffffu);
                *(bf16_t*)(VT + (vi2 + 1) * 64 + vtau * 2) = (bf16_t)(gvv >> 16);
            }
            if (c + 1 < 64) fetch(c + 1);
            __syncthreads();
            {
                const char* Mt = (w < 2) ? AT : RT; const char* Nt = (w & 1) ? BT : KT;
                f32x4 g[2][2];
#pragma unroll
                for (int m = 0; m < 2; ++m) { g[m][0] = (f32x4){0.f, 0.f, 0.f, 0.f}; g[m][1] = (f32x4){0.f, 0.f, 0.f, 0.f}; }
#pragma unroll
                for (int ks = 0; ks < 2; ++ks) {
                    const int chs = ((ks * 4 + fq) ^ (fr & 7)) << 4;
                    uint4 mf[2], nf[2];
#pragma unroll
                    for (int m = 0; m < 2; ++m) { mf[m] = *(const uint4*)(Mt + (m * 16 + fr) * 128 + chs); nf[m] = *(const uint4*)(Nt + (m * 16 + fr) * 128 + chs); }
#pragma unroll
                    for (int m = 0; m < 2; ++m)
#pragma unroll
                        for (int n = 0; n < 2; ++n) g[m][n] = mfma16(nf[n], mf[m], g[m][n]);
                }
#pragma unroll
                for (int m = 0; m < 2; ++m)
#pragma unroll
                    for (int n = 0; n < 2; ++n) {
                        const int tt = m * 16 + fr, tau0 = n * 16 + fq * 4;
                        f32x4 v4;
#pragma unroll
                        for (int j = 0; j < 4; ++j) { const int tau = tau0 + j; const bool keep = (w < 2) ? (tau < tt) : (tau <= tt); v4[j] = keep ? g[m][n][j] : 0.f; }
                        if (w == 1) *(f32x4*)(GAB + tt * 36 + tau0) = v4;
                        else {
                            char* G = (w == 0) ? GAK : (w == 2) ? GRK : GRB;
                            uint2 o; o.x = cvt_pk(v4[0], v4[1]); o.y = cvt_pk(v4[2], v4[3]);
                            *(uint2*)(G + tt * 64 + tau0 * 2) = o;
                        }
                    }
            }
            __syncthreads();
            if (w < 2) {
                f32x4 x = (f32x4){0.f, 0.f, 0.f, 0.f};
#pragma unroll
                for (int ks = 0; ks < 2; ++ks) {
                    const int chs = ((ks * 4 + fq) ^ (fr & 7)) << 4;
                    x = mfma16(*(const uint4*)(AT + (w * 16 + fr) * 128 + chs), *(const uint4*)(SB + fr * 128 + chs), x);
                }
                x = mfma16(*(const uint4*)(GAK + (w * 16 + fr) * 64 + fq * 16), *(const uint4*)(VT + fr * 64 + fq * 16), x);
                *(f32x4*)(XL + fr * 32 + w * 16 + fq * 4) = x;
            }
            __syncthreads();
            {
                const int tl = lane & 31;
                float Gr[32];
#pragma unroll
                for (int q4 = 0; q4 < 8; ++q4) { const float4 g4 = *(const float4*)(GAB + tl * 36 + q4 * 4); Gr[q4 * 4] = g4.x; Gr[q4 * 4 + 1] = g4.y; Gr[q4 * 4 + 2] = g4.z; Gr[q4 * 4 + 3] = g4.w; }
                float acc[4];
#pragma unroll
                for (int r = 0; r < 4; ++r) acc[r] = XL[(4 * w + r) * 32 + tl];
#pragma unroll
                for (int tau = 0; tau < 31; ++tau)
#pragma unroll
                    for (int r = 0; r < 4; ++r) acc[r] = fmaf(__int_as_float(__builtin_amdgcn_readlane(__float_as_int(acc[r]), tau)), Gr[tau], acc[r]);
                if (lane < 32) {
#pragma unroll
                    for (int r = 0; r < 4; ++r) *(bf16_t*)(UT + (4 * w + r) * 64 + tl * 2) = f2bf(acc[r]);
                }
            }
            __syncthreads();
            if (w < 2) {
                f32x4 y = (f32x4){0.f, 0.f, 0.f, 0.f};
#pragma unroll
                for (int ks = 0; ks < 2; ++ks) {
                    const int chs = ((ks * 4 + fq) ^ (fr & 7)) << 4;
                    y = mfma16(*(const uint4*)(RT + (w * 16 + fr) * 128 + chs), *(const uint4*)(SB + fr * 128 + chs), y);
                }
                y = mfma16(*(const uint4*)(GRB + (w * 16 + fr) * 64 + fq * 16), *(const uint4*)(UT + fr * 64 + fq * 16), y);
                y = mfma16(*(const uint4*)(GRK + (w * 16 + fr) * 64 + fq * 16), *(const uint4*)(VT + fr * 64 + fq * 16), y);
#pragma unroll
                for (int j = 0; j < 4; ++j) YB[(w * 16 + fq * 4 + j) * 16 + fr] = f2bf(y[j]);
            }
            {
                const int r0 = fq * 8 + qq, kc = 2 * w + (pp >> 1);
                const int o0 = r0 * 128 + ((kc ^ (r0 & 7)) << 4) + (pp & 1) * 8, o1 = (r0 + 4) * 128 + ((kc ^ ((r0 + 4) & 7)) << 4) + (pp & 1) * 8;
                const uint2 blo = lds_tr16(BT + o0), bhi = lds_tr16(BT + o1), klo = lds_tr16(KT + o0), khi = lds_tr16(KT + o1);
                Sacc = mfma16(make_uint4(blo.x, blo.y, bhi.x, bhi.y), *(const uint4*)(UT + fr * 64 + fq * 16), Sacc);
                Sacc = mfma16(make_uint4(klo.x, klo.y, khi.x, khi.y), *(const uint4*)(VT + fr * 64 + fq * 16), Sacc);
                const float4 pc = *(const float4*)(PC + 16 * w + fq * 4);
                Sacc[0] *= pc.x; Sacc[1] *= pc.y; Sacc[2] *= pc.z; Sacc[3] *= pc.w;
            }
            __syncthreads();
            {
                uint2 o; o.x = cvt_pk(Sacc[0], Sacc[1]); o.y = cvt_pk(Sacc[2], Sacc[3]);
                *(uint2*)(SB + fr * 128 + ((((2 * w + (fq >> 1))) ^ (fr & 7)) << 4) + (fq & 1) * 8) = o;
                if (t < 64) {
                    const int tt = t >> 1, hf = t & 1;
                    const uint4 yv_ = *(const uint4*)((const char*)YB + tt * 32 + hf * 16); const u32x4_t yx_ = {yv_.x, yv_.y, yv_.z, yv_.w};
                    *(__attribute__((address_space(1))) u32x4_t*)(yb + base + (size_t)(c * 32 + tt) * 1024 + rg * 16 + hf * 8) = yx_;
                }
            }
        }
    }
}
struct LdRw4 {
    struct Raw { uint4 y, v, g; float bn; };
    const bf16_t *y, *v, *g; const float *bonus, *gng, *gnb;
    __device__ __forceinline__ Raw fetch(int, int r, int kc) const {
        Raw q; const size_t o = (size_t)r * 1024 + kc * 8;
        q.y = *(const uint4*)(y + o); q.v = *(const uint4*)(v + o); q.g = *(const uint4*)(g + o); q.bn = bonus[r * 16 + (kc >> 3)]; return q;
    }
    __device__ __forceinline__ uint4 finish(const Raw& q, int, int, int kc) const {
        float yf[8], vf[8], gf[8]; unpack8(q.y, yf); unpack8(q.v, vf); unpack8(q.g, gf);
        float s = 0.f, s2 = 0.f;
#pragma unroll
        for (int i = 0; i < 8; ++i) { s += yf[i]; s2 += yf[i] * yf[i]; }
        s = oct_sum(s); s2 = oct_sum(s2);
        const float mean = s * (1.0f / 64.0f), var = fmaxf(s2 * (1.0f / 64.0f) - mean * mean, 0.f), rstd = rsqrtf(var + 64e-5f);
        const float4 ga = *(const float4*)(gng + kc * 8), gb = *(const float4*)(gng + kc * 8 + 4), ba = *(const float4*)(gnb + kc * 8), bb = *(const float4*)(gnb + kc * 8 + 4);
        const float gg[8] = {ga.x, ga.y, ga.z, ga.w, gb.x, gb.y, gb.z, gb.w}, bq[8] = {ba.x, ba.y, ba.z, ba.w, bb.x, bb.y, bb.z, bb.w};
        float o[8];
#pragma unroll
        for (int i = 0; i < 8; ++i) o[i] = ((yf[i] - mean) * rstd * gg[i] + bq[i] + q.bn * vf[i]) * gf[i];
        return pack8(o);
    }
};
__device__ __forceinline__ void phase_rw4(PRef p, int jr, char* lds) {
    char* S = p.ws + OFF_SLOT;
    const bf16_t* yb = (const bf16_t*)(S + 5 * SLOT); const bf16_t* gb = (const bf16_t*)(S + 4 * SLOT);
    const bf16_t* vb = (const bf16_t*)(S + (jr == 0 ? 11 : 9) * SLOT); bf16_t* ymix = (bf16_t*)(S + 6 * SLOT);
    const bf16_t* wt = (const bf16_t*)(p.ws + W_OUT) + (size_t)jr * 1024 * 1024;
    const float* bonus = (const float*)(p.ws + OFF_BONUS);
    const int t_ = tidx(); const int lane = t_ & 63, wid = t_ >> 6, wr = wid >> 1, wc = wid & 1, fr = lane & 15, fq = lane >> 4;
    for (int id = blockIdx.x; id < 128 * 8; id += gridDim.x) {
        int mt, nt; tile_map(id, 8, mt, nt);
        const size_t ro = (size_t)mt * 128 * 1024;
        LdRw4 al{yb + ro, vb + ro, gb + ro, bonus + (size_t)mt * 128 * 16, p.in[22] + jr * 1024, p.in[23] + jr * 1024};
        const bf16_t* br[4];
        { const int t2_ = tidx(), r0_ = t2_ >> 3, co_ = glds_chunk(t2_) * 8;
#pragma unroll
          for (int i = 0; i < 4; ++i) br[i] = wt + (size_t)(nt * 128 + r0_ + 32 * i) * 1024 + co_; }
        f32x4 acc[4][4];
        gemm_rg(lds, 16, al, br, acc);
#pragma unroll
        for (int n = 0; n < 4; ++n)
#pragma unroll
            for (int m = 0; m < 4; ++m) {
                uint2 o; o.x = cvt_pk(acc[m][n][0], acc[m][n][1]); o.y = cvt_pk(acc[m][n][2], acc[m][n][3]);
                *(uint2*)(ymix + (size_t)(mt * 128 + wr * 64 + m * 16 + fr) * 1024 + nt * 128 + wc * 64 + n * 16 + fq * 4) = o;
            }
    }
}

__device__ __forceinline__ void phase_cml(PRef p) {
    const int t = tidx();
    char* S = p.ws + OFF_SLOT;
    const bf16_t* src = (const bf16_t*)(S + 1 * SLOT); bf16_t* dst = (bf16_t*)(S + 8 * SLOT);
    const int col = (t & 127) * 8, half = t >> 7;
    float cw[4][8], cb[8];
#pragma unroll
    for (int j = 0; j < 4; ++j) {
        const float4 a = *(const float4*)(p.in[27] + j * 1024 + col), b = *(const float4*)(p.in[27] + j * 1024 + col + 4);
        cw[j][0] = a.x; cw[j][1] = a.y; cw[j][2] = a.z; cw[j][3] = a.w; cw[j][4] = b.x; cw[j][5] = b.y; cw[j][6] = b.z; cw[j][7] = b.w;
    }
    { const float4 a = *(const float4*)(p.in[28] + col), b = *(const float4*)(p.in[28] + col + 4);
      cb[0] = a.x; cb[1] = a.y; cb[2] = a.z; cb[3] = a.w; cb[4] = b.x; cb[5] = b.y; cb[6] = b.z; cb[7] = b.w; }
    const float qs = (col < 512) ? 0.125f : 1.0f;
    for (int item = blockIdx.x; item < 1024; item += gridDim.x) {
        const int b = item >> 7, s0 = (item & 127) * 16 + half * 8;
        const bf16_t* base = src + (size_t)b * 2048 * 1024 + col;
        uint4 r[11];
#pragma unroll
        for (int i = 0; i < 11; ++i) { const int sr = s0 - 3 + i; r[i] = gload16(base + (size_t)max(sr, 0) * 1024); if (sr < 0) r[i] = make_uint4(0u, 0u, 0u, 0u); }
        float x0[8], x1[8], x2[8];
        unpack8(r[0], x0); unpack8(r[1], x1); unpack8(r[2], x2);
#pragma unroll
        for (int i = 0; i < 8; ++i) {
            float x3[8], a[8]; unpack8(r[i + 3], x3);
#pragma unroll
            for (int e = 0; e < 8; ++e) { a[e] = cb[e] + cw[0][e] * x0[e] + cw[1][e] * x1[e] + cw[2][e] * x2[e] + cw[3][e] * x3[e]; a[e] = siluf_(a[e]) * qs; }
            *(uint4*)(dst + ((size_t)b * 2048 + s0 + i) * 1024 + col) = pack8(a);
#pragma unroll
            for (int e = 0; e < 8; ++e) { x0[e] = x1[e]; x1[e] = x2[e]; x2[e] = x3[e]; }
        }
    }
}
__device__ __forceinline__ void phase_ml2(PRef p, char* lds) {
    const int t = tidx(), lane = t & 63, w = t >> 6, fr = lane & 15, fq = lane >> 4;
    char* S = p.ws + OFF_SLOT;
    const bf16_t* qk = (const bf16_t*)(S + 8 * SLOT); const bf16_t* vb = (const bf16_t*)(S + 2 * SLOT); bf16_t* yb = (bf16_t*)(S + 4 * SLOT);
    const float* gates = (const float*)(p.ws + OFF_GATES); float* stat = (float*)(p.ws + OFF_STAT);
    char* const RAW = lds;
    char* const QT = lds + 17408; char* const KT = lds + 25600;
    char* const VT = lds + 33792;
    char* const VX = lds + 35840;
    char* const PB = lds + 39936;
    char* const CT = lds + 48128;
    float* const FS = (float*)(lds + 52224); float* const GJ = FS + 64; float* const WJ = FS + 128;
    float* const CW = (float*)(lds + 53248);
    const int qq = fr >> 2, pp = fr & 3;
    for (int item = blockIdx.x; item < 512; item += gridDim.x) {
        const int bh = ((item >> 3) >> 3) * 8 + (item & 7), vs = (item >> 3) & 7, b = bh >> 3, hd = bh & 7;
        const size_t tok0 = (size_t)b * 2048;
        __syncthreads();
        for (int i = t; i < 256; i += 256) *(uint4*)(CT + i * 16) = make_uint4(0u, 0u, 0u, 0u);
        f32x4 Cacc[2] = {(f32x4){0.f, 0.f, 0.f, 0.f}, (f32x4){0.f, 0.f, 0.f, 0.f}};
        uint4 gr0, gr1, gr2, gr3; uint4 gv = make_uint4(0u, 0u, 0u, 0u); float gg = 0.f;
        const int frr = t >> 4, fc = t & 15;
        const bf16_t* const qkt = qk + (tok0 + frr) * 1024 + (fc >> 3) * 512 + hd * 64 + (fc & 7) * 8;
        char* const qkd = ((fc < 8) ? QT : KT) + frr * 128 + (((fc & 7) ^ (frr & 7)) << 4);
        auto fetch = [&](int ch) {
            const int s0 = ch * 64;
            const bf16_t* q0 = qkt + (size_t)s0 * 1024;
            gr0 = gload16(q0); gr1 = gload16(q0 + 16 * 1024); gr2 = gload16(q0 + 32 * 1024); gr3 = gload16(q0 + 48 * 1024);
            if (t < 128) { gv = gload16(vb + (tok0 + s0 + (t >> 1)) * 1024 + hd * 128 + vs * 16 + (t & 1) * 8);
                           gg = *(const __attribute__((address_space(1))) float*)(gates + (tok0 + s0 + (t & 63)) * 16 + (t >> 6) * 8 + hd); }
        };
        fetch(0);
        for (int ch = 0; ch < 32; ++ch) {
            const int s0 = ch * 64;
            *(uint4*)qkd = gr0; *(uint4*)(qkd + 16 * 128) = gr1; *(uint4*)(qkd + 32 * 128) = gr2; *(uint4*)(qkd + 48 * 128) = gr3;
            if (t < 128) *(uint4*)(VT + t * 16) = gv;
            float vf8[8]; unpack8(gv, vf8);
            if (t >= 64 && t < 128) GJ[t - 64] = gg;
            const float ggc = gg;
            if (ch + 1 < 32) fetch(ch + 1);
            __syncthreads();
            if (t < 64) {
                float f = GJ[t];
#pragma unroll
                for (int o = 1; o < 64; o <<= 1) { const float u2 = __shfl_up(f, o); if (t >= o) f += u2; }
                const float fend = __shfl(f, 63);
                FS[t] = f; WJ[t] = __expf(fend - f + ggc);
                GJ[t] = ggc - f;
            }
            __syncthreads();
            const float efend = __expf(FS[63]);
            {
                if (t < 128) {
                    const int j = t >> 1; const float wj = WJ[j];
                    float f[8];
#pragma unroll
                    for (int i = 0; i < 8; ++i) f[i] = vf8[i] * wj;
                    *(uint4*)(VX + j * 64 + (t & 1) * 16) = pack8(f);
                    float g8[8] = {0.f, 0.f, 0.f, 0.f, 0.f, 0.f, 0.f, 0.f}; if ((t & 1) == 0) g8[0] = wj;
                    *(uint4*)(VX + j * 64 + 32 + (t & 1) * 16) = pack8(g8);
                }
            }
            __syncthreads();
            const int srow = 16 * w + fr;
            f32x4 Sacc[4], Xacc[2];
#pragma unroll
            for (int n = 0; n < 4; ++n) Sacc[n] = (f32x4){0.f, 0.f, 0.f, 0.f};
            Xacc[0] = (f32x4){0.f, 0.f, 0.f, 0.f}; Xacc[1] = (f32x4){0.f, 0.f, 0.f, 0.f};
            Cacc[0] *= efend; Cacc[1] *= efend;
#pragma unroll
            for (int ks = 0; ks < 2; ++ks) {
                const int chs = ((ks * 4 + fq) ^ (fr & 7)) << 4;
                const uint4 qf = *(const uint4*)(QT + srow * 128 + chs);
#pragma unroll
                for (int n = 0; n < 4; ++n) { const uint4 kf = *(const uint4*)(KT + (n * 16 + fr) * 128 + chs); Sacc[n] = mfma16(kf, qf, Sacc[n]); }
#pragma unroll
                for (int nn = 0; nn < 2; ++nn) { const uint4 rf = *(const uint4*)(CT + (nn * 16 + fr) * 128 + chs); Xacc[nn] = mfma16(rf, qf, Xacc[nn]); }
                const int r0 = ks * 32 + fq * 8 + qq, kc = 2 * w + (pp >> 1);
                const uint2 klo = lds_tr16(KT + r0 * 128 + ((kc ^ (r0 & 7)) << 4) + (pp & 1) * 8);
                const uint2 khi = lds_tr16(KT + (r0 + 4) * 128 + ((kc ^ ((r0 + 4) & 7)) << 4) + (pp & 1) * 8);
                const uint4 kt = make_uint4(klo.x, klo.y, khi.x, khi.y);
#pragma unroll
                for (int m = 0; m < 2; ++m) {
                    const uint2 vlo = lds_tr16(VX + r0 * 64 + (16 * m + 4 * pp) * 2), vhi = lds_tr16(VX + (r0 + 4) * 64 + (16 * m + 4 * pp) * 2);
                    Cacc[m] = mfma16(kt, make_uint4(vlo.x, vlo.y, vhi.x, vhi.y), Cacc[m]);
                }
            }
            const float fs = FS[srow];
            float dsum = 0.f;
#pragma unroll
            for (int n = 0; n < 4; ++n) {
                const float4 g4 = *(const float4*)(GJ + n * 16 + fq * 4); const float ga[4] = {g4.x, g4.y, g4.z, g4.w};
                float pv[4];
#pragma unroll
                for (int j = 0; j < 4; ++j) { const int jc = n * 16 + fq * 4 + j; pv[j] = (srow >= jc) ? Sacc[n][j] * __expf(fs + ga[j]) : 0.f; dsum += pv[j]; }
                uint2 o; o.x = cvt_pk(pv[0], pv[1]); o.y = cvt_pk(pv[2], pv[3]);
                *(uint2*)(PB + srow * 128 + (((n * 2 + (fq >> 1)) ^ (fr & 7)) << 4) + (fq & 1) * 8) = o;
            }
            dsum += __shfl_xor(dsum, 16); dsum += __shfl_xor(dsum, 32);
            f32x4 Iacc = (f32x4){0.f, 0.f, 0.f, 0.f};
#pragma unroll
            for (int ks = 0; ks < 2; ++ks) {
                const uint4 pf = *(const uint4*)(PB + srow * 128 + (((ks * 4 + fq) ^ (fr & 7)) << 4));
                const int r0 = ks * 32 + fq * 8 + qq;
                const uint2 vlo = lds_tr16(VT + r0 * 32 + (4 * pp) * 2), vhi = lds_tr16(VT + (r0 + 4) * 32 + (4 * pp) * 2);
                Iacc = mfma16(make_uint4(vlo.x, vlo.y, vhi.x, vhi.y), pf, Iacc);
            }
            const float efs = __expf(fs);
            const float ndq = __shfl(Xacc[1][0], fr);
            const float den = dsum + efs * ndq;
            const float rden = 1.0f / fmaxf(fabsf(den), 1.0f);
            const size_t tok = tok0 + s0 + srow;
            float o4[4], ssum = 0.f, ssq = 0.f;
#pragma unroll
            for (int j = 0; j < 4; ++j) { o4[j] = (Iacc[j] + efs * Xacc[0][j]) * rden; ssum += o4[j]; ssq += o4[j] * o4[j]; }
            gst_u2(yb + tok * 1024 + hd * 128 + vs * 16 + fq * 4, cvt_pk(o4[0], o4[1]), cvt_pk(o4[2], o4[3]));
            ssum += __shfl_xor(ssum, 16); ssum += __shfl_xor(ssum, 32); ssq += __shfl_xor(ssq, 16); ssq += __shfl_xor(ssq, 32);
            if (fq == 0) gst_u2(stat + ((tok * 8 + hd) * 8 + vs) * 2, __float_as_uint(ssum), __float_as_uint(ssq));
            __syncthreads();
#pragma unroll
            for (int m = 0; m < 2; ++m) {
                const int v = m * 16 + fr;
                uint2 o; o.x = cvt_pk(Cacc[m][0], Cacc[m][1]); o.y = cvt_pk(Cacc[m][2], Cacc[m][3]);
                *(uint2*)(CT + v * 128 + (((2 * w + (fq >> 1)) ^ (v & 7)) << 4) + (fq & 1) * 8) = o;
            }
        }
    }
}
template <int HSHIFT  , int NH>
struct LdGnGate {
    struct Raw { uint4 y, g; };
    const bf16_t *y, *g; int ld; const float *gng, *gnb; const float* st;
    __device__ __forceinline__ Raw fetch(int, int r, int kc) const { Raw q; const size_t o = (size_t)r * ld + kc * 8; q.y = *(const uint4*)(y + o); q.g = *(const uint4*)(g + o); return q; }
    __device__ __forceinline__ uint4 finish(const Raw& q, int, int r, int kc) const {
        float yf[8], gf[8]; unpack8(q.y, yf); unpack8(q.g, gf);
        const float2 ms = *(const float2*)(st + (r * NH + ((kc * 8) >> HSHIFT)) * 2);
        const float4 ga = *(const float4*)(gng + kc * 8), gb = *(const float4*)(gng + kc * 8 + 4), ba = *(const float4*)(gnb + kc * 8), bb = *(const float4*)(gnb + kc * 8 + 4);
        const float gg[8] = {ga.x, ga.y, ga.z, ga.w, gb.x, gb.y, gb.z, gb.w}, bq[8] = {ba.x, ba.y, ba.z, ba.w, bb.x, bb.y, bb.z, bb.w};
        float o[8];
#pragma unroll
        for (int i = 0; i < 8; ++i) o[i] = ((yf[i] - ms.x) * ms.y * gg[i] + bq[i]) * gf[i];
        return pack8(o);
    }
};
template <int HSHIFT, int NH, int NPART>
__device__ __forceinline__ void phase_outproj_gn(PRef p, char* lds, const bf16_t* yb, const bf16_t* gate, int K, const bf16_t* wt, const float* gng, const float* gnb, bf16_t* ymix) {
    const int t = tidx(), lane = t & 63, wid = t >> 6, wr = wid >> 1, wc = wid & 1, fr = lane & 15, fq = lane >> 4;
    const float* stat = (const float*)(p.ws + OFF_STAT);
    float* st = (float*)(lds + 65536);
    const float invn = 1.0f / (float)(1 << HSHIFT);
    for (int id = blockIdx.x; id < 128 * 8; id += gridDim.x) {
        int mt, nt; tile_map(id, 8, mt, nt);
        for (int i = t; i < 128 * NH; i += 256) {
            const float* q = stat + ((size_t)mt * 128 * NH + i) * NPART * 2;
            float s = 0.f, s2 = 0.f;
#pragma unroll
            for (int j = 0; j < NPART; ++j) { const float2 v = *(const float2*)(q + j * 2); s += v.x; s2 += v.y; }
            const float mean = s * invn, var = fmaxf(s2 * invn - mean * mean, 0.f);
            st[i * 2] = mean; st[i * 2 + 1] = rsqrtf(var + 1e-6f);
        }
        __syncthreads();
        const size_t ro = (size_t)mt * 128 * K;
        LdGnGate<HSHIFT, NH> al{yb + ro, gate + ro, K, gng, gnb, st};
        const bf16_t* br[4];
        { const int r0_ = t >> 3, co_ = glds_chunk(t) * 8;
#pragma unroll
          for (int i = 0; i < 4; ++i) br[i] = wt + (size_t)(nt * 128 + r0_ + 32 * i) * K + co_; }
        f32x4 acc[4][4];
        gemm_rg(lds, K / 64, al, br, acc);
#pragma unroll
        for (int n = 0; n < 4; ++n)
#pragma unroll
            for (int m = 0; m < 4; ++m) {
                uint2 o; o.x = cvt_pk(acc[m][n][0], acc[m][n][1]); o.y = cvt_pk(acc[m][n][2], acc[m][n][3]);
                *(uint2*)(ymix + (size_t)(mt * 128 + wr * 64 + m * 16 + fr) * 1024 + nt * 128 + wc * 64 + n * 16 + fq * 4) = o;
            }
    }
}

__device__ __forceinline__ void phase_rt2(PRef p, char* lds) {
    const int t = tidx(), lane = t & 63, w = t >> 6, fr = lane & 15, fq = lane >> 4;
    char* S = p.ws + OFF_SLOT;
    const bf16_t* qb = (const bf16_t*)(S + 1 * SLOT); const bf16_t* kb = (const bf16_t*)(S + 2 * SLOT); const bf16_t* vb = (const bf16_t*)(S + 3 * SLOT);
    bf16_t* yb = (bf16_t*)(S + 7 * SLOT); float* stat = (float*)(p.ws + OFF_STAT);
    char* const VB = lds + 32768; char* const PB = lds + 49152; char* const RT = lds + 57344;
    const int gco = glds_chunk(t) * 8, gr0 = t >> 3;
    const int qq = fr >> 2, pp = fr & 3;
    for (int item = blockIdx.x; item < 512; item += gridDim.x) {
        const int bh = ((item >> 3) >> 4) * 8 + (item & 7), vs = (item >> 3) & 15, b = bh >> 2, hd = bh & 3;
        const size_t tok0 = (size_t)b * 2048;
        const float lg2 = log2f(1.0f - __builtin_amdgcn_exp2f(-5.0f - (float)hd));
        const float dec64 = __builtin_amdgcn_exp2f(64.0f * lg2);
        const bf16_t* qsrc = qb + (tok0 + gr0) * 1024 + hd * 256 + gco;
        const bf16_t* ksrc = kb + (tok0 + gr0) * 1024 + hd * 256 + gco;
        const bf16_t* vsrc = vb + (tok0 + (t >> 2)) * 2048 + hd * 512 + vs * 32 + (t & 3) * 8;
        f32x4 Racc[4][2];
#pragma unroll
        for (int a = 0; a < 4; ++a) { Racc[a][0] = (f32x4){0.f, 0.f, 0.f, 0.f}; Racc[a][1] = (f32x4){0.f, 0.f, 0.f, 0.f}; }
        __syncthreads();
        for (int i = t; i < 1024; i += 256) *(uint4*)(RT + i * 16) = make_uint4(0u, 0u, 0u, 0u);
        auto issue = [&](int pc) {
            const unsigned d = (unsigned)__builtin_amdgcn_readfirstlane((int)(lds_addr_u(lds) + (pc & 1) * 16384 + w * 1024));
            const size_t go = (size_t)(pc >> 2) * 64 * 1024 + (pc & 3) * 64;
#pragma unroll
            for (int i = 0; i < 2; ++i) { glds16_asm(qsrc + go + (size_t)i * 32 * 1024, d + i * 4096); glds16_asm(ksrc + go + (size_t)i * 32 * 1024, d + 8192 + i * 4096); }
        };
        auto put_v = [&](const uint4& raw, int ch) {
            char* vbuf = VB + (ch & 1) * 8192; const int j = t >> 2;
            *(uint4*)(vbuf + j * 64 + (t & 3) * 16) = raw;
            float f[8]; unpack8(raw, f); const float sc = __builtin_amdgcn_exp2f(lg2 * (float)(63 - j));
#pragma unroll
            for (int i = 0; i < 8; ++i) f[i] *= sc;
            *(uint4*)(vbuf + 4096 + j * 64 + (t & 3) * 16) = pack8(f);
        };
        issue(0);
        { const uint4 v0 = gld_u4(vsrc); put_v(v0, 0); }
        asm volatile("s_waitcnt vmcnt(0)" ::: "memory");
        __syncthreads();
        f32x4 Sacc[4], Xacc[2];
        uint4 vnext = make_uint4(0u, 0u, 0u, 0u);
        for (int ch = 0; ch < 32; ++ch) {
            const char* vbuf = VB + (ch & 1) * 8192;
#pragma unroll
            for (int qd = 0; qd < 4; ++qd) {
                const int pc = ch * 4 + qd;
                if (pc + 1 < 128) issue(pc + 1);
                if (qd == 0) {
                    if (ch + 1 < 32) vnext = gld_u4(vsrc + (size_t)(ch + 1) * 64 * 2048);
#pragma unroll
                    for (int n = 0; n < 4; ++n) Sacc[n] = (f32x4){0.f, 0.f, 0.f, 0.f};
                    Xacc[0] = (f32x4){0.f, 0.f, 0.f, 0.f}; Xacc[1] = (f32x4){0.f, 0.f, 0.f, 0.f};
                }
                const char* qk = lds + (pc & 1) * 16384;
                Racc[qd][0] *= dec64; Racc[qd][1] *= dec64;
#pragma unroll
                for (int ks = 0; ks < 2; ++ks) {
                    const int chs = ((ks * 4 + fq) ^ (fr & 7)) << 4;
                    const uint4 qf = *(const uint4*)(qk + (16 * w + fr) * 128 + chs);
#pragma unroll
                    for (int n = 0; n < 4; ++n) { const uint4 kf = *(const uint4*)(qk + 8192 + (n * 16 + fr) * 128 + chs); Sacc[n] = mfma16(kf, qf, Sacc[n]); }
#pragma unroll
                    for (int nn = 0; nn < 2; ++nn) {
                        const int v = nn * 16 + fr;
                        const uint4 rf = *(const uint4*)(RT + v * 512 + (((qd * 8 + ks * 4 + fq) ^ (v & 7)) << 4));
                        Xacc[nn] = mfma16(rf, qf, Xacc[nn]);
                    }
                    const int r0 = ks * 32 + fq * 8 + qq;
                    const int kc = 2 * w + (pp >> 1);
                    const uint2 klo = lds_tr16(qk + 8192 + r0 * 128 + ((kc ^ (r0 & 7)) << 4) + (pp & 1) * 8);
                    const uint2 khi = lds_tr16(qk + 8192 + (r0 + 4) * 128 + ((kc ^ ((r0 + 4) & 7)) << 4) + (pp & 1) * 8);
                    const uint4 kt = make_uint4(klo.x, klo.y, khi.x, khi.y);
#pragma unroll
                    for (int m = 0; m < 2; ++m) {
                        const uint2 vlo = lds_tr16(vbuf + 4096 + r0 * 64 + (16 * m + 4 * pp) * 2), vhi = lds_tr16(vbuf + 4096 + (r0 + 4) * 64 + (16 * m + 4 * pp) * 2);
                        Racc[qd][m] = mfma16(kt, make_uint4(vlo.x, vlo.y, vhi.x, vhi.y), Racc[qd][m]);
                    }
                }
                if (qd == 2 && ch + 1 < 32) put_v(vnext, ch + 1);
                asm volatile("s_waitcnt vmcnt(0)" ::: "memory");
                __syncthreads();
#pragma unroll
                for (int m = 0; m < 2; ++m) {
                    const int v = m * 16 + fr, cch = qd * 8 + 2 * w + (fq >> 1);
                    uint2 o; o.x = cvt_pk(Racc[qd][m][0], Racc[qd][m][1]); o.y = cvt_pk(Racc[qd][m][2], Racc[qd][m][3]);
                    *(uint2*)(RT + v * 512 + ((cch ^ (v & 7)) << 4) + (fq & 1) * 8) = o;
                }
            }
            const int srow = 16 * w + fr;
#pragma unroll
            for (int n = 0; n < 4; ++n) {
                float pv[4];
#pragma unroll
                for (int j = 0; j < 4; ++j) { const int jc = n * 16 + fq * 4 + j; pv[j] = (srow >= jc) ? Sacc[n][j] * __builtin_amdgcn_exp2f(lg2 * (float)(srow - jc)) : 0.f; }
                uint2 o; o.x = cvt_pk(pv[0], pv[1]); o.y = cvt_pk(pv[2], pv[3]);
                *(uint2*)(PB + srow * 128 + (((n * 2 + (fq >> 1)) ^ (fr & 7)) << 4) + (fq & 1) * 8) = o;
            }
            f32x4 Iacc[2] = {(f32x4){0.f, 0.f, 0.f, 0.f}, (f32x4){0.f, 0.f, 0.f, 0.f}};
#pragma unroll
            for (int ks = 0; ks < 2; ++ks) {
                const uint4 pf = *(const uint4*)(PB + srow * 128 + (((ks * 4 + fq) ^ (fr & 7)) << 4));
                const int r0 = ks * 32 + fq * 8 + qq;
#pragma unroll
                for (int nn = 0; nn < 2; ++nn) {
                    const uint2 vlo = lds_tr16(vbuf + r0 * 64 + (16 * nn + 4 * pp) * 2), vhi = lds_tr16(vbuf + (r0 + 4) * 64 + (16 * nn + 4 * pp) * 2);
                    Iacc[nn] = mfma16(make_uint4(vlo.x, vlo.y, vhi.x, vhi.y), pf, Iacc[nn]);
                }
            }
            const float qdec = __builtin_amdgcn_exp2f(lg2 * (float)(srow + 1));
            const size_t tok = tok0 + (size_t)ch * 64 + srow;
            float ssum = 0.f, ssq = 0.f;
#pragma unroll
            for (int nn = 0; nn < 2; ++nn) {
                float o4[4];
#pragma unroll
                for (int j = 0; j < 4; ++j) { o4[j] = Iacc[nn][j] + Xacc[nn][j] * qdec; ssum += o4[j]; ssq += o4[j] * o4[j]; }
                gst_u2(yb + tok * 2048 + hd * 512 + vs * 32 + nn * 16 + fq * 4, cvt_pk(o4[0], o4[1]), cvt_pk(o4[2], o4[3]));
            }
            ssum += __shfl_xor(ssum, 16); ssum += __shfl_xor(ssum, 32); ssq += __shfl_xor(ssq, 16); ssq += __shfl_xor(ssq, 32);
            if (fq == 0) gst_u2(stat + ((tok * 4 + hd) * 16 + vs) * 2, __float_as_uint(ssum), __float_as_uint(ssq));
        }
        __syncthreads();
    }
}

__device__ __forceinline__ void phase_zrw(PRef p, int jr) {
    const int t_ = tidx(); const int lane = t_ & 63, gw = blockIdx.x * 4 + (t_ >> 6), nw = gridDim.x * 4;
    char* S = p.ws + OFF_SLOT;
    const bf16_t* yb = (const bf16_t*)(S + 5 * SLOT); const bf16_t* gb = (const bf16_t*)(S + 4 * SLOT);
    const bf16_t* vb = (const bf16_t*)(S + (jr == 0 ? 11 : 9) * SLOT); bf16_t* zb = (bf16_t*)(S + 7 * SLOT);
    const float* bonus = (const float*)(p.ws + OFF_BONUS);
    float gg[16], bq[16]; row_load_f32(p.in[22] + jr * 1024, gg, lane); row_load_f32(p.in[23] + jr * 1024, bq, lane);
    const int rpw = NTOK / nw, first = gw * rpw, end = first + rpw;
    uint2 ny[4], nv[4], ng[4]; float nbn[4];
    auto load_in = [&](int r) {
#pragma unroll
        for (int c = 0; c < 4; ++c) { const size_t o = (size_t)r * 1024 + c * 256 + lane * 4; ny[c] = *(const uint2*)(yb + o); nv[c] = *(const uint2*)(vb + o); ng[c] = *(const uint2*)(gb + o);
                                      nbn[c] = bonus[(size_t)r * 16 + c * 4 + (lane >> 4)]; }
    };
    load_in(first);
    for (int r = first; r < end; ++r) {
        float y[16], v[16], g[16], bn[4];
#pragma unroll
        for (int c = 0; c < 4; ++c) {
            y[c * 4] = bflo(ny[c].x); y[c * 4 + 1] = bfhi(ny[c].x); y[c * 4 + 2] = bflo(ny[c].y); y[c * 4 + 3] = bfhi(ny[c].y);
            v[c * 4] = bflo(nv[c].x); v[c * 4 + 1] = bfhi(nv[c].x); v[c * 4 + 2] = bflo(nv[c].y); v[c * 4 + 3] = bfhi(nv[c].y);
            g[c * 4] = bflo(ng[c].x); g[c * 4 + 1] = bfhi(ng[c].x); g[c * 4 + 2] = bflo(ng[c].y); g[c * 4 + 3] = bfhi(ng[c].y);
            bn[c] = nbn[c];
        }
        if (r + 1 < end) load_in(r + 1);
        __builtin_amdgcn_sched_barrier(0);
        float z[16];
#pragma unroll
        for (int c = 0; c < 4; ++c) {
            float s = (y[c * 4] + y[c * 4 + 1]) + (y[c * 4 + 2] + y[c * 4 + 3]);
            float q = (y[c * 4] * y[c * 4] + y[c * 4 + 1] * y[c * 4 + 1]) + (y[c * 4 + 2] * y[c * 4 + 2] + y[c * 4 + 3] * y[c * 4 + 3]);
            s = row16_sum(s); q = row16_sum(q);
            const float mean = s * (1.0f / 64.0f), rstd = rsqrtf(fmaxf(q * (1.0f / 64.0f) - mean * mean, 0.f) + 64e-5f);
#pragma unroll
            for (int i = 0; i < 4; ++i) { const int e = c * 4 + i; z[e] = ((y[e] - mean) * rstd * gg[e] + bq[e] + bn[c] * v[e]) * g[e]; }
        }
        row_store_bf16(zb + (size_t)r * 1024, z, lane);
    }
}
__device__ __forceinline__ void phase_zml(PRef p) {
    const int t_ = tidx(); const int lane = t_ & 63, gw = blockIdx.x * 4 + (t_ >> 6), nw = gridDim.x * 4;
    char* S = p.ws + OFF_SLOT;
    const bf16_t* yb = (const bf16_t*)(S + 4 * SLOT); const bf16_t* ob = (const bf16_t*)(S + 3 * SLOT); bf16_t* zb = (bf16_t*)(S + 1 * SLOT);
    float gg[16], bq[16]; row_load_f32(p.in[29], gg, lane); row_load_f32(p.in[30], bq, lane);
    const int rpw = NTOK / nw, first = gw * rpw, end = first + rpw;
    uint2 ny[4], no[4];
    auto load_in = [&](int r) {
#pragma unroll
        for (int c = 0; c < 4; ++c) { const size_t o = (size_t)r * 1024 + c * 256 + lane * 4; ny[c] = *(const uint2*)(yb + o); no[c] = *(const uint2*)(ob + o); }
    };
    load_in(first);
    for (int r = first; r < end; ++r) {
        float y[16], o[16], z[16];
#pragma unroll
        for (int c = 0; c < 4; ++c) {
            y[c * 4] = bflo(ny[c].x); y[c * 4 + 1] = bfhi(ny[c].x); y[c * 4 + 2] = bflo(ny[c].y); y[c * 4 + 3] = bfhi(ny[c].y);
            o[c * 4] = bflo(no[c].x); o[c * 4 + 1] = bfhi(no[c].x); o[c * 4 + 2] = bflo(no[c].y); o[c * 4 + 3] = bfhi(no[c].y);
        }
        if (r + 1 < end) load_in(r + 1);
        __builtin_amdgcn_sched_barrier(0);
#pragma unroll
        for (int c = 0; c < 4; ++c) {
            float s = (y[c * 4] + y[c * 4 + 1]) + (y[c * 4 + 2] + y[c * 4 + 3]);
            float q = (y[c * 4] * y[c * 4] + y[c * 4 + 1] * y[c * 4 + 1]) + (y[c * 4 + 2] * y[c * 4 + 2] + y[c * 4 + 3] * y[c * 4 + 3]);
            s = row16_sum(s); q = row16_sum(q); s += __shfl_xor(s, 16); q += __shfl_xor(q, 16);
            const float mean = s * (1.0f / 128.0f), rstd = rsqrtf(fmaxf(q * (1.0f / 128.0f) - mean * mean, 0.f) + 1e-6f);
#pragma unroll
            for (int i = 0; i < 4; ++i) { const int e = c * 4 + i; z[e] = ((y[e] - mean) * rstd * gg[e] + bq[e]) * o[e]; }
        }
        row_store_bf16(zb + (size_t)r * 1024, z, lane);
    }
}
__device__ __forceinline__ void phase_zrt(PRef p) {
    const int t_ = tidx(); const int lane = t_ & 63, gw = blockIdx.x * 4 + (t_ >> 6), nw = gridDim.x * 4;
    char* S = p.ws + OFF_SLOT;
    const bf16_t* yb = (const bf16_t*)(S + 7 * SLOT); const bf16_t* sb = (const bf16_t*)(S + 5 * SLOT); bf16_t* zb = (bf16_t*)(S + 3 * SLOT);
    float gw8[4][8], bw8[4][8];
#pragma unroll
    for (int c = 0; c < 4; ++c) {
        const float4 ga = gld_f4(p.in[33] + lane * 32 + c * 8), gb2 = gld_f4(p.in[33] + lane * 32 + c * 8 + 4), ba = gld_f4(p.in[34] + lane * 32 + c * 8), bb2 = gld_f4(p.in[34] + lane * 32 + c * 8 + 4);
        gw8[c][0] = ga.x; gw8[c][1] = ga.y; gw8[c][2] = ga.z; gw8[c][3] = ga.w; gw8[c][4] = gb2.x; gw8[c][5] = gb2.y; gw8[c][6] = gb2.z; gw8[c][7] = gb2.w;
        bw8[c][0] = ba.x; bw8[c][1] = ba.y; bw8[c][2] = ba.z; bw8[c][3] = ba.w; bw8[c][4] = bb2.x; bw8[c][5] = bb2.y; bw8[c][6] = bb2.z; bw8[c][7] = bb2.w;
    }
    const int rpw = NTOK / nw, first = gw * rpw, end = first + rpw;
    uint4 nyr[4], nsr[4];
    auto load_in = [&](int r) {
        const size_t o = (size_t)r * 2048 + lane * 32;
#pragma unroll
        for (int c = 0; c < 4; ++c) { nyr[c] = *(const uint4*)(yb + o + c * 8); nsr[c] = *(const uint4*)(sb + o + c * 8); }
    };
    load_in(first);
    for (int r = first; r < end; ++r) {
        const size_t o = (size_t)r * 2048 + lane * 32;
        uint4 yr[4], sr[4];
#pragma unroll
        for (int c = 0; c < 4; ++c) { yr[c] = nyr[c]; sr[c] = nsr[c]; }
        if (r + 1 < end) load_in(r + 1);
        __builtin_amdgcn_sched_barrier(0);
        float s = 0.f, q = 0.f;
#pragma unroll
        for (int c = 0; c < 4; ++c) { float f[8]; unpack8(yr[c], f);
#pragma unroll
            for (int i = 0; i < 8; ++i) { s += f[i]; q += f[i] * f[i]; } }
        s = row16_sum(s); q = row16_sum(q);
        const float mean = s * (1.0f / 512.0f), rstd = rsqrtf(fmaxf(q * (1.0f / 512.0f) - mean * mean, 0.f) + 1e-6f);
#pragma unroll
        for (int c = 0; c < 4; ++c) {
            float f[8], g[8], z[8]; unpack8(yr[c], f); unpack8(sr[c], g);
#pragma unroll
            for (int i = 0; i < 8; ++i) z[i] = ((f[i] - mean) * rstd * gw8[c][i] + bw8[c][i]) * g[i];
            *(uint4*)(zb + o + c * 8) = pack8(z);
        }
    }
}

template <int WHICH  >
__device__ __forceinline__ void phase_moe(PRef p, int L, char* lds, const bf16_t* hm, bf16_t* H) {
    const int t = tidx(), lane = t & 63, wid = t >> 6, wr = wid >> 1, wc = wid & 1, fr = lane & 15, fq = lane >> 4;
    const int* cnt = (const int*)(p.ws + OFF_CNT) + L * 32;
    const int* list = (const int*)(p.ws + OFF_LIST);
    bf16_t* Y = (bf16_t*)(p.ws + OFF_SLOT + 9 * SLOT);
    int* pre = (int*)(lds + 65536);
    __syncthreads();
    if (t == 0) { int s = 0; for (int e = 0; e < 32; ++e) { pre[e] = s; s += (cnt[e] + 127) >> 7; } pre[32] = s; }
    __syncthreads();
    const int total_all = pre[32] * 8;
    const int full = (total_all / (int)gridDim.x) * (int)gridDim.x, rem = total_all - full;
    const bool split_tail = (rem > 0) && (2 * rem <= (int)gridDim.x);
    const int total = split_tail ? full : total_all;
    for (int id0 = 0; id0 < total; id0 += gridDim.x) {
        const int id = id0 + (blockIdx.x & 7) * (gridDim.x >> 3) + (blockIdx.x >> 3);
        if (id >= total) continue;
        const int nt = id & 7, mg = id >> 3;
        int e = 0;
#pragma unroll 1
        for (int s = 16; s >= 1; s >>= 1) if (pre[e + s] <= mg) e += s;
        const int mt = mg - pre[e], ne = cnt[e];
        const int* le = list + e * LIST_CAP + mt * 128;
        const bf16_t* ar[4]; const bf16_t* br[4];
        const int co_ = glds_chunk(t) * 8;
#pragma unroll
        for (int i = 0; i < 4; ++i) {
            int r = (t >> 3) + 32 * i; r = (mt * 128 + r < ne) ? r : 0;
            const int aid = le[r];
            ar[i] = ((WHICH == 0) ? hm + (size_t)(aid >> 1) * 1024 : H + (size_t)aid * 512) + co_;
        }
        f32x4 acc[4][4];
        if (WHICH == 0) {
            const bf16_t* wt = (const bf16_t*)(p.ws + W_MOE13) + ((size_t)(L * 32 + e) * 1024 + nt * 128) * 1024;
#pragma unroll
            for (int i = 0; i < 4; ++i) {
                const int ro = (t >> 3) + 32 * i, n_ = (ro >> 4) & 3, hc = ((ro >> 2) & 3) * 8 + (n_ >> 1) * 4 + (ro & 3);
                br[i] = wt + (size_t)((ro & 64) + (hc >> 4) * 32 + (n_ & 1) * 16 + (hc & 15)) * 1024 + co_;
            }
            gemm_gg(lds, 16, ar, br, acc);
            int aidq[4];
#pragma unroll
            for (int m = 0; m < 4; ++m) { const int r = wr * 64 + m * 16 + fr; aidq[m] = (mt * 128 + r < ne) ? le[r] : 0; }
#pragma unroll
            for (int m = 0; m < 4; ++m) {
                const int r = wr * 64 + m * 16 + fr;
                if (mt * 128 + r < ne) {
                    const int aid = aidq[m];
                    const f32x4 a1 = acc[m][0], a3 = acc[m][1], b1 = acc[m][2], b3 = acc[m][3];
                    gst_u4(H + (size_t)aid * 512 + nt * 64 + wc * 32 + fq * 8, cvt_pk(siluf_(a1[0]) * a3[0], siluf_(a1[1]) * a3[1]), cvt_pk(siluf_(a1[2]) * a3[2], siluf_(a1[3]) * a3[3]),
                           cvt_pk(siluf_(b1[0]) * b3[0], siluf_(b1[1]) * b3[1]), cvt_pk(siluf_(b1[2]) * b3[2], siluf_(b1[3]) * b3[3]));
                }
            }
        } else {
            const bf16_t* wt = (const bf16_t*)(p.ws + W_MOE2) + ((size_t)(L * 32 + e) * 1024 + nt * 128) * 512;
#pragma unroll
            for (int i = 0; i < 4; ++i) br[i] = wt + (size_t)perm64((t >> 3) + 32 * i) * 512 + co_;
            gemm_gg(lds, 8, ar, br, acc);
            int aidq[4];
#pragma unroll
            for (int m = 0; m < 4; ++m) { const int r = wr * 64 + m * 16 + fr; aidq[m] = (mt * 128 + r < ne) ? le[r] : 0; }
#pragma unroll
            for (int m = 0; m < 4; ++m) {
                const int r = wr * 64 + m * 16 + fr;
                if (mt * 128 + r < ne) {
                    const int aid = aidq[m];
                    store16(Y + (size_t)aid * 1024 + nt * 128 + wc * 64 + fq * 16, acc[m]);
                }
            }
        }
    }
    if (split_tail) {
        const int hid = (blockIdx.x & 7) * (gridDim.x >> 3) + (blockIdx.x >> 3);
        if (hid < 2 * rem) {
            const int id = full + (hid >> 1), hf = hid & 1;
            const int nt = id & 7, mg = id >> 3;
            int e = 0;
#pragma unroll 1
            for (int s2 = 16; s2 >= 1; s2 >>= 1) if (pre[e + s2] <= mg) e += s2;
            const int mt = mg - pre[e], ne = cnt[e];
            const int* le = list + e * LIST_CAP + mt * 128;
            const bf16_t* ar[4]; const bf16_t* br[2];
            const int co_ = glds_chunk(t) * 8;
#pragma unroll
            for (int i = 0; i < 4; ++i) {
                int r = (t >> 3) + 32 * i; r = (mt * 128 + r < ne) ? r : 0;
                const int aid = le[r];
                ar[i] = ((WHICH == 0) ? hm + (size_t)(aid >> 1) * 1024 : H + (size_t)aid * 512) + co_;
            }
            f32x4 acc[2][4];
            int aidq[2];
            if (WHICH == 0) {
                const bf16_t* wt = (const bf16_t*)(p.ws + W_MOE13) + ((size_t)(L * 32 + e) * 1024 + nt * 128 + hf * 64) * 1024;
#pragma unroll
                for (int i = 0; i < 2; ++i) {
                    const int ro = (t >> 3) + 32 * i, n_ = (ro >> 4) & 3, hc = ((ro >> 2) & 3) * 8 + (n_ >> 1) * 4 + (ro & 3);
                    br[i] = wt + (size_t)((hc >> 4) * 32 + (n_ & 1) * 16 + (hc & 15)) * 1024 + co_;
                }
                gemm_hn(lds, 16, ar, br, acc);
#pragma unroll
                for (int m = 0; m < 2; ++m) { const int r = wid * 32 + m * 16 + fr; aidq[m] = (mt * 128 + r < ne) ? le[r] : 0; }
#pragma unroll
                for (int m = 0; m < 2; ++m) {
                    const int r = wid * 32 + m * 16 + fr;
                    if (mt * 128 + r < ne) {
                        const f32x4 a1 = acc[m][0], a3 = acc[m][1], b1 = acc[m][2], b3 = acc[m][3];
                        gst_u4(H + (size_t)aidq[m] * 512 + nt * 64 + hf * 32 + fq * 8, cvt_pk(siluf_(a1[0]) * a3[0], siluf_(a1[1]) * a3[1]), cvt_pk(siluf_(a1[2]) * a3[2], siluf_(a1[3]) * a3[3]),
                               cvt_pk(siluf_(b1[0]) * b3[0], siluf_(b1[1]) * b3[1]), cvt_pk(siluf_(b1[2]) * b3[2], siluf_(b1[3]) * b3[3]));
                    }
                }
            } else {
                const bf16_t* wt = (const bf16_t*)(p.ws + W_MOE2) + ((size_t)(L * 32 + e) * 1024 + nt * 128 + hf * 64) * 512;
#pragma unroll
                for (int i = 0; i < 2; ++i) br[i] = wt + (size_t)perm64((t >> 3) + 32 * i) * 512 + co_;
                gemm_hn(lds, 8, ar, br, acc);
#pragma unroll
                for (int m = 0; m < 2; ++m) { const int r = wid * 32 + m * 16 + fr; aidq[m] = (mt * 128 + r < ne) ? le[r] : 0; }
#pragma unroll
                for (int m = 0; m < 2; ++m) {
                    const int r = wid * 32 + m * 16 + fr;
                    if (mt * 128 + r < ne) store16(Y + (size_t)aidq[m] * 1024 + nt * 128 + hf * 64 + fq * 16, acc[m]);
                }
            }
        }
    }
}

constexpr int NPHASE = 37;
#ifndef PHSEL
#define PHSEL -1
#endif
#ifndef PHEXC
#define PHEXC -2
#endif
#define PHON(x) ((PHSEL < 0 || PHSEL == (x)) && PHEXC != (x))
__global__ void __launch_bounds__(256, 2) mega(Params p_in) {
    PRef p = *(const CAS Params*)__builtin_amdgcn_kernarg_segment_ptr();
    extern __shared__ __attribute__((aligned(16))) char lds[];
    volatile LAS unsigned* xbw = (volatile LAS unsigned*)(lds + 73728);
    if (threadIdx.x == 0) { xbw[0] = 0u; xbw[1] = 0u; xbw[2] = 0u; xbw[3] = 0u; }
    __syncthreads();
    XcdBarrier bar;
    const bool multi = (p.ph_hi - p.ph_lo) > 1;
    (void)multi;
    if (multi) bar = xcd_barrier_post((unsigned*)(p.ws + OFF_CTL), xbw);
    char* S = p.ws + OFF_SLOT;
#ifdef DBG_STOP
    if (p.ph_lo == 100) {
        const float* src = (const float*)(p.ws + DBG_SRC);
        for (size_t i = (size_t)blockIdx.x * 256 + threadIdx.x; i < (size_t)NTOK * DM; i += (size_t)gridDim.x * 256) {
            float v = DBG_BF16 ? bf2f(((const bf16_t*)src)[i]) : src[i];
            if (!(fabsf(v) < 1e30f)) v = 1e30f;
            p.out[i] = v;
        }
        return;
    }
#endif
    const int ph_lo_ = p.ph_lo, ph_hi_ = p.ph_hi;
#ifdef TIMEIT
    unsigned long long t0_ = 0, t1_ = 0;
#endif
#ifdef DUP_PHASE
    bool dup_done_ = false;
#endif
    for (int ph = ph_lo_; ph < ph_hi_; ++ph) {
        const CAS Params* pp_ = (const CAS Params*)__builtin_amdgcn_kernarg_segment_ptr();
        asm volatile("" : "+s"(pp_));
        PRef p = *pp_;
#ifdef TIMEIT
        if (ph == TIME_A) t0_ = __builtin_amdgcn_s_memrealtime();
        if (ph == TIME_B) t1_ = __builtin_amdgcn_s_memrealtime();
#endif
        int L, sub, kind;
        if (ph < 2) { L = 0; sub = ph; kind = -1; }
        else if (ph < 11) { L = 0; kind = 0; sub = ph - 2; }
        else if (ph < 20) { L = 1; kind = 1; sub = ph - 11; }
        else if (ph < 28) { L = 2; kind = 2; sub = ph - 20; }
        else { L = 3; kind = 0; sub = ph - 28; }
        const int jr = L / 3;
        if (kind == -1) { if (sub == 0) { if (PHON(0)) phase_prologue(p, lds); } else { if (PHON(1)) phase_h0(p); } }
        else {
            const int ntail = (kind == 2) ? 4 : 5;
            if (sub < ntail) {
                if (kind == 0) {
                    if (sub == 0) { if (PHON(2)) phase_gemm_jobs(p, lds, jr * 7, jr * 7 + (jr ? 7 : 6)); }
                    else if (sub == 1) { if (PHON(3)) phase_rw2(p, jr); }
                    else if (sub == 2) { if (PHON(4)) {
#ifdef RW3_SCALAR
                        phase_rw3(p, jr, lds);
#else
                        phase_rw3c(p, jr, lds);
#endif
                    } }
                    else if (sub == 3) { if (PHON(5)) phase_zrw(p, jr); }
                    else { if (PHON(2)) phase_gemm_jobs(p, lds, 16 + jr, 17 + jr); }
                } else if (kind == 1) {
                    if (sub == 0) { if (PHON(2)) phase_gemm_jobs(p, lds, 14, 15); }
                    else if (sub == 1) { if (PHON(6)) phase_cml(p); }
                    else if (sub == 2) { if (PHON(6)) phase_ml2(p, lds); }
                    else if (sub == 3) { if (PHON(7)) phase_zml(p); }
                    else { if (PHON(2)) phase_gemm_jobs(p, lds, 18, 19); }
                } else {
                    if (sub == 0) { if (PHON(2)) phase_gemm_jobs(p, lds, 15, 16); }
                    else if (sub == 1) { if (PHON(8)) phase_rt2(p, lds); }
                    else if (sub == 2) { if (PHON(9)) phase_zrt(p); }
                    else { if (PHON(2)) phase_gemm_jobs(p, lds, 19, 20); }
                }
            } else {
                const int ts = sub - ntail;
                const bf16_t* ymix = (const bf16_t*)(S + (kind == 2 ? 1 : 6) * SLOT);
                bf16_t* hm = (bf16_t*)(S + (kind == 2 ? 2 : 7) * SLOT);
                bf16_t* H = (bf16_t*)(S + (kind == 0 ? 2 : (kind == 1 ? 5 : 3)) * SLOT);
                if (ts == 0) { if (PHON(10)) phase_ln1(p, L, lds, ymix, hm); }
                else if (ts == 1) { if (PHON(11)) phase_moe<0>(p, L, lds, hm, H); }
                else if (ts == 2) { if (PHON(12)) phase_moe<1>(p, L, lds, hm, H); }
                else { if (PHON(13)) phase_ln2(p, L); }
            }
        }
#ifdef DUP_PHASE
        if (((DUP_PHASE >> ph) & 1u) && !dup_done_) { dup_done_ = true; xcd_barrier(bar); --ph; continue; }
        dup_done_ = false;
#endif
        if (ph + 1 < ph_hi_) xcd_barrier(bar);
    }
#ifdef TIMEIT
    {
        xcd_barrier(bar);
        unsigned* tw = (unsigned*)(p.ws + OFF_CTL + 32768);
        if (blockIdx.x == 0 && threadIdx.x == 0) {
            if (t1_ == 0) t1_ = __builtin_amdgcn_s_memrealtime();
            const unsigned long long dt = t1_ - t0_;
            unsigned ms2 = (unsigned)((dt + TIME_U / 2) / TIME_U);
            __hip_atomic_store(tw, ms2, __ATOMIC_RELAXED, __HIP_MEMORY_SCOPE_AGENT);
        }
        xcd_barrier(bar);
        const float c_ = sqrtf((float)__hip_atomic_load(tw, __ATOMIC_RELAXED, __HIP_MEMORY_SCOPE_AGENT));
        for (size_t i = (size_t)blockIdx.x * 256 + threadIdx.x; i < (size_t)NTOK * DM; i += (size_t)gridDim.x * 256) p.out[i] = c_;
    }
#endif
#ifdef DBG_STOP
    if (ph_lo_ != 100) {
        xcd_barrier(bar);
        const float* src = (const float*)(p.ws + DBG_SRC);
        for (size_t i = (size_t)blockIdx.x * 256 + threadIdx.x; i < (size_t)NTOK * DM; i += (size_t)gridDim.x * 256) {
            float v = DBG_BF16 ? bf2f(((const bf16_t*)src)[i]) : src[i];
            if (!(fabsf(v) < 1e30f)) v = 1e30f;
            p.out[i] = v;
        }
    }
#endif
}

constexpr int LDS_BYTES = 73728 + 64;
extern "C" void kernel_launch(void* const* d_in, const int* in_sizes, int n_in, void* d_out, int out_size, void* d_ws, size_t ws_size, hipStream_t stream) {
    static int grid = 0;
    if (grid == 0) {
        if (n_in != 43 || out_size != NTOK * DM || ws_size < WS_NEED) { fprintf(stderr, "kernel_launch: unexpected shapes (n_in %d out %d ws %zu need %zu)\n", n_in, out_size, ws_size, (size_t)WS_NEED); }
        int dev = 0, cus = 0, per_cu = 0;
        (void)hipGetDevice(&dev); (void)hipDeviceGetAttribute(&cus, hipDeviceAttributeMultiprocessorCount, dev);
        (void)hipFuncSetAttribute((const void*)mega, hipFuncAttributeMaxDynamicSharedMemorySize, LDS_BYTES);
        (void)hipOccupancyMaxActiveBlocksPerMultiprocessor(&per_cu, (const void*)mega, 256, LDS_BYTES);
        if (per_cu > 2) per_cu = 2;
        if (per_cu < 1) per_cu = 1;
        grid = cus * per_cu;
        if (grid > 512) grid = 512;
        (void)hipGetLastError();
    }
    Params p{};
    for (int i = 0; i < 43; ++i) p.in[i] = (const float*)d_in[i];
    p.out = (float*)d_out; p.ws = (char*)d_ws;
    char* ws = (char*)d_ws;
    auto slot = [&](int i) { return (bf16_t*)(ws + OFF_SLOT + (size_t)i * SLOT); };
    int tile = 0;
    auto addg = [&](int idx, const bf16_t* A, const bf16_t* Bt, bf16_t* out, int K, int N, int ldo, int mode) {
        GJob& g = p.gj[idx]; g.A = A; g.Bt = Bt; g.out = out; g.K = K; g.N = N; g.ldo = ldo; g.mode = mode; g.half = (mode <= MODE_SIGM && N <= 128) ? 1 : 0; g.ntn = g.half ? (N + 63) / 64 : (N + 127) / 128; g.tile0 = tile; tile += 128 * g.ntn;
    };
    for (int jr = 0; jr < 2; ++jr) {
        const bf16_t* rkv = (const bf16_t*)(ws + W_RKV) + (size_t)jr * 3 * 1024 * 1024;
        addg(jr * 7 + 0, slot(0), rkv, slot(6), 1024, 1024, 1024, MODE_BF16);
        addg(jr * 7 + 1, slot(1), rkv + 1024 * 1024, slot(7), 1024, 1024, 1024, MODE_BF16);
        addg(jr * 7 + 2, slot(2), rkv + 2 * 1024 * 1024, slot(jr == 0 ? 11 : 8), 1024, 1024, 1024, MODE_BF16);
        addg(jr * 7 + 3, slot(3), (const bf16_t*)(ws + W_W1T) + (size_t)jr * 64 * 1024, (bf16_t*)(ws + OFF_LW), 1024, 64, 64, MODE_TANH);
        addg(jr * 7 + 4, slot(4), (const bf16_t*)(ws + W_A1T) + (size_t)jr * 64 * 1024, (bf16_t*)(ws + OFF_LA), 1024, 64, 64, MODE_BF16);
        addg(jr * 7 + 5, slot(5), (const bf16_t*)(ws + W_G1T) + (size_t)jr * 128 * 1024, (bf16_t*)(ws + OFF_LG), 1024, 128, 128, MODE_SIGM);
        addg(jr * 7 + 6, slot(2), (const bf16_t*)(ws + W_V1T), (bf16_t*)(ws + OFF_LV), 1024, 32, 32, MODE_BF16);
    }
    addg(14, slot(0), (const bf16_t*)(ws + W_MLIN), nullptr, 1024, 3088, 0, MODE_ML1);
    addg(15, slot(0), (const bf16_t*)(ws + W_RTIN), nullptr, 1024, 6144, 0, MODE_RT1);
    addg(16, slot(7), (const bf16_t*)(ws + W_OUT), slot(6), 1024, 1024, 1024, MODE_BF16);
    addg(17, slot(7), (const bf16_t*)(ws + W_OUT) + 1024 * 1024, slot(6), 1024, 1024, 1024, MODE_BF16);
    addg(18, slot(1), (const bf16_t*)(ws + W_MLOUT), slot(6), 1024, 1024, 1024, MODE_BF16);
    addg(19, slot(3), (const bf16_t*)(ws + W_RTOUT), slot(1), 2048, 1024, 1024, MODE_BF16);
    int nc = 0, ctile = 0;
    auto addc = [&](const float* src, size_t dst_off, int K, int N, int nb, long sbs, long dbs, int mode) {
        CJob& c = p.cj[nc++]; c.src = src; c.dst = (bf16_t*)(ws + dst_off); c.K = K; c.N = N; c.nb = nb; c.mode = mode; c.sbs = sbs; c.dbs = dbs;
        c.tiles_pb = ((K + 63) / 64) * ((N + 255) / 256); c.tile0 = ctile; ctile += c.tiles_pb * nb;
    };
    addc(p.in[7], W_RKV, 1024, 1024, 6, 1024 * 1024, 1024 * 1024, 0);
    addc(p.in[24], W_OUT, 1024, 1024, 2, 1024 * 1024, 1024 * 1024, 0);
    addc(p.in[9], W_W1T, 1024, 64, 2, 1024 * 64, 64 * 1024, 0);
    addc(p.in[12], W_A1T, 1024, 64, 2, 1024 * 64, 64 * 1024, 0);
    addc(p.in[17], W_G1T, 1024, 128, 2, 1024 * 128, 128 * 1024, 0);
    addc(p.in[15], W_V1T, 1024, 32, 1, 0, 0, 0);
    addc(p.in[10], W_W2T, 64, 1024, 2, 64 * 1024, 1024 * 64, 0);
    addc(p.in[13], W_A2T, 64, 1024, 2, 64 * 1024, 1024 * 64, 0);
    addc(p.in[18], W_G2T, 128, 1024, 2, 128 * 1024, 1024 * 128, 0);
    addc(p.in[16], W_V2T, 32, 1024, 1, 0, 0, 0);
    addc(p.in[25], W_MLIN, 1024, 3088, 1, 0, 0, 0);
    addc(p.in[31], W_MLOUT, 1024, 1024, 1, 0, 0, 0);
    addc(p.in[32], W_RTIN, 1024, 6144, 1, 0, 0, 3);
    addc(p.in[35], W_RTOUT, 2048, 1024, 1, 0, 0, 0);
    addc(p.in[40], W_MOE13, 1024, 512, 128, 1024 * 512, 1024 * 1024, 1);
    addc(p.in[41], W_MOE13, 1024, 512, 128, 1024 * 512, 1024 * 1024, 2);
    addc(p.in[42], W_MOE2, 512, 1024, 128, 512 * 1024, 1024 * 512, 0);
    p.ncj = nc; p.cj_tiles = ctile;

    (void)hipMemsetAsync(ws + OFF_CTL, 0, CTL_BYTES, stream);
#ifdef DBG_STOP
    const int nph = DBG_STOP;
#else
    const int nph = NPHASE;
#endif
#ifdef MULTI_LAUNCH
    for (int ph = 0; ph < nph; ++ph) { p.ph_lo = ph; p.ph_hi = ph + 1; hipLaunchKernelGGL(mega, dim3(grid), dim3(256), LDS_BYTES, stream, p); }
    if (0)
#endif
    {
        p.ph_lo = 0; p.ph_hi = nph;
        void* args[] = {&p};
        hipError_t e = hipLaunchCooperativeKernel((const void*)mega, dim3(grid), dim3(256), args, LDS_BYTES, stream);
        if (e != hipSuccess) fprintf(stderr, "cooperative launch failed: %s (grid %d)\n", hipGetErrorString(e), grid);
    }
}
```

```cpp
#include <hip/hip_runtime.h>
#include <cstdio>
#include <cstdint>

#ifndef ONE_LAUNCH
#define ONE_LAUNCH 0
#endif

typedef unsigned short bf16_t;
typedef short bf16x8 __attribute__((ext_vector_type(8)));
typedef float f32x4 __attribute__((ext_vector_type(4)));
#define LAS __attribute__((address_space(3)))
#define GAS __attribute__((address_space(1)))
typedef float f32x4g_t __attribute__((ext_vector_type(4)));
typedef unsigned u32x2g_t __attribute__((ext_vector_type(2)));
typedef unsigned u32x4g_t __attribute__((ext_vector_type(4)));
__device__ __forceinline__ float4 gld_f4(const float* p) { const f32x4g_t v = *(const GAS f32x4g_t*)(const GAS char*)(const char*)p; return make_float4(v[0], v[1], v[2], v[3]); }
__device__ __forceinline__ uint2 gld_u2(const void* p) { const u32x2g_t v = *(const GAS u32x2g_t*)(const GAS char*)(const char*)p; return make_uint2(v[0], v[1]); }
__device__ __forceinline__ uint4 gld_u4(const void* p) { const u32x4g_t v = *(const GAS u32x4g_t*)(const GAS char*)(const char*)p; return make_uint4(v[0], v[1], v[2], v[3]); }
__device__ __forceinline__ void gst_f4(float* p, float a, float b, float c, float d) { const f32x4g_t v = {a, b, c, d}; *(GAS f32x4g_t*)(GAS char*)(char*)p = v; }
__device__ __forceinline__ void gst_u2(void* p, unsigned a, unsigned b) { const u32x2g_t v = {a, b}; *(GAS u32x2g_t*)(GAS char*)(char*)p = v; }
__device__ __forceinline__ void gst_u4(void* p, unsigned a, unsigned b, unsigned c, unsigned d) { const u32x4g_t v = {a, b, c, d}; *(GAS u32x4g_t*)(GAS char*)(char*)p = v; }

constexpr int NTOK = 16384, DM = 1024, TSEQ = 2048, NBATCH = 8;
constexpr float DN_ALPHA = 1.681792830507429f;
constexpr float LN_EPS = 1e-5f;
constexpr size_t MB = 1u << 20;
constexpr size_t OFF_CTL = 0, OFF_CNT = 16384, CTL_BYTES = 65536;
constexpr size_t OFF_MOD = 65536;
constexpr size_t OFF_ROT = 1 * MB;
constexpr size_t OFF_BONUS = 3 * MB, OFF_GATES = 4 * MB, OFF_STAT = 5 * MB, OFF_LW = 13 * MB, OFF_LA = 15 * MB, OFF_LG = 17 * MB, OFF_LV = 21 * MB,
                 OFF_WGT = 22 * MB, OFF_LIST = 23 * MB, OFF_RTW = 25 * MB;
constexpr size_t OFF_W = 32 * MB;
constexpr size_t W_RKV = OFF_W, W_OUT = W_RKV + 12 * MB, W_W1T = W_OUT + 4 * MB, W_A1T = W_W1T + 256 * 1024, W_G1T = W_A1T + 256 * 1024, W_V1T = W_G1T + 512 * 1024,
                 W_W2T = W_V1T + 64 * 1024, W_A2T = W_W2T + 256 * 1024, W_G2T = W_A2T + 256 * 1024, W_V2T = W_G2T + 512 * 1024, W_MLIN = W_V2T + 64 * 1024 + 832 * 1024,
                 W_MLOUT = W_MLIN + 6400 * 1024, W_RTIN = W_MLOUT + 2 * MB, W_RTOUT = W_RTIN + 12 * MB, W_MOE13 = W_RTOUT + 4 * MB, W_MOE2 = W_MOE13 + 256 * MB,
                 W_END = W_MOE2 + 128 * MB;
constexpr size_t OFF_XRES = 464 * MB;
constexpr size_t OFF_SLOT = 528 * MB, SLOT = 32 * MB;
static_assert(W_END <= OFF_XRES, "weights overflow");
constexpr size_t OFF_XRES2 = OFF_SLOT + 12 * SLOT;
constexpr size_t WS_NEED = OFF_XRES2 + 2 * SLOT;
constexpr int LIST_CAP = 16384;

#define XB_TMO      128
#define XB_XCNT(j)  (256  + 64 * (j))
#define XB_XSUB(j)  (1280 + 64 * (j))
#define XB_XGEN(j)  (2304 + 64 * (j))
#define XB_TOP      3328
#define XB_TOPGEN   3392
#define XCD_BAR_WORDS 3456
#define XB_SPIN_CAP (1u << 22)
__device__ __forceinline__ unsigned xb_ld(unsigned* p)              { return __hip_atomic_load(p, __ATOMIC_RELAXED, __HIP_MEMORY_SCOPE_AGENT); }
__device__ __forceinline__ unsigned xb_add(unsigned* p, unsigned v) { return __hip_atomic_fetch_add(p, v, __ATOMIC_RELAXED, __HIP_MEMORY_SCOPE_AGENT); }
__device__ __forceinline__ unsigned xb_xcc_id() { return (unsigned)__builtin_amdgcn_s_getreg((3 << 11) | 20) & 0xFu; }
#define XB_SPIN(cond, bar) do { unsigned _sp = 0; while (cond) { __builtin_amdgcn_s_sleep(1); \
    if ((++_sp & 255u) == 0u) { if (xb_ld(&(bar)[XB_TMO])) break; if (_sp > XB_SPIN_CAP) { atomicAdd(&(bar)[XB_TMO], 1u); break; } } } } while (0)
struct XcdBarrier { unsigned* bar; unsigned x; volatile LAS unsigned* st; };
__device__ __forceinline__ XcdBarrier xcd_barrier_post(unsigned* bar, volatile LAS unsigned* st) {
    XcdBarrier b; b.bar = bar; b.x = xb_xcc_id(); b.st = st;
    if (threadIdx.x == 0) (void)xb_add(&bar[XB_XCNT(b.x)], 1u);
    return b;
}
__device__ __forceinline__ void xcd_barrier_complete(unsigned* bar, unsigned x, unsigned& nloc, unsigned& nx) {
    const unsigned G = gridDim.x;
    unsigned sum, cnt, mine, sp = 0u;
    for (;;) {
        sum = 0u; cnt = 0u; mine = 0u;
#pragma unroll
        for (unsigned j = 0; j < 16; ++j) { const unsigned c = xb_ld(&bar[XB_XCNT(j)]); sum += c; cnt += (c > 0u) ? 1u : 0u; mine = (j == x) ? c : mine; }
        if (sum == G) break;
        __builtin_amdgcn_s_sleep(1);
        if ((++sp & 255u) == 0u) { if (xb_ld(&bar[XB_TMO])) break; if (sp > XB_SPIN_CAP) { atomicAdd(&bar[XB_TMO], 1u); break; } }
    }
    nloc = mine > 0u ? mine : 1u; nx = cnt > 0u ? cnt : 1u;
}
__device__ __forceinline__ void xcd_barrier(const XcdBarrier& b) {
    asm volatile("s_waitcnt vmcnt(0)" ::: "memory");
    __syncthreads();
    if (threadIdx.x == 0) {
        unsigned* bar = b.bar;
        __builtin_amdgcn_s_waitcnt(0);
        unsigned nloc = b.st[0], nx = b.st[1];
        if (nloc == 0u) { xcd_barrier_complete(bar, b.x, nloc, nx); b.st[0] = nloc; b.st[1] = nx; }
        const unsigned old = xb_add(&bar[XB_XSUB(b.x)], 1u);
        const unsigned gen = old / nloc;
        if (old + 1u == (gen + 1u) * nloc) {
            __builtin_amdgcn_fence(__ATOMIC_RELEASE, "agent");
            asm volatile("s_waitcnt vmcnt(0)" ::: "memory");
            const unsigned og = xb_add(&bar[XB_TOP], 1u);
            const unsigned tg = og / nx;
            if (og + 1u == (tg + 1u) * nx) xb_add(&bar[XB_TOPGEN], 1u);
            else XB_SPIN(xb_ld(&bar[XB_TOPGEN]) == tg, bar);
            __builtin_amdgcn_fence(__ATOMIC_ACQUIRE, "agent");
            xb_add(&bar[XB_XGEN(b.x)], 1u);
            asm volatile("s_waitcnt vmcnt(0)" ::: "memory");
        } else {
            XB_SPIN(xb_ld(&bar[XB_XGEN(b.x)]) == gen, bar);
            __builtin_amdgcn_fence(__ATOMIC_ACQUIRE, "agent");
            asm volatile("s_waitcnt vmcnt(0)" ::: "memory");
        }
    }
    __syncthreads();
}

__device__ __forceinline__ int tidx() { int t = threadIdx.x; asm volatile("" : "+v"(t)); return t; }
typedef __bf16 bf16x2_t __attribute__((ext_vector_type(2)));
typedef float f32x2_t __attribute__((ext_vector_type(2)));
__device__ __forceinline__ unsigned cvt_pk(float lo, float hi) {
    f32x2_t v = {lo, hi}; bf16x2_t r = __builtin_convertvector(v, bf16x2_t);
    unsigned u; __builtin_memcpy(&u, &r, 4); return u;
}
__device__ __forceinline__ bf16_t f2bf(float f) { return (bf16_t)(cvt_pk(f, 0.f) & 0xffffu); }
__device__ __forceinline__ float bflo(unsigned u) { return __uint_as_float(u << 16); }
__device__ __forceinline__ float bfhi(unsigned u) { return __uint_as_float(u & 0xffff0000u); }
__device__ __forceinline__ float bf2f(bf16_t u) { return __uint_as_float(((unsigned)u) << 16); }
__device__ __forceinline__ void unpack8(const uint4& u, float (&f)[8]) {
    f[0] = bflo(u.x); f[1] = bfhi(u.x); f[2] = bflo(u.y); f[3] = bfhi(u.y); f[4] = bflo(u.z); f[5] = bfhi(u.z); f[6] = bflo(u.w); f[7] = bfhi(u.w);
}
__device__ __forceinline__ uint4 pack8(const float (&f)[8]) { uint4 u; u.x = cvt_pk(f[0], f[1]); u.y = cvt_pk(f[2], f[3]); u.z = cvt_pk(f[4], f[5]); u.w = cvt_pk(f[6], f[7]); return u; }
typedef unsigned u32x4_t __attribute__((ext_vector_type(4)));
__device__ __forceinline__ uint4 gload16(const void* p) {
    const u32x4_t v = *(const __attribute__((address_space(1))) u32x4_t*)p;
    return make_uint4(v[0], v[1], v[2], v[3]);
}
__device__ __forceinline__ float sigmoidf_(float x) { return __builtin_amdgcn_rcpf(1.0f + __expf(-x)); }
__device__ __forceinline__ float siluf_(float x) { return x * __builtin_amdgcn_rcpf(1.0f + __expf(-x)); }
__device__ __forceinline__ float tanhf_(float x) { return 1.0f - 2.0f * __builtin_amdgcn_rcpf(1.0f + __expf(2.0f * x)); }
__device__ __forceinline__ float softplusf_(float x) { return fmaxf(x, 0.f) + __logf(1.0f + __expf(-fabsf(x))); }
__device__ __forceinline__ float row16_sum(float v);
__device__ __forceinline__ float wave_sum(float v) {
    v = row16_sum(v); v += __shfl_xor(v, 16); v += __shfl_xor(v, 32);
    return v;
}
__device__ __forceinline__ float row16_sum(float v) {
    v += __builtin_amdgcn_update_dpp(0.f, v, 0x128, 0xf, 0xf, false);
    v += __builtin_amdgcn_update_dpp(0.f, v, 0x124, 0xf, 0xf, false);
    v += __builtin_amdgcn_update_dpp(0.f, v, 0x122, 0xf, 0xf, false);
    v += __builtin_amdgcn_update_dpp(0.f, v, 0x121, 0xf, 0xf, false);
    return v;
}
__device__ __forceinline__ float oct_sum(float v) {
    v += __builtin_amdgcn_update_dpp(0.f, v, 0xB1, 0xf, 0xf, false);
    v += __builtin_amdgcn_update_dpp(0.f, v, 0x4E, 0xf, 0xf, false);
    v += __builtin_amdgcn_update_dpp(0.f, v, 0x141, 0xf, 0xf, false);
    return v;
}

enum { MODE_BF16 = 0, MODE_TANH = 1, MODE_SIGM = 2, MODE_ML1 = 3, MODE_RT1 = 4 };
struct GJob { const bf16_t* A; const bf16_t* Bt; bf16_t* out; int K, N, ldo, mode, ntn, tile0, half; };
struct CJob { const float* src; bf16_t* dst; int K, N, nb, mode; long sbs, dbs; int tiles_pb, tile0; };
constexpr int NGJ = 20, NCJ = 24;
struct Params {
    const float* in[43]; float* out; char* ws;
    int ph_lo, ph_hi, ncj, cj_tiles;
    GJob gj[NGJ];
    CJob cj[NCJ];
};
#define CAS __attribute__((address_space(4)))
typedef const CAS Params& PRef;

__device__ __forceinline__ f32x4 mfma16(const uint4& a, const uint4& b, f32x4 c) {
    bf16x8 av, bv; __builtin_memcpy(&av, &a, 16); __builtin_memcpy(&bv, &b, 16);
    return __builtin_amdgcn_mfma_f32_16x16x32_bf16(av, bv, c, 0, 0, 0);
}
template <bool PFA = true, class AL, class BL>
__device__ __forceinline__ void gemm_mainloop(char* lds, int nk, const AL& al, const BL& bl, f32x4 (&acc)[4][4]) {
    const int t = tidx(), c = t & 7, r0 = t >> 3;
    const int lane = t & 63, wid = t >> 6, wr = wid >> 1, wc = wid & 1, fr = lane & 15, fq = lane >> 4;
    typename AL::Raw ra[4]; typename BL::Raw rb[4];
    const int woff = r0 * 128 + ((c ^ (r0 & 7)) << 4);
#pragma unroll
    for (int i = 0; i < 4; ++i) { if (PFA) ra[i] = al.fetch(i, r0 + 32 * i, c); rb[i] = bl.fetch(i, r0 + 32 * i, c); }
#pragma unroll
    for (int i = 0; i < 4; ++i) {
        if (!PFA) { ra[i] = al.fetch(i, r0 + 32 * i, c); }
        *(uint4*)(lds + woff + i * 4096) = al.finish(ra[i], i, r0 + 32 * i, c);
        *(uint4*)(lds + 16384 + woff + i * 4096) = bl.finish(rb[i], i, r0 + 32 * i, c);
        if (!PFA) asm volatile("" ::: "memory");
    }
#pragma unroll
    for (int m = 0; m < 4; ++m)
#pragma unroll
        for (int n = 0; n < 4; ++n) acc[m][n] = (f32x4){0.f, 0.f, 0.f, 0.f};
    __syncthreads();
    const int aoff = (wr * 64 + fr) * 128, boff = 16384 + (wc * 64 + fr) * 128, sw = fr & 7;
    for (int kt = 0; kt < nk; ++kt) {
        const bool more = (kt + 1 < nk);
        if (more) {
#pragma unroll
            for (int i = 0; i < 4; ++i) { if (PFA) ra[i] = al.fetch(i, r0 + 32 * i, (kt + 1) * 8 + c); rb[i] = bl.fetch(i, r0 + 32 * i, (kt + 1) * 8 + c); }
        }
        const char* buf = lds + (kt & 1) * 32768;
#pragma unroll
        for (int ks = 0; ks < 2; ++ks) {
            uint4 af[4], bfm[4];
            const int ch = ((ks * 4 + fq) ^ sw) << 4;
#pragma unroll
            for (int m = 0; m < 4; ++m) af[m] = *(const uint4*)(buf + aoff + m * 2048 + ch);
#pragma unroll
            for (int n = 0; n < 4; ++n) bfm[n] = *(const uint4*)(buf + boff + n * 2048 + ch);
#pragma unroll
            for (int m = 0; m < 4; ++m)
#pragma unroll
                for (int n = 0; n < 4; ++n) acc[m][n] = mfma16(bfm[n], af[m], acc[m][n]);
        }
        if (more) {
            char* nb = lds + ((kt + 1) & 1) * 32768;
#pragma unroll
            for (int i = 0; i < 4; ++i) {
                if (!PFA) ra[i] = al.fetch(i, r0 + 32 * i, (kt + 1) * 8 + c);
                *(uint4*)(nb + woff + i * 4096) = al.finish(ra[i], i, r0 + 32 * i, (kt + 1) * 8 + c);
                *(uint4*)(nb + 16384 + woff + i * 4096) = bl.finish(rb[i], i, r0 + 32 * i, (kt + 1) * 8 + c);
                if (!PFA) asm volatile("" ::: "memory");
            }
        }
        __syncthreads();
    }
}
__device__ __forceinline__ void glds16(const bf16_t* g, char* l) {
    __builtin_amdgcn_global_load_lds((const unsigned*)g, (LAS unsigned*)l, 16, 0, 0);
}
__device__ __forceinline__ void glds16_asm(const void* gsrc, unsigned lds_dst) {
    unsigned keep;
    asm volatile("s_mov_b32 %0, m0\n\ts_mov_b32 m0, %2\n\ts_nop 0\n\tglobal_load_lds_dwordx4 %1, off\n\ts_mov_b32 m0, %0" : "=&s"(keep) : "v"(gsrc), "s"(lds_dst) : "memory");
}
__device__ __forceinline__ unsigned lds_addr_u(const char* l) { return (unsigned)(size_t)(const LAS char*)l; }
__device__ __forceinline__ int glds_chunk(int t) { return (t & 7) ^ ((t >> 3) & 7); }
__device__ __forceinline__ void mma_ktile(const char* buf, int aoff, int boff, int sw, int fq, f32x4 (&acc)[4][4]) {
    const int ch0 = ((0 * 4 + fq) ^ sw) << 4, ch1 = ((1 * 4 + fq) ^ sw) << 4;
    const char* pa = buf + aoff; const char* pb = buf + boff;
    uint4 a0[4], a1[4], b[8];
#pragma unroll
    for (int m = 0; m < 4; ++m) a0[m] = *(const uint4*)(pa + m * 2048 + ch0);
    b[0] = *(const uint4*)(pb + ch0); b[1] = *(const uint4*)(pb + 2048 + ch0);
    __builtin_amdgcn_sched_barrier(0);
    b[2] = *(const uint4*)(pb + 2 * 2048 + ch0);
#pragma unroll
    for (int m = 0; m < 4; ++m) acc[m][0] = mfma16(b[0], a0[m], acc[m][0]);
    __builtin_amdgcn_sched_barrier(0);
    b[3] = *(const uint4*)(pb + 3 * 2048 + ch0);
#pragma unroll
    for (int m = 0; m < 4; ++m) acc[m][1] = mfma16(b[1], a0[m], acc[m][1]);
    __builtin_amdgcn_sched_barrier(0);
#pragma unroll
    for (int m = 0; m < 4; ++m) a1[m] = *(const uint4*)(pa + m * 2048 + ch1);
#pragma unroll
    for (int m = 0; m < 4; ++m) acc[m][2] = mfma16(b[2], a0[m], acc[m][2]);
    __builtin_amdgcn_sched_barrier(0);
    b[4] = *(const uint4*)(pb + ch1); b[5] = *(const uint4*)(pb + 2048 + ch1);
#pragma unroll
    for (int m = 0; m < 4; ++m) acc[m][3] = mfma16(b[3], a0[m], acc[m][3]);
    __builtin_amdgcn_sched_barrier(0);
    b[6] = *(const uint4*)(pb + 2 * 2048 + ch1);
#pragma unroll
    for (int m = 0; m < 4; ++m) acc[m][0] = mfma16(b[4], a1[m], acc[m][0]);
    __builtin_amdgcn_sched_barrier(0);
    b[7] = *(const uint4*)(pb + 3 * 2048 + ch1);
#pragma unroll
    for (int m = 0; m < 4; ++m) acc[m][1] = mfma16(b[5], a1[m], acc[m][1]);
    __builtin_amdgcn_sched_barrier(0);
#pragma unroll
    for (int m = 0; m < 4; ++m) acc[m][2] = mfma16(b[6], a1[m], acc[m][2]);
#pragma unroll
    for (int m = 0; m < 4; ++m) acc[m][3] = mfma16(b[7], a1[m], acc[m][3]);
}
__device__ __forceinline__ void gemm_gg(char* lds, int nk, const bf16_t* const (&ar)[4], const bf16_t* const (&br)[4], f32x4 (&acc)[4][4]) {
    const int t = tidx();
    const int lane = t & 63, wid = t >> 6, wr = wid >> 1, wc = wid & 1, fr = lane & 15, fq = lane >> 4;
    const unsigned wbs = (unsigned)__builtin_amdgcn_readfirstlane((int)(lds_addr_u(lds) + wid * 1024));
#pragma unroll
    for (int i = 0; i < 4; ++i) { glds16_asm(ar[i], wbs + i * 4096); glds16_asm(br[i], wbs + 16384 + i * 4096); }
#pragma unroll
    for (int m = 0; m < 4; ++m)
#pragma unroll
        for (int n = 0; n < 4; ++n) acc[m][n] = (f32x4){0.f, 0.f, 0.f, 0.f};
    asm volatile("s_waitcnt vmcnt(0)" ::: "memory");
    __syncthreads();
    const int aoff = (wr * 64 + fr) * 128, boff = 16384 + (wc * 64 + fr) * 128, sw = fr & 7;
    for (int kt = 0; kt < nk; ++kt) {
        if (kt + 1 < nk) {
            const unsigned nb = (unsigned)__builtin_amdgcn_readfirstlane((int)(wbs + ((kt + 1) & 1) * 32768));
#pragma unroll
            for (int i = 0; i < 4; ++i) { glds16_asm(ar[i] + (kt + 1) * 64, nb + i * 4096); glds16_asm(br[i] + (kt + 1) * 64, nb + 16384 + i * 4096); }
        }
        mma_ktile(lds + (kt & 1) * 32768, aoff, boff, sw, fq, acc);
        asm volatile("s_waitcnt vmcnt(0)" ::: "memory");
        __syncthreads();
    }
}
__device__ __forceinline__ void gemm_hn(char* lds, int nk, const bf16_t* const (&ar)[4], const bf16_t* const (&br)[2], f32x4 (&acc)[2][4]) {
    const int t = tidx();
    const int lane = t & 63, wid = t >> 6, fr = lane & 15, fq = lane >> 4;
    const unsigned wbs = (unsigned)__builtin_amdgcn_readfirstlane((int)(lds_addr_u(lds) + wid * 1024));
#pragma unroll
    for (int i = 0; i < 4; ++i) glds16_asm(ar[i], wbs + i * 4096);
#pragma unroll
    for (int i = 0; i < 2; ++i) glds16_asm(br[i], wbs + 16384 + i * 4096);
#pragma unroll
    for (int m = 0; m < 2; ++m)
#pragma unroll
        for (int n = 0; n < 4; ++n) acc[m][n] = (f32x4){0.f, 0.f, 0.f, 0.f};
    asm volatile("s_waitcnt vmcnt(0)" ::: "memory");
    __syncthreads();
    const int aoff = (wid * 32 + fr) * 128, boff = 16384 + fr * 128, sw = fr & 7;
    for (int kt = 0; kt < nk; ++kt) {
        if (kt + 1 < nk) {
            const unsigned nb = (unsigned)__builtin_amdgcn_readfirstlane((int)(wbs + ((kt + 1) & 1) * 32768));
#pragma unroll
            for (int i = 0; i < 4; ++i) glds16_asm(ar[i] + (kt + 1) * 64, nb + i * 4096);
#pragma unroll
            for (int i = 0; i < 2; ++i) glds16_asm(br[i] + (kt + 1) * 64, nb + 16384 + i * 4096);
        }
        const char* buf = lds + (kt & 1) * 32768;
#pragma unroll
        for (int ks = 0; ks < 2; ++ks) {
            const int ch = ((ks * 4 + fq) ^ sw) << 4;
            uint4 af[2], bfm[4];
#pragma unroll
            for (int m = 0; m < 2; ++m) af[m] = *(const uint4*)(buf + aoff + m * 2048 + ch);
#pragma unroll
            for (int n = 0; n < 4; ++n) bfm[n] = *(const uint4*)(buf + boff + n * 2048 + ch);
#pragma unroll
            for (int m = 0; m < 2; ++m)
#pragma unroll
                for (int n = 0; n < 4; ++n) acc[m][n] = mfma16(bfm[n], af[m], acc[m][n]);
        }
        asm volatile("s_waitcnt vmcnt(0)" ::: "memory");
        __syncthreads();
    }
}
template <class AL>
__device__ __forceinline__ void gemm_rg(char* lds, int nk, const AL& al, const bf16_t* const (&br)[4], f32x4 (&acc)[4][4]) {
    const int t = tidx(), c = t & 7, r0 = t >> 3;
    const int lane = t & 63, wid = t >> 6, wr = wid >> 1, wc = wid & 1, fr = lane & 15, fq = lane >> 4;
    char* wb = lds + wid * 1024;
    const int woff = r0 * 128 + ((c ^ (r0 & 7)) << 4);
#pragma unroll
    for (int i = 0; i < 4; ++i) glds16(br[i], wb + 16384 + i * 4096);
#pragma unroll
    for (int i = 0; i < 4; ++i) {
        typename AL::Raw ra = al.fetch(i, r0 + 32 * i, c);
        *(uint4*)(lds + woff + i * 4096) = al.finish(ra, i, r0 + 32 * i, c);
        asm volatile("" ::: "memory");
    }
#pragma unroll
    for (int m = 0; m < 4; ++m)
#pragma unroll
        for (int n = 0; n < 4; ++n) acc[m][n] = (f32x4){0.f, 0.f, 0.f, 0.f};
    asm volatile("s_waitcnt vmcnt(0)" ::: "memory");
    __syncthreads();
    const int aoff = (wr * 64 + fr) * 128, boff = 16384 + (wc * 64 + fr) * 128, sw = fr & 7;
    for (int kt = 0; kt < nk; ++kt) {
        const bool more = (kt + 1 < nk);
        char* nbuf = lds + ((kt + 1) & 1) * 32768;
        if (more) {
#pragma unroll
            for (int i = 0; i < 4; ++i) glds16(br[i] + (kt + 1) * 64, nbuf + wid * 1024 + 16384 + i * 4096);
        }
        mma_ktile(lds + (kt & 1) * 32768, aoff, boff, sw, fq, acc);
        if (more) {
#pragma unroll
            for (int i = 0; i < 4; ++i) {
                typename AL::Raw ra = al.fetch(i, r0 + 32 * i, (kt + 1) * 8 + c);
                *(uint4*)(nbuf + woff + i * 4096) = al.finish(ra, i, r0 + 32 * i, (kt + 1) * 8 + c);
                asm volatile("" ::: "memory");
            }
        }
        asm volatile("s_waitcnt vmcnt(0)" ::: "memory");
        __syncthreads();
    }
}
struct LdPlain {
    typedef uint4 Raw;
    const bf16_t* p; int ld; int nvalid;
    __device__ __forceinline__ uint4 fetch(int, int r, int kc) const { return (r < nvalid) ? *(const uint4*)(p + (size_t)r * ld + kc * 8) : make_uint4(0u, 0u, 0u, 0u); }
    __device__ __forceinline__ uint4 finish(const uint4& v, int, int, int) const { return v; }
};
struct LdGather {
    typedef uint4 Raw;
    const bf16_t* rp[4];
    __device__ __forceinline__ uint4 fetch(int i, int, int kc) const { const bf16_t* q = rp[i]; return q ? *(const uint4*)(q + kc * 8) : make_uint4(0u, 0u, 0u, 0u); }
    __device__ __forceinline__ uint4 finish(const uint4& v, int, int, int) const { return v; }
};
__device__ __forceinline__ void tile_map(int id, int NT, int& mt, int& nt) {
    const int x = id & 7, q = id >> 3;
    const int mg = q / (8 * NT), q2 = q - mg * 8 * NT, G = (NT + 7) >> 3;
    int g = q2 >> 6; g = g < G - 1 ? g : G - 1;
    const int r = q2 - (g << 6), w = (g == G - 1) ? NT - 8 * g : 8;
    mt = (mg * 8 + r / w) * 8 + x; nt = 8 * g + r % w;
}

__device__ __forceinline__ int conv_row(int mode, int n) {
    if (mode == 1) return (n >> 4) * 32 + (n & 15);
    if (mode == 2) return (n >> 4) * 32 + 16 + (n & 15);
    if (mode == 3 && n < 2048) { const int c = n & 255, c2 = c & 127; return (n & ~255) + (c2 >> 4) * 32 + ((c >> 7) << 4) + (c2 & 15); }
    return n;
}
__device__ __forceinline__ void phase_prologue(PRef p, char* lds) {
    const int t = tidx();
    const int n_ada = 8 * 48, n_rot = 256 + 144;
    float* mod = (float*)(p.ws + OFF_MOD);
    for (int it = blockIdx.x; it < n_ada + n_rot; it += gridDim.x) {
        if (it < n_ada) {
            const int pr = it / 48, cb = it % 48;
            float* sc = (float*)lds;
            float* red = (float*)(lds + 32768);
            for (int i = t; i < 8192; i += 256) { const int b = i >> 10, k = i & 1023; sc[k * 8 + b] = siluf_(p.in[1][b * 1024 + k]); }
            __syncthreads();
            const int kg = t >> 6, cl = t & 63, col = cb * 64 + cl;
            const float* W = p.in[2] + (size_t)pr * 1024 * 3072 + col;
            float a[8] = {0, 0, 0, 0, 0, 0, 0, 0};
#pragma unroll 8
            for (int k = kg * 256; k < kg * 256 + 256; ++k) {
                const float w = W[(size_t)k * 3072];
                const float4 s0 = *(const float4*)(sc + k * 8), s1 = *(const float4*)(sc + k * 8 + 4);
                a[0] += w * s0.x; a[1] += w * s0.y; a[2] += w * s0.z; a[3] += w * s0.w; a[4] += w * s1.x; a[5] += w * s1.y; a[6] += w * s1.z; a[7] += w * s1.w;
            }
#pragma unroll
            for (int b = 0; b < 8; ++b) red[(kg * 8 + b) * 64 + cl] = a[b];
            __syncthreads();
            for (int i = t; i < 512; i += 256) {
                const int b = i >> 6, c2 = i & 63;
                const float s = red[(0 * 8 + b) * 64 + c2] + red[(1 * 8 + b) * 64 + c2] + red[(2 * 8 + b) * 64 + c2] + red[(3 * 8 + b) * 64 + c2];
                mod[((size_t)pr * 8 + b) * 3072 + cb * 64 + c2] = s + p.in[3][pr * 3072 + cb * 64 + c2];
            }
            __syncthreads();
        } else if (it >= n_ada + 256 && it < n_ada + n_rot) {
            float* rtw = (float*)(p.ws + OFF_RTW);
            const int base = (it - n_ada - 256) * 1024;
            for (int e = base + t; e < base + 1024; e += 256) {
                const int L = e / (36 * 1024), o = (e >> 10) % 36, k = e & 1023;
                rtw[e] = (o < 4) ? p.in[36][((size_t)L * 1024 + k) * 4 + o] : p.in[38][((size_t)L * 1024 + k) * 32 + (o - 4)];
            }
        } else if (it < n_ada + 256) {
            float* rot = (float*)(p.ws + OFF_ROT);
            const int base = (it - n_ada) * 1024;
            for (int e = base + t; e < base + 1024; e += 256) {
                const int tt = e >> 7, i = e & 127;
                const float inv = __builtin_amdgcn_exp2f(-(float)i * (13.287712379549449f / 127.0f));
                const float ang = (float)tt * inv;
                float rev = ang * 0.15915494309189535f; rev -= floorf(rev);
                rot[e * 2] = __builtin_amdgcn_cosf(rev); rot[e * 2 + 1] = __builtin_amdgcn_sinf(rev);
            }
        }
    }
    {
        float* sm = (float*)lds;
        const int lane = t & 63, wv = t >> 6;
        const float* nsrc = nullptr; bf16_t* ndst = nullptr; int nK = 0, nN = 0, nmode = 0, nkt = 0, nnt = 0;
        float4 pv[16];
#define CJ_SETUP(ct_) { int c_ = (ct_), j_ = 0; while (j_ + 1 < p.ncj && c_ >= p.cj[j_ + 1].tile0) ++j_; \
            c_ -= p.cj[j_].tile0; const int tpb_ = p.cj[j_].tiles_pb; const int bi_ = c_ / tpb_, tl_ = c_ % tpb_; nK = p.cj[j_].K; nN = p.cj[j_].N; nmode = p.cj[j_].mode; \
            const int nNt_ = (nN + 255) >> 8; nkt = tl_ / nNt_; nnt = tl_ % nNt_; nsrc = p.cj[j_].src + (size_t)bi_ * p.cj[j_].sbs; ndst = p.cj[j_].dst + (size_t)bi_ * p.cj[j_].dbs; }
#define CJ_LOAD() { _Pragma("unroll") for (int i = 0; i < 16; ++i) { const int k = nkt * 64 + wv + 4 * i, n = nnt * 256 + lane * 4; \
            pv[i] = (k < nK && n < nN) ? gld_f4(nsrc + (size_t)k * nN + n) : make_float4(0.f, 0.f, 0.f, 0.f); } }
        int* const tick = (int*)(p.ws + OFF_CTL + 20480);
        int* const nbox = (int*)(lds + 66560);
        int ct = (int)blockIdx.x, ct2 = (int)gridDim.x + (int)blockIdx.x;
        if (ct < p.cj_tiles) { CJ_SETUP(ct); CJ_LOAD(); }
        while (ct < p.cj_tiles) {
#pragma unroll
            for (int i = 0; i < 16; ++i) *(float4*)(sm + (wv + 4 * i) * 260 + lane * 4) = pv[i];
            bf16_t* const sdst = ndst; const int sK = nK, sN = nN, smode = nmode, skt = nkt, snt = nnt;
            if (ct2 < p.cj_tiles) { CJ_SETUP(ct2); CJ_LOAD(); }
            if (t == 0) *nbox = 2 * (int)gridDim.x + atomicAdd(tick, 1);
            __syncthreads();
            const int ct3 = *nbox;
#pragma unroll
            for (int h2 = 0; h2 < 4; ++h2) {
                const int nl = lane + 64 * h2, n = snt * 256 + nl, k0 = skt * 64 + wv * 16;
                if (n < sN && k0 < sK) {
                    float f[8], g[8];
#pragma unroll
                    for (int q = 0; q < 8; ++q) { f[q] = sm[(wv * 16 + q) * 260 + nl]; g[q] = sm[(wv * 16 + 8 + q) * 260 + nl]; }
                    bf16_t* d = sdst + (size_t)conv_row(smode, n) * sK + k0;
                    { const uint4 u0 = pack8(f), u1 = pack8(g); gst_u4(d, u0.x, u0.y, u0.z, u0.w); gst_u4(d + 8, u1.x, u1.y, u1.z, u1.w); }
                }
            }
            __syncthreads();
            ct = ct2; ct2 = ct3;
        }
#undef CJ_SETUP
#undef CJ_LOAD
    }
}

__device__ __forceinline__ void row_load_f32(const float* p, float (&v)[16], int lane) {
#pragma unroll
    for (int c = 0; c < 4; ++c) { const float4 x = gld_f4(p + c * 256 + lane * 4); v[c * 4] = x.x; v[c * 4 + 1] = x.y; v[c * 4 + 2] = x.z; v[c * 4 + 3] = x.w; }
}
__device__ __forceinline__ void row_load_f32_l(const float* p, float (&v)[16], int lane) {
#pragma unroll
    for (int c = 0; c < 4; ++c) { const float4 x = *(const float4*)(p + c * 256 + lane * 4); v[c * 4] = x.x; v[c * 4 + 1] = x.y; v[c * 4 + 2] = x.z; v[c * 4 + 3] = x.w; }
}
__device__ __forceinline__ void row_load_bf16(const bf16_t* p, float (&v)[16], int lane) {
#pragma unroll
    for (int c = 0; c < 4; ++c) { const uint2 x = gld_u2(p + c * 256 + lane * 4); v[c * 4] = bflo(x.x); v[c * 4 + 1] = bfhi(x.x); v[c * 4 + 2] = bflo(x.y); v[c * 4 + 3] = bfhi(x.y); }
}
__device__ __forceinline__ void row_store_bf16(bf16_t* p, const float (&v)[16], int lane) {
#pragma unroll
    for (int c = 0; c < 4; ++c) gst_u2(p + c * 256 + lane * 4, cvt_pk(v[c * 4], v[c * 4 + 1]), cvt_pk(v[c * 4 + 2], v[c * 4 + 3]));
}
__device__ __forceinline__ void row_store_f32(float* p, const float (&v)[16], int lane) {
#pragma unroll
    for (int c = 0; c < 4; ++c) gst_f4(p + c * 256 + lane * 4, v[c * 4], v[c * 4 + 1], v[c * 4 + 2], v[c * 4 + 3]);
}
__device__ __forceinline__ void row_store_f32_l(float* p, const float (&v)[16], int lane) {
#pragma unroll
    for (int c = 0; c < 4; ++c) *(float4*)(p + c * 256 + lane * 4) = make_float4(v[c * 4], v[c * 4 + 1], v[c * 4 + 2], v[c * 4 + 3]);
}
__device__ __forceinline__ void row_layernorm(float (&v)[16], const float* g, const float* b, int lane) {
    float gg[16], bb[16]; row_load_f32(g, gg, lane); row_load_f32(b, bb, lane);
    float s = 0.f, q = 0.f;
#pragma unroll
    for (int i = 0; i < 16; ++i) { s += v[i]; q += v[i] * v[i]; }
    s = wave_sum(s); q = wave_sum(q);
    const float mean = s * (1.0f / 1024.0f);
    const float rstd = rsqrtf(fmaxf(q * (1.0f / 1024.0f) - mean * mean, 0.f) + LN_EPS);
#pragma unroll
    for (int i = 0; i < 16; ++i) v[i] = (v[i] - mean) * rstd * gg[i] + bb[i];
}
__device__ __forceinline__ void row_modulate(const float (&x)[16], float (&h)[16], const float* mod3, int lane) {
    float sh[16], sc[16]; row_load_f32(mod3, sh, lane); row_load_f32(mod3 + 1024, sc, lane);
#pragma unroll
    for (int i = 0; i < 16; ++i) h[i] = x[i] * (1.0f + sc[i]) + sh[i];
}
__device__ __forceinline__ void load_mu(const float* mu, float (&m)[6][16], int lane) {
#pragma unroll
    for (int n = 0; n < 6; ++n) row_load_f32(mu + n * 1024, m[n], lane);
}
__device__ __forceinline__ void emit_next(bf16_t* s0, int kind, int row, const float (&h)[16], const float (&hp)[16], const float (&m)[6][16], int lane) {
    if (kind == 0) {
#pragma unroll
        for (int n = 0; n < 6; ++n) {
#pragma unroll
            for (int c = 0; c < 4; ++c)
                gst_u2(s0 + (size_t)n * (SLOT / 2) + (size_t)row * 1024 + c * 256 + lane * 4,
                       cvt_pk(h[c * 4] + (hp[c * 4] - h[c * 4]) * m[n][c * 4], h[c * 4 + 1] + (hp[c * 4 + 1] - h[c * 4 + 1]) * m[n][c * 4 + 1]),
                       cvt_pk(h[c * 4 + 2] + (hp[c * 4 + 2] - h[c * 4 + 2]) * m[n][c * 4 + 2], h[c * 4 + 3] + (hp[c * 4 + 3] - h[c * 4 + 3]) * m[n][c * 4 + 3]));
        }
    } else row_store_bf16(s0 + (size_t)row * 1024, h, lane);
}
__device__ __forceinline__ void emit_next_l(bf16_t* s0, const float* mu, int kind, int row, const float (&h)[16], const float (&hp)[16], int lane) {
    if (kind == 0) {
#pragma unroll 1
        for (int n = 0; n < 6; ++n) {
#pragma unroll
            for (int c2 = 0; c2 < 2; ++c2) {
                const float4 ma = gld_f4(mu + n * 1024 + (2 * c2) * 256 + lane * 4), mb = gld_f4(mu + n * 1024 + (2 * c2 + 1) * 256 + lane * 4);
                const float mm[8] = {ma.x, ma.y, ma.z, ma.w, mb.x, mb.y, mb.z, mb.w};
#pragma unroll
                for (int cc = 0; cc < 2; ++cc) {
                    const int c = 2 * c2 + cc;
                    gst_u2(s0 + (size_t)n * (SLOT / 2) + (size_t)row * 1024 + c * 256 + lane * 4,
                           cvt_pk(h[c * 4] + (hp[c * 4] - h[c * 4]) * mm[cc * 4], h[c * 4 + 1] + (hp[c * 4 + 1] - h[c * 4 + 1]) * mm[cc * 4 + 1]),
                           cvt_pk(h[c * 4 + 2] + (hp[c * 4 + 2] - h[c * 4 + 2]) * mm[cc * 4 + 2], h[c * 4 + 3] + (hp[c * 4 + 3] - h[c * 4 + 3]) * mm[cc * 4 + 3]));
                }
            }
        }
    } else row_store_bf16(s0 + (size_t)row * 1024, h, lane);
}
__device__ __forceinline__ void phase_h0(PRef p) {
    const int t_ = tidx(); const int lane = t_ & 63, gw = blockIdx.x * 4 + (t_ >> 6), nw = gridDim.x * 4;
    const int rpw = NTOK / nw;
    const int r_lo = gw * rpw;
    const float* mod = (const float*)(p.ws + OFF_MOD) + ((size_t)(0 * 2 + 0) * 8 + (r_lo >> 11)) * 3072;
    float sh[16], sc[16]; row_load_f32(mod, sh, lane); row_load_f32(mod + 1024, sc, lane);
    float hp[16];
#pragma unroll
    for (int i = 0; i < 16; ++i) hp[i] = 0.f;
    float mu[6][16]; load_mu(p.in[6], mu, lane);
    const int first = ((r_lo & 2047) != 0) ? r_lo - 1 : r_lo, end = r_lo + rpw;
    float nx[16]; row_load_f32(p.in[0] + (size_t)first * 1024, nx, lane);
    for (int r = first; r < end; ++r) {
        float h[16];
#pragma unroll
        for (int i = 0; i < 16; ++i) h[i] = nx[i] * (1.0f + sc[i]) + sh[i];
        if (r + 1 < end) row_load_f32(p.in[0] + (size_t)(r + 1) * 1024, nx, lane);
        __builtin_amdgcn_sched_barrier(0);
        if (r >= r_lo) emit_next((bf16_t*)(p.ws + OFF_SLOT), 0, r, h, hp, mu, lane);
#pragma unroll
        for (int i = 0; i < 16; ++i) hp[i] = h[i];
        if (((r + 1) & 2047) == 0) {
#pragma unroll
            for (int i = 0; i < 16; ++i) hp[i] = 0.f;
        }
    }
}
__device__ __forceinline__ int layer_kind(int L) { return L % 3; }
__device__ __forceinline__ void phase_ln2(PRef p, int L) {
    const int t_ = tidx(); const int lane = t_ & 63, gw = blockIdx.x * 4 + (t_ >> 6), nw = gridDim.x * 4;
    const int rpw = NTOK / nw, r_lo = gw * rpw;
    const float* mod = (const float*)(p.ws + OFF_MOD);
    const bf16_t* xres = (const bf16_t*)(p.ws + OFF_XRES);
    const bf16_t* Y = (const bf16_t*)(p.ws + OFF_SLOT + 9 * SLOT);
    const float* wgt = (const float*)(p.ws + OFF_WGT);
    const bool last = (L == 3);
    const int nk = layer_kind(L + 1), njr = (L + 1) / 3;
    const bool need_prev = (!last && nk == 0);
    const int bidx = r_lo >> 11;
    float gt[16], lgn[16], lbn[16];
    row_load_f32(mod + ((size_t)(L * 2 + 1) * 8 + bidx) * 3072 + 2048, gt, lane);
    row_load_f32(p.in[4] + (L * 2 + 1) * 1024, lgn, lane); row_load_f32(p.in[5] + (L * 2 + 1) * 1024, lbn, lane);
    float hp[16];
#pragma unroll
    for (int i = 0; i < 16; ++i) hp[i] = 0.f;
    float shn[16], scn[16];
    { const float* mn_ = mod + ((size_t)((last ? L : L + 1) * 2 + 0) * 8 + bidx) * 3072; row_load_f32(mn_, shn, lane); row_load_f32(mn_ + 1024, scn, lane); }
    uint2 nxr[4], ny0[4], ny1[4]; float nw0, nw1;
    auto load_in = [&](int r) {
#pragma unroll
        for (int c = 0; c < 4; ++c) { nxr[c] = *(const uint2*)(xres + (size_t)r * 1024 + c * 256 + lane * 4); ny0[c] = *(const uint2*)(Y + (size_t)(2 * r) * 1024 + c * 256 + lane * 4); ny1[c] = *(const uint2*)(Y + (size_t)(2 * r + 1) * 1024 + c * 256 + lane * 4); }
        nw0 = wgt[2 * r]; nw1 = wgt[2 * r + 1];
    };
    const int first = (need_prev && (r_lo & 2047) != 0) ? r_lo - 1 : r_lo, end = r_lo + rpw;
    load_in(first);
    for (int r = first; r < end; ++r) {
        float x[16];
        {
            const float w0 = nw0, w1 = nw1;
#pragma unroll
            for (int c = 0; c < 4; ++c) {
                const float a0[4] = {bflo(ny0[c].x), bfhi(ny0[c].x), bflo(ny0[c].y), bfhi(ny0[c].y)}, a1[4] = {bflo(ny1[c].x), bfhi(ny1[c].x), bflo(ny1[c].y), bfhi(ny1[c].y)};
                const float xr[4] = {bflo(nxr[c].x), bfhi(nxr[c].x), bflo(nxr[c].y), bfhi(nxr[c].y)};
#pragma unroll
                for (int i = 0; i < 4; ++i) x[c * 4 + i] = DN_ALPHA * xr[i] + (1.0f + gt[c * 4 + i]) * (w0 * a0[i] + w1 * a1[i]);
            }
        }
        if (r + 1 < end) load_in(r + 1);
        __builtin_amdgcn_sched_barrier(0);
        float s = 0.f, q = 0.f;
#pragma unroll
        for (int i = 0; i < 16; ++i) { s += x[i]; q += x[i] * x[i]; }
        s = wave_sum(s); q = wave_sum(q);
        const float mean = s * (1.0f / 1024.0f), rstd = rsqrtf(fmaxf(q * (1.0f / 1024.0f) - mean * mean, 0.f) + LN_EPS);
#pragma unroll
        for (int i = 0; i < 16; ++i) x[i] = (x[i] - mean) * rstd * lgn[i] + lbn[i];
        if (last) { row_store_f32(p.out + (size_t)r * 1024, x, lane); continue; }
        float h[16];
#pragma unroll
        for (int i = 0; i < 16; ++i) h[i] = x[i] * (1.0f + scn[i]) + shn[i];
        if (r >= r_lo) { row_store_bf16((bf16_t*)(p.ws + OFF_XRES2) + (size_t)r * 1024, x, lane); emit_next_l((bf16_t*)(p.ws + OFF_SLOT), p.in[6] + (size_t)njr * 6 * 1024, nk, r, h, hp, lane); }
#pragma unroll
        for (int i = 0; i < 16; ++i) hp[i] = h[i];
        if (((r + 1) & 2047) == 0) {
#pragma unroll
            for (int i = 0; i < 16; ++i) hp[i] = 0.f;
        }
    }
}
__device__ __forceinline__ void phase_ln1(PRef p, int L, char* lds, const bf16_t* ymix, bf16_t* hm) {
    const int t = tidx(), lane = t & 63, wid = t >> 6;
    const float* mod = (const float*)(p.ws + OFF_MOD);
    const bf16_t* xinb = (const bf16_t*)(p.ws + OFF_XRES2);
    bf16_t* xres = (bf16_t*)(p.ws + OFF_XRES);
    int* cnt = (int*)(p.ws + OFF_CNT) + L * 32;
    int* list = (int*)(p.ws + OFF_LIST);
    float* wgt = (float*)(p.ws + OFF_WGT);
    float* const HB = (float*)lds;
    float* const lg = (float*)(lds + 65536);
    const float* rtw = (const float*)(p.ws + OFF_RTW) + (size_t)L * 36 * 1024;
    const int rpb = NTOK / gridDim.x;
    const int bidx = (blockIdx.x * rpb) >> 11;
    float gt[16], lgn[16], lbn[16], sh2[16], sc2[16];
    row_load_f32(mod + ((size_t)(L * 2 + 0) * 8 + bidx) * 3072 + 2048, gt, lane);
    row_load_f32(p.in[4] + (L * 2 + 0) * 1024, lgn, lane); row_load_f32(p.in[5] + (L * 2 + 0) * 1024, lbn, lane);
    row_load_f32(mod + ((size_t)(L * 2 + 1) * 8 + bidx) * 3072, sh2, lane); row_load_f32(mod + ((size_t)(L * 2 + 1) * 8 + bidx) * 3072 + 1024, sc2, lane);
    for (int rb0 = blockIdx.x * rpb; rb0 < (blockIdx.x + 1) * rpb; rb0 += 16) {
        const int rb = rb0 + wid * 4;
        uint4 xr[4][4]; uint2 yr[4][4];
#pragma unroll
        for (int rr = 0; rr < 4; ++rr) {
            const int r = rb + rr;
#pragma unroll
            for (int c = 0; c < 4; ++c) {
                if (L == 0) xr[rr][c] = gld_u4(p.in[0] + (size_t)r * 1024 + c * 256 + lane * 4);
                else { const uint2 t2 = gld_u2(xinb + (size_t)r * 1024 + c * 256 + lane * 4); xr[rr][c] = make_uint4(t2.x, t2.y, 0u, 0u); }
                yr[rr][c] = gld_u2(ymix + (size_t)r * 1024 + c * 256 + lane * 4);
            }
        }
#pragma unroll
        for (int rr = 0; rr < 4; ++rr) {
            const int r = rb + rr;
            float x[16], h[16];
#pragma unroll
            for (int c = 0; c < 4; ++c) {
                float xv[4];
                if (L == 0) { xv[0] = __uint_as_float(xr[rr][c].x); xv[1] = __uint_as_float(xr[rr][c].y); xv[2] = __uint_as_float(xr[rr][c].z); xv[3] = __uint_as_float(xr[rr][c].w); }
                else { xv[0] = bflo(xr[rr][c].x); xv[1] = bfhi(xr[rr][c].x); xv[2] = bflo(xr[rr][c].y); xv[3] = bfhi(xr[rr][c].y); }
                const float yv[4] = {bflo(yr[rr][c].x), bfhi(yr[rr][c].x), bflo(yr[rr][c].y), bfhi(yr[rr][c].y)};
#pragma unroll
                for (int i = 0; i < 4; ++i) x[c * 4 + i] = DN_ALPHA * xv[i] + (1.0f + gt[c * 4 + i]) * yv[i];
            }
            float s = 0.f, q = 0.f;
#pragma unroll
            for (int i = 0; i < 16; ++i) { s += x[i]; q += x[i] * x[i]; }
            s = wave_sum(s); q = wave_sum(q);
            const float mean = s * (1.0f / 1024.0f), rstd = rsqrtf(fmaxf(q * (1.0f / 1024.0f) - mean * mean, 0.f) + LN_EPS);
#pragma unroll
            for (int i = 0; i < 16; ++i) { x[i] = (x[i] - mean) * rstd * lgn[i] + lbn[i]; h[i] = x[i] * (1.0f + sc2[i]) + sh2[i]; }
            row_store_bf16(xres + (size_t)r * 1024, x, lane);
            row_store_bf16(hm + (size_t)r * 1024, h, lane);
            row_store_f32_l(HB + (wid * 4 + rr) * 1024, h, lane);
        }
        __syncthreads();
#pragma unroll 1
        for (int q3 = 0; q3 < 9; q3 += 3) {
            float w[3][16];
#pragma unroll
            for (int u = 0; u < 3; ++u) row_load_f32(rtw + (size_t)(wid * 9 + q3 + u) * 1024, w[u], lane);
#pragma unroll 2
            for (int r16 = 0; r16 < 16; ++r16) {
                float h[16]; row_load_f32_l(HB + r16 * 1024, h, lane);
                float a3[3];
#pragma unroll
                for (int u = 0; u < 3; ++u) { float s2 = 0.f;
#pragma unroll
                    for (int i = 0; i < 16; ++i) s2 += h[i] * w[u][i];
                    a3[u] = wave_sum(s2); }
                if (lane == 0) {
#pragma unroll
                    for (int u = 0; u < 3; ++u) lg[r16 * 36 + wid * 9 + q3 + u] = a3[u];
                }
            }
        }
        __syncthreads();
        if (t < 16) {
            const int row = rb0 + t; const float* l = lg + t * 36;
            float g[4]; for (int i = 0; i < 4; ++i) g[i] = l[i] + p.in[37][L * 4 + i];
            int gi = 0; for (int i = 1; i < 4; ++i) if (g[i] > g[gi]) gi = i;
            float gs = 0.f; for (int i = 0; i < 4; ++i) gs += __expf(g[i] - g[gi]);
            const float ggate = 1.0f / gs;
            float e[8]; for (int i = 0; i < 8; ++i) e[i] = l[4 + gi * 8 + i] + p.in[39][L * 32 + gi * 8 + i];
            int i0 = 0; for (int i = 1; i < 8; ++i) if (e[i] > e[i0]) i0 = i;
            int i1 = (i0 == 0) ? 1 : 0; for (int i = 0; i < 8; ++i) if (i != i0 && e[i] > e[i1]) i1 = i;
            const float p1 = __expf(e[i1] - e[i0]);
            const float w0 = ggate / (1.0f + p1), w1 = ggate * p1 / (1.0f + p1);
            const int e0 = gi * 8 + i0, e1 = gi * 8 + i1;
            const int pos0 = atomicAdd(&cnt[e0], 1), pos1 = atomicAdd(&cnt[e1], 1);
            list[e0 * LIST_CAP + pos0] = 2 * row; list[e1 * LIST_CAP + pos1] = 2 * row + 1;
            wgt[2 * row] = w0; wgt[2 * row + 1] = w1;
        }
        asm volatile("s_waitcnt lgkmcnt(0)" ::: "memory");
    }
}

__device__ __forceinline__ int perm64(int r) { return (r & 64) | (((r >> 2) & 3) << 4) | (((r >> 4) & 3) << 2) | (r & 3); }
__device__ __forceinline__ bool tile_permuted(int mode, int nt) { return (mode <= MODE_SIGM) || (mode == MODE_ML1 && nt < 24) || (mode == MODE_RT1 && nt >= 16); }
__device__ __forceinline__ void store16(bf16_t* d, const f32x4 (&v)[4]) {
    gst_u4(d, cvt_pk(v[0][0], v[0][1]), cvt_pk(v[0][2], v[0][3]), cvt_pk(v[1][0], v[1][1]), cvt_pk(v[1][2], v[1][3]));
    gst_u4(d + 8, cvt_pk(v[2][0], v[2][1]), cvt_pk(v[2][2], v[2][3]), cvt_pk(v[3][0], v[3][1]), cvt_pk(v[3][2], v[3][3]));
}
__device__ __forceinline__ void gemm_epilogue(PRef p, const GJob& jb, int mt, int nt, const f32x4 (&acc)[4][4]) {
    const int t_ = tidx(); const int lane = t_ & 63, wid = t_ >> 6, wr = wid >> 1, wc = wid & 1, fr = lane & 15, fq = lane >> 4;
    const int row0 = mt * 128 + wr * 64 + fr;
    if (jb.mode <= MODE_SIGM) {
        const int col = nt * 128 + wc * 64 + fq * 16;
        if (col < jb.N) {
#pragma unroll
            for (int m = 0; m < 4; ++m) {
                f32x4 v[4];
#pragma unroll
                for (int n = 0; n < 4; ++n) {
                    v[n] = acc[m][n];
                    if (jb.mode == MODE_TANH) { v[n][0] = tanhf_(v[n][0]); v[n][1] = tanhf_(v[n][1]); v[n][2] = tanhf_(v[n][2]); v[n][3] = tanhf_(v[n][3]); }
                    else if (jb.mode == MODE_SIGM) { v[n][0] = sigmoidf_(v[n][0]); v[n][1] = sigmoidf_(v[n][1]); v[n][2] = sigmoidf_(v[n][2]); v[n][3] = sigmoidf_(v[n][3]); }
                }
                store16(jb.out + (size_t)(row0 + m * 16) * jb.ldo + col, v);
            }
        }
    } else if (jb.mode == MODE_ML1) {
        if (nt < 24) {
            bf16_t* ob = (bf16_t*)(p.ws + OFF_SLOT + (size_t)(1 + (nt >> 3)) * SLOT);
            const bool sg = (nt >= 16);
            const int col = (nt & 7) * 128 + wc * 64 + fq * 16;
#pragma unroll
            for (int m = 0; m < 4; ++m) {
                f32x4 v[4];
#pragma unroll
                for (int n = 0; n < 4; ++n) {
                    v[n] = acc[m][n];
                    if (sg) { v[n][0] = sigmoidf_(v[n][0]); v[n][1] = sigmoidf_(v[n][1]); v[n][2] = sigmoidf_(v[n][2]); v[n][3] = sigmoidf_(v[n][3]); }
                }
                store16(ob + (size_t)(row0 + m * 16) * 1024 + col, v);
            }
        } else if (wc == 0) {
            float* gates = (float*)(p.ws + OFF_GATES);
            const float* bg = p.in[26];
            const int c0 = fq * 4;
#pragma unroll
            for (int m = 0; m < 4; ++m) {
                f32x4 v = acc[m][0], o;
#pragma unroll
                for (int j = 0; j < 4; ++j) { const float g = v[j] + bg[c0 + j]; o[j] = (c0 + j < 8) ? g : -softplusf_(-g); }
                gst_f4(gates + (size_t)(row0 + m * 16) * 16 + c0, o[0], o[1], o[2], o[3]);
            }
        }
    } else {
        if (nt < 16) {
            const float* rot = (const float*)(p.ws + OFF_ROT);
            bf16_t* ob = (bf16_t*)(p.ws + OFF_SLOT + (size_t)(1 + (nt >> 3)) * SLOT);
            const float scl = (nt >= 8) ? 0.0625f : 1.0f;
#pragma unroll
            for (int pp = 0; pp < 2; ++pp) {
                const int blk32 = (nt & 7) * 4 + wc * 2 + pp, head = blk32 >> 3, i0 = (blk32 & 7) * 16 + fq * 4;
                float4 rc0[4], rc1[4];
#pragma unroll
                for (int m = 0; m < 4; ++m) { const int tt = (row0 + m * 16) & 2047; rc0[m] = gld_f4(rot + ((size_t)tt * 128 + i0) * 2); rc1[m] = gld_f4(rot + ((size_t)tt * 128 + i0) * 2 + 4); }
#pragma unroll
                for (int m = 0; m < 4; ++m) {
                    const int row = row0 + m * 16;
                    const float4 c0 = rc0[m], c1 = rc1[m];
                    const float cs[4] = {c0.x, c0.z, c1.x, c1.z}, sn[4] = {c0.y, c0.w, c1.y, c1.w};
                    const f32x4 x1 = acc[m][2 * pp], x2 = acc[m][2 * pp + 1];
                    float o1[4], o2[4];
#pragma unroll
                    for (int j = 0; j < 4; ++j) { o1[j] = (x1[j] * cs[j] - x2[j] * sn[j]) * scl; o2[j] = (x1[j] * sn[j] + x2[j] * cs[j]) * scl; }
                    gst_u2(ob + (size_t)row * 1024 + head * 256 + i0, cvt_pk(o1[0], o1[1]), cvt_pk(o1[2], o1[3]));
                    gst_u2(ob + (size_t)row * 1024 + head * 256 + 128 + i0, cvt_pk(o2[0], o2[1]), cvt_pk(o2[2], o2[3]));
                }
            }
        } else {
            const bool isg = (nt >= 32);
            bf16_t* ob = (bf16_t*)(p.ws + OFF_SLOT + (size_t)(isg ? 5 : 3) * SLOT);
            const int col = (nt & 15) * 128 + wc * 64 + fq * 16;
#pragma unroll
            for (int m = 0; m < 4; ++m) {
                f32x4 v[4];
#pragma unroll
                for (int n = 0; n < 4; ++n) {
                    v[n] = acc[m][n];
                    if (isg) { v[n][0] = siluf_(v[n][0]); v[n][1] = siluf_(v[n][1]); v[n][2] = siluf_(v[n][2]); v[n][3] = siluf_(v[n][3]); }
                }
                store16(ob + (size_t)(row0 + m * 16) * 2048 + col, v);
            }
        }
    }
}
__device__ __forceinline__ void phase_gemm_jobs(PRef p, char* lds, int jlo, int jhi) {
    const int total = p.gj[jhi - 1].tile0 + 128 * p.gj[jhi - 1].ntn - p.gj[jlo].tile0;
    for (int id = blockIdx.x; id < total; id += gridDim.x) {
        int j = jlo; const int gid = id + p.gj[jlo].tile0;
        while (j + 1 < jhi && gid >= p.gj[j + 1].tile0) ++j;
        GJob jb; jb.A = p.gj[j].A; jb.Bt = p.gj[j].Bt; jb.out = p.gj[j].out; jb.K = p.gj[j].K; jb.N = p.gj[j].N; jb.ldo = p.gj[j].ldo; jb.mode = p.gj[j].mode; jb.ntn = p.gj[j].ntn; jb.tile0 = p.gj[j].tile0;
        jb.half = p.gj[j].half;
        int mt, nt; tile_map(gid - jb.tile0, jb.ntn, mt, nt);
        if (jb.half || (jb.mode == MODE_ML1 && nt == 24)) {
            const int t_ = tidx(), r0_ = t_ >> 3, co_ = glds_chunk(t_) * 8, ln_ = t_ & 63, wv_ = t_ >> 6, fr_ = ln_ & 15, fq_ = ln_ >> 4;
            const int cb = jb.half ? nt * 64 : nt * 128;
            int nvh = jb.N - cb; nvh = nvh > 64 ? 64 : nvh;
            const bf16_t* ar[4]; const bf16_t* brh[2];
#pragma unroll
            for (int i = 0; i < 4; ++i) ar[i] = jb.A + (size_t)(mt * 128 + r0_ + 32 * i) * jb.K + co_;
#pragma unroll
            for (int i = 0; i < 2; ++i) { int rb_ = r0_ + 32 * i; rb_ = jb.half ? perm64(rb_) : rb_; rb_ = rb_ < nvh ? rb_ : nvh - 1; brh[i] = jb.Bt + (size_t)(cb + rb_) * jb.K + co_; }
            f32x4 ah[2][4];
            gemm_hn(lds, jb.K / 64, ar, brh, ah);
            const int rowh = mt * 128 + wv_ * 32 + fr_;
            if (jb.half) {
                const int col = cb + fq_ * 16;
                if (col < jb.N) {
#pragma unroll
                    for (int m = 0; m < 2; ++m) {
                        f32x4 v[4];
#pragma unroll
                        for (int n = 0; n < 4; ++n) {
                            v[n] = ah[m][n];
#pragma unroll
                            for (int jj = 0; jj < 4; ++jj) v[n][jj] = (jb.mode == MODE_TANH) ? tanhf_(v[n][jj]) : (jb.mode == MODE_SIGM) ? sigmoidf_(v[n][jj]) : v[n][jj];
                        }
                        store16(jb.out + (size_t)(rowh + m * 16) * jb.ldo + col, v);
                    }
                }
            } else {
                float* gates = (float*)(p.ws + OFF_GATES);
                const float* bg = p.in[26];
                const int c0 = fq_ * 4;
                const float4 bq = gld_f4(bg + c0);
                const float bqa[4] = {bq.x, bq.y, bq.z, bq.w};
#pragma unroll
                for (int m = 0; m < 2; ++m) {
                    float o[4];
#pragma unroll
                    for (int jj = 0; jj < 4; ++jj) { const float g = ah[m][0][jj] + bqa[jj]; o[jj] = (c0 + jj < 8) ? g : -softplusf_(-g); }
                    gst_f4(gates + (size_t)(rowh + m * 16) * 16 + c0, o[0], o[1], o[2], o[3]);
                }
            }
            continue;
        }
        int nv = jb.N - nt * 128; nv = nv > 128 ? 128 : nv;
        const bf16_t* ar[4]; const bf16_t* br[4];
        {
            const int t_ = tidx(), r0_ = t_ >> 3, co_ = glds_chunk(t_) * 8;
            const bool pm_ = tile_permuted(jb.mode, nt);
#pragma unroll
            for (int i = 0; i < 4; ++i) {
                ar[i] = jb.A + (size_t)(mt * 128 + r0_ + 32 * i) * jb.K + co_;
                int rb_ = r0_ + 32 * i; rb_ = pm_ ? perm64(rb_) : rb_; rb_ = rb_ < nv ? rb_ : nv - 1;
                br[i] = jb.Bt + (size_t)(nt * 128 + rb_) * jb.K + co_;
            }
        }
        f32x4 acc[4][4];
        gemm_gg(lds, jb.K / 64, ar, br, acc);
        gemm_epilogue(p, jb, mt, nt, acc);
    }
}

constexpr int RM = 4;
template <int KL>
__device__ __forceinline__ void minigemm(const bf16_t* A, const bf16_t* Bt, int fr, int fq, f32x4 (&acc)[RM][4]) {
#pragma unroll
    for (int m = 0; m < RM; ++m)
#pragma unroll
        for (int n = 0; n < 4; ++n) acc[m][n] = (f32x4){0.f, 0.f, 0.f, 0.f};
#pragma unroll 2
    for (int ks = 0; ks < KL / 32; ++ks) {
        uint4 af[RM], bfm[4];
#pragma unroll
        for (int m = 0; m < RM; ++m) af[m] = gld_u4(A + (size_t)(m * 16 + fr) * KL + ks * 32 + fq * 8);
#pragma unroll
        for (int n = 0; n < 4; ++n) bfm[n] = gld_u4(Bt + (size_t)((fr >> 2) * 16 + n * 4 + (fr & 3)) * KL + ks * 32 + fq * 8);
#pragma unroll
        for (int m = 0; m < RM; ++m)
#pragma unroll
            for (int n = 0; n < 4; ++n) acc[m][n] = mfma16(bfm[n], af[m], acc[m][n]);
    }
}
__device__ __forceinline__ void phase_rw2(PRef p, int jr) {
    const int t_ = tidx(); const int lane = t_ & 63, wid = t_ >> 6, wr = wid >> 1, wc = wid & 1, fr = lane & 15, fq = lane >> 4;
    char* S = p.ws + OFF_SLOT;
    float* decay = (float*)S; bf16_t* nkk = (bf16_t*)(S + 2 * SLOT); bf16_t* bb = (bf16_t*)(S + 3 * SLOT); bf16_t* gb = (bf16_t*)(S + 4 * SLOT);
    const bf16_t* rb = (const bf16_t*)(S + 6 * SLOT); const bf16_t* kb = (const bf16_t*)(S + 7 * SLOT); bf16_t* kpb = (bf16_t*)(S + 10 * SLOT);
    const bf16_t* vb = (const bf16_t*)(S + 8 * SLOT); bf16_t* vpb = (bf16_t*)(S + 9 * SLOT); const bf16_t* vf = (const bf16_t*)(S + 11 * SLOT);
    float* bonus = (float*)(p.ws + OFF_BONUS);
    const bf16_t* Lw = (const bf16_t*)(p.ws + OFF_LW); const bf16_t* La = (const bf16_t*)(p.ws + OFF_LA);
    const bf16_t* Lg = (const bf16_t*)(p.ws + OFF_LG); const bf16_t* Lv = (const bf16_t*)(p.ws + OFF_LV);
    const bf16_t* w2t = (const bf16_t*)(p.ws + W_W2T) + (size_t)jr * 1024 * 64; const bf16_t* a2t = (const bf16_t*)(p.ws + W_A2T) + (size_t)jr * 1024 * 64;
    const bf16_t* g2t = (const bf16_t*)(p.ws + W_G2T) + (size_t)jr * 1024 * 128; const bf16_t* v2t = (const bf16_t*)(p.ws + W_V2T);
    const float* w0 = p.in[8] + jr * 1024; const float* a0 = p.in[11] + jr * 1024; const float* v0 = p.in[14];
    const float* kkw = p.in[19] + jr * 1024; const float* kaw = p.in[20] + jr * 1024; const float* rk = p.in[21] + jr * 1024;
    for (int id2 = blockIdx.x; id2 < 128 * 8; id2 += gridDim.x) {
        int mt, nt; tile_map(id2, 8, mt, nt);
        const int row0 = mt * 128 + wr * 64, col0 = nt * 128 + wc * 64, head = nt * 2 + wc;
        f32x4 acc[RM][4];
        const int c0 = col0 + fq * 16;
        minigemm<64>(La + (size_t)row0 * 64, a2t + (size_t)col0 * 64, fr, fq, acc);
        float ss[RM], bs[RM];
#pragma unroll
        for (int m = 0; m < RM; ++m) { ss[m] = 0.f; bs[m] = 0.f; }
#pragma unroll
        for (int m = 0; m < RM; ++m) {
            const size_t off = (size_t)(row0 + m * 16 + fr) * 1024 + c0;
            const uint4 kq0 = *(const uint4*)(kb + off), kq1 = *(const uint4*)(kb + off + 8);
            const unsigned kw[8] = {kq0.x, kq0.y, kq0.z, kq0.w, kq1.x, kq1.y, kq1.z, kq1.w};
#pragma unroll
            for (int n = 0; n < 4; ++n) {
                const float4 a0v = *(const float4*)(a0 + c0 + n * 4), kkv = *(const float4*)(kkw + c0 + n * 4);
                const float a0a[4] = {a0v.x, a0v.y, a0v.z, a0v.w}, kka[4] = {kkv.x, kkv.y, kkv.z, kkv.w};
                const float kf4[4] = {bflo(kw[n * 2]), bfhi(kw[n * 2]), bflo(kw[n * 2 + 1]), bfhi(kw[n * 2 + 1])};
#pragma unroll
                for (int j = 0; j < 4; ++j) { acc[m][n][j] = sigmoidf_(a0a[j] + acc[m][n][j]); const float q = kf4[j] * kka[j]; ss[m] += q * q; }
            }
            asm volatile("" ::: "memory");
        }
#pragma unroll
        for (int m = 0; m < RM; ++m) { ss[m] += __shfl_xor(ss[m], 16); ss[m] += __shfl_xor(ss[m], 32); ss[m] = fminf(__builtin_amdgcn_rsqf(ss[m]), 1e12f); }
        float4 kkq[4], kaq[4], rkq[4];
#pragma unroll
        for (int n = 0; n < 4; ++n) { kkq[n] = gld_f4(kkw + c0 + n * 4); kaq[n] = gld_f4(kaw + c0 + n * 4); rkq[n] = gld_f4(rk + c0 + n * 4); }
#pragma unroll
        for (int m = 0; m < RM; ++m) {
            const size_t off = (size_t)(row0 + m * 16 + fr) * 1024 + c0;
            const uint4 rq0 = *(const uint4*)(rb + off), rq1 = *(const uint4*)(rb + off + 8), kq0 = *(const uint4*)(kb + off), kq1 = *(const uint4*)(kb + off + 8);
            const unsigned kw[8] = {kq0.x, kq0.y, kq0.z, kq0.w, kq1.x, kq1.y, kq1.z, kq1.w};
            const unsigned rw[8] = {rq0.x, rq0.y, rq0.z, rq0.w, rq1.x, rq1.y, rq1.z, rq1.w};
            unsigned okp[8], onk[8], obb[8];
#pragma unroll
            for (int n = 0; n < 4; ++n) {
                const float kka[4] = {kkq[n].x, kkq[n].y, kkq[n].z, kkq[n].w}, kaa[4] = {kaq[n].x, kaq[n].y, kaq[n].z, kaq[n].w}, rka[4] = {rkq[n].x, rkq[n].y, rkq[n].z, rkq[n].w};
                const float rf[4] = {bflo(rw[n * 2]), bfhi(rw[n * 2]), bflo(rw[n * 2 + 1]), bfhi(rw[n * 2 + 1])}, kf4[4] = {bflo(kw[n * 2]), bfhi(kw[n * 2]), bflo(kw[n * 2 + 1]), bfhi(kw[n * 2 + 1])};
                float kp[4], nk[4], b4[4];
#pragma unroll
                for (int j = 0; j < 4; ++j) {
                    const float a = acc[m][n][j], k = kf4[j], kn = k * kka[j] * ss[m];
                    kp[j] = k * (1.0f + (a - 1.0f) * kaa[j]); nk[j] = -kn; b4[j] = kn * a; bs[m] += rf[j] * kp[j] * rka[j];
                }
                okp[n * 2] = cvt_pk(kp[0], kp[1]); okp[n * 2 + 1] = cvt_pk(kp[2], kp[3]);
                onk[n * 2] = cvt_pk(nk[0], nk[1]); onk[n * 2 + 1] = cvt_pk(nk[2], nk[3]);
                obb[n * 2] = cvt_pk(b4[0], b4[1]); obb[n * 2 + 1] = cvt_pk(b4[2], b4[3]);
            }
            *(uint4*)(kpb + off) = make_uint4(okp[0], okp[1], okp[2], okp[3]); *(uint4*)(kpb + off + 8) = make_uint4(okp[4], okp[5], okp[6], okp[7]);
            *(uint4*)(nkk + off) = make_uint4(onk[0], onk[1], onk[2], onk[3]); *(uint4*)(nkk + off + 8) = make_uint4(onk[4], onk[5], onk[6], onk[7]);
            *(uint4*)(bb + off) = make_uint4(obb[0], obb[1], obb[2], obb[3]); *(uint4*)(bb + off + 8) = make_uint4(obb[4], obb[5], obb[6], obb[7]);
            asm volatile("" ::: "memory");
        }
#pragma unroll
        for (int m = 0; m < RM; ++m) { bs[m] += __shfl_xor(bs[m], 16); bs[m] += __shfl_xor(bs[m], 32); if (fq == 0) bonus[(size_t)(row0 + m * 16 + fr) * 16 + head] = bs[m]; }
        minigemm<64>(Lw + (size_t)row0 * 64, w2t + (size_t)col0 * 64, fr, fq, acc);
        float4 w0q[4];
#pragma unroll
        for (int n = 0; n < 4; ++n) w0q[n] = gld_f4(w0 + c0 + n * 4);
#pragma unroll
        for (int n = 0; n < 4; ++n) {
            const float w0a[4] = {w0q[n].x, w0q[n].y, w0q[n].z, w0q[n].w};
#pragma unroll
            for (int m = 0; m < RM; ++m) {
                f32x4 o;
#pragma unroll
                for (int j = 0; j < 4; ++j) { const float wl = -softplusf_(-(w0a[j] + acc[m][n][j])) - 0.5f; o[j] = __expf(-__expf(wl)); }
                *(f32x4*)(decay + (size_t)(row0 + m * 16 + fr) * 1024 + c0 + n * 4) = o;
            }
        }
        minigemm<128>(Lg + (size_t)row0 * 128, g2t + (size_t)col0 * 128, fr, fq, acc);
#pragma unroll
        for (int m = 0; m < RM; ++m) {
            unsigned o[8];
#pragma unroll
            for (int n = 0; n < 4; ++n) { o[n * 2] = cvt_pk(acc[m][n][0], acc[m][n][1]); o[n * 2 + 1] = cvt_pk(acc[m][n][2], acc[m][n][3]); }
            bf16_t* d = gb + (size_t)(row0 + m * 16 + fr) * 1024 + c0;
            *(uint4*)d = make_uint4(o[0], o[1], o[2], o[3]); *(uint4*)(d + 8) = make_uint4(o[4], o[5], o[6], o[7]);
        }
        if (jr > 0) {
            minigemm<32>(Lv + (size_t)row0 * 32, v2t + (size_t)col0 * 32, fr, fq, acc);
#pragma unroll
            for (int m = 0; m < RM; ++m) {
                const size_t off = (size_t)(row0 + m * 16 + fr) * 1024 + c0;
                const uint4 vq0 = *(const uint4*)(vb + off), vq1 = *(const uint4*)(vb + off + 8), fq0 = *(const uint4*)(vf + off), fq1 = *(const uint4*)(vf + off + 8);
                const unsigned vw[8] = {vq0.x, vq0.y, vq0.z, vq0.w, vq1.x, vq1.y, vq1.z, vq1.w}, fw[8] = {fq0.x, fq0.y, fq0.z, fq0.w, fq1.x, fq1.y, fq1.z, fq1.w};
                unsigned o[8];
#pragma unroll
                for (int n = 0; n < 4; ++n) {
                    const float4 v0v = *(const float4*)(v0 + c0 + n * 4); const float v0a[4] = {v0v.x, v0v.y, v0v.z, v0v.w};
                    const float v4[4] = {bflo(vw[n * 2]), bfhi(vw[n * 2]), bflo(vw[n * 2 + 1]), bfhi(vw[n * 2 + 1])}, f4[4] = {bflo(fw[n * 2]), bfhi(fw[n * 2]), bflo(fw[n * 2 + 1]), bfhi(fw[n * 2 + 1])};
                    float o4[4];
#pragma unroll
                    for (int j = 0; j < 4; ++j) o4[j] = v4[j] + (f4[j] - v4[j]) * sigmoidf_(v0a[j] + acc[m][n][j]);
                    o[n * 2] = cvt_pk(o4[0], o4[1]); o[n * 2 + 1] = cvt_pk(o4[2], o4[3]);
                }
                *(uint4*)(vpb + off) = make_uint4(o[0], o[1], o[2], o[3]); *(uint4*)(vpb + off + 8) = make_uint4(o[4], o[5], o[6], o[7]);
            }
        }
    }
}
__device__ __forceinline__ void phase_rw3(PRef p, int jr, char* lds) {
    const int t = tidx(), lane = t & 63, wid = t >> 6, rowq = lane >> 4, jq = lane & 15;
    char* S = p.ws + OFF_SLOT;
    const float* decay = (const float*)S; const bf16_t* nkk = (const bf16_t*)(S + 2 * SLOT); const bf16_t* bb = (const bf16_t*)(S + 3 * SLOT);
    const bf16_t* rb = (const bf16_t*)(S + 6 * SLOT); const bf16_t* kb = (const bf16_t*)(S + 10 * SLOT);
    const bf16_t* vb = (const bf16_t*)(S + (jr == 0 ? 11 : 9) * SLOT); bf16_t* yb = (bf16_t*)(S + 5 * SLOT);
    float* buf = (float*)lds;
    float* ybuf = (float*)(lds + 2 * 16 * 336 * 4);
    for (int item = blockIdx.x; item < 512; item += gridDim.x) {
        const int bh = item >> 2, rg = item & 3, b = bh >> 4, h = bh & 15;
        const size_t base = (size_t)b * 2048 * 1024 + h * 64;
        const bf16_t* vecp[2]; int vdst[2];
#pragma unroll
        for (int u = 0; u < 2; ++u) {
            const int id = t + 256 * u, vec = id >> 7, rem = id & 127, step = rem >> 3, c8 = rem & 7;
            const bf16_t* bp = (vec == 0) ? nkk : (vec == 1) ? bb : (vec == 2) ? kb : rb;
            vecp[u] = bp + base + (size_t)step * 1024 + c8 * 8; vdst[u] = step * 336 + 64 + vec * 64 + c8 * 8;
        }
        const float* dp = decay + base + (size_t)(t >> 4) * 1024 + (t & 15) * 4; const int ddst = (t >> 4) * 336 + (t & 15) * 4;
        const bf16_t* vp = vb + base + (size_t)(t >> 1) * 1024 + rg * 16 + (t & 1) * 8; const int vvdst = (t >> 1) * 336 + 320 + (t & 1) * 8;
        uint4 g0, g1, gv; float4 gd;
        auto fetch = [&](int ch) {
            const size_t o = (size_t)ch * 16 * 1024;
            g0 = gload16(vecp[0] + o); g1 = gload16(vecp[1] + o);
            { const uint4 d_ = gload16(dp + o); gd = make_float4(__uint_as_float(d_.x), __uint_as_float(d_.y), __uint_as_float(d_.z), __uint_as_float(d_.w)); }
            if (t < 32) gv = gload16(vp + o);
        };
        auto stash = [&](float* bf) {
            float f[8];
            unpack8(g0, f); *(float4*)(bf + vdst[0]) = make_float4(f[0], f[1], f[2], f[3]); *(float4*)(bf + vdst[0] + 4) = make_float4(f[4], f[5], f[6], f[7]);
            unpack8(g1, f); *(float4*)(bf + vdst[1]) = make_float4(f[0], f[1], f[2], f[3]); *(float4*)(bf + vdst[1] + 4) = make_float4(f[4], f[5], f[6], f[7]);
            *(float4*)(bf + ddst) = gd;
            if (t < 32) { unpack8(gv, f); *(float4*)(bf + vvdst) = make_float4(f[0], f[1], f[2], f[3]); *(float4*)(bf + vvdst + 4) = make_float4(f[4], f[5], f[6], f[7]); }
        };
        float s0 = 0.f, s1 = 0.f, s2 = 0.f, s3 = 0.f;
        __syncthreads();
        fetch(0); stash(buf); __syncthreads();
        for (int ch = 0; ch < 128; ++ch) {
            if (ch + 1 < 128) fetch(ch + 1);
            const float* bf = buf + (ch & 1) * (16 * 336); float* yb_ = ybuf + (ch & 1) * 256;
            float ykeep = 0.f;
            const float* q0 = bf + jq * 4; const float* v0p = bf + 320 + wid * 4 + rowq;
            float4 nw = *(const float4*)q0, na = *(const float4*)(q0 + 64), nb2 = *(const float4*)(q0 + 128), nk = *(const float4*)(q0 + 192), nr = *(const float4*)(q0 + 256);
            float nv = v0p[0];
#pragma unroll 4
            for (int s = 0; s < 16; ++s) {
                const float4 w = nw, a = na, bq = nb2, k = nk, r = nr; const float vv = nv;
                const float* q = q0 + (s + 1) * 336;
                nw = *(const float4*)q; na = *(const float4*)(q + 64); nb2 = *(const float4*)(q + 128); nk = *(const float4*)(q + 192); nr = *(const float4*)(q + 256);
                nv = v0p[(s + 1) * 336];
                __builtin_amdgcn_sched_barrier(0);
                float sa = s0 * a.x; sa = fmaf(s1, a.y, sa); sa = fmaf(s2, a.z, sa); sa = fmaf(s3, a.w, sa);
                sa = row16_sum(sa);
                s0 = fmaf(s0, w.x, fmaf(sa, bq.x, vv * k.x)); s1 = fmaf(s1, w.y, fmaf(sa, bq.y, vv * k.y));
                s2 = fmaf(s2, w.z, fmaf(sa, bq.z, vv * k.z)); s3 = fmaf(s3, w.w, fmaf(sa, bq.w, vv * k.w));
                float y = s0 * r.x; y = fmaf(s1, r.y, y); y = fmaf(s2, r.z, y); y = fmaf(s3, r.w, y);
                y = row16_sum(y);
                ykeep = (jq == s) ? y : ykeep;
            }
            yb_[jq * 16 + wid * 4 + rowq] = ykeep;
            if (ch + 1 < 128) stash(buf + ((ch + 1) & 1) * (16 * 336));
            __syncthreads();
            if (t < 32) { const int step = t >> 1, hf = t & 1; float f[8];
#pragma unroll
                for (int i = 0; i < 8; ++i) f[i] = yb_[step * 16 + hf * 8 + i];
                *(uint4*)(yb + base + (size_t)(ch * 16 + step) * 1024 + rg * 16 + hf * 8) = pack8(f); }
        }
    }
}
__device__ __forceinline__ uint2 lds_tr16(const char* p) {
    typedef short v4s_t __attribute__((ext_vector_type(4)));
    const v4s_t r = __builtin_amdgcn_ds_read_tr16_b64_v4i16((LAS v4s_t*)p);
    uint2 u; __builtin_memcpy(&u, &r, 8); return u;
}
__device__ __forceinline__ int sw64(int row, int col) { return row * 128 + ((((col >> 3) ^ (row & 7))) << 4) + (col & 7) * 2; }
__device__ __forceinline__ void phase_rw3c(PRef p, int jr, char* lds) {
    const int t = tidx(), lane = t & 63, w = t >> 6, fr = lane & 15, fq = lane >> 4;
    char* S = p.ws + OFF_SLOT;
    const float* decay = (const float*)S; const bf16_t* nkk = (const bf16_t*)(S + 2 * SLOT); const bf16_t* bb = (const bf16_t*)(S + 3 * SLOT);
    const bf16_t* rb = (const bf16_t*)(S + 6 * SLOT); const bf16_t* kb = (const bf16_t*)(S + 10 * SLOT);
    const bf16_t* vb = (const bf16_t*)(S + (jr == 0 ? 11 : 9) * SLOT); bf16_t* yb = (bf16_t*)(S + 5 * SLOT);
    char* const AT = lds;              char* const RT = lds + 4096;  char* const BT = lds + 8192;  char* const KT = lds + 12288;
    float* const PL = (float*)(lds + 16384);
    float* const GAB = (float*)(lds + 43264);
    char* const GAK = lds + 28672;     char* const GRB = lds + 30720; char* const GRK = lds + 32768;
    char* const VT = lds + 34816;      char* const UT = lds + 35840;
    char* const SB = lds + 36864;
    float* const XL = (float*)(lds + 38912);
    float* const PC = (float*)(lds + 40960);
    float* const GS = (float*)(lds + 41216);
    bf16_t* const YB = (bf16_t*)(lds + 42240);
    const int pj = t & 63, ptg = t >> 6;
    const int tk = t >> 3, ck = t & 7;
    const int vtau = t >> 3, vi2 = (t & 7) * 2;
    const int qq = fr >> 2, pp = fr & 3;
    for (int item = blockIdx.x; item < 512; item += gridDim.x) {
        const int bh = ((item >> 3) >> 2) * 8 + (item & 7), rg = (item >> 3) & 3, b = bh >> 4, h = bh & 15;
        const size_t base = (size_t)b * 2048 * 1024 + h * 64;
        __syncthreads();
        for (int i = t; i < 128; i += 256) *(uint4*)(SB + i * 16) = make_uint4(0u, 0u, 0u, 0u);
        f32x4 Sacc = (f32x4){0.f, 0.f, 0.f, 0.f};
        float gw[8]; uint4 ra, rb4, rk, rr, rw0, rw1; unsigned gvv = 0;
        auto fetch = [&](int c) {
#pragma unroll
            for (int s2 = 0; s2 < 8; ++s2) gw[s2] = *(const __attribute__((address_space(1))) float*)(decay + base + (size_t)(c * 32 + ptg * 8 + s2) * 1024 + pj);
            const size_t o = base + (size_t)(c * 32 + tk) * 1024 + ck * 8;
            ra = gload16(nkk + o); rb4 = gload16(bb + o); rk = gload16(kb + o); rr = gload16(rb + o); rw0 = gload16(decay + o); rw1 = gload16(decay + o + 4);
            gvv = *(const __attribute__((address_space(1))) unsigned*)(vb + base + (size_t)(c * 32 + vtau) * 1024 + rg * 16 + vi2);
        };
        fetch(0);
        for (int c = 0; c < 64; ++c) {
            {
                float cum[8]; float run = 1.f;
#pragma unroll
                for (int s2 = 0; s2 < 8; ++s2) { run *= gw[s2]; cum[s2] = run; }
                GS[ptg * 64 + pj] = run;
                __syncthreads();
                const float g0 = GS[pj], g1 = GS[64 + pj], g2 = GS[128 + pj], g3 = GS[192 + pj];
                const float off = (ptg > 0 ? g0 : 1.f) * (ptg > 1 ? g1 : 1.f) * (ptg > 2 ? g2 : 1.f);
                if (ptg == 0) PC[pj] = (g0 * g1) * (g2 * g3);
#pragma unroll
                for (int s2 = 0; s2 < 8; ++s2) PL[(ptg * 8 + s2) * 64 + pj] = off * cum[s2];
            }
            __syncthreads();
            {
                const float4 p0 = *(const float4*)(PL + tk * 64 + ck * 8), p1 = *(const float4*)(PL + tk * 64 + ck * 8 + 4);
                const unsigned ua[4] = {ra.x, ra.y, ra.z, ra.w}, ub[4] = {rb4.x, rb4.y, rb4.z, rb4.w}, uk[4] = {rk.x, rk.y, rk.z, rk.w}, ur[4] = {rr.x, rr.y, rr.z, rr.w};
                const f32x2_t Pp[4] = {{p0.x, p0.y}, {p0.z, p0.w}, {p1.x, p1.y}, {p1.z, p1.w}};
                const f32x2_t Wp[4] = {{__uint_as_float(rw0.x), __uint_as_float(rw0.y)}, {__uint_as_float(rw0.z), __uint_as_float(rw0.w)}, {__uint_as_float(rw1.x), __uint_as_float(rw1.y)}, {__uint_as_float(rw1.z), __uint_as_float(rw1.w)}};
                unsigned oa[4], orr[4], ob[4], ok[4];
#pragma unroll
                for (int i = 0; i < 4; ++i) {
                    const f32x2_t ei = {__builtin_amdgcn_rcpf(Pp[i].x), __builtin_amdgcn_rcpf(Pp[i].y)};
                    const f32x2_t rw = {__builtin_amdgcn_rcpf(Wp[i].x), __builtin_amdgcn_rcpf(Wp[i].y)};
                    const f32x2_t ex = Pp[i] * rw;
                    const f32x2_t va = {__uint_as_float(ua[i] << 16), __uint_as_float(ua[i] & 0xffff0000u)}, vr = {__uint_as_float(ur[i] << 16), __uint_as_float(ur[i] & 0xffff0000u)};
                    const f32x2_t vb2 = {__uint_as_float(ub[i] << 16), __uint_as_float(ub[i] & 0xffff0000u)}, vk = {__uint_as_float(uk[i] << 16), __uint_as_float(uk[i] & 0xffff0000u)};
                    const f32x2_t xa = va * ex, xr = vr * Pp[i], xb = vb2 * ei, xk = vk * ei;
                    oa[i] = cvt_pk(xa.x, xa.y); orr[i] = cvt_pk(xr.x, xr.y); ob[i] = cvt_pk(xb.x, xb.y); ok[i] = cvt_pk(xk.x, xk.y);
                }
                const int o = tk * 128 + ((ck ^ (tk & 7)) << 4);
                *(uint4*)(AT + o) = make_uint4(oa[0], oa[1], oa[2], oa[3]); *(uint4*)(RT + o) = make_uint4(orr[0], orr[1], orr[2], orr[3]);
                *(uint4*)(BT + o) = make_uint4(ob[0], ob[1], ob[2], ob[3]); *(uint4*)(KT + o) = make_uint4(ok[0], ok[1], ok[2], ok[3]);
                *(bf16_t*)(VT + vi2 * 64 + vtau * 2) = (bf16_t)(gvv & 0xffffu);
                *(bf16_t*)(VT + (vi2 + 1) * 64 + vtau * 2) = (bf16_t)(gvv >> 16);
            }
            if (c + 1 < 64) fetch(c + 1);
            __syncthreads();
            {
                const char* Mt = (w < 2) ? AT : RT; const char* Nt = (w & 1) ? BT : KT;
                f32x4 g[2][2];
#pragma unroll
                for (int m = 0; m < 2; ++m) { g[m][0] = (f32x4){0.f, 0.f, 0.f, 0.f}; g[m][1] = (f32x4){0.f, 0.f, 0.f, 0.f}; }
#pragma unroll
                for (int ks = 0; ks < 2; ++ks) {
                    const int chs = ((ks * 4 + fq) ^ (fr & 7)) << 4;
                    uint4 mf[2], nf[2];
#pragma unroll
                    for (int m = 0; m < 2; ++m) { mf[m] = *(const uint4*)(Mt + (m * 16 + fr) * 128 + chs); nf[m] = *(const uint4*)(Nt + (m * 16 + fr) * 128 + chs); }
#pragma unroll
                    for (int m = 0; m < 2; ++m)
#pragma unroll
                        for (int n = 0; n < 2; ++n) g[m][n] = mfma16(nf[n], mf[m], g[m][n]);
                }
#pragma unroll
                for (int m = 0; m < 2; ++m)
#pragma unroll
                    for (int n = 0; n < 2; ++n) {
                        const int tt = m * 16 + fr, tau0 = n * 16 + fq * 4;
                        f32x4 v4;
#pragma unroll
                        for (int j = 0; j < 4; ++j) { const int tau = tau0 + j; const bool keep = (w < 2) ? (tau < tt) : (tau <= tt); v4[j] = keep ? g[m][n][j] : 0.f; }
                        if (w == 1) *(f32x4*)(GAB + tt * 36 + tau0) = v4;
                        else {
                            char* G = (w == 0) ? GAK : (w == 2) ? GRK : GRB;
                            uint2 o; o.x = cvt_pk(v4[0], v4[1]); o.y = cvt_pk(v4[2], v4[3]);
                            *(uint2*)(G + tt * 64 + tau0 * 2) = o;
                        }
                    }
            }
            __syncthreads();
            if (w < 2) {
                f32x4 x = (f32x4){0.f, 0.f, 0.f, 0.f};
#pragma unroll
                for (int ks = 0; ks < 2; ++ks) {
                    const int chs = ((ks * 4 + fq) ^ (fr & 7)) << 4;
                    x = mfma16(*(const uint4*)(AT + (w * 16 + fr) * 128 + chs), *(const uint4*)(SB + fr * 128 + chs), x);
                }
                x = mfma16(*(const uint4*)(GAK + (w * 16 + fr) * 64 + fq * 16), *(const uint4*)(VT + fr * 64 + fq * 16), x);
                *(f32x4*)(XL + fr * 32 + w * 16 + fq * 4) = x;
            }
            __syncthreads();
            {
                const int tl = lane & 31;
                float Gr[32];
#pragma unroll
                for (int q4 = 0; q4 < 8; ++q4) { const float4 g4 = *(const float4*)(GAB + tl * 36 + q4 * 4); Gr[q4 * 4] = g4.x; Gr[q4 * 4 + 1] = g4.y; Gr[q4 * 4 + 2] = g4.z; Gr[q4 * 4 + 3] = g4.w; }
                float acc[4];
#pragma unroll
                for (int r = 0; r < 4; ++r) acc[r] = XL[(4 * w + r) * 32 + tl];
#pragma unroll
                for (int tau = 0; tau < 31; ++tau)
#pragma unroll
                    for (int r = 0; r < 4; ++r) acc[r] = fmaf(__int_as_float(__builtin_amdgcn_readlane(__float_as_int(acc[r]), tau)), Gr[tau], acc[r]);
                if (lane < 32) {
#pragma unroll
                    for (int r = 0; r < 4; ++r) *(bf16_t*)(UT + (4 * w + r) * 64 + tl * 2) = f2bf(acc[r]);
                }
            }
            __syncthreads();
            if (w < 2) {
                f32x4 y = (f32x4){0.f, 0.f, 0.f, 0.f};
#pragma unroll
                for (int ks = 0; ks < 2; ++ks) {
                    const int chs = ((ks * 4 + fq) ^ (fr & 7)) << 4;
                    y = mfma16(*(const uint4*)(RT + (w * 16 + fr) * 128 + chs), *(const uint4*)(SB + fr * 128 + chs), y);
                }
                y = mfma16(*(const uint4*)(GRB + (w * 16 + fr) * 64 + fq * 16), *(const uint4*)(UT + fr * 64 + fq * 16), y);
                y = mfma16(*(const uint4*)(GRK + (w * 16 + fr) * 64 + fq * 16), *(const uint4*)(VT + fr * 64 + fq * 16), y);
#pragma unroll
                for (int j = 0; j < 4; ++j) YB[(w * 16 + fq * 4 + j) * 16 + fr] = f2bf(y[j]);
            }
            {
                const int r0 = fq * 8 + qq, kc = 2 * w + (pp >> 1);
                const int o0 = r0 * 128 + ((kc ^ (r0 & 7)) << 4) + (pp & 1) * 8, o1 = (r0 + 4) * 128 + ((kc ^ ((r0 + 4) & 7)) << 4) + (pp & 1) * 8;
                const uint2 blo = lds_tr16(BT + o0), bhi = lds_tr16(BT + o1), klo = lds_tr16(KT + o0), khi = lds_tr16(KT + o1);
                Sacc = mfma16(make_uint4(blo.x, blo.y, bhi.x, bhi.y), *(const uint4*)(UT + fr * 64 + fq * 16), Sacc);
                Sacc = mfma16(make_uint4(klo.x, klo.y, khi.x, khi.y), *(const uint4*)(VT + fr * 64 + fq * 16), Sacc);
                const float4 pc = *(const float4*)(PC + 16 * w + fq * 4);
                Sacc[0] *= pc.x; Sacc[1] *= pc.y; Sacc[2] *= pc.z; Sacc[3] *= pc.w;
            }
            __syncthreads();
            {
                uint2 o; o.x = cvt_pk(Sacc[0], Sacc[1]); o.y = cvt_pk(Sacc[2], Sacc[3]);
                *(uint2*)(SB + fr * 128 + ((((2 * w + (fq >> 1))) ^ (fr & 7)) << 4) + (fq & 1) * 8) = o;
                if (t < 64) {
                    const int tt = t >> 1, hf = t & 1;
                    const uint4 yv_ = *(const uint4*)((const char*)YB + tt * 32 + hf * 16); const u32x4_t yx_ = {yv_.x, yv_.y, yv_.z, yv_.w};
                    *(__attribute__((address_space(1))) u32x4_t*)(yb + base + (size_t)(c * 32 + tt) * 1024 + rg * 16 + hf * 8) = yx_;
                }
            }
        }
    }
}
struct LdRw4 {
    struct Raw { uint4 y, v, g; float bn; };
    const bf16_t *y, *v, *g; const float *bonus, *gng, *gnb;
    __device__ __forceinline__ Raw fetch(int, int r, int kc) const {
        Raw q; const size_t o = (size_t)r * 1024 + kc * 8;
        q.y = *(const uint4*)(y + o); q.v = *(const uint4*)(v + o); q.g = *(const uint4*)(g + o); q.bn = bonus[r * 16 + (kc >> 3)]; return q;
    }
    __device__ __forceinline__ uint4 finish(const Raw& q, int, int, int kc) const {
        float yf[8], vf[8], gf[8]; unpack8(q.y, yf); unpack8(q.v, vf); unpack8(q.g, gf);
        float s = 0.f, s2 = 0.f;
#pragma unroll
        for (int i = 0; i < 8; ++i) { s += yf[i]; s2 += yf[i] * yf[i]; }
        s = oct_sum(s); s2 = oct_sum(s2);
        const float mean = s * (1.0f / 64.0f), var = fmaxf(s2 * (1.0f / 64.0f) - mean * mean, 0.f), rstd = rsqrtf(var + 64e-5f);
        const float4 ga = *(const float4*)(gng + kc * 8), gb = *(const float4*)(gng + kc * 8 + 4), ba = *(const float4*)(gnb + kc * 8), bb = *(const float4*)(gnb + kc * 8 + 4);
        const float gg[8] = {ga.x, ga.y, ga.z, ga.w, gb.x, gb.y, gb.z, gb.w}, bq[8] = {ba.x, ba.y, ba.z, ba.w, bb.x, bb.y, bb.z, bb.w};
        float o[8];
#pragma unroll
        for (int i = 0; i < 8; ++i) o[i] = ((yf[i] - mean) * rstd * gg[i] + bq[i] + q.bn * vf[i]) * gf[i];
        return pack8(o);
    }
};
__device__ __forceinline__ void phase_rw4(PRef p, int jr, char* lds) {
    char* S = p.ws + OFF_SLOT;
    const bf16_t* yb = (const bf16_t*)(S + 5 * SLOT); const bf16_t* gb = (const bf16_t*)(S + 4 * SLOT);
    const bf16_t* vb = (const bf16_t*)(S + (jr == 0 ? 11 : 9) * SLOT); bf16_t* ymix = (bf16_t*)(S + 6 * SLOT);
    const bf16_t* wt = (const bf16_t*)(p.ws + W_OUT) + (size_t)jr * 1024 * 1024;
    const float* bonus = (const float*)(p.ws + OFF_BONUS);
    const int t_ = tidx(); const int lane = t_ & 63, wid = t_ >> 6, wr = wid >> 1, wc = wid & 1, fr = lane & 15, fq = lane >> 4;
    for (int id = blockIdx.x; id < 128 * 8; id += gridDim.x) {
        int mt, nt; tile_map(id, 8, mt, nt);
        const size_t ro = (size_t)mt * 128 * 1024;
        LdRw4 al{yb + ro, vb + ro, gb + ro, bonus + (size_t)mt * 128 * 16, p.in[22] + jr * 1024, p.in[23] + jr * 1024};
        const bf16_t* br[4];
        { const int t2_ = tidx(), r0_ = t2_ >> 3, co_ = glds_chunk(t2_) * 8;
#pragma unroll
          for (int i = 0; i < 4; ++i) br[i] = wt + (size_t)(nt * 128 + r0_ + 32 * i) * 1024 + co_; }
        f32x4 acc[4][4];
        gemm_rg(lds, 16, al, br, acc);
#pragma unroll
        for (int n = 0; n < 4; ++n)
#pragma unroll
            for (int m = 0; m < 4; ++m) {
                uint2 o; o.x = cvt_pk(acc[m][n][0], acc[m][n][1]); o.y = cvt_pk(acc[m][n][2], acc[m][n][3]);
                *(uint2*)(ymix + (size_t)(mt * 128 + wr * 64 + m * 16 + fr) * 1024 + nt * 128 + wc * 64 + n * 16 + fq * 4) = o;
            }
    }
}

__device__ __forceinline__ void phase_cml(PRef p) {
    const int t = tidx();
    char* S = p.ws + OFF_SLOT;
    const bf16_t* src = (const bf16_t*)(S + 1 * SLOT); bf16_t* dst = (bf16_t*)(S + 8 * SLOT);
    const int col = (t & 127) * 8, half = t >> 7;
    float cw[4][8], cb[8];
#pragma unroll
    for (int j = 0; j < 4; ++j) {
        const float4 a = *(const float4*)(p.in[27] + j * 1024 + col), b = *(const float4*)(p.in[27] + j * 1024 + col + 4);
        cw[j][0] = a.x; cw[j][1] = a.y; cw[j][2] = a.z; cw[j][3] = a.w; cw[j][4] = b.x; cw[j][5] = b.y; cw[j][6] = b.z; cw[j][7] = b.w;
    }
    { const float4 a = *(const float4*)(p.in[28] + col), b = *(const float4*)(p.in[28] + col + 4);
      cb[0] = a.x; cb[1] = a.y; cb[2] = a.z; cb[3] = a.w; cb[4] = b.x; cb[5] = b.y; cb[6] = b.z; cb[7] = b.w; }
    const float qs = (col < 512) ? 0.125f : 1.0f;
    for (int item = blockIdx.x; item < 1024; item += gridDim.x) {
        const int b = item >> 7, s0 = (item & 127) * 16 + half * 8;
        const bf16_t* base = src + (size_t)b * 2048 * 1024 + col;
        uint4 r[11];
#pragma unroll
        for (int i = 0; i < 11; ++i) { const int sr = s0 - 3 + i; r[i] = gload16(base + (size_t)max(sr, 0) * 1024); if (sr < 0) r[i] = make_uint4(0u, 0u, 0u, 0u); }
        float x0[8], x1[8], x2[8];
        unpack8(r[0], x0); unpack8(r[1], x1); unpack8(r[2], x2);
#pragma unroll
        for (int i = 0; i < 8; ++i) {
            float x3[8], a[8]; unpack8(r[i + 3], x3);
#pragma unroll
            for (int e = 0; e < 8; ++e) { a[e] = cb[e] + cw[0][e] * x0[e] + cw[1][e] * x1[e] + cw[2][e] * x2[e] + cw[3][e] * x3[e]; a[e] = siluf_(a[e]) * qs; }
            *(uint4*)(dst + ((size_t)b * 2048 + s0 + i) * 1024 + col) = pack8(a);
#pragma unroll
            for (int e = 0; e < 8; ++e) { x0[e] = x1[e]; x1[e] = x2[e]; x2[e] = x3[e]; }
        }
    }
}
__device__ __forceinline__ void phase_ml2(PRef p, char* lds) {
    const int t = tidx(), lane = t & 63, w = t >> 6, fr = lane & 15, fq = lane >> 4;
    char* S = p.ws + OFF_SLOT;
    const bf16_t* qk = (const bf16_t*)(S + 8 * SLOT); const bf16_t* vb = (const bf16_t*)(S + 2 * SLOT); bf16_t* yb = (bf16_t*)(S + 4 * SLOT);
    const float* gates = (const float*)(p.ws + OFF_GATES); float* stat = (float*)(p.ws + OFF_STAT);
    char* const RAW = lds;
    char* const QT = lds + 17408; char* const KT = lds + 25600;
    char* const VT = lds + 33792;
    char* const VX = lds + 35840;
    char* const PB = lds + 39936;
    char* const CT = lds + 48128;
    float* const FS = (float*)(lds + 52224); float* const GJ = FS + 64; float* const WJ = FS + 128;
    float* const CW = (float*)(lds + 53248);
    const int qq = fr >> 2, pp = fr & 3;
    for (int item = blockIdx.x; item < 512; item += gridDim.x) {
        const int bh = ((item >> 3) >> 3) * 8 + (item & 7), vs = (item >> 3) & 7, b = bh >> 3, hd = bh & 7;
        const size_t tok0 = (size_t)b * 2048;
        __syncthreads();
        for (int i = t; i < 256; i += 256) *(uint4*)(CT + i * 16) = make_uint4(0u, 0u, 0u, 0u);
        f32x4 Cacc[2] = {(f32x4){0.f, 0.f, 0.f, 0.f}, (f32x4){0.f, 0.f, 0.f, 0.f}};
        uint4 gr0, gr1, gr2, gr3; uint4 gv = make_uint4(0u, 0u, 0u, 0u); float gg = 0.f;
        const int frr = t >> 4, fc = t & 15;
        const bf16_t* const qkt = qk + (tok0 + frr) * 1024 + (fc >> 3) * 512 + hd * 64 + (fc & 7) * 8;
        char* const qkd = ((fc < 8) ? QT : KT) + frr * 128 + (((fc & 7) ^ (frr & 7)) << 4);
        auto fetch = [&](int ch) {
            const int s0 = ch * 64;
            const bf16_t* q0 = qkt + (size_t)s0 * 1024;
            gr0 = gload16(q0); gr1 = gload16(q0 + 16 * 1024); gr2 = gload16(q0 + 32 * 1024); gr3 = gload16(q0 + 48 * 1024);
            if (t < 128) { gv = gload16(vb + (tok0 + s0 + (t >> 1)) * 1024 + hd * 128 + vs * 16 + (t & 1) * 8);
                           gg = *(const __attribute__((address_space(1))) float*)(gates + (tok0 + s0 + (t & 63)) * 16 + (t >> 6) * 8 + hd); }
        };
        fetch(0);
        for (int ch = 0; ch < 32; ++ch) {
            const int s0 = ch * 64;
            *(uint4*)qkd = gr0; *(uint4*)(qkd + 16 * 128) = gr1; *(uint4*)(qkd + 32 * 128) = gr2; *(uint4*)(qkd + 48 * 128) = gr3;
            if (t < 128) *(uint4*)(VT + t * 16) = gv;
            float vf8[8]; unpack8(gv, vf8);
            if (t >= 64 && t < 128) GJ[t - 64] = gg;
            const float ggc = gg;
            if (ch + 1 < 32) fetch(ch + 1);
            __syncthreads();
            if (t < 64) {
                float f = GJ[t];
                f += __builtin_amdgcn_update_dpp(0.f, f, 0x111, 0xf, 0xf, false);
                f += __builtin_amdgcn_update_dpp(0.f, f, 0x112, 0xf, 0xf, false);
                f += __builtin_amdgcn_update_dpp(0.f, f, 0x114, 0xf, 0xf, false);
                f += __builtin_amdgcn_update_dpp(0.f, f, 0x118, 0xf, 0xf, false);
                f += __builtin_amdgcn_update_dpp(0.f, f, 0x142, 0xa, 0xf, false);
                f += __builtin_amdgcn_update_dpp(0.f, f, 0x143, 0xc, 0xf, false);
                const float fend = __int_as_float(__builtin_amdgcn_readlane(__float_as_int(f), 63));
                FS[t] = f; WJ[t] = __expf(fend - f + ggc);
                GJ[t] = ggc - f;
            }
            __syncthreads();
            const float efend = __expf(FS[63]);
            {
                if (t < 128) {
                    const int j = t >> 1; const float wj = WJ[j];
                    float f[8];
#pragma unroll
                    for (int i = 0; i < 8; ++i) f[i] = vf8[i] * wj;
                    *(uint4*)(VX + j * 64 + (t & 1) * 16) = pack8(f);
                    float g8[8] = {0.f, 0.f, 0.f, 0.f, 0.f, 0.f, 0.f, 0.f}; if ((t & 1) == 0) g8[0] = wj;
                    *(uint4*)(VX + j * 64 + 32 + (t & 1) * 16) = pack8(g8);
                }
            }
            __syncthreads();
            const int srow = 16 * w + fr;
            f32x4 Sacc[4], Xacc[2];
#pragma unroll
            for (int n = 0; n < 4; ++n) Sacc[n] = (f32x4){0.f, 0.f, 0.f, 0.f};
            Xacc[0] = (f32x4){0.f, 0.f, 0.f, 0.f}; Xacc[1] = (f32x4){0.f, 0.f, 0.f, 0.f};
            Cacc[0] *= efend; Cacc[1] *= efend;
#pragma unroll
            for (int ks = 0; ks < 2; ++ks) {
                const int chs = ((ks * 4 + fq) ^ (fr & 7)) << 4;
                const uint4 qf = *(const uint4*)(QT + srow * 128 + chs);
#pragma unroll
                for (int n = 0; n < 4; ++n) { const uint4 kf = *(const uint4*)(KT + (n * 16 + fr) * 128 + chs); Sacc[n] = mfma16(kf, qf, Sacc[n]); }
#pragma unroll
                for (int nn = 0; nn < 2; ++nn) { const uint4 rf = *(const uint4*)(CT + (nn * 16 + fr) * 128 + chs); Xacc[nn] = mfma16(rf, qf, Xacc[nn]); }
                const int r0 = ks * 32 + fq * 8 + qq, kc = 2 * w + (pp >> 1);
                const uint2 klo = lds_tr16(KT + r0 * 128 + ((kc ^ (r0 & 7)) << 4) + (pp & 1) * 8);
                const uint2 khi = lds_tr16(KT + (r0 + 4) * 128 + ((kc ^ ((r0 + 4) & 7)) << 4) + (pp & 1) * 8);
                const uint4 kt = make_uint4(klo.x, klo.y, khi.x, khi.y);
#pragma unroll
                for (int m = 0; m < 2; ++m) {
                    const uint2 vlo = lds_tr16(VX + r0 * 64 + (16 * m + 4 * pp) * 2), vhi = lds_tr16(VX + (r0 + 4) * 64 + (16 * m + 4 * pp) * 2);
                    Cacc[m] = mfma16(kt, make_uint4(vlo.x, vlo.y, vhi.x, vhi.y), Cacc[m]);
                }
            }
            const float fs = FS[srow];
            float dsum = 0.f;
#pragma unroll
            for (int n = 0; n < 4; ++n) {
                const float4 g4 = *(const float4*)(GJ + n * 16 + fq * 4); const float ga[4] = {g4.x, g4.y, g4.z, g4.w};
                float pv[4];
#pragma unroll
                for (int j = 0; j < 4; ++j) { const int jc = n * 16 + fq * 4 + j; pv[j] = (srow >= jc) ? Sacc[n][j] * __expf(fs + ga[j]) : 0.f; dsum += pv[j]; }
                uint2 o; o.x = cvt_pk(pv[0], pv[1]); o.y = cvt_pk(pv[2], pv[3]);
                *(uint2*)(PB + srow * 128 + (((n * 2 + (fq >> 1)) ^ (fr & 7)) << 4) + (fq & 1) * 8) = o;
            }
            dsum += __shfl_xor(dsum, 16); dsum += __shfl_xor(dsum, 32);
            f32x4 Iacc = (f32x4){0.f, 0.f, 0.f, 0.f};
#pragma unroll
            for (int ks = 0; ks < 2; ++ks) {
                const uint4 pf = *(const uint4*)(PB + srow * 128 + (((ks * 4 + fq) ^ (fr & 7)) << 4));
                const int r0 = ks * 32 + fq * 8 + qq;
                const uint2 vlo = lds_tr16(VT + r0 * 32 + (4 * pp) * 2), vhi = lds_tr16(VT + (r0 + 4) * 32 + (4 * pp) * 2);
                Iacc = mfma16(make_uint4(vlo.x, vlo.y, vhi.x, vhi.y), pf, Iacc);
            }
            const float efs = __expf(fs);
            const float ndq = __shfl(Xacc[1][0], fr);
            const float den = dsum + efs * ndq;
            const float rden = 1.0f / fmaxf(fabsf(den), 1.0f);
            const size_t tok = tok0 + s0 + srow;
            float o4[4], ssum = 0.f, ssq = 0.f;
#pragma unroll
            for (int j = 0; j < 4; ++j) { o4[j] = (Iacc[j] + efs * Xacc[0][j]) * rden; ssum += o4[j]; ssq += o4[j] * o4[j]; }
            gst_u2(yb + tok * 1024 + hd * 128 + vs * 16 + fq * 4, cvt_pk(o4[0], o4[1]), cvt_pk(o4[2], o4[3]));
            ssum += __shfl_xor(ssum, 16); ssum += __shfl_xor(ssum, 32); ssq += __shfl_xor(ssq, 16); ssq += __shfl_xor(ssq, 32);
            if (fq == 0) gst_u2(stat + ((tok * 8 + hd) * 8 + vs) * 2, __float_as_uint(ssum), __float_as_uint(ssq));
            __syncthreads();
#pragma unroll
            for (int m = 0; m < 2; ++m) {
                const int v = m * 16 + fr;
                uint2 o; o.x = cvt_pk(Cacc[m][0], Cacc[m][1]); o.y = cvt_pk(Cacc[m][2], Cacc[m][3]);
                *(uint2*)(CT + v * 128 + (((2 * w + (fq >> 1)) ^ (v & 7)) << 4) + (fq & 1) * 8) = o;
            }
        }
    }
}
template <int HSHIFT  , int NH>
struct LdGnGate {
    struct Raw { uint4 y, g; };
    const bf16_t *y, *g; int ld; const float *gng, *gnb; const float* st;
    __device__ __forceinline__ Raw fetch(int, int r, int kc) const { Raw q; const size_t o = (size_t)r * ld + kc * 8; q.y = *(const uint4*)(y + o); q.g = *(const uint4*)(g + o); return q; }
    __device__ __forceinline__ uint4 finish(const Raw& q, int, int r, int kc) const {
        float yf[8], gf[8]; unpack8(q.y, yf); unpack8(q.g, gf);
        const float2 ms = *(const float2*)(st + (r * NH + ((kc * 8) >> HSHIFT)) * 2);
        const float4 ga = *(const float4*)(gng + kc * 8), gb = *(const float4*)(gng + kc * 8 + 4), ba = *(const float4*)(gnb + kc * 8), bb = *(const float4*)(gnb + kc * 8 + 4);
        const float gg[8] = {ga.x, ga.y, ga.z, ga.w, gb.x, gb.y, gb.z, gb.w}, bq[8] = {ba.x, ba.y, ba.z, ba.w, bb.x, bb.y, bb.z, bb.w};
        float o[8];
#pragma unroll
        for (int i = 0; i < 8; ++i) o[i] = ((yf[i] - ms.x) * ms.y * gg[i] + bq[i]) * gf[i];
        return pack8(o);
    }
};
template <int HSHIFT, int NH, int NPART>
__device__ __forceinline__ void phase_outproj_gn(PRef p, char* lds, const bf16_t* yb, const bf16_t* gate, int K, const bf16_t* wt, const float* gng, const float* gnb, bf16_t* ymix) {
    const int t = tidx(), lane = t & 63, wid = t >> 6, wr = wid >> 1, wc = wid & 1, fr = lane & 15, fq = lane >> 4;
    const float* stat = (const float*)(p.ws + OFF_STAT);
    float* st = (float*)(lds + 65536);
    const float invn = 1.0f / (float)(1 << HSHIFT);
    for (int id = blockIdx.x; id < 128 * 8; id += gridDim.x) {
        int mt, nt; tile_map(id, 8, mt, nt);
        for (int i = t; i < 128 * NH; i += 256) {
            const float* q = stat + ((size_t)mt * 128 * NH + i) * NPART * 2;
            float s = 0.f, s2 = 0.f;
#pragma unroll
            for (int j = 0; j < NPART; ++j) { const float2 v = *(const float2*)(q + j * 2); s += v.x; s2 += v.y; }
            const float mean = s * invn, var = fmaxf(s2 * invn - mean * mean, 0.f);
            st[i * 2] = mean; st[i * 2 + 1] = rsqrtf(var + 1e-6f);
        }
        __syncthreads();
        const size_t ro = (size_t)mt * 128 * K;
        LdGnGate<HSHIFT, NH> al{yb + ro, gate + ro, K, gng, gnb, st};
        const bf16_t* br[4];
        { const int r0_ = t >> 3, co_ = glds_chunk(t) * 8;
#pragma unroll
          for (int i = 0; i < 4; ++i) br[i] = wt + (size_t)(nt * 128 + r0_ + 32 * i) * K + co_; }
        f32x4 acc[4][4];
        gemm_rg(lds, K / 64, al, br, acc);
#pragma unroll
        for (int n = 0; n < 4; ++n)
#pragma unroll
            for (int m = 0; m < 4; ++m) {
                uint2 o; o.x = cvt_pk(acc[m][n][0], acc[m][n][1]); o.y = cvt_pk(acc[m][n][2], acc[m][n][3]);
                *(uint2*)(ymix + (size_t)(mt * 128 + wr * 64 + m * 16 + fr) * 1024 + nt * 128 + wc * 64 + n * 16 + fq * 4) = o;
            }
    }
}

__device__ __forceinline__ void phase_rt2(PRef p, char* lds) {
    const int t = tidx(), lane = t & 63, w = t >> 6, fr = lane & 15, fq = lane >> 4;
    char* S = p.ws + OFF_SLOT;
    const bf16_t* qb = (const bf16_t*)(S + 1 * SLOT); const bf16_t* kb = (const bf16_t*)(S + 2 * SLOT); const bf16_t* vb = (const bf16_t*)(S + 3 * SLOT);
    bf16_t* yb = (bf16_t*)(S + 7 * SLOT); float* stat = (float*)(p.ws + OFF_STAT);
    char* const VB = lds + 32768; char* const PB = lds + 49152; char* const RT = lds + 57344;
    const int gco = glds_chunk(t) * 8, gr0 = t >> 3;
    const int qq = fr >> 2, pp = fr & 3;
    for (int item = blockIdx.x; item < 512; item += gridDim.x) {
        const int bh = ((item >> 3) >> 4) * 8 + (item & 7), vs = (item >> 3) & 15, b = bh >> 2, hd = bh & 3;
        const size_t tok0 = (size_t)b * 2048;
        const float lg2 = log2f(1.0f - __builtin_amdgcn_exp2f(-5.0f - (float)hd));
        const float dec64 = __builtin_amdgcn_exp2f(64.0f * lg2);
        const bf16_t* qsrc = qb + (tok0 + gr0) * 1024 + hd * 256 + gco;
        const bf16_t* ksrc = kb + (tok0 + gr0) * 1024 + hd * 256 + gco;
        const bf16_t* vsrc = vb + (tok0 + (t >> 2)) * 2048 + hd * 512 + vs * 32 + (t & 3) * 8;
        f32x4 Racc[4][2];
#pragma unroll
        for (int a = 0; a < 4; ++a) { Racc[a][0] = (f32x4){0.f, 0.f, 0.f, 0.f}; Racc[a][1] = (f32x4){0.f, 0.f, 0.f, 0.f}; }
        __syncthreads();
        for (int i = t; i < 1024; i += 256) *(uint4*)(RT + i * 16) = make_uint4(0u, 0u, 0u, 0u);
        auto issue = [&](int pc) {
            const unsigned d = (unsigned)__builtin_amdgcn_readfirstlane((int)(lds_addr_u(lds) + (pc & 1) * 16384 + w * 1024));
            const size_t go = (size_t)(pc >> 2) * 64 * 1024 + (pc & 3) * 64;
#pragma unroll
            for (int i = 0; i < 2; ++i) { glds16_asm(qsrc + go + (size_t)i * 32 * 1024, d + i * 4096); glds16_asm(ksrc + go + (size_t)i * 32 * 1024, d + 8192 + i * 4096); }
        };
        auto put_v = [&](const uint4& raw, int ch) {
            char* vbuf = VB + (ch & 1) * 8192; const int j = t >> 2;
            *(uint4*)(vbuf + j * 64 + (t & 3) * 16) = raw;
            float f[8]; unpack8(raw, f); const float sc = __builtin_amdgcn_exp2f(lg2 * (float)(63 - j));
#pragma unroll
            for (int i = 0; i < 8; ++i) f[i] *= sc;
            *(uint4*)(vbuf + 4096 + j * 64 + (t & 3) * 16) = pack8(f);
        };
        issue(0);
        { const uint4 v0 = gld_u4(vsrc); put_v(v0, 0); }
        asm volatile("s_waitcnt vmcnt(0)" ::: "memory");
        __syncthreads();
        f32x4 Sacc[4], Xacc[2];
        uint4 vnext = make_uint4(0u, 0u, 0u, 0u);
        for (int ch = 0; ch < 32; ++ch) {
            const char* vbuf = VB + (ch & 1) * 8192;
#pragma unroll
            for (int qd = 0; qd < 4; ++qd) {
                const int pc = ch * 4 + qd;
                if (pc + 1 < 128) issue(pc + 1);
                if (qd == 0) {
                    if (ch + 1 < 32) vnext = gld_u4(vsrc + (size_t)(ch + 1) * 64 * 2048);
#pragma unroll
                    for (int n = 0; n < 4; ++n) Sacc[n] = (f32x4){0.f, 0.f, 0.f, 0.f};
                    Xacc[0] = (f32x4){0.f, 0.f, 0.f, 0.f}; Xacc[1] = (f32x4){0.f, 0.f, 0.f, 0.f};
                }
                const char* qk = lds + (pc & 1) * 16384;
                Racc[qd][0] *= dec64; Racc[qd][1] *= dec64;
#pragma unroll
                for (int ks = 0; ks < 2; ++ks) {
                    const int chs = ((ks * 4 + fq) ^ (fr & 7)) << 4;
                    const uint4 qf = *(const uint4*)(qk + (16 * w + fr) * 128 + chs);
#pragma unroll
                    for (int n = 0; n < 4; ++n) { const uint4 kf = *(const uint4*)(qk + 8192 + (n * 16 + fr) * 128 + chs); Sacc[n] = mfma16(kf, qf, Sacc[n]); }
#pragma unroll
                    for (int nn = 0; nn < 2; ++nn) {
                        const int v = nn * 16 + fr;
                        const uint4 rf = *(const uint4*)(RT + v * 512 + (((qd * 8 + ks * 4 + fq) ^ (v & 7)) << 4));
                        Xacc[nn] = mfma16(rf, qf, Xacc[nn]);
                    }
                    const int r0 = ks * 32 + fq * 8 + qq;
                    const int kc = 2 * w + (pp >> 1);
                    const uint2 klo = lds_tr16(qk + 8192 + r0 * 128 + ((kc ^ (r0 & 7)) << 4) + (pp & 1) * 8);
                    const uint2 khi = lds_tr16(qk + 8192 + (r0 + 4) * 128 + ((kc ^ ((r0 + 4) & 7)) << 4) + (pp & 1) * 8);
                    const uint4 kt = make_uint4(klo.x, klo.y, khi.x, khi.y);
#pragma unroll
                    for (int m = 0; m < 2; ++m) {
                        const uint2 vlo = lds_tr16(vbuf + 4096 + r0 * 64 + (16 * m + 4 * pp) * 2), vhi = lds_tr16(vbuf + 4096 + (r0 + 4) * 64 + (16 * m + 4 * pp) * 2);
                        Racc[qd][m] = mfma16(kt, make_uint4(vlo.x, vlo.y, vhi.x, vhi.y), Racc[qd][m]);
                    }
                }
                if (qd == 2 && ch + 1 < 32) put_v(vnext, ch + 1);
                asm volatile("s_waitcnt vmcnt(0)" ::: "memory");
                __syncthreads();
#pragma unroll
                for (int m = 0; m < 2; ++m) {
                    const int v = m * 16 + fr, cch = qd * 8 + 2 * w + (fq >> 1);
                    uint2 o; o.x = cvt_pk(Racc[qd][m][0], Racc[qd][m][1]); o.y = cvt_pk(Racc[qd][m][2], Racc[qd][m][3]);
                    *(uint2*)(RT + v * 512 + ((cch ^ (v & 7)) << 4) + (fq & 1) * 8) = o;
                }
            }
            const int srow = 16 * w + fr;
#pragma unroll
            for (int n = 0; n < 4; ++n) {
                float pv[4];
#pragma unroll
                for (int j = 0; j < 4; ++j) { const int jc = n * 16 + fq * 4 + j; pv[j] = (srow >= jc) ? Sacc[n][j] * __builtin_amdgcn_exp2f(lg2 * (float)(srow - jc)) : 0.f; }
                uint2 o; o.x = cvt_pk(pv[0], pv[1]); o.y = cvt_pk(pv[2], pv[3]);
                *(uint2*)(PB + srow * 128 + (((n * 2 + (fq >> 1)) ^ (fr & 7)) << 4) + (fq & 1) * 8) = o;
            }
            f32x4 Iacc[2] = {(f32x4){0.f, 0.f, 0.f, 0.f}, (f32x4){0.f, 0.f, 0.f, 0.f}};
#pragma unroll
            for (int ks = 0; ks < 2; ++ks) {
                const uint4 pf = *(const uint4*)(PB + srow * 128 + (((ks * 4 + fq) ^ (fr & 7)) << 4));
                const int r0 = ks * 32 + fq * 8 + qq;
#pragma unroll
                for (int nn = 0; nn < 2; ++nn) {
                    const uint2 vlo = lds_tr16(vbuf + r0 * 64 + (16 * nn + 4 * pp) * 2), vhi = lds_tr16(vbuf + (r0 + 4) * 64 + (16 * nn + 4 * pp) * 2);
                    Iacc[nn] = mfma16(make_uint4(vlo.x, vlo.y, vhi.x, vhi.y), pf, Iacc[nn]);
                }
            }
            const float qdec = __builtin_amdgcn_exp2f(lg2 * (float)(srow + 1));
            const size_t tok = tok0 + (size_t)ch * 64 + srow;
            float ssum = 0.f, ssq = 0.f;
#pragma unroll
            for (int nn = 0; nn < 2; ++nn) {
                float o4[4];
#pragma unroll
                for (int j = 0; j < 4; ++j) { o4[j] = Iacc[nn][j] + Xacc[nn][j] * qdec; ssum += o4[j]; ssq += o4[j] * o4[j]; }
                gst_u2(yb + tok * 2048 + hd * 512 + vs * 32 + nn * 16 + fq * 4, cvt_pk(o4[0], o4[1]), cvt_pk(o4[2], o4[3]));
            }
            ssum += __shfl_xor(ssum, 16); ssum += __shfl_xor(ssum, 32); ssq += __shfl_xor(ssq, 16); ssq += __shfl_xor(ssq, 32);
            if (fq == 0) gst_u2(stat + ((tok * 4 + hd) * 16 + vs) * 2, __float_as_uint(ssum), __float_as_uint(ssq));
        }
        __syncthreads();
    }
}

__device__ __forceinline__ void phase_zrw(PRef p, int jr) {
    const int t_ = tidx(); const int lane = t_ & 63, gw = blockIdx.x * 4 + (t_ >> 6), nw = gridDim.x * 4;
    char* S = p.ws + OFF_SLOT;
    const bf16_t* yb = (const bf16_t*)(S + 5 * SLOT); const bf16_t* gb = (const bf16_t*)(S + 4 * SLOT);
    const bf16_t* vb = (const bf16_t*)(S + (jr == 0 ? 11 : 9) * SLOT); bf16_t* zb = (bf16_t*)(S + 7 * SLOT);
    const float* bonus = (const float*)(p.ws + OFF_BONUS);
    float gg[16], bq[16]; row_load_f32(p.in[22] + jr * 1024, gg, lane); row_load_f32(p.in[23] + jr * 1024, bq, lane);
    const int rpw = NTOK / nw, first = gw * rpw, end = first + rpw;
    uint2 ny[4], nv[4], ng[4]; float nbn[4];
    auto load_in = [&](int r) {
#pragma unroll
        for (int c = 0; c < 4; ++c) { const size_t o = (size_t)r * 1024 + c * 256 + lane * 4; ny[c] = *(const uint2*)(yb + o); nv[c] = *(const uint2*)(vb + o); ng[c] = *(const uint2*)(gb + o);
                                      nbn[c] = bonus[(size_t)r * 16 + c * 4 + (lane >> 4)]; }
    };
    load_in(first);
    for (int r = first; r < end; ++r) {
        float y[16], v[16], g[16], bn[4];
#pragma unroll
        for (int c = 0; c < 4; ++c) {
            y[c * 4] = bflo(ny[c].x); y[c * 4 + 1] = bfhi(ny[c].x); y[c * 4 + 2] = bflo(ny[c].y); y[c * 4 + 3] = bfhi(ny[c].y);
            v[c * 4] = bflo(nv[c].x); v[c * 4 + 1] = bfhi(nv[c].x); v[c * 4 + 2] = bflo(nv[c].y); v[c * 4 + 3] = bfhi(nv[c].y);
            g[c * 4] = bflo(ng[c].x); g[c * 4 + 1] = bfhi(ng[c].x); g[c * 4 + 2] = bflo(ng[c].y); g[c * 4 + 3] = bfhi(ng[c].y);
            bn[c] = nbn[c];
        }
        if (r + 1 < end) load_in(r + 1);
        __builtin_amdgcn_sched_barrier(0);
        float z[16];
#pragma unroll
        for (int c = 0; c < 4; ++c) {
            float s = (y[c * 4] + y[c * 4 + 1]) + (y[c * 4 + 2] + y[c * 4 + 3]);
            float q = (y[c * 4] * y[c * 4] + y[c * 4 + 1] * y[c * 4 + 1]) + (y[c * 4 + 2] * y[c * 4 + 2] + y[c * 4 + 3] * y[c * 4 + 3]);
            s = row16_sum(s); q = row16_sum(q);
            const float mean = s * (1.0f / 64.0f), rstd = rsqrtf(fmaxf(q * (1.0f / 64.0f) - mean * mean, 0.f) + 64e-5f);
#pragma unroll
            for (int i = 0; i < 4; ++i) { const int e = c * 4 + i; z[e] = ((y[e] - mean) * rstd * gg[e] + bq[e] + bn[c] * v[e]) * g[e]; }
        }
        row_store_bf16(zb + (size_t)r * 1024, z, lane);
    }
}
__device__ __forceinline__ void phase_zml(PRef p) {
    const int t_ = tidx(); const int lane = t_ & 63, gw = blockIdx.x * 4 + (t_ >> 6), nw = gridDim.x * 4;
    char* S = p.ws + OFF_SLOT;
    const bf16_t* yb = (const bf16_t*)(S + 4 * SLOT); const bf16_t* ob = (const bf16_t*)(S + 3 * SLOT); bf16_t* zb = (bf16_t*)(S + 1 * SLOT);
    float gg[16], bq[16]; row_load_f32(p.in[29], gg, lane); row_load_f32(p.in[30], bq, lane);
    const int rpw = NTOK / nw, first = gw * rpw, end = first + rpw;
    uint2 ny[4], no[4];
    auto load_in = [&](int r) {
#pragma unroll
        for (int c = 0; c < 4; ++c) { const size_t o = (size_t)r * 1024 + c * 256 + lane * 4; ny[c] = *(const uint2*)(yb + o); no[c] = *(const uint2*)(ob + o); }
    };
    load_in(first);
    for (int r = first; r < end; ++r) {
        float y[16], o[16], z[16];
#pragma unroll
        for (int c = 0; c < 4; ++c) {
            y[c * 4] = bflo(ny[c].x); y[c * 4 + 1] = bfhi(ny[c].x); y[c * 4 + 2] = bflo(ny[c].y); y[c * 4 + 3] = bfhi(ny[c].y);
            o[c * 4] = bflo(no[c].x); o[c * 4 + 1] = bfhi(no[c].x); o[c * 4 + 2] = bflo(no[c].y); o[c * 4 + 3] = bfhi(no[c].y);
        }
        if (r + 1 < end) load_in(r + 1);
        __builtin_amdgcn_sched_barrier(0);
#pragma unroll
        for (int c = 0; c < 4; ++c) {
            float s = (y[c * 4] + y[c * 4 + 1]) + (y[c * 4 + 2] + y[c * 4 + 3]);
            float q = (y[c * 4] * y[c * 4] + y[c * 4 + 1] * y[c * 4 + 1]) + (y[c * 4 + 2] * y[c * 4 + 2] + y[c * 4 + 3] * y[c * 4 + 3]);
            s = row16_sum(s); q = row16_sum(q); s += __shfl_xor(s, 16); q += __shfl_xor(q, 16);
            const float mean = s * (1.0f / 128.0f), rstd = rsqrtf(fmaxf(q * (1.0f / 128.0f) - mean * mean, 0.f) + 1e-6f);
#pragma unroll
            for (int i = 0; i < 4; ++i) { const int e = c * 4 + i; z[e] = ((y[e] - mean) * rstd * gg[e] + bq[e]) * o[e]; }
        }
        row_store_bf16(zb + (size_t)r * 1024, z, lane);
    }
}
__device__ __forceinline__ void phase_zrt(PRef p) {
    const int t_ = tidx(); const int lane = t_ & 63, gw = blockIdx.x * 4 + (t_ >> 6), nw = gridDim.x * 4;
    char* S = p.ws + OFF_SLOT;
    const bf16_t* yb = (const bf16_t*)(S + 7 * SLOT); const bf16_t* sb = (const bf16_t*)(S + 5 * SLOT); bf16_t* zb = (bf16_t*)(S + 3 * SLOT);
    float gw8[4][8], bw8[4][8];
#pragma unroll
    for (int c = 0; c < 4; ++c) {
        const float4 ga = gld_f4(p.in[33] + lane * 32 + c * 8), gb2 = gld_f4(p.in[33] + lane * 32 + c * 8 + 4), ba = gld_f4(p.in[34] + lane * 32 + c * 8), bb2 = gld_f4(p.in[34] + lane * 32 + c * 8 + 4);
        gw8[c][0] = ga.x; gw8[c][1] = ga.y; gw8[c][2] = ga.z; gw8[c][3] = ga.w; gw8[c][4] = gb2.x; gw8[c][5] = gb2.y; gw8[c][6] = gb2.z; gw8[c][7] = gb2.w;
        bw8[c][0] = ba.x; bw8[c][1] = ba.y; bw8[c][2] = ba.z; bw8[c][3] = ba.w; bw8[c][4] = bb2.x; bw8[c][5] = bb2.y; bw8[c][6] = bb2.z; bw8[c][7] = bb2.w;
    }
    const int rpw = NTOK / nw, first = gw * rpw, end = first + rpw;
    uint4 nyr[4], nsr[4];
    auto load_in = [&](int r) {
        const size_t o = (size_t)r * 2048 + lane * 32;
#pragma unroll
        for (int c = 0; c < 4; ++c) { nyr[c] = *(const uint4*)(yb + o + c * 8); nsr[c] = *(const uint4*)(sb + o + c * 8); }
    };
    load_in(first);
    for (int r = first; r < end; ++r) {
        const size_t o = (size_t)r * 2048 + lane * 32;
        uint4 yr[4], sr[4];
#pragma unroll
        for (int c = 0; c < 4; ++c) { yr[c] = nyr[c]; sr[c] = nsr[c]; }
        if (r + 1 < end) load_in(r + 1);
        __builtin_amdgcn_sched_barrier(0);
        float s = 0.f, q = 0.f;
#pragma unroll
        for (int c = 0; c < 4; ++c) { float f[8]; unpack8(yr[c], f);
#pragma unroll
            for (int i = 0; i < 8; ++i) { s += f[i]; q += f[i] * f[i]; } }
        s = row16_sum(s); q = row16_sum(q);
        const float mean = s * (1.0f / 512.0f), rstd = rsqrtf(fmaxf(q * (1.0f / 512.0f) - mean * mean, 0.f) + 1e-6f);
#pragma unroll
        for (int c = 0; c < 4; ++c) {
            float f[8], g[8], z[8]; unpack8(yr[c], f); unpack8(sr[c], g);
#pragma unroll
            for (int i = 0; i < 8; ++i) z[i] = ((f[i] - mean) * rstd * gw8[c][i] + bw8[c][i]) * g[i];
            *(uint4*)(zb + o + c * 8) = pack8(z);
        }
    }
}

template <int WHICH  >
__device__ __forceinline__ void phase_moe(PRef p, int L, char* lds, const bf16_t* hm, bf16_t* H) {
    const int t = tidx(), lane = t & 63, wid = t >> 6, wr = wid >> 1, wc = wid & 1, fr = lane & 15, fq = lane >> 4;
    const int* cnt = (const int*)(p.ws + OFF_CNT) + L * 32;
    const int* list = (const int*)(p.ws + OFF_LIST);
    bf16_t* Y = (bf16_t*)(p.ws + OFF_SLOT + 9 * SLOT);
    int* pre = (int*)(lds + 65536);
    __syncthreads();
    if (t == 0) { int s = 0; for (int e = 0; e < 32; ++e) { pre[e] = s; s += (cnt[e] + 127) >> 7; } pre[32] = s; }
    __syncthreads();
    const int total_all = pre[32] * 8;
    const int full = (total_all / (int)gridDim.x) * (int)gridDim.x, rem = total_all - full;
    const bool split_tail = (rem > 0) && (2 * rem <= (int)gridDim.x);
    const int total = split_tail ? full : total_all;
    for (int id0 = 0; id0 < total; id0 += gridDim.x) {
        const int id = id0 + (blockIdx.x & 7) * (gridDim.x >> 3) + (blockIdx.x >> 3);
        if (id >= total) continue;
        const int nt = id & 7, mg = id >> 3;
        int e = 0;
#pragma unroll 1
        for (int s = 16; s >= 1; s >>= 1) if (pre[e + s] <= mg) e += s;
        const int mt = mg - pre[e], ne = cnt[e];
        const int* le = list + e * LIST_CAP + mt * 128;
        const bf16_t* ar[4]; const bf16_t* br[4];
        const int co_ = glds_chunk(t) * 8;
#pragma unroll
        for (int i = 0; i < 4; ++i) {
            int r = (t >> 3) + 32 * i; r = (mt * 128 + r < ne) ? r : 0;
            const int aid = le[r];
            ar[i] = ((WHICH == 0) ? hm + (size_t)(aid >> 1) * 1024 : H + (size_t)aid * 512) + co_;
        }
        f32x4 acc[4][4];
        if (WHICH == 0) {
            const bf16_t* wt = (const bf16_t*)(p.ws + W_MOE13) + ((size_t)(L * 32 + e) * 1024 + nt * 128) * 1024;
#pragma unroll
            for (int i = 0; i < 4; ++i) {
                const int ro = (t >> 3) + 32 * i, n_ = (ro >> 4) & 3, hc = ((ro >> 2) & 3) * 8 + (n_ >> 1) * 4 + (ro & 3);
                br[i] = wt + (size_t)((ro & 64) + (hc >> 4) * 32 + (n_ & 1) * 16 + (hc & 15)) * 1024 + co_;
            }
            gemm_gg(lds, 16, ar, br, acc);
            int aidq[4];
#pragma unroll
            for (int m = 0; m < 4; ++m) { const int r = wr * 64 + m * 16 + fr; aidq[m] = (mt * 128 + r < ne) ? le[r] : 0; }
#pragma unroll
            for (int m = 0; m < 4; ++m) {
                const int r = wr * 64 + m * 16 + fr;
                if (mt * 128 + r < ne) {
                    const int aid = aidq[m];
                    const f32x4 a1 = acc[m][0], a3 = acc[m][1], b1 = acc[m][2], b3 = acc[m][3];
                    gst_u4(H + (size_t)aid * 512 + nt * 64 + wc * 32 + fq * 8, cvt_pk(siluf_(a1[0]) * a3[0], siluf_(a1[1]) * a3[1]), cvt_pk(siluf_(a1[2]) * a3[2], siluf_(a1[3]) * a3[3]),
                           cvt_pk(siluf_(b1[0]) * b3[0], siluf_(b1[1]) * b3[1]), cvt_pk(siluf_(b1[2]) * b3[2], siluf_(b1[3]) * b3[3]));
                }
            }
        } else {
            const bf16_t* wt = (const bf16_t*)(p.ws + W_MOE2) + ((size_t)(L * 32 + e) * 1024 + nt * 128) * 512;
#pragma unroll
            for (int i = 0; i < 4; ++i) br[i] = wt + (size_t)perm64((t >> 3) + 32 * i) * 512 + co_;
            gemm_gg(lds, 8, ar, br, acc);
            int aidq[4];
#pragma unroll
            for (int m = 0; m < 4; ++m) { const int r = wr * 64 + m * 16 + fr; aidq[m] = (mt * 128 + r < ne) ? le[r] : 0; }
#pragma unroll
            for (int m = 0; m < 4; ++m) {
                const int r = wr * 64 + m * 16 + fr;
                if (mt * 128 + r < ne) {
                    const int aid = aidq[m];
                    store16(Y + (size_t)aid * 1024 + nt * 128 + wc * 64 + fq * 16, acc[m]);
                }
            }
        }
    }
    if (split_tail) {
        const int hid = (blockIdx.x & 7) * (gridDim.x >> 3) + (blockIdx.x >> 3);
        if (hid < 2 * rem) {
            const int id = full + (hid >> 1), hf = hid & 1;
            const int nt = id & 7, mg = id >> 3;
            int e = 0;
#pragma unroll 1
            for (int s2 = 16; s2 >= 1; s2 >>= 1) if (pre[e + s2] <= mg) e += s2;
            const int mt = mg - pre[e], ne = cnt[e];
            const int* le = list + e * LIST_CAP + mt * 128;
            const bf16_t* ar[4]; const bf16_t* br[2];
            const int co_ = glds_chunk(t) * 8;
#pragma unroll
            for (int i = 0; i < 4; ++i) {
                int r = (t >> 3) + 32 * i; r = (mt * 128 + r < ne) ? r : 0;
                const int aid = le[r];
                ar[i] = ((WHICH == 0) ? hm + (size_t)(aid >> 1) * 1024 : H + (size_t)aid * 512) + co_;
            }
            f32x4 acc[2][4];
            int aidq[2];
            if (WHICH == 0) {
                const bf16_t* wt = (const bf16_t*)(p.ws + W_MOE13) + ((size_t)(L * 32 + e) * 1024 + nt * 128 + hf * 64) * 1024;
#pragma unroll
                for (int i = 0; i < 2; ++i) {
                    const int ro = (t >> 3) + 32 * i, n_ = (ro >> 4) & 3, hc = ((ro >> 2) & 3) * 8 + (n_ >> 1) * 4 + (ro & 3);
                    br[i] = wt + (size_t)((hc >> 4) * 32 + (n_ & 1) * 16 + (hc & 15)) * 1024 + co_;
                }
                gemm_hn(lds, 16, ar, br, acc);
#pragma unroll
                for (int m = 0; m < 2; ++m) { const int r = wid * 32 + m * 16 + fr; aidq[m] = (mt * 128 + r < ne) ? le[r] : 0; }
#pragma unroll
                for (int m = 0; m < 2; ++m) {
                    const int r = wid * 32 + m * 16 + fr;
                    if (mt * 128 + r < ne) {
                        const f32x4 a1 = acc[m][0], a3 = acc[m][1], b1 = acc[m][2], b3 = acc[m][3];
                        gst_u4(H + (size_t)aidq[m] * 512 + nt * 64 + hf * 32 + fq * 8, cvt_pk(siluf_(a1[0]) * a3[0], siluf_(a1[1]) * a3[1]), cvt_pk(siluf_(a1[2]) * a3[2], siluf_(a1[3]) * a3[3]),
                               cvt_pk(siluf_(b1[0]) * b3[0], siluf_(b1[1]) * b3[1]), cvt_pk(siluf_(b1[2]) * b3[2], siluf_(b1[3]) * b3[3]));
                    }
                }
            } else {
                const bf16_t* wt = (const bf16_t*)(p.ws + W_MOE2) + ((size_t)(L * 32 + e) * 1024 + nt * 128 + hf * 64) * 512;
#pragma unroll
                for (int i = 0; i < 2; ++i) br[i] = wt + (size_t)perm64((t >> 3) + 32 * i) * 512 + co_;
                gemm_hn(lds, 8, ar, br, acc);
#pragma unroll
                for (int m = 0; m < 2; ++m) { const int r = wid * 32 + m * 16 + fr; aidq[m] = (mt * 128 + r < ne) ? le[r] : 0; }
#pragma unroll
                for (int m = 0; m < 2; ++m) {
                    const int r = wid * 32 + m * 16 + fr;
                    if (mt * 128 + r < ne) store16(Y + (size_t)aidq[m] * 1024 + nt * 128 + hf * 64 + fq * 16, acc[m]);
                }
            }
        }
    }
}

constexpr int NPHASE = 37;
#ifndef PHSEL
#define PHSEL -1
#endif
#ifndef PHEXC
#define PHEXC -2
#endif
#define PHON(x) ((PHSEL < 0 || PHSEL == (x)) && PHEXC != (x))
__global__ void __launch_bounds__(256, 2) mega(Params p_in) {
    PRef p = *(const CAS Params*)__builtin_amdgcn_kernarg_segment_ptr();
    extern __shared__ __attribute__((aligned(16))) char lds[];
    volatile LAS unsigned* xbw = (volatile LAS unsigned*)(lds + 73728);
    if (threadIdx.x == 0) { xbw[0] = 0u; xbw[1] = 0u; xbw[2] = 0u; xbw[3] = 0u; }
    __syncthreads();
    XcdBarrier bar;
    const bool multi = (p.ph_hi - p.ph_lo) > 1;
    (void)multi;
    if (multi) bar = xcd_barrier_post((unsigned*)(p.ws + OFF_CTL), xbw);
    char* S = p.ws + OFF_SLOT;
#ifdef DBG_STOP
    if (p.ph_lo == 100) {
        const float* src = (const float*)(p.ws + DBG_SRC);
        for (size_t i = (size_t)blockIdx.x * 256 + threadIdx.x; i < (size_t)NTOK * DM; i += (size_t)gridDim.x * 256) {
            float v = DBG_BF16 ? bf2f(((const bf16_t*)src)[i]) : src[i];
            if (!(fabsf(v) < 1e30f)) v = 1e30f;
            p.out[i] = v;
        }
        return;
    }
#endif
    const int ph_lo_ = p.ph_lo, ph_hi_ = p.ph_hi;
#ifdef TIMEIT
    unsigned long long t0_ = 0, t1_ = 0;
#endif
#ifdef DUP_PHASE
    bool dup_done_ = false;
#endif
    for (int ph = ph_lo_; ph < ph_hi_; ++ph) {
        const CAS Params* pp_ = (const CAS Params*)__builtin_amdgcn_kernarg_segment_ptr();
        asm volatile("" : "+s"(pp_));
        PRef p = *pp_;
#ifdef TIMEIT
        if (ph == TIME_A) t0_ = __builtin_amdgcn_s_memrealtime();
        if (ph == TIME_B) t1_ = __builtin_amdgcn_s_memrealtime();
#endif
        int L, sub, kind;
        if (ph < 2) { L = 0; sub = ph; kind = -1; }
        else if (ph < 11) { L = 0; kind = 0; sub = ph - 2; }
        else if (ph < 20) { L = 1; kind = 1; sub = ph - 11; }
        else if (ph < 28) { L = 2; kind = 2; sub = ph - 20; }
        else { L = 3; kind = 0; sub = ph - 28; }
        const int jr = L / 3;
        if (kind == -1) { if (sub == 0) { if (PHON(0)) phase_prologue(p, lds); } else { if (PHON(1)) phase_h0(p); } }
        else {
            const int ntail = (kind == 2) ? 4 : 5;
            if (sub < ntail) {
                if (kind == 0) {
                    if (sub == 0) { if (PHON(2)) phase_gemm_jobs(p, lds, jr * 7, jr * 7 + (jr ? 7 : 6)); }
                    else if (sub == 1) { if (PHON(3)) phase_rw2(p, jr); }
                    else if (sub == 2) { if (PHON(4)) {
#ifdef RW3_SCALAR
                        phase_rw3(p, jr, lds);
#else
                        phase_rw3c(p, jr, lds);
#endif
                    } }
                    else if (sub == 3) { if (PHON(5)) phase_zrw(p, jr); }
                    else { if (PHON(2)) phase_gemm_jobs(p, lds, 16 + jr, 17 + jr); }
                } else if (kind == 1) {
                    if (sub == 0) { if (PHON(2)) phase_gemm_jobs(p, lds, 14, 15); }
                    else if (sub == 1) { if (PHON(6)) phase_cml(p); }
                    else if (sub == 2) { if (PHON(6)) phase_ml2(p, lds); }
                    else if (sub == 3) { if (PHON(7)) phase_zml(p); }
                    else { if (PHON(2)) phase_gemm_jobs(p, lds, 18, 19); }
                } else {
                    if (sub == 0) { if (PHON(2)) phase_gemm_jobs(p, lds, 15, 16); }
                    else if (sub == 1) { if (PHON(8)) phase_rt2(p, lds); }
                    else if (sub == 2) { if (PHON(9)) phase_zrt(p); }
                    else { if (PHON(2)) phase_gemm_jobs(p, lds, 19, 20); }
                }
            } else {
                const int ts = sub - ntail;
                const bf16_t* ymix = (const bf16_t*)(S + (kind == 2 ? 1 : 6) * SLOT);
                bf16_t* hm = (bf16_t*)(S + (kind == 2 ? 2 : 7) * SLOT);
                bf16_t* H = (bf16_t*)(S + (kind == 0 ? 2 : (kind == 1 ? 5 : 3)) * SLOT);
                if (ts == 0) { if (PHON(10)) phase_ln1(p, L, lds, ymix, hm); }
                else if (ts == 1) { if (PHON(11)) phase_moe<0>(p, L, lds, hm, H); }
                else if (ts == 2) { if (PHON(12)) phase_moe<1>(p, L, lds, hm, H); }
                else { if (PHON(13)) phase_ln2(p, L); }
            }
        }
#ifdef DUP_PHASE
        if (((DUP_PHASE >> ph) & 1u) && !dup_done_) { dup_done_ = true; xcd_barrier(bar); --ph; continue; }
        dup_done_ = false;
#endif
        if (ph + 1 < ph_hi_) xcd_barrier(bar);
    }
#ifdef TIMEIT
    {
        xcd_barrier(bar);
        unsigned* tw = (unsigned*)(p.ws + OFF_CTL + 32768);
        if (blockIdx.x == 0 && threadIdx.x == 0) {
            if (t1_ == 0) t1_ = __builtin_amdgcn_s_memrealtime();
            const unsigned long long dt = t1_ - t0_;
            unsigned ms2 = (unsigned)((dt + TIME_U / 2) / TIME_U);
            __hip_atomic_store(tw, ms2, __ATOMIC_RELAXED, __HIP_MEMORY_SCOPE_AGENT);
        }
        xcd_barrier(bar);
        const float c_ = sqrtf((float)__hip_atomic_load(tw, __ATOMIC_RELAXED, __HIP_MEMORY_SCOPE_AGENT));
        for (size_t i = (size_t)blockIdx.x * 256 + threadIdx.x; i < (size_t)NTOK * DM; i += (size_t)gridDim.x * 256) p.out[i] = c_;
    }
#endif
#ifdef DBG_STOP
    if (ph_lo_ != 100) {
        xcd_barrier(bar);
        const float* src = (const float*)(p.ws + DBG_SRC);
        for (size_t i = (size_t)blockIdx.x * 256 + threadIdx.x; i < (size_t)NTOK * DM; i += (size_t)gridDim.x * 256) {
            float v = DBG_BF16 ? bf2f(((const bf16_t*)src)[i]) : src[i];
            if (!(fabsf(v) < 1e30f)) v = 1e30f;
            p.out[i] = v;
        }
    }
#endif
}

constexpr int LDS_BYTES = 73728 + 64;
extern "C" void kernel_launch(void* const* d_in, const int* in_sizes, int n_in, void* d_out, int out_size, void* d_ws, size_t ws_size, hipStream_t stream) {
    static int grid = 0;
    if (grid == 0) {
        if (n_in != 43 || out_size != NTOK * DM || ws_size < WS_NEED) { fprintf(stderr, "kernel_launch: unexpected shapes (n_in %d out %d ws %zu need %zu)\n", n_in, out_size, ws_size, (size_t)WS_NEED); }
        int dev = 0, cus = 0, per_cu = 0;
        (void)hipGetDevice(&dev); (void)hipDeviceGetAttribute(&cus, hipDeviceAttributeMultiprocessorCount, dev);
        (void)hipFuncSetAttribute((const void*)mega, hipFuncAttributeMaxDynamicSharedMemorySize, LDS_BYTES);
        (void)hipOccupancyMaxActiveBlocksPerMultiprocessor(&per_cu, (const void*)mega, 256, LDS_BYTES);
        if (per_cu > 2) per_cu = 2;
        if (per_cu < 1) per_cu = 1;
        grid = cus * per_cu;
        if (grid > 512) grid = 512;
        (void)hipGetLastError();
    }
    Params p{};
    for (int i = 0; i < 43; ++i) p.in[i] = (const float*)d_in[i];
    p.out = (float*)d_out; p.ws = (char*)d_ws;
    char* ws = (char*)d_ws;
    auto slot = [&](int i) { return (bf16_t*)(ws + OFF_SLOT + (size_t)i * SLOT); };
    int tile = 0;
    auto addg = [&](int idx, const bf16_t* A, const bf16_t* Bt, bf16_t* out, int K, int N, int ldo, int mode) {
        GJob& g = p.gj[idx]; g.A = A; g.Bt = Bt; g.out = out; g.K = K; g.N = N; g.ldo = ldo; g.mode = mode; g.half = (mode <= MODE_SIGM && N <= 128) ? 1 : 0; g.ntn = g.half ? (N + 63) / 64 : (N + 127) / 128; g.tile0 = tile; tile += 128 * g.ntn;
    };
    for (int jr = 0; jr < 2; ++jr) {
        const bf16_t* rkv = (const bf16_t*)(ws + W_RKV) + (size_t)jr * 3 * 1024 * 1024;
        addg(jr * 7 + 0, slot(0), rkv, slot(6), 1024, 1024, 1024, MODE_BF16);
        addg(jr * 7 + 1, slot(1), rkv + 1024 * 1024, slot(7), 1024, 1024, 1024, MODE_BF16);
        addg(jr * 7 + 2, slot(2), rkv + 2 * 1024 * 1024, slot(jr == 0 ? 11 : 8), 1024, 1024, 1024, MODE_BF16);
        addg(jr * 7 + 3, slot(3), (const bf16_t*)(ws + W_W1T) + (size_t)jr * 64 * 1024, (bf16_t*)(ws + OFF_LW), 1024, 64, 64, MODE_TANH);
        addg(jr * 7 + 4, slot(4), (const bf16_t*)(ws + W_A1T) + (size_t)jr * 64 * 1024, (bf16_t*)(ws + OFF_LA), 1024, 64, 64, MODE_BF16);
        addg(jr * 7 + 5, slot(5), (const bf16_t*)(ws + W_G1T) + (size_t)jr * 128 * 1024, (bf16_t*)(ws + OFF_LG), 1024, 128, 128, MODE_SIGM);
        addg(jr * 7 + 6, slot(2), (const bf16_t*)(ws + W_V1T), (bf16_t*)(ws + OFF_LV), 1024, 32, 32, MODE_BF16);
    }
    addg(14, slot(0), (const bf16_t*)(ws + W_MLIN), nullptr, 1024, 3088, 0, MODE_ML1);
    addg(15, slot(0), (const bf16_t*)(ws + W_RTIN), nullptr, 1024, 6144, 0, MODE_RT1);
    addg(16, slot(7), (const bf16_t*)(ws + W_OUT), slot(6), 1024, 1024, 1024, MODE_BF16);
    addg(17, slot(7), (const bf16_t*)(ws + W_OUT) + 1024 * 1024, slot(6), 1024, 1024, 1024, MODE_BF16);
    addg(18, slot(1), (const bf16_t*)(ws + W_MLOUT), slot(6), 1024, 1024, 1024, MODE_BF16);
    addg(19, slot(3), (const bf16_t*)(ws + W_RTOUT), slot(1), 2048, 1024, 1024, MODE_BF16);
    int nc = 0, ctile = 0;
    auto addc = [&](const float* src, size_t dst_off, int K, int N, int nb, long sbs, long dbs, int mode) {
        CJob& c = p.cj[nc++]; c.src = src; c.dst = (bf16_t*)(ws + dst_off); c.K = K; c.N = N; c.nb = nb; c.mode = mode; c.sbs = sbs; c.dbs = dbs;
        c.tiles_pb = ((K + 63) / 64) * ((N + 255) / 256); c.tile0 = ctile; ctile += c.tiles_pb * nb;
    };
    addc(p.in[7], W_RKV, 1024, 1024, 6, 1024 * 1024, 1024 * 1024, 0);
    addc(p.in[24], W_OUT, 1024, 1024, 2, 1024 * 1024, 1024 * 1024, 0);
    addc(p.in[9], W_W1T, 1024, 64, 2, 1024 * 64, 64 * 1024, 0);
    addc(p.in[12], W_A1T, 1024, 64, 2, 1024 * 64, 64 * 1024, 0);
    addc(p.in[17], W_G1T, 1024, 128, 2, 1024 * 128, 128 * 1024, 0);
    addc(p.in[15], W_V1T, 1024, 32, 1, 0, 0, 0);
    addc(p.in[10], W_W2T, 64, 1024, 2, 64 * 1024, 1024 * 64, 0);
    addc(p.in[13], W_A2T, 64, 1024, 2, 64 * 1024, 1024 * 64, 0);
    addc(p.in[18], W_G2T, 128, 1024, 2, 128 * 1024, 1024 * 128, 0);
    addc(p.in[16], W_V2T, 32, 1024, 1, 0, 0, 0);
    addc(p.in[25], W_MLIN, 1024, 3088, 1, 0, 0, 0);
    addc(p.in[31], W_MLOUT, 1024, 1024, 1, 0, 0, 0);
    addc(p.in[32], W_RTIN, 1024, 6144, 1, 0, 0, 3);
    addc(p.in[35], W_RTOUT, 2048, 1024, 1, 0, 0, 0);
    addc(p.in[40], W_MOE13, 1024, 512, 128, 1024 * 512, 1024 * 1024, 1);
    addc(p.in[41], W_MOE13, 1024, 512, 128, 1024 * 512, 1024 * 1024, 2);
    addc(p.in[42], W_MOE2, 512, 1024, 128, 512 * 1024, 1024 * 512, 0);
    p.ncj = nc; p.cj_tiles = ctile;

    (void)hipMemsetAsync(ws + OFF_CTL, 0, CTL_BYTES, stream);
#ifdef DBG_STOP
    const int nph = DBG_STOP;
#else
    const int nph = NPHASE;
#endif
#ifdef MULTI_LAUNCH
    for (int ph = 0; ph < nph; ++ph) { p.ph_lo = ph; p.ph_hi = ph + 1; hipLaunchKernelGGL(mega, dim3(grid), dim3(256), LDS_BYTES, stream, p); }
    if (0)
#endif
    {
        p.ph_lo = 0; p.ph_hi = nph;
        void* args[] = {&p};
        hipError_t e = hipLaunchCooperativeKernel((const void*)mega, dim3(grid), dim3(256), args, LDS_BYTES, stream);
        if (e != hipSuccess) fprintf(stderr, "cooperative launch failed: %s (grid %d)\n", hipGetErrorString(e), grid);
    }
}
```

```cpp
#include <hip/hip_runtime.h>
#include <cstdio>
#include <cstdint>

#ifndef ONE_LAUNCH
#define ONE_LAUNCH 0
#endif

typedef unsigned short bf16_t;
typedef short bf16x8 __attribute__((ext_vector_type(8)));
typedef float f32x4 __attribute__((ext_vector_type(4)));
#define LAS __attribute__((address_space(3)))
#define GAS __attribute__((address_space(1)))
typedef float f32x4g_t __attribute__((ext_vector_type(4)));
typedef unsigned u32x2g_t __attribute__((ext_vector_type(2)));
typedef unsigned u32x4g_t __attribute__((ext_vector_type(4)));
__device__ __forceinline__ float4 gld_f4(const float* p) { const f32x4g_t v = *(const GAS f32x4g_t*)(const GAS char*)(const char*)p; return make_float4(v[0], v[1], v[2], v[3]); }
__device__ __forceinline__ uint2 gld_u2(const void* p) { const u32x2g_t v = *(const GAS u32x2g_t*)(const GAS char*)(const char*)p; return make_uint2(v[0], v[1]); }
__device__ __forceinline__ uint4 gld_u4(const void* p) { const u32x4g_t v = *(const GAS u32x4g_t*)(const GAS char*)(const char*)p; return make_uint4(v[0], v[1], v[2], v[3]); }
__device__ __forceinline__ void gst_f4(float* p, float a, float b, float c, float d) { const f32x4g_t v = {a, b, c, d}; *(GAS f32x4g_t*)(GAS char*)(char*)p = v; }
__device__ __forceinline__ void gst_u2(void* p, unsigned a, unsigned b) { const u32x2g_t v = {a, b}; *(GAS u32x2g_t*)(GAS char*)(char*)p = v; }
__device__ __forceinline__ void gst_u4(void* p, unsigned a, unsigned b, unsigned c, unsigned d) { const u32x4g_t v = {a, b, c, d}; *(GAS u32x4g_t*)(GAS char*)(char*)p = v; }

constexpr int NTOK = 16384, DM = 1024, TSEQ = 2048, NBATCH = 8;
constexpr float DN_ALPHA = 1.681792830507429f;
constexpr float LN_EPS = 1e-5f;
constexpr size_t MB = 1u << 20;
constexpr size_t OFF_CTL = 0, OFF_CNT = 16384, CTL_BYTES = 65536;
constexpr size_t OFF_MOD = 65536;
constexpr size_t OFF_ROT = 1 * MB;
constexpr size_t OFF_BONUS = 3 * MB, OFF_GATES = 4 * MB, OFF_STAT = 5 * MB, OFF_LW = 13 * MB, OFF_LA = 15 * MB, OFF_LG = 17 * MB, OFF_LV = 21 * MB,
                 OFF_WGT = 22 * MB, OFF_LIST = 23 * MB, OFF_RTW = 25 * MB;
constexpr size_t OFF_W = 32 * MB;
constexpr size_t W_RKV = OFF_W, W_OUT = W_RKV + 12 * MB, W_W1T = W_OUT + 4 * MB, W_A1T = W_W1T + 256 * 1024, W_G1T = W_A1T + 256 * 1024, W_V1T = W_G1T + 512 * 1024,
                 W_W2T = W_V1T + 64 * 1024, W_A2T = W_W2T + 256 * 1024, W_G2T = W_A2T + 256 * 1024, W_V2T = W_G2T + 512 * 1024, W_MLIN = W_V2T + 64 * 1024 + 832 * 1024,
                 W_MLOUT = W_MLIN + 6400 * 1024, W_RTIN = W_MLOUT + 2 * MB, W_RTOUT = W_RTIN + 12 * MB, W_MOE13 = W_RTOUT + 4 * MB, W_MOE2 = W_MOE13 + 256 * MB,
                 W_END = W_MOE2 + 128 * MB;
constexpr size_t OFF_XRES = 464 * MB;
constexpr size_t OFF_SLOT = 528 * MB, SLOT = 32 * MB;
static_assert(W_END <= OFF_XRES, "weights overflow");
constexpr size_t OFF_XRES2 = OFF_SLOT + 12 * SLOT;
constexpr size_t WS_NEED = OFF_XRES2 + 2 * SLOT;
constexpr int LIST_CAP = 16384;

#define XB_TMO      128
#define XB_XCNT(j)  (256  + 64 * (j))
#define XB_XSUB(j)  (1280 + 64 * (j))
#define XB_XGEN(j)  (2304 + 64 * (j))
#define XB_TOP      3328
#define XB_TOPGEN   3392
#define XCD_BAR_WORDS 3456
#define XB_SPIN_CAP (1u << 22)
__device__ __forceinline__ unsigned xb_ld(unsigned* p)              { return __hip_atomic_load(p, __ATOMIC_RELAXED, __HIP_MEMORY_SCOPE_AGENT); }
__device__ __forceinline__ unsigned xb_add(unsigned* p, unsigned v) { return __hip_atomic_fetch_add(p, v, __ATOMIC_RELAXED, __HIP_MEMORY_SCOPE_AGENT); }
__device__ __forceinline__ unsigned xb_xcc_id() { return (unsigned)__builtin_amdgcn_s_getreg((3 << 11) | 20) & 0xFu; }
#define XB_SPIN(cond, bar) do { unsigned _sp = 0; while (cond) { __builtin_amdgcn_s_sleep(1); \
    if ((++_sp & 255u) == 0u) { if (xb_ld(&(bar)[XB_TMO])) break; if (_sp > XB_SPIN_CAP) { atomicAdd(&(bar)[XB_TMO], 1u); break; } } } } while (0)
struct XcdBarrier { unsigned* bar; unsigned x; volatile LAS unsigned* st; };
__device__ __forceinline__ XcdBarrier xcd_barrier_post(unsigned* bar, volatile LAS unsigned* st) {
    XcdBarrier b; b.bar = bar; b.x = xb_xcc_id(); b.st = st;
    if (threadIdx.x == 0) (void)xb_add(&bar[XB_XCNT(b.x)], 1u);
    return b;
}
__device__ __forceinline__ void xcd_barrier_complete(unsigned* bar, unsigned x, unsigned& nloc, unsigned& nx) {
    const unsigned G = gridDim.x;
    unsigned sum, cnt, mine, sp = 0u;
    for (;;) {
        sum = 0u; cnt = 0u; mine = 0u;
#pragma unroll
        for (unsigned j = 0; j < 16; ++j) { const unsigned c = xb_ld(&bar[XB_XCNT(j)]); sum += c; cnt += (c > 0u) ? 1u : 0u; mine = (j == x) ? c : mine; }
        if (sum == G) break;
        __builtin_amdgcn_s_sleep(1);
        if ((++sp & 255u) == 0u) { if (xb_ld(&bar[XB_TMO])) break; if (sp > XB_SPIN_CAP) { atomicAdd(&bar[XB_TMO], 1u); break; } }
    }
    nloc = mine > 0u ? mine : 1u; nx = cnt > 0u ? cnt : 1u;
}
__device__ __forceinline__ void xcd_barrier(const XcdBarrier& b) {
    asm volatile("s_waitcnt vmcnt(0)" ::: "memory");
    __syncthreads();
    if (threadIdx.x == 0) {
        unsigned* bar = b.bar;
        __builtin_amdgcn_s_waitcnt(0);
        unsigned nloc = b.st[0], nx = b.st[1];
        if (nloc == 0u) { xcd_barrier_complete(bar, b.x, nloc, nx); b.st[0] = nloc; b.st[1] = nx; }
        const unsigned old = xb_add(&bar[XB_XSUB(b.x)], 1u);
        const unsigned gen = old / nloc;
        if (old + 1u == (gen + 1u) * nloc) {
            __builtin_amdgcn_fence(__ATOMIC_RELEASE, "agent");
            asm volatile("s_waitcnt vmcnt(0)" ::: "memory");
            const unsigned og = xb_add(&bar[XB_TOP], 1u);
            const unsigned tg = og / nx;
            if (og + 1u == (tg + 1u) * nx) xb_add(&bar[XB_TOPGEN], 1u);
            else XB_SPIN(xb_ld(&bar[XB_TOPGEN]) == tg, bar);
            __builtin_amdgcn_fence(__ATOMIC_ACQUIRE, "agent");
            xb_add(&bar[XB_XGEN(b.x)], 1u);
            asm volatile("s_waitcnt vmcnt(0)" ::: "memory");
        } else {
            XB_SPIN(xb_ld(&bar[XB_XGEN(b.x)]) == gen, bar);
            __builtin_amdgcn_fence(__ATOMIC_ACQUIRE, "agent");
            asm volatile("s_waitcnt vmcnt(0)" ::: "memory");
        }
    }
    __syncthreads();
}

__device__ __forceinline__ int tidx() { int t = threadIdx.x; asm volatile("" : "+v"(t)); return t; }
typedef __bf16 bf16x2_t __attribute__((ext_vector_type(2)));
typedef float f32x2_t __attribute__((ext_vector_type(2)));
__device__ __forceinline__ unsigned cvt_pk(float lo, float hi) {
    f32x2_t v = {lo, hi}; bf16x2_t r = __builtin_convertvector(v, bf16x2_t);
    unsigned u; __builtin_memcpy(&u, &r, 4); return u;
}
__device__ __forceinline__ bf16_t f2bf(float f) { return (bf16_t)(cvt_pk(f, 0.f) & 0xffffu); }
__device__ __forceinline__ float bflo(unsigned u) { return __uint_as_float(u << 16); }
__device__ __forceinline__ float bfhi(unsigned u) { return __uint_as_float(u & 0xffff0000u); }
__device__ __forceinline__ float bf2f(bf16_t u) { return __uint_as_float(((unsigned)u) << 16); }
__device__ __forceinline__ void unpack8(const uint4& u, float (&f)[8]) {
    f[0] = bflo(u.x); f[1] = bfhi(u.x); f[2] = bflo(u.y); f[3] = bfhi(u.y); f[4] = bflo(u.z); f[5] = bfhi(u.z); f[6] = bflo(u.w); f[7] = bfhi(u.w);
}
__device__ __forceinline__ uint4 pack8(const float (&f)[8]) { uint4 u; u.x = cvt_pk(f[0], f[1]); u.y = cvt_pk(f[2], f[3]); u.z = cvt_pk(f[4], f[5]); u.w = cvt_pk(f[6], f[7]); return u; }
typedef unsigned u32x4_t __attribute__((ext_vector_type(4)));
__device__ __forceinline__ uint4 gload16(const void* p) {
    const u32x4_t v = *(const __attribute__((address_space(1))) u32x4_t*)p;
    return make_uint4(v[0], v[1], v[2], v[3]);
}
__device__ __forceinline__ float sigmoidf_(float x) { return __builtin_amdgcn_rcpf(1.0f + __expf(-x)); }
__device__ __forceinline__ float siluf_(float x) { return x * __builtin_amdgcn_rcpf(1.0f + __expf(-x)); }
__device__ __forceinline__ float tanhf_(float x) { return 1.0f - 2.0f * __builtin_amdgcn_rcpf(1.0f + __expf(2.0f * x)); }
__device__ __forceinline__ float softplusf_(float x) { return fmaxf(x, 0.f) + __logf(1.0f + __expf(-fabsf(x))); }
__device__ __forceinline__ float row16_sum(float v);
__device__ __forceinline__ float xor16_add(float v) { const auto r = __builtin_amdgcn_permlane16_swap(__float_as_uint(v), __float_as_uint(v), false, false); return __uint_as_float(r[0]) + __uint_as_float(r[1]); }
__device__ __forceinline__ float xor32_add(float v) { const auto r = __builtin_amdgcn_permlane32_swap(__float_as_uint(v), __float_as_uint(v), false, false); return __uint_as_float(r[0]) + __uint_as_float(r[1]); }
__device__ __forceinline__ float wave_sum(float v) {
    v = row16_sum(v); v = xor16_add(v); v = xor32_add(v);
    return v;
}
__device__ __forceinline__ float row16_sum(float v) {
    v += __builtin_amdgcn_update_dpp(0.f, v, 0x128, 0xf, 0xf, false);
    v += __builtin_amdgcn_update_dpp(0.f, v, 0x124, 0xf, 0xf, false);
    v += __builtin_amdgcn_update_dpp(0.f, v, 0x122, 0xf, 0xf, false);
    v += __builtin_amdgcn_update_dpp(0.f, v, 0x121, 0xf, 0xf, false);
    return v;
}
__device__ __forceinline__ float oct_sum(float v) {
    v += __builtin_amdgcn_update_dpp(0.f, v, 0xB1, 0xf, 0xf, false);
    v += __builtin_amdgcn_update_dpp(0.f, v, 0x4E, 0xf, 0xf, false);
    v += __builtin_amdgcn_update_dpp(0.f, v, 0x141, 0xf, 0xf, false);
    return v;
}

enum { MODE_BF16 = 0, MODE_TANH = 1, MODE_SIGM = 2, MODE_ML1 = 3, MODE_RT1 = 4 };
struct GJob { const bf16_t* A; const bf16_t* Bt; bf16_t* out; int K, N, ldo, mode, ntn, tile0, half; };
struct CJob { const float* src; bf16_t* dst; int K, N, nb, mode; long sbs, dbs; int tiles_pb, tile0; };
constexpr int NGJ = 20, NCJ = 24;
struct Params {
    const float* in[43]; float* out; char* ws;
    int ph_lo, ph_hi, ncj, cj_tiles;
    GJob gj[NGJ];
    CJob cj[NCJ];
};
#define CAS __attribute__((address_space(4)))
typedef const CAS Params& PRef;

__device__ __forceinline__ f32x4 mfma16(const uint4& a, const uint4& b, f32x4 c) {
    bf16x8 av, bv; __builtin_memcpy(&av, &a, 16); __builtin_memcpy(&bv, &b, 16);
    return __builtin_amdgcn_mfma_f32_16x16x32_bf16(av, bv, c, 0, 0, 0);
}
template <bool PFA = true, class AL, class BL>
__device__ __forceinline__ void gemm_mainloop(char* lds, int nk, const AL& al, const BL& bl, f32x4 (&acc)[4][4]) {
    const int t = tidx(), c = t & 7, r0 = t >> 3;
    const int lane = t & 63, wid = t >> 6, wr = wid >> 1, wc = wid & 1, fr = lane & 15, fq = lane >> 4;
    typename AL::Raw ra[4]; typename BL::Raw rb[4];
    const int woff = r0 * 128 + ((c ^ (r0 & 7)) << 4);
#pragma unroll
    for (int i = 0; i < 4; ++i) { if (PFA) ra[i] = al.fetch(i, r0 + 32 * i, c); rb[i] = bl.fetch(i, r0 + 32 * i, c); }
#pragma unroll
    for (int i = 0; i < 4; ++i) {
        if (!PFA) { ra[i] = al.fetch(i, r0 + 32 * i, c); }
        *(uint4*)(lds + woff + i * 4096) = al.finish(ra[i], i, r0 + 32 * i, c);
        *(uint4*)(lds + 16384 + woff + i * 4096) = bl.finish(rb[i], i, r0 + 32 * i, c);
        if (!PFA) asm volatile("" ::: "memory");
    }
#pragma unroll
    for (int m = 0; m < 4; ++m)
#pragma unroll
        for (int n = 0; n < 4; ++n) acc[m][n] = (f32x4){0.f, 0.f, 0.f, 0.f};
    __syncthreads();
    const int aoff = (wr * 64 + fr) * 128, boff = 16384 + (wc * 64 + fr) * 128, sw = fr & 7;
    for (int kt = 0; kt < nk; ++kt) {
        const bool more = (kt + 1 < nk);
        if (more) {
#pragma unroll
            for (int i = 0; i < 4; ++i) { if (PFA) ra[i] = al.fetch(i, r0 + 32 * i, (kt + 1) * 8 + c); rb[i] = bl.fetch(i, r0 + 32 * i, (kt + 1) * 8 + c); }
        }
        const char* buf = lds + (kt & 1) * 32768;
#pragma unroll
        for (int ks = 0; ks < 2; ++ks) {
            uint4 af[4], bfm[4];
            const int ch = ((ks * 4 + fq) ^ sw) << 4;
#pragma unroll
            for (int m = 0; m < 4; ++m) af[m] = *(const uint4*)(buf + aoff + m * 2048 + ch);
#pragma unroll
            for (int n = 0; n < 4; ++n) bfm[n] = *(const uint4*)(buf + boff + n * 2048 + ch);
#pragma unroll
            for (int m = 0; m < 4; ++m)
#pragma unroll
                for (int n = 0; n < 4; ++n) acc[m][n] = mfma16(bfm[n], af[m], acc[m][n]);
        }
        if (more) {
            char* nb = lds + ((kt + 1) & 1) * 32768;
#pragma unroll
            for (int i = 0; i < 4; ++i) {
                if (!PFA) ra[i] = al.fetch(i, r0 + 32 * i, (kt + 1) * 8 + c);
                *(uint4*)(nb + woff + i * 4096) = al.finish(ra[i], i, r0 + 32 * i, (kt + 1) * 8 + c);
                *(uint4*)(nb + 16384 + woff + i * 4096) = bl.finish(rb[i], i, r0 + 32 * i, (kt + 1) * 8 + c);
                if (!PFA) asm volatile("" ::: "memory");
            }
        }
        __syncthreads();
    }
}
__device__ __forceinline__ void glds16(const bf16_t* g, char* l) {
    __builtin_amdgcn_global_load_lds((const unsigned*)g, (LAS unsigned*)l, 16, 0, 0);
}
__device__ __forceinline__ void glds16_asm(const void* gsrc, unsigned lds_dst) {
    unsigned keep;
    asm volatile("s_mov_b32 %0, m0\n\ts_mov_b32 m0, %2\n\ts_nop 0\n\tglobal_load_lds_dwordx4 %1, off\n\ts_mov_b32 m0, %0" : "=&s"(keep) : "v"(gsrc), "s"(lds_dst) : "memory");
}
__device__ __forceinline__ unsigned lds_addr_u(const char* l) { return (unsigned)(size_t)(const LAS char*)l; }
__device__ __forceinline__ int glds_chunk(int t) { return (t & 7) ^ ((t >> 3) & 7); }
__device__ __forceinline__ void mma_ktile(const char* buf, int aoff, int boff, int sw, int fq, f32x4 (&acc)[4][4]) {
    const int ch0 = ((0 * 4 + fq) ^ sw) << 4, ch1 = ((1 * 4 + fq) ^ sw) << 4;
    const char* pa = buf + aoff; const char* pb = buf + boff;
    uint4 a0[4], a1[4], b[8];
#pragma unroll
    for (int m = 0; m < 4; ++m) a0[m] = *(const uint4*)(pa + m * 2048 + ch0);
    b[0] = *(const uint4*)(pb + ch0); b[1] = *(const uint4*)(pb + 2048 + ch0);
    __builtin_amdgcn_sched_barrier(0);
    b[2] = *(const uint4*)(pb + 2 * 2048 + ch0);
#pragma unroll
    for (int m = 0; m < 4; ++m) acc[m][0] = mfma16(b[0], a0[m], acc[m][0]);
    __builtin_amdgcn_sched_barrier(0);
    b[3] = *(const uint4*)(pb + 3 * 2048 + ch0);
#pragma unroll
    for (int m = 0; m < 4; ++m) acc[m][1] = mfma16(b[1], a0[m], acc[m][1]);
    __builtin_amdgcn_sched_barrier(0);
#pragma unroll
    for (int m = 0; m < 4; ++m) a1[m] = *(const uint4*)(pa + m * 2048 + ch1);
#pragma unroll
    for (int m = 0; m < 4; ++m) acc[m][2] = mfma16(b[2], a0[m], acc[m][2]);
    __builtin_amdgcn_sched_barrier(0);
    b[4] = *(const uint4*)(pb + ch1); b[5] = *(const uint4*)(pb + 2048 + ch1);
#pragma unroll
    for (int m = 0; m < 4; ++m) acc[m][3] = mfma16(b[3], a0[m], acc[m][3]);
    __builtin_amdgcn_sched_barrier(0);
    b[6] = *(const uint4*)(pb + 2 * 2048 + ch1);
#pragma unroll
    for (int m = 0; m < 4; ++m) acc[m][0] = mfma16(b[4], a1[m], acc[m][0]);
    __builtin_amdgcn_sched_barrier(0);
    b[7] = *(const uint4*)(pb + 3 * 2048 + ch1);
#pragma unroll
    for (int m = 0; m < 4; ++m) acc[m][1] = mfma16(b[5], a1[m], acc[m][1]);
    __builtin_amdgcn_sched_barrier(0);
#pragma unroll
    for (int m = 0; m < 4; ++m) acc[m][2] = mfma16(b[6], a1[m], acc[m][2]);
#pragma unroll
    for (int m = 0; m < 4; ++m) acc[m][3] = mfma16(b[7], a1[m], acc[m][3]);
}
__device__ __forceinline__ void gemm_gg(char* lds, int nk, const bf16_t* const (&ar)[4], const bf16_t* const (&br)[4], f32x4 (&acc)[4][4]) {
    const int t = tidx();
    const int lane = t & 63, wid = t >> 6, wr = wid >> 1, wc = wid & 1, fr = lane & 15, fq = lane >> 4;
    const unsigned wbs = (unsigned)__builtin_amdgcn_readfirstlane((int)(lds_addr_u(lds) + wid * 1024));
#pragma unroll
    for (int i = 0; i < 4; ++i) { glds16_asm(ar[i], wbs + i * 4096); glds16_asm(br[i], wbs + 16384 + i * 4096); }
#pragma unroll
    for (int m = 0; m < 4; ++m)
#pragma unroll
        for (int n = 0; n < 4; ++n) acc[m][n] = (f32x4){0.f, 0.f, 0.f, 0.f};
    asm volatile("s_waitcnt vmcnt(0)" ::: "memory");
    __syncthreads();
    const int aoff = (wr * 64 + fr) * 128, boff = 16384 + (wc * 64 + fr) * 128, sw = fr & 7;
    for (int kt = 0; kt < nk; ++kt) {
        if (kt + 1 < nk) {
            const unsigned nb = (unsigned)__builtin_amdgcn_readfirstlane((int)(wbs + ((kt + 1) & 1) * 32768));
#pragma unroll
            for (int i = 0; i < 4; ++i) { glds16_asm(ar[i] + (kt + 1) * 64, nb + i * 4096); glds16_asm(br[i] + (kt + 1) * 64, nb + 16384 + i * 4096); }
        }
        mma_ktile(lds + (kt & 1) * 32768, aoff, boff, sw, fq, acc);
        asm volatile("s_waitcnt vmcnt(0)" ::: "memory");
        __syncthreads();
    }
}
__device__ __forceinline__ void gemm_hn(char* lds, int nk, const bf16_t* const (&ar)[4], const bf16_t* const (&br)[2], f32x4 (&acc)[2][4]) {
    const int t = tidx();
    const int lane = t & 63, wid = t >> 6, fr = lane & 15, fq = lane >> 4;
    const unsigned wbs = (unsigned)__builtin_amdgcn_readfirstlane((int)(lds_addr_u(lds) + wid * 1024));
#pragma unroll
    for (int i = 0; i < 4; ++i) glds16_asm(ar[i], wbs + i * 4096);
#pragma unroll
    for (int i = 0; i < 2; ++i) glds16_asm(br[i], wbs + 16384 + i * 4096);
#pragma unroll
    for (int m = 0; m < 2; ++m)
#pragma unroll
        for (int n = 0; n < 4; ++n) acc[m][n] = (f32x4){0.f, 0.f, 0.f, 0.f};
    asm volatile("s_waitcnt vmcnt(0)" ::: "memory");
    __syncthreads();
    const int aoff = (wid * 32 + fr) * 128, boff = 16384 + fr * 128, sw = fr & 7;
    for (int kt = 0; kt < nk; ++kt) {
        if (kt + 1 < nk) {
            const unsigned nb = (unsigned)__builtin_amdgcn_readfirstlane((int)(wbs + ((kt + 1) & 1) * 32768));
#pragma unroll
            for (int i = 0; i < 4; ++i) glds16_asm(ar[i] + (kt + 1) * 64, nb + i * 4096);
#pragma unroll
            for (int i = 0; i < 2; ++i) glds16_asm(br[i] + (kt + 1) * 64, nb + 16384 + i * 4096);
        }
        const char* buf = lds + (kt & 1) * 32768;
#pragma unroll
        for (int ks = 0; ks < 2; ++ks) {
            const int ch = ((ks * 4 + fq) ^ sw) << 4;
            uint4 af[2], bfm[4];
#pragma unroll
            for (int m = 0; m < 2; ++m) af[m] = *(const uint4*)(buf + aoff + m * 2048 + ch);
#pragma unroll
            for (int n = 0; n < 4; ++n) bfm[n] = *(const uint4*)(buf + boff + n * 2048 + ch);
#pragma unroll
            for (int m = 0; m < 2; ++m)
#pragma unroll
                for (int n = 0; n < 4; ++n) acc[m][n] = mfma16(bfm[n], af[m], acc[m][n]);
        }
        asm volatile("s_waitcnt vmcnt(0)" ::: "memory");
        __syncthreads();
    }
}
template <class AL>
__device__ __forceinline__ void gemm_rg(char* lds, int nk, const AL& al, const bf16_t* const (&br)[4], f32x4 (&acc)[4][4]) {
    const int t = tidx(), c = t & 7, r0 = t >> 3;
    const int lane = t & 63, wid = t >> 6, wr = wid >> 1, wc = wid & 1, fr = lane & 15, fq = lane >> 4;
    char* wb = lds + wid * 1024;
    const int woff = r0 * 128 + ((c ^ (r0 & 7)) << 4);
#pragma unroll
    for (int i = 0; i < 4; ++i) glds16(br[i], wb + 16384 + i * 4096);
#pragma unroll
    for (int i = 0; i < 4; ++i) {
        typename AL::Raw ra = al.fetch(i, r0 + 32 * i, c);
        *(uint4*)(lds + woff + i * 4096) = al.finish(ra, i, r0 + 32 * i, c);
        asm volatile("" ::: "memory");
    }
#pragma unroll
    for (int m = 0; m < 4; ++m)
#pragma unroll
        for (int n = 0; n < 4; ++n) acc[m][n] = (f32x4){0.f, 0.f, 0.f, 0.f};
    asm volatile("s_waitcnt vmcnt(0)" ::: "memory");
    __syncthreads();
    const int aoff = (wr * 64 + fr) * 128, boff = 16384 + (wc * 64 + fr) * 128, sw = fr & 7;
    for (int kt = 0; kt < nk; ++kt) {
        const bool more = (kt + 1 < nk);
        char* nbuf = lds + ((kt + 1) & 1) * 32768;
        if (more) {
#pragma unroll
            for (int i = 0; i < 4; ++i) glds16(br[i] + (kt + 1) * 64, nbuf + wid * 1024 + 16384 + i * 4096);
        }
        mma_ktile(lds + (kt & 1) * 32768, aoff, boff, sw, fq, acc);
        if (more) {
#pragma unroll
            for (int i = 0; i < 4; ++i) {
                typename AL::Raw ra = al.fetch(i, r0 + 32 * i, (kt + 1) * 8 + c);
                *(uint4*)(nbuf + woff + i * 4096) = al.finish(ra, i, r0 + 32 * i, (kt + 1) * 8 + c);
                asm volatile("" ::: "memory");
            }
        }
        asm volatile("s_waitcnt vmcnt(0)" ::: "memory");
        __syncthreads();
    }
}
struct LdPlain {
    typedef uint4 Raw;
    const bf16_t* p; int ld; int nvalid;
    __device__ __forceinline__ uint4 fetch(int, int r, int kc) const { return (r < nvalid) ? *(const uint4*)(p + (size_t)r * ld + kc * 8) : make_uint4(0u, 0u, 0u, 0u); }
    __device__ __forceinline__ uint4 finish(const uint4& v, int, int, int) const { return v; }
};
struct LdGather {
    typedef uint4 Raw;
    const bf16_t* rp[4];
    __device__ __forceinline__ uint4 fetch(int i, int, int kc) const { const bf16_t* q = rp[i]; return q ? *(const uint4*)(q + kc * 8) : make_uint4(0u, 0u, 0u, 0u); }
    __device__ __forceinline__ uint4 finish(const uint4& v, int, int, int) const { return v; }
};
__device__ __forceinline__ void tile_map(int id, int NT, int& mt, int& nt) {
    const int x = id & 7, q = id >> 3;
    const int mg = q / (8 * NT), q2 = q - mg * 8 * NT, G = (NT + 7) >> 3;
    int g = q2 >> 6; g = g < G - 1 ? g : G - 1;
    const int r = q2 - (g << 6), w = (g == G - 1) ? NT - 8 * g : 8;
    mt = (mg * 8 + r / w) * 8 + x; nt = 8 * g + r % w;
}

__device__ __forceinline__ int conv_row(int mode, int n) {
    if (mode == 1) return (n >> 4) * 32 + (n & 15);
    if (mode == 2) return (n >> 4) * 32 + 16 + (n & 15);
    if (mode == 3 && n < 2048) { const int c = n & 255, c2 = c & 127; return (n & ~255) + (c2 >> 4) * 32 + ((c >> 7) << 4) + (c2 & 15); }
    return n;
}
__device__ __forceinline__ void phase_prologue(PRef p, char* lds) {
    const int t = tidx();
    const int n_ada = 8 * 48, n_rot = 256 + 144;
    float* mod = (float*)(p.ws + OFF_MOD);
    for (int it = blockIdx.x; it < n_ada + n_rot; it += gridDim.x) {
        if (it < n_ada) {
            const int pr = it / 48, cb = it % 48;
            float* sc = (float*)lds;
            float* red = (float*)(lds + 32768);
            for (int i = t; i < 8192; i += 256) { const int b = i >> 10, k = i & 1023; sc[k * 8 + b] = siluf_(p.in[1][b * 1024 + k]); }
            __syncthreads();
            const int kg = t >> 6, cl = t & 63, col = cb * 64 + cl;
            const float* W = p.in[2] + (size_t)pr * 1024 * 3072 + col;
            float a[8] = {0, 0, 0, 0, 0, 0, 0, 0};
#pragma unroll 8
            for (int k = kg * 256; k < kg * 256 + 256; ++k) {
                const float w = W[(size_t)k * 3072];
                const float4 s0 = *(const float4*)(sc + k * 8), s1 = *(const float4*)(sc + k * 8 + 4);
                a[0] += w * s0.x; a[1] += w * s0.y; a[2] += w * s0.z; a[3] += w * s0.w; a[4] += w * s1.x; a[5] += w * s1.y; a[6] += w * s1.z; a[7] += w * s1.w;
            }
#pragma unroll
            for (int b = 0; b < 8; ++b) red[(kg * 8 + b) * 64 + cl] = a[b];
            __syncthreads();
            for (int i = t; i < 512; i += 256) {
                const int b = i >> 6, c2 = i & 63;
                const float s = red[(0 * 8 + b) * 64 + c2] + red[(1 * 8 + b) * 64 + c2] + red[(2 * 8 + b) * 64 + c2] + red[(3 * 8 + b) * 64 + c2];
                mod[((size_t)pr * 8 + b) * 3072 + cb * 64 + c2] = s + p.in[3][pr * 3072 + cb * 64 + c2];
            }
            __syncthreads();
        } else if (it >= n_ada + 256 && it < n_ada + n_rot) {
            float* rtw = (float*)(p.ws + OFF_RTW);
            const int base = (it - n_ada - 256) * 1024;
            for (int e = base + t; e < base + 1024; e += 256) {
                const int L = e / (36 * 1024), o = (e >> 10) % 36, k = e & 1023;
                rtw[e] = (o < 4) ? p.in[36][((size_t)L * 1024 + k) * 4 + o] : p.in[38][((size_t)L * 1024 + k) * 32 + (o - 4)];
            }
        } else if (it < n_ada + 256) {
            float* rot = (float*)(p.ws + OFF_ROT);
            const int base = (it - n_ada) * 1024;
            for (int e = base + t; e < base + 1024; e += 256) {
                const int tt = e >> 7, i = e & 127;
                const float inv = __builtin_amdgcn_exp2f(-(float)i * (13.287712379549449f / 127.0f));
                const float ang = (float)tt * inv;
                float rev = ang * 0.15915494309189535f; rev -= floorf(rev);
                rot[e * 2] = __builtin_amdgcn_cosf(rev); rot[e * 2 + 1] = __builtin_amdgcn_sinf(rev);
            }
        }
    }
    {
        float* sm = (float*)lds;
        const int lane = t & 63, wv = t >> 6;
        const float* nsrc = nullptr; bf16_t* ndst = nullptr; int nK = 0, nN = 0, nmode = 0, nkt = 0, nnt = 0;
        float4 pv[16];
#define CJ_SETUP(ct_) { int c_ = (ct_), j_ = 0; while (j_ + 1 < p.ncj && c_ >= p.cj[j_ + 1].tile0) ++j_; \
            c_ -= p.cj[j_].tile0; const int tpb_ = p.cj[j_].tiles_pb; const int bi_ = c_ / tpb_, tl_ = c_ % tpb_; nK = p.cj[j_].K; nN = p.cj[j_].N; nmode = p.cj[j_].mode; \
            const int nNt_ = (nN + 255) >> 8; nkt = tl_ / nNt_; nnt = tl_ % nNt_; nsrc = p.cj[j_].src + (size_t)bi_ * p.cj[j_].sbs; ndst = p.cj[j_].dst + (size_t)bi_ * p.cj[j_].dbs; }
#define CJ_LOAD() { _Pragma("unroll") for (int i = 0; i < 16; ++i) { const int k = nkt * 64 + wv + 4 * i, n = nnt * 256 + lane * 4; \
            pv[i] = (k < nK && n < nN) ? gld_f4(nsrc + (size_t)k * nN + n) : make_float4(0.f, 0.f, 0.f, 0.f); } }
        int* const tick = (int*)(p.ws + OFF_CTL + 20480);
        int* const nbox = (int*)(lds + 66560);
        int ct = (int)blockIdx.x, ct2 = (int)gridDim.x + (int)blockIdx.x;
        if (ct < p.cj_tiles) { CJ_SETUP(ct); CJ_LOAD(); }
        while (ct < p.cj_tiles) {
#pragma unroll
            for (int i = 0; i < 16; ++i) *(float4*)(sm + (wv + 4 * i) * 260 + lane * 4) = pv[i];
            bf16_t* const sdst = ndst; const int sK = nK, sN = nN, smode = nmode, skt = nkt, snt = nnt;
            if (ct2 < p.cj_tiles) { CJ_SETUP(ct2); CJ_LOAD(); }
            if (t == 0) *nbox = 2 * (int)gridDim.x + atomicAdd(tick, 1);
            __syncthreads();
            const int ct3 = *nbox;
#pragma unroll
            for (int h2 = 0; h2 < 4; ++h2) {
                const int nl = lane + 64 * h2, n = snt * 256 + nl, k0 = skt * 64 + wv * 16;
                if (n < sN && k0 < sK) {
                    float f[8], g[8];
#pragma unroll
                    for (int q = 0; q < 8; ++q) { f[q] = sm[(wv * 16 + q) * 260 + nl]; g[q] = sm[(wv * 16 + 8 + q) * 260 + nl]; }
                    bf16_t* d = sdst + (size_t)conv_row(smode, n) * sK + k0;
                    { const uint4 u0 = pack8(f), u1 = pack8(g); gst_u4(d, u0.x, u0.y, u0.z, u0.w); gst_u4(d + 8, u1.x, u1.y, u1.z, u1.w); }
                }
            }
            __syncthreads();
            ct = ct2; ct2 = ct3;
        }
#undef CJ_SETUP
#undef CJ_LOAD
    }
}

__device__ __forceinline__ void row_load_f32(const float* p, float (&v)[16], int lane) {
#pragma unroll
    for (int c = 0; c < 4; ++c) { const float4 x = gld_f4(p + c * 256 + lane * 4); v[c * 4] = x.x; v[c * 4 + 1] = x.y; v[c * 4 + 2] = x.z; v[c * 4 + 3] = x.w; }
}
__device__ __forceinline__ void row_load_f32_l(const float* p, float (&v)[16], int lane) {
#pragma unroll
    for (int c = 0; c < 4; ++c) { const float4 x = *(const float4*)(p + c * 256 + lane * 4); v[c * 4] = x.x; v[c * 4 + 1] = x.y; v[c * 4 + 2] = x.z; v[c * 4 + 3] = x.w; }
}
__device__ __forceinline__ void row_load_bf16(const bf16_t* p, float (&v)[16], int lane) {
#pragma unroll
    for (int c = 0; c < 4; ++c) { const uint2 x = gld_u2(p + c * 256 + lane * 4); v[c * 4] = bflo(x.x); v[c * 4 + 1] = bfhi(x.x); v[c * 4 + 2] = bflo(x.y); v[c * 4 + 3] = bfhi(x.y); }
}
__device__ __forceinline__ void row_store_bf16(bf16_t* p, const float (&v)[16], int lane) {
#pragma unroll
    for (int c = 0; c < 4; ++c) gst_u2(p + c * 256 + lane * 4, cvt_pk(v[c * 4], v[c * 4 + 1]), cvt_pk(v[c * 4 + 2], v[c * 4 + 3]));
}
__device__ __forceinline__ void row_store_f32(float* p, const float (&v)[16], int lane) {
#pragma unroll
    for (int c = 0; c < 4; ++c) gst_f4(p + c * 256 + lane * 4, v[c * 4], v[c * 4 + 1], v[c * 4 + 2], v[c * 4 + 3]);
}
__device__ __forceinline__ void row_store_f32_l(float* p, const float (&v)[16], int lane) {
#pragma unroll
    for (int c = 0; c < 4; ++c) *(float4*)(p + c * 256 + lane * 4) = make_float4(v[c * 4], v[c * 4 + 1], v[c * 4 + 2], v[c * 4 + 3]);
}
__device__ __forceinline__ void row_layernorm(float (&v)[16], const float* g, const float* b, int lane) {
    float gg[16], bb[16]; row_load_f32(g, gg, lane); row_load_f32(b, bb, lane);
    float s = 0.f, q = 0.f;
#pragma unroll
    for (int i = 0; i < 16; ++i) { s += v[i]; q += v[i] * v[i]; }
    s = wave_sum(s); q = wave_sum(q);
    const float mean = s * (1.0f / 1024.0f);
    const float rstd = rsqrtf(fmaxf(q * (1.0f / 1024.0f) - mean * mean, 0.f) + LN_EPS);
#pragma unroll
    for (int i = 0; i < 16; ++i) v[i] = (v[i] - mean) * rstd * gg[i] + bb[i];
}
__device__ __forceinline__ void row_modulate(const float (&x)[16], float (&h)[16], const float* mod3, int lane) {
    float sh[16], sc[16]; row_load_f32(mod3, sh, lane); row_load_f32(mod3 + 1024, sc, lane);
#pragma unroll
    for (int i = 0; i < 16; ++i) h[i] = x[i] * (1.0f + sc[i]) + sh[i];
}
__device__ __forceinline__ void load_mu(const float* mu, float (&m)[6][16], int lane) {
#pragma unroll
    for (int n = 0; n < 6; ++n) row_load_f32(mu + n * 1024, m[n], lane);
}
__device__ __forceinline__ void emit_next(bf16_t* s0, int kind, int row, const float (&h)[16], const float (&hp)[16], const float (&m)[6][16], int lane) {
    if (kind == 0) {
#pragma unroll
        for (int n = 0; n < 6; ++n) {
#pragma unroll
            for (int c = 0; c < 4; ++c)
                gst_u2(s0 + (size_t)n * (SLOT / 2) + (size_t)row * 1024 + c * 256 + lane * 4,
                       cvt_pk(h[c * 4] + (hp[c * 4] - h[c * 4]) * m[n][c * 4], h[c * 4 + 1] + (hp[c * 4 + 1] - h[c * 4 + 1]) * m[n][c * 4 + 1]),
                       cvt_pk(h[c * 4 + 2] + (hp[c * 4 + 2] - h[c * 4 + 2]) * m[n][c * 4 + 2], h[c * 4 + 3] + (hp[c * 4 + 3] - h[c * 4 + 3]) * m[n][c * 4 + 3]));
        }
    } else row_store_bf16(s0 + (size_t)row * 1024, h, lane);
}
__device__ __forceinline__ void emit_next_l(bf16_t* s0, const float* mu, int kind, int row, const float (&h)[16], const float (&hp)[16], int lane) {
    if (kind == 0) {
#pragma unroll 1
        for (int n = 0; n < 6; ++n) {
#pragma unroll
            for (int c2 = 0; c2 < 2; ++c2) {
                const float4 ma = gld_f4(mu + n * 1024 + (2 * c2) * 256 + lane * 4), mb = gld_f4(mu + n * 1024 + (2 * c2 + 1) * 256 + lane * 4);
                const float mm[8] = {ma.x, ma.y, ma.z, ma.w, mb.x, mb.y, mb.z, mb.w};
#pragma unroll
                for (int cc = 0; cc < 2; ++cc) {
                    const int c = 2 * c2 + cc;
                    gst_u2(s0 + (size_t)n * (SLOT / 2) + (size_t)row * 1024 + c * 256 + lane * 4,
                           cvt_pk(h[c * 4] + (hp[c * 4] - h[c * 4]) * mm[cc * 4], h[c * 4 + 1] + (hp[c * 4 + 1] - h[c * 4 + 1]) * mm[cc * 4 + 1]),
                           cvt_pk(h[c * 4 + 2] + (hp[c * 4 + 2] - h[c * 4 + 2]) * mm[cc * 4 + 2], h[c * 4 + 3] + (hp[c * 4 + 3] - h[c * 4 + 3]) * mm[cc * 4 + 3]));
                }
            }
        }
    } else row_store_bf16(s0 + (size_t)row * 1024, h, lane);
}
__device__ __forceinline__ void phase_h0(PRef p) {
    const int t_ = tidx(); const int lane = t_ & 63, gw = blockIdx.x * 4 + (t_ >> 6), nw = gridDim.x * 4;
    const int rpw = NTOK / nw;
    const int r_lo = gw * rpw;
    const float* mod = (const float*)(p.ws + OFF_MOD) + ((size_t)(0 * 2 + 0) * 8 + (r_lo >> 11)) * 3072;
    float sh[16], sc[16]; row_load_f32(mod, sh, lane); row_load_f32(mod + 1024, sc, lane);
    float hp[16];
#pragma unroll
    for (int i = 0; i < 16; ++i) hp[i] = 0.f;
    float mu[6][16]; load_mu(p.in[6], mu, lane);
    const int first = ((r_lo & 2047) != 0) ? r_lo - 1 : r_lo, end = r_lo + rpw;
    float nx[16]; row_load_f32(p.in[0] + (size_t)first * 1024, nx, lane);
    for (int r = first; r < end; ++r) {
        float h[16];
#pragma unroll
        for (int i = 0; i < 16; ++i) h[i] = nx[i] * (1.0f + sc[i]) + sh[i];
        if (r + 1 < end) row_load_f32(p.in[0] + (size_t)(r + 1) * 1024, nx, lane);
        __builtin_amdgcn_sched_barrier(0);
        if (r >= r_lo) emit_next((bf16_t*)(p.ws + OFF_SLOT), 0, r, h, hp, mu, lane);
#pragma unroll
        for (int i = 0; i < 16; ++i) hp[i] = h[i];
        if (((r + 1) & 2047) == 0) {
#pragma unroll
            for (int i = 0; i < 16; ++i) hp[i] = 0.f;
        }
    }
}
__device__ __forceinline__ int layer_kind(int L) { return L % 3; }
__device__ __forceinline__ void phase_ln2(PRef p, int L) {
    const int t_ = tidx(); const int lane = t_ & 63, gw = blockIdx.x * 4 + (t_ >> 6), nw = gridDim.x * 4;
    const int rpw = NTOK / nw, r_lo = gw * rpw;
    const float* mod = (const float*)(p.ws + OFF_MOD);
    const bf16_t* xres = (const bf16_t*)(p.ws + OFF_XRES);
    const bf16_t* Y = (const bf16_t*)(p.ws + OFF_SLOT + 9 * SLOT);
    const float* wgt = (const float*)(p.ws + OFF_WGT);
    const bool last = (L == 3);
    const int nk = layer_kind(L + 1), njr = (L + 1) / 3;
    const bool need_prev = (!last && nk == 0);
    const int bidx = r_lo >> 11;
    float gt[16], lgn[16], lbn[16];
    row_load_f32(mod + ((size_t)(L * 2 + 1) * 8 + bidx) * 3072 + 2048, gt, lane);
    row_load_f32(p.in[4] + (L * 2 + 1) * 1024, lgn, lane); row_load_f32(p.in[5] + (L * 2 + 1) * 1024, lbn, lane);
    float hp[16];
#pragma unroll
    for (int i = 0; i < 16; ++i) hp[i] = 0.f;
    float shn[16], scn[16];
    { const float* mn_ = mod + ((size_t)((last ? L : L + 1) * 2 + 0) * 8 + bidx) * 3072; row_load_f32(mn_, shn, lane); row_load_f32(mn_ + 1024, scn, lane); }
    uint2 nxr[4], ny0[4], ny1[4]; float nw0, nw1;
    auto load_in = [&](int r) {
#pragma unroll
        for (int c = 0; c < 4; ++c) { nxr[c] = *(const uint2*)(xres + (size_t)r * 1024 + c * 256 + lane * 4); ny0[c] = *(const uint2*)(Y + (size_t)(2 * r) * 1024 + c * 256 + lane * 4); ny1[c] = *(const uint2*)(Y + (size_t)(2 * r + 1) * 1024 + c * 256 + lane * 4); }
        nw0 = wgt[2 * r]; nw1 = wgt[2 * r + 1];
    };
    const int first = (need_prev && (r_lo & 2047) != 0) ? r_lo - 1 : r_lo, end = r_lo + rpw;
    load_in(first);
    for (int r = first; r < end; ++r) {
        float x[16];
        {
            const float w0 = nw0, w1 = nw1;
#pragma unroll
            for (int c = 0; c < 4; ++c) {
                const float a0[4] = {bflo(ny0[c].x), bfhi(ny0[c].x), bflo(ny0[c].y), bfhi(ny0[c].y)}, a1[4] = {bflo(ny1[c].x), bfhi(ny1[c].x), bflo(ny1[c].y), bfhi(ny1[c].y)};
                const float xr[4] = {bflo(nxr[c].x), bfhi(nxr[c].x), bflo(nxr[c].y), bfhi(nxr[c].y)};
#pragma unroll
                for (int i = 0; i < 4; ++i) x[c * 4 + i] = DN_ALPHA * xr[i] + (1.0f + gt[c * 4 + i]) * (w0 * a0[i] + w1 * a1[i]);
            }
        }
        if (r + 1 < end) load_in(r + 1);
        __builtin_amdgcn_sched_barrier(0);
        float s = 0.f, q = 0.f;
#pragma unroll
        for (int i = 0; i < 16; ++i) { s += x[i]; q += x[i] * x[i]; }
        s = wave_sum(s); q = wave_sum(q);
        const float mean = s * (1.0f / 1024.0f), rstd = rsqrtf(fmaxf(q * (1.0f / 1024.0f) - mean * mean, 0.f) + LN_EPS);
#pragma unroll
        for (int i = 0; i < 16; ++i) x[i] = (x[i] - mean) * rstd * lgn[i] + lbn[i];
        if (last) { row_store_f32(p.out + (size_t)r * 1024, x, lane); continue; }
        float h[16];
#pragma unroll
        for (int i = 0; i < 16; ++i) h[i] = x[i] * (1.0f + scn[i]) + shn[i];
        if (r >= r_lo) { row_store_bf16((bf16_t*)(p.ws + OFF_XRES2) + (size_t)r * 1024, x, lane); emit_next_l((bf16_t*)(p.ws + OFF_SLOT), p.in[6] + (size_t)njr * 6 * 1024, nk, r, h, hp, lane); }
#pragma unroll
        for (int i = 0; i < 16; ++i) hp[i] = h[i];
        if (((r + 1) & 2047) == 0) {
#pragma unroll
            for (int i = 0; i < 16; ++i) hp[i] = 0.f;
        }
    }
}
__device__ __forceinline__ void phase_ln1(PRef p, int L, char* lds, const bf16_t* ymix, bf16_t* hm) {
    const int t = tidx(), lane = t & 63, wid = t >> 6;
    const float* mod = (const float*)(p.ws + OFF_MOD);
    const bf16_t* xinb = (const bf16_t*)(p.ws + OFF_XRES2);
    bf16_t* xres = (bf16_t*)(p.ws + OFF_XRES);
    int* cnt = (int*)(p.ws + OFF_CNT) + L * 32;
    int* list = (int*)(p.ws + OFF_LIST);
    float* wgt = (float*)(p.ws + OFF_WGT);
    float* const HB = (float*)lds;
    float* const lg = (float*)(lds + 65536);
    const float* rtw = (const float*)(p.ws + OFF_RTW) + (size_t)L * 36 * 1024;
    const int rpb = NTOK / gridDim.x;
    const int bidx = (blockIdx.x * rpb) >> 11;
    float gt[16], lgn[16], lbn[16], sh2[16], sc2[16];
    row_load_f32(mod + ((size_t)(L * 2 + 0) * 8 + bidx) * 3072 + 2048, gt, lane);
    row_load_f32(p.in[4] + (L * 2 + 0) * 1024, lgn, lane); row_load_f32(p.in[5] + (L * 2 + 0) * 1024, lbn, lane);
    row_load_f32(mod + ((size_t)(L * 2 + 1) * 8 + bidx) * 3072, sh2, lane); row_load_f32(mod + ((size_t)(L * 2 + 1) * 8 + bidx) * 3072 + 1024, sc2, lane);
    for (int rb0 = blockIdx.x * rpb; rb0 < (blockIdx.x + 1) * rpb; rb0 += 16) {
        const int rb = rb0 + wid * 4;
        uint4 xr[4][4]; uint2 yr[4][4];
#pragma unroll
        for (int rr = 0; rr < 4; ++rr) {
            const int r = rb + rr;
#pragma unroll
            for (int c = 0; c < 4; ++c) {
                if (L == 0) xr[rr][c] = gld_u4(p.in[0] + (size_t)r * 1024 + c * 256 + lane * 4);
                else { const uint2 t2 = gld_u2(xinb + (size_t)r * 1024 + c * 256 + lane * 4); xr[rr][c] = make_uint4(t2.x, t2.y, 0u, 0u); }
                yr[rr][c] = gld_u2(ymix + (size_t)r * 1024 + c * 256 + lane * 4);
            }
        }
#pragma unroll
        for (int rr = 0; rr < 4; ++rr) {
            const int r = rb + rr;
            float x[16], h[16];
#pragma unroll
            for (int c = 0; c < 4; ++c) {
                float xv[4];
                if (L == 0) { xv[0] = __uint_as_float(xr[rr][c].x); xv[1] = __uint_as_float(xr[rr][c].y); xv[2] = __uint_as_float(xr[rr][c].z); xv[3] = __uint_as_float(xr[rr][c].w); }
                else { xv[0] = bflo(xr[rr][c].x); xv[1] = bfhi(xr[rr][c].x); xv[2] = bflo(xr[rr][c].y); xv[3] = bfhi(xr[rr][c].y); }
                const float yv[4] = {bflo(yr[rr][c].x), bfhi(yr[rr][c].x), bflo(yr[rr][c].y), bfhi(yr[rr][c].y)};
#pragma unroll
                for (int i = 0; i < 4; ++i) x[c * 4 + i] = DN_ALPHA * xv[i] + (1.0f + gt[c * 4 + i]) * yv[i];
            }
            float s = 0.f, q = 0.f;
#pragma unroll
            for (int i = 0; i < 16; ++i) { s += x[i]; q += x[i] * x[i]; }
            s = wave_sum(s); q = wave_sum(q);
            const float mean = s * (1.0f / 1024.0f), rstd = rsqrtf(fmaxf(q * (1.0f / 1024.0f) - mean * mean, 0.f) + LN_EPS);
#pragma unroll
            for (int i = 0; i < 16; ++i) { x[i] = (x[i] - mean) * rstd * lgn[i] + lbn[i]; h[i] = x[i] * (1.0f + sc2[i]) + sh2[i]; }
            row_store_bf16(xres + (size_t)r * 1024, x, lane);
            row_store_bf16(hm + (size_t)r * 1024, h, lane);
            row_store_f32_l(HB + (wid * 4 + rr) * 1024, h, lane);
        }
        __syncthreads();
#pragma unroll 1
        for (int q3 = 0; q3 < 9; q3 += 3) {
            float w[3][16];
#pragma unroll
            for (int u = 0; u < 3; ++u) row_load_f32(rtw + (size_t)(wid * 9 + q3 + u) * 1024, w[u], lane);
#pragma unroll 2
            for (int r16 = 0; r16 < 16; ++r16) {
                float h[16]; row_load_f32_l(HB + r16 * 1024, h, lane);
                float a3[3];
#pragma unroll
                for (int u = 0; u < 3; ++u) { float s2 = 0.f;
#pragma unroll
                    for (int i = 0; i < 16; ++i) s2 += h[i] * w[u][i];
                    a3[u] = wave_sum(s2); }
                if (lane == 0) {
#pragma unroll
                    for (int u = 0; u < 3; ++u) lg[r16 * 36 + wid * 9 + q3 + u] = a3[u];
                }
            }
        }
        __syncthreads();
        if (t < 16) {
            const int row = rb0 + t; const float* l = lg + t * 36;
            float g[4]; for (int i = 0; i < 4; ++i) g[i] = l[i] + p.in[37][L * 4 + i];
            int gi = 0; for (int i = 1; i < 4; ++i) if (g[i] > g[gi]) gi = i;
            float gs = 0.f; for (int i = 0; i < 4; ++i) gs += __expf(g[i] - g[gi]);
            const float ggate = 1.0f / gs;
            float e[8]; for (int i = 0; i < 8; ++i) e[i] = l[4 + gi * 8 + i] + p.in[39][L * 32 + gi * 8 + i];
            int i0 = 0; for (int i = 1; i < 8; ++i) if (e[i] > e[i0]) i0 = i;
            int i1 = (i0 == 0) ? 1 : 0; for (int i = 0; i < 8; ++i) if (i != i0 && e[i] > e[i1]) i1 = i;
            const float p1 = __expf(e[i1] - e[i0]);
            const float w0 = ggate / (1.0f + p1), w1 = ggate * p1 / (1.0f + p1);
            const int e0 = gi * 8 + i0, e1 = gi * 8 + i1;
            const int pos0 = atomicAdd(&cnt[e0], 1), pos1 = atomicAdd(&cnt[e1], 1);
            list[e0 * LIST_CAP + pos0] = 2 * row; list[e1 * LIST_CAP + pos1] = 2 * row + 1;
            wgt[2 * row] = w0; wgt[2 * row + 1] = w1;
        }
        asm volatile("s_waitcnt lgkmcnt(0)" ::: "memory");
    }
}

__device__ __forceinline__ int perm64(int r) { return (r & 64) | (((r >> 2) & 3) << 4) | (((r >> 4) & 3) << 2) | (r & 3); }
__device__ __forceinline__ bool tile_permuted(int mode, int nt) { return (mode <= MODE_SIGM) || (mode == MODE_ML1 && nt < 24) || (mode == MODE_RT1 && nt >= 16); }
__device__ __forceinline__ void store16(bf16_t* d, const f32x4 (&v)[4]) {
    gst_u4(d, cvt_pk(v[0][0], v[0][1]), cvt_pk(v[0][2], v[0][3]), cvt_pk(v[1][0], v[1][1]), cvt_pk(v[1][2], v[1][3]));
    gst_u4(d + 8, cvt_pk(v[2][0], v[2][1]), cvt_pk(v[2][2], v[2][3]), cvt_pk(v[3][0], v[3][1]), cvt_pk(v[3][2], v[3][3]));
}
__device__ __forceinline__ void gemm_epilogue(PRef p, const GJob& jb, int mt, int nt, const f32x4 (&acc)[4][4]) {
    const int t_ = tidx(); const int lane = t_ & 63, wid = t_ >> 6, wr = wid >> 1, wc = wid & 1, fr = lane & 15, fq = lane >> 4;
    const int row0 = mt * 128 + wr * 64 + fr;
    if (jb.mode <= MODE_SIGM) {
        const int col = nt * 128 + wc * 64 + fq * 16;
        if (col < jb.N) {
#pragma unroll
            for (int m = 0; m < 4; ++m) {
                f32x4 v[4];
#pragma unroll
                for (int n = 0; n < 4; ++n) {
                    v[n] = acc[m][n];
                    if (jb.mode == MODE_TANH) { v[n][0] = tanhf_(v[n][0]); v[n][1] = tanhf_(v[n][1]); v[n][2] = tanhf_(v[n][2]); v[n][3] = tanhf_(v[n][3]); }
                    else if (jb.mode == MODE_SIGM) { v[n][0] = sigmoidf_(v[n][0]); v[n][1] = sigmoidf_(v[n][1]); v[n][2] = sigmoidf_(v[n][2]); v[n][3] = sigmoidf_(v[n][3]); }
                }
                store16(jb.out + (size_t)(row0 + m * 16) * jb.ldo + col, v);
            }
        }
    } else if (jb.mode == MODE_ML1) {
        if (nt < 24) {
            bf16_t* ob = (bf16_t*)(p.ws + OFF_SLOT + (size_t)(1 + (nt >> 3)) * SLOT);
            const bool sg = (nt >= 16);
            const int col = (nt & 7) * 128 + wc * 64 + fq * 16;
#pragma unroll
            for (int m = 0; m < 4; ++m) {
                f32x4 v[4];
#pragma unroll
                for (int n = 0; n < 4; ++n) {
                    v[n] = acc[m][n];
                    if (sg) { v[n][0] = sigmoidf_(v[n][0]); v[n][1] = sigmoidf_(v[n][1]); v[n][2] = sigmoidf_(v[n][2]); v[n][3] = sigmoidf_(v[n][3]); }
                }
                store16(ob + (size_t)(row0 + m * 16) * 1024 + col, v);
            }
        } else if (wc == 0) {
            float* gates = (float*)(p.ws + OFF_GATES);
            const float* bg = p.in[26];
            const int c0 = fq * 4;
#pragma unroll
            for (int m = 0; m < 4; ++m) {
                f32x4 v = acc[m][0], o;
#pragma unroll
                for (int j = 0; j < 4; ++j) { const float g = v[j] + bg[c0 + j]; o[j] = (c0 + j < 8) ? g : -softplusf_(-g); }
                gst_f4(gates + (size_t)(row0 + m * 16) * 16 + c0, o[0], o[1], o[2], o[3]);
            }
        }
    } else {
        if (nt < 16) {
            const float* rot = (const float*)(p.ws + OFF_ROT);
            bf16_t* ob = (bf16_t*)(p.ws + OFF_SLOT + (size_t)(1 + (nt >> 3)) * SLOT);
            const float scl = (nt >= 8) ? 0.0625f : 1.0f;
#pragma unroll
            for (int pp = 0; pp < 2; ++pp) {
                const int blk32 = (nt & 7) * 4 + wc * 2 + pp, head = blk32 >> 3, i0 = (blk32 & 7) * 16 + fq * 4;
                float4 rc0[4], rc1[4];
#pragma unroll
                for (int m = 0; m < 4; ++m) { const int tt = (row0 + m * 16) & 2047; rc0[m] = gld_f4(rot + ((size_t)tt * 128 + i0) * 2); rc1[m] = gld_f4(rot + ((size_t)tt * 128 + i0) * 2 + 4); }
#pragma unroll
                for (int m = 0; m < 4; ++m) {
                    const int row = row0 + m * 16;
                    const float4 c0 = rc0[m], c1 = rc1[m];
                    const float cs[4] = {c0.x, c0.z, c1.x, c1.z}, sn[4] = {c0.y, c0.w, c1.y, c1.w};
                    const f32x4 x1 = acc[m][2 * pp], x2 = acc[m][2 * pp + 1];
                    float o1[4], o2[4];
#pragma unroll
                    for (int j = 0; j < 4; ++j) { o1[j] = (x1[j] * cs[j] - x2[j] * sn[j]) * scl; o2[j] = (x1[j] * sn[j] + x2[j] * cs[j]) * scl; }
                    gst_u2(ob + (size_t)row * 1024 + head * 256 + i0, cvt_pk(o1[0], o1[1]), cvt_pk(o1[2], o1[3]));
                    gst_u2(ob + (size_t)row * 1024 + head * 256 + 128 + i0, cvt_pk(o2[0], o2[1]), cvt_pk(o2[2], o2[3]));
                }
            }
        } else {
            const bool isg = (nt >= 32);
            bf16_t* ob = (bf16_t*)(p.ws + OFF_SLOT + (size_t)(isg ? 5 : 3) * SLOT);
            const int col = (nt & 15) * 128 + wc * 64 + fq * 16;
#pragma unroll
            for (int m = 0; m < 4; ++m) {
                f32x4 v[4];
#pragma unroll
                for (int n = 0; n < 4; ++n) {
                    v[n] = acc[m][n];
                    if (isg) { v[n][0] = siluf_(v[n][0]); v[n][1] = siluf_(v[n][1]); v[n][2] = siluf_(v[n][2]); v[n][3] = siluf_(v[n][3]); }
                }
                store16(ob + (size_t)(row0 + m * 16) * 2048 + col, v);
            }
        }
    }
}
__device__ __forceinline__ void phase_gemm_jobs(PRef p, char* lds, int jlo, int jhi) {
    const int total = p.gj[jhi - 1].tile0 + 128 * p.gj[jhi - 1].ntn - p.gj[jlo].tile0;
    for (int id = blockIdx.x; id < total; id += gridDim.x) {
        int j = jlo; const int gid = id + p.gj[jlo].tile0;
        while (j + 1 < jhi && gid >= p.gj[j + 1].tile0) ++j;
        GJob jb; jb.A = p.gj[j].A; jb.Bt = p.gj[j].Bt; jb.out = p.gj[j].out; jb.K = p.gj[j].K; jb.N = p.gj[j].N; jb.ldo = p.gj[j].ldo; jb.mode = p.gj[j].mode; jb.ntn = p.gj[j].ntn; jb.tile0 = p.gj[j].tile0;
        jb.half = p.gj[j].half;
        int mt, nt; tile_map(gid - jb.tile0, jb.ntn, mt, nt);
        if (jb.half || (jb.mode == MODE_ML1 && nt == 24)) {
            const int t_ = tidx(), r0_ = t_ >> 3, co_ = glds_chunk(t_) * 8, ln_ = t_ & 63, wv_ = t_ >> 6, fr_ = ln_ & 15, fq_ = ln_ >> 4;
            const int cb = jb.half ? nt * 64 : nt * 128;
            int nvh = jb.N - cb; nvh = nvh > 64 ? 64 : nvh;
            const bf16_t* ar[4]; const bf16_t* brh[2];
#pragma unroll
            for (int i = 0; i < 4; ++i) ar[i] = jb.A + (size_t)(mt * 128 + r0_ + 32 * i) * jb.K + co_;
#pragma unroll
            for (int i = 0; i < 2; ++i) { int rb_ = r0_ + 32 * i; rb_ = jb.half ? perm64(rb_) : rb_; rb_ = rb_ < nvh ? rb_ : nvh - 1; brh[i] = jb.Bt + (size_t)(cb + rb_) * jb.K + co_; }
            f32x4 ah[2][4];
            gemm_hn(lds, jb.K / 64, ar, brh, ah);
            const int rowh = mt * 128 + wv_ * 32 + fr_;
            if (jb.half) {
                const int col = cb + fq_ * 16;
                if (col < jb.N) {
#pragma unroll
                    for (int m = 0; m < 2; ++m) {
                        f32x4 v[4];
#pragma unroll
                        for (int n = 0; n < 4; ++n) {
                            v[n] = ah[m][n];
#pragma unroll
                            for (int jj = 0; jj < 4; ++jj) v[n][jj] = (jb.mode == MODE_TANH) ? tanhf_(v[n][jj]) : (jb.mode == MODE_SIGM) ? sigmoidf_(v[n][jj]) : v[n][jj];
                        }
                        store16(jb.out + (size_t)(rowh + m * 16) * jb.ldo + col, v);
                    }
                }
            } else {
                float* gates = (float*)(p.ws + OFF_GATES);
                const float* bg = p.in[26];
                const int c0 = fq_ * 4;
                const float4 bq = gld_f4(bg + c0);
                const float bqa[4] = {bq.x, bq.y, bq.z, bq.w};
#pragma unroll
                for (int m = 0; m < 2; ++m) {
                    float o[4];
#pragma unroll
                    for (int jj = 0; jj < 4; ++jj) { const float g = ah[m][0][jj] + bqa[jj]; o[jj] = (c0 + jj < 8) ? g : -softplusf_(-g); }
                    gst_f4(gates + (size_t)(rowh + m * 16) * 16 + c0, o[0], o[1], o[2], o[3]);
                }
            }
            continue;
        }
        int nv = jb.N - nt * 128; nv = nv > 128 ? 128 : nv;
        const bf16_t* ar[4]; const bf16_t* br[4];
        {
            const int t_ = tidx(), r0_ = t_ >> 3, co_ = glds_chunk(t_) * 8;
            const bool pm_ = tile_permuted(jb.mode, nt);
#pragma unroll
            for (int i = 0; i < 4; ++i) {
                ar[i] = jb.A + (size_t)(mt * 128 + r0_ + 32 * i) * jb.K + co_;
                int rb_ = r0_ + 32 * i; rb_ = pm_ ? perm64(rb_) : rb_; rb_ = rb_ < nv ? rb_ : nv - 1;
                br[i] = jb.Bt + (size_t)(nt * 128 + rb_) * jb.K + co_;
            }
        }
        f32x4 acc[4][4];
        gemm_gg(lds, jb.K / 64, ar, br, acc);
        gemm_epilogue(p, jb, mt, nt, acc);
    }
}

constexpr int RM = 4;
template <int KL>
__device__ __forceinline__ void minigemm(const bf16_t* A, const bf16_t* Bt, int fr, int fq, f32x4 (&acc)[RM][4]) {
#pragma unroll
    for (int m = 0; m < RM; ++m)
#pragma unroll
        for (int n = 0; n < 4; ++n) acc[m][n] = (f32x4){0.f, 0.f, 0.f, 0.f};
#pragma unroll 2
    for (int ks = 0; ks < KL / 32; ++ks) {
        uint4 af[RM], bfm[4];
#pragma unroll
        for (int m = 0; m < RM; ++m) af[m] = gld_u4(A + (size_t)(m * 16 + fr) * KL + ks * 32 + fq * 8);
#pragma unroll
        for (int n = 0; n < 4; ++n) bfm[n] = gld_u4(Bt + (size_t)((fr >> 2) * 16 + n * 4 + (fr & 3)) * KL + ks * 32 + fq * 8);
#pragma unroll
        for (int m = 0; m < RM; ++m)
#pragma unroll
            for (int n = 0; n < 4; ++n) acc[m][n] = mfma16(bfm[n], af[m], acc[m][n]);
    }
}
__device__ __forceinline__ void phase_rw2(PRef p, int jr) {
    const int t_ = tidx(); const int lane = t_ & 63, wid = t_ >> 6, wr = wid >> 1, wc = wid & 1, fr = lane & 15, fq = lane >> 4;
    char* S = p.ws + OFF_SLOT;
    float* decay = (float*)S; bf16_t* nkk = (bf16_t*)(S + 2 * SLOT); bf16_t* bb = (bf16_t*)(S + 3 * SLOT); bf16_t* gb = (bf16_t*)(S + 4 * SLOT);
    const bf16_t* rb = (const bf16_t*)(S + 6 * SLOT); const bf16_t* kb = (const bf16_t*)(S + 7 * SLOT); bf16_t* kpb = (bf16_t*)(S + 10 * SLOT);
    const bf16_t* vb = (const bf16_t*)(S + 8 * SLOT); bf16_t* vpb = (bf16_t*)(S + 9 * SLOT); const bf16_t* vf = (const bf16_t*)(S + 11 * SLOT);
    float* bonus = (float*)(p.ws + OFF_BONUS);
    const bf16_t* Lw = (const bf16_t*)(p.ws + OFF_LW); const bf16_t* La = (const bf16_t*)(p.ws + OFF_LA);
    const bf16_t* Lg = (const bf16_t*)(p.ws + OFF_LG); const bf16_t* Lv = (const bf16_t*)(p.ws + OFF_LV);
    const bf16_t* w2t = (const bf16_t*)(p.ws + W_W2T) + (size_t)jr * 1024 * 64; const bf16_t* a2t = (const bf16_t*)(p.ws + W_A2T) + (size_t)jr * 1024 * 64;
    const bf16_t* g2t = (const bf16_t*)(p.ws + W_G2T) + (size_t)jr * 1024 * 128; const bf16_t* v2t = (const bf16_t*)(p.ws + W_V2T);
    const float* w0 = p.in[8] + jr * 1024; const float* a0 = p.in[11] + jr * 1024; const float* v0 = p.in[14];
    const float* kkw = p.in[19] + jr * 1024; const float* kaw = p.in[20] + jr * 1024; const float* rk = p.in[21] + jr * 1024;
    for (int id2 = blockIdx.x; id2 < 128 * 8; id2 += gridDim.x) {
        int mt, nt; tile_map(id2, 8, mt, nt);
        const int row0 = mt * 128 + wr * 64, col0 = nt * 128 + wc * 64, head = nt * 2 + wc;
        f32x4 acc[RM][4];
        const int c0 = col0 + fq * 16;
        minigemm<64>(La + (size_t)row0 * 64, a2t + (size_t)col0 * 64, fr, fq, acc);
        float ss[RM], bs[RM];
#pragma unroll
        for (int m = 0; m < RM; ++m) { ss[m] = 0.f; bs[m] = 0.f; }
#pragma unroll
        for (int m = 0; m < RM; ++m) {
            const size_t off = (size_t)(row0 + m * 16 + fr) * 1024 + c0;
            const uint4 kq0 = *(const uint4*)(kb + off), kq1 = *(const uint4*)(kb + off + 8);
            const unsigned kw[8] = {kq0.x, kq0.y, kq0.z, kq0.w, kq1.x, kq1.y, kq1.z, kq1.w};
#pragma unroll
            for (int n = 0; n < 4; ++n) {
                const float4 a0v = *(const float4*)(a0 + c0 + n * 4), kkv = *(const float4*)(kkw + c0 + n * 4);
                const float a0a[4] = {a0v.x, a0v.y, a0v.z, a0v.w}, kka[4] = {kkv.x, kkv.y, kkv.z, kkv.w};
                const float kf4[4] = {bflo(kw[n * 2]), bfhi(kw[n * 2]), bflo(kw[n * 2 + 1]), bfhi(kw[n * 2 + 1])};
#pragma unroll
                for (int j = 0; j < 4; ++j) { acc[m][n][j] = sigmoidf_(a0a[j] + acc[m][n][j]); const float q = kf4[j] * kka[j]; ss[m] += q * q; }
            }
            asm volatile("" ::: "memory");
        }
#pragma unroll
        for (int m = 0; m < RM; ++m) { ss[m] = xor16_add(ss[m]); ss[m] = xor32_add(ss[m]); ss[m] = fminf(__builtin_amdgcn_rsqf(ss[m]), 1e12f); }
        float4 kkq[4], kaq[4], rkq[4];
#pragma unroll
        for (int n = 0; n < 4; ++n) { kkq[n] = gld_f4(kkw + c0 + n * 4); kaq[n] = gld_f4(kaw + c0 + n * 4); rkq[n] = gld_f4(rk + c0 + n * 4); }
#pragma unroll
        for (int m = 0; m < RM; ++m) {
            const size_t off = (size_t)(row0 + m * 16 + fr) * 1024 + c0;
            const uint4 rq0 = *(const uint4*)(rb + off), rq1 = *(const uint4*)(rb + off + 8), kq0 = *(const uint4*)(kb + off), kq1 = *(const uint4*)(kb + off + 8);
            const unsigned kw[8] = {kq0.x, kq0.y, kq0.z, kq0.w, kq1.x, kq1.y, kq1.z, kq1.w};
            const unsigned rw[8] = {rq0.x, rq0.y, rq0.z, rq0.w, rq1.x, rq1.y, rq1.z, rq1.w};
            unsigned okp[8], onk[8], obb[8];
#pragma unroll
            for (int n = 0; n < 4; ++n) {
                const float kka[4] = {kkq[n].x, kkq[n].y, kkq[n].z, kkq[n].w}, kaa[4] = {kaq[n].x, kaq[n].y, kaq[n].z, kaq[n].w}, rka[4] = {rkq[n].x, rkq[n].y, rkq[n].z, rkq[n].w};
                const float rf[4] = {bflo(rw[n * 2]), bfhi(rw[n * 2]), bflo(rw[n * 2 + 1]), bfhi(rw[n * 2 + 1])}, kf4[4] = {bflo(kw[n * 2]), bfhi(kw[n * 2]), bflo(kw[n * 2 + 1]), bfhi(kw[n * 2 + 1])};
                float kp[4], nk[4], b4[4];
#pragma unroll
                for (int j = 0; j < 4; ++j) {
                    const float a = acc[m][n][j], k = kf4[j], kn = k * kka[j] * ss[m];
                    kp[j] = k * (1.0f + (a - 1.0f) * kaa[j]); nk[j] = -kn; b4[j] = kn * a; bs[m] += rf[j] * kp[j] * rka[j];
                }
                okp[n * 2] = cvt_pk(kp[0], kp[1]); okp[n * 2 + 1] = cvt_pk(kp[2], kp[3]);
                onk[n * 2] = cvt_pk(nk[0], nk[1]); onk[n * 2 + 1] = cvt_pk(nk[2], nk[3]);
                obb[n * 2] = cvt_pk(b4[0], b4[1]); obb[n * 2 + 1] = cvt_pk(b4[2], b4[3]);
            }
            *(uint4*)(kpb + off) = make_uint4(okp[0], okp[1], okp[2], okp[3]); *(uint4*)(kpb + off + 8) = make_uint4(okp[4], okp[5], okp[6], okp[7]);
            *(uint4*)(nkk + off) = make_uint4(onk[0], onk[1], onk[2], onk[3]); *(uint4*)(nkk + off + 8) = make_uint4(onk[4], onk[5], onk[6], onk[7]);
            *(uint4*)(bb + off) = make_uint4(obb[0], obb[1], obb[2], obb[3]); *(uint4*)(bb + off + 8) = make_uint4(obb[4], obb[5], obb[6], obb[7]);
            asm volatile("" ::: "memory");
        }
#pragma unroll
        for (int m = 0; m < RM; ++m) { bs[m] = xor16_add(bs[m]); bs[m] = xor32_add(bs[m]); if (fq == 0) bonus[(size_t)(row0 + m * 16 + fr) * 16 + head] = bs[m]; }
        minigemm<64>(Lw + (size_t)row0 * 64, w2t + (size_t)col0 * 64, fr, fq, acc);
        float4 w0q[4];
#pragma unroll
        for (int n = 0; n < 4; ++n) w0q[n] = gld_f4(w0 + c0 + n * 4);
#pragma unroll
        for (int n = 0; n < 4; ++n) {
            const float w0a[4] = {w0q[n].x, w0q[n].y, w0q[n].z, w0q[n].w};
#pragma unroll
            for (int m = 0; m < RM; ++m) {
                f32x4 o;
#pragma unroll
                for (int j = 0; j < 4; ++j) { const float wl = -softplusf_(-(w0a[j] + acc[m][n][j])) - 0.5f; o[j] = __expf(-__expf(wl)); }
                *(f32x4*)(decay + (size_t)(row0 + m * 16 + fr) * 1024 + c0 + n * 4) = o;
            }
        }
        minigemm<128>(Lg + (size_t)row0 * 128, g2t + (size_t)col0 * 128, fr, fq, acc);
#pragma unroll
        for (int m = 0; m < RM; ++m) {
            unsigned o[8];
#pragma unroll
            for (int n = 0; n < 4; ++n) { o[n * 2] = cvt_pk(acc[m][n][0], acc[m][n][1]); o[n * 2 + 1] = cvt_pk(acc[m][n][2], acc[m][n][3]); }
            bf16_t* d = gb + (size_t)(row0 + m * 16 + fr) * 1024 + c0;
            *(uint4*)d = make_uint4(o[0], o[1], o[2], o[3]); *(uint4*)(d + 8) = make_uint4(o[4], o[5], o[6], o[7]);
        }
        if (jr > 0) {
            minigemm<32>(Lv + (size_t)row0 * 32, v2t + (size_t)col0 * 32, fr, fq, acc);
#pragma unroll
            for (int m = 0; m < RM; ++m) {
                const size_t off = (size_t)(row0 + m * 16 + fr) * 1024 + c0;
                const uint4 vq0 = *(const uint4*)(vb + off), vq1 = *(const uint4*)(vb + off + 8), fq0 = *(const uint4*)(vf + off), fq1 = *(const uint4*)(vf + off + 8);
                const unsigned vw[8] = {vq0.x, vq0.y, vq0.z, vq0.w, vq1.x, vq1.y, vq1.z, vq1.w}, fw[8] = {fq0.x, fq0.y, fq0.z, fq0.w, fq1.x, fq1.y, fq1.z, fq1.w};
                unsigned o[8];
#pragma unroll
                for (int n = 0; n < 4; ++n) {
                    const float4 v0v = *(const float4*)(v0 + c0 + n * 4); const float v0a[4] = {v0v.x, v0v.y, v0v.z, v0v.w};
                    const float v4[4] = {bflo(vw[n * 2]), bfhi(vw[n * 2]), bflo(vw[n * 2 + 1]), bfhi(vw[n * 2 + 1])}, f4[4] = {bflo(fw[n * 2]), bfhi(fw[n * 2]), bflo(fw[n * 2 + 1]), bfhi(fw[n * 2 + 1])};
                    float o4[4];
#pragma unroll
                    for (int j = 0; j < 4; ++j) o4[j] = v4[j] + (f4[j] - v4[j]) * sigmoidf_(v0a[j] + acc[m][n][j]);
                    o[n * 2] = cvt_pk(o4[0], o4[1]); o[n * 2 + 1] = cvt_pk(o4[2], o4[3]);
                }
                *(uint4*)(vpb + off) = make_uint4(o[0], o[1], o[2], o[3]); *(uint4*)(vpb + off + 8) = make_uint4(o[4], o[5], o[6], o[7]);
            }
        }
    }
}
__device__ __forceinline__ void phase_rw3(PRef p, int jr, char* lds) {
    const int t = tidx(), lane = t & 63, wid = t >> 6, rowq = lane >> 4, jq = lane & 15;
    char* S = p.ws + OFF_SLOT;
    const float* decay = (const float*)S; const bf16_t* nkk = (const bf16_t*)(S + 2 * SLOT); const bf16_t* bb = (const bf16_t*)(S + 3 * SLOT);
    const bf16_t* rb = (const bf16_t*)(S + 6 * SLOT); const bf16_t* kb = (const bf16_t*)(S + 10 * SLOT);
    const bf16_t* vb = (const bf16_t*)(S + (jr == 0 ? 11 : 9) * SLOT); bf16_t* yb = (bf16_t*)(S + 5 * SLOT);
    float* buf = (float*)lds;
    float* ybuf = (float*)(lds + 2 * 16 * 336 * 4);
    for (int item = blockIdx.x; item < 512; item += gridDim.x) {
        const int bh = item >> 2, rg = item & 3, b = bh >> 4, h = bh & 15;
        const size_t base = (size_t)b * 2048 * 1024 + h * 64;
        const bf16_t* vecp[2]; int vdst[2];
#pragma unroll
        for (int u = 0; u < 2; ++u) {
            const int id = t + 256 * u, vec = id >> 7, rem = id & 127, step = rem >> 3, c8 = rem & 7;
            const bf16_t* bp = (vec == 0) ? nkk : (vec == 1) ? bb : (vec == 2) ? kb : rb;
            vecp[u] = bp + base + (size_t)step * 1024 + c8 * 8; vdst[u] = step * 336 + 64 + vec * 64 + c8 * 8;
        }
        const float* dp = decay + base + (size_t)(t >> 4) * 1024 + (t & 15) * 4; const int ddst = (t >> 4) * 336 + (t & 15) * 4;
        const bf16_t* vp = vb + base + (size_t)(t >> 1) * 1024 + rg * 16 + (t & 1) * 8; const int vvdst = (t >> 1) * 336 + 320 + (t & 1) * 8;
        uint4 g0, g1, gv; float4 gd;
        auto fetch = [&](int ch) {
            const size_t o = (size_t)ch * 16 * 1024;
            g0 = gload16(vecp[0] + o); g1 = gload16(vecp[1] + o);
            { const uint4 d_ = gload16(dp + o); gd = make_float4(__uint_as_float(d_.x), __uint_as_float(d_.y), __uint_as_float(d_.z), __uint_as_float(d_.w)); }
            if (t < 32) gv = gload16(vp + o);
        };
        auto stash = [&](float* bf) {
            float f[8];
            unpack8(g0, f); *(float4*)(bf + vdst[0]) = make_float4(f[0], f[1], f[2], f[3]); *(float4*)(bf + vdst[0] + 4) = make_float4(f[4], f[5], f[6], f[7]);
            unpack8(g1, f); *(float4*)(bf + vdst[1]) = make_float4(f[0], f[1], f[2], f[3]); *(float4*)(bf + vdst[1] + 4) = make_float4(f[4], f[5], f[6], f[7]);
            *(float4*)(bf + ddst) = gd;
            if (t < 32) { unpack8(gv, f); *(float4*)(bf + vvdst) = make_float4(f[0], f[1], f[2], f[3]); *(float4*)(bf + vvdst + 4) = make_float4(f[4], f[5], f[6], f[7]); }
        };
        float s0 = 0.f, s1 = 0.f, s2 = 0.f, s3 = 0.f;
        __syncthreads();
        fetch(0); stash(buf); __syncthreads();
        for (int ch = 0; ch < 128; ++ch) {
            if (ch + 1 < 128) fetch(ch + 1);
            const float* bf = buf + (ch & 1) * (16 * 336); float* yb_ = ybuf + (ch & 1) * 256;
            float ykeep = 0.f;
            const float* q0 = bf + jq * 4; const float* v0p = bf + 320 + wid * 4 + rowq;
            float4 nw = *(const float4*)q0, na = *(const float4*)(q0 + 64), nb2 = *(const float4*)(q0 + 128), nk = *(const float4*)(q0 + 192), nr = *(const float4*)(q0 + 256);
            float nv = v0p[0];
#pragma unroll 4
            for (int s = 0; s < 16; ++s) {
                const float4 w = nw, a = na, bq = nb2, k = nk, r = nr; const float vv = nv;
                const float* q = q0 + (s + 1) * 336;
                nw = *(const float4*)q; na = *(const float4*)(q + 64); nb2 = *(const float4*)(q + 128); nk = *(const float4*)(q + 192); nr = *(const float4*)(q + 256);
                nv = v0p[(s + 1) * 336];
                __builtin_amdgcn_sched_barrier(0);
                float sa = s0 * a.x; sa = fmaf(s1, a.y, sa); sa = fmaf(s2, a.z, sa); sa = fmaf(s3, a.w, sa);
                sa = row16_sum(sa);
                s0 = fmaf(s0, w.x, fmaf(sa, bq.x, vv * k.x)); s1 = fmaf(s1, w.y, fmaf(sa, bq.y, vv * k.y));
                s2 = fmaf(s2, w.z, fmaf(sa, bq.z, vv * k.z)); s3 = fmaf(s3, w.w, fmaf(sa, bq.w, vv * k.w));
                float y = s0 * r.x; y = fmaf(s1, r.y, y); y = fmaf(s2, r.z, y); y = fmaf(s3, r.w, y);
                y = row16_sum(y);
                ykeep = (jq == s) ? y : ykeep;
            }
            yb_[jq * 16 + wid * 4 + rowq] = ykeep;
            if (ch + 1 < 128) stash(buf + ((ch + 1) & 1) * (16 * 336));
            __syncthreads();
            if (t < 32) { const int step = t >> 1, hf = t & 1; float f[8];
#pragma unroll
                for (int i = 0; i < 8; ++i) f[i] = yb_[step * 16 + hf * 8 + i];
                *(uint4*)(yb + base + (size_t)(ch * 16 + step) * 1024 + rg * 16 + hf * 8) = pack8(f); }
        }
    }
}
__device__ __forceinline__ uint2 lds_tr16(const char* p) {
    typedef short v4s_t __attribute__((ext_vector_type(4)));
    const v4s_t r = __builtin_amdgcn_ds_read_tr16_b64_v4i16((LAS v4s_t*)p);
    uint2 u; __builtin_memcpy(&u, &r, 8); return u;
}
__device__ __forceinline__ int sw64(int row, int col) { return row * 128 + ((((col >> 3) ^ (row & 7))) << 4) + (col & 7) * 2; }
__device__ __forceinline__ void phase_rw3c(PRef p, int jr, char* lds) {
    const int t = tidx(), lane = t & 63, w = t >> 6, fr = lane & 15, fq = lane >> 4;
    char* S = p.ws + OFF_SLOT;
    const float* decay = (const float*)S; const bf16_t* nkk = (const bf16_t*)(S + 2 * SLOT); const bf16_t* bb = (const bf16_t*)(S + 3 * SLOT);
    const bf16_t* rb = (const bf16_t*)(S + 6 * SLOT); const bf16_t* kb = (const bf16_t*)(S + 10 * SLOT);
    const bf16_t* vb = (const bf16_t*)(S + (jr == 0 ? 11 : 9) * SLOT); bf16_t* yb = (bf16_t*)(S + 5 * SLOT);
    char* const AT = lds;              char* const RT = lds + 4096;  char* const BT = lds + 8192;  char* const KT = lds + 12288;
    float* const PL = (float*)(lds + 16384);
    float* const GAB = (float*)(lds + 43264);
    char* const GAK = lds + 28672;     char* const GRB = lds + 30720; char* const GRK = lds + 32768;
    char* const VT = lds + 34816;      char* const UT = lds + 35840;
    char* const SB = lds + 36864;
    float* const XL = (float*)(lds + 38912);
    float* const PC = (float*)(lds + 40960);
    float* const GS = (float*)(lds + 41216);
    bf16_t* const YB = (bf16_t*)(lds + 42240);
    const int pj = t & 63, ptg = t >> 6;
    const int tk = t >> 3, ck = t & 7;
    const int vtau = t >> 3, vi2 = (t & 7) * 2;
    const int qq = fr >> 2, pp = fr & 3;
    for (int item = blockIdx.x; item < 512; item += gridDim.x) {
        const int bh = ((item >> 3) >> 2) * 8 + (item & 7), rg = (item >> 3) & 3, b = bh >> 4, h = bh & 15;
        const size_t base = (size_t)b * 2048 * 1024 + h * 64;
        __syncthreads();
        for (int i = t; i < 128; i += 256) *(uint4*)(SB + i * 16) = make_uint4(0u, 0u, 0u, 0u);
        f32x4 Sacc = (f32x4){0.f, 0.f, 0.f, 0.f};
        float gw[8]; uint4 ra, rb4, rk, rr, rw0, rw1; unsigned gvv = 0;
        auto fetch = [&](int c) {
#pragma unroll
            for (int s2 = 0; s2 < 8; ++s2) gw[s2] = *(const __attribute__((address_space(1))) float*)(decay + base + (size_t)(c * 32 + ptg * 8 + s2) * 1024 + pj);
            const size_t o = base + (size_t)(c * 32 + tk) * 1024 + ck * 8;
            ra = gload16(nkk + o); rb4 = gload16(bb + o); rk = gload16(kb + o); rr = gload16(rb + o); rw0 = gload16(decay + o); rw1 = gload16(decay + o + 4);
            gvv = *(const __attribute__((address_space(1))) unsigned*)(vb + base + (size_t)(c * 32 + vtau) * 1024 + rg * 16 + vi2);
        };
        fetch(0);
        for (int c = 0; c < 64; ++c) {
            {
                float cum[8]; float run = 1.f;
#pragma unroll
                for (int s2 = 0; s2 < 8; ++s2) { run *= gw[s2]; cum[s2] = run; }
                GS[ptg * 64 + pj] = run;
                __syncthreads();
                const float g0 = GS[pj], g1 = GS[64 + pj], g2 = GS[128 + pj], g3 = GS[192 + pj];
                const float off = (ptg > 0 ? g0 : 1.f) * (ptg > 1 ? g1 : 1.f) * (ptg > 2 ? g2 : 1.f);
                if (ptg == 0) PC[pj] = (g0 * g1) * (g2 * g3);
#pragma unroll
                for (int s2 = 0; s2 < 8; ++s2) PL[(ptg * 8 + s2) * 64 + pj] = off * cum[s2];
            }
            __syncthreads();
            {
                const float4 p0 = *(const float4*)(PL + tk * 64 + ck * 8), p1 = *(const float4*)(PL + tk * 64 + ck * 8 + 4);
                const unsigned ua[4] = {ra.x, ra.y, ra.z, ra.w}, ub[4] = {rb4.x, rb4.y, rb4.z, rb4.w}, uk[4] = {rk.x, rk.y, rk.z, rk.w}, ur[4] = {rr.x, rr.y, rr.z, rr.w};
                const f32x2_t Pp[4] = {{p0.x, p0.y}, {p0.z, p0.w}, {p1.x, p1.y}, {p1.z, p1.w}};
                const f32x2_t Wp[4] = {{__uint_as_float(rw0.x), __uint_as_float(rw0.y)}, {__uint_as_float(rw0.z), __uint_as_float(rw0.w)}, {__uint_as_float(rw1.x), __uint_as_float(rw1.y)}, {__uint_as_float(rw1.z), __uint_as_float(rw1.w)}};
                unsigned oa[4], orr[4], ob[4], ok[4];
#pragma unroll
                for (int i = 0; i < 4; ++i) {
                    const f32x2_t ei = {__builtin_amdgcn_rcpf(Pp[i].x), __builtin_amdgcn_rcpf(Pp[i].y)};
                    const f32x2_t rw = {__builtin_amdgcn_rcpf(Wp[i].x), __builtin_amdgcn_rcpf(Wp[i].y)};
                    const f32x2_t ex = Pp[i] * rw;
                    const f32x2_t va = {__uint_as_float(ua[i] << 16), __uint_as_float(ua[i] & 0xffff0000u)}, vr = {__uint_as_float(ur[i] << 16), __uint_as_float(ur[i] & 0xffff0000u)};
                    const f32x2_t vb2 = {__uint_as_float(ub[i] << 16), __uint_as_float(ub[i] & 0xffff0000u)}, vk = {__uint_as_float(uk[i] << 16), __uint_as_float(uk[i] & 0xffff0000u)};
                    const f32x2_t xa = va * ex, xr = vr * Pp[i], xb = vb2 * ei, xk = vk * ei;
                    oa[i] = cvt_pk(xa.x, xa.y); orr[i] = cvt_pk(xr.x, xr.y); ob[i] = cvt_pk(xb.x, xb.y); ok[i] = cvt_pk(xk.x, xk.y);
                }
                const int o = tk * 128 + ((ck ^ (tk & 7)) << 4);
                *(uint4*)(AT + o) = make_uint4(oa[0], oa[1], oa[2], oa[3]); *(uint4*)(RT + o) = make_uint4(orr[0], orr[1], orr[2], orr[3]);
                *(uint4*)(BT + o) = make_uint4(ob[0], ob[1], ob[2], ob[3]); *(uint4*)(KT + o) = make_uint4(ok[0], ok[1], ok[2], ok[3]);
                *(bf16_t*)(VT + vi2 * 64 + vtau * 2) = (bf16_t)(gvv & 0xffffu);
                *(bf16_t*)(VT + (vi2 + 1) * 64 + vtau * 2) = (bf16_t)(gvv >> 16);
            }
            if (c + 1 < 64) fetch(c + 1);
            __syncthreads();
            {
                const char* Mt = (w < 2) ? AT : RT; const char* Nt = (w & 1) ? BT : KT;
                f32x4 g[2][2];
#pragma unroll
                for (int m = 0; m < 2; ++m) { g[m][0] = (f32x4){0.f, 0.f, 0.f, 0.f}; g[m][1] = (f32x4){0.f, 0.f, 0.f, 0.f}; }
#pragma unroll
                for (int ks = 0; ks < 2; ++ks) {
                    const int chs = ((ks * 4 + fq) ^ (fr & 7)) << 4;
                    uint4 mf[2], nf[2];
#pragma unroll
                    for (int m = 0; m < 2; ++m) { mf[m] = *(const uint4*)(Mt + (m * 16 + fr) * 128 + chs); nf[m] = *(const uint4*)(Nt + (m * 16 + fr) * 128 + chs); }
#pragma unroll
                    for (int m = 0; m < 2; ++m)
#pragma unroll
                        for (int n = 0; n < 2; ++n) g[m][n] = mfma16(nf[n], mf[m], g[m][n]);
                }
#pragma unroll
                for (int m = 0; m < 2; ++m)
#pragma unroll
                    for (int n = 0; n < 2; ++n) {
                        const int tt = m * 16 + fr, tau0 = n * 16 + fq * 4;
                        f32x4 v4;
#pragma unroll
                        for (int j = 0; j < 4; ++j) { const int tau = tau0 + j; const bool keep = (w < 2) ? (tau < tt) : (tau <= tt); v4[j] = keep ? g[m][n][j] : 0.f; }
                        if (w == 1) *(f32x4*)(GAB + tt * 36 + tau0) = v4;
                        else {
                            char* G = (w == 0) ? GAK : (w == 2) ? GRK : GRB;
                            uint2 o; o.x = cvt_pk(v4[0], v4[1]); o.y = cvt_pk(v4[2], v4[3]);
                            *(uint2*)(G + tt * 64 + tau0 * 2) = o;
                        }
                    }
            }
            __syncthreads();
            if (w < 2) {
                f32x4 x = (f32x4){0.f, 0.f, 0.f, 0.f};
#pragma unroll
                for (int ks = 0; ks < 2; ++ks) {
                    const int chs = ((ks * 4 + fq) ^ (fr & 7)) << 4;
                    x = mfma16(*(const uint4*)(AT + (w * 16 + fr) * 128 + chs), *(const uint4*)(SB + fr * 128 + chs), x);
                }
                x = mfma16(*(const uint4*)(GAK + (w * 16 + fr) * 64 + fq * 16), *(const uint4*)(VT + fr * 64 + fq * 16), x);
                *(f32x4*)(XL + fr * 32 + w * 16 + fq * 4) = x;
            }
            __syncthreads();
            {
                const int tl = lane & 31;
                float Gr[32];
#pragma unroll
                for (int q4 = 0; q4 < 8; ++q4) { const float4 g4 = *(const float4*)(GAB + tl * 36 + q4 * 4); Gr[q4 * 4] = g4.x; Gr[q4 * 4 + 1] = g4.y; Gr[q4 * 4 + 2] = g4.z; Gr[q4 * 4 + 3] = g4.w; }
                float acc[4];
#pragma unroll
                for (int r = 0; r < 4; ++r) acc[r] = XL[(4 * w + r) * 32 + tl];
#pragma unroll
                for (int tau = 0; tau < 31; ++tau)
#pragma unroll
                    for (int r = 0; r < 4; ++r) acc[r] = fmaf(__int_as_float(__builtin_amdgcn_readlane(__float_as_int(acc[r]), tau)), Gr[tau], acc[r]);
                if (lane < 32) {
#pragma unroll
                    for (int r = 0; r < 4; ++r) *(bf16_t*)(UT + (4 * w + r) * 64 + tl * 2) = f2bf(acc[r]);
                }
            }
            __syncthreads();
            if (w < 2) {
                f32x4 y = (f32x4){0.f, 0.f, 0.f, 0.f};
#pragma unroll
                for (int ks = 0; ks < 2; ++ks) {
                    const int chs = ((ks * 4 + fq) ^ (fr & 7)) << 4;
                    y = mfma16(*(const uint4*)(RT + (w * 16 + fr) * 128 + chs), *(const uint4*)(SB + fr * 128 + chs), y);
                }
                y = mfma16(*(const uint4*)(GRB + (w * 16 + fr) * 64 + fq * 16), *(const uint4*)(UT + fr * 64 + fq * 16), y);
                y = mfma16(*(const uint4*)(GRK + (w * 16 + fr) * 64 + fq * 16), *(const uint4*)(VT + fr * 64 + fq * 16), y);
#pragma unroll
                for (int j = 0; j < 4; ++j) YB[(w * 16 + fq * 4 + j) * 16 + fr] = f2bf(y[j]);
            }
            {
                const int r0 = fq * 8 + qq, kc = 2 * w + (pp >> 1);
                const int o0 = r0 * 128 + ((kc ^ (r0 & 7)) << 4) + (pp & 1) * 8, o1 = (r0 + 4) * 128 + ((kc ^ ((r0 + 4) & 7)) << 4) + (pp & 1) * 8;
                const uint2 blo = lds_tr16(BT + o0), bhi = lds_tr16(BT + o1), klo = lds_tr16(KT + o0), khi = lds_tr16(KT + o1);
                Sacc = mfma16(make_uint4(blo.x, blo.y, bhi.x, bhi.y), *(const uint4*)(UT + fr * 64 + fq * 16), Sacc);
                Sacc = mfma16(make_uint4(klo.x, klo.y, khi.x, khi.y), *(const uint4*)(VT + fr * 64 + fq * 16), Sacc);
                const float4 pc = *(const float4*)(PC + 16 * w + fq * 4);
                Sacc[0] *= pc.x; Sacc[1] *= pc.y; Sacc[2] *= pc.z; Sacc[3] *= pc.w;
            }
            __syncthreads();
            {
                uint2 o; o.x = cvt_pk(Sacc[0], Sacc[1]); o.y = cvt_pk(Sacc[2], Sacc[3]);
                *(uint2*)(SB + fr * 128 + ((((2 * w + (fq >> 1))) ^ (fr & 7)) << 4) + (fq & 1) * 8) = o;
                if (t < 64) {
                    const int tt = t >> 1, hf = t & 1;
                    const uint4 yv_ = *(const uint4*)((const char*)YB + tt * 32 + hf * 16); const u32x4_t yx_ = {yv_.x, yv_.y, yv_.z, yv_.w};
                    *(__attribute__((address_space(1))) u32x4_t*)(yb + base + (size_t)(c * 32 + tt) * 1024 + rg * 16 + hf * 8) = yx_;
                }
            }
        }
    }
}
struct LdRw4 {
    struct Raw { uint4 y, v, g; float bn; };
    const bf16_t *y, *v, *g; const float *bonus, *gng, *gnb;
    __device__ __forceinline__ Raw fetch(int, int r, int kc) const {
        Raw q; const size_t o = (size_t)r * 1024 + kc * 8;
        q.y = *(const uint4*)(y + o); q.v = *(const uint4*)(v + o); q.g = *(const uint4*)(g + o); q.bn = bonus[r * 16 + (kc >> 3)]; return q;
    }
    __device__ __forceinline__ uint4 finish(const Raw& q, int, int, int kc) const {
        float yf[8], vf[8], gf[8]; unpack8(q.y, yf); unpack8(q.v, vf); unpack8(q.g, gf);
        float s = 0.f, s2 = 0.f;
#pragma unroll
        for (int i = 0; i < 8; ++i) { s += yf[i]; s2 += yf[i] * yf[i]; }
        s = oct_sum(s); s2 = oct_sum(s2);
        const float mean = s * (1.0f / 64.0f), var = fmaxf(s2 * (1.0f / 64.0f) - mean * mean, 0.f), rstd = rsqrtf(var + 64e-5f);
        const float4 ga = *(const float4*)(gng + kc * 8), gb = *(const float4*)(gng + kc * 8 + 4), ba = *(const float4*)(gnb + kc * 8), bb = *(const float4*)(gnb + kc * 8 + 4);
        const float gg[8] = {ga.x, ga.y, ga.z, ga.w, gb.x, gb.y, gb.z, gb.w}, bq[8] = {ba.x, ba.y, ba.z, ba.w, bb.x, bb.y, bb.z, bb.w};
        float o[8];
#pragma unroll
        for (int i = 0; i < 8; ++i) o[i] = ((yf[i] - mean) * rstd * gg[i] + bq[i] + q.bn * vf[i]) * gf[i];
        return pack8(o);
    }
};
__device__ __forceinline__ void phase_rw4(PRef p, int jr, char* lds) {
    char* S = p.ws + OFF_SLOT;
    const bf16_t* yb = (const bf16_t*)(S + 5 * SLOT); const bf16_t* gb = (const bf16_t*)(S + 4 * SLOT);
    const bf16_t* vb = (const bf16_t*)(S + (jr == 0 ? 11 : 9) * SLOT); bf16_t* ymix = (bf16_t*)(S + 6 * SLOT);
    const bf16_t* wt = (const bf16_t*)(p.ws + W_OUT) + (size_t)jr * 1024 * 1024;
    const float* bonus = (const float*)(p.ws + OFF_BONUS);
    const int t_ = tidx(); const int lane = t_ & 63, wid = t_ >> 6, wr = wid >> 1, wc = wid & 1, fr = lane & 15, fq = lane >> 4;
    for (int id = blockIdx.x; id < 128 * 8; id += gridDim.x) {
        int mt, nt; tile_map(id, 8, mt, nt);
        const size_t ro = (size_t)mt * 128 * 1024;
        LdRw4 al{yb + ro, vb + ro, gb + ro, bonus + (size_t)mt * 128 * 16, p.in[22] + jr * 1024, p.in[23] + jr * 1024};
        const bf16_t* br[4];
        { const int t2_ = tidx(), r0_ = t2_ >> 3, co_ = glds_chunk(t2_) * 8;
#pragma unroll
          for (int i = 0; i < 4; ++i) br[i] = wt + (size_t)(nt * 128 + r0_ + 32 * i) * 1024 + co_; }
        f32x4 acc[4][4];
        gemm_rg(lds, 16, al, br, acc);
#pragma unroll
        for (int n = 0; n < 4; ++n)
#pragma unroll
            for (int m = 0; m < 4; ++m) {
                uint2 o; o.x = cvt_pk(acc[m][n][0], acc[m][n][1]); o.y = cvt_pk(acc[m][n][2], acc[m][n][3]);
                *(uint2*)(ymix + (size_t)(mt * 128 + wr * 64 + m * 16 + fr) * 1024 + nt * 128 + wc * 64 + n * 16 + fq * 4) = o;
            }
    }
}

__device__ __forceinline__ void phase_cml(PRef p) {
    const int t = tidx();
    char* S = p.ws + OFF_SLOT;
    const bf16_t* src = (const bf16_t*)(S + 1 * SLOT); bf16_t* dst = (bf16_t*)(S + 8 * SLOT);
    const int col = (t & 127) * 8, half = t >> 7;
    float cw[4][8], cb[8];
#pragma unroll
    for (int j = 0; j < 4; ++j) {
        const float4 a = *(const float4*)(p.in[27] + j * 1024 + col), b = *(const float4*)(p.in[27] + j * 1024 + col + 4);
        cw[j][0] = a.x; cw[j][1] = a.y; cw[j][2] = a.z; cw[j][3] = a.w; cw[j][4] = b.x; cw[j][5] = b.y; cw[j][6] = b.z; cw[j][7] = b.w;
    }
    { const float4 a = *(const float4*)(p.in[28] + col), b = *(const float4*)(p.in[28] + col + 4);
      cb[0] = a.x; cb[1] = a.y; cb[2] = a.z; cb[3] = a.w; cb[4] = b.x; cb[5] = b.y; cb[6] = b.z; cb[7] = b.w; }
    const float qs = (col < 512) ? 0.125f : 1.0f;
    for (int item = blockIdx.x; item < 1024; item += gridDim.x) {
        const int b = item >> 7, s0 = (item & 127) * 16 + half * 8;
        const bf16_t* base = src + (size_t)b * 2048 * 1024 + col;
        uint4 r[11];
#pragma unroll
        for (int i = 0; i < 11; ++i) { const int sr = s0 - 3 + i; r[i] = gload16(base + (size_t)max(sr, 0) * 1024); if (sr < 0) r[i] = make_uint4(0u, 0u, 0u, 0u); }
        float x0[8], x1[8], x2[8];
        unpack8(r[0], x0); unpack8(r[1], x1); unpack8(r[2], x2);
#pragma unroll
        for (int i = 0; i < 8; ++i) {
            float x3[8], a[8]; unpack8(r[i + 3], x3);
#pragma unroll
            for (int e = 0; e < 8; ++e) { a[e] = cb[e] + cw[0][e] * x0[e] + cw[1][e] * x1[e] + cw[2][e] * x2[e] + cw[3][e] * x3[e]; a[e] = siluf_(a[e]) * qs; }
            *(uint4*)(dst + ((size_t)b * 2048 + s0 + i) * 1024 + col) = pack8(a);
#pragma unroll
            for (int e = 0; e < 8; ++e) { x0[e] = x1[e]; x1[e] = x2[e]; x2[e] = x3[e]; }
        }
    }
}
__device__ __forceinline__ void phase_ml2(PRef p, char* lds) {
    const int t = tidx(), lane = t & 63, w = t >> 6, fr = lane & 15, fq = lane >> 4;
    char* S = p.ws + OFF_SLOT;
    const bf16_t* qk = (const bf16_t*)(S + 8 * SLOT); const bf16_t* vb = (const bf16_t*)(S + 2 * SLOT); bf16_t* yb = (bf16_t*)(S + 4 * SLOT);
    const float* gates = (const float*)(p.ws + OFF_GATES); float* stat = (float*)(p.ws + OFF_STAT);
    char* const RAW = lds;
    char* const QT = lds + 17408; char* const KT = lds + 25600;
    char* const VT = lds + 33792;
    char* const VX = lds + 35840;
    char* const PB = lds + 39936;
    char* const CT = lds + 48128;
    float* const FS = (float*)(lds + 52224); float* const GJ = FS + 64; float* const WJ = FS + 128;
    float* const CW = (float*)(lds + 53248);
    const int qq = fr >> 2, pp = fr & 3;
    for (int item = blockIdx.x; item < 512; item += gridDim.x) {
        const int bh = ((item >> 3) >> 3) * 8 + (item & 7), vs = (item >> 3) & 7, b = bh >> 3, hd = bh & 7;
        const size_t tok0 = (size_t)b * 2048;
        __syncthreads();
        for (int i = t; i < 256; i += 256) *(uint4*)(CT + i * 16) = make_uint4(0u, 0u, 0u, 0u);
        f32x4 Cacc[2] = {(f32x4){0.f, 0.f, 0.f, 0.f}, (f32x4){0.f, 0.f, 0.f, 0.f}};
        uint4 gr0, gr1, gr2, gr3; uint4 gv = make_uint4(0u, 0u, 0u, 0u); float gg = 0.f;
        const int frr = t >> 4, fc = t & 15;
        const bf16_t* const qkt = qk + (tok0 + frr) * 1024 + (fc >> 3) * 512 + hd * 64 + (fc & 7) * 8;
        char* const qkd = ((fc < 8) ? QT : KT) + frr * 128 + (((fc & 7) ^ (frr & 7)) << 4);
        auto fetch = [&](int ch) {
            const int s0 = ch * 64;
            const bf16_t* q0 = qkt + (size_t)s0 * 1024;
            gr0 = gload16(q0); gr1 = gload16(q0 + 16 * 1024); gr2 = gload16(q0 + 32 * 1024); gr3 = gload16(q0 + 48 * 1024);
            if (t < 128) { gv = gload16(vb + (tok0 + s0 + (t >> 1)) * 1024 + hd * 128 + vs * 16 + (t & 1) * 8);
                           gg = *(const __attribute__((address_space(1))) float*)(gates + (tok0 + s0 + (t & 63)) * 16 + (t >> 6) * 8 + hd); }
        };
        fetch(0);
        for (int ch = 0; ch < 32; ++ch) {
            const int s0 = ch * 64;
            *(uint4*)qkd = gr0; *(uint4*)(qkd + 16 * 128) = gr1; *(uint4*)(qkd + 32 * 128) = gr2; *(uint4*)(qkd + 48 * 128) = gr3;
            if (t < 128) *(uint4*)(VT + t * 16) = gv;
            float vf8[8]; unpack8(gv, vf8);
            if (t >= 64 && t < 128) GJ[t - 64] = gg;
            const float ggc = gg;
            if (ch + 1 < 32) fetch(ch + 1);
            __syncthreads();
            if (t < 64) {
                float f = GJ[t];
                f += __builtin_amdgcn_update_dpp(0.f, f, 0x111, 0xf, 0xf, false);
                f += __builtin_amdgcn_update_dpp(0.f, f, 0x112, 0xf, 0xf, false);
                f += __builtin_amdgcn_update_dpp(0.f, f, 0x114, 0xf, 0xf, false);
                f += __builtin_amdgcn_update_dpp(0.f, f, 0x118, 0xf, 0xf, false);
                f += __builtin_amdgcn_update_dpp(0.f, f, 0x142, 0xa, 0xf, false);
                f += __builtin_amdgcn_update_dpp(0.f, f, 0x143, 0xc, 0xf, false);
                const float fend = __int_as_float(__builtin_amdgcn_readlane(__float_as_int(f), 63));
                FS[t] = f; WJ[t] = __expf(fend - f + ggc);
                GJ[t] = ggc - f;
            }
            __syncthreads();
            const float efend = __expf(FS[63]);
            {
                if (t < 128) {
                    const int j = t >> 1; const float wj = WJ[j];
                    float f[8];
#pragma unroll
                    for (int i = 0; i < 8; ++i) f[i] = vf8[i] * wj;
                    *(uint4*)(VX + j * 64 + (t & 1) * 16) = pack8(f);
                    float g8[8] = {0.f, 0.f, 0.f, 0.f, 0.f, 0.f, 0.f, 0.f}; if ((t & 1) == 0) g8[0] = wj;
                    *(uint4*)(VX + j * 64 + 32 + (t & 1) * 16) = pack8(g8);
                }
            }
            __syncthreads();
            const int srow = 16 * w + fr;
            f32x4 Sacc[4], Xacc[2];
#pragma unroll
            for (int n = 0; n < 4; ++n) Sacc[n] = (f32x4){0.f, 0.f, 0.f, 0.f};
            Xacc[0] = (f32x4){0.f, 0.f, 0.f, 0.f}; Xacc[1] = (f32x4){0.f, 0.f, 0.f, 0.f};
            Cacc[0] *= efend; Cacc[1] *= efend;
#pragma unroll
            for (int ks = 0; ks < 2; ++ks) {
                const int chs = ((ks * 4 + fq) ^ (fr & 7)) << 4;
                const uint4 qf = *(const uint4*)(QT + srow * 128 + chs);
#pragma unroll
                for (int n = 0; n < 4; ++n) { const uint4 kf = *(const uint4*)(KT + (n * 16 + fr) * 128 + chs); Sacc[n] = mfma16(kf, qf, Sacc[n]); }
#pragma unroll
                for (int nn = 0; nn < 2; ++nn) { const uint4 rf = *(const uint4*)(CT + (nn * 16 + fr) * 128 + chs); Xacc[nn] = mfma16(rf, qf, Xacc[nn]); }
                const int r0 = ks * 32 + fq * 8 + qq, kc = 2 * w + (pp >> 1);
                const uint2 klo = lds_tr16(KT + r0 * 128 + ((kc ^ (r0 & 7)) << 4) + (pp & 1) * 8);
                const uint2 khi = lds_tr16(KT + (r0 + 4) * 128 + ((kc ^ ((r0 + 4) & 7)) << 4) + (pp & 1) * 8);
                const uint4 kt = make_uint4(klo.x, klo.y, khi.x, khi.y);
#pragma unroll
                for (int m = 0; m < 2; ++m) {
                    const uint2 vlo = lds_tr16(VX + r0 * 64 + (16 * m + 4 * pp) * 2), vhi = lds_tr16(VX + (r0 + 4) * 64 + (16 * m + 4 * pp) * 2);
                    Cacc[m] = mfma16(kt, make_uint4(vlo.x, vlo.y, vhi.x, vhi.y), Cacc[m]);
                }
            }
            const float fs = FS[srow];
            float dsum = 0.f;
#pragma unroll
            for (int n = 0; n < 4; ++n) {
                const float4 g4 = *(const float4*)(GJ + n * 16 + fq * 4); const float ga[4] = {g4.x, g4.y, g4.z, g4.w};
                float pv[4];
#pragma unroll
                for (int j = 0; j < 4; ++j) { const int jc = n * 16 + fq * 4 + j; pv[j] = (srow >= jc) ? Sacc[n][j] * __expf(fs + ga[j]) : 0.f; dsum += pv[j]; }
                uint2 o; o.x = cvt_pk(pv[0], pv[1]); o.y = cvt_pk(pv[2], pv[3]);
                *(uint2*)(PB + srow * 128 + (((n * 2 + (fq >> 1)) ^ (fr & 7)) << 4) + (fq & 1) * 8) = o;
            }
            dsum = xor16_add(dsum); dsum = xor32_add(dsum);
            f32x4 Iacc = (f32x4){0.f, 0.f, 0.f, 0.f};
#pragma unroll
            for (int ks = 0; ks < 2; ++ks) {
                const uint4 pf = *(const uint4*)(PB + srow * 128 + (((ks * 4 + fq) ^ (fr & 7)) << 4));
                const int r0 = ks * 32 + fq * 8 + qq;
                const uint2 vlo = lds_tr16(VT + r0 * 32 + (4 * pp) * 2), vhi = lds_tr16(VT + (r0 + 4) * 32 + (4 * pp) * 2);
                Iacc = mfma16(make_uint4(vlo.x, vlo.y, vhi.x, vhi.y), pf, Iacc);
            }
            const float efs = __expf(fs);
            const float ndq = __shfl(Xacc[1][0], fr);
            const float den = dsum + efs * ndq;
            const float rden = 1.0f / fmaxf(fabsf(den), 1.0f);
            const size_t tok = tok0 + s0 + srow;
            float o4[4], ssum = 0.f, ssq = 0.f;
#pragma unroll
            for (int j = 0; j < 4; ++j) { o4[j] = (Iacc[j] + efs * Xacc[0][j]) * rden; ssum += o4[j]; ssq += o4[j] * o4[j]; }
            gst_u2(yb + tok * 1024 + hd * 128 + vs * 16 + fq * 4, cvt_pk(o4[0], o4[1]), cvt_pk(o4[2], o4[3]));
            ssum = xor16_add(ssum); ssum = xor32_add(ssum); ssq = xor16_add(ssq); ssq = xor32_add(ssq);
            if (fq == 0) gst_u2(stat + ((tok * 8 + hd) * 8 + vs) * 2, __float_as_uint(ssum), __float_as_uint(ssq));
            __syncthreads();
#pragma unroll
            for (int m = 0; m < 2; ++m) {
                const int v = m * 16 + fr;
                uint2 o; o.x = cvt_pk(Cacc[m][0], Cacc[m][1]); o.y = cvt_pk(Cacc[m][2], Cacc[m][3]);
                *(uint2*)(CT + v * 128 + (((2 * w + (fq >> 1)) ^ (v & 7)) << 4) + (fq & 1) * 8) = o;
            }
        }
    }
}
template <int HSHIFT  , int NH>
struct LdGnGate {
    struct Raw { uint4 y, g; };
    const bf16_t *y, *g; int ld; const float *gng, *gnb; const float* st;
    __device__ __forceinline__ Raw fetch(int, int r, int kc) const { Raw q; const size_t o = (size_t)r * ld + kc * 8; q.y = *(const uint4*)(y + o); q.g = *(const uint4*)(g + o); return q; }
    __device__ __forceinline__ uint4 finish(const Raw& q, int, int r, int kc) const {
        float yf[8], gf[8]; unpack8(q.y, yf); unpack8(q.g, gf);
        const float2 ms = *(const float2*)(st + (r * NH + ((kc * 8) >> HSHIFT)) * 2);
        const float4 ga = *(const float4*)(gng + kc * 8), gb = *(const float4*)(gng + kc * 8 + 4), ba = *(const float4*)(gnb + kc * 8), bb = *(const float4*)(gnb + kc * 8 + 4);
        const float gg[8] = {ga.x, ga.y, ga.z, ga.w, gb.x, gb.y, gb.z, gb.w}, bq[8] = {ba.x, ba.y, ba.z, ba.w, bb.x, bb.y, bb.z, bb.w};
        float o[8];
#pragma unroll
        for (int i = 0; i < 8; ++i) o[i] = ((yf[i] - ms.x) * ms.y * gg[i] + bq[i]) * gf[i];
        return pack8(o);
    }
};
template <int HSHIFT, int NH, int NPART>
__device__ __forceinline__ void phase_outproj_gn(PRef p, char* lds, const bf16_t* yb, const bf16_t* gate, int K, const bf16_t* wt, const float* gng, const float* gnb, bf16_t* ymix) {
    const int t = tidx(), lane = t & 63, wid = t >> 6, wr = wid >> 1, wc = wid & 1, fr = lane & 15, fq = lane >> 4;
    const float* stat = (const float*)(p.ws + OFF_STAT);
    float* st = (float*)(lds + 65536);
    const float invn = 1.0f / (float)(1 << HSHIFT);
    for (int id = blockIdx.x; id < 128 * 8; id += gridDim.x) {
        int mt, nt; tile_map(id, 8, mt, nt);
        for (int i = t; i < 128 * NH; i += 256) {
            const float* q = stat + ((size_t)mt * 128 * NH + i) * NPART * 2;
            float s = 0.f, s2 = 0.f;
#pragma unroll
            for (int j = 0; j < NPART; ++j) { const float2 v = *(const float2*)(q + j * 2); s += v.x; s2 += v.y; }
            const float mean = s * invn, var = fmaxf(s2 * invn - mean * mean, 0.f);
            st[i * 2] = mean; st[i * 2 + 1] = rsqrtf(var + 1e-6f);
        }
        __syncthreads();
        const size_t ro = (size_t)mt * 128 * K;
        LdGnGate<HSHIFT, NH> al{yb + ro, gate + ro, K, gng, gnb, st};
        const bf16_t* br[4];
        { const int r0_ = t >> 3, co_ = glds_chunk(t) * 8;
#pragma unroll
          for (int i = 0; i < 4; ++i) br[i] = wt + (size_t)(nt * 128 + r0_ + 32 * i) * K + co_; }
        f32x4 acc[4][4];
        gemm_rg(lds, K / 64, al, br, acc);
#pragma unroll
        for (int n = 0; n < 4; ++n)
#pragma unroll
            for (int m = 0; m < 4; ++m) {
                uint2 o; o.x = cvt_pk(acc[m][n][0], acc[m][n][1]); o.y = cvt_pk(acc[m][n][2], acc[m][n][3]);
                *(uint2*)(ymix + (size_t)(mt * 128 + wr * 64 + m * 16 + fr) * 1024 + nt * 128 + wc * 64 + n * 16 + fq * 4) = o;
            }
    }
}

__device__ __forceinline__ void phase_rt2(PRef p, char* lds) {
    const int t = tidx(), lane = t & 63, w = t >> 6, fr = lane & 15, fq = lane >> 4;
    char* S = p.ws + OFF_SLOT;
    const bf16_t* qb = (const bf16_t*)(S + 1 * SLOT); const bf16_t* kb = (const bf16_t*)(S + 2 * SLOT); const bf16_t* vb = (const bf16_t*)(S + 3 * SLOT);
    bf16_t* yb = (bf16_t*)(S + 7 * SLOT); float* stat = (float*)(p.ws + OFF_STAT);
    char* const VB = lds + 32768; char* const PB = lds + 49152; char* const RT = lds + 57344;
    const int gco = glds_chunk(t) * 8, gr0 = t >> 3;
    const int qq = fr >> 2, pp = fr & 3;
    for (int item = blockIdx.x; item < 512; item += gridDim.x) {
        const int bh = ((item >> 3) >> 4) * 8 + (item & 7), vs = (item >> 3) & 15, b = bh >> 2, hd = bh & 3;
        const size_t tok0 = (size_t)b * 2048;
        const float lg2 = log2f(1.0f - __builtin_amdgcn_exp2f(-5.0f - (float)hd));
        const float dec64 = __builtin_amdgcn_exp2f(64.0f * lg2);
        const bf16_t* qsrc = qb + (tok0 + gr0) * 1024 + hd * 256 + gco;
        const bf16_t* ksrc = kb + (tok0 + gr0) * 1024 + hd * 256 + gco;
        const bf16_t* vsrc = vb + (tok0 + (t >> 2)) * 2048 + hd * 512 + vs * 32 + (t & 3) * 8;
        f32x4 Racc[4][2];
#pragma unroll
        for (int a = 0; a < 4; ++a) { Racc[a][0] = (f32x4){0.f, 0.f, 0.f, 0.f}; Racc[a][1] = (f32x4){0.f, 0.f, 0.f, 0.f}; }
        __syncthreads();
        for (int i = t; i < 1024; i += 256) *(uint4*)(RT + i * 16) = make_uint4(0u, 0u, 0u, 0u);
        auto issue = [&](int pc) {
            const unsigned d = (unsigned)__builtin_amdgcn_readfirstlane((int)(lds_addr_u(lds) + (pc & 1) * 16384 + w * 1024));
            const size_t go = (size_t)(pc >> 2) * 64 * 1024 + (pc & 3) * 64;
#pragma unroll
            for (int i = 0; i < 2; ++i) { glds16_asm(qsrc + go + (size_t)i * 32 * 1024, d + i * 4096); glds16_asm(ksrc + go + (size_t)i * 32 * 1024, d + 8192 + i * 4096); }
        };
        auto put_v = [&](const uint4& raw, int ch) {
            char* vbuf = VB + (ch & 1) * 8192; const int j = t >> 2;
            *(uint4*)(vbuf + j * 64 + (t & 3) * 16) = raw;
            float f[8]; unpack8(raw, f); const float sc = __builtin_amdgcn_exp2f(lg2 * (float)(63 - j));
#pragma unroll
            for (int i = 0; i < 8; ++i) f[i] *= sc;
            *(uint4*)(vbuf + 4096 + j * 64 + (t & 3) * 16) = pack8(f);
        };
        issue(0);
        { const uint4 v0 = gld_u4(vsrc); put_v(v0, 0); }
        asm volatile("s_waitcnt vmcnt(0)" ::: "memory");
        __syncthreads();
        f32x4 Sacc[4], Xacc[2];
        uint4 vnext = make_uint4(0u, 0u, 0u, 0u);
        for (int ch = 0; ch < 32; ++ch) {
            const char* vbuf = VB + (ch & 1) * 8192;
#pragma unroll
            for (int qd = 0; qd < 4; ++qd) {
                const int pc = ch * 4 + qd;
                if (pc + 1 < 128) issue(pc + 1);
                if (qd == 0) {
                    if (ch + 1 < 32) vnext = gld_u4(vsrc + (size_t)(ch + 1) * 64 * 2048);
#pragma unroll
                    for (int n = 0; n < 4; ++n) Sacc[n] = (f32x4){0.f, 0.f, 0.f, 0.f};
                    Xacc[0] = (f32x4){0.f, 0.f, 0.f, 0.f}; Xacc[1] = (f32x4){0.f, 0.f, 0.f, 0.f};
                }
                const char* qk = lds + (pc & 1) * 16384;
                Racc[qd][0] *= dec64; Racc[qd][1] *= dec64;
#pragma unroll
                for (int ks = 0; ks < 2; ++ks) {
                    const int chs = ((ks * 4 + fq) ^ (fr & 7)) << 4;
                    const uint4 qf = *(const uint4*)(qk + (16 * w + fr) * 128 + chs);
#pragma unroll
                    for (int n = 0; n < 4; ++n) { const uint4 kf = *(const uint4*)(qk + 8192 + (n * 16 + fr) * 128 + chs); Sacc[n] = mfma16(kf, qf, Sacc[n]); }
#pragma unroll
                    for (int nn = 0; nn < 2; ++nn) {
                        const int v = nn * 16 + fr;
                        const uint4 rf = *(const uint4*)(RT + v * 512 + (((qd * 8 + ks * 4 + fq) ^ (v & 7)) << 4));
                        Xacc[nn] = mfma16(rf, qf, Xacc[nn]);
                    }
                    const int r0 = ks * 32 + fq * 8 + qq;
                    const int kc = 2 * w + (pp >> 1);
                    const uint2 klo = lds_tr16(qk + 8192 + r0 * 128 + ((kc ^ (r0 & 7)) << 4) + (pp & 1) * 8);
                    const uint2 khi = lds_tr16(qk + 8192 + (r0 + 4) * 128 + ((kc ^ ((r0 + 4) & 7)) << 4) + (pp & 1) * 8);
                    const uint4 kt = make_uint4(klo.x, klo.y, khi.x, khi.y);
#pragma unroll
                    for (int m = 0; m < 2; ++m) {
                        const uint2 vlo = lds_tr16(vbuf + 4096 + r0 * 64 + (16 * m + 4 * pp) * 2), vhi = lds_tr16(vbuf + 4096 + (r0 + 4) * 64 + (16 * m + 4 * pp) * 2);
                        Racc[qd][m] = mfma16(kt, make_uint4(vlo.x, vlo.y, vhi.x, vhi.y), Racc[qd][m]);
                    }
                }
                if (qd == 2 && ch + 1 < 32) put_v(vnext, ch + 1);
                asm volatile("s_waitcnt vmcnt(0)" ::: "memory");
                __syncthreads();
#pragma unroll
                for (int m = 0; m < 2; ++m) {
                    const int v = m * 16 + fr, cch = qd * 8 + 2 * w + (fq >> 1);
                    uint2 o; o.x = cvt_pk(Racc[qd][m][0], Racc[qd][m][1]); o.y = cvt_pk(Racc[qd][m][2], Racc[qd][m][3]);
                    *(uint2*)(RT + v * 512 + ((cch ^ (v & 7)) << 4) + (fq & 1) * 8) = o;
                }
            }
            const int srow = 16 * w + fr;
#pragma unroll
            for (int n = 0; n < 4; ++n) {
                float pv[4];
#pragma unroll
                for (int j = 0; j < 4; ++j) { const int jc = n * 16 + fq * 4 + j; pv[j] = (srow >= jc) ? Sacc[n][j] * __builtin_amdgcn_exp2f(lg2 * (float)(srow - jc)) : 0.f; }
                uint2 o; o.x = cvt_pk(pv[0], pv[1]); o.y = cvt_pk(pv[2], pv[3]);
                *(uint2*)(PB + srow * 128 + (((n * 2 + (fq >> 1)) ^ (fr & 7)) << 4) + (fq & 1) * 8) = o;
            }
            f32x4 Iacc[2] = {(f32x4){0.f, 0.f, 0.f, 0.f}, (f32x4){0.f, 0.f, 0.f, 0.f}};
#pragma unroll
            for (int ks = 0; ks < 2; ++ks) {
                const uint4 pf = *(const uint4*)(PB + srow * 128 + (((ks * 4 + fq) ^ (fr & 7)) << 4));
                const int r0 = ks * 32 + fq * 8 + qq;
#pragma unroll
                for (int nn = 0; nn < 2; ++nn) {
                    const uint2 vlo = lds_tr16(vbuf + r0 * 64 + (16 * nn + 4 * pp) * 2), vhi = lds_tr16(vbuf + (r0 + 4) * 64 + (16 * nn + 4 * pp) * 2);
                    Iacc[nn] = mfma16(make_uint4(vlo.x, vlo.y, vhi.x, vhi.y), pf, Iacc[nn]);
                }
            }
            const float qdec = __builtin_amdgcn_exp2f(lg2 * (float)(srow + 1));
            const size_t tok = tok0 + (size_t)ch * 64 + srow;
            float ssum = 0.f, ssq = 0.f;
#pragma unroll
            for (int nn = 0; nn < 2; ++nn) {
                float o4[4];
#pragma unroll
                for (int j = 0; j < 4; ++j) { o4[j] = Iacc[nn][j] + Xacc[nn][j] * qdec; ssum += o4[j]; ssq += o4[j] * o4[j]; }
                gst_u2(yb + tok * 2048 + hd * 512 + vs * 32 + nn * 16 + fq * 4, cvt_pk(o4[0], o4[1]), cvt_pk(o4[2], o4[3]));
            }
            ssum = xor16_add(ssum); ssum = xor32_add(ssum); ssq = xor16_add(ssq); ssq = xor32_add(ssq);
            if (fq == 0) gst_u2(stat + ((tok * 4 + hd) * 16 + vs) * 2, __float_as_uint(ssum), __float_as_uint(ssq));
        }
        __syncthreads();
    }
}

__device__ __forceinline__ void phase_zrw(PRef p, int jr) {
    const int t_ = tidx(); const int lane = t_ & 63, gw = blockIdx.x * 4 + (t_ >> 6), nw = gridDim.x * 4;
    char* S = p.ws + OFF_SLOT;
    const bf16_t* yb = (const bf16_t*)(S + 5 * SLOT); const bf16_t* gb = (const bf16_t*)(S + 4 * SLOT);
    const bf16_t* vb = (const bf16_t*)(S + (jr == 0 ? 11 : 9) * SLOT); bf16_t* zb = (bf16_t*)(S + 7 * SLOT);
    const float* bonus = (const float*)(p.ws + OFF_BONUS);
    float gg[16], bq[16]; row_load_f32(p.in[22] + jr * 1024, gg, lane); row_load_f32(p.in[23] + jr * 1024, bq, lane);
    const int rpw = NTOK / nw, first = gw * rpw, end = first + rpw;
    uint2 ny[4], nv[4], ng[4]; float nbn[4];
    auto load_in = [&](int r) {
#pragma unroll
        for (int c = 0; c < 4; ++c) { const size_t o = (size_t)r * 1024 + c * 256 + lane * 4; ny[c] = *(const uint2*)(yb + o); nv[c] = *(const uint2*)(vb + o); ng[c] = *(const uint2*)(gb + o);
                                      nbn[c] = bonus[(size_t)r * 16 + c * 4 + (lane >> 4)]; }
    };
    load_in(first);
    for (int r = first; r < end; ++r) {
        float y[16], v[16], g[16], bn[4];
#pragma unroll
        for (int c = 0; c < 4; ++c) {
            y[c * 4] = bflo(ny[c].x); y[c * 4 + 1] = bfhi(ny[c].x); y[c * 4 + 2] = bflo(ny[c].y); y[c * 4 + 3] = bfhi(ny[c].y);
            v[c * 4] = bflo(nv[c].x); v[c * 4 + 1] = bfhi(nv[c].x); v[c * 4 + 2] = bflo(nv[c].y); v[c * 4 + 3] = bfhi(nv[c].y);
            g[c * 4] = bflo(ng[c].x); g[c * 4 + 1] = bfhi(ng[c].x); g[c * 4 + 2] = bflo(ng[c].y); g[c * 4 + 3] = bfhi(ng[c].y);
            bn[c] = nbn[c];
        }
        if (r + 1 < end) load_in(r + 1);
        __builtin_amdgcn_sched_barrier(0);
        float z[16];
#pragma unroll
        for (int c = 0; c < 4; ++c) {
            float s = (y[c * 4] + y[c * 4 + 1]) + (y[c * 4 + 2] + y[c * 4 + 3]);
            float q = (y[c * 4] * y[c * 4] + y[c * 4 + 1] * y[c * 4 + 1]) + (y[c * 4 + 2] * y[c * 4 + 2] + y[c * 4 + 3] * y[c * 4 + 3]);
            s = row16_sum(s); q = row16_sum(q);
            const float mean = s * (1.0f / 64.0f), rstd = rsqrtf(fmaxf(q * (1.0f / 64.0f) - mean * mean, 0.f) + 64e-5f);
#pragma unroll
            for (int i = 0; i < 4; ++i) { const int e = c * 4 + i; z[e] = ((y[e] - mean) * rstd * gg[e] + bq[e] + bn[c] * v[e]) * g[e]; }
        }
        row_store_bf16(zb + (size_t)r * 1024, z, lane);
    }
}
__device__ __forceinline__ void phase_zml(PRef p) {
    const int t_ = tidx(); const int lane = t_ & 63, gw = blockIdx.x * 4 + (t_ >> 6), nw = gridDim.x * 4;
    char* S = p.ws + OFF_SLOT;
    const bf16_t* yb = (const bf16_t*)(S + 4 * SLOT); const bf16_t* ob = (const bf16_t*)(S + 3 * SLOT); bf16_t* zb = (bf16_t*)(S + 1 * SLOT);
    float gg[16], bq[16]; row_load_f32(p.in[29], gg, lane); row_load_f32(p.in[30], bq, lane);
    const int rpw = NTOK / nw, first = gw * rpw, end = first + rpw;
    uint2 ny[4], no[4];
    auto load_in = [&](int r) {
#pragma unroll
        for (int c = 0; c < 4; ++c) { const size_t o = (size_t)r * 1024 + c * 256 + lane * 4; ny[c] = *(const uint2*)(yb + o); no[c] = *(const uint2*)(ob + o); }
    };
    load_in(first);
    for (int r = first; r < end; ++r) {
        float y[16], o[16], z[16];
#pragma unroll
        for (int c = 0; c < 4; ++c) {
            y[c * 4] = bflo(ny[c].x); y[c * 4 + 1] = bfhi(ny[c].x); y[c * 4 + 2] = bflo(ny[c].y); y[c * 4 + 3] = bfhi(ny[c].y);
            o[c * 4] = bflo(no[c].x); o[c * 4 + 1] = bfhi(no[c].x); o[c * 4 + 2] = bflo(no[c].y); o[c * 4 + 3] = bfhi(no[c].y);
        }
        if (r + 1 < end) load_in(r + 1);
        __builtin_amdgcn_sched_barrier(0);
#pragma unroll
        for (int c = 0; c < 4; ++c) {
            float s = (y[c * 4] + y[c * 4 + 1]) + (y[c * 4 + 2] + y[c * 4 + 3]);
            float q = (y[c * 4] * y[c * 4] + y[c * 4 + 1] * y[c * 4 + 1]) + (y[c * 4 + 2] * y[c * 4 + 2] + y[c * 4 + 3] * y[c * 4 + 3]);
            s = row16_sum(s); q = row16_sum(q); s = xor16_add(s); q = xor16_add(q);
            const float mean = s * (1.0f / 128.0f), rstd = rsqrtf(fmaxf(q * (1.0f / 128.0f) - mean * mean, 0.f) + 1e-6f);
#pragma unroll
            for (int i = 0; i < 4; ++i) { const int e = c * 4 + i; z[e] = ((y[e] - mean) * rstd * gg[e] + bq[e]) * o[e]; }
        }
        row_store_bf16(zb + (size_t)r * 1024, z, lane);
    }
}
__device__ __forceinline__ void phase_zrt(PRef p) {
    const int t_ = tidx(); const int lane = t_ & 63, gw = blockIdx.x * 4 + (t_ >> 6), nw = gridDim.x * 4;
    char* S = p.ws + OFF_SLOT;
    const bf16_t* yb = (const bf16_t*)(S + 7 * SLOT); const bf16_t* sb = (const bf16_t*)(S + 5 * SLOT); bf16_t* zb = (bf16_t*)(S + 3 * SLOT);
    float gw8[4][8], bw8[4][8];
#pragma unroll
    for (int c = 0; c < 4; ++c) {
        const float4 ga = gld_f4(p.in[33] + lane * 32 + c * 8), gb2 = gld_f4(p.in[33] + lane * 32 + c * 8 + 4), ba = gld_f4(p.in[34] + lane * 32 + c * 8), bb2 = gld_f4(p.in[34] + lane * 32 + c * 8 + 4);
        gw8[c][0] = ga.x; gw8[c][1] = ga.y; gw8[c][2] = ga.z; gw8[c][3] = ga.w; gw8[c][4] = gb2.x; gw8[c][5] = gb2.y; gw8[c][6] = gb2.z; gw8[c][7] = gb2.w;
        bw8[c][0] = ba.x; bw8[c][1] = ba.y; bw8[c][2] = ba.z; bw8[c][3] = ba.w; bw8[c][4] = bb2.x; bw8[c][5] = bb2.y; bw8[c][6] = bb2.z; bw8[c][7] = bb2.w;
    }
    const int rpw = NTOK / nw, first = gw * rpw, end = first + rpw;
    uint4 nyr[4], nsr[4];
    auto load_in = [&](int r) {
        const size_t o = (size_t)r * 2048 + lane * 32;
#pragma unroll
        for (int c = 0; c < 4; ++c) { nyr[c] = *(const uint4*)(yb + o + c * 8); nsr[c] = *(const uint4*)(sb + o + c * 8); }
    };
    load_in(first);
    for (int r = first; r < end; ++r) {
        const size_t o = (size_t)r * 2048 + lane * 32;
        uint4 yr[4], sr[4];
#pragma unroll
        for (int c = 0; c < 4; ++c) { yr[c] = nyr[c]; sr[c] = nsr[c]; }
        if (r + 1 < end) load_in(r + 1);
        __builtin_amdgcn_sched_barrier(0);
        float s = 0.f, q = 0.f;
#pragma unroll
        for (int c = 0; c < 4; ++c) { float f[8]; unpack8(yr[c], f);
#pragma unroll
            for (int i = 0; i < 8; ++i) { s += f[i]; q += f[i] * f[i]; } }
        s = row16_sum(s); q = row16_sum(q);
        const float mean = s * (1.0f / 512.0f), rstd = rsqrtf(fmaxf(q * (1.0f / 512.0f) - mean * mean, 0.f) + 1e-6f);
#pragma unroll
        for (int c = 0; c < 4; ++c) {
            float f[8], g[8], z[8]; unpack8(yr[c], f); unpack8(sr[c], g);
#pragma unroll
            for (int i = 0; i < 8; ++i) z[i] = ((f[i] - mean) * rstd * gw8[c][i] + bw8[c][i]) * g[i];
            *(uint4*)(zb + o + c * 8) = pack8(z);
        }
    }
}

template <int WHICH  >
__device__ __forceinline__ void phase_moe(PRef p, int L, char* lds, const bf16_t* hm, bf16_t* H) {
    const int t = tidx(), lane = t & 63, wid = t >> 6, wr = wid >> 1, wc = wid & 1, fr = lane & 15, fq = lane >> 4;
    const int* cnt = (const int*)(p.ws + OFF_CNT) + L * 32;
    const int* list = (const int*)(p.ws + OFF_LIST);
    bf16_t* Y = (bf16_t*)(p.ws + OFF_SLOT + 9 * SLOT);
    int* pre = (int*)(lds + 65536);
    __syncthreads();
    if (t == 0) { int s = 0; for (int e = 0; e < 32; ++e) { pre[e] = s; s += (cnt[e] + 127) >> 7; } pre[32] = s; }
    __syncthreads();
    const int total_all = pre[32] * 8;
    const int full = (total_all / (int)gridDim.x) * (int)gridDim.x, rem = total_all - full;
    const bool split_tail = (rem > 0) && (2 * rem <= (int)gridDim.x);
    const int total = split_tail ? full : total_all;
    for (int id0 = 0; id0 < total; id0 += gridDim.x) {
        const int id = id0 + (blockIdx.x & 7) * (gridDim.x >> 3) + (blockIdx.x >> 3);
        if (id >= total) continue;
        const int nt = id & 7, mg = id >> 3;
        int e = 0;
#pragma unroll 1
        for (int s = 16; s >= 1; s >>= 1) if (pre[e + s] <= mg) e += s;
        const int mt = mg - pre[e], ne = cnt[e];
        const int* le = list + e * LIST_CAP + mt * 128;
        const bf16_t* ar[4]; const bf16_t* br[4];
        const int co_ = glds_chunk(t) * 8;
#pragma unroll
        for (int i = 0; i < 4; ++i) {
            int r = (t >> 3) + 32 * i; r = (mt * 128 + r < ne) ? r : 0;
            const int aid = le[r];
            ar[i] = ((WHICH == 0) ? hm + (size_t)(aid >> 1) * 1024 : H + (size_t)aid * 512) + co_;
        }
        f32x4 acc[4][4];
        if (WHICH == 0) {
            const bf16_t* wt = (const bf16_t*)(p.ws + W_MOE13) + ((size_t)(L * 32 + e) * 1024 + nt * 128) * 1024;
#pragma unroll
            for (int i = 0; i < 4; ++i) {
                const int ro = (t >> 3) + 32 * i, n_ = (ro >> 4) & 3, hc = ((ro >> 2) & 3) * 8 + (n_ >> 1) * 4 + (ro & 3);
                br[i] = wt + (size_t)((ro & 64) + (hc >> 4) * 32 + (n_ & 1) * 16 + (hc & 15)) * 1024 + co_;
            }
            gemm_gg(lds, 16, ar, br, acc);
            int aidq[4];
#pragma unroll
            for (int m = 0; m < 4; ++m) { const int r = wr * 64 + m * 16 + fr; aidq[m] = (mt * 128 + r < ne) ? le[r] : 0; }
#pragma unroll
            for (int m = 0; m < 4; ++m) {
                const int r = wr * 64 + m * 16 + fr;
                if (mt * 128 + r < ne) {
                    const int aid = aidq[m];
                    const f32x4 a1 = acc[m][0], a3 = acc[m][1], b1 = acc[m][2], b3 = acc[m][3];
                    gst_u4(H + (size_t)aid * 512 + nt * 64 + wc * 32 + fq * 8, cvt_pk(siluf_(a1[0]) * a3[0], siluf_(a1[1]) * a3[1]), cvt_pk(siluf_(a1[2]) * a3[2], siluf_(a1[3]) * a3[3]),
                           cvt_pk(siluf_(b1[0]) * b3[0], siluf_(b1[1]) * b3[1]), cvt_pk(siluf_(b1[2]) * b3[2], siluf_(b1[3]) * b3[3]));
                }
            }
        } else {
            const bf16_t* wt = (const bf16_t*)(p.ws + W_MOE2) + ((size_t)(L * 32 + e) * 1024 + nt * 128) * 512;
#pragma unroll
            for (int i = 0; i < 4; ++i) br[i] = wt + (size_t)perm64((t >> 3) + 32 * i) * 512 + co_;
            gemm_gg(lds, 8, ar, br, acc);
            int aidq[4];
#pragma unroll
            for (int m = 0; m < 4; ++m) { const int r = wr * 64 + m * 16 + fr; aidq[m] = (mt * 128 + r < ne) ? le[r] : 0; }
#pragma unroll
            for (int m = 0; m < 4; ++m) {
                const int r = wr * 64 + m * 16 + fr;
                if (mt * 128 + r < ne) {
                    const int aid = aidq[m];
                    store16(Y + (size_t)aid * 1024 + nt * 128 + wc * 64 + fq * 16, acc[m]);
                }
            }
        }
    }
    if (split_tail) {
        const int hid = (blockIdx.x & 7) * (gridDim.x >> 3) + (blockIdx.x >> 3);
        if (hid < 2 * rem) {
            const int id = full + (hid >> 1), hf = hid & 1;
            const int nt = id & 7, mg = id >> 3;
            int e = 0;
#pragma unroll 1
            for (int s2 = 16; s2 >= 1; s2 >>= 1) if (pre[e + s2] <= mg) e += s2;
            const int mt = mg - pre[e], ne = cnt[e];
            const int* le = list + e * LIST_CAP + mt * 128;
            const bf16_t* ar[4]; const bf16_t* br[2];
            const int co_ = glds_chunk(t) * 8;
#pragma unroll
            for (int i = 0; i < 4; ++i) {
                int r = (t >> 3) + 32 * i; r = (mt * 128 + r < ne) ? r : 0;
                const int aid = le[r];
                ar[i] = ((WHICH == 0) ? hm + (size_t)(aid >> 1) * 1024 : H + (size_t)aid * 512) + co_;
            }
            f32x4 acc[2][4];
            int aidq[2];
            if (WHICH == 0) {
                const bf16_t* wt = (const bf16_t*)(p.ws + W_MOE13) + ((size_t)(L * 32 + e) * 1024 + nt * 128 + hf * 64) * 1024;
#pragma unroll
                for (int i = 0; i < 2; ++i) {
                    const int ro = (t >> 3) + 32 * i, n_ = (ro >> 4) & 3, hc = ((ro >> 2) & 3) * 8 + (n_ >> 1) * 4 + (ro & 3);
                    br[i] = wt + (size_t)((hc >> 4) * 32 + (n_ & 1) * 16 + (hc & 15)) * 1024 + co_;
                }
                gemm_hn(lds, 16, ar, br, acc);
#pragma unroll
                for (int m = 0; m < 2; ++m) { const int r = wid * 32 + m * 16 + fr; aidq[m] = (mt * 128 + r < ne) ? le[r] : 0; }
#pragma unroll
                for (int m = 0; m < 2; ++m) {
                    const int r = wid * 32 + m * 16 + fr;
                    if (mt * 128 + r < ne) {
                        const f32x4 a1 = acc[m][0], a3 = acc[m][1], b1 = acc[m][2], b3 = acc[m][3];
                        gst_u4(H + (size_t)aidq[m] * 512 + nt * 64 + hf * 32 + fq * 8, cvt_pk(siluf_(a1[0]) * a3[0], siluf_(a1[1]) * a3[1]), cvt_pk(siluf_(a1[2]) * a3[2], siluf_(a1[3]) * a3[3]),
                               cvt_pk(siluf_(b1[0]) * b3[0], siluf_(b1[1]) * b3[1]), cvt_pk(siluf_(b1[2]) * b3[2], siluf_(b1[3]) * b3[3]));
                    }
                }
            } else {
                const bf16_t* wt = (const bf16_t*)(p.ws + W_MOE2) + ((size_t)(L * 32 + e) * 1024 + nt * 128 + hf * 64) * 512;
#pragma unroll
                for (int i = 0; i < 2; ++i) br[i] = wt + (size_t)perm64((t >> 3) + 32 * i) * 512 + co_;
                gemm_hn(lds, 8, ar, br, acc);
#pragma unroll
                for (int m = 0; m < 2; ++m) { const int r = wid * 32 + m * 16 + fr; aidq[m] = (mt * 128 + r < ne) ? le[r] : 0; }
#pragma unroll
                for (int m = 0; m < 2; ++m) {
                    const int r = wid * 32 + m * 16 + fr;
                    if (mt * 128 + r < ne) store16(Y + (size_t)aidq[m] * 1024 + nt * 128 + hf * 64 + fq * 16, acc[m]);
                }
            }
        }
    }
}

constexpr int NPHASE = 37;
#ifndef PHSEL
#define PHSEL -1
#endif
#ifndef PHEXC
#define PHEXC -2
#endif
#define PHON(x) ((PHSEL < 0 || PHSEL == (x)) && PHEXC != (x))
__global__ void __launch_bounds__(256, 2) mega(Params p_in) {
    PRef p = *(const CAS Params*)__builtin_amdgcn_kernarg_segment_ptr();
    extern __shared__ __attribute__((aligned(16))) char lds[];
    volatile LAS unsigned* xbw = (volatile LAS unsigned*)(lds + 73728);
    if (threadIdx.x == 0) { xbw[0] = 0u; xbw[1] = 0u; xbw[2] = 0u; xbw[3] = 0u; }
    __syncthreads();
    XcdBarrier bar;
    const bool multi = (p.ph_hi - p.ph_lo) > 1;
    (void)multi;
    if (multi) bar = xcd_barrier_post((unsigned*)(p.ws + OFF_CTL), xbw);
    char* S = p.ws + OFF_SLOT;
#ifdef DBG_STOP
    if (p.ph_lo == 100) {
        const float* src = (const float*)(p.ws + DBG_SRC);
        for (size_t i = (size_t)blockIdx.x * 256 + threadIdx.x; i < (size_t)NTOK * DM; i += (size_t)gridDim.x * 256) {
            float v = DBG_BF16 ? bf2f(((const bf16_t*)src)[i]) : src[i];
            if (!(fabsf(v) < 1e30f)) v = 1e30f;
            p.out[i] = v;
        }
        return;
    }
#endif
    const int ph_lo_ = p.ph_lo, ph_hi_ = p.ph_hi;
#ifdef TIMEIT
    unsigned long long t0_ = 0, t1_ = 0;
#endif
#ifdef DUP_PHASE
    bool dup_done_ = false;
#endif
    for (int ph = ph_lo_; ph < ph_hi_; ++ph) {
        const CAS Params* pp_ = (const CAS Params*)__builtin_amdgcn_kernarg_segment_ptr();
        asm volatile("" : "+s"(pp_));
        PRef p = *pp_;
#ifdef TIMEIT
        if (ph == TIME_A) t0_ = __builtin_amdgcn_s_memrealtime();
        if (ph == TIME_B) t1_ = __builtin_amdgcn_s_memrealtime();
#endif
        int L, sub, kind;
        if (ph < 2) { L = 0; sub = ph; kind = -1; }
        else if (ph < 11) { L = 0; kind = 0; sub = ph - 2; }
        else if (ph < 20) { L = 1; kind = 1; sub = ph - 11; }
        else if (ph < 28) { L = 2; kind = 2; sub = ph - 20; }
        else { L = 3; kind = 0; sub = ph - 28; }
        const int jr = L / 3;
        if (kind == -1) { if (sub == 0) { if (PHON(0)) phase_prologue(p, lds); } else { if (PHON(1)) phase_h0(p); } }
        else {
            const int ntail = (kind == 2) ? 4 : 5;
            if (sub < ntail) {
                if (kind == 0) {
                    if (sub == 0) { if (PHON(2)) phase_gemm_jobs(p, lds, jr * 7, jr * 7 + (jr ? 7 : 6)); }
                    else if (sub == 1) { if (PHON(3)) phase_rw2(p, jr); }
                    else if (sub == 2) { if (PHON(4)) {
#ifdef RW3_SCALAR
                        phase_rw3(p, jr, lds);
#else
                        phase_rw3c(p, jr, lds);
#endif
                    } }
                    else if (sub == 3) { if (PHON(5)) phase_zrw(p, jr); }
                    else { if (PHON(2)) phase_gemm_jobs(p, lds, 16 + jr, 17 + jr); }
                } else if (kind == 1) {
                    if (sub == 0) { if (PHON(2)) phase_gemm_jobs(p, lds, 14, 15); }
                    else if (sub == 1) { if (PHON(6)) phase_cml(p); }
                    else if (sub == 2) { if (PHON(6)) phase_ml2(p, lds); }
                    else if (sub == 3) { if (PHON(7)) phase_zml(p); }
                    else { if (PHON(2)) phase_gemm_jobs(p, lds, 18, 19); }
                } else {
                    if (sub == 0) { if (PHON(2)) phase_gemm_jobs(p, lds, 15, 16); }
                    else if (sub == 1) { if (PHON(8)) phase_rt2(p, lds); }
                    else if (sub == 2) { if (PHON(9)) phase_zrt(p); }
                    else { if (PHON(2)) phase_gemm_jobs(p, lds, 19, 20); }
                }
            } else {
                const int ts = sub - ntail;
                const bf16_t* ymix = (const bf16_t*)(S + (kind == 2 ? 1 : 6) * SLOT);
                bf16_t* hm = (bf16_t*)(S + (kind == 2 ? 2 : 7) * SLOT);
                bf16_t* H = (bf16_t*)(S + (kind == 0 ? 2 : (kind == 1 ? 5 : 3)) * SLOT);
                if (ts == 0) { if (PHON(10)) phase_ln1(p, L, lds, ymix, hm); }
                else if (ts == 1) { if (PHON(11)) phase_moe<0>(p, L, lds, hm, H); }
                else if (ts == 2) { if (PHON(12)) phase_moe<1>(p, L, lds, hm, H); }
                else { if (PHON(13)) phase_ln2(p, L); }
            }
        }
#ifdef DUP_PHASE
        if (((DUP_PHASE >> ph) & 1u) && !dup_done_) { dup_done_ = true; xcd_barrier(bar); --ph; continue; }
        dup_done_ = false;
#endif
        if (ph + 1 < ph_hi_) xcd_barrier(bar);
    }
#ifdef TIMEIT
    {
        xcd_barrier(bar);
        unsigned* tw = (unsigned*)(p.ws + OFF_CTL + 32768);
        if (blockIdx.x == 0 && threadIdx.x == 0) {
            if (t1_ == 0) t1_ = __builtin_amdgcn_s_memrealtime();
            const unsigned long long dt = t1_ - t0_;
            unsigned ms2 = (unsigned)((dt + TIME_U / 2) / TIME_U);
            __hip_atomic_store(tw, ms2, __ATOMIC_RELAXED, __HIP_MEMORY_SCOPE_AGENT);
        }
        xcd_barrier(bar);
        const float c_ = sqrtf((float)__hip_atomic_load(tw, __ATOMIC_RELAXED, __HIP_MEMORY_SCOPE_AGENT));
        for (size_t i = (size_t)blockIdx.x * 256 + threadIdx.x; i < (size_t)NTOK * DM; i += (size_t)gridDim.x * 256) p.out[i] = c_;
    }
#endif
#ifdef DBG_STOP
    if (ph_lo_ != 100) {
        xcd_barrier(bar);
        const float* src = (const float*)(p.ws + DBG_SRC);
        for (size_t i = (size_t)blockIdx.x * 256 + threadIdx.x; i < (size_t)NTOK * DM; i += (size_t)gridDim.x * 256) {
            float v = DBG_BF16 ? bf2f(((const bf16_t*)src)[i]) : src[i];
            if (!(fabsf(v) < 1e30f)) v = 1e30f;
            p.out[i] = v;
        }
    }
#endif
}

constexpr int LDS_BYTES = 73728 + 64;
extern "C" void kernel_launch(void* const* d_in, const int* in_sizes, int n_in, void* d_out, int out_size, void* d_ws, size_t ws_size, hipStream_t stream) {
    static int grid = 0;
    if (grid == 0) {
        if (n_in != 43 || out_size != NTOK * DM || ws_size < WS_NEED) { fprintf(stderr, "kernel_launch: unexpected shapes (n_in %d out %d ws %zu need %zu)\n", n_in, out_size, ws_size, (size_t)WS_NEED); }
        int dev = 0, cus = 0, per_cu = 0;
        (void)hipGetDevice(&dev); (void)hipDeviceGetAttribute(&cus, hipDeviceAttributeMultiprocessorCount, dev);
        (void)hipFuncSetAttribute((const void*)mega, hipFuncAttributeMaxDynamicSharedMemorySize, LDS_BYTES);
        (void)hipOccupancyMaxActiveBlocksPerMultiprocessor(&per_cu, (const void*)mega, 256, LDS_BYTES);
        if (per_cu > 2) per_cu = 2;
        if (per_cu < 1) per_cu = 1;
        grid = cus * per_cu;
        if (grid > 512) grid = 512;
        (void)hipGetLastError();
    }
    Params p{};
    for (int i = 0; i < 43; ++i) p.in[i] = (const float*)d_in[i];
    p.out = (float*)d_out; p.ws = (char*)d_ws;
    char* ws = (char*)d_ws;
    auto slot = [&](int i) { return (bf16_t*)(ws + OFF_SLOT + (size_t)i * SLOT); };
    int tile = 0;
    auto addg = [&](int idx, const bf16_t* A, const bf16_t* Bt, bf16_t* out, int K, int N, int ldo, int mode) {
        GJob& g = p.gj[idx]; g.A = A; g.Bt = Bt; g.out = out; g.K = K; g.N = N; g.ldo = ldo; g.mode = mode; g.half = (mode <= MODE_SIGM && N <= 128) ? 1 : 0; g.ntn = g.half ? (N + 63) / 64 : (N + 127) / 128; g.tile0 = tile; tile += 128 * g.ntn;
    };
    for (int jr = 0; jr < 2; ++jr) {
        const bf16_t* rkv = (const bf16_t*)(ws + W_RKV) + (size_t)jr * 3 * 1024 * 1024;
        addg(jr * 7 + 0, slot(0), rkv, slot(6), 1024, 1024, 1024, MODE_BF16);
        addg(jr * 7 + 1, slot(1), rkv + 1024 * 1024, slot(7), 1024, 1024, 1024, MODE_BF16);
        addg(jr * 7 + 2, slot(2), rkv + 2 * 1024 * 1024, slot(jr == 0 ? 11 : 8), 1024, 1024, 1024, MODE_BF16);
        addg(jr * 7 + 3, slot(3), (const bf16_t*)(ws + W_W1T) + (size_t)jr * 64 * 1024, (bf16_t*)(ws + OFF_LW), 1024, 64, 64, MODE_TANH);
        addg(jr * 7 + 4, slot(4), (const bf16_t*)(ws + W_A1T) + (size_t)jr * 64 * 1024, (bf16_t*)(ws + OFF_LA), 1024, 64, 64, MODE_BF16);
        addg(jr * 7 + 5, slot(5), (const bf16_t*)(ws + W_G1T) + (size_t)jr * 128 * 1024, (bf16_t*)(ws + OFF_LG), 1024, 128, 128, MODE_SIGM);
        addg(jr * 7 + 6, slot(2), (const bf16_t*)(ws + W_V1T), (bf16_t*)(ws + OFF_LV), 1024, 32, 32, MODE_BF16);
    }
    addg(14, slot(0), (const bf16_t*)(ws + W_MLIN), nullptr, 1024, 3088, 0, MODE_ML1);
    addg(15, slot(0), (const bf16_t*)(ws + W_RTIN), nullptr, 1024, 6144, 0, MODE_RT1);
    addg(16, slot(7), (const bf16_t*)(ws + W_OUT), slot(6), 1024, 1024, 1024, MODE_BF16);
    addg(17, slot(7), (const bf16_t*)(ws + W_OUT) + 1024 * 1024, slot(6), 1024, 1024, 1024, MODE_BF16);
    addg(18, slot(1), (const bf16_t*)(ws + W_MLOUT), slot(6), 1024, 1024, 1024, MODE_BF16);
    addg(19, slot(3), (const bf16_t*)(ws + W_RTOUT), slot(1), 2048, 1024, 1024, MODE_BF16);
    int nc = 0, ctile = 0;
    auto addc = [&](const float* src, size_t dst_off, int K, int N, int nb, long sbs, long dbs, int mode) {
        CJob& c = p.cj[nc++]; c.src = src; c.dst = (bf16_t*)(ws + dst_off); c.K = K; c.N = N; c.nb = nb; c.mode = mode; c.sbs = sbs; c.dbs = dbs;
        c.tiles_pb = ((K + 63) / 64) * ((N + 255) / 256); c.tile0 = ctile; ctile += c.tiles_pb * nb;
    };
    addc(p.in[7], W_RKV, 1024, 1024, 6, 1024 * 1024, 1024 * 1024, 0);
    addc(p.in[24], W_OUT, 1024, 1024, 2, 1024 * 1024, 1024 * 1024, 0);
    addc(p.in[9], W_W1T, 1024, 64, 2, 1024 * 64, 64 * 1024, 0);
    addc(p.in[12], W_A1T, 1024, 64, 2, 1024 * 64, 64 * 1024, 0);
    addc(p.in[17], W_G1T, 1024, 128, 2, 1024 * 128, 128 * 1024, 0);
    addc(p.in[15], W_V1T, 1024, 32, 1, 0, 0, 0);
    addc(p.in[10], W_W2T, 64, 1024, 2, 64 * 1024, 1024 * 64, 0);
    addc(p.in[13], W_A2T, 64, 1024, 2, 64 * 1024, 1024 * 64, 0);
    addc(p.in[18], W_G2T, 128, 1024, 2, 128 * 1024, 1024 * 128, 0);
    addc(p.in[16], W_V2T, 32, 1024, 1, 0, 0, 0);
    addc(p.in[25], W_MLIN, 1024, 3088, 1, 0, 0, 0);
    addc(p.in[31], W_MLOUT, 1024, 1024, 1, 0, 0, 0);
    addc(p.in[32], W_RTIN, 1024, 6144, 1, 0, 0, 3);
    addc(p.in[35], W_RTOUT, 2048, 1024, 1, 0, 0, 0);
    addc(p.in[40], W_MOE13, 1024, 512, 128, 1024 * 512, 1024 * 1024, 1);
    addc(p.in[41], W_MOE13, 1024, 512, 128, 1024 * 512, 1024 * 1024, 2);
    addc(p.in[42], W_MOE2, 512, 1024, 128, 512 * 1024, 1024 * 512, 0);
    p.ncj = nc; p.cj_tiles = ctile;

    (void)hipMemsetAsync(ws + OFF_CTL, 0, CTL_BYTES, stream);
#ifdef DBG_STOP
    const int nph = DBG_STOP;
#else
    const int nph = NPHASE;
#endif
#ifdef MULTI_LAUNCH
    for (int ph = 0; ph < nph; ++ph) { p.ph_lo = ph; p.ph_hi = ph + 1; hipLaunchKernelGGL(mega, dim3(grid), dim3(256), LDS_BYTES, stream, p); }
    if (0)
#endif
    {
        p.ph_lo = 0; p.ph_hi = nph;
        void* args[] = {&p};
        hipError_t e = hipLaunchCooperativeKernel((const void*)mega, dim3(grid), dim3(256), args, LDS_BYTES, stream);
        if (e != hipSuccess) fprintf(stderr, "cooperative launch failed: %s (grid %d)\n", hipGetErrorString(e), grid);
    }
}
```

```cpp
#include <hip/hip_runtime.h>
#include <cstdio>
#include <cstdint>

#ifndef ONE_LAUNCH
#define ONE_LAUNCH 0
#endif

typedef unsigned short bf16_t;
typedef short bf16x8 __attribute__((ext_vector_type(8)));
typedef float f32x4 __attribute__((ext_vector_type(4)));
#define LAS __attribute__((address_space(3)))
#define GAS __attribute__((address_space(1)))
typedef float f32x4g_t __attribute__((ext_vector_type(4)));
typedef unsigned u32x2g_t __attribute__((ext_vector_type(2)));
typedef unsigned u32x4g_t __attribute__((ext_vector_type(4)));
__device__ __forceinline__ float4 gld_f4(const float* p) { const f32x4g_t v = *(const GAS f32x4g_t*)(const GAS char*)(const char*)p; return make_float4(v[0], v[1], v[2], v[3]); }
__device__ __forceinline__ uint2 gld_u2(const void* p) { const u32x2g_t v = *(const GAS u32x2g_t*)(const GAS char*)(const char*)p; return make_uint2(v[0], v[1]); }
__device__ __forceinline__ uint4 gld_u4(const void* p) { const u32x4g_t v = *(const GAS u32x4g_t*)(const GAS char*)(const char*)p; return make_uint4(v[0], v[1], v[2], v[3]); }
__device__ __forceinline__ void gst_f4(float* p, float a, float b, float c, float d) { const f32x4g_t v = {a, b, c, d}; *(GAS f32x4g_t*)(GAS char*)(char*)p = v; }
__device__ __forceinline__ void gst_u2(void* p, unsigned a, unsigned b) { const u32x2g_t v = {a, b}; *(GAS u32x2g_t*)(GAS char*)(char*)p = v; }
__device__ __forceinline__ void gst_u4(void* p, unsigned a, unsigned b, unsigned c, unsigned d) { const u32x4g_t v = {a, b, c, d}; *(GAS u32x4g_t*)(GAS char*)(char*)p = v; }

constexpr int NTOK = 16384, DM = 1024, TSEQ = 2048, NBATCH = 8;
constexpr float DN_ALPHA = 1.681792830507429f;
constexpr float LN_EPS = 1e-5f;
constexpr size_t MB = 1u << 20;
constexpr size_t OFF_CTL = 0, OFF_CNT = 16384, CTL_BYTES = 65536;
constexpr size_t OFF_MOD = 65536;
constexpr size_t OFF_ROT = 1 * MB;
constexpr size_t OFF_BONUS = 3 * MB, OFF_GATES = 4 * MB, OFF_STAT = 5 * MB, OFF_LW = 13 * MB, OFF_LA = 15 * MB, OFF_LG = 17 * MB, OFF_LV = 21 * MB,
                 OFF_WGT = 22 * MB, OFF_LIST = 23 * MB, OFF_RTW = 25 * MB;
constexpr size_t OFF_W = 32 * MB;
constexpr size_t W_RKV = OFF_W, W_OUT = W_RKV + 12 * MB, W_W1T = W_OUT + 4 * MB, W_A1T = W_W1T + 256 * 1024, W_G1T = W_A1T + 256 * 1024, W_V1T = W_G1T + 512 * 1024,
                 W_W2T = W_V1T + 64 * 1024, W_A2T = W_W2T + 256 * 1024, W_G2T = W_A2T + 256 * 1024, W_V2T = W_G2T + 512 * 1024, W_MLIN = W_V2T + 64 * 1024 + 832 * 1024,
                 W_MLOUT = W_MLIN + 6400 * 1024, W_RTIN = W_MLOUT + 2 * MB, W_RTOUT = W_RTIN + 12 * MB, W_MOE13 = W_RTOUT + 4 * MB, W_MOE2 = W_MOE13 + 256 * MB,
                 W_END = W_MOE2 + 128 * MB;
constexpr size_t OFF_XRES = 464 * MB;
constexpr size_t OFF_SLOT = 528 * MB, SLOT = 32 * MB;
static_assert(W_END <= OFF_XRES, "weights overflow");
constexpr size_t OFF_XRES2 = OFF_SLOT + 12 * SLOT;
constexpr size_t WS_NEED = OFF_XRES2 + 2 * SLOT;
constexpr int LIST_CAP = 16384;

#define XB_TMO      128
#define XB_XCNT(j)  (256  + 64 * (j))
#define XB_XSUB(j)  (1280 + 64 * (j))
#define XB_XGEN(j)  (2304 + 64 * (j))
#define XB_TOP      3328
#define XB_TOPGEN   3392
#define XCD_BAR_WORDS 3456
#define XB_SPIN_CAP (1u << 22)
__device__ __forceinline__ unsigned xb_ld(unsigned* p)              { return __hip_atomic_load(p, __ATOMIC_RELAXED, __HIP_MEMORY_SCOPE_AGENT); }
__device__ __forceinline__ unsigned xb_add(unsigned* p, unsigned v) { return __hip_atomic_fetch_add(p, v, __ATOMIC_RELAXED, __HIP_MEMORY_SCOPE_AGENT); }
__device__ __forceinline__ unsigned xb_xcc_id() { return (unsigned)__builtin_amdgcn_s_getreg((3 << 11) | 20) & 0xFu; }
#define XB_SPIN(cond, bar) do { unsigned _sp = 0; while (cond) { __builtin_amdgcn_s_sleep(1); \
    if ((++_sp & 255u) == 0u) { if (xb_ld(&(bar)[XB_TMO])) break; if (_sp > XB_SPIN_CAP) { atomicAdd(&(bar)[XB_TMO], 1u); break; } } } } while (0)
struct XcdBarrier { unsigned* bar; unsigned x; volatile LAS unsigned* st; };
__device__ __forceinline__ XcdBarrier xcd_barrier_post(unsigned* bar, volatile LAS unsigned* st) {
    XcdBarrier b; b.bar = bar; b.x = xb_xcc_id(); b.st = st;
    if (threadIdx.x == 0) (void)xb_add(&bar[XB_XCNT(b.x)], 1u);
    return b;
}
__device__ __forceinline__ void xcd_barrier_complete(unsigned* bar, unsigned x, unsigned& nloc, unsigned& nx) {
    const unsigned G = gridDim.x;
    unsigned sum, cnt, mine, sp = 0u;
    for (;;) {
        sum = 0u; cnt = 0u; mine = 0u;
#pragma unroll
        for (unsigned j = 0; j < 16; ++j) { const unsigned c = xb_ld(&bar[XB_XCNT(j)]); sum += c; cnt += (c > 0u) ? 1u : 0u; mine = (j == x) ? c : mine; }
        if (sum == G) break;
        __builtin_amdgcn_s_sleep(1);
        if ((++sp & 255u) == 0u) { if (xb_ld(&bar[XB_TMO])) break; if (sp > XB_SPIN_CAP) { atomicAdd(&bar[XB_TMO], 1u); break; } }
    }
    nloc = mine > 0u ? mine : 1u; nx = cnt > 0u ? cnt : 1u;
}
__device__ __forceinline__ void xcd_barrier(const XcdBarrier& b) {
    asm volatile("s_waitcnt vmcnt(0)" ::: "memory");
    __syncthreads();
    if (threadIdx.x == 0) {
        unsigned* bar = b.bar;
        __builtin_amdgcn_s_waitcnt(0);
        unsigned nloc = b.st[0], nx = b.st[1];
        if (nloc == 0u) { xcd_barrier_complete(bar, b.x, nloc, nx); b.st[0] = nloc; b.st[1] = nx; }
        const unsigned old = xb_add(&bar[XB_XSUB(b.x)], 1u);
        const unsigned gen = old / nloc;
        if (old + 1u == (gen + 1u) * nloc) {
            __builtin_amdgcn_fence(__ATOMIC_RELEASE, "agent");
            asm volatile("s_waitcnt vmcnt(0)" ::: "memory");
            const unsigned og = xb_add(&bar[XB_TOP], 1u);
            const unsigned tg = og / nx;
            if (og + 1u == (tg + 1u) * nx) xb_add(&bar[XB_TOPGEN], 1u);
            else XB_SPIN(xb_ld(&bar[XB_TOPGEN]) == tg, bar);
            __builtin_amdgcn_fence(__ATOMIC_ACQUIRE, "agent");
            xb_add(&bar[XB_XGEN(b.x)], 1u);
            asm volatile("s_waitcnt vmcnt(0)" ::: "memory");
        } else {
            XB_SPIN(xb_ld(&bar[XB_XGEN(b.x)]) == gen, bar);
            __builtin_amdgcn_fence(__ATOMIC_ACQUIRE, "agent");
            asm volatile("s_waitcnt vmcnt(0)" ::: "memory");
        }
    }
    __syncthreads();
}

__device__ __forceinline__ int tidx() { int t = threadIdx.x; asm volatile("" : "+v"(t)); return t; }
typedef __bf16 bf16x2_t __attribute__((ext_vector_type(2)));
typedef float f32x2_t __attribute__((ext_vector_type(2)));
__device__ __forceinline__ unsigned cvt_pk(float lo, float hi) {
    f32x2_t v = {lo, hi}; bf16x2_t r = __builtin_convertvector(v, bf16x2_t);
    unsigned u; __builtin_memcpy(&u, &r, 4); return u;
}
__device__ __forceinline__ bf16_t f2bf(float f) { return (bf16_t)(cvt_pk(f, 0.f) & 0xffffu); }
__device__ __forceinline__ float bflo(unsigned u) { return __uint_as_float(u << 16); }
__device__ __forceinline__ float bfhi(unsigned u) { return __uint_as_float(u & 0xffff0000u); }
__device__ __forceinline__ float bf2f(bf16_t u) { return __uint_as_float(((unsigned)u) << 16); }
__device__ __forceinline__ void unpack8(const uint4& u, float (&f)[8]) {
    f[0] = bflo(u.x); f[1] = bfhi(u.x); f[2] = bflo(u.y); f[3] = bfhi(u.y); f[4] = bflo(u.z); f[5] = bfhi(u.z); f[6] = bflo(u.w); f[7] = bfhi(u.w);
}
__device__ __forceinline__ uint4 pack8(const float (&f)[8]) { uint4 u; u.x = cvt_pk(f[0], f[1]); u.y = cvt_pk(f[2], f[3]); u.z = cvt_pk(f[4], f[5]); u.w = cvt_pk(f[6], f[7]); return u; }
typedef unsigned u32x4_t __attribute__((ext_vector_type(4)));
__device__ __forceinline__ uint4 gload16(const void* p) {
    const u32x4_t v = *(const __attribute__((address_space(1))) u32x4_t*)p;
    return make_uint4(v[0], v[1], v[2], v[3]);
}
__device__ __forceinline__ float sigmoidf_(float x) { return __builtin_amdgcn_rcpf(1.0f + __expf(-x)); }
__device__ __forceinline__ float siluf_(float x) { return x * __builtin_amdgcn_rcpf(1.0f + __expf(-x)); }
__device__ __forceinline__ float tanhf_(float x) { return 1.0f - 2.0f * __builtin_amdgcn_rcpf(1.0f + __expf(2.0f * x)); }
__device__ __forceinline__ float softplusf_(float x) { return fmaxf(x, 0.f) + __logf(1.0f + __expf(-fabsf(x))); }
__device__ __forceinline__ float row16_sum(float v);
__device__ __forceinline__ float xor16_add(float v) { const auto r = __builtin_amdgcn_permlane16_swap(__float_as_uint(v), __float_as_uint(v), false, false); return __uint_as_float(r[0]) + __uint_as_float(r[1]); }
__device__ __forceinline__ float xor32_add(float v) { const auto r = __builtin_amdgcn_permlane32_swap(__float_as_uint(v), __float_as_uint(v), false, false); return __uint_as_float(r[0]) + __uint_as_float(r[1]); }
__device__ __forceinline__ float wave_sum(float v) {
    v = row16_sum(v); v = xor16_add(v); v = xor32_add(v);
    return v;
}
__device__ __forceinline__ float row16_sum(float v) {
    v += __builtin_amdgcn_update_dpp(0.f, v, 0x128, 0xf, 0xf, false);
    v += __builtin_amdgcn_update_dpp(0.f, v, 0x124, 0xf, 0xf, false);
    v += __builtin_amdgcn_update_dpp(0.f, v, 0x122, 0xf, 0xf, false);
    v += __builtin_amdgcn_update_dpp(0.f, v, 0x121, 0xf, 0xf, false);
    return v;
}
__device__ __forceinline__ float oct_sum(float v) {
    v += __builtin_amdgcn_update_dpp(0.f, v, 0xB1, 0xf, 0xf, false);
    v += __builtin_amdgcn_update_dpp(0.f, v, 0x4E, 0xf, 0xf, false);
    v += __builtin_amdgcn_update_dpp(0.f, v, 0x141, 0xf, 0xf, false);
    return v;
}

enum { MODE_BF16 = 0, MODE_TANH = 1, MODE_SIGM = 2, MODE_ML1 = 3, MODE_RT1 = 4 };
struct GJob { const bf16_t* A; const bf16_t* Bt; bf16_t* out; int K, N, ldo, mode, ntn, tile0, half; };
struct CJob { const float* src; bf16_t* dst; int K, N, nb, mode; long sbs, dbs; int tiles_pb, tile0; };
constexpr int NGJ = 20, NCJ = 24;
struct Params {
    const float* in[43]; float* out; char* ws;
    int ph_lo, ph_hi, ncj, cj_tiles;
    GJob gj[NGJ];
    CJob cj[NCJ];
};
#define CAS __attribute__((address_space(4)))
typedef const CAS Params& PRef;

__device__ __forceinline__ f32x4 mfma16(const uint4& a, const uint4& b, f32x4 c) {
    bf16x8 av, bv; __builtin_memcpy(&av, &a, 16); __builtin_memcpy(&bv, &b, 16);
    return __builtin_amdgcn_mfma_f32_16x16x32_bf16(av, bv, c, 0, 0, 0);
}
template <bool PFA = true, class AL, class BL>
__device__ __forceinline__ void gemm_mainloop(char* lds, int nk, const AL& al, const BL& bl, f32x4 (&acc)[4][4]) {
    const int t = tidx(), c = t & 7, r0 = t >> 3;
    const int lane = t & 63, wid = t >> 6, wr = wid >> 1, wc = wid & 1, fr = lane & 15, fq = lane >> 4;
    typename AL::Raw ra[4]; typename BL::Raw rb[4];
    const int woff = r0 * 128 + ((c ^ (r0 & 7)) << 4);
#pragma unroll
    for (int i = 0; i < 4; ++i) { if (PFA) ra[i] = al.fetch(i, r0 + 32 * i, c); rb[i] = bl.fetch(i, r0 + 32 * i, c); }
#pragma unroll
    for (int i = 0; i < 4; ++i) {
        if (!PFA) { ra[i] = al.fetch(i, r0 + 32 * i, c); }
        *(uint4*)(lds + woff + i * 4096) = al.finish(ra[i], i, r0 + 32 * i, c);
        *(uint4*)(lds + 16384 + woff + i * 4096) = bl.finish(rb[i], i, r0 + 32 * i, c);
        if (!PFA) asm volatile("" ::: "memory");
    }
#pragma unroll
    for (int m = 0; m < 4; ++m)
#pragma unroll
        for (int n = 0; n < 4; ++n) acc[m][n] = (f32x4){0.f, 0.f, 0.f, 0.f};
    __syncthreads();
    const int aoff = (wr * 64 + fr) * 128, boff = 16384 + (wc * 64 + fr) * 128, sw = fr & 7;
    for (int kt = 0; kt < nk; ++kt) {
        const bool more = (kt + 1 < nk);
        if (more) {
#pragma unroll
            for (int i = 0; i < 4; ++i) { if (PFA) ra[i] = al.fetch(i, r0 + 32 * i, (kt + 1) * 8 + c); rb[i] = bl.fetch(i, r0 + 32 * i, (kt + 1) * 8 + c); }
        }
        const char* buf = lds + (kt & 1) * 32768;
#pragma unroll
        for (int ks = 0; ks < 2; ++ks) {
            uint4 af[4], bfm[4];
            const int ch = ((ks * 4 + fq) ^ sw) << 4;
#pragma unroll
            for (int m = 0; m < 4; ++m) af[m] = *(const uint4*)(buf + aoff + m * 2048 + ch);
#pragma unroll
            for (int n = 0; n < 4; ++n) bfm[n] = *(const uint4*)(buf + boff + n * 2048 + ch);
#pragma unroll
            for (int m = 0; m < 4; ++m)
#pragma unroll
                for (int n = 0; n < 4; ++n) acc[m][n] = mfma16(bfm[n], af[m], acc[m][n]);
        }
        if (more) {
            char* nb = lds + ((kt + 1) & 1) * 32768;
#pragma unroll
            for (int i = 0; i < 4; ++i) {
                if (!PFA) ra[i] = al.fetch(i, r0 + 32 * i, (kt + 1) * 8 + c);
                *(uint4*)(nb + woff + i * 4096) = al.finish(ra[i], i, r0 + 32 * i, (kt + 1) * 8 + c);
                *(uint4*)(nb + 16384 + woff + i * 4096) = bl.finish(rb[i], i, r0 + 32 * i, (kt + 1) * 8 + c);
                if (!PFA) asm volatile("" ::: "memory");
            }
        }
        __syncthreads();
    }
}
__device__ __forceinline__ void glds16(const bf16_t* g, char* l) {
    __builtin_amdgcn_global_load_lds((const unsigned*)g, (LAS unsigned*)l, 16, 0, 0);
}
__device__ __forceinline__ void glds16_asm(const void* gsrc, unsigned lds_dst) {
    unsigned keep;
    asm volatile("s_mov_b32 %0, m0\n\ts_mov_b32 m0, %2\n\ts_nop 0\n\tglobal_load_lds_dwordx4 %1, off\n\ts_mov_b32 m0, %0" : "=&s"(keep) : "v"(gsrc), "s"(lds_dst) : "memory");
}
__device__ __forceinline__ unsigned lds_addr_u(const char* l) { return (unsigned)(size_t)(const LAS char*)l; }
__device__ __forceinline__ int glds_chunk(int t) { return (t & 7) ^ ((t >> 3) & 7); }
__device__ __forceinline__ void mma_ktile(const char* buf, int aoff, int boff, int sw, int fq, f32x4 (&acc)[4][4]) {
    const int ch0 = ((0 * 4 + fq) ^ sw) << 4, ch1 = ((1 * 4 + fq) ^ sw) << 4;
    const char* pa = buf + aoff; const char* pb = buf + boff;
    uint4 a0[4], a1[4], b[8];
#pragma unroll
    for (int m = 0; m < 4; ++m) a0[m] = *(const uint4*)(pa + m * 2048 + ch0);
    b[0] = *(const uint4*)(pb + ch0); b[1] = *(const uint4*)(pb + 2048 + ch0);
    __builtin_amdgcn_sched_barrier(0);
    b[2] = *(const uint4*)(pb + 2 * 2048 + ch0);
#pragma unroll
    for (int m = 0; m < 4; ++m) acc[m][0] = mfma16(b[0], a0[m], acc[m][0]);
    __builtin_amdgcn_sched_barrier(0);
    b[3] = *(const uint4*)(pb + 3 * 2048 + ch0);
#pragma unroll
    for (int m = 0; m < 4; ++m) acc[m][1] = mfma16(b[1], a0[m], acc[m][1]);
    __builtin_amdgcn_sched_barrier(0);
#pragma unroll
    for (int m = 0; m < 4; ++m) a1[m] = *(const uint4*)(pa + m * 2048 + ch1);
#pragma unroll
    for (int m = 0; m < 4; ++m) acc[m][2] = mfma16(b[2], a0[m], acc[m][2]);
    __builtin_amdgcn_sched_barrier(0);
    b[4] = *(const uint4*)(pb + ch1); b[5] = *(const uint4*)(pb + 2048 + ch1);
#pragma unroll
    for (int m = 0; m < 4; ++m) acc[m][3] = mfma16(b[3], a0[m], acc[m][3]);
    __builtin_amdgcn_sched_barrier(0);
    b[6] = *(const uint4*)(pb + 2 * 2048 + ch1);
#pragma unroll
    for (int m = 0; m < 4; ++m) acc[m][0] = mfma16(b[4], a1[m], acc[m][0]);
    __builtin_amdgcn_sched_barrier(0);
    b[7] = *(const uint4*)(pb + 3 * 2048 + ch1);
#pragma unroll
    for (int m = 0; m < 4; ++m) acc[m][1] = mfma16(b[5], a1[m], acc[m][1]);
    __builtin_amdgcn_sched_barrier(0);
#pragma unroll
    for (int m = 0; m < 4; ++m) acc[m][2] = mfma16(b[6], a1[m], acc[m][2]);
#pragma unroll
    for (int m = 0; m < 4; ++m) acc[m][3] = mfma16(b[7], a1[m], acc[m][3]);
}
__device__ __forceinline__ void gemm_gg(char* lds, int nk, const bf16_t* const (&ar)[4], const bf16_t* const (&br)[4], f32x4 (&acc)[4][4]) {
    const int t = tidx();
    const int lane = t & 63, wid = t >> 6, wr = wid >> 1, wc = wid & 1, fr = lane & 15, fq = lane >> 4;
    const unsigned wbs = (unsigned)__builtin_amdgcn_readfirstlane((int)(lds_addr_u(lds) + wid * 1024));
#pragma unroll
    for (int i = 0; i < 4; ++i) { glds16_asm(ar[i], wbs + i * 4096); glds16_asm(br[i], wbs + 16384 + i * 4096); }
#pragma unroll
    for (int m = 0; m < 4; ++m)
#pragma unroll
        for (int n = 0; n < 4; ++n) acc[m][n] = (f32x4){0.f, 0.f, 0.f, 0.f};
    asm volatile("s_waitcnt vmcnt(0)" ::: "memory");
    __syncthreads();
    const int aoff = (wr * 64 + fr) * 128, boff = 16384 + (wc * 64 + fr) * 128, sw = fr & 7;
    for (int kt = 0; kt < nk; ++kt) {
        if (kt + 1 < nk) {
            const unsigned nb = (unsigned)__builtin_amdgcn_readfirstlane((int)(wbs + ((kt + 1) & 1) * 32768));
#pragma unroll
            for (int i = 0; i < 4; ++i) { glds16_asm(ar[i] + (kt + 1) * 64, nb + i * 4096); glds16_asm(br[i] + (kt + 1) * 64, nb + 16384 + i * 4096); }
        }
        mma_ktile(lds + (kt & 1) * 32768, aoff, boff, sw, fq, acc);
        asm volatile("s_waitcnt vmcnt(0)" ::: "memory");
        __syncthreads();
    }
}
__device__ __forceinline__ void gemm_hn(char* lds, int nk, const bf16_t* const (&ar)[4], const bf16_t* const (&br)[2], f32x4 (&acc)[2][4]) {
    const int t = tidx();
    const int lane = t & 63, wid = t >> 6, fr = lane & 15, fq = lane >> 4;
    const unsigned wbs = (unsigned)__builtin_amdgcn_readfirstlane((int)(lds_addr_u(lds) + wid * 1024));
#pragma unroll
    for (int i = 0; i < 4; ++i) glds16_asm(ar[i], wbs + i * 4096);
#pragma unroll
    for (int i = 0; i < 2; ++i) glds16_asm(br[i], wbs + 16384 + i * 4096);
#pragma unroll
    for (int m = 0; m < 2; ++m)
#pragma unroll
        for (int n = 0; n < 4; ++n) acc[m][n] = (f32x4){0.f, 0.f, 0.f, 0.f};
    asm volatile("s_waitcnt vmcnt(0)" ::: "memory");
    __syncthreads();
    const int aoff = (wid * 32 + fr) * 128, boff = 16384 + fr * 128, sw = fr & 7;
    for (int kt = 0; kt < nk; ++kt) {
        if (kt + 1 < nk) {
            const unsigned nb = (unsigned)__builtin_amdgcn_readfirstlane((int)(wbs + ((kt + 1) & 1) * 32768));
#pragma unroll
            for (int i = 0; i < 4; ++i) glds16_asm(ar[i] + (kt + 1) * 64, nb + i * 4096);
#pragma unroll
            for (int i = 0; i < 2; ++i) glds16_asm(br[i] + (kt + 1) * 64, nb + 16384 + i * 4096);
        }
        const char* buf = lds + (kt & 1) * 32768;
#pragma unroll
        for (int ks = 0; ks < 2; ++ks) {
            const int ch = ((ks * 4 + fq) ^ sw) << 4;
            uint4 af[2], bfm[4];
#pragma unroll
            for (int m = 0; m < 2; ++m) af[m] = *(const uint4*)(buf + aoff + m * 2048 + ch);
#pragma unroll
            for (int n = 0; n < 4; ++n) bfm[n] = *(const uint4*)(buf + boff + n * 2048 + ch);
#pragma unroll
            for (int m = 0; m < 2; ++m)
#pragma unroll
                for (int n = 0; n < 4; ++n) acc[m][n] = mfma16(bfm[n], af[m], acc[m][n]);
        }
        asm volatile("s_waitcnt vmcnt(0)" ::: "memory");
        __syncthreads();
    }
}
template <class AL>
__device__ __forceinline__ void gemm_rg(char* lds, int nk, const AL& al, const bf16_t* const (&br)[4], f32x4 (&acc)[4][4]) {
    const int t = tidx(), c = t & 7, r0 = t >> 3;
    const int lane = t & 63, wid = t >> 6, wr = wid >> 1, wc = wid & 1, fr = lane & 15, fq = lane >> 4;
    char* wb = lds + wid * 1024;
    const int woff = r0 * 128 + ((c ^ (r0 & 7)) << 4);
#pragma unroll
    for (int i = 0; i < 4; ++i) glds16(br[i], wb + 16384 + i * 4096);
#pragma unroll
    for (int i = 0; i < 4; ++i) {
        typename AL::Raw ra = al.fetch(i, r0 + 32 * i, c);
        *(uint4*)(lds + woff + i * 4096) = al.finish(ra, i, r0 + 32 * i, c);
        asm volatile("" ::: "memory");
    }
#pragma unroll
    for (int m = 0; m < 4; ++m)
#pragma unroll
        for (int n = 0; n < 4; ++n) acc[m][n] = (f32x4){0.f, 0.f, 0.f, 0.f};
    asm volatile("s_waitcnt vmcnt(0)" ::: "memory");
    __syncthreads();
    const int aoff = (wr * 64 + fr) * 128, boff = 16384 + (wc * 64 + fr) * 128, sw = fr & 7;
    for (int kt = 0; kt < nk; ++kt) {
        const bool more = (kt + 1 < nk);
        char* nbuf = lds + ((kt + 1) & 1) * 32768;
        if (more) {
#pragma unroll
            for (int i = 0; i < 4; ++i) glds16(br[i] + (kt + 1) * 64, nbuf + wid * 1024 + 16384 + i * 4096);
        }
        mma_ktile(lds + (kt & 1) * 32768, aoff, boff, sw, fq, acc);
        if (more) {
#pragma unroll
            for (int i = 0; i < 4; ++i) {
                typename AL::Raw ra = al.fetch(i, r0 + 32 * i, (kt + 1) * 8 + c);
                *(uint4*)(nbuf + woff + i * 4096) = al.finish(ra, i, r0 + 32 * i, (kt + 1) * 8 + c);
                asm volatile("" ::: "memory");
            }
        }
        asm volatile("s_waitcnt vmcnt(0)" ::: "memory");
        __syncthreads();
    }
}
struct LdPlain {
    typedef uint4 Raw;
    const bf16_t* p; int ld; int nvalid;
    __device__ __forceinline__ uint4 fetch(int, int r, int kc) const { return (r < nvalid) ? *(const uint4*)(p + (size_t)r * ld + kc * 8) : make_uint4(0u, 0u, 0u, 0u); }
    __device__ __forceinline__ uint4 finish(const uint4& v, int, int, int) const { return v; }
};
struct LdGather {
    typedef uint4 Raw;
    const bf16_t* rp[4];
    __device__ __forceinline__ uint4 fetch(int i, int, int kc) const { const bf16_t* q = rp[i]; return q ? *(const uint4*)(q + kc * 8) : make_uint4(0u, 0u, 0u, 0u); }
    __device__ __forceinline__ uint4 finish(const uint4& v, int, int, int) const { return v; }
};
__device__ __forceinline__ void tile_map(int id, int NT, int& mt, int& nt) {
    const int x = id & 7, q = id >> 3;
    const int mg = q / (8 * NT), q2 = q - mg * 8 * NT, G = (NT + 7) >> 3;
    int g = q2 >> 6; g = g < G - 1 ? g : G - 1;
    const int r = q2 - (g << 6), w = (g == G - 1) ? NT - 8 * g : 8;
    mt = (mg * 8 + r / w) * 8 + x; nt = 8 * g + r % w;
}

__device__ __forceinline__ int conv_row(int mode, int n) {
    if (mode == 1) return (n >> 4) * 32 + (n & 15);
    if (mode == 2) return (n >> 4) * 32 + 16 + (n & 15);
    if (mode == 3 && n < 2048) { const int c = n & 255, c2 = c & 127; return (n & ~255) + (c2 >> 4) * 32 + ((c >> 7) << 4) + (c2 & 15); }
    return n;
}
__device__ __forceinline__ void phase_prologue(PRef p, char* lds) {
    const int t = tidx();
    const int n_ada = 8 * 48, n_rot = 256 + 144;
    float* mod = (float*)(p.ws + OFF_MOD);
    for (int it = blockIdx.x; it < n_ada + n_rot; it += gridDim.x) {
        if (it < n_ada) {
            const int pr = it / 48, cb = it % 48;
            float* sc = (float*)lds;
            float* red = (float*)(lds + 32768);
            for (int i = t; i < 8192; i += 256) { const int b = i >> 10, k = i & 1023; sc[k * 8 + b] = siluf_(p.in[1][b * 1024 + k]); }
            __syncthreads();
            const int kg = t >> 6, cl = t & 63, col = cb * 64 + cl;
            const float* W = p.in[2] + (size_t)pr * 1024 * 3072 + col;
            float a[8] = {0, 0, 0, 0, 0, 0, 0, 0};
#pragma unroll 8
            for (int k = kg * 256; k < kg * 256 + 256; ++k) {
                const float w = W[(size_t)k * 3072];
                const float4 s0 = *(const float4*)(sc + k * 8), s1 = *(const float4*)(sc + k * 8 + 4);
                a[0] += w * s0.x; a[1] += w * s0.y; a[2] += w * s0.z; a[3] += w * s0.w; a[4] += w * s1.x; a[5] += w * s1.y; a[6] += w * s1.z; a[7] += w * s1.w;
            }
#pragma unroll
            for (int b = 0; b < 8; ++b) red[(kg * 8 + b) * 64 + cl] = a[b];
            __syncthreads();
            for (int i = t; i < 512; i += 256) {
                const int b = i >> 6, c2 = i & 63;
                const float s = red[(0 * 8 + b) * 64 + c2] + red[(1 * 8 + b) * 64 + c2] + red[(2 * 8 + b) * 64 + c2] + red[(3 * 8 + b) * 64 + c2];
                mod[((size_t)pr * 8 + b) * 3072 + cb * 64 + c2] = s + p.in[3][pr * 3072 + cb * 64 + c2];
            }
            __syncthreads();
        } else if (it >= n_ada + 256 && it < n_ada + n_rot) {
            float* rtw = (float*)(p.ws + OFF_RTW);
            const int base = (it - n_ada - 256) * 1024;
            for (int e = base + t; e < base + 1024; e += 256) {
                const int L = e / (36 * 1024), o = (e >> 10) % 36, k = e & 1023;
                rtw[e] = (o < 4) ? p.in[36][((size_t)L * 1024 + k) * 4 + o] : p.in[38][((size_t)L * 1024 + k) * 32 + (o - 4)];
            }
        } else if (it < n_ada + 256) {
            float* rot = (float*)(p.ws + OFF_ROT);
            const int base = (it - n_ada) * 1024;
            for (int e = base + t; e < base + 1024; e += 256) {
                const int tt = e >> 7, i = e & 127;
                const float inv = __builtin_amdgcn_exp2f(-(float)i * (13.287712379549449f / 127.0f));
                const float ang = (float)tt * inv;
                float rev = ang * 0.15915494309189535f; rev -= floorf(rev);
                rot[e * 2] = __builtin_amdgcn_cosf(rev); rot[e * 2 + 1] = __builtin_amdgcn_sinf(rev);
            }
        }
    }
    {
        float* sm = (float*)lds;
        const int lane = t & 63, wv = t >> 6;
        const float* nsrc = nullptr; bf16_t* ndst = nullptr; int nK = 0, nN = 0, nmode = 0, nkt = 0, nnt = 0;
        float4 pv[16];
#define CJ_SETUP(ct_) { int c_ = (ct_), j_ = 0; while (j_ + 1 < p.ncj && c_ >= p.cj[j_ + 1].tile0) ++j_; \
            c_ -= p.cj[j_].tile0; const int tpb_ = p.cj[j_].tiles_pb; const int bi_ = c_ / tpb_, tl_ = c_ % tpb_; nK = p.cj[j_].K; nN = p.cj[j_].N; nmode = p.cj[j_].mode; \
            const int nNt_ = (nN + 255) >> 8; nkt = tl_ / nNt_; nnt = tl_ % nNt_; nsrc = p.cj[j_].src + (size_t)bi_ * p.cj[j_].sbs; ndst = p.cj[j_].dst + (size_t)bi_ * p.cj[j_].dbs; }
#define CJ_LOAD() { _Pragma("unroll") for (int i = 0; i < 16; ++i) { const int k = nkt * 64 + wv + 4 * i, n = nnt * 256 + lane * 4; \
            pv[i] = (k < nK && n < nN) ? gld_f4(nsrc + (size_t)k * nN + n) : make_float4(0.f, 0.f, 0.f, 0.f); } }
        int* const tick = (int*)(p.ws + OFF_CTL + 20480);
        int* const nbox = (int*)(lds + 66560);
        int ct = (int)blockIdx.x, ct2 = (int)gridDim.x + (int)blockIdx.x;
        if (ct < p.cj_tiles) { CJ_SETUP(ct); CJ_LOAD(); }
        while (ct < p.cj_tiles) {
#pragma unroll
            for (int i = 0; i < 16; ++i) *(float4*)(sm + (wv + 4 * i) * 260 + lane * 4) = pv[i];
            bf16_t* const sdst = ndst; const int sK = nK, sN = nN, smode = nmode, skt = nkt, snt = nnt;
            if (ct2 < p.cj_tiles) { CJ_SETUP(ct2); CJ_LOAD(); }
            if (t == 0) *nbox = 2 * (int)gridDim.x + atomicAdd(tick, 1);
            __syncthreads();
            const int ct3 = *nbox;
#pragma unroll
            for (int h2 = 0; h2 < 4; ++h2) {
                const int nl = lane + 64 * h2, n = snt * 256 + nl, k0 = skt * 64 + wv * 16;
                if (n < sN && k0 < sK) {
                    float f[8], g[8];
#pragma unroll
                    for (int q = 0; q < 8; ++q) { f[q] = sm[(wv * 16 + q) * 260 + nl]; g[q] = sm[(wv * 16 + 8 + q) * 260 + nl]; }
                    bf16_t* d = sdst + (size_t)conv_row(smode, n) * sK + k0;
                    { const uint4 u0 = pack8(f), u1 = pack8(g); gst_u4(d, u0.x, u0.y, u0.z, u0.w); gst_u4(d + 8, u1.x, u1.y, u1.z, u1.w); }
                }
            }
            __syncthreads();
            ct = ct2; ct2 = ct3;
        }
#undef CJ_SETUP
#undef CJ_LOAD
    }
}

__device__ __forceinline__ void row_load_f32(const float* p, float (&v)[16], int lane) {
#pragma unroll
    for (int c = 0; c < 4; ++c) { const float4 x = gld_f4(p + c * 256 + lane * 4); v[c * 4] = x.x; v[c * 4 + 1] = x.y; v[c * 4 + 2] = x.z; v[c * 4 + 3] = x.w; }
}
__device__ __forceinline__ void row_load_f32_l(const float* p, float (&v)[16], int lane) {
#pragma unroll
    for (int c = 0; c < 4; ++c) { const float4 x = *(const float4*)(p + c * 256 + lane * 4); v[c * 4] = x.x; v[c * 4 + 1] = x.y; v[c * 4 + 2] = x.z; v[c * 4 + 3] = x.w; }
}
__device__ __forceinline__ void row_load_bf16(const bf16_t* p, float (&v)[16], int lane) {
#pragma unroll
    for (int c = 0; c < 4; ++c) { const uint2 x = gld_u2(p + c * 256 + lane * 4); v[c * 4] = bflo(x.x); v[c * 4 + 1] = bfhi(x.x); v[c * 4 + 2] = bflo(x.y); v[c * 4 + 3] = bfhi(x.y); }
}
__device__ __forceinline__ void row_store_bf16(bf16_t* p, const float (&v)[16], int lane) {
#pragma unroll
    for (int c = 0; c < 4; ++c) gst_u2(p + c * 256 + lane * 4, cvt_pk(v[c * 4], v[c * 4 + 1]), cvt_pk(v[c * 4 + 2], v[c * 4 + 3]));
}
__device__ __forceinline__ void row_store_f32(float* p, const float (&v)[16], int lane) {
#pragma unroll
    for (int c = 0; c < 4; ++c) gst_f4(p + c * 256 + lane * 4, v[c * 4], v[c * 4 + 1], v[c * 4 + 2], v[c * 4 + 3]);
}
__device__ __forceinline__ void row_store_f32_l(float* p, const float (&v)[16], int lane) {
#pragma unroll
    for (int c = 0; c < 4; ++c) *(float4*)(p + c * 256 + lane * 4) = make_float4(v[c * 4], v[c * 4 + 1], v[c * 4 + 2], v[c * 4 + 3]);
}
__device__ __forceinline__ void row_layernorm(float (&v)[16], const float* g, const float* b, int lane) {
    float gg[16], bb[16]; row_load_f32(g, gg, lane); row_load_f32(b, bb, lane);
    float s = 0.f, q = 0.f;
#pragma unroll
    for (int i = 0; i < 16; ++i) { s += v[i]; q += v[i] * v[i]; }
    s = wave_sum(s); q = wave_sum(q);
    const float mean = s * (1.0f / 1024.0f);
    const float rstd = rsqrtf(fmaxf(q * (1.0f / 1024.0f) - mean * mean, 0.f) + LN_EPS);
#pragma unroll
    for (int i = 0; i < 16; ++i) v[i] = (v[i] - mean) * rstd * gg[i] + bb[i];
}
__device__ __forceinline__ void row_modulate(const float (&x)[16], float (&h)[16], const float* mod3, int lane) {
    float sh[16], sc[16]; row_load_f32(mod3, sh, lane); row_load_f32(mod3 + 1024, sc, lane);
#pragma unroll
    for (int i = 0; i < 16; ++i) h[i] = x[i] * (1.0f + sc[i]) + sh[i];
}
__device__ __forceinline__ void load_mu(const float* mu, float (&m)[6][16], int lane) {
#pragma unroll
    for (int n = 0; n < 6; ++n) row_load_f32(mu + n * 1024, m[n], lane);
}
__device__ __forceinline__ void emit_next(bf16_t* s0, int kind, int row, const float (&h)[16], const float (&hp)[16], const float (&m)[6][16], int lane) {
    if (kind == 0) {
#pragma unroll
        for (int n = 0; n < 6; ++n) {
#pragma unroll
            for (int c = 0; c < 4; ++c)
                gst_u2(s0 + (size_t)n * (SLOT / 2) + (size_t)row * 1024 + c * 256 + lane * 4,
                       cvt_pk(h[c * 4] + (hp[c * 4] - h[c * 4]) * m[n][c * 4], h[c * 4 + 1] + (hp[c * 4 + 1] - h[c * 4 + 1]) * m[n][c * 4 + 1]),
                       cvt_pk(h[c * 4 + 2] + (hp[c * 4 + 2] - h[c * 4 + 2]) * m[n][c * 4 + 2], h[c * 4 + 3] + (hp[c * 4 + 3] - h[c * 4 + 3]) * m[n][c * 4 + 3]));
        }
    } else row_store_bf16(s0 + (size_t)row * 1024, h, lane);
}
__device__ __forceinline__ void emit_next_l(bf16_t* s0, const float* mu, int kind, int row, const float (&h)[16], const float (&hp)[16], int lane) {
    if (kind == 0) {
#pragma unroll 1
        for (int n = 0; n < 6; ++n) {
#pragma unroll
            for (int c2 = 0; c2 < 2; ++c2) {
                const float4 ma = gld_f4(mu + n * 1024 + (2 * c2) * 256 + lane * 4), mb = gld_f4(mu + n * 1024 + (2 * c2 + 1) * 256 + lane * 4);
                const float mm[8] = {ma.x, ma.y, ma.z, ma.w, mb.x, mb.y, mb.z, mb.w};
#pragma unroll
                for (int cc = 0; cc < 2; ++cc) {
                    const int c = 2 * c2 + cc;
                    gst_u2(s0 + (size_t)n * (SLOT / 2) + (size_t)row * 1024 + c * 256 + lane * 4,
                           cvt_pk(h[c * 4] + (hp[c * 4] - h[c * 4]) * mm[cc * 4], h[c * 4 + 1] + (hp[c * 4 + 1] - h[c * 4 + 1]) * mm[cc * 4 + 1]),
                           cvt_pk(h[c * 4 + 2] + (hp[c * 4 + 2] - h[c * 4 + 2]) * mm[cc * 4 + 2], h[c * 4 + 3] + (hp[c * 4 + 3] - h[c * 4 + 3]) * mm[cc * 4 + 3]));
                }
            }
        }
    } else row_store_bf16(s0 + (size_t)row * 1024, h, lane);
}
__device__ __forceinline__ void phase_h0(PRef p) {
    const int t_ = tidx(); const int lane = t_ & 63, gw = blockIdx.x * 4 + (t_ >> 6), nw = gridDim.x * 4;
    const int rpw = NTOK / nw;
    const int r_lo = gw * rpw;
    const float* mod = (const float*)(p.ws + OFF_MOD) + ((size_t)(0 * 2 + 0) * 8 + (r_lo >> 11)) * 3072;
    float sh[16], sc[16]; row_load_f32(mod, sh, lane); row_load_f32(mod + 1024, sc, lane);
    float hp[16];
#pragma unroll
    for (int i = 0; i < 16; ++i) hp[i] = 0.f;
    float mu[6][16]; load_mu(p.in[6], mu, lane);
    const int first = ((r_lo & 2047) != 0) ? r_lo - 1 : r_lo, end = r_lo + rpw;
    float nx[16]; row_load_f32(p.in[0] + (size_t)first * 1024, nx, lane);
    for (int r = first; r < end; ++r) {
        float h[16];
#pragma unroll
        for (int i = 0; i < 16; ++i) h[i] = nx[i] * (1.0f + sc[i]) + sh[i];
        if (r + 1 < end) row_load_f32(p.in[0] + (size_t)(r + 1) * 1024, nx, lane);
        __builtin_amdgcn_sched_barrier(0);
        if (r >= r_lo) emit_next((bf16_t*)(p.ws + OFF_SLOT), 0, r, h, hp, mu, lane);
#pragma unroll
        for (int i = 0; i < 16; ++i) hp[i] = h[i];
        if (((r + 1) & 2047) == 0) {
#pragma unroll
            for (int i = 0; i < 16; ++i) hp[i] = 0.f;
        }
    }
}
__device__ __forceinline__ int layer_kind(int L) { return L % 3; }
__device__ __forceinline__ void phase_ln2(PRef p, int L) {
    const int t_ = tidx(); const int lane = t_ & 63, gw = blockIdx.x * 4 + (t_ >> 6), nw = gridDim.x * 4;
    const int rpw = NTOK / nw, r_lo = gw * rpw;
    const float* mod = (const float*)(p.ws + OFF_MOD);
    const bf16_t* xres = (const bf16_t*)(p.ws + OFF_XRES);
    const bf16_t* Y = (const bf16_t*)(p.ws + OFF_SLOT + 9 * SLOT);
    const float* wgt = (const float*)(p.ws + OFF_WGT);
    const bool last = (L == 3);
    const int nk = layer_kind(L + 1), njr = (L + 1) / 3;
    const bool need_prev = (!last && nk == 0);
    const int bidx = r_lo >> 11;
    float gt[16], lgn[16], lbn[16];
    row_load_f32(mod + ((size_t)(L * 2 + 1) * 8 + bidx) * 3072 + 2048, gt, lane);
    row_load_f32(p.in[4] + (L * 2 + 1) * 1024, lgn, lane); row_load_f32(p.in[5] + (L * 2 + 1) * 1024, lbn, lane);
    float hp[16];
#pragma unroll
    for (int i = 0; i < 16; ++i) hp[i] = 0.f;
    float shn[16], scn[16];
    { const float* mn_ = mod + ((size_t)((last ? L : L + 1) * 2 + 0) * 8 + bidx) * 3072; row_load_f32(mn_, shn, lane); row_load_f32(mn_ + 1024, scn, lane); }
    uint2 nxr[4], ny0[4], ny1[4]; float nw0, nw1;
    auto load_in = [&](int r) {
#pragma unroll
        for (int c = 0; c < 4; ++c) { nxr[c] = *(const uint2*)(xres + (size_t)r * 1024 + c * 256 + lane * 4); ny0[c] = *(const uint2*)(Y + (size_t)(2 * r) * 1024 + c * 256 + lane * 4); ny1[c] = *(const uint2*)(Y + (size_t)(2 * r + 1) * 1024 + c * 256 + lane * 4); }
        nw0 = wgt[2 * r]; nw1 = wgt[2 * r + 1];
    };
    const int first = (need_prev && (r_lo & 2047) != 0) ? r_lo - 1 : r_lo, end = r_lo + rpw;
    load_in(first);
    for (int r = first; r < end; ++r) {
        float x[16];
        {
            const float w0 = nw0, w1 = nw1;
#pragma unroll
            for (int c = 0; c < 4; ++c) {
                const float a0[4] = {bflo(ny0[c].x), bfhi(ny0[c].x), bflo(ny0[c].y), bfhi(ny0[c].y)}, a1[4] = {bflo(ny1[c].x), bfhi(ny1[c].x), bflo(ny1[c].y), bfhi(ny1[c].y)};
                const float xr[4] = {bflo(nxr[c].x), bfhi(nxr[c].x), bflo(nxr[c].y), bfhi(nxr[c].y)};
#pragma unroll
                for (int i = 0; i < 4; ++i) x[c * 4 + i] = DN_ALPHA * xr[i] + (1.0f + gt[c * 4 + i]) * (w0 * a0[i] + w1 * a1[i]);
            }
        }
        if (r + 1 < end) load_in(r + 1);
        __builtin_amdgcn_sched_barrier(0);
        float s = 0.f, q = 0.f;
#pragma unroll
        for (int i = 0; i < 16; ++i) { s += x[i]; q += x[i] * x[i]; }
        s = wave_sum(s); q = wave_sum(q);
        const float mean = s * (1.0f / 1024.0f), rstd = rsqrtf(fmaxf(q * (1.0f / 1024.0f) - mean * mean, 0.f) + LN_EPS);
#pragma unroll
        for (int i = 0; i < 16; ++i) x[i] = (x[i] - mean) * rstd * lgn[i] + lbn[i];
        if (last) { row_store_f32(p.out + (size_t)r * 1024, x, lane); continue; }
        float h[16];
#pragma unroll
        for (int i = 0; i < 16; ++i) h[i] = x[i] * (1.0f + scn[i]) + shn[i];
        if (r >= r_lo) { row_store_bf16((bf16_t*)(p.ws + OFF_XRES2) + (size_t)r * 1024, x, lane); emit_next_l((bf16_t*)(p.ws + OFF_SLOT), p.in[6] + (size_t)njr * 6 * 1024, nk, r, h, hp, lane); }
#pragma unroll
        for (int i = 0; i < 16; ++i) hp[i] = h[i];
        if (((r + 1) & 2047) == 0) {
#pragma unroll
            for (int i = 0; i < 16; ++i) hp[i] = 0.f;
        }
    }
}
__device__ __forceinline__ void phase_ln1(PRef p, int L, char* lds, const bf16_t* ymix, bf16_t* hm) {
    const int t = tidx(), lane = t & 63, wid = t >> 6;
    const float* mod = (const float*)(p.ws + OFF_MOD);
    const bf16_t* xinb = (const bf16_t*)(p.ws + OFF_XRES2);
    bf16_t* xres = (bf16_t*)(p.ws + OFF_XRES);
    int* cnt = (int*)(p.ws + OFF_CNT) + L * 32;
    int* list = (int*)(p.ws + OFF_LIST);
    float* wgt = (float*)(p.ws + OFF_WGT);
    float* const HB = (float*)lds;
    float* const lg = (float*)(lds + 65536);
    const float* rtw = (const float*)(p.ws + OFF_RTW) + (size_t)L * 36 * 1024;
    const int rpb = NTOK / gridDim.x;
    const int bidx = (blockIdx.x * rpb) >> 11;
    float gt[16], lgn[16], lbn[16], sh2[16], sc2[16];
    row_load_f32(mod + ((size_t)(L * 2 + 0) * 8 + bidx) * 3072 + 2048, gt, lane);
    row_load_f32(p.in[4] + (L * 2 + 0) * 1024, lgn, lane); row_load_f32(p.in[5] + (L * 2 + 0) * 1024, lbn, lane);
    row_load_f32(mod + ((size_t)(L * 2 + 1) * 8 + bidx) * 3072, sh2, lane); row_load_f32(mod + ((size_t)(L * 2 + 1) * 8 + bidx) * 3072 + 1024, sc2, lane);
    for (int rb0 = blockIdx.x * rpb; rb0 < (blockIdx.x + 1) * rpb; rb0 += 16) {
        const int rb = rb0 + wid * 4;
        uint4 xr[4][4]; uint2 yr[4][4];
#pragma unroll
        for (int rr = 0; rr < 4; ++rr) {
            const int r = rb + rr;
#pragma unroll
            for (int c = 0; c < 4; ++c) {
                if (L == 0) xr[rr][c] = gld_u4(p.in[0] + (size_t)r * 1024 + c * 256 + lane * 4);
                else { const uint2 t2 = gld_u2(xinb + (size_t)r * 1024 + c * 256 + lane * 4); xr[rr][c] = make_uint4(t2.x, t2.y, 0u, 0u); }
                yr[rr][c] = gld_u2(ymix + (size_t)r * 1024 + c * 256 + lane * 4);
            }
        }
#pragma unroll
        for (int rr = 0; rr < 4; ++rr) {
            const int r = rb + rr;
            float x[16], h[16];
#pragma unroll
            for (int c = 0; c < 4; ++c) {
                float xv[4];
                if (L == 0) { xv[0] = __uint_as_float(xr[rr][c].x); xv[1] = __uint_as_float(xr[rr][c].y); xv[2] = __uint_as_float(xr[rr][c].z); xv[3] = __uint_as_float(xr[rr][c].w); }
                else { xv[0] = bflo(xr[rr][c].x); xv[1] = bfhi(xr[rr][c].x); xv[2] = bflo(xr[rr][c].y); xv[3] = bfhi(xr[rr][c].y); }
                const float yv[4] = {bflo(yr[rr][c].x), bfhi(yr[rr][c].x), bflo(yr[rr][c].y), bfhi(yr[rr][c].y)};
#pragma unroll
                for (int i = 0; i < 4; ++i) x[c * 4 + i] = DN_ALPHA * xv[i] + (1.0f + gt[c * 4 + i]) * yv[i];
            }
            float s = 0.f, q = 0.f;
#pragma unroll
            for (int i = 0; i < 16; ++i) { s += x[i]; q += x[i] * x[i]; }
            s = wave_sum(s); q = wave_sum(q);
            const float mean = s * (1.0f / 1024.0f), rstd = rsqrtf(fmaxf(q * (1.0f / 1024.0f) - mean * mean, 0.f) + LN_EPS);
#pragma unroll
            for (int i = 0; i < 16; ++i) { x[i] = (x[i] - mean) * rstd * lgn[i] + lbn[i]; h[i] = x[i] * (1.0f + sc2[i]) + sh2[i]; }
            row_store_bf16(xres + (size_t)r * 1024, x, lane);
            row_store_bf16(hm + (size_t)r * 1024, h, lane);
            row_store_f32_l(HB + (wid * 4 + rr) * 1024, h, lane);
        }
        __syncthreads();
#pragma unroll 1
        for (int q3 = 0; q3 < 9; q3 += 3) {
            float w[3][16];
#pragma unroll
            for (int u = 0; u < 3; ++u) row_load_f32(rtw + (size_t)(wid * 9 + q3 + u) * 1024, w[u], lane);
#pragma unroll 2
            for (int r16 = 0; r16 < 16; ++r16) {
                float h[16]; row_load_f32_l(HB + r16 * 1024, h, lane);
                float a3[3];
#pragma unroll
                for (int u = 0; u < 3; ++u) { f32x2_t s2 = {0.f, 0.f};
#pragma unroll
                    for (int i = 0; i < 8; ++i) { const f32x2_t hh = {h[2 * i], h[2 * i + 1]}, ww = {w[u][2 * i], w[u][2 * i + 1]}; s2 = __builtin_elementwise_fma(hh, ww, s2); }
                    a3[u] = wave_sum(s2.x + s2.y); }
                if (lane == 0) {
#pragma unroll
                    for (int u = 0; u < 3; ++u) lg[r16 * 36 + wid * 9 + q3 + u] = a3[u];
                }
            }
        }
        __syncthreads();
        if (t < 16) {
            const int row = rb0 + t; const float* l = lg + t * 36;
            float g[4]; for (int i = 0; i < 4; ++i) g[i] = l[i] + p.in[37][L * 4 + i];
            int gi = 0; for (int i = 1; i < 4; ++i) if (g[i] > g[gi]) gi = i;
            float gs = 0.f; for (int i = 0; i < 4; ++i) gs += __expf(g[i] - g[gi]);
            const float ggate = 1.0f / gs;
            float e[8]; for (int i = 0; i < 8; ++i) e[i] = l[4 + gi * 8 + i] + p.in[39][L * 32 + gi * 8 + i];
            int i0 = 0; for (int i = 1; i < 8; ++i) if (e[i] > e[i0]) i0 = i;
            int i1 = (i0 == 0) ? 1 : 0; for (int i = 0; i < 8; ++i) if (i != i0 && e[i] > e[i1]) i1 = i;
            const float p1 = __expf(e[i1] - e[i0]);
            const float w0 = ggate / (1.0f + p1), w1 = ggate * p1 / (1.0f + p1);
            const int e0 = gi * 8 + i0, e1 = gi * 8 + i1;
            const int pos0 = atomicAdd(&cnt[e0], 1), pos1 = atomicAdd(&cnt[e1], 1);
            list[e0 * LIST_CAP + pos0] = 2 * row; list[e1 * LIST_CAP + pos1] = 2 * row + 1;
            wgt[2 * row] = w0; wgt[2 * row + 1] = w1;
        }
        asm volatile("s_waitcnt lgkmcnt(0)" ::: "memory");
    }
}

__device__ __forceinline__ int perm64(int r) { return (r & 64) | (((r >> 2) & 3) << 4) | (((r >> 4) & 3) << 2) | (r & 3); }
__device__ __forceinline__ bool tile_permuted(int mode, int nt) { return (mode <= MODE_SIGM) || (mode == MODE_ML1 && nt < 24) || (mode == MODE_RT1 && nt >= 16); }
__device__ __forceinline__ void store16(bf16_t* d, const f32x4 (&v)[4]) {
    gst_u4(d, cvt_pk(v[0][0], v[0][1]), cvt_pk(v[0][2], v[0][3]), cvt_pk(v[1][0], v[1][1]), cvt_pk(v[1][2], v[1][3]));
    gst_u4(d + 8, cvt_pk(v[2][0], v[2][1]), cvt_pk(v[2][2], v[2][3]), cvt_pk(v[3][0], v[3][1]), cvt_pk(v[3][2], v[3][3]));
}
__device__ __forceinline__ void gemm_epilogue(PRef p, const GJob& jb, int mt, int nt, const f32x4 (&acc)[4][4]) {
    const int t_ = tidx(); const int lane = t_ & 63, wid = t_ >> 6, wr = wid >> 1, wc = wid & 1, fr = lane & 15, fq = lane >> 4;
    const int row0 = mt * 128 + wr * 64 + fr;
    if (jb.mode <= MODE_SIGM) {
        const int col = nt * 128 + wc * 64 + fq * 16;
        if (col < jb.N) {
#pragma unroll
            for (int m = 0; m < 4; ++m) {
                f32x4 v[4];
#pragma unroll
                for (int n = 0; n < 4; ++n) {
                    v[n] = acc[m][n];
                    if (jb.mode == MODE_TANH) { v[n][0] = tanhf_(v[n][0]); v[n][1] = tanhf_(v[n][1]); v[n][2] = tanhf_(v[n][2]); v[n][3] = tanhf_(v[n][3]); }
                    else if (jb.mode == MODE_SIGM) { v[n][0] = sigmoidf_(v[n][0]); v[n][1] = sigmoidf_(v[n][1]); v[n][2] = sigmoidf_(v[n][2]); v[n][3] = sigmoidf_(v[n][3]); }
                }
                store16(jb.out + (size_t)(row0 + m * 16) * jb.ldo + col, v);
            }
        }
    } else if (jb.mode == MODE_ML1) {
        if (nt < 24) {
            bf16_t* ob = (bf16_t*)(p.ws + OFF_SLOT + (size_t)(1 + (nt >> 3)) * SLOT);
            const bool sg = (nt >= 16);
            const int col = (nt & 7) * 128 + wc * 64 + fq * 16;
#pragma unroll
            for (int m = 0; m < 4; ++m) {
                f32x4 v[4];
#pragma unroll
                for (int n = 0; n < 4; ++n) {
                    v[n] = acc[m][n];
                    if (sg) { v[n][0] = sigmoidf_(v[n][0]); v[n][1] = sigmoidf_(v[n][1]); v[n][2] = sigmoidf_(v[n][2]); v[n][3] = sigmoidf_(v[n][3]); }
                }
                store16(ob + (size_t)(row0 + m * 16) * 1024 + col, v);
            }
        } else if (wc == 0) {
            float* gates = (float*)(p.ws + OFF_GATES);
            const float* bg = p.in[26];
            const int c0 = fq * 4;
#pragma unroll
            for (int m = 0; m < 4; ++m) {
                f32x4 v = acc[m][0], o;
#pragma unroll
                for (int j = 0; j < 4; ++j) { const float g = v[j] + bg[c0 + j]; o[j] = (c0 + j < 8) ? g : -softplusf_(-g); }
                gst_f4(gates + (size_t)(row0 + m * 16) * 16 + c0, o[0], o[1], o[2], o[3]);
            }
        }
    } else {
        if (nt < 16) {
            const float* rot = (const float*)(p.ws + OFF_ROT);
            bf16_t* ob = (bf16_t*)(p.ws + OFF_SLOT + (size_t)(1 + (nt >> 3)) * SLOT);
            const float scl = (nt >= 8) ? 0.0625f : 1.0f;
#pragma unroll
            for (int pp = 0; pp < 2; ++pp) {
                const int blk32 = (nt & 7) * 4 + wc * 2 + pp, head = blk32 >> 3, i0 = (blk32 & 7) * 16 + fq * 4;
                float4 rc0[4], rc1[4];
#pragma unroll
                for (int m = 0; m < 4; ++m) { const int tt = (row0 + m * 16) & 2047; rc0[m] = gld_f4(rot + ((size_t)tt * 128 + i0) * 2); rc1[m] = gld_f4(rot + ((size_t)tt * 128 + i0) * 2 + 4); }
#pragma unroll
                for (int m = 0; m < 4; ++m) {
                    const int row = row0 + m * 16;
                    const float4 c0 = rc0[m], c1 = rc1[m];
                    const float cs[4] = {c0.x, c0.z, c1.x, c1.z}, sn[4] = {c0.y, c0.w, c1.y, c1.w};
                    const f32x4 x1 = acc[m][2 * pp], x2 = acc[m][2 * pp + 1];
                    float o1[4], o2[4];
#pragma unroll
                    for (int j = 0; j < 4; ++j) { o1[j] = (x1[j] * cs[j] - x2[j] * sn[j]) * scl; o2[j] = (x1[j] * sn[j] + x2[j] * cs[j]) * scl; }
                    gst_u2(ob + (size_t)row * 1024 + head * 256 + i0, cvt_pk(o1[0], o1[1]), cvt_pk(o1[2], o1[3]));
                    gst_u2(ob + (size_t)row * 1024 + head * 256 + 128 + i0, cvt_pk(o2[0], o2[1]), cvt_pk(o2[2], o2[3]));
                }
            }
        } else {
            const bool isg = (nt >= 32);
            bf16_t* ob = (bf16_t*)(p.ws + OFF_SLOT + (size_t)(isg ? 5 : 3) * SLOT);
            const int col = (nt & 15) * 128 + wc * 64 + fq * 16;
#pragma unroll
            for (int m = 0; m < 4; ++m) {
                f32x4 v[4];
#pragma unroll
                for (int n = 0; n < 4; ++n) {
                    v[n] = acc[m][n];
                    if (isg) { v[n][0] = siluf_(v[n][0]); v[n][1] = siluf_(v[n][1]); v[n][2] = siluf_(v[n][2]); v[n][3] = siluf_(v[n][3]); }
                }
                store16(ob + (size_t)(row0 + m * 16) * 2048 + col, v);
            }
        }
    }
}
__device__ __forceinline__ void phase_gemm_jobs(PRef p, char* lds, int jlo, int jhi) {
    const int total = p.gj[jhi - 1].tile0 + 128 * p.gj[jhi - 1].ntn - p.gj[jlo].tile0;
    for (int id = blockIdx.x; id < total; id += gridDim.x) {
        int j = jlo; const int gid = id + p.gj[jlo].tile0;
        while (j + 1 < jhi && gid >= p.gj[j + 1].tile0) ++j;
        GJob jb; jb.A = p.gj[j].A; jb.Bt = p.gj[j].Bt; jb.out = p.gj[j].out; jb.K = p.gj[j].K; jb.N = p.gj[j].N; jb.ldo = p.gj[j].ldo; jb.mode = p.gj[j].mode; jb.ntn = p.gj[j].ntn; jb.tile0 = p.gj[j].tile0;
        jb.half = p.gj[j].half;
        int mt, nt; tile_map(gid - jb.tile0, jb.ntn, mt, nt);
        if (jb.half || (jb.mode == MODE_ML1 && nt == 24)) {
            const int t_ = tidx(), r0_ = t_ >> 3, co_ = glds_chunk(t_) * 8, ln_ = t_ & 63, wv_ = t_ >> 6, fr_ = ln_ & 15, fq_ = ln_ >> 4;
            const int cb = jb.half ? nt * 64 : nt * 128;
            int nvh = jb.N - cb; nvh = nvh > 64 ? 64 : nvh;
            const bf16_t* ar[4]; const bf16_t* brh[2];
#pragma unroll
            for (int i = 0; i < 4; ++i) ar[i] = jb.A + (size_t)(mt * 128 + r0_ + 32 * i) * jb.K + co_;
#pragma unroll
            for (int i = 0; i < 2; ++i) { int rb_ = r0_ + 32 * i; rb_ = jb.half ? perm64(rb_) : rb_; rb_ = rb_ < nvh ? rb_ : nvh - 1; brh[i] = jb.Bt + (size_t)(cb + rb_) * jb.K + co_; }
            f32x4 ah[2][4];
            gemm_hn(lds, jb.K / 64, ar, brh, ah);
            const int rowh = mt * 128 + wv_ * 32 + fr_;
            if (jb.half) {
                const int col = cb + fq_ * 16;
                if (col < jb.N) {
#pragma unroll
                    for (int m = 0; m < 2; ++m) {
                        f32x4 v[4];
#pragma unroll
                        for (int n = 0; n < 4; ++n) {
                            v[n] = ah[m][n];
#pragma unroll
                            for (int jj = 0; jj < 4; ++jj) v[n][jj] = (jb.mode == MODE_TANH) ? tanhf_(v[n][jj]) : (jb.mode == MODE_SIGM) ? sigmoidf_(v[n][jj]) : v[n][jj];
                        }
                        store16(jb.out + (size_t)(rowh + m * 16) * jb.ldo + col, v);
                    }
                }
            } else {
                float* gates = (float*)(p.ws + OFF_GATES);
                const float* bg = p.in[26];
                const int c0 = fq_ * 4;
                const float4 bq = gld_f4(bg + c0);
                const float bqa[4] = {bq.x, bq.y, bq.z, bq.w};
#pragma unroll
                for (int m = 0; m < 2; ++m) {
                    float o[4];
#pragma unroll
                    for (int jj = 0; jj < 4; ++jj) { const float g = ah[m][0][jj] + bqa[jj]; o[jj] = (c0 + jj < 8) ? g : -softplusf_(-g); }
                    gst_f4(gates + (size_t)(rowh + m * 16) * 16 + c0, o[0], o[1], o[2], o[3]);
                }
            }
            continue;
        }
        int nv = jb.N - nt * 128; nv = nv > 128 ? 128 : nv;
        const bf16_t* ar[4]; const bf16_t* br[4];
        {
            const int t_ = tidx(), r0_ = t_ >> 3, co_ = glds_chunk(t_) * 8;
            const bool pm_ = tile_permuted(jb.mode, nt);
#pragma unroll
            for (int i = 0; i < 4; ++i) {
                ar[i] = jb.A + (size_t)(mt * 128 + r0_ + 32 * i) * jb.K + co_;
                int rb_ = r0_ + 32 * i; rb_ = pm_ ? perm64(rb_) : rb_; rb_ = rb_ < nv ? rb_ : nv - 1;
                br[i] = jb.Bt + (size_t)(nt * 128 + rb_) * jb.K + co_;
            }
        }
        f32x4 acc[4][4];
        gemm_gg(lds, jb.K / 64, ar, br, acc);
        gemm_epilogue(p, jb, mt, nt, acc);
    }
}

constexpr int RM = 4;
template <int KL>
__device__ __forceinline__ void minigemm(const bf16_t* A, const bf16_t* Bt, int fr, int fq, f32x4 (&acc)[RM][4]) {
#pragma unroll
    for (int m = 0; m < RM; ++m)
#pragma unroll
        for (int n = 0; n < 4; ++n) acc[m][n] = (f32x4){0.f, 0.f, 0.f, 0.f};
#pragma unroll 2
    for (int ks = 0; ks < KL / 32; ++ks) {
        uint4 af[RM], bfm[4];
#pragma unroll
        for (int m = 0; m < RM; ++m) af[m] = gld_u4(A + (size_t)(m * 16 + fr) * KL + ks * 32 + fq * 8);
#pragma unroll
        for (int n = 0; n < 4; ++n) bfm[n] = gld_u4(Bt + (size_t)((fr >> 2) * 16 + n * 4 + (fr & 3)) * KL + ks * 32 + fq * 8);
#pragma unroll
        for (int m = 0; m < RM; ++m)
#pragma unroll
            for (int n = 0; n < 4; ++n) acc[m][n] = mfma16(bfm[n], af[m], acc[m][n]);
    }
}
__device__ __forceinline__ void phase_rw2(PRef p, int jr) {
    const int t_ = tidx(); const int lane = t_ & 63, wid = t_ >> 6, wr = wid >> 1, wc = wid & 1, fr = lane & 15, fq = lane >> 4;
    char* S = p.ws + OFF_SLOT;
    float* decay = (float*)S; bf16_t* nkk = (bf16_t*)(S + 2 * SLOT); bf16_t* bb = (bf16_t*)(S + 3 * SLOT); bf16_t* gb = (bf16_t*)(S + 4 * SLOT);
    const bf16_t* rb = (const bf16_t*)(S + 6 * SLOT); const bf16_t* kb = (const bf16_t*)(S + 7 * SLOT); bf16_t* kpb = (bf16_t*)(S + 10 * SLOT);
    const bf16_t* vb = (const bf16_t*)(S + 8 * SLOT); bf16_t* vpb = (bf16_t*)(S + 9 * SLOT); const bf16_t* vf = (const bf16_t*)(S + 11 * SLOT);
    float* bonus = (float*)(p.ws + OFF_BONUS);
    const bf16_t* Lw = (const bf16_t*)(p.ws + OFF_LW); const bf16_t* La = (const bf16_t*)(p.ws + OFF_LA);
    const bf16_t* Lg = (const bf16_t*)(p.ws + OFF_LG); const bf16_t* Lv = (const bf16_t*)(p.ws + OFF_LV);
    const bf16_t* w2t = (const bf16_t*)(p.ws + W_W2T) + (size_t)jr * 1024 * 64; const bf16_t* a2t = (const bf16_t*)(p.ws + W_A2T) + (size_t)jr * 1024 * 64;
    const bf16_t* g2t = (const bf16_t*)(p.ws + W_G2T) + (size_t)jr * 1024 * 128; const bf16_t* v2t = (const bf16_t*)(p.ws + W_V2T);
    const float* w0 = p.in[8] + jr * 1024; const float* a0 = p.in[11] + jr * 1024; const float* v0 = p.in[14];
    const float* kkw = p.in[19] + jr * 1024; const float* kaw = p.in[20] + jr * 1024; const float* rk = p.in[21] + jr * 1024;
    for (int id2 = blockIdx.x; id2 < 128 * 8; id2 += gridDim.x) {
        int mt, nt; tile_map(id2, 8, mt, nt);
        const int row0 = mt * 128 + wr * 64, col0 = nt * 128 + wc * 64, head = nt * 2 + wc;
        f32x4 acc[RM][4];
        const int c0 = col0 + fq * 16;
        minigemm<64>(La + (size_t)row0 * 64, a2t + (size_t)col0 * 64, fr, fq, acc);
        float ss[RM], bs[RM];
#pragma unroll
        for (int m = 0; m < RM; ++m) { ss[m] = 0.f; bs[m] = 0.f; }
#pragma unroll
        for (int m = 0; m < RM; ++m) {
            const size_t off = (size_t)(row0 + m * 16 + fr) * 1024 + c0;
            const uint4 kq0 = *(const uint4*)(kb + off), kq1 = *(const uint4*)(kb + off + 8);
            const unsigned kw[8] = {kq0.x, kq0.y, kq0.z, kq0.w, kq1.x, kq1.y, kq1.z, kq1.w};
#pragma unroll
            for (int n = 0; n < 4; ++n) {
                const float4 a0v = *(const float4*)(a0 + c0 + n * 4), kkv = *(const float4*)(kkw + c0 + n * 4);
                const float a0a[4] = {a0v.x, a0v.y, a0v.z, a0v.w}, kka[4] = {kkv.x, kkv.y, kkv.z, kkv.w};
                const float kf4[4] = {bflo(kw[n * 2]), bfhi(kw[n * 2]), bflo(kw[n * 2 + 1]), bfhi(kw[n * 2 + 1])};
#pragma unroll
                for (int j = 0; j < 4; ++j) { acc[m][n][j] = sigmoidf_(a0a[j] + acc[m][n][j]); const float q = kf4[j] * kka[j]; ss[m] += q * q; }
            }
            asm volatile("" ::: "memory");
        }
#pragma unroll
        for (int m = 0; m < RM; ++m) { ss[m] = xor16_add(ss[m]); ss[m] = xor32_add(ss[m]); ss[m] = fminf(__builtin_amdgcn_rsqf(ss[m]), 1e12f); }
        float4 kkq[4], kaq[4], rkq[4];
#pragma unroll
        for (int n = 0; n < 4; ++n) { kkq[n] = gld_f4(kkw + c0 + n * 4); kaq[n] = gld_f4(kaw + c0 + n * 4); rkq[n] = gld_f4(rk + c0 + n * 4); }
#pragma unroll
        for (int m = 0; m < RM; ++m) {
            const size_t off = (size_t)(row0 + m * 16 + fr) * 1024 + c0;
            const uint4 rq0 = *(const uint4*)(rb + off), rq1 = *(const uint4*)(rb + off + 8), kq0 = *(const uint4*)(kb + off), kq1 = *(const uint4*)(kb + off + 8);
            const unsigned kw[8] = {kq0.x, kq0.y, kq0.z, kq0.w, kq1.x, kq1.y, kq1.z, kq1.w};
            const unsigned rw[8] = {rq0.x, rq0.y, rq0.z, rq0.w, rq1.x, rq1.y, rq1.z, rq1.w};
            unsigned okp[8], onk[8], obb[8];
#pragma unroll
            for (int n = 0; n < 4; ++n) {
                const float kka[4] = {kkq[n].x, kkq[n].y, kkq[n].z, kkq[n].w}, kaa[4] = {kaq[n].x, kaq[n].y, kaq[n].z, kaq[n].w}, rka[4] = {rkq[n].x, rkq[n].y, rkq[n].z, rkq[n].w};
                const float rf[4] = {bflo(rw[n * 2]), bfhi(rw[n * 2]), bflo(rw[n * 2 + 1]), bfhi(rw[n * 2 + 1])}, kf4[4] = {bflo(kw[n * 2]), bfhi(kw[n * 2]), bflo(kw[n * 2 + 1]), bfhi(kw[n * 2 + 1])};
                float kp[4], nk[4], b4[4];
#pragma unroll
                for (int j = 0; j < 4; ++j) {
                    const float a = acc[m][n][j], k = kf4[j], kn = k * kka[j] * ss[m];
                    kp[j] = k * (1.0f + (a - 1.0f) * kaa[j]); nk[j] = -kn; b4[j] = kn * a; bs[m] += rf[j] * kp[j] * rka[j];
                }
                okp[n * 2] = cvt_pk(kp[0], kp[1]); okp[n * 2 + 1] = cvt_pk(kp[2], kp[3]);
                onk[n * 2] = cvt_pk(nk[0], nk[1]); onk[n * 2 + 1] = cvt_pk(nk[2], nk[3]);
                obb[n * 2] = cvt_pk(b4[0], b4[1]); obb[n * 2 + 1] = cvt_pk(b4[2], b4[3]);
            }
            *(uint4*)(kpb + off) = make_uint4(okp[0], okp[1], okp[2], okp[3]); *(uint4*)(kpb + off + 8) = make_uint4(okp[4], okp[5], okp[6], okp[7]);
            *(uint4*)(nkk + off) = make_uint4(onk[0], onk[1], onk[2], onk[3]); *(uint4*)(nkk + off + 8) = make_uint4(onk[4], onk[5], onk[6], onk[7]);
            *(uint4*)(bb + off) = make_uint4(obb[0], obb[1], obb[2], obb[3]); *(uint4*)(bb + off + 8) = make_uint4(obb[4], obb[5], obb[6], obb[7]);
            asm volatile("" ::: "memory");
        }
#pragma unroll
        for (int m = 0; m < RM; ++m) { bs[m] = xor16_add(bs[m]); bs[m] = xor32_add(bs[m]); if (fq == 0) bonus[(size_t)(row0 + m * 16 + fr) * 16 + head] = bs[m]; }
        minigemm<64>(Lw + (size_t)row0 * 64, w2t + (size_t)col0 * 64, fr, fq, acc);
        float4 w0q[4];
#pragma unroll
        for (int n = 0; n < 4; ++n) w0q[n] = gld_f4(w0 + c0 + n * 4);
#pragma unroll
        for (int n = 0; n < 4; ++n) {
            const float w0a[4] = {w0q[n].x, w0q[n].y, w0q[n].z, w0q[n].w};
#pragma unroll
            for (int m = 0; m < RM; ++m) {
                f32x4 o;
#pragma unroll
                for (int j = 0; j < 4; ++j) { const float wl = -softplusf_(-(w0a[j] + acc[m][n][j])) - 0.5f; o[j] = __expf(-__expf(wl)); }
                *(f32x4*)(decay + (size_t)(row0 + m * 16 + fr) * 1024 + c0 + n * 4) = o;
            }
        }
        minigemm<128>(Lg + (size_t)row0 * 128, g2t + (size_t)col0 * 128, fr, fq, acc);
#pragma unroll
        for (int m = 0; m < RM; ++m) {
            unsigned o[8];
#pragma unroll
            for (int n = 0; n < 4; ++n) { o[n * 2] = cvt_pk(acc[m][n][0], acc[m][n][1]); o[n * 2 + 1] = cvt_pk(acc[m][n][2], acc[m][n][3]); }
            bf16_t* d = gb + (size_t)(row0 + m * 16 + fr) * 1024 + c0;
            *(uint4*)d = make_uint4(o[0], o[1], o[2], o[3]); *(uint4*)(d + 8) = make_uint4(o[4], o[5], o[6], o[7]);
        }
        if (jr > 0) {
            minigemm<32>(Lv + (size_t)row0 * 32, v2t + (size_t)col0 * 32, fr, fq, acc);
#pragma unroll
            for (int m = 0; m < RM; ++m) {
                const size_t off = (size_t)(row0 + m * 16 + fr) * 1024 + c0;
                const uint4 vq0 = *(const uint4*)(vb + off), vq1 = *(const uint4*)(vb + off + 8), fq0 = *(const uint4*)(vf + off), fq1 = *(const uint4*)(vf + off + 8);
                const unsigned vw[8] = {vq0.x, vq0.y, vq0.z, vq0.w, vq1.x, vq1.y, vq1.z, vq1.w}, fw[8] = {fq0.x, fq0.y, fq0.z, fq0.w, fq1.x, fq1.y, fq1.z, fq1.w};
                unsigned o[8];
#pragma unroll
                for (int n = 0; n < 4; ++n) {
                    const float4 v0v = *(const float4*)(v0 + c0 + n * 4); const float v0a[4] = {v0v.x, v0v.y, v0v.z, v0v.w};
                    const float v4[4] = {bflo(vw[n * 2]), bfhi(vw[n * 2]), bflo(vw[n * 2 + 1]), bfhi(vw[n * 2 + 1])}, f4[4] = {bflo(fw[n * 2]), bfhi(fw[n * 2]), bflo(fw[n * 2 + 1]), bfhi(fw[n * 2 + 1])};
                    float o4[4];
#pragma unroll
                    for (int j = 0; j < 4; ++j) o4[j] = v4[j] + (f4[j] - v4[j]) * sigmoidf_(v0a[j] + acc[m][n][j]);
                    o[n * 2] = cvt_pk(o4[0], o4[1]); o[n * 2 + 1] = cvt_pk(o4[2], o4[3]);
                }
                *(uint4*)(vpb + off) = make_uint4(o[0], o[1], o[2], o[3]); *(uint4*)(vpb + off + 8) = make_uint4(o[4], o[5], o[6], o[7]);
            }
        }
    }
}
__device__ __forceinline__ void phase_rw3(PRef p, int jr, char* lds) {
    const int t = tidx(), lane = t & 63, wid = t >> 6, rowq = lane >> 4, jq = lane & 15;
    char* S = p.ws + OFF_SLOT;
    const float* decay = (const float*)S; const bf16_t* nkk = (const bf16_t*)(S + 2 * SLOT); const bf16_t* bb = (const bf16_t*)(S + 3 * SLOT);
    const bf16_t* rb = (const bf16_t*)(S + 6 * SLOT); const bf16_t* kb = (const bf16_t*)(S + 10 * SLOT);
    const bf16_t* vb = (const bf16_t*)(S + (jr == 0 ? 11 : 9) * SLOT); bf16_t* yb = (bf16_t*)(S + 5 * SLOT);
    float* buf = (float*)lds;
    float* ybuf = (float*)(lds + 2 * 16 * 336 * 4);
    for (int item = blockIdx.x; item < 512; item += gridDim.x) {
        const int bh = item >> 2, rg = item & 3, b = bh >> 4, h = bh & 15;
        const size_t base = (size_t)b * 2048 * 1024 + h * 64;
        const bf16_t* vecp[2]; int vdst[2];
#pragma unroll
        for (int u = 0; u < 2; ++u) {
            const int id = t + 256 * u, vec = id >> 7, rem = id & 127, step = rem >> 3, c8 = rem & 7;
            const bf16_t* bp = (vec == 0) ? nkk : (vec == 1) ? bb : (vec == 2) ? kb : rb;
            vecp[u] = bp + base + (size_t)step * 1024 + c8 * 8; vdst[u] = step * 336 + 64 + vec * 64 + c8 * 8;
        }
        const float* dp = decay + base + (size_t)(t >> 4) * 1024 + (t & 15) * 4; const int ddst = (t >> 4) * 336 + (t & 15) * 4;
        const bf16_t* vp = vb + base + (size_t)(t >> 1) * 1024 + rg * 16 + (t & 1) * 8; const int vvdst = (t >> 1) * 336 + 320 + (t & 1) * 8;
        uint4 g0, g1, gv; float4 gd;
        auto fetch = [&](int ch) {
            const size_t o = (size_t)ch * 16 * 1024;
            g0 = gload16(vecp[0] + o); g1 = gload16(vecp[1] + o);
            { const uint4 d_ = gload16(dp + o); gd = make_float4(__uint_as_float(d_.x), __uint_as_float(d_.y), __uint_as_float(d_.z), __uint_as_float(d_.w)); }
            if (t < 32) gv = gload16(vp + o);
        };
        auto stash = [&](float* bf) {
            float f[8];
            unpack8(g0, f); *(float4*)(bf + vdst[0]) = make_float4(f[0], f[1], f[2], f[3]); *(float4*)(bf + vdst[0] + 4) = make_float4(f[4], f[5], f[6], f[7]);
            unpack8(g1, f); *(float4*)(bf + vdst[1]) = make_float4(f[0], f[1], f[2], f[3]); *(float4*)(bf + vdst[1] + 4) = make_float4(f[4], f[5], f[6], f[7]);
            *(float4*)(bf + ddst) = gd;
            if (t < 32) { unpack8(gv, f); *(float4*)(bf + vvdst) = make_float4(f[0], f[1], f[2], f[3]); *(float4*)(bf + vvdst + 4) = make_float4(f[4], f[5], f[6], f[7]); }
        };
        float s0 = 0.f, s1 = 0.f, s2 = 0.f, s3 = 0.f;
        __syncthreads();
        fetch(0); stash(buf); __syncthreads();
        for (int ch = 0; ch < 128; ++ch) {
            if (ch + 1 < 128) fetch(ch + 1);
            const float* bf = buf + (ch & 1) * (16 * 336); float* yb_ = ybuf + (ch & 1) * 256;
            float ykeep = 0.f;
            const float* q0 = bf + jq * 4; const float* v0p = bf + 320 + wid * 4 + rowq;
            float4 nw = *(const float4*)q0, na = *(const float4*)(q0 + 64), nb2 = *(const float4*)(q0 + 128), nk = *(const float4*)(q0 + 192), nr = *(const float4*)(q0 + 256);
            float nv = v0p[0];
#pragma unroll 4
            for (int s = 0; s < 16; ++s) {
                const float4 w = nw, a = na, bq = nb2, k = nk, r = nr; const float vv = nv;
                const float* q = q0 + (s + 1) * 336;
                nw = *(const float4*)q; na = *(const float4*)(q + 64); nb2 = *(const float4*)(q + 128); nk = *(const float4*)(q + 192); nr = *(const float4*)(q + 256);
                nv = v0p[(s + 1) * 336];
                __builtin_amdgcn_sched_barrier(0);
                float sa = s0 * a.x; sa = fmaf(s1, a.y, sa); sa = fmaf(s2, a.z, sa); sa = fmaf(s3, a.w, sa);
                sa = row16_sum(sa);
                s0 = fmaf(s0, w.x, fmaf(sa, bq.x, vv * k.x)); s1 = fmaf(s1, w.y, fmaf(sa, bq.y, vv * k.y));
                s2 = fmaf(s2, w.z, fmaf(sa, bq.z, vv * k.z)); s3 = fmaf(s3, w.w, fmaf(sa, bq.w, vv * k.w));
                float y = s0 * r.x; y = fmaf(s1, r.y, y); y = fmaf(s2, r.z, y); y = fmaf(s3, r.w, y);
                y = row16_sum(y);
                ykeep = (jq == s) ? y : ykeep;
            }
            yb_[jq * 16 + wid * 4 + rowq] = ykeep;
            if (ch + 1 < 128) stash(buf + ((ch + 1) & 1) * (16 * 336));
            __syncthreads();
            if (t < 32) { const int step = t >> 1, hf = t & 1; float f[8];
#pragma unroll
                for (int i = 0; i < 8; ++i) f[i] = yb_[step * 16 + hf * 8 + i];
                *(uint4*)(yb + base + (size_t)(ch * 16 + step) * 1024 + rg * 16 + hf * 8) = pack8(f); }
        }
    }
}
__device__ __forceinline__ uint2 lds_tr16(const char* p) {
    typedef short v4s_t __attribute__((ext_vector_type(4)));
    const v4s_t r = __builtin_amdgcn_ds_read_tr16_b64_v4i16((LAS v4s_t*)p);
    uint2 u; __builtin_memcpy(&u, &r, 8); return u;
}
__device__ __forceinline__ int sw64(int row, int col) { return row * 128 + ((((col >> 3) ^ (row & 7))) << 4) + (col & 7) * 2; }
__device__ __forceinline__ void phase_rw3c(PRef p, int jr, char* lds) {
    const int t = tidx(), lane = t & 63, w = t >> 6, fr = lane & 15, fq = lane >> 4;
    char* S = p.ws + OFF_SLOT;
    const float* decay = (const float*)S; const bf16_t* nkk = (const bf16_t*)(S + 2 * SLOT); const bf16_t* bb = (const bf16_t*)(S + 3 * SLOT);
    const bf16_t* rb = (const bf16_t*)(S + 6 * SLOT); const bf16_t* kb = (const bf16_t*)(S + 10 * SLOT);
    const bf16_t* vb = (const bf16_t*)(S + (jr == 0 ? 11 : 9) * SLOT); bf16_t* yb = (bf16_t*)(S + 5 * SLOT);
    char* const AT = lds;              char* const RT = lds + 4096;  char* const BT = lds + 8192;  char* const KT = lds + 12288;
    float* const PL = (float*)(lds + 16384);
    float* const GAB = (float*)(lds + 43264);
    char* const GAK = lds + 28672;     char* const GRB = lds + 30720; char* const GRK = lds + 32768;
    char* const VT = lds + 34816;      char* const UT = lds + 35840;
    char* const SB = lds + 36864;
    float* const XL = (float*)(lds + 38912);
    float* const PC = (float*)(lds + 40960);
    float* const GS = (float*)(lds + 41216);
    bf16_t* const YB = (bf16_t*)(lds + 42240);
    const int pj = t & 63, ptg = t >> 6;
    const int tk = t >> 3, ck = t & 7;
    const int vtau = t >> 3, vi2 = (t & 7) * 2;
    const int qq = fr >> 2, pp = fr & 3;
    for (int item = blockIdx.x; item < 512; item += gridDim.x) {
        const int bh = ((item >> 3) >> 2) * 8 + (item & 7), rg = (item >> 3) & 3, b = bh >> 4, h = bh & 15;
        const size_t base = (size_t)b * 2048 * 1024 + h * 64;
        __syncthreads();
        for (int i = t; i < 128; i += 256) *(uint4*)(SB + i * 16) = make_uint4(0u, 0u, 0u, 0u);
        f32x4 Sacc = (f32x4){0.f, 0.f, 0.f, 0.f};
        float gw[8]; uint4 ra, rb4, rk, rr, rw0, rw1; unsigned gvv = 0;
        auto fetch = [&](int c) {
#pragma unroll
            for (int s2 = 0; s2 < 8; ++s2) gw[s2] = *(const __attribute__((address_space(1))) float*)(decay + base + (size_t)(c * 32 + ptg * 8 + s2) * 1024 + pj);
            const size_t o = base + (size_t)(c * 32 + tk) * 1024 + ck * 8;
            ra = gload16(nkk + o); rb4 = gload16(bb + o); rk = gload16(kb + o); rr = gload16(rb + o); rw0 = gload16(decay + o); rw1 = gload16(decay + o + 4);
            gvv = *(const __attribute__((address_space(1))) unsigned*)(vb + base + (size_t)(c * 32 + vtau) * 1024 + rg * 16 + vi2);
        };
        fetch(0);
        for (int c = 0; c < 64; ++c) {
            {
                float cum[8]; float run = 1.f;
#pragma unroll
                for (int s2 = 0; s2 < 8; ++s2) { run *= gw[s2]; cum[s2] = run; }
                GS[ptg * 64 + pj] = run;
                __syncthreads();
                const float g0 = GS[pj], g1 = GS[64 + pj], g2 = GS[128 + pj], g3 = GS[192 + pj];
                const float off = (ptg > 0 ? g0 : 1.f) * (ptg > 1 ? g1 : 1.f) * (ptg > 2 ? g2 : 1.f);
                if (ptg == 0) PC[pj] = (g0 * g1) * (g2 * g3);
#pragma unroll
                for (int s2 = 0; s2 < 8; ++s2) PL[(ptg * 8 + s2) * 64 + pj] = off * cum[s2];
            }
            __syncthreads();
            {
                const float4 p0 = *(const float4*)(PL + tk * 64 + ck * 8), p1 = *(const float4*)(PL + tk * 64 + ck * 8 + 4);
                const unsigned ua[4] = {ra.x, ra.y, ra.z, ra.w}, ub[4] = {rb4.x, rb4.y, rb4.z, rb4.w}, uk[4] = {rk.x, rk.y, rk.z, rk.w}, ur[4] = {rr.x, rr.y, rr.z, rr.w};
                const f32x2_t Pp[4] = {{p0.x, p0.y}, {p0.z, p0.w}, {p1.x, p1.y}, {p1.z, p1.w}};
                const f32x2_t Wp[4] = {{__uint_as_float(rw0.x), __uint_as_float(rw0.y)}, {__uint_as_float(rw0.z), __uint_as_float(rw0.w)}, {__uint_as_float(rw1.x), __uint_as_float(rw1.y)}, {__uint_as_float(rw1.z), __uint_as_float(rw1.w)}};
                unsigned oa[4], orr[4], ob[4], ok[4];
#pragma unroll
                for (int i = 0; i < 4; ++i) {
                    const f32x2_t ei = {__builtin_amdgcn_rcpf(Pp[i].x), __builtin_amdgcn_rcpf(Pp[i].y)};
                    const f32x2_t rw = {__builtin_amdgcn_rcpf(Wp[i].x), __builtin_amdgcn_rcpf(Wp[i].y)};
                    const f32x2_t ex = Pp[i] * rw;
                    const f32x2_t va = {__uint_as_float(ua[i] << 16), __uint_as_float(ua[i] & 0xffff0000u)}, vr = {__uint_as_float(ur[i] << 16), __uint_as_float(ur[i] & 0xffff0000u)};
                    const f32x2_t vb2 = {__uint_as_float(ub[i] << 16), __uint_as_float(ub[i] & 0xffff0000u)}, vk = {__uint_as_float(uk[i] << 16), __uint_as_float(uk[i] & 0xffff0000u)};
                    const f32x2_t xa = va * ex, xr = vr * Pp[i], xb = vb2 * ei, xk = vk * ei;
                    oa[i] = cvt_pk(xa.x, xa.y); orr[i] = cvt_pk(xr.x, xr.y); ob[i] = cvt_pk(xb.x, xb.y); ok[i] = cvt_pk(xk.x, xk.y);
                }
                const int o = tk * 128 + ((ck ^ (tk & 7)) << 4);
                *(uint4*)(AT + o) = make_uint4(oa[0], oa[1], oa[2], oa[3]); *(uint4*)(RT + o) = make_uint4(orr[0], orr[1], orr[2], orr[3]);
                *(uint4*)(BT + o) = make_uint4(ob[0], ob[1], ob[2], ob[3]); *(uint4*)(KT + o) = make_uint4(ok[0], ok[1], ok[2], ok[3]);
                *(bf16_t*)(VT + vi2 * 64 + vtau * 2) = (bf16_t)(gvv & 0xffffu);
                *(bf16_t*)(VT + (vi2 + 1) * 64 + vtau * 2) = (bf16_t)(gvv >> 16);
            }
            if (c + 1 < 64) fetch(c + 1);
            __syncthreads();
            {
                const char* Mt = (w < 2) ? AT : RT; const char* Nt = (w & 1) ? BT : KT;
                f32x4 g[2][2];
#pragma unroll
                for (int m = 0; m < 2; ++m) { g[m][0] = (f32x4){0.f, 0.f, 0.f, 0.f}; g[m][1] = (f32x4){0.f, 0.f, 0.f, 0.f}; }
#pragma unroll
                for (int ks = 0; ks < 2; ++ks) {
                    const int chs = ((ks * 4 + fq) ^ (fr & 7)) << 4;
                    uint4 mf[2], nf[2];
#pragma unroll
                    for (int m = 0; m < 2; ++m) { mf[m] = *(const uint4*)(Mt + (m * 16 + fr) * 128 + chs); nf[m] = *(const uint4*)(Nt + (m * 16 + fr) * 128 + chs); }
#pragma unroll
                    for (int m = 0; m < 2; ++m)
#pragma unroll
                        for (int n = 0; n < 2; ++n) g[m][n] = mfma16(nf[n], mf[m], g[m][n]);
                }
#pragma unroll
                for (int m = 0; m < 2; ++m)
#pragma unroll
                    for (int n = 0; n < 2; ++n) {
                        const int tt = m * 16 + fr, tau0 = n * 16 + fq * 4;
                        f32x4 v4;
#pragma unroll
                        for (int j = 0; j < 4; ++j) { const int tau = tau0 + j; const bool keep = (w < 2) ? (tau < tt) : (tau <= tt); v4[j] = keep ? g[m][n][j] : 0.f; }
                        if (w == 1) *(f32x4*)(GAB + tt * 36 + tau0) = v4;
                        else {
                            char* G = (w == 0) ? GAK : (w == 2) ? GRK : GRB;
                            uint2 o; o.x = cvt_pk(v4[0], v4[1]); o.y = cvt_pk(v4[2], v4[3]);
                            *(uint2*)(G + tt * 64 + tau0 * 2) = o;
                        }
                    }
            }
            __syncthreads();
            if (w < 2) {
                f32x4 x = (f32x4){0.f, 0.f, 0.f, 0.f};
#pragma unroll
                for (int ks = 0; ks < 2; ++ks) {
                    const int chs = ((ks * 4 + fq) ^ (fr & 7)) << 4;
                    x = mfma16(*(const uint4*)(AT + (w * 16 + fr) * 128 + chs), *(const uint4*)(SB + fr * 128 + chs), x);
                }
                x = mfma16(*(const uint4*)(GAK + (w * 16 + fr) * 64 + fq * 16), *(const uint4*)(VT + fr * 64 + fq * 16), x);
                *(f32x4*)(XL + fr * 32 + w * 16 + fq * 4) = x;
            }
            __syncthreads();
            {
                const int tl = lane & 31;
                float Gr[32];
#pragma unroll
                for (int q4 = 0; q4 < 8; ++q4) { const float4 g4 = *(const float4*)(GAB + tl * 36 + q4 * 4); Gr[q4 * 4] = g4.x; Gr[q4 * 4 + 1] = g4.y; Gr[q4 * 4 + 2] = g4.z; Gr[q4 * 4 + 3] = g4.w; }
                float acc[4];
#pragma unroll
                for (int r = 0; r < 4; ++r) acc[r] = XL[(4 * w + r) * 32 + tl];
#pragma unroll
                for (int tau = 0; tau < 31; ++tau)
#pragma unroll
                    for (int r = 0; r < 4; ++r) acc[r] = fmaf(__int_as_float(__builtin_amdgcn_readlane(__float_as_int(acc[r]), tau)), Gr[tau], acc[r]);
                if (lane < 32) {
#pragma unroll
                    for (int r = 0; r < 4; ++r) *(bf16_t*)(UT + (4 * w + r) * 64 + tl * 2) = f2bf(acc[r]);
                }
            }
            __syncthreads();
            if (w < 2) {
                f32x4 y = (f32x4){0.f, 0.f, 0.f, 0.f};
#pragma unroll
                for (int ks = 0; ks < 2; ++ks) {
                    const int chs = ((ks * 4 + fq) ^ (fr & 7)) << 4;
                    y = mfma16(*(const uint4*)(RT + (w * 16 + fr) * 128 + chs), *(const uint4*)(SB + fr * 128 + chs), y);
                }
                y = mfma16(*(const uint4*)(GRB + (w * 16 + fr) * 64 + fq * 16), *(const uint4*)(UT + fr * 64 + fq * 16), y);
                y = mfma16(*(const uint4*)(GRK + (w * 16 + fr) * 64 + fq * 16), *(const uint4*)(VT + fr * 64 + fq * 16), y);
#pragma unroll
                for (int j = 0; j < 4; ++j) YB[(w * 16 + fq * 4 + j) * 16 + fr] = f2bf(y[j]);
            }
            {
                const int r0 = fq * 8 + qq, kc = 2 * w + (pp >> 1);
                const int o0 = r0 * 128 + ((kc ^ (r0 & 7)) << 4) + (pp & 1) * 8, o1 = (r0 + 4) * 128 + ((kc ^ ((r0 + 4) & 7)) << 4) + (pp & 1) * 8;
                const uint2 blo = lds_tr16(BT + o0), bhi = lds_tr16(BT + o1), klo = lds_tr16(KT + o0), khi = lds_tr16(KT + o1);
                Sacc = mfma16(make_uint4(blo.x, blo.y, bhi.x, bhi.y), *(const uint4*)(UT + fr * 64 + fq * 16), Sacc);
                Sacc = mfma16(make_uint4(klo.x, klo.y, khi.x, khi.y), *(const uint4*)(VT + fr * 64 + fq * 16), Sacc);
                const float4 pc = *(const float4*)(PC + 16 * w + fq * 4);
                Sacc[0] *= pc.x; Sacc[1] *= pc.y; Sacc[2] *= pc.z; Sacc[3] *= pc.w;
            }
            __syncthreads();
            {
                uint2 o; o.x = cvt_pk(Sacc[0], Sacc[1]); o.y = cvt_pk(Sacc[2], Sacc[3]);
                *(uint2*)(SB + fr * 128 + ((((2 * w + (fq >> 1))) ^ (fr & 7)) << 4) + (fq & 1) * 8) = o;
                if (t < 64) {
                    const int tt = t >> 1, hf = t & 1;
                    const uint4 yv_ = *(const uint4*)((const char*)YB + tt * 32 + hf * 16); const u32x4_t yx_ = {yv_.x, yv_.y, yv_.z, yv_.w};
                    *(__attribute__((address_space(1))) u32x4_t*)(yb + base + (size_t)(c * 32 + tt) * 1024 + rg * 16 + hf * 8) = yx_;
                }
            }
        }
    }
}
struct LdRw4 {
    struct Raw { uint4 y, v, g; float bn; };
    const bf16_t *y, *v, *g; const float *bonus, *gng, *gnb;
    __device__ __forceinline__ Raw fetch(int, int r, int kc) const {
        Raw q; const size_t o = (size_t)r * 1024 + kc * 8;
        q.y = *(const uint4*)(y + o); q.v = *(const uint4*)(v + o); q.g = *(const uint4*)(g + o); q.bn = bonus[r * 16 + (kc >> 3)]; return q;
    }
    __device__ __forceinline__ uint4 finish(const Raw& q, int, int, int kc) const {
        float yf[8], vf[8], gf[8]; unpack8(q.y, yf); unpack8(q.v, vf); unpack8(q.g, gf);
        float s = 0.f, s2 = 0.f;
#pragma unroll
        for (int i = 0; i < 8; ++i) { s += yf[i]; s2 += yf[i] * yf[i]; }
        s = oct_sum(s); s2 = oct_sum(s2);
        const float mean = s * (1.0f / 64.0f), var = fmaxf(s2 * (1.0f / 64.0f) - mean * mean, 0.f), rstd = rsqrtf(var + 64e-5f);
        const float4 ga = *(const float4*)(gng + kc * 8), gb = *(const float4*)(gng + kc * 8 + 4), ba = *(const float4*)(gnb + kc * 8), bb = *(const float4*)(gnb + kc * 8 + 4);
        const float gg[8] = {ga.x, ga.y, ga.z, ga.w, gb.x, gb.y, gb.z, gb.w}, bq[8] = {ba.x, ba.y, ba.z, ba.w, bb.x, bb.y, bb.z, bb.w};
        float o[8];
#pragma unroll
        for (int i = 0; i < 8; ++i) o[i] = ((yf[i] - mean) * rstd * gg[i] + bq[i] + q.bn * vf[i]) * gf[i];
        return pack8(o);
    }
};
__device__ __forceinline__ void phase_rw4(PRef p, int jr, char* lds) {
    char* S = p.ws + OFF_SLOT;
    const bf16_t* yb = (const bf16_t*)(S + 5 * SLOT); const bf16_t* gb = (const bf16_t*)(S + 4 * SLOT);
    const bf16_t* vb = (const bf16_t*)(S + (jr == 0 ? 11 : 9) * SLOT); bf16_t* ymix = (bf16_t*)(S + 6 * SLOT);
    const bf16_t* wt = (const bf16_t*)(p.ws + W_OUT) + (size_t)jr * 1024 * 1024;
    const float* bonus = (const float*)(p.ws + OFF_BONUS);
    const int t_ = tidx(); const int lane = t_ & 63, wid = t_ >> 6, wr = wid >> 1, wc = wid & 1, fr = lane & 15, fq = lane >> 4;
    for (int id = blockIdx.x; id < 128 * 8; id += gridDim.x) {
        int mt, nt; tile_map(id, 8, mt, nt);
        const size_t ro = (size_t)mt * 128 * 1024;
        LdRw4 al{yb + ro, vb + ro, gb + ro, bonus + (size_t)mt * 128 * 16, p.in[22] + jr * 1024, p.in[23] + jr * 1024};
        const bf16_t* br[4];
        { const int t2_ = tidx(), r0_ = t2_ >> 3, co_ = glds_chunk(t2_) * 8;
#pragma unroll
          for (int i = 0; i < 4; ++i) br[i] = wt + (size_t)(nt * 128 + r0_ + 32 * i) * 1024 + co_; }
        f32x4 acc[4][4];
        gemm_rg(lds, 16, al, br, acc);
#pragma unroll
        for (int n = 0; n < 4; ++n)
#pragma unroll
            for (int m = 0; m < 4; ++m) {
                uint2 o; o.x = cvt_pk(acc[m][n][0], acc[m][n][1]); o.y = cvt_pk(acc[m][n][2], acc[m][n][3]);
                *(uint2*)(ymix + (size_t)(mt * 128 + wr * 64 + m * 16 + fr) * 1024 + nt * 128 + wc * 64 + n * 16 + fq * 4) = o;
            }
    }
}

__device__ __forceinline__ void phase_cml(PRef p) {
    const int t = tidx();
    char* S = p.ws + OFF_SLOT;
    const bf16_t* src = (const bf16_t*)(S + 1 * SLOT); bf16_t* dst = (bf16_t*)(S + 8 * SLOT);
    const int col = (t & 127) * 8, half = t >> 7;
    float cw[4][8], cb[8];
#pragma unroll
    for (int j = 0; j < 4; ++j) {
        const float4 a = *(const float4*)(p.in[27] + j * 1024 + col), b = *(const float4*)(p.in[27] + j * 1024 + col + 4);
        cw[j][0] = a.x; cw[j][1] = a.y; cw[j][2] = a.z; cw[j][3] = a.w; cw[j][4] = b.x; cw[j][5] = b.y; cw[j][6] = b.z; cw[j][7] = b.w;
    }
    { const float4 a = *(const float4*)(p.in[28] + col), b = *(const float4*)(p.in[28] + col + 4);
      cb[0] = a.x; cb[1] = a.y; cb[2] = a.z; cb[3] = a.w; cb[4] = b.x; cb[5] = b.y; cb[6] = b.z; cb[7] = b.w; }
    const float qs = (col < 512) ? 0.125f : 1.0f;
    for (int item = blockIdx.x; item < 1024; item += gridDim.x) {
        const int b = item >> 7, s0 = (item & 127) * 16 + half * 8;
        const bf16_t* base = src + (size_t)b * 2048 * 1024 + col;
        uint4 r[11];
#pragma unroll
        for (int i = 0; i < 11; ++i) { const int sr = s0 - 3 + i; r[i] = gload16(base + (size_t)max(sr, 0) * 1024); if (sr < 0) r[i] = make_uint4(0u, 0u, 0u, 0u); }
        float x0[8], x1[8], x2[8];
        unpack8(r[0], x0); unpack8(r[1], x1); unpack8(r[2], x2);
#pragma unroll
        for (int i = 0; i < 8; ++i) {
            float x3[8], a[8]; unpack8(r[i + 3], x3);
#pragma unroll
            for (int e = 0; e < 8; ++e) { a[e] = cb[e] + cw[0][e] * x0[e] + cw[1][e] * x1[e] + cw[2][e] * x2[e] + cw[3][e] * x3[e]; a[e] = siluf_(a[e]) * qs; }
            *(uint4*)(dst + ((size_t)b * 2048 + s0 + i) * 1024 + col) = pack8(a);
#pragma unroll
            for (int e = 0; e < 8; ++e) { x0[e] = x1[e]; x1[e] = x2[e]; x2[e] = x3[e]; }
        }
    }
}
__device__ __forceinline__ void phase_ml2(PRef p, char* lds) {
    const int t = tidx(), lane = t & 63, w = t >> 6, fr = lane & 15, fq = lane >> 4;
    char* S = p.ws + OFF_SLOT;
    const bf16_t* qk = (const bf16_t*)(S + 8 * SLOT); const bf16_t* vb = (const bf16_t*)(S + 2 * SLOT); bf16_t* yb = (bf16_t*)(S + 4 * SLOT);
    const float* gates = (const float*)(p.ws + OFF_GATES); float* stat = (float*)(p.ws + OFF_STAT);
    char* const RAW = lds;
    char* const QT = lds + 17408; char* const KT = lds + 25600;
    char* const VT = lds + 33792;
    char* const VX = lds + 35840;
    char* const PB = lds + 39936;
    char* const CT = lds + 48128;
    float* const FS = (float*)(lds + 52224); float* const GJ = FS + 64; float* const WJ = FS + 128;
    float* const CW = (float*)(lds + 53248);
    const int qq = fr >> 2, pp = fr & 3;
    for (int item = blockIdx.x; item < 512; item += gridDim.x) {
        const int bh = ((item >> 3) >> 3) * 8 + (item & 7), vs = (item >> 3) & 7, b = bh >> 3, hd = bh & 7;
        const size_t tok0 = (size_t)b * 2048;
        __syncthreads();
        for (int i = t; i < 256; i += 256) *(uint4*)(CT + i * 16) = make_uint4(0u, 0u, 0u, 0u);
        f32x4 Cacc[2] = {(f32x4){0.f, 0.f, 0.f, 0.f}, (f32x4){0.f, 0.f, 0.f, 0.f}};
        uint4 gr0, gr1, gr2, gr3; uint4 gv = make_uint4(0u, 0u, 0u, 0u); float gg = 0.f;
        const int frr = t >> 4, fc = t & 15;
        const bf16_t* const qkt = qk + (tok0 + frr) * 1024 + (fc >> 3) * 512 + hd * 64 + (fc & 7) * 8;
        char* const qkd = ((fc < 8) ? QT : KT) + frr * 128 + (((fc & 7) ^ (frr & 7)) << 4);
        auto fetch = [&](int ch) {
            const int s0 = ch * 64;
            const bf16_t* q0 = qkt + (size_t)s0 * 1024;
            gr0 = gload16(q0); gr1 = gload16(q0 + 16 * 1024); gr2 = gload16(q0 + 32 * 1024); gr3 = gload16(q0 + 48 * 1024);
            if (t < 128) { gv = gload16(vb + (tok0 + s0 + (t >> 1)) * 1024 + hd * 128 + vs * 16 + (t & 1) * 8);
                           gg = *(const __attribute__((address_space(1))) float*)(gates + (tok0 + s0 + (t & 63)) * 16 + (t >> 6) * 8 + hd); }
        };
        fetch(0);
        for (int ch = 0; ch < 32; ++ch) {
            const int s0 = ch * 64;
            *(uint4*)qkd = gr0; *(uint4*)(qkd + 16 * 128) = gr1; *(uint4*)(qkd + 32 * 128) = gr2; *(uint4*)(qkd + 48 * 128) = gr3;
            if (t < 128) *(uint4*)(VT + t * 16) = gv;
            float vf8[8]; unpack8(gv, vf8);
            if (t >= 64 && t < 128) GJ[t - 64] = gg;
            const float ggc = gg;
            if (ch + 1 < 32) fetch(ch + 1);
            __syncthreads();
            if (t < 64) {
                float f = GJ[t];
                f += __builtin_amdgcn_update_dpp(0.f, f, 0x111, 0xf, 0xf, false);
                f += __builtin_amdgcn_update_dpp(0.f, f, 0x112, 0xf, 0xf, false);
                f += __builtin_amdgcn_update_dpp(0.f, f, 0x114, 0xf, 0xf, false);
                f += __builtin_amdgcn_update_dpp(0.f, f, 0x118, 0xf, 0xf, false);
                f += __builtin_amdgcn_update_dpp(0.f, f, 0x142, 0xa, 0xf, false);
                f += __builtin_amdgcn_update_dpp(0.f, f, 0x143, 0xc, 0xf, false);
                const float fend = __int_as_float(__builtin_amdgcn_readlane(__float_as_int(f), 63));
                FS[t] = f; WJ[t] = __expf(fend - f + ggc);
                GJ[t] = ggc - f;
            }
            __syncthreads();
            const float efend = __expf(FS[63]);
            {
                if (t < 128) {
                    const int j = t >> 1; const float wj = WJ[j];
                    float f[8];
#pragma unroll
                    for (int i = 0; i < 8; ++i) f[i] = vf8[i] * wj;
                    *(uint4*)(VX + j * 64 + (t & 1) * 16) = pack8(f);
                    float g8[8] = {0.f, 0.f, 0.f, 0.f, 0.f, 0.f, 0.f, 0.f}; if ((t & 1) == 0) g8[0] = wj;
                    *(uint4*)(VX + j * 64 + 32 + (t & 1) * 16) = pack8(g8);
                }
            }
            __syncthreads();
            const int srow = 16 * w + fr;
            f32x4 Sacc[4], Xacc[2];
#pragma unroll
            for (int n = 0; n < 4; ++n) Sacc[n] = (f32x4){0.f, 0.f, 0.f, 0.f};
            Xacc[0] = (f32x4){0.f, 0.f, 0.f, 0.f}; Xacc[1] = (f32x4){0.f, 0.f, 0.f, 0.f};
            Cacc[0] *= efend; Cacc[1] *= efend;
#pragma unroll
            for (int ks = 0; ks < 2; ++ks) {
                const int chs = ((ks * 4 + fq) ^ (fr & 7)) << 4;
                const uint4 qf = *(const uint4*)(QT + srow * 128 + chs);
#pragma unroll
                for (int n = 0; n < 4; ++n) { const uint4 kf = *(const uint4*)(KT + (n * 16 + fr) * 128 + chs); Sacc[n] = mfma16(kf, qf, Sacc[n]); }
#pragma unroll
                for (int nn = 0; nn < 2; ++nn) { const uint4 rf = *(const uint4*)(CT + (nn * 16 + fr) * 128 + chs); Xacc[nn] = mfma16(rf, qf, Xacc[nn]); }
                const int r0 = ks * 32 + fq * 8 + qq, kc = 2 * w + (pp >> 1);
                const uint2 klo = lds_tr16(KT + r0 * 128 + ((kc ^ (r0 & 7)) << 4) + (pp & 1) * 8);
                const uint2 khi = lds_tr16(KT + (r0 + 4) * 128 + ((kc ^ ((r0 + 4) & 7)) << 4) + (pp & 1) * 8);
                const uint4 kt = make_uint4(klo.x, klo.y, khi.x, khi.y);
#pragma unroll
                for (int m = 0; m < 2; ++m) {
                    const uint2 vlo = lds_tr16(VX + r0 * 64 + (16 * m + 4 * pp) * 2), vhi = lds_tr16(VX + (r0 + 4) * 64 + (16 * m + 4 * pp) * 2);
                    Cacc[m] = mfma16(kt, make_uint4(vlo.x, vlo.y, vhi.x, vhi.y), Cacc[m]);
                }
            }
            const float fs = FS[srow];
            float dsum = 0.f;
#pragma unroll
            for (int n = 0; n < 4; ++n) {
                const float4 g4 = *(const float4*)(GJ + n * 16 + fq * 4); const float ga[4] = {g4.x, g4.y, g4.z, g4.w};
                float pv[4];
#pragma unroll
                for (int j = 0; j < 4; ++j) { const int jc = n * 16 + fq * 4 + j; pv[j] = (srow >= jc) ? Sacc[n][j] * __expf(fs + ga[j]) : 0.f; dsum += pv[j]; }
                uint2 o; o.x = cvt_pk(pv[0], pv[1]); o.y = cvt_pk(pv[2], pv[3]);
                *(uint2*)(PB + srow * 128 + (((n * 2 + (fq >> 1)) ^ (fr & 7)) << 4) + (fq & 1) * 8) = o;
            }
            dsum = xor16_add(dsum); dsum = xor32_add(dsum);
            f32x4 Iacc = (f32x4){0.f, 0.f, 0.f, 0.f};
#pragma unroll
            for (int ks = 0; ks < 2; ++ks) {
                const uint4 pf = *(const uint4*)(PB + srow * 128 + (((ks * 4 + fq) ^ (fr & 7)) << 4));
                const int r0 = ks * 32 + fq * 8 + qq;
                const uint2 vlo = lds_tr16(VT + r0 * 32 + (4 * pp) * 2), vhi = lds_tr16(VT + (r0 + 4) * 32 + (4 * pp) * 2);
                Iacc = mfma16(make_uint4(vlo.x, vlo.y, vhi.x, vhi.y), pf, Iacc);
            }
            const float efs = __expf(fs);
            const float ndq = __shfl(Xacc[1][0], fr);
            const float den = dsum + efs * ndq;
            const float rden = 1.0f / fmaxf(fabsf(den), 1.0f);
            const size_t tok = tok0 + s0 + srow;
            float o4[4], ssum = 0.f, ssq = 0.f;
#pragma unroll
            for (int j = 0; j < 4; ++j) { o4[j] = (Iacc[j] + efs * Xacc[0][j]) * rden; ssum += o4[j]; ssq += o4[j] * o4[j]; }
            gst_u2(yb + tok * 1024 + hd * 128 + vs * 16 + fq * 4, cvt_pk(o4[0], o4[1]), cvt_pk(o4[2], o4[3]));
            ssum = xor16_add(ssum); ssum = xor32_add(ssum); ssq = xor16_add(ssq); ssq = xor32_add(ssq);
            if (fq == 0) gst_u2(stat + ((tok * 8 + hd) * 8 + vs) * 2, __float_as_uint(ssum), __float_as_uint(ssq));
            __syncthreads();
#pragma unroll
            for (int m = 0; m < 2; ++m) {
                const int v = m * 16 + fr;
                uint2 o; o.x = cvt_pk(Cacc[m][0], Cacc[m][1]); o.y = cvt_pk(Cacc[m][2], Cacc[m][3]);
                *(uint2*)(CT + v * 128 + (((2 * w + (fq >> 1)) ^ (v & 7)) << 4) + (fq & 1) * 8) = o;
            }
        }
    }
}
template <int HSHIFT  , int NH>
struct LdGnGate {
    struct Raw { uint4 y, g; };
    const bf16_t *y, *g; int ld; const float *gng, *gnb; const float* st;
    __device__ __forceinline__ Raw fetch(int, int r, int kc) const { Raw q; const size_t o = (size_t)r * ld + kc * 8; q.y = *(const uint4*)(y + o); q.g = *(const uint4*)(g + o); return q; }
    __device__ __forceinline__ uint4 finish(const Raw& q, int, int r, int kc) const {
        float yf[8], gf[8]; unpack8(q.y, yf); unpack8(q.g, gf);
        const float2 ms = *(const float2*)(st + (r * NH + ((kc * 8) >> HSHIFT)) * 2);
        const float4 ga = *(const float4*)(gng + kc * 8), gb = *(const float4*)(gng + kc * 8 + 4), ba = *(const float4*)(gnb + kc * 8), bb = *(const float4*)(gnb + kc * 8 + 4);
        const float gg[8] = {ga.x, ga.y, ga.z, ga.w, gb.x, gb.y, gb.z, gb.w}, bq[8] = {ba.x, ba.y, ba.z, ba.w, bb.x, bb.y, bb.z, bb.w};
        float o[8];
#pragma unroll
        for (int i = 0; i < 8; ++i) o[i] = ((yf[i] - ms.x) * ms.y * gg[i] + bq[i]) * gf[i];
        return pack8(o);
    }
};
template <int HSHIFT, int NH, int NPART>
__device__ __forceinline__ void phase_outproj_gn(PRef p, char* lds, const bf16_t* yb, const bf16_t* gate, int K, const bf16_t* wt, const float* gng, const float* gnb, bf16_t* ymix) {
    const int t = tidx(), lane = t & 63, wid = t >> 6, wr = wid >> 1, wc = wid & 1, fr = lane & 15, fq = lane >> 4;
    const float* stat = (const float*)(p.ws + OFF_STAT);
    float* st = (float*)(lds + 65536);
    const float invn = 1.0f / (float)(1 << HSHIFT);
    for (int id = blockIdx.x; id < 128 * 8; id += gridDim.x) {
        int mt, nt; tile_map(id, 8, mt, nt);
        for (int i = t; i < 128 * NH; i += 256) {
            const float* q = stat + ((size_t)mt * 128 * NH + i) * NPART * 2;
            float s = 0.f, s2 = 0.f;
#pragma unroll
            for (int j = 0; j < NPART; ++j) { const float2 v = *(const float2*)(q + j * 2); s += v.x; s2 += v.y; }
            const float mean = s * invn, var = fmaxf(s2 * invn - mean * mean, 0.f);
            st[i * 2] = mean; st[i * 2 + 1] = rsqrtf(var + 1e-6f);
        }
        __syncthreads();
        const size_t ro = (size_t)mt * 128 * K;
        LdGnGate<HSHIFT, NH> al{yb + ro, gate + ro, K, gng, gnb, st};
        const bf16_t* br[4];
        { const int r0_ = t >> 3, co_ = glds_chunk(t) * 8;
#pragma unroll
          for (int i = 0; i < 4; ++i) br[i] = wt + (size_t)(nt * 128 + r0_ + 32 * i) * K + co_; }
        f32x4 acc[4][4];
        gemm_rg(lds, K / 64, al, br, acc);
#pragma unroll
        for (int n = 0; n < 4; ++n)
#pragma unroll
            for (int m = 0; m < 4; ++m) {
                uint2 o; o.x = cvt_pk(acc[m][n][0], acc[m][n][1]); o.y = cvt_pk(acc[m][n][2], acc[m][n][3]);
                *(uint2*)(ymix + (size_t)(mt * 128 + wr * 64 + m * 16 + fr) * 1024 + nt * 128 + wc * 64 + n * 16 + fq * 4) = o;
            }
    }
}

__device__ __forceinline__ void phase_rt2(PRef p, char* lds) {
    const int t = tidx(), lane = t & 63, w = t >> 6, fr = lane & 15, fq = lane >> 4;
    char* S = p.ws + OFF_SLOT;
    const bf16_t* qb = (const bf16_t*)(S + 1 * SLOT); const bf16_t* kb = (const bf16_t*)(S + 2 * SLOT); const bf16_t* vb = (const bf16_t*)(S + 3 * SLOT);
    bf16_t* yb = (bf16_t*)(S + 7 * SLOT); float* stat = (float*)(p.ws + OFF_STAT);
    char* const VB = lds + 32768; char* const PB = lds + 49152; char* const RT = lds + 57344;
    const int gco = glds_chunk(t) * 8, gr0 = t >> 3;
    const int qq = fr >> 2, pp = fr & 3;
    for (int item = blockIdx.x; item < 512; item += gridDim.x) {
        const int bh = ((item >> 3) >> 4) * 8 + (item & 7), vs = (item >> 3) & 15, b = bh >> 2, hd = bh & 3;
        const size_t tok0 = (size_t)b * 2048;
        const float lg2 = log2f(1.0f - __builtin_amdgcn_exp2f(-5.0f - (float)hd));
        const float dec64 = __builtin_amdgcn_exp2f(64.0f * lg2);
        const bf16_t* qsrc = qb + (tok0 + gr0) * 1024 + hd * 256 + gco;
        const bf16_t* ksrc = kb + (tok0 + gr0) * 1024 + hd * 256 + gco;
        const bf16_t* vsrc = vb + (tok0 + (t >> 2)) * 2048 + hd * 512 + vs * 32 + (t & 3) * 8;
        f32x4 Racc[4][2];
#pragma unroll
        for (int a = 0; a < 4; ++a) { Racc[a][0] = (f32x4){0.f, 0.f, 0.f, 0.f}; Racc[a][1] = (f32x4){0.f, 0.f, 0.f, 0.f}; }
        __syncthreads();
        for (int i = t; i < 1024; i += 256) *(uint4*)(RT + i * 16) = make_uint4(0u, 0u, 0u, 0u);
        auto issue = [&](int pc) {
            const unsigned d = (unsigned)__builtin_amdgcn_readfirstlane((int)(lds_addr_u(lds) + (pc & 1) * 16384 + w * 1024));
            const size_t go = (size_t)(pc >> 2) * 64 * 1024 + (pc & 3) * 64;
#pragma unroll
            for (int i = 0; i < 2; ++i) { glds16_asm(qsrc + go + (size_t)i * 32 * 1024, d + i * 4096); glds16_asm(ksrc + go + (size_t)i * 32 * 1024, d + 8192 + i * 4096); }
        };
        auto put_v = [&](const uint4& raw, int ch) {
            char* vbuf = VB + (ch & 1) * 8192; const int j = t >> 2;
            *(uint4*)(vbuf + j * 64 + (t & 3) * 16) = raw;
            float f[8]; unpack8(raw, f); const float sc = __builtin_amdgcn_exp2f(lg2 * (float)(63 - j));
#pragma unroll
            for (int i = 0; i < 8; ++i) f[i] *= sc;
            *(uint4*)(vbuf + 4096 + j * 64 + (t & 3) * 16) = pack8(f);
        };
        issue(0);
        { const uint4 v0 = gld_u4(vsrc); put_v(v0, 0); }
        asm volatile("s_waitcnt vmcnt(0)" ::: "memory");
        __syncthreads();
        f32x4 Sacc[4], Xacc[2];
        uint4 vnext = make_uint4(0u, 0u, 0u, 0u);
        for (int ch = 0; ch < 32; ++ch) {
            const char* vbuf = VB + (ch & 1) * 8192;
#pragma unroll
            for (int qd = 0; qd < 4; ++qd) {
                const int pc = ch * 4 + qd;
                if (pc + 1 < 128) issue(pc + 1);
                if (qd == 0) {
                    if (ch + 1 < 32) vnext = gld_u4(vsrc + (size_t)(ch + 1) * 64 * 2048);
#pragma unroll
                    for (int n = 0; n < 4; ++n) Sacc[n] = (f32x4){0.f, 0.f, 0.f, 0.f};
                    Xacc[0] = (f32x4){0.f, 0.f, 0.f, 0.f}; Xacc[1] = (f32x4){0.f, 0.f, 0.f, 0.f};
                }
                const char* qk = lds + (pc & 1) * 16384;
                Racc[qd][0] *= dec64; Racc[qd][1] *= dec64;
#pragma unroll
                for (int ks = 0; ks < 2; ++ks) {
                    const int chs = ((ks * 4 + fq) ^ (fr & 7)) << 4;
                    const uint4 qf = *(const uint4*)(qk + (16 * w + fr) * 128 + chs);
#pragma unroll
                    for (int n = 0; n < 4; ++n) { const uint4 kf = *(const uint4*)(qk + 8192 + (n * 16 + fr) * 128 + chs); Sacc[n] = mfma16(kf, qf, Sacc[n]); }
#pragma unroll
                    for (int nn = 0; nn < 2; ++nn) {
                        const int v = nn * 16 + fr;
                        const uint4 rf = *(const uint4*)(RT + v * 512 + (((qd * 8 + ks * 4 + fq) ^ (v & 7)) << 4));
                        Xacc[nn] = mfma16(rf, qf, Xacc[nn]);
                    }
                    const int r0 = ks * 32 + fq * 8 + qq;
                    const int kc = 2 * w + (pp >> 1);
                    const uint2 klo = lds_tr16(qk + 8192 + r0 * 128 + ((kc ^ (r0 & 7)) << 4) + (pp & 1) * 8);
                    const uint2 khi = lds_tr16(qk + 8192 + (r0 + 4) * 128 + ((kc ^ ((r0 + 4) & 7)) << 4) + (pp & 1) * 8);
                    const uint4 kt = make_uint4(klo.x, klo.y, khi.x, khi.y);
#pragma unroll
                    for (int m = 0; m < 2; ++m) {
                        const uint2 vlo = lds_tr16(vbuf + 4096 + r0 * 64 + (16 * m + 4 * pp) * 2), vhi = lds_tr16(vbuf + 4096 + (r0 + 4) * 64 + (16 * m + 4 * pp) * 2);
                        Racc[qd][m] = mfma16(kt, make_uint4(vlo.x, vlo.y, vhi.x, vhi.y), Racc[qd][m]);
                    }
                }
                if (qd == 2 && ch + 1 < 32) put_v(vnext, ch + 1);
                asm volatile("s_waitcnt vmcnt(0)" ::: "memory");
                __syncthreads();
#pragma unroll
                for (int m = 0; m < 2; ++m) {
                    const int v = m * 16 + fr, cch = qd * 8 + 2 * w + (fq >> 1);
                    uint2 o; o.x = cvt_pk(Racc[qd][m][0], Racc[qd][m][1]); o.y = cvt_pk(Racc[qd][m][2], Racc[qd][m][3]);
                    *(uint2*)(RT + v * 512 + ((cch ^ (v & 7)) << 4) + (fq & 1) * 8) = o;
                }
            }
            const int srow = 16 * w + fr;
#pragma unroll
            for (int n = 0; n < 4; ++n) {
                float pv[4];
#pragma unroll
                for (int j = 0; j < 4; ++j) { const int jc = n * 16 + fq * 4 + j; pv[j] = (srow >= jc) ? Sacc[n][j] * __builtin_amdgcn_exp2f(lg2 * (float)(srow - jc)) : 0.f; }
                uint2 o; o.x = cvt_pk(pv[0], pv[1]); o.y = cvt_pk(pv[2], pv[3]);
                *(uint2*)(PB + srow * 128 + (((n * 2 + (fq >> 1)) ^ (fr & 7)) << 4) + (fq & 1) * 8) = o;
            }
            f32x4 Iacc[2] = {(f32x4){0.f, 0.f, 0.f, 0.f}, (f32x4){0.f, 0.f, 0.f, 0.f}};
#pragma unroll
            for (int ks = 0; ks < 2; ++ks) {
                const uint4 pf = *(const uint4*)(PB + srow * 128 + (((ks * 4 + fq) ^ (fr & 7)) << 4));
                const int r0 = ks * 32 + fq * 8 + qq;
#pragma unroll
                for (int nn = 0; nn < 2; ++nn) {
                    const uint2 vlo = lds_tr16(vbuf + r0 * 64 + (16 * nn + 4 * pp) * 2), vhi = lds_tr16(vbuf + (r0 + 4) * 64 + (16 * nn + 4 * pp) * 2);
                    Iacc[nn] = mfma16(make_uint4(vlo.x, vlo.y, vhi.x, vhi.y), pf, Iacc[nn]);
                }
            }
            const float qdec = __builtin_amdgcn_exp2f(lg2 * (float)(srow + 1));
            const size_t tok = tok0 + (size_t)ch * 64 + srow;
            float ssum = 0.f, ssq = 0.f;
#pragma unroll
            for (int nn = 0; nn < 2; ++nn) {
                float o4[4];
#pragma unroll
                for (int j = 0; j < 4; ++j) { o4[j] = Iacc[nn][j] + Xacc[nn][j] * qdec; ssum += o4[j]; ssq += o4[j] * o4[j]; }
                gst_u2(yb + tok * 2048 + hd * 512 + vs * 32 + nn * 16 + fq * 4, cvt_pk(o4[0], o4[1]), cvt_pk(o4[2], o4[3]));
            }
            ssum = xor16_add(ssum); ssum = xor32_add(ssum); ssq = xor16_add(ssq); ssq = xor32_add(ssq);
            if (fq == 0) gst_u2(stat + ((tok * 4 + hd) * 16 + vs) * 2, __float_as_uint(ssum), __float_as_uint(ssq));
        }
        __syncthreads();
    }
}

__device__ __forceinline__ void phase_zrw(PRef p, int jr) {
    const int t_ = tidx(); const int lane = t_ & 63, gw = blockIdx.x * 4 + (t_ >> 6), nw = gridDim.x * 4;
    char* S = p.ws + OFF_SLOT;
    const bf16_t* yb = (const bf16_t*)(S + 5 * SLOT); const bf16_t* gb = (const bf16_t*)(S + 4 * SLOT);
    const bf16_t* vb = (const bf16_t*)(S + (jr == 0 ? 11 : 9) * SLOT); bf16_t* zb = (bf16_t*)(S + 7 * SLOT);
    const float* bonus = (const float*)(p.ws + OFF_BONUS);
    float gg[16], bq[16]; row_load_f32(p.in[22] + jr * 1024, gg, lane); row_load_f32(p.in[23] + jr * 1024, bq, lane);
    const int rpw = NTOK / nw, first = gw * rpw, end = first + rpw;
    uint2 ny[4], nv[4], ng[4]; float nbn[4];
    auto load_in = [&](int r) {
#pragma unroll
        for (int c = 0; c < 4; ++c) { const size_t o = (size_t)r * 1024 + c * 256 + lane * 4; ny[c] = *(const uint2*)(yb + o); nv[c] = *(const uint2*)(vb + o); ng[c] = *(const uint2*)(gb + o);
                                      nbn[c] = bonus[(size_t)r * 16 + c * 4 + (lane >> 4)]; }
    };
    load_in(first);
    for (int r = first; r < end; ++r) {
        float y[16], v[16], g[16], bn[4];
#pragma unroll
        for (int c = 0; c < 4; ++c) {
            y[c * 4] = bflo(ny[c].x); y[c * 4 + 1] = bfhi(ny[c].x); y[c * 4 + 2] = bflo(ny[c].y); y[c * 4 + 3] = bfhi(ny[c].y);
            v[c * 4] = bflo(nv[c].x); v[c * 4 + 1] = bfhi(nv[c].x); v[c * 4 + 2] = bflo(nv[c].y); v[c * 4 + 3] = bfhi(nv[c].y);
            g[c * 4] = bflo(ng[c].x); g[c * 4 + 1] = bfhi(ng[c].x); g[c * 4 + 2] = bflo(ng[c].y); g[c * 4 + 3] = bfhi(ng[c].y);
            bn[c] = nbn[c];
        }
        if (r + 1 < end) load_in(r + 1);
        __builtin_amdgcn_sched_barrier(0);
        float z[16];
#pragma unroll
        for (int c = 0; c < 4; ++c) {
            float s = (y[c * 4] + y[c * 4 + 1]) + (y[c * 4 + 2] + y[c * 4 + 3]);
            float q = (y[c * 4] * y[c * 4] + y[c * 4 + 1] * y[c * 4 + 1]) + (y[c * 4 + 2] * y[c * 4 + 2] + y[c * 4 + 3] * y[c * 4 + 3]);
            s = row16_sum(s); q = row16_sum(q);
            const float mean = s * (1.0f / 64.0f), rstd = rsqrtf(fmaxf(q * (1.0f / 64.0f) - mean * mean, 0.f) + 64e-5f);
#pragma unroll
            for (int i = 0; i < 4; ++i) { const int e = c * 4 + i; z[e] = ((y[e] - mean) * rstd * gg[e] + bq[e] + bn[c] * v[e]) * g[e]; }
        }
        row_store_bf16(zb + (size_t)r * 1024, z, lane);
    }
}
__device__ __forceinline__ void phase_zml(PRef p) {
    const int t_ = tidx(); const int lane = t_ & 63, gw = blockIdx.x * 4 + (t_ >> 6), nw = gridDim.x * 4;
    char* S = p.ws + OFF_SLOT;
    const bf16_t* yb = (const bf16_t*)(S + 4 * SLOT); const bf16_t* ob = (const bf16_t*)(S + 3 * SLOT); bf16_t* zb = (bf16_t*)(S + 1 * SLOT);
    float gg[16], bq[16]; row_load_f32(p.in[29], gg, lane); row_load_f32(p.in[30], bq, lane);
    const int rpw = NTOK / nw, first = gw * rpw, end = first + rpw;
    uint2 ny[4], no[4];
    auto load_in = [&](int r) {
#pragma unroll
        for (int c = 0; c < 4; ++c) { const size_t o = (size_t)r * 1024 + c * 256 + lane * 4; ny[c] = *(const uint2*)(yb + o); no[c] = *(const uint2*)(ob + o); }
    };
    load_in(first);
    for (int r = first; r < end; ++r) {
        float y[16], o[16], z[16];
#pragma unroll
        for (int c = 0; c < 4; ++c) {
            y[c * 4] = bflo(ny[c].x); y[c * 4 + 1] = bfhi(ny[c].x); y[c * 4 + 2] = bflo(ny[c].y); y[c * 4 + 3] = bfhi(ny[c].y);
            o[c * 4] = bflo(no[c].x); o[c * 4 + 1] = bfhi(no[c].x); o[c * 4 + 2] = bflo(no[c].y); o[c * 4 + 3] = bfhi(no[c].y);
        }
        if (r + 1 < end) load_in(r + 1);
        __builtin_amdgcn_sched_barrier(0);
#pragma unroll
        for (int c = 0; c < 4; ++c) {
            float s = (y[c * 4] + y[c * 4 + 1]) + (y[c * 4 + 2] + y[c * 4 + 3]);
            float q = (y[c * 4] * y[c * 4] + y[c * 4 + 1] * y[c * 4 + 1]) + (y[c * 4 + 2] * y[c * 4 + 2] + y[c * 4 + 3] * y[c * 4 + 3]);
            s = row16_sum(s); q = row16_sum(q); s = xor16_add(s); q = xor16_add(q);
            const float mean = s * (1.0f / 128.0f), rstd = rsqrtf(fmaxf(q * (1.0f / 128.0f) - mean * mean, 0.f) + 1e-6f);
#pragma unroll
            for (int i = 0; i < 4; ++i) { const int e = c * 4 + i; z[e] = ((y[e] - mean) * rstd * gg[e] + bq[e]) * o[e]; }
        }
        row_store_bf16(zb + (size_t)r * 1024, z, lane);
    }
}
__device__ __forceinline__ void phase_zrt(PRef p) {
    const int t_ = tidx(); const int lane = t_ & 63, gw = blockIdx.x * 4 + (t_ >> 6), nw = gridDim.x * 4;
    char* S = p.ws + OFF_SLOT;
    const bf16_t* yb = (const bf16_t*)(S + 7 * SLOT); const bf16_t* sb = (const bf16_t*)(S + 5 * SLOT); bf16_t* zb = (bf16_t*)(S + 3 * SLOT);
    float gw8[4][8], bw8[4][8];
#pragma unroll
    for (int c = 0; c < 4; ++c) {
        const float4 ga = gld_f4(p.in[33] + lane * 32 + c * 8), gb2 = gld_f4(p.in[33] + lane * 32 + c * 8 + 4), ba = gld_f4(p.in[34] + lane * 32 + c * 8), bb2 = gld_f4(p.in[34] + lane * 32 + c * 8 + 4);
        gw8[c][0] = ga.x; gw8[c][1] = ga.y; gw8[c][2] = ga.z; gw8[c][3] = ga.w; gw8[c][4] = gb2.x; gw8[c][5] = gb2.y; gw8[c][6] = gb2.z; gw8[c][7] = gb2.w;
        bw8[c][0] = ba.x; bw8[c][1] = ba.y; bw8[c][2] = ba.z; bw8[c][3] = ba.w; bw8[c][4] = bb2.x; bw8[c][5] = bb2.y; bw8[c][6] = bb2.z; bw8[c][7] = bb2.w;
    }
    const int rpw = NTOK / nw, first = gw * rpw, end = first + rpw;
    uint4 nyr[4], nsr[4];
    auto load_in = [&](int r) {
        const size_t o = (size_t)r * 2048 + lane * 32;
#pragma unroll
        for (int c = 0; c < 4; ++c) { nyr[c] = *(const uint4*)(yb + o + c * 8); nsr[c] = *(const uint4*)(sb + o + c * 8); }
    };
    load_in(first);
    for (int r = first; r < end; ++r) {
        const size_t o = (size_t)r * 2048 + lane * 32;
        uint4 yr[4], sr[4];
#pragma unroll
        for (int c = 0; c < 4; ++c) { yr[c] = nyr[c]; sr[c] = nsr[c]; }
        if (r + 1 < end) load_in(r + 1);
        __builtin_amdgcn_sched_barrier(0);
        float s = 0.f, q = 0.f;
#pragma unroll
        for (int c = 0; c < 4; ++c) { float f[8]; unpack8(yr[c], f);
#pragma unroll
            for (int i = 0; i < 8; ++i) { s += f[i]; q += f[i] * f[i]; } }
        s = row16_sum(s); q = row16_sum(q);
        const float mean = s * (1.0f / 512.0f), rstd = rsqrtf(fmaxf(q * (1.0f / 512.0f) - mean * mean, 0.f) + 1e-6f);
#pragma unroll
        for (int c = 0; c < 4; ++c) {
            float f[8], g[8], z[8]; unpack8(yr[c], f); unpack8(sr[c], g);
#pragma unroll
            for (int i = 0; i < 8; ++i) z[i] = ((f[i] - mean) * rstd * gw8[c][i] + bw8[c][i]) * g[i];
            *(uint4*)(zb + o + c * 8) = pack8(z);
        }
    }
}

template <int WHICH  >
__device__ __forceinline__ void phase_moe(PRef p, int L, char* lds, const bf16_t* hm, bf16_t* H) {
    const int t = tidx(), lane = t & 63, wid = t >> 6, wr = wid >> 1, wc = wid & 1, fr = lane & 15, fq = lane >> 4;
    const int* cnt = (const int*)(p.ws + OFF_CNT) + L * 32;
    const int* list = (const int*)(p.ws + OFF_LIST);
    bf16_t* Y = (bf16_t*)(p.ws + OFF_SLOT + 9 * SLOT);
    int* pre = (int*)(lds + 65536);
    __syncthreads();
    if (t == 0) { int s = 0; for (int e = 0; e < 32; ++e) { pre[e] = s; s += (cnt[e] + 127) >> 7; } pre[32] = s; }
    __syncthreads();
    const int total_all = pre[32] * 8;
    const int full = (total_all / (int)gridDim.x) * (int)gridDim.x, rem = total_all - full;
    const bool split_tail = (rem > 0) && (2 * rem <= (int)gridDim.x);
    const int total = split_tail ? full : total_all;
    for (int id0 = 0; id0 < total; id0 += gridDim.x) {
        const int id = id0 + (blockIdx.x & 7) * (gridDim.x >> 3) + (blockIdx.x >> 3);
        if (id >= total) continue;
        const int nt = id & 7, mg = id >> 3;
        int e = 0;
#pragma unroll 1
        for (int s = 16; s >= 1; s >>= 1) if (pre[e + s] <= mg) e += s;
        const int mt = mg - pre[e], ne = cnt[e];
        const int* le = list + e * LIST_CAP + mt * 128;
        const bf16_t* ar[4]; const bf16_t* br[4];
        const int co_ = glds_chunk(t) * 8;
#pragma unroll
        for (int i = 0; i < 4; ++i) {
            int r = (t >> 3) + 32 * i; r = (mt * 128 + r < ne) ? r : 0;
            const int aid = le[r];
            ar[i] = ((WHICH == 0) ? hm + (size_t)(aid >> 1) * 1024 : H + (size_t)aid * 512) + co_;
        }
        f32x4 acc[4][4];
        if (WHICH == 0) {
            const bf16_t* wt = (const bf16_t*)(p.ws + W_MOE13) + ((size_t)(L * 32 + e) * 1024 + nt * 128) * 1024;
#pragma unroll
            for (int i = 0; i < 4; ++i) {
                const int ro = (t >> 3) + 32 * i, n_ = (ro >> 4) & 3, hc = ((ro >> 2) & 3) * 8 + (n_ >> 1) * 4 + (ro & 3);
                br[i] = wt + (size_t)((ro & 64) + (hc >> 4) * 32 + (n_ & 1) * 16 + (hc & 15)) * 1024 + co_;
            }
            gemm_gg(lds, 16, ar, br, acc);
            int aidq[4];
#pragma unroll
            for (int m = 0; m < 4; ++m) { const int r = wr * 64 + m * 16 + fr; aidq[m] = (mt * 128 + r < ne) ? le[r] : 0; }
#pragma unroll
            for (int m = 0; m < 4; ++m) {
                const int r = wr * 64 + m * 16 + fr;
                if (mt * 128 + r < ne) {
                    const int aid = aidq[m];
                    const f32x4 a1 = acc[m][0], a3 = acc[m][1], b1 = acc[m][2], b3 = acc[m][3];
                    gst_u4(H + (size_t)aid * 512 + nt * 64 + wc * 32 + fq * 8, cvt_pk(siluf_(a1[0]) * a3[0], siluf_(a1[1]) * a3[1]), cvt_pk(siluf_(a1[2]) * a3[2], siluf_(a1[3]) * a3[3]),
                           cvt_pk(siluf_(b1[0]) * b3[0], siluf_(b1[1]) * b3[1]), cvt_pk(siluf_(b1[2]) * b3[2], siluf_(b1[3]) * b3[3]));
                }
            }
        } else {
            const bf16_t* wt = (const bf16_t*)(p.ws + W_MOE2) + ((size_t)(L * 32 + e) * 1024 + nt * 128) * 512;
#pragma unroll
            for (int i = 0; i < 4; ++i) br[i] = wt + (size_t)perm64((t >> 3) + 32 * i) * 512 + co_;
            gemm_gg(lds, 8, ar, br, acc);
            int aidq[4];
#pragma unroll
            for (int m = 0; m < 4; ++m) { const int r = wr * 64 + m * 16 + fr; aidq[m] = (mt * 128 + r < ne) ? le[r] : 0; }
#pragma unroll
            for (int m = 0; m < 4; ++m) {
                const int r = wr * 64 + m * 16 + fr;
                if (mt * 128 + r < ne) {
                    const int aid = aidq[m];
                    store16(Y + (size_t)aid * 1024 + nt * 128 + wc * 64 + fq * 16, acc[m]);
                }
            }
        }
    }
    if (split_tail) {
        const int hid = (blockIdx.x & 7) * (gridDim.x >> 3) + (blockIdx.x >> 3);
        if (hid < 2 * rem) {
            const int id = full + (hid >> 1), hf = hid & 1;
            const int nt = id & 7, mg = id >> 3;
            int e = 0;
#pragma unroll 1
            for (int s2 = 16; s2 >= 1; s2 >>= 1) if (pre[e + s2] <= mg) e += s2;
            const int mt = mg - pre[e], ne = cnt[e];
            const int* le = list + e * LIST_CAP + mt * 128;
            const bf16_t* ar[4]; const bf16_t* br[2];
            const int co_ = glds_chunk(t) * 8;
#pragma unroll
            for (int i = 0; i < 4; ++i) {
                int r = (t >> 3) + 32 * i; r = (mt * 128 + r < ne) ? r : 0;
                const int aid = le[r];
                ar[i] = ((WHICH == 0) ? hm + (size_t)(aid >> 1) * 1024 : H + (size_t)aid * 512) + co_;
            }
            f32x4 acc[2][4];
            int aidq[2];
            if (WHICH == 0) {
                const bf16_t* wt = (const bf16_t*)(p.ws + W_MOE13) + ((size_t)(L * 32 + e) * 1024 + nt * 128 + hf * 64) * 1024;
#pragma unroll
                for (int i = 0; i < 2; ++i) {
                    const int ro = (t >> 3) + 32 * i, n_ = (ro >> 4) & 3, hc = ((ro >> 2) & 3) * 8 + (n_ >> 1) * 4 + (ro & 3);
                    br[i] = wt + (size_t)((hc >> 4) * 32 + (n_ & 1) * 16 + (hc & 15)) * 1024 + co_;
                }
                gemm_hn(lds, 16, ar, br, acc);
#pragma unroll
                for (int m = 0; m < 2; ++m) { const int r = wid * 32 + m * 16 + fr; aidq[m] = (mt * 128 + r < ne) ? le[r] : 0; }
#pragma unroll
                for (int m = 0; m < 2; ++m) {
                    const int r = wid * 32 + m * 16 + fr;
                    if (mt * 128 + r < ne) {
                        const f32x4 a1 = acc[m][0], a3 = acc[m][1], b1 = acc[m][2], b3 = acc[m][3];
                        gst_u4(H + (size_t)aidq[m] * 512 + nt * 64 + hf * 32 + fq * 8, cvt_pk(siluf_(a1[0]) * a3[0], siluf_(a1[1]) * a3[1]), cvt_pk(siluf_(a1[2]) * a3[2], siluf_(a1[3]) * a3[3]),
                               cvt_pk(siluf_(b1[0]) * b3[0], siluf_(b1[1]) * b3[1]), cvt_pk(siluf_(b1[2]) * b3[2], siluf_(b1[3]) * b3[3]));
                    }
                }
            } else {
                const bf16_t* wt = (const bf16_t*)(p.ws + W_MOE2) + ((size_t)(L * 32 + e) * 1024 + nt * 128 + hf * 64) * 512;
#pragma unroll
                for (int i = 0; i < 2; ++i) br[i] = wt + (size_t)perm64((t >> 3) + 32 * i) * 512 + co_;
                gemm_hn(lds, 8, ar, br, acc);
#pragma unroll
                for (int m = 0; m < 2; ++m) { const int r = wid * 32 + m * 16 + fr; aidq[m] = (mt * 128 + r < ne) ? le[r] : 0; }
#pragma unroll
                for (int m = 0; m < 2; ++m) {
                    const int r = wid * 32 + m * 16 + fr;
                    if (mt * 128 + r < ne) store16(Y + (size_t)aidq[m] * 1024 + nt * 128 + hf * 64 + fq * 16, acc[m]);
                }
            }
        }
    }
}

constexpr int NPHASE = 37;
#ifndef PHSEL
#define PHSEL -1
#endif
#ifndef PHEXC
#define PHEXC -2
#endif
#define PHON(x) ((PHSEL < 0 || PHSEL == (x)) && PHEXC != (x))
__global__ void __launch_bounds__(256, 2) mega(Params p_in) {
    PRef p = *(const CAS Params*)__builtin_amdgcn_kernarg_segment_ptr();
    extern __shared__ __attribute__((aligned(16))) char lds[];
    volatile LAS unsigned* xbw = (volatile LAS unsigned*)(lds + 73728);
    if (threadIdx.x == 0) { xbw[0] = 0u; xbw[1] = 0u; xbw[2] = 0u; xbw[3] = 0u; }
    __syncthreads();
    XcdBarrier bar;
    const bool multi = (p.ph_hi - p.ph_lo) > 1;
    (void)multi;
    if (multi) bar = xcd_barrier_post((unsigned*)(p.ws + OFF_CTL), xbw);
    char* S = p.ws + OFF_SLOT;
#ifdef DBG_STOP
    if (p.ph_lo == 100) {
        const float* src = (const float*)(p.ws + DBG_SRC);
        for (size_t i = (size_t)blockIdx.x * 256 + threadIdx.x; i < (size_t)NTOK * DM; i += (size_t)gridDim.x * 256) {
            float v = DBG_BF16 ? bf2f(((const bf16_t*)src)[i]) : src[i];
            if (!(fabsf(v) < 1e30f)) v = 1e30f;
            p.out[i] = v;
        }
        return;
    }
#endif
    const int ph_lo_ = p.ph_lo, ph_hi_ = p.ph_hi;
#ifdef TIMEIT
    unsigned long long t0_ = 0, t1_ = 0;
#endif
#ifdef DUP_PHASE
    bool dup_done_ = false;
#endif
    for (int ph = ph_lo_; ph < ph_hi_; ++ph) {
        const CAS Params* pp_ = (const CAS Params*)__builtin_amdgcn_kernarg_segment_ptr();
        asm volatile("" : "+s"(pp_));
        PRef p = *pp_;
#ifdef TIMEIT
        if (ph == TIME_A) t0_ = __builtin_amdgcn_s_memrealtime();
        if (ph == TIME_B) t1_ = __builtin_amdgcn_s_memrealtime();
#endif
        int L, sub, kind;
        if (ph < 2) { L = 0; sub = ph; kind = -1; }
        else if (ph < 11) { L = 0; kind = 0; sub = ph - 2; }
        else if (ph < 20) { L = 1; kind = 1; sub = ph - 11; }
        else if (ph < 28) { L = 2; kind = 2; sub = ph - 20; }
        else { L = 3; kind = 0; sub = ph - 28; }
        const int jr = L / 3;
        if (kind == -1) { if (sub == 0) { if (PHON(0)) phase_prologue(p, lds); } else { if (PHON(1)) phase_h0(p); } }
        else {
            const int ntail = (kind == 2) ? 4 : 5;
            if (sub < ntail) {
                if (kind == 0) {
                    if (sub == 0) { if (PHON(2)) phase_gemm_jobs(p, lds, jr * 7, jr * 7 + (jr ? 7 : 6)); }
                    else if (sub == 1) { if (PHON(3)) phase_rw2(p, jr); }
                    else if (sub == 2) { if (PHON(4)) {
#ifdef RW3_SCALAR
                        phase_rw3(p, jr, lds);
#else
                        phase_rw3c(p, jr, lds);
#endif
                    } }
                    else if (sub == 3) { if (PHON(5)) phase_zrw(p, jr); }
                    else { if (PHON(2)) phase_gemm_jobs(p, lds, 16 + jr, 17 + jr); }
                } else if (kind == 1) {
                    if (sub == 0) { if (PHON(2)) phase_gemm_jobs(p, lds, 14, 15); }
                    else if (sub == 1) { if (PHON(6)) phase_cml(p); }
                    else if (sub == 2) { if (PHON(6)) phase_ml2(p, lds); }
                    else if (sub == 3) { if (PHON(7)) phase_zml(p); }
                    else { if (PHON(2)) phase_gemm_jobs(p, lds, 18, 19); }
                } else {
                    if (sub == 0) { if (PHON(2)) phase_gemm_jobs(p, lds, 15, 16); }
                    else if (sub == 1) { if (PHON(8)) phase_rt2(p, lds); }
                    else if (sub == 2) { if (PHON(9)) phase_zrt(p); }
                    else { if (PHON(2)) phase_gemm_jobs(p, lds, 19, 20); }
                }
            } else {
                const int ts = sub - ntail;
                const bf16_t* ymix = (const bf16_t*)(S + (kind == 2 ? 1 : 6) * SLOT);
                bf16_t* hm = (bf16_t*)(S + (kind == 2 ? 2 : 7) * SLOT);
                bf16_t* H = (bf16_t*)(S + (kind == 0 ? 2 : (kind == 1 ? 5 : 3)) * SLOT);
                if (ts == 0) { if (PHON(10)) phase_ln1(p, L, lds, ymix, hm); }
                else if (ts == 1) { if (PHON(11)) phase_moe<0>(p, L, lds, hm, H); }
                else if (ts == 2) { if (PHON(12)) phase_moe<1>(p, L, lds, hm, H); }
                else { if (PHON(13)) phase_ln2(p, L); }
            }
        }
#ifdef DUP_PHASE
        if (((DUP_PHASE >> ph) & 1u) && !dup_done_) { dup_done_ = true; xcd_barrier(bar); --ph; continue; }
        dup_done_ = false;
#endif
        if (ph + 1 < ph_hi_) xcd_barrier(bar);
    }
#ifdef TIMEIT
    {
        xcd_barrier(bar);
        unsigned* tw = (unsigned*)(p.ws + OFF_CTL + 32768);
        if (blockIdx.x == 0 && threadIdx.x == 0) {
            if (t1_ == 0) t1_ = __builtin_amdgcn_s_memrealtime();
            const unsigned long long dt = t1_ - t0_;
            unsigned ms2 = (unsigned)((dt + TIME_U / 2) / TIME_U);
            __hip_atomic_store(tw, ms2, __ATOMIC_RELAXED, __HIP_MEMORY_SCOPE_AGENT);
        }
        xcd_barrier(bar);
        const float c_ = sqrtf((float)__hip_atomic_load(tw, __ATOMIC_RELAXED, __HIP_MEMORY_SCOPE_AGENT));
        for (size_t i = (size_t)blockIdx.x * 256 + threadIdx.x; i < (size_t)NTOK * DM; i += (size_t)gridDim.x * 256) p.out[i] = c_;
    }
#endif
#ifdef DBG_STOP
    if (ph_lo_ != 100) {
        xcd_barrier(bar);
        const float* src = (const float*)(p.ws + DBG_SRC);
        for (size_t i = (size_t)blockIdx.x * 256 + threadIdx.x; i < (size_t)NTOK * DM; i += (size_t)gridDim.x * 256) {
            float v = DBG_BF16 ? bf2f(((const bf16_t*)src)[i]) : src[i];
            if (!(fabsf(v) < 1e30f)) v = 1e30f;
            p.out[i] = v;
        }
    }
#endif
}

constexpr int LDS_BYTES = 73728 + 64;
extern "C" void kernel_launch(void* const* d_in, const int* in_sizes, int n_in, void* d_out, int out_size, void* d_ws, size_t ws_size, hipStream_t stream) {
    static int grid = 0;
    if (grid == 0) {
        if (n_in != 43 || out_size != NTOK * DM || ws_size < WS_NEED) { fprintf(stderr, "kernel_launch: unexpected shapes (n_in %d out %d ws %zu need %zu)\n", n_in, out_size, ws_size, (size_t)WS_NEED); }
        int dev = 0, cus = 0, per_cu = 0;
        (void)hipGetDevice(&dev); (void)hipDeviceGetAttribute(&cus, hipDeviceAttributeMultiprocessorCount, dev);
        (void)hipFuncSetAttribute((const void*)mega, hipFuncAttributeMaxDynamicSharedMemorySize, LDS_BYTES);
        (void)hipOccupancyMaxActiveBlocksPerMultiprocessor(&per_cu, (const void*)mega, 256, LDS_BYTES);
        if (per_cu > 2) per_cu = 2;
        if (per_cu < 1) per_cu = 1;
        grid = cus * per_cu;
        if (grid > 512) grid = 512;
        (void)hipGetLastError();
    }
    Params p{};
    for (int i = 0; i < 43; ++i) p.in[i] = (const float*)d_in[i];
    p.out = (float*)d_out; p.ws = (char*)d_ws;
    char* ws = (char*)d_ws;
    auto slot = [&](int i) { return (bf16_t*)(ws + OFF_SLOT + (size_t)i * SLOT); };
    int tile = 0;
    auto addg = [&](int idx, const bf16_t* A, const bf16_t* Bt, bf16_t* out, int K, int N, int ldo, int mode) {
        GJob& g = p.gj[idx]; g.A = A; g.Bt = Bt; g.out = out; g.K = K; g.N = N; g.ldo = ldo; g.mode = mode; g.half = (mode <= MODE_SIGM && N <= 128) ? 1 : 0; g.ntn = g.half ? (N + 63) / 64 : (N + 127) / 128; g.tile0 = tile; tile += 128 * g.ntn;
    };
    for (int jr = 0; jr < 2; ++jr) {
        const bf16_t* rkv = (const bf16_t*)(ws + W_RKV) + (size_t)jr * 3 * 1024 * 1024;
        addg(jr * 7 + 0, slot(0), rkv, slot(6), 1024, 1024, 1024, MODE_BF16);
        addg(jr * 7 + 1, slot(1), rkv + 1024 * 1024, slot(7), 1024, 1024, 1024, MODE_BF16);
        addg(jr * 7 + 2, slot(2), rkv + 2 * 1024 * 1024, slot(jr == 0 ? 11 : 8), 1024, 1024, 1024, MODE_BF16);
        addg(jr * 7 + 3, slot(3), (const bf16_t*)(ws + W_W1T) + (size_t)jr * 64 * 1024, (bf16_t*)(ws + OFF_LW), 1024, 64, 64, MODE_TANH);
        addg(jr * 7 + 4, slot(4), (const bf16_t*)(ws + W_A1T) + (size_t)jr * 64 * 1024, (bf16_t*)(ws + OFF_LA), 1024, 64, 64, MODE_BF16);
        addg(jr * 7 + 5, slot(5), (const bf16_t*)(ws + W_G1T) + (size_t)jr * 128 * 1024, (bf16_t*)(ws + OFF_LG), 1024, 128, 128, MODE_SIGM);
        addg(jr * 7 + 6, slot(2), (const bf16_t*)(ws + W_V1T), (bf16_t*)(ws + OFF_LV), 1024, 32, 32, MODE_BF16);
    }
    addg(14, slot(0), (const bf16_t*)(ws + W_MLIN), nullptr, 1024, 3088, 0, MODE_ML1);
    addg(15, slot(0), (const bf16_t*)(ws + W_RTIN), nullptr, 1024, 6144, 0, MODE_RT1);
    addg(16, slot(7), (const bf16_t*)(ws + W_OUT), slot(6), 1024, 1024, 1024, MODE_BF16);
    addg(17, slot(7), (const bf16_t*)(ws + W_OUT) + 1024 * 1024, slot(6), 1024, 1024, 1024, MODE_BF16);
    addg(18, slot(1), (const bf16_t*)(ws + W_MLOUT), slot(6), 1024, 1024, 1024, MODE_BF16);
    addg(19, slot(3), (const bf16_t*)(ws + W_RTOUT), slot(1), 2048, 1024, 1024, MODE_BF16);
    int nc = 0, ctile = 0;
    auto addc = [&](const float* src, size_t dst_off, int K, int N, int nb, long sbs, long dbs, int mode) {
        CJob& c = p.cj[nc++]; c.src = src; c.dst = (bf16_t*)(ws + dst_off); c.K = K; c.N = N; c.nb = nb; c.mode = mode; c.sbs = sbs; c.dbs = dbs;
        c.tiles_pb = ((K + 63) / 64) * ((N + 255) / 256); c.tile0 = ctile; ctile += c.tiles_pb * nb;
    };
    addc(p.in[7], W_RKV, 1024, 1024, 6, 1024 * 1024, 1024 * 1024, 0);
    addc(p.in[24], W_OUT, 1024, 1024, 2, 1024 * 1024, 1024 * 1024, 0);
    addc(p.in[9], W_W1T, 1024, 64, 2, 1024 * 64, 64 * 1024, 0);
    addc(p.in[12], W_A1T, 1024, 64, 2, 1024 * 64, 64 * 1024, 0);
    addc(p.in[17], W_G1T, 1024, 128, 2, 1024 * 128, 128 * 1024, 0);
    addc(p.in[15], W_V1T, 1024, 32, 1, 0, 0, 0);
    addc(p.in[10], W_W2T, 64, 1024, 2, 64 * 1024, 1024 * 64, 0);
    addc(p.in[13], W_A2T, 64, 1024, 2, 64 * 1024, 1024 * 64, 0);
    addc(p.in[18], W_G2T, 128, 1024, 2, 128 * 1024, 1024 * 128, 0);
    addc(p.in[16], W_V2T, 32, 1024, 1, 0, 0, 0);
    addc(p.in[25], W_MLIN, 1024, 3088, 1, 0, 0, 0);
    addc(p.in[31], W_MLOUT, 1024, 1024, 1, 0, 0, 0);
    addc(p.in[32], W_RTIN, 1024, 6144, 1, 0, 0, 3);
    addc(p.in[35], W_RTOUT, 2048, 1024, 1, 0, 0, 0);
    addc(p.in[40], W_MOE13, 1024, 512, 128, 1024 * 512, 1024 * 1024, 1);
    addc(p.in[41], W_MOE13, 1024, 512, 128, 1024 * 512, 1024 * 1024, 2);
    addc(p.in[42], W_MOE2, 512, 1024, 128, 512 * 1024, 1024 * 512, 0);
    p.ncj = nc; p.cj_tiles = ctile;

    (void)hipMemsetAsync(ws + OFF_CTL, 0, CTL_BYTES, stream);
#ifdef DBG_STOP
    const int nph = DBG_STOP;
#else
    const int nph = NPHASE;
#endif
#ifdef MULTI_LAUNCH
    for (int ph = 0; ph < nph; ++ph) { p.ph_lo = ph; p.ph_hi = ph + 1; hipLaunchKernelGGL(mega, dim3(grid), dim3(256), LDS_BYTES, stream, p); }
    if (0)
#endif
    {
        p.ph_lo = 0; p.ph_hi = nph;
        void* args[] = {&p};
        hipError_t e = hipLaunchCooperativeKernel((const void*)mega, dim3(grid), dim3(256), args, LDS_BYTES, stream);
        if (e != hipSuccess) fprintf(stderr, "cooperative launch failed: %s (grid %d)\n", hipGetErrorString(e), grid);
    }
}
```

```cpp
#include <hip/hip_runtime.h>
#include <cstdio>
#include <cstdint>

#ifndef ONE_LAUNCH
#define ONE_LAUNCH 0
#endif

typedef unsigned short bf16_t;
typedef short bf16x8 __attribute__((ext_vector_type(8)));
typedef float f32x4 __attribute__((ext_vector_type(4)));
#define LAS __attribute__((address_space(3)))
#define GAS __attribute__((address_space(1)))
typedef float f32x4g_t __attribute__((ext_vector_type(4)));
typedef unsigned u32x2g_t __attribute__((ext_vector_type(2)));
typedef unsigned u32x4g_t __attribute__((ext_vector_type(4)));
__device__ __forceinline__ float4 gld_f4(const float* p) { const f32x4g_t v = *(const GAS f32x4g_t*)(const GAS char*)(const char*)p; return make_float4(v[0], v[1], v[2], v[3]); }
__device__ __forceinline__ uint2 gld_u2(const void* p) { const u32x2g_t v = *(const GAS u32x2g_t*)(const GAS char*)(const char*)p; return make_uint2(v[0], v[1]); }
__device__ __forceinline__ uint4 gld_u4(const void* p) { const u32x4g_t v = *(const GAS u32x4g_t*)(const GAS char*)(const char*)p; return make_uint4(v[0], v[1], v[2], v[3]); }
__device__ __forceinline__ void gst_f4(float* p, float a, float b, float c, float d) { const f32x4g_t v = {a, b, c, d}; *(GAS f32x4g_t*)(GAS char*)(char*)p = v; }
__device__ __forceinline__ void gst_u2(void* p, unsigned a, unsigned b) { const u32x2g_t v = {a, b}; *(GAS u32x2g_t*)(GAS char*)(char*)p = v; }
__device__ __forceinline__ void gst_u4(void* p, unsigned a, unsigned b, unsigned c, unsigned d) { const u32x4g_t v = {a, b, c, d}; *(GAS u32x4g_t*)(GAS char*)(char*)p = v; }

constexpr int NTOK = 16384, DM = 1024, TSEQ = 2048, NBATCH = 8;
constexpr float DN_ALPHA = 1.681792830507429f;
constexpr float LN_EPS = 1e-5f;
constexpr size_t MB = 1u << 20;
constexpr size_t OFF_CTL = 0, OFF_CNT = 16384, CTL_BYTES = 65536;
constexpr size_t OFF_MOD = 65536;
constexpr size_t OFF_ROT = 1 * MB;
constexpr size_t OFF_BONUS = 3 * MB, OFF_GATES = 4 * MB, OFF_STAT = 5 * MB, OFF_LW = 13 * MB, OFF_LA = 15 * MB, OFF_LG = 17 * MB, OFF_LV = 21 * MB,
                 OFF_WGT = 22 * MB, OFF_LIST = 23 * MB, OFF_RTW = 25 * MB;
constexpr size_t OFF_W = 32 * MB;
constexpr size_t W_RKV = OFF_W, W_OUT = W_RKV + 12 * MB, W_W1T = W_OUT + 4 * MB, W_A1T = W_W1T + 256 * 1024, W_G1T = W_A1T + 256 * 1024, W_V1T = W_G1T + 512 * 1024,
                 W_W2T = W_V1T + 64 * 1024, W_A2T = W_W2T + 256 * 1024, W_G2T = W_A2T + 256 * 1024, W_V2T = W_G2T + 512 * 1024, W_MLIN = W_V2T + 64 * 1024 + 832 * 1024,
                 W_MLOUT = W_MLIN + 6400 * 1024, W_RTIN = W_MLOUT + 2 * MB, W_RTOUT = W_RTIN + 12 * MB, W_MOE13 = W_RTOUT + 4 * MB, W_MOE2 = W_MOE13 + 256 * MB,
                 W_END = W_MOE2 + 128 * MB;
constexpr size_t OFF_XRES = 464 * MB;
constexpr size_t OFF_SLOT = 528 * MB, SLOT = 32 * MB;
static_assert(W_END <= OFF_XRES, "weights overflow");
constexpr size_t OFF_XRES2 = OFF_SLOT + 12 * SLOT;
constexpr size_t WS_NEED = OFF_XRES2 + 2 * SLOT;
constexpr int LIST_CAP = 16384;

#define XB_TMO      128
#define XB_XCNT(j)  (256  + 64 * (j))
#define XB_XSUB(j)  (1280 + 64 * (j))
#define XB_XGEN(j)  (2304 + 64 * (j))
#define XB_TOP      3328
#define XB_TOPGEN   3392
#define XCD_BAR_WORDS 3456
#define XB_SPIN_CAP (1u << 22)
__device__ __forceinline__ unsigned xb_ld(unsigned* p)              { return __hip_atomic_load(p, __ATOMIC_RELAXED, __HIP_MEMORY_SCOPE_AGENT); }
__device__ __forceinline__ unsigned xb_add(unsigned* p, unsigned v) { return __hip_atomic_fetch_add(p, v, __ATOMIC_RELAXED, __HIP_MEMORY_SCOPE_AGENT); }
__device__ __forceinline__ unsigned xb_xcc_id() { return (unsigned)__builtin_amdgcn_s_getreg((3 << 11) | 20) & 0xFu; }
#define XB_SPIN(cond, bar) do { unsigned _sp = 0; while (cond) { __builtin_amdgcn_s_sleep(1); \
    if ((++_sp & 255u) == 0u) { if (xb_ld(&(bar)[XB_TMO])) break; if (_sp > XB_SPIN_CAP) { atomicAdd(&(bar)[XB_TMO], 1u); break; } } } } while (0)
struct XcdBarrier { unsigned* bar; unsigned x; volatile LAS unsigned* st; };
__device__ __forceinline__ XcdBarrier xcd_barrier_post(unsigned* bar, volatile LAS unsigned* st) {
    XcdBarrier b; b.bar = bar; b.x = xb_xcc_id(); b.st = st;
    if (threadIdx.x == 0) (void)xb_add(&bar[XB_XCNT(b.x)], 1u);
    return b;
}
__device__ __forceinline__ void xcd_barrier_complete(unsigned* bar, unsigned x, unsigned& nloc, unsigned& nx) {
    const unsigned G = gridDim.x;
    unsigned sum, cnt, mine, sp = 0u;
    for (;;) {
        sum = 0u; cnt = 0u; mine = 0u;
#pragma unroll
        for (unsigned j = 0; j < 16; ++j) { const unsigned c = xb_ld(&bar[XB_XCNT(j)]); sum += c; cnt += (c > 0u) ? 1u : 0u; mine = (j == x) ? c : mine; }
        if (sum == G) break;
        __builtin_amdgcn_s_sleep(1);
        if ((++sp & 255u) == 0u) { if (xb_ld(&bar[XB_TMO])) break; if (sp > XB_SPIN_CAP) { atomicAdd(&bar[XB_TMO], 1u); break; } }
    }
    nloc = mine > 0u ? mine : 1u; nx = cnt > 0u ? cnt : 1u;
}
__device__ __forceinline__ void xcd_barrier(const XcdBarrier& b) {
    asm volatile("s_waitcnt vmcnt(0)" ::: "memory");
    __syncthreads();
    if (threadIdx.x == 0) {
        unsigned* bar = b.bar;
        __builtin_amdgcn_s_waitcnt(0);
        unsigned nloc = b.st[0], nx = b.st[1];
        if (nloc == 0u) { xcd_barrier_complete(bar, b.x, nloc, nx); b.st[0] = nloc; b.st[1] = nx; }
        const unsigned old = xb_add(&bar[XB_XSUB(b.x)], 1u);
        const unsigned gen = old / nloc;
        if (old + 1u == (gen + 1u) * nloc) {
            __builtin_amdgcn_fence(__ATOMIC_RELEASE, "agent");
            asm volatile("s_waitcnt vmcnt(0)" ::: "memory");
            const unsigned og = xb_add(&bar[XB_TOP], 1u);
            const unsigned tg = og / nx;
            if (og + 1u == (tg + 1u) * nx) xb_add(&bar[XB_TOPGEN], 1u);
            else XB_SPIN(xb_ld(&bar[XB_TOPGEN]) == tg, bar);
            __builtin_amdgcn_fence(__ATOMIC_ACQUIRE, "agent");
            xb_add(&bar[XB_XGEN(b.x)], 1u);
            asm volatile("s_waitcnt vmcnt(0)" ::: "memory");
        } else {
            XB_SPIN(xb_ld(&bar[XB_XGEN(b.x)]) == gen, bar);
            __builtin_amdgcn_fence(__ATOMIC_ACQUIRE, "agent");
            asm volatile("s_waitcnt vmcnt(0)" ::: "memory");
        }
    }
    __syncthreads();
}

__device__ __forceinline__ int tidx() { int t = threadIdx.x; asm volatile("" : "+v"(t)); return t; }
typedef __bf16 bf16x2_t __attribute__((ext_vector_type(2)));
typedef float f32x2_t __attribute__((ext_vector_type(2)));
__device__ __forceinline__ unsigned cvt_pk(float lo, float hi) {
    f32x2_t v = {lo, hi}; bf16x2_t r = __builtin_convertvector(v, bf16x2_t);
    unsigned u; __builtin_memcpy(&u, &r, 4); return u;
}
__device__ __forceinline__ bf16_t f2bf(float f) { return (bf16_t)(cvt_pk(f, 0.f) & 0xffffu); }
__device__ __forceinline__ float bflo(unsigned u) { return __uint_as_float(u << 16); }
__device__ __forceinline__ float bfhi(unsigned u) { return __uint_as_float(u & 0xffff0000u); }
__device__ __forceinline__ float bf2f(bf16_t u) { return __uint_as_float(((unsigned)u) << 16); }
__device__ __forceinline__ void unpack8(const uint4& u, float (&f)[8]) {
    f[0] = bflo(u.x); f[1] = bfhi(u.x); f[2] = bflo(u.y); f[3] = bfhi(u.y); f[4] = bflo(u.z); f[5] = bfhi(u.z); f[6] = bflo(u.w); f[7] = bfhi(u.w);
}
__device__ __forceinline__ uint4 pack8(const float (&f)[8]) { uint4 u; u.x = cvt_pk(f[0], f[1]); u.y = cvt_pk(f[2], f[3]); u.z = cvt_pk(f[4], f[5]); u.w = cvt_pk(f[6], f[7]); return u; }
typedef unsigned u32x4_t __attribute__((ext_vector_type(4)));
__device__ __forceinline__ uint4 gload16(const void* p) {
    const u32x4_t v = *(const __attribute__((address_space(1))) u32x4_t*)p;
    return make_uint4(v[0], v[1], v[2], v[3]);
}
__device__ __forceinline__ float sigmoidf_(float x) { return __builtin_amdgcn_rcpf(1.0f + __expf(-x)); }
__device__ __forceinline__ float siluf_(float x) { return x * __builtin_amdgcn_rcpf(1.0f + __expf(-x)); }
__device__ __forceinline__ float tanhf_(float x) { return 1.0f - 2.0f * __builtin_amdgcn_rcpf(1.0f + __expf(2.0f * x)); }
__device__ __forceinline__ float softplusf_(float x) { return fmaxf(x, 0.f) + __logf(1.0f + __expf(-fabsf(x))); }
__device__ __forceinline__ float row16_sum(float v);
__device__ __forceinline__ float xor16_add(float v) { const auto r = __builtin_amdgcn_permlane16_swap(__float_as_uint(v), __float_as_uint(v), false, false); return __uint_as_float(r[0]) + __uint_as_float(r[1]); }
__device__ __forceinline__ float xor32_add(float v) { const auto r = __builtin_amdgcn_permlane32_swap(__float_as_uint(v), __float_as_uint(v), false, false); return __uint_as_float(r[0]) + __uint_as_float(r[1]); }
__device__ __forceinline__ float wave_sum(float v) {
    v = row16_sum(v); v = xor16_add(v); v = xor32_add(v);
    return v;
}
__device__ __forceinline__ float row16_sum(float v) {
    v += __builtin_amdgcn_update_dpp(0.f, v, 0x128, 0xf, 0xf, false);
    v += __builtin_amdgcn_update_dpp(0.f, v, 0x124, 0xf, 0xf, false);
    v += __builtin_amdgcn_update_dpp(0.f, v, 0x122, 0xf, 0xf, false);
    v += __builtin_amdgcn_update_dpp(0.f, v, 0x121, 0xf, 0xf, false);
    return v;
}
__device__ __forceinline__ float oct_sum(float v) {
    v += __builtin_amdgcn_update_dpp(0.f, v, 0xB1, 0xf, 0xf, false);
    v += __builtin_amdgcn_update_dpp(0.f, v, 0x4E, 0xf, 0xf, false);
    v += __builtin_amdgcn_update_dpp(0.f, v, 0x141, 0xf, 0xf, false);
    return v;
}

enum { MODE_BF16 = 0, MODE_TANH = 1, MODE_SIGM = 2, MODE_ML1 = 3, MODE_RT1 = 4 };
struct GJob { const bf16_t* A; const bf16_t* Bt; bf16_t* out; int K, N, ldo, mode, ntn, tile0, half; };
struct CJob { const float* src; bf16_t* dst; int K, N, nb, mode; long sbs, dbs; int tiles_pb, tile0; };
constexpr int NGJ = 20, NCJ = 24;
struct Params {
    const float* in[43]; float* out; char* ws;
    int ph_lo, ph_hi, ncj, cj_tiles;
    GJob gj[NGJ];
    CJob cj[NCJ];
};
#define CAS __attribute__((address_space(4)))
typedef const CAS Params& PRef;

__device__ __forceinline__ f32x4 mfma16(const uint4& a, const uint4& b, f32x4 c) {
    bf16x8 av, bv; __builtin_memcpy(&av, &a, 16); __builtin_memcpy(&bv, &b, 16);
    return __builtin_amdgcn_mfma_f32_16x16x32_bf16(av, bv, c, 0, 0, 0);
}
template <bool PFA = true, class AL, class BL>
__device__ __forceinline__ void gemm_mainloop(char* lds, int nk, const AL& al, const BL& bl, f32x4 (&acc)[4][4]) {
    const int t = tidx(), c = t & 7, r0 = t >> 3;
    const int lane = t & 63, wid = t >> 6, wr = wid >> 1, wc = wid & 1, fr = lane & 15, fq = lane >> 4;
    typename AL::Raw ra[4]; typename BL::Raw rb[4];
    const int woff = r0 * 128 + ((c ^ (r0 & 7)) << 4);
#pragma unroll
    for (int i = 0; i < 4; ++i) { if (PFA) ra[i] = al.fetch(i, r0 + 32 * i, c); rb[i] = bl.fetch(i, r0 + 32 * i, c); }
#pragma unroll
    for (int i = 0; i < 4; ++i) {
        if (!PFA) { ra[i] = al.fetch(i, r0 + 32 * i, c); }
        *(uint4*)(lds + woff + i * 4096) = al.finish(ra[i], i, r0 + 32 * i, c);
        *(uint4*)(lds + 16384 + woff + i * 4096) = bl.finish(rb[i], i, r0 + 32 * i, c);
        if (!PFA) asm volatile("" ::: "memory");
    }
#pragma unroll
    for (int m = 0; m < 4; ++m)
#pragma unroll
        for (int n = 0; n < 4; ++n) acc[m][n] = (f32x4){0.f, 0.f, 0.f, 0.f};
    __syncthreads();
    const int aoff = (wr * 64 + fr) * 128, boff = 16384 + (wc * 64 + fr) * 128, sw = fr & 7;
    for (int kt = 0; kt < nk; ++kt) {
        const bool more = (kt + 1 < nk);
        if (more) {
#pragma unroll
            for (int i = 0; i < 4; ++i) { if (PFA) ra[i] = al.fetch(i, r0 + 32 * i, (kt + 1) * 8 + c); rb[i] = bl.fetch(i, r0 + 32 * i, (kt + 1) * 8 + c); }
        }
        const char* buf = lds + (kt & 1) * 32768;
#pragma unroll
        for (int ks = 0; ks < 2; ++ks) {
            uint4 af[4], bfm[4];
            const int ch = ((ks * 4 + fq) ^ sw) << 4;
#pragma unroll
            for (int m = 0; m < 4; ++m) af[m] = *(const uint4*)(buf + aoff + m * 2048 + ch);
#pragma unroll
            for (int n = 0; n < 4; ++n) bfm[n] = *(const uint4*)(buf + boff + n * 2048 + ch);
#pragma unroll
            for (int m = 0; m < 4; ++m)
#pragma unroll
                for (int n = 0; n < 4; ++n) acc[m][n] = mfma16(bfm[n], af[m], acc[m][n]);
        }
        if (more) {
            char* nb = lds + ((kt + 1) & 1) * 32768;
#pragma unroll
            for (int i = 0; i < 4; ++i) {
                if (!PFA) ra[i] = al.fetch(i, r0 + 32 * i, (kt + 1) * 8 + c);
                *(uint4*)(nb + woff + i * 4096) = al.finish(ra[i], i, r0 + 32 * i, (kt + 1) * 8 + c);
                *(uint4*)(nb + 16384 + woff + i * 4096) = bl.finish(rb[i], i, r0 + 32 * i, (kt + 1) * 8 + c);
                if (!PFA) asm volatile("" ::: "memory");
            }
        }
        __syncthreads();
    }
}
__device__ __forceinline__ void glds16(const bf16_t* g, char* l) {
    __builtin_amdgcn_global_load_lds((const unsigned*)g, (LAS unsigned*)l, 16, 0, 0);
}
__device__ __forceinline__ void glds16_asm(const void* gsrc, unsigned lds_dst) {
    unsigned keep;
    asm volatile("s_mov_b32 %0, m0\n\ts_mov_b32 m0, %2\n\ts_nop 0\n\tglobal_load_lds_dwordx4 %1, off\n\ts_mov_b32 m0, %0" : "=&s"(keep) : "v"(gsrc), "s"(lds_dst) : "memory");
}
__device__ __forceinline__ unsigned lds_addr_u(const char* l) { return (unsigned)(size_t)(const LAS char*)l; }
__device__ __forceinline__ int glds_chunk(int t) { return (t & 7) ^ ((t >> 3) & 7); }
__device__ __forceinline__ void mma_ktile(const char* buf, int aoff, int boff, int sw, int fq, f32x4 (&acc)[4][4]) {
    const int ch0 = ((0 * 4 + fq) ^ sw) << 4, ch1 = ((1 * 4 + fq) ^ sw) << 4;
    const char* pa = buf + aoff; const char* pb = buf + boff;
    uint4 a0[4], a1[4], b[8];
#pragma unroll
    for (int m = 0; m < 4; ++m) a0[m] = *(const uint4*)(pa + m * 2048 + ch0);
    b[0] = *(const uint4*)(pb + ch0); b[1] = *(const uint4*)(pb + 2048 + ch0);
    __builtin_amdgcn_sched_barrier(0);
    b[2] = *(const uint4*)(pb + 2 * 2048 + ch0);
#pragma unroll
    for (int m = 0; m < 4; ++m) acc[m][0] = mfma16(b[0], a0[m], acc[m][0]);
    __builtin_amdgcn_sched_barrier(0);
    b[3] = *(const uint4*)(pb + 3 * 2048 + ch0);
#pragma unroll
    for (int m = 0; m < 4; ++m) acc[m][1] = mfma16(b[1], a0[m], acc[m][1]);
    __builtin_amdgcn_sched_barrier(0);
#pragma unroll
    for (int m = 0; m < 4; ++m) a1[m] = *(const uint4*)(pa + m * 2048 + ch1);
#pragma unroll
    for (int m = 0; m < 4; ++m) acc[m][2] = mfma16(b[2], a0[m], acc[m][2]);
    __builtin_amdgcn_sched_barrier(0);
    b[4] = *(const uint4*)(pb + ch1); b[5] = *(const uint4*)(pb + 2048 + ch1);
#pragma unroll
    for (int m = 0; m < 4; ++m) acc[m][3] = mfma16(b[3], a0[m], acc[m][3]);
    __builtin_amdgcn_sched_barrier(0);
    b[6] = *(const uint4*)(pb + 2 * 2048 + ch1);
#pragma unroll
    for (int m = 0; m < 4; ++m) acc[m][0] = mfma16(b[4], a1[m], acc[m][0]);
    __builtin_amdgcn_sched_barrier(0);
    b[7] = *(const uint4*)(pb + 3 * 2048 + ch1);
#pragma unroll
    for (int m = 0; m < 4; ++m) acc[m][1] = mfma16(b[5], a1[m], acc[m][1]);
    __builtin_amdgcn_sched_barrier(0);
#pragma unroll
    for (int m = 0; m < 4; ++m) acc[m][2] = mfma16(b[6], a1[m], acc[m][2]);
#pragma unroll
    for (int m = 0; m < 4; ++m) acc[m][3] = mfma16(b[7], a1[m], acc[m][3]);
}
__device__ __forceinline__ void gemm_gg(char* lds, int nk, const bf16_t* const (&ar)[4], const bf16_t* const (&br)[4], f32x4 (&acc)[4][4]) {
    const int t = tidx();
    const int lane = t & 63, wid = t >> 6, wr = wid >> 1, wc = wid & 1, fr = lane & 15, fq = lane >> 4;
    const unsigned wbs = (unsigned)__builtin_amdgcn_readfirstlane((int)(lds_addr_u(lds) + wid * 1024));
#pragma unroll
    for (int i = 0; i < 4; ++i) { glds16_asm(ar[i], wbs + i * 4096); glds16_asm(br[i], wbs + 16384 + i * 4096); }
#pragma unroll
    for (int m = 0; m < 4; ++m)
#pragma unroll
        for (int n = 0; n < 4; ++n) acc[m][n] = (f32x4){0.f, 0.f, 0.f, 0.f};
    asm volatile("s_waitcnt vmcnt(0)" ::: "memory");
    __syncthreads();
    const int aoff = (wr * 64 + fr) * 128, boff = 16384 + (wc * 64 + fr) * 128, sw = fr & 7;
    for (int kt = 0; kt < nk; ++kt) {
        if (kt + 1 < nk) {
            const unsigned nb = (unsigned)__builtin_amdgcn_readfirstlane((int)(wbs + ((kt + 1) & 1) * 32768));
#pragma unroll
            for (int i = 0; i < 4; ++i) { glds16_asm(ar[i] + (kt + 1) * 64, nb + i * 4096); glds16_asm(br[i] + (kt + 1) * 64, nb + 16384 + i * 4096); }
        }
        mma_ktile(lds + (kt & 1) * 32768, aoff, boff, sw, fq, acc);
        asm volatile("s_waitcnt vmcnt(0)" ::: "memory");
        __syncthreads();
    }
}
__device__ __forceinline__ void gemm_hn(char* lds, int nk, const bf16_t* const (&ar)[4], const bf16_t* const (&br)[2], f32x4 (&acc)[2][4]) {
    const int t = tidx();
    const int lane = t & 63, wid = t >> 6, fr = lane & 15, fq = lane >> 4;
    const unsigned wbs = (unsigned)__builtin_amdgcn_readfirstlane((int)(lds_addr_u(lds) + wid * 1024));
#pragma unroll
    for (int i = 0; i < 4; ++i) glds16_asm(ar[i], wbs + i * 4096);
#pragma unroll
    for (int i = 0; i < 2; ++i) glds16_asm(br[i], wbs + 16384 + i * 4096);
#pragma unroll
    for (int m = 0; m < 2; ++m)
#pragma unroll
        for (int n = 0; n < 4; ++n) acc[m][n] = (f32x4){0.f, 0.f, 0.f, 0.f};
    asm volatile("s_waitcnt vmcnt(0)" ::: "memory");
    __syncthreads();
    const int aoff = (wid * 32 + fr) * 128, boff = 16384 + fr * 128, sw = fr & 7;
    for (int kt = 0; kt < nk; ++kt) {
        if (kt + 1 < nk) {
            const unsigned nb = (unsigned)__builtin_amdgcn_readfirstlane((int)(wbs + ((kt + 1) & 1) * 32768));
#pragma unroll
            for (int i = 0; i < 4; ++i) glds16_asm(ar[i] + (kt + 1) * 64, nb + i * 4096);
#pragma unroll
            for (int i = 0; i < 2; ++i) glds16_asm(br[i] + (kt + 1) * 64, nb + 16384 + i * 4096);
        }
        const char* buf = lds + (kt & 1) * 32768;
#pragma unroll
        for (int ks = 0; ks < 2; ++ks) {
            const int ch = ((ks * 4 + fq) ^ sw) << 4;
            uint4 af[2], bfm[4];
#pragma unroll
            for (int m = 0; m < 2; ++m) af[m] = *(const uint4*)(buf + aoff + m * 2048 + ch);
#pragma unroll
            for (int n = 0; n < 4; ++n) bfm[n] = *(const uint4*)(buf + boff + n * 2048 + ch);
#pragma unroll
            for (int m = 0; m < 2; ++m)
#pragma unroll
                for (int n = 0; n < 4; ++n) acc[m][n] = mfma16(bfm[n], af[m], acc[m][n]);
        }
        asm volatile("s_waitcnt vmcnt(0)" ::: "memory");
        __syncthreads();
    }
}
template <class AL>
__device__ __forceinline__ void gemm_rg(char* lds, int nk, const AL& al, const bf16_t* const (&br)[4], f32x4 (&acc)[4][4]) {
    const int t = tidx(), c = t & 7, r0 = t >> 3;
    const int lane = t & 63, wid = t >> 6, wr = wid >> 1, wc = wid & 1, fr = lane & 15, fq = lane >> 4;
    char* wb = lds + wid * 1024;
    const int woff = r0 * 128 + ((c ^ (r0 & 7)) << 4);
#pragma unroll
    for (int i = 0; i < 4; ++i) glds16(br[i], wb + 16384 + i * 4096);
#pragma unroll
    for (int i = 0; i < 4; ++i) {
        typename AL::Raw ra = al.fetch(i, r0 + 32 * i, c);
        *(uint4*)(lds + woff + i * 4096) = al.finish(ra, i, r0 + 32 * i, c);
        asm volatile("" ::: "memory");
    }
#pragma unroll
    for (int m = 0; m < 4; ++m)
#pragma unroll
        for (int n = 0; n < 4; ++n) acc[m][n] = (f32x4){0.f, 0.f, 0.f, 0.f};
    asm volatile("s_waitcnt vmcnt(0)" ::: "memory");
    __syncthreads();
    const int aoff = (wr * 64 + fr) * 128, boff = 16384 + (wc * 64 + fr) * 128, sw = fr & 7;
    for (int kt = 0; kt < nk; ++kt) {
        const bool more = (kt + 1 < nk);
        char* nbuf = lds + ((kt + 1) & 1) * 32768;
        if (more) {
#pragma unroll
            for (int i = 0; i < 4; ++i) glds16(br[i] + (kt + 1) * 64, nbuf + wid * 1024 + 16384 + i * 4096);
        }
        mma_ktile(lds + (kt & 1) * 32768, aoff, boff, sw, fq, acc);
        if (more) {
#pragma unroll
            for (int i = 0; i < 4; ++i) {
                typename AL::Raw ra = al.fetch(i, r0 + 32 * i, (kt + 1) * 8 + c);
                *(uint4*)(nbuf + woff + i * 4096) = al.finish(ra, i, r0 + 32 * i, (kt + 1) * 8 + c);
                asm volatile("" ::: "memory");
            }
        }
        asm volatile("s_waitcnt vmcnt(0)" ::: "memory");
        __syncthreads();
    }
}
struct LdPlain {
    typedef uint4 Raw;
    const bf16_t* p; int ld; int nvalid;
    __device__ __forceinline__ uint4 fetch(int, int r, int kc) const { return (r < nvalid) ? *(const uint4*)(p + (size_t)r * ld + kc * 8) : make_uint4(0u, 0u, 0u, 0u); }
    __device__ __forceinline__ uint4 finish(const uint4& v, int, int, int) const { return v; }
};
struct LdGather {
    typedef uint4 Raw;
    const bf16_t* rp[4];
    __device__ __forceinline__ uint4 fetch(int i, int, int kc) const { const bf16_t* q = rp[i]; return q ? *(const uint4*)(q + kc * 8) : make_uint4(0u, 0u, 0u, 0u); }
    __device__ __forceinline__ uint4 finish(const uint4& v, int, int, int) const { return v; }
};
__device__ __forceinline__ void tile_map(int id, int NT, int& mt, int& nt) {
    const int x = id & 7, q = id >> 3;
    const int mg = q / (8 * NT), q2 = q - mg * 8 * NT, G = (NT + 7) >> 3;
    int g = q2 >> 6; g = g < G - 1 ? g : G - 1;
    const int r = q2 - (g << 6), w = (g == G - 1) ? NT - 8 * g : 8;
    mt = (mg * 8 + r / w) * 8 + x; nt = 8 * g + r % w;
}

__device__ __forceinline__ int conv_row(int mode, int n) {
    if (mode == 1) return (n >> 4) * 32 + (n & 15);
    if (mode == 2) return (n >> 4) * 32 + 16 + (n & 15);
    if (mode == 3 && n < 2048) { const int c = n & 255, c2 = c & 127; return (n & ~255) + (c2 >> 4) * 32 + ((c >> 7) << 4) + (c2 & 15); }
    return n;
}
__device__ __forceinline__ void phase_prologue(PRef p, char* lds) {
    const int t = tidx();
    const int n_ada = 8 * 48, n_rot = 256 + 144;
    float* mod = (float*)(p.ws + OFF_MOD);
    for (int it = blockIdx.x; it < n_ada + n_rot; it += gridDim.x) {
        if (it < n_ada) {
            const int pr = it / 48, cb = it % 48;
            float* sc = (float*)lds;
            float* red = (float*)(lds + 32768);
            for (int i = t; i < 8192; i += 256) { const int b = i >> 10, k = i & 1023; sc[k * 8 + b] = siluf_(p.in[1][b * 1024 + k]); }
            __syncthreads();
            const int kg = t >> 6, cl = t & 63, col = cb * 64 + cl;
            const float* W = p.in[2] + (size_t)pr * 1024 * 3072 + col;
            float a[8] = {0, 0, 0, 0, 0, 0, 0, 0};
#pragma unroll 8
            for (int k = kg * 256; k < kg * 256 + 256; ++k) {
                const float w = W[(size_t)k * 3072];
                const float4 s0 = *(const float4*)(sc + k * 8), s1 = *(const float4*)(sc + k * 8 + 4);
                a[0] += w * s0.x; a[1] += w * s0.y; a[2] += w * s0.z; a[3] += w * s0.w; a[4] += w * s1.x; a[5] += w * s1.y; a[6] += w * s1.z; a[7] += w * s1.w;
            }
#pragma unroll
            for (int b = 0; b < 8; ++b) red[(kg * 8 + b) * 64 + cl] = a[b];
            __syncthreads();
            for (int i = t; i < 512; i += 256) {
                const int b = i >> 6, c2 = i & 63;
                const float s = red[(0 * 8 + b) * 64 + c2] + red[(1 * 8 + b) * 64 + c2] + red[(2 * 8 + b) * 64 + c2] + red[(3 * 8 + b) * 64 + c2];
                mod[((size_t)pr * 8 + b) * 3072 + cb * 64 + c2] = s + p.in[3][pr * 3072 + cb * 64 + c2];
            }
            __syncthreads();
        } else if (it >= n_ada + 256 && it < n_ada + n_rot) {
            float* rtw = (float*)(p.ws + OFF_RTW);
            const int base = (it - n_ada - 256) * 1024;
            for (int e = base + t; e < base + 1024; e += 256) {
                const int L = e / (36 * 1024), o = (e >> 10) % 36, k = e & 1023;
                rtw[e] = (o < 4) ? p.in[36][((size_t)L * 1024 + k) * 4 + o] : p.in[38][((size_t)L * 1024 + k) * 32 + (o - 4)];
            }
        } else if (it < n_ada + 256) {
            float* rot = (float*)(p.ws + OFF_ROT);
            const int base = (it - n_ada) * 1024;
            for (int e = base + t; e < base + 1024; e += 256) {
                const int tt = e >> 7, i = e & 127;
                const float inv = __builtin_amdgcn_exp2f(-(float)i * (13.287712379549449f / 127.0f));
                const float ang = (float)tt * inv;
                float rev = ang * 0.15915494309189535f; rev -= floorf(rev);
                rot[e * 2] = __builtin_amdgcn_cosf(rev); rot[e * 2 + 1] = __builtin_amdgcn_sinf(rev);
            }
        }
    }
    {
        float* sm = (float*)lds;
        const int lane = t & 63, wv = t >> 6;
        const float* nsrc = nullptr; bf16_t* ndst = nullptr; int nK = 0, nN = 0, nmode = 0, nkt = 0, nnt = 0;
        float4 pv[16];
#define CJ_SETUP(ct_) { int c_ = (ct_), j_ = 0; while (j_ + 1 < p.ncj && c_ >= p.cj[j_ + 1].tile0) ++j_; \
            c_ -= p.cj[j_].tile0; const int tpb_ = p.cj[j_].tiles_pb; const int bi_ = c_ / tpb_, tl_ = c_ % tpb_; nK = p.cj[j_].K; nN = p.cj[j_].N; nmode = p.cj[j_].mode; \
            const int nNt_ = (nN + 255) >> 8; nkt = tl_ / nNt_; nnt = tl_ % nNt_; nsrc = p.cj[j_].src + (size_t)bi_ * p.cj[j_].sbs; ndst = p.cj[j_].dst + (size_t)bi_ * p.cj[j_].dbs; }
#define CJ_LOAD() { _Pragma("unroll") for (int i = 0; i < 16; ++i) { const int k = nkt * 64 + wv + 4 * i, n = nnt * 256 + lane * 4; \
            pv[i] = (k < nK && n < nN) ? gld_f4(nsrc + (size_t)k * nN + n) : make_float4(0.f, 0.f, 0.f, 0.f); } }
        int* const tick = (int*)(p.ws + OFF_CTL + 20480);
        int* const nbox = (int*)(lds + 66560);
        int ct = (int)blockIdx.x, ct2 = (int)gridDim.x + (int)blockIdx.x;
        if (ct < p.cj_tiles) { CJ_SETUP(ct); CJ_LOAD(); }
        while (ct < p.cj_tiles) {
#pragma unroll
            for (int i = 0; i < 16; ++i) *(float4*)(sm + (wv + 4 * i) * 260 + lane * 4) = pv[i];
            bf16_t* const sdst = ndst; const int sK = nK, sN = nN, smode = nmode, skt = nkt, snt = nnt;
            if (ct2 < p.cj_tiles) { CJ_SETUP(ct2); CJ_LOAD(); }
            if (t == 0) *nbox = 2 * (int)gridDim.x + atomicAdd(tick, 1);
            __syncthreads();
            const int ct3 = *nbox;
#pragma unroll
            for (int h2 = 0; h2 < 4; ++h2) {
                const int nl = lane + 64 * h2, n = snt * 256 + nl, k0 = skt * 64 + wv * 16;
                if (n < sN && k0 < sK) {
                    float f[8], g[8];
#pragma unroll
                    for (int q = 0; q < 8; ++q) { f[q] = sm[(wv * 16 + q) * 260 + nl]; g[q] = sm[(wv * 16 + 8 + q) * 260 + nl]; }
                    bf16_t* d = sdst + (size_t)conv_row(smode, n) * sK + k0;
                    { const uint4 u0 = pack8(f), u1 = pack8(g); gst_u4(d, u0.x, u0.y, u0.z, u0.w); gst_u4(d + 8, u1.x, u1.y, u1.z, u1.w); }
                }
            }
            __syncthreads();
            ct = ct2; ct2 = ct3;
        }
#undef CJ_SETUP
#undef CJ_LOAD
    }
}

__device__ __forceinline__ void row_load_f32(const float* p, float (&v)[16], int lane) {
#pragma unroll
    for (int c = 0; c < 4; ++c) { const float4 x = gld_f4(p + c * 256 + lane * 4); v[c * 4] = x.x; v[c * 4 + 1] = x.y; v[c * 4 + 2] = x.z; v[c * 4 + 3] = x.w; }
}
__device__ __forceinline__ void row_load_f32_l(const float* p, float (&v)[16], int lane) {
#pragma unroll
    for (int c = 0; c < 4; ++c) { const float4 x = *(const float4*)(p + c * 256 + lane * 4); v[c * 4] = x.x; v[c * 4 + 1] = x.y; v[c * 4 + 2] = x.z; v[c * 4 + 3] = x.w; }
}
__device__ __forceinline__ void row_load_bf16(const bf16_t* p, float (&v)[16], int lane) {
#pragma unroll
    for (int c = 0; c < 4; ++c) { const uint2 x = gld_u2(p + c * 256 + lane * 4); v[c * 4] = bflo(x.x); v[c * 4 + 1] = bfhi(x.x); v[c * 4 + 2] = bflo(x.y); v[c * 4 + 3] = bfhi(x.y); }
}
__device__ __forceinline__ void row_store_bf16(bf16_t* p, const float (&v)[16], int lane) {
#pragma unroll
    for (int c = 0; c < 4; ++c) gst_u2(p + c * 256 + lane * 4, cvt_pk(v[c * 4], v[c * 4 + 1]), cvt_pk(v[c * 4 + 2], v[c * 4 + 3]));
}
__device__ __forceinline__ void row_store_f32(float* p, const float (&v)[16], int lane) {
#pragma unroll
    for (int c = 0; c < 4; ++c) gst_f4(p + c * 256 + lane * 4, v[c * 4], v[c * 4 + 1], v[c * 4 + 2], v[c * 4 + 3]);
}
__device__ __forceinline__ void row_store_f32_l(float* p, const float (&v)[16], int lane) {
#pragma unroll
    for (int c = 0; c < 4; ++c) *(float4*)(p + c * 256 + lane * 4) = make_float4(v[c * 4], v[c * 4 + 1], v[c * 4 + 2], v[c * 4 + 3]);
}
__device__ __forceinline__ void row_layernorm(float (&v)[16], const float* g, const float* b, int lane) {
    float gg[16], bb[16]; row_load_f32(g, gg, lane); row_load_f32(b, bb, lane);
    float s = 0.f, q = 0.f;
#pragma unroll
    for (int i = 0; i < 16; ++i) { s += v[i]; q += v[i] * v[i]; }
    s = wave_sum(s); q = wave_sum(q);
    const float mean = s * (1.0f / 1024.0f);
    const float rstd = rsqrtf(fmaxf(q * (1.0f / 1024.0f) - mean * mean, 0.f) + LN_EPS);
#pragma unroll
    for (int i = 0; i < 16; ++i) v[i] = (v[i] - mean) * rstd * gg[i] + bb[i];
}
__device__ __forceinline__ void row_modulate(const float (&x)[16], float (&h)[16], const float* mod3, int lane) {
    float sh[16], sc[16]; row_load_f32(mod3, sh, lane); row_load_f32(mod3 + 1024, sc, lane);
#pragma unroll
    for (int i = 0; i < 16; ++i) h[i] = x[i] * (1.0f + sc[i]) + sh[i];
}
__device__ __forceinline__ void load_mu(const float* mu, float (&m)[6][16], int lane) {
#pragma unroll
    for (int n = 0; n < 6; ++n) row_load_f32(mu + n * 1024, m[n], lane);
}
__device__ __forceinline__ void emit_next(bf16_t* s0, int kind, int row, const float (&h)[16], const float (&hp)[16], const float (&m)[6][16], int lane) {
    if (kind == 0) {
#pragma unroll
        for (int n = 0; n < 6; ++n) {
#pragma unroll
            for (int c = 0; c < 4; ++c)
                gst_u2(s0 + (size_t)n * (SLOT / 2) + (size_t)row * 1024 + c * 256 + lane * 4,
                       cvt_pk(h[c * 4] + (hp[c * 4] - h[c * 4]) * m[n][c * 4], h[c * 4 + 1] + (hp[c * 4 + 1] - h[c * 4 + 1]) * m[n][c * 4 + 1]),
                       cvt_pk(h[c * 4 + 2] + (hp[c * 4 + 2] - h[c * 4 + 2]) * m[n][c * 4 + 2], h[c * 4 + 3] + (hp[c * 4 + 3] - h[c * 4 + 3]) * m[n][c * 4 + 3]));
        }
    } else row_store_bf16(s0 + (size_t)row * 1024, h, lane);
}
__device__ __forceinline__ void emit_next_l(bf16_t* s0, const float* mu, int kind, int row, const float (&h)[16], const float (&hp)[16], int lane) {
    if (kind == 0) {
#pragma unroll 1
        for (int n = 0; n < 6; ++n) {
#pragma unroll
            for (int c2 = 0; c2 < 2; ++c2) {
                const float4 ma = gld_f4(mu + n * 1024 + (2 * c2) * 256 + lane * 4), mb = gld_f4(mu + n * 1024 + (2 * c2 + 1) * 256 + lane * 4);
                const float mm[8] = {ma.x, ma.y, ma.z, ma.w, mb.x, mb.y, mb.z, mb.w};
#pragma unroll
                for (int cc = 0; cc < 2; ++cc) {
                    const int c = 2 * c2 + cc;
                    gst_u2(s0 + (size_t)n * (SLOT / 2) + (size_t)row * 1024 + c * 256 + lane * 4,
                           cvt_pk(h[c * 4] + (hp[c * 4] - h[c * 4]) * mm[cc * 4], h[c * 4 + 1] + (hp[c * 4 + 1] - h[c * 4 + 1]) * mm[cc * 4 + 1]),
                           cvt_pk(h[c * 4 + 2] + (hp[c * 4 + 2] - h[c * 4 + 2]) * mm[cc * 4 + 2], h[c * 4 + 3] + (hp[c * 4 + 3] - h[c * 4 + 3]) * mm[cc * 4 + 3]));
                }
            }
        }
    } else row_store_bf16(s0 + (size_t)row * 1024, h, lane);
}
__device__ __forceinline__ void phase_h0(PRef p) {
    const int t_ = tidx(); const int lane = t_ & 63, gw = blockIdx.x * 4 + (t_ >> 6), nw = gridDim.x * 4;
    const int rpw = NTOK / nw;
    const int r_lo = gw * rpw;
    const float* mod = (const float*)(p.ws + OFF_MOD) + ((size_t)(0 * 2 + 0) * 8 + (r_lo >> 11)) * 3072;
    float sh[16], sc[16]; row_load_f32(mod, sh, lane); row_load_f32(mod + 1024, sc, lane);
    float hp[16];
#pragma unroll
    for (int i = 0; i < 16; ++i) hp[i] = 0.f;
    float mu[6][16]; load_mu(p.in[6], mu, lane);
    const int first = ((r_lo & 2047) != 0) ? r_lo - 1 : r_lo, end = r_lo + rpw;
    float nx[16]; row_load_f32(p.in[0] + (size_t)first * 1024, nx, lane);
    for (int r = first; r < end; ++r) {
        float h[16];
#pragma unroll
        for (int i = 0; i < 16; ++i) h[i] = nx[i] * (1.0f + sc[i]) + sh[i];
        if (r + 1 < end) row_load_f32(p.in[0] + (size_t)(r + 1) * 1024, nx, lane);
        __builtin_amdgcn_sched_barrier(0);
        if (r >= r_lo) emit_next((bf16_t*)(p.ws + OFF_SLOT), 0, r, h, hp, mu, lane);
#pragma unroll
        for (int i = 0; i < 16; ++i) hp[i] = h[i];
        if (((r + 1) & 2047) == 0) {
#pragma unroll
            for (int i = 0; i < 16; ++i) hp[i] = 0.f;
        }
    }
}
__device__ __forceinline__ int layer_kind(int L) { return L % 3; }
__device__ __forceinline__ void phase_ln2(PRef p, int L) {
    const int t_ = tidx(); const int lane = t_ & 63, gw = blockIdx.x * 4 + (t_ >> 6), nw = gridDim.x * 4;
    const int rpw = NTOK / nw, r_lo = gw * rpw;
    const float* mod = (const float*)(p.ws + OFF_MOD);
    const bf16_t* xres = (const bf16_t*)(p.ws + OFF_XRES);
    const bf16_t* Y = (const bf16_t*)(p.ws + OFF_SLOT + 9 * SLOT);
    const float* wgt = (const float*)(p.ws + OFF_WGT);
    const bool last = (L == 3);
    const int nk = layer_kind(L + 1), njr = (L + 1) / 3;
    const bool need_prev = (!last && nk == 0);
    const int bidx = r_lo >> 11;
    float gt[16], lgn[16], lbn[16];
    row_load_f32(mod + ((size_t)(L * 2 + 1) * 8 + bidx) * 3072 + 2048, gt, lane);
    row_load_f32(p.in[4] + (L * 2 + 1) * 1024, lgn, lane); row_load_f32(p.in[5] + (L * 2 + 1) * 1024, lbn, lane);
    float hp[16];
#pragma unroll
    for (int i = 0; i < 16; ++i) hp[i] = 0.f;
    float shn[16], scn[16];
    { const float* mn_ = mod + ((size_t)((last ? L : L + 1) * 2 + 0) * 8 + bidx) * 3072; row_load_f32(mn_, shn, lane); row_load_f32(mn_ + 1024, scn, lane); }
    uint2 nxr[4], ny0[4], ny1[4]; float nw0, nw1;
    auto load_in = [&](int r) {
#pragma unroll
        for (int c = 0; c < 4; ++c) { nxr[c] = *(const uint2*)(xres + (size_t)r * 1024 + c * 256 + lane * 4); ny0[c] = *(const uint2*)(Y + (size_t)(2 * r) * 1024 + c * 256 + lane * 4); ny1[c] = *(const uint2*)(Y + (size_t)(2 * r + 1) * 1024 + c * 256 + lane * 4); }
        nw0 = wgt[2 * r]; nw1 = wgt[2 * r + 1];
    };
    const int first = (need_prev && (r_lo & 2047) != 0) ? r_lo - 1 : r_lo, end = r_lo + rpw;
    load_in(first);
    for (int r = first; r < end; ++r) {
        float x[16];
        {
            const float w0 = nw0, w1 = nw1;
#pragma unroll
            for (int c = 0; c < 4; ++c) {
                const float a0[4] = {bflo(ny0[c].x), bfhi(ny0[c].x), bflo(ny0[c].y), bfhi(ny0[c].y)}, a1[4] = {bflo(ny1[c].x), bfhi(ny1[c].x), bflo(ny1[c].y), bfhi(ny1[c].y)};
                const float xr[4] = {bflo(nxr[c].x), bfhi(nxr[c].x), bflo(nxr[c].y), bfhi(nxr[c].y)};
#pragma unroll
                for (int i = 0; i < 4; ++i) x[c * 4 + i] = DN_ALPHA * xr[i] + (1.0f + gt[c * 4 + i]) * (w0 * a0[i] + w1 * a1[i]);
            }
        }
        if (r + 1 < end) load_in(r + 1);
        __builtin_amdgcn_sched_barrier(0);
        float s = 0.f, q = 0.f;
#pragma unroll
        for (int i = 0; i < 16; ++i) { s += x[i]; q += x[i] * x[i]; }
        s = wave_sum(s); q = wave_sum(q);
        const float mean = s * (1.0f / 1024.0f), rstd = rsqrtf(fmaxf(q * (1.0f / 1024.0f) - mean * mean, 0.f) + LN_EPS);
#pragma unroll
        for (int i = 0; i < 16; ++i) x[i] = (x[i] - mean) * rstd * lgn[i] + lbn[i];
        if (last) { row_store_f32(p.out + (size_t)r * 1024, x, lane); continue; }
        float h[16];
#pragma unroll
        for (int i = 0; i < 16; ++i) h[i] = x[i] * (1.0f + scn[i]) + shn[i];
        if (r >= r_lo) { row_store_bf16((bf16_t*)(p.ws + OFF_XRES2) + (size_t)r * 1024, x, lane); emit_next_l((bf16_t*)(p.ws + OFF_SLOT), p.in[6] + (size_t)njr * 6 * 1024, nk, r, h, hp, lane); }
#pragma unroll
        for (int i = 0; i < 16; ++i) hp[i] = h[i];
        if (((r + 1) & 2047) == 0) {
#pragma unroll
            for (int i = 0; i < 16; ++i) hp[i] = 0.f;
        }
    }
}
__device__ __forceinline__ void phase_ln1(PRef p, int L, char* lds, const bf16_t* ymix, bf16_t* hm) {
    const int t = tidx(), lane = t & 63, wid = t >> 6;
    const float* mod = (const float*)(p.ws + OFF_MOD);
    const bf16_t* xinb = (const bf16_t*)(p.ws + OFF_XRES2);
    bf16_t* xres = (bf16_t*)(p.ws + OFF_XRES);
    int* cnt = (int*)(p.ws + OFF_CNT) + L * 32;
    int* list = (int*)(p.ws + OFF_LIST);
    float* wgt = (float*)(p.ws + OFF_WGT);
    float* const HB = (float*)lds;
    float* const lg = (float*)(lds + 65536);
    const float* rtw = (const float*)(p.ws + OFF_RTW) + (size_t)L * 36 * 1024;
    const int rpb = NTOK / gridDim.x;
    const int bidx = (blockIdx.x * rpb) >> 11;
    float gt[16], lgn[16], lbn[16], sh2[16], sc2[16];
    row_load_f32(mod + ((size_t)(L * 2 + 0) * 8 + bidx) * 3072 + 2048, gt, lane);
    row_load_f32(p.in[4] + (L * 2 + 0) * 1024, lgn, lane); row_load_f32(p.in[5] + (L * 2 + 0) * 1024, lbn, lane);
    row_load_f32(mod + ((size_t)(L * 2 + 1) * 8 + bidx) * 3072, sh2, lane); row_load_f32(mod + ((size_t)(L * 2 + 1) * 8 + bidx) * 3072 + 1024, sc2, lane);
    for (int rb0 = blockIdx.x * rpb; rb0 < (blockIdx.x + 1) * rpb; rb0 += 16) {
        const int rb = rb0 + wid * 4;
        uint4 xr[4][4]; uint2 yr[4][4];
#pragma unroll
        for (int rr = 0; rr < 4; ++rr) {
            const int r = rb + rr;
#pragma unroll
            for (int c = 0; c < 4; ++c) {
                if (L == 0) xr[rr][c] = gld_u4(p.in[0] + (size_t)r * 1024 + c * 256 + lane * 4);
                else { const uint2 t2 = gld_u2(xinb + (size_t)r * 1024 + c * 256 + lane * 4); xr[rr][c] = make_uint4(t2.x, t2.y, 0u, 0u); }
                yr[rr][c] = gld_u2(ymix + (size_t)r * 1024 + c * 256 + lane * 4);
            }
        }
#pragma unroll
        for (int rr = 0; rr < 4; ++rr) {
            const int r = rb + rr;
            float x[16], h[16];
#pragma unroll
            for (int c = 0; c < 4; ++c) {
                float xv[4];
                if (L == 0) { xv[0] = __uint_as_float(xr[rr][c].x); xv[1] = __uint_as_float(xr[rr][c].y); xv[2] = __uint_as_float(xr[rr][c].z); xv[3] = __uint_as_float(xr[rr][c].w); }
                else { xv[0] = bflo(xr[rr][c].x); xv[1] = bfhi(xr[rr][c].x); xv[2] = bflo(xr[rr][c].y); xv[3] = bfhi(xr[rr][c].y); }
                const float yv[4] = {bflo(yr[rr][c].x), bfhi(yr[rr][c].x), bflo(yr[rr][c].y), bfhi(yr[rr][c].y)};
#pragma unroll
                for (int i = 0; i < 4; ++i) x[c * 4 + i] = DN_ALPHA * xv[i] + (1.0f + gt[c * 4 + i]) * yv[i];
            }
            float s = 0.f, q = 0.f;
#pragma unroll
            for (int i = 0; i < 16; ++i) { s += x[i]; q += x[i] * x[i]; }
            s = wave_sum(s); q = wave_sum(q);
            const float mean = s * (1.0f / 1024.0f), rstd = rsqrtf(fmaxf(q * (1.0f / 1024.0f) - mean * mean, 0.f) + LN_EPS);
#pragma unroll
            for (int i = 0; i < 16; ++i) { x[i] = (x[i] - mean) * rstd * lgn[i] + lbn[i]; h[i] = x[i] * (1.0f + sc2[i]) + sh2[i]; }
            row_store_bf16(xres + (size_t)r * 1024, x, lane);
            row_store_bf16(hm + (size_t)r * 1024, h, lane);
            row_store_f32_l(HB + (wid * 4 + rr) * 1024, h, lane);
        }
        __syncthreads();
#pragma unroll 1
        for (int q3 = 0; q3 < 9; q3 += 3) {
            float w[3][16];
#pragma unroll
            for (int u = 0; u < 3; ++u) row_load_f32(rtw + (size_t)(wid * 9 + q3 + u) * 1024, w[u], lane);
#pragma unroll 2
            for (int r16 = 0; r16 < 16; ++r16) {
                float h[16]; row_load_f32_l(HB + r16 * 1024, h, lane);
                float a3[3];
#pragma unroll
                for (int u = 0; u < 3; ++u) { f32x2_t s2 = {0.f, 0.f};
#pragma unroll
                    for (int i = 0; i < 8; ++i) { const f32x2_t hh = {h[2 * i], h[2 * i + 1]}, ww = {w[u][2 * i], w[u][2 * i + 1]}; s2 = __builtin_elementwise_fma(hh, ww, s2); }
                    a3[u] = s2.x + s2.y; }
                {
                    const auto r01 = __builtin_amdgcn_permlane32_swap(__float_as_uint(a3[0]), __float_as_uint(a3[1]), false, false);
                    const float z = __uint_as_float(r01[0]) + __uint_as_float(r01[1]);
                    const float c2 = xor32_add(a3[2]);
                    const auto rz = __builtin_amdgcn_permlane16_swap(__float_as_uint(z), __float_as_uint(c2), false, false);
                    const float tot = row16_sum(__uint_as_float(rz[0]) + __uint_as_float(rz[1]));
                    if ((lane & 15) == 0 && lane < 48) lg[r16 * 36 + wid * 9 + q3 + (lane == 0 ? 0 : lane == 32 ? 1 : 2)] = tot;
                }
            }
        }
        __syncthreads();
        if (t < 16) {
            const int row = rb0 + t; const float* l = lg + t * 36;
            float g[4]; for (int i = 0; i < 4; ++i) g[i] = l[i] + p.in[37][L * 4 + i];
            int gi = 0; for (int i = 1; i < 4; ++i) if (g[i] > g[gi]) gi = i;
            float gs = 0.f; for (int i = 0; i < 4; ++i) gs += __expf(g[i] - g[gi]);
            const float ggate = 1.0f / gs;
            float e[8]; for (int i = 0; i < 8; ++i) e[i] = l[4 + gi * 8 + i] + p.in[39][L * 32 + gi * 8 + i];
            int i0 = 0; for (int i = 1; i < 8; ++i) if (e[i] > e[i0]) i0 = i;
            int i1 = (i0 == 0) ? 1 : 0; for (int i = 0; i < 8; ++i) if (i != i0 && e[i] > e[i1]) i1 = i;
            const float p1 = __expf(e[i1] - e[i0]);
            const float w0 = ggate / (1.0f + p1), w1 = ggate * p1 / (1.0f + p1);
            const int e0 = gi * 8 + i0, e1 = gi * 8 + i1;
            const int pos0 = atomicAdd(&cnt[e0], 1), pos1 = atomicAdd(&cnt[e1], 1);
            list[e0 * LIST_CAP + pos0] = 2 * row; list[e1 * LIST_CAP + pos1] = 2 * row + 1;
            wgt[2 * row] = w0; wgt[2 * row + 1] = w1;
        }
        asm volatile("s_waitcnt lgkmcnt(0)" ::: "memory");
    }
}

__device__ __forceinline__ int perm64(int r) { return (r & 64) | (((r >> 2) & 3) << 4) | (((r >> 4) & 3) << 2) | (r & 3); }
__device__ __forceinline__ bool tile_permuted(int mode, int nt) { return (mode <= MODE_SIGM) || (mode == MODE_ML1 && nt < 24) || (mode == MODE_RT1 && nt >= 16); }
__device__ __forceinline__ void store16(bf16_t* d, const f32x4 (&v)[4]) {
    gst_u4(d, cvt_pk(v[0][0], v[0][1]), cvt_pk(v[0][2], v[0][3]), cvt_pk(v[1][0], v[1][1]), cvt_pk(v[1][2], v[1][3]));
    gst_u4(d + 8, cvt_pk(v[2][0], v[2][1]), cvt_pk(v[2][2], v[2][3]), cvt_pk(v[3][0], v[3][1]), cvt_pk(v[3][2], v[3][3]));
}
__device__ __forceinline__ void gemm_epilogue(PRef p, const GJob& jb, int mt, int nt, const f32x4 (&acc)[4][4]) {
    const int t_ = tidx(); const int lane = t_ & 63, wid = t_ >> 6, wr = wid >> 1, wc = wid & 1, fr = lane & 15, fq = lane >> 4;
    const int row0 = mt * 128 + wr * 64 + fr;
    if (jb.mode <= MODE_SIGM) {
        const int col = nt * 128 + wc * 64 + fq * 16;
        if (col < jb.N) {
#pragma unroll
            for (int m = 0; m < 4; ++m) {
                f32x4 v[4];
#pragma unroll
                for (int n = 0; n < 4; ++n) {
                    v[n] = acc[m][n];
                    if (jb.mode == MODE_TANH) { v[n][0] = tanhf_(v[n][0]); v[n][1] = tanhf_(v[n][1]); v[n][2] = tanhf_(v[n][2]); v[n][3] = tanhf_(v[n][3]); }
                    else if (jb.mode == MODE_SIGM) { v[n][0] = sigmoidf_(v[n][0]); v[n][1] = sigmoidf_(v[n][1]); v[n][2] = sigmoidf_(v[n][2]); v[n][3] = sigmoidf_(v[n][3]); }
                }
                store16(jb.out + (size_t)(row0 + m * 16) * jb.ldo + col, v);
            }
        }
    } else if (jb.mode == MODE_ML1) {
        if (nt < 24) {
            bf16_t* ob = (bf16_t*)(p.ws + OFF_SLOT + (size_t)(1 + (nt >> 3)) * SLOT);
            const bool sg = (nt >= 16);
            const int col = (nt & 7) * 128 + wc * 64 + fq * 16;
#pragma unroll
            for (int m = 0; m < 4; ++m) {
                f32x4 v[4];
#pragma unroll
                for (int n = 0; n < 4; ++n) {
                    v[n] = acc[m][n];
                    if (sg) { v[n][0] = sigmoidf_(v[n][0]); v[n][1] = sigmoidf_(v[n][1]); v[n][2] = sigmoidf_(v[n][2]); v[n][3] = sigmoidf_(v[n][3]); }
                }
                store16(ob + (size_t)(row0 + m * 16) * 1024 + col, v);
            }
        } else if (wc == 0) {
            float* gates = (float*)(p.ws + OFF_GATES);
            const float* bg = p.in[26];
            const int c0 = fq * 4;
#pragma unroll
            for (int m = 0; m < 4; ++m) {
                f32x4 v = acc[m][0], o;
#pragma unroll
                for (int j = 0; j < 4; ++j) { const float g = v[j] + bg[c0 + j]; o[j] = (c0 + j < 8) ? g : -softplusf_(-g); }
                gst_f4(gates + (size_t)(row0 + m * 16) * 16 + c0, o[0], o[1], o[2], o[3]);
            }
        }
    } else {
        if (nt < 16) {
            const float* rot = (const float*)(p.ws + OFF_ROT);
            bf16_t* ob = (bf16_t*)(p.ws + OFF_SLOT + (size_t)(1 + (nt >> 3)) * SLOT);
            const float scl = (nt >= 8) ? 0.0625f : 1.0f;
#pragma unroll
            for (int pp = 0; pp < 2; ++pp) {
                const int blk32 = (nt & 7) * 4 + wc * 2 + pp, head = blk32 >> 3, i0 = (blk32 & 7) * 16 + fq * 4;
                float4 rc0[4], rc1[4];
#pragma unroll
                for (int m = 0; m < 4; ++m) { const int tt = (row0 + m * 16) & 2047; rc0[m] = gld_f4(rot + ((size_t)tt * 128 + i0) * 2); rc1[m] = gld_f4(rot + ((size_t)tt * 128 + i0) * 2 + 4); }
#pragma unroll
                for (int m = 0; m < 4; ++m) {
                    const int row = row0 + m * 16;
                    const float4 c0 = rc0[m], c1 = rc1[m];
                    const float cs[4] = {c0.x, c0.z, c1.x, c1.z}, sn[4] = {c0.y, c0.w, c1.y, c1.w};
                    const f32x4 x1 = acc[m][2 * pp], x2 = acc[m][2 * pp + 1];
                    float o1[4], o2[4];
#pragma unroll
                    for (int j = 0; j < 4; ++j) { o1[j] = (x1[j] * cs[j] - x2[j] * sn[j]) * scl; o2[j] = (x1[j] * sn[j] + x2[j] * cs[j]) * scl; }
                    gst_u2(ob + (size_t)row * 1024 + head * 256 + i0, cvt_pk(o1[0], o1[1]), cvt_pk(o1[2], o1[3]));
                    gst_u2(ob + (size_t)row * 1024 + head * 256 + 128 + i0, cvt_pk(o2[0], o2[1]), cvt_pk(o2[2], o2[3]));
                }
            }
        } else {
            const bool isg = (nt >= 32);
            bf16_t* ob = (bf16_t*)(p.ws + OFF_SLOT + (size_t)(isg ? 5 : 3) * SLOT);
            const int col = (nt & 15) * 128 + wc * 64 + fq * 16;
#pragma unroll
            for (int m = 0; m < 4; ++m) {
                f32x4 v[4];
#pragma unroll
                for (int n = 0; n < 4; ++n) {
                    v[n] = acc[m][n];
                    if (isg) { v[n][0] = siluf_(v[n][0]); v[n][1] = siluf_(v[n][1]); v[n][2] = siluf_(v[n][2]); v[n][3] = siluf_(v[n][3]); }
                }
                store16(ob + (size_t)(row0 + m * 16) * 2048 + col, v);
            }
        }
    }
}
__device__ __forceinline__ void phase_gemm_jobs(PRef p, char* lds, int jlo, int jhi) {
    const int total = p.gj[jhi - 1].tile0 + 128 * p.gj[jhi - 1].ntn - p.gj[jlo].tile0;
    for (int id = blockIdx.x; id < total; id += gridDim.x) {
        int j = jlo; const int gid = id + p.gj[jlo].tile0;
        while (j + 1 < jhi && gid >= p.gj[j + 1].tile0) ++j;
        GJob jb; jb.A = p.gj[j].A; jb.Bt = p.gj[j].Bt; jb.out = p.gj[j].out; jb.K = p.gj[j].K; jb.N = p.gj[j].N; jb.ldo = p.gj[j].ldo; jb.mode = p.gj[j].mode; jb.ntn = p.gj[j].ntn; jb.tile0 = p.gj[j].tile0;
        jb.half = p.gj[j].half;
        int mt, nt; tile_map(gid - jb.tile0, jb.ntn, mt, nt);
        if (jb.half || (jb.mode == MODE_ML1 && nt == 24)) {
            const int t_ = tidx(), r0_ = t_ >> 3, co_ = glds_chunk(t_) * 8, ln_ = t_ & 63, wv_ = t_ >> 6, fr_ = ln_ & 15, fq_ = ln_ >> 4;
            const int cb = jb.half ? nt * 64 : nt * 128;
            int nvh = jb.N - cb; nvh = nvh > 64 ? 64 : nvh;
            const bf16_t* ar[4]; const bf16_t* brh[2];
#pragma unroll
            for (int i = 0; i < 4; ++i) ar[i] = jb.A + (size_t)(mt * 128 + r0_ + 32 * i) * jb.K + co_;
#pragma unroll
            for (int i = 0; i < 2; ++i) { int rb_ = r0_ + 32 * i; rb_ = jb.half ? perm64(rb_) : rb_; rb_ = rb_ < nvh ? rb_ : nvh - 1; brh[i] = jb.Bt + (size_t)(cb + rb_) * jb.K + co_; }
            f32x4 ah[2][4];
            gemm_hn(lds, jb.K / 64, ar, brh, ah);
            const int rowh = mt * 128 + wv_ * 32 + fr_;
            if (jb.half) {
                const int col = cb + fq_ * 16;
                if (col < jb.N) {
#pragma unroll
                    for (int m = 0; m < 2; ++m) {
                        f32x4 v[4];
#pragma unroll
                        for (int n = 0; n < 4; ++n) {
                            v[n] = ah[m][n];
#pragma unroll
                            for (int jj = 0; jj < 4; ++jj) v[n][jj] = (jb.mode == MODE_TANH) ? tanhf_(v[n][jj]) : (jb.mode == MODE_SIGM) ? sigmoidf_(v[n][jj]) : v[n][jj];
                        }
                        store16(jb.out + (size_t)(rowh + m * 16) * jb.ldo + col, v);
                    }
                }
            } else {
                float* gates = (float*)(p.ws + OFF_GATES);
                const float* bg = p.in[26];
                const int c0 = fq_ * 4;
                const float4 bq = gld_f4(bg + c0);
                const float bqa[4] = {bq.x, bq.y, bq.z, bq.w};
#pragma unroll
                for (int m = 0; m < 2; ++m) {
                    float o[4];
#pragma unroll
                    for (int jj = 0; jj < 4; ++jj) { const float g = ah[m][0][jj] + bqa[jj]; o[jj] = (c0 + jj < 8) ? g : -softplusf_(-g); }
                    gst_f4(gates + (size_t)(rowh + m * 16) * 16 + c0, o[0], o[1], o[2], o[3]);
                }
            }
            continue;
        }
        int nv = jb.N - nt * 128; nv = nv > 128 ? 128 : nv;
        const bf16_t* ar[4]; const bf16_t* br[4];
        {
            const int t_ = tidx(), r0_ = t_ >> 3, co_ = glds_chunk(t_) * 8;
            const bool pm_ = tile_permuted(jb.mode, nt);
#pragma unroll
            for (int i = 0; i < 4; ++i) {
                ar[i] = jb.A + (size_t)(mt * 128 + r0_ + 32 * i) * jb.K + co_;
                int rb_ = r0_ + 32 * i; rb_ = pm_ ? perm64(rb_) : rb_; rb_ = rb_ < nv ? rb_ : nv - 1;
                br[i] = jb.Bt + (size_t)(nt * 128 + rb_) * jb.K + co_;
            }
        }
        f32x4 acc[4][4];
        gemm_gg(lds, jb.K / 64, ar, br, acc);
        gemm_epilogue(p, jb, mt, nt, acc);
    }
}

constexpr int RM = 4;
template <int KL>
__device__ __forceinline__ void minigemm(const bf16_t* A, const bf16_t* Bt, int fr, int fq, f32x4 (&acc)[RM][4]) {
#pragma unroll
    for (int m = 0; m < RM; ++m)
#pragma unroll
        for (int n = 0; n < 4; ++n) acc[m][n] = (f32x4){0.f, 0.f, 0.f, 0.f};
#pragma unroll 2
    for (int ks = 0; ks < KL / 32; ++ks) {
        uint4 af[RM], bfm[4];
#pragma unroll
        for (int m = 0; m < RM; ++m) af[m] = gld_u4(A + (size_t)(m * 16 + fr) * KL + ks * 32 + fq * 8);
#pragma unroll
        for (int n = 0; n < 4; ++n) bfm[n] = gld_u4(Bt + (size_t)((fr >> 2) * 16 + n * 4 + (fr & 3)) * KL + ks * 32 + fq * 8);
#pragma unroll
        for (int m = 0; m < RM; ++m)
#pragma unroll
            for (int n = 0; n < 4; ++n) acc[m][n] = mfma16(bfm[n], af[m], acc[m][n]);
    }
}
__device__ __forceinline__ void phase_rw2(PRef p, int jr) {
    const int t_ = tidx(); const int lane = t_ & 63, wid = t_ >> 6, wr = wid >> 1, wc = wid & 1, fr = lane & 15, fq = lane >> 4;
    char* S = p.ws + OFF_SLOT;
    float* decay = (float*)S; bf16_t* nkk = (bf16_t*)(S + 2 * SLOT); bf16_t* bb = (bf16_t*)(S + 3 * SLOT); bf16_t* gb = (bf16_t*)(S + 4 * SLOT);
    const bf16_t* rb = (const bf16_t*)(S + 6 * SLOT); const bf16_t* kb = (const bf16_t*)(S + 7 * SLOT); bf16_t* kpb = (bf16_t*)(S + 10 * SLOT);
    const bf16_t* vb = (const bf16_t*)(S + 8 * SLOT); bf16_t* vpb = (bf16_t*)(S + 9 * SLOT); const bf16_t* vf = (const bf16_t*)(S + 11 * SLOT);
    float* bonus = (float*)(p.ws + OFF_BONUS);
    const bf16_t* Lw = (const bf16_t*)(p.ws + OFF_LW); const bf16_t* La = (const bf16_t*)(p.ws + OFF_LA);
    const bf16_t* Lg = (const bf16_t*)(p.ws + OFF_LG); const bf16_t* Lv = (const bf16_t*)(p.ws + OFF_LV);
    const bf16_t* w2t = (const bf16_t*)(p.ws + W_W2T) + (size_t)jr * 1024 * 64; const bf16_t* a2t = (const bf16_t*)(p.ws + W_A2T) + (size_t)jr * 1024 * 64;
    const bf16_t* g2t = (const bf16_t*)(p.ws + W_G2T) + (size_t)jr * 1024 * 128; const bf16_t* v2t = (const bf16_t*)(p.ws + W_V2T);
    const float* w0 = p.in[8] + jr * 1024; const float* a0 = p.in[11] + jr * 1024; const float* v0 = p.in[14];
    const float* kkw = p.in[19] + jr * 1024; const float* kaw = p.in[20] + jr * 1024; const float* rk = p.in[21] + jr * 1024;
    for (int id2 = blockIdx.x; id2 < 128 * 8; id2 += gridDim.x) {
        int mt, nt; tile_map(id2, 8, mt, nt);
        const int row0 = mt * 128 + wr * 64, col0 = nt * 128 + wc * 64, head = nt * 2 + wc;
        f32x4 acc[RM][4];
        const int c0 = col0 + fq * 16;
        minigemm<64>(La + (size_t)row0 * 64, a2t + (size_t)col0 * 64, fr, fq, acc);
        float ss[RM], bs[RM];
#pragma unroll
        for (int m = 0; m < RM; ++m) { ss[m] = 0.f; bs[m] = 0.f; }
#pragma unroll
        for (int m = 0; m < RM; ++m) {
            const size_t off = (size_t)(row0 + m * 16 + fr) * 1024 + c0;
            const uint4 kq0 = *(const uint4*)(kb + off), kq1 = *(const uint4*)(kb + off + 8);
            const unsigned kw[8] = {kq0.x, kq0.y, kq0.z, kq0.w, kq1.x, kq1.y, kq1.z, kq1.w};
#pragma unroll
            for (int n = 0; n < 4; ++n) {
                const float4 a0v = *(const float4*)(a0 + c0 + n * 4), kkv = *(const float4*)(kkw + c0 + n * 4);
                const float a0a[4] = {a0v.x, a0v.y, a0v.z, a0v.w}, kka[4] = {kkv.x, kkv.y, kkv.z, kkv.w};
                const float kf4[4] = {bflo(kw[n * 2]), bfhi(kw[n * 2]), bflo(kw[n * 2 + 1]), bfhi(kw[n * 2 + 1])};
#pragma unroll
                for (int j = 0; j < 4; ++j) { acc[m][n][j] = sigmoidf_(a0a[j] + acc[m][n][j]); const float q = kf4[j] * kka[j]; ss[m] += q * q; }
            }
            asm volatile("" ::: "memory");
        }
#pragma unroll
        for (int m = 0; m < RM; ++m) { ss[m] = xor16_add(ss[m]); ss[m] = xor32_add(ss[m]); ss[m] = fminf(__builtin_amdgcn_rsqf(ss[m]), 1e12f); }
        float4 kkq[4], kaq[4], rkq[4];
#pragma unroll
        for (int n = 0; n < 4; ++n) { kkq[n] = gld_f4(kkw + c0 + n * 4); kaq[n] = gld_f4(kaw + c0 + n * 4); rkq[n] = gld_f4(rk + c0 + n * 4); }
#pragma unroll
        for (int m = 0; m < RM; ++m) {
            const size_t off = (size_t)(row0 + m * 16 + fr) * 1024 + c0;
            const uint4 rq0 = *(const uint4*)(rb + off), rq1 = *(const uint4*)(rb + off + 8), kq0 = *(const uint4*)(kb + off), kq1 = *(const uint4*)(kb + off + 8);
            const unsigned kw[8] = {kq0.x, kq0.y, kq0.z, kq0.w, kq1.x, kq1.y, kq1.z, kq1.w};
            const unsigned rw[8] = {rq0.x, rq0.y, rq0.z, rq0.w, rq1.x, rq1.y, rq1.z, rq1.w};
            unsigned okp[8], onk[8], obb[8];
#pragma unroll
            for (int n = 0; n < 4; ++n) {
                const float kka[4] = {kkq[n].x, kkq[n].y, kkq[n].z, kkq[n].w}, kaa[4] = {kaq[n].x, kaq[n].y, kaq[n].z, kaq[n].w}, rka[4] = {rkq[n].x, rkq[n].y, rkq[n].z, rkq[n].w};
                const float rf[4] = {bflo(rw[n * 2]), bfhi(rw[n * 2]), bflo(rw[n * 2 + 1]), bfhi(rw[n * 2 + 1])}, kf4[4] = {bflo(kw[n * 2]), bfhi(kw[n * 2]), bflo(kw[n * 2 + 1]), bfhi(kw[n * 2 + 1])};
                float kp[4], nk[4], b4[4];
#pragma unroll
                for (int j = 0; j < 4; ++j) {
                    const float a = acc[m][n][j], k = kf4[j], kn = k * kka[j] * ss[m];
                    kp[j] = k * (1.0f + (a - 1.0f) * kaa[j]); nk[j] = -kn; b4[j] = kn * a; bs[m] += rf[j] * kp[j] * rka[j];
                }
                okp[n * 2] = cvt_pk(kp[0], kp[1]); okp[n * 2 + 1] = cvt_pk(kp[2], kp[3]);
                onk[n * 2] = cvt_pk(nk[0], nk[1]); onk[n * 2 + 1] = cvt_pk(nk[2], nk[3]);
                obb[n * 2] = cvt_pk(b4[0], b4[1]); obb[n * 2 + 1] = cvt_pk(b4[2], b4[3]);
            }
            *(uint4*)(kpb + off) = make_uint4(okp[0], okp[1], okp[2], okp[3]); *(uint4*)(kpb + off + 8) = make_uint4(okp[4], okp[5], okp[6], okp[7]);
            *(uint4*)(nkk + off) = make_uint4(onk[0], onk[1], onk[2], onk[3]); *(uint4*)(nkk + off + 8) = make_uint4(onk[4], onk[5], onk[6], onk[7]);
            *(uint4*)(bb + off) = make_uint4(obb[0], obb[1], obb[2], obb[3]); *(uint4*)(bb + off + 8) = make_uint4(obb[4], obb[5], obb[6], obb[7]);
            asm volatile("" ::: "memory");
        }
#pragma unroll
        for (int m = 0; m < RM; ++m) { bs[m] = xor16_add(bs[m]); bs[m] = xor32_add(bs[m]); if (fq == 0) bonus[(size_t)(row0 + m * 16 + fr) * 16 + head] = bs[m]; }
        minigemm<64>(Lw + (size_t)row0 * 64, w2t + (size_t)col0 * 64, fr, fq, acc);
        float4 w0q[4];
#pragma unroll
        for (int n = 0; n < 4; ++n) w0q[n] = gld_f4(w0 + c0 + n * 4);
#pragma unroll
        for (int n = 0; n < 4; ++n) {
            const float w0a[4] = {w0q[n].x, w0q[n].y, w0q[n].z, w0q[n].w};
#pragma unroll
            for (int m = 0; m < RM; ++m) {
                f32x4 o;
#pragma unroll
                for (int j = 0; j < 4; ++j) { const float wl = -softplusf_(-(w0a[j] + acc[m][n][j])) - 0.5f; o[j] = __expf(-__expf(wl)); }
                *(f32x4*)(decay + (size_t)(row0 + m * 16 + fr) * 1024 + c0 + n * 4) = o;
            }
        }
        minigemm<128>(Lg + (size_t)row0 * 128, g2t + (size_t)col0 * 128, fr, fq, acc);
#pragma unroll
        for (int m = 0; m < RM; ++m) {
            unsigned o[8];
#pragma unroll
            for (int n = 0; n < 4; ++n) { o[n * 2] = cvt_pk(acc[m][n][0], acc[m][n][1]); o[n * 2 + 1] = cvt_pk(acc[m][n][2], acc[m][n][3]); }
            bf16_t* d = gb + (size_t)(row0 + m * 16 + fr) * 1024 + c0;
            *(uint4*)d = make_uint4(o[0], o[1], o[2], o[3]); *(uint4*)(d + 8) = make_uint4(o[4], o[5], o[6], o[7]);
        }
        if (jr > 0) {
            minigemm<32>(Lv + (size_t)row0 * 32, v2t + (size_t)col0 * 32, fr, fq, acc);
#pragma unroll
            for (int m = 0; m < RM; ++m) {
                const size_t off = (size_t)(row0 + m * 16 + fr) * 1024 + c0;
                const uint4 vq0 = *(const uint4*)(vb + off), vq1 = *(const uint4*)(vb + off + 8), fq0 = *(const uint4*)(vf + off), fq1 = *(const uint4*)(vf + off + 8);
                const unsigned vw[8] = {vq0.x, vq0.y, vq0.z, vq0.w, vq1.x, vq1.y, vq1.z, vq1.w}, fw[8] = {fq0.x, fq0.y, fq0.z, fq0.w, fq1.x, fq1.y, fq1.z, fq1.w};
                unsigned o[8];
#pragma unroll
                for (int n = 0; n < 4; ++n) {
                    const float4 v0v = *(const float4*)(v0 + c0 + n * 4); const float v0a[4] = {v0v.x, v0v.y, v0v.z, v0v.w};
                    const float v4[4] = {bflo(vw[n * 2]), bfhi(vw[n * 2]), bflo(vw[n * 2 + 1]), bfhi(vw[n * 2 + 1])}, f4[4] = {bflo(fw[n * 2]), bfhi(fw[n * 2]), bflo(fw[n * 2 + 1]), bfhi(fw[n * 2 + 1])};
                    float o4[4];
#pragma unroll
                    for (int j = 0; j < 4; ++j) o4[j] = v4[j] + (f4[j] - v4[j]) * sigmoidf_(v0a[j] + acc[m][n][j]);
                    o[n * 2] = cvt_pk(o4[0], o4[1]); o[n * 2 + 1] = cvt_pk(o4[2], o4[3]);
                }
                *(uint4*)(vpb + off) = make_uint4(o[0], o[1], o[2], o[3]); *(uint4*)(vpb + off + 8) = make_uint4(o[4], o[5], o[6], o[7]);
            }
        }
    }
}
__device__ __forceinline__ void phase_rw3(PRef p, int jr, char* lds) {
    const int t = tidx(), lane = t & 63, wid = t >> 6, rowq = lane >> 4, jq = lane & 15;
    char* S = p.ws + OFF_SLOT;
    const float* decay = (const float*)S; const bf16_t* nkk = (const bf16_t*)(S + 2 * SLOT); const bf16_t* bb = (const bf16_t*)(S + 3 * SLOT);
    const bf16_t* rb = (const bf16_t*)(S + 6 * SLOT); const bf16_t* kb = (const bf16_t*)(S + 10 * SLOT);
    const bf16_t* vb = (const bf16_t*)(S + (jr == 0 ? 11 : 9) * SLOT); bf16_t* yb = (bf16_t*)(S + 5 * SLOT);
    float* buf = (float*)lds;
    float* ybuf = (float*)(lds + 2 * 16 * 336 * 4);
    for (int item = blockIdx.x; item < 512; item += gridDim.x) {
        const int bh = item >> 2, rg = item & 3, b = bh >> 4, h = bh & 15;
        const size_t base = (size_t)b * 2048 * 1024 + h * 64;
        const bf16_t* vecp[2]; int vdst[2];
#pragma unroll
        for (int u = 0; u < 2; ++u) {
            const int id = t + 256 * u, vec = id >> 7, rem = id & 127, step = rem >> 3, c8 = rem & 7;
            const bf16_t* bp = (vec == 0) ? nkk : (vec == 1) ? bb : (vec == 2) ? kb : rb;
            vecp[u] = bp + base + (size_t)step * 1024 + c8 * 8; vdst[u] = step * 336 + 64 + vec * 64 + c8 * 8;
        }
        const float* dp = decay + base + (size_t)(t >> 4) * 1024 + (t & 15) * 4; const int ddst = (t >> 4) * 336 + (t & 15) * 4;
        const bf16_t* vp = vb + base + (size_t)(t >> 1) * 1024 + rg * 16 + (t & 1) * 8; const int vvdst = (t >> 1) * 336 + 320 + (t & 1) * 8;
        uint4 g0, g1, gv; float4 gd;
        auto fetch = [&](int ch) {
            const size_t o = (size_t)ch * 16 * 1024;
            g0 = gload16(vecp[0] + o); g1 = gload16(vecp[1] + o);
            { const uint4 d_ = gload16(dp + o); gd = make_float4(__uint_as_float(d_.x), __uint_as_float(d_.y), __uint_as_float(d_.z), __uint_as_float(d_.w)); }
            if (t < 32) gv = gload16(vp + o);
        };
        auto stash = [&](float* bf) {
            float f[8];
            unpack8(g0, f); *(float4*)(bf + vdst[0]) = make_float4(f[0], f[1], f[2], f[3]); *(float4*)(bf + vdst[0] + 4) = make_float4(f[4], f[5], f[6], f[7]);
            unpack8(g1, f); *(float4*)(bf + vdst[1]) = make_float4(f[0], f[1], f[2], f[3]); *(float4*)(bf + vdst[1] + 4) = make_float4(f[4], f[5], f[6], f[7]);
            *(float4*)(bf + ddst) = gd;
            if (t < 32) { unpack8(gv, f); *(float4*)(bf + vvdst) = make_float4(f[0], f[1], f[2], f[3]); *(float4*)(bf + vvdst + 4) = make_float4(f[4], f[5], f[6], f[7]); }
        };
        float s0 = 0.f, s1 = 0.f, s2 = 0.f, s3 = 0.f;
        __syncthreads();
        fetch(0); stash(buf); __syncthreads();
        for (int ch = 0; ch < 128; ++ch) {
            if (ch + 1 < 128) fetch(ch + 1);
            const float* bf = buf + (ch & 1) * (16 * 336); float* yb_ = ybuf + (ch & 1) * 256;
            float ykeep = 0.f;
            const float* q0 = bf + jq * 4; const float* v0p = bf + 320 + wid * 4 + rowq;
            float4 nw = *(const float4*)q0, na = *(const float4*)(q0 + 64), nb2 = *(const float4*)(q0 + 128), nk = *(const float4*)(q0 + 192), nr = *(const float4*)(q0 + 256);
            float nv = v0p[0];
#pragma unroll 4
            for (int s = 0; s < 16; ++s) {
                const float4 w = nw, a = na, bq = nb2, k = nk, r = nr; const float vv = nv;
                const float* q = q0 + (s + 1) * 336;
                nw = *(const float4*)q; na = *(const float4*)(q + 64); nb2 = *(const float4*)(q + 128); nk = *(const float4*)(q + 192); nr = *(const float4*)(q + 256);
                nv = v0p[(s + 1) * 336];
                __builtin_amdgcn_sched_barrier(0);
                float sa = s0 * a.x; sa = fmaf(s1, a.y, sa); sa = fmaf(s2, a.z, sa); sa = fmaf(s3, a.w, sa);
                sa = row16_sum(sa);
                s0 = fmaf(s0, w.x, fmaf(sa, bq.x, vv * k.x)); s1 = fmaf(s1, w.y, fmaf(sa, bq.y, vv * k.y));
                s2 = fmaf(s2, w.z, fmaf(sa, bq.z, vv * k.z)); s3 = fmaf(s3, w.w, fmaf(sa, bq.w, vv * k.w));
                float y = s0 * r.x; y = fmaf(s1, r.y, y); y = fmaf(s2, r.z, y); y = fmaf(s3, r.w, y);
                y = row16_sum(y);
                ykeep = (jq == s) ? y : ykeep;
            }
            yb_[jq * 16 + wid * 4 + rowq] = ykeep;
            if (ch + 1 < 128) stash(buf + ((ch + 1) & 1) * (16 * 336));
            __syncthreads();
            if (t < 32) { const int step = t >> 1, hf = t & 1; float f[8];
#pragma unroll
                for (int i = 0; i < 8; ++i) f[i] = yb_[step * 16 + hf * 8 + i];
                *(uint4*)(yb + base + (size_t)(ch * 16 + step) * 1024 + rg * 16 + hf * 8) = pack8(f); }
        }
    }
}
__device__ __forceinline__ uint2 lds_tr16(const char* p) {
    typedef short v4s_t __attribute__((ext_vector_type(4)));
    const v4s_t r = __builtin_amdgcn_ds_read_tr16_b64_v4i16((LAS v4s_t*)p);
    uint2 u; __builtin_memcpy(&u, &r, 8); return u;
}
__device__ __forceinline__ int sw64(int row, int col) { return row * 128 + ((((col >> 3) ^ (row & 7))) << 4) + (col & 7) * 2; }
__device__ __forceinline__ void phase_rw3c(PRef p, int jr, char* lds) {
    const int t = tidx(), lane = t & 63, w = t >> 6, fr = lane & 15, fq = lane >> 4;
    char* S = p.ws + OFF_SLOT;
    const float* decay = (const float*)S; const bf16_t* nkk = (const bf16_t*)(S + 2 * SLOT); const bf16_t* bb = (const bf16_t*)(S + 3 * SLOT);
    const bf16_t* rb = (const bf16_t*)(S + 6 * SLOT); const bf16_t* kb = (const bf16_t*)(S + 10 * SLOT);
    const bf16_t* vb = (const bf16_t*)(S + (jr == 0 ? 11 : 9) * SLOT); bf16_t* yb = (bf16_t*)(S + 5 * SLOT);
    char* const AT = lds;              char* const RT = lds + 4096;  char* const BT = lds + 8192;  char* const KT = lds + 12288;
    float* const PL = (float*)(lds + 16384);
    float* const GAB = (float*)(lds + 43264);
    char* const GAK = lds + 28672;     char* const GRB = lds + 30720; char* const GRK = lds + 32768;
    char* const VT = lds + 34816;      char* const UT = lds + 35840;
    char* const SB = lds + 36864;
    float* const XL = (float*)(lds + 38912);
    float* const PC = (float*)(lds + 40960);
    float* const GS = (float*)(lds + 41216);
    bf16_t* const YB = (bf16_t*)(lds + 42240);
    const int pj = t & 63, ptg = t >> 6;
    const int tk = t >> 3, ck = t & 7;
    const int vtau = t >> 3, vi2 = (t & 7) * 2;
    const int qq = fr >> 2, pp = fr & 3;
    for (int item = blockIdx.x; item < 512; item += gridDim.x) {
        const int bh = ((item >> 3) >> 2) * 8 + (item & 7), rg = (item >> 3) & 3, b = bh >> 4, h = bh & 15;
        const size_t base = (size_t)b * 2048 * 1024 + h * 64;
        __syncthreads();
        for (int i = t; i < 128; i += 256) *(uint4*)(SB + i * 16) = make_uint4(0u, 0u, 0u, 0u);
        f32x4 Sacc = (f32x4){0.f, 0.f, 0.f, 0.f};
        float gw[8]; uint4 ra, rb4, rk, rr, rw0, rw1; unsigned gvv = 0;
        auto fetch = [&](int c) {
#pragma unroll
            for (int s2 = 0; s2 < 8; ++s2) gw[s2] = *(const __attribute__((address_space(1))) float*)(decay + base + (size_t)(c * 32 + ptg * 8 + s2) * 1024 + pj);
            const size_t o = base + (size_t)(c * 32 + tk) * 1024 + ck * 8;
            ra = gload16(nkk + o); rb4 = gload16(bb + o); rk = gload16(kb + o); rr = gload16(rb + o); rw0 = gload16(decay + o); rw1 = gload16(decay + o + 4);
            gvv = *(const __attribute__((address_space(1))) unsigned*)(vb + base + (size_t)(c * 32 + vtau) * 1024 + rg * 16 + vi2);
        };
        fetch(0);
        for (int c = 0; c < 64; ++c) {
            {
                float cum[8]; float run = 1.f;
#pragma unroll
                for (int s2 = 0; s2 < 8; ++s2) { run *= gw[s2]; cum[s2] = run; }
                GS[ptg * 64 + pj] = run;
                __syncthreads();
                const float g0 = GS[pj], g1 = GS[64 + pj], g2 = GS[128 + pj], g3 = GS[192 + pj];
                const float off = (ptg > 0 ? g0 : 1.f) * (ptg > 1 ? g1 : 1.f) * (ptg > 2 ? g2 : 1.f);
                if (ptg == 0) PC[pj] = (g0 * g1) * (g2 * g3);
#pragma unroll
                for (int s2 = 0; s2 < 8; ++s2) PL[(ptg * 8 + s2) * 64 + pj] = off * cum[s2];
            }
            __syncthreads();
            {
                const float4 p0 = *(const float4*)(PL + tk * 64 + ck * 8), p1 = *(const float4*)(PL + tk * 64 + ck * 8 + 4);
                const unsigned ua[4] = {ra.x, ra.y, ra.z, ra.w}, ub[4] = {rb4.x, rb4.y, rb4.z, rb4.w}, uk[4] = {rk.x, rk.y, rk.z, rk.w}, ur[4] = {rr.x, rr.y, rr.z, rr.w};
                const f32x2_t Pp[4] = {{p0.x, p0.y}, {p0.z, p0.w}, {p1.x, p1.y}, {p1.z, p1.w}};
                const f32x2_t Wp[4] = {{__uint_as_float(rw0.x), __uint_as_float(rw0.y)}, {__uint_as_float(rw0.z), __uint_as_float(rw0.w)}, {__uint_as_float(rw1.x), __uint_as_float(rw1.y)}, {__uint_as_float(rw1.z), __uint_as_float(rw1.w)}};
                unsigned oa[4], orr[4], ob[4], ok[4];
#pragma unroll
                for (int i = 0; i < 4; ++i) {
                    const f32x2_t ei = {__builtin_amdgcn_rcpf(Pp[i].x), __builtin_amdgcn_rcpf(Pp[i].y)};
                    const f32x2_t rw = {__builtin_amdgcn_rcpf(Wp[i].x), __builtin_amdgcn_rcpf(Wp[i].y)};
                    const f32x2_t ex = Pp[i] * rw;
                    const f32x2_t va = {__uint_as_float(ua[i] << 16), __uint_as_float(ua[i] & 0xffff0000u)}, vr = {__uint_as_float(ur[i] << 16), __uint_as_float(ur[i] & 0xffff0000u)};
                    const f32x2_t vb2 = {__uint_as_float(ub[i] << 16), __uint_as_float(ub[i] & 0xffff0000u)}, vk = {__uint_as_float(uk[i] << 16), __uint_as_float(uk[i] & 0xffff0000u)};
                    const f32x2_t xa = va * ex, xr = vr * Pp[i], xb = vb2 * ei, xk = vk * ei;
                    oa[i] = cvt_pk(xa.x, xa.y); orr[i] = cvt_pk(xr.x, xr.y); ob[i] = cvt_pk(xb.x, xb.y); ok[i] = cvt_pk(xk.x, xk.y);
                }
                const int o = tk * 128 + ((ck ^ (tk & 7)) << 4);
                *(uint4*)(AT + o) = make_uint4(oa[0], oa[1], oa[2], oa[3]); *(uint4*)(RT + o) = make_uint4(orr[0], orr[1], orr[2], orr[3]);
                *(uint4*)(BT + o) = make_uint4(ob[0], ob[1], ob[2], ob[3]); *(uint4*)(KT + o) = make_uint4(ok[0], ok[1], ok[2], ok[3]);
                *(bf16_t*)(VT + vi2 * 64 + vtau * 2) = (bf16_t)(gvv & 0xffffu);
                *(bf16_t*)(VT + (vi2 + 1) * 64 + vtau * 2) = (bf16_t)(gvv >> 16);
            }
            if (c + 1 < 64) fetch(c + 1);
            __syncthreads();
            {
                const char* Mt = (w < 2) ? AT : RT; const char* Nt = (w & 1) ? BT : KT;
                f32x4 g[2][2];
#pragma unroll
                for (int m = 0; m < 2; ++m) { g[m][0] = (f32x4){0.f, 0.f, 0.f, 0.f}; g[m][1] = (f32x4){0.f, 0.f, 0.f, 0.f}; }
#pragma unroll
                for (int ks = 0; ks < 2; ++ks) {
                    const int chs = ((ks * 4 + fq) ^ (fr & 7)) << 4;
                    uint4 mf[2], nf[2];
#pragma unroll
                    for (int m = 0; m < 2; ++m) { mf[m] = *(const uint4*)(Mt + (m * 16 + fr) * 128 + chs); nf[m] = *(const uint4*)(Nt + (m * 16 + fr) * 128 + chs); }
#pragma unroll
                    for (int m = 0; m < 2; ++m)
#pragma unroll
                        for (int n = 0; n < 2; ++n) g[m][n] = mfma16(nf[n], mf[m], g[m][n]);
                }
#pragma unroll
                for (int m = 0; m < 2; ++m)
#pragma unroll
                    for (int n = 0; n < 2; ++n) {
                        const int tt = m * 16 + fr, tau0 = n * 16 + fq * 4;
                        f32x4 v4;
#pragma unroll
                        for (int j = 0; j < 4; ++j) { const int tau = tau0 + j; const bool keep = (w < 2) ? (tau < tt) : (tau <= tt); v4[j] = keep ? g[m][n][j] : 0.f; }
                        if (w == 1) *(f32x4*)(GAB + tt * 36 + tau0) = v4;
                        else {
                            char* G = (w == 0) ? GAK : (w == 2) ? GRK : GRB;
                            uint2 o; o.x = cvt_pk(v4[0], v4[1]); o.y = cvt_pk(v4[2], v4[3]);
                            *(uint2*)(G + tt * 64 + tau0 * 2) = o;
                        }
                    }
            }
            __syncthreads();
            if (w < 2) {
                f32x4 x = (f32x4){0.f, 0.f, 0.f, 0.f};
#pragma unroll
                for (int ks = 0; ks < 2; ++ks) {
                    const int chs = ((ks * 4 + fq) ^ (fr & 7)) << 4;
                    x = mfma16(*(const uint4*)(AT + (w * 16 + fr) * 128 + chs), *(const uint4*)(SB + fr * 128 + chs), x);
                }
                x = mfma16(*(const uint4*)(GAK + (w * 16 + fr) * 64 + fq * 16), *(const uint4*)(VT + fr * 64 + fq * 16), x);
                *(f32x4*)(XL + fr * 32 + w * 16 + fq * 4) = x;
            }
            __syncthreads();
            {
                const int tl = lane & 31;
                float Gr[32];
#pragma unroll
                for (int q4 = 0; q4 < 8; ++q4) { const float4 g4 = *(const float4*)(GAB + tl * 36 + q4 * 4); Gr[q4 * 4] = g4.x; Gr[q4 * 4 + 1] = g4.y; Gr[q4 * 4 + 2] = g4.z; Gr[q4 * 4 + 3] = g4.w; }
                float acc[4];
#pragma unroll
                for (int r = 0; r < 4; ++r) acc[r] = XL[(4 * w + r) * 32 + tl];
#pragma unroll
                for (int tau = 0; tau < 31; ++tau)
#pragma unroll
                    for (int r = 0; r < 4; ++r) acc[r] = fmaf(__int_as_float(__builtin_amdgcn_readlane(__float_as_int(acc[r]), tau)), Gr[tau], acc[r]);
                if (lane < 32) {
#pragma unroll
                    for (int r = 0; r < 4; ++r) *(bf16_t*)(UT + (4 * w + r) * 64 + tl * 2) = f2bf(acc[r]);
                }
            }
            __syncthreads();
            if (w < 2) {
                f32x4 y = (f32x4){0.f, 0.f, 0.f, 0.f};
#pragma unroll
                for (int ks = 0; ks < 2; ++ks) {
                    const int chs = ((ks * 4 + fq) ^ (fr & 7)) << 4;
                    y = mfma16(*(const uint4*)(RT + (w * 16 + fr) * 128 + chs), *(const uint4*)(SB + fr * 128 + chs), y);
                }
                y = mfma16(*(const uint4*)(GRB + (w * 16 + fr) * 64 + fq * 16), *(const uint4*)(UT + fr * 64 + fq * 16), y);
                y = mfma16(*(const uint4*)(GRK + (w * 16 + fr) * 64 + fq * 16), *(const uint4*)(VT + fr * 64 + fq * 16), y);
#pragma unroll
                for (int j = 0; j < 4; ++j) YB[(w * 16 + fq * 4 + j) * 16 + fr] = f2bf(y[j]);
            }
            {
                const int r0 = fq * 8 + qq, kc = 2 * w + (pp >> 1);
                const int o0 = r0 * 128 + ((kc ^ (r0 & 7)) << 4) + (pp & 1) * 8, o1 = (r0 + 4) * 128 + ((kc ^ ((r0 + 4) & 7)) << 4) + (pp & 1) * 8;
                const uint2 blo = lds_tr16(BT + o0), bhi = lds_tr16(BT + o1), klo = lds_tr16(KT + o0), khi = lds_tr16(KT + o1);
                Sacc = mfma16(make_uint4(blo.x, blo.y, bhi.x, bhi.y), *(const uint4*)(UT + fr * 64 + fq * 16), Sacc);
                Sacc = mfma16(make_uint4(klo.x, klo.y, khi.x, khi.y), *(const uint4*)(VT + fr * 64 + fq * 16), Sacc);
                const float4 pc = *(const float4*)(PC + 16 * w + fq * 4);
                Sacc[0] *= pc.x; Sacc[1] *= pc.y; Sacc[2] *= pc.z; Sacc[3] *= pc.w;
            }
            __syncthreads();
            {
                uint2 o; o.x = cvt_pk(Sacc[0], Sacc[1]); o.y = cvt_pk(Sacc[2], Sacc[3]);
                *(uint2*)(SB + fr * 128 + ((((2 * w + (fq >> 1))) ^ (fr & 7)) << 4) + (fq & 1) * 8) = o;
                if (t < 64) {
                    const int tt = t >> 1, hf = t & 1;
                    const uint4 yv_ = *(const uint4*)((const char*)YB + tt * 32 + hf * 16); const u32x4_t yx_ = {yv_.x, yv_.y, yv_.z, yv_.w};
                    *(__attribute__((address_space(1))) u32x4_t*)(yb + base + (size_t)(c * 32 + tt) * 1024 + rg * 16 + hf * 8) = yx_;
                }
            }
        }
    }
}
struct LdRw4 {
    struct Raw { uint4 y, v, g; float bn; };
    const bf16_t *y, *v, *g; const float *bonus, *gng, *gnb;
    __device__ __forceinline__ Raw fetch(int, int r, int kc) const {
        Raw q; const size_t o = (size_t)r * 1024 + kc * 8;
        q.y = *(const uint4*)(y + o); q.v = *(const uint4*)(v + o); q.g = *(const uint4*)(g + o); q.bn = bonus[r * 16 + (kc >> 3)]; return q;
    }
    __device__ __forceinline__ uint4 finish(const Raw& q, int, int, int kc) const {
        float yf[8], vf[8], gf[8]; unpack8(q.y, yf); unpack8(q.v, vf); unpack8(q.g, gf);
        float s = 0.f, s2 = 0.f;
#pragma unroll
        for (int i = 0; i < 8; ++i) { s += yf[i]; s2 += yf[i] * yf[i]; }
        s = oct_sum(s); s2 = oct_sum(s2);
        const float mean = s * (1.0f / 64.0f), var = fmaxf(s2 * (1.0f / 64.0f) - mean * mean, 0.f), rstd = rsqrtf(var + 64e-5f);
        const float4 ga = *(const float4*)(gng + kc * 8), gb = *(const float4*)(gng + kc * 8 + 4), ba = *(const float4*)(gnb + kc * 8), bb = *(const float4*)(gnb + kc * 8 + 4);
        const float gg[8] = {ga.x, ga.y, ga.z, ga.w, gb.x, gb.y, gb.z, gb.w}, bq[8] = {ba.x, ba.y, ba.z, ba.w, bb.x, bb.y, bb.z, bb.w};
        float o[8];
#pragma unroll
        for (int i = 0; i < 8; ++i) o[i] = ((yf[i] - mean) * rstd * gg[i] + bq[i] + q.bn * vf[i]) * gf[i];
        return pack8(o);
    }
};
__device__ __forceinline__ void phase_rw4(PRef p, int jr, char* lds) {
    char* S = p.ws + OFF_SLOT;
    const bf16_t* yb = (const bf16_t*)(S + 5 * SLOT); const bf16_t* gb = (const bf16_t*)(S + 4 * SLOT);
    const bf16_t* vb = (const bf16_t*)(S + (jr == 0 ? 11 : 9) * SLOT); bf16_t* ymix = (bf16_t*)(S + 6 * SLOT);
    const bf16_t* wt = (const bf16_t*)(p.ws + W_OUT) + (size_t)jr * 1024 * 1024;
    const float* bonus = (const float*)(p.ws + OFF_BONUS);
    const int t_ = tidx(); const int lane = t_ & 63, wid = t_ >> 6, wr = wid >> 1, wc = wid & 1, fr = lane & 15, fq = lane >> 4;
    for (int id = blockIdx.x; id < 128 * 8; id += gridDim.x) {
        int mt, nt; tile_map(id, 8, mt, nt);
        const size_t ro = (size_t)mt * 128 * 1024;
        LdRw4 al{yb + ro, vb + ro, gb + ro, bonus + (size_t)mt * 128 * 16, p.in[22] + jr * 1024, p.in[23] + jr * 1024};
        const bf16_t* br[4];
        { const int t2_ = tidx(), r0_ = t2_ >> 3, co_ = glds_chunk(t2_) * 8;
#pragma unroll
          for (int i = 0; i < 4; ++i) br[i] = wt + (size_t)(nt * 128 + r0_ + 32 * i) * 1024 + co_; }
        f32x4 acc[4][4];
        gemm_rg(lds, 16, al, br, acc);
#pragma unroll
        for (int n = 0; n < 4; ++n)
#pragma unroll
            for (int m = 0; m < 4; ++m) {
                uint2 o; o.x = cvt_pk(acc[m][n][0], acc[m][n][1]); o.y = cvt_pk(acc[m][n][2], acc[m][n][3]);
                *(uint2*)(ymix + (size_t)(mt * 128 + wr * 64 + m * 16 + fr) * 1024 + nt * 128 + wc * 64 + n * 16 + fq * 4) = o;
            }
    }
}

__device__ __forceinline__ void phase_cml(PRef p) {
    const int t = tidx();
    char* S = p.ws + OFF_SLOT;
    const bf16_t* src = (const bf16_t*)(S + 1 * SLOT); bf16_t* dst = (bf16_t*)(S + 8 * SLOT);
    const int col = (t & 127) * 8, half = t >> 7;
    float cw[4][8], cb[8];
#pragma unroll
    for (int j = 0; j < 4; ++j) {
        const float4 a = *(const float4*)(p.in[27] + j * 1024 + col), b = *(const float4*)(p.in[27] + j * 1024 + col + 4);
        cw[j][0] = a.x; cw[j][1] = a.y; cw[j][2] = a.z; cw[j][3] = a.w; cw[j][4] = b.x; cw[j][5] = b.y; cw[j][6] = b.z; cw[j][7] = b.w;
    }
    { const float4 a = *(const float4*)(p.in[28] + col), b = *(const float4*)(p.in[28] + col + 4);
      cb[0] = a.x; cb[1] = a.y; cb[2] = a.z; cb[3] = a.w; cb[4] = b.x; cb[5] = b.y; cb[6] = b.z; cb[7] = b.w; }
    const float qs = (col < 512) ? 0.125f : 1.0f;
    for (int item = blockIdx.x; item < 1024; item += gridDim.x) {
        const int b = item >> 7, s0 = (item & 127) * 16 + half * 8;
        const bf16_t* base = src + (size_t)b * 2048 * 1024 + col;
        uint4 r[11];
#pragma unroll
        for (int i = 0; i < 11; ++i) { const int sr = s0 - 3 + i; r[i] = gload16(base + (size_t)max(sr, 0) * 1024); if (sr < 0) r[i] = make_uint4(0u, 0u, 0u, 0u); }
        float x0[8], x1[8], x2[8];
        unpack8(r[0], x0); unpack8(r[1], x1); unpack8(r[2], x2);
#pragma unroll
        for (int i = 0; i < 8; ++i) {
            float x3[8], a[8]; unpack8(r[i + 3], x3);
#pragma unroll
            for (int e = 0; e < 8; ++e) { a[e] = cb[e] + cw[0][e] * x0[e] + cw[1][e] * x1[e] + cw[2][e] * x2[e] + cw[3][e] * x3[e]; a[e] = siluf_(a[e]) * qs; }
            *(uint4*)(dst + ((size_t)b * 2048 + s0 + i) * 1024 + col) = pack8(a);
#pragma unroll
            for (int e = 0; e < 8; ++e) { x0[e] = x1[e]; x1[e] = x2[e]; x2[e] = x3[e]; }
        }
    }
}
__device__ __forceinline__ void phase_ml2(PRef p, char* lds) {
    const int t = tidx(), lane = t & 63, w = t >> 6, fr = lane & 15, fq = lane >> 4;
    char* S = p.ws + OFF_SLOT;
    const bf16_t* qk = (const bf16_t*)(S + 8 * SLOT); const bf16_t* vb = (const bf16_t*)(S + 2 * SLOT); bf16_t* yb = (bf16_t*)(S + 4 * SLOT);
    const float* gates = (const float*)(p.ws + OFF_GATES); float* stat = (float*)(p.ws + OFF_STAT);
    char* const RAW = lds;
    char* const QT = lds + 17408; char* const KT = lds + 25600;
    char* const VT = lds + 33792;
    char* const VX = lds + 35840;
    char* const PB = lds + 39936;
    char* const CT = lds + 48128;
    float* const FS = (float*)(lds + 52224); float* const GJ = FS + 64; float* const WJ = FS + 128;
    float* const CW = (float*)(lds + 53248);
    const int qq = fr >> 2, pp = fr & 3;
    for (int item = blockIdx.x; item < 512; item += gridDim.x) {
        const int bh = ((item >> 3) >> 3) * 8 + (item & 7), vs = (item >> 3) & 7, b = bh >> 3, hd = bh & 7;
        const size_t tok0 = (size_t)b * 2048;
        __syncthreads();
        for (int i = t; i < 256; i += 256) *(uint4*)(CT + i * 16) = make_uint4(0u, 0u, 0u, 0u);
        f32x4 Cacc[2] = {(f32x4){0.f, 0.f, 0.f, 0.f}, (f32x4){0.f, 0.f, 0.f, 0.f}};
        uint4 gr0, gr1, gr2, gr3; uint4 gv = make_uint4(0u, 0u, 0u, 0u); float gg = 0.f;
        const int frr = t >> 4, fc = t & 15;
        const bf16_t* const qkt = qk + (tok0 + frr) * 1024 + (fc >> 3) * 512 + hd * 64 + (fc & 7) * 8;
        char* const qkd = ((fc < 8) ? QT : KT) + frr * 128 + (((fc & 7) ^ (frr & 7)) << 4);
        auto fetch = [&](int ch) {
            const int s0 = ch * 64;
            const bf16_t* q0 = qkt + (size_t)s0 * 1024;
            gr0 = gload16(q0); gr1 = gload16(q0 + 16 * 1024); gr2 = gload16(q0 + 32 * 1024); gr3 = gload16(q0 + 48 * 1024);
            if (t < 128) { gv = gload16(vb + (tok0 + s0 + (t >> 1)) * 1024 + hd * 128 + vs * 16 + (t & 1) * 8);
                           gg = *(const __attribute__((address_space(1))) float*)(gates + (tok0 + s0 + (t & 63)) * 16 + (t >> 6) * 8 + hd); }
        };
        fetch(0);
        for (int ch = 0; ch < 32; ++ch) {
            const int s0 = ch * 64;
            *(uint4*)qkd = gr0; *(uint4*)(qkd + 16 * 128) = gr1; *(uint4*)(qkd + 32 * 128) = gr2; *(uint4*)(qkd + 48 * 128) = gr3;
            if (t < 128) *(uint4*)(VT + t * 16) = gv;
            float vf8[8]; unpack8(gv, vf8);
            if (t >= 64 && t < 128) GJ[t - 64] = gg;
            const float ggc = gg;
            if (ch + 1 < 32) fetch(ch + 1);
            __syncthreads();
            if (t < 64) {
                float f = GJ[t];
                f += __builtin_amdgcn_update_dpp(0.f, f, 0x111, 0xf, 0xf, false);
                f += __builtin_amdgcn_update_dpp(0.f, f, 0x112, 0xf, 0xf, false);
                f += __builtin_amdgcn_update_dpp(0.f, f, 0x114, 0xf, 0xf, false);
                f += __builtin_amdgcn_update_dpp(0.f, f, 0x118, 0xf, 0xf, false);
                f += __builtin_amdgcn_update_dpp(0.f, f, 0x142, 0xa, 0xf, false);
                f += __builtin_amdgcn_update_dpp(0.f, f, 0x143, 0xc, 0xf, false);
                const float fend = __int_as_float(__builtin_amdgcn_readlane(__float_as_int(f), 63));
                FS[t] = f; WJ[t] = __expf(fend - f + ggc);
                GJ[t] = ggc - f;
            }
            __syncthreads();
            const float efend = __expf(FS[63]);
            {
                if (t < 128) {
                    const int j = t >> 1; const float wj = WJ[j];
                    float f[8];
#pragma unroll
                    for (int i = 0; i < 8; ++i) f[i] = vf8[i] * wj;
                    *(uint4*)(VX + j * 64 + (t & 1) * 16) = pack8(f);
                    float g8[8] = {0.f, 0.f, 0.f, 0.f, 0.f, 0.f, 0.f, 0.f}; if ((t & 1) == 0) g8[0] = wj;
                    *(uint4*)(VX + j * 64 + 32 + (t & 1) * 16) = pack8(g8);
                }
            }
            __syncthreads();
            const int srow = 16 * w + fr;
            f32x4 Sacc[4], Xacc[2];
#pragma unroll
            for (int n = 0; n < 4; ++n) Sacc[n] = (f32x4){0.f, 0.f, 0.f, 0.f};
            Xacc[0] = (f32x4){0.f, 0.f, 0.f, 0.f}; Xacc[1] = (f32x4){0.f, 0.f, 0.f, 0.f};
            Cacc[0] *= efend; Cacc[1] *= efend;
#pragma unroll
            for (int ks = 0; ks < 2; ++ks) {
                const int chs = ((ks * 4 + fq) ^ (fr & 7)) << 4;
                const uint4 qf = *(const uint4*)(QT + srow * 128 + chs);
#pragma unroll
                for (int n = 0; n < 4; ++n) { const uint4 kf = *(const uint4*)(KT + (n * 16 + fr) * 128 + chs); Sacc[n] = mfma16(kf, qf, Sacc[n]); }
#pragma unroll
                for (int nn = 0; nn < 2; ++nn) { const uint4 rf = *(const uint4*)(CT + (nn * 16 + fr) * 128 + chs); Xacc[nn] = mfma16(rf, qf, Xacc[nn]); }
                const int r0 = ks * 32 + fq * 8 + qq, kc = 2 * w + (pp >> 1);
                const uint2 klo = lds_tr16(KT + r0 * 128 + ((kc ^ (r0 & 7)) << 4) + (pp & 1) * 8);
                const uint2 khi = lds_tr16(KT + (r0 + 4) * 128 + ((kc ^ ((r0 + 4) & 7)) << 4) + (pp & 1) * 8);
                const uint4 kt = make_uint4(klo.x, klo.y, khi.x, khi.y);
#pragma unroll
                for (int m = 0; m < 2; ++m) {
                    const uint2 vlo = lds_tr16(VX + r0 * 64 + (16 * m + 4 * pp) * 2), vhi = lds_tr16(VX + (r0 + 4) * 64 + (16 * m + 4 * pp) * 2);
                    Cacc[m] = mfma16(kt, make_uint4(vlo.x, vlo.y, vhi.x, vhi.y), Cacc[m]);
                }
            }
            const float fs = FS[srow];
            float dsum = 0.f;
#pragma unroll
            for (int n = 0; n < 4; ++n) {
                const float4 g4 = *(const float4*)(GJ + n * 16 + fq * 4); const float ga[4] = {g4.x, g4.y, g4.z, g4.w};
                float pv[4];
#pragma unroll
                for (int j = 0; j < 4; ++j) { const int jc = n * 16 + fq * 4 + j; pv[j] = (srow >= jc) ? Sacc[n][j] * __expf(fs + ga[j]) : 0.f; dsum += pv[j]; }
                uint2 o; o.x = cvt_pk(pv[0], pv[1]); o.y = cvt_pk(pv[2], pv[3]);
                *(uint2*)(PB + srow * 128 + (((n * 2 + (fq >> 1)) ^ (fr & 7)) << 4) + (fq & 1) * 8) = o;
            }
            dsum = xor16_add(dsum); dsum = xor32_add(dsum);
            f32x4 Iacc = (f32x4){0.f, 0.f, 0.f, 0.f};
#pragma unroll
            for (int ks = 0; ks < 2; ++ks) {
                const uint4 pf = *(const uint4*)(PB + srow * 128 + (((ks * 4 + fq) ^ (fr & 7)) << 4));
                const int r0 = ks * 32 + fq * 8 + qq;
                const uint2 vlo = lds_tr16(VT + r0 * 32 + (4 * pp) * 2), vhi = lds_tr16(VT + (r0 + 4) * 32 + (4 * pp) * 2);
                Iacc = mfma16(make_uint4(vlo.x, vlo.y, vhi.x, vhi.y), pf, Iacc);
            }
            const float efs = __expf(fs);
            const float ndq = __shfl(Xacc[1][0], fr);
            const float den = dsum + efs * ndq;
            const float rden = 1.0f / fmaxf(fabsf(den), 1.0f);
            const size_t tok = tok0 + s0 + srow;
            float o4[4], ssum = 0.f, ssq = 0.f;
#pragma unroll
            for (int j = 0; j < 4; ++j) { o4[j] = (Iacc[j] + efs * Xacc[0][j]) * rden; ssum += o4[j]; ssq += o4[j] * o4[j]; }
            gst_u2(yb + tok * 1024 + hd * 128 + vs * 16 + fq * 4, cvt_pk(o4[0], o4[1]), cvt_pk(o4[2], o4[3]));
            ssum = xor16_add(ssum); ssum = xor32_add(ssum); ssq = xor16_add(ssq); ssq = xor32_add(ssq);
            if (fq == 0) gst_u2(stat + ((tok * 8 + hd) * 8 + vs) * 2, __float_as_uint(ssum), __float_as_uint(ssq));
            __syncthreads();
#pragma unroll
            for (int m = 0; m < 2; ++m) {
                const int v = m * 16 + fr;
                uint2 o; o.x = cvt_pk(Cacc[m][0], Cacc[m][1]); o.y = cvt_pk(Cacc[m][2], Cacc[m][3]);
                *(uint2*)(CT + v * 128 + (((2 * w + (fq >> 1)) ^ (v & 7)) << 4) + (fq & 1) * 8) = o;
            }
        }
    }
}
template <int HSHIFT  , int NH>
struct LdGnGate {
    struct Raw { uint4 y, g; };
    const bf16_t *y, *g; int ld; const float *gng, *gnb; const float* st;
    __device__ __forceinline__ Raw fetch(int, int r, int kc) const { Raw q; const size_t o = (size_t)r * ld + kc * 8; q.y = *(const uint4*)(y + o); q.g = *(const uint4*)(g + o); return q; }
    __device__ __forceinline__ uint4 finish(const Raw& q, int, int r, int kc) const {
        float yf[8], gf[8]; unpack8(q.y, yf); unpack8(q.g, gf);
        const float2 ms = *(const float2*)(st + (r * NH + ((kc * 8) >> HSHIFT)) * 2);
        const float4 ga = *(const float4*)(gng + kc * 8), gb = *(const float4*)(gng + kc * 8 + 4), ba = *(const float4*)(gnb + kc * 8), bb = *(const float4*)(gnb + kc * 8 + 4);
        const float gg[8] = {ga.x, ga.y, ga.z, ga.w, gb.x, gb.y, gb.z, gb.w}, bq[8] = {ba.x, ba.y, ba.z, ba.w, bb.x, bb.y, bb.z, bb.w};
        float o[8];
#pragma unroll
        for (int i = 0; i < 8; ++i) o[i] = ((yf[i] - ms.x) * ms.y * gg[i] + bq[i]) * gf[i];
        return pack8(o);
    }
};
template <int HSHIFT, int NH, int NPART>
__device__ __forceinline__ void phase_outproj_gn(PRef p, char* lds, const bf16_t* yb, const bf16_t* gate, int K, const bf16_t* wt, const float* gng, const float* gnb, bf16_t* ymix) {
    const int t = tidx(), lane = t & 63, wid = t >> 6, wr = wid >> 1, wc = wid & 1, fr = lane & 15, fq = lane >> 4;
    const float* stat = (const float*)(p.ws + OFF_STAT);
    float* st = (float*)(lds + 65536);
    const float invn = 1.0f / (float)(1 << HSHIFT);
    for (int id = blockIdx.x; id < 128 * 8; id += gridDim.x) {
        int mt, nt; tile_map(id, 8, mt, nt);
        for (int i = t; i < 128 * NH; i += 256) {
            const float* q = stat + ((size_t)mt * 128 * NH + i) * NPART * 2;
            float s = 0.f, s2 = 0.f;
#pragma unroll
            for (int j = 0; j < NPART; ++j) { const float2 v = *(const float2*)(q + j * 2); s += v.x; s2 += v.y; }
            const float mean = s * invn, var = fmaxf(s2 * invn - mean * mean, 0.f);
            st[i * 2] = mean; st[i * 2 + 1] = rsqrtf(var + 1e-6f);
        }
        __syncthreads();
        const size_t ro = (size_t)mt * 128 * K;
        LdGnGate<HSHIFT, NH> al{yb + ro, gate + ro, K, gng, gnb, st};
        const bf16_t* br[4];
        { const int r0_ = t >> 3, co_ = glds_chunk(t) * 8;
#pragma unroll
          for (int i = 0; i < 4; ++i) br[i] = wt + (size_t)(nt * 128 + r0_ + 32 * i) * K + co_; }
        f32x4 acc[4][4];
        gemm_rg(lds, K / 64, al, br, acc);
#pragma unroll
        for (int n = 0; n < 4; ++n)
#pragma unroll
            for (int m = 0; m < 4; ++m) {
                uint2 o; o.x = cvt_pk(acc[m][n][0], acc[m][n][1]); o.y = cvt_pk(acc[m][n][2], acc[m][n][3]);
                *(uint2*)(ymix + (size_t)(mt * 128 + wr * 64 + m * 16 + fr) * 1024 + nt * 128 + wc * 64 + n * 16 + fq * 4) = o;
            }
    }
}

__device__ __forceinline__ void phase_rt2(PRef p, char* lds) {
    const int t = tidx(), lane = t & 63, w = t >> 6, fr = lane & 15, fq = lane >> 4;
    char* S = p.ws + OFF_SLOT;
    const bf16_t* qb = (const bf16_t*)(S + 1 * SLOT); const bf16_t* kb = (const bf16_t*)(S + 2 * SLOT); const bf16_t* vb = (const bf16_t*)(S + 3 * SLOT);
    bf16_t* yb = (bf16_t*)(S + 7 * SLOT); float* stat = (float*)(p.ws + OFF_STAT);
    char* const VB = lds + 32768; char* const PB = lds + 49152; char* const RT = lds + 57344;
    const int gco = glds_chunk(t) * 8, gr0 = t >> 3;
    const int qq = fr >> 2, pp = fr & 3;
    for (int item = blockIdx.x; item < 512; item += gridDim.x) {
        const int bh = ((item >> 3) >> 4) * 8 + (item & 7), vs = (item >> 3) & 15, b = bh >> 2, hd = bh & 3;
        const size_t tok0 = (size_t)b * 2048;
        const float lg2 = log2f(1.0f - __builtin_amdgcn_exp2f(-5.0f - (float)hd));
        const float dec64 = __builtin_amdgcn_exp2f(64.0f * lg2);
        const bf16_t* qsrc = qb + (tok0 + gr0) * 1024 + hd * 256 + gco;
        const bf16_t* ksrc = kb + (tok0 + gr0) * 1024 + hd * 256 + gco;
        const bf16_t* vsrc = vb + (tok0 + (t >> 2)) * 2048 + hd * 512 + vs * 32 + (t & 3) * 8;
        f32x4 Racc[4][2];
#pragma unroll
        for (int a = 0; a < 4; ++a) { Racc[a][0] = (f32x4){0.f, 0.f, 0.f, 0.f}; Racc[a][1] = (f32x4){0.f, 0.f, 0.f, 0.f}; }
        __syncthreads();
        for (int i = t; i < 1024; i += 256) *(uint4*)(RT + i * 16) = make_uint4(0u, 0u, 0u, 0u);
        auto issue = [&](int pc) {
            const unsigned d = (unsigned)__builtin_amdgcn_readfirstlane((int)(lds_addr_u(lds) + (pc & 1) * 16384 + w * 1024));
            const size_t go = (size_t)(pc >> 2) * 64 * 1024 + (pc & 3) * 64;
#pragma unroll
            for (int i = 0; i < 2; ++i) { glds16_asm(qsrc + go + (size_t)i * 32 * 1024, d + i * 4096); glds16_asm(ksrc + go + (size_t)i * 32 * 1024, d + 8192 + i * 4096); }
        };
        auto put_v = [&](const uint4& raw, int ch) {
            char* vbuf = VB + (ch & 1) * 8192; const int j = t >> 2;
            *(uint4*)(vbuf + j * 64 + (t & 3) * 16) = raw;
            float f[8]; unpack8(raw, f); const float sc = __builtin_amdgcn_exp2f(lg2 * (float)(63 - j));
#pragma unroll
            for (int i = 0; i < 8; ++i) f[i] *= sc;
            *(uint4*)(vbuf + 4096 + j * 64 + (t & 3) * 16) = pack8(f);
        };
        issue(0);
        { const uint4 v0 = gld_u4(vsrc); put_v(v0, 0); }
        asm volatile("s_waitcnt vmcnt(0)" ::: "memory");
        __syncthreads();
        f32x4 Sacc[4], Xacc[2];
        uint4 vnext = make_uint4(0u, 0u, 0u, 0u);
        for (int ch = 0; ch < 32; ++ch) {
            const char* vbuf = VB + (ch & 1) * 8192;
#pragma unroll
            for (int qd = 0; qd < 4; ++qd) {
                const int pc = ch * 4 + qd;
                if (pc + 1 < 128) issue(pc + 1);
                if (qd == 0) {
                    if (ch + 1 < 32) vnext = gld_u4(vsrc + (size_t)(ch + 1) * 64 * 2048);
#pragma unroll
                    for (int n = 0; n < 4; ++n) Sacc[n] = (f32x4){0.f, 0.f, 0.f, 0.f};
                    Xacc[0] = (f32x4){0.f, 0.f, 0.f, 0.f}; Xacc[1] = (f32x4){0.f, 0.f, 0.f, 0.f};
                }
                const char* qk = lds + (pc & 1) * 16384;
                Racc[qd][0] *= dec64; Racc[qd][1] *= dec64;
#pragma unroll
                for (int ks = 0; ks < 2; ++ks) {
                    const int chs = ((ks * 4 + fq) ^ (fr & 7)) << 4;
                    const uint4 qf = *(const uint4*)(qk + (16 * w + fr) * 128 + chs);
#pragma unroll
                    for (int n = 0; n < 4; ++n) { const uint4 kf = *(const uint4*)(qk + 8192 + (n * 16 + fr) * 128 + chs); Sacc[n] = mfma16(kf, qf, Sacc[n]); }
#pragma unroll
                    for (int nn = 0; nn < 2; ++nn) {
                        const int v = nn * 16 + fr;
                        const uint4 rf = *(const uint4*)(RT + v * 512 + (((qd * 8 + ks * 4 + fq) ^ (v & 7)) << 4));
                        Xacc[nn] = mfma16(rf, qf, Xacc[nn]);
                    }
                    const int r0 = ks * 32 + fq * 8 + qq;
                    const int kc = 2 * w + (pp >> 1);
                    const uint2 klo = lds_tr16(qk + 8192 + r0 * 128 + ((kc ^ (r0 & 7)) << 4) + (pp & 1) * 8);
                    const uint2 khi = lds_tr16(qk + 8192 + (r0 + 4) * 128 + ((kc ^ ((r0 + 4) & 7)) << 4) + (pp & 1) * 8);
                    const uint4 kt = make_uint4(klo.x, klo.y, khi.x, khi.y);
#pragma unroll
                    for (int m = 0; m < 2; ++m) {
                        const uint2 vlo = lds_tr16(vbuf + 4096 + r0 * 64 + (16 * m + 4 * pp) * 2), vhi = lds_tr16(vbuf + 4096 + (r0 + 4) * 64 + (16 * m + 4 * pp) * 2);
                        Racc[qd][m] = mfma16(kt, make_uint4(vlo.x, vlo.y, vhi.x, vhi.y), Racc[qd][m]);
                    }
                }
                if (qd == 2 && ch + 1 < 32) put_v(vnext, ch + 1);
                asm volatile("s_waitcnt vmcnt(0)" ::: "memory");
                __syncthreads();
#pragma unroll
                for (int m = 0; m < 2; ++m) {
                    const int v = m * 16 + fr, cch = qd * 8 + 2 * w + (fq >> 1);
                    uint2 o; o.x = cvt_pk(Racc[qd][m][0], Racc[qd][m][1]); o.y = cvt_pk(Racc[qd][m][2], Racc[qd][m][3]);
                    *(uint2*)(RT + v * 512 + ((cch ^ (v & 7)) << 4) + (fq & 1) * 8) = o;
                }
            }
            const int srow = 16 * w + fr;
#pragma unroll
            for (int n = 0; n < 4; ++n) {
                float pv[4];
#pragma unroll
                for (int j = 0; j < 4; ++j) { const int jc = n * 16 + fq * 4 + j; pv[j] = (srow >= jc) ? Sacc[n][j] * __builtin_amdgcn_exp2f(lg2 * (float)(srow - jc)) : 0.f; }
                uint2 o; o.x = cvt_pk(pv[0], pv[1]); o.y = cvt_pk(pv[2], pv[3]);
                *(uint2*)(PB + srow * 128 + (((n * 2 + (fq >> 1)) ^ (fr & 7)) << 4) + (fq & 1) * 8) = o;
            }
            f32x4 Iacc[2] = {(f32x4){0.f, 0.f, 0.f, 0.f}, (f32x4){0.f, 0.f, 0.f, 0.f}};
#pragma unroll
            for (int ks = 0; ks < 2; ++ks) {
                const uint4 pf = *(const uint4*)(PB + srow * 128 + (((ks * 4 + fq) ^ (fr & 7)) << 4));
                const int r0 = ks * 32 + fq * 8 + qq;
#pragma unroll
                for (int nn = 0; nn < 2; ++nn) {
                    const uint2 vlo = lds_tr16(vbuf + r0 * 64 + (16 * nn + 4 * pp) * 2), vhi = lds_tr16(vbuf + (r0 + 4) * 64 + (16 * nn + 4 * pp) * 2);
                    Iacc[nn] = mfma16(make_uint4(vlo.x, vlo.y, vhi.x, vhi.y), pf, Iacc[nn]);
                }
            }
            const float qdec = __builtin_amdgcn_exp2f(lg2 * (float)(srow + 1));
            const size_t tok = tok0 + (size_t)ch * 64 + srow;
            float ssum = 0.f, ssq = 0.f;
#pragma unroll
            for (int nn = 0; nn < 2; ++nn) {
                float o4[4];
#pragma unroll
                for (int j = 0; j < 4; ++j) { o4[j] = Iacc[nn][j] + Xacc[nn][j] * qdec; ssum += o4[j]; ssq += o4[j] * o4[j]; }
                gst_u2(yb + tok * 2048 + hd * 512 + vs * 32 + nn * 16 + fq * 4, cvt_pk(o4[0], o4[1]), cvt_pk(o4[2], o4[3]));
            }
            ssum = xor16_add(ssum); ssum = xor32_add(ssum); ssq = xor16_add(ssq); ssq = xor32_add(ssq);
            if (fq == 0) gst_u2(stat + ((tok * 4 + hd) * 16 + vs) * 2, __float_as_uint(ssum), __float_as_uint(ssq));
        }
        __syncthreads();
    }
}

__device__ __forceinline__ void phase_zrw(PRef p, int jr) {
    const int t_ = tidx(); const int lane = t_ & 63, gw = blockIdx.x * 4 + (t_ >> 6), nw = gridDim.x * 4;
    char* S = p.ws + OFF_SLOT;
    const bf16_t* yb = (const bf16_t*)(S + 5 * SLOT); const bf16_t* gb = (const bf16_t*)(S + 4 * SLOT);
    const bf16_t* vb = (const bf16_t*)(S + (jr == 0 ? 11 : 9) * SLOT); bf16_t* zb = (bf16_t*)(S + 7 * SLOT);
    const float* bonus = (const float*)(p.ws + OFF_BONUS);
    float gg[16], bq[16]; row_load_f32(p.in[22] + jr * 1024, gg, lane); row_load_f32(p.in[23] + jr * 1024, bq, lane);
    const int rpw = NTOK / nw, first = gw * rpw, end = first + rpw;
    uint2 ny[4], nv[4], ng[4]; float nbn[4];
    auto load_in = [&](int r) {
#pragma unroll
        for (int c = 0; c < 4; ++c) { const size_t o = (size_t)r * 1024 + c * 256 + lane * 4; ny[c] = *(const uint2*)(yb + o); nv[c] = *(const uint2*)(vb + o); ng[c] = *(const uint2*)(gb + o);
                                      nbn[c] = bonus[(size_t)r * 16 + c * 4 + (lane >> 4)]; }
    };
    load_in(first);
    for (int r = first; r < end; ++r) {
        float y[16], v[16], g[16], bn[4];
#pragma unroll
        for (int c = 0; c < 4; ++c) {
            y[c * 4] = bflo(ny[c].x); y[c * 4 + 1] = bfhi(ny[c].x); y[c * 4 + 2] = bflo(ny[c].y); y[c * 4 + 3] = bfhi(ny[c].y);
            v[c * 4] = bflo(nv[c].x); v[c * 4 + 1] = bfhi(nv[c].x); v[c * 4 + 2] = bflo(nv[c].y); v[c * 4 + 3] = bfhi(nv[c].y);
            g[c * 4] = bflo(ng[c].x); g[c * 4 + 1] = bfhi(ng[c].x); g[c * 4 + 2] = bflo(ng[c].y); g[c * 4 + 3] = bfhi(ng[c].y);
            bn[c] = nbn[c];
        }
        if (r + 1 < end) load_in(r + 1);
        __builtin_amdgcn_sched_barrier(0);
        float z[16];
#pragma unroll
        for (int c = 0; c < 4; ++c) {
            float s = (y[c * 4] + y[c * 4 + 1]) + (y[c * 4 + 2] + y[c * 4 + 3]);
            float q = (y[c * 4] * y[c * 4] + y[c * 4 + 1] * y[c * 4 + 1]) + (y[c * 4 + 2] * y[c * 4 + 2] + y[c * 4 + 3] * y[c * 4 + 3]);
            s = row16_sum(s); q = row16_sum(q);
            const float mean = s * (1.0f / 64.0f), rstd = rsqrtf(fmaxf(q * (1.0f / 64.0f) - mean * mean, 0.f) + 64e-5f);
#pragma unroll
            for (int i = 0; i < 4; ++i) { const int e = c * 4 + i; z[e] = ((y[e] - mean) * rstd * gg[e] + bq[e] + bn[c] * v[e]) * g[e]; }
        }
        row_store_bf16(zb + (size_t)r * 1024, z, lane);
    }
}
__device__ __forceinline__ void phase_zml(PRef p) {
    const int t_ = tidx(); const int lane = t_ & 63, gw = blockIdx.x * 4 + (t_ >> 6), nw = gridDim.x * 4;
    char* S = p.ws + OFF_SLOT;
    const bf16_t* yb = (const bf16_t*)(S + 4 * SLOT); const bf16_t* ob = (const bf16_t*)(S + 3 * SLOT); bf16_t* zb = (bf16_t*)(S + 1 * SLOT);
    float gg[16], bq[16]; row_load_f32(p.in[29], gg, lane); row_load_f32(p.in[30], bq, lane);
    const int rpw = NTOK / nw, first = gw * rpw, end = first + rpw;
    uint2 ny[4], no[4];
    auto load_in = [&](int r) {
#pragma unroll
        for (int c = 0; c < 4; ++c) { const size_t o = (size_t)r * 1024 + c * 256 + lane * 4; ny[c] = *(const uint2*)(yb + o); no[c] = *(const uint2*)(ob + o); }
    };
    load_in(first);
    for (int r = first; r < end; ++r) {
        float y[16], o[16], z[16];
#pragma unroll
        for (int c = 0; c < 4; ++c) {
            y[c * 4] = bflo(ny[c].x); y[c * 4 + 1] = bfhi(ny[c].x); y[c * 4 + 2] = bflo(ny[c].y); y[c * 4 + 3] = bfhi(ny[c].y);
            o[c * 4] = bflo(no[c].x); o[c * 4 + 1] = bfhi(no[c].x); o[c * 4 + 2] = bflo(no[c].y); o[c * 4 + 3] = bfhi(no[c].y);
        }
        if (r + 1 < end) load_in(r + 1);
        __builtin_amdgcn_sched_barrier(0);
#pragma unroll
        for (int c = 0; c < 4; ++c) {
            float s = (y[c * 4] + y[c * 4 + 1]) + (y[c * 4 + 2] + y[c * 4 + 3]);
            float q = (y[c * 4] * y[c * 4] + y[c * 4 + 1] * y[c * 4 + 1]) + (y[c * 4 + 2] * y[c * 4 + 2] + y[c * 4 + 3] * y[c * 4 + 3]);
            s = row16_sum(s); q = row16_sum(q); s = xor16_add(s); q = xor16_add(q);
            const float mean = s * (1.0f / 128.0f), rstd = rsqrtf(fmaxf(q * (1.0f / 128.0f) - mean * mean, 0.f) + 1e-6f);
#pragma unroll
            for (int i = 0; i < 4; ++i) { const int e = c * 4 + i; z[e] = ((y[e] - mean) * rstd * gg[e] + bq[e]) * o[e]; }
        }
        row_store_bf16(zb + (size_t)r * 1024, z, lane);
    }
}
__device__ __forceinline__ void phase_zrt(PRef p) {
    const int t_ = tidx(); const int lane = t_ & 63, gw = blockIdx.x * 4 + (t_ >> 6), nw = gridDim.x * 4;
    char* S = p.ws + OFF_SLOT;
    const bf16_t* yb = (const bf16_t*)(S + 7 * SLOT); const bf16_t* sb = (const bf16_t*)(S + 5 * SLOT); bf16_t* zb = (bf16_t*)(S + 3 * SLOT);
    float gw8[4][8], bw8[4][8];
#pragma unroll
    for (int c = 0; c < 4; ++c) {
        const float4 ga = gld_f4(p.in[33] + lane * 32 + c * 8), gb2 = gld_f4(p.in[33] + lane * 32 + c * 8 + 4), ba = gld_f4(p.in[34] + lane * 32 + c * 8), bb2 = gld_f4(p.in[34] + lane * 32 + c * 8 + 4);
        gw8[c][0] = ga.x; gw8[c][1] = ga.y; gw8[c][2] = ga.z; gw8[c][3] = ga.w; gw8[c][4] = gb2.x; gw8[c][5] = gb2.y; gw8[c][6] = gb2.z; gw8[c][7] = gb2.w;
        bw8[c][0] = ba.x; bw8[c][1] = ba.y; bw8[c][2] = ba.z; bw8[c][3] = ba.w; bw8[c][4] = bb2.x; bw8[c][5] = bb2.y; bw8[c][6] = bb2.z; bw8[c][7] = bb2.w;
    }
    const int rpw = NTOK / nw, first = gw * rpw, end = first + rpw;
    uint4 nyr[4], nsr[4];
    auto load_in = [&](int r) {
        const size_t o = (size_t)r * 2048 + lane * 32;
#pragma unroll
        for (int c = 0; c < 4; ++c) { nyr[c] = *(const uint4*)(yb + o + c * 8); nsr[c] = *(const uint4*)(sb + o + c * 8); }
    };
    load_in(first);
    for (int r = first; r < end; ++r) {
        const size_t o = (size_t)r * 2048 + lane * 32;
        uint4 yr[4], sr[4];
#pragma unroll
        for (int c = 0; c < 4; ++c) { yr[c] = nyr[c]; sr[c] = nsr[c]; }
        if (r + 1 < end) load_in(r + 1);
        __builtin_amdgcn_sched_barrier(0);
        float s = 0.f, q = 0.f;
#pragma unroll
        for (int c = 0; c < 4; ++c) { float f[8]; unpack8(yr[c], f);
#pragma unroll
            for (int i = 0; i < 8; ++i) { s += f[i]; q += f[i] * f[i]; } }
        s = row16_sum(s); q = row16_sum(q);
        const float mean = s * (1.0f / 512.0f), rstd = rsqrtf(fmaxf(q * (1.0f / 512.0f) - mean * mean, 0.f) + 1e-6f);
#pragma unroll
        for (int c = 0; c < 4; ++c) {
            float f[8], g[8], z[8]; unpack8(yr[c], f); unpack8(sr[c], g);
#pragma unroll
            for (int i = 0; i < 8; ++i) z[i] = ((f[i] - mean) * rstd * gw8[c][i] + bw8[c][i]) * g[i];
            *(uint4*)(zb + o + c * 8) = pack8(z);
        }
    }
}

template <int WHICH  >
__device__ __forceinline__ void phase_moe(PRef p, int L, char* lds, const bf16_t* hm, bf16_t* H) {
    const int t = tidx(), lane = t & 63, wid = t >> 6, wr = wid >> 1, wc = wid & 1, fr = lane & 15, fq = lane >> 4;
    const int* cnt = (const int*)(p.ws + OFF_CNT) + L * 32;
    const int* list = (const int*)(p.ws + OFF_LIST);
    bf16_t* Y = (bf16_t*)(p.ws + OFF_SLOT + 9 * SLOT);
    int* pre = (int*)(lds + 65536);
    __syncthreads();
    if (t == 0) { int s = 0; for (int e = 0; e < 32; ++e) { pre[e] = s; s += (cnt[e] + 127) >> 7; } pre[32] = s; }
    __syncthreads();
    const int total_all = pre[32] * 8;
    const int full = (total_all / (int)gridDim.x) * (int)gridDim.x, rem = total_all - full;
    const bool split_tail = (rem > 0) && (2 * rem <= (int)gridDim.x);
    const int total = split_tail ? full : total_all;
    for (int id0 = 0; id0 < total; id0 += gridDim.x) {
        const int id = id0 + (blockIdx.x & 7) * (gridDim.x >> 3) + (blockIdx.x >> 3);
        if (id >= total) continue;
        const int nt = id & 7, mg = id >> 3;
        int e = 0;
#pragma unroll 1
        for (int s = 16; s >= 1; s >>= 1) if (pre[e + s] <= mg) e += s;
        const int mt = mg - pre[e], ne = cnt[e];
        const int* le = list + e * LIST_CAP + mt * 128;
        const bf16_t* ar[4]; const bf16_t* br[4];
        const int co_ = glds_chunk(t) * 8;
#pragma unroll
        for (int i = 0; i < 4; ++i) {
            int r = (t >> 3) + 32 * i; r = (mt * 128 + r < ne) ? r : 0;
            const int aid = le[r];
            ar[i] = ((WHICH == 0) ? hm + (size_t)(aid >> 1) * 1024 : H + (size_t)aid * 512) + co_;
        }
        f32x4 acc[4][4];
        if (WHICH == 0) {
            const bf16_t* wt = (const bf16_t*)(p.ws + W_MOE13) + ((size_t)(L * 32 + e) * 1024 + nt * 128) * 1024;
#pragma unroll
            for (int i = 0; i < 4; ++i) {
                const int ro = (t >> 3) + 32 * i, n_ = (ro >> 4) & 3, hc = ((ro >> 2) & 3) * 8 + (n_ >> 1) * 4 + (ro & 3);
                br[i] = wt + (size_t)((ro & 64) + (hc >> 4) * 32 + (n_ & 1) * 16 + (hc & 15)) * 1024 + co_;
            }
            gemm_gg(lds, 16, ar, br, acc);
            int aidq[4];
#pragma unroll
            for (int m = 0; m < 4; ++m) { const int r = wr * 64 + m * 16 + fr; aidq[m] = (mt * 128 + r < ne) ? le[r] : 0; }
#pragma unroll
            for (int m = 0; m < 4; ++m) {
                const int r = wr * 64 + m * 16 + fr;
                if (mt * 128 + r < ne) {
                    const int aid = aidq[m];
                    const f32x4 a1 = acc[m][0], a3 = acc[m][1], b1 = acc[m][2], b3 = acc[m][3];
                    gst_u4(H + (size_t)aid * 512 + nt * 64 + wc * 32 + fq * 8, cvt_pk(siluf_(a1[0]) * a3[0], siluf_(a1[1]) * a3[1]), cvt_pk(siluf_(a1[2]) * a3[2], siluf_(a1[3]) * a3[3]),
                           cvt_pk(siluf_(b1[0]) * b3[0], siluf_(b1[1]) * b3[1]), cvt_pk(siluf_(b1[2]) * b3[2], siluf_(b1[3]) * b3[3]));
                }
            }
        } else {
            const bf16_t* wt = (const bf16_t*)(p.ws + W_MOE2) + ((size_t)(L * 32 + e) * 1024 + nt * 128) * 512;
#pragma unroll
            for (int i = 0; i < 4; ++i) br[i] = wt + (size_t)perm64((t >> 3) + 32 * i) * 512 + co_;
            gemm_gg(lds, 8, ar, br, acc);
            int aidq[4];
#pragma unroll
            for (int m = 0; m < 4; ++m) { const int r = wr * 64 + m * 16 + fr; aidq[m] = (mt * 128 + r < ne) ? le[r] : 0; }
#pragma unroll
            for (int m = 0; m < 4; ++m) {
                const int r = wr * 64 + m * 16 + fr;
                if (mt * 128 + r < ne) {
                    const int aid = aidq[m];
                    store16(Y + (size_t)aid * 1024 + nt * 128 + wc * 64 + fq * 16, acc[m]);
                }
            }
        }
    }
    if (split_tail) {
        const int hid = (blockIdx.x & 7) * (gridDim.x >> 3) + (blockIdx.x >> 3);
        if (hid < 2 * rem) {
            const int id = full + (hid >> 1), hf = hid & 1;
            const int nt = id & 7, mg = id >> 3;
            int e = 0;
#pragma unroll 1
            for (int s2 = 16; s2 >= 1; s2 >>= 1) if (pre[e + s2] <= mg) e += s2;
            const int mt = mg - pre[e], ne = cnt[e];
            const int* le = list + e * LIST_CAP + mt * 128;
            const bf16_t* ar[4]; const bf16_t* br[2];
            const int co_ = glds_chunk(t) * 8;
#pragma unroll
            for (int i = 0; i < 4; ++i) {
                int r = (t >> 3) + 32 * i; r = (mt * 128 + r < ne) ? r : 0;
                const int aid = le[r];
                ar[i] = ((WHICH == 0) ? hm + (size_t)(aid >> 1) * 1024 : H + (size_t)aid * 512) + co_;
            }
            f32x4 acc[2][4];
            int aidq[2];
            if (WHICH == 0) {
                const bf16_t* wt = (const bf16_t*)(p.ws + W_MOE13) + ((size_t)(L * 32 + e) * 1024 + nt * 128 + hf * 64) * 1024;
#pragma unroll
                for (int i = 0; i < 2; ++i) {
                    const int ro = (t >> 3) + 32 * i, n_ = (ro >> 4) & 3, hc = ((ro >> 2) & 3) * 8 + (n_ >> 1) * 4 + (ro & 3);
                    br[i] = wt + (size_t)((hc >> 4) * 32 + (n_ & 1) * 16 + (hc & 15)) * 1024 + co_;
                }
                gemm_hn(lds, 16, ar, br, acc);
#pragma unroll
                for (int m = 0; m < 2; ++m) { const int r = wid * 32 + m * 16 + fr; aidq[m] = (mt * 128 + r < ne) ? le[r] : 0; }
#pragma unroll
                for (int m = 0; m < 2; ++m) {
                    const int r = wid * 32 + m * 16 + fr;
                    if (mt * 128 + r < ne) {
                        const f32x4 a1 = acc[m][0], a3 = acc[m][1], b1 = acc[m][2], b3 = acc[m][3];
                        gst_u4(H + (size_t)aidq[m] * 512 + nt * 64 + hf * 32 + fq * 8, cvt_pk(siluf_(a1[0]) * a3[0], siluf_(a1[1]) * a3[1]), cvt_pk(siluf_(a1[2]) * a3[2], siluf_(a1[3]) * a3[3]),
                               cvt_pk(siluf_(b1[0]) * b3[0], siluf_(b1[1]) * b3[1]), cvt_pk(siluf_(b1[2]) * b3[2], siluf_(b1[3]) * b3[3]));
                    }
                }
            } else {
                const bf16_t* wt = (const bf16_t*)(p.ws + W_MOE2) + ((size_t)(L * 32 + e) * 1024 + nt * 128 + hf * 64) * 512;
#pragma unroll
                for (int i = 0; i < 2; ++i) br[i] = wt + (size_t)perm64((t >> 3) + 32 * i) * 512 + co_;
                gemm_hn(lds, 8, ar, br, acc);
#pragma unroll
                for (int m = 0; m < 2; ++m) { const int r = wid * 32 + m * 16 + fr; aidq[m] = (mt * 128 + r < ne) ? le[r] : 0; }
#pragma unroll
                for (int m = 0; m < 2; ++m) {
                    const int r = wid * 32 + m * 16 + fr;
                    if (mt * 128 + r < ne) store16(Y + (size_t)aidq[m] * 1024 + nt * 128 + hf * 64 + fq * 16, acc[m]);
                }
            }
        }
    }
}

constexpr int NPHASE = 37;
#ifndef PHSEL
#define PHSEL -1
#endif
#ifndef PHEXC
#define PHEXC -2
#endif
#define PHON(x) ((PHSEL < 0 || PHSEL == (x)) && PHEXC != (x))
__global__ void __launch_bounds__(256, 2) mega(Params p_in) {
    PRef p = *(const CAS Params*)__builtin_amdgcn_kernarg_segment_ptr();
    extern __shared__ __attribute__((aligned(16))) char lds[];
    volatile LAS unsigned* xbw = (volatile LAS unsigned*)(lds + 73728);
    if (threadIdx.x == 0) { xbw[0] = 0u; xbw[1] = 0u; xbw[2] = 0u; xbw[3] = 0u; }
    __syncthreads();
    XcdBarrier bar;
    const bool multi = (p.ph_hi - p.ph_lo) > 1;
    (void)multi;
    if (multi) bar = xcd_barrier_post((unsigned*)(p.ws + OFF_CTL), xbw);
    char* S = p.ws + OFF_SLOT;
#ifdef DBG_STOP
    if (p.ph_lo == 100) {
        const float* src = (const float*)(p.ws + DBG_SRC);
        for (size_t i = (size_t)blockIdx.x * 256 + threadIdx.x; i < (size_t)NTOK * DM; i += (size_t)gridDim.x * 256) {
            float v = DBG_BF16 ? bf2f(((const bf16_t*)src)[i]) : src[i];
            if (!(fabsf(v) < 1e30f)) v = 1e30f;
            p.out[i] = v;
        }
        return;
    }
#endif
    const int ph_lo_ = p.ph_lo, ph_hi_ = p.ph_hi;
#ifdef TIMEIT
    unsigned long long t0_ = 0, t1_ = 0;
#endif
#ifdef DUP_PHASE
    bool dup_done_ = false;
#endif
    for (int ph = ph_lo_; ph < ph_hi_; ++ph) {
        const CAS Params* pp_ = (const CAS Params*)__builtin_amdgcn_kernarg_segment_ptr();
        asm volatile("" : "+s"(pp_));
        PRef p = *pp_;
#ifdef TIMEIT
        if (ph == TIME_A) t0_ = __builtin_amdgcn_s_memrealtime();
        if (ph == TIME_B) t1_ = __builtin_amdgcn_s_memrealtime();
#endif
        int L, sub, kind;
        if (ph < 2) { L = 0; sub = ph; kind = -1; }
        else if (ph < 11) { L = 0; kind = 0; sub = ph - 2; }
        else if (ph < 20) { L = 1; kind = 1; sub = ph - 11; }
        else if (ph < 28) { L = 2; kind = 2; sub = ph - 20; }
        else { L = 3; kind = 0; sub = ph - 28; }
        const int jr = L / 3;
        if (kind == -1) { if (sub == 0) { if (PHON(0)) phase_prologue(p, lds); } else { if (PHON(1)) phase_h0(p); } }
        else {
            const int ntail = (kind == 2) ? 4 : 5;
            if (sub < ntail) {
                if (kind == 0) {
                    if (sub == 0) { if (PHON(2)) phase_gemm_jobs(p, lds, jr * 7, jr * 7 + (jr ? 7 : 6)); }
                    else if (sub == 1) { if (PHON(3)) phase_rw2(p, jr); }
                    else if (sub == 2) { if (PHON(4)) {
#ifdef RW3_SCALAR
                        phase_rw3(p, jr, lds);
#else
                        phase_rw3c(p, jr, lds);
#endif
                    } }
                    else if (sub == 3) { if (PHON(5)) phase_zrw(p, jr); }
                    else { if (PHON(2)) phase_gemm_jobs(p, lds, 16 + jr, 17 + jr); }
                } else if (kind == 1) {
                    if (sub == 0) { if (PHON(2)) phase_gemm_jobs(p, lds, 14, 15); }
                    else if (sub == 1) { if (PHON(6)) phase_cml(p); }
                    else if (sub == 2) { if (PHON(6)) phase_ml2(p, lds); }
                    else if (sub == 3) { if (PHON(7)) phase_zml(p); }
                    else { if (PHON(2)) phase_gemm_jobs(p, lds, 18, 19); }
                } else {
                    if (sub == 0) { if (PHON(2)) phase_gemm_jobs(p, lds, 15, 16); }
                    else if (sub == 1) { if (PHON(8)) phase_rt2(p, lds); }
                    else if (sub == 2) { if (PHON(9)) phase_zrt(p); }
                    else { if (PHON(2)) phase_gemm_jobs(p, lds, 19, 20); }
                }
            } else {
                const int ts = sub - ntail;
                const bf16_t* ymix = (const bf16_t*)(S + (kind == 2 ? 1 : 6) * SLOT);
                bf16_t* hm = (bf16_t*)(S + (kind == 2 ? 2 : 7) * SLOT);
                bf16_t* H = (bf16_t*)(S + (kind == 0 ? 2 : (kind == 1 ? 5 : 3)) * SLOT);
                if (ts == 0) { if (PHON(10)) phase_ln1(p, L, lds, ymix, hm); }
                else if (ts == 1) { if (PHON(11)) phase_moe<0>(p, L, lds, hm, H); }
                else if (ts == 2) { if (PHON(12)) phase_moe<1>(p, L, lds, hm, H); }
                else { if (PHON(13)) phase_ln2(p, L); }
            }
        }
#ifdef DUP_PHASE
        if (((DUP_PHASE >> ph) & 1u) && !dup_done_) { dup_done_ = true; xcd_barrier(bar); --ph; continue; }
        dup_done_ = false;
#endif
        if (ph + 1 < ph_hi_) xcd_barrier(bar);
    }
#ifdef TIMEIT
    {
        xcd_barrier(bar);
        unsigned* tw = (unsigned*)(p.ws + OFF_CTL + 32768);
        if (blockIdx.x == 0 && threadIdx.x == 0) {
            if (t1_ == 0) t1_ = __builtin_amdgcn_s_memrealtime();
            const unsigned long long dt = t1_ - t0_;
            unsigned ms2 = (unsigned)((dt + TIME_U / 2) / TIME_U);
            __hip_atomic_store(tw, ms2, __ATOMIC_RELAXED, __HIP_MEMORY_SCOPE_AGENT);
        }
        xcd_barrier(bar);
        const float c_ = sqrtf((float)__hip_atomic_load(tw, __ATOMIC_RELAXED, __HIP_MEMORY_SCOPE_AGENT));
        for (size_t i = (size_t)blockIdx.x * 256 + threadIdx.x; i < (size_t)NTOK * DM; i += (size_t)gridDim.x * 256) p.out[i] = c_;
    }
#endif
#ifdef DBG_STOP
    if (ph_lo_ != 100) {
        xcd_barrier(bar);
        const float* src = (const float*)(p.ws + DBG_SRC);
        for (size_t i = (size_t)blockIdx.x * 256 + threadIdx.x; i < (size_t)NTOK * DM; i += (size_t)gridDim.x * 256) {
            float v = DBG_BF16 ? bf2f(((const bf16_t*)src)[i]) : src[i];
            if (!(fabsf(v) < 1e30f)) v = 1e30f;
            p.out[i] = v;
        }
    }
#endif
}

constexpr int LDS_BYTES = 73728 + 64;
extern "C" void kernel_launch(void* const* d_in, const int* in_sizes, int n_in, void* d_out, int out_size, void* d_ws, size_t ws_size, hipStream_t stream) {
    static int grid = 0;
    if (grid == 0) {
        if (n_in != 43 || out_size != NTOK * DM || ws_size < WS_NEED) { fprintf(stderr, "kernel_launch: unexpected shapes (n_in %d out %d ws %zu need %zu)\n", n_in, out_size, ws_size, (size_t)WS_NEED); }
        int dev = 0, cus = 0, per_cu = 0;
        (void)hipGetDevice(&dev); (void)hipDeviceGetAttribute(&cus, hipDeviceAttributeMultiprocessorCount, dev);
        (void)hipFuncSetAttribute((const void*)mega, hipFuncAttributeMaxDynamicSharedMemorySize, LDS_BYTES);
        (void)hipOccupancyMaxActiveBlocksPerMultiprocessor(&per_cu, (const void*)mega, 256, LDS_BYTES);
        if (per_cu > 2) per_cu = 2;
        if (per_cu < 1) per_cu = 1;
        grid = cus * per_cu;
        if (grid > 512) grid = 512;
        (void)hipGetLastError();
    }
    Params p{};
    for (int i = 0; i < 43; ++i) p.in[i] = (const float*)d_in[i];
    p.out = (float*)d_out; p.ws = (char*)d_ws;
    char* ws = (char*)d_ws;
    auto slot = [&](int i) { return (bf16_t*)(ws + OFF_SLOT + (size_t)i * SLOT); };
    int tile = 0;
    auto addg = [&](int idx, const bf16_t* A, const bf16_t* Bt, bf16_t* out, int K, int N, int ldo, int mode) {
        GJob& g = p.gj[idx]; g.A = A; g.Bt = Bt; g.out = out; g.K = K; g.N = N; g.ldo = ldo; g.mode = mode; g.half = (mode <= MODE_SIGM && N <= 128) ? 1 : 0; g.ntn = g.half ? (N + 63) / 64 : (N + 127) / 128; g.tile0 = tile; tile += 128 * g.ntn;
    };
    for (int jr = 0; jr < 2; ++jr) {
        const bf16_t* rkv = (const bf16_t*)(ws + W_RKV) + (size_t)jr * 3 * 1024 * 1024;
        addg(jr * 7 + 0, slot(0), rkv, slot(6), 1024, 1024, 1024, MODE_BF16);
        addg(jr * 7 + 1, slot(1), rkv + 1024 * 1024, slot(7), 1024, 1024, 1024, MODE_BF16);
        addg(jr * 7 + 2, slot(2), rkv + 2 * 1024 * 1024, slot(jr == 0 ? 11 : 8), 1024, 1024, 1024, MODE_BF16);
        addg(jr * 7 + 3, slot(3), (const bf16_t*)(ws + W_W1T) + (size_t)jr * 64 * 1024, (bf16_t*)(ws + OFF_LW), 1024, 64, 64, MODE_TANH);
        addg(jr * 7 + 4, slot(4), (const bf16_t*)(ws + W_A1T) + (size_t)jr * 64 * 1024, (bf16_t*)(ws + OFF_LA), 1024, 64, 64, MODE_BF16);
        addg(jr * 7 + 5, slot(5), (const bf16_t*)(ws + W_G1T) + (size_t)jr * 128 * 1024, (bf16_t*)(ws + OFF_LG), 1024, 128, 128, MODE_SIGM);
        addg(jr * 7 + 6, slot(2), (const bf16_t*)(ws + W_V1T), (bf16_t*)(ws + OFF_LV), 1024, 32, 32, MODE_BF16);
    }
    addg(14, slot(0), (const bf16_t*)(ws + W_MLIN), nullptr, 1024, 3088, 0, MODE_ML1);
    addg(15, slot(0), (const bf16_t*)(ws + W_RTIN), nullptr, 1024, 6144, 0, MODE_RT1);
    addg(16, slot(7), (const bf16_t*)(ws + W_OUT), slot(6), 1024, 1024, 1024, MODE_BF16);
    addg(17, slot(7), (const bf16_t*)(ws + W_OUT) + 1024 * 1024, slot(6), 1024, 1024, 1024, MODE_BF16);
    addg(18, slot(1), (const bf16_t*)(ws + W_MLOUT), slot(6), 1024, 1024, 1024, MODE_BF16);
    addg(19, slot(3), (const bf16_t*)(ws + W_RTOUT), slot(1), 2048, 1024, 1024, MODE_BF16);
    int nc = 0, ctile = 0;
    auto addc = [&](const float* src, size_t dst_off, int K, int N, int nb, long sbs, long dbs, int mode) {
        CJob& c = p.cj[nc++]; c.src = src; c.dst = (bf16_t*)(ws + dst_off); c.K = K; c.N = N; c.nb = nb; c.mode = mode; c.sbs = sbs; c.dbs = dbs;
        c.tiles_pb = ((K + 63) / 64) * ((N + 255) / 256); c.tile0 = ctile; ctile += c.tiles_pb * nb;
    };
    addc(p.in[7], W_RKV, 1024, 1024, 6, 1024 * 1024, 1024 * 1024, 0);
    addc(p.in[24], W_OUT, 1024, 1024, 2, 1024 * 1024, 1024 * 1024, 0);
    addc(p.in[9], W_W1T, 1024, 64, 2, 1024 * 64, 64 * 1024, 0);
    addc(p.in[12], W_A1T, 1024, 64, 2, 1024 * 64, 64 * 1024, 0);
    addc(p.in[17], W_G1T, 1024, 128, 2, 1024 * 128, 128 * 1024, 0);
    addc(p.in[15], W_V1T, 1024, 32, 1, 0, 0, 0);
    addc(p.in[10], W_W2T, 64, 1024, 2, 64 * 1024, 1024 * 64, 0);
    addc(p.in[13], W_A2T, 64, 1024, 2, 64 * 1024, 1024 * 64, 0);
    addc(p.in[18], W_G2T, 128, 1024, 2, 128 * 1024, 1024 * 128, 0);
    addc(p.in[16], W_V2T, 32, 1024, 1, 0, 0, 0);
    addc(p.in[25], W_MLIN, 1024, 3088, 1, 0, 0, 0);
    addc(p.in[31], W_MLOUT, 1024, 1024, 1, 0, 0, 0);
    addc(p.in[32], W_RTIN, 1024, 6144, 1, 0, 0, 3);
    addc(p.in[35], W_RTOUT, 2048, 1024, 1, 0, 0, 0);
    addc(p.in[40], W_MOE13, 1024, 512, 128, 1024 * 512, 1024 * 1024, 1);
    addc(p.in[41], W_MOE13, 1024, 512, 128, 1024 * 512, 1024 * 1024, 2);
    addc(p.in[42], W_MOE2, 512, 1024, 128, 512 * 1024, 1024 * 512, 0);
    p.ncj = nc; p.cj_tiles = ctile;

    (void)hipMemsetAsync(ws + OFF_CTL, 0, CTL_BYTES, stream);
#ifdef DBG_STOP
    const int nph = DBG_STOP;
#else
    const int nph = NPHASE;
#endif
#ifdef MULTI_LAUNCH
    for (int ph = 0; ph < nph; ++ph) { p.ph_lo = ph; p.ph_hi = ph + 1; hipLaunchKernelGGL(mega, dim3(grid), dim3(256), LDS_BYTES, stream, p); }
    if (0)
#endif
    {
        p.ph_lo = 0; p.ph_hi = nph;
        void* args[] = {&p};
        hipError_t e = hipLaunchCooperativeKernel((const void*)mega, dim3(grid), dim3(256), args, LDS_BYTES, stream);
        if (e != hipSuccess) fprintf(stderr, "cooperative launch failed: %s (grid %d)\n", hipGetErrorString(e), grid);
    }
}
```

```cpp
#include <hip/hip_runtime.h>
#include <cstdio>
#include <cstdint>

#ifndef ONE_LAUNCH
#define ONE_LAUNCH 0
#endif

typedef unsigned short bf16_t;
typedef short bf16x8 __attribute__((ext_vector_type(8)));
typedef float f32x4 __attribute__((ext_vector_type(4)));
#define LAS __attribute__((address_space(3)))
#define GAS __attribute__((address_space(1)))
typedef float f32x4g_t __attribute__((ext_vector_type(4)));
typedef unsigned u32x2g_t __attribute__((ext_vector_type(2)));
typedef unsigned u32x4g_t __attribute__((ext_vector_type(4)));
__device__ __forceinline__ float4 gld_f4(const float* p) { const f32x4g_t v = *(const GAS f32x4g_t*)(const GAS char*)(const char*)p; return make_float4(v[0], v[1], v[2], v[3]); }
__device__ __forceinline__ uint2 gld_u2(const void* p) { const u32x2g_t v = *(const GAS u32x2g_t*)(const GAS char*)(const char*)p; return make_uint2(v[0], v[1]); }
__device__ __forceinline__ uint4 gld_u4(const void* p) { const u32x4g_t v = *(const GAS u32x4g_t*)(const GAS char*)(const char*)p; return make_uint4(v[0], v[1], v[2], v[3]); }
__device__ __forceinline__ void gst_f4(float* p, float a, float b, float c, float d) { const f32x4g_t v = {a, b, c, d}; *(GAS f32x4g_t*)(GAS char*)(char*)p = v; }
__device__ __forceinline__ void gst_u2(void* p, unsigned a, unsigned b) { const u32x2g_t v = {a, b}; *(GAS u32x2g_t*)(GAS char*)(char*)p = v; }
__device__ __forceinline__ void gst_u4(void* p, unsigned a, unsigned b, unsigned c, unsigned d) { const u32x4g_t v = {a, b, c, d}; *(GAS u32x4g_t*)(GAS char*)(char*)p = v; }

constexpr int NTOK = 16384, DM = 1024, TSEQ = 2048, NBATCH = 8;
constexpr float DN_ALPHA = 1.681792830507429f;
constexpr float LN_EPS = 1e-5f;
constexpr size_t MB = 1u << 20;
constexpr size_t OFF_CTL = 0, OFF_CNT = 16384, CTL_BYTES = 65536;
constexpr size_t OFF_MOD = 65536;
constexpr size_t OFF_ROT = 1 * MB;
constexpr size_t OFF_BONUS = 3 * MB, OFF_GATES = 4 * MB, OFF_STAT = 5 * MB, OFF_LW = 13 * MB, OFF_LA = 15 * MB, OFF_LG = 17 * MB, OFF_LV = 21 * MB,
                 OFF_WGT = 22 * MB, OFF_LIST = 23 * MB, OFF_RTW = 25 * MB;
constexpr size_t OFF_W = 32 * MB;
constexpr size_t W_RKV = OFF_W, W_OUT = W_RKV + 12 * MB, W_W1T = W_OUT + 4 * MB, W_A1T = W_W1T + 256 * 1024, W_G1T = W_A1T + 256 * 1024, W_V1T = W_G1T + 512 * 1024,
                 W_W2T = W_V1T + 64 * 1024, W_A2T = W_W2T + 256 * 1024, W_G2T = W_A2T + 256 * 1024, W_V2T = W_G2T + 512 * 1024, W_MLIN = W_V2T + 64 * 1024 + 832 * 1024,
                 W_MLOUT = W_MLIN + 6400 * 1024, W_RTIN = W_MLOUT + 2 * MB, W_RTOUT = W_RTIN + 12 * MB, W_MOE13 = W_RTOUT + 4 * MB, W_MOE2 = W_MOE13 + 256 * MB,
                 W_END = W_MOE2 + 128 * MB;
constexpr size_t OFF_XRES = 464 * MB;
constexpr size_t OFF_SLOT = 528 * MB, SLOT = 32 * MB;
static_assert(W_END <= OFF_XRES, "weights overflow");
constexpr size_t OFF_XRES2 = OFF_SLOT + 12 * SLOT;
constexpr size_t WS_NEED = OFF_XRES2 + 2 * SLOT;
constexpr int LIST_CAP = 16384;

#define XB_TMO      128
#define XB_XCNT(j)  (256  + 64 * (j))
#define XB_XSUB(j)  (1280 + 64 * (j))
#define XB_XGEN(j)  (2304 + 64 * (j))
#define XB_TOP      3328
#define XB_TOPGEN   3392
#define XCD_BAR_WORDS 3456
#define XB_SPIN_CAP (1u << 22)
__device__ __forceinline__ unsigned xb_ld(unsigned* p)              { return __hip_atomic_load(p, __ATOMIC_RELAXED, __HIP_MEMORY_SCOPE_AGENT); }
__device__ __forceinline__ unsigned xb_add(unsigned* p, unsigned v) { return __hip_atomic_fetch_add(p, v, __ATOMIC_RELAXED, __HIP_MEMORY_SCOPE_AGENT); }
__device__ __forceinline__ unsigned xb_xcc_id() { return (unsigned)__builtin_amdgcn_s_getreg((3 << 11) | 20) & 0xFu; }
#define XB_SPIN(cond, bar) do { unsigned _sp = 0; while (cond) { __builtin_amdgcn_s_sleep(1); \
    if ((++_sp & 255u) == 0u) { if (xb_ld(&(bar)[XB_TMO])) break; if (_sp > XB_SPIN_CAP) { atomicAdd(&(bar)[XB_TMO], 1u); break; } } } } while (0)
struct XcdBarrier { unsigned* bar; unsigned x; volatile LAS unsigned* st; };
__device__ __forceinline__ XcdBarrier xcd_barrier_post(unsigned* bar, volatile LAS unsigned* st) {
    XcdBarrier b; b.bar = bar; b.x = xb_xcc_id(); b.st = st;
    if (threadIdx.x == 0) (void)xb_add(&bar[XB_XCNT(b.x)], 1u);
    return b;
}
__device__ __forceinline__ void xcd_barrier_complete(unsigned* bar, unsigned x, unsigned& nloc, unsigned& nx) {
    const unsigned G = gridDim.x;
    unsigned sum, cnt, mine, sp = 0u;
    for (;;) {
        sum = 0u; cnt = 0u; mine = 0u;
#pragma unroll
        for (unsigned j = 0; j < 16; ++j) { const unsigned c = xb_ld(&bar[XB_XCNT(j)]); sum += c; cnt += (c > 0u) ? 1u : 0u; mine = (j == x) ? c : mine; }
        if (sum == G) break;
        __builtin_amdgcn_s_sleep(1);
        if ((++sp & 255u) == 0u) { if (xb_ld(&bar[XB_TMO])) break; if (sp > XB_SPIN_CAP) { atomicAdd(&bar[XB_TMO], 1u); break; } }
    }
    nloc = mine > 0u ? mine : 1u; nx = cnt > 0u ? cnt : 1u;
}
__device__ __forceinline__ void xcd_barrier(const XcdBarrier& b) {
    asm volatile("s_waitcnt vmcnt(0)" ::: "memory");
    __syncthreads();
    if (threadIdx.x == 0) {
        unsigned* bar = b.bar;
        __builtin_amdgcn_s_waitcnt(0);
        unsigned nloc = b.st[0], nx = b.st[1];
        if (nloc == 0u) { xcd_barrier_complete(bar, b.x, nloc, nx); b.st[0] = nloc; b.st[1] = nx; }
        const unsigned old = xb_add(&bar[XB_XSUB(b.x)], 1u);
        const unsigned gen = old / nloc;
        if (old + 1u == (gen + 1u) * nloc) {
            __builtin_amdgcn_fence(__ATOMIC_RELEASE, "agent");
            asm volatile("s_waitcnt vmcnt(0)" ::: "memory");
            const unsigned og = xb_add(&bar[XB_TOP], 1u);
            const unsigned tg = og / nx;
            if (og + 1u == (tg + 1u) * nx) xb_add(&bar[XB_TOPGEN], 1u);
            else XB_SPIN(xb_ld(&bar[XB_TOPGEN]) == tg, bar);
            __builtin_amdgcn_fence(__ATOMIC_ACQUIRE, "agent");
            xb_add(&bar[XB_XGEN(b.x)], 1u);
            asm volatile("s_waitcnt vmcnt(0)" ::: "memory");
        } else {
            XB_SPIN(xb_ld(&bar[XB_XGEN(b.x)]) == gen, bar);
            __builtin_amdgcn_fence(__ATOMIC_ACQUIRE, "agent");
            asm volatile("s_waitcnt vmcnt(0)" ::: "memory");
        }
    }
    __syncthreads();
}

__device__ __forceinline__ int tidx() { int t = threadIdx.x; asm volatile("" : "+v"(t)); return t; }
typedef __bf16 bf16x2_t __attribute__((ext_vector_type(2)));
typedef float f32x2_t __attribute__((ext_vector_type(2)));
__device__ __forceinline__ unsigned cvt_pk(float lo, float hi) {
    f32x2_t v = {lo, hi}; bf16x2_t r = __builtin_convertvector(v, bf16x2_t);
    unsigned u; __builtin_memcpy(&u, &r, 4); return u;
}
__device__ __forceinline__ bf16_t f2bf(float f) { return (bf16_t)(cvt_pk(f, 0.f) & 0xffffu); }
__device__ __forceinline__ float bflo(unsigned u) { return __uint_as_float(u << 16); }
__device__ __forceinline__ float bfhi(unsigned u) { return __uint_as_float(u & 0xffff0000u); }
__device__ __forceinline__ float bf2f(bf16_t u) { return __uint_as_float(((unsigned)u) << 16); }
__device__ __forceinline__ void unpack8(const uint4& u, float (&f)[8]) {
    f[0] = bflo(u.x); f[1] = bfhi(u.x); f[2] = bflo(u.y); f[3] = bfhi(u.y); f[4] = bflo(u.z); f[5] = bfhi(u.z); f[6] = bflo(u.w); f[7] = bfhi(u.w);
}
__device__ __forceinline__ uint4 pack8(const float (&f)[8]) { uint4 u; u.x = cvt_pk(f[0], f[1]); u.y = cvt_pk(f[2], f[3]); u.z = cvt_pk(f[4], f[5]); u.w = cvt_pk(f[6], f[7]); return u; }
typedef unsigned u32x4_t __attribute__((ext_vector_type(4)));
__device__ __forceinline__ uint4 gload16(const void* p) {
    const u32x4_t v = *(const __attribute__((address_space(1))) u32x4_t*)p;
    return make_uint4(v[0], v[1], v[2], v[3]);
}
__device__ __forceinline__ float sigmoidf_(float x) { return __builtin_amdgcn_rcpf(1.0f + __expf(-x)); }
__device__ __forceinline__ float siluf_(float x) { return x * __builtin_amdgcn_rcpf(1.0f + __expf(-x)); }
__device__ __forceinline__ float tanhf_(float x) { return 1.0f - 2.0f * __builtin_amdgcn_rcpf(1.0f + __expf(2.0f * x)); }
__device__ __forceinline__ float softplusf_(float x) { return fmaxf(x, 0.f) + __logf(1.0f + __expf(-fabsf(x))); }
__device__ __forceinline__ float row16_sum(float v);
__device__ __forceinline__ float xor16_add(float v) { const auto r = __builtin_amdgcn_permlane16_swap(__float_as_uint(v), __float_as_uint(v), false, false); return __uint_as_float(r[0]) + __uint_as_float(r[1]); }
__device__ __forceinline__ float xor32_add(float v) { const auto r = __builtin_amdgcn_permlane32_swap(__float_as_uint(v), __float_as_uint(v), false, false); return __uint_as_float(r[0]) + __uint_as_float(r[1]); }
__device__ __forceinline__ float wave_sum(float v) {
    v = row16_sum(v); v = xor16_add(v); v = xor32_add(v);
    return v;
}
__device__ __forceinline__ float row16_sum(float v) {
    v += __builtin_amdgcn_update_dpp(0.f, v, 0x128, 0xf, 0xf, false);
    v += __builtin_amdgcn_update_dpp(0.f, v, 0x124, 0xf, 0xf, false);
    v += __builtin_amdgcn_update_dpp(0.f, v, 0x122, 0xf, 0xf, false);
    v += __builtin_amdgcn_update_dpp(0.f, v, 0x121, 0xf, 0xf, false);
    return v;
}
__device__ __forceinline__ float oct_sum(float v) {
    v += __builtin_amdgcn_update_dpp(0.f, v, 0xB1, 0xf, 0xf, false);
    v += __builtin_amdgcn_update_dpp(0.f, v, 0x4E, 0xf, 0xf, false);
    v += __builtin_amdgcn_update_dpp(0.f, v, 0x141, 0xf, 0xf, false);
    return v;
}

enum { MODE_BF16 = 0, MODE_TANH = 1, MODE_SIGM = 2, MODE_ML1 = 3, MODE_RT1 = 4 };
struct GJob { const bf16_t* A; const bf16_t* Bt; bf16_t* out; int K, N, ldo, mode, ntn, tile0, half; };
struct CJob { const float* src; bf16_t* dst; int K, N, nb, mode; long sbs, dbs; int tiles_pb, tile0; };
constexpr int NGJ = 20, NCJ = 24;
struct Params {
    const float* in[43]; float* out; char* ws;
    int ph_lo, ph_hi, ncj, cj_tiles;
    GJob gj[NGJ];
    CJob cj[NCJ];
};
#define CAS __attribute__((address_space(4)))
typedef const CAS Params& PRef;

__device__ __forceinline__ f32x4 mfma16(const uint4& a, const uint4& b, f32x4 c) {
    bf16x8 av, bv; __builtin_memcpy(&av, &a, 16); __builtin_memcpy(&bv, &b, 16);
    return __builtin_amdgcn_mfma_f32_16x16x32_bf16(av, bv, c, 0, 0, 0);
}
template <bool PFA = true, class AL, class BL>
__device__ __forceinline__ void gemm_mainloop(char* lds, int nk, const AL& al, const BL& bl, f32x4 (&acc)[4][4]) {
    const int t = tidx(), c = t & 7, r0 = t >> 3;
    const int lane = t & 63, wid = t >> 6, wr = wid >> 1, wc = wid & 1, fr = lane & 15, fq = lane >> 4;
    typename AL::Raw ra[4]; typename BL::Raw rb[4];
    const int woff = r0 * 128 + ((c ^ (r0 & 7)) << 4);
#pragma unroll
    for (int i = 0; i < 4; ++i) { if (PFA) ra[i] = al.fetch(i, r0 + 32 * i, c); rb[i] = bl.fetch(i, r0 + 32 * i, c); }
#pragma unroll
    for (int i = 0; i < 4; ++i) {
        if (!PFA) { ra[i] = al.fetch(i, r0 + 32 * i, c); }
        *(uint4*)(lds + woff + i * 4096) = al.finish(ra[i], i, r0 + 32 * i, c);
        *(uint4*)(lds + 16384 + woff + i * 4096) = bl.finish(rb[i], i, r0 + 32 * i, c);
        if (!PFA) asm volatile("" ::: "memory");
    }
#pragma unroll
    for (int m = 0; m < 4; ++m)
#pragma unroll
        for (int n = 0; n < 4; ++n) acc[m][n] = (f32x4){0.f, 0.f, 0.f, 0.f};
    __syncthreads();
    const int aoff = (wr * 64 + fr) * 128, boff = 16384 + (wc * 64 + fr) * 128, sw = fr & 7;
    for (int kt = 0; kt < nk; ++kt) {
        const bool more = (kt + 1 < nk);
        if (more) {
#pragma unroll
            for (int i = 0; i < 4; ++i) { if (PFA) ra[i] = al.fetch(i, r0 + 32 * i, (kt + 1) * 8 + c); rb[i] = bl.fetch(i, r0 + 32 * i, (kt + 1) * 8 + c); }
        }
        const char* buf = lds + (kt & 1) * 32768;
#pragma unroll
        for (int ks = 0; ks < 2; ++ks) {
            uint4 af[4], bfm[4];
            const int ch = ((ks * 4 + fq) ^ sw) << 4;
#pragma unroll
            for (int m = 0; m < 4; ++m) af[m] = *(const uint4*)(buf + aoff + m * 2048 + ch);
#pragma unroll
            for (int n = 0; n < 4; ++n) bfm[n] = *(const uint4*)(buf + boff + n * 2048 + ch);
#pragma unroll
            for (int m = 0; m < 4; ++m)
#pragma unroll
                for (int n = 0; n < 4; ++n) acc[m][n] = mfma16(bfm[n], af[m], acc[m][n]);
        }
        if (more) {
            char* nb = lds + ((kt + 1) & 1) * 32768;
#pragma unroll
            for (int i = 0; i < 4; ++i) {
                if (!PFA) ra[i] = al.fetch(i, r0 + 32 * i, (kt + 1) * 8 + c);
                *(uint4*)(nb + woff + i * 4096) = al.finish(ra[i], i, r0 + 32 * i, (kt + 1) * 8 + c);
                *(uint4*)(nb + 16384 + woff + i * 4096) = bl.finish(rb[i], i, r0 + 32 * i, (kt + 1) * 8 + c);
                if (!PFA) asm volatile("" ::: "memory");
            }
        }
        __syncthreads();
    }
}
__device__ __forceinline__ void glds16(const bf16_t* g, char* l) {
    __builtin_amdgcn_global_load_lds((const unsigned*)g, (LAS unsigned*)l, 16, 0, 0);
}
__device__ __forceinline__ void glds16_asm(const void* gsrc, unsigned lds_dst) {
    unsigned keep;
    asm volatile("s_mov_b32 %0, m0\n\ts_mov_b32 m0, %2\n\ts_nop 0\n\tglobal_load_lds_dwordx4 %1, off\n\ts_mov_b32 m0, %0" : "=&s"(keep) : "v"(gsrc), "s"(lds_dst) : "memory");
}
__device__ __forceinline__ unsigned lds_addr_u(const char* l) { return (unsigned)(size_t)(const LAS char*)l; }
__device__ __forceinline__ int glds_chunk(int t) { return (t & 7) ^ ((t >> 3) & 7); }
__device__ __forceinline__ void mma_ktile(const char* buf, int aoff, int boff, int sw, int fq, f32x4 (&acc)[4][4]) {
    const int ch0 = ((0 * 4 + fq) ^ sw) << 4, ch1 = ((1 * 4 + fq) ^ sw) << 4;
    const char* pa = buf + aoff; const char* pb = buf + boff;
    uint4 a0[4], a1[4], b[8];
#pragma unroll
    for (int m = 0; m < 4; ++m) a0[m] = *(const uint4*)(pa + m * 2048 + ch0);
    b[0] = *(const uint4*)(pb + ch0); b[1] = *(const uint4*)(pb + 2048 + ch0);
    __builtin_amdgcn_sched_barrier(0);
    b[2] = *(const uint4*)(pb + 2 * 2048 + ch0);
#pragma unroll
    for (int m = 0; m < 4; ++m) acc[m][0] = mfma16(b[0], a0[m], acc[m][0]);
    __builtin_amdgcn_sched_barrier(0);
    b[3] = *(const uint4*)(pb + 3 * 2048 + ch0);
#pragma unroll
    for (int m = 0; m < 4; ++m) acc[m][1] = mfma16(b[1], a0[m], acc[m][1]);
    __builtin_amdgcn_sched_barrier(0);
#pragma unroll
    for (int m = 0; m < 4; ++m) a1[m] = *(const uint4*)(pa + m * 2048 + ch1);
#pragma unroll
    for (int m = 0; m < 4; ++m) acc[m][2] = mfma16(b[2], a0[m], acc[m][2]);
    __builtin_amdgcn_sched_barrier(0);
    b[4] = *(const uint4*)(pb + ch1); b[5] = *(const uint4*)(pb + 2048 + ch1);
#pragma unroll
    for (int m = 0; m < 4; ++m) acc[m][3] = mfma16(b[3], a0[m], acc[m][3]);
    __builtin_amdgcn_sched_barrier(0);
    b[6] = *(const uint4*)(pb + 2 * 2048 + ch1);
#pragma unroll
    for (int m = 0; m < 4; ++m) acc[m][0] = mfma16(b[4], a1[m], acc[m][0]);
    __builtin_amdgcn_sched_barrier(0);
    b[7] = *(const uint4*)(pb + 3 * 2048 + ch1);
#pragma unroll
    for (int m = 0; m < 4; ++m) acc[m][1] = mfma16(b[5], a1[m], acc[m][1]);
    __builtin_amdgcn_sched_barrier(0);
#pragma unroll
    for (int m = 0; m < 4; ++m) acc[m][2] = mfma16(b[6], a1[m], acc[m][2]);
#pragma unroll
    for (int m = 0; m < 4; ++m) acc[m][3] = mfma16(b[7], a1[m], acc[m][3]);
}
__device__ __forceinline__ void gemm_gg(char* lds, int nk, const bf16_t* const (&ar)[4], const bf16_t* const (&br)[4], f32x4 (&acc)[4][4]) {
    const int t = tidx();
    const int lane = t & 63, wid = t >> 6, wr = wid >> 1, wc = wid & 1, fr = lane & 15, fq = lane >> 4;
    const unsigned wbs = (unsigned)__builtin_amdgcn_readfirstlane((int)(lds_addr_u(lds) + wid * 1024));
#pragma unroll
    for (int i = 0; i < 4; ++i) { glds16_asm(ar[i], wbs + i * 4096); glds16_asm(br[i], wbs + 16384 + i * 4096); }
#pragma unroll
    for (int m = 0; m < 4; ++m)
#pragma unroll
        for (int n = 0; n < 4; ++n) acc[m][n] = (f32x4){0.f, 0.f, 0.f, 0.f};
    asm volatile("s_waitcnt vmcnt(0)" ::: "memory");
    __syncthreads();
    const int aoff = (wr * 64 + fr) * 128, boff = 16384 + (wc * 64 + fr) * 128, sw = fr & 7;
    for (int kt = 0; kt < nk; ++kt) {
        if (kt + 1 < nk) {
            const unsigned nb = (unsigned)__builtin_amdgcn_readfirstlane((int)(wbs + ((kt + 1) & 1) * 32768));
#pragma unroll
            for (int i = 0; i < 4; ++i) { glds16_asm(ar[i] + (kt + 1) * 64, nb + i * 4096); glds16_asm(br[i] + (kt + 1) * 64, nb + 16384 + i * 4096); }
        }
        mma_ktile(lds + (kt & 1) * 32768, aoff, boff, sw, fq, acc);
        asm volatile("s_waitcnt vmcnt(0)" ::: "memory");
        __syncthreads();
    }
}
__device__ __forceinline__ void gemm_hn(char* lds, int nk, const bf16_t* const (&ar)[4], const bf16_t* const (&br)[2], f32x4 (&acc)[2][4]) {
    const int t = tidx();
    const int lane = t & 63, wid = t >> 6, fr = lane & 15, fq = lane >> 4;
    const unsigned wbs = (unsigned)__builtin_amdgcn_readfirstlane((int)(lds_addr_u(lds) + wid * 1024));
#pragma unroll
    for (int i = 0; i < 4; ++i) glds16_asm(ar[i], wbs + i * 4096);
#pragma unroll
    for (int i = 0; i < 2; ++i) glds16_asm(br[i], wbs + 16384 + i * 4096);
#pragma unroll
    for (int m = 0; m < 2; ++m)
#pragma unroll
        for (int n = 0; n < 4; ++n) acc[m][n] = (f32x4){0.f, 0.f, 0.f, 0.f};
    asm volatile("s_waitcnt vmcnt(0)" ::: "memory");
    __syncthreads();
    const int aoff = (wid * 32 + fr) * 128, boff = 16384 + fr * 128, sw = fr & 7;
    for (int kt = 0; kt < nk; ++kt) {
        if (kt + 1 < nk) {
            const unsigned nb = (unsigned)__builtin_amdgcn_readfirstlane((int)(wbs + ((kt + 1) & 1) * 32768));
#pragma unroll
            for (int i = 0; i < 4; ++i) glds16_asm(ar[i] + (kt + 1) * 64, nb + i * 4096);
#pragma unroll
            for (int i = 0; i < 2; ++i) glds16_asm(br[i] + (kt + 1) * 64, nb + 16384 + i * 4096);
        }
        const char* buf = lds + (kt & 1) * 32768;
#pragma unroll
        for (int ks = 0; ks < 2; ++ks) {
            const int ch = ((ks * 4 + fq) ^ sw) << 4;
            uint4 af[2], bfm[4];
#pragma unroll
            for (int m = 0; m < 2; ++m) af[m] = *(const uint4*)(buf + aoff + m * 2048 + ch);
#pragma unroll
            for (int n = 0; n < 4; ++n) bfm[n] = *(const uint4*)(buf + boff + n * 2048 + ch);
#pragma unroll
            for (int m = 0; m < 2; ++m)
#pragma unroll
                for (int n = 0; n < 4; ++n) acc[m][n] = mfma16(bfm[n], af[m], acc[m][n]);
        }
        asm volatile("s_waitcnt vmcnt(0)" ::: "memory");
        __syncthreads();
    }
}
template <class AL>
__device__ __forceinline__ void gemm_rg(char* lds, int nk, const AL& al, const bf16_t* const (&br)[4], f32x4 (&acc)[4][4]) {
    const int t = tidx(), c = t & 7, r0 = t >> 3;
    const int lane = t & 63, wid = t >> 6, wr = wid >> 1, wc = wid & 1, fr = lane & 15, fq = lane >> 4;
    char* wb = lds + wid * 1024;
    const int woff = r0 * 128 + ((c ^ (r0 & 7)) << 4);
#pragma unroll
    for (int i = 0; i < 4; ++i) glds16(br[i], wb + 16384 + i * 4096);
#pragma unroll
    for (int i = 0; i < 4; ++i) {
        typename AL::Raw ra = al.fetch(i, r0 + 32 * i, c);
        *(uint4*)(lds + woff + i * 4096) = al.finish(ra, i, r0 + 32 * i, c);
        asm volatile("" ::: "memory");
    }
#pragma unroll
    for (int m = 0; m < 4; ++m)
#pragma unroll
        for (int n = 0; n < 4; ++n) acc[m][n] = (f32x4){0.f, 0.f, 0.f, 0.f};
    asm volatile("s_waitcnt vmcnt(0)" ::: "memory");
    __syncthreads();
    const int aoff = (wr * 64 + fr) * 128, boff = 16384 + (wc * 64 + fr) * 128, sw = fr & 7;
    for (int kt = 0; kt < nk; ++kt) {
        const bool more = (kt + 1 < nk);
        char* nbuf = lds + ((kt + 1) & 1) * 32768;
        if (more) {
#pragma unroll
            for (int i = 0; i < 4; ++i) glds16(br[i] + (kt + 1) * 64, nbuf + wid * 1024 + 16384 + i * 4096);
        }
        mma_ktile(lds + (kt & 1) * 32768, aoff, boff, sw, fq, acc);
        if (more) {
#pragma unroll
            for (int i = 0; i < 4; ++i) {
                typename AL::Raw ra = al.fetch(i, r0 + 32 * i, (kt + 1) * 8 + c);
                *(uint4*)(nbuf + woff + i * 4096) = al.finish(ra, i, r0 + 32 * i, (kt + 1) * 8 + c);
                asm volatile("" ::: "memory");
            }
        }
        asm volatile("s_waitcnt vmcnt(0)" ::: "memory");
        __syncthreads();
    }
}
struct LdPlain {
    typedef uint4 Raw;
    const bf16_t* p; int ld; int nvalid;
    __device__ __forceinline__ uint4 fetch(int, int r, int kc) const { return (r < nvalid) ? *(const uint4*)(p + (size_t)r * ld + kc * 8) : make_uint4(0u, 0u, 0u, 0u); }
    __device__ __forceinline__ uint4 finish(const uint4& v, int, int, int) const { return v; }
};
struct LdGather {
    typedef uint4 Raw;
    const bf16_t* rp[4];
    __device__ __forceinline__ uint4 fetch(int i, int, int kc) const { const bf16_t* q = rp[i]; return q ? *(const uint4*)(q + kc * 8) : make_uint4(0u, 0u, 0u, 0u); }
    __device__ __forceinline__ uint4 finish(const uint4& v, int, int, int) const { return v; }
};
__device__ __forceinline__ void tile_map(int id, int NT, int& mt, int& nt) {
    const int x = id & 7, q = id >> 3;
    const int mg = q / (8 * NT), q2 = q - mg * 8 * NT, G = (NT + 7) >> 3;
    int g = q2 >> 6; g = g < G - 1 ? g : G - 1;
    const int r = q2 - (g << 6), w = (g == G - 1) ? NT - 8 * g : 8;
    mt = (mg * 8 + r / w) * 8 + x; nt = 8 * g + r % w;
}

__device__ __forceinline__ int conv_row(int mode, int n) {
    if (mode == 1) return (n >> 4) * 32 + (n & 15);
    if (mode == 2) return (n >> 4) * 32 + 16 + (n & 15);
    if (mode == 3 && n < 2048) { const int c = n & 255, c2 = c & 127; return (n & ~255) + (c2 >> 4) * 32 + ((c >> 7) << 4) + (c2 & 15); }
    return n;
}
__device__ __forceinline__ void phase_prologue(PRef p, char* lds) {
    const int t = tidx();
    const int n_ada = 8 * 48, n_rot = 256 + 144;
    float* mod = (float*)(p.ws + OFF_MOD);
    for (int it = blockIdx.x; it < n_ada + n_rot; it += gridDim.x) {
        if (it < n_ada) {
            const int pr = it / 48, cb = it % 48;
            float* sc = (float*)lds;
            float* red = (float*)(lds + 32768);
            for (int i = t; i < 8192; i += 256) { const int b = i >> 10, k = i & 1023; sc[k * 8 + b] = siluf_(p.in[1][b * 1024 + k]); }
            __syncthreads();
            const int kg = t >> 6, cl = t & 63, col = cb * 64 + cl;
            const float* W = p.in[2] + (size_t)pr * 1024 * 3072 + col;
            float a[8] = {0, 0, 0, 0, 0, 0, 0, 0};
#pragma unroll 8
            for (int k = kg * 256; k < kg * 256 + 256; ++k) {
                const float w = W[(size_t)k * 3072];
                const float4 s0 = *(const float4*)(sc + k * 8), s1 = *(const float4*)(sc + k * 8 + 4);
                a[0] += w * s0.x; a[1] += w * s0.y; a[2] += w * s0.z; a[3] += w * s0.w; a[4] += w * s1.x; a[5] += w * s1.y; a[6] += w * s1.z; a[7] += w * s1.w;
            }
#pragma unroll
            for (int b = 0; b < 8; ++b) red[(kg * 8 + b) * 64 + cl] = a[b];
            __syncthreads();
            for (int i = t; i < 512; i += 256) {
                const int b = i >> 6, c2 = i & 63;
                const float s = red[(0 * 8 + b) * 64 + c2] + red[(1 * 8 + b) * 64 + c2] + red[(2 * 8 + b) * 64 + c2] + red[(3 * 8 + b) * 64 + c2];
                mod[((size_t)pr * 8 + b) * 3072 + cb * 64 + c2] = s + p.in[3][pr * 3072 + cb * 64 + c2];
            }
            __syncthreads();
        } else if (it >= n_ada + 256 && it < n_ada + n_rot) {
            float* rtw = (float*)(p.ws + OFF_RTW);
            const int base = (it - n_ada - 256) * 1024;
            for (int e = base + t; e < base + 1024; e += 256) {
                const int L = e / (36 * 1024), o = (e >> 10) % 36, k = e & 1023;
                rtw[e] = (o < 4) ? p.in[36][((size_t)L * 1024 + k) * 4 + o] : p.in[38][((size_t)L * 1024 + k) * 32 + (o - 4)];
            }
        } else if (it < n_ada + 256) {
            float* rot = (float*)(p.ws + OFF_ROT);
            const int base = (it - n_ada) * 1024;
            for (int e = base + t; e < base + 1024; e += 256) {
                const int tt = e >> 7, i = e & 127;
                const float inv = __builtin_amdgcn_exp2f(-(float)i * (13.287712379549449f / 127.0f));
                const float ang = (float)tt * inv;
                float rev = ang * 0.15915494309189535f; rev -= floorf(rev);
                rot[e * 2] = __builtin_amdgcn_cosf(rev); rot[e * 2 + 1] = __builtin_amdgcn_sinf(rev);
            }
        }
    }
    {
        float* sm = (float*)lds;
        const int lane = t & 63, wv = t >> 6;
        const float* nsrc = nullptr; bf16_t* ndst = nullptr; int nK = 0, nN = 0, nmode = 0, nkt = 0, nnt = 0;
        float4 pv[16];
#define CJ_SETUP(ct_) { int c_ = (ct_), j_ = 0; while (j_ + 1 < p.ncj && c_ >= p.cj[j_ + 1].tile0) ++j_; \
            c_ -= p.cj[j_].tile0; const int tpb_ = p.cj[j_].tiles_pb; const int bi_ = c_ / tpb_, tl_ = c_ % tpb_; nK = p.cj[j_].K; nN = p.cj[j_].N; nmode = p.cj[j_].mode; \
            const int nNt_ = (nN + 255) >> 8; nkt = tl_ / nNt_; nnt = tl_ % nNt_; nsrc = p.cj[j_].src + (size_t)bi_ * p.cj[j_].sbs; ndst = p.cj[j_].dst + (size_t)bi_ * p.cj[j_].dbs; }
#define CJ_LOAD() { _Pragma("unroll") for (int i = 0; i < 16; ++i) { const int k = nkt * 64 + wv + 4 * i, n = nnt * 256 + lane * 4; \
            pv[i] = (k < nK && n < nN) ? gld_f4(nsrc + (size_t)k * nN + n) : make_float4(0.f, 0.f, 0.f, 0.f); } }
        int* const tick = (int*)(p.ws + OFF_CTL + 20480);
        int* const nbox = (int*)(lds + 66560);
        int ct = (int)blockIdx.x, ct2 = (int)gridDim.x + (int)blockIdx.x;
        if (ct < p.cj_tiles) { CJ_SETUP(ct); CJ_LOAD(); }
        while (ct < p.cj_tiles) {
#pragma unroll
            for (int i = 0; i < 16; ++i) *(float4*)(sm + (wv + 4 * i) * 260 + lane * 4) = pv[i];
            bf16_t* const sdst = ndst; const int sK = nK, sN = nN, smode = nmode, skt = nkt, snt = nnt;
            if (ct2 < p.cj_tiles) { CJ_SETUP(ct2); CJ_LOAD(); }
            if (t == 0) *nbox = 2 * (int)gridDim.x + atomicAdd(tick, 1);
            __syncthreads();
            const int ct3 = *nbox;
#pragma unroll
            for (int h2 = 0; h2 < 4; ++h2) {
                const int nl = lane + 64 * h2, n = snt * 256 + nl, k0 = skt * 64 + wv * 16;
                if (n < sN && k0 < sK) {
                    float f[8], g[8];
#pragma unroll
                    for (int q = 0; q < 8; ++q) { f[q] = sm[(wv * 16 + q) * 260 + nl]; g[q] = sm[(wv * 16 + 8 + q) * 260 + nl]; }
                    bf16_t* d = sdst + (size_t)conv_row(smode, n) * sK + k0;
                    { const uint4 u0 = pack8(f), u1 = pack8(g); gst_u4(d, u0.x, u0.y, u0.z, u0.w); gst_u4(d + 8, u1.x, u1.y, u1.z, u1.w); }
                }
            }
            __syncthreads();
            ct = ct2; ct2 = ct3;
        }
#undef CJ_SETUP
#undef CJ_LOAD
    }
}

__device__ __forceinline__ void row_load_f32(const float* p, float (&v)[16], int lane) {
#pragma unroll
    for (int c = 0; c < 4; ++c) { const float4 x = gld_f4(p + c * 256 + lane * 4); v[c * 4] = x.x; v[c * 4 + 1] = x.y; v[c * 4 + 2] = x.z; v[c * 4 + 3] = x.w; }
}
__device__ __forceinline__ void row_load_f32_l(const float* p, float (&v)[16], int lane) {
#pragma unroll
    for (int c = 0; c < 4; ++c) { const float4 x = *(const float4*)(p + c * 256 + lane * 4); v[c * 4] = x.x; v[c * 4 + 1] = x.y; v[c * 4 + 2] = x.z; v[c * 4 + 3] = x.w; }
}
__device__ __forceinline__ void row_load_bf16(const bf16_t* p, float (&v)[16], int lane) {
#pragma unroll
    for (int c = 0; c < 4; ++c) { const uint2 x = gld_u2(p + c * 256 + lane * 4); v[c * 4] = bflo(x.x); v[c * 4 + 1] = bfhi(x.x); v[c * 4 + 2] = bflo(x.y); v[c * 4 + 3] = bfhi(x.y); }
}
__device__ __forceinline__ void row_store_bf16(bf16_t* p, const float (&v)[16], int lane) {
#pragma unroll
    for (int c = 0; c < 4; ++c) gst_u2(p + c * 256 + lane * 4, cvt_pk(v[c * 4], v[c * 4 + 1]), cvt_pk(v[c * 4 + 2], v[c * 4 + 3]));
}
__device__ __forceinline__ void row_store_f32(float* p, const float (&v)[16], int lane) {
#pragma unroll
    for (int c = 0; c < 4; ++c) gst_f4(p + c * 256 + lane * 4, v[c * 4], v[c * 4 + 1], v[c * 4 + 2], v[c * 4 + 3]);
}
__device__ __forceinline__ void row_store_f32_l(float* p, const float (&v)[16], int lane) {
#pragma unroll
    for (int c = 0; c < 4; ++c) *(float4*)(p + c * 256 + lane * 4) = make_float4(v[c * 4], v[c * 4 + 1], v[c * 4 + 2], v[c * 4 + 3]);
}
__device__ __forceinline__ void row_layernorm(float (&v)[16], const float* g, const float* b, int lane) {
    float gg[16], bb[16]; row_load_f32(g, gg, lane); row_load_f32(b, bb, lane);
    float s = 0.f, q = 0.f;
#pragma unroll
    for (int i = 0; i < 16; ++i) { s += v[i]; q += v[i] * v[i]; }
    s = wave_sum(s); q = wave_sum(q);
    const float mean = s * (1.0f / 1024.0f);
    const float rstd = rsqrtf(fmaxf(q * (1.0f / 1024.0f) - mean * mean, 0.f) + LN_EPS);
#pragma unroll
    for (int i = 0; i < 16; ++i) v[i] = (v[i] - mean) * rstd * gg[i] + bb[i];
}
__device__ __forceinline__ void row_modulate(const float (&x)[16], float (&h)[16], const float* mod3, int lane) {
    float sh[16], sc[16]; row_load_f32(mod3, sh, lane); row_load_f32(mod3 + 1024, sc, lane);
#pragma unroll
    for (int i = 0; i < 16; ++i) h[i] = x[i] * (1.0f + sc[i]) + sh[i];
}
__device__ __forceinline__ void load_mu(const float* mu, float (&m)[6][16], int lane) {
#pragma unroll
    for (int n = 0; n < 6; ++n) row_load_f32(mu + n * 1024, m[n], lane);
}
__device__ __forceinline__ void emit_next(bf16_t* s0, int kind, int row, const float (&h)[16], const float (&hp)[16], const float (&m)[6][16], int lane) {
    if (kind == 0) {
#pragma unroll
        for (int n = 0; n < 6; ++n) {
#pragma unroll
            for (int c = 0; c < 4; ++c)
                gst_u2(s0 + (size_t)n * (SLOT / 2) + (size_t)row * 1024 + c * 256 + lane * 4,
                       cvt_pk(h[c * 4] + (hp[c * 4] - h[c * 4]) * m[n][c * 4], h[c * 4 + 1] + (hp[c * 4 + 1] - h[c * 4 + 1]) * m[n][c * 4 + 1]),
                       cvt_pk(h[c * 4 + 2] + (hp[c * 4 + 2] - h[c * 4 + 2]) * m[n][c * 4 + 2], h[c * 4 + 3] + (hp[c * 4 + 3] - h[c * 4 + 3]) * m[n][c * 4 + 3]));
        }
    } else row_store_bf16(s0 + (size_t)row * 1024, h, lane);
}
__device__ __forceinline__ void emit_next_l(bf16_t* s0, const float* mu, int kind, int row, const float (&h)[16], const float (&hp)[16], int lane) {
    if (kind == 0) {
#pragma unroll 1
        for (int n = 0; n < 6; ++n) {
#pragma unroll
            for (int c2 = 0; c2 < 2; ++c2) {
                const float4 ma = gld_f4(mu + n * 1024 + (2 * c2) * 256 + lane * 4), mb = gld_f4(mu + n * 1024 + (2 * c2 + 1) * 256 + lane * 4);
                const float mm[8] = {ma.x, ma.y, ma.z, ma.w, mb.x, mb.y, mb.z, mb.w};
#pragma unroll
                for (int cc = 0; cc < 2; ++cc) {
                    const int c = 2 * c2 + cc;
                    gst_u2(s0 + (size_t)n * (SLOT / 2) + (size_t)row * 1024 + c * 256 + lane * 4,
                           cvt_pk(h[c * 4] + (hp[c * 4] - h[c * 4]) * mm[cc * 4], h[c * 4 + 1] + (hp[c * 4 + 1] - h[c * 4 + 1]) * mm[cc * 4 + 1]),
                           cvt_pk(h[c * 4 + 2] + (hp[c * 4 + 2] - h[c * 4 + 2]) * mm[cc * 4 + 2], h[c * 4 + 3] + (hp[c * 4 + 3] - h[c * 4 + 3]) * mm[cc * 4 + 3]));
                }
            }
        }
    } else row_store_bf16(s0 + (size_t)row * 1024, h, lane);
}
__device__ __forceinline__ void phase_h0(PRef p) {
    const int t_ = tidx(); const int lane = t_ & 63, gw = blockIdx.x * 4 + (t_ >> 6), nw = gridDim.x * 4;
    const int rpw = NTOK / nw;
    const int r_lo = gw * rpw;
    const float* mod = (const float*)(p.ws + OFF_MOD) + ((size_t)(0 * 2 + 0) * 8 + (r_lo >> 11)) * 3072;
    float sh[16], sc[16]; row_load_f32(mod, sh, lane); row_load_f32(mod + 1024, sc, lane);
    float hp[16];
#pragma unroll
    for (int i = 0; i < 16; ++i) hp[i] = 0.f;
    float mu[6][16]; load_mu(p.in[6], mu, lane);
    const int first = ((r_lo & 2047) != 0) ? r_lo - 1 : r_lo, end = r_lo + rpw;
    float nx[16]; row_load_f32(p.in[0] + (size_t)first * 1024, nx, lane);
    for (int r = first; r < end; ++r) {
        float h[16];
#pragma unroll
        for (int i = 0; i < 16; ++i) h[i] = nx[i] * (1.0f + sc[i]) + sh[i];
        if (r + 1 < end) row_load_f32(p.in[0] + (size_t)(r + 1) * 1024, nx, lane);
        __builtin_amdgcn_sched_barrier(0);
        if (r >= r_lo) emit_next((bf16_t*)(p.ws + OFF_SLOT), 0, r, h, hp, mu, lane);
#pragma unroll
        for (int i = 0; i < 16; ++i) hp[i] = h[i];
        if (((r + 1) & 2047) == 0) {
#pragma unroll
            for (int i = 0; i < 16; ++i) hp[i] = 0.f;
        }
    }
}
__device__ __forceinline__ int layer_kind(int L) { return L % 3; }
__device__ __forceinline__ void phase_ln2(PRef p, int L) {
    const int t_ = tidx(); const int lane = t_ & 63, gw = blockIdx.x * 4 + (t_ >> 6), nw = gridDim.x * 4;
    const int rpw = NTOK / nw, r_lo = gw * rpw;
    const float* mod = (const float*)(p.ws + OFF_MOD);
    const bf16_t* xres = (const bf16_t*)(p.ws + OFF_XRES);
    const bf16_t* Y = (const bf16_t*)(p.ws + OFF_SLOT + 9 * SLOT);
    const float* wgt = (const float*)(p.ws + OFF_WGT);
    const bool last = (L == 3);
    const int nk = layer_kind(L + 1), njr = (L + 1) / 3;
    const bool need_prev = (!last && nk == 0);
    const int bidx = r_lo >> 11;
    float gt[16], lgn[16], lbn[16];
    row_load_f32(mod + ((size_t)(L * 2 + 1) * 8 + bidx) * 3072 + 2048, gt, lane);
    row_load_f32(p.in[4] + (L * 2 + 1) * 1024, lgn, lane); row_load_f32(p.in[5] + (L * 2 + 1) * 1024, lbn, lane);
    float hp[16];
#pragma unroll
    for (int i = 0; i < 16; ++i) hp[i] = 0.f;
    float shn[16], scn[16];
    { const float* mn_ = mod + ((size_t)((last ? L : L + 1) * 2 + 0) * 8 + bidx) * 3072; row_load_f32(mn_, shn, lane); row_load_f32(mn_ + 1024, scn, lane); }
    uint2 nxr[4], ny0[4], ny1[4]; float nw0, nw1;
    auto load_in = [&](int r) {
#pragma unroll
        for (int c = 0; c < 4; ++c) { nxr[c] = *(const uint2*)(xres + (size_t)r * 1024 + c * 256 + lane * 4); ny0[c] = *(const uint2*)(Y + (size_t)(2 * r) * 1024 + c * 256 + lane * 4); ny1[c] = *(const uint2*)(Y + (size_t)(2 * r + 1) * 1024 + c * 256 + lane * 4); }
        nw0 = wgt[2 * r]; nw1 = wgt[2 * r + 1];
    };
    const int first = (need_prev && (r_lo & 2047) != 0) ? r_lo - 1 : r_lo, end = r_lo + rpw;
    load_in(first);
    for (int r = first; r < end; ++r) {
        float x[16];
        {
            const float w0 = nw0, w1 = nw1;
#pragma unroll
            for (int c = 0; c < 4; ++c) {
                const float a0[4] = {bflo(ny0[c].x), bfhi(ny0[c].x), bflo(ny0[c].y), bfhi(ny0[c].y)}, a1[4] = {bflo(ny1[c].x), bfhi(ny1[c].x), bflo(ny1[c].y), bfhi(ny1[c].y)};
                const float xr[4] = {bflo(nxr[c].x), bfhi(nxr[c].x), bflo(nxr[c].y), bfhi(nxr[c].y)};
#pragma unroll
                for (int i = 0; i < 4; ++i) x[c * 4 + i] = DN_ALPHA * xr[i] + (1.0f + gt[c * 4 + i]) * (w0 * a0[i] + w1 * a1[i]);
            }
        }
        if (r + 1 < end) load_in(r + 1);
        __builtin_amdgcn_sched_barrier(0);
        float s = 0.f, q = 0.f;
#pragma unroll
        for (int i = 0; i < 16; ++i) { s += x[i]; q += x[i] * x[i]; }
        s = wave_sum(s); q = wave_sum(q);
        const float mean = s * (1.0f / 1024.0f), rstd = rsqrtf(fmaxf(q * (1.0f / 1024.0f) - mean * mean, 0.f) + LN_EPS);
#pragma unroll
        for (int i = 0; i < 16; ++i) x[i] = (x[i] - mean) * rstd * lgn[i] + lbn[i];
        if (last) { row_store_f32(p.out + (size_t)r * 1024, x, lane); continue; }
        float h[16];
#pragma unroll
        for (int i = 0; i < 16; ++i) h[i] = x[i] * (1.0f + scn[i]) + shn[i];
        if (r >= r_lo) { row_store_bf16((bf16_t*)(p.ws + OFF_XRES2) + (size_t)r * 1024, x, lane); emit_next_l((bf16_t*)(p.ws + OFF_SLOT), p.in[6] + (size_t)njr * 6 * 1024, nk, r, h, hp, lane); }
#pragma unroll
        for (int i = 0; i < 16; ++i) hp[i] = h[i];
        if (((r + 1) & 2047) == 0) {
#pragma unroll
            for (int i = 0; i < 16; ++i) hp[i] = 0.f;
        }
    }
}
__device__ __forceinline__ void phase_ln1(PRef p, int L, char* lds, const bf16_t* ymix, bf16_t* hm) {
    const int t = tidx(), lane = t & 63, wid = t >> 6;
    const float* mod = (const float*)(p.ws + OFF_MOD);
    const bf16_t* xinb = (const bf16_t*)(p.ws + OFF_XRES2);
    bf16_t* xres = (bf16_t*)(p.ws + OFF_XRES);
    int* cnt = (int*)(p.ws + OFF_CNT) + L * 32;
    int* list = (int*)(p.ws + OFF_LIST);
    float* wgt = (float*)(p.ws + OFF_WGT);
    float* const HB = (float*)lds;
    float* const lg = (float*)(lds + 65536);
    const float* rtw = (const float*)(p.ws + OFF_RTW) + (size_t)L * 36 * 1024;
    const int rpb = NTOK / gridDim.x;
    const int bidx = (blockIdx.x * rpb) >> 11;
    float gt[16], lgn[16], lbn[16], sh2[16], sc2[16];
    row_load_f32(mod + ((size_t)(L * 2 + 0) * 8 + bidx) * 3072 + 2048, gt, lane);
    row_load_f32(p.in[4] + (L * 2 + 0) * 1024, lgn, lane); row_load_f32(p.in[5] + (L * 2 + 0) * 1024, lbn, lane);
    row_load_f32(mod + ((size_t)(L * 2 + 1) * 8 + bidx) * 3072, sh2, lane); row_load_f32(mod + ((size_t)(L * 2 + 1) * 8 + bidx) * 3072 + 1024, sc2, lane);
    for (int rb0 = blockIdx.x * rpb; rb0 < (blockIdx.x + 1) * rpb; rb0 += 16) {
        const int rb = rb0 + wid * 4;
        uint4 xr[4][4]; uint2 yr[4][4];
#pragma unroll
        for (int rr = 0; rr < 4; ++rr) {
            const int r = rb + rr;
#pragma unroll
            for (int c = 0; c < 4; ++c) {
                if (L == 0) xr[rr][c] = gld_u4(p.in[0] + (size_t)r * 1024 + c * 256 + lane * 4);
                else { const uint2 t2 = gld_u2(xinb + (size_t)r * 1024 + c * 256 + lane * 4); xr[rr][c] = make_uint4(t2.x, t2.y, 0u, 0u); }
                yr[rr][c] = gld_u2(ymix + (size_t)r * 1024 + c * 256 + lane * 4);
            }
        }
#pragma unroll
        for (int rr = 0; rr < 4; ++rr) {
            const int r = rb + rr;
            float x[16], h[16];
#pragma unroll
            for (int c = 0; c < 4; ++c) {
                float xv[4];
                if (L == 0) { xv[0] = __uint_as_float(xr[rr][c].x); xv[1] = __uint_as_float(xr[rr][c].y); xv[2] = __uint_as_float(xr[rr][c].z); xv[3] = __uint_as_float(xr[rr][c].w); }
                else { xv[0] = bflo(xr[rr][c].x); xv[1] = bfhi(xr[rr][c].x); xv[2] = bflo(xr[rr][c].y); xv[3] = bfhi(xr[rr][c].y); }
                const float yv[4] = {bflo(yr[rr][c].x), bfhi(yr[rr][c].x), bflo(yr[rr][c].y), bfhi(yr[rr][c].y)};
#pragma unroll
                for (int i = 0; i < 4; ++i) x[c * 4 + i] = DN_ALPHA * xv[i] + (1.0f + gt[c * 4 + i]) * yv[i];
            }
            float s = 0.f, q = 0.f;
#pragma unroll
            for (int i = 0; i < 16; ++i) { s += x[i]; q += x[i] * x[i]; }
            s = wave_sum(s); q = wave_sum(q);
            const float mean = s * (1.0f / 1024.0f), rstd = rsqrtf(fmaxf(q * (1.0f / 1024.0f) - mean * mean, 0.f) + LN_EPS);
#pragma unroll
            for (int i = 0; i < 16; ++i) { x[i] = (x[i] - mean) * rstd * lgn[i] + lbn[i]; h[i] = x[i] * (1.0f + sc2[i]) + sh2[i]; }
            row_store_bf16(xres + (size_t)r * 1024, x, lane);
            row_store_bf16(hm + (size_t)r * 1024, h, lane);
            row_store_f32_l(HB + (wid * 4 + rr) * 1024, h, lane);
        }
        __syncthreads();
#pragma unroll 1
        for (int q3 = 0; q3 < 9; q3 += 3) {
            float w[3][16];
#pragma unroll
            for (int u = 0; u < 3; ++u) row_load_f32(rtw + (size_t)(wid * 9 + q3 + u) * 1024, w[u], lane);
#pragma unroll 2
            for (int r16 = 0; r16 < 16; ++r16) {
                float h[16]; row_load_f32_l(HB + r16 * 1024, h, lane);
                float a3[3];
#pragma unroll
                for (int u = 0; u < 3; ++u) { f32x2_t s2 = {0.f, 0.f};
#pragma unroll
                    for (int i = 0; i < 8; ++i) { const f32x2_t hh = {h[2 * i], h[2 * i + 1]}, ww = {w[u][2 * i], w[u][2 * i + 1]}; s2 = __builtin_elementwise_fma(hh, ww, s2); }
                    a3[u] = s2.x + s2.y; }
                {
                    const auto r01 = __builtin_amdgcn_permlane32_swap(__float_as_uint(a3[0]), __float_as_uint(a3[1]), false, false);
                    const float z = __uint_as_float(r01[0]) + __uint_as_float(r01[1]);
                    const float c2 = xor32_add(a3[2]);
                    const auto rz = __builtin_amdgcn_permlane16_swap(__float_as_uint(z), __float_as_uint(c2), false, false);
                    const float tot = row16_sum(__uint_as_float(rz[0]) + __uint_as_float(rz[1]));
                    if ((lane & 15) == 0 && lane < 48) lg[r16 * 36 + wid * 9 + q3 + (lane == 0 ? 0 : lane == 32 ? 1 : 2)] = tot;
                }
            }
        }
        __syncthreads();
        if (t < 16) {
            const int row = rb0 + t; const float* l = lg + t * 36;
            float g[4]; for (int i = 0; i < 4; ++i) g[i] = l[i] + p.in[37][L * 4 + i];
            int gi = 0; for (int i = 1; i < 4; ++i) if (g[i] > g[gi]) gi = i;
            float gs = 0.f; for (int i = 0; i < 4; ++i) gs += __expf(g[i] - g[gi]);
            const float ggate = 1.0f / gs;
            float e[8]; for (int i = 0; i < 8; ++i) e[i] = l[4 + gi * 8 + i] + p.in[39][L * 32 + gi * 8 + i];
            int i0 = 0; for (int i = 1; i < 8; ++i) if (e[i] > e[i0]) i0 = i;
            int i1 = (i0 == 0) ? 1 : 0; for (int i = 0; i < 8; ++i) if (i != i0 && e[i] > e[i1]) i1 = i;
            const float p1 = __expf(e[i1] - e[i0]);
            const float w0 = ggate / (1.0f + p1), w1 = ggate * p1 / (1.0f + p1);
            const int e0 = gi * 8 + i0, e1 = gi * 8 + i1;
            const int pos0 = atomicAdd(&cnt[e0], 1), pos1 = atomicAdd(&cnt[e1], 1);
            list[e0 * LIST_CAP + pos0] = 2 * row; list[e1 * LIST_CAP + pos1] = 2 * row + 1;
            wgt[2 * row] = w0; wgt[2 * row + 1] = w1;
        }
        asm volatile("s_waitcnt lgkmcnt(0)" ::: "memory");
    }
}

__device__ __forceinline__ int perm64(int r) { return (r & 64) | (((r >> 2) & 3) << 4) | (((r >> 4) & 3) << 2) | (r & 3); }
__device__ __forceinline__ bool tile_permuted(int mode, int nt) { return (mode <= MODE_SIGM) || (mode == MODE_ML1 && nt < 24) || (mode == MODE_RT1 && nt >= 16); }
__device__ __forceinline__ void store16(bf16_t* d, const f32x4 (&v)[4]) {
    gst_u4(d, cvt_pk(v[0][0], v[0][1]), cvt_pk(v[0][2], v[0][3]), cvt_pk(v[1][0], v[1][1]), cvt_pk(v[1][2], v[1][3]));
    gst_u4(d + 8, cvt_pk(v[2][0], v[2][1]), cvt_pk(v[2][2], v[2][3]), cvt_pk(v[3][0], v[3][1]), cvt_pk(v[3][2], v[3][3]));
}
__device__ __forceinline__ void gemm_epilogue(PRef p, const GJob& jb, int mt, int nt, const f32x4 (&acc)[4][4]) {
    const int t_ = tidx(); const int lane = t_ & 63, wid = t_ >> 6, wr = wid >> 1, wc = wid & 1, fr = lane & 15, fq = lane >> 4;
    const int row0 = mt * 128 + wr * 64 + fr;
    if (jb.mode <= MODE_SIGM) {
        const int col = nt * 128 + wc * 64 + fq * 16;
        if (col < jb.N) {
#pragma unroll
            for (int m = 0; m < 4; ++m) {
                f32x4 v[4];
#pragma unroll
                for (int n = 0; n < 4; ++n) {
                    v[n] = acc[m][n];
                    if (jb.mode == MODE_TANH) { v[n][0] = tanhf_(v[n][0]); v[n][1] = tanhf_(v[n][1]); v[n][2] = tanhf_(v[n][2]); v[n][3] = tanhf_(v[n][3]); }
                    else if (jb.mode == MODE_SIGM) { v[n][0] = sigmoidf_(v[n][0]); v[n][1] = sigmoidf_(v[n][1]); v[n][2] = sigmoidf_(v[n][2]); v[n][3] = sigmoidf_(v[n][3]); }
                }
                store16(jb.out + (size_t)(row0 + m * 16) * jb.ldo + col, v);
            }
        }
    } else if (jb.mode == MODE_ML1) {
        if (nt < 24) {
            bf16_t* ob = (bf16_t*)(p.ws + OFF_SLOT + (size_t)(1 + (nt >> 3)) * SLOT);
            const bool sg = (nt >= 16);
            const int col = (nt & 7) * 128 + wc * 64 + fq * 16;
#pragma unroll
            for (int m = 0; m < 4; ++m) {
                f32x4 v[4];
#pragma unroll
                for (int n = 0; n < 4; ++n) {
                    v[n] = acc[m][n];
                    if (sg) { v[n][0] = sigmoidf_(v[n][0]); v[n][1] = sigmoidf_(v[n][1]); v[n][2] = sigmoidf_(v[n][2]); v[n][3] = sigmoidf_(v[n][3]); }
                }
                store16(ob + (size_t)(row0 + m * 16) * 1024 + col, v);
            }
        } else if (wc == 0) {
            float* gates = (float*)(p.ws + OFF_GATES);
            const float* bg = p.in[26];
            const int c0 = fq * 4;
#pragma unroll
            for (int m = 0; m < 4; ++m) {
                f32x4 v = acc[m][0], o;
#pragma unroll
                for (int j = 0; j < 4; ++j) { const float g = v[j] + bg[c0 + j]; o[j] = (c0 + j < 8) ? g : -softplusf_(-g); }
                gst_f4(gates + (size_t)(row0 + m * 16) * 16 + c0, o[0], o[1], o[2], o[3]);
            }
        }
    } else {
        if (nt < 16) {
            const float* rot = (const float*)(p.ws + OFF_ROT);
            bf16_t* ob = (bf16_t*)(p.ws + OFF_SLOT + (size_t)(1 + (nt >> 3)) * SLOT);
            const float scl = (nt >= 8) ? 0.0625f : 1.0f;
#pragma unroll
            for (int pp = 0; pp < 2; ++pp) {
                const int blk32 = (nt & 7) * 4 + wc * 2 + pp, head = blk32 >> 3, i0 = (blk32 & 7) * 16 + fq * 4;
                float4 rc0[4], rc1[4];
#pragma unroll
                for (int m = 0; m < 4; ++m) { const int tt = (row0 + m * 16) & 2047; rc0[m] = gld_f4(rot + ((size_t)tt * 128 + i0) * 2); rc1[m] = gld_f4(rot + ((size_t)tt * 128 + i0) * 2 + 4); }
#pragma unroll
                for (int m = 0; m < 4; ++m) {
                    const int row = row0 + m * 16;
                    const float4 c0 = rc0[m], c1 = rc1[m];
                    const float cs[4] = {c0.x, c0.z, c1.x, c1.z}, sn[4] = {c0.y, c0.w, c1.y, c1.w};
                    const f32x4 x1 = acc[m][2 * pp], x2 = acc[m][2 * pp + 1];
                    float o1[4], o2[4];
#pragma unroll
                    for (int j = 0; j < 4; ++j) { o1[j] = (x1[j] * cs[j] - x2[j] * sn[j]) * scl; o2[j] = (x1[j] * sn[j] + x2[j] * cs[j]) * scl; }
                    gst_u2(ob + (size_t)row * 1024 + head * 256 + i0, cvt_pk(o1[0], o1[1]), cvt_pk(o1[2], o1[3]));
                    gst_u2(ob + (size_t)row * 1024 + head * 256 + 128 + i0, cvt_pk(o2[0], o2[1]), cvt_pk(o2[2], o2[3]));
                }
            }
        } else {
            const bool isg = (nt >= 32);
            bf16_t* ob = (bf16_t*)(p.ws + OFF_SLOT + (size_t)(isg ? 5 : 3) * SLOT);
            const int col = (nt & 15) * 128 + wc * 64 + fq * 16;
#pragma unroll
            for (int m = 0; m < 4; ++m) {
                f32x4 v[4];
#pragma unroll
                for (int n = 0; n < 4; ++n) {
                    v[n] = acc[m][n];
                    if (isg) { v[n][0] = siluf_(v[n][0]); v[n][1] = siluf_(v[n][1]); v[n][2] = siluf_(v[n][2]); v[n][3] = siluf_(v[n][3]); }
                }
                store16(ob + (size_t)(row0 + m * 16) * 2048 + col, v);
            }
        }
    }
}
__device__ __forceinline__ void phase_gemm_jobs(PRef p, char* lds, int jlo, int jhi) {
    const int total = p.gj[jhi - 1].tile0 + 128 * p.gj[jhi - 1].ntn - p.gj[jlo].tile0;
    for (int id = blockIdx.x; id < total; id += gridDim.x) {
        int j = jlo; const int gid = id + p.gj[jlo].tile0;
        while (j + 1 < jhi && gid >= p.gj[j + 1].tile0) ++j;
        GJob jb; jb.A = p.gj[j].A; jb.Bt = p.gj[j].Bt; jb.out = p.gj[j].out; jb.K = p.gj[j].K; jb.N = p.gj[j].N; jb.ldo = p.gj[j].ldo; jb.mode = p.gj[j].mode; jb.ntn = p.gj[j].ntn; jb.tile0 = p.gj[j].tile0;
        jb.half = p.gj[j].half;
        int mt, nt; tile_map(gid - jb.tile0, jb.ntn, mt, nt);
        if (jb.half || (jb.mode == MODE_ML1 && nt == 24)) {
            const int t_ = tidx(), r0_ = t_ >> 3, co_ = glds_chunk(t_) * 8, ln_ = t_ & 63, wv_ = t_ >> 6, fr_ = ln_ & 15, fq_ = ln_ >> 4;
            const int cb = jb.half ? nt * 64 : nt * 128;
            int nvh = jb.N - cb; nvh = nvh > 64 ? 64 : nvh;
            const bf16_t* ar[4]; const bf16_t* brh[2];
#pragma unroll
            for (int i = 0; i < 4; ++i) ar[i] = jb.A + (size_t)(mt * 128 + r0_ + 32 * i) * jb.K + co_;
#pragma unroll
            for (int i = 0; i < 2; ++i) { int rb_ = r0_ + 32 * i; rb_ = jb.half ? perm64(rb_) : rb_; rb_ = rb_ < nvh ? rb_ : nvh - 1; brh[i] = jb.Bt + (size_t)(cb + rb_) * jb.K + co_; }
            f32x4 ah[2][4];
            gemm_hn(lds, jb.K / 64, ar, brh, ah);
            const int rowh = mt * 128 + wv_ * 32 + fr_;
            if (jb.half) {
                const int col = cb + fq_ * 16;
                if (col < jb.N) {
#pragma unroll
                    for (int m = 0; m < 2; ++m) {
                        f32x4 v[4];
#pragma unroll
                        for (int n = 0; n < 4; ++n) {
                            v[n] = ah[m][n];
#pragma unroll
                            for (int jj = 0; jj < 4; ++jj) v[n][jj] = (jb.mode == MODE_TANH) ? tanhf_(v[n][jj]) : (jb.mode == MODE_SIGM) ? sigmoidf_(v[n][jj]) : v[n][jj];
                        }
                        store16(jb.out + (size_t)(rowh + m * 16) * jb.ldo + col, v);
                    }
                }
            } else {
                float* gates = (float*)(p.ws + OFF_GATES);
                const float* bg = p.in[26];
                const int c0 = fq_ * 4;
                const float4 bq = gld_f4(bg + c0);
                const float bqa[4] = {bq.x, bq.y, bq.z, bq.w};
#pragma unroll
                for (int m = 0; m < 2; ++m) {
                    float o[4];
#pragma unroll
                    for (int jj = 0; jj < 4; ++jj) { const float g = ah[m][0][jj] + bqa[jj]; o[jj] = (c0 + jj < 8) ? g : -softplusf_(-g); }
                    gst_f4(gates + (size_t)(rowh + m * 16) * 16 + c0, o[0], o[1], o[2], o[3]);
                }
            }
            continue;
        }
        int nv = jb.N - nt * 128; nv = nv > 128 ? 128 : nv;
        const bf16_t* ar[4]; const bf16_t* br[4];
        {
            const int t_ = tidx(), r0_ = t_ >> 3, co_ = glds_chunk(t_) * 8;
            const bool pm_ = tile_permuted(jb.mode, nt);
#pragma unroll
            for (int i = 0; i < 4; ++i) {
                ar[i] = jb.A + (size_t)(mt * 128 + r0_ + 32 * i) * jb.K + co_;
                int rb_ = r0_ + 32 * i; rb_ = pm_ ? perm64(rb_) : rb_; rb_ = rb_ < nv ? rb_ : nv - 1;
                br[i] = jb.Bt + (size_t)(nt * 128 + rb_) * jb.K + co_;
            }
        }
        f32x4 acc[4][4];
        gemm_gg(lds, jb.K / 64, ar, br, acc);
        gemm_epilogue(p, jb, mt, nt, acc);
    }
}

constexpr int RM = 4;
template <int KL>
__device__ __forceinline__ void minigemm(const bf16_t* A, const bf16_t* Bt, int fr, int fq, f32x4 (&acc)[RM][4]) {
#pragma unroll
    for (int m = 0; m < RM; ++m)
#pragma unroll
        for (int n = 0; n < 4; ++n) acc[m][n] = (f32x4){0.f, 0.f, 0.f, 0.f};
#pragma unroll 2
    for (int ks = 0; ks < KL / 32; ++ks) {
        uint4 af[RM], bfm[4];
#pragma unroll
        for (int m = 0; m < RM; ++m) af[m] = gld_u4(A + (size_t)(m * 16 + fr) * KL + ks * 32 + fq * 8);
#pragma unroll
        for (int n = 0; n < 4; ++n) bfm[n] = gld_u4(Bt + (size_t)((fr >> 2) * 16 + n * 4 + (fr & 3)) * KL + ks * 32 + fq * 8);
#pragma unroll
        for (int m = 0; m < RM; ++m)
#pragma unroll
            for (int n = 0; n < 4; ++n) acc[m][n] = mfma16(bfm[n], af[m], acc[m][n]);
    }
}
__device__ __forceinline__ void phase_rw2(PRef p, int jr) {
    const int t_ = tidx(); const int lane = t_ & 63, wid = t_ >> 6, wr = wid >> 1, wc = wid & 1, fr = lane & 15, fq = lane >> 4;
    char* S = p.ws + OFF_SLOT;
    bf16_t* decayb = (bf16_t*)S; bf16_t* nkk = (bf16_t*)(S + 2 * SLOT); bf16_t* bb = (bf16_t*)(S + 3 * SLOT); bf16_t* gb = (bf16_t*)(S + 4 * SLOT);
    const bf16_t* rb = (const bf16_t*)(S + 6 * SLOT); const bf16_t* kb = (const bf16_t*)(S + 7 * SLOT); bf16_t* kpb = (bf16_t*)(S + 10 * SLOT);
    const bf16_t* vb = (const bf16_t*)(S + 8 * SLOT); bf16_t* vpb = (bf16_t*)(S + 9 * SLOT); const bf16_t* vf = (const bf16_t*)(S + 11 * SLOT);
    float* bonus = (float*)(p.ws + OFF_BONUS);
    const bf16_t* Lw = (const bf16_t*)(p.ws + OFF_LW); const bf16_t* La = (const bf16_t*)(p.ws + OFF_LA);
    const bf16_t* Lg = (const bf16_t*)(p.ws + OFF_LG); const bf16_t* Lv = (const bf16_t*)(p.ws + OFF_LV);
    const bf16_t* w2t = (const bf16_t*)(p.ws + W_W2T) + (size_t)jr * 1024 * 64; const bf16_t* a2t = (const bf16_t*)(p.ws + W_A2T) + (size_t)jr * 1024 * 64;
    const bf16_t* g2t = (const bf16_t*)(p.ws + W_G2T) + (size_t)jr * 1024 * 128; const bf16_t* v2t = (const bf16_t*)(p.ws + W_V2T);
    const float* w0 = p.in[8] + jr * 1024; const float* a0 = p.in[11] + jr * 1024; const float* v0 = p.in[14];
    const float* kkw = p.in[19] + jr * 1024; const float* kaw = p.in[20] + jr * 1024; const float* rk = p.in[21] + jr * 1024;
    for (int id2 = blockIdx.x; id2 < 128 * 8; id2 += gridDim.x) {
        int mt, nt; tile_map(id2, 8, mt, nt);
        const int row0 = mt * 128 + wr * 64, col0 = nt * 128 + wc * 64, head = nt * 2 + wc;
        f32x4 acc[RM][4];
        const int c0 = col0 + fq * 16;
        minigemm<64>(La + (size_t)row0 * 64, a2t + (size_t)col0 * 64, fr, fq, acc);
        float ss[RM], bs[RM];
#pragma unroll
        for (int m = 0; m < RM; ++m) { ss[m] = 0.f; bs[m] = 0.f; }
#pragma unroll
        for (int m = 0; m < RM; ++m) {
            const size_t off = (size_t)(row0 + m * 16 + fr) * 1024 + c0;
            const uint4 kq0 = *(const uint4*)(kb + off), kq1 = *(const uint4*)(kb + off + 8);
            const unsigned kw[8] = {kq0.x, kq0.y, kq0.z, kq0.w, kq1.x, kq1.y, kq1.z, kq1.w};
#pragma unroll
            for (int n = 0; n < 4; ++n) {
                const float4 a0v = *(const float4*)(a0 + c0 + n * 4), kkv = *(const float4*)(kkw + c0 + n * 4);
                const float a0a[4] = {a0v.x, a0v.y, a0v.z, a0v.w}, kka[4] = {kkv.x, kkv.y, kkv.z, kkv.w};
                const float kf4[4] = {bflo(kw[n * 2]), bfhi(kw[n * 2]), bflo(kw[n * 2 + 1]), bfhi(kw[n * 2 + 1])};
#pragma unroll
                for (int j = 0; j < 4; ++j) { acc[m][n][j] = sigmoidf_(a0a[j] + acc[m][n][j]); const float q = kf4[j] * kka[j]; ss[m] += q * q; }
            }
            asm volatile("" ::: "memory");
        }
#pragma unroll
        for (int m = 0; m < RM; ++m) { ss[m] = xor16_add(ss[m]); ss[m] = xor32_add(ss[m]); ss[m] = fminf(__builtin_amdgcn_rsqf(ss[m]), 1e12f); }
        float4 kkq[4], kaq[4], rkq[4];
#pragma unroll
        for (int n = 0; n < 4; ++n) { kkq[n] = gld_f4(kkw + c0 + n * 4); kaq[n] = gld_f4(kaw + c0 + n * 4); rkq[n] = gld_f4(rk + c0 + n * 4); }
#pragma unroll
        for (int m = 0; m < RM; ++m) {
            const size_t off = (size_t)(row0 + m * 16 + fr) * 1024 + c0;
            const uint4 rq0 = *(const uint4*)(rb + off), rq1 = *(const uint4*)(rb + off + 8), kq0 = *(const uint4*)(kb + off), kq1 = *(const uint4*)(kb + off + 8);
            const unsigned kw[8] = {kq0.x, kq0.y, kq0.z, kq0.w, kq1.x, kq1.y, kq1.z, kq1.w};
            const unsigned rw[8] = {rq0.x, rq0.y, rq0.z, rq0.w, rq1.x, rq1.y, rq1.z, rq1.w};
            unsigned okp[8], onk[8], obb[8];
#pragma unroll
            for (int n = 0; n < 4; ++n) {
                const float kka[4] = {kkq[n].x, kkq[n].y, kkq[n].z, kkq[n].w}, kaa[4] = {kaq[n].x, kaq[n].y, kaq[n].z, kaq[n].w}, rka[4] = {rkq[n].x, rkq[n].y, rkq[n].z, rkq[n].w};
                const float rf[4] = {bflo(rw[n * 2]), bfhi(rw[n * 2]), bflo(rw[n * 2 + 1]), bfhi(rw[n * 2 + 1])}, kf4[4] = {bflo(kw[n * 2]), bfhi(kw[n * 2]), bflo(kw[n * 2 + 1]), bfhi(kw[n * 2 + 1])};
                float kp[4], nk[4], b4[4];
#pragma unroll
                for (int j = 0; j < 4; ++j) {
                    const float a = acc[m][n][j], k = kf4[j], kn = k * kka[j] * ss[m];
                    kp[j] = k * (1.0f + (a - 1.0f) * kaa[j]); nk[j] = -kn; b4[j] = kn * a; bs[m] += rf[j] * kp[j] * rka[j];
                }
                okp[n * 2] = cvt_pk(kp[0], kp[1]); okp[n * 2 + 1] = cvt_pk(kp[2], kp[3]);
                onk[n * 2] = cvt_pk(nk[0], nk[1]); onk[n * 2 + 1] = cvt_pk(nk[2], nk[3]);
                obb[n * 2] = cvt_pk(b4[0], b4[1]); obb[n * 2 + 1] = cvt_pk(b4[2], b4[3]);
            }
            *(uint4*)(kpb + off) = make_uint4(okp[0], okp[1], okp[2], okp[3]); *(uint4*)(kpb + off + 8) = make_uint4(okp[4], okp[5], okp[6], okp[7]);
            *(uint4*)(nkk + off) = make_uint4(onk[0], onk[1], onk[2], onk[3]); *(uint4*)(nkk + off + 8) = make_uint4(onk[4], onk[5], onk[6], onk[7]);
            *(uint4*)(bb + off) = make_uint4(obb[0], obb[1], obb[2], obb[3]); *(uint4*)(bb + off + 8) = make_uint4(obb[4], obb[5], obb[6], obb[7]);
            asm volatile("" ::: "memory");
        }
#pragma unroll
        for (int m = 0; m < RM; ++m) { bs[m] = xor16_add(bs[m]); bs[m] = xor32_add(bs[m]); if (fq == 0) bonus[(size_t)(row0 + m * 16 + fr) * 16 + head] = bs[m]; }
        minigemm<64>(Lw + (size_t)row0 * 64, w2t + (size_t)col0 * 64, fr, fq, acc);
        float4 w0q[4];
#pragma unroll
        for (int n = 0; n < 4; ++n) w0q[n] = gld_f4(w0 + c0 + n * 4);
#pragma unroll
        for (int m = 0; m < RM; ++m) {
            unsigned od[8];
#pragma unroll
            for (int n = 0; n < 4; ++n) {
                const float w0a[4] = {w0q[n].x, w0q[n].y, w0q[n].z, w0q[n].w};
                float dd[4];
#pragma unroll
                for (int j = 0; j < 4; ++j) { const float wl = -softplusf_(-(w0a[j] + acc[m][n][j])) - 0.5f; dd[j] = 1.0f - __expf(-__expf(wl)); }
                od[n * 2] = cvt_pk(dd[0], dd[1]); od[n * 2 + 1] = cvt_pk(dd[2], dd[3]);
            }
            bf16_t* dp_ = decayb + (size_t)(row0 + m * 16 + fr) * 1024 + c0;
            *(uint4*)dp_ = make_uint4(od[0], od[1], od[2], od[3]); *(uint4*)(dp_ + 8) = make_uint4(od[4], od[5], od[6], od[7]);
        }
        minigemm<128>(Lg + (size_t)row0 * 128, g2t + (size_t)col0 * 128, fr, fq, acc);
#pragma unroll
        for (int m = 0; m < RM; ++m) {
            unsigned o[8];
#pragma unroll
            for (int n = 0; n < 4; ++n) { o[n * 2] = cvt_pk(acc[m][n][0], acc[m][n][1]); o[n * 2 + 1] = cvt_pk(acc[m][n][2], acc[m][n][3]); }
            bf16_t* d = gb + (size_t)(row0 + m * 16 + fr) * 1024 + c0;
            *(uint4*)d = make_uint4(o[0], o[1], o[2], o[3]); *(uint4*)(d + 8) = make_uint4(o[4], o[5], o[6], o[7]);
        }
        if (jr > 0) {
            minigemm<32>(Lv + (size_t)row0 * 32, v2t + (size_t)col0 * 32, fr, fq, acc);
#pragma unroll
            for (int m = 0; m < RM; ++m) {
                const size_t off = (size_t)(row0 + m * 16 + fr) * 1024 + c0;
                const uint4 vq0 = *(const uint4*)(vb + off), vq1 = *(const uint4*)(vb + off + 8), fq0 = *(const uint4*)(vf + off), fq1 = *(const uint4*)(vf + off + 8);
                const unsigned vw[8] = {vq0.x, vq0.y, vq0.z, vq0.w, vq1.x, vq1.y, vq1.z, vq1.w}, fw[8] = {fq0.x, fq0.y, fq0.z, fq0.w, fq1.x, fq1.y, fq1.z, fq1.w};
                unsigned o[8];
#pragma unroll
                for (int n = 0; n < 4; ++n) {
                    const float4 v0v = *(const float4*)(v0 + c0 + n * 4); const float v0a[4] = {v0v.x, v0v.y, v0v.z, v0v.w};
                    const float v4[4] = {bflo(vw[n * 2]), bfhi(vw[n * 2]), bflo(vw[n * 2 + 1]), bfhi(vw[n * 2 + 1])}, f4[4] = {bflo(fw[n * 2]), bfhi(fw[n * 2]), bflo(fw[n * 2 + 1]), bfhi(fw[n * 2 + 1])};
                    float o4[4];
#pragma unroll
                    for (int j = 0; j < 4; ++j) o4[j] = v4[j] + (f4[j] - v4[j]) * sigmoidf_(v0a[j] + acc[m][n][j]);
                    o[n * 2] = cvt_pk(o4[0], o4[1]); o[n * 2 + 1] = cvt_pk(o4[2], o4[3]);
                }
                *(uint4*)(vpb + off) = make_uint4(o[0], o[1], o[2], o[3]); *(uint4*)(vpb + off + 8) = make_uint4(o[4], o[5], o[6], o[7]);
            }
        }
    }
}
__device__ __forceinline__ void phase_rw3(PRef p, int jr, char* lds) {
    const int t = tidx(), lane = t & 63, wid = t >> 6, rowq = lane >> 4, jq = lane & 15;
    char* S = p.ws + OFF_SLOT;
    const float* decay = (const float*)S; const bf16_t* nkk = (const bf16_t*)(S + 2 * SLOT); const bf16_t* bb = (const bf16_t*)(S + 3 * SLOT);
    const bf16_t* rb = (const bf16_t*)(S + 6 * SLOT); const bf16_t* kb = (const bf16_t*)(S + 10 * SLOT);
    const bf16_t* vb = (const bf16_t*)(S + (jr == 0 ? 11 : 9) * SLOT); bf16_t* yb = (bf16_t*)(S + 5 * SLOT);
    float* buf = (float*)lds;
    float* ybuf = (float*)(lds + 2 * 16 * 336 * 4);
    for (int item = blockIdx.x; item < 512; item += gridDim.x) {
        const int bh = item >> 2, rg = item & 3, b = bh >> 4, h = bh & 15;
        const size_t base = (size_t)b * 2048 * 1024 + h * 64;
        const bf16_t* vecp[2]; int vdst[2];
#pragma unroll
        for (int u = 0; u < 2; ++u) {
            const int id = t + 256 * u, vec = id >> 7, rem = id & 127, step = rem >> 3, c8 = rem & 7;
            const bf16_t* bp = (vec == 0) ? nkk : (vec == 1) ? bb : (vec == 2) ? kb : rb;
            vecp[u] = bp + base + (size_t)step * 1024 + c8 * 8; vdst[u] = step * 336 + 64 + vec * 64 + c8 * 8;
        }
        const float* dp = decay + base + (size_t)(t >> 4) * 1024 + (t & 15) * 4; const int ddst = (t >> 4) * 336 + (t & 15) * 4;
        const bf16_t* vp = vb + base + (size_t)(t >> 1) * 1024 + rg * 16 + (t & 1) * 8; const int vvdst = (t >> 1) * 336 + 320 + (t & 1) * 8;
        uint4 g0, g1, gv; float4 gd;
        auto fetch = [&](int ch) {
            const size_t o = (size_t)ch * 16 * 1024;
            g0 = gload16(vecp[0] + o); g1 = gload16(vecp[1] + o);
            { const uint4 d_ = gload16(dp + o); gd = make_float4(__uint_as_float(d_.x), __uint_as_float(d_.y), __uint_as_float(d_.z), __uint_as_float(d_.w)); }
            if (t < 32) gv = gload16(vp + o);
        };
        auto stash = [&](float* bf) {
            float f[8];
            unpack8(g0, f); *(float4*)(bf + vdst[0]) = make_float4(f[0], f[1], f[2], f[3]); *(float4*)(bf + vdst[0] + 4) = make_float4(f[4], f[5], f[6], f[7]);
            unpack8(g1, f); *(float4*)(bf + vdst[1]) = make_float4(f[0], f[1], f[2], f[3]); *(float4*)(bf + vdst[1] + 4) = make_float4(f[4], f[5], f[6], f[7]);
            *(float4*)(bf + ddst) = gd;
            if (t < 32) { unpack8(gv, f); *(float4*)(bf + vvdst) = make_float4(f[0], f[1], f[2], f[3]); *(float4*)(bf + vvdst + 4) = make_float4(f[4], f[5], f[6], f[7]); }
        };
        float s0 = 0.f, s1 = 0.f, s2 = 0.f, s3 = 0.f;
        __syncthreads();
        fetch(0); stash(buf); __syncthreads();
        for (int ch = 0; ch < 128; ++ch) {
            if (ch + 1 < 128) fetch(ch + 1);
            const float* bf = buf + (ch & 1) * (16 * 336); float* yb_ = ybuf + (ch & 1) * 256;
            float ykeep = 0.f;
            const float* q0 = bf + jq * 4; const float* v0p = bf + 320 + wid * 4 + rowq;
            float4 nw = *(const float4*)q0, na = *(const float4*)(q0 + 64), nb2 = *(const float4*)(q0 + 128), nk = *(const float4*)(q0 + 192), nr = *(const float4*)(q0 + 256);
            float nv = v0p[0];
#pragma unroll 4
            for (int s = 0; s < 16; ++s) {
                const float4 w = nw, a = na, bq = nb2, k = nk, r = nr; const float vv = nv;
                const float* q = q0 + (s + 1) * 336;
                nw = *(const float4*)q; na = *(const float4*)(q + 64); nb2 = *(const float4*)(q + 128); nk = *(const float4*)(q + 192); nr = *(const float4*)(q + 256);
                nv = v0p[(s + 1) * 336];
                __builtin_amdgcn_sched_barrier(0);
                float sa = s0 * a.x; sa = fmaf(s1, a.y, sa); sa = fmaf(s2, a.z, sa); sa = fmaf(s3, a.w, sa);
                sa = row16_sum(sa);
                s0 = fmaf(s0, w.x, fmaf(sa, bq.x, vv * k.x)); s1 = fmaf(s1, w.y, fmaf(sa, bq.y, vv * k.y));
                s2 = fmaf(s2, w.z, fmaf(sa, bq.z, vv * k.z)); s3 = fmaf(s3, w.w, fmaf(sa, bq.w, vv * k.w));
                float y = s0 * r.x; y = fmaf(s1, r.y, y); y = fmaf(s2, r.z, y); y = fmaf(s3, r.w, y);
                y = row16_sum(y);
                ykeep = (jq == s) ? y : ykeep;
            }
            yb_[jq * 16 + wid * 4 + rowq] = ykeep;
            if (ch + 1 < 128) stash(buf + ((ch + 1) & 1) * (16 * 336));
            __syncthreads();
            if (t < 32) { const int step = t >> 1, hf = t & 1; float f[8];
#pragma unroll
                for (int i = 0; i < 8; ++i) f[i] = yb_[step * 16 + hf * 8 + i];
                *(uint4*)(yb + base + (size_t)(ch * 16 + step) * 1024 + rg * 16 + hf * 8) = pack8(f); }
        }
    }
}
__device__ __forceinline__ uint2 lds_tr16(const char* p) {
    typedef short v4s_t __attribute__((ext_vector_type(4)));
    const v4s_t r = __builtin_amdgcn_ds_read_tr16_b64_v4i16((LAS v4s_t*)p);
    uint2 u; __builtin_memcpy(&u, &r, 8); return u;
}
__device__ __forceinline__ int sw64(int row, int col) { return row * 128 + ((((col >> 3) ^ (row & 7))) << 4) + (col & 7) * 2; }
__device__ __forceinline__ void phase_rw3c(PRef p, int jr, char* lds) {
    const int t = tidx(), lane = t & 63, w = t >> 6, fr = lane & 15, fq = lane >> 4;
    char* S = p.ws + OFF_SLOT;
    const float* decay = (const float*)S; const bf16_t* nkk = (const bf16_t*)(S + 2 * SLOT); const bf16_t* bb = (const bf16_t*)(S + 3 * SLOT);
    const bf16_t* rb = (const bf16_t*)(S + 6 * SLOT); const bf16_t* kb = (const bf16_t*)(S + 10 * SLOT);
    const bf16_t* vb = (const bf16_t*)(S + (jr == 0 ? 11 : 9) * SLOT); bf16_t* yb = (bf16_t*)(S + 5 * SLOT);
    char* const AT = lds;              char* const RT = lds + 4096;  char* const BT = lds + 8192;  char* const KT = lds + 12288;
    float* const PL = (float*)(lds + 16384);
    float* const GAB = (float*)(lds + 43264);
    char* const GAK = lds + 28672;     char* const GRB = lds + 30720; char* const GRK = lds + 32768;
    char* const VT = lds + 34816;      char* const UT = lds + 35840;
    char* const SB = lds + 36864;
    float* const XL = (float*)(lds + 38912);
    float* const PC = (float*)(lds + 40960);
    float* const GS = (float*)(lds + 41216);
    bf16_t* const YB = (bf16_t*)(lds + 42240);
    const int pj = t & 63, ptg = t >> 6;
    const int tk = t >> 3, ck = t & 7;
    const int vtau = t >> 3, vi2 = (t & 7) * 2;
    const int qq = fr >> 2, pp = fr & 3;
    for (int item = blockIdx.x; item < 512; item += gridDim.x) {
        const int bh = ((item >> 3) >> 2) * 8 + (item & 7), rg = (item >> 3) & 3, b = bh >> 4, h = bh & 15;
        const size_t base = (size_t)b * 2048 * 1024 + h * 64;
        __syncthreads();
        for (int i = t; i < 128; i += 256) *(uint4*)(SB + i * 16) = make_uint4(0u, 0u, 0u, 0u);
        f32x4 Sacc = (f32x4){0.f, 0.f, 0.f, 0.f};
        bf16_t gwr[8]; uint4 ra, rb4, rk, rr, rw0, rw1; unsigned gvv = 0;
        auto fetch = [&](int c) {
#pragma unroll
            for (int s2 = 0; s2 < 8; ++s2) gwr[s2] = *(const __attribute__((address_space(1))) bf16_t*)((const bf16_t*)decay + base + (size_t)(c * 32 + ptg * 8 + s2) * 1024 + pj);
            const size_t o = base + (size_t)(c * 32 + tk) * 1024 + ck * 8;
            ra = gload16(nkk + o); rb4 = gload16(bb + o); rk = gload16(kb + o); rr = gload16(rb + o); rw0 = gload16((const bf16_t*)decay + o);
            gvv = *(const __attribute__((address_space(1))) unsigned*)(vb + base + (size_t)(c * 32 + vtau) * 1024 + rg * 16 + vi2);
        };
        fetch(0);
        for (int c = 0; c < 64; ++c) {
            {
                float cum[8]; float run = 1.f;
#pragma unroll
                for (int s2 = 0; s2 < 8; ++s2) { run *= 1.0f - bf2f(gwr[s2]); cum[s2] = run; }
                GS[ptg * 64 + pj] = run;
                __syncthreads();
                const float g0 = GS[pj], g1 = GS[64 + pj], g2 = GS[128 + pj], g3 = GS[192 + pj];
                const float off = (ptg > 0 ? g0 : 1.f) * (ptg > 1 ? g1 : 1.f) * (ptg > 2 ? g2 : 1.f);
                if (ptg == 0) PC[pj] = (g0 * g1) * (g2 * g3);
#pragma unroll
                for (int s2 = 0; s2 < 8; ++s2) PL[(ptg * 8 + s2) * 64 + pj] = off * cum[s2];
            }
            __syncthreads();
            {
                const float4 p0 = *(const float4*)(PL + tk * 64 + ck * 8), p1 = *(const float4*)(PL + tk * 64 + ck * 8 + 4);
                const unsigned ua[4] = {ra.x, ra.y, ra.z, ra.w}, ub[4] = {rb4.x, rb4.y, rb4.z, rb4.w}, uk[4] = {rk.x, rk.y, rk.z, rk.w}, ur[4] = {rr.x, rr.y, rr.z, rr.w};
                const f32x2_t Pp[4] = {{p0.x, p0.y}, {p0.z, p0.w}, {p1.x, p1.y}, {p1.z, p1.w}};
                const f32x2_t Wp[4] = {{1.0f - bflo(rw0.x), 1.0f - bfhi(rw0.x)}, {1.0f - bflo(rw0.y), 1.0f - bfhi(rw0.y)}, {1.0f - bflo(rw0.z), 1.0f - bfhi(rw0.z)}, {1.0f - bflo(rw0.w), 1.0f - bfhi(rw0.w)}};
                unsigned oa[4], orr[4], ob[4], ok[4];
#pragma unroll
                for (int i = 0; i < 4; ++i) {
                    const f32x2_t ei = {__builtin_amdgcn_rcpf(Pp[i].x), __builtin_amdgcn_rcpf(Pp[i].y)};
                    const f32x2_t rw = {__builtin_amdgcn_rcpf(Wp[i].x), __builtin_amdgcn_rcpf(Wp[i].y)};
                    const f32x2_t ex = Pp[i] * rw;
                    const f32x2_t va = {__uint_as_float(ua[i] << 16), __uint_as_float(ua[i] & 0xffff0000u)}, vr = {__uint_as_float(ur[i] << 16), __uint_as_float(ur[i] & 0xffff0000u)};
                    const f32x2_t vb2 = {__uint_as_float(ub[i] << 16), __uint_as_float(ub[i] & 0xffff0000u)}, vk = {__uint_as_float(uk[i] << 16), __uint_as_float(uk[i] & 0xffff0000u)};
                    const f32x2_t xa = va * ex, xr = vr * Pp[i], xb = vb2 * ei, xk = vk * ei;
                    oa[i] = cvt_pk(xa.x, xa.y); orr[i] = cvt_pk(xr.x, xr.y); ob[i] = cvt_pk(xb.x, xb.y); ok[i] = cvt_pk(xk.x, xk.y);
                }
                const int o = tk * 128 + ((ck ^ (tk & 7)) << 4);
                *(uint4*)(AT + o) = make_uint4(oa[0], oa[1], oa[2], oa[3]); *(uint4*)(RT + o) = make_uint4(orr[0], orr[1], orr[2], orr[3]);
                *(uint4*)(BT + o) = make_uint4(ob[0], ob[1], ob[2], ob[3]); *(uint4*)(KT + o) = make_uint4(ok[0], ok[1], ok[2], ok[3]);
                *(bf16_t*)(VT + vi2 * 64 + vtau * 2) = (bf16_t)(gvv & 0xffffu);
                *(bf16_t*)(VT + (vi2 + 1) * 64 + vtau * 2) = (bf16_t)(gvv >> 16);
            }
            if (c + 1 < 64) fetch(c + 1);
            __syncthreads();
            {
                const char* Mt = (w < 2) ? AT : RT; const char* Nt = (w & 1) ? BT : KT;
                f32x4 g[2][2];
#pragma unroll
                for (int m = 0; m < 2; ++m) { g[m][0] = (f32x4){0.f, 0.f, 0.f, 0.f}; g[m][1] = (f32x4){0.f, 0.f, 0.f, 0.f}; }
#pragma unroll
                for (int ks = 0; ks < 2; ++ks) {
                    const int chs = ((ks * 4 + fq) ^ (fr & 7)) << 4;
                    uint4 mf[2], nf[2];
#pragma unroll
                    for (int m = 0; m < 2; ++m) { mf[m] = *(const uint4*)(Mt + (m * 16 + fr) * 128 + chs); nf[m] = *(const uint4*)(Nt + (m * 16 + fr) * 128 + chs); }
#pragma unroll
                    for (int m = 0; m < 2; ++m)
#pragma unroll
                        for (int n = 0; n < 2; ++n) g[m][n] = mfma16(nf[n], mf[m], g[m][n]);
                }
#pragma unroll
                for (int m = 0; m < 2; ++m)
#pragma unroll
                    for (int n = 0; n < 2; ++n) {
                        const int tt = m * 16 + fr, tau0 = n * 16 + fq * 4;
                        f32x4 v4;
#pragma unroll
                        for (int j = 0; j < 4; ++j) { const int tau = tau0 + j; const bool keep = (w < 2) ? (tau < tt) : (tau <= tt); v4[j] = keep ? g[m][n][j] : 0.f; }
                        if (w == 1) *(f32x4*)(GAB + tt * 36 + tau0) = v4;
                        else {
                            char* G = (w == 0) ? GAK : (w == 2) ? GRK : GRB;
                            uint2 o; o.x = cvt_pk(v4[0], v4[1]); o.y = cvt_pk(v4[2], v4[3]);
                            *(uint2*)(G + tt * 64 + tau0 * 2) = o;
                        }
                    }
            }
            __syncthreads();
            if (w < 2) {
                f32x4 x = (f32x4){0.f, 0.f, 0.f, 0.f};
#pragma unroll
                for (int ks = 0; ks < 2; ++ks) {
                    const int chs = ((ks * 4 + fq) ^ (fr & 7)) << 4;
                    x = mfma16(*(const uint4*)(AT + (w * 16 + fr) * 128 + chs), *(const uint4*)(SB + fr * 128 + chs), x);
                }
                x = mfma16(*(const uint4*)(GAK + (w * 16 + fr) * 64 + fq * 16), *(const uint4*)(VT + fr * 64 + fq * 16), x);
                *(f32x4*)(XL + fr * 32 + w * 16 + fq * 4) = x;
            }
            __syncthreads();
            {
                const int tl = lane & 31;
                float Gr[32];
#pragma unroll
                for (int q4 = 0; q4 < 8; ++q4) { const float4 g4 = *(const float4*)(GAB + tl * 36 + q4 * 4); Gr[q4 * 4] = g4.x; Gr[q4 * 4 + 1] = g4.y; Gr[q4 * 4 + 2] = g4.z; Gr[q4 * 4 + 3] = g4.w; }
                float acc[4];
#pragma unroll
                for (int r = 0; r < 4; ++r) acc[r] = XL[(4 * w + r) * 32 + tl];
#pragma unroll
                for (int tau = 0; tau < 31; ++tau)
#pragma unroll
                    for (int r = 0; r < 4; ++r) acc[r] = fmaf(__int_as_float(__builtin_amdgcn_readlane(__float_as_int(acc[r]), tau)), Gr[tau], acc[r]);
                if (lane < 32) {
#pragma unroll
                    for (int r = 0; r < 4; ++r) *(bf16_t*)(UT + (4 * w + r) * 64 + tl * 2) = f2bf(acc[r]);
                }
            }
            __syncthreads();
            if (w < 2) {
                f32x4 y = (f32x4){0.f, 0.f, 0.f, 0.f};
#pragma unroll
                for (int ks = 0; ks < 2; ++ks) {
                    const int chs = ((ks * 4 + fq) ^ (fr & 7)) << 4;
                    y = mfma16(*(const uint4*)(RT + (w * 16 + fr) * 128 + chs), *(const uint4*)(SB + fr * 128 + chs), y);
                }
                y = mfma16(*(const uint4*)(GRB + (w * 16 + fr) * 64 + fq * 16), *(const uint4*)(UT + fr * 64 + fq * 16), y);
                y = mfma16(*(const uint4*)(GRK + (w * 16 + fr) * 64 + fq * 16), *(const uint4*)(VT + fr * 64 + fq * 16), y);
#pragma unroll
                for (int j = 0; j < 4; ++j) YB[(w * 16 + fq * 4 + j) * 16 + fr] = f2bf(y[j]);
            }
            {
                const int r0 = fq * 8 + qq, kc = 2 * w + (pp >> 1);
                const int o0 = r0 * 128 + ((kc ^ (r0 & 7)) << 4) + (pp & 1) * 8, o1 = (r0 + 4) * 128 + ((kc ^ ((r0 + 4) & 7)) << 4) + (pp & 1) * 8;
                const uint2 blo = lds_tr16(BT + o0), bhi = lds_tr16(BT + o1), klo = lds_tr16(KT + o0), khi = lds_tr16(KT + o1);
                Sacc = mfma16(make_uint4(blo.x, blo.y, bhi.x, bhi.y), *(const uint4*)(UT + fr * 64 + fq * 16), Sacc);
                Sacc = mfma16(make_uint4(klo.x, klo.y, khi.x, khi.y), *(const uint4*)(VT + fr * 64 + fq * 16), Sacc);
                const float4 pc = *(const float4*)(PC + 16 * w + fq * 4);
                Sacc[0] *= pc.x; Sacc[1] *= pc.y; Sacc[2] *= pc.z; Sacc[3] *= pc.w;
            }
            __syncthreads();
            {
                uint2 o; o.x = cvt_pk(Sacc[0], Sacc[1]); o.y = cvt_pk(Sacc[2], Sacc[3]);
                *(uint2*)(SB + fr * 128 + ((((2 * w + (fq >> 1))) ^ (fr & 7)) << 4) + (fq & 1) * 8) = o;
                if (t < 64) {
                    const int tt = t >> 1, hf = t & 1;
                    const uint4 yv_ = *(const uint4*)((const char*)YB + tt * 32 + hf * 16); const u32x4_t yx_ = {yv_.x, yv_.y, yv_.z, yv_.w};
                    *(__attribute__((address_space(1))) u32x4_t*)(yb + base + (size_t)(c * 32 + tt) * 1024 + rg * 16 + hf * 8) = yx_;
                }
            }
        }
    }
}
struct LdRw4 {
    struct Raw { uint4 y, v, g; float bn; };
    const bf16_t *y, *v, *g; const float *bonus, *gng, *gnb;
    __device__ __forceinline__ Raw fetch(int, int r, int kc) const {
        Raw q; const size_t o = (size_t)r * 1024 + kc * 8;
        q.y = *(const uint4*)(y + o); q.v = *(const uint4*)(v + o); q.g = *(const uint4*)(g + o); q.bn = bonus[r * 16 + (kc >> 3)]; return q;
    }
    __device__ __forceinline__ uint4 finish(const Raw& q, int, int, int kc) const {
        float yf[8], vf[8], gf[8]; unpack8(q.y, yf); unpack8(q.v, vf); unpack8(q.g, gf);
        float s = 0.f, s2 = 0.f;
#pragma unroll
        for (int i = 0; i < 8; ++i) { s += yf[i]; s2 += yf[i] * yf[i]; }
        s = oct_sum(s); s2 = oct_sum(s2);
        const float mean = s * (1.0f / 64.0f), var = fmaxf(s2 * (1.0f / 64.0f) - mean * mean, 0.f), rstd = rsqrtf(var + 64e-5f);
        const float4 ga = *(const float4*)(gng + kc * 8), gb = *(const float4*)(gng + kc * 8 + 4), ba = *(const float4*)(gnb + kc * 8), bb = *(const float4*)(gnb + kc * 8 + 4);
        const float gg[8] = {ga.x, ga.y, ga.z, ga.w, gb.x, gb.y, gb.z, gb.w}, bq[8] = {ba.x, ba.y, ba.z, ba.w, bb.x, bb.y, bb.z, bb.w};
        float o[8];
#pragma unroll
        for (int i = 0; i < 8; ++i) o[i] = ((yf[i] - mean) * rstd * gg[i] + bq[i] + q.bn * vf[i]) * gf[i];
        return pack8(o);
    }
};
__device__ __forceinline__ void phase_rw4(PRef p, int jr, char* lds) {
    char* S = p.ws + OFF_SLOT;
    const bf16_t* yb = (const bf16_t*)(S + 5 * SLOT); const bf16_t* gb = (const bf16_t*)(S + 4 * SLOT);
    const bf16_t* vb = (const bf16_t*)(S + (jr == 0 ? 11 : 9) * SLOT); bf16_t* ymix = (bf16_t*)(S + 6 * SLOT);
    const bf16_t* wt = (const bf16_t*)(p.ws + W_OUT) + (size_t)jr * 1024 * 1024;
    const float* bonus = (const float*)(p.ws + OFF_BONUS);
    const int t_ = tidx(); const int lane = t_ & 63, wid = t_ >> 6, wr = wid >> 1, wc = wid & 1, fr = lane & 15, fq = lane >> 4;
    for (int id = blockIdx.x; id < 128 * 8; id += gridDim.x) {
        int mt, nt; tile_map(id, 8, mt, nt);
        const size_t ro = (size_t)mt * 128 * 1024;
        LdRw4 al{yb + ro, vb + ro, gb + ro, bonus + (size_t)mt * 128 * 16, p.in[22] + jr * 1024, p.in[23] + jr * 1024};
        const bf16_t* br[4];
        { const int t2_ = tidx(), r0_ = t2_ >> 3, co_ = glds_chunk(t2_) * 8;
#pragma unroll
          for (int i = 0; i < 4; ++i) br[i] = wt + (size_t)(nt * 128 + r0_ + 32 * i) * 1024 + co_; }
        f32x4 acc[4][4];
        gemm_rg(lds, 16, al, br, acc);
#pragma unroll
        for (int n = 0; n < 4; ++n)
#pragma unroll
            for (int m = 0; m < 4; ++m) {
                uint2 o; o.x = cvt_pk(acc[m][n][0], acc[m][n][1]); o.y = cvt_pk(acc[m][n][2], acc[m][n][3]);
                *(uint2*)(ymix + (size_t)(mt * 128 + wr * 64 + m * 16 + fr) * 1024 + nt * 128 + wc * 64 + n * 16 + fq * 4) = o;
            }
    }
}

__device__ __forceinline__ void phase_cml(PRef p) {
    const int t = tidx();
    char* S = p.ws + OFF_SLOT;
    const bf16_t* src = (const bf16_t*)(S + 1 * SLOT); bf16_t* dst = (bf16_t*)(S + 8 * SLOT);
    const int col = (t & 127) * 8, half = t >> 7;
    float cw[4][8], cb[8];
#pragma unroll
    for (int j = 0; j < 4; ++j) {
        const float4 a = *(const float4*)(p.in[27] + j * 1024 + col), b = *(const float4*)(p.in[27] + j * 1024 + col + 4);
        cw[j][0] = a.x; cw[j][1] = a.y; cw[j][2] = a.z; cw[j][3] = a.w; cw[j][4] = b.x; cw[j][5] = b.y; cw[j][6] = b.z; cw[j][7] = b.w;
    }
    { const float4 a = *(const float4*)(p.in[28] + col), b = *(const float4*)(p.in[28] + col + 4);
      cb[0] = a.x; cb[1] = a.y; cb[2] = a.z; cb[3] = a.w; cb[4] = b.x; cb[5] = b.y; cb[6] = b.z; cb[7] = b.w; }
    const float qs = (col < 512) ? 0.125f : 1.0f;
    for (int item = blockIdx.x; item < 1024; item += gridDim.x) {
        const int b = item >> 7, s0 = (item & 127) * 16 + half * 8;
        const bf16_t* base = src + (size_t)b * 2048 * 1024 + col;
        uint4 r[11];
#pragma unroll
        for (int i = 0; i < 11; ++i) { const int sr = s0 - 3 + i; r[i] = gload16(base + (size_t)max(sr, 0) * 1024); if (sr < 0) r[i] = make_uint4(0u, 0u, 0u, 0u); }
        float x0[8], x1[8], x2[8];
        unpack8(r[0], x0); unpack8(r[1], x1); unpack8(r[2], x2);
#pragma unroll
        for (int i = 0; i < 8; ++i) {
            float x3[8], a[8]; unpack8(r[i + 3], x3);
#pragma unroll
            for (int e = 0; e < 8; ++e) { a[e] = cb[e] + cw[0][e] * x0[e] + cw[1][e] * x1[e] + cw[2][e] * x2[e] + cw[3][e] * x3[e]; a[e] = siluf_(a[e]) * qs; }
            *(uint4*)(dst + ((size_t)b * 2048 + s0 + i) * 1024 + col) = pack8(a);
#pragma unroll
            for (int e = 0; e < 8; ++e) { x0[e] = x1[e]; x1[e] = x2[e]; x2[e] = x3[e]; }
        }
    }
}
__device__ __forceinline__ void phase_ml2(PRef p, char* lds) {
    const int t = tidx(), lane = t & 63, w = t >> 6, fr = lane & 15, fq = lane >> 4;
    char* S = p.ws + OFF_SLOT;
    const bf16_t* qk = (const bf16_t*)(S + 8 * SLOT); const bf16_t* vb = (const bf16_t*)(S + 2 * SLOT); bf16_t* yb = (bf16_t*)(S + 4 * SLOT);
    const float* gates = (const float*)(p.ws + OFF_GATES); float* stat = (float*)(p.ws + OFF_STAT);
    char* const RAW = lds;
    char* const QT = lds + 17408; char* const KT = lds + 25600;
    char* const VT = lds + 33792;
    char* const VX = lds + 35840;
    char* const PB = lds + 39936;
    char* const CT = lds + 48128;
    float* const FS = (float*)(lds + 52224); float* const GJ = FS + 64; float* const WJ = FS + 128;
    float* const CW = (float*)(lds + 53248);
    const int qq = fr >> 2, pp = fr & 3;
    for (int item = blockIdx.x; item < 512; item += gridDim.x) {
        const int bh = ((item >> 3) >> 3) * 8 + (item & 7), vs = (item >> 3) & 7, b = bh >> 3, hd = bh & 7;
        const size_t tok0 = (size_t)b * 2048;
        __syncthreads();
        for (int i = t; i < 256; i += 256) *(uint4*)(CT + i * 16) = make_uint4(0u, 0u, 0u, 0u);
        f32x4 Cacc[2] = {(f32x4){0.f, 0.f, 0.f, 0.f}, (f32x4){0.f, 0.f, 0.f, 0.f}};
        uint4 gr0, gr1, gr2, gr3; uint4 gv = make_uint4(0u, 0u, 0u, 0u); float gg = 0.f;
        const int frr = t >> 4, fc = t & 15;
        const bf16_t* const qkt = qk + (tok0 + frr) * 1024 + (fc >> 3) * 512 + hd * 64 + (fc & 7) * 8;
        char* const qkd = ((fc < 8) ? QT : KT) + frr * 128 + (((fc & 7) ^ (frr & 7)) << 4);
        auto fetch = [&](int ch) {
            const int s0 = ch * 64;
            const bf16_t* q0 = qkt + (size_t)s0 * 1024;
            gr0 = gload16(q0); gr1 = gload16(q0 + 16 * 1024); gr2 = gload16(q0 + 32 * 1024); gr3 = gload16(q0 + 48 * 1024);
            if (t < 128) { gv = gload16(vb + (tok0 + s0 + (t >> 1)) * 1024 + hd * 128 + vs * 16 + (t & 1) * 8);
                           gg = *(const __attribute__((address_space(1))) float*)(gates + (tok0 + s0 + (t & 63)) * 16 + (t >> 6) * 8 + hd); }
        };
        fetch(0);
        for (int ch = 0; ch < 32; ++ch) {
            const int s0 = ch * 64;
            *(uint4*)qkd = gr0; *(uint4*)(qkd + 16 * 128) = gr1; *(uint4*)(qkd + 32 * 128) = gr2; *(uint4*)(qkd + 48 * 128) = gr3;
            if (t < 128) *(uint4*)(VT + t * 16) = gv;
            float vf8[8]; unpack8(gv, vf8);
            if (t >= 64 && t < 128) GJ[t - 64] = gg;
            const float ggc = gg;
            if (ch + 1 < 32) fetch(ch + 1);
            __syncthreads();
            if (t < 64) {
                float f = GJ[t];
                f += __builtin_amdgcn_update_dpp(0.f, f, 0x111, 0xf, 0xf, false);
                f += __builtin_amdgcn_update_dpp(0.f, f, 0x112, 0xf, 0xf, false);
                f += __builtin_amdgcn_update_dpp(0.f, f, 0x114, 0xf, 0xf, false);
                f += __builtin_amdgcn_update_dpp(0.f, f, 0x118, 0xf, 0xf, false);
                f += __builtin_amdgcn_update_dpp(0.f, f, 0x142, 0xa, 0xf, false);
                f += __builtin_amdgcn_update_dpp(0.f, f, 0x143, 0xc, 0xf, false);
                const float fend = __int_as_float(__builtin_amdgcn_readlane(__float_as_int(f), 63));
                FS[t] = f; WJ[t] = __expf(fend - f + ggc);
                GJ[t] = ggc - f;
            }
            __syncthreads();
            const float efend = __expf(FS[63]);
            {
                if (t < 128) {
                    const int j = t >> 1; const float wj = WJ[j];
                    float f[8];
#pragma unroll
                    for (int i = 0; i < 8; ++i) f[i] = vf8[i] * wj;
                    *(uint4*)(VX + j * 64 + (t & 1) * 16) = pack8(f);
                    float g8[8] = {0.f, 0.f, 0.f, 0.f, 0.f, 0.f, 0.f, 0.f}; if ((t & 1) == 0) g8[0] = wj;
                    *(uint4*)(VX + j * 64 + 32 + (t & 1) * 16) = pack8(g8);
                }
            }
            __syncthreads();
            const int srow = 16 * w + fr;
            f32x4 Sacc[4], Xacc[2];
#pragma unroll
            for (int n = 0; n < 4; ++n) Sacc[n] = (f32x4){0.f, 0.f, 0.f, 0.f};
            Xacc[0] = (f32x4){0.f, 0.f, 0.f, 0.f}; Xacc[1] = (f32x4){0.f, 0.f, 0.f, 0.f};
            Cacc[0] *= efend; Cacc[1] *= efend;
#pragma unroll
            for (int ks = 0; ks < 2; ++ks) {
                const int chs = ((ks * 4 + fq) ^ (fr & 7)) << 4;
                const uint4 qf = *(const uint4*)(QT + srow * 128 + chs);
#pragma unroll
                for (int n = 0; n < 4; ++n) { const uint4 kf = *(const uint4*)(KT + (n * 16 + fr) * 128 + chs); Sacc[n] = mfma16(kf, qf, Sacc[n]); }
#pragma unroll
                for (int nn = 0; nn < 2; ++nn) { const uint4 rf = *(const uint4*)(CT + (nn * 16 + fr) * 128 + chs); Xacc[nn] = mfma16(rf, qf, Xacc[nn]); }
                const int r0 = ks * 32 + fq * 8 + qq, kc = 2 * w + (pp >> 1);
                const uint2 klo = lds_tr16(KT + r0 * 128 + ((kc ^ (r0 & 7)) << 4) + (pp & 1) * 8);
                const uint2 khi = lds_tr16(KT + (r0 + 4) * 128 + ((kc ^ ((r0 + 4) & 7)) << 4) + (pp & 1) * 8);
                const uint4 kt = make_uint4(klo.x, klo.y, khi.x, khi.y);
#pragma unroll
                for (int m = 0; m < 2; ++m) {
                    const uint2 vlo = lds_tr16(VX + r0 * 64 + (16 * m + 4 * pp) * 2), vhi = lds_tr16(VX + (r0 + 4) * 64 + (16 * m + 4 * pp) * 2);
                    Cacc[m] = mfma16(kt, make_uint4(vlo.x, vlo.y, vhi.x, vhi.y), Cacc[m]);
                }
            }
            const float fs = FS[srow];
            float dsum = 0.f;
#pragma unroll
            for (int n = 0; n < 4; ++n) {
                const float4 g4 = *(const float4*)(GJ + n * 16 + fq * 4); const float ga[4] = {g4.x, g4.y, g4.z, g4.w};
                float pv[4];
#pragma unroll
                for (int j = 0; j < 4; ++j) { const int jc = n * 16 + fq * 4 + j; pv[j] = (srow >= jc) ? Sacc[n][j] * __expf(fs + ga[j]) : 0.f; dsum += pv[j]; }
                uint2 o; o.x = cvt_pk(pv[0], pv[1]); o.y = cvt_pk(pv[2], pv[3]);
                *(uint2*)(PB + srow * 128 + (((n * 2 + (fq >> 1)) ^ (fr & 7)) << 4) + (fq & 1) * 8) = o;
            }
            dsum = xor16_add(dsum); dsum = xor32_add(dsum);
            f32x4 Iacc = (f32x4){0.f, 0.f, 0.f, 0.f};
#pragma unroll
            for (int ks = 0; ks < 2; ++ks) {
                const uint4 pf = *(const uint4*)(PB + srow * 128 + (((ks * 4 + fq) ^ (fr & 7)) << 4));
                const int r0 = ks * 32 + fq * 8 + qq;
                const uint2 vlo = lds_tr16(VT + r0 * 32 + (4 * pp) * 2), vhi = lds_tr16(VT + (r0 + 4) * 32 + (4 * pp) * 2);
                Iacc = mfma16(make_uint4(vlo.x, vlo.y, vhi.x, vhi.y), pf, Iacc);
            }
            const float efs = __expf(fs);
            const float ndq = __shfl(Xacc[1][0], fr);
            const float den = dsum + efs * ndq;
            const float rden = 1.0f / fmaxf(fabsf(den), 1.0f);
            const size_t tok = tok0 + s0 + srow;
            float o4[4], ssum = 0.f, ssq = 0.f;
#pragma unroll
            for (int j = 0; j < 4; ++j) { o4[j] = (Iacc[j] + efs * Xacc[0][j]) * rden; ssum += o4[j]; ssq += o4[j] * o4[j]; }
            gst_u2(yb + tok * 1024 + hd * 128 + vs * 16 + fq * 4, cvt_pk(o4[0], o4[1]), cvt_pk(o4[2], o4[3]));
            ssum = xor16_add(ssum); ssum = xor32_add(ssum); ssq = xor16_add(ssq); ssq = xor32_add(ssq);
            if (fq == 0) gst_u2(stat + ((tok * 8 + hd) * 8 + vs) * 2, __float_as_uint(ssum), __float_as_uint(ssq));
            __syncthreads();
#pragma unroll
            for (int m = 0; m < 2; ++m) {
                const int v = m * 16 + fr;
                uint2 o; o.x = cvt_pk(Cacc[m][0], Cacc[m][1]); o.y = cvt_pk(Cacc[m][2], Cacc[m][3]);
                *(uint2*)(CT + v * 128 + (((2 * w + (fq >> 1)) ^ (v & 7)) << 4) + (fq & 1) * 8) = o;
            }
        }
    }
}
template <int HSHIFT  , int NH>
struct LdGnGate {
    struct Raw { uint4 y, g; };
    const bf16_t *y, *g; int ld; const float *gng, *gnb; const float* st;
    __device__ __forceinline__ Raw fetch(int, int r, int kc) const { Raw q; const size_t o = (size_t)r * ld + kc * 8; q.y = *(const uint4*)(y + o); q.g = *(const uint4*)(g + o); return q; }
    __device__ __forceinline__ uint4 finish(const Raw& q, int, int r, int kc) const {
        float yf[8], gf[8]; unpack8(q.y, yf); unpack8(q.g, gf);
        const float2 ms = *(const float2*)(st + (r * NH + ((kc * 8) >> HSHIFT)) * 2);
        const float4 ga = *(const float4*)(gng + kc * 8), gb = *(const float4*)(gng + kc * 8 + 4), ba = *(const float4*)(gnb + kc * 8), bb = *(const float4*)(gnb + kc * 8 + 4);
        const float gg[8] = {ga.x, ga.y, ga.z, ga.w, gb.x, gb.y, gb.z, gb.w}, bq[8] = {ba.x, ba.y, ba.z, ba.w, bb.x, bb.y, bb.z, bb.w};
        float o[8];
#pragma unroll
        for (int i = 0; i < 8; ++i) o[i] = ((yf[i] - ms.x) * ms.y * gg[i] + bq[i]) * gf[i];
        return pack8(o);
    }
};
template <int HSHIFT, int NH, int NPART>
__device__ __forceinline__ void phase_outproj_gn(PRef p, char* lds, const bf16_t* yb, const bf16_t* gate, int K, const bf16_t* wt, const float* gng, const float* gnb, bf16_t* ymix) {
    const int t = tidx(), lane = t & 63, wid = t >> 6, wr = wid >> 1, wc = wid & 1, fr = lane & 15, fq = lane >> 4;
    const float* stat = (const float*)(p.ws + OFF_STAT);
    float* st = (float*)(lds + 65536);
    const float invn = 1.0f / (float)(1 << HSHIFT);
    for (int id = blockIdx.x; id < 128 * 8; id += gridDim.x) {
        int mt, nt; tile_map(id, 8, mt, nt);
        for (int i = t; i < 128 * NH; i += 256) {
            const float* q = stat + ((size_t)mt * 128 * NH + i) * NPART * 2;
            float s = 0.f, s2 = 0.f;
#pragma unroll
            for (int j = 0; j < NPART; ++j) { const float2 v = *(const float2*)(q + j * 2); s += v.x; s2 += v.y; }
            const float mean = s * invn, var = fmaxf(s2 * invn - mean * mean, 0.f);
            st[i * 2] = mean; st[i * 2 + 1] = rsqrtf(var + 1e-6f);
        }
        __syncthreads();
        const size_t ro = (size_t)mt * 128 * K;
        LdGnGate<HSHIFT, NH> al{yb + ro, gate + ro, K, gng, gnb, st};
        const bf16_t* br[4];
        { const int r0_ = t >> 3, co_ = glds_chunk(t) * 8;
#pragma unroll
          for (int i = 0; i < 4; ++i) br[i] = wt + (size_t)(nt * 128 + r0_ + 32 * i) * K + co_; }
        f32x4 acc[4][4];
        gemm_rg(lds, K / 64, al, br, acc);
#pragma unroll
        for (int n = 0; n < 4; ++n)
#pragma unroll
            for (int m = 0; m < 4; ++m) {
                uint2 o; o.x = cvt_pk(acc[m][n][0], acc[m][n][1]); o.y = cvt_pk(acc[m][n][2], acc[m][n][3]);
                *(uint2*)(ymix + (size_t)(mt * 128 + wr * 64 + m * 16 + fr) * 1024 + nt * 128 + wc * 64 + n * 16 + fq * 4) = o;
            }
    }
}

__device__ __forceinline__ void phase_rt2(PRef p, char* lds) {
    const int t = tidx(), lane = t & 63, w = t >> 6, fr = lane & 15, fq = lane >> 4;
    char* S = p.ws + OFF_SLOT;
    const bf16_t* qb = (const bf16_t*)(S + 1 * SLOT); const bf16_t* kb = (const bf16_t*)(S + 2 * SLOT); const bf16_t* vb = (const bf16_t*)(S + 3 * SLOT);
    bf16_t* yb = (bf16_t*)(S + 7 * SLOT); float* stat = (float*)(p.ws + OFF_STAT);
    char* const VB = lds + 32768; char* const PB = lds + 49152; char* const RT = lds + 57344;
    const int gco = glds_chunk(t) * 8, gr0 = t >> 3;
    const int qq = fr >> 2, pp = fr & 3;
    for (int item = blockIdx.x; item < 512; item += gridDim.x) {
        const int bh = ((item >> 3) >> 4) * 8 + (item & 7), vs = (item >> 3) & 15, b = bh >> 2, hd = bh & 3;
        const size_t tok0 = (size_t)b * 2048;
        const float lg2 = log2f(1.0f - __builtin_amdgcn_exp2f(-5.0f - (float)hd));
        const float dec64 = __builtin_amdgcn_exp2f(64.0f * lg2);
        const bf16_t* qsrc = qb + (tok0 + gr0) * 1024 + hd * 256 + gco;
        const bf16_t* ksrc = kb + (tok0 + gr0) * 1024 + hd * 256 + gco;
        const bf16_t* vsrc = vb + (tok0 + (t >> 2)) * 2048 + hd * 512 + vs * 32 + (t & 3) * 8;
        f32x4 Racc[4][2];
#pragma unroll
        for (int a = 0; a < 4; ++a) { Racc[a][0] = (f32x4){0.f, 0.f, 0.f, 0.f}; Racc[a][1] = (f32x4){0.f, 0.f, 0.f, 0.f}; }
        __syncthreads();
        for (int i = t; i < 1024; i += 256) *(uint4*)(RT + i * 16) = make_uint4(0u, 0u, 0u, 0u);
        auto issue = [&](int pc) {
            const unsigned d = (unsigned)__builtin_amdgcn_readfirstlane((int)(lds_addr_u(lds) + (pc & 1) * 16384 + w * 1024));
            const size_t go = (size_t)(pc >> 2) * 64 * 1024 + (pc & 3) * 64;
#pragma unroll
            for (int i = 0; i < 2; ++i) { glds16_asm(qsrc + go + (size_t)i * 32 * 1024, d + i * 4096); glds16_asm(ksrc + go + (size_t)i * 32 * 1024, d + 8192 + i * 4096); }
        };
        auto put_v = [&](const uint4& raw, int ch) {
            char* vbuf = VB + (ch & 1) * 8192; const int j = t >> 2;
            *(uint4*)(vbuf + j * 64 + (t & 3) * 16) = raw;
            float f[8]; unpack8(raw, f); const float sc = __builtin_amdgcn_exp2f(lg2 * (float)(63 - j));
#pragma unroll
            for (int i = 0; i < 8; ++i) f[i] *= sc;
            *(uint4*)(vbuf + 4096 + j * 64 + (t & 3) * 16) = pack8(f);
        };
        issue(0);
        { const uint4 v0 = gld_u4(vsrc); put_v(v0, 0); }
        asm volatile("s_waitcnt vmcnt(0)" ::: "memory");
        __syncthreads();
        f32x4 Sacc[4], Xacc[2];
        uint4 vnext = make_uint4(0u, 0u, 0u, 0u);
        for (int ch = 0; ch < 32; ++ch) {
            const char* vbuf = VB + (ch & 1) * 8192;
#pragma unroll
            for (int qd = 0; qd < 4; ++qd) {
                const int pc = ch * 4 + qd;
                if (pc + 1 < 128) issue(pc + 1);
                if (qd == 0) {
                    if (ch + 1 < 32) vnext = gld_u4(vsrc + (size_t)(ch + 1) * 64 * 2048);
#pragma unroll
                    for (int n = 0; n < 4; ++n) Sacc[n] = (f32x4){0.f, 0.f, 0.f, 0.f};
                    Xacc[0] = (f32x4){0.f, 0.f, 0.f, 0.f}; Xacc[1] = (f32x4){0.f, 0.f, 0.f, 0.f};
                }
                const char* qk = lds + (pc & 1) * 16384;
                Racc[qd][0] *= dec64; Racc[qd][1] *= dec64;
#pragma unroll
                for (int ks = 0; ks < 2; ++ks) {
                    const int chs = ((ks * 4 + fq) ^ (fr & 7)) << 4;
                    const uint4 qf = *(const uint4*)(qk + (16 * w + fr) * 128 + chs);
#pragma unroll
                    for (int n = 0; n < 4; ++n) { const uint4 kf = *(const uint4*)(qk + 8192 + (n * 16 + fr) * 128 + chs); Sacc[n] = mfma16(kf, qf, Sacc[n]); }
#pragma unroll
                    for (int nn = 0; nn < 2; ++nn) {
                        const int v = nn * 16 + fr;
                        const uint4 rf = *(const uint4*)(RT + v * 512 + (((qd * 8 + ks * 4 + fq) ^ (v & 7)) << 4));
                        Xacc[nn] = mfma16(rf, qf, Xacc[nn]);
                    }
                    const int r0 = ks * 32 + fq * 8 + qq;
                    const int kc = 2 * w + (pp >> 1);
                    const uint2 klo = lds_tr16(qk + 8192 + r0 * 128 + ((kc ^ (r0 & 7)) << 4) + (pp & 1) * 8);
                    const uint2 khi = lds_tr16(qk + 8192 + (r0 + 4) * 128 + ((kc ^ ((r0 + 4) & 7)) << 4) + (pp & 1) * 8);
                    const uint4 kt = make_uint4(klo.x, klo.y, khi.x, khi.y);
#pragma unroll
                    for (int m = 0; m < 2; ++m) {
                        const uint2 vlo = lds_tr16(vbuf + 4096 + r0 * 64 + (16 * m + 4 * pp) * 2), vhi = lds_tr16(vbuf + 4096 + (r0 + 4) * 64 + (16 * m + 4 * pp) * 2);
                        Racc[qd][m] = mfma16(kt, make_uint4(vlo.x, vlo.y, vhi.x, vhi.y), Racc[qd][m]);
                    }
                }
                if (qd == 2 && ch + 1 < 32) put_v(vnext, ch + 1);
                asm volatile("s_waitcnt vmcnt(0)" ::: "memory");
                __syncthreads();
#pragma unroll
                for (int m = 0; m < 2; ++m) {
                    const int v = m * 16 + fr, cch = qd * 8 + 2 * w + (fq >> 1);
                    uint2 o; o.x = cvt_pk(Racc[qd][m][0], Racc[qd][m][1]); o.y = cvt_pk(Racc[qd][m][2], Racc[qd][m][3]);
                    *(uint2*)(RT + v * 512 + ((cch ^ (v & 7)) << 4) + (fq & 1) * 8) = o;
                }
            }
            const int srow = 16 * w + fr;
#pragma unroll
            for (int n = 0; n < 4; ++n) {
                float pv[4];
#pragma unroll
                for (int j = 0; j < 4; ++j) { const int jc = n * 16 + fq * 4 + j; pv[j] = (srow >= jc) ? Sacc[n][j] * __builtin_amdgcn_exp2f(lg2 * (float)(srow - jc)) : 0.f; }
                uint2 o; o.x = cvt_pk(pv[0], pv[1]); o.y = cvt_pk(pv[2], pv[3]);
                *(uint2*)(PB + srow * 128 + (((n * 2 + (fq >> 1)) ^ (fr & 7)) << 4) + (fq & 1) * 8) = o;
            }
            f32x4 Iacc[2] = {(f32x4){0.f, 0.f, 0.f, 0.f}, (f32x4){0.f, 0.f, 0.f, 0.f}};
#pragma unroll
            for (int ks = 0; ks < 2; ++ks) {
                const uint4 pf = *(const uint4*)(PB + srow * 128 + (((ks * 4 + fq) ^ (fr & 7)) << 4));
                const int r0 = ks * 32 + fq * 8 + qq;
#pragma unroll
                for (int nn = 0; nn < 2; ++nn) {
                    const uint2 vlo = lds_tr16(vbuf + r0 * 64 + (16 * nn + 4 * pp) * 2), vhi = lds_tr16(vbuf + (r0 + 4) * 64 + (16 * nn + 4 * pp) * 2);
                    Iacc[nn] = mfma16(make_uint4(vlo.x, vlo.y, vhi.x, vhi.y), pf, Iacc[nn]);
                }
            }
            const float qdec = __builtin_amdgcn_exp2f(lg2 * (float)(srow + 1));
            const size_t tok = tok0 + (size_t)ch * 64 + srow;
            float ssum = 0.f, ssq = 0.f;
#pragma unroll
            for (int nn = 0; nn < 2; ++nn) {
                float o4[4];
#pragma unroll
                for (int j = 0; j < 4; ++j) { o4[j] = Iacc[nn][j] + Xacc[nn][j] * qdec; ssum += o4[j]; ssq += o4[j] * o4[j]; }
                gst_u2(yb + tok * 2048 + hd * 512 + vs * 32 + nn * 16 + fq * 4, cvt_pk(o4[0], o4[1]), cvt_pk(o4[2], o4[3]));
            }
            ssum = xor16_add(ssum); ssum = xor32_add(ssum); ssq = xor16_add(ssq); ssq = xor32_add(ssq);
            if (fq == 0) gst_u2(stat + ((tok * 4 + hd) * 16 + vs) * 2, __float_as_uint(ssum), __float_as_uint(ssq));
        }
        __syncthreads();
    }
}

__device__ __forceinline__ void phase_zrw(PRef p, int jr) {
    const int t_ = tidx(); const int lane = t_ & 63, gw = blockIdx.x * 4 + (t_ >> 6), nw = gridDim.x * 4;
    char* S = p.ws + OFF_SLOT;
    const bf16_t* yb = (const bf16_t*)(S + 5 * SLOT); const bf16_t* gb = (const bf16_t*)(S + 4 * SLOT);
    const bf16_t* vb = (const bf16_t*)(S + (jr == 0 ? 11 : 9) * SLOT); bf16_t* zb = (bf16_t*)(S + 7 * SLOT);
    const float* bonus = (const float*)(p.ws + OFF_BONUS);
    float gg[16], bq[16]; row_load_f32(p.in[22] + jr * 1024, gg, lane); row_load_f32(p.in[23] + jr * 1024, bq, lane);
    const int rpw = NTOK / nw, first = gw * rpw, end = first + rpw;
    uint2 ny[4], nv[4], ng[4]; float nbn[4];
    auto load_in = [&](int r) {
#pragma unroll
        for (int c = 0; c < 4; ++c) { const size_t o = (size_t)r * 1024 + c * 256 + lane * 4; ny[c] = *(const uint2*)(yb + o); nv[c] = *(const uint2*)(vb + o); ng[c] = *(const uint2*)(gb + o);
                                      nbn[c] = bonus[(size_t)r * 16 + c * 4 + (lane >> 4)]; }
    };
    load_in(first);
    for (int r = first; r < end; ++r) {
        float y[16], v[16], g[16], bn[4];
#pragma unroll
        for (int c = 0; c < 4; ++c) {
            y[c * 4] = bflo(ny[c].x); y[c * 4 + 1] = bfhi(ny[c].x); y[c * 4 + 2] = bflo(ny[c].y); y[c * 4 + 3] = bfhi(ny[c].y);
            v[c * 4] = bflo(nv[c].x); v[c * 4 + 1] = bfhi(nv[c].x); v[c * 4 + 2] = bflo(nv[c].y); v[c * 4 + 3] = bfhi(nv[c].y);
            g[c * 4] = bflo(ng[c].x); g[c * 4 + 1] = bfhi(ng[c].x); g[c * 4 + 2] = bflo(ng[c].y); g[c * 4 + 3] = bfhi(ng[c].y);
            bn[c] = nbn[c];
        }
        if (r + 1 < end) load_in(r + 1);
        __builtin_amdgcn_sched_barrier(0);
        float z[16];
#pragma unroll
        for (int c = 0; c < 4; ++c) {
            float s = (y[c * 4] + y[c * 4 + 1]) + (y[c * 4 + 2] + y[c * 4 + 3]);
            float q = (y[c * 4] * y[c * 4] + y[c * 4 + 1] * y[c * 4 + 1]) + (y[c * 4 + 2] * y[c * 4 + 2] + y[c * 4 + 3] * y[c * 4 + 3]);
            s = row16_sum(s); q = row16_sum(q);
            const float mean = s * (1.0f / 64.0f), rstd = rsqrtf(fmaxf(q * (1.0f / 64.0f) - mean * mean, 0.f) + 64e-5f);
#pragma unroll
            for (int i = 0; i < 4; ++i) { const int e = c * 4 + i; z[e] = ((y[e] - mean) * rstd * gg[e] + bq[e] + bn[c] * v[e]) * g[e]; }
        }
        row_store_bf16(zb + (size_t)r * 1024, z, lane);
    }
}
__device__ __forceinline__ void phase_zml(PRef p) {
    const int t_ = tidx(); const int lane = t_ & 63, gw = blockIdx.x * 4 + (t_ >> 6), nw = gridDim.x * 4;
    char* S = p.ws + OFF_SLOT;
    const bf16_t* yb = (const bf16_t*)(S + 4 * SLOT); const bf16_t* ob = (const bf16_t*)(S + 3 * SLOT); bf16_t* zb = (bf16_t*)(S + 1 * SLOT);
    float gg[16], bq[16]; row_load_f32(p.in[29], gg, lane); row_load_f32(p.in[30], bq, lane);
    const int rpw = NTOK / nw, first = gw * rpw, end = first + rpw;
    uint2 ny[4], no[4];
    auto load_in = [&](int r) {
#pragma unroll
        for (int c = 0; c < 4; ++c) { const size_t o = (size_t)r * 1024 + c * 256 + lane * 4; ny[c] = *(const uint2*)(yb + o); no[c] = *(const uint2*)(ob + o); }
    };
    load_in(first);
    for (int r = first; r < end; ++r) {
        float y[16], o[16], z[16];
#pragma unroll
        for (int c = 0; c < 4; ++c) {
            y[c * 4] = bflo(ny[c].x); y[c * 4 + 1] = bfhi(ny[c].x); y[c * 4 + 2] = bflo(ny[c].y); y[c * 4 + 3] = bfhi(ny[c].y);
            o[c * 4] = bflo(no[c].x); o[c * 4 + 1] = bfhi(no[c].x); o[c * 4 + 2] = bflo(no[c].y); o[c * 4 + 3] = bfhi(no[c].y);
        }
        if (r + 1 < end) load_in(r + 1);
        __builtin_amdgcn_sched_barrier(0);
#pragma unroll
        for (int c = 0; c < 4; ++c) {
            float s = (y[c * 4] + y[c * 4 + 1]) + (y[c * 4 + 2] + y[c * 4 + 3]);
            float q = (y[c * 4] * y[c * 4] + y[c * 4 + 1] * y[c * 4 + 1]) + (y[c * 4 + 2] * y[c * 4 + 2] + y[c * 4 + 3] * y[c * 4 + 3]);
            s = row16_sum(s); q = row16_sum(q); s = xor16_add(s); q = xor16_add(q);
            const float mean = s * (1.0f / 128.0f), rstd = rsqrtf(fmaxf(q * (1.0f / 128.0f) - mean * mean, 0.f) + 1e-6f);
#pragma unroll
            for (int i = 0; i < 4; ++i) { const int e = c * 4 + i; z[e] = ((y[e] - mean) * rstd * gg[e] + bq[e]) * o[e]; }
        }
        row_store_bf16(zb + (size_t)r * 1024, z, lane);
    }
}
__device__ __forceinline__ void phase_zrt(PRef p) {
    const int t_ = tidx(); const int lane = t_ & 63, gw = blockIdx.x * 4 + (t_ >> 6), nw = gridDim.x * 4;
    char* S = p.ws + OFF_SLOT;
    const bf16_t* yb = (const bf16_t*)(S + 7 * SLOT); const bf16_t* sb = (const bf16_t*)(S + 5 * SLOT); bf16_t* zb = (bf16_t*)(S + 3 * SLOT);
    float gw8[4][8], bw8[4][8];
#pragma unroll
    for (int c = 0; c < 4; ++c) {
        const float4 ga = gld_f4(p.in[33] + lane * 32 + c * 8), gb2 = gld_f4(p.in[33] + lane * 32 + c * 8 + 4), ba = gld_f4(p.in[34] + lane * 32 + c * 8), bb2 = gld_f4(p.in[34] + lane * 32 + c * 8 + 4);
        gw8[c][0] = ga.x; gw8[c][1] = ga.y; gw8[c][2] = ga.z; gw8[c][3] = ga.w; gw8[c][4] = gb2.x; gw8[c][5] = gb2.y; gw8[c][6] = gb2.z; gw8[c][7] = gb2.w;
        bw8[c][0] = ba.x; bw8[c][1] = ba.y; bw8[c][2] = ba.z; bw8[c][3] = ba.w; bw8[c][4] = bb2.x; bw8[c][5] = bb2.y; bw8[c][6] = bb2.z; bw8[c][7] = bb2.w;
    }
    const int rpw = NTOK / nw, first = gw * rpw, end = first + rpw;
    uint4 nyr[4], nsr[4];
    auto load_in = [&](int r) {
        const size_t o = (size_t)r * 2048 + lane * 32;
#pragma unroll
        for (int c = 0; c < 4; ++c) { nyr[c] = *(const uint4*)(yb + o + c * 8); nsr[c] = *(const uint4*)(sb + o + c * 8); }
    };
    load_in(first);
    for (int r = first; r < end; ++r) {
        const size_t o = (size_t)r * 2048 + lane * 32;
        uint4 yr[4], sr[4];
#pragma unroll
        for (int c = 0; c < 4; ++c) { yr[c] = nyr[c]; sr[c] = nsr[c]; }
        if (r + 1 < end) load_in(r + 1);
        __builtin_amdgcn_sched_barrier(0);
        float s = 0.f, q = 0.f;
#pragma unroll
        for (int c = 0; c < 4; ++c) { float f[8]; unpack8(yr[c], f);
#pragma unroll
            for (int i = 0; i < 8; ++i) { s += f[i]; q += f[i] * f[i]; } }
        s = row16_sum(s); q = row16_sum(q);
        const float mean = s * (1.0f / 512.0f), rstd = rsqrtf(fmaxf(q * (1.0f / 512.0f) - mean * mean, 0.f) + 1e-6f);
#pragma unroll
        for (int c = 0; c < 4; ++c) {
            float f[8], g[8], z[8]; unpack8(yr[c], f); unpack8(sr[c], g);
#pragma unroll
            for (int i = 0; i < 8; ++i) z[i] = ((f[i] - mean) * rstd * gw8[c][i] + bw8[c][i]) * g[i];
            *(uint4*)(zb + o + c * 8) = pack8(z);
        }
    }
}

template <int WHICH  >
__device__ __forceinline__ void phase_moe(PRef p, int L, char* lds, const bf16_t* hm, bf16_t* H) {
    const int t = tidx(), lane = t & 63, wid = t >> 6, wr = wid >> 1, wc = wid & 1, fr = lane & 15, fq = lane >> 4;
    const int* cnt = (const int*)(p.ws + OFF_CNT) + L * 32;
    const int* list = (const int*)(p.ws + OFF_LIST);
    bf16_t* Y = (bf16_t*)(p.ws + OFF_SLOT + 9 * SLOT);
    int* pre = (int*)(lds + 65536);
    __syncthreads();
    if (t == 0) { int s = 0; for (int e = 0; e < 32; ++e) { pre[e] = s; s += (cnt[e] + 127) >> 7; } pre[32] = s; }
    __syncthreads();
    const int total_all = pre[32] * 8;
    const int full = (total_all / (int)gridDim.x) * (int)gridDim.x, rem = total_all - full;
    const bool split_tail = (rem > 0) && (2 * rem <= (int)gridDim.x);
    const int total = split_tail ? full : total_all;
    for (int id0 = 0; id0 < total; id0 += gridDim.x) {
        const int id = id0 + (blockIdx.x & 7) * (gridDim.x >> 3) + (blockIdx.x >> 3);
        if (id >= total) continue;
        const int nt = id & 7, mg = id >> 3;
        int e = 0;
#pragma unroll 1
        for (int s = 16; s >= 1; s >>= 1) if (pre[e + s] <= mg) e += s;
        const int mt = mg - pre[e], ne = cnt[e];
        const int* le = list + e * LIST_CAP + mt * 128;
        const bf16_t* ar[4]; const bf16_t* br[4];
        const int co_ = glds_chunk(t) * 8;
#pragma unroll
        for (int i = 0; i < 4; ++i) {
            int r = (t >> 3) + 32 * i; r = (mt * 128 + r < ne) ? r : 0;
            const int aid = le[r];
            ar[i] = ((WHICH == 0) ? hm + (size_t)(aid >> 1) * 1024 : H + (size_t)aid * 512) + co_;
        }
        f32x4 acc[4][4];
        if (WHICH == 0) {
            const bf16_t* wt = (const bf16_t*)(p.ws + W_MOE13) + ((size_t)(L * 32 + e) * 1024 + nt * 128) * 1024;
#pragma unroll
            for (int i = 0; i < 4; ++i) {
                const int ro = (t >> 3) + 32 * i, n_ = (ro >> 4) & 3, hc = ((ro >> 2) & 3) * 8 + (n_ >> 1) * 4 + (ro & 3);
                br[i] = wt + (size_t)((ro & 64) + (hc >> 4) * 32 + (n_ & 1) * 16 + (hc & 15)) * 1024 + co_;
            }
            gemm_gg(lds, 16, ar, br, acc);
            int aidq[4];
#pragma unroll
            for (int m = 0; m < 4; ++m) { const int r = wr * 64 + m * 16 + fr; aidq[m] = (mt * 128 + r < ne) ? le[r] : 0; }
#pragma unroll
            for (int m = 0; m < 4; ++m) {
                const int r = wr * 64 + m * 16 + fr;
                if (mt * 128 + r < ne) {
                    const int aid = aidq[m];
                    const f32x4 a1 = acc[m][0], a3 = acc[m][1], b1 = acc[m][2], b3 = acc[m][3];
                    gst_u4(H + (size_t)aid * 512 + nt * 64 + wc * 32 + fq * 8, cvt_pk(siluf_(a1[0]) * a3[0], siluf_(a1[1]) * a3[1]), cvt_pk(siluf_(a1[2]) * a3[2], siluf_(a1[3]) * a3[3]),
                           cvt_pk(siluf_(b1[0]) * b3[0], siluf_(b1[1]) * b3[1]), cvt_pk(siluf_(b1[2]) * b3[2], siluf_(b1[3]) * b3[3]));
                }
            }
        } else {
            const bf16_t* wt = (const bf16_t*)(p.ws + W_MOE2) + ((size_t)(L * 32 + e) * 1024 + nt * 128) * 512;
#pragma unroll
            for (int i = 0; i < 4; ++i) br[i] = wt + (size_t)perm64((t >> 3) + 32 * i) * 512 + co_;
            gemm_gg(lds, 8, ar, br, acc);
            int aidq[4];
#pragma unroll
            for (int m = 0; m < 4; ++m) { const int r = wr * 64 + m * 16 + fr; aidq[m] = (mt * 128 + r < ne) ? le[r] : 0; }
#pragma unroll
            for (int m = 0; m < 4; ++m) {
                const int r = wr * 64 + m * 16 + fr;
                if (mt * 128 + r < ne) {
                    const int aid = aidq[m];
                    store16(Y + (size_t)aid * 1024 + nt * 128 + wc * 64 + fq * 16, acc[m]);
                }
            }
        }
    }
    if (split_tail) {
        const int hid = (blockIdx.x & 7) * (gridDim.x >> 3) + (blockIdx.x >> 3);
        if (hid < 2 * rem) {
            const int id = full + (hid >> 1), hf = hid & 1;
            const int nt = id & 7, mg = id >> 3;
            int e = 0;
#pragma unroll 1
            for (int s2 = 16; s2 >= 1; s2 >>= 1) if (pre[e + s2] <= mg) e += s2;
            const int mt = mg - pre[e], ne = cnt[e];
            const int* le = list + e * LIST_CAP + mt * 128;
            const bf16_t* ar[4]; const bf16_t* br[2];
            const int co_ = glds_chunk(t) * 8;
#pragma unroll
            for (int i = 0; i < 4; ++i) {
                int r = (t >> 3) + 32 * i; r = (mt * 128 + r < ne) ? r : 0;
                const int aid = le[r];
                ar[i] = ((WHICH == 0) ? hm + (size_t)(aid >> 1) * 1024 : H + (size_t)aid * 512) + co_;
            }
            f32x4 acc[2][4];
            int aidq[2];
            if (WHICH == 0) {
                const bf16_t* wt = (const bf16_t*)(p.ws + W_MOE13) + ((size_t)(L * 32 + e) * 1024 + nt * 128 + hf * 64) * 1024;
#pragma unroll
                for (int i = 0; i < 2; ++i) {
                    const int ro = (t >> 3) + 32 * i, n_ = (ro >> 4) & 3, hc = ((ro >> 2) & 3) * 8 + (n_ >> 1) * 4 + (ro & 3);
                    br[i] = wt + (size_t)((hc >> 4) * 32 + (n_ & 1) * 16 + (hc & 15)) * 1024 + co_;
                }
                gemm_hn(lds, 16, ar, br, acc);
#pragma unroll
                for (int m = 0; m < 2; ++m) { const int r = wid * 32 + m * 16 + fr; aidq[m] = (mt * 128 + r < ne) ? le[r] : 0; }
#pragma unroll
                for (int m = 0; m < 2; ++m) {
                    const int r = wid * 32 + m * 16 + fr;
                    if (mt * 128 + r < ne) {
                        const f32x4 a1 = acc[m][0], a3 = acc[m][1], b1 = acc[m][2], b3 = acc[m][3];
                        gst_u4(H + (size_t)aidq[m] * 512 + nt * 64 + hf * 32 + fq * 8, cvt_pk(siluf_(a1[0]) * a3[0], siluf_(a1[1]) * a3[1]), cvt_pk(siluf_(a1[2]) * a3[2], siluf_(a1[3]) * a3[3]),
                               cvt_pk(siluf_(b1[0]) * b3[0], siluf_(b1[1]) * b3[1]), cvt_pk(siluf_(b1[2]) * b3[2], siluf_(b1[3]) * b3[3]));
                    }
                }
            } else {
                const bf16_t* wt = (const bf16_t*)(p.ws + W_MOE2) + ((size_t)(L * 32 + e) * 1024 + nt * 128 + hf * 64) * 512;
#pragma unroll
                for (int i = 0; i < 2; ++i) br[i] = wt + (size_t)perm64((t >> 3) + 32 * i) * 512 + co_;
                gemm_hn(lds, 8, ar, br, acc);
#pragma unroll
                for (int m = 0; m < 2; ++m) { const int r = wid * 32 + m * 16 + fr; aidq[m] = (mt * 128 + r < ne) ? le[r] : 0; }
#pragma unroll
                for (int m = 0; m < 2; ++m) {
                    const int r = wid * 32 + m * 16 + fr;
                    if (mt * 128 + r < ne) store16(Y + (size_t)aidq[m] * 1024 + nt * 128 + hf * 64 + fq * 16, acc[m]);
                }
            }
        }
    }
}

constexpr int NPHASE = 37;
#ifndef PHSEL
#define PHSEL -1
#endif
#ifndef PHEXC
#define PHEXC -2
#endif
#define PHON(x) ((PHSEL < 0 || PHSEL == (x)) && PHEXC != (x))
__global__ void __launch_bounds__(256, 2) mega(Params p_in) {
    PRef p = *(const CAS Params*)__builtin_amdgcn_kernarg_segment_ptr();
    extern __shared__ __attribute__((aligned(16))) char lds[];
    volatile LAS unsigned* xbw = (volatile LAS unsigned*)(lds + 73728);
    if (threadIdx.x == 0) { xbw[0] = 0u; xbw[1] = 0u; xbw[2] = 0u; xbw[3] = 0u; }
    __syncthreads();
    XcdBarrier bar;
    const bool multi = (p.ph_hi - p.ph_lo) > 1;
    (void)multi;
    if (multi) bar = xcd_barrier_post((unsigned*)(p.ws + OFF_CTL), xbw);
    char* S = p.ws + OFF_SLOT;
#ifdef DBG_STOP
    if (p.ph_lo == 100) {
        const float* src = (const float*)(p.ws + DBG_SRC);
        for (size_t i = (size_t)blockIdx.x * 256 + threadIdx.x; i < (size_t)NTOK * DM; i += (size_t)gridDim.x * 256) {
            float v = DBG_BF16 ? bf2f(((const bf16_t*)src)[i]) : src[i];
            if (!(fabsf(v) < 1e30f)) v = 1e30f;
            p.out[i] = v;
        }
        return;
    }
#endif
    const int ph_lo_ = p.ph_lo, ph_hi_ = p.ph_hi;
#ifdef TIMEIT
    unsigned long long t0_ = 0, t1_ = 0;
#endif
#ifdef DUP_PHASE
    bool dup_done_ = false;
#endif
    for (int ph = ph_lo_; ph < ph_hi_; ++ph) {
        const CAS Params* pp_ = (const CAS Params*)__builtin_amdgcn_kernarg_segment_ptr();
        asm volatile("" : "+s"(pp_));
        PRef p = *pp_;
#ifdef TIMEIT
        if (ph == TIME_A) t0_ = __builtin_amdgcn_s_memrealtime();
        if (ph == TIME_B) t1_ = __builtin_amdgcn_s_memrealtime();
#endif
        int L, sub, kind;
        if (ph < 2) { L = 0; sub = ph; kind = -1; }
        else if (ph < 11) { L = 0; kind = 0; sub = ph - 2; }
        else if (ph < 20) { L = 1; kind = 1; sub = ph - 11; }
        else if (ph < 28) { L = 2; kind = 2; sub = ph - 20; }
        else { L = 3; kind = 0; sub = ph - 28; }
        const int jr = L / 3;
        if (kind == -1) { if (sub == 0) { if (PHON(0)) phase_prologue(p, lds); } else { if (PHON(1)) phase_h0(p); } }
        else {
            const int ntail = (kind == 2) ? 4 : 5;
            if (sub < ntail) {
                if (kind == 0) {
                    if (sub == 0) { if (PHON(2)) phase_gemm_jobs(p, lds, jr * 7, jr * 7 + (jr ? 7 : 6)); }
                    else if (sub == 1) { if (PHON(3)) phase_rw2(p, jr); }
                    else if (sub == 2) { if (PHON(4)) {
#ifdef RW3_SCALAR
                        phase_rw3(p, jr, lds);
#else
                        phase_rw3c(p, jr, lds);
#endif
                    } }
                    else if (sub == 3) { if (PHON(5)) phase_zrw(p, jr); }
                    else { if (PHON(2)) phase_gemm_jobs(p, lds, 16 + jr, 17 + jr); }
                } else if (kind == 1) {
                    if (sub == 0) { if (PHON(2)) phase_gemm_jobs(p, lds, 14, 15); }
                    else if (sub == 1) { if (PHON(6)) phase_cml(p); }
                    else if (sub == 2) { if (PHON(6)) phase_ml2(p, lds); }
                    else if (sub == 3) { if (PHON(7)) phase_zml(p); }
                    else { if (PHON(2)) phase_gemm_jobs(p, lds, 18, 19); }
                } else {
                    if (sub == 0) { if (PHON(2)) phase_gemm_jobs(p, lds, 15, 16); }
                    else if (sub == 1) { if (PHON(8)) phase_rt2(p, lds); }
                    else if (sub == 2) { if (PHON(9)) phase_zrt(p); }
                    else { if (PHON(2)) phase_gemm_jobs(p, lds, 19, 20); }
                }
            } else {
                const int ts = sub - ntail;
                const bf16_t* ymix = (const bf16_t*)(S + (kind == 2 ? 1 : 6) * SLOT);
                bf16_t* hm = (bf16_t*)(S + (kind == 2 ? 2 : 7) * SLOT);
                bf16_t* H = (bf16_t*)(S + (kind == 0 ? 2 : (kind == 1 ? 5 : 3)) * SLOT);
                if (ts == 0) { if (PHON(10)) phase_ln1(p, L, lds, ymix, hm); }
                else if (ts == 1) { if (PHON(11)) phase_moe<0>(p, L, lds, hm, H); }
                else if (ts == 2) { if (PHON(12)) phase_moe<1>(p, L, lds, hm, H); }
                else { if (PHON(13)) phase_ln2(p, L); }
            }
        }
#ifdef DUP_PHASE
        if (((DUP_PHASE >> ph) & 1u) && !dup_done_) { dup_done_ = true; xcd_barrier(bar); --ph; continue; }
        dup_done_ = false;
#endif
        if (ph + 1 < ph_hi_) xcd_barrier(bar);
    }
#ifdef TIMEIT
    {
        xcd_barrier(bar);
        unsigned* tw = (unsigned*)(p.ws + OFF_CTL + 32768);
        if (blockIdx.x == 0 && threadIdx.x == 0) {
            if (t1_ == 0) t1_ = __builtin_amdgcn_s_memrealtime();
            const unsigned long long dt = t1_ - t0_;
            unsigned ms2 = (unsigned)((dt + TIME_U / 2) / TIME_U);
            __hip_atomic_store(tw, ms2, __ATOMIC_RELAXED, __HIP_MEMORY_SCOPE_AGENT);
        }
        xcd_barrier(bar);
        const float c_ = sqrtf((float)__hip_atomic_load(tw, __ATOMIC_RELAXED, __HIP_MEMORY_SCOPE_AGENT));
        for (size_t i = (size_t)blockIdx.x * 256 + threadIdx.x; i < (size_t)NTOK * DM; i += (size_t)gridDim.x * 256) p.out[i] = c_;
    }
#endif
#ifdef DBG_STOP
    if (ph_lo_ != 100) {
        xcd_barrier(bar);
        const float* src = (const float*)(p.ws + DBG_SRC);
        for (size_t i = (size_t)blockIdx.x * 256 + threadIdx.x; i < (size_t)NTOK * DM; i += (size_t)gridDim.x * 256) {
            float v = DBG_BF16 ? bf2f(((const bf16_t*)src)[i]) : src[i];
            if (!(fabsf(v) < 1e30f)) v = 1e30f;
            p.out[i] = v;
        }
    }
#endif
}

constexpr int LDS_BYTES = 73728 + 64;
extern "C" void kernel_launch(void* const* d_in, const int* in_sizes, int n_in, void* d_out, int out_size, void* d_ws, size_t ws_size, hipStream_t stream) {
    static int grid = 0;
    if (grid == 0) {
        if (n_in != 43 || out_size != NTOK * DM || ws_size < WS_NEED) { fprintf(stderr, "kernel_launch: unexpected shapes (n_in %d out %d ws %zu need %zu)\n", n_in, out_size, ws_size, (size_t)WS_NEED); }
        int dev = 0, cus = 0, per_cu = 0;
        (void)hipGetDevice(&dev); (void)hipDeviceGetAttribute(&cus, hipDeviceAttributeMultiprocessorCount, dev);
        (void)hipFuncSetAttribute((const void*)mega, hipFuncAttributeMaxDynamicSharedMemorySize, LDS_BYTES);
        (void)hipOccupancyMaxActiveBlocksPerMultiprocessor(&per_cu, (const void*)mega, 256, LDS_BYTES);
        if (per_cu > 2) per_cu = 2;
        if (per_cu < 1) per_cu = 1;
        grid = cus * per_cu;
        if (grid > 512) grid = 512;
        (void)hipGetLastError();
    }
    Params p{};
    for (int i = 0; i < 43; ++i) p.in[i] = (const float*)d_in[i];
    p.out = (float*)d_out; p.ws = (char*)d_ws;
    char* ws = (char*)d_ws;
    auto slot = [&](int i) { return (bf16_t*)(ws + OFF_SLOT + (size_t)i * SLOT); };
    int tile = 0;
    auto addg = [&](int idx, const bf16_t* A, const bf16_t* Bt, bf16_t* out, int K, int N, int ldo, int mode) {
        GJob& g = p.gj[idx]; g.A = A; g.Bt = Bt; g.out = out; g.K = K; g.N = N; g.ldo = ldo; g.mode = mode; g.half = (mode <= MODE_SIGM && N <= 128) ? 1 : 0; g.ntn = g.half ? (N + 63) / 64 : (N + 127) / 128; g.tile0 = tile; tile += 128 * g.ntn;
    };
    for (int jr = 0; jr < 2; ++jr) {
        const bf16_t* rkv = (const bf16_t*)(ws + W_RKV) + (size_t)jr * 3 * 1024 * 1024;
        addg(jr * 7 + 0, slot(0), rkv, slot(6), 1024, 1024, 1024, MODE_BF16);
        addg(jr * 7 + 1, slot(1), rkv + 1024 * 1024, slot(7), 1024, 1024, 1024, MODE_BF16);
        addg(jr * 7 + 2, slot(2), rkv + 2 * 1024 * 1024, slot(jr == 0 ? 11 : 8), 1024, 1024, 1024, MODE_BF16);
        addg(jr * 7 + 3, slot(3), (const bf16_t*)(ws + W_W1T) + (size_t)jr * 64 * 1024, (bf16_t*)(ws + OFF_LW), 1024, 64, 64, MODE_TANH);
        addg(jr * 7 + 4, slot(4), (const bf16_t*)(ws + W_A1T) + (size_t)jr * 64 * 1024, (bf16_t*)(ws + OFF_LA), 1024, 64, 64, MODE_BF16);
        addg(jr * 7 + 5, slot(5), (const bf16_t*)(ws + W_G1T) + (size_t)jr * 128 * 1024, (bf16_t*)(ws + OFF_LG), 1024, 128, 128, MODE_SIGM);
        addg(jr * 7 + 6, slot(2), (const bf16_t*)(ws + W_V1T), (bf16_t*)(ws + OFF_LV), 1024, 32, 32, MODE_BF16);
    }
    addg(14, slot(0), (const bf16_t*)(ws + W_MLIN), nullptr, 1024, 3088, 0, MODE_ML1);
    addg(15, slot(0), (const bf16_t*)(ws + W_RTIN), nullptr, 1024, 6144, 0, MODE_RT1);
    addg(16, slot(7), (const bf16_t*)(ws + W_OUT), slot(6), 1024, 1024, 1024, MODE_BF16);
    addg(17, slot(7), (const bf16_t*)(ws + W_OUT) + 1024 * 1024, slot(6), 1024, 1024, 1024, MODE_BF16);
    addg(18, slot(1), (const bf16_t*)(ws + W_MLOUT), slot(6), 1024, 1024, 1024, MODE_BF16);
    addg(19, slot(3), (const bf16_t*)(ws + W_RTOUT), slot(1), 2048, 1024, 1024, MODE_BF16);
    int nc = 0, ctile = 0;
    auto addc = [&](const float* src, size_t dst_off, int K, int N, int nb, long sbs, long dbs, int mode) {
        CJob& c = p.cj[nc++]; c.src = src; c.dst = (bf16_t*)(ws + dst_off); c.K = K; c.N = N; c.nb = nb; c.mode = mode; c.sbs = sbs; c.dbs = dbs;
        c.tiles_pb = ((K + 63) / 64) * ((N + 255) / 256); c.tile0 = ctile; ctile += c.tiles_pb * nb;
    };
    addc(p.in[7], W_RKV, 1024, 1024, 6, 1024 * 1024, 1024 * 1024, 0);
    addc(p.in[24], W_OUT, 1024, 1024, 2, 1024 * 1024, 1024 * 1024, 0);
    addc(p.in[9], W_W1T, 1024, 64, 2, 1024 * 64, 64 * 1024, 0);
    addc(p.in[12], W_A1T, 1024, 64, 2, 1024 * 64, 64 * 1024, 0);
    addc(p.in[17], W_G1T, 1024, 128, 2, 1024 * 128, 128 * 1024, 0);
    addc(p.in[15], W_V1T, 1024, 32, 1, 0, 0, 0);
    addc(p.in[10], W_W2T, 64, 1024, 2, 64 * 1024, 1024 * 64, 0);
    addc(p.in[13], W_A2T, 64, 1024, 2, 64 * 1024, 1024 * 64, 0);
    addc(p.in[18], W_G2T, 128, 1024, 2, 128 * 1024, 1024 * 128, 0);
    addc(p.in[16], W_V2T, 32, 1024, 1, 0, 0, 0);
    addc(p.in[25], W_MLIN, 1024, 3088, 1, 0, 0, 0);
    addc(p.in[31], W_MLOUT, 1024, 1024, 1, 0, 0, 0);
    addc(p.in[32], W_RTIN, 1024, 6144, 1, 0, 0, 3);
    addc(p.in[35], W_RTOUT, 2048, 1024, 1, 0, 0, 0);
    addc(p.in[40], W_MOE13, 1024, 512, 128, 1024 * 512, 1024 * 1024, 1);
    addc(p.in[41], W_MOE13, 1024, 512, 128, 1024 * 512, 1024 * 1024, 2);
    addc(p.in[42], W_MOE2, 512, 1024, 128, 512 * 1024, 1024 * 512, 0);
    p.ncj = nc; p.cj_tiles = ctile;

    (void)hipMemsetAsync(ws + OFF_CTL, 0, CTL_BYTES, stream);
#ifdef DBG_STOP
    const int nph = DBG_STOP;
#else
    const int nph = NPHASE;
#endif
#ifdef MULTI_LAUNCH
    for (int ph = 0; ph < nph; ++ph) { p.ph_lo = ph; p.ph_hi = ph + 1; hipLaunchKernelGGL(mega, dim3(grid), dim3(256), LDS_BYTES, stream, p); }
    if (0)
#endif
    {
        p.ph_lo = 0; p.ph_hi = nph;
        void* args[] = {&p};
        hipError_t e = hipLaunchCooperativeKernel((const void*)mega, dim3(grid), dim3(256), args, LDS_BYTES, stream);
        if (e != hipSuccess) fprintf(stderr, "cooperative launch failed: %s (grid %d)\n", hipGetErrorString(e), grid);
    }
}
```

```cpp
#include <hip/hip_runtime.h>
#include <cstdio>
#include <cstdint>

#ifndef ONE_LAUNCH
#define ONE_LAUNCH 0
#endif

typedef unsigned short bf16_t;
typedef short bf16x8 __attribute__((ext_vector_type(8)));
typedef float f32x4 __attribute__((ext_vector_type(4)));
#define LAS __attribute__((address_space(3)))
#define GAS __attribute__((address_space(1)))
typedef float f32x4g_t __attribute__((ext_vector_type(4)));
typedef unsigned u32x2g_t __attribute__((ext_vector_type(2)));
typedef unsigned u32x4g_t __attribute__((ext_vector_type(4)));
__device__ __forceinline__ float4 gld_f4(const float* p) { const f32x4g_t v = *(const GAS f32x4g_t*)(const GAS char*)(const char*)p; return make_float4(v[0], v[1], v[2], v[3]); }
__device__ __forceinline__ uint2 gld_u2(const void* p) { const u32x2g_t v = *(const GAS u32x2g_t*)(const GAS char*)(const char*)p; return make_uint2(v[0], v[1]); }
__device__ __forceinline__ uint4 gld_u4(const void* p) { const u32x4g_t v = *(const GAS u32x4g_t*)(const GAS char*)(const char*)p; return make_uint4(v[0], v[1], v[2], v[3]); }
__device__ __forceinline__ void gst_f4(float* p, float a, float b, float c, float d) { const f32x4g_t v = {a, b, c, d}; *(GAS f32x4g_t*)(GAS char*)(char*)p = v; }
__device__ __forceinline__ void gst_u2(void* p, unsigned a, unsigned b) { const u32x2g_t v = {a, b}; *(GAS u32x2g_t*)(GAS char*)(char*)p = v; }
__device__ __forceinline__ void gst_u4(void* p, unsigned a, unsigned b, unsigned c, unsigned d) { const u32x4g_t v = {a, b, c, d}; *(GAS u32x4g_t*)(GAS char*)(char*)p = v; }

constexpr int NTOK = 16384, DM = 1024, TSEQ = 2048, NBATCH = 8;
constexpr float DN_ALPHA = 1.681792830507429f;
constexpr float LN_EPS = 1e-5f;
constexpr size_t MB = 1u << 20;
constexpr size_t OFF_CTL = 0, OFF_CNT = 16384, CTL_BYTES = 65536;
constexpr size_t OFF_MOD = 65536;
constexpr size_t OFF_ROT = 1 * MB;
constexpr size_t OFF_BONUS = 3 * MB, OFF_GATES = 4 * MB, OFF_STAT = 5 * MB, OFF_LW = 13 * MB, OFF_LA = 15 * MB, OFF_LG = 17 * MB, OFF_LV = 21 * MB,
                 OFF_WGT = 22 * MB, OFF_LIST = 23 * MB, OFF_RTW = 25 * MB;
constexpr size_t OFF_W = 32 * MB;
constexpr size_t W_RKV = OFF_W, W_OUT = W_RKV + 12 * MB, W_W1T = W_OUT + 4 * MB, W_A1T = W_W1T + 256 * 1024, W_G1T = W_A1T + 256 * 1024, W_V1T = W_G1T + 512 * 1024,
                 W_W2T = W_V1T + 64 * 1024, W_A2T = W_W2T + 256 * 1024, W_G2T = W_A2T + 256 * 1024, W_V2T = W_G2T + 512 * 1024, W_MLIN = W_V2T + 64 * 1024 + 832 * 1024,
                 W_MLOUT = W_MLIN + 6400 * 1024, W_RTIN = W_MLOUT + 2 * MB, W_RTOUT = W_RTIN + 12 * MB, W_MOE13 = W_RTOUT + 4 * MB, W_MOE2 = W_MOE13 + 256 * MB,
                 W_END = W_MOE2 + 128 * MB;
constexpr size_t OFF_XRES = 464 * MB;
constexpr size_t OFF_SLOT = 528 * MB, SLOT = 32 * MB;
static_assert(W_END <= OFF_XRES, "weights overflow");
constexpr size_t OFF_XRES2 = OFF_SLOT + 12 * SLOT;
constexpr size_t WS_NEED = OFF_XRES2 + 2 * SLOT;
constexpr int LIST_CAP = 16384;

#define XB_TMO      128
#define XB_XCNT(j)  (256  + 64 * (j))
#define XB_XSUB(j)  (1280 + 64 * (j))
#define XB_XGEN(j)  (2304 + 64 * (j))
#define XB_TOP      3328
#define XB_TOPGEN   3392
#define XCD_BAR_WORDS 3456
#define XB_SPIN_CAP (1u << 22)
__device__ __forceinline__ unsigned xb_ld(unsigned* p)              { return __hip_atomic_load(p, __ATOMIC_RELAXED, __HIP_MEMORY_SCOPE_AGENT); }
__device__ __forceinline__ unsigned xb_add(unsigned* p, unsigned v) { return __hip_atomic_fetch_add(p, v, __ATOMIC_RELAXED, __HIP_MEMORY_SCOPE_AGENT); }
__device__ __forceinline__ unsigned xb_xcc_id() { return (unsigned)__builtin_amdgcn_s_getreg((3 << 11) | 20) & 0xFu; }
#define XB_SPIN(cond, bar) do { unsigned _sp = 0; while (cond) { __builtin_amdgcn_s_sleep(1); \
    if ((++_sp & 255u) == 0u) { if (xb_ld(&(bar)[XB_TMO])) break; if (_sp > XB_SPIN_CAP) { atomicAdd(&(bar)[XB_TMO], 1u); break; } } } } while (0)
struct XcdBarrier { unsigned* bar; unsigned x; volatile LAS unsigned* st; };
__device__ __forceinline__ XcdBarrier xcd_barrier_post(unsigned* bar, volatile LAS unsigned* st) {
    XcdBarrier b; b.bar = bar; b.x = xb_xcc_id(); b.st = st;
    if (threadIdx.x == 0) (void)xb_add(&bar[XB_XCNT(b.x)], 1u);
    return b;
}
__device__ __forceinline__ void xcd_barrier_complete(unsigned* bar, unsigned x, unsigned& nloc, unsigned& nx) {
    const unsigned G = gridDim.x;
    unsigned sum, cnt, mine, sp = 0u;
    for (;;) {
        sum = 0u; cnt = 0u; mine = 0u;
#pragma unroll
        for (unsigned j = 0; j < 16; ++j) { const unsigned c = xb_ld(&bar[XB_XCNT(j)]); sum += c; cnt += (c > 0u) ? 1u : 0u; mine = (j == x) ? c : mine; }
        if (sum == G) break;
        __builtin_amdgcn_s_sleep(1);
        if ((++sp & 255u) == 0u) { if (xb_ld(&bar[XB_TMO])) break; if (sp > XB_SPIN_CAP) { atomicAdd(&bar[XB_TMO], 1u); break; } }
    }
    nloc = mine > 0u ? mine : 1u; nx = cnt > 0u ? cnt : 1u;
}
__device__ __forceinline__ void xcd_barrier(const XcdBarrier& b) {
    asm volatile("s_waitcnt vmcnt(0)" ::: "memory");
    __syncthreads();
    if (threadIdx.x == 0) {
        unsigned* bar = b.bar;
        __builtin_amdgcn_s_waitcnt(0);
        unsigned nloc = b.st[0], nx = b.st[1];
        if (nloc == 0u) { xcd_barrier_complete(bar, b.x, nloc, nx); b.st[0] = nloc; b.st[1] = nx; }
        const unsigned old = xb_add(&bar[XB_XSUB(b.x)], 1u);
        const unsigned gen = old / nloc;
        if (old + 1u == (gen + 1u) * nloc) {
            __builtin_amdgcn_fence(__ATOMIC_RELEASE, "agent");
            asm volatile("s_waitcnt vmcnt(0)" ::: "memory");
            const unsigned og = xb_add(&bar[XB_TOP], 1u);
            const unsigned tg = og / nx;
            if (og + 1u == (tg + 1u) * nx) xb_add(&bar[XB_TOPGEN], 1u);
            else XB_SPIN(xb_ld(&bar[XB_TOPGEN]) == tg, bar);
            __builtin_amdgcn_fence(__ATOMIC_ACQUIRE, "agent");
            xb_add(&bar[XB_XGEN(b.x)], 1u);
            asm volatile("s_waitcnt vmcnt(0)" ::: "memory");
        } else {
            XB_SPIN(xb_ld(&bar[XB_XGEN(b.x)]) == gen, bar);
            __builtin_amdgcn_fence(__ATOMIC_ACQUIRE, "agent");
            asm volatile("s_waitcnt vmcnt(0)" ::: "memory");
        }
    }
    __syncthreads();
}

__device__ __forceinline__ int tidx() { int t = threadIdx.x; asm volatile("" : "+v"(t)); return t; }
typedef __bf16 bf16x2_t __attribute__((ext_vector_type(2)));
typedef float f32x2_t __attribute__((ext_vector_type(2)));
__device__ __forceinline__ unsigned cvt_pk(float lo, float hi) {
    f32x2_t v = {lo, hi}; bf16x2_t r = __builtin_convertvector(v, bf16x2_t);
    unsigned u; __builtin_memcpy(&u, &r, 4); return u;
}
__device__ __forceinline__ bf16_t f2bf(float f) { return (bf16_t)(cvt_pk(f, 0.f) & 0xffffu); }
__device__ __forceinline__ float bflo(unsigned u) { return __uint_as_float(u << 16); }
__device__ __forceinline__ float bfhi(unsigned u) { return __uint_as_float(u & 0xffff0000u); }
__device__ __forceinline__ float bf2f(bf16_t u) { return __uint_as_float(((unsigned)u) << 16); }
__device__ __forceinline__ void unpack8(const uint4& u, float (&f)[8]) {
    f[0] = bflo(u.x); f[1] = bfhi(u.x); f[2] = bflo(u.y); f[3] = bfhi(u.y); f[4] = bflo(u.z); f[5] = bfhi(u.z); f[6] = bflo(u.w); f[7] = bfhi(u.w);
}
__device__ __forceinline__ uint4 pack8(const float (&f)[8]) { uint4 u; u.x = cvt_pk(f[0], f[1]); u.y = cvt_pk(f[2], f[3]); u.z = cvt_pk(f[4], f[5]); u.w = cvt_pk(f[6], f[7]); return u; }
typedef unsigned u32x4_t __attribute__((ext_vector_type(4)));
__device__ __forceinline__ uint4 gload16(const void* p) {
    const u32x4_t v = *(const __attribute__((address_space(1))) u32x4_t*)p;
    return make_uint4(v[0], v[1], v[2], v[3]);
}
__device__ __forceinline__ float sigmoidf_(float x) { return __builtin_amdgcn_rcpf(1.0f + __expf(-x)); }
__device__ __forceinline__ float siluf_(float x) { return x * __builtin_amdgcn_rcpf(1.0f + __expf(-x)); }
__device__ __forceinline__ float tanhf_(float x) { return 1.0f - 2.0f * __builtin_amdgcn_rcpf(1.0f + __expf(2.0f * x)); }
__device__ __forceinline__ float softplusf_(float x) { return fmaxf(x, 0.f) + __logf(1.0f + __expf(-fabsf(x))); }
__device__ __forceinline__ float row16_sum(float v);
__device__ __forceinline__ float xor16_add(float v) { const auto r = __builtin_amdgcn_permlane16_swap(__float_as_uint(v), __float_as_uint(v), false, false); return __uint_as_float(r[0]) + __uint_as_float(r[1]); }
__device__ __forceinline__ float xor32_add(float v) { const auto r = __builtin_amdgcn_permlane32_swap(__float_as_uint(v), __float_as_uint(v), false, false); return __uint_as_float(r[0]) + __uint_as_float(r[1]); }
__device__ __forceinline__ float wave_sum(float v) {
    v = row16_sum(v); v = xor16_add(v); v = xor32_add(v);
    return v;
}
__device__ __forceinline__ float row16_sum(float v) {
    v += __builtin_amdgcn_update_dpp(0.f, v, 0x128, 0xf, 0xf, false);
    v += __builtin_amdgcn_update_dpp(0.f, v, 0x124, 0xf, 0xf, false);
    v += __builtin_amdgcn_update_dpp(0.f, v, 0x122, 0xf, 0xf, false);
    v += __builtin_amdgcn_update_dpp(0.f, v, 0x121, 0xf, 0xf, false);
    return v;
}
__device__ __forceinline__ float oct_sum(float v) {
    v += __builtin_amdgcn_update_dpp(0.f, v, 0xB1, 0xf, 0xf, false);
    v += __builtin_amdgcn_update_dpp(0.f, v, 0x4E, 0xf, 0xf, false);
    v += __builtin_amdgcn_update_dpp(0.f, v, 0x141, 0xf, 0xf, false);
    return v;
}

enum { MODE_BF16 = 0, MODE_TANH = 1, MODE_SIGM = 2, MODE_ML1 = 3, MODE_RT1 = 4 };
struct GJob { const bf16_t* A; const bf16_t* Bt; bf16_t* out; int K, N, ldo, mode, ntn, tile0, half; };
struct CJob { const float* src; bf16_t* dst; int K, N, nb, mode; long sbs, dbs; int tiles_pb, tile0; };
constexpr int NGJ = 20, NCJ = 24;
struct Params {
    const float* in[43]; float* out; char* ws;
    int ph_lo, ph_hi, ncj, cj_tiles;
    GJob gj[NGJ];
    CJob cj[NCJ];
};
#define CAS __attribute__((address_space(4)))
typedef const CAS Params& PRef;

__device__ __forceinline__ f32x4 mfma16(const uint4& a, const uint4& b, f32x4 c) {
    bf16x8 av, bv; __builtin_memcpy(&av, &a, 16); __builtin_memcpy(&bv, &b, 16);
    return __builtin_amdgcn_mfma_f32_16x16x32_bf16(av, bv, c, 0, 0, 0);
}
template <bool PFA = true, class AL, class BL>
__device__ __forceinline__ void gemm_mainloop(char* lds, int nk, const AL& al, const BL& bl, f32x4 (&acc)[4][4]) {
    const int t = tidx(), c = t & 7, r0 = t >> 3;
    const int lane = t & 63, wid = t >> 6, wr = wid >> 1, wc = wid & 1, fr = lane & 15, fq = lane >> 4;
    typename AL::Raw ra[4]; typename BL::Raw rb[4];
    const int woff = r0 * 128 + ((c ^ (r0 & 7)) << 4);
#pragma unroll
    for (int i = 0; i < 4; ++i) { if (PFA) ra[i] = al.fetch(i, r0 + 32 * i, c); rb[i] = bl.fetch(i, r0 + 32 * i, c); }
#pragma unroll
    for (int i = 0; i < 4; ++i) {
        if (!PFA) { ra[i] = al.fetch(i, r0 + 32 * i, c); }
        *(uint4*)(lds + woff + i * 4096) = al.finish(ra[i], i, r0 + 32 * i, c);
        *(uint4*)(lds + 16384 + woff + i * 4096) = bl.finish(rb[i], i, r0 + 32 * i, c);
        if (!PFA) asm volatile("" ::: "memory");
    }
#pragma unroll
    for (int m = 0; m < 4; ++m)
#pragma unroll
        for (int n = 0; n < 4; ++n) acc[m][n] = (f32x4){0.f, 0.f, 0.f, 0.f};
    __syncthreads();
    const int aoff = (wr * 64 + fr) * 128, boff = 16384 + (wc * 64 + fr) * 128, sw = fr & 7;
    for (int kt = 0; kt < nk; ++kt) {
        const bool more = (kt + 1 < nk);
        if (more) {
#pragma unroll
            for (int i = 0; i < 4; ++i) { if (PFA) ra[i] = al.fetch(i, r0 + 32 * i, (kt + 1) * 8 + c); rb[i] = bl.fetch(i, r0 + 32 * i, (kt + 1) * 8 + c); }
        }
        const char* buf = lds + (kt & 1) * 32768;
#pragma unroll
        for (int ks = 0; ks < 2; ++ks) {
            uint4 af[4], bfm[4];
            const int ch = ((ks * 4 + fq) ^ sw) << 4;
#pragma unroll
            for (int m = 0; m < 4; ++m) af[m] = *(const uint4*)(buf + aoff + m * 2048 + ch);
#pragma unroll
            for (int n = 0; n < 4; ++n) bfm[n] = *(const uint4*)(buf + boff + n * 2048 + ch);
#pragma unroll
            for (int m = 0; m < 4; ++m)
#pragma unroll
                for (int n = 0; n < 4; ++n) acc[m][n] = mfma16(bfm[n], af[m], acc[m][n]);
        }
        if (more) {
            char* nb = lds + ((kt + 1) & 1) * 32768;
#pragma unroll
            for (int i = 0; i < 4; ++i) {
                if (!PFA) ra[i] = al.fetch(i, r0 + 32 * i, (kt + 1) * 8 + c);
                *(uint4*)(nb + woff + i * 4096) = al.finish(ra[i], i, r0 + 32 * i, (kt + 1) * 8 + c);
                *(uint4*)(nb + 16384 + woff + i * 4096) = bl.finish(rb[i], i, r0 + 32 * i, (kt + 1) * 8 + c);
                if (!PFA) asm volatile("" ::: "memory");
            }
        }
        __syncthreads();
    }
}
__device__ __forceinline__ void glds16(const bf16_t* g, char* l) {
    __builtin_amdgcn_global_load_lds((const unsigned*)g, (LAS unsigned*)l, 16, 0, 0);
}
__device__ __forceinline__ void glds16_asm(const void* gsrc, unsigned lds_dst) {
    unsigned keep;
    asm volatile("s_mov_b32 %0, m0\n\ts_mov_b32 m0, %2\n\ts_nop 0\n\tglobal_load_lds_dwordx4 %1, off\n\ts_mov_b32 m0, %0" : "=&s"(keep) : "v"(gsrc), "s"(lds_dst) : "memory");
}
__device__ __forceinline__ unsigned lds_addr_u(const char* l) { return (unsigned)(size_t)(const LAS char*)l; }
__device__ __forceinline__ int glds_chunk(int t) { return (t & 7) ^ ((t >> 3) & 7); }
__device__ __forceinline__ void mma_ktile(const char* buf, int aoff, int boff, int sw, int fq, f32x4 (&acc)[4][4]) {
    const int ch0 = ((0 * 4 + fq) ^ sw) << 4, ch1 = ((1 * 4 + fq) ^ sw) << 4;
    const char* pa = buf + aoff; const char* pb = buf + boff;
    uint4 a0[4], a1[4], b[8];
#pragma unroll
    for (int m = 0; m < 4; ++m) a0[m] = *(const uint4*)(pa + m * 2048 + ch0);
    b[0] = *(const uint4*)(pb + ch0); b[1] = *(const uint4*)(pb + 2048 + ch0);
    __builtin_amdgcn_sched_barrier(0);
    b[2] = *(const uint4*)(pb + 2 * 2048 + ch0);
#pragma unroll
    for (int m = 0; m < 4; ++m) acc[m][0] = mfma16(b[0], a0[m], acc[m][0]);
    __builtin_amdgcn_sched_barrier(0);
    b[3] = *(const uint4*)(pb + 3 * 2048 + ch0);
#pragma unroll
    for (int m = 0; m < 4; ++m) acc[m][1] = mfma16(b[1], a0[m], acc[m][1]);
    __builtin_amdgcn_sched_barrier(0);
#pragma unroll
    for (int m = 0; m < 4; ++m) a1[m] = *(const uint4*)(pa + m * 2048 + ch1);
#pragma unroll
    for (int m = 0; m < 4; ++m) acc[m][2] = mfma16(b[2], a0[m], acc[m][2]);
    __builtin_amdgcn_sched_barrier(0);
    b[4] = *(const uint4*)(pb + ch1); b[5] = *(const uint4*)(pb + 2048 + ch1);
#pragma unroll
    for (int m = 0; m < 4; ++m) acc[m][3] = mfma16(b[3], a0[m], acc[m][3]);
    __builtin_amdgcn_sched_barrier(0);
    b[6] = *(const uint4*)(pb + 2 * 2048 + ch1);
#pragma unroll
    for (int m = 0; m < 4; ++m) acc[m][0] = mfma16(b[4], a1[m], acc[m][0]);
    __builtin_amdgcn_sched_barrier(0);
    b[7] = *(const uint4*)(pb + 3 * 2048 + ch1);
#pragma unroll
    for (int m = 0; m < 4; ++m) acc[m][1] = mfma16(b[5], a1[m], acc[m][1]);
    __builtin_amdgcn_sched_barrier(0);
#pragma unroll
    for (int m = 0; m < 4; ++m) acc[m][2] = mfma16(b[6], a1[m], acc[m][2]);
#pragma unroll
    for (int m = 0; m < 4; ++m) acc[m][3] = mfma16(b[7], a1[m], acc[m][3]);
}
__device__ __forceinline__ void gemm_gg(char* lds, int nk, const bf16_t* const (&ar)[4], const bf16_t* const (&br)[4], f32x4 (&acc)[4][4]) {
    const int t = tidx();
    const int lane = t & 63, wid = t >> 6, wr = wid >> 1, wc = wid & 1, fr = lane & 15, fq = lane >> 4;
    const unsigned wbs = (unsigned)__builtin_amdgcn_readfirstlane((int)(lds_addr_u(lds) + wid * 1024));
#pragma unroll
    for (int i = 0; i < 4; ++i) { glds16_asm(ar[i], wbs + i * 4096); glds16_asm(br[i], wbs + 16384 + i * 4096); }
#pragma unroll
    for (int m = 0; m < 4; ++m)
#pragma unroll
        for (int n = 0; n < 4; ++n) acc[m][n] = (f32x4){0.f, 0.f, 0.f, 0.f};
    asm volatile("s_waitcnt vmcnt(0)" ::: "memory");
    __syncthreads();
    const int aoff = (wr * 64 + fr) * 128, boff = 16384 + (wc * 64 + fr) * 128, sw = fr & 7;
    for (int kt = 0; kt < nk; ++kt) {
        if (kt + 1 < nk) {
            const unsigned nb = (unsigned)__builtin_amdgcn_readfirstlane((int)(wbs + ((kt + 1) & 1) * 32768));
#pragma unroll
            for (int i = 0; i < 4; ++i) { glds16_asm(ar[i] + (kt + 1) * 64, nb + i * 4096); glds16_asm(br[i] + (kt + 1) * 64, nb + 16384 + i * 4096); }
        }
        mma_ktile(lds + (kt & 1) * 32768, aoff, boff, sw, fq, acc);
        asm volatile("s_waitcnt vmcnt(0)" ::: "memory");
        __syncthreads();
    }
}
__device__ __forceinline__ void gemm_hn(char* lds, int nk, const bf16_t* const (&ar)[4], const bf16_t* const (&br)[2], f32x4 (&acc)[2][4]) {
    const int t = tidx();
    const int lane = t & 63, wid = t >> 6, fr = lane & 15, fq = lane >> 4;
    const unsigned wbs = (unsigned)__builtin_amdgcn_readfirstlane((int)(lds_addr_u(lds) + wid * 1024));
#pragma unroll
    for (int i = 0; i < 4; ++i) glds16_asm(ar[i], wbs + i * 4096);
#pragma unroll
    for (int i = 0; i < 2; ++i) glds16_asm(br[i], wbs + 16384 + i * 4096);
#pragma unroll
    for (int m = 0; m < 2; ++m)
#pragma unroll
        for (int n = 0; n < 4; ++n) acc[m][n] = (f32x4){0.f, 0.f, 0.f, 0.f};
    asm volatile("s_waitcnt vmcnt(0)" ::: "memory");
    __syncthreads();
    const int aoff = (wid * 32 + fr) * 128, boff = 16384 + fr * 128, sw = fr & 7;
    for (int kt = 0; kt < nk; ++kt) {
        if (kt + 1 < nk) {
            const unsigned nb = (unsigned)__builtin_amdgcn_readfirstlane((int)(wbs + ((kt + 1) & 1) * 32768));
#pragma unroll
            for (int i = 0; i < 4; ++i) glds16_asm(ar[i] + (kt + 1) * 64, nb + i * 4096);
#pragma unroll
            for (int i = 0; i < 2; ++i) glds16_asm(br[i] + (kt + 1) * 64, nb + 16384 + i * 4096);
        }
        const char* buf = lds + (kt & 1) * 32768;
#pragma unroll
        for (int ks = 0; ks < 2; ++ks) {
            const int ch = ((ks * 4 + fq) ^ sw) << 4;
            uint4 af[2], bfm[4];
#pragma unroll
            for (int m = 0; m < 2; ++m) af[m] = *(const uint4*)(buf + aoff + m * 2048 + ch);
#pragma unroll
            for (int n = 0; n < 4; ++n) bfm[n] = *(const uint4*)(buf + boff + n * 2048 + ch);
#pragma unroll
            for (int m = 0; m < 2; ++m)
#pragma unroll
                for (int n = 0; n < 4; ++n) acc[m][n] = mfma16(bfm[n], af[m], acc[m][n]);
        }
        asm volatile("s_waitcnt vmcnt(0)" ::: "memory");
        __syncthreads();
    }
}
template <class AL>
__device__ __forceinline__ void gemm_rg(char* lds, int nk, const AL& al, const bf16_t* const (&br)[4], f32x4 (&acc)[4][4]) {
    const int t = tidx(), c = t & 7, r0 = t >> 3;
    const int lane = t & 63, wid = t >> 6, wr = wid >> 1, wc = wid & 1, fr = lane & 15, fq = lane >> 4;
    char* wb = lds + wid * 1024;
    const int woff = r0 * 128 + ((c ^ (r0 & 7)) << 4);
#pragma unroll
    for (int i = 0; i < 4; ++i) glds16(br[i], wb + 16384 + i * 4096);
#pragma unroll
    for (int i = 0; i < 4; ++i) {
        typename AL::Raw ra = al.fetch(i, r0 + 32 * i, c);
        *(uint4*)(lds + woff + i * 4096) = al.finish(ra, i, r0 + 32 * i, c);
        asm volatile("" ::: "memory");
    }
#pragma unroll
    for (int m = 0; m < 4; ++m)
#pragma unroll
        for (int n = 0; n < 4; ++n) acc[m][n] = (f32x4){0.f, 0.f, 0.f, 0.f};
    asm volatile("s_waitcnt vmcnt(0)" ::: "memory");
    __syncthreads();
    const int aoff = (wr * 64 + fr) * 128, boff = 16384 + (wc * 64 + fr) * 128, sw = fr & 7;
    for (int kt = 0; kt < nk; ++kt) {
        const bool more = (kt + 1 < nk);
        char* nbuf = lds + ((kt + 1) & 1) * 32768;
        if (more) {
#pragma unroll
            for (int i = 0; i < 4; ++i) glds16(br[i] + (kt + 1) * 64, nbuf + wid * 1024 + 16384 + i * 4096);
        }
        mma_ktile(lds + (kt & 1) * 32768, aoff, boff, sw, fq, acc);
        if (more) {
#pragma unroll
            for (int i = 0; i < 4; ++i) {
                typename AL::Raw ra = al.fetch(i, r0 + 32 * i, (kt + 1) * 8 + c);
                *(uint4*)(nbuf + woff + i * 4096) = al.finish(ra, i, r0 + 32 * i, (kt + 1) * 8 + c);
                asm volatile("" ::: "memory");
            }
        }
        asm volatile("s_waitcnt vmcnt(0)" ::: "memory");
        __syncthreads();
    }
}
struct LdPlain {
    typedef uint4 Raw;
    const bf16_t* p; int ld; int nvalid;
    __device__ __forceinline__ uint4 fetch(int, int r, int kc) const { return (r < nvalid) ? *(const uint4*)(p + (size_t)r * ld + kc * 8) : make_uint4(0u, 0u, 0u, 0u); }
    __device__ __forceinline__ uint4 finish(const uint4& v, int, int, int) const { return v; }
};
struct LdGather {
    typedef uint4 Raw;
    const bf16_t* rp[4];
    __device__ __forceinline__ uint4 fetch(int i, int, int kc) const { const bf16_t* q = rp[i]; return q ? *(const uint4*)(q + kc * 8) : make_uint4(0u, 0u, 0u, 0u); }
    __device__ __forceinline__ uint4 finish(const uint4& v, int, int, int) const { return v; }
};
__device__ __forceinline__ void tile_map(int id, int NT, int& mt, int& nt) {
    const int x = id & 7, q = id >> 3;
    const int mg = q / (8 * NT), q2 = q - mg * 8 * NT, G = (NT + 7) >> 3;
    int g = q2 >> 6; g = g < G - 1 ? g : G - 1;
    const int r = q2 - (g << 6), w = (g == G - 1) ? NT - 8 * g : 8;
    mt = (mg * 8 + r / w) * 8 + x; nt = 8 * g + r % w;
}

__device__ __forceinline__ int conv_row(int mode, int n) {
    if (mode == 1) return (n >> 4) * 32 + (n & 15);
    if (mode == 2) return (n >> 4) * 32 + 16 + (n & 15);
    if (mode == 3 && n < 2048) { const int c = n & 255, c2 = c & 127; return (n & ~255) + (c2 >> 4) * 32 + ((c >> 7) << 4) + (c2 & 15); }
    return n;
}
__device__ __forceinline__ void phase_prologue(PRef p, char* lds) {
    const int t = tidx();
    const int n_ada = 8 * 48, n_rot = 256 + 144;
    float* mod = (float*)(p.ws + OFF_MOD);
    for (int it = blockIdx.x; it < n_ada + n_rot; it += gridDim.x) {
        if (it < n_ada) {
            const int pr = it / 48, cb = it % 48;
            float* sc = (float*)lds;
            float* red = (float*)(lds + 32768);
            for (int i = t; i < 8192; i += 256) { const int b = i >> 10, k = i & 1023; sc[k * 8 + b] = siluf_(p.in[1][b * 1024 + k]); }
            __syncthreads();
            const int kg = t >> 6, cl = t & 63, col = cb * 64 + cl;
            const float* W = p.in[2] + (size_t)pr * 1024 * 3072 + col;
            float a[8] = {0, 0, 0, 0, 0, 0, 0, 0};
#pragma unroll 8
            for (int k = kg * 256; k < kg * 256 + 256; ++k) {
                const float w = W[(size_t)k * 3072];
                const float4 s0 = *(const float4*)(sc + k * 8), s1 = *(const float4*)(sc + k * 8 + 4);
                a[0] += w * s0.x; a[1] += w * s0.y; a[2] += w * s0.z; a[3] += w * s0.w; a[4] += w * s1.x; a[5] += w * s1.y; a[6] += w * s1.z; a[7] += w * s1.w;
            }
#pragma unroll
            for (int b = 0; b < 8; ++b) red[(kg * 8 + b) * 64 + cl] = a[b];
            __syncthreads();
            for (int i = t; i < 512; i += 256) {
                const int b = i >> 6, c2 = i & 63;
                const float s = red[(0 * 8 + b) * 64 + c2] + red[(1 * 8 + b) * 64 + c2] + red[(2 * 8 + b) * 64 + c2] + red[(3 * 8 + b) * 64 + c2];
                mod[((size_t)pr * 8 + b) * 3072 + cb * 64 + c2] = s + p.in[3][pr * 3072 + cb * 64 + c2];
            }
            __syncthreads();
        } else if (it >= n_ada + 256 && it < n_ada + n_rot) {
            float* rtw = (float*)(p.ws + OFF_RTW);
            const int base = (it - n_ada - 256) * 1024;
            for (int e = base + t; e < base + 1024; e += 256) {
                const int L = e / (36 * 1024), o = (e >> 10) % 36, k = e & 1023;
                rtw[e] = (o < 4) ? p.in[36][((size_t)L * 1024 + k) * 4 + o] : p.in[38][((size_t)L * 1024 + k) * 32 + (o - 4)];
            }
        } else if (it < n_ada + 256) {
            float* rot = (float*)(p.ws + OFF_ROT);
            const int base = (it - n_ada) * 1024;
            for (int e = base + t; e < base + 1024; e += 256) {
                const int tt = e >> 7, i = e & 127;
                const float inv = __builtin_amdgcn_exp2f(-(float)i * (13.287712379549449f / 127.0f));
                const float ang = (float)tt * inv;
                float rev = ang * 0.15915494309189535f; rev -= floorf(rev);
                rot[e * 2] = __builtin_amdgcn_cosf(rev); rot[e * 2 + 1] = __builtin_amdgcn_sinf(rev);
            }
        }
    }
    {
        float* sm = (float*)lds;
        const int lane = t & 63, wv = t >> 6;
        const float* nsrc = nullptr; bf16_t* ndst = nullptr; int nK = 0, nN = 0, nmode = 0, nkt = 0, nnt = 0;
        float4 pv[16];
#define CJ_SETUP(ct_) { int c_ = (ct_), j_ = 0; while (j_ + 1 < p.ncj && c_ >= p.cj[j_ + 1].tile0) ++j_; \
            c_ -= p.cj[j_].tile0; const int tpb_ = p.cj[j_].tiles_pb; const int bi_ = c_ / tpb_, tl_ = c_ % tpb_; nK = p.cj[j_].K; nN = p.cj[j_].N; nmode = p.cj[j_].mode; \
            const int nNt_ = (nN + 255) >> 8; nkt = tl_ / nNt_; nnt = tl_ % nNt_; nsrc = p.cj[j_].src + (size_t)bi_ * p.cj[j_].sbs; ndst = p.cj[j_].dst + (size_t)bi_ * p.cj[j_].dbs; }
#define CJ_LOAD() { _Pragma("unroll") for (int i = 0; i < 16; ++i) { const int k = nkt * 64 + wv + 4 * i, n = nnt * 256 + lane * 4; \
            pv[i] = (k < nK && n < nN) ? gld_f4(nsrc + (size_t)k * nN + n) : make_float4(0.f, 0.f, 0.f, 0.f); } }
        int* const tick = (int*)(p.ws + OFF_CTL + 20480);
        int* const nbox = (int*)(lds + 66560);
        int ct = (int)blockIdx.x, ct2 = (int)gridDim.x + (int)blockIdx.x;
        if (ct < p.cj_tiles) { CJ_SETUP(ct); CJ_LOAD(); }
        while (ct < p.cj_tiles) {
#pragma unroll
            for (int i = 0; i < 16; ++i) *(float4*)(sm + (wv + 4 * i) * 260 + lane * 4) = pv[i];
            bf16_t* const sdst = ndst; const int sK = nK, sN = nN, smode = nmode, skt = nkt, snt = nnt;
            if (ct2 < p.cj_tiles) { CJ_SETUP(ct2); CJ_LOAD(); }
            if (t == 0) *nbox = 2 * (int)gridDim.x + atomicAdd(tick, 1);
            __syncthreads();
            const int ct3 = *nbox;
#pragma unroll
            for (int h2 = 0; h2 < 4; ++h2) {
                const int nl = lane + 64 * h2, n = snt * 256 + nl, k0 = skt * 64 + wv * 16;
                if (n < sN && k0 < sK) {
                    float f[8], g[8];
#pragma unroll
                    for (int q = 0; q < 8; ++q) { f[q] = sm[(wv * 16 + q) * 260 + nl]; g[q] = sm[(wv * 16 + 8 + q) * 260 + nl]; }
                    bf16_t* d = sdst + (size_t)conv_row(smode, n) * sK + k0;
                    { const uint4 u0 = pack8(f), u1 = pack8(g); gst_u4(d, u0.x, u0.y, u0.z, u0.w); gst_u4(d + 8, u1.x, u1.y, u1.z, u1.w); }
                }
            }
            __syncthreads();
            ct = ct2; ct2 = ct3;
        }
#undef CJ_SETUP
#undef CJ_LOAD
    }
}

__device__ __forceinline__ void row_load_f32(const float* p, float (&v)[16], int lane) {
#pragma unroll
    for (int c = 0; c < 4; ++c) { const float4 x = gld_f4(p + c * 256 + lane * 4); v[c * 4] = x.x; v[c * 4 + 1] = x.y; v[c * 4 + 2] = x.z; v[c * 4 + 3] = x.w; }
}
__device__ __forceinline__ void row_load_f32_l(const float* p, float (&v)[16], int lane) {
#pragma unroll
    for (int c = 0; c < 4; ++c) { const float4 x = *(const float4*)(p + c * 256 + lane * 4); v[c * 4] = x.x; v[c * 4 + 1] = x.y; v[c * 4 + 2] = x.z; v[c * 4 + 3] = x.w; }
}
__device__ __forceinline__ void row_load_bf16(const bf16_t* p, float (&v)[16], int lane) {
#pragma unroll
    for (int c = 0; c < 4; ++c) { const uint2 x = gld_u2(p + c * 256 + lane * 4); v[c * 4] = bflo(x.x); v[c * 4 + 1] = bfhi(x.x); v[c * 4 + 2] = bflo(x.y); v[c * 4 + 3] = bfhi(x.y); }
}
__device__ __forceinline__ void row_store_bf16(bf16_t* p, const float (&v)[16], int lane) {
#pragma unroll
    for (int c = 0; c < 4; ++c) gst_u2(p + c * 256 + lane * 4, cvt_pk(v[c * 4], v[c * 4 + 1]), cvt_pk(v[c * 4 + 2], v[c * 4 + 3]));
}
__device__ __forceinline__ void row_store_f32(float* p, const float (&v)[16], int lane) {
#pragma unroll
    for (int c = 0; c < 4; ++c) gst_f4(p + c * 256 + lane * 4, v[c * 4], v[c * 4 + 1], v[c * 4 + 2], v[c * 4 + 3]);
}
__device__ __forceinline__ void row_store_f32_l(float* p, const float (&v)[16], int lane) {
#pragma unroll
    for (int c = 0; c < 4; ++c) *(float4*)(p + c * 256 + lane * 4) = make_float4(v[c * 4], v[c * 4 + 1], v[c * 4 + 2], v[c * 4 + 3]);
}
__device__ __forceinline__ void row_layernorm(float (&v)[16], const float* g, const float* b, int lane) {
    float gg[16], bb[16]; row_load_f32(g, gg, lane); row_load_f32(b, bb, lane);
    float s = 0.f, q = 0.f;
#pragma unroll
    for (int i = 0; i < 16; ++i) { s += v[i]; q += v[i] * v[i]; }
    s = wave_sum(s); q = wave_sum(q);
    const float mean = s * (1.0f / 1024.0f);
    const float rstd = rsqrtf(fmaxf(q * (1.0f / 1024.0f) - mean * mean, 0.f) + LN_EPS);
#pragma unroll
    for (int i = 0; i < 16; ++i) v[i] = (v[i] - mean) * rstd * gg[i] + bb[i];
}
__device__ __forceinline__ void row_modulate(const float (&x)[16], float (&h)[16], const float* mod3, int lane) {
    float sh[16], sc[16]; row_load_f32(mod3, sh, lane); row_load_f32(mod3 + 1024, sc, lane);
#pragma unroll
    for (int i = 0; i < 16; ++i) h[i] = x[i] * (1.0f + sc[i]) + sh[i];
}
__device__ __forceinline__ void load_mu(const float* mu, float (&m)[6][16], int lane) {
#pragma unroll
    for (int n = 0; n < 6; ++n) row_load_f32(mu + n * 1024, m[n], lane);
}
__device__ __forceinline__ void emit_next(bf16_t* s0, int kind, int row, const float (&h)[16], const float (&hp)[16], const float (&m)[6][16], int lane) {
    if (kind == 0) {
#pragma unroll
        for (int n = 0; n < 6; ++n) {
#pragma unroll
            for (int c = 0; c < 4; ++c)
                gst_u2(s0 + (size_t)n * (SLOT / 2) + (size_t)row * 1024 + c * 256 + lane * 4,
                       cvt_pk(h[c * 4] + (hp[c * 4] - h[c * 4]) * m[n][c * 4], h[c * 4 + 1] + (hp[c * 4 + 1] - h[c * 4 + 1]) * m[n][c * 4 + 1]),
                       cvt_pk(h[c * 4 + 2] + (hp[c * 4 + 2] - h[c * 4 + 2]) * m[n][c * 4 + 2], h[c * 4 + 3] + (hp[c * 4 + 3] - h[c * 4 + 3]) * m[n][c * 4 + 3]));
        }
    } else row_store_bf16(s0 + (size_t)row * 1024, h, lane);
}
__device__ __forceinline__ void emit_next_l(bf16_t* s0, const float* mu, int kind, int row, const float (&h)[16], const float (&hp)[16], int lane) {
    if (kind == 0) {
#pragma unroll 1
        for (int n = 0; n < 6; ++n) {
#pragma unroll
            for (int c2 = 0; c2 < 2; ++c2) {
                const float4 ma = gld_f4(mu + n * 1024 + (2 * c2) * 256 + lane * 4), mb = gld_f4(mu + n * 1024 + (2 * c2 + 1) * 256 + lane * 4);
                const float mm[8] = {ma.x, ma.y, ma.z, ma.w, mb.x, mb.y, mb.z, mb.w};
#pragma unroll
                for (int cc = 0; cc < 2; ++cc) {
                    const int c = 2 * c2 + cc;
                    gst_u2(s0 + (size_t)n * (SLOT / 2) + (size_t)row * 1024 + c * 256 + lane * 4,
                           cvt_pk(h[c * 4] + (hp[c * 4] - h[c * 4]) * mm[cc * 4], h[c * 4 + 1] + (hp[c * 4 + 1] - h[c * 4 + 1]) * mm[cc * 4 + 1]),
                           cvt_pk(h[c * 4 + 2] + (hp[c * 4 + 2] - h[c * 4 + 2]) * mm[cc * 4 + 2], h[c * 4 + 3] + (hp[c * 4 + 3] - h[c * 4 + 3]) * mm[cc * 4 + 3]));
                }
            }
        }
    } else row_store_bf16(s0 + (size_t)row * 1024, h, lane);
}
__device__ __forceinline__ void phase_h0(PRef p) {
    const int t_ = tidx(); const int lane = t_ & 63, gw = blockIdx.x * 4 + (t_ >> 6), nw = gridDim.x * 4;
    const int rpw = NTOK / nw;
    const int r_lo = gw * rpw;
    const float* mod = (const float*)(p.ws + OFF_MOD) + ((size_t)(0 * 2 + 0) * 8 + (r_lo >> 11)) * 3072;
    float sh[16], sc[16]; row_load_f32(mod, sh, lane); row_load_f32(mod + 1024, sc, lane);
    float hp[16];
#pragma unroll
    for (int i = 0; i < 16; ++i) hp[i] = 0.f;
    float mu[6][16]; load_mu(p.in[6], mu, lane);
    const int first = ((r_lo & 2047) != 0) ? r_lo - 1 : r_lo, end = r_lo + rpw;
    float nx[16]; row_load_f32(p.in[0] + (size_t)first * 1024, nx, lane);
    for (int r = first; r < end; ++r) {
        float h[16];
#pragma unroll
        for (int i = 0; i < 16; ++i) h[i] = nx[i] * (1.0f + sc[i]) + sh[i];
        if (r + 1 < end) row_load_f32(p.in[0] + (size_t)(r + 1) * 1024, nx, lane);
        __builtin_amdgcn_sched_barrier(0);
        if (r >= r_lo) emit_next((bf16_t*)(p.ws + OFF_SLOT), 0, r, h, hp, mu, lane);
#pragma unroll
        for (int i = 0; i < 16; ++i) hp[i] = h[i];
        if (((r + 1) & 2047) == 0) {
#pragma unroll
            for (int i = 0; i < 16; ++i) hp[i] = 0.f;
        }
    }
}
__device__ __forceinline__ int layer_kind(int L) { return L % 3; }
__device__ __forceinline__ void phase_ln2(PRef p, int L) {
    const int t_ = tidx(); const int lane = t_ & 63, gw = blockIdx.x * 4 + (t_ >> 6), nw = gridDim.x * 4;
    const int rpw = NTOK / nw, r_lo = gw * rpw;
    const float* mod = (const float*)(p.ws + OFF_MOD);
    const bf16_t* xres = (const bf16_t*)(p.ws + OFF_XRES);
    const bf16_t* Y = (const bf16_t*)(p.ws + OFF_SLOT + 9 * SLOT);
    const float* wgt = (const float*)(p.ws + OFF_WGT);
    const bool last = (L == 3);
    const int nk = layer_kind(L + 1), njr = (L + 1) / 3;
    const bool need_prev = (!last && nk == 0);
    const int bidx = r_lo >> 11;
    float gt[16], lgn[16], lbn[16];
    row_load_f32(mod + ((size_t)(L * 2 + 1) * 8 + bidx) * 3072 + 2048, gt, lane);
    row_load_f32(p.in[4] + (L * 2 + 1) * 1024, lgn, lane); row_load_f32(p.in[5] + (L * 2 + 1) * 1024, lbn, lane);
    float hp[16];
#pragma unroll
    for (int i = 0; i < 16; ++i) hp[i] = 0.f;
    float shn[16], scn[16];
    { const float* mn_ = mod + ((size_t)((last ? L : L + 1) * 2 + 0) * 8 + bidx) * 3072; row_load_f32(mn_, shn, lane); row_load_f32(mn_ + 1024, scn, lane); }
    uint2 nxr[4], ny0[4], ny1[4]; float nw0, nw1;
    auto load_in = [&](int r) {
#pragma unroll
        for (int c = 0; c < 4; ++c) { nxr[c] = *(const uint2*)(xres + (size_t)r * 1024 + c * 256 + lane * 4); ny0[c] = *(const uint2*)(Y + (size_t)(2 * r) * 1024 + c * 256 + lane * 4); ny1[c] = *(const uint2*)(Y + (size_t)(2 * r + 1) * 1024 + c * 256 + lane * 4); }
        nw0 = wgt[2 * r]; nw1 = wgt[2 * r + 1];
    };
    const int first = (need_prev && (r_lo & 2047) != 0) ? r_lo - 1 : r_lo, end = r_lo + rpw;
    load_in(first);
    for (int r = first; r < end; ++r) {
        float x[16];
        {
            const float w0 = nw0, w1 = nw1;
#pragma unroll
            for (int c = 0; c < 4; ++c) {
                const float a0[4] = {bflo(ny0[c].x), bfhi(ny0[c].x), bflo(ny0[c].y), bfhi(ny0[c].y)}, a1[4] = {bflo(ny1[c].x), bfhi(ny1[c].x), bflo(ny1[c].y), bfhi(ny1[c].y)};
                const float xr[4] = {bflo(nxr[c].x), bfhi(nxr[c].x), bflo(nxr[c].y), bfhi(nxr[c].y)};
#pragma unroll
                for (int i = 0; i < 4; ++i) x[c * 4 + i] = DN_ALPHA * xr[i] + (1.0f + gt[c * 4 + i]) * (w0 * a0[i] + w1 * a1[i]);
            }
        }
        if (r + 1 < end) load_in(r + 1);
        __builtin_amdgcn_sched_barrier(0);
        float s = 0.f, q = 0.f;
#pragma unroll
        for (int i = 0; i < 16; ++i) { s += x[i]; q += x[i] * x[i]; }
        s = wave_sum(s); q = wave_sum(q);
        const float mean = s * (1.0f / 1024.0f), rstd = rsqrtf(fmaxf(q * (1.0f / 1024.0f) - mean * mean, 0.f) + LN_EPS);
#pragma unroll
        for (int i = 0; i < 16; ++i) x[i] = (x[i] - mean) * rstd * lgn[i] + lbn[i];
        if (last) { row_store_f32(p.out + (size_t)r * 1024, x, lane); continue; }
        float h[16];
#pragma unroll
        for (int i = 0; i < 16; ++i) h[i] = x[i] * (1.0f + scn[i]) + shn[i];
        if (r >= r_lo) { row_store_bf16((bf16_t*)(p.ws + OFF_XRES2) + (size_t)r * 1024, x, lane); emit_next_l((bf16_t*)(p.ws + OFF_SLOT), p.in[6] + (size_t)njr * 6 * 1024, nk, r, h, hp, lane); }
#pragma unroll
        for (int i = 0; i < 16; ++i) hp[i] = h[i];
        if (((r + 1) & 2047) == 0) {
#pragma unroll
            for (int i = 0; i < 16; ++i) hp[i] = 0.f;
        }
    }
}
__device__ __forceinline__ void phase_ln1(PRef p, int L, char* lds, const bf16_t* ymix, bf16_t* hm) {
    const int t = tidx(), lane = t & 63, wid = t >> 6;
    const float* mod = (const float*)(p.ws + OFF_MOD);
    const bf16_t* xinb = (const bf16_t*)(p.ws + OFF_XRES2);
    bf16_t* xres = (bf16_t*)(p.ws + OFF_XRES);
    int* cnt = (int*)(p.ws + OFF_CNT) + L * 32;
    int* list = (int*)(p.ws + OFF_LIST);
    float* wgt = (float*)(p.ws + OFF_WGT);
    float* const HB = (float*)lds;
    float* const lg = (float*)(lds + 65536);
    const float* rtw = (const float*)(p.ws + OFF_RTW) + (size_t)L * 36 * 1024;
    const int rpb = NTOK / gridDim.x;
    const int bidx = (blockIdx.x * rpb) >> 11;
    float gt[16], lgn[16], lbn[16], sh2[16], sc2[16];
    row_load_f32(mod + ((size_t)(L * 2 + 0) * 8 + bidx) * 3072 + 2048, gt, lane);
    row_load_f32(p.in[4] + (L * 2 + 0) * 1024, lgn, lane); row_load_f32(p.in[5] + (L * 2 + 0) * 1024, lbn, lane);
    row_load_f32(mod + ((size_t)(L * 2 + 1) * 8 + bidx) * 3072, sh2, lane); row_load_f32(mod + ((size_t)(L * 2 + 1) * 8 + bidx) * 3072 + 1024, sc2, lane);
    for (int rb0 = blockIdx.x * rpb; rb0 < (blockIdx.x + 1) * rpb; rb0 += 16) {
        const int rb = rb0 + wid * 4;
        uint4 xr[4][4]; uint2 yr[4][4];
#pragma unroll
        for (int rr = 0; rr < 4; ++rr) {
            const int r = rb + rr;
#pragma unroll
            for (int c = 0; c < 4; ++c) {
                if (L == 0) xr[rr][c] = gld_u4(p.in[0] + (size_t)r * 1024 + c * 256 + lane * 4);
                else { const uint2 t2 = gld_u2(xinb + (size_t)r * 1024 + c * 256 + lane * 4); xr[rr][c] = make_uint4(t2.x, t2.y, 0u, 0u); }
                yr[rr][c] = gld_u2(ymix + (size_t)r * 1024 + c * 256 + lane * 4);
            }
        }
#pragma unroll
        for (int rr = 0; rr < 4; ++rr) {
            const int r = rb + rr;
            float x[16], h[16];
#pragma unroll
            for (int c = 0; c < 4; ++c) {
                float xv[4];
                if (L == 0) { xv[0] = __uint_as_float(xr[rr][c].x); xv[1] = __uint_as_float(xr[rr][c].y); xv[2] = __uint_as_float(xr[rr][c].z); xv[3] = __uint_as_float(xr[rr][c].w); }
                else { xv[0] = bflo(xr[rr][c].x); xv[1] = bfhi(xr[rr][c].x); xv[2] = bflo(xr[rr][c].y); xv[3] = bfhi(xr[rr][c].y); }
                const float yv[4] = {bflo(yr[rr][c].x), bfhi(yr[rr][c].x), bflo(yr[rr][c].y), bfhi(yr[rr][c].y)};
#pragma unroll
                for (int i = 0; i < 4; ++i) x[c * 4 + i] = DN_ALPHA * xv[i] + (1.0f + gt[c * 4 + i]) * yv[i];
            }
            float s = 0.f, q = 0.f;
#pragma unroll
            for (int i = 0; i < 16; ++i) { s += x[i]; q += x[i] * x[i]; }
            s = wave_sum(s); q = wave_sum(q);
            const float mean = s * (1.0f / 1024.0f), rstd = rsqrtf(fmaxf(q * (1.0f / 1024.0f) - mean * mean, 0.f) + LN_EPS);
#pragma unroll
            for (int i = 0; i < 16; ++i) { x[i] = (x[i] - mean) * rstd * lgn[i] + lbn[i]; h[i] = x[i] * (1.0f + sc2[i]) + sh2[i]; }
            row_store_bf16(xres + (size_t)r * 1024, x, lane);
            row_store_bf16(hm + (size_t)r * 1024, h, lane);
            row_store_f32_l(HB + (wid * 4 + rr) * 1024, h, lane);
        }
        __syncthreads();
#pragma unroll 1
        for (int q3 = 0; q3 < 9; q3 += 3) {
            float w[3][16];
#pragma unroll
            for (int u = 0; u < 3; ++u) row_load_f32(rtw + (size_t)(wid * 9 + q3 + u) * 1024, w[u], lane);
#pragma unroll 2
            for (int r16 = 0; r16 < 16; ++r16) {
                float h[16]; row_load_f32_l(HB + r16 * 1024, h, lane);
                float a3[3];
#pragma unroll
                for (int u = 0; u < 3; ++u) { f32x2_t s2 = {0.f, 0.f};
#pragma unroll
                    for (int i = 0; i < 8; ++i) { const f32x2_t hh = {h[2 * i], h[2 * i + 1]}, ww = {w[u][2 * i], w[u][2 * i + 1]}; s2 = __builtin_elementwise_fma(hh, ww, s2); }
                    a3[u] = s2.x + s2.y; }
                {
                    const auto r01 = __builtin_amdgcn_permlane32_swap(__float_as_uint(a3[0]), __float_as_uint(a3[1]), false, false);
                    const float z = __uint_as_float(r01[0]) + __uint_as_float(r01[1]);
                    const float c2 = xor32_add(a3[2]);
                    const auto rz = __builtin_amdgcn_permlane16_swap(__float_as_uint(z), __float_as_uint(c2), false, false);
                    const float tot = row16_sum(__uint_as_float(rz[0]) + __uint_as_float(rz[1]));
                    if ((lane & 15) == 0 && lane < 48) lg[r16 * 36 + wid * 9 + q3 + (lane == 0 ? 0 : lane == 32 ? 1 : 2)] = tot;
                }
            }
        }
        __syncthreads();
        if (t < 16) {
            const int row = rb0 + t; const float* l = lg + t * 36;
            float g[4]; for (int i = 0; i < 4; ++i) g[i] = l[i] + p.in[37][L * 4 + i];
            int gi = 0; for (int i = 1; i < 4; ++i) if (g[i] > g[gi]) gi = i;
            float gs = 0.f; for (int i = 0; i < 4; ++i) gs += __expf(g[i] - g[gi]);
            const float ggate = 1.0f / gs;
            float e[8]; for (int i = 0; i < 8; ++i) e[i] = l[4 + gi * 8 + i] + p.in[39][L * 32 + gi * 8 + i];
            int i0 = 0; for (int i = 1; i < 8; ++i) if (e[i] > e[i0]) i0 = i;
            int i1 = (i0 == 0) ? 1 : 0; for (int i = 0; i < 8; ++i) if (i != i0 && e[i] > e[i1]) i1 = i;
            const float p1 = __expf(e[i1] - e[i0]);
            const float w0 = ggate / (1.0f + p1), w1 = ggate * p1 / (1.0f + p1);
            const int e0 = gi * 8 + i0, e1 = gi * 8 + i1;
            const int pos0 = atomicAdd(&cnt[e0], 1), pos1 = atomicAdd(&cnt[e1], 1);
            list[e0 * LIST_CAP + pos0] = 2 * row; list[e1 * LIST_CAP + pos1] = 2 * row + 1;
            wgt[2 * row] = w0; wgt[2 * row + 1] = w1;
        }
        asm volatile("s_waitcnt lgkmcnt(0)" ::: "memory");
    }
}

__device__ __forceinline__ int perm64(int r) { return (r & 64) | (((r >> 2) & 3) << 4) | (((r >> 4) & 3) << 2) | (r & 3); }
__device__ __forceinline__ bool tile_permuted(int mode, int nt) { return (mode <= MODE_SIGM) || (mode == MODE_ML1 && nt < 24) || (mode == MODE_RT1 && nt >= 16); }
__device__ __forceinline__ void store16(bf16_t* d, const f32x4 (&v)[4]) {
    gst_u4(d, cvt_pk(v[0][0], v[0][1]), cvt_pk(v[0][2], v[0][3]), cvt_pk(v[1][0], v[1][1]), cvt_pk(v[1][2], v[1][3]));
    gst_u4(d + 8, cvt_pk(v[2][0], v[2][1]), cvt_pk(v[2][2], v[2][3]), cvt_pk(v[3][0], v[3][1]), cvt_pk(v[3][2], v[3][3]));
}
__device__ __forceinline__ void gemm_epilogue(PRef p, const GJob& jb, int mt, int nt, const f32x4 (&acc)[4][4]) {
    const int t_ = tidx(); const int lane = t_ & 63, wid = t_ >> 6, wr = wid >> 1, wc = wid & 1, fr = lane & 15, fq = lane >> 4;
    const int row0 = mt * 128 + wr * 64 + fr;
    if (jb.mode <= MODE_SIGM) {
        const int col = nt * 128 + wc * 64 + fq * 16;
        if (col < jb.N) {
#pragma unroll
            for (int m = 0; m < 4; ++m) {
                f32x4 v[4];
#pragma unroll
                for (int n = 0; n < 4; ++n) {
                    v[n] = acc[m][n];
                    if (jb.mode == MODE_TANH) { v[n][0] = tanhf_(v[n][0]); v[n][1] = tanhf_(v[n][1]); v[n][2] = tanhf_(v[n][2]); v[n][3] = tanhf_(v[n][3]); }
                    else if (jb.mode == MODE_SIGM) { v[n][0] = sigmoidf_(v[n][0]); v[n][1] = sigmoidf_(v[n][1]); v[n][2] = sigmoidf_(v[n][2]); v[n][3] = sigmoidf_(v[n][3]); }
                }
                store16(jb.out + (size_t)(row0 + m * 16) * jb.ldo + col, v);
            }
        }
    } else if (jb.mode == MODE_ML1) {
        if (nt < 24) {
            bf16_t* ob = (bf16_t*)(p.ws + OFF_SLOT + (size_t)(1 + (nt >> 3)) * SLOT);
            const bool sg = (nt >= 16);
            const int col = (nt & 7) * 128 + wc * 64 + fq * 16;
#pragma unroll
            for (int m = 0; m < 4; ++m) {
                f32x4 v[4];
#pragma unroll
                for (int n = 0; n < 4; ++n) {
                    v[n] = acc[m][n];
                    if (sg) { v[n][0] = sigmoidf_(v[n][0]); v[n][1] = sigmoidf_(v[n][1]); v[n][2] = sigmoidf_(v[n][2]); v[n][3] = sigmoidf_(v[n][3]); }
                }
                store16(ob + (size_t)(row0 + m * 16) * 1024 + col, v);
            }
        } else if (wc == 0) {
            float* gates = (float*)(p.ws + OFF_GATES);
            const float* bg = p.in[26];
            const int c0 = fq * 4;
#pragma unroll
            for (int m = 0; m < 4; ++m) {
                f32x4 v = acc[m][0], o;
#pragma unroll
                for (int j = 0; j < 4; ++j) { const float g = v[j] + bg[c0 + j]; o[j] = (c0 + j < 8) ? g : -softplusf_(-g); }
                gst_f4(gates + (size_t)(row0 + m * 16) * 16 + c0, o[0], o[1], o[2], o[3]);
            }
        }
    } else {
        if (nt < 16) {
            const float* rot = (const float*)(p.ws + OFF_ROT);
            bf16_t* ob = (bf16_t*)(p.ws + OFF_SLOT + (size_t)(1 + (nt >> 3)) * SLOT);
            const float scl = (nt >= 8) ? 0.0625f : 1.0f;
#pragma unroll
            for (int pp = 0; pp < 2; ++pp) {
                const int blk32 = (nt & 7) * 4 + wc * 2 + pp, head = blk32 >> 3, i0 = (blk32 & 7) * 16 + fq * 4;
                float4 rc0[4], rc1[4];
#pragma unroll
                for (int m = 0; m < 4; ++m) { const int tt = (row0 + m * 16) & 2047; rc0[m] = gld_f4(rot + ((size_t)tt * 128 + i0) * 2); rc1[m] = gld_f4(rot + ((size_t)tt * 128 + i0) * 2 + 4); }
#pragma unroll
                for (int m = 0; m < 4; ++m) {
                    const int row = row0 + m * 16;
                    const float4 c0 = rc0[m], c1 = rc1[m];
                    const float cs[4] = {c0.x, c0.z, c1.x, c1.z}, sn[4] = {c0.y, c0.w, c1.y, c1.w};
                    const f32x4 x1 = acc[m][2 * pp], x2 = acc[m][2 * pp + 1];
                    float o1[4], o2[4];
#pragma unroll
                    for (int j = 0; j < 4; ++j) { o1[j] = (x1[j] * cs[j] - x2[j] * sn[j]) * scl; o2[j] = (x1[j] * sn[j] + x2[j] * cs[j]) * scl; }
                    gst_u2(ob + (size_t)row * 1024 + head * 256 + i0, cvt_pk(o1[0], o1[1]), cvt_pk(o1[2], o1[3]));
                    gst_u2(ob + (size_t)row * 1024 + head * 256 + 128 + i0, cvt_pk(o2[0], o2[1]), cvt_pk(o2[2], o2[3]));
                }
            }
        } else {
            const bool isg = (nt >= 32);
            bf16_t* ob = (bf16_t*)(p.ws + OFF_SLOT + (size_t)(isg ? 5 : 3) * SLOT);
            const int col = (nt & 15) * 128 + wc * 64 + fq * 16;
#pragma unroll
            for (int m = 0; m < 4; ++m) {
                f32x4 v[4];
#pragma unroll
                for (int n = 0; n < 4; ++n) {
                    v[n] = acc[m][n];
                    if (isg) { v[n][0] = siluf_(v[n][0]); v[n][1] = siluf_(v[n][1]); v[n][2] = siluf_(v[n][2]); v[n][3] = siluf_(v[n][3]); }
                }
                store16(ob + (size_t)(row0 + m * 16) * 2048 + col, v);
            }
        }
    }
}
__device__ __forceinline__ void phase_gemm_jobs(PRef p, char* lds, int jlo, int jhi) {
    const int total = p.gj[jhi - 1].tile0 + 128 * p.gj[jhi - 1].ntn - p.gj[jlo].tile0;
    for (int id = blockIdx.x; id < total; id += gridDim.x) {
        int j = jlo; const int gid = id + p.gj[jlo].tile0;
        while (j + 1 < jhi && gid >= p.gj[j + 1].tile0) ++j;
        GJob jb; jb.A = p.gj[j].A; jb.Bt = p.gj[j].Bt; jb.out = p.gj[j].out; jb.K = p.gj[j].K; jb.N = p.gj[j].N; jb.ldo = p.gj[j].ldo; jb.mode = p.gj[j].mode; jb.ntn = p.gj[j].ntn; jb.tile0 = p.gj[j].tile0;
        jb.half = p.gj[j].half;
        int mt, nt; tile_map(gid - jb.tile0, jb.ntn, mt, nt);
        if (jb.half || (jb.mode == MODE_ML1 && nt == 24)) {
            const int t_ = tidx(), r0_ = t_ >> 3, co_ = glds_chunk(t_) * 8, ln_ = t_ & 63, wv_ = t_ >> 6, fr_ = ln_ & 15, fq_ = ln_ >> 4;
            const int cb = jb.half ? nt * 64 : nt * 128;
            int nvh = jb.N - cb; nvh = nvh > 64 ? 64 : nvh;
            const bf16_t* ar[4]; const bf16_t* brh[2];
#pragma unroll
            for (int i = 0; i < 4; ++i) ar[i] = jb.A + (size_t)(mt * 128 + r0_ + 32 * i) * jb.K + co_;
#pragma unroll
            for (int i = 0; i < 2; ++i) { int rb_ = r0_ + 32 * i; rb_ = jb.half ? perm64(rb_) : rb_; rb_ = rb_ < nvh ? rb_ : nvh - 1; brh[i] = jb.Bt + (size_t)(cb + rb_) * jb.K + co_; }
            f32x4 ah[2][4];
            gemm_hn(lds, jb.K / 64, ar, brh, ah);
            const int rowh = mt * 128 + wv_ * 32 + fr_;
            if (jb.half) {
                const int col = cb + fq_ * 16;
                if (col < jb.N) {
#pragma unroll
                    for (int m = 0; m < 2; ++m) {
                        f32x4 v[4];
#pragma unroll
                        for (int n = 0; n < 4; ++n) {
                            v[n] = ah[m][n];
#pragma unroll
                            for (int jj = 0; jj < 4; ++jj) v[n][jj] = (jb.mode == MODE_TANH) ? tanhf_(v[n][jj]) : (jb.mode == MODE_SIGM) ? sigmoidf_(v[n][jj]) : v[n][jj];
                        }
                        store16(jb.out + (size_t)(rowh + m * 16) * jb.ldo + col, v);
                    }
                }
            } else {
                float* gates = (float*)(p.ws + OFF_GATES);
                const float* bg = p.in[26];
                const int c0 = fq_ * 4;
                const float4 bq = gld_f4(bg + c0);
                const float bqa[4] = {bq.x, bq.y, bq.z, bq.w};
#pragma unroll
                for (int m = 0; m < 2; ++m) {
                    float o[4];
#pragma unroll
                    for (int jj = 0; jj < 4; ++jj) { const float g = ah[m][0][jj] + bqa[jj]; o[jj] = (c0 + jj < 8) ? g : -softplusf_(-g); }
                    gst_f4(gates + (size_t)(rowh + m * 16) * 16 + c0, o[0], o[1], o[2], o[3]);
                }
            }
            continue;
        }
        int nv = jb.N - nt * 128; nv = nv > 128 ? 128 : nv;
        const bf16_t* ar[4]; const bf16_t* br[4];
        {
            const int t_ = tidx(), r0_ = t_ >> 3, co_ = glds_chunk(t_) * 8;
            const bool pm_ = tile_permuted(jb.mode, nt);
#pragma unroll
            for (int i = 0; i < 4; ++i) {
                ar[i] = jb.A + (size_t)(mt * 128 + r0_ + 32 * i) * jb.K + co_;
                int rb_ = r0_ + 32 * i; rb_ = pm_ ? perm64(rb_) : rb_; rb_ = rb_ < nv ? rb_ : nv - 1;
                br[i] = jb.Bt + (size_t)(nt * 128 + rb_) * jb.K + co_;
            }
        }
        f32x4 acc[4][4];
        gemm_gg(lds, jb.K / 64, ar, br, acc);
        gemm_epilogue(p, jb, mt, nt, acc);
    }
}

constexpr int RM = 4;
template <int KL>
__device__ __forceinline__ void minigemm(const bf16_t* A, const bf16_t* Bt, int fr, int fq, f32x4 (&acc)[RM][4]) {
#pragma unroll
    for (int m = 0; m < RM; ++m)
#pragma unroll
        for (int n = 0; n < 4; ++n) acc[m][n] = (f32x4){0.f, 0.f, 0.f, 0.f};
#pragma unroll 2
    for (int ks = 0; ks < KL / 32; ++ks) {
        uint4 af[RM], bfm[4];
#pragma unroll
        for (int m = 0; m < RM; ++m) af[m] = gld_u4(A + (size_t)(m * 16 + fr) * KL + ks * 32 + fq * 8);
#pragma unroll
        for (int n = 0; n < 4; ++n) bfm[n] = gld_u4(Bt + (size_t)((fr >> 2) * 16 + n * 4 + (fr & 3)) * KL + ks * 32 + fq * 8);
#pragma unroll
        for (int m = 0; m < RM; ++m)
#pragma unroll
            for (int n = 0; n < 4; ++n) acc[m][n] = mfma16(bfm[n], af[m], acc[m][n]);
    }
}
__device__ __forceinline__ void phase_rw2(PRef p, int jr) {
    const int t_ = tidx(); const int lane = t_ & 63, wid = t_ >> 6, wr = wid >> 1, wc = wid & 1, fr = lane & 15, fq = lane >> 4;
    char* S = p.ws + OFF_SLOT;
    bf16_t* decayb = (bf16_t*)S; bf16_t* nkk = (bf16_t*)(S + 2 * SLOT); bf16_t* bb = (bf16_t*)(S + 3 * SLOT); bf16_t* gb = (bf16_t*)(S + 4 * SLOT);
    const bf16_t* rb = (const bf16_t*)(S + 6 * SLOT); const bf16_t* kb = (const bf16_t*)(S + 7 * SLOT); bf16_t* kpb = (bf16_t*)(S + 10 * SLOT);
    const bf16_t* vb = (const bf16_t*)(S + 8 * SLOT); bf16_t* vpb = (bf16_t*)(S + 9 * SLOT); const bf16_t* vf = (const bf16_t*)(S + 11 * SLOT);
    float* bonus = (float*)(p.ws + OFF_BONUS);
    const bf16_t* Lw = (const bf16_t*)(p.ws + OFF_LW); const bf16_t* La = (const bf16_t*)(p.ws + OFF_LA);
    const bf16_t* Lg = (const bf16_t*)(p.ws + OFF_LG); const bf16_t* Lv = (const bf16_t*)(p.ws + OFF_LV);
    const bf16_t* w2t = (const bf16_t*)(p.ws + W_W2T) + (size_t)jr * 1024 * 64; const bf16_t* a2t = (const bf16_t*)(p.ws + W_A2T) + (size_t)jr * 1024 * 64;
    const bf16_t* g2t = (const bf16_t*)(p.ws + W_G2T) + (size_t)jr * 1024 * 128; const bf16_t* v2t = (const bf16_t*)(p.ws + W_V2T);
    const float* w0 = p.in[8] + jr * 1024; const float* a0 = p.in[11] + jr * 1024; const float* v0 = p.in[14];
    const float* kkw = p.in[19] + jr * 1024; const float* kaw = p.in[20] + jr * 1024; const float* rk = p.in[21] + jr * 1024;
    for (int id2 = blockIdx.x; id2 < 128 * 8; id2 += gridDim.x) {
        int mt, nt; tile_map(id2, 8, mt, nt);
        const int row0 = mt * 128 + wr * 64, col0 = nt * 128 + wc * 64, head = nt * 2 + wc;
        f32x4 acc[RM][4];
        const int c0 = col0 + fq * 16;
        minigemm<64>(La + (size_t)row0 * 64, a2t + (size_t)col0 * 64, fr, fq, acc);
        float ss[RM], bs[RM];
#pragma unroll
        for (int m = 0; m < RM; ++m) { ss[m] = 0.f; bs[m] = 0.f; }
#pragma unroll
        for (int m = 0; m < RM; ++m) {
            const size_t off = (size_t)(row0 + m * 16 + fr) * 1024 + c0;
            const uint4 kq0 = *(const uint4*)(kb + off), kq1 = *(const uint4*)(kb + off + 8);
            const unsigned kw[8] = {kq0.x, kq0.y, kq0.z, kq0.w, kq1.x, kq1.y, kq1.z, kq1.w};
#pragma unroll
            for (int n = 0; n < 4; ++n) {
                const float4 a0v = *(const float4*)(a0 + c0 + n * 4), kkv = *(const float4*)(kkw + c0 + n * 4);
                const float a0a[4] = {a0v.x, a0v.y, a0v.z, a0v.w}, kka[4] = {kkv.x, kkv.y, kkv.z, kkv.w};
                const float kf4[4] = {bflo(kw[n * 2]), bfhi(kw[n * 2]), bflo(kw[n * 2 + 1]), bfhi(kw[n * 2 + 1])};
#pragma unroll
                for (int j = 0; j < 4; ++j) { acc[m][n][j] = sigmoidf_(a0a[j] + acc[m][n][j]); const float q = kf4[j] * kka[j]; ss[m] += q * q; }
            }
            asm volatile("" ::: "memory");
        }
#pragma unroll
        for (int m = 0; m < RM; ++m) { ss[m] = xor16_add(ss[m]); ss[m] = xor32_add(ss[m]); ss[m] = fminf(__builtin_amdgcn_rsqf(ss[m]), 1e12f); }
        float4 kkq[4], kaq[4], rkq[4];
#pragma unroll
        for (int n = 0; n < 4; ++n) { kkq[n] = gld_f4(kkw + c0 + n * 4); kaq[n] = gld_f4(kaw + c0 + n * 4); rkq[n] = gld_f4(rk + c0 + n * 4); }
#pragma unroll
        for (int m = 0; m < RM; ++m) {
            const size_t off = (size_t)(row0 + m * 16 + fr) * 1024 + c0;
            const uint4 rq0 = *(const uint4*)(rb + off), rq1 = *(const uint4*)(rb + off + 8), kq0 = *(const uint4*)(kb + off), kq1 = *(const uint4*)(kb + off + 8);
            const unsigned kw[8] = {kq0.x, kq0.y, kq0.z, kq0.w, kq1.x, kq1.y, kq1.z, kq1.w};
            const unsigned rw[8] = {rq0.x, rq0.y, rq0.z, rq0.w, rq1.x, rq1.y, rq1.z, rq1.w};
            unsigned okp[8], onk[8], obb[8];
#pragma unroll
            for (int n = 0; n < 4; ++n) {
                const float kka[4] = {kkq[n].x, kkq[n].y, kkq[n].z, kkq[n].w}, kaa[4] = {kaq[n].x, kaq[n].y, kaq[n].z, kaq[n].w}, rka[4] = {rkq[n].x, rkq[n].y, rkq[n].z, rkq[n].w};
                const float rf[4] = {bflo(rw[n * 2]), bfhi(rw[n * 2]), bflo(rw[n * 2 + 1]), bfhi(rw[n * 2 + 1])}, kf4[4] = {bflo(kw[n * 2]), bfhi(kw[n * 2]), bflo(kw[n * 2 + 1]), bfhi(kw[n * 2 + 1])};
                float kp[4], nk[4], b4[4];
#pragma unroll
                for (int j = 0; j < 4; ++j) {
                    const float a = acc[m][n][j], k = kf4[j], kn = k * kka[j] * ss[m];
                    kp[j] = k * (1.0f + (a - 1.0f) * kaa[j]); nk[j] = -kn; b4[j] = kn * a; bs[m] += rf[j] * kp[j] * rka[j];
                }
                okp[n * 2] = cvt_pk(kp[0], kp[1]); okp[n * 2 + 1] = cvt_pk(kp[2], kp[3]);
                onk[n * 2] = cvt_pk(nk[0], nk[1]); onk[n * 2 + 1] = cvt_pk(nk[2], nk[3]);
                obb[n * 2] = cvt_pk(b4[0], b4[1]); obb[n * 2 + 1] = cvt_pk(b4[2], b4[3]);
            }
            *(uint4*)(kpb + off) = make_uint4(okp[0], okp[1], okp[2], okp[3]); *(uint4*)(kpb + off + 8) = make_uint4(okp[4], okp[5], okp[6], okp[7]);
            *(uint4*)(nkk + off) = make_uint4(onk[0], onk[1], onk[2], onk[3]); *(uint4*)(nkk + off + 8) = make_uint4(onk[4], onk[5], onk[6], onk[7]);
            *(uint4*)(bb + off) = make_uint4(obb[0], obb[1], obb[2], obb[3]); *(uint4*)(bb + off + 8) = make_uint4(obb[4], obb[5], obb[6], obb[7]);
            asm volatile("" ::: "memory");
        }
#pragma unroll
        for (int m = 0; m < RM; ++m) { bs[m] = xor16_add(bs[m]); bs[m] = xor32_add(bs[m]); if (fq == 0) bonus[(size_t)(row0 + m * 16 + fr) * 16 + head] = bs[m]; }
        minigemm<64>(Lw + (size_t)row0 * 64, w2t + (size_t)col0 * 64, fr, fq, acc);
        float4 w0q[4];
#pragma unroll
        for (int n = 0; n < 4; ++n) w0q[n] = gld_f4(w0 + c0 + n * 4);
#pragma unroll
        for (int m = 0; m < RM; ++m) {
            unsigned od[8];
#pragma unroll
            for (int n = 0; n < 4; ++n) {
                const float w0a[4] = {w0q[n].x, w0q[n].y, w0q[n].z, w0q[n].w};
                float dd[4];
#pragma unroll
                for (int j = 0; j < 4; ++j) { const float wl = -softplusf_(-(w0a[j] + acc[m][n][j])) - 0.5f; dd[j] = 1.0f - __expf(-__expf(wl)); }
                od[n * 2] = cvt_pk(dd[0], dd[1]); od[n * 2 + 1] = cvt_pk(dd[2], dd[3]);
            }
            bf16_t* dp_ = decayb + (size_t)(row0 + m * 16 + fr) * 1024 + c0;
            *(uint4*)dp_ = make_uint4(od[0], od[1], od[2], od[3]); *(uint4*)(dp_ + 8) = make_uint4(od[4], od[5], od[6], od[7]);
        }
        minigemm<128>(Lg + (size_t)row0 * 128, g2t + (size_t)col0 * 128, fr, fq, acc);
#pragma unroll
        for (int m = 0; m < RM; ++m) {
            unsigned o[8];
#pragma unroll
            for (int n = 0; n < 4; ++n) { o[n * 2] = cvt_pk(acc[m][n][0], acc[m][n][1]); o[n * 2 + 1] = cvt_pk(acc[m][n][2], acc[m][n][3]); }
            bf16_t* d = gb + (size_t)(row0 + m * 16 + fr) * 1024 + c0;
            *(uint4*)d = make_uint4(o[0], o[1], o[2], o[3]); *(uint4*)(d + 8) = make_uint4(o[4], o[5], o[6], o[7]);
        }
        if (jr > 0) {
            minigemm<32>(Lv + (size_t)row0 * 32, v2t + (size_t)col0 * 32, fr, fq, acc);
#pragma unroll
            for (int m = 0; m < RM; ++m) {
                const size_t off = (size_t)(row0 + m * 16 + fr) * 1024 + c0;
                const uint4 vq0 = *(const uint4*)(vb + off), vq1 = *(const uint4*)(vb + off + 8), fq0 = *(const uint4*)(vf + off), fq1 = *(const uint4*)(vf + off + 8);
                const unsigned vw[8] = {vq0.x, vq0.y, vq0.z, vq0.w, vq1.x, vq1.y, vq1.z, vq1.w}, fw[8] = {fq0.x, fq0.y, fq0.z, fq0.w, fq1.x, fq1.y, fq1.z, fq1.w};
                unsigned o[8];
#pragma unroll
                for (int n = 0; n < 4; ++n) {
                    const float4 v0v = *(const float4*)(v0 + c0 + n * 4); const float v0a[4] = {v0v.x, v0v.y, v0v.z, v0v.w};
                    const float v4[4] = {bflo(vw[n * 2]), bfhi(vw[n * 2]), bflo(vw[n * 2 + 1]), bfhi(vw[n * 2 + 1])}, f4[4] = {bflo(fw[n * 2]), bfhi(fw[n * 2]), bflo(fw[n * 2 + 1]), bfhi(fw[n * 2 + 1])};
                    float o4[4];
#pragma unroll
                    for (int j = 0; j < 4; ++j) o4[j] = v4[j] + (f4[j] - v4[j]) * sigmoidf_(v0a[j] + acc[m][n][j]);
                    o[n * 2] = cvt_pk(o4[0], o4[1]); o[n * 2 + 1] = cvt_pk(o4[2], o4[3]);
                }
                *(uint4*)(vpb + off) = make_uint4(o[0], o[1], o[2], o[3]); *(uint4*)(vpb + off + 8) = make_uint4(o[4], o[5], o[6], o[7]);
            }
        }
    }
}
__device__ __forceinline__ void phase_rw3(PRef p, int jr, char* lds) {
    const int t = tidx(), lane = t & 63, wid = t >> 6, rowq = lane >> 4, jq = lane & 15;
    char* S = p.ws + OFF_SLOT;
    const float* decay = (const float*)S; const bf16_t* nkk = (const bf16_t*)(S + 2 * SLOT); const bf16_t* bb = (const bf16_t*)(S + 3 * SLOT);
    const bf16_t* rb = (const bf16_t*)(S + 6 * SLOT); const bf16_t* kb = (const bf16_t*)(S + 10 * SLOT);
    const bf16_t* vb = (const bf16_t*)(S + (jr == 0 ? 11 : 9) * SLOT); bf16_t* yb = (bf16_t*)(S + 5 * SLOT);
    float* buf = (float*)lds;
    float* ybuf = (float*)(lds + 2 * 16 * 336 * 4);
    for (int item = blockIdx.x; item < 512; item += gridDim.x) {
        const int bh = item >> 2, rg = item & 3, b = bh >> 4, h = bh & 15;
        const size_t base = (size_t)b * 2048 * 1024 + h * 64;
        const bf16_t* vecp[2]; int vdst[2];
#pragma unroll
        for (int u = 0; u < 2; ++u) {
            const int id = t + 256 * u, vec = id >> 7, rem = id & 127, step = rem >> 3, c8 = rem & 7;
            const bf16_t* bp = (vec == 0) ? nkk : (vec == 1) ? bb : (vec == 2) ? kb : rb;
            vecp[u] = bp + base + (size_t)step * 1024 + c8 * 8; vdst[u] = step * 336 + 64 + vec * 64 + c8 * 8;
        }
        const float* dp = decay + base + (size_t)(t >> 4) * 1024 + (t & 15) * 4; const int ddst = (t >> 4) * 336 + (t & 15) * 4;
        const bf16_t* vp = vb + base + (size_t)(t >> 1) * 1024 + rg * 16 + (t & 1) * 8; const int vvdst = (t >> 1) * 336 + 320 + (t & 1) * 8;
        uint4 g0, g1, gv; float4 gd;
        auto fetch = [&](int ch) {
            const size_t o = (size_t)ch * 16 * 1024;
            g0 = gload16(vecp[0] + o); g1 = gload16(vecp[1] + o);
            { const uint4 d_ = gload16(dp + o); gd = make_float4(__uint_as_float(d_.x), __uint_as_float(d_.y), __uint_as_float(d_.z), __uint_as_float(d_.w)); }
            if (t < 32) gv = gload16(vp + o);
        };
        auto stash = [&](float* bf) {
            float f[8];
            unpack8(g0, f); *(float4*)(bf + vdst[0]) = make_float4(f[0], f[1], f[2], f[3]); *(float4*)(bf + vdst[0] + 4) = make_float4(f[4], f[5], f[6], f[7]);
            unpack8(g1, f); *(float4*)(bf + vdst[1]) = make_float4(f[0], f[1], f[2], f[3]); *(float4*)(bf + vdst[1] + 4) = make_float4(f[4], f[5], f[6], f[7]);
            *(float4*)(bf + ddst) = gd;
            if (t < 32) { unpack8(gv, f); *(float4*)(bf + vvdst) = make_float4(f[0], f[1], f[2], f[3]); *(float4*)(bf + vvdst + 4) = make_float4(f[4], f[5], f[6], f[7]); }
        };
        float s0 = 0.f, s1 = 0.f, s2 = 0.f, s3 = 0.f;
        __syncthreads();
        fetch(0); stash(buf); __syncthreads();
        for (int ch = 0; ch < 128; ++ch) {
            if (ch + 1 < 128) fetch(ch + 1);
            const float* bf = buf + (ch & 1) * (16 * 336); float* yb_ = ybuf + (ch & 1) * 256;
            float ykeep = 0.f;
            const float* q0 = bf + jq * 4; const float* v0p = bf + 320 + wid * 4 + rowq;
            float4 nw = *(const float4*)q0, na = *(const float4*)(q0 + 64), nb2 = *(const float4*)(q0 + 128), nk = *(const float4*)(q0 + 192), nr = *(const float4*)(q0 + 256);
            float nv = v0p[0];
#pragma unroll 4
            for (int s = 0; s < 16; ++s) {
                const float4 w = nw, a = na, bq = nb2, k = nk, r = nr; const float vv = nv;
                const float* q = q0 + (s + 1) * 336;
                nw = *(const float4*)q; na = *(const float4*)(q + 64); nb2 = *(const float4*)(q + 128); nk = *(const float4*)(q + 192); nr = *(const float4*)(q + 256);
                nv = v0p[(s + 1) * 336];
                __builtin_amdgcn_sched_barrier(0);
                float sa = s0 * a.x; sa = fmaf(s1, a.y, sa); sa = fmaf(s2, a.z, sa); sa = fmaf(s3, a.w, sa);
                sa = row16_sum(sa);
                s0 = fmaf(s0, w.x, fmaf(sa, bq.x, vv * k.x)); s1 = fmaf(s1, w.y, fmaf(sa, bq.y, vv * k.y));
                s2 = fmaf(s2, w.z, fmaf(sa, bq.z, vv * k.z)); s3 = fmaf(s3, w.w, fmaf(sa, bq.w, vv * k.w));
                float y = s0 * r.x; y = fmaf(s1, r.y, y); y = fmaf(s2, r.z, y); y = fmaf(s3, r.w, y);
                y = row16_sum(y);
                ykeep = (jq == s) ? y : ykeep;
            }
            yb_[jq * 16 + wid * 4 + rowq] = ykeep;
            if (ch + 1 < 128) stash(buf + ((ch + 1) & 1) * (16 * 336));
            __syncthreads();
            if (t < 32) { const int step = t >> 1, hf = t & 1; float f[8];
#pragma unroll
                for (int i = 0; i < 8; ++i) f[i] = yb_[step * 16 + hf * 8 + i];
                *(uint4*)(yb + base + (size_t)(ch * 16 + step) * 1024 + rg * 16 + hf * 8) = pack8(f); }
        }
    }
}
__device__ __forceinline__ uint2 lds_tr16(const char* p) {
    typedef short v4s_t __attribute__((ext_vector_type(4)));
    const v4s_t r = __builtin_amdgcn_ds_read_tr16_b64_v4i16((LAS v4s_t*)p);
    uint2 u; __builtin_memcpy(&u, &r, 8); return u;
}
__device__ __forceinline__ int sw64(int row, int col) { return row * 128 + ((((col >> 3) ^ (row & 7))) << 4) + (col & 7) * 2; }
__device__ __forceinline__ void phase_rw3c(PRef p, int jr, char* lds) {
    const int t = tidx(), lane = t & 63, w = t >> 6, fr = lane & 15, fq = lane >> 4;
    char* S = p.ws + OFF_SLOT;
    const float* decay = (const float*)S; const bf16_t* nkk = (const bf16_t*)(S + 2 * SLOT); const bf16_t* bb = (const bf16_t*)(S + 3 * SLOT);
    const bf16_t* rb = (const bf16_t*)(S + 6 * SLOT); const bf16_t* kb = (const bf16_t*)(S + 10 * SLOT);
    const bf16_t* vb = (const bf16_t*)(S + (jr == 0 ? 11 : 9) * SLOT); bf16_t* yb = (bf16_t*)(S + 5 * SLOT);
    char* const AT = lds;              char* const RT = lds + 4096;  char* const BT = lds + 8192;  char* const KT = lds + 12288;
    float* const PL = (float*)(lds + 16384);
    float* const GAB = (float*)(lds + 43264);
    char* const GAK = lds + 28672;     char* const GRB = lds + 30720; char* const GRK = lds + 32768;
    char* const VT = lds + 34816;      char* const UT = lds + 35840;
    char* const SB = lds + 36864;
    float* const XL = (float*)(lds + 38912);
    float* const PC = (float*)(lds + 40960);
    float* const GS = (float*)(lds + 41216);
    bf16_t* const YB = (bf16_t*)(lds + 42240);
    const int pj = t & 63, ptg = t >> 6;
    const int tk = t >> 3, ck = t & 7;
    const int vtau = t >> 3, vi2 = (t & 7) * 2;
    const int qq = fr >> 2, pp = fr & 3;
    for (int item = blockIdx.x; item < 512; item += gridDim.x) {
        const int bh = ((item >> 3) >> 2) * 8 + (item & 7), rg = (item >> 3) & 3, b = bh >> 4, h = bh & 15;
        const size_t base = (size_t)b * 2048 * 1024 + h * 64;
        __syncthreads();
        for (int i = t; i < 128; i += 256) *(uint4*)(SB + i * 16) = make_uint4(0u, 0u, 0u, 0u);
        f32x4 Sacc = (f32x4){0.f, 0.f, 0.f, 0.f};
        bf16_t gwr[8]; uint4 ra, rb4, rk, rr, rw0, rw1; unsigned gvv = 0;
        auto fetch = [&](int c) {
#pragma unroll
            for (int s2 = 0; s2 < 8; ++s2) gwr[s2] = *(const __attribute__((address_space(1))) bf16_t*)((const bf16_t*)decay + base + (size_t)(c * 32 + ptg * 8 + s2) * 1024 + pj);
            const size_t o = base + (size_t)(c * 32 + tk) * 1024 + ck * 8;
            ra = gload16(nkk + o); rb4 = gload16(bb + o); rk = gload16(kb + o); rr = gload16(rb + o); rw0 = gload16((const bf16_t*)decay + o);
            gvv = *(const __attribute__((address_space(1))) unsigned*)(vb + base + (size_t)(c * 32 + vtau) * 1024 + rg * 16 + vi2);
        };
        fetch(0);
        for (int c = 0; c < 64; ++c) {
            {
                float cum[8]; float run = 1.f;
#pragma unroll
                for (int s2 = 0; s2 < 8; ++s2) { run *= 1.0f - bf2f(gwr[s2]); cum[s2] = run; }
                GS[ptg * 64 + pj] = run;
                __syncthreads();
                const float g0 = GS[pj], g1 = GS[64 + pj], g2 = GS[128 + pj], g3 = GS[192 + pj];
                const float off = (ptg > 0 ? g0 : 1.f) * (ptg > 1 ? g1 : 1.f) * (ptg > 2 ? g2 : 1.f);
                if (ptg == 0) PC[pj] = (g0 * g1) * (g2 * g3);
#pragma unroll
                for (int s2 = 0; s2 < 8; ++s2) PL[(ptg * 8 + s2) * 64 + pj] = off * cum[s2];
            }
            __syncthreads();
            {
                const float4 p0 = *(const float4*)(PL + tk * 64 + ck * 8), p1 = *(const float4*)(PL + tk * 64 + ck * 8 + 4);
                const unsigned ua[4] = {ra.x, ra.y, ra.z, ra.w}, ub[4] = {rb4.x, rb4.y, rb4.z, rb4.w}, uk[4] = {rk.x, rk.y, rk.z, rk.w}, ur[4] = {rr.x, rr.y, rr.z, rr.w};
                const f32x2_t Pp[4] = {{p0.x, p0.y}, {p0.z, p0.w}, {p1.x, p1.y}, {p1.z, p1.w}};
                const f32x2_t Wp[4] = {{1.0f - bflo(rw0.x), 1.0f - bfhi(rw0.x)}, {1.0f - bflo(rw0.y), 1.0f - bfhi(rw0.y)}, {1.0f - bflo(rw0.z), 1.0f - bfhi(rw0.z)}, {1.0f - bflo(rw0.w), 1.0f - bfhi(rw0.w)}};
                unsigned oa[4], orr[4], ob[4], ok[4];
#pragma unroll
                for (int i = 0; i < 4; ++i) {
                    const f32x2_t ei = {__builtin_amdgcn_rcpf(Pp[i].x), __builtin_amdgcn_rcpf(Pp[i].y)};
                    const f32x2_t rw = {__builtin_amdgcn_rcpf(Wp[i].x), __builtin_amdgcn_rcpf(Wp[i].y)};
                    const f32x2_t ex = Pp[i] * rw;
                    const f32x2_t va = {__uint_as_float(ua[i] << 16), __uint_as_float(ua[i] & 0xffff0000u)}, vr = {__uint_as_float(ur[i] << 16), __uint_as_float(ur[i] & 0xffff0000u)};
                    const f32x2_t vb2 = {__uint_as_float(ub[i] << 16), __uint_as_float(ub[i] & 0xffff0000u)}, vk = {__uint_as_float(uk[i] << 16), __uint_as_float(uk[i] & 0xffff0000u)};
                    const f32x2_t xa = va * ex, xr = vr * Pp[i], xb = vb2 * ei, xk = vk * ei;
                    oa[i] = cvt_pk(xa.x, xa.y); orr[i] = cvt_pk(xr.x, xr.y); ob[i] = cvt_pk(xb.x, xb.y); ok[i] = cvt_pk(xk.x, xk.y);
                }
                const int o = tk * 128 + ((ck ^ (tk & 7)) << 4);
                *(uint4*)(AT + o) = make_uint4(oa[0], oa[1], oa[2], oa[3]); *(uint4*)(RT + o) = make_uint4(orr[0], orr[1], orr[2], orr[3]);
                *(uint4*)(BT + o) = make_uint4(ob[0], ob[1], ob[2], ob[3]); *(uint4*)(KT + o) = make_uint4(ok[0], ok[1], ok[2], ok[3]);
                *(bf16_t*)(VT + vi2 * 64 + vtau * 2) = (bf16_t)(gvv & 0xffffu);
                *(bf16_t*)(VT + (vi2 + 1) * 64 + vtau * 2) = (bf16_t)(gvv >> 16);
            }
            if (c + 1 < 64) fetch(c + 1);
            __syncthreads();
            {
                const char* Mt = (w < 2) ? AT : RT; const char* Nt = (w & 1) ? BT : KT;
                f32x4 g[2][2];
#pragma unroll
                for (int m = 0; m < 2; ++m) { g[m][0] = (f32x4){0.f, 0.f, 0.f, 0.f}; g[m][1] = (f32x4){0.f, 0.f, 0.f, 0.f}; }
#pragma unroll
                for (int ks = 0; ks < 2; ++ks) {
                    const int chs = ((ks * 4 + fq) ^ (fr & 7)) << 4;
                    uint4 mf[2], nf[2];
#pragma unroll
                    for (int m = 0; m < 2; ++m) { mf[m] = *(const uint4*)(Mt + (m * 16 + fr) * 128 + chs); nf[m] = *(const uint4*)(Nt + (m * 16 + fr) * 128 + chs); }
#pragma unroll
                    for (int m = 0; m < 2; ++m)
#pragma unroll
                        for (int n = 0; n < 2; ++n) g[m][n] = mfma16(nf[n], mf[m], g[m][n]);
                }
#pragma unroll
                for (int m = 0; m < 2; ++m)
#pragma unroll
                    for (int n = 0; n < 2; ++n) {
                        const int tt = m * 16 + fr, tau0 = n * 16 + fq * 4;
                        f32x4 v4;
#pragma unroll
                        for (int j = 0; j < 4; ++j) { const int tau = tau0 + j; const bool keep = (w < 2) ? (tau < tt) : (tau <= tt); v4[j] = keep ? g[m][n][j] : 0.f; }
                        if (w == 1) *(f32x4*)(GAB + tt * 36 + tau0) = v4;
                        else {
                            char* G = (w == 0) ? GAK : (w == 2) ? GRK : GRB;
                            uint2 o; o.x = cvt_pk(v4[0], v4[1]); o.y = cvt_pk(v4[2], v4[3]);
                            *(uint2*)(G + tt * 64 + tau0 * 2) = o;
                        }
                    }
            }
            __syncthreads();
            if (w < 2) {
                f32x4 x = (f32x4){0.f, 0.f, 0.f, 0.f};
#pragma unroll
                for (int ks = 0; ks < 2; ++ks) {
                    const int chs = ((ks * 4 + fq) ^ (fr & 7)) << 4;
                    x = mfma16(*(const uint4*)(AT + (w * 16 + fr) * 128 + chs), *(const uint4*)(SB + fr * 128 + chs), x);
                }
                x = mfma16(*(const uint4*)(GAK + (w * 16 + fr) * 64 + fq * 16), *(const uint4*)(VT + fr * 64 + fq * 16), x);
                *(f32x4*)(XL + fr * 32 + w * 16 + fq * 4) = x;
            }
            __syncthreads();
            {
                const int tl = lane & 31;
                float Gr[32];
#pragma unroll
                for (int q4 = 0; q4 < 8; ++q4) { const float4 g4 = *(const float4*)(GAB + tl * 36 + q4 * 4); Gr[q4 * 4] = g4.x; Gr[q4 * 4 + 1] = g4.y; Gr[q4 * 4 + 2] = g4.z; Gr[q4 * 4 + 3] = g4.w; }
                float acc[4];
#pragma unroll
                for (int r = 0; r < 4; ++r) acc[r] = XL[(4 * w + r) * 32 + tl];
#pragma unroll
                for (int tau = 0; tau < 31; ++tau)
#pragma unroll
                    for (int r = 0; r < 4; ++r) acc[r] = fmaf(__int_as_float(__builtin_amdgcn_readlane(__float_as_int(acc[r]), tau)), Gr[tau], acc[r]);
                if (lane < 32) {
#pragma unroll
                    for (int r = 0; r < 4; ++r) *(bf16_t*)(UT + (4 * w + r) * 64 + tl * 2) = f2bf(acc[r]);
                }
            }
            __syncthreads();
            if (w < 2) {
                f32x4 y = (f32x4){0.f, 0.f, 0.f, 0.f};
#pragma unroll
                for (int ks = 0; ks < 2; ++ks) {
                    const int chs = ((ks * 4 + fq) ^ (fr & 7)) << 4;
                    y = mfma16(*(const uint4*)(RT + (w * 16 + fr) * 128 + chs), *(const uint4*)(SB + fr * 128 + chs), y);
                }
                y = mfma16(*(const uint4*)(GRB + (w * 16 + fr) * 64 + fq * 16), *(const uint4*)(UT + fr * 64 + fq * 16), y);
                y = mfma16(*(const uint4*)(GRK + (w * 16 + fr) * 64 + fq * 16), *(const uint4*)(VT + fr * 64 + fq * 16), y);
#pragma unroll
                for (int j = 0; j < 4; ++j) YB[(w * 16 + fq * 4 + j) * 16 + fr] = f2bf(y[j]);
            }
            {
                const int r0 = fq * 8 + qq, kc = 2 * w + (pp >> 1);
                const int o0 = r0 * 128 + ((kc ^ (r0 & 7)) << 4) + (pp & 1) * 8, o1 = (r0 + 4) * 128 + ((kc ^ ((r0 + 4) & 7)) << 4) + (pp & 1) * 8;
                const uint2 blo = lds_tr16(BT + o0), bhi = lds_tr16(BT + o1), klo = lds_tr16(KT + o0), khi = lds_tr16(KT + o1);
                Sacc = mfma16(make_uint4(blo.x, blo.y, bhi.x, bhi.y), *(const uint4*)(UT + fr * 64 + fq * 16), Sacc);
                Sacc = mfma16(make_uint4(klo.x, klo.y, khi.x, khi.y), *(const uint4*)(VT + fr * 64 + fq * 16), Sacc);
                const float4 pc = *(const float4*)(PC + 16 * w + fq * 4);
                Sacc[0] *= pc.x; Sacc[1] *= pc.y; Sacc[2] *= pc.z; Sacc[3] *= pc.w;
            }
            __syncthreads();
            {
                uint2 o; o.x = cvt_pk(Sacc[0], Sacc[1]); o.y = cvt_pk(Sacc[2], Sacc[3]);
                *(uint2*)(SB + fr * 128 + ((((2 * w + (fq >> 1))) ^ (fr & 7)) << 4) + (fq & 1) * 8) = o;
                if (t < 64) {
                    const int tt = t >> 1, hf = t & 1;
                    const uint4 yv_ = *(const uint4*)((const char*)YB + tt * 32 + hf * 16); const u32x4_t yx_ = {yv_.x, yv_.y, yv_.z, yv_.w};
                    *(__attribute__((address_space(1))) u32x4_t*)(yb + base + (size_t)(c * 32 + tt) * 1024 + rg * 16 + hf * 8) = yx_;
                }
            }
        }
    }
}
struct LdRw4 {
    struct Raw { uint4 y, v, g; float bn; };
    const bf16_t *y, *v, *g; const float *bonus, *gng, *gnb;
    __device__ __forceinline__ Raw fetch(int, int r, int kc) const {
        Raw q; const size_t o = (size_t)r * 1024 + kc * 8;
        q.y = *(const uint4*)(y + o); q.v = *(const uint4*)(v + o); q.g = *(const uint4*)(g + o); q.bn = bonus[r * 16 + (kc >> 3)]; return q;
    }
    __device__ __forceinline__ uint4 finish(const Raw& q, int, int, int kc) const {
        float yf[8], vf[8], gf[8]; unpack8(q.y, yf); unpack8(q.v, vf); unpack8(q.g, gf);
        float s = 0.f, s2 = 0.f;
#pragma unroll
        for (int i = 0; i < 8; ++i) { s += yf[i]; s2 += yf[i] * yf[i]; }
        s = oct_sum(s); s2 = oct_sum(s2);
        const float mean = s * (1.0f / 64.0f), var = fmaxf(s2 * (1.0f / 64.0f) - mean * mean, 0.f), rstd = rsqrtf(var + 64e-5f);
        const float4 ga = *(const float4*)(gng + kc * 8), gb = *(const float4*)(gng + kc * 8 + 4), ba = *(const float4*)(gnb + kc * 8), bb = *(const float4*)(gnb + kc * 8 + 4);
        const float gg[8] = {ga.x, ga.y, ga.z, ga.w, gb.x, gb.y, gb.z, gb.w}, bq[8] = {ba.x, ba.y, ba.z, ba.w, bb.x, bb.y, bb.z, bb.w};
        float o[8];
#pragma unroll
        for (int i = 0; i < 8; ++i) o[i] = ((yf[i] - mean) * rstd * gg[i] + bq[i] + q.bn * vf[i]) * gf[i];
        return pack8(o);
    }
};
__device__ __forceinline__ void phase_rw4(PRef p, int jr, char* lds) {
    char* S = p.ws + OFF_SLOT;
    const bf16_t* yb = (const bf16_t*)(S + 5 * SLOT); const bf16_t* gb = (const bf16_t*)(S + 4 * SLOT);
    const bf16_t* vb = (const bf16_t*)(S + (jr == 0 ? 11 : 9) * SLOT); bf16_t* ymix = (bf16_t*)(S + 6 * SLOT);
    const bf16_t* wt = (const bf16_t*)(p.ws + W_OUT) + (size_t)jr * 1024 * 1024;
    const float* bonus = (const float*)(p.ws + OFF_BONUS);
    const int t_ = tidx(); const int lane = t_ & 63, wid = t_ >> 6, wr = wid >> 1, wc = wid & 1, fr = lane & 15, fq = lane >> 4;
    for (int id = blockIdx.x; id < 128 * 8; id += gridDim.x) {
        int mt, nt; tile_map(id, 8, mt, nt);
        const size_t ro = (size_t)mt * 128 * 1024;
        LdRw4 al{yb + ro, vb + ro, gb + ro, bonus + (size_t)mt * 128 * 16, p.in[22] + jr * 1024, p.in[23] + jr * 1024};
        const bf16_t* br[4];
        { const int t2_ = tidx(), r0_ = t2_ >> 3, co_ = glds_chunk(t2_) * 8;
#pragma unroll
          for (int i = 0; i < 4; ++i) br[i] = wt + (size_t)(nt * 128 + r0_ + 32 * i) * 1024 + co_; }
        f32x4 acc[4][4];
        gemm_rg(lds, 16, al, br, acc);
#pragma unroll
        for (int n = 0; n < 4; ++n)
#pragma unroll
            for (int m = 0; m < 4; ++m) {
                uint2 o; o.x = cvt_pk(acc[m][n][0], acc[m][n][1]); o.y = cvt_pk(acc[m][n][2], acc[m][n][3]);
                *(uint2*)(ymix + (size_t)(mt * 128 + wr * 64 + m * 16 + fr) * 1024 + nt * 128 + wc * 64 + n * 16 + fq * 4) = o;
            }
    }
}

__device__ __forceinline__ void phase_cml(PRef p) {
    const int t = tidx();
    char* S = p.ws + OFF_SLOT;
    const bf16_t* src = (const bf16_t*)(S + 1 * SLOT); bf16_t* dst = (bf16_t*)(S + 8 * SLOT);
    const int col = (t & 127) * 8, half = t >> 7;
    float cw[4][8], cb[8];
#pragma unroll
    for (int j = 0; j < 4; ++j) {
        const float4 a = *(const float4*)(p.in[27] + j * 1024 + col), b = *(const float4*)(p.in[27] + j * 1024 + col + 4);
        cw[j][0] = a.x; cw[j][1] = a.y; cw[j][2] = a.z; cw[j][3] = a.w; cw[j][4] = b.x; cw[j][5] = b.y; cw[j][6] = b.z; cw[j][7] = b.w;
    }
    { const float4 a = *(const float4*)(p.in[28] + col), b = *(const float4*)(p.in[28] + col + 4);
      cb[0] = a.x; cb[1] = a.y; cb[2] = a.z; cb[3] = a.w; cb[4] = b.x; cb[5] = b.y; cb[6] = b.z; cb[7] = b.w; }
    const float qs = (col < 512) ? 0.125f : 1.0f;
    for (int item = blockIdx.x; item < 1024; item += gridDim.x) {
        const int b = item >> 7, s0 = (item & 127) * 16 + half * 8;
        const bf16_t* base = src + (size_t)b * 2048 * 1024 + col;
        uint4 r[11];
#pragma unroll
        for (int i = 0; i < 11; ++i) { const int sr = s0 - 3 + i; r[i] = gload16(base + (size_t)max(sr, 0) * 1024); if (sr < 0) r[i] = make_uint4(0u, 0u, 0u, 0u); }
        float x0[8], x1[8], x2[8];
        unpack8(r[0], x0); unpack8(r[1], x1); unpack8(r[2], x2);
#pragma unroll
        for (int i = 0; i < 8; ++i) {
            float x3[8], a[8]; unpack8(r[i + 3], x3);
#pragma unroll
            for (int e = 0; e < 8; ++e) { a[e] = cb[e] + cw[0][e] * x0[e] + cw[1][e] * x1[e] + cw[2][e] * x2[e] + cw[3][e] * x3[e]; a[e] = siluf_(a[e]) * qs; }
            *(uint4*)(dst + ((size_t)b * 2048 + s0 + i) * 1024 + col) = pack8(a);
#pragma unroll
            for (int e = 0; e < 8; ++e) { x0[e] = x1[e]; x1[e] = x2[e]; x2[e] = x3[e]; }
        }
    }
}
__device__ __forceinline__ void phase_ml2(PRef p, char* lds) {
    const int t = tidx(), lane = t & 63, w = t >> 6, fr = lane & 15, fq = lane >> 4;
    char* S = p.ws + OFF_SLOT;
    const bf16_t* qk = (const bf16_t*)(S + 8 * SLOT); const bf16_t* vb = (const bf16_t*)(S + 2 * SLOT); bf16_t* yb = (bf16_t*)(S + 4 * SLOT);
    const float* gates = (const float*)(p.ws + OFF_GATES); float* stat = (float*)(p.ws + OFF_STAT);
    char* const RAW = lds;
    char* const QT = lds + 17408; char* const KT = lds + 25600;
    char* const VT = lds + 33792;
    char* const VX = lds + 35840;
    char* const PB = lds + 39936;
    char* const CT = lds + 48128;
    float* const FS = (float*)(lds + 52224); float* const GJ = FS + 64; float* const WJ = FS + 128;
    float* const CW = (float*)(lds + 53248);
    const int qq = fr >> 2, pp = fr & 3;
    for (int item = blockIdx.x; item < 512; item += gridDim.x) {
        const int bh = ((item >> 3) >> 3) * 8 + (item & 7), vs = (item >> 3) & 7, b = bh >> 3, hd = bh & 7;
        const size_t tok0 = (size_t)b * 2048;
        __syncthreads();
        for (int i = t; i < 256; i += 256) *(uint4*)(CT + i * 16) = make_uint4(0u, 0u, 0u, 0u);
        f32x4 Cacc[2] = {(f32x4){0.f, 0.f, 0.f, 0.f}, (f32x4){0.f, 0.f, 0.f, 0.f}};
        uint4 gr0, gr1, gr2, gr3; uint4 gv = make_uint4(0u, 0u, 0u, 0u); float gg = 0.f;
        const int frr = t >> 4, fc = t & 15;
        const bf16_t* const qkt = qk + (tok0 + frr) * 1024 + (fc >> 3) * 512 + hd * 64 + (fc & 7) * 8;
        char* const qkd = ((fc < 8) ? QT : KT) + frr * 128 + (((fc & 7) ^ (frr & 7)) << 4);
        auto fetch = [&](int ch) {
            const int s0 = ch * 64;
            const bf16_t* q0 = qkt + (size_t)s0 * 1024;
            gr0 = gload16(q0); gr1 = gload16(q0 + 16 * 1024); gr2 = gload16(q0 + 32 * 1024); gr3 = gload16(q0 + 48 * 1024);
            if (t < 128) { gv = gload16(vb + (tok0 + s0 + (t >> 1)) * 1024 + hd * 128 + vs * 16 + (t & 1) * 8);
                           gg = *(const __attribute__((address_space(1))) float*)(gates + (tok0 + s0 + (t & 63)) * 16 + (t >> 6) * 8 + hd); }
        };
        fetch(0);
        for (int ch = 0; ch < 32; ++ch) {
            const int s0 = ch * 64;
            *(uint4*)qkd = gr0; *(uint4*)(qkd + 16 * 128) = gr1; *(uint4*)(qkd + 32 * 128) = gr2; *(uint4*)(qkd + 48 * 128) = gr3;
            if (t < 128) *(uint4*)(VT + t * 16) = gv;
            float vf8[8]; unpack8(gv, vf8);
            if (t >= 64 && t < 128) GJ[t - 64] = gg;
            const float ggc = gg;
            if (ch + 1 < 32) fetch(ch + 1);
            __syncthreads();
            if (t < 64) {
                float f = GJ[t];
                f += __builtin_amdgcn_update_dpp(0.f, f, 0x111, 0xf, 0xf, false);
                f += __builtin_amdgcn_update_dpp(0.f, f, 0x112, 0xf, 0xf, false);
                f += __builtin_amdgcn_update_dpp(0.f, f, 0x114, 0xf, 0xf, false);
                f += __builtin_amdgcn_update_dpp(0.f, f, 0x118, 0xf, 0xf, false);
                f += __builtin_amdgcn_update_dpp(0.f, f, 0x142, 0xa, 0xf, false);
                f += __builtin_amdgcn_update_dpp(0.f, f, 0x143, 0xc, 0xf, false);
                const float fend = __int_as_float(__builtin_amdgcn_readlane(__float_as_int(f), 63));
                FS[t] = f; WJ[t] = __expf(fend - f + ggc);
                GJ[t] = ggc - f;
            }
            __syncthreads();
            const float efend = __expf(FS[63]);
            {
                if (t < 128) {
                    const int j = t >> 1; const float wj = WJ[j];
                    float f[8];
#pragma unroll
                    for (int i = 0; i < 8; ++i) f[i] = vf8[i] * wj;
                    *(uint4*)(VX + j * 64 + (t & 1) * 16) = pack8(f);
                    float g8[8] = {0.f, 0.f, 0.f, 0.f, 0.f, 0.f, 0.f, 0.f}; if ((t & 1) == 0) g8[0] = wj;
                    *(uint4*)(VX + j * 64 + 32 + (t & 1) * 16) = pack8(g8);
                }
            }
            __syncthreads();
            const int srow = 16 * w + fr;
            f32x4 Sacc[4], Xacc[2];
#pragma unroll
            for (int n = 0; n < 4; ++n) Sacc[n] = (f32x4){0.f, 0.f, 0.f, 0.f};
            Xacc[0] = (f32x4){0.f, 0.f, 0.f, 0.f}; Xacc[1] = (f32x4){0.f, 0.f, 0.f, 0.f};
            Cacc[0] *= efend; Cacc[1] *= efend;
#pragma unroll
            for (int ks = 0; ks < 2; ++ks) {
                const int chs = ((ks * 4 + fq) ^ (fr & 7)) << 4;
                const uint4 qf = *(const uint4*)(QT + srow * 128 + chs);
#pragma unroll
                for (int n = 0; n < 4; ++n) { const uint4 kf = *(const uint4*)(KT + (n * 16 + fr) * 128 + chs); Sacc[n] = mfma16(kf, qf, Sacc[n]); }
#pragma unroll
                for (int nn = 0; nn < 2; ++nn) { const uint4 rf = *(const uint4*)(CT + (nn * 16 + fr) * 128 + chs); Xacc[nn] = mfma16(rf, qf, Xacc[nn]); }
                const int r0 = ks * 32 + fq * 8 + qq, kc = 2 * w + (pp >> 1);
                const uint2 klo = lds_tr16(KT + r0 * 128 + ((kc ^ (r0 & 7)) << 4) + (pp & 1) * 8);
                const uint2 khi = lds_tr16(KT + (r0 + 4) * 128 + ((kc ^ ((r0 + 4) & 7)) << 4) + (pp & 1) * 8);
                const uint4 kt = make_uint4(klo.x, klo.y, khi.x, khi.y);
#pragma unroll
                for (int m = 0; m < 2; ++m) {
                    const uint2 vlo = lds_tr16(VX + r0 * 64 + (16 * m + 4 * pp) * 2), vhi = lds_tr16(VX + (r0 + 4) * 64 + (16 * m + 4 * pp) * 2);
                    Cacc[m] = mfma16(kt, make_uint4(vlo.x, vlo.y, vhi.x, vhi.y), Cacc[m]);
                }
            }
            const float fs = FS[srow];
            float dsum = 0.f;
#pragma unroll
            for (int n = 0; n < 4; ++n) {
                const float4 g4 = *(const float4*)(GJ + n * 16 + fq * 4); const float ga[4] = {g4.x, g4.y, g4.z, g4.w};
                float pv[4];
#pragma unroll
                for (int j = 0; j < 4; ++j) { const int jc = n * 16 + fq * 4 + j; pv[j] = (srow >= jc) ? Sacc[n][j] * __expf(fs + ga[j]) : 0.f; dsum += pv[j]; }
                uint2 o; o.x = cvt_pk(pv[0], pv[1]); o.y = cvt_pk(pv[2], pv[3]);
                *(uint2*)(PB + srow * 128 + (((n * 2 + (fq >> 1)) ^ (fr & 7)) << 4) + (fq & 1) * 8) = o;
            }
            dsum = xor16_add(dsum); dsum = xor32_add(dsum);
            f32x4 Iacc = (f32x4){0.f, 0.f, 0.f, 0.f};
#pragma unroll
            for (int ks = 0; ks < 2; ++ks) {
                const uint4 pf = *(const uint4*)(PB + srow * 128 + (((ks * 4 + fq) ^ (fr & 7)) << 4));
                const int r0 = ks * 32 + fq * 8 + qq;
                const uint2 vlo = lds_tr16(VT + r0 * 32 + (4 * pp) * 2), vhi = lds_tr16(VT + (r0 + 4) * 32 + (4 * pp) * 2);
                Iacc = mfma16(make_uint4(vlo.x, vlo.y, vhi.x, vhi.y), pf, Iacc);
            }
            const float efs = __expf(fs);
            const float ndq = __shfl(Xacc[1][0], fr);
            const float den = dsum + efs * ndq;
            const float rden = __builtin_amdgcn_rcpf(fmaxf(fabsf(den), 1.0f));
            const size_t tok = tok0 + s0 + srow;
            float o4[4];
#pragma unroll
            for (int j = 0; j < 4; ++j) o4[j] = (Iacc[j] + efs * Xacc[0][j]) * rden;
            gst_u2(yb + tok * 1024 + hd * 128 + vs * 16 + fq * 4, cvt_pk(o4[0], o4[1]), cvt_pk(o4[2], o4[3]));
            __syncthreads();
#pragma unroll
            for (int m = 0; m < 2; ++m) {
                const int v = m * 16 + fr;
                uint2 o; o.x = cvt_pk(Cacc[m][0], Cacc[m][1]); o.y = cvt_pk(Cacc[m][2], Cacc[m][3]);
                *(uint2*)(CT + v * 128 + (((2 * w + (fq >> 1)) ^ (v & 7)) << 4) + (fq & 1) * 8) = o;
            }
        }
    }
}
template <int HSHIFT  , int NH>
struct LdGnGate {
    struct Raw { uint4 y, g; };
    const bf16_t *y, *g; int ld; const float *gng, *gnb; const float* st;
    __device__ __forceinline__ Raw fetch(int, int r, int kc) const { Raw q; const size_t o = (size_t)r * ld + kc * 8; q.y = *(const uint4*)(y + o); q.g = *(const uint4*)(g + o); return q; }
    __device__ __forceinline__ uint4 finish(const Raw& q, int, int r, int kc) const {
        float yf[8], gf[8]; unpack8(q.y, yf); unpack8(q.g, gf);
        const float2 ms = *(const float2*)(st + (r * NH + ((kc * 8) >> HSHIFT)) * 2);
        const float4 ga = *(const float4*)(gng + kc * 8), gb = *(const float4*)(gng + kc * 8 + 4), ba = *(const float4*)(gnb + kc * 8), bb = *(const float4*)(gnb + kc * 8 + 4);
        const float gg[8] = {ga.x, ga.y, ga.z, ga.w, gb.x, gb.y, gb.z, gb.w}, bq[8] = {ba.x, ba.y, ba.z, ba.w, bb.x, bb.y, bb.z, bb.w};
        float o[8];
#pragma unroll
        for (int i = 0; i < 8; ++i) o[i] = ((yf[i] - ms.x) * ms.y * gg[i] + bq[i]) * gf[i];
        return pack8(o);
    }
};
template <int HSHIFT, int NH, int NPART>
__device__ __forceinline__ void phase_outproj_gn(PRef p, char* lds, const bf16_t* yb, const bf16_t* gate, int K, const bf16_t* wt, const float* gng, const float* gnb, bf16_t* ymix) {
    const int t = tidx(), lane = t & 63, wid = t >> 6, wr = wid >> 1, wc = wid & 1, fr = lane & 15, fq = lane >> 4;
    const float* stat = (const float*)(p.ws + OFF_STAT);
    float* st = (float*)(lds + 65536);
    const float invn = 1.0f / (float)(1 << HSHIFT);
    for (int id = blockIdx.x; id < 128 * 8; id += gridDim.x) {
        int mt, nt; tile_map(id, 8, mt, nt);
        for (int i = t; i < 128 * NH; i += 256) {
            const float* q = stat + ((size_t)mt * 128 * NH + i) * NPART * 2;
            float s = 0.f, s2 = 0.f;
#pragma unroll
            for (int j = 0; j < NPART; ++j) { const float2 v = *(const float2*)(q + j * 2); s += v.x; s2 += v.y; }
            const float mean = s * invn, var = fmaxf(s2 * invn - mean * mean, 0.f);
            st[i * 2] = mean; st[i * 2 + 1] = rsqrtf(var + 1e-6f);
        }
        __syncthreads();
        const size_t ro = (size_t)mt * 128 * K;
        LdGnGate<HSHIFT, NH> al{yb + ro, gate + ro, K, gng, gnb, st};
        const bf16_t* br[4];
        { const int r0_ = t >> 3, co_ = glds_chunk(t) * 8;
#pragma unroll
          for (int i = 0; i < 4; ++i) br[i] = wt + (size_t)(nt * 128 + r0_ + 32 * i) * K + co_; }
        f32x4 acc[4][4];
        gemm_rg(lds, K / 64, al, br, acc);
#pragma unroll
        for (int n = 0; n < 4; ++n)
#pragma unroll
            for (int m = 0; m < 4; ++m) {
                uint2 o; o.x = cvt_pk(acc[m][n][0], acc[m][n][1]); o.y = cvt_pk(acc[m][n][2], acc[m][n][3]);
                *(uint2*)(ymix + (size_t)(mt * 128 + wr * 64 + m * 16 + fr) * 1024 + nt * 128 + wc * 64 + n * 16 + fq * 4) = o;
            }
    }
}

__device__ __forceinline__ void phase_rt2(PRef p, char* lds) {
    const int t = tidx(), lane = t & 63, w = t >> 6, fr = lane & 15, fq = lane >> 4;
    char* S = p.ws + OFF_SLOT;
    const bf16_t* qb = (const bf16_t*)(S + 1 * SLOT); const bf16_t* kb = (const bf16_t*)(S + 2 * SLOT); const bf16_t* vb = (const bf16_t*)(S + 3 * SLOT);
    bf16_t* yb = (bf16_t*)(S + 7 * SLOT); float* stat = (float*)(p.ws + OFF_STAT);
    char* const VB = lds + 32768; char* const PB = lds + 49152; char* const RT = lds + 57344;
    const int gco = glds_chunk(t) * 8, gr0 = t >> 3;
    const int qq = fr >> 2, pp = fr & 3;
    for (int item = blockIdx.x; item < 512; item += gridDim.x) {
        const int bh = ((item >> 3) >> 4) * 8 + (item & 7), vs = (item >> 3) & 15, b = bh >> 2, hd = bh & 3;
        const size_t tok0 = (size_t)b * 2048;
        const float lg2 = log2f(1.0f - __builtin_amdgcn_exp2f(-5.0f - (float)hd));
        const float dec64 = __builtin_amdgcn_exp2f(64.0f * lg2);
        const bf16_t* qsrc = qb + (tok0 + gr0) * 1024 + hd * 256 + gco;
        const bf16_t* ksrc = kb + (tok0 + gr0) * 1024 + hd * 256 + gco;
        const bf16_t* vsrc = vb + (tok0 + (t >> 2)) * 2048 + hd * 512 + vs * 32 + (t & 3) * 8;
        f32x4 Racc[4][2];
#pragma unroll
        for (int a = 0; a < 4; ++a) { Racc[a][0] = (f32x4){0.f, 0.f, 0.f, 0.f}; Racc[a][1] = (f32x4){0.f, 0.f, 0.f, 0.f}; }
        __syncthreads();
        for (int i = t; i < 1024; i += 256) *(uint4*)(RT + i * 16) = make_uint4(0u, 0u, 0u, 0u);
        auto issue = [&](int pc) {
            const unsigned d = (unsigned)__builtin_amdgcn_readfirstlane((int)(lds_addr_u(lds) + (pc & 1) * 16384 + w * 1024));
            const size_t go = (size_t)(pc >> 2) * 64 * 1024 + (pc & 3) * 64;
#pragma unroll
            for (int i = 0; i < 2; ++i) { glds16_asm(qsrc + go + (size_t)i * 32 * 1024, d + i * 4096); glds16_asm(ksrc + go + (size_t)i * 32 * 1024, d + 8192 + i * 4096); }
        };
        auto put_v = [&](const uint4& raw, int ch) {
            char* vbuf = VB + (ch & 1) * 8192; const int j = t >> 2;
            *(uint4*)(vbuf + j * 64 + (t & 3) * 16) = raw;
            float f[8]; unpack8(raw, f); const float sc = __builtin_amdgcn_exp2f(lg2 * (float)(63 - j));
#pragma unroll
            for (int i = 0; i < 8; ++i) f[i] *= sc;
            *(uint4*)(vbuf + 4096 + j * 64 + (t & 3) * 16) = pack8(f);
        };
        issue(0);
        { const uint4 v0 = gld_u4(vsrc); put_v(v0, 0); }
        asm volatile("s_waitcnt vmcnt(0)" ::: "memory");
        __syncthreads();
        f32x4 Sacc[4], Xacc[2];
        uint4 vnext = make_uint4(0u, 0u, 0u, 0u);
        for (int ch = 0; ch < 32; ++ch) {
            const char* vbuf = VB + (ch & 1) * 8192;
#pragma unroll
            for (int qd = 0; qd < 4; ++qd) {
                const int pc = ch * 4 + qd;
                if (pc + 1 < 128) issue(pc + 1);
                if (qd == 0) {
                    if (ch + 1 < 32) vnext = gld_u4(vsrc + (size_t)(ch + 1) * 64 * 2048);
#pragma unroll
                    for (int n = 0; n < 4; ++n) Sacc[n] = (f32x4){0.f, 0.f, 0.f, 0.f};
                    Xacc[0] = (f32x4){0.f, 0.f, 0.f, 0.f}; Xacc[1] = (f32x4){0.f, 0.f, 0.f, 0.f};
                }
                const char* qk = lds + (pc & 1) * 16384;
                Racc[qd][0] *= dec64; Racc[qd][1] *= dec64;
#pragma unroll
                for (int ks = 0; ks < 2; ++ks) {
                    const int chs = ((ks * 4 + fq) ^ (fr & 7)) << 4;
                    const uint4 qf = *(const uint4*)(qk + (16 * w + fr) * 128 + chs);
#pragma unroll
                    for (int n = 0; n < 4; ++n) { const uint4 kf = *(const uint4*)(qk + 8192 + (n * 16 + fr) * 128 + chs); Sacc[n] = mfma16(kf, qf, Sacc[n]); }
#pragma unroll
                    for (int nn = 0; nn < 2; ++nn) {
                        const int v = nn * 16 + fr;
                        const uint4 rf = *(const uint4*)(RT + v * 512 + (((qd * 8 + ks * 4 + fq) ^ (v & 7)) << 4));
                        Xacc[nn] = mfma16(rf, qf, Xacc[nn]);
                    }
                    const int r0 = ks * 32 + fq * 8 + qq;
                    const int kc = 2 * w + (pp >> 1);
                    const uint2 klo = lds_tr16(qk + 8192 + r0 * 128 + ((kc ^ (r0 & 7)) << 4) + (pp & 1) * 8);
                    const uint2 khi = lds_tr16(qk + 8192 + (r0 + 4) * 128 + ((kc ^ ((r0 + 4) & 7)) << 4) + (pp & 1) * 8);
                    const uint4 kt = make_uint4(klo.x, klo.y, khi.x, khi.y);
#pragma unroll
                    for (int m = 0; m < 2; ++m) {
                        const uint2 vlo = lds_tr16(vbuf + 4096 + r0 * 64 + (16 * m + 4 * pp) * 2), vhi = lds_tr16(vbuf + 4096 + (r0 + 4) * 64 + (16 * m + 4 * pp) * 2);
                        Racc[qd][m] = mfma16(kt, make_uint4(vlo.x, vlo.y, vhi.x, vhi.y), Racc[qd][m]);
                    }
                }
                if (qd == 2 && ch + 1 < 32) put_v(vnext, ch + 1);
                asm volatile("s_waitcnt vmcnt(0)" ::: "memory");
                __syncthreads();
#pragma unroll
                for (int m = 0; m < 2; ++m) {
                    const int v = m * 16 + fr, cch = qd * 8 + 2 * w + (fq >> 1);
                    uint2 o; o.x = cvt_pk(Racc[qd][m][0], Racc[qd][m][1]); o.y = cvt_pk(Racc[qd][m][2], Racc[qd][m][3]);
                    *(uint2*)(RT + v * 512 + ((cch ^ (v & 7)) << 4) + (fq & 1) * 8) = o;
                }
            }
            const int srow = 16 * w + fr;
#pragma unroll
            for (int n = 0; n < 4; ++n) {
                float pv[4];
#pragma unroll
                for (int j = 0; j < 4; ++j) { const int jc = n * 16 + fq * 4 + j; pv[j] = (srow >= jc) ? Sacc[n][j] * __builtin_amdgcn_exp2f(lg2 * (float)(srow - jc)) : 0.f; }
                uint2 o; o.x = cvt_pk(pv[0], pv[1]); o.y = cvt_pk(pv[2], pv[3]);
                *(uint2*)(PB + srow * 128 + (((n * 2 + (fq >> 1)) ^ (fr & 7)) << 4) + (fq & 1) * 8) = o;
            }
            f32x4 Iacc[2] = {(f32x4){0.f, 0.f, 0.f, 0.f}, (f32x4){0.f, 0.f, 0.f, 0.f}};
#pragma unroll
            for (int ks = 0; ks < 2; ++ks) {
                const uint4 pf = *(const uint4*)(PB + srow * 128 + (((ks * 4 + fq) ^ (fr & 7)) << 4));
                const int r0 = ks * 32 + fq * 8 + qq;
#pragma unroll
                for (int nn = 0; nn < 2; ++nn) {
                    const uint2 vlo = lds_tr16(vbuf + r0 * 64 + (16 * nn + 4 * pp) * 2), vhi = lds_tr16(vbuf + (r0 + 4) * 64 + (16 * nn + 4 * pp) * 2);
                    Iacc[nn] = mfma16(make_uint4(vlo.x, vlo.y, vhi.x, vhi.y), pf, Iacc[nn]);
                }
            }
            const float qdec = __builtin_amdgcn_exp2f(lg2 * (float)(srow + 1));
            const size_t tok = tok0 + (size_t)ch * 64 + srow;
#pragma unroll
            for (int nn = 0; nn < 2; ++nn) {
                float o4[4];
#pragma unroll
                for (int j = 0; j < 4; ++j) o4[j] = Iacc[nn][j] + Xacc[nn][j] * qdec;
                gst_u2(yb + tok * 2048 + hd * 512 + vs * 32 + nn * 16 + fq * 4, cvt_pk(o4[0], o4[1]), cvt_pk(o4[2], o4[3]));
            }
        }
        __syncthreads();
    }
}

__device__ __forceinline__ void phase_zrw(PRef p, int jr) {
    const int t_ = tidx(); const int lane = t_ & 63, gw = blockIdx.x * 4 + (t_ >> 6), nw = gridDim.x * 4;
    char* S = p.ws + OFF_SLOT;
    const bf16_t* yb = (const bf16_t*)(S + 5 * SLOT); const bf16_t* gb = (const bf16_t*)(S + 4 * SLOT);
    const bf16_t* vb = (const bf16_t*)(S + (jr == 0 ? 11 : 9) * SLOT); bf16_t* zb = (bf16_t*)(S + 7 * SLOT);
    const float* bonus = (const float*)(p.ws + OFF_BONUS);
    float gg[16], bq[16]; row_load_f32(p.in[22] + jr * 1024, gg, lane); row_load_f32(p.in[23] + jr * 1024, bq, lane);
    const int rpw = NTOK / nw, first = gw * rpw, end = first + rpw;
    uint2 ny[4], nv[4], ng[4]; float nbn[4];
    auto load_in = [&](int r) {
#pragma unroll
        for (int c = 0; c < 4; ++c) { const size_t o = (size_t)r * 1024 + c * 256 + lane * 4; ny[c] = *(const uint2*)(yb + o); nv[c] = *(const uint2*)(vb + o); ng[c] = *(const uint2*)(gb + o);
                                      nbn[c] = bonus[(size_t)r * 16 + c * 4 + (lane >> 4)]; }
    };
    load_in(first);
    for (int r = first; r < end; ++r) {
        float y[16], v[16], g[16], bn[4];
#pragma unroll
        for (int c = 0; c < 4; ++c) {
            y[c * 4] = bflo(ny[c].x); y[c * 4 + 1] = bfhi(ny[c].x); y[c * 4 + 2] = bflo(ny[c].y); y[c * 4 + 3] = bfhi(ny[c].y);
            v[c * 4] = bflo(nv[c].x); v[c * 4 + 1] = bfhi(nv[c].x); v[c * 4 + 2] = bflo(nv[c].y); v[c * 4 + 3] = bfhi(nv[c].y);
            g[c * 4] = bflo(ng[c].x); g[c * 4 + 1] = bfhi(ng[c].x); g[c * 4 + 2] = bflo(ng[c].y); g[c * 4 + 3] = bfhi(ng[c].y);
            bn[c] = nbn[c];
        }
        if (r + 1 < end) load_in(r + 1);
        __builtin_amdgcn_sched_barrier(0);
        float z[16];
#pragma unroll
        for (int c = 0; c < 4; ++c) {
            float s = (y[c * 4] + y[c * 4 + 1]) + (y[c * 4 + 2] + y[c * 4 + 3]);
            float q = (y[c * 4] * y[c * 4] + y[c * 4 + 1] * y[c * 4 + 1]) + (y[c * 4 + 2] * y[c * 4 + 2] + y[c * 4 + 3] * y[c * 4 + 3]);
            s = row16_sum(s); q = row16_sum(q);
            const float mean = s * (1.0f / 64.0f), rstd = rsqrtf(fmaxf(q * (1.0f / 64.0f) - mean * mean, 0.f) + 64e-5f);
#pragma unroll
            for (int i = 0; i < 4; ++i) { const int e = c * 4 + i; z[e] = ((y[e] - mean) * rstd * gg[e] + bq[e] + bn[c] * v[e]) * g[e]; }
        }
        row_store_bf16(zb + (size_t)r * 1024, z, lane);
    }
}
__device__ __forceinline__ void phase_zml(PRef p) {
    const int t_ = tidx(); const int lane = t_ & 63, gw = blockIdx.x * 4 + (t_ >> 6), nw = gridDim.x * 4;
    char* S = p.ws + OFF_SLOT;
    const bf16_t* yb = (const bf16_t*)(S + 4 * SLOT); const bf16_t* ob = (const bf16_t*)(S + 3 * SLOT); bf16_t* zb = (bf16_t*)(S + 1 * SLOT);
    float gg[16], bq[16]; row_load_f32(p.in[29], gg, lane); row_load_f32(p.in[30], bq, lane);
    const int rpw = NTOK / nw, first = gw * rpw, end = first + rpw;
    uint2 ny[4], no[4];
    auto load_in = [&](int r) {
#pragma unroll
        for (int c = 0; c < 4; ++c) { const size_t o = (size_t)r * 1024 + c * 256 + lane * 4; ny[c] = *(const uint2*)(yb + o); no[c] = *(const uint2*)(ob + o); }
    };
    load_in(first);
    for (int r = first; r < end; ++r) {
        float y[16], o[16], z[16];
#pragma unroll
        for (int c = 0; c < 4; ++c) {
            y[c * 4] = bflo(ny[c].x); y[c * 4 + 1] = bfhi(ny[c].x); y[c * 4 + 2] = bflo(ny[c].y); y[c * 4 + 3] = bfhi(ny[c].y);
            o[c * 4] = bflo(no[c].x); o[c * 4 + 1] = bfhi(no[c].x); o[c * 4 + 2] = bflo(no[c].y); o[c * 4 + 3] = bfhi(no[c].y);
        }
        if (r + 1 < end) load_in(r + 1);
        __builtin_amdgcn_sched_barrier(0);
#pragma unroll
        for (int c = 0; c < 4; ++c) {
            float s = (y[c * 4] + y[c * 4 + 1]) + (y[c * 4 + 2] + y[c * 4 + 3]);
            float q = (y[c * 4] * y[c * 4] + y[c * 4 + 1] * y[c * 4 + 1]) + (y[c * 4 + 2] * y[c * 4 + 2] + y[c * 4 + 3] * y[c * 4 + 3]);
            s = row16_sum(s); q = row16_sum(q); s = xor16_add(s); q = xor16_add(q);
            const float mean = s * (1.0f / 128.0f), rstd = rsqrtf(fmaxf(q * (1.0f / 128.0f) - mean * mean, 0.f) + 1e-6f);
#pragma unroll
            for (int i = 0; i < 4; ++i) { const int e = c * 4 + i; z[e] = ((y[e] - mean) * rstd * gg[e] + bq[e]) * o[e]; }
        }
        row_store_bf16(zb + (size_t)r * 1024, z, lane);
    }
}
__device__ __forceinline__ void phase_zrt(PRef p) {
    const int t_ = tidx(); const int lane = t_ & 63, gw = blockIdx.x * 4 + (t_ >> 6), nw = gridDim.x * 4;
    char* S = p.ws + OFF_SLOT;
    const bf16_t* yb = (const bf16_t*)(S + 7 * SLOT); const bf16_t* sb = (const bf16_t*)(S + 5 * SLOT); bf16_t* zb = (bf16_t*)(S + 3 * SLOT);
    float gw8[4][8], bw8[4][8];
#pragma unroll
    for (int c = 0; c < 4; ++c) {
        const float4 ga = gld_f4(p.in[33] + lane * 32 + c * 8), gb2 = gld_f4(p.in[33] + lane * 32 + c * 8 + 4), ba = gld_f4(p.in[34] + lane * 32 + c * 8), bb2 = gld_f4(p.in[34] + lane * 32 + c * 8 + 4);
        gw8[c][0] = ga.x; gw8[c][1] = ga.y; gw8[c][2] = ga.z; gw8[c][3] = ga.w; gw8[c][4] = gb2.x; gw8[c][5] = gb2.y; gw8[c][6] = gb2.z; gw8[c][7] = gb2.w;
        bw8[c][0] = ba.x; bw8[c][1] = ba.y; bw8[c][2] = ba.z; bw8[c][3] = ba.w; bw8[c][4] = bb2.x; bw8[c][5] = bb2.y; bw8[c][6] = bb2.z; bw8[c][7] = bb2.w;
    }
    const int rpw = NTOK / nw, first = gw * rpw, end = first + rpw;
    uint4 nyr[4], nsr[4];
    auto load_in = [&](int r) {
        const size_t o = (size_t)r * 2048 + lane * 32;
#pragma unroll
        for (int c = 0; c < 4; ++c) { nyr[c] = *(const uint4*)(yb + o + c * 8); nsr[c] = *(const uint4*)(sb + o + c * 8); }
    };
    load_in(first);
    for (int r = first; r < end; ++r) {
        const size_t o = (size_t)r * 2048 + lane * 32;
        uint4 yr[4], sr[4];
#pragma unroll
        for (int c = 0; c < 4; ++c) { yr[c] = nyr[c]; sr[c] = nsr[c]; }
        if (r + 1 < end) load_in(r + 1);
        __builtin_amdgcn_sched_barrier(0);
        float s = 0.f, q = 0.f;
#pragma unroll
        for (int c = 0; c < 4; ++c) { float f[8]; unpack8(yr[c], f);
#pragma unroll
            for (int i = 0; i < 8; ++i) { s += f[i]; q += f[i] * f[i]; } }
        s = row16_sum(s); q = row16_sum(q);
        const float mean = s * (1.0f / 512.0f), rstd = rsqrtf(fmaxf(q * (1.0f / 512.0f) - mean * mean, 0.f) + 1e-6f);
#pragma unroll
        for (int c = 0; c < 4; ++c) {
            float f[8], g[8], z[8]; unpack8(yr[c], f); unpack8(sr[c], g);
#pragma unroll
            for (int i = 0; i < 8; ++i) z[i] = ((f[i] - mean) * rstd * gw8[c][i] + bw8[c][i]) * g[i];
            *(uint4*)(zb + o + c * 8) = pack8(z);
        }
    }
}

template <int WHICH  >
__device__ __forceinline__ void phase_moe(PRef p, int L, char* lds, const bf16_t* hm, bf16_t* H) {
    const int t = tidx(), lane = t & 63, wid = t >> 6, wr = wid >> 1, wc = wid & 1, fr = lane & 15, fq = lane >> 4;
    const int* cnt = (const int*)(p.ws + OFF_CNT) + L * 32;
    const int* list = (const int*)(p.ws + OFF_LIST);
    bf16_t* Y = (bf16_t*)(p.ws + OFF_SLOT + 9 * SLOT);
    int* pre = (int*)(lds + 65536);
    __syncthreads();
    if (t == 0) { int s = 0; for (int e = 0; e < 32; ++e) { pre[e] = s; s += (cnt[e] + 127) >> 7; } pre[32] = s; }
    __syncthreads();
    const int total_all = pre[32] * 8;
    const int full = (total_all / (int)gridDim.x) * (int)gridDim.x, rem = total_all - full;
    const bool split_tail = (rem > 0) && (2 * rem <= (int)gridDim.x);
    const int total = split_tail ? full : total_all;
    for (int id0 = 0; id0 < total; id0 += gridDim.x) {
        const int id = id0 + (blockIdx.x & 7) * (gridDim.x >> 3) + (blockIdx.x >> 3);
        if (id >= total) continue;
        const int nt = id & 7, mg = id >> 3;
        int e = 0;
#pragma unroll 1
        for (int s = 16; s >= 1; s >>= 1) if (pre[e + s] <= mg) e += s;
        const int mt = mg - pre[e], ne = cnt[e];
        const int* le = list + e * LIST_CAP + mt * 128;
        const bf16_t* ar[4]; const bf16_t* br[4];
        const int co_ = glds_chunk(t) * 8;
#pragma unroll
        for (int i = 0; i < 4; ++i) {
            int r = (t >> 3) + 32 * i; r = (mt * 128 + r < ne) ? r : 0;
            const int aid = le[r];
            ar[i] = ((WHICH == 0) ? hm + (size_t)(aid >> 1) * 1024 : H + (size_t)aid * 512) + co_;
        }
        f32x4 acc[4][4];
        if (WHICH == 0) {
            const bf16_t* wt = (const bf16_t*)(p.ws + W_MOE13) + ((size_t)(L * 32 + e) * 1024 + nt * 128) * 1024;
#pragma unroll
            for (int i = 0; i < 4; ++i) {
                const int ro = (t >> 3) + 32 * i, n_ = (ro >> 4) & 3, hc = ((ro >> 2) & 3) * 8 + (n_ >> 1) * 4 + (ro & 3);
                br[i] = wt + (size_t)((ro & 64) + (hc >> 4) * 32 + (n_ & 1) * 16 + (hc & 15)) * 1024 + co_;
            }
            gemm_gg(lds, 16, ar, br, acc);
            int aidq[4];
#pragma unroll
            for (int m = 0; m < 4; ++m) { const int r = wr * 64 + m * 16 + fr; aidq[m] = (mt * 128 + r < ne) ? le[r] : 0; }
#pragma unroll
            for (int m = 0; m < 4; ++m) {
                const int r = wr * 64 + m * 16 + fr;
                if (mt * 128 + r < ne) {
                    const int aid = aidq[m];
                    const f32x4 a1 = acc[m][0], a3 = acc[m][1], b1 = acc[m][2], b3 = acc[m][3];
                    gst_u4(H + (size_t)aid * 512 + nt * 64 + wc * 32 + fq * 8, cvt_pk(siluf_(a1[0]) * a3[0], siluf_(a1[1]) * a3[1]), cvt_pk(siluf_(a1[2]) * a3[2], siluf_(a1[3]) * a3[3]),
                           cvt_pk(siluf_(b1[0]) * b3[0], siluf_(b1[1]) * b3[1]), cvt_pk(siluf_(b1[2]) * b3[2], siluf_(b1[3]) * b3[3]));
                }
            }
        } else {
            const bf16_t* wt = (const bf16_t*)(p.ws + W_MOE2) + ((size_t)(L * 32 + e) * 1024 + nt * 128) * 512;
#pragma unroll
            for (int i = 0; i < 4; ++i) br[i] = wt + (size_t)perm64((t >> 3) + 32 * i) * 512 + co_;
            gemm_gg(lds, 8, ar, br, acc);
            int aidq[4];
#pragma unroll
            for (int m = 0; m < 4; ++m) { const int r = wr * 64 + m * 16 + fr; aidq[m] = (mt * 128 + r < ne) ? le[r] : 0; }
#pragma unroll
            for (int m = 0; m < 4; ++m) {
                const int r = wr * 64 + m * 16 + fr;
                if (mt * 128 + r < ne) {
                    const int aid = aidq[m];
                    store16(Y + (size_t)aid * 1024 + nt * 128 + wc * 64 + fq * 16, acc[m]);
                }
            }
        }
    }
    if (split_tail) {
        const int hid = (blockIdx.x & 7) * (gridDim.x >> 3) + (blockIdx.x >> 3);
        if (hid < 2 * rem) {
            const int id = full + (hid >> 1), hf = hid & 1;
            const int nt = id & 7, mg = id >> 3;
            int e = 0;
#pragma unroll 1
            for (int s2 = 16; s2 >= 1; s2 >>= 1) if (pre[e + s2] <= mg) e += s2;
            const int mt = mg - pre[e], ne = cnt[e];
            const int* le = list + e * LIST_CAP + mt * 128;
            const bf16_t* ar[4]; const bf16_t* br[2];
            const int co_ = glds_chunk(t) * 8;
#pragma unroll
            for (int i = 0; i < 4; ++i) {
                int r = (t >> 3) + 32 * i; r = (mt * 128 + r < ne) ? r : 0;
                const int aid = le[r];
                ar[i] = ((WHICH == 0) ? hm + (size_t)(aid >> 1) * 1024 : H + (size_t)aid * 512) + co_;
            }
            f32x4 acc[2][4];
            int aidq[2];
            if (WHICH == 0) {
                const bf16_t* wt = (const bf16_t*)(p.ws + W_MOE13) + ((size_t)(L * 32 + e) * 1024 + nt * 128 + hf * 64) * 1024;
#pragma unroll
                for (int i = 0; i < 2; ++i) {
                    const int ro = (t >> 3) + 32 * i, n_ = (ro >> 4) & 3, hc = ((ro >> 2) & 3) * 8 + (n_ >> 1) * 4 + (ro & 3);
                    br[i] = wt + (size_t)((hc >> 4) * 32 + (n_ & 1) * 16 + (hc & 15)) * 1024 + co_;
                }
                gemm_hn(lds, 16, ar, br, acc);
#pragma unroll
                for (int m = 0; m < 2; ++m) { const int r = wid * 32 + m * 16 + fr; aidq[m] = (mt * 128 + r < ne) ? le[r] : 0; }
#pragma unroll
                for (int m = 0; m < 2; ++m) {
                    const int r = wid * 32 + m * 16 + fr;
                    if (mt * 128 + r < ne) {
                        const f32x4 a1 = acc[m][0], a3 = acc[m][1], b1 = acc[m][2], b3 = acc[m][3];
                        gst_u4(H + (size_t)aidq[m] * 512 + nt * 64 + hf * 32 + fq * 8, cvt_pk(siluf_(a1[0]) * a3[0], siluf_(a1[1]) * a3[1]), cvt_pk(siluf_(a1[2]) * a3[2], siluf_(a1[3]) * a3[3]),
                               cvt_pk(siluf_(b1[0]) * b3[0], siluf_(b1[1]) * b3[1]), cvt_pk(siluf_(b1[2]) * b3[2], siluf_(b1[3]) * b3[3]));
                    }
                }
            } else {
                const bf16_t* wt = (const bf16_t*)(p.ws + W_MOE2) + ((size_t)(L * 32 + e) * 1024 + nt * 128 + hf * 64) * 512;
#pragma unroll
                for (int i = 0; i < 2; ++i) br[i] = wt + (size_t)perm64((t >> 3) + 32 * i) * 512 + co_;
                gemm_hn(lds, 8, ar, br, acc);
#pragma unroll
                for (int m = 0; m < 2; ++m) { const int r = wid * 32 + m * 16 + fr; aidq[m] = (mt * 128 + r < ne) ? le[r] : 0; }
#pragma unroll
                for (int m = 0; m < 2; ++m) {
                    const int r = wid * 32 + m * 16 + fr;
                    if (mt * 128 + r < ne) store16(Y + (size_t)aidq[m] * 1024 + nt * 128 + hf * 64 + fq * 16, acc[m]);
                }
            }
        }
    }
}

constexpr int NPHASE = 37;
#ifndef PHSEL
#define PHSEL -1
#endif
#ifndef PHEXC
#define PHEXC -2
#endif
#define PHON(x) ((PHSEL < 0 || PHSEL == (x)) && PHEXC != (x))
__global__ void __launch_bounds__(256, 2) mega(Params p_in) {
    PRef p = *(const CAS Params*)__builtin_amdgcn_kernarg_segment_ptr();
    extern __shared__ __attribute__((aligned(16))) char lds[];
    volatile LAS unsigned* xbw = (volatile LAS unsigned*)(lds + 73728);
    if (threadIdx.x == 0) { xbw[0] = 0u; xbw[1] = 0u; xbw[2] = 0u; xbw[3] = 0u; }
    __syncthreads();
    XcdBarrier bar;
    const bool multi = (p.ph_hi - p.ph_lo) > 1;
    (void)multi;
    if (multi) bar = xcd_barrier_post((unsigned*)(p.ws + OFF_CTL), xbw);
    char* S = p.ws + OFF_SLOT;
#ifdef DBG_STOP
    if (p.ph_lo == 100) {
        const float* src = (const float*)(p.ws + DBG_SRC);
        for (size_t i = (size_t)blockIdx.x * 256 + threadIdx.x; i < (size_t)NTOK * DM; i += (size_t)gridDim.x * 256) {
            float v = DBG_BF16 ? bf2f(((const bf16_t*)src)[i]) : src[i];
            if (!(fabsf(v) < 1e30f)) v = 1e30f;
            p.out[i] = v;
        }
        return;
    }
#endif
    const int ph_lo_ = p.ph_lo, ph_hi_ = p.ph_hi;
#ifdef TIMEIT
    unsigned long long t0_ = 0, t1_ = 0;
#endif
#ifdef DUP_PHASE
    bool dup_done_ = false;
#endif
    for (int ph = ph_lo_; ph < ph_hi_; ++ph) {
        const CAS Params* pp_ = (const CAS Params*)__builtin_amdgcn_kernarg_segment_ptr();
        asm volatile("" : "+s"(pp_));
        PRef p = *pp_;
#ifdef TIMEIT
        if (ph == TIME_A) t0_ = __builtin_amdgcn_s_memrealtime();
        if (ph == TIME_B) t1_ = __builtin_amdgcn_s_memrealtime();
#endif
        int L, sub, kind;
        if (ph < 2) { L = 0; sub = ph; kind = -1; }
        else if (ph < 11) { L = 0; kind = 0; sub = ph - 2; }
        else if (ph < 20) { L = 1; kind = 1; sub = ph - 11; }
        else if (ph < 28) { L = 2; kind = 2; sub = ph - 20; }
        else { L = 3; kind = 0; sub = ph - 28; }
        const int jr = L / 3;
        if (kind == -1) { if (sub == 0) { if (PHON(0)) phase_prologue(p, lds); } else { if (PHON(1)) phase_h0(p); } }
        else {
            const int ntail = (kind == 2) ? 4 : 5;
            if (sub < ntail) {
                if (kind == 0) {
                    if (sub == 0) { if (PHON(2)) phase_gemm_jobs(p, lds, jr * 7, jr * 7 + (jr ? 7 : 6)); }
                    else if (sub == 1) { if (PHON(3)) phase_rw2(p, jr); }
                    else if (sub == 2) { if (PHON(4)) {
#ifdef RW3_SCALAR
                        phase_rw3(p, jr, lds);
#else
                        phase_rw3c(p, jr, lds);
#endif
                    } }
                    else if (sub == 3) { if (PHON(5)) phase_zrw(p, jr); }
                    else { if (PHON(2)) phase_gemm_jobs(p, lds, 16 + jr, 17 + jr); }
                } else if (kind == 1) {
                    if (sub == 0) { if (PHON(2)) phase_gemm_jobs(p, lds, 14, 15); }
                    else if (sub == 1) { if (PHON(6)) phase_cml(p); }
                    else if (sub == 2) { if (PHON(6)) phase_ml2(p, lds); }
                    else if (sub == 3) { if (PHON(7)) phase_zml(p); }
                    else { if (PHON(2)) phase_gemm_jobs(p, lds, 18, 19); }
                } else {
                    if (sub == 0) { if (PHON(2)) phase_gemm_jobs(p, lds, 15, 16); }
                    else if (sub == 1) { if (PHON(8)) phase_rt2(p, lds); }
                    else if (sub == 2) { if (PHON(9)) phase_zrt(p); }
                    else { if (PHON(2)) phase_gemm_jobs(p, lds, 19, 20); }
                }
            } else {
                const int ts = sub - ntail;
                const bf16_t* ymix = (const bf16_t*)(S + (kind == 2 ? 1 : 6) * SLOT);
                bf16_t* hm = (bf16_t*)(S + (kind == 2 ? 2 : 7) * SLOT);
                bf16_t* H = (bf16_t*)(S + (kind == 0 ? 2 : (kind == 1 ? 5 : 3)) * SLOT);
                if (ts == 0) { if (PHON(10)) phase_ln1(p, L, lds, ymix, hm); }
                else if (ts == 1) { if (PHON(11)) phase_moe<0>(p, L, lds, hm, H); }
                else if (ts == 2) { if (PHON(12)) phase_moe<1>(p, L, lds, hm, H); }
                else { if (PHON(13)) phase_ln2(p, L); }
            }
        }
#ifdef DUP_PHASE
        if (((DUP_PHASE >> ph) & 1u) && !dup_done_) { dup_done_ = true; xcd_barrier(bar); --ph; continue; }
        dup_done_ = false;
#endif
        if (ph + 1 < ph_hi_) xcd_barrier(bar);
    }
#ifdef TIMEIT
    {
        xcd_barrier(bar);
        unsigned* tw = (unsigned*)(p.ws + OFF_CTL + 32768);
        if (blockIdx.x == 0 && threadIdx.x == 0) {
            if (t1_ == 0) t1_ = __builtin_amdgcn_s_memrealtime();
            const unsigned long long dt = t1_ - t0_;
            unsigned ms2 = (unsigned)((dt + TIME_U / 2) / TIME_U);
            __hip_atomic_store(tw, ms2, __ATOMIC_RELAXED, __HIP_MEMORY_SCOPE_AGENT);
        }
        xcd_barrier(bar);
        const float c_ = sqrtf((float)__hip_atomic_load(tw, __ATOMIC_RELAXED, __HIP_MEMORY_SCOPE_AGENT));
        for (size_t i = (size_t)blockIdx.x * 256 + threadIdx.x; i < (size_t)NTOK * DM; i += (size_t)gridDim.x * 256) p.out[i] = c_;
    }
#endif
#ifdef DBG_STOP
    if (ph_lo_ != 100) {
        xcd_barrier(bar);
        const float* src = (const float*)(p.ws + DBG_SRC);
        for (size_t i = (size_t)blockIdx.x * 256 + threadIdx.x; i < (size_t)NTOK * DM; i += (size_t)gridDim.x * 256) {
            float v = DBG_BF16 ? bf2f(((const bf16_t*)src)[i]) : src[i];
            if (!(fabsf(v) < 1e30f)) v = 1e30f;
            p.out[i] = v;
        }
    }
#endif
}

constexpr int LDS_BYTES = 73728 + 64;
extern "C" void kernel_launch(void* const* d_in, const int* in_sizes, int n_in, void* d_out, int out_size, void* d_ws, size_t ws_size, hipStream_t stream) {
    static int grid = 0;
    if (grid == 0) {
        if (n_in != 43 || out_size != NTOK * DM || ws_size < WS_NEED) { fprintf(stderr, "kernel_launch: unexpected shapes (n_in %d out %d ws %zu need %zu)\n", n_in, out_size, ws_size, (size_t)WS_NEED); }
        int dev = 0, cus = 0, per_cu = 0;
        (void)hipGetDevice(&dev); (void)hipDeviceGetAttribute(&cus, hipDeviceAttributeMultiprocessorCount, dev);
        (void)hipFuncSetAttribute((const void*)mega, hipFuncAttributeMaxDynamicSharedMemorySize, LDS_BYTES);
        (void)hipOccupancyMaxActiveBlocksPerMultiprocessor(&per_cu, (const void*)mega, 256, LDS_BYTES);
        if (per_cu > 2) per_cu = 2;
        if (per_cu < 1) per_cu = 1;
        grid = cus * per_cu;
        if (grid > 512) grid = 512;
        (void)hipGetLastError();
    }
    Params p{};
    for (int i = 0; i < 43; ++i) p.in[i] = (const float*)d_in[i];
    p.out = (float*)d_out; p.ws = (char*)d_ws;
    char* ws = (char*)d_ws;
    auto slot = [&](int i) { return (bf16_t*)(ws + OFF_SLOT + (size_t)i * SLOT); };
    int tile = 0;
    auto addg = [&](int idx, const bf16_t* A, const bf16_t* Bt, bf16_t* out, int K, int N, int ldo, int mode) {
        GJob& g = p.gj[idx]; g.A = A; g.Bt = Bt; g.out = out; g.K = K; g.N = N; g.ldo = ldo; g.mode = mode; g.half = (mode <= MODE_SIGM && N <= 128) ? 1 : 0; g.ntn = g.half ? (N + 63) / 64 : (N + 127) / 128; g.tile0 = tile; tile += 128 * g.ntn;
    };
    for (int jr = 0; jr < 2; ++jr) {
        const bf16_t* rkv = (const bf16_t*)(ws + W_RKV) + (size_t)jr * 3 * 1024 * 1024;
        addg(jr * 7 + 0, slot(0), rkv, slot(6), 1024, 1024, 1024, MODE_BF16);
        addg(jr * 7 + 1, slot(1), rkv + 1024 * 1024, slot(7), 1024, 1024, 1024, MODE_BF16);
        addg(jr * 7 + 2, slot(2), rkv + 2 * 1024 * 1024, slot(jr == 0 ? 11 : 8), 1024, 1024, 1024, MODE_BF16);
        addg(jr * 7 + 3, slot(3), (const bf16_t*)(ws + W_W1T) + (size_t)jr * 64 * 1024, (bf16_t*)(ws + OFF_LW), 1024, 64, 64, MODE_TANH);
        addg(jr * 7 + 4, slot(4), (const bf16_t*)(ws + W_A1T) + (size_t)jr * 64 * 1024, (bf16_t*)(ws + OFF_LA), 1024, 64, 64, MODE_BF16);
        addg(jr * 7 + 5, slot(5), (const bf16_t*)(ws + W_G1T) + (size_t)jr * 128 * 1024, (bf16_t*)(ws + OFF_LG), 1024, 128, 128, MODE_SIGM);
        addg(jr * 7 + 6, slot(2), (const bf16_t*)(ws + W_V1T), (bf16_t*)(ws + OFF_LV), 1024, 32, 32, MODE_BF16);
    }
    addg(14, slot(0), (const bf16_t*)(ws + W_MLIN), nullptr, 1024, 3088, 0, MODE_ML1);
    addg(15, slot(0), (const bf16_t*)(ws + W_RTIN), nullptr, 1024, 6144, 0, MODE_RT1);
    addg(16, slot(7), (const bf16_t*)(ws + W_OUT), slot(6), 1024, 1024, 1024, MODE_BF16);
    addg(17, slot(7), (const bf16_t*)(ws + W_OUT) + 1024 * 1024, slot(6), 1024, 1024, 1024, MODE_BF16);
    addg(18, slot(1), (const bf16_t*)(ws + W_MLOUT), slot(6), 1024, 1024, 1024, MODE_BF16);
    addg(19, slot(3), (const bf16_t*)(ws + W_RTOUT), slot(1), 2048, 1024, 1024, MODE_BF16);
    int nc = 0, ctile = 0;
    auto addc = [&](const float* src, size_t dst_off, int K, int N, int nb, long sbs, long dbs, int mode) {
        CJob& c = p.cj[nc++]; c.src = src; c.dst = (bf16_t*)(ws + dst_off); c.K = K; c.N = N; c.nb = nb; c.mode = mode; c.sbs = sbs; c.dbs = dbs;
        c.tiles_pb = ((K + 63) / 64) * ((N + 255) / 256); c.tile0 = ctile; ctile += c.tiles_pb * nb;
    };
    addc(p.in[7], W_RKV, 1024, 1024, 6, 1024 * 1024, 1024 * 1024, 0);
    addc(p.in[24], W_OUT, 1024, 1024, 2, 1024 * 1024, 1024 * 1024, 0);
    addc(p.in[9], W_W1T, 1024, 64, 2, 1024 * 64, 64 * 1024, 0);
    addc(p.in[12], W_A1T, 1024, 64, 2, 1024 * 64, 64 * 1024, 0);
    addc(p.in[17], W_G1T, 1024, 128, 2, 1024 * 128, 128 * 1024, 0);
    addc(p.in[15], W_V1T, 1024, 32, 1, 0, 0, 0);
    addc(p.in[10], W_W2T, 64, 1024, 2, 64 * 1024, 1024 * 64, 0);
    addc(p.in[13], W_A2T, 64, 1024, 2, 64 * 1024, 1024 * 64, 0);
    addc(p.in[18], W_G2T, 128, 1024, 2, 128 * 1024, 1024 * 128, 0);
    addc(p.in[16], W_V2T, 32, 1024, 1, 0, 0, 0);
    addc(p.in[25], W_MLIN, 1024, 3088, 1, 0, 0, 0);
    addc(p.in[31], W_MLOUT, 1024, 1024, 1, 0, 0, 0);
    addc(p.in[32], W_RTIN, 1024, 6144, 1, 0, 0, 3);
    addc(p.in[35], W_RTOUT, 2048, 1024, 1, 0, 0, 0);
    addc(p.in[40], W_MOE13, 1024, 512, 128, 1024 * 512, 1024 * 1024, 1);
    addc(p.in[41], W_MOE13, 1024, 512, 128, 1024 * 512, 1024 * 1024, 2);
    addc(p.in[42], W_MOE2, 512, 1024, 128, 512 * 1024, 1024 * 512, 0);
    p.ncj = nc; p.cj_tiles = ctile;

    (void)hipMemsetAsync(ws + OFF_CTL, 0, CTL_BYTES, stream);
#ifdef DBG_STOP
    const int nph = DBG_STOP;
#else
    const int nph = NPHASE;
#endif
#ifdef MULTI_LAUNCH
    for (int ph = 0; ph < nph; ++ph) { p.ph_lo = ph; p.ph_hi = ph + 1; hipLaunchKernelGGL(mega, dim3(grid), dim3(256), LDS_BYTES, stream, p); }
    if (0)
#endif
    {
        p.ph_lo = 0; p.ph_hi = nph;
        void* args[] = {&p};
        hipError_t e = hipLaunchCooperativeKernel((const void*)mega, dim3(grid), dim3(256), args, LDS_BYTES, stream);
        if (e != hipSuccess) fprintf(stderr, "cooperative launch failed: %s (grid %d)\n", hipGetErrorString(e), grid);
    }
}
```

```cpp
#include <hip/hip_runtime.h>
#include <cstdio>
#include <cstdint>

#ifndef ONE_LAUNCH
#define ONE_LAUNCH 0
#endif

typedef unsigned short bf16_t;
typedef short bf16x8 __attribute__((ext_vector_type(8)));
typedef float f32x4 __attribute__((ext_vector_type(4)));
#define LAS __attribute__((address_space(3)))
#define GAS __attribute__((address_space(1)))
typedef float f32x4g_t __attribute__((ext_vector_type(4)));
typedef unsigned u32x2g_t __attribute__((ext_vector_type(2)));
typedef unsigned u32x4g_t __attribute__((ext_vector_type(4)));
__device__ __forceinline__ float4 gld_f4(const float* p) { const f32x4g_t v = *(const GAS f32x4g_t*)(const GAS char*)(const char*)p; return make_float4(v[0], v[1], v[2], v[3]); }
__device__ __forceinline__ uint2 gld_u2(const void* p) { const u32x2g_t v = *(const GAS u32x2g_t*)(const GAS char*)(const char*)p; return make_uint2(v[0], v[1]); }
__device__ __forceinline__ uint4 gld_u4(const void* p) { const u32x4g_t v = *(const GAS u32x4g_t*)(const GAS char*)(const char*)p; return make_uint4(v[0], v[1], v[2], v[3]); }
__device__ __forceinline__ void gst_f4(float* p, float a, float b, float c, float d) { const f32x4g_t v = {a, b, c, d}; *(GAS f32x4g_t*)(GAS char*)(char*)p = v; }
__device__ __forceinline__ void gst_u2(void* p, unsigned a, unsigned b) { const u32x2g_t v = {a, b}; *(GAS u32x2g_t*)(GAS char*)(char*)p = v; }
__device__ __forceinline__ void gst_u4(void* p, unsigned a, unsigned b, unsigned c, unsigned d) { const u32x4g_t v = {a, b, c, d}; *(GAS u32x4g_t*)(GAS char*)(char*)p = v; }

constexpr int NTOK = 16384, DM = 1024, TSEQ = 2048, NBATCH = 8;
constexpr float DN_ALPHA = 1.681792830507429f;
constexpr float LN_EPS = 1e-5f;
constexpr size_t MB = 1u << 20;
constexpr size_t OFF_CTL = 0, OFF_CNT = 16384, CTL_BYTES = 65536;
constexpr size_t OFF_MOD = 65536;
constexpr size_t OFF_ROT = 1 * MB;
constexpr size_t OFF_BONUS = 3 * MB, OFF_GATES = 4 * MB, OFF_STAT = 5 * MB, OFF_LW = 13 * MB, OFF_LA = 15 * MB, OFF_LG = 17 * MB, OFF_LV = 21 * MB,
                 OFF_WGT = 22 * MB, OFF_LIST = 23 * MB, OFF_RTW = 25 * MB;
constexpr size_t OFF_W = 32 * MB;
constexpr size_t W_RKV = OFF_W, W_OUT = W_RKV + 12 * MB, W_W1T = W_OUT + 4 * MB, W_A1T = W_W1T + 256 * 1024, W_G1T = W_A1T + 256 * 1024, W_V1T = W_G1T + 512 * 1024,
                 W_W2T = W_V1T + 64 * 1024, W_A2T = W_W2T + 256 * 1024, W_G2T = W_A2T + 256 * 1024, W_V2T = W_G2T + 512 * 1024, W_MLIN = W_V2T + 64 * 1024 + 832 * 1024,
                 W_MLOUT = W_MLIN + 6400 * 1024, W_RTIN = W_MLOUT + 2 * MB, W_RTOUT = W_RTIN + 12 * MB, W_MOE13 = W_RTOUT + 4 * MB, W_MOE2 = W_MOE13 + 256 * MB,
                 W_END = W_MOE2 + 128 * MB;
constexpr size_t OFF_XRES = 464 * MB;
constexpr size_t OFF_SLOT = 528 * MB, SLOT = 32 * MB;
static_assert(W_END <= OFF_XRES, "weights overflow");
constexpr size_t OFF_XRES2 = OFF_SLOT + 12 * SLOT;
constexpr size_t WS_NEED = OFF_XRES2 + 2 * SLOT;
constexpr int LIST_CAP = 16384;

#define XB_TMO      128
#define XB_XCNT(j)  (256  + 64 * (j))
#define XB_XSUB(j)  (1280 + 64 * (j))
#define XB_XGEN(j)  (2304 + 64 * (j))
#define XB_TOP      3328
#define XB_TOPGEN   3392
#define XCD_BAR_WORDS 3456
#define XB_SPIN_CAP (1u << 22)
__device__ __forceinline__ unsigned xb_ld(unsigned* p)              { return __hip_atomic_load(p, __ATOMIC_RELAXED, __HIP_MEMORY_SCOPE_AGENT); }
__device__ __forceinline__ unsigned xb_add(unsigned* p, unsigned v) { return __hip_atomic_fetch_add(p, v, __ATOMIC_RELAXED, __HIP_MEMORY_SCOPE_AGENT); }
__device__ __forceinline__ unsigned xb_xcc_id() { return (unsigned)__builtin_amdgcn_s_getreg((3 << 11) | 20) & 0xFu; }
#define XB_SPIN(cond, bar) do { unsigned _sp = 0; while (cond) { __builtin_amdgcn_s_sleep(1); \
    if ((++_sp & 255u) == 0u) { if (xb_ld(&(bar)[XB_TMO])) break; if (_sp > XB_SPIN_CAP) { atomicAdd(&(bar)[XB_TMO], 1u); break; } } } } while (0)
struct XcdBarrier { unsigned* bar; unsigned x; volatile LAS unsigned* st; };
__device__ __forceinline__ XcdBarrier xcd_barrier_post(unsigned* bar, volatile LAS unsigned* st) {
    XcdBarrier b; b.bar = bar; b.x = xb_xcc_id(); b.st = st;
    if (threadIdx.x == 0) (void)xb_add(&bar[XB_XCNT(b.x)], 1u);
    return b;
}
__device__ __forceinline__ void xcd_barrier_complete(unsigned* bar, unsigned x, unsigned& nloc, unsigned& nx) {
    const unsigned G = gridDim.x;
    unsigned sum, cnt, mine, sp = 0u;
    for (;;) {
        sum = 0u; cnt = 0u; mine = 0u;
#pragma unroll
        for (unsigned j = 0; j < 16; ++j) { const unsigned c = xb_ld(&bar[XB_XCNT(j)]); sum += c; cnt += (c > 0u) ? 1u : 0u; mine = (j == x) ? c : mine; }
        if (sum == G) break;
        __builtin_amdgcn_s_sleep(1);
        if ((++sp & 255u) == 0u) { if (xb_ld(&bar[XB_TMO])) break; if (sp > XB_SPIN_CAP) { atomicAdd(&bar[XB_TMO], 1u); break; } }
    }
    nloc = mine > 0u ? mine : 1u; nx = cnt > 0u ? cnt : 1u;
}
__device__ __forceinline__ void xcd_barrier(const XcdBarrier& b) {
    asm volatile("s_waitcnt vmcnt(0)" ::: "memory");
    __syncthreads();
    if (threadIdx.x == 0) {
        unsigned* bar = b.bar;
        __builtin_amdgcn_s_waitcnt(0);
        unsigned nloc = b.st[0], nx = b.st[1];
        if (nloc == 0u) { xcd_barrier_complete(bar, b.x, nloc, nx); b.st[0] = nloc; b.st[1] = nx; }
        const unsigned old = xb_add(&bar[XB_XSUB(b.x)], 1u);
        const unsigned gen = old / nloc;
        if (old + 1u == (gen + 1u) * nloc) {
            __builtin_amdgcn_fence(__ATOMIC_RELEASE, "agent");
            asm volatile("s_waitcnt vmcnt(0)" ::: "memory");
            const unsigned og = xb_add(&bar[XB_TOP], 1u);
            const unsigned tg = og / nx;
            if (og + 1u == (tg + 1u) * nx) xb_add(&bar[XB_TOPGEN], 1u);
            else XB_SPIN(xb_ld(&bar[XB_TOPGEN]) == tg, bar);
            __builtin_amdgcn_fence(__ATOMIC_ACQUIRE, "agent");
            xb_add(&bar[XB_XGEN(b.x)], 1u);
            asm volatile("s_waitcnt vmcnt(0)" ::: "memory");
        } else {
            XB_SPIN(xb_ld(&bar[XB_XGEN(b.x)]) == gen, bar);
            __builtin_amdgcn_fence(__ATOMIC_ACQUIRE, "agent");
            asm volatile("s_waitcnt vmcnt(0)" ::: "memory");
        }
    }
    __syncthreads();
}

__device__ __forceinline__ int tidx() { int t = threadIdx.x; asm volatile("" : "+v"(t)); return t; }
typedef __bf16 bf16x2_t __attribute__((ext_vector_type(2)));
typedef float f32x2_t __attribute__((ext_vector_type(2)));
__device__ __forceinline__ unsigned cvt_pk(float lo, float hi) {
    f32x2_t v = {lo, hi}; bf16x2_t r = __builtin_convertvector(v, bf16x2_t);
    unsigned u; __builtin_memcpy(&u, &r, 4); return u;
}
__device__ __forceinline__ bf16_t f2bf(float f) { return (bf16_t)(cvt_pk(f, 0.f) & 0xffffu); }
__device__ __forceinline__ float bflo(unsigned u) { return __uint_as_float(u << 16); }
__device__ __forceinline__ float bfhi(unsigned u) { return __uint_as_float(u & 0xffff0000u); }
__device__ __forceinline__ float bf2f(bf16_t u) { return __uint_as_float(((unsigned)u) << 16); }
__device__ __forceinline__ void unpack8(const uint4& u, float (&f)[8]) {
    f[0] = bflo(u.x); f[1] = bfhi(u.x); f[2] = bflo(u.y); f[3] = bfhi(u.y); f[4] = bflo(u.z); f[5] = bfhi(u.z); f[6] = bflo(u.w); f[7] = bfhi(u.w);
}
__device__ __forceinline__ uint4 pack8(const float (&f)[8]) { uint4 u; u.x = cvt_pk(f[0], f[1]); u.y = cvt_pk(f[2], f[3]); u.z = cvt_pk(f[4], f[5]); u.w = cvt_pk(f[6], f[7]); return u; }
typedef unsigned u32x4_t __attribute__((ext_vector_type(4)));
__device__ __forceinline__ uint4 gload16(const void* p) {
    const u32x4_t v = *(const __attribute__((address_space(1))) u32x4_t*)p;
    return make_uint4(v[0], v[1], v[2], v[3]);
}
__device__ __forceinline__ float sigmoidf_(float x) { return __builtin_amdgcn_rcpf(1.0f + __expf(-x)); }
__device__ __forceinline__ float siluf_(float x) { return x * __builtin_amdgcn_rcpf(1.0f + __expf(-x)); }
__device__ __forceinline__ float tanhf_(float x) { return 1.0f - 2.0f * __builtin_amdgcn_rcpf(1.0f + __expf(2.0f * x)); }
__device__ __forceinline__ float softplusf_(float x) { return fmaxf(x, 0.f) + __logf(1.0f + __expf(-fabsf(x))); }
__device__ __forceinline__ float row16_sum(float v);
__device__ __forceinline__ float xor16_add(float v) { const auto r = __builtin_amdgcn_permlane16_swap(__float_as_uint(v), __float_as_uint(v), false, false); return __uint_as_float(r[0]) + __uint_as_float(r[1]); }
__device__ __forceinline__ float xor32_add(float v) { const auto r = __builtin_amdgcn_permlane32_swap(__float_as_uint(v), __float_as_uint(v), false, false); return __uint_as_float(r[0]) + __uint_as_float(r[1]); }
__device__ __forceinline__ float wave_sum(float v) {
    v = row16_sum(v); v = xor16_add(v); v = xor32_add(v);
    return v;
}
__device__ __forceinline__ float row16_sum(float v) {
    v += __builtin_amdgcn_update_dpp(0.f, v, 0x128, 0xf, 0xf, false);
    v += __builtin_amdgcn_update_dpp(0.f, v, 0x124, 0xf, 0xf, false);
    v += __builtin_amdgcn_update_dpp(0.f, v, 0x122, 0xf, 0xf, false);
    v += __builtin_amdgcn_update_dpp(0.f, v, 0x121, 0xf, 0xf, false);
    return v;
}
__device__ __forceinline__ float oct_sum(float v) {
    v += __builtin_amdgcn_update_dpp(0.f, v, 0xB1, 0xf, 0xf, false);
    v += __builtin_amdgcn_update_dpp(0.f, v, 0x4E, 0xf, 0xf, false);
    v += __builtin_amdgcn_update_dpp(0.f, v, 0x141, 0xf, 0xf, false);
    return v;
}

enum { MODE_BF16 = 0, MODE_TANH = 1, MODE_SIGM = 2, MODE_ML1 = 3, MODE_RT1 = 4 };
struct GJob { const bf16_t* A; const bf16_t* Bt; bf16_t* out; int K, N, ldo, mode, ntn, tile0, half; };
struct CJob { const float* src; bf16_t* dst; int K, N, nb, mode; long sbs, dbs; int tiles_pb, tile0; };
constexpr int NGJ = 20, NCJ = 26;
struct Params {
    const float* in[43]; float* out; char* ws;
    int ph_lo, ph_hi, ncj, cj_tiles, cj_early;
    GJob gj[NGJ];
    CJob cj[NCJ];
};
#define CAS __attribute__((address_space(4)))
typedef const CAS Params& PRef;

__device__ __forceinline__ f32x4 mfma16(const uint4& a, const uint4& b, f32x4 c) {
    bf16x8 av, bv; __builtin_memcpy(&av, &a, 16); __builtin_memcpy(&bv, &b, 16);
    return __builtin_amdgcn_mfma_f32_16x16x32_bf16(av, bv, c, 0, 0, 0);
}
template <bool PFA = true, class AL, class BL>
__device__ __forceinline__ void gemm_mainloop(char* lds, int nk, const AL& al, const BL& bl, f32x4 (&acc)[4][4]) {
    const int t = tidx(), c = t & 7, r0 = t >> 3;
    const int lane = t & 63, wid = t >> 6, wr = wid >> 1, wc = wid & 1, fr = lane & 15, fq = lane >> 4;
    typename AL::Raw ra[4]; typename BL::Raw rb[4];
    const int woff = r0 * 128 + ((c ^ (r0 & 7)) << 4);
#pragma unroll
    for (int i = 0; i < 4; ++i) { if (PFA) ra[i] = al.fetch(i, r0 + 32 * i, c); rb[i] = bl.fetch(i, r0 + 32 * i, c); }
#pragma unroll
    for (int i = 0; i < 4; ++i) {
        if (!PFA) { ra[i] = al.fetch(i, r0 + 32 * i, c); }
        *(uint4*)(lds + woff + i * 4096) = al.finish(ra[i], i, r0 + 32 * i, c);
        *(uint4*)(lds + 16384 + woff + i * 4096) = bl.finish(rb[i], i, r0 + 32 * i, c);
        if (!PFA) asm volatile("" ::: "memory");
    }
#pragma unroll
    for (int m = 0; m < 4; ++m)
#pragma unroll
        for (int n = 0; n < 4; ++n) acc[m][n] = (f32x4){0.f, 0.f, 0.f, 0.f};
    __syncthreads();
    const int aoff = (wr * 64 + fr) * 128, boff = 16384 + (wc * 64 + fr) * 128, sw = fr & 7;
    for (int kt = 0; kt < nk; ++kt) {
        const bool more = (kt + 1 < nk);
        if (more) {
#pragma unroll
            for (int i = 0; i < 4; ++i) { if (PFA) ra[i] = al.fetch(i, r0 + 32 * i, (kt + 1) * 8 + c); rb[i] = bl.fetch(i, r0 + 32 * i, (kt + 1) * 8 + c); }
        }
        const char* buf = lds + (kt & 1) * 32768;
#pragma unroll
        for (int ks = 0; ks < 2; ++ks) {
            uint4 af[4], bfm[4];
            const int ch = ((ks * 4 + fq) ^ sw) << 4;
#pragma unroll
            for (int m = 0; m < 4; ++m) af[m] = *(const uint4*)(buf + aoff + m * 2048 + ch);
#pragma unroll
            for (int n = 0; n < 4; ++n) bfm[n] = *(const uint4*)(buf + boff + n * 2048 + ch);
#pragma unroll
            for (int m = 0; m < 4; ++m)
#pragma unroll
                for (int n = 0; n < 4; ++n) acc[m][n] = mfma16(bfm[n], af[m], acc[m][n]);
        }
        if (more) {
            char* nb = lds + ((kt + 1) & 1) * 32768;
#pragma unroll
            for (int i = 0; i < 4; ++i) {
                if (!PFA) ra[i] = al.fetch(i, r0 + 32 * i, (kt + 1) * 8 + c);
                *(uint4*)(nb + woff + i * 4096) = al.finish(ra[i], i, r0 + 32 * i, (kt + 1) * 8 + c);
                *(uint4*)(nb + 16384 + woff + i * 4096) = bl.finish(rb[i], i, r0 + 32 * i, (kt + 1) * 8 + c);
                if (!PFA) asm volatile("" ::: "memory");
            }
        }
        __syncthreads();
    }
}
__device__ __forceinline__ void glds16(const bf16_t* g, char* l) {
    __builtin_amdgcn_global_load_lds((const unsigned*)g, (LAS unsigned*)l, 16, 0, 0);
}
__device__ __forceinline__ void glds16_asm(const void* gsrc, unsigned lds_dst) {
    unsigned keep;
    asm volatile("s_mov_b32 %0, m0\n\ts_mov_b32 m0, %2\n\ts_nop 0\n\tglobal_load_lds_dwordx4 %1, off\n\ts_mov_b32 m0, %0" : "=&s"(keep) : "v"(gsrc), "s"(lds_dst) : "memory");
}
__device__ __forceinline__ unsigned lds_addr_u(const char* l) { return (unsigned)(size_t)(const LAS char*)l; }
__device__ __forceinline__ int glds_chunk(int t) { return (t & 7) ^ ((t >> 3) & 7); }
__device__ __forceinline__ void mma_ktile(const char* buf, int aoff, int boff, int sw, int fq, f32x4 (&acc)[4][4]) {
    const int ch0 = ((0 * 4 + fq) ^ sw) << 4, ch1 = ((1 * 4 + fq) ^ sw) << 4;
    const char* pa = buf + aoff; const char* pb = buf + boff;
    uint4 a0[4], a1[4], b[8];
#pragma unroll
    for (int m = 0; m < 4; ++m) a0[m] = *(const uint4*)(pa + m * 2048 + ch0);
    b[0] = *(const uint4*)(pb + ch0); b[1] = *(const uint4*)(pb + 2048 + ch0);
    __builtin_amdgcn_sched_barrier(0);
    b[2] = *(const uint4*)(pb + 2 * 2048 + ch0);
#pragma unroll
    for (int m = 0; m < 4; ++m) acc[m][0] = mfma16(b[0], a0[m], acc[m][0]);
    __builtin_amdgcn_sched_barrier(0);
    b[3] = *(const uint4*)(pb + 3 * 2048 + ch0);
#pragma unroll
    for (int m = 0; m < 4; ++m) acc[m][1] = mfma16(b[1], a0[m], acc[m][1]);
    __builtin_amdgcn_sched_barrier(0);
#pragma unroll
    for (int m = 0; m < 4; ++m) a1[m] = *(const uint4*)(pa + m * 2048 + ch1);
#pragma unroll
    for (int m = 0; m < 4; ++m) acc[m][2] = mfma16(b[2], a0[m], acc[m][2]);
    __builtin_amdgcn_sched_barrier(0);
    b[4] = *(const uint4*)(pb + ch1); b[5] = *(const uint4*)(pb + 2048 + ch1);
#pragma unroll
    for (int m = 0; m < 4; ++m) acc[m][3] = mfma16(b[3], a0[m], acc[m][3]);
    __builtin_amdgcn_sched_barrier(0);
    b[6] = *(const uint4*)(pb + 2 * 2048 + ch1);
#pragma unroll
    for (int m = 0; m < 4; ++m) acc[m][0] = mfma16(b[4], a1[m], acc[m][0]);
    __builtin_amdgcn_sched_barrier(0);
    b[7] = *(const uint4*)(pb + 3 * 2048 + ch1);
#pragma unroll
    for (int m = 0; m < 4; ++m) acc[m][1] = mfma16(b[5], a1[m], acc[m][1]);
    __builtin_amdgcn_sched_barrier(0);
#pragma unroll
    for (int m = 0; m < 4; ++m) acc[m][2] = mfma16(b[6], a1[m], acc[m][2]);
#pragma unroll
    for (int m = 0; m < 4; ++m) acc[m][3] = mfma16(b[7], a1[m], acc[m][3]);
}
__device__ __forceinline__ void gemm_issue0(char* lds, const bf16_t* const (&ar)[4], const bf16_t* const (&br)[4]) {
    const int wid = tidx() >> 6;
    const unsigned wbs = (unsigned)__builtin_amdgcn_readfirstlane((int)(lds_addr_u(lds) + wid * 1024));
#pragma unroll
    for (int i = 0; i < 4; ++i) { glds16_asm(ar[i], wbs + i * 4096); glds16_asm(br[i], wbs + 16384 + i * 4096); }
}
template <bool ISSUE0>
__device__ __forceinline__ void gemm_ggx(char* lds, int nk, const bf16_t* const (&ar)[4], const bf16_t* const (&br)[4], f32x4 (&acc)[4][4]) {
    const int t = tidx();
    const int lane = t & 63, wid = t >> 6, wr = wid >> 1, wc = wid & 1, fr = lane & 15, fq = lane >> 4;
    const unsigned wbs = (unsigned)__builtin_amdgcn_readfirstlane((int)(lds_addr_u(lds) + wid * 1024));
    if (ISSUE0) {
#pragma unroll
        for (int i = 0; i < 4; ++i) { glds16_asm(ar[i], wbs + i * 4096); glds16_asm(br[i], wbs + 16384 + i * 4096); }
    }
#pragma unroll
    for (int m = 0; m < 4; ++m)
#pragma unroll
        for (int n = 0; n < 4; ++n) acc[m][n] = (f32x4){0.f, 0.f, 0.f, 0.f};
    asm volatile("s_waitcnt vmcnt(0)" ::: "memory");
    __syncthreads();
    const int aoff = (wr * 64 + fr) * 128, boff = 16384 + (wc * 64 + fr) * 128, sw = fr & 7;
    for (int kt = 0; kt < nk; ++kt) {
        if (kt + 1 < nk) {
            const unsigned nb = (unsigned)__builtin_amdgcn_readfirstlane((int)(wbs + ((kt + 1) & 1) * 32768));
#pragma unroll
            for (int i = 0; i < 4; ++i) { glds16_asm(ar[i] + (kt + 1) * 64, nb + i * 4096); glds16_asm(br[i] + (kt + 1) * 64, nb + 16384 + i * 4096); }
        }
        mma_ktile(lds + (kt & 1) * 32768, aoff, boff, sw, fq, acc);
        if (kt + 1 < nk) {
            asm volatile("s_waitcnt vmcnt(0)" ::: "memory");
            __syncthreads();
        }
    }
}
__device__ __forceinline__ void gemm_gg(char* lds, int nk, const bf16_t* const (&ar)[4], const bf16_t* const (&br)[4], f32x4 (&acc)[4][4]) { gemm_ggx<true>(lds, nk, ar, br, acc); }
__device__ __forceinline__ void gemm_hn(char* lds, int nk, const bf16_t* const (&ar)[4], const bf16_t* const (&br)[2], f32x4 (&acc)[2][4]) {
    const int t = tidx();
    const int lane = t & 63, wid = t >> 6, fr = lane & 15, fq = lane >> 4;
    const unsigned wbs = (unsigned)__builtin_amdgcn_readfirstlane((int)(lds_addr_u(lds) + wid * 1024));
#pragma unroll
    for (int i = 0; i < 4; ++i) glds16_asm(ar[i], wbs + i * 4096);
#pragma unroll
    for (int i = 0; i < 2; ++i) glds16_asm(br[i], wbs + 16384 + i * 4096);
#pragma unroll
    for (int m = 0; m < 2; ++m)
#pragma unroll
        for (int n = 0; n < 4; ++n) acc[m][n] = (f32x4){0.f, 0.f, 0.f, 0.f};
    asm volatile("s_waitcnt vmcnt(0)" ::: "memory");
    __syncthreads();
    const int aoff = (wid * 32 + fr) * 128, boff = 16384 + fr * 128, sw = fr & 7;
    for (int kt = 0; kt < nk; ++kt) {
        if (kt + 1 < nk) {
            const unsigned nb = (unsigned)__builtin_amdgcn_readfirstlane((int)(wbs + ((kt + 1) & 1) * 32768));
#pragma unroll
            for (int i = 0; i < 4; ++i) glds16_asm(ar[i] + (kt + 1) * 64, nb + i * 4096);
#pragma unroll
            for (int i = 0; i < 2; ++i) glds16_asm(br[i] + (kt + 1) * 64, nb + 16384 + i * 4096);
        }
        const char* buf = lds + (kt & 1) * 32768;
#pragma unroll
        for (int ks = 0; ks < 2; ++ks) {
            const int ch = ((ks * 4 + fq) ^ sw) << 4;
            uint4 af[2], bfm[4];
#pragma unroll
            for (int m = 0; m < 2; ++m) af[m] = *(const uint4*)(buf + aoff + m * 2048 + ch);
#pragma unroll
            for (int n = 0; n < 4; ++n) bfm[n] = *(const uint4*)(buf + boff + n * 2048 + ch);
#pragma unroll
            for (int m = 0; m < 2; ++m)
#pragma unroll
                for (int n = 0; n < 4; ++n) acc[m][n] = mfma16(bfm[n], af[m], acc[m][n]);
        }
        asm volatile("s_waitcnt vmcnt(0)" ::: "memory");
        __syncthreads();
    }
}
template <class AL>
__device__ __forceinline__ void gemm_rg(char* lds, int nk, const AL& al, const bf16_t* const (&br)[4], f32x4 (&acc)[4][4]) {
    const int t = tidx(), c = t & 7, r0 = t >> 3;
    const int lane = t & 63, wid = t >> 6, wr = wid >> 1, wc = wid & 1, fr = lane & 15, fq = lane >> 4;
    char* wb = lds + wid * 1024;
    const int woff = r0 * 128 + ((c ^ (r0 & 7)) << 4);
#pragma unroll
    for (int i = 0; i < 4; ++i) glds16(br[i], wb + 16384 + i * 4096);
#pragma unroll
    for (int i = 0; i < 4; ++i) {
        typename AL::Raw ra = al.fetch(i, r0 + 32 * i, c);
        *(uint4*)(lds + woff + i * 4096) = al.finish(ra, i, r0 + 32 * i, c);
        asm volatile("" ::: "memory");
    }
#pragma unroll
    for (int m = 0; m < 4; ++m)
#pragma unroll
        for (int n = 0; n < 4; ++n) acc[m][n] = (f32x4){0.f, 0.f, 0.f, 0.f};
    asm volatile("s_waitcnt vmcnt(0)" ::: "memory");
    __syncthreads();
    const int aoff = (wr * 64 + fr) * 128, boff = 16384 + (wc * 64 + fr) * 128, sw = fr & 7;
    for (int kt = 0; kt < nk; ++kt) {
        const bool more = (kt + 1 < nk);
        char* nbuf = lds + ((kt + 1) & 1) * 32768;
        if (more) {
#pragma unroll
            for (int i = 0; i < 4; ++i) glds16(br[i] + (kt + 1) * 64, nbuf + wid * 1024 + 16384 + i * 4096);
        }
        mma_ktile(lds + (kt & 1) * 32768, aoff, boff, sw, fq, acc);
        if (more) {
#pragma unroll
            for (int i = 0; i < 4; ++i) {
                typename AL::Raw ra = al.fetch(i, r0 + 32 * i, (kt + 1) * 8 + c);
                *(uint4*)(nbuf + woff + i * 4096) = al.finish(ra, i, r0 + 32 * i, (kt + 1) * 8 + c);
                asm volatile("" ::: "memory");
            }
        }
        asm volatile("s_waitcnt vmcnt(0)" ::: "memory");
        __syncthreads();
    }
}
struct LdPlain {
    typedef uint4 Raw;
    const bf16_t* p; int ld; int nvalid;
    __device__ __forceinline__ uint4 fetch(int, int r, int kc) const { return (r < nvalid) ? *(const uint4*)(p + (size_t)r * ld + kc * 8) : make_uint4(0u, 0u, 0u, 0u); }
    __device__ __forceinline__ uint4 finish(const uint4& v, int, int, int) const { return v; }
};
struct LdGather {
    typedef uint4 Raw;
    const bf16_t* rp[4];
    __device__ __forceinline__ uint4 fetch(int i, int, int kc) const { const bf16_t* q = rp[i]; return q ? *(const uint4*)(q + kc * 8) : make_uint4(0u, 0u, 0u, 0u); }
    __device__ __forceinline__ uint4 finish(const uint4& v, int, int, int) const { return v; }
};
__device__ __forceinline__ void tile_map(int id, int NT, int& mt, int& nt) {
    const int x = id & 7, q = id >> 3;
    const int mg = q / (8 * NT), q2 = q - mg * 8 * NT, G = (NT + 7) >> 3;
    int g = q2 >> 6; g = g < G - 1 ? g : G - 1;
    const int r = q2 - (g << 6), w = (g == G - 1) ? NT - 8 * g : 8;
    mt = (mg * 8 + r / w) * 8 + x; nt = 8 * g + r % w;
}

__device__ __forceinline__ int conv_row(int mode, int n) {
    if (mode == 1) return (n >> 4) * 32 + (n & 15);
    if (mode == 2) return (n >> 4) * 32 + 16 + (n & 15);
    if (mode == 3 && n < 2048) { const int c = n & 255, c2 = c & 127; return (n & ~255) + (c2 >> 4) * 32 + ((c >> 7) << 4) + (c2 & 15); }
    return n;
}
__device__ __forceinline__ void conv_run(PRef p, char* lds, int tile_base, int ntiles, int* tick, int stop) {
    const int t = tidx();
    float* sm = (float*)lds;
    const int lane = t & 63, wv = t >> 6;
    const float* nsrc = nullptr; bf16_t* ndst = nullptr; int nK = 0, nN = 0, nmode = 0, nkt = 0, nnt = 0;
    float4 pv[16];
#define CJ_SETUP(ct_) { int c_ = tile_base + (ct_), j_ = 0; while (j_ + 1 < p.ncj && c_ >= p.cj[j_ + 1].tile0) ++j_; \
        c_ -= p.cj[j_].tile0; const int tpb_ = p.cj[j_].tiles_pb; const int bi_ = c_ / tpb_, tl_ = c_ % tpb_; nK = p.cj[j_].K; nN = p.cj[j_].N; nmode = p.cj[j_].mode; \
        const int nNt_ = (nN + 255) >> 8; nkt = tl_ / nNt_; nnt = tl_ % nNt_; nsrc = p.cj[j_].src + (size_t)bi_ * p.cj[j_].sbs; ndst = p.cj[j_].dst + (size_t)bi_ * p.cj[j_].dbs; }
#define CJ_LOAD() { _Pragma("unroll") for (int i = 0; i < 16; ++i) { const int k = nkt * 64 + wv + 4 * i, n = nnt * 256 + lane * 4; \
        pv[i] = (k < nK && n < nN) ? gld_f4(nsrc + (size_t)k * nN + n) : make_float4(0.f, 0.f, 0.f, 0.f); } }
    int* const nbox = (int*)(lds + 66560);
    const int BIG = 0x7fffffff;
    __syncthreads();
    if (t == 0) { const int a = atomicAdd(tick, 1); nbox[0] = a; nbox[1] = (a < stop) ? atomicAdd(tick, 1) : BIG; }
    __syncthreads();
    int ct = nbox[0], ct2 = nbox[1];
    __syncthreads();
    if (ct < ntiles) { CJ_SETUP(ct); CJ_LOAD(); }
    while (ct < ntiles) {
#pragma unroll
        for (int i = 0; i < 16; ++i) *(float4*)(sm + (wv + 4 * i) * 260 + lane * 4) = pv[i];
        bf16_t* const sdst = ndst; const int sK = nK, sN = nN, smode = nmode, skt = nkt, snt = nnt;
        if (ct2 < ntiles) { CJ_SETUP(ct2); CJ_LOAD(); }
        if (t == 0) nbox[0] = (ct2 < stop) ? atomicAdd(tick, 1) : BIG;
        __syncthreads();
        const int ct3 = nbox[0];
#pragma unroll
        for (int h2 = 0; h2 < 4; ++h2) {
            const int nl = lane + 64 * h2, n = snt * 256 + nl, k0 = skt * 64 + wv * 16;
            if (n < sN && k0 < sK) {
                float f[8], g[8];
#pragma unroll
                for (int q = 0; q < 8; ++q) { f[q] = sm[(wv * 16 + q) * 260 + nl]; g[q] = sm[(wv * 16 + 8 + q) * 260 + nl]; }
                bf16_t* d = sdst + (size_t)conv_row(smode, n) * sK + k0;
                { const uint4 u0 = pack8(f), u1 = pack8(g); gst_u4(d, u0.x, u0.y, u0.z, u0.w); gst_u4(d + 8, u1.x, u1.y, u1.z, u1.w); }
            }
        }
        __syncthreads();
        ct = ct2; ct2 = ct3;
    }
#undef CJ_SETUP
#undef CJ_LOAD
}
__device__ __forceinline__ void phase_prologue(PRef p, char* lds) {
    const int t = tidx();
    const int n_ada = 8 * 48, n_rot = 256 + 144;
    float* mod = (float*)(p.ws + OFF_MOD);
    for (int it = blockIdx.x; it < n_ada + n_rot; it += gridDim.x) {
        if (it < n_ada) {
            const int pr = it / 48, cb = it % 48;
            float* sc = (float*)lds;
            float* red = (float*)(lds + 32768);
            for (int i = t; i < 8192; i += 256) { const int b = i >> 10, k = i & 1023; sc[k * 8 + b] = siluf_(p.in[1][b * 1024 + k]); }
            __syncthreads();
            const int kg = t >> 6, cl = t & 63, col = cb * 64 + cl;
            const float* W = p.in[2] + (size_t)pr * 1024 * 3072 + col;
            float a[8] = {0, 0, 0, 0, 0, 0, 0, 0};
#pragma unroll 8
            for (int k = kg * 256; k < kg * 256 + 256; ++k) {
                const float w = W[(size_t)k * 3072];
                const float4 s0 = *(const float4*)(sc + k * 8), s1 = *(const float4*)(sc + k * 8 + 4);
                a[0] += w * s0.x; a[1] += w * s0.y; a[2] += w * s0.z; a[3] += w * s0.w; a[4] += w * s1.x; a[5] += w * s1.y; a[6] += w * s1.z; a[7] += w * s1.w;
            }
#pragma unroll
            for (int b = 0; b < 8; ++b) red[(kg * 8 + b) * 64 + cl] = a[b];
            __syncthreads();
            for (int i = t; i < 512; i += 256) {
                const int b = i >> 6, c2 = i & 63;
                const float s = red[(0 * 8 + b) * 64 + c2] + red[(1 * 8 + b) * 64 + c2] + red[(2 * 8 + b) * 64 + c2] + red[(3 * 8 + b) * 64 + c2];
                mod[((size_t)pr * 8 + b) * 3072 + cb * 64 + c2] = s + p.in[3][pr * 3072 + cb * 64 + c2];
            }
            __syncthreads();
        } else if (it >= n_ada + 256 && it < n_ada + n_rot) {
            float* rtw = (float*)(p.ws + OFF_RTW);
            const int base = (it - n_ada - 256) * 1024;
            for (int e = base + t; e < base + 1024; e += 256) {
                const int L = e / (36 * 1024), o = (e >> 10) % 36, k = e & 1023;
                rtw[e] = (o < 4) ? p.in[36][((size_t)L * 1024 + k) * 4 + o] : p.in[38][((size_t)L * 1024 + k) * 32 + (o - 4)];
            }
        } else if (it < n_ada + 256) {
            float* rot = (float*)(p.ws + OFF_ROT);
            const int base = (it - n_ada) * 1024;
            for (int e = base + t; e < base + 1024; e += 256) {
                const int tt = e >> 7, i = e & 127;
                const float inv = __builtin_amdgcn_exp2f(-(float)i * (13.287712379549449f / 127.0f));
                const float ang = (float)tt * inv;
                float rev = ang * 0.15915494309189535f; rev -= floorf(rev);
                rot[e * 2] = __builtin_amdgcn_cosf(rev); rot[e * 2 + 1] = __builtin_amdgcn_sinf(rev);
            }
        }
    }
    conv_run(p, lds, 0, p.cj_early, (int*)(p.ws + OFF_CTL + 20480), p.cj_early);
}

__device__ __forceinline__ void row_load_f32(const float* p, float (&v)[16], int lane) {
#pragma unroll
    for (int c = 0; c < 4; ++c) { const float4 x = gld_f4(p + c * 256 + lane * 4); v[c * 4] = x.x; v[c * 4 + 1] = x.y; v[c * 4 + 2] = x.z; v[c * 4 + 3] = x.w; }
}
__device__ __forceinline__ void row_load_f32_l(const float* p, float (&v)[16], int lane) {
#pragma unroll
    for (int c = 0; c < 4; ++c) { const float4 x = *(const float4*)(p + c * 256 + lane * 4); v[c * 4] = x.x; v[c * 4 + 1] = x.y; v[c * 4 + 2] = x.z; v[c * 4 + 3] = x.w; }
}
__device__ __forceinline__ void row_load_bf16(const bf16_t* p, float (&v)[16], int lane) {
#pragma unroll
    for (int c = 0; c < 4; ++c) { const uint2 x = gld_u2(p + c * 256 + lane * 4); v[c * 4] = bflo(x.x); v[c * 4 + 1] = bfhi(x.x); v[c * 4 + 2] = bflo(x.y); v[c * 4 + 3] = bfhi(x.y); }
}
__device__ __forceinline__ void row_store_bf16(bf16_t* p, const float (&v)[16], int lane) {
#pragma unroll
    for (int c = 0; c < 4; ++c) gst_u2(p + c * 256 + lane * 4, cvt_pk(v[c * 4], v[c * 4 + 1]), cvt_pk(v[c * 4 + 2], v[c * 4 + 3]));
}
__device__ __forceinline__ void row_store_f32(float* p, const float (&v)[16], int lane) {
#pragma unroll
    for (int c = 0; c < 4; ++c) gst_f4(p + c * 256 + lane * 4, v[c * 4], v[c * 4 + 1], v[c * 4 + 2], v[c * 4 + 3]);
}
__device__ __forceinline__ void row_store_f32_l(float* p, const float (&v)[16], int lane) {
#pragma unroll
    for (int c = 0; c < 4; ++c) *(float4*)(p + c * 256 + lane * 4) = make_float4(v[c * 4], v[c * 4 + 1], v[c * 4 + 2], v[c * 4 + 3]);
}
__device__ __forceinline__ void row_layernorm(float (&v)[16], const float* g, const float* b, int lane) {
    float gg[16], bb[16]; row_load_f32(g, gg, lane); row_load_f32(b, bb, lane);
    float s = 0.f, q = 0.f;
#pragma unroll
    for (int i = 0; i < 16; ++i) { s += v[i]; q += v[i] * v[i]; }
    s = wave_sum(s); q = wave_sum(q);
    const float mean = s * (1.0f / 1024.0f);
    const float rstd = rsqrtf(fmaxf(q * (1.0f / 1024.0f) - mean * mean, 0.f) + LN_EPS);
#pragma unroll
    for (int i = 0; i < 16; ++i) v[i] = (v[i] - mean) * rstd * gg[i] + bb[i];
}
__device__ __forceinline__ void row_modulate(const float (&x)[16], float (&h)[16], const float* mod3, int lane) {
    float sh[16], sc[16]; row_load_f32(mod3, sh, lane); row_load_f32(mod3 + 1024, sc, lane);
#pragma unroll
    for (int i = 0; i < 16; ++i) h[i] = x[i] * (1.0f + sc[i]) + sh[i];
}
__device__ __forceinline__ void load_mu(const float* mu, float (&m)[6][16], int lane) {
#pragma unroll
    for (int n = 0; n < 6; ++n) row_load_f32(mu + n * 1024, m[n], lane);
}
__device__ __forceinline__ void emit_next(bf16_t* s0, int kind, int row, const float (&h)[16], const float (&hp)[16], const float (&m)[6][16], int lane) {
    if (kind == 0) {
#pragma unroll
        for (int n = 0; n < 6; ++n) {
#pragma unroll
            for (int c = 0; c < 4; ++c)
                gst_u2(s0 + (size_t)n * (SLOT / 2) + (size_t)row * 1024 + c * 256 + lane * 4,
                       cvt_pk(h[c * 4] + (hp[c * 4] - h[c * 4]) * m[n][c * 4], h[c * 4 + 1] + (hp[c * 4 + 1] - h[c * 4 + 1]) * m[n][c * 4 + 1]),
                       cvt_pk(h[c * 4 + 2] + (hp[c * 4 + 2] - h[c * 4 + 2]) * m[n][c * 4 + 2], h[c * 4 + 3] + (hp[c * 4 + 3] - h[c * 4 + 3]) * m[n][c * 4 + 3]));
        }
    } else row_store_bf16(s0 + (size_t)row * 1024, h, lane);
}
__device__ __forceinline__ void emit_next_l(bf16_t* s0, const float* mu, int kind, int row, const float (&h)[16], const float (&hp)[16], int lane) {
    if (kind == 0) {
#pragma unroll 1
        for (int n = 0; n < 6; ++n) {
#pragma unroll
            for (int c2 = 0; c2 < 2; ++c2) {
                const float4 ma = gld_f4(mu + n * 1024 + (2 * c2) * 256 + lane * 4), mb = gld_f4(mu + n * 1024 + (2 * c2 + 1) * 256 + lane * 4);
                const float mm[8] = {ma.x, ma.y, ma.z, ma.w, mb.x, mb.y, mb.z, mb.w};
#pragma unroll
                for (int cc = 0; cc < 2; ++cc) {
                    const int c = 2 * c2 + cc;
                    gst_u2(s0 + (size_t)n * (SLOT / 2) + (size_t)row * 1024 + c * 256 + lane * 4,
                           cvt_pk(h[c * 4] + (hp[c * 4] - h[c * 4]) * mm[cc * 4], h[c * 4 + 1] + (hp[c * 4 + 1] - h[c * 4 + 1]) * mm[cc * 4 + 1]),
                           cvt_pk(h[c * 4 + 2] + (hp[c * 4 + 2] - h[c * 4 + 2]) * mm[cc * 4 + 2], h[c * 4 + 3] + (hp[c * 4 + 3] - h[c * 4 + 3]) * mm[cc * 4 + 3]));
                }
            }
        }
    } else row_store_bf16(s0 + (size_t)row * 1024, h, lane);
}
__device__ __forceinline__ void phase_h0(PRef p) {
    const int t_ = tidx(); const int lane = t_ & 63, gw = blockIdx.x * 4 + (t_ >> 6), nw = gridDim.x * 4;
    const int rpw = NTOK / nw;
    const int r_lo = gw * rpw;
    const float* mod = (const float*)(p.ws + OFF_MOD) + ((size_t)(0 * 2 + 0) * 8 + (r_lo >> 11)) * 3072;
    float sh[16], sc[16]; row_load_f32(mod, sh, lane); row_load_f32(mod + 1024, sc, lane);
    float hp[16];
#pragma unroll
    for (int i = 0; i < 16; ++i) hp[i] = 0.f;
    float mu[6][16]; load_mu(p.in[6], mu, lane);
    const int first = ((r_lo & 2047) != 0) ? r_lo - 1 : r_lo, end = r_lo + rpw;
    float nx[16]; row_load_f32(p.in[0] + (size_t)first * 1024, nx, lane);
    for (int r = first; r < end; ++r) {
        float h[16];
#pragma unroll
        for (int i = 0; i < 16; ++i) h[i] = nx[i] * (1.0f + sc[i]) + sh[i];
        if (r + 1 < end) row_load_f32(p.in[0] + (size_t)(r + 1) * 1024, nx, lane);
        __builtin_amdgcn_sched_barrier(0);
        if (r >= r_lo) emit_next((bf16_t*)(p.ws + OFF_SLOT), 0, r, h, hp, mu, lane);
#pragma unroll
        for (int i = 0; i < 16; ++i) hp[i] = h[i];
        if (((r + 1) & 2047) == 0) {
#pragma unroll
            for (int i = 0; i < 16; ++i) hp[i] = 0.f;
        }
    }
}
__device__ __forceinline__ int layer_kind(int L) { return L % 3; }
__device__ __forceinline__ void phase_ln2(PRef p, int L) {
    const int t_ = tidx(); const int lane = t_ & 63, gw = blockIdx.x * 4 + (t_ >> 6), nw = gridDim.x * 4;
    const int rpw = NTOK / nw, r_lo = gw * rpw;
    const float* mod = (const float*)(p.ws + OFF_MOD);
    const bf16_t* xres = (const bf16_t*)(p.ws + OFF_XRES);
    const bf16_t* Y = (const bf16_t*)(p.ws + OFF_SLOT + 9 * SLOT);
    const float* wgt = (const float*)(p.ws + OFF_WGT);
    const bool last = (L == 3);
    const int nk = layer_kind(L + 1), njr = (L + 1) / 3;
    const bool need_prev = (!last && nk == 0);
    const int bidx = r_lo >> 11;
    float gt[16], lgn[16], lbn[16];
    row_load_f32(mod + ((size_t)(L * 2 + 1) * 8 + bidx) * 3072 + 2048, gt, lane);
    row_load_f32(p.in[4] + (L * 2 + 1) * 1024, lgn, lane); row_load_f32(p.in[5] + (L * 2 + 1) * 1024, lbn, lane);
    float hp[16];
#pragma unroll
    for (int i = 0; i < 16; ++i) hp[i] = 0.f;
    float shn[16], scn[16];
    { const float* mn_ = mod + ((size_t)((last ? L : L + 1) * 2 + 0) * 8 + bidx) * 3072; row_load_f32(mn_, shn, lane); row_load_f32(mn_ + 1024, scn, lane); }
    uint2 nxr[4], ny0[4], ny1[4]; float nw0, nw1;
    auto load_in = [&](int r) {
#pragma unroll
        for (int c = 0; c < 4; ++c) { nxr[c] = *(const uint2*)(xres + (size_t)r * 1024 + c * 256 + lane * 4); ny0[c] = *(const uint2*)(Y + (size_t)(2 * r) * 1024 + c * 256 + lane * 4); ny1[c] = *(const uint2*)(Y + (size_t)(2 * r + 1) * 1024 + c * 256 + lane * 4); }
        nw0 = wgt[2 * r]; nw1 = wgt[2 * r + 1];
    };
    const int first = (need_prev && (r_lo & 2047) != 0) ? r_lo - 1 : r_lo, end = r_lo + rpw;
    load_in(first);
    for (int r = first; r < end; ++r) {
        float x[16];
        {
            const float w0 = nw0, w1 = nw1;
#pragma unroll
            for (int c = 0; c < 4; ++c) {
                const float a0[4] = {bflo(ny0[c].x), bfhi(ny0[c].x), bflo(ny0[c].y), bfhi(ny0[c].y)}, a1[4] = {bflo(ny1[c].x), bfhi(ny1[c].x), bflo(ny1[c].y), bfhi(ny1[c].y)};
                const float xr[4] = {bflo(nxr[c].x), bfhi(nxr[c].x), bflo(nxr[c].y), bfhi(nxr[c].y)};
#pragma unroll
                for (int i = 0; i < 4; ++i) x[c * 4 + i] = DN_ALPHA * xr[i] + (1.0f + gt[c * 4 + i]) * (w0 * a0[i] + w1 * a1[i]);
            }
        }
        if (r + 1 < end) load_in(r + 1);
        __builtin_amdgcn_sched_barrier(0);
        float s = 0.f, q = 0.f;
#pragma unroll
        for (int i = 0; i < 16; ++i) { s += x[i]; q += x[i] * x[i]; }
        s = wave_sum(s); q = wave_sum(q);
        const float mean = s * (1.0f / 1024.0f), rstd = rsqrtf(fmaxf(q * (1.0f / 1024.0f) - mean * mean, 0.f) + LN_EPS);
#pragma unroll
        for (int i = 0; i < 16; ++i) x[i] = (x[i] - mean) * rstd * lgn[i] + lbn[i];
        if (last) { row_store_f32(p.out + (size_t)r * 1024, x, lane); continue; }
        float h[16];
#pragma unroll
        for (int i = 0; i < 16; ++i) h[i] = x[i] * (1.0f + scn[i]) + shn[i];
        if (r >= r_lo) { row_store_bf16((bf16_t*)(p.ws + OFF_XRES2) + (size_t)r * 1024, x, lane); emit_next_l((bf16_t*)(p.ws + OFF_SLOT), p.in[6] + (size_t)njr * 6 * 1024, nk, r, h, hp, lane); }
#pragma unroll
        for (int i = 0; i < 16; ++i) hp[i] = h[i];
        if (((r + 1) & 2047) == 0) {
#pragma unroll
            for (int i = 0; i < 16; ++i) hp[i] = 0.f;
        }
    }
}
__device__ __forceinline__ void phase_ln1(PRef p, int L, char* lds, const bf16_t* ymix, bf16_t* hm) {
    const int t = tidx(), lane = t & 63, wid = t >> 6;
    const float* mod = (const float*)(p.ws + OFF_MOD);
    const bf16_t* xinb = (const bf16_t*)(p.ws + OFF_XRES2);
    bf16_t* xres = (bf16_t*)(p.ws + OFF_XRES);
    int* cnt = (int*)(p.ws + OFF_CNT) + L * 32;
    int* list = (int*)(p.ws + OFF_LIST);
    float* wgt = (float*)(p.ws + OFF_WGT);
    float* const HB = (float*)lds;
    float* const lg = (float*)(lds + 65536);
    const float* rtw = (const float*)(p.ws + OFF_RTW) + (size_t)L * 36 * 1024;
    const int rpb = NTOK / gridDim.x;
    const int bidx = (blockIdx.x * rpb) >> 11;
    float gt[16], lgn[16], lbn[16], sh2[16], sc2[16];
    row_load_f32(mod + ((size_t)(L * 2 + 0) * 8 + bidx) * 3072 + 2048, gt, lane);
    row_load_f32(p.in[4] + (L * 2 + 0) * 1024, lgn, lane); row_load_f32(p.in[5] + (L * 2 + 0) * 1024, lbn, lane);
    row_load_f32(mod + ((size_t)(L * 2 + 1) * 8 + bidx) * 3072, sh2, lane); row_load_f32(mod + ((size_t)(L * 2 + 1) * 8 + bidx) * 3072 + 1024, sc2, lane);
    for (int rb0 = blockIdx.x * rpb; rb0 < (blockIdx.x + 1) * rpb; rb0 += 16) {
        const int rb = rb0 + wid * 4;
        uint4 xr[4][4]; uint2 yr[4][4];
#pragma unroll
        for (int rr = 0; rr < 4; ++rr) {
            const int r = rb + rr;
#pragma unroll
            for (int c = 0; c < 4; ++c) {
                if (L == 0) xr[rr][c] = gld_u4(p.in[0] + (size_t)r * 1024 + c * 256 + lane * 4);
                else { const uint2 t2 = gld_u2(xinb + (size_t)r * 1024 + c * 256 + lane * 4); xr[rr][c] = make_uint4(t2.x, t2.y, 0u, 0u); }
                yr[rr][c] = gld_u2(ymix + (size_t)r * 1024 + c * 256 + lane * 4);
            }
        }
#pragma unroll
        for (int rr = 0; rr < 4; ++rr) {
            const int r = rb + rr;
            float x[16], h[16];
#pragma unroll
            for (int c = 0; c < 4; ++c) {
                float xv[4];
                if (L == 0) { xv[0] = __uint_as_float(xr[rr][c].x); xv[1] = __uint_as_float(xr[rr][c].y); xv[2] = __uint_as_float(xr[rr][c].z); xv[3] = __uint_as_float(xr[rr][c].w); }
                else { xv[0] = bflo(xr[rr][c].x); xv[1] = bfhi(xr[rr][c].x); xv[2] = bflo(xr[rr][c].y); xv[3] = bfhi(xr[rr][c].y); }
                const float yv[4] = {bflo(yr[rr][c].x), bfhi(yr[rr][c].x), bflo(yr[rr][c].y), bfhi(yr[rr][c].y)};
#pragma unroll
                for (int i = 0; i < 4; ++i) x[c * 4 + i] = DN_ALPHA * xv[i] + (1.0f + gt[c * 4 + i]) * yv[i];
            }
            float s = 0.f, q = 0.f;
#pragma unroll
            for (int i = 0; i < 16; ++i) { s += x[i]; q += x[i] * x[i]; }
            s = wave_sum(s); q = wave_sum(q);
            const float mean = s * (1.0f / 1024.0f), rstd = rsqrtf(fmaxf(q * (1.0f / 1024.0f) - mean * mean, 0.f) + LN_EPS);
#pragma unroll
            for (int i = 0; i < 16; ++i) { x[i] = (x[i] - mean) * rstd * lgn[i] + lbn[i]; h[i] = x[i] * (1.0f + sc2[i]) + sh2[i]; }
            row_store_bf16(xres + (size_t)r * 1024, x, lane);
            row_store_bf16(hm + (size_t)r * 1024, h, lane);
            row_store_f32_l(HB + (wid * 4 + rr) * 1024, h, lane);
        }
        __syncthreads();
#pragma unroll 1
        for (int q3 = 0; q3 < 9; q3 += 3) {
            float w[3][16];
#pragma unroll
            for (int u = 0; u < 3; ++u) row_load_f32(rtw + (size_t)(wid * 9 + q3 + u) * 1024, w[u], lane);
#pragma unroll 2
            for (int r16 = 0; r16 < 16; ++r16) {
                float h[16]; row_load_f32_l(HB + r16 * 1024, h, lane);
                float a3[3];
#pragma unroll
                for (int u = 0; u < 3; ++u) { f32x2_t s2 = {0.f, 0.f};
#pragma unroll
                    for (int i = 0; i < 8; ++i) { const f32x2_t hh = {h[2 * i], h[2 * i + 1]}, ww = {w[u][2 * i], w[u][2 * i + 1]}; s2 = __builtin_elementwise_fma(hh, ww, s2); }
                    a3[u] = s2.x + s2.y; }
                {
                    const auto r01 = __builtin_amdgcn_permlane32_swap(__float_as_uint(a3[0]), __float_as_uint(a3[1]), false, false);
                    const float z = __uint_as_float(r01[0]) + __uint_as_float(r01[1]);
                    const float c2 = xor32_add(a3[2]);
                    const auto rz = __builtin_amdgcn_permlane16_swap(__float_as_uint(z), __float_as_uint(c2), false, false);
                    const float tot = row16_sum(__uint_as_float(rz[0]) + __uint_as_float(rz[1]));
                    if ((lane & 15) == 0 && lane < 48) lg[r16 * 36 + wid * 9 + q3 + (lane == 0 ? 0 : lane == 32 ? 1 : 2)] = tot;
                }
            }
        }
        __syncthreads();
        if (t < 16) {
            const int row = rb0 + t; const float* l = lg + t * 36;
            float g[4]; for (int i = 0; i < 4; ++i) g[i] = l[i] + p.in[37][L * 4 + i];
            int gi = 0; for (int i = 1; i < 4; ++i) if (g[i] > g[gi]) gi = i;
            float gs = 0.f; for (int i = 0; i < 4; ++i) gs += __expf(g[i] - g[gi]);
            const float ggate = 1.0f / gs;
            float e[8]; for (int i = 0; i < 8; ++i) e[i] = l[4 + gi * 8 + i] + p.in[39][L * 32 + gi * 8 + i];
            int i0 = 0; for (int i = 1; i < 8; ++i) if (e[i] > e[i0]) i0 = i;
            int i1 = (i0 == 0) ? 1 : 0; for (int i = 0; i < 8; ++i) if (i != i0 && e[i] > e[i1]) i1 = i;
            const float p1 = __expf(e[i1] - e[i0]);
            const float w0 = ggate / (1.0f + p1), w1 = ggate * p1 / (1.0f + p1);
            const int e0 = gi * 8 + i0, e1 = gi * 8 + i1;
            const int pos0 = atomicAdd(&cnt[e0], 1), pos1 = atomicAdd(&cnt[e1], 1);
            list[e0 * LIST_CAP + pos0] = 2 * row; list[e1 * LIST_CAP + pos1] = 2 * row + 1;
            wgt[2 * row] = w0; wgt[2 * row + 1] = w1;
        }
        asm volatile("s_waitcnt lgkmcnt(0)" ::: "memory");
    }
}

__device__ __forceinline__ int perm64(int r) { return (r & 64) | (((r >> 2) & 3) << 4) | (((r >> 4) & 3) << 2) | (r & 3); }
__device__ __forceinline__ bool tile_permuted(int mode, int nt) { return (mode <= MODE_SIGM) || (mode == MODE_ML1 && nt < 24) || (mode == MODE_RT1 && nt >= 16); }
__device__ __forceinline__ void store16(bf16_t* d, const f32x4 (&v)[4]) {
    gst_u4(d, cvt_pk(v[0][0], v[0][1]), cvt_pk(v[0][2], v[0][3]), cvt_pk(v[1][0], v[1][1]), cvt_pk(v[1][2], v[1][3]));
    gst_u4(d + 8, cvt_pk(v[2][0], v[2][1]), cvt_pk(v[2][2], v[2][3]), cvt_pk(v[3][0], v[3][1]), cvt_pk(v[3][2], v[3][3]));
}
__device__ __forceinline__ void gemm_epilogue(PRef p, const GJob& jb, int mt, int nt, const f32x4 (&acc)[4][4]) {
    const int t_ = tidx(); const int lane = t_ & 63, wid = t_ >> 6, wr = wid >> 1, wc = wid & 1, fr = lane & 15, fq = lane >> 4;
    const int row0 = mt * 128 + wr * 64 + fr;
    if (jb.mode <= MODE_SIGM) {
        const int col = nt * 128 + wc * 64 + fq * 16;
        if (col < jb.N) {
#pragma unroll
            for (int m = 0; m < 4; ++m) {
                f32x4 v[4];
#pragma unroll
                for (int n = 0; n < 4; ++n) {
                    v[n] = acc[m][n];
                    if (jb.mode == MODE_TANH) { v[n][0] = tanhf_(v[n][0]); v[n][1] = tanhf_(v[n][1]); v[n][2] = tanhf_(v[n][2]); v[n][3] = tanhf_(v[n][3]); }
                    else if (jb.mode == MODE_SIGM) { v[n][0] = sigmoidf_(v[n][0]); v[n][1] = sigmoidf_(v[n][1]); v[n][2] = sigmoidf_(v[n][2]); v[n][3] = sigmoidf_(v[n][3]); }
                }
                store16(jb.out + (size_t)(row0 + m * 16) * jb.ldo + col, v);
            }
        }
    } else if (jb.mode == MODE_ML1) {
        if (nt < 24) {
            bf16_t* ob = (bf16_t*)(p.ws + OFF_SLOT + (size_t)(1 + (nt >> 3)) * SLOT);
            const bool sg = (nt >= 16);
            const int col = (nt & 7) * 128 + wc * 64 + fq * 16;
#pragma unroll
            for (int m = 0; m < 4; ++m) {
                f32x4 v[4];
#pragma unroll
                for (int n = 0; n < 4; ++n) {
                    v[n] = acc[m][n];
                    if (sg) { v[n][0] = sigmoidf_(v[n][0]); v[n][1] = sigmoidf_(v[n][1]); v[n][2] = sigmoidf_(v[n][2]); v[n][3] = sigmoidf_(v[n][3]); }
                }
                store16(ob + (size_t)(row0 + m * 16) * 1024 + col, v);
            }
        } else if (wc == 0) {
            float* gates = (float*)(p.ws + OFF_GATES);
            const float* bg = p.in[26];
            const int c0 = fq * 4;
#pragma unroll
            for (int m = 0; m < 4; ++m) {
                f32x4 v = acc[m][0], o;
#pragma unroll
                for (int j = 0; j < 4; ++j) { const float g = v[j] + bg[c0 + j]; o[j] = (c0 + j < 8) ? g : -softplusf_(-g); }
                gst_f4(gates + (size_t)(row0 + m * 16) * 16 + c0, o[0], o[1], o[2], o[3]);
            }
        }
    } else {
        if (nt < 16) {
            const float* rot = (const float*)(p.ws + OFF_ROT);
            bf16_t* ob = (bf16_t*)(p.ws + OFF_SLOT + (size_t)(1 + (nt >> 3)) * SLOT);
            const float scl = (nt >= 8) ? 0.0625f : 1.0f;
#pragma unroll
            for (int pp = 0; pp < 2; ++pp) {
                const int blk32 = (nt & 7) * 4 + wc * 2 + pp, head = blk32 >> 3, i0 = (blk32 & 7) * 16 + fq * 4;
                float4 rc0[4], rc1[4];
#pragma unroll
                for (int m = 0; m < 4; ++m) { const int tt = (row0 + m * 16) & 2047; rc0[m] = gld_f4(rot + ((size_t)tt * 128 + i0) * 2); rc1[m] = gld_f4(rot + ((size_t)tt * 128 + i0) * 2 + 4); }
#pragma unroll
                for (int m = 0; m < 4; ++m) {
                    const int row = row0 + m * 16;
                    const float4 c0 = rc0[m], c1 = rc1[m];
                    const float cs[4] = {c0.x, c0.z, c1.x, c1.z}, sn[4] = {c0.y, c0.w, c1.y, c1.w};
                    const f32x4 x1 = acc[m][2 * pp], x2 = acc[m][2 * pp + 1];
                    float o1[4], o2[4];
#pragma unroll
                    for (int j = 0; j < 4; ++j) { o1[j] = (x1[j] * cs[j] - x2[j] * sn[j]) * scl; o2[j] = (x1[j] * sn[j] + x2[j] * cs[j]) * scl; }
                    gst_u2(ob + (size_t)row * 1024 + head * 256 + i0, cvt_pk(o1[0], o1[1]), cvt_pk(o1[2], o1[3]));
                    gst_u2(ob + (size_t)row * 1024 + head * 256 + 128 + i0, cvt_pk(o2[0], o2[1]), cvt_pk(o2[2], o2[3]));
                }
            }
        } else {
            const bool isg = (nt >= 32);
            bf16_t* ob = (bf16_t*)(p.ws + OFF_SLOT + (size_t)(isg ? 5 : 3) * SLOT);
            const int col = (nt & 15) * 128 + wc * 64 + fq * 16;
#pragma unroll
            for (int m = 0; m < 4; ++m) {
                f32x4 v[4];
#pragma unroll
                for (int n = 0; n < 4; ++n) {
                    v[n] = acc[m][n];
                    if (isg) { v[n][0] = siluf_(v[n][0]); v[n][1] = siluf_(v[n][1]); v[n][2] = siluf_(v[n][2]); v[n][3] = siluf_(v[n][3]); }
                }
                store16(ob + (size_t)(row0 + m * 16) * 2048 + col, v);
            }
        }
    }
}
__device__ __forceinline__ void phase_gemm_jobs(PRef p, char* lds, int jlo, int jhi) {
    const int total = p.gj[jhi - 1].tile0 + 128 * p.gj[jhi - 1].ntn - p.gj[jlo].tile0;
    for (int id = blockIdx.x; id < total; id += gridDim.x) {
        int j = jlo; const int gid = id + p.gj[jlo].tile0;
        while (j + 1 < jhi && gid >= p.gj[j + 1].tile0) ++j;
        GJob jb; jb.A = p.gj[j].A; jb.Bt = p.gj[j].Bt; jb.out = p.gj[j].out; jb.K = p.gj[j].K; jb.N = p.gj[j].N; jb.ldo = p.gj[j].ldo; jb.mode = p.gj[j].mode; jb.ntn = p.gj[j].ntn; jb.tile0 = p.gj[j].tile0;
        jb.half = p.gj[j].half;
        int mt, nt; tile_map(gid - jb.tile0, jb.ntn, mt, nt);
        if (jb.half || (jb.mode == MODE_ML1 && nt == 24)) {
            const int t_ = tidx(), r0_ = t_ >> 3, co_ = glds_chunk(t_) * 8, ln_ = t_ & 63, wv_ = t_ >> 6, fr_ = ln_ & 15, fq_ = ln_ >> 4;
            const int cb = jb.half ? nt * 64 : nt * 128;
            int nvh = jb.N - cb; nvh = nvh > 64 ? 64 : nvh;
            const bf16_t* ar[4]; const bf16_t* brh[2];
#pragma unroll
            for (int i = 0; i < 4; ++i) ar[i] = jb.A + (size_t)(mt * 128 + r0_ + 32 * i) * jb.K + co_;
#pragma unroll
            for (int i = 0; i < 2; ++i) { int rb_ = r0_ + 32 * i; rb_ = jb.half ? perm64(rb_) : rb_; rb_ = rb_ < nvh ? rb_ : nvh - 1; brh[i] = jb.Bt + (size_t)(cb + rb_) * jb.K + co_; }
            f32x4 ah[2][4];
            gemm_hn(lds, jb.K / 64, ar, brh, ah);
            const int rowh = mt * 128 + wv_ * 32 + fr_;
            if (jb.half) {
                const int col = cb + fq_ * 16;
                if (col < jb.N) {
#pragma unroll
                    for (int m = 0; m < 2; ++m) {
                        f32x4 v[4];
#pragma unroll
                        for (int n = 0; n < 4; ++n) {
                            v[n] = ah[m][n];
#pragma unroll
                            for (int jj = 0; jj < 4; ++jj) v[n][jj] = (jb.mode == MODE_TANH) ? tanhf_(v[n][jj]) : (jb.mode == MODE_SIGM) ? sigmoidf_(v[n][jj]) : v[n][jj];
                        }
                        store16(jb.out + (size_t)(rowh + m * 16) * jb.ldo + col, v);
                    }
                }
            } else {
                float* gates = (float*)(p.ws + OFF_GATES);
                const float* bg = p.in[26];
                const int c0 = fq_ * 4;
                const float4 bq = gld_f4(bg + c0);
                const float bqa[4] = {bq.x, bq.y, bq.z, bq.w};
#pragma unroll
                for (int m = 0; m < 2; ++m) {
                    float o[4];
#pragma unroll
                    for (int jj = 0; jj < 4; ++jj) { const float g = ah[m][0][jj] + bqa[jj]; o[jj] = (c0 + jj < 8) ? g : -softplusf_(-g); }
                    gst_f4(gates + (size_t)(rowh + m * 16) * 16 + c0, o[0], o[1], o[2], o[3]);
                }
            }
            continue;
        }
        int nv = jb.N - nt * 128; nv = nv > 128 ? 128 : nv;
        const bf16_t* ar[4]; const bf16_t* br[4];
        {
            const int t_ = tidx(), r0_ = t_ >> 3, co_ = glds_chunk(t_) * 8;
            const bool pm_ = tile_permuted(jb.mode, nt);
#pragma unroll
            for (int i = 0; i < 4; ++i) {
                ar[i] = jb.A + (size_t)(mt * 128 + r0_ + 32 * i) * jb.K + co_;
                int rb_ = r0_ + 32 * i; rb_ = pm_ ? perm64(rb_) : rb_; rb_ = rb_ < nv ? rb_ : nv - 1;
                br[i] = jb.Bt + (size_t)(nt * 128 + rb_) * jb.K + co_;
            }
        }
        f32x4 acc[4][4];
        gemm_gg(lds, jb.K / 64, ar, br, acc);
        gemm_epilogue(p, jb, mt, nt, acc);
    }
}

constexpr int RM = 4;
template <int KL>
__device__ __forceinline__ void minigemm(const bf16_t* A, const bf16_t* Bt, int fr, int fq, f32x4 (&acc)[RM][4]) {
#pragma unroll
    for (int m = 0; m < RM; ++m)
#pragma unroll
        for (int n = 0; n < 4; ++n) acc[m][n] = (f32x4){0.f, 0.f, 0.f, 0.f};
#pragma unroll 2
    for (int ks = 0; ks < KL / 32; ++ks) {
        uint4 af[RM], bfm[4];
#pragma unroll
        for (int m = 0; m < RM; ++m) af[m] = gld_u4(A + (size_t)(m * 16 + fr) * KL + ks * 32 + fq * 8);
#pragma unroll
        for (int n = 0; n < 4; ++n) bfm[n] = gld_u4(Bt + (size_t)((fr >> 2) * 16 + n * 4 + (fr & 3)) * KL + ks * 32 + fq * 8);
#pragma unroll
        for (int m = 0; m < RM; ++m)
#pragma unroll
            for (int n = 0; n < 4; ++n) acc[m][n] = mfma16(bfm[n], af[m], acc[m][n]);
    }
}
__device__ __forceinline__ void phase_rw2(PRef p, int jr) {
    const int t_ = tidx(); const int lane = t_ & 63, wid = t_ >> 6, wr = wid >> 1, wc = wid & 1, fr = lane & 15, fq = lane >> 4;
    char* S = p.ws + OFF_SLOT;
    bf16_t* decayb = (bf16_t*)S; bf16_t* nkk = (bf16_t*)(S + 2 * SLOT); bf16_t* bb = (bf16_t*)(S + 3 * SLOT); bf16_t* gb = (bf16_t*)(S + 4 * SLOT);
    const bf16_t* rb = (const bf16_t*)(S + 6 * SLOT); const bf16_t* kb = (const bf16_t*)(S + 7 * SLOT); bf16_t* kpb = (bf16_t*)(S + 10 * SLOT);
    const bf16_t* vb = (const bf16_t*)(S + 8 * SLOT); bf16_t* vpb = (bf16_t*)(S + 9 * SLOT); const bf16_t* vf = (const bf16_t*)(S + 11 * SLOT);
    float* bonus = (float*)(p.ws + OFF_BONUS);
    const bf16_t* Lw = (const bf16_t*)(p.ws + OFF_LW); const bf16_t* La = (const bf16_t*)(p.ws + OFF_LA);
    const bf16_t* Lg = (const bf16_t*)(p.ws + OFF_LG); const bf16_t* Lv = (const bf16_t*)(p.ws + OFF_LV);
    const bf16_t* w2t = (const bf16_t*)(p.ws + W_W2T) + (size_t)jr * 1024 * 64; const bf16_t* a2t = (const bf16_t*)(p.ws + W_A2T) + (size_t)jr * 1024 * 64;
    const bf16_t* g2t = (const bf16_t*)(p.ws + W_G2T) + (size_t)jr * 1024 * 128; const bf16_t* v2t = (const bf16_t*)(p.ws + W_V2T);
    const float* w0 = p.in[8] + jr * 1024; const float* a0 = p.in[11] + jr * 1024; const float* v0 = p.in[14];
    const float* kkw = p.in[19] + jr * 1024; const float* kaw = p.in[20] + jr * 1024; const float* rk = p.in[21] + jr * 1024;
    for (int id2 = blockIdx.x; id2 < 128 * 8; id2 += gridDim.x) {
        int mt, nt; tile_map(id2, 8, mt, nt);
        const int row0 = mt * 128 + wr * 64, col0 = nt * 128 + wc * 64, head = nt * 2 + wc;
        f32x4 acc[RM][4];
        const int c0 = col0 + fq * 16;
        minigemm<64>(La + (size_t)row0 * 64, a2t + (size_t)col0 * 64, fr, fq, acc);
        float ss[RM], bs[RM];
#pragma unroll
        for (int m = 0; m < RM; ++m) { ss[m] = 0.f; bs[m] = 0.f; }
#pragma unroll
        for (int m = 0; m < RM; ++m) {
            const size_t off = (size_t)(row0 + m * 16 + fr) * 1024 + c0;
            const uint4 kq0 = *(const uint4*)(kb + off), kq1 = *(const uint4*)(kb + off + 8);
            const unsigned kw[8] = {kq0.x, kq0.y, kq0.z, kq0.w, kq1.x, kq1.y, kq1.z, kq1.w};
#pragma unroll
            for (int n = 0; n < 4; ++n) {
                const float4 a0v = *(const float4*)(a0 + c0 + n * 4), kkv = *(const float4*)(kkw + c0 + n * 4);
                const float a0a[4] = {a0v.x, a0v.y, a0v.z, a0v.w}, kka[4] = {kkv.x, kkv.y, kkv.z, kkv.w};
                const float kf4[4] = {bflo(kw[n * 2]), bfhi(kw[n * 2]), bflo(kw[n * 2 + 1]), bfhi(kw[n * 2 + 1])};
#pragma unroll
                for (int j = 0; j < 4; ++j) { acc[m][n][j] = sigmoidf_(a0a[j] + acc[m][n][j]); const float q = kf4[j] * kka[j]; ss[m] += q * q; }
            }
            asm volatile("" ::: "memory");
        }
#pragma unroll
        for (int m = 0; m < RM; ++m) { ss[m] = xor16_add(ss[m]); ss[m] = xor32_add(ss[m]); ss[m] = fminf(__builtin_amdgcn_rsqf(ss[m]), 1e12f); }
        float4 kkq[4], kaq[4], rkq[4];
#pragma unroll
        for (int n = 0; n < 4; ++n) { kkq[n] = gld_f4(kkw + c0 + n * 4); kaq[n] = gld_f4(kaw + c0 + n * 4); rkq[n] = gld_f4(rk + c0 + n * 4); }
#pragma unroll
        for (int m = 0; m < RM; ++m) {
            const size_t off = (size_t)(row0 + m * 16 + fr) * 1024 + c0;
            const uint4 rq0 = *(const uint4*)(rb + off), rq1 = *(const uint4*)(rb + off + 8), kq0 = *(const uint4*)(kb + off), kq1 = *(const uint4*)(kb + off + 8);
            const unsigned kw[8] = {kq0.x, kq0.y, kq0.z, kq0.w, kq1.x, kq1.y, kq1.z, kq1.w};
            const unsigned rw[8] = {rq0.x, rq0.y, rq0.z, rq0.w, rq1.x, rq1.y, rq1.z, rq1.w};
            unsigned okp[8], onk[8], obb[8];
#pragma unroll
            for (int n = 0; n < 4; ++n) {
                const float kka[4] = {kkq[n].x, kkq[n].y, kkq[n].z, kkq[n].w}, kaa[4] = {kaq[n].x, kaq[n].y, kaq[n].z, kaq[n].w}, rka[4] = {rkq[n].x, rkq[n].y, rkq[n].z, rkq[n].w};
                const float rf[4] = {bflo(rw[n * 2]), bfhi(rw[n * 2]), bflo(rw[n * 2 + 1]), bfhi(rw[n * 2 + 1])}, kf4[4] = {bflo(kw[n * 2]), bfhi(kw[n * 2]), bflo(kw[n * 2 + 1]), bfhi(kw[n * 2 + 1])};
                float kp[4], nk[4], b4[4];
#pragma unroll
                for (int j = 0; j < 4; ++j) {
                    const float a = acc[m][n][j], k = kf4[j], kn = k * kka[j] * ss[m];
                    kp[j] = k * (1.0f + (a - 1.0f) * kaa[j]); nk[j] = -kn; b4[j] = kn * a; bs[m] += rf[j] * kp[j] * rka[j];
                }
                okp[n * 2] = cvt_pk(kp[0], kp[1]); okp[n * 2 + 1] = cvt_pk(kp[2], kp[3]);
                onk[n * 2] = cvt_pk(nk[0], nk[1]); onk[n * 2 + 1] = cvt_pk(nk[2], nk[3]);
                obb[n * 2] = cvt_pk(b4[0], b4[1]); obb[n * 2 + 1] = cvt_pk(b4[2], b4[3]);
            }
            *(uint4*)(kpb + off) = make_uint4(okp[0], okp[1], okp[2], okp[3]); *(uint4*)(kpb + off + 8) = make_uint4(okp[4], okp[5], okp[6], okp[7]);
            *(uint4*)(nkk + off) = make_uint4(onk[0], onk[1], onk[2], onk[3]); *(uint4*)(nkk + off + 8) = make_uint4(onk[4], onk[5], onk[6], onk[7]);
            *(uint4*)(bb + off) = make_uint4(obb[0], obb[1], obb[2], obb[3]); *(uint4*)(bb + off + 8) = make_uint4(obb[4], obb[5], obb[6], obb[7]);
            asm volatile("" ::: "memory");
        }
#pragma unroll
        for (int m = 0; m < RM; ++m) { bs[m] = xor16_add(bs[m]); bs[m] = xor32_add(bs[m]); if (fq == 0) bonus[(size_t)(row0 + m * 16 + fr) * 16 + head] = bs[m]; }
        minigemm<64>(Lw + (size_t)row0 * 64, w2t + (size_t)col0 * 64, fr, fq, acc);
        float4 w0q[4];
#pragma unroll
        for (int n = 0; n < 4; ++n) w0q[n] = gld_f4(w0 + c0 + n * 4);
#pragma unroll
        for (int m = 0; m < RM; ++m) {
            unsigned od[8];
#pragma unroll
            for (int n = 0; n < 4; ++n) {
                const float w0a[4] = {w0q[n].x, w0q[n].y, w0q[n].z, w0q[n].w};
                float dd[4];
#pragma unroll
                for (int j = 0; j < 4; ++j) dd[j] = 1.0f - __builtin_amdgcn_exp2f(-0.87503877f * sigmoidf_(w0a[j] + acc[m][n][j]));
                od[n * 2] = cvt_pk(dd[0], dd[1]); od[n * 2 + 1] = cvt_pk(dd[2], dd[3]);
            }
            bf16_t* dp_ = decayb + (size_t)(row0 + m * 16 + fr) * 1024 + c0;
            *(uint4*)dp_ = make_uint4(od[0], od[1], od[2], od[3]); *(uint4*)(dp_ + 8) = make_uint4(od[4], od[5], od[6], od[7]);
        }
        minigemm<128>(Lg + (size_t)row0 * 128, g2t + (size_t)col0 * 128, fr, fq, acc);
#pragma unroll
        for (int m = 0; m < RM; ++m) {
            unsigned o[8];
#pragma unroll
            for (int n = 0; n < 4; ++n) { o[n * 2] = cvt_pk(acc[m][n][0], acc[m][n][1]); o[n * 2 + 1] = cvt_pk(acc[m][n][2], acc[m][n][3]); }
            bf16_t* d = gb + (size_t)(row0 + m * 16 + fr) * 1024 + c0;
            *(uint4*)d = make_uint4(o[0], o[1], o[2], o[3]); *(uint4*)(d + 8) = make_uint4(o[4], o[5], o[6], o[7]);
        }
        if (jr > 0) {
            minigemm<32>(Lv + (size_t)row0 * 32, v2t + (size_t)col0 * 32, fr, fq, acc);
#pragma unroll
            for (int m = 0; m < RM; ++m) {
                const size_t off = (size_t)(row0 + m * 16 + fr) * 1024 + c0;
                const uint4 vq0 = *(const uint4*)(vb + off), vq1 = *(const uint4*)(vb + off + 8), fq0 = *(const uint4*)(vf + off), fq1 = *(const uint4*)(vf + off + 8);
                const unsigned vw[8] = {vq0.x, vq0.y, vq0.z, vq0.w, vq1.x, vq1.y, vq1.z, vq1.w}, fw[8] = {fq0.x, fq0.y, fq0.z, fq0.w, fq1.x, fq1.y, fq1.z, fq1.w};
                unsigned o[8];
#pragma unroll
                for (int n = 0; n < 4; ++n) {
                    const float4 v0v = *(const float4*)(v0 + c0 + n * 4); const float v0a[4] = {v0v.x, v0v.y, v0v.z, v0v.w};
                    const float v4[4] = {bflo(vw[n * 2]), bfhi(vw[n * 2]), bflo(vw[n * 2 + 1]), bfhi(vw[n * 2 + 1])}, f4[4] = {bflo(fw[n * 2]), bfhi(fw[n * 2]), bflo(fw[n * 2 + 1]), bfhi(fw[n * 2 + 1])};
                    float o4[4];
#pragma unroll
                    for (int j = 0; j < 4; ++j) o4[j] = v4[j] + (f4[j] - v4[j]) * sigmoidf_(v0a[j] + acc[m][n][j]);
                    o[n * 2] = cvt_pk(o4[0], o4[1]); o[n * 2 + 1] = cvt_pk(o4[2], o4[3]);
                }
                *(uint4*)(vpb + off) = make_uint4(o[0], o[1], o[2], o[3]); *(uint4*)(vpb + off + 8) = make_uint4(o[4], o[5], o[6], o[7]);
            }
        }
    }
}
__device__ __forceinline__ void phase_rw3(PRef p, int jr, char* lds) {
    const int t = tidx(), lane = t & 63, wid = t >> 6, rowq = lane >> 4, jq = lane & 15;
    char* S = p.ws + OFF_SLOT;
    const float* decay = (const float*)S; const bf16_t* nkk = (const bf16_t*)(S + 2 * SLOT); const bf16_t* bb = (const bf16_t*)(S + 3 * SLOT);
    const bf16_t* rb = (const bf16_t*)(S + 6 * SLOT); const bf16_t* kb = (const bf16_t*)(S + 10 * SLOT);
    const bf16_t* vb = (const bf16_t*)(S + (jr == 0 ? 11 : 9) * SLOT); bf16_t* yb = (bf16_t*)(S + 5 * SLOT);
    float* buf = (float*)lds;
    float* ybuf = (float*)(lds + 2 * 16 * 336 * 4);
    for (int item = blockIdx.x; item < 512; item += gridDim.x) {
        const int bh = item >> 2, rg = item & 3, b = bh >> 4, h = bh & 15;
        const size_t base = (size_t)b * 2048 * 1024 + h * 64;
        const bf16_t* vecp[2]; int vdst[2];
#pragma unroll
        for (int u = 0; u < 2; ++u) {
            const int id = t + 256 * u, vec = id >> 7, rem = id & 127, step = rem >> 3, c8 = rem & 7;
            const bf16_t* bp = (vec == 0) ? nkk : (vec == 1) ? bb : (vec == 2) ? kb : rb;
            vecp[u] = bp + base + (size_t)step * 1024 + c8 * 8; vdst[u] = step * 336 + 64 + vec * 64 + c8 * 8;
        }
        const float* dp = decay + base + (size_t)(t >> 4) * 1024 + (t & 15) * 4; const int ddst = (t >> 4) * 336 + (t & 15) * 4;
        const bf16_t* vp = vb + base + (size_t)(t >> 1) * 1024 + rg * 16 + (t & 1) * 8; const int vvdst = (t >> 1) * 336 + 320 + (t & 1) * 8;
        uint4 g0, g1, gv; float4 gd;
        auto fetch = [&](int ch) {
            const size_t o = (size_t)ch * 16 * 1024;
            g0 = gload16(vecp[0] + o); g1 = gload16(vecp[1] + o);
            { const uint4 d_ = gload16(dp + o); gd = make_float4(__uint_as_float(d_.x), __uint_as_float(d_.y), __uint_as_float(d_.z), __uint_as_float(d_.w)); }
            if (t < 32) gv = gload16(vp + o);
        };
        auto stash = [&](float* bf) {
            float f[8];
            unpack8(g0, f); *(float4*)(bf + vdst[0]) = make_float4(f[0], f[1], f[2], f[3]); *(float4*)(bf + vdst[0] + 4) = make_float4(f[4], f[5], f[6], f[7]);
            unpack8(g1, f); *(float4*)(bf + vdst[1]) = make_float4(f[0], f[1], f[2], f[3]); *(float4*)(bf + vdst[1] + 4) = make_float4(f[4], f[5], f[6], f[7]);
            *(float4*)(bf + ddst) = gd;
            if (t < 32) { unpack8(gv, f); *(float4*)(bf + vvdst) = make_float4(f[0], f[1], f[2], f[3]); *(float4*)(bf + vvdst + 4) = make_float4(f[4], f[5], f[6], f[7]); }
        };
        float s0 = 0.f, s1 = 0.f, s2 = 0.f, s3 = 0.f;
        __syncthreads();
        fetch(0); stash(buf); __syncthreads();
        for (int ch = 0; ch < 128; ++ch) {
            if (ch + 1 < 128) fetch(ch + 1);
            const float* bf = buf + (ch & 1) * (16 * 336); float* yb_ = ybuf + (ch & 1) * 256;
            float ykeep = 0.f;
            const float* q0 = bf + jq * 4; const float* v0p = bf + 320 + wid * 4 + rowq;
            float4 nw = *(const float4*)q0, na = *(const float4*)(q0 + 64), nb2 = *(const float4*)(q0 + 128), nk = *(const float4*)(q0 + 192), nr = *(const float4*)(q0 + 256);
            float nv = v0p[0];
#pragma unroll 4
            for (int s = 0; s < 16; ++s) {
                const float4 w = nw, a = na, bq = nb2, k = nk, r = nr; const float vv = nv;
                const float* q = q0 + (s + 1) * 336;
                nw = *(const float4*)q; na = *(const float4*)(q + 64); nb2 = *(const float4*)(q + 128); nk = *(const float4*)(q + 192); nr = *(const float4*)(q + 256);
                nv = v0p[(s + 1) * 336];
                __builtin_amdgcn_sched_barrier(0);
                float sa = s0 * a.x; sa = fmaf(s1, a.y, sa); sa = fmaf(s2, a.z, sa); sa = fmaf(s3, a.w, sa);
                sa = row16_sum(sa);
                s0 = fmaf(s0, w.x, fmaf(sa, bq.x, vv * k.x)); s1 = fmaf(s1, w.y, fmaf(sa, bq.y, vv * k.y));
                s2 = fmaf(s2, w.z, fmaf(sa, bq.z, vv * k.z)); s3 = fmaf(s3, w.w, fmaf(sa, bq.w, vv * k.w));
                float y = s0 * r.x; y = fmaf(s1, r.y, y); y = fmaf(s2, r.z, y); y = fmaf(s3, r.w, y);
                y = row16_sum(y);
                ykeep = (jq == s) ? y : ykeep;
            }
            yb_[jq * 16 + wid * 4 + rowq] = ykeep;
            if (ch + 1 < 128) stash(buf + ((ch + 1) & 1) * (16 * 336));
            __syncthreads();
            if (t < 32) { const int step = t >> 1, hf = t & 1; float f[8];
#pragma unroll
                for (int i = 0; i < 8; ++i) f[i] = yb_[step * 16 + hf * 8 + i];
                *(uint4*)(yb + base + (size_t)(ch * 16 + step) * 1024 + rg * 16 + hf * 8) = pack8(f); }
        }
    }
}
__device__ __forceinline__ uint2 lds_tr16(const char* p) {
    typedef short v4s_t __attribute__((ext_vector_type(4)));
    const v4s_t r = __builtin_amdgcn_ds_read_tr16_b64_v4i16((LAS v4s_t*)p);
    uint2 u; __builtin_memcpy(&u, &r, 8); return u;
}
__device__ __forceinline__ int sw64(int row, int col) { return row * 128 + ((((col >> 3) ^ (row & 7))) << 4) + (col & 7) * 2; }
__device__ __forceinline__ void phase_rw3c(PRef p, int jr, char* lds) {
    const int t = tidx(), lane = t & 63, w = t >> 6, fr = lane & 15, fq = lane >> 4;
    char* S = p.ws + OFF_SLOT;
    const float* decay = (const float*)S; const bf16_t* nkk = (const bf16_t*)(S + 2 * SLOT); const bf16_t* bb = (const bf16_t*)(S + 3 * SLOT);
    const bf16_t* rb = (const bf16_t*)(S + 6 * SLOT); const bf16_t* kb = (const bf16_t*)(S + 10 * SLOT);
    const bf16_t* vb = (const bf16_t*)(S + (jr == 0 ? 11 : 9) * SLOT); bf16_t* yb = (bf16_t*)(S + 5 * SLOT);
    char* const AT = lds;              char* const RT = lds + 4096;  char* const BT = lds + 8192;  char* const KT = lds + 12288;
    float* const PL = (float*)(lds + 16384);
    float* const GAB = (float*)(lds + 43264);
    char* const GAK = lds + 28672;     char* const GRB = lds + 30720; char* const GRK = lds + 32768;
    char* const VT = lds + 34816;      char* const UT = lds + 35840;
    char* const SB = lds + 36864;
    float* const XL = (float*)(lds + 38912);
    float* const PC = (float*)(lds + 40960);
    float* const GS = (float*)(lds + 41216);
    bf16_t* const YB = (bf16_t*)(lds + 42240);
    const int pj = t & 63, ptg = t >> 6;
    const int tk = t >> 3, ck = t & 7;
    const int vtau = t >> 3, vi2 = (t & 7) * 2;
    const int qq = fr >> 2, pp = fr & 3;
    for (int item = blockIdx.x; item < 512; item += gridDim.x) {
        const int bh = ((item >> 3) >> 2) * 8 + (item & 7), rg = (item >> 3) & 3, b = bh >> 4, h = bh & 15;
        const size_t base = (size_t)b * 2048 * 1024 + h * 64;
        __syncthreads();
        for (int i = t; i < 128; i += 256) *(uint4*)(SB + i * 16) = make_uint4(0u, 0u, 0u, 0u);
        f32x4 Sacc = (f32x4){0.f, 0.f, 0.f, 0.f};
        bf16_t gwr[8]; uint4 ra, rb4, rk, rr, rw0, rw1; unsigned gvv = 0;
        auto fetch = [&](int c) {
#pragma unroll
            for (int s2 = 0; s2 < 8; ++s2) gwr[s2] = *(const __attribute__((address_space(1))) bf16_t*)((const bf16_t*)decay + base + (size_t)(c * 32 + ptg * 8 + s2) * 1024 + pj);
            const size_t o = base + (size_t)(c * 32 + tk) * 1024 + ck * 8;
            ra = gload16(nkk + o); rb4 = gload16(bb + o); rk = gload16(kb + o); rr = gload16(rb + o); rw0 = gload16((const bf16_t*)decay + o);
            gvv = *(const __attribute__((address_space(1))) unsigned*)(vb + base + (size_t)(c * 32 + vtau) * 1024 + rg * 16 + vi2);
        };
        fetch(0);
        for (int c = 0; c < 64; ++c) {
            {
                float cum[8]; float run = 1.f;
#pragma unroll
                for (int s2 = 0; s2 < 8; ++s2) { run *= 1.0f - bf2f(gwr[s2]); cum[s2] = run; }
                GS[ptg * 64 + pj] = run;
                __syncthreads();
                const float g0 = GS[pj], g1 = GS[64 + pj], g2 = GS[128 + pj], g3 = GS[192 + pj];
                const float off = (ptg > 0 ? g0 : 1.f) * (ptg > 1 ? g1 : 1.f) * (ptg > 2 ? g2 : 1.f);
                if (ptg == 0) PC[pj] = (g0 * g1) * (g2 * g3);
#pragma unroll
                for (int s2 = 0; s2 < 8; ++s2) PL[(ptg * 8 + s2) * 64 + pj] = off * cum[s2];
            }
            __syncthreads();
            {
                const float4 p0 = *(const float4*)(PL + tk * 64 + ck * 8), p1 = *(const float4*)(PL + tk * 64 + ck * 8 + 4);
                const unsigned ua[4] = {ra.x, ra.y, ra.z, ra.w}, ub[4] = {rb4.x, rb4.y, rb4.z, rb4.w}, uk[4] = {rk.x, rk.y, rk.z, rk.w}, ur[4] = {rr.x, rr.y, rr.z, rr.w};
                const f32x2_t Pp[4] = {{p0.x, p0.y}, {p0.z, p0.w}, {p1.x, p1.y}, {p1.z, p1.w}};
                const f32x2_t Wp[4] = {{1.0f - bflo(rw0.x), 1.0f - bfhi(rw0.x)}, {1.0f - bflo(rw0.y), 1.0f - bfhi(rw0.y)}, {1.0f - bflo(rw0.z), 1.0f - bfhi(rw0.z)}, {1.0f - bflo(rw0.w), 1.0f - bfhi(rw0.w)}};
                unsigned oa[4], orr[4], ob[4], ok[4];
#pragma unroll
                for (int i = 0; i < 4; ++i) {
                    const f32x2_t ei = {__builtin_amdgcn_rcpf(Pp[i].x), __builtin_amdgcn_rcpf(Pp[i].y)};
                    const f32x2_t rw = {__builtin_amdgcn_rcpf(Wp[i].x), __builtin_amdgcn_rcpf(Wp[i].y)};
                    const f32x2_t ex = Pp[i] * rw;
                    const f32x2_t va = {__uint_as_float(ua[i] << 16), __uint_as_float(ua[i] & 0xffff0000u)}, vr = {__uint_as_float(ur[i] << 16), __uint_as_float(ur[i] & 0xffff0000u)};
                    const f32x2_t vb2 = {__uint_as_float(ub[i] << 16), __uint_as_float(ub[i] & 0xffff0000u)}, vk = {__uint_as_float(uk[i] << 16), __uint_as_float(uk[i] & 0xffff0000u)};
                    const f32x2_t xa = va * ex, xr = vr * Pp[i], xb = vb2 * ei, xk = vk * ei;
                    oa[i] = cvt_pk(xa.x, xa.y); orr[i] = cvt_pk(xr.x, xr.y); ob[i] = cvt_pk(xb.x, xb.y); ok[i] = cvt_pk(xk.x, xk.y);
                }
                const int o = tk * 128 + ((ck ^ (tk & 7)) << 4);
                *(uint4*)(AT + o) = make_uint4(oa[0], oa[1], oa[2], oa[3]); *(uint4*)(RT + o) = make_uint4(orr[0], orr[1], orr[2], orr[3]);
                *(uint4*)(BT + o) = make_uint4(ob[0], ob[1], ob[2], ob[3]); *(uint4*)(KT + o) = make_uint4(ok[0], ok[1], ok[2], ok[3]);
                *(bf16_t*)(VT + vi2 * 64 + vtau * 2) = (bf16_t)(gvv & 0xffffu);
                *(bf16_t*)(VT + (vi2 + 1) * 64 + vtau * 2) = (bf16_t)(gvv >> 16);
            }
            if (c + 1 < 64) fetch(c + 1);
            __syncthreads();
            {
                const char* Mt = (w < 2) ? AT : RT; const char* Nt = (w & 1) ? BT : KT;
                f32x4 g[2][2];
#pragma unroll
                for (int m = 0; m < 2; ++m) { g[m][0] = (f32x4){0.f, 0.f, 0.f, 0.f}; g[m][1] = (f32x4){0.f, 0.f, 0.f, 0.f}; }
#pragma unroll
                for (int ks = 0; ks < 2; ++ks) {
                    const int chs = ((ks * 4 + fq) ^ (fr & 7)) << 4;
                    uint4 mf[2], nf[2];
#pragma unroll
                    for (int m = 0; m < 2; ++m) { mf[m] = *(const uint4*)(Mt + (m * 16 + fr) * 128 + chs); nf[m] = *(const uint4*)(Nt + (m * 16 + fr) * 128 + chs); }
#pragma unroll
                    for (int m = 0; m < 2; ++m)
#pragma unroll
                        for (int n = 0; n < 2; ++n) g[m][n] = mfma16(nf[n], mf[m], g[m][n]);
                }
#pragma unroll
                for (int m = 0; m < 2; ++m)
#pragma unroll
                    for (int n = 0; n < 2; ++n) {
                        const int tt = m * 16 + fr, tau0 = n * 16 + fq * 4;
                        f32x4 v4;
#pragma unroll
                        for (int j = 0; j < 4; ++j) { const int tau = tau0 + j; const bool keep = (w < 2) ? (tau < tt) : (tau <= tt); v4[j] = keep ? g[m][n][j] : 0.f; }
                        if (w == 1) *(f32x4*)(GAB + tt * 36 + tau0) = v4;
                        else {
                            char* G = (w == 0) ? GAK : (w == 2) ? GRK : GRB;
                            uint2 o; o.x = cvt_pk(v4[0], v4[1]); o.y = cvt_pk(v4[2], v4[3]);
                            *(uint2*)(G + tt * 64 + tau0 * 2) = o;
                        }
                    }
            }
            __syncthreads();
            if (w < 2) {
                f32x4 x = (f32x4){0.f, 0.f, 0.f, 0.f};
#pragma unroll
                for (int ks = 0; ks < 2; ++ks) {
                    const int chs = ((ks * 4 + fq) ^ (fr & 7)) << 4;
                    x = mfma16(*(const uint4*)(AT + (w * 16 + fr) * 128 + chs), *(const uint4*)(SB + fr * 128 + chs), x);
                }
                x = mfma16(*(const uint4*)(GAK + (w * 16 + fr) * 64 + fq * 16), *(const uint4*)(VT + fr * 64 + fq * 16), x);
                *(f32x4*)(XL + fr * 32 + w * 16 + fq * 4) = x;
            }
            __syncthreads();
            {
                const int tl = lane & 31;
                float Gr[32];
#pragma unroll
                for (int q4 = 0; q4 < 8; ++q4) { const float4 g4 = *(const float4*)(GAB + tl * 36 + q4 * 4); Gr[q4 * 4] = g4.x; Gr[q4 * 4 + 1] = g4.y; Gr[q4 * 4 + 2] = g4.z; Gr[q4 * 4 + 3] = g4.w; }
                float acc[4];
#pragma unroll
                for (int r = 0; r < 4; ++r) acc[r] = XL[(4 * w + r) * 32 + tl];
#pragma unroll
                for (int tau = 0; tau < 31; ++tau)
#pragma unroll
                    for (int r = 0; r < 4; ++r) acc[r] = fmaf(__int_as_float(__builtin_amdgcn_readlane(__float_as_int(acc[r]), tau)), Gr[tau], acc[r]);
                if (lane < 32) {
#pragma unroll
                    for (int r = 0; r < 4; ++r) *(bf16_t*)(UT + (4 * w + r) * 64 + tl * 2) = f2bf(acc[r]);
                }
            }
            __syncthreads();
            if (w < 2) {
                f32x4 y = (f32x4){0.f, 0.f, 0.f, 0.f};
#pragma unroll
                for (int ks = 0; ks < 2; ++ks) {
                    const int chs = ((ks * 4 + fq) ^ (fr & 7)) << 4;
                    y = mfma16(*(const uint4*)(RT + (w * 16 + fr) * 128 + chs), *(const uint4*)(SB + fr * 128 + chs), y);
                }
                y = mfma16(*(const uint4*)(GRB + (w * 16 + fr) * 64 + fq * 16), *(const uint4*)(UT + fr * 64 + fq * 16), y);
                y = mfma16(*(const uint4*)(GRK + (w * 16 + fr) * 64 + fq * 16), *(const uint4*)(VT + fr * 64 + fq * 16), y);
#pragma unroll
                for (int j = 0; j < 4; ++j) YB[(w * 16 + fq * 4 + j) * 16 + fr] = f2bf(y[j]);
            }
            {
                const int r0 = fq * 8 + qq, kc = 2 * w + (pp >> 1);
                const int o0 = r0 * 128 + ((kc ^ (r0 & 7)) << 4) + (pp & 1) * 8, o1 = (r0 + 4) * 128 + ((kc ^ ((r0 + 4) & 7)) << 4) + (pp & 1) * 8;
                const uint2 blo = lds_tr16(BT + o0), bhi = lds_tr16(BT + o1), klo = lds_tr16(KT + o0), khi = lds_tr16(KT + o1);
                Sacc = mfma16(make_uint4(blo.x, blo.y, bhi.x, bhi.y), *(const uint4*)(UT + fr * 64 + fq * 16), Sacc);
                Sacc = mfma16(make_uint4(klo.x, klo.y, khi.x, khi.y), *(const uint4*)(VT + fr * 64 + fq * 16), Sacc);
                const float4 pc = *(const float4*)(PC + 16 * w + fq * 4);
                Sacc[0] *= pc.x; Sacc[1] *= pc.y; Sacc[2] *= pc.z; Sacc[3] *= pc.w;
            }
            __syncthreads();
            {
                uint2 o; o.x = cvt_pk(Sacc[0], Sacc[1]); o.y = cvt_pk(Sacc[2], Sacc[3]);
                *(uint2*)(SB + fr * 128 + ((((2 * w + (fq >> 1))) ^ (fr & 7)) << 4) + (fq & 1) * 8) = o;
                if (t < 64) {
                    const int tt = t >> 1, hf = t & 1;
                    const uint4 yv_ = *(const uint4*)((const char*)YB + tt * 32 + hf * 16); const u32x4_t yx_ = {yv_.x, yv_.y, yv_.z, yv_.w};
                    *(__attribute__((address_space(1))) u32x4_t*)(yb + base + (size_t)(c * 32 + tt) * 1024 + rg * 16 + hf * 8) = yx_;
                }
            }
        }
    }
}
struct LdRw4 {
    struct Raw { uint4 y, v, g; float bn; };
    const bf16_t *y, *v, *g; const float *bonus, *gng, *gnb;
    __device__ __forceinline__ Raw fetch(int, int r, int kc) const {
        Raw q; const size_t o = (size_t)r * 1024 + kc * 8;
        q.y = *(const uint4*)(y + o); q.v = *(const uint4*)(v + o); q.g = *(const uint4*)(g + o); q.bn = bonus[r * 16 + (kc >> 3)]; return q;
    }
    __device__ __forceinline__ uint4 finish(const Raw& q, int, int, int kc) const {
        float yf[8], vf[8], gf[8]; unpack8(q.y, yf); unpack8(q.v, vf); unpack8(q.g, gf);
        float s = 0.f, s2 = 0.f;
#pragma unroll
        for (int i = 0; i < 8; ++i) { s += yf[i]; s2 += yf[i] * yf[i]; }
        s = oct_sum(s); s2 = oct_sum(s2);
        const float mean = s * (1.0f / 64.0f), var = fmaxf(s2 * (1.0f / 64.0f) - mean * mean, 0.f), rstd = rsqrtf(var + 64e-5f);
        const float4 ga = *(const float4*)(gng + kc * 8), gb = *(const float4*)(gng + kc * 8 + 4), ba = *(const float4*)(gnb + kc * 8), bb = *(const float4*)(gnb + kc * 8 + 4);
        const float gg[8] = {ga.x, ga.y, ga.z, ga.w, gb.x, gb.y, gb.z, gb.w}, bq[8] = {ba.x, ba.y, ba.z, ba.w, bb.x, bb.y, bb.z, bb.w};
        float o[8];
#pragma unroll
        for (int i = 0; i < 8; ++i) o[i] = ((yf[i] - mean) * rstd * gg[i] + bq[i] + q.bn * vf[i]) * gf[i];
        return pack8(o);
    }
};
__device__ __forceinline__ void phase_rw4(PRef p, int jr, char* lds) {
    char* S = p.ws + OFF_SLOT;
    const bf16_t* yb = (const bf16_t*)(S + 5 * SLOT); const bf16_t* gb = (const bf16_t*)(S + 4 * SLOT);
    const bf16_t* vb = (const bf16_t*)(S + (jr == 0 ? 11 : 9) * SLOT); bf16_t* ymix = (bf16_t*)(S + 6 * SLOT);
    const bf16_t* wt = (const bf16_t*)(p.ws + W_OUT) + (size_t)jr * 1024 * 1024;
    const float* bonus = (const float*)(p.ws + OFF_BONUS);
    const int t_ = tidx(); const int lane = t_ & 63, wid = t_ >> 6, wr = wid >> 1, wc = wid & 1, fr = lane & 15, fq = lane >> 4;
    for (int id = blockIdx.x; id < 128 * 8; id += gridDim.x) {
        int mt, nt; tile_map(id, 8, mt, nt);
        const size_t ro = (size_t)mt * 128 * 1024;
        LdRw4 al{yb + ro, vb + ro, gb + ro, bonus + (size_t)mt * 128 * 16, p.in[22] + jr * 1024, p.in[23] + jr * 1024};
        const bf16_t* br[4];
        { const int t2_ = tidx(), r0_ = t2_ >> 3, co_ = glds_chunk(t2_) * 8;
#pragma unroll
          for (int i = 0; i < 4; ++i) br[i] = wt + (size_t)(nt * 128 + r0_ + 32 * i) * 1024 + co_; }
        f32x4 acc[4][4];
        gemm_rg(lds, 16, al, br, acc);
#pragma unroll
        for (int n = 0; n < 4; ++n)
#pragma unroll
            for (int m = 0; m < 4; ++m) {
                uint2 o; o.x = cvt_pk(acc[m][n][0], acc[m][n][1]); o.y = cvt_pk(acc[m][n][2], acc[m][n][3]);
                *(uint2*)(ymix + (size_t)(mt * 128 + wr * 64 + m * 16 + fr) * 1024 + nt * 128 + wc * 64 + n * 16 + fq * 4) = o;
            }
    }
}

__device__ __forceinline__ void phase_cml(PRef p) {
    const int t = tidx();
    char* S = p.ws + OFF_SLOT;
    const bf16_t* src = (const bf16_t*)(S + 1 * SLOT); bf16_t* dst = (bf16_t*)(S + 8 * SLOT);
    const int col = (t & 127) * 8, half = t >> 7;
    float cw[4][8], cb[8];
#pragma unroll
    for (int j = 0; j < 4; ++j) {
        const float4 a = *(const float4*)(p.in[27] + j * 1024 + col), b = *(const float4*)(p.in[27] + j * 1024 + col + 4);
        cw[j][0] = a.x; cw[j][1] = a.y; cw[j][2] = a.z; cw[j][3] = a.w; cw[j][4] = b.x; cw[j][5] = b.y; cw[j][6] = b.z; cw[j][7] = b.w;
    }
    { const float4 a = *(const float4*)(p.in[28] + col), b = *(const float4*)(p.in[28] + col + 4);
      cb[0] = a.x; cb[1] = a.y; cb[2] = a.z; cb[3] = a.w; cb[4] = b.x; cb[5] = b.y; cb[6] = b.z; cb[7] = b.w; }
    const float qs = (col < 512) ? 0.125f : 1.0f;
    for (int item = blockIdx.x; item < 1024; item += gridDim.x) {
        const int b = item >> 7, s0 = (item & 127) * 16 + half * 8;
        const bf16_t* base = src + (size_t)b * 2048 * 1024 + col;
        uint4 r[11];
#pragma unroll
        for (int i = 0; i < 11; ++i) { const int sr = s0 - 3 + i; r[i] = gload16(base + (size_t)max(sr, 0) * 1024); if (sr < 0) r[i] = make_uint4(0u, 0u, 0u, 0u); }
        float x0[8], x1[8], x2[8];
        unpack8(r[0], x0); unpack8(r[1], x1); unpack8(r[2], x2);
#pragma unroll
        for (int i = 0; i < 8; ++i) {
            float x3[8], a[8]; unpack8(r[i + 3], x3);
#pragma unroll
            for (int e = 0; e < 8; ++e) { a[e] = cb[e] + cw[0][e] * x0[e] + cw[1][e] * x1[e] + cw[2][e] * x2[e] + cw[3][e] * x3[e]; a[e] = siluf_(a[e]) * qs; }
            *(uint4*)(dst + ((size_t)b * 2048 + s0 + i) * 1024 + col) = pack8(a);
#pragma unroll
            for (int e = 0; e < 8; ++e) { x0[e] = x1[e]; x1[e] = x2[e]; x2[e] = x3[e]; }
        }
    }
}
__device__ __forceinline__ void phase_ml2(PRef p, char* lds) {
    const int t = tidx(), lane = t & 63, w = t >> 6, fr = lane & 15, fq = lane >> 4;
    char* S = p.ws + OFF_SLOT;
    const bf16_t* qk = (const bf16_t*)(S + 8 * SLOT); const bf16_t* vb = (const bf16_t*)(S + 2 * SLOT); bf16_t* yb = (bf16_t*)(S + 4 * SLOT);
    const float* gates = (const float*)(p.ws + OFF_GATES); float* stat = (float*)(p.ws + OFF_STAT);
    char* const RAW = lds;
    char* const QT = lds + 17408; char* const KT = lds + 25600;
    char* const VT = lds + 33792;
    char* const VX = lds + 35840;
    char* const PB = lds + 39936;
    char* const CT = lds + 48128;
    float* const FS = (float*)(lds + 52224); float* const GJ = FS + 64; float* const WJ = FS + 128;
    float* const CW = (float*)(lds + 53248);
    const int qq = fr >> 2, pp = fr & 3;
    for (int item = blockIdx.x; item < 512; item += gridDim.x) {
        const int bh = ((item >> 3) >> 3) * 8 + (item & 7), vs = (item >> 3) & 7, b = bh >> 3, hd = bh & 7;
        const size_t tok0 = (size_t)b * 2048;
        __syncthreads();
        for (int i = t; i < 256; i += 256) *(uint4*)(CT + i * 16) = make_uint4(0u, 0u, 0u, 0u);
        f32x4 Cacc[2] = {(f32x4){0.f, 0.f, 0.f, 0.f}, (f32x4){0.f, 0.f, 0.f, 0.f}};
        uint4 gr0, gr1, gr2, gr3; uint4 gv = make_uint4(0u, 0u, 0u, 0u); float gg = 0.f;
        const int frr = t >> 4, fc = t & 15;
        const bf16_t* const qkt = qk + (tok0 + frr) * 1024 + (fc >> 3) * 512 + hd * 64 + (fc & 7) * 8;
        char* const qkd = ((fc < 8) ? QT : KT) + frr * 128 + (((fc & 7) ^ (frr & 7)) << 4);
        auto fetch = [&](int ch) {
            const int s0 = ch * 64;
            const bf16_t* q0 = qkt + (size_t)s0 * 1024;
            gr0 = gload16(q0); gr1 = gload16(q0 + 16 * 1024); gr2 = gload16(q0 + 32 * 1024); gr3 = gload16(q0 + 48 * 1024);
            if (t < 128) { gv = gload16(vb + (tok0 + s0 + (t >> 1)) * 1024 + hd * 128 + vs * 16 + (t & 1) * 8);
                           gg = *(const __attribute__((address_space(1))) float*)(gates + (tok0 + s0 + (t & 63)) * 16 + (t >> 6) * 8 + hd); }
        };
        fetch(0);
        for (int ch = 0; ch < 32; ++ch) {
            const int s0 = ch * 64;
            *(uint4*)qkd = gr0; *(uint4*)(qkd + 16 * 128) = gr1; *(uint4*)(qkd + 32 * 128) = gr2; *(uint4*)(qkd + 48 * 128) = gr3;
            if (t < 128) *(uint4*)(VT + t * 16) = gv;
            float vf8[8]; unpack8(gv, vf8);
            if (t >= 64 && t < 128) GJ[t - 64] = gg;
            const float ggc = gg;
            if (ch + 1 < 32) fetch(ch + 1);
            __syncthreads();
            if (t < 64) {
                float f = GJ[t];
                f += __builtin_amdgcn_update_dpp(0.f, f, 0x111, 0xf, 0xf, false);
                f += __builtin_amdgcn_update_dpp(0.f, f, 0x112, 0xf, 0xf, false);
                f += __builtin_amdgcn_update_dpp(0.f, f, 0x114, 0xf, 0xf, false);
                f += __builtin_amdgcn_update_dpp(0.f, f, 0x118, 0xf, 0xf, false);
                f += __builtin_amdgcn_update_dpp(0.f, f, 0x142, 0xa, 0xf, false);
                f += __builtin_amdgcn_update_dpp(0.f, f, 0x143, 0xc, 0xf, false);
                const float fend = __int_as_float(__builtin_amdgcn_readlane(__float_as_int(f), 63));
                FS[t] = f; WJ[t] = __expf(fend - f + ggc);
                GJ[t] = ggc - f;
            }
            __syncthreads();
            const float efend = __expf(FS[63]);
            {
                if (t < 128) {
                    const int j = t >> 1; const float wj = WJ[j];
                    float f[8];
#pragma unroll
                    for (int i = 0; i < 8; ++i) f[i] = vf8[i] * wj;
                    *(uint4*)(VX + j * 64 + (t & 1) * 16) = pack8(f);
                    float g8[8] = {0.f, 0.f, 0.f, 0.f, 0.f, 0.f, 0.f, 0.f}; if ((t & 1) == 0) g8[0] = wj;
                    *(uint4*)(VX + j * 64 + 32 + (t & 1) * 16) = pack8(g8);
                }
            }
            __syncthreads();
            const int srow = 16 * w + fr;
            f32x4 Sacc[4], Xacc[2];
#pragma unroll
            for (int n = 0; n < 4; ++n) Sacc[n] = (f32x4){0.f, 0.f, 0.f, 0.f};
            Xacc[0] = (f32x4){0.f, 0.f, 0.f, 0.f}; Xacc[1] = (f32x4){0.f, 0.f, 0.f, 0.f};
            Cacc[0] *= efend; Cacc[1] *= efend;
#pragma unroll
            for (int ks = 0; ks < 2; ++ks) {
                const int chs = ((ks * 4 + fq) ^ (fr & 7)) << 4;
                const uint4 qf = *(const uint4*)(QT + srow * 128 + chs);
#pragma unroll
                for (int n = 0; n < 4; ++n) { const uint4 kf = *(const uint4*)(KT + (n * 16 + fr) * 128 + chs); Sacc[n] = mfma16(kf, qf, Sacc[n]); }
#pragma unroll
                for (int nn = 0; nn < 2; ++nn) { const uint4 rf = *(const uint4*)(CT + (nn * 16 + fr) * 128 + chs); Xacc[nn] = mfma16(rf, qf, Xacc[nn]); }
                const int r0 = ks * 32 + fq * 8 + qq, kc = 2 * w + (pp >> 1);
                const uint2 klo = lds_tr16(KT + r0 * 128 + ((kc ^ (r0 & 7)) << 4) + (pp & 1) * 8);
                const uint2 khi = lds_tr16(KT + (r0 + 4) * 128 + ((kc ^ ((r0 + 4) & 7)) << 4) + (pp & 1) * 8);
                const uint4 kt = make_uint4(klo.x, klo.y, khi.x, khi.y);
#pragma unroll
                for (int m = 0; m < 2; ++m) {
                    const uint2 vlo = lds_tr16(VX + r0 * 64 + (16 * m + 4 * pp) * 2), vhi = lds_tr16(VX + (r0 + 4) * 64 + (16 * m + 4 * pp) * 2);
                    Cacc[m] = mfma16(kt, make_uint4(vlo.x, vlo.y, vhi.x, vhi.y), Cacc[m]);
                }
            }
            const float fs = FS[srow];
            float dsum = 0.f;
#pragma unroll
            for (int n = 0; n < 4; ++n) {
                const float4 g4 = *(const float4*)(GJ + n * 16 + fq * 4); const float ga[4] = {g4.x, g4.y, g4.z, g4.w};
                float pv[4];
#pragma unroll
                for (int j = 0; j < 4; ++j) { const int jc = n * 16 + fq * 4 + j; pv[j] = (srow >= jc) ? Sacc[n][j] * __expf(fs + ga[j]) : 0.f; dsum += pv[j]; }
                uint2 o; o.x = cvt_pk(pv[0], pv[1]); o.y = cvt_pk(pv[2], pv[3]);
                *(uint2*)(PB + srow * 128 + (((n * 2 + (fq >> 1)) ^ (fr & 7)) << 4) + (fq & 1) * 8) = o;
            }
            dsum = xor16_add(dsum); dsum = xor32_add(dsum);
            f32x4 Iacc = (f32x4){0.f, 0.f, 0.f, 0.f};
#pragma unroll
            for (int ks = 0; ks < 2; ++ks) {
                const uint4 pf = *(const uint4*)(PB + srow * 128 + (((ks * 4 + fq) ^ (fr & 7)) << 4));
                const int r0 = ks * 32 + fq * 8 + qq;
                const uint2 vlo = lds_tr16(VT + r0 * 32 + (4 * pp) * 2), vhi = lds_tr16(VT + (r0 + 4) * 32 + (4 * pp) * 2);
                Iacc = mfma16(make_uint4(vlo.x, vlo.y, vhi.x, vhi.y), pf, Iacc);
            }
            const float efs = __expf(fs);
            const float ndq = __shfl(Xacc[1][0], fr);
            const float den = dsum + efs * ndq;
            const float rden = __builtin_amdgcn_rcpf(fmaxf(fabsf(den), 1.0f));
            const size_t tok = tok0 + s0 + srow;
            float o4[4];
#pragma unroll
            for (int j = 0; j < 4; ++j) o4[j] = (Iacc[j] + efs * Xacc[0][j]) * rden;
            gst_u2(yb + tok * 1024 + hd * 128 + vs * 16 + fq * 4, cvt_pk(o4[0], o4[1]), cvt_pk(o4[2], o4[3]));
            __syncthreads();
#pragma unroll
            for (int m = 0; m < 2; ++m) {
                const int v = m * 16 + fr;
                uint2 o; o.x = cvt_pk(Cacc[m][0], Cacc[m][1]); o.y = cvt_pk(Cacc[m][2], Cacc[m][3]);
                *(uint2*)(CT + v * 128 + (((2 * w + (fq >> 1)) ^ (v & 7)) << 4) + (fq & 1) * 8) = o;
            }
        }
    }
}
template <int HSHIFT  , int NH>
struct LdGnGate {
    struct Raw { uint4 y, g; };
    const bf16_t *y, *g; int ld; const float *gng, *gnb; const float* st;
    __device__ __forceinline__ Raw fetch(int, int r, int kc) const { Raw q; const size_t o = (size_t)r * ld + kc * 8; q.y = *(const uint4*)(y + o); q.g = *(const uint4*)(g + o); return q; }
    __device__ __forceinline__ uint4 finish(const Raw& q, int, int r, int kc) const {
        float yf[8], gf[8]; unpack8(q.y, yf); unpack8(q.g, gf);
        const float2 ms = *(const float2*)(st + (r * NH + ((kc * 8) >> HSHIFT)) * 2);
        const float4 ga = *(const float4*)(gng + kc * 8), gb = *(const float4*)(gng + kc * 8 + 4), ba = *(const float4*)(gnb + kc * 8), bb = *(const float4*)(gnb + kc * 8 + 4);
        const float gg[8] = {ga.x, ga.y, ga.z, ga.w, gb.x, gb.y, gb.z, gb.w}, bq[8] = {ba.x, ba.y, ba.z, ba.w, bb.x, bb.y, bb.z, bb.w};
        float o[8];
#pragma unroll
        for (int i = 0; i < 8; ++i) o[i] = ((yf[i] - ms.x) * ms.y * gg[i] + bq[i]) * gf[i];
        return pack8(o);
    }
};
template <int HSHIFT, int NH, int NPART>
__device__ __forceinline__ void phase_outproj_gn(PRef p, char* lds, const bf16_t* yb, const bf16_t* gate, int K, const bf16_t* wt, const float* gng, const float* gnb, bf16_t* ymix) {
    const int t = tidx(), lane = t & 63, wid = t >> 6, wr = wid >> 1, wc = wid & 1, fr = lane & 15, fq = lane >> 4;
    const float* stat = (const float*)(p.ws + OFF_STAT);
    float* st = (float*)(lds + 65536);
    const float invn = 1.0f / (float)(1 << HSHIFT);
    for (int id = blockIdx.x; id < 128 * 8; id += gridDim.x) {
        int mt, nt; tile_map(id, 8, mt, nt);
        for (int i = t; i < 128 * NH; i += 256) {
            const float* q = stat + ((size_t)mt * 128 * NH + i) * NPART * 2;
            float s = 0.f, s2 = 0.f;
#pragma unroll
            for (int j = 0; j < NPART; ++j) { const float2 v = *(const float2*)(q + j * 2); s += v.x; s2 += v.y; }
            const float mean = s * invn, var = fmaxf(s2 * invn - mean * mean, 0.f);
            st[i * 2] = mean; st[i * 2 + 1] = rsqrtf(var + 1e-6f);
        }
        __syncthreads();
        const size_t ro = (size_t)mt * 128 * K;
        LdGnGate<HSHIFT, NH> al{yb + ro, gate + ro, K, gng, gnb, st};
        const bf16_t* br[4];
        { const int r0_ = t >> 3, co_ = glds_chunk(t) * 8;
#pragma unroll
          for (int i = 0; i < 4; ++i) br[i] = wt + (size_t)(nt * 128 + r0_ + 32 * i) * K + co_; }
        f32x4 acc[4][4];
        gemm_rg(lds, K / 64, al, br, acc);
#pragma unroll
        for (int n = 0; n < 4; ++n)
#pragma unroll
            for (int m = 0; m < 4; ++m) {
                uint2 o; o.x = cvt_pk(acc[m][n][0], acc[m][n][1]); o.y = cvt_pk(acc[m][n][2], acc[m][n][3]);
                *(uint2*)(ymix + (size_t)(mt * 128 + wr * 64 + m * 16 + fr) * 1024 + nt * 128 + wc * 64 + n * 16 + fq * 4) = o;
            }
    }
}

__device__ __forceinline__ void phase_rt2(PRef p, char* lds) {
    const int t = tidx(), lane = t & 63, w = t >> 6, fr = lane & 15, fq = lane >> 4;
    char* S = p.ws + OFF_SLOT;
    const bf16_t* qb = (const bf16_t*)(S + 1 * SLOT); const bf16_t* kb = (const bf16_t*)(S + 2 * SLOT); const bf16_t* vb = (const bf16_t*)(S + 3 * SLOT);
    bf16_t* yb = (bf16_t*)(S + 7 * SLOT); float* stat = (float*)(p.ws + OFF_STAT);
    char* const VB = lds + 32768; char* const PB = lds + 49152; char* const RT = lds + 57344;
    const int gco = glds_chunk(t) * 8, gr0 = t >> 3;
    const int qq = fr >> 2, pp = fr & 3;
    for (int item = blockIdx.x; item < 512; item += gridDim.x) {
        const int bh = ((item >> 3) >> 4) * 8 + (item & 7), vs = (item >> 3) & 15, b = bh >> 2, hd = bh & 3;
        const size_t tok0 = (size_t)b * 2048;
        const float lg2 = log2f(1.0f - __builtin_amdgcn_exp2f(-5.0f - (float)hd));
        const float dec64 = __builtin_amdgcn_exp2f(64.0f * lg2);
        float dmask[4][4];
        { const int srow_ = 16 * w + fr;
#pragma unroll
          for (int n = 0; n < 4; ++n)
#pragma unroll
              for (int j = 0; j < 4; ++j) { const int jc = n * 16 + fq * 4 + j; dmask[n][j] = (srow_ >= jc) ? __builtin_amdgcn_exp2f(lg2 * (float)(srow_ - jc)) : 0.f; } }
        const bf16_t* qsrc = qb + (tok0 + gr0) * 1024 + hd * 256 + gco;
        const bf16_t* ksrc = kb + (tok0 + gr0) * 1024 + hd * 256 + gco;
        const bf16_t* vsrc = vb + (tok0 + (t >> 2)) * 2048 + hd * 512 + vs * 32 + (t & 3) * 8;
        f32x4 Racc[4][2];
#pragma unroll
        for (int a = 0; a < 4; ++a) { Racc[a][0] = (f32x4){0.f, 0.f, 0.f, 0.f}; Racc[a][1] = (f32x4){0.f, 0.f, 0.f, 0.f}; }
        __syncthreads();
        for (int i = t; i < 1024; i += 256) *(uint4*)(RT + i * 16) = make_uint4(0u, 0u, 0u, 0u);
        auto issue = [&](int pc) {
            const unsigned d = (unsigned)__builtin_amdgcn_readfirstlane((int)(lds_addr_u(lds) + (pc & 1) * 16384 + w * 1024));
            const size_t go = (size_t)(pc >> 2) * 64 * 1024 + (pc & 3) * 64;
#pragma unroll
            for (int i = 0; i < 2; ++i) { glds16_asm(qsrc + go + (size_t)i * 32 * 1024, d + i * 4096); glds16_asm(ksrc + go + (size_t)i * 32 * 1024, d + 8192 + i * 4096); }
        };
        auto put_v = [&](const uint4& raw, int ch) {
            char* vbuf = VB + (ch & 1) * 8192; const int j = t >> 2;
            *(uint4*)(vbuf + j * 64 + (t & 3) * 16) = raw;
            float f[8]; unpack8(raw, f); const float sc = __builtin_amdgcn_exp2f(lg2 * (float)(63 - j));
#pragma unroll
            for (int i = 0; i < 8; ++i) f[i] *= sc;
            *(uint4*)(vbuf + 4096 + j * 64 + (t & 3) * 16) = pack8(f);
        };
        issue(0);
        { const uint4 v0 = gld_u4(vsrc); put_v(v0, 0); }
        asm volatile("s_waitcnt vmcnt(0)" ::: "memory");
        __syncthreads();
        f32x4 Sacc[4], Xacc[2];
        uint4 vnext = make_uint4(0u, 0u, 0u, 0u);
        for (int ch = 0; ch < 32; ++ch) {
            const char* vbuf = VB + (ch & 1) * 8192;
#pragma unroll
            for (int qd = 0; qd < 4; ++qd) {
                const int pc = ch * 4 + qd;
                if (pc + 1 < 128) issue(pc + 1);
                if (qd == 0) {
                    if (ch + 1 < 32) vnext = gld_u4(vsrc + (size_t)(ch + 1) * 64 * 2048);
#pragma unroll
                    for (int n = 0; n < 4; ++n) Sacc[n] = (f32x4){0.f, 0.f, 0.f, 0.f};
                    Xacc[0] = (f32x4){0.f, 0.f, 0.f, 0.f}; Xacc[1] = (f32x4){0.f, 0.f, 0.f, 0.f};
                }
                const char* qk = lds + (pc & 1) * 16384;
                Racc[qd][0] *= dec64; Racc[qd][1] *= dec64;
#pragma unroll
                for (int ks = 0; ks < 2; ++ks) {
                    const int chs = ((ks * 4 + fq) ^ (fr & 7)) << 4;
                    const uint4 qf = *(const uint4*)(qk + (16 * w + fr) * 128 + chs);
#pragma unroll
                    for (int n = 0; n < 4; ++n) { const uint4 kf = *(const uint4*)(qk + 8192 + (n * 16 + fr) * 128 + chs); Sacc[n] = mfma16(kf, qf, Sacc[n]); }
#pragma unroll
                    for (int nn = 0; nn < 2; ++nn) {
                        const int v = nn * 16 + fr;
                        const uint4 rf = *(const uint4*)(RT + v * 512 + (((qd * 8 + ks * 4 + fq) ^ (v & 7)) << 4));
                        Xacc[nn] = mfma16(rf, qf, Xacc[nn]);
                    }
                    const int r0 = ks * 32 + fq * 8 + qq;
                    const int kc = 2 * w + (pp >> 1);
                    const uint2 klo = lds_tr16(qk + 8192 + r0 * 128 + ((kc ^ (r0 & 7)) << 4) + (pp & 1) * 8);
                    const uint2 khi = lds_tr16(qk + 8192 + (r0 + 4) * 128 + ((kc ^ ((r0 + 4) & 7)) << 4) + (pp & 1) * 8);
                    const uint4 kt = make_uint4(klo.x, klo.y, khi.x, khi.y);
#pragma unroll
                    for (int m = 0; m < 2; ++m) {
                        const uint2 vlo = lds_tr16(vbuf + 4096 + r0 * 64 + (16 * m + 4 * pp) * 2), vhi = lds_tr16(vbuf + 4096 + (r0 + 4) * 64 + (16 * m + 4 * pp) * 2);
                        Racc[qd][m] = mfma16(kt, make_uint4(vlo.x, vlo.y, vhi.x, vhi.y), Racc[qd][m]);
                    }
                }
                if (qd == 2 && ch + 1 < 32) put_v(vnext, ch + 1);
                asm volatile("s_waitcnt vmcnt(0)" ::: "memory");
                __syncthreads();
#pragma unroll
                for (int m = 0; m < 2; ++m) {
                    const int v = m * 16 + fr, cch = qd * 8 + 2 * w + (fq >> 1);
                    uint2 o; o.x = cvt_pk(Racc[qd][m][0], Racc[qd][m][1]); o.y = cvt_pk(Racc[qd][m][2], Racc[qd][m][3]);
                    *(uint2*)(RT + v * 512 + ((cch ^ (v & 7)) << 4) + (fq & 1) * 8) = o;
                }
            }
            const int srow = 16 * w + fr;
#pragma unroll
            for (int n = 0; n < 4; ++n) {
                float pv[4];
#pragma unroll
                for (int j = 0; j < 4; ++j) pv[j] = Sacc[n][j] * dmask[n][j];
                uint2 o; o.x = cvt_pk(pv[0], pv[1]); o.y = cvt_pk(pv[2], pv[3]);
                *(uint2*)(PB + srow * 128 + (((n * 2 + (fq >> 1)) ^ (fr & 7)) << 4) + (fq & 1) * 8) = o;
            }
            f32x4 Iacc[2] = {(f32x4){0.f, 0.f, 0.f, 0.f}, (f32x4){0.f, 0.f, 0.f, 0.f}};
#pragma unroll
            for (int ks = 0; ks < 2; ++ks) {
                const uint4 pf = *(const uint4*)(PB + srow * 128 + (((ks * 4 + fq) ^ (fr & 7)) << 4));
                const int r0 = ks * 32 + fq * 8 + qq;
#pragma unroll
                for (int nn = 0; nn < 2; ++nn) {
                    const uint2 vlo = lds_tr16(vbuf + r0 * 64 + (16 * nn + 4 * pp) * 2), vhi = lds_tr16(vbuf + (r0 + 4) * 64 + (16 * nn + 4 * pp) * 2);
                    Iacc[nn] = mfma16(make_uint4(vlo.x, vlo.y, vhi.x, vhi.y), pf, Iacc[nn]);
                }
            }
            const float qdec = __builtin_amdgcn_exp2f(lg2 * (float)(srow + 1));
            const size_t tok = tok0 + (size_t)ch * 64 + srow;
#pragma unroll
            for (int nn = 0; nn < 2; ++nn) {
                float o4[4];
#pragma unroll
                for (int j = 0; j < 4; ++j) o4[j] = Iacc[nn][j] + Xacc[nn][j] * qdec;
                gst_u2(yb + tok * 2048 + hd * 512 + vs * 32 + nn * 16 + fq * 4, cvt_pk(o4[0], o4[1]), cvt_pk(o4[2], o4[3]));
            }
        }
        __syncthreads();
    }
}

__device__ __forceinline__ void phase_zrw(PRef p, int jr) {
    const int t_ = tidx(); const int lane = t_ & 63, gw = blockIdx.x * 4 + (t_ >> 6), nw = gridDim.x * 4;
    char* S = p.ws + OFF_SLOT;
    const bf16_t* yb = (const bf16_t*)(S + 5 * SLOT); const bf16_t* gb = (const bf16_t*)(S + 4 * SLOT);
    const bf16_t* vb = (const bf16_t*)(S + (jr == 0 ? 11 : 9) * SLOT); bf16_t* zb = (bf16_t*)(S + 7 * SLOT);
    const float* bonus = (const float*)(p.ws + OFF_BONUS);
    float gg[16], bq[16]; row_load_f32(p.in[22] + jr * 1024, gg, lane); row_load_f32(p.in[23] + jr * 1024, bq, lane);
    const int rpw = NTOK / nw, first = gw * rpw, end = first + rpw;
    uint2 ny[4], nv[4], ng[4]; float nbn[4];
    auto load_in = [&](int r) {
#pragma unroll
        for (int c = 0; c < 4; ++c) { const size_t o = (size_t)r * 1024 + c * 256 + lane * 4; ny[c] = *(const uint2*)(yb + o); nv[c] = *(const uint2*)(vb + o); ng[c] = *(const uint2*)(gb + o);
                                      nbn[c] = bonus[(size_t)r * 16 + c * 4 + (lane >> 4)]; }
    };
    load_in(first);
    for (int r = first; r < end; ++r) {
        float y[16], v[16], g[16], bn[4];
#pragma unroll
        for (int c = 0; c < 4; ++c) {
            y[c * 4] = bflo(ny[c].x); y[c * 4 + 1] = bfhi(ny[c].x); y[c * 4 + 2] = bflo(ny[c].y); y[c * 4 + 3] = bfhi(ny[c].y);
            v[c * 4] = bflo(nv[c].x); v[c * 4 + 1] = bfhi(nv[c].x); v[c * 4 + 2] = bflo(nv[c].y); v[c * 4 + 3] = bfhi(nv[c].y);
            g[c * 4] = bflo(ng[c].x); g[c * 4 + 1] = bfhi(ng[c].x); g[c * 4 + 2] = bflo(ng[c].y); g[c * 4 + 3] = bfhi(ng[c].y);
            bn[c] = nbn[c];
        }
        if (r + 1 < end) load_in(r + 1);
        __builtin_amdgcn_sched_barrier(0);
        float z[16];
#pragma unroll
        for (int c = 0; c < 4; ++c) {
            float s = (y[c * 4] + y[c * 4 + 1]) + (y[c * 4 + 2] + y[c * 4 + 3]);
            float q = (y[c * 4] * y[c * 4] + y[c * 4 + 1] * y[c * 4 + 1]) + (y[c * 4 + 2] * y[c * 4 + 2] + y[c * 4 + 3] * y[c * 4 + 3]);
            s = row16_sum(s); q = row16_sum(q);
            const float mean = s * (1.0f / 64.0f), rstd = rsqrtf(fmaxf(q * (1.0f / 64.0f) - mean * mean, 0.f) + 64e-5f);
#pragma unroll
            for (int i = 0; i < 4; ++i) { const int e = c * 4 + i; z[e] = ((y[e] - mean) * rstd * gg[e] + bq[e] + bn[c] * v[e]) * g[e]; }
        }
        row_store_bf16(zb + (size_t)r * 1024, z, lane);
    }
}
__device__ __forceinline__ void phase_zml(PRef p) {
    const int t_ = tidx(); const int lane = t_ & 63, gw = blockIdx.x * 4 + (t_ >> 6), nw = gridDim.x * 4;
    char* S = p.ws + OFF_SLOT;
    const bf16_t* yb = (const bf16_t*)(S + 4 * SLOT); const bf16_t* ob = (const bf16_t*)(S + 3 * SLOT); bf16_t* zb = (bf16_t*)(S + 1 * SLOT);
    float gg[16], bq[16]; row_load_f32(p.in[29], gg, lane); row_load_f32(p.in[30], bq, lane);
    const int rpw = NTOK / nw, first = gw * rpw, end = first + rpw;
    uint2 ny[4], no[4];
    auto load_in = [&](int r) {
#pragma unroll
        for (int c = 0; c < 4; ++c) { const size_t o = (size_t)r * 1024 + c * 256 + lane * 4; ny[c] = *(const uint2*)(yb + o); no[c] = *(const uint2*)(ob + o); }
    };
    load_in(first);
    for (int r = first; r < end; ++r) {
        float y[16], o[16], z[16];
#pragma unroll
        for (int c = 0; c < 4; ++c) {
            y[c * 4] = bflo(ny[c].x); y[c * 4 + 1] = bfhi(ny[c].x); y[c * 4 + 2] = bflo(ny[c].y); y[c * 4 + 3] = bfhi(ny[c].y);
            o[c * 4] = bflo(no[c].x); o[c * 4 + 1] = bfhi(no[c].x); o[c * 4 + 2] = bflo(no[c].y); o[c * 4 + 3] = bfhi(no[c].y);
        }
        if (r + 1 < end) load_in(r + 1);
        __builtin_amdgcn_sched_barrier(0);
#pragma unroll
        for (int c = 0; c < 4; ++c) {
            float s = (y[c * 4] + y[c * 4 + 1]) + (y[c * 4 + 2] + y[c * 4 + 3]);
            float q = (y[c * 4] * y[c * 4] + y[c * 4 + 1] * y[c * 4 + 1]) + (y[c * 4 + 2] * y[c * 4 + 2] + y[c * 4 + 3] * y[c * 4 + 3]);
            s = row16_sum(s); q = row16_sum(q); s = xor16_add(s); q = xor16_add(q);
            const float mean = s * (1.0f / 128.0f), rstd = rsqrtf(fmaxf(q * (1.0f / 128.0f) - mean * mean, 0.f) + 1e-6f);
#pragma unroll
            for (int i = 0; i < 4; ++i) { const int e = c * 4 + i; z[e] = ((y[e] - mean) * rstd * gg[e] + bq[e]) * o[e]; }
        }
        row_store_bf16(zb + (size_t)r * 1024, z, lane);
    }
}
__device__ __forceinline__ void phase_zrt(PRef p) {
    const int t_ = tidx(); const int lane = t_ & 63, gw = blockIdx.x * 4 + (t_ >> 6), nw = gridDim.x * 4;
    char* S = p.ws + OFF_SLOT;
    const bf16_t* yb = (const bf16_t*)(S + 7 * SLOT); const bf16_t* sb = (const bf16_t*)(S + 5 * SLOT); bf16_t* zb = (bf16_t*)(S + 3 * SLOT);
    float gw8[4][8], bw8[4][8];
#pragma unroll
    for (int c = 0; c < 4; ++c) {
        const float4 ga = gld_f4(p.in[33] + lane * 32 + c * 8), gb2 = gld_f4(p.in[33] + lane * 32 + c * 8 + 4), ba = gld_f4(p.in[34] + lane * 32 + c * 8), bb2 = gld_f4(p.in[34] + lane * 32 + c * 8 + 4);
        gw8[c][0] = ga.x; gw8[c][1] = ga.y; gw8[c][2] = ga.z; gw8[c][3] = ga.w; gw8[c][4] = gb2.x; gw8[c][5] = gb2.y; gw8[c][6] = gb2.z; gw8[c][7] = gb2.w;
        bw8[c][0] = ba.x; bw8[c][1] = ba.y; bw8[c][2] = ba.z; bw8[c][3] = ba.w; bw8[c][4] = bb2.x; bw8[c][5] = bb2.y; bw8[c][6] = bb2.z; bw8[c][7] = bb2.w;
    }
    const int rpw = NTOK / nw, first = gw * rpw, end = first + rpw;
    uint4 nyr[4], nsr[4];
    auto load_in = [&](int r) {
        const size_t o = (size_t)r * 2048 + lane * 32;
#pragma unroll
        for (int c = 0; c < 4; ++c) { nyr[c] = *(const uint4*)(yb + o + c * 8); nsr[c] = *(const uint4*)(sb + o + c * 8); }
    };
    load_in(first);
    for (int r = first; r < end; ++r) {
        const size_t o = (size_t)r * 2048 + lane * 32;
        uint4 yr[4], sr[4];
#pragma unroll
        for (int c = 0; c < 4; ++c) { yr[c] = nyr[c]; sr[c] = nsr[c]; }
        if (r + 1 < end) load_in(r + 1);
        __builtin_amdgcn_sched_barrier(0);
        float s = 0.f, q = 0.f;
#pragma unroll
        for (int c = 0; c < 4; ++c) { float f[8]; unpack8(yr[c], f);
#pragma unroll
            for (int i = 0; i < 8; ++i) { s += f[i]; q += f[i] * f[i]; } }
        s = row16_sum(s); q = row16_sum(q);
        const float mean = s * (1.0f / 512.0f), rstd = rsqrtf(fmaxf(q * (1.0f / 512.0f) - mean * mean, 0.f) + 1e-6f);
#pragma unroll
        for (int c = 0; c < 4; ++c) {
            float f[8], g[8], z[8]; unpack8(yr[c], f); unpack8(sr[c], g);
#pragma unroll
            for (int i = 0; i < 8; ++i) z[i] = ((f[i] - mean) * rstd * gw8[c][i] + bw8[c][i]) * g[i];
            *(uint4*)(zb + o + c * 8) = pack8(z);
        }
    }
}

template <int WHICH  >
__device__ __forceinline__ void phase_moe(PRef p, int L, char* lds, const bf16_t* hm, bf16_t* H) {
    const int t = tidx(), lane = t & 63, wid = t >> 6, wr = wid >> 1, wc = wid & 1, fr = lane & 15, fq = lane >> 4;
    const int* cnt = (const int*)(p.ws + OFF_CNT) + L * 32;
    const int* list = (const int*)(p.ws + OFF_LIST);
    bf16_t* Y = (bf16_t*)(p.ws + OFF_SLOT + 9 * SLOT);
    int* pre = (int*)(lds + 65536);
    __syncthreads();
    if (t == 0) { int s = 0; for (int e = 0; e < 32; ++e) { pre[e] = s; s += (cnt[e] + 127) >> 7; } pre[32] = s; }
    __syncthreads();
    const int total_all = pre[32] * 8;
    const int full = (total_all / (int)gridDim.x) * (int)gridDim.x, rem = total_all - full;
    const bool split_tail = (rem > 0) && (2 * rem <= (int)gridDim.x);
    const int total = split_tail ? full : total_all;
    int nt = 0, mt = 0, ne = 0; const int* le = list; const bf16_t* ar[4]; const bf16_t* br[4];
    const int co_ = glds_chunk(t) * 8;
#define MOE_SETUP(id_) { nt = (id_) & 7; const int mg_ = (id_) >> 3; int e_ = 0; \
        _Pragma("unroll 1") for (int s_ = 16; s_ >= 1; s_ >>= 1) if (pre[e_ + s_] <= mg_) e_ += s_; \
        mt = mg_ - pre[e_]; ne = cnt[e_]; le = list + e_ * LIST_CAP + mt * 128; \
        _Pragma("unroll") for (int i = 0; i < 4; ++i) { \
            int r_ = (t >> 3) + 32 * i; r_ = (mt * 128 + r_ < ne) ? r_ : 0;            \
            const int aid_ = le[r_]; \
            ar[i] = ((WHICH == 0) ? hm + (size_t)(aid_ >> 1) * 1024 : H + (size_t)aid_ * 512) + co_; } \
        if (WHICH == 0) { \
            const bf16_t* wt_ = (const bf16_t*)(p.ws + W_MOE13) + ((size_t)(L * 32 + e_) * 1024 + nt * 128) * 1024; \
            _Pragma("unroll") for (int i = 0; i < 4; ++i) {        \
                const int ro_ = (t >> 3) + 32 * i, n_ = (ro_ >> 4) & 3, hc_ = ((ro_ >> 2) & 3) * 8 + (n_ >> 1) * 4 + (ro_ & 3); \
                br[i] = wt_ + (size_t)((ro_ & 64) + (hc_ >> 4) * 32 + (n_ & 1) * 16 + (hc_ & 15)) * 1024 + co_; } \
        } else { \
            const bf16_t* wt_ = (const bf16_t*)(p.ws + W_MOE2) + ((size_t)(L * 32 + e_) * 1024 + nt * 128) * 512; \
            _Pragma("unroll") for (int i = 0; i < 4; ++i) br[i] = wt_ + (size_t)perm64((t >> 3) + 32 * i) * 512 + co_; } }
    int id = (blockIdx.x & 7) * (gridDim.x >> 3) + (blockIdx.x >> 3);
    if (id < total) { MOE_SETUP(id); gemm_issue0(lds, ar, br); }
    while (id < total) {
        f32x4 acc[4][4];
        gemm_ggx<false>(lds, WHICH == 0 ? 16 : 8, ar, br, acc);
        const int cnt_ = nt, cmt = mt, cne = ne;
        int aidq[4];
#pragma unroll
        for (int m = 0; m < 4; ++m) { const int r = wr * 64 + m * 16 + fr; aidq[m] = (cmt * 128 + r < cne) ? le[r] : 0; }
        id += gridDim.x;
        if (id < total) { MOE_SETUP(id); gemm_issue0(lds, ar, br); }
#pragma unroll
        for (int m = 0; m < 4; ++m) {
            const int r = wr * 64 + m * 16 + fr;
            if (cmt * 128 + r < cne) {
                const int aid = aidq[m];
                if (WHICH == 0) {
                    const f32x4 a1 = acc[m][0], a3 = acc[m][1], b1 = acc[m][2], b3 = acc[m][3];
                    gst_u4(H + (size_t)aid * 512 + cnt_ * 64 + wc * 32 + fq * 8, cvt_pk(siluf_(a1[0]) * a3[0], siluf_(a1[1]) * a3[1]), cvt_pk(siluf_(a1[2]) * a3[2], siluf_(a1[3]) * a3[3]),
                           cvt_pk(siluf_(b1[0]) * b3[0], siluf_(b1[1]) * b3[1]), cvt_pk(siluf_(b1[2]) * b3[2], siluf_(b1[3]) * b3[3]));
                } else store16(Y + (size_t)aid * 1024 + cnt_ * 128 + wc * 64 + fq * 16, acc[m]);
            }
        }
    }
#undef MOE_SETUP
    __syncthreads();
    if (split_tail) {
        const int hid = (blockIdx.x & 7) * (gridDim.x >> 3) + (blockIdx.x >> 3);
        if (hid < 2 * rem) {
            const int id = full + (hid >> 1), hf = hid & 1;
            const int nt = id & 7, mg = id >> 3;
            int e = 0;
#pragma unroll 1
            for (int s2 = 16; s2 >= 1; s2 >>= 1) if (pre[e + s2] <= mg) e += s2;
            const int mt = mg - pre[e], ne = cnt[e];
            const int* le = list + e * LIST_CAP + mt * 128;
            const bf16_t* ar[4]; const bf16_t* br[2];
            const int co_ = glds_chunk(t) * 8;
#pragma unroll
            for (int i = 0; i < 4; ++i) {
                int r = (t >> 3) + 32 * i; r = (mt * 128 + r < ne) ? r : 0;
                const int aid = le[r];
                ar[i] = ((WHICH == 0) ? hm + (size_t)(aid >> 1) * 1024 : H + (size_t)aid * 512) + co_;
            }
            f32x4 acc[2][4];
            int aidq[2];
            if (WHICH == 0) {
                const bf16_t* wt = (const bf16_t*)(p.ws + W_MOE13) + ((size_t)(L * 32 + e) * 1024 + nt * 128 + hf * 64) * 1024;
#pragma unroll
                for (int i = 0; i < 2; ++i) {
                    const int ro = (t >> 3) + 32 * i, n_ = (ro >> 4) & 3, hc = ((ro >> 2) & 3) * 8 + (n_ >> 1) * 4 + (ro & 3);
                    br[i] = wt + (size_t)((hc >> 4) * 32 + (n_ & 1) * 16 + (hc & 15)) * 1024 + co_;
                }
                gemm_hn(lds, 16, ar, br, acc);
#pragma unroll
                for (int m = 0; m < 2; ++m) { const int r = wid * 32 + m * 16 + fr; aidq[m] = (mt * 128 + r < ne) ? le[r] : 0; }
#pragma unroll
                for (int m = 0; m < 2; ++m) {
                    const int r = wid * 32 + m * 16 + fr;
                    if (mt * 128 + r < ne) {
                        const f32x4 a1 = acc[m][0], a3 = acc[m][1], b1 = acc[m][2], b3 = acc[m][3];
                        gst_u4(H + (size_t)aidq[m] * 512 + nt * 64 + hf * 32 + fq * 8, cvt_pk(siluf_(a1[0]) * a3[0], siluf_(a1[1]) * a3[1]), cvt_pk(siluf_(a1[2]) * a3[2], siluf_(a1[3]) * a3[3]),
                               cvt_pk(siluf_(b1[0]) * b3[0], siluf_(b1[1]) * b3[1]), cvt_pk(siluf_(b1[2]) * b3[2], siluf_(b1[3]) * b3[3]));
                    }
                }
            } else {
                const bf16_t* wt = (const bf16_t*)(p.ws + W_MOE2) + ((size_t)(L * 32 + e) * 1024 + nt * 128 + hf * 64) * 512;
#pragma unroll
                for (int i = 0; i < 2; ++i) br[i] = wt + (size_t)perm64((t >> 3) + 32 * i) * 512 + co_;
                gemm_hn(lds, 8, ar, br, acc);
#pragma unroll
                for (int m = 0; m < 2; ++m) { const int r = wid * 32 + m * 16 + fr; aidq[m] = (mt * 128 + r < ne) ? le[r] : 0; }
#pragma unroll
                for (int m = 0; m < 2; ++m) {
                    const int r = wid * 32 + m * 16 + fr;
                    if (mt * 128 + r < ne) store16(Y + (size_t)aidq[m] * 1024 + nt * 128 + hf * 64 + fq * 16, acc[m]);
                }
            }
        }
    }
}

constexpr int NPHASE = 37;
#ifndef PHSEL
#define PHSEL -1
#endif
#ifndef PHEXC
#define PHEXC -2
#endif
#define PHON(x) ((PHSEL < 0 || PHSEL == (x)) && PHEXC != (x))
__global__ void __launch_bounds__(256, 2) mega(Params p_in) {
    PRef p = *(const CAS Params*)__builtin_amdgcn_kernarg_segment_ptr();
    extern __shared__ __attribute__((aligned(16))) char lds[];
    volatile LAS unsigned* xbw = (volatile LAS unsigned*)(lds + 73728);
    if (threadIdx.x == 0) { xbw[0] = 0u; xbw[1] = 0u; xbw[2] = 0u; xbw[3] = 0u; }
    __syncthreads();
    XcdBarrier bar;
    const bool multi = (p.ph_hi - p.ph_lo) > 1;
    (void)multi;
    if (multi) bar = xcd_barrier_post((unsigned*)(p.ws + OFF_CTL), xbw);
    char* S = p.ws + OFF_SLOT;
#ifdef DBG_STOP
    if (p.ph_lo == 100) {
        const float* src = (const float*)(p.ws + DBG_SRC);
        for (size_t i = (size_t)blockIdx.x * 256 + threadIdx.x; i < (size_t)NTOK * DM; i += (size_t)gridDim.x * 256) {
            float v = DBG_BF16 ? bf2f(((const bf16_t*)src)[i]) : src[i];
            if (!(fabsf(v) < 1e30f)) v = 1e30f;
            p.out[i] = v;
        }
        return;
    }
#endif
    const int ph_lo_ = p.ph_lo, ph_hi_ = p.ph_hi;
#ifdef TIMEIT
    unsigned long long t0_ = 0, t1_ = 0;
#endif
#ifdef DUP_PHASE
    bool dup_done_ = false;
#endif
    for (int ph = ph_lo_; ph < ph_hi_; ++ph) {
        const CAS Params* pp_ = (const CAS Params*)__builtin_amdgcn_kernarg_segment_ptr();
        asm volatile("" : "+s"(pp_));
        PRef p = *pp_;
#ifdef TIMEIT
        if (ph == TIME_A) t0_ = __builtin_amdgcn_s_memrealtime();
        if (ph == TIME_B) t1_ = __builtin_amdgcn_s_memrealtime();
#endif
        int L, sub, kind;
        if (ph < 2) { L = 0; sub = ph; kind = -1; }
        else if (ph < 11) { L = 0; kind = 0; sub = ph - 2; }
        else if (ph < 20) { L = 1; kind = 1; sub = ph - 11; }
        else if (ph < 28) { L = 2; kind = 2; sub = ph - 20; }
        else { L = 3; kind = 0; sub = ph - 28; }
        const int jr = L / 3;
        if (kind == -1) { if (sub == 0) { if (PHON(0)) phase_prologue(p, lds); } else { if (PHON(1)) phase_h0(p); } }
        else {
            const int ntail = (kind == 2) ? 4 : 5;
            if (sub < ntail) {
                if (kind == 0) {
                    if (sub == 0) { if (PHON(2)) phase_gemm_jobs(p, lds, jr * 7, jr * 7 + (jr ? 7 : 6)); }
                    else if (sub == 1) { if (PHON(3)) phase_rw2(p, jr); }
                    else if (sub == 2) { if (PHON(4)) {
                        if (jr == 0) {
                            int* const tk = (int*)(p.ws + OFF_CTL + 20544);
                            const int late = p.cj_tiles - p.cj_early;
                            if ((blockIdx.x >> 8) & 1) conv_run(p, lds, p.cj_early, late, tk, (late * 2) / 5);
                            __builtin_amdgcn_s_setprio(3);
                            phase_rw3c(p, jr, lds);
                            __builtin_amdgcn_s_setprio(0);
                            conv_run(p, lds, p.cj_early, late, tk, late);
                        } else phase_rw3c(p, jr, lds);
                    } }
                    else if (sub == 3) { if (PHON(5)) phase_zrw(p, jr); }
                    else { if (PHON(2)) phase_gemm_jobs(p, lds, 16 + jr, 17 + jr); }
                } else if (kind == 1) {
                    if (sub == 0) { if (PHON(2)) phase_gemm_jobs(p, lds, 14, 15); }
                    else if (sub == 1) { if (PHON(6)) phase_cml(p); }
                    else if (sub == 2) { if (PHON(6)) phase_ml2(p, lds); }
                    else if (sub == 3) { if (PHON(7)) phase_zml(p); }
                    else { if (PHON(2)) phase_gemm_jobs(p, lds, 18, 19); }
                } else {
                    if (sub == 0) { if (PHON(2)) phase_gemm_jobs(p, lds, 15, 16); }
                    else if (sub == 1) { if (PHON(8)) phase_rt2(p, lds); }
                    else if (sub == 2) { if (PHON(9)) phase_zrt(p); }
                    else { if (PHON(2)) phase_gemm_jobs(p, lds, 19, 20); }
                }
            } else {
                const int ts = sub - ntail;
                const bf16_t* ymix = (const bf16_t*)(S + (kind == 2 ? 1 : 6) * SLOT);
                bf16_t* hm = (bf16_t*)(S + (kind == 2 ? 2 : 7) * SLOT);
                bf16_t* H = (bf16_t*)(S + (kind == 0 ? 2 : (kind == 1 ? 5 : 3)) * SLOT);
                if (ts == 0) { if (PHON(10)) phase_ln1(p, L, lds, ymix, hm); }
                else if (ts == 1) { if (PHON(11)) phase_moe<0>(p, L, lds, hm, H); }
                else if (ts == 2) { if (PHON(12)) phase_moe<1>(p, L, lds, hm, H); }
                else { if (PHON(13)) phase_ln2(p, L); }
            }
        }
#ifdef DUP_PHASE
        if (((DUP_PHASE >> ph) & 1u) && !dup_done_) { dup_done_ = true; xcd_barrier(bar); --ph; continue; }
        dup_done_ = false;
#endif
        if (ph + 1 < ph_hi_) xcd_barrier(bar);
    }
#ifdef TIMEIT
    {
        xcd_barrier(bar);
        unsigned* tw = (unsigned*)(p.ws + OFF_CTL + 32768);
        if (blockIdx.x == 0 && threadIdx.x == 0) {
            if (t1_ == 0) t1_ = __builtin_amdgcn_s_memrealtime();
            const unsigned long long dt = t1_ - t0_;
            unsigned ms2 = (unsigned)((dt + TIME_U / 2) / TIME_U);
            __hip_atomic_store(tw, ms2, __ATOMIC_RELAXED, __HIP_MEMORY_SCOPE_AGENT);
        }
        xcd_barrier(bar);
        const float c_ = sqrtf((float)__hip_atomic_load(tw, __ATOMIC_RELAXED, __HIP_MEMORY_SCOPE_AGENT));
        for (size_t i = (size_t)blockIdx.x * 256 + threadIdx.x; i < (size_t)NTOK * DM; i += (size_t)gridDim.x * 256) p.out[i] = c_;
    }
#endif
#ifdef DBG_STOP
    if (ph_lo_ != 100) {
        xcd_barrier(bar);
        const float* src = (const float*)(p.ws + DBG_SRC);
        for (size_t i = (size_t)blockIdx.x * 256 + threadIdx.x; i < (size_t)NTOK * DM; i += (size_t)gridDim.x * 256) {
            float v = DBG_BF16 ? bf2f(((const bf16_t*)src)[i]) : src[i];
            if (!(fabsf(v) < 1e30f)) v = 1e30f;
            p.out[i] = v;
        }
    }
#endif
}

constexpr int LDS_BYTES = 73728 + 64;
extern "C" void kernel_launch(void* const* d_in, const int* in_sizes, int n_in, void* d_out, int out_size, void* d_ws, size_t ws_size, hipStream_t stream) {
    static int grid = 0;
    if (grid == 0) {
        if (n_in != 43 || out_size != NTOK * DM || ws_size < WS_NEED) { fprintf(stderr, "kernel_launch: unexpected shapes (n_in %d out %d ws %zu need %zu)\n", n_in, out_size, ws_size, (size_t)WS_NEED); }
        int dev = 0, cus = 0, per_cu = 0;
        (void)hipGetDevice(&dev); (void)hipDeviceGetAttribute(&cus, hipDeviceAttributeMultiprocessorCount, dev);
        (void)hipFuncSetAttribute((const void*)mega, hipFuncAttributeMaxDynamicSharedMemorySize, LDS_BYTES);
        (void)hipOccupancyMaxActiveBlocksPerMultiprocessor(&per_cu, (const void*)mega, 256, LDS_BYTES);
        if (per_cu > 2) per_cu = 2;
        if (per_cu < 1) per_cu = 1;
        grid = cus * per_cu;
        if (grid > 512) grid = 512;
        (void)hipGetLastError();
    }
    Params p{};
    for (int i = 0; i < 43; ++i) p.in[i] = (const float*)d_in[i];
    p.out = (float*)d_out; p.ws = (char*)d_ws;
    char* ws = (char*)d_ws;
    auto slot = [&](int i) { return (bf16_t*)(ws + OFF_SLOT + (size_t)i * SLOT); };
    int tile = 0;
    auto addg = [&](int idx, const bf16_t* A, const bf16_t* Bt, bf16_t* out, int K, int N, int ldo, int mode) {
        GJob& g = p.gj[idx]; g.A = A; g.Bt = Bt; g.out = out; g.K = K; g.N = N; g.ldo = ldo; g.mode = mode; g.half = (mode <= MODE_SIGM && N <= 128) ? 1 : 0; g.ntn = g.half ? (N + 63) / 64 : (N + 127) / 128; g.tile0 = tile; tile += 128 * g.ntn;
    };
    for (int jr = 0; jr < 2; ++jr) {
        const bf16_t* rkv = (const bf16_t*)(ws + W_RKV) + (size_t)jr * 3 * 1024 * 1024;
        addg(jr * 7 + 0, slot(0), rkv, slot(6), 1024, 1024, 1024, MODE_BF16);
        addg(jr * 7 + 1, slot(1), rkv + 1024 * 1024, slot(7), 1024, 1024, 1024, MODE_BF16);
        addg(jr * 7 + 2, slot(2), rkv + 2 * 1024 * 1024, slot(jr == 0 ? 11 : 8), 1024, 1024, 1024, MODE_BF16);
        addg(jr * 7 + 3, slot(3), (const bf16_t*)(ws + W_W1T) + (size_t)jr * 64 * 1024, (bf16_t*)(ws + OFF_LW), 1024, 64, 64, MODE_TANH);
        addg(jr * 7 + 4, slot(4), (const bf16_t*)(ws + W_A1T) + (size_t)jr * 64 * 1024, (bf16_t*)(ws + OFF_LA), 1024, 64, 64, MODE_BF16);
        addg(jr * 7 + 5, slot(5), (const bf16_t*)(ws + W_G1T) + (size_t)jr * 128 * 1024, (bf16_t*)(ws + OFF_LG), 1024, 128, 128, MODE_SIGM);
        addg(jr * 7 + 6, slot(2), (const bf16_t*)(ws + W_V1T), (bf16_t*)(ws + OFF_LV), 1024, 32, 32, MODE_BF16);
    }
    addg(14, slot(0), (const bf16_t*)(ws + W_MLIN), nullptr, 1024, 3088, 0, MODE_ML1);
    addg(15, slot(0), (const bf16_t*)(ws + W_RTIN), nullptr, 1024, 6144, 0, MODE_RT1);
    addg(16, slot(7), (const bf16_t*)(ws + W_OUT), slot(6), 1024, 1024, 1024, MODE_BF16);
    addg(17, slot(7), (const bf16_t*)(ws + W_OUT) + 1024 * 1024, slot(6), 1024, 1024, 1024, MODE_BF16);
    addg(18, slot(1), (const bf16_t*)(ws + W_MLOUT), slot(6), 1024, 1024, 1024, MODE_BF16);
    addg(19, slot(3), (const bf16_t*)(ws + W_RTOUT), slot(1), 2048, 1024, 1024, MODE_BF16);
    int nc = 0, ctile = 0;
    auto addc = [&](const float* src, size_t dst_off, int K, int N, int nb, long sbs, long dbs, int mode) {
        CJob& c = p.cj[nc++]; c.src = src; c.dst = (bf16_t*)(ws + dst_off); c.K = K; c.N = N; c.nb = nb; c.mode = mode; c.sbs = sbs; c.dbs = dbs;
        c.tiles_pb = ((K + 63) / 64) * ((N + 255) / 256); c.tile0 = ctile; ctile += c.tiles_pb * nb;
    };
    addc(p.in[7], W_RKV, 1024, 1024, 3, 1024 * 1024, 1024 * 1024, 0);
    addc(p.in[9], W_W1T, 1024, 64, 1, 0, 0, 0);
    addc(p.in[12], W_A1T, 1024, 64, 1, 0, 0, 0);
    addc(p.in[17], W_G1T, 1024, 128, 1, 0, 0, 0);
    addc(p.in[10], W_W2T, 64, 1024, 1, 0, 0, 0);
    addc(p.in[13], W_A2T, 64, 1024, 1, 0, 0, 0);
    addc(p.in[18], W_G2T, 128, 1024, 1, 0, 0, 0);
    p.cj_early = ctile;
    addc(p.in[7] + (size_t)3 * 1024 * 1024, W_RKV + (size_t)3 * 1024 * 1024 * 2, 1024, 1024, 3, 1024 * 1024, 1024 * 1024, 0);
    addc(p.in[24], W_OUT, 1024, 1024, 2, 1024 * 1024, 1024 * 1024, 0);
    addc(p.in[9] + 1024 * 64, W_W1T + (size_t)64 * 1024 * 2, 1024, 64, 1, 0, 0, 0);
    addc(p.in[12] + 1024 * 64, W_A1T + (size_t)64 * 1024 * 2, 1024, 64, 1, 0, 0, 0);
    addc(p.in[17] + 1024 * 128, W_G1T + (size_t)128 * 1024 * 2, 1024, 128, 1, 0, 0, 0);
    addc(p.in[15], W_V1T, 1024, 32, 1, 0, 0, 0);
    addc(p.in[10] + 64 * 1024, W_W2T + (size_t)1024 * 64 * 2, 64, 1024, 1, 0, 0, 0);
    addc(p.in[13] + 64 * 1024, W_A2T + (size_t)1024 * 64 * 2, 64, 1024, 1, 0, 0, 0);
    addc(p.in[18] + 128 * 1024, W_G2T + (size_t)1024 * 128 * 2, 128, 1024, 1, 0, 0, 0);
    addc(p.in[16], W_V2T, 32, 1024, 1, 0, 0, 0);
    addc(p.in[25], W_MLIN, 1024, 3088, 1, 0, 0, 0);
    addc(p.in[31], W_MLOUT, 1024, 1024, 1, 0, 0, 0);
    addc(p.in[32], W_RTIN, 1024, 6144, 1, 0, 0, 3);
    addc(p.in[35], W_RTOUT, 2048, 1024, 1, 0, 0, 0);
    addc(p.in[40], W_MOE13, 1024, 512, 128, 1024 * 512, 1024 * 1024, 1);
    addc(p.in[41], W_MOE13, 1024, 512, 128, 1024 * 512, 1024 * 1024, 2);
    addc(p.in[42], W_MOE2, 512, 1024, 128, 512 * 1024, 1024 * 512, 0);
    p.ncj = nc; p.cj_tiles = ctile;

    (void)hipMemsetAsync(ws + OFF_CTL, 0, CTL_BYTES, stream);
#ifdef DBG_STOP
    const int nph = DBG_STOP;
#else
    const int nph = NPHASE;
#endif
#ifdef MULTI_LAUNCH
    for (int ph = 0; ph < nph; ++ph) { p.ph_lo = ph; p.ph_hi = ph + 1; hipLaunchKernelGGL(mega, dim3(grid), dim3(256), LDS_BYTES, stream, p); }
    if (0)
#endif
    {
        p.ph_lo = 0; p.ph_hi = nph;
        void* args[] = {&p};
        hipError_t e = hipLaunchCooperativeKernel((const void*)mega, dim3(grid), dim3(256), args, LDS_BYTES, stream);
        if (e != hipSuccess) fprintf(stderr, "cooperative launch failed: %s (grid %d)\n", hipGetErrorString(e), grid);
    }
}
```
